# Optimizing an MI355X kernel written in HIP

```python
import numpy as np
import jax
import jax.numpy as jnp
from jax import lax

D_MODEL = 1024
BATCH = 8
SEQ = 4096
DEPTH = 2

HEAD_DIM = 64
N_MIXERS = 4
GROUP_W = D_MODEL // N_MIXERS
N_HEADS = GROUP_W // HEAD_DIM
MIX_W = N_MIXERS * GROUP_W

RWKV_DECAY_RANK = 64
RWKV_AAA_RANK = 64
RWKV_GATE_RANK = 128
RWKV_DECAY_SCALE = 0.606531
RWKV_GN_EPS = 64e-5

CONV_W = 3

DIL_CFG = ((128, 1), (512, 4), (2048, 16))

CMP_LEN = 32
CMP_STRIDE = 16
CMP_HIDDEN = 256
SEL_BLK = 64
SEL_TOP = 16
SWA_WIN = 512
FORCE_SCORE = 1e4

N_EXPERTS = 32
TOP_K = 4
EXPERT_FF = D_MODEL
SWIGLU_LIMIT = 7.0
SWIGLU_ALPHA = 1.702
MOE_BLK = 128

ROPE_THETA = 10000.0
NORM_EPS = 1e-6
QBLK = 128
NEG = -1e30

A_WIDTHS = (GROUP_W, GROUP_W, GROUP_W, RWKV_DECAY_RANK, RWKV_AAA_RANK, RWKV_GATE_RANK)
B_WIDTHS = (GROUP_W, GROUP_W, GROUP_W)
C_WIDTHS = (GROUP_W, GROUP_W, GROUP_W)
D_WIDTHS = (GROUP_W, HEAD_DIM, HEAD_DIM, HEAD_DIM, HEAD_DIM, HEAD_DIM, HEAD_DIM, 3 * N_HEADS)
SECTION_WIDTHS = (sum(A_WIDTHS), sum(B_WIDTHS), sum(C_WIDTHS), sum(D_WIDTHS))
PROJ_W = sum(SECTION_WIDTHS)

kernel_name = 'hybrid_rwkv7_shortconv_dilattn_nsa_moe'


def split_cols(z, widths):
    offs = np.cumsum((0,) + tuple(widths))
    return [z[..., int(offs[i]):int(offs[i + 1])] for i in range(len(widths))]


def rmsnorm(x, g):
    xf = x.astype(jnp.float32)
    y = xf * lax.rsqrt(jnp.mean(xf * xf, axis=-1, keepdims=True) + NORM_EPS)
    return (y * g.astype(jnp.float32)).astype(x.dtype)


def rope(x, pos):
    half = x.shape[-1] // 2
    inv = ROPE_THETA ** (-jnp.arange(half, dtype=jnp.float32) / half)
    ang = pos.astype(jnp.float32)[:, :, None, None] * inv
    cos, sin = jnp.cos(ang), jnp.sin(ang)
    xf = x.astype(jnp.float32)
    x1, x2 = xf[..., :half], xf[..., half:]
    return jnp.concatenate([x1 * cos - x2 * sin, x2 * cos + x1 * sin], axis=-1).astype(x.dtype)


def token_shift(z):
    return jnp.pad(z, ((0, 0), (1, 0), (0, 0)))[:, :-1]


def banded_attention(q, k, v, window):
    B, L, Hq, hd = q.shape
    Hk = k.shape[2]
    G = Hq // Hk
    nb = -(-L // QBLK)
    Lp = nb * QBLK
    npv = -(-window // QBLK)
    pad = ((0, 0), (0, Lp - L), (0, 0), (0, 0))
    q, k, v = jnp.pad(q, pad), jnp.pad(k, pad), jnp.pad(v, pad)
    bpad = ((0, 0), (npv, 0), (0, 0), (0, 0), (0, 0))
    kb = jnp.pad(k.reshape(B, nb, QBLK, Hk, hd), bpad)
    vb = jnp.pad(v.reshape(B, nb, QBLK, Hk, hd), bpad)
    bidx = np.arange(nb)[:, None] + np.arange(npv + 1)[None, :]
    J = (npv + 1) * QBLK
    kband = kb[:, bidx].reshape(B, nb, J, Hk, hd)
    vband = vb[:, bidx].reshape(B, nb, J, Hk, hd)
    qb = q.reshape(B, nb, QBLK, Hk, G, hd)
    s = jnp.einsum('bnqkgd,bnjkd->bnkgqj', qb, kband).astype(jnp.float32) * (hd ** -0.5)
    qpos = np.arange(nb)[:, None] * QBLK + np.arange(QBLK)[None, :]
    kpos = (np.arange(nb)[:, None] - npv) * QBLK + np.arange(J)[None, :]
    dist = qpos[:, :, None] - kpos[:, None, :]
    mask = (dist >= 0) & (dist <= window) & (kpos[:, None, :] >= 0)
    s = jnp.where(mask[None, :, None, None], s, NEG)
    lse = jax.nn.logsumexp(s, axis=-1)
    p = jnp.exp(s - lse[..., None]).astype(v.dtype)
    o = jnp.einsum('bnkgqj,bnjkd->bnqkgd', p, vband).reshape(B, Lp, Hq, hd)[:, :L]
    lse = jnp.transpose(lse, (0, 1, 4, 2, 3)).reshape(B, Lp, Hq)[:, :L]
    return o, lse


def decimate(t, d):
    B, S = t.shape[:2]
    t = t.reshape((B, S // d, d) + t.shape[2:])
    return jnp.moveaxis(t, 2, 1).reshape((B * d, S // d) + t.shape[3:])


def undecimate(t, d, B):
    Sd = t.shape[1]
    t = t.reshape((B, d, Sd) + t.shape[2:])
    return jnp.moveaxis(t, 1, 2).reshape((B, Sd * d) + t.shape[3:])


def rwkv7_scan(r, w, k, v, kk, b):
    B, S, H, N = r.shape
    tm = lambda t: jnp.moveaxis(t, 1, 0)

    def step(st, inp):
        r_t, w_t, k_t, v_t, kk_t, b_t = inp
        sa = jnp.einsum('bhij,bhj->bhi', st, -kk_t)
        st = st * w_t[:, :, None, :] + sa[..., None] * b_t[:, :, None, :] + v_t[..., None] * k_t[:, :, None, :]
        return st, jnp.einsum('bhij,bhj->bhi', st, r_t)

    s0 = jnp.zeros((B, H, N, N), jnp.float32)
    _, ys = lax.scan(step, s0, (tm(r), tm(w), tm(k), tm(v), tm(kk), tm(b)))
    return jnp.moveaxis(ys, 0, 1)


def rwkv7_mix(r, k, v, wd, ad, gd, w0, w2, a0, a2, g2, k_k, k_a, r_k, gn_w, gn_b):
    B, S, C = r.shape
    H = C // HEAD_DIM
    f32 = jnp.float32
    heads = lambda t: t.reshape(B, S, H, HEAD_DIM).astype(f32)
    w = jnp.exp(-RWKV_DECAY_SCALE * jax.nn.sigmoid((w0 + jnp.tanh(wd) @ w2).astype(f32)))
    a = jax.nn.sigmoid(a0 + ad @ a2)
    g = jax.nn.sigmoid(gd) @ g2
    kk = heads(k * k_k)
    kk = kk * lax.rsqrt(jnp.sum(kk * kk, axis=-1, keepdims=True) + 1e-12)
    k = k * (1.0 + (a - 1.0) * k_a)
    y = rwkv7_scan(heads(r), heads(w), heads(k), heads(v), kk, kk * heads(a))
    mu = jnp.mean(y, axis=-1, keepdims=True)
    var = jnp.mean(jnp.square(y - mu), axis=-1, keepdims=True)
    y = (y - mu) * lax.rsqrt(var + RWKV_GN_EPS) * gn_w.reshape(H, HEAD_DIM).astype(f32) + gn_b.reshape(H, HEAD_DIM).astype(f32)
    y = y + jnp.sum(heads(r) * heads(k) * r_k.astype(f32), axis=-1, keepdims=True) * heads(v)
    return (y.reshape(B, S, C) * g.astype(f32)).astype(r.dtype)


def short_conv_mix(bg, cg, xin, conv_w):
    u = cg * xin
    y = lax.conv_general_dilated(u, conv_w[:, None, :].astype(u.dtype), window_strides=(1,),
                                 padding=((CONV_W - 1, 0),), dimension_numbers=('NWC', 'WIO', 'NWC'),
                                 feature_group_count=u.shape[-1])
    return bg * y


def dilated_mix(q, k, v, q_g, k_g, pos):
    B, S, H, hd = q.shape
    q = rope(rmsnorm(q, q_g), pos)
    k = rope(rmsnorm(k, k_g), pos)
    outs, lses = [], []
    for window, dil in DIL_CFG:
        o, lse = banded_attention(decimate(q, dil), decimate(k, dil), decimate(v, dil), window // dil)
        outs.append(undecimate(o, dil, B))
        lses.append(undecimate(lse, dil, B))
    wts = jax.nn.softmax(jnp.stack(lses), axis=0)
    o = jnp.einsum('cbsh,cbshd->bshd', wts.astype(q.dtype), jnp.stack(outs))
    return o.reshape(B, S, H * hd)


def selection_overlap(n_c, n_sel):
    r = SEL_BLK // CMP_STRIDE
    m = CMP_LEN // CMP_STRIDE
    diff = np.arange(n_c)[:, None] - r * np.arange(n_sel)[None, :]
    offs = (np.arange(r)[:, None] - np.arange(m)[None, :]).reshape(-1)
    return (diff[..., None] == offs).sum(-1).astype(np.float32)


def nsa_mix(q, kc, vc, ks, vs, kw, vw, gl, q_g, kc_g, ks_g, kw_g, pe_k, pe_v, wk1, wk2, wv1, wv2, pos):
    B, S, H, hd = q.shape
    f32 = jnp.float32
    scale = hd ** -0.5
    q_n = rmsnorm(q, q_g)
    q_r = rope(q_n, pos)
    qidx = np.arange(S)
    n_c = (S - CMP_LEN) // CMP_STRIDE + 1
    cidx = np.arange(n_c)[:, None] * CMP_STRIDE + np.arange(CMP_LEN)[None, :]

    def compress(t, pe, w1, w2):
        blk = (t[:, cidx] + pe).reshape(B, n_c, CMP_LEN * hd)
        return jax.nn.gelu(blk @ w1) @ w2

    k_cmp = rmsnorm(compress(kc, pe_k, wk1, wk2), kc_g)
    v_cmp = compress(vc, pe_v, wv1, wv2)
    s = jnp.einsum('bshd,bcd->bhsc', q_n, k_cmp).astype(f32) * scale
    valid = cidx[:, -1][None, :] <= qidx[:, None]
    s = jnp.where(valid, s, NEG)
    p_cmp = jax.nn.softmax(s, axis=-1) * valid.any(-1, keepdims=True).astype(np.float32)
    o_cmp = jnp.einsum('bhsc,bcd->bshd', p_cmp.astype(v_cmp.dtype), v_cmp)
    n_sel = S // SEL_BLK
    n_top = min(SEL_TOP, n_sel)
    imp = jnp.einsum('bhsc,cj->bsj', p_cmp, selection_overlap(n_c, n_sel))
    cur = qidx[:, None] // SEL_BLK
    jb = np.arange(n_sel)[None, :]
    future = jb > cur
    forced = (jb == 0) | (jb == cur) | (jb == cur - 1)
    score = jnp.where(future, -1.0, jnp.where(forced, FORCE_SCORE, imp))
    _, sel = lax.top_k(score, n_top)
    ks_r = rope(rmsnorm(ks[:, :, None, :], ks_g), pos)[:, :, 0]
    kb = ks_r.reshape(B, n_sel, SEL_BLK, hd)
    vb = vs.reshape(B, n_sel, SEL_BLK, hd)
    nq = S // QBLK
    gather = jax.vmap(lambda t, i: t[i])

    def sel_block(args):
        qc, ic, tc = args
        kg = gather(kb, ic).reshape(B, QBLK, n_top * SEL_BLK, hd)
        vg = gather(vb, ic).reshape(B, QBLK, n_top * SEL_BLK, hd)
        kpos = (ic[..., None] * SEL_BLK + jnp.arange(SEL_BLK)).reshape(B, QBLK, n_top * SEL_BLK)
        sc = jnp.einsum('bqhd,bqjd->bhqj', qc, kg).astype(f32) * scale
        sc = jnp.where((kpos <= tc[None, :, None])[:, None], sc, NEG)
        pc = jax.nn.softmax(sc, axis=-1).astype(vg.dtype)
        return jnp.einsum('bhqj,bqjd->bqhd', pc, vg)

    o_slc = lax.map(sel_block, (jnp.moveaxis(q_r.reshape(B, nq, QBLK, H, hd), 1, 0),
                                jnp.moveaxis(sel.reshape(B, nq, QBLK, n_top), 1, 0),
                                jnp.asarray(qidx.reshape(nq, QBLK))))
    o_slc = jnp.moveaxis(o_slc, 0, 1).reshape(B, S, H, hd)
    kw_r = rope(rmsnorm(kw[:, :, None, :], kw_g), pos)
    o_swa, _ = banded_attention(q_r, kw_r, vw[:, :, None, :], SWA_WIN - 1)
    gt = jax.nn.sigmoid(gl.astype(f32)).reshape(B, S, H, 3).astype(q.dtype)
    o = gt[..., 0:1] * o_cmp + gt[..., 1:2] * o_slc + gt[..., 2:3] * o_swa
    return o.reshape(B, S, H * hd)


def hybrid_mixer(h, positions, w_in, w_out, rwkv_mu, rwkv_w0, rwkv_w2, rwkv_a0, rwkv_a2, rwkv_g2,
                 rwkv_kk, rwkv_ka, rwkv_rk, rwkv_gn_w, rwkv_gn_b, conv_w, dil_q_g, dil_k_g,
                 nsa_q_g, nsa_kc_g, nsa_ks_g, nsa_kw_g, nsa_pe_k, nsa_pe_v, nsa_wk1, nsa_wk2,
                 nsa_wv1, nsa_wv2, onorm_g):
    B, S, _ = h.shape
    proj = h @ w_in
    za, zb, zc, zd = split_cols(proj, SECTION_WIDTHS)
    za = za + (token_shift(za) - za) * rwkv_mu
    r, k, v, wd, ad, gd = split_cols(za, A_WIDTHS)
    y_a = rwkv7_mix(r, k, v, wd, ad, gd, rwkv_w0, rwkv_w2, rwkv_a0, rwkv_a2, rwkv_g2,
                    rwkv_kk, rwkv_ka, rwkv_rk, rwkv_gn_w, rwkv_gn_b)
    bg, cg, xin = split_cols(zb, B_WIDTHS)
    y_b = short_conv_mix(bg, cg, xin, conv_w)
    cq, ck, cv = [t.reshape(B, S, N_HEADS, HEAD_DIM) for t in split_cols(zc, C_WIDTHS)]
    y_c = dilated_mix(cq, ck, cv, dil_q_g, dil_k_g, positions)
    dq, dkc, dvc, dks, dvs, dkw, dvw, dg = split_cols(zd, D_WIDTHS)
    y_d = nsa_mix(dq.reshape(B, S, N_HEADS, HEAD_DIM), dkc, dvc, dks, dvs, dkw, dvw, dg,
                  nsa_q_g, nsa_kc_g, nsa_ks_g, nsa_kw_g, nsa_pe_k, nsa_pe_v,
                  nsa_wk1, nsa_wk2, nsa_wv1, nsa_wv2, positions)
    y_bcd = jnp.concatenate([y_b, y_c, y_d], axis=-1).reshape(B, S, 3 * N_HEADS, HEAD_DIM)
    y_bcd = rmsnorm(y_bcd, onorm_g.reshape(3 * N_HEADS, HEAD_DIM)).reshape(B, S, 3 * GROUP_W)
    return jnp.concatenate([y_a, y_bcd], axis=-1) @ w_out


def moe(h, w_router, b_router, w_gu, b_gu, w_down, b_down):
    B, S, D = h.shape
    T = B * S
    TK = T * TOP_K
    xt = h.reshape(T, D)
    logits = (xt @ w_router + b_router).astype(jnp.float32)
    top_val, top_idx = lax.top_k(logits, TOP_K)
    gates = jax.nn.softmax(top_val, axis=-1)
    e_flat = top_idx.reshape(TK)
    order = jnp.argsort(e_flat)
    e_s = e_flat[order]
    tok_s = order // TOP_K
    g_s = gates.reshape(TK)[order]
    counts = jnp.bincount(e_flat, length=N_EXPERTS)
    padded = (counts + MOE_BLK - 1) // MOE_BLK * MOE_BLK
    pad_end = jnp.cumsum(padded)
    pad_start = pad_end - padded
    start = jnp.cumsum(counts) - counts
    dest = pad_start[e_s] + jnp.arange(TK) - start[e_s]
    n_rows = TK + N_EXPERTS * MOE_BLK
    n_blk = n_rows // MOE_BLK
    buf = jnp.zeros((n_rows, D), h.dtype).at[dest].set(xt[tok_s])
    blk_e = jnp.minimum(jnp.searchsorted(pad_end, jnp.arange(n_blk) * MOE_BLK, side='right'), N_EXPERTS - 1)

    def expert_block(args):
        xb, e = args
        gu = xb @ w_gu[e] + b_gu[e]
        gate, up = gu[:, :EXPERT_FF], gu[:, EXPERT_FF:]
        gate = jnp.minimum(gate, SWIGLU_LIMIT)
        up = jnp.clip(up, -SWIGLU_LIMIT, SWIGLU_LIMIT)
        act = gate * jax.nn.sigmoid(SWIGLU_ALPHA * gate) * (up + 1.0)
        return act @ w_down[e] + b_down[e]

    ybuf = lax.map(expert_block, (buf.reshape(n_blk, MOE_BLK, D), blk_e)).reshape(n_rows, D)
    y = ybuf[dest] * g_s[:, None].astype(h.dtype)
    return jax.ops.segment_sum(y, tok_s, num_segments=T).reshape(B, S, D)


def setup_inputs(seed: int = 0) -> dict:
    key = jax.random.key(seed)
    ks = iter(jax.random.split(key, 64))

    def nrm(shape, scale):
        return scale * jax.random.normal(next(ks), shape, jnp.float32)

    L, H, hd, D, F, E = DEPTH, N_HEADS, HEAD_DIM, D_MODEL, EXPERT_FF, N_EXPERTS
    x = nrm((BATCH, SEQ, D), 1.0)
    c = nrm((BATCH, D), 1.0)
    positions = (jax.random.randint(next(ks), (BATCH, 1), 0, 1024) + jnp.arange(SEQ)[None, :]).astype(jnp.int32)
    return {
        'x': x,
        'c': c,
        'positions': positions,
        'w_ada': nrm((L, D, 6 * D), 0.5 * D ** -0.5),
        'b_ada': nrm((L, 6 * D), 0.01),
        'norm1_g': 1.0 + nrm((L, D), 0.05),
        'norm2_g': 1.0 + nrm((L, D), 0.05),
        'w_in': nrm((L, D, PROJ_W), D ** -0.5),
        'w_out': nrm((L, MIX_W, D), MIX_W ** -0.5),
        'rwkv_mu': jax.random.uniform(next(ks), (L, SECTION_WIDTHS[0]), jnp.float32),
        'rwkv_w0': nrm((L, GROUP_W), 0.5),
        'rwkv_w2': nrm((L, RWKV_DECAY_RANK, GROUP_W), 0.5 * RWKV_DECAY_RANK ** -0.5),
        'rwkv_a0': nrm((L, GROUP_W), 0.5),
        'rwkv_a2': nrm((L, RWKV_AAA_RANK, GROUP_W), 0.5 * RWKV_AAA_RANK ** -0.5),
        'rwkv_g2': nrm((L, RWKV_GATE_RANK, GROUP_W), RWKV_GATE_RANK ** -0.5),
        'rwkv_kk': 0.85 + nrm((L, GROUP_W), 0.05),
        'rwkv_ka': 1.0 + nrm((L, GROUP_W), 0.05),
        'rwkv_rk': nrm((L, H, hd), 0.1),
        'rwkv_gn_w': 1.0 + nrm((L, GROUP_W), 0.05),
        'rwkv_gn_b': nrm((L, GROUP_W), 0.01),
        'conv_w': nrm((L, CONV_W, GROUP_W), CONV_W ** -0.5),
        'dil_q_g': 1.0 + nrm((L, hd), 0.05),
        'dil_k_g': 1.0 + nrm((L, hd), 0.05),
        'nsa_q_g': 1.0 + nrm((L, hd), 0.05),
        'nsa_kc_g': 1.0 + nrm((L, hd), 0.05),
        'nsa_ks_g': 1.0 + nrm((L, hd), 0.05),
        'nsa_kw_g': 1.0 + nrm((L, hd), 0.05),
        'nsa_pe_k': nrm((L, CMP_LEN, hd), 0.1),
        'nsa_pe_v': nrm((L, CMP_LEN, hd), 0.1),
        'nsa_wk1': nrm((L, CMP_LEN * hd, CMP_HIDDEN), (CMP_LEN * hd) ** -0.5),
        'nsa_wk2': nrm((L, CMP_HIDDEN, hd), CMP_HIDDEN ** -0.5),
        'nsa_wv1': nrm((L, CMP_LEN * hd, CMP_HIDDEN), (CMP_LEN * hd) ** -0.5),
        'nsa_wv2': nrm((L, CMP_HIDDEN, hd), CMP_HIDDEN ** -0.5),
        'onorm_g': 1.0 + nrm((L, 3 * GROUP_W), 0.05),
        'w_router': nrm((L, D, E), D ** -0.5),
        'b_router': nrm((L, E), 0.01),
        'w_gu': nrm((L, E, D, 2 * F), D ** -0.5),
        'b_gu': nrm((L, E, 2 * F), 0.01),
        'w_down': nrm((L, E, F, D), F ** -0.5),
        'b_down': nrm((L, E, D), 0.01),
    }


def reference(x, c, positions, w_ada, b_ada, norm1_g, norm2_g, w_in, w_out, rwkv_mu, rwkv_w0,
              rwkv_w2, rwkv_a0, rwkv_a2, rwkv_g2, rwkv_kk, rwkv_ka, rwkv_rk, rwkv_gn_w, rwkv_gn_b,
              conv_w, dil_q_g, dil_k_g, nsa_q_g, nsa_kc_g, nsa_ks_g, nsa_kw_g, nsa_pe_k, nsa_pe_v,
              nsa_wk1, nsa_wk2, nsa_wv1, nsa_wv2, onorm_g, w_router, b_router, w_gu, b_gu,
              w_down, b_down):
    for l in range(DEPTH):
        mod = jax.nn.silu(c) @ w_ada[l] + b_ada[l]
        sh1, sc1, gt1, sh2, sc2, gt2 = [m[:, None, :] for m in jnp.split(mod, 6, axis=-1)]
        h = rmsnorm(x, norm1_g[l]) * (1.0 + sc1) + sh1
        y = hybrid_mixer(h, positions, w_in[l], w_out[l], rwkv_mu[l], rwkv_w0[l], rwkv_w2[l],
                         rwkv_a0[l], rwkv_a2[l], rwkv_g2[l], rwkv_kk[l], rwkv_ka[l], rwkv_rk[l],
                         rwkv_gn_w[l], rwkv_gn_b[l], conv_w[l], dil_q_g[l], dil_k_g[l],
                         nsa_q_g[l], nsa_kc_g[l], nsa_ks_g[l], nsa_kw_g[l], nsa_pe_k[l], nsa_pe_v[l],
                         nsa_wk1[l], nsa_wk2[l], nsa_wv1[l], nsa_wv2[l], onorm_g[l])
        x = x + gt1 * y
        h = rmsnorm(x, norm2_g[l]) * (1.0 + sc2) + sh2
        x = x + gt2 * moe(h, w_router[l], b_router[l], w_gu[l], b_gu[l], w_down[l], b_down[l])
    return x
```

```cpp
#include <hip/hip_runtime.h>
#include <cstdio>
#include <cstdint>

#define DI __device__ __forceinline__
#define LAS __attribute__((address_space(3)))
#define GAS __attribute__((address_space(1)))
typedef unsigned short bf16;
typedef short bf16x8 __attribute__((ext_vector_type(8)));
typedef float f32x4 __attribute__((ext_vector_type(4)));
typedef float f32x2 __attribute__((ext_vector_type(2)));
typedef unsigned u32x4 __attribute__((ext_vector_type(4)));
typedef unsigned u32x2 __attribute__((ext_vector_type(2)));
typedef unsigned char uchar;

constexpr int NB = 8, NS = 4096, NT = NB * NS, DM = 1024, NPJ = 3328, NE = 32, FF = 1024, NLAYER = 2;
constexpr int PJ_A = 0, PJ_B = 1024, PJ_C = 1792, PJ_D = 2560;
constexpr int NR = NT * 4 + NE * 256;
constexpr int NTHR = 512, NWAVE = 8;

DI float bf2f(unsigned v) { return __builtin_bit_cast(float, v << 16); }
DI unsigned f2bf(float f) { unsigned u = __builtin_bit_cast(unsigned, f); return (u + 0x7fffu + ((u >> 16) & 1u)) >> 16; }
DI unsigned pk2(float lo, float hi) { return f2bf(lo) | (f2bf(hi) << 16); }
DI float bflo(unsigned w) { return __builtin_bit_cast(float, w << 16); }
DI float bfhi(unsigned w) { return __builtin_bit_cast(float, w & 0xffff0000u); }
DI float fexp2(float x) { return __builtin_amdgcn_exp2f(x); }
DI float fsigmoid(float x) { return 1.f / (1.f + __expf(-x)); }
DI float wsum_xor(float v, int o) { return v + __shfl_xor(v, o); }
template <int W> DI float group_sum(float v) {
#pragma unroll
    for (int o = 1; o < W; o <<= 1) v += __shfl_xor(v, o);
    return v;
}
DI float dpp_f(float x, const int ctrl_dummy);
template <int CTRL> DI float dppmov(float x) { return __builtin_bit_cast(float, __builtin_amdgcn_update_dpp(0, __builtin_bit_cast(int, x), CTRL, 0xF, 0xF, true)); }
DI float sum8(float x) { x += dppmov<0xB1>(x); x += dppmov<0x4E>(x); x += dppmov<0x141>(x); return x; }

#define XB_TMO      128
#define XB_XCNT(j)  (256  + 64 * (j))
#define XB_XSUB(j)  (1280 + 64 * (j))
#define XB_XGEN(j)  (2304 + 64 * (j))
#define XB_TOP      3328
#define XB_TOPGEN   3392
#define XCD_BAR_WORDS 3456
#define XB_SPIN_CAP (1u << 18)
DI unsigned xb_ld(unsigned* p)              { return __hip_atomic_load(p, __ATOMIC_RELAXED, __HIP_MEMORY_SCOPE_AGENT); }
DI unsigned xb_add(unsigned* p, unsigned v) { return __hip_atomic_fetch_add(p, v, __ATOMIC_RELAXED, __HIP_MEMORY_SCOPE_AGENT); }
DI unsigned xb_xcc_id() { return (unsigned)__builtin_amdgcn_s_getreg((3 << 11) | 20) & 0xFu; }
#define XB_SPIN(cond, bar) do { unsigned _sp = 0; while (cond) { __builtin_amdgcn_s_sleep(1); \
    if ((++_sp & 255u) == 0u) { if (xb_ld(&(bar)[XB_TMO])) break; if (_sp > XB_SPIN_CAP) { atomicAdd(&(bar)[XB_TMO], 1u); break; } } } } while (0)
struct XcdBarrier { unsigned* bar; unsigned x; volatile LAS unsigned* st; };
DI XcdBarrier xcd_barrier_post(unsigned* bar, volatile LAS unsigned* st) {
    XcdBarrier b; b.bar = bar; b.x = xb_xcc_id(); b.st = st;
    if (threadIdx.x == 0) (void)xb_add(&bar[XB_XCNT(b.x)], 1u);
    return b;
}
DI void xcd_barrier_complete(unsigned* bar, unsigned x, unsigned& nloc, unsigned& nx) {
    const unsigned G = gridDim.x * gridDim.y * gridDim.z;
    unsigned sum, cnt, mine, sp = 0u;
    for (;;) {
        sum = 0u; cnt = 0u; mine = 0u;
#pragma unroll
        for (unsigned j = 0; j < 16; ++j) { const unsigned c = xb_ld(&bar[XB_XCNT(j)]); sum += c; cnt += (c > 0u) ? 1u : 0u; mine = (j == x) ? c : mine; }
        if (sum == G) break;
        __builtin_amdgcn_s_sleep(1);
        if ((++sp & 255u) == 0u) { if (xb_ld(&bar[XB_TMO])) break; if (sp > XB_SPIN_CAP) { atomicAdd(&bar[XB_TMO], 1u); break; } }
    }
    nloc = mine > 0u ? mine : 1u; nx = cnt > 0u ? cnt : 1u;
}
DI void xcd_barrier(const XcdBarrier& b) {
    asm volatile("s_waitcnt vmcnt(0)" ::: "memory");
    __syncthreads();
    if (threadIdx.x == 0) {
        unsigned* bar = b.bar;
        __builtin_amdgcn_s_waitcnt(0);
        unsigned nloc = b.st[0], nx = b.st[1];
        if (nloc == 0u) { xcd_barrier_complete(bar, b.x, nloc, nx); b.st[0] = nloc; b.st[1] = nx; }
        const unsigned old = xb_add(&bar[XB_XSUB(b.x)], 1u);
        const unsigned gen = old / nloc;
        if (old + 1u == (gen + 1u) * nloc) {
            __builtin_amdgcn_fence(__ATOMIC_RELEASE, "agent");
            asm volatile("s_waitcnt vmcnt(0)" ::: "memory");
            const unsigned og = xb_add(&bar[XB_TOP], 1u);
            const unsigned tg = og / nx;
            if (og + 1u == (tg + 1u) * nx) xb_add(&bar[XB_TOPGEN], 1u);
            else XB_SPIN(xb_ld(&bar[XB_TOPGEN]) == tg, bar);
            __builtin_amdgcn_fence(__ATOMIC_ACQUIRE, "agent");
            xb_add(&bar[XB_XGEN(b.x)], 1u);
            asm volatile("s_waitcnt vmcnt(0)" ::: "memory");
        } else {
            XB_SPIN(xb_ld(&bar[XB_XGEN(b.x)]) == gen, bar);
            __builtin_amdgcn_fence(__ATOMIC_ACQUIRE, "agent");
            asm volatile("s_waitcnt vmcnt(0)" ::: "memory");
        }
    }
    __syncthreads();
}
namespace pg8 {
constexpr int BM = 256, BK = 64, HALF = 128, HTB = HALF * BK * 2, STAGE_BYTES = 8 * HTB, NXCD = 8, WGM = 8;
__host__ __device__ __forceinline__ int lds_byte(int r, int c) { const int st = (r >> 4) * 2 + (c >> 5), rr = r & 15, cc = c & 31, ob = rr * 64 + cc * 2; return st * 1024 + (ob ^ (((ob >> 9) & 1) << 5)); }
__host__ __device__ __forceinline__ void stage_rc(int b, int& R, int& C) { const int st = b / 1024, sb = b % 1024, swz = sb ^ (((sb >> 9) & 1) << 5); R = (st >> 1) * 16 + swz / 64; C = (st & 1) * 32 + (swz % 64) / 2; }
__host__ __device__ __forceinline__ int perm32(int rho) { const int n = rho >> 4, i = rho & 15; return 8 * (i >> 2) + 4 * n + (i & 3); }

struct Unit { int pm, pn, brow, e; };
struct Gemm { const bf16* A; const bf16* Bt; int lda, K; };

struct StaticOrder {
    int nM, nN, nwg, G, c;
    __device__ void init(int nM_, int nN_, int G_, int c_) { nM = nM_; nN = nN_; nwg = nM * nN; G = G_; c = c_; }
    __device__ bool tile(int i, int& pm, int& pn) const {
        const long L = (long)i * G + c; if (L >= nwg) return false;
        int wgid = (int)L; { const int q = nwg / NXCD, r = nwg % NXCD, xcd = wgid % NXCD, off = wgid / NXCD; wgid = (xcd < r ? xcd * (q + 1) : r * (q + 1) + (xcd - r) * q) + off; }
        const int nig = WGM * nN, gid = wgid / nig, fm = gid * WGM, gsz = (nM - fm) < WGM ? (nM - fm) : WGM;
        pm = fm + ((wgid % nig) % gsz); pn = (wgid % nig) / gsz; return true;
    }
    __device__ bool next(int i, Unit& u) const { if (!tile(i, u.pm, u.pn)) return false; u.brow = u.pn * BM; u.e = 0; return true; }
};
struct GroupedOrder : StaticOrder {
    const LAS int* tstart; int nrow_e;
    __device__ bool next(int i, Unit& u) const {
        if (!tile(i, u.pm, u.pn)) return false;
        int e = 0;
#pragma unroll 1
        for (int j = 16; j > 0; j >>= 1) if (tstart[e + j] <= u.pm) e += j;
        u.e = e; u.brow = e * nrow_e + u.pn * BM; return true;
    }
};
DI unsigned cvt_pk_bf16(float lo, float hi) { unsigned r; asm volatile("v_cvt_pk_bf16_f32 %0, %1, %2" : "=v"(r) : "v"(lo), "v"(hi)); return r; }

template <class Epi, class Sched>
DI void gemm_phase(LAS unsigned char* lds, const int tid, const Gemm g, const Sched& S, const Epi& E) {
    const int wid = __builtin_amdgcn_readfirstlane(tid >> 6), lane = tid & 63, wr = wid >> 2, wc = wid & 3, fr = lane & 15, fq = lane >> 4;
    int K = g.K, lda = g.lda; asm volatile("" : "+s"(K), "+s"(lda));
    const int nt = K / BK;
    unsigned voffA[2], voffB[2];
#pragma unroll
    for (int i = 0; i < 2; ++i) { int R, C; stage_rc(tid * 16 + i * 8192, R, C); const int Rb = Epi::PERM ? ((R & ~31) + perm32(R & 31)) : R;
        voffA[i] = (unsigned)(R * lda + C) * 2u; voffB[i] = (unsigned)(Rb * K + C) * 2u; }
    const size_t kstep = (size_t)(BK * 2);
    const size_t hstepA = (size_t)HALF * lda * 2, hstepB = (size_t)HALF * K * 2;
    const size_t tstepA = 2 * hstepA;
    const unsigned ldsw = (unsigned)wid * 1024u;
    const int aoff = lds_byte(wr * 64 + fr, fq * 8), boff = lds_byte(wc * 32 + fr, fq * 8);
#define PG8_SA(b, h) (((b) * 2 + (h)) * HTB)
#define PG8_SB(b, h) ((4 + (b) * 2 + (h)) * HTB)
#define PG8_STAGE(bufoff, gbase, voff) do { _Pragma("unroll") for (int _i = 0; _i < 2; ++_i) \
        __builtin_amdgcn_global_load_lds((const unsigned*)((const char*)(gbase) + (voff)[_i]), (LAS unsigned*)(lds + (bufoff) + ldsw + _i * 8192), 16, 0, 0); } while (0)
#define PG8_LDA(dst, b, h) do { _Pragma("unroll") for (int m = 0; m < 4; ++m) _Pragma("unroll") for (int k = 0; k < 2; ++k) dst[m][k] = *(const LAS bf16x8*)(lds + PG8_SA(b, h) + aoff + m * 2048 + k * 1024); } while (0)
#define PG8_LDB(dst, b, h) do { _Pragma("unroll") for (int n = 0; n < 2; ++n) _Pragma("unroll") for (int k = 0; k < 2; ++k) dst[n][k] = *(const LAS bf16x8*)(lds + PG8_SB(b, h) + boff + n * 2048 + k * 1024); } while (0)
#define PG8_MMA(ai, bj, At, Bt) do { __builtin_amdgcn_s_setprio(1); _Pragma("unroll") for (int m = 0; m < 4; ++m) _Pragma("unroll") for (int n = 0; n < 2; ++n) _Pragma("unroll") for (int k = 0; k < 2; ++k) \
        acc[ai][bj][m][n] = __builtin_amdgcn_mfma_f32_16x16x32_bf16(Bt[n][k], At[m][k], acc[ai][bj][m][n], 0, 0, 0); __builtin_amdgcn_s_setprio(0); } while (0)
#define PG8_WAIT_V(n) asm volatile("s_waitcnt vmcnt(" #n ")" ::: "memory")
#define PG8_WAIT_L(n) asm volatile("s_waitcnt lgkmcnt(" #n ")" ::: "memory")
#define PG8_BAR __builtin_amdgcn_s_barrier()
#define PG8_SCHED __builtin_amdgcn_sched_barrier(0)
    Unit cur, nxt; int ui = 0;
    if (!S.next(0, cur)) return;
    f32x4 acc[2][2][4][2];
#pragma unroll
    for (int a = 0; a < 2; ++a)
#pragma unroll
        for (int b = 0; b < 2; ++b)
#pragma unroll
            for (int m = 0; m < 4; ++m)
#pragma unroll
                for (int n = 0; n < 2; ++n) acc[a][b][m][n] = (f32x4){0.f, 0.f, 0.f, 0.f};
    bf16x8 At[4][2], B0[2][2], B1[2][2];
    const char* cA = (const char*)g.A + (size_t)cur.pm * tstepA; const char* cB = (const char*)g.Bt + (size_t)cur.brow * K * 2;
    PG8_STAGE(PG8_SB(0, 0), cB, voffB); PG8_STAGE(PG8_SB(0, 1), cB + hstepB, voffB); PG8_STAGE(PG8_SA(0, 0), cA, voffA); PG8_STAGE(PG8_SA(0, 1), cA + hstepA, voffA);
    if (wr == 1) PG8_BAR;
    PG8_WAIT_V(2); PG8_BAR;
    PG8_STAGE(PG8_SB(1, 0), cB + kstep, voffB); PG8_STAGE(PG8_SA(1, 0), cA + kstep, voffA); PG8_STAGE(PG8_SB(1, 1), cB + hstepB + kstep, voffB);
    PG8_WAIT_V(6); PG8_BAR;
    for (;;) {
        const bool has_next = S.next(ui + 1, nxt);
        const char* nA = has_next ? (const char*)g.A + (size_t)nxt.pm * tstepA : cA; const char* nB = has_next ? (const char*)g.Bt + (size_t)nxt.brow * K * 2 : cB;
#pragma unroll 1
        for (int t = 0; t < nt; t += 2) {
            const bool last = (t == nt - 2);
            const char* a1 = cA + (size_t)(t + 1) * kstep;
            const char* a2 = last ? nA : cA + (size_t)(t + 2) * kstep; const char* b2 = last ? nB : cB + (size_t)(t + 2) * kstep;
            const char* a3 = a2 + kstep; const char* b3 = b2 + kstep;
            PG8_LDB(B0, 0, 0); PG8_LDB(B1, 0, 1); PG8_SCHED; PG8_LDA(At, 0, 0); PG8_STAGE(PG8_SA(1, 1), a1 + hstepA, voffA);
            PG8_WAIT_V(8); PG8_WAIT_L(0); PG8_BAR; PG8_MMA(0, 0, At, B0); PG8_MMA(0, 1, At, B1); PG8_BAR; PG8_SCHED;
            PG8_LDA(At, 0, 1); PG8_STAGE(PG8_SB(0, 0), b2, voffB); PG8_STAGE(PG8_SB(0, 1), b2 + hstepB, voffB); PG8_STAGE(PG8_SA(0, 0), a2, voffA);
            PG8_WAIT_V(8); PG8_WAIT_L(0); PG8_BAR; PG8_MMA(1, 0, At, B0); PG8_MMA(1, 1, At, B1); PG8_BAR; PG8_SCHED;
            PG8_LDB(B0, 1, 0); PG8_LDB(B1, 1, 1); PG8_SCHED; PG8_LDA(At, 1, 0); PG8_STAGE(PG8_SA(0, 1), a2 + hstepA, voffA);
            PG8_WAIT_V(8); PG8_WAIT_L(0); PG8_BAR; PG8_MMA(0, 0, At, B0); PG8_MMA(0, 1, At, B1); PG8_BAR; PG8_SCHED;
            PG8_LDA(At, 1, 1); PG8_STAGE(PG8_SB(1, 0), b3, voffB); PG8_STAGE(PG8_SB(1, 1), b3 + hstepB, voffB); PG8_STAGE(PG8_SA(1, 0), a3, voffA);
            PG8_WAIT_V(8); PG8_WAIT_L(0); PG8_BAR; PG8_MMA(1, 0, At, B0); PG8_MMA(1, 1, At, B1); PG8_BAR; PG8_SCHED;
        }
        if (wr == 0) PG8_BAR;
        { int fr2 = fr, fq2 = fq; asm volatile("" : "+v"(fr2), "+v"(fq2)); E(acc, cur, wr, wc, fr2, fq2); }
        if (!has_next) break;
#pragma unroll
        for (int a = 0; a < 2; ++a)
#pragma unroll
            for (int b = 0; b < 2; ++b)
#pragma unroll
                for (int m = 0; m < 4; ++m)
#pragma unroll
                    for (int n = 0; n < 2; ++n) acc[a][b][m][n] = (f32x4){0.f, 0.f, 0.f, 0.f};
        cur = nxt; cA = nA; cB = nB; ++ui;
        if (wr == 1) PG8_BAR;
    }
    PG8_WAIT_V(0);
    PG8_BAR;
#undef PG8_SA
#undef PG8_SB
#undef PG8_STAGE
#undef PG8_LDA
#undef PG8_LDB
#undef PG8_MMA
#undef PG8_WAIT_V
#undef PG8_WAIT_L
#undef PG8_BAR
#undef PG8_SCHED
}
}
constexpr size_t MiB = 1u << 20;
constexpr size_t WS_CTL = 0;
constexpr size_t WS_LORA = 1 * MiB;
constexpr size_t WS_WK2 = 2 * MiB;
constexpr size_t ZERO_BYTES = 3 * MiB;
constexpr size_t WS_WIN = 3 * MiB;
constexpr size_t WS_WOUT = 17 * MiB;
constexpr size_t WS_WK1 = 21 * MiB;
constexpr size_t WS_SMALL = 25 * MiB;
constexpr size_t WS_ROUTE = 27 * MiB;
constexpr size_t WS_WGU = 32 * MiB;
constexpr size_t WS_WDN = 288 * MiB;
constexpr size_t WS_H = 416 * MiB;
constexpr size_t WS_R = 480 * MiB;
constexpr size_t R_PROJ = WS_R;
constexpr size_t R_SC = R_PROJ + 208 * MiB;
constexpr size_t R_LIN = R_SC + 192 * MiB;
constexpr size_t R_G = R_LIN + 16 * MiB;
constexpr size_t R_YA = R_G + 32 * MiB;
constexpr size_t R_YCAT = R_YA + 32 * MiB;
constexpr size_t R_QC = R_YCAT + 64 * MiB;
constexpr size_t R_KC = R_QC + 16 * MiB;
constexpr size_t R_OC = R_KC + 16 * MiB;
constexpr size_t R_LSE = R_OC + 96 * MiB;
constexpr size_t R_QN = R_LSE + 2 * MiB;
constexpr size_t R_QR = R_QN + 16 * MiB;
constexpr size_t R_KCR = R_QR + 16 * MiB;
constexpr size_t R_VCR = R_KCR + 5 * MiB;
constexpr size_t R_KS = R_VCR + 5 * MiB;
constexpr size_t R_KW = R_KS + 4 * MiB;
constexpr size_t R_GATE = R_KW + 4 * MiB;
constexpr size_t R_CH1 = R_GATE + 2 * MiB;
constexpr size_t R_CMP = R_CH1 + 2 * MiB;
constexpr size_t R_OCMP = R_CMP + 1 * MiB;
constexpr size_t R_OSLC = R_OCMP + 32 * MiB;
constexpr size_t R_OSWA = R_OSLC + 32 * MiB;
constexpr size_t R_IMP = R_OSWA + 32 * MiB;
constexpr size_t R_SELM = R_IMP + 8 * MiB;
constexpr size_t R_MIX_END = R_SELM + 1 * MiB;
constexpr size_t R_XS = WS_R;
constexpr size_t R_ACT = R_XS + 272 * MiB;
constexpr size_t R_YB = R_ACT + 272 * MiB;
constexpr size_t R_MOE_END = R_YB + 272 * MiB;
constexpr size_t WS_END = (R_MIX_END > R_MOE_END ? R_MIX_END : R_MOE_END);
static_assert((size_t)NR * 1024 * 2 <= 272 * MiB, "sorted buffers");
constexpr int CW_BAR = 4096;
constexpr int CW_CNT = 16384;
constexpr int CW_CUR = 16384 + 64;

constexpr int RING_BYTES = 131072;
constexpr int MISC_OFF = RING_BYTES;
constexpr int LDS_BYTES = 147456;

struct Args { const void* in[40]; float* out; unsigned char* ws; int ph_lo, ph_hi; };

struct Ctx {
    LAS unsigned char* lds; int tid, lane, wave, G, bid;
    const float *x, *c, *w_ada, *b_ada, *norm1_g, *norm2_g, *w_in, *w_out, *mu, *w0, *w2, *a0, *a2, *g2, *kkw, *ka, *rk, *gn_w, *gn_b, *conv_w, *dil_q_g, *dil_k_g,
        *nsa_q_g, *nsa_kc_g, *nsa_ks_g, *nsa_kw_g, *pe_k, *pe_v, *wk1, *wk2, *wv1, *wv2, *onorm_g, *w_router, *b_router, *w_gu, *b_gu, *w_down, *b_down;
    const int* pos;
    float* out; unsigned char* ws;
};
#define WSP(T, off) ((T*)(C.ws + (off)))

typedef f32x4 Acc[2][2][4][2];
struct EpiProj {
    static constexpr bool PERM = true; bf16* O;
    DI void operator()(const Acc& acc, const pg8::Unit& u, int wr, int wc, int fr, int fq) const {
        const int row0 = u.pm * 256 + wr * 64 + fr, col0 = u.pn * 256 + wc * 32 + 8 * fq;
#pragma unroll
        for (int ai = 0; ai < 2; ++ai)
#pragma unroll
            for (int m = 0; m < 4; ++m) { bf16* rowp = O + (size_t)(row0 + ai * 128 + m * 16) * NPJ + col0;
#pragma unroll
                for (int bj = 0; bj < 2; ++bj) { const f32x4 v0 = acc[ai][bj][m][0], v1 = acc[ai][bj][m][1]; u32x4 w;
                    w.x = pg8::cvt_pk_bf16(v0[0], v0[1]); w.y = pg8::cvt_pk_bf16(v0[2], v0[3]); w.z = pg8::cvt_pk_bf16(v1[0], v1[1]); w.w = pg8::cvt_pk_bf16(v1[2], v1[3]);
                    *(u32x4*)(rowp + bj * 128) = w; } }
    }
};
struct EpiLora {
    static constexpr bool PERM = false; float* SC; float* Gb; const float *w0, *a0, *ka;
    DI void operator()(const Acc& acc, const pg8::Unit& u, int wr, int wc, int fr, int fq) const {
        const int row0 = u.pm * 256 + wr * 64 + fr, col0 = wc * 32 + 4 * fq;
        if (u.pn == 0) {
#pragma unroll
            for (int bj = 0; bj < 2; ++bj)
#pragma unroll
                for (int n = 0; n < 2; ++n) { const int ch = col0 + bj * 128 + n * 16; const f32x4 b = *(const f32x4*)(w0 + ch);
#pragma unroll
                    for (int ai = 0; ai < 2; ++ai)
#pragma unroll
                        for (int m = 0; m < 4; ++m) { const size_t o = (size_t)(row0 + ai * 128 + m * 16) * 256 + ch; const f32x4 v = acc[ai][bj][m][n] + b; f32x4 r;
#pragma unroll
                            for (int j = 0; j < 4; ++j) r[j] = __expf(-0.606531f * fsigmoid(v[j]));
                            *(f32x4*)(SC + o) = r; } }
        } else if (u.pn == 1) {
#pragma unroll
            for (int bj = 0; bj < 2; ++bj)
#pragma unroll
                for (int n = 0; n < 2; ++n) { const int ch = col0 + bj * 128 + n * 16; const f32x4 b = *(const f32x4*)(a0 + ch), kav = *(const f32x4*)(ka + ch);
#pragma unroll
                    for (int ai = 0; ai < 2; ++ai)
#pragma unroll
                        for (int m = 0; m < 4; ++m) { __builtin_amdgcn_sched_barrier(0); const size_t o = (size_t)(row0 + ai * 128 + m * 16) * 256 + ch; const f32x4 v = acc[ai][bj][m][n] + b;
                            float* pk = SC + (size_t)1 * NT * 256 + o; const f32x4 kr = *(const f32x4*)pk, kn = *(const f32x4*)(SC + (size_t)2 * NT * 256 + o); f32x4 k2, bb;
#pragma unroll
                            for (int j = 0; j < 4; ++j) { const float a = fsigmoid(v[j]); k2[j] = kr[j] * (1.f + (a - 1.f) * kav[j]); bb[j] = kn[j] * a; }
                            *(f32x4*)pk = k2; *(f32x4*)(SC + (size_t)3 * NT * 256 + o) = bb; } }
        } else {
#pragma unroll
            for (int bj = 0; bj < 2; ++bj)
#pragma unroll
                for (int n = 0; n < 2; ++n) { const int ch = col0 + bj * 128 + n * 16;
#pragma unroll
                    for (int ai = 0; ai < 2; ++ai)
#pragma unroll
                        for (int m = 0; m < 4; ++m) { const size_t o = (size_t)(row0 + ai * 128 + m * 16) * 256 + ch; *(f32x4*)(Gb + o) = acc[ai][bj][m][n]; } }
        }
    }
};
DI float gelu_tanh(float x) { const float t = 0.7978845608f * (x + 0.044715f * x * x * x); const float e = __expf(2.f * t); const float th = 1.f - 2.f / (e + 1.f); return 0.5f * x * (1.f + th); }
struct EpiC1 {
    static constexpr bool PERM = true; bf16* O; const float* peb;
    DI void operator()(const Acc& acc, const pg8::Unit& u, int wr, int wc, int fr, int fq) const {
        const int row0 = u.pm * 256 + wr * 64 + fr, col0 = wc * 32 + 8 * fq;
#pragma unroll
        for (int bj = 0; bj < 2; ++bj) { const f32x4 b0 = *(const f32x4*)(peb + col0 + bj * 128), b1 = *(const f32x4*)(peb + col0 + bj * 128 + 4);
#pragma unroll
            for (int ai = 0; ai < 2; ++ai)
#pragma unroll
                for (int m = 0; m < 4; ++m) { bf16* p = O + (size_t)(row0 + ai * 128 + m * 16) * 256 + col0 + bj * 128; const f32x4 v0 = acc[ai][bj][m][0] + b0, v1 = acc[ai][bj][m][1] + b1; u32x4 w;
                    w.x = pk2(gelu_tanh(v0[0]), gelu_tanh(v0[1])); w.y = pk2(gelu_tanh(v0[2]), gelu_tanh(v0[3])); w.z = pk2(gelu_tanh(v1[0]), gelu_tanh(v1[1])); w.w = pk2(gelu_tanh(v1[2]), gelu_tanh(v1[3]));
                    *(u32x4*)p = w; } }
    }
};
struct EpiC2 {
    static constexpr bool PERM = false; float* O;
    DI void operator()(const Acc& acc, const pg8::Unit& u, int wr, int wc, int fr, int fq) const {
        if (wc >= 2) return;
        const int row0 = u.pm * 256 + wr * 64 + fr, col0 = wc * 32 + 4 * fq;
#pragma unroll
        for (int ai = 0; ai < 2; ++ai)
#pragma unroll
            for (int m = 0; m < 4; ++m)
#pragma unroll
                for (int n = 0; n < 2; ++n) *(f32x4*)(O + (size_t)(row0 + ai * 128 + m * 16) * 64 + col0 + n * 16) = acc[ai][0][m][n];
    }
};
struct EpiOut {
    static constexpr bool PERM = false; float* O; const float* xin; const float* gt;
    DI void operator()(const Acc& acc, const pg8::Unit& u, int wr, int wc, int fr, int fq) const {
        const int row0 = u.pm * 256 + wr * 64 + fr, col0 = u.pn * 256 + wc * 32 + 4 * fq; const int b = (u.pm * 256) / NS;
#pragma unroll
        for (int bj = 0; bj < 2; ++bj)
#pragma unroll
            for (int n = 0; n < 2; ++n) { const int col = col0 + bj * 128 + n * 16; const f32x4 g = *(const f32x4*)(gt + (size_t)b * 6144 + col);
#pragma unroll
                for (int ai = 0; ai < 2; ++ai)
#pragma unroll
                    for (int m = 0; m < 4; ++m) { const size_t o = (size_t)(row0 + ai * 128 + m * 16) * DM + col; *(f32x4*)(O + o) = *(const f32x4*)(xin + o) + g * acc[ai][bj][m][n]; } }
    }
};
struct EpiGU {
    static constexpr bool PERM = true; bf16* O; const float* bgu;
    DI void operator()(const Acc& acc, const pg8::Unit& u, int wr, int wc, int fr, int fq) const {
        const int row0 = u.pm * 256 + wr * 64 + fr, cc = u.pn * 128 + wc * 32 + 8 * fq; const float* bp = bgu + (size_t)u.e * 2048 + cc;
        const f32x4 g0 = *(const f32x4*)bp, g1 = *(const f32x4*)(bp + 4), u0 = *(const f32x4*)(bp + 1024), u1 = *(const f32x4*)(bp + 1028);
#pragma unroll
        for (int ai = 0; ai < 2; ++ai)
#pragma unroll
            for (int m = 0; m < 4; ++m) { bf16* p = O + (size_t)(row0 + ai * 128 + m * 16) * FF + cc; float r[8];
#pragma unroll
                for (int n = 0; n < 2; ++n) { const f32x4 gv = acc[ai][0][m][n] + (n ? g1 : g0), uv = acc[ai][1][m][n] + (n ? u1 : u0);
#pragma unroll
                    for (int j = 0; j < 4; ++j) { const float ga = fminf(gv[j], 7.f), up = fminf(fmaxf(uv[j], -7.f), 7.f); r[4 * n + j] = ga * fsigmoid(1.702f * ga) * (up + 1.f); } }
                u32x4 w; w.x = pk2(r[0], r[1]); w.y = pk2(r[2], r[3]); w.z = pk2(r[4], r[5]); w.w = pk2(r[6], r[7]); *(u32x4*)p = w; }
    }
};
struct EpiDN {
    static constexpr bool PERM = true; bf16* O; const float* bd;
    DI void operator()(const Acc& acc, const pg8::Unit& u, int wr, int wc, int fr, int fq) const {
        const int row0 = u.pm * 256 + wr * 64 + fr, col0 = u.pn * 256 + wc * 32 + 8 * fq; const float* bp = bd + (size_t)u.e * 1024 + col0;
#pragma unroll
        for (int bj = 0; bj < 2; ++bj) { const f32x4 b0 = *(const f32x4*)(bp + bj * 128), b1 = *(const f32x4*)(bp + bj * 128 + 4);
#pragma unroll
            for (int ai = 0; ai < 2; ++ai)
#pragma unroll
                for (int m = 0; m < 4; ++m) { bf16* p = O + (size_t)(row0 + ai * 128 + m * 16) * DM + col0 + bj * 128; const f32x4 v0 = acc[ai][bj][m][0] + b0, v1 = acc[ai][bj][m][1] + b1; u32x4 w;
                    w.x = pk2(v0[0], v0[1]); w.y = pk2(v0[2], v0[3]); w.z = pk2(v1[0], v1[1]); w.w = pk2(v1[2], v1[3]); *(u32x4*)p = w; } }
    }
};
DI void tr_item(const float* src, int ld_src, int scol0, int nvalid, int k0, bf16* dst, int ld_dst, int drow0, int dk0, LAS float* scr, int lane) {
#pragma unroll 8
    for (int i = 0; i < 32; ++i) { const int kk = 2 * i + (lane >> 5), j = lane & 31; scr[kk * 33 + j] = (j < nvalid) ? src[(size_t)(k0 + kk) * ld_src + scol0 + j] : 0.f; }
    asm volatile("s_waitcnt lgkmcnt(0)" ::: "memory");
    const int c = lane & 7;
#pragma unroll
    for (int jq = 0; jq < 4; ++jq) { const int n = (lane >> 3) + 8 * jq; const LAS float* s = scr + (8 * c) * 33 + n;
        u32x4 o; o.x = pk2(s[0 * 33], s[1 * 33]); o.y = pk2(s[2 * 33], s[3 * 33]); o.z = pk2(s[4 * 33], s[5 * 33]); o.w = pk2(s[6 * 33], s[7 * 33]);
        *(u32x4*)(dst + (size_t)(drow0 + n) * ld_dst + dk0 + k0 + 8 * c) = o; }
    asm volatile("s_waitcnt lgkmcnt(0)" ::: "memory");
}
DI void p0_prologue(const Ctx& C) {
    LAS float* scr = (LAS float*)(C.lds + C.wave * 16384);
    const int gw = C.bid * NWAVE + C.wave, NGW = C.G * NWAVE;
    constexpr int I_IN = 16 * 104, I_OUT = 16 * 32, I_GU = 32 * 16 * 64, I_DN = 32 * 16 * 32, I_LW = 8, I_LA = 8, I_LG = 16, I_K1 = 256, I_K2 = 8;
    constexpr int I_LAYER = I_IN + I_OUT + I_GU + I_DN + I_LW + I_LA + I_LG + 2 * I_K1 + 2 * I_K2;
    for (int it = gw; it < NLAYER * I_LAYER; it += NGW) {
        const int l = it / I_LAYER; int r = it % I_LAYER;
        if (r < I_GU) { const int e = r / 1024, r2 = r % 1024, kb = r2 / 64, nb = r2 % 64, n0 = 32 * nb, j = n0 / 256, i = n0 % 256;
            const int scol0 = (i < 128) ? 128 * j + i : 1024 + 128 * j + (i - 128);
            tr_item(C.w_gu + (size_t)(l * 32 + e) * 1024 * 2048, 2048, scol0, 32, 64 * kb, WSP(bf16, WS_WGU) + (size_t)(l * 32 + e) * 2048 * 1024, 1024, n0, 0, scr, C.lane); continue; } r -= I_GU;
        if (r < I_DN) { const int e = r / 512, r2 = r % 512, kb = r2 / 32, nb = r2 % 32;
            tr_item(C.w_down + (size_t)(l * 32 + e) * 1024 * 1024, 1024, 32 * nb, 32, 64 * kb, WSP(bf16, WS_WDN) + (size_t)(l * 32 + e) * 1024 * 1024, 1024, 32 * nb, 0, scr, C.lane); continue; } r -= I_DN;
        if (r < I_IN) { const int kb = r / 104, nb = r % 104, n0 = 32 * nb; int nv = 3212 - n0; nv = nv < 0 ? 0 : (nv > 32 ? 32 : nv);
            tr_item(C.w_in + (size_t)l * 1024 * 3212, 3212, n0, nv, 64 * kb, WSP(bf16, WS_WIN) + (size_t)l * NPJ * 1024, 1024, n0, 0, scr, C.lane); continue; } r -= I_IN;
        if (r < I_OUT) { const int kb = r / 32, nb = r % 32;
            tr_item(C.w_out + (size_t)l * 1024 * 1024, 1024, 32 * nb, 32, 64 * kb, WSP(bf16, WS_WOUT) + (size_t)l * 1024 * 1024, 1024, 32 * nb, 0, scr, C.lane); continue; } r -= I_OUT;
        bf16* lora = WSP(bf16, WS_LORA) + (size_t)l * 768 * 256;
        if (r < I_LW) { tr_item(C.w2 + (size_t)l * 64 * 256, 256, 32 * r, 32, 0, lora, 256, 32 * r, 0, scr, C.lane); continue; } r -= I_LW;
        if (r < I_LA) { tr_item(C.a2 + (size_t)l * 64 * 256, 256, 32 * r, 32, 0, lora, 256, 256 + 32 * r, 64, scr, C.lane); continue; } r -= I_LA;
        if (r < I_LG) { const int kb = r / 8, nb = r % 8; tr_item(C.g2 + (size_t)l * 128 * 256, 256, 32 * nb, 32, 64 * kb, lora, 256, 512 + 32 * nb, 128, scr, C.lane); continue; } r -= I_LG;
        if (r < 2 * I_K1) { const int kv = r / I_K1, r2 = r % I_K1, kb = r2 / 8, nb = r2 % 8;
            tr_item((kv ? C.wv1 : C.wk1) + (size_t)l * 2048 * 256, 256, 32 * nb, 32, 64 * kb, WSP(bf16, WS_WK1) + (size_t)(l * 2 + kv) * 256 * 2048, 2048, 32 * nb, 0, scr, C.lane); continue; } r -= 2 * I_K1;
        { const int kv = r / I_K2, r2 = r % I_K2, kb = r2 / 2, nb = r2 % 2;
            tr_item((kv ? C.wv2 : C.wk2) + (size_t)l * 256 * 64, 64, 32 * nb, 32, 64 * kb, WSP(bf16, WS_WK2) + (size_t)(l * 2 + kv) * 256 * 256, 256, 32 * nb, 0, scr, C.lane); }
    }
    __syncthreads();
    float* MOD = WSP(float, WS_SMALL); float* PEB = MOD + NLAYER * 8 * 6144;
    LAS float* sc = (LAS float*)C.lds;
    LAS float* red = sc + 8192;
    for (int it = C.bid; it < 192 + 4; it += C.G) {
        if (it < 192) {
            const int l = it / 96, n0 = (it % 96) * 64;
            for (int i = C.tid; i < 8192; i += NTHR) { const float v = C.c[i]; sc[i] = v / (1.f + __expf(-v)); }
            __syncthreads();
            const int kq = C.tid >> 6, col = C.tid & 63; float a[8];
#pragma unroll
            for (int b = 0; b < 8; ++b) a[b] = 0.f;
            const float* wp = C.w_ada + (size_t)l * 1024 * 6144 + n0 + col;
#pragma unroll 8
            for (int k = kq * 128; k < kq * 128 + 128; ++k) { const float w = wp[(size_t)k * 6144];
#pragma unroll
                for (int b = 0; b < 8; ++b) a[b] += sc[b * 1024 + k] * w; }
#pragma unroll
            for (int b = 0; b < 8; ++b) red[(kq * 8 + b) * 64 + col] = a[b];
            __syncthreads();
            { const int b = C.tid >> 6; float s = C.b_ada[(size_t)l * 6144 + n0 + col];
#pragma unroll
              for (int q = 0; q < 8; ++q) s += red[(q * 8 + b) * 64 + col];
              MOD[((size_t)l * 8 + b) * 6144 + n0 + col] = s; }
            __syncthreads();
        } else {
            const int l = (it - 192) / 2, kv = (it - 192) % 2; const float* pe = (kv ? C.pe_v : C.pe_k) + (size_t)l * 2048; const float* w1 = (kv ? C.wv1 : C.wk1) + (size_t)l * 2048 * 256;
            const int kq = C.tid >> 8, col = C.tid & 255; float a = 0.f;
#pragma unroll 8
            for (int k = kq * 1024; k < kq * 1024 + 1024; ++k) a += pe[k] * w1[(size_t)k * 256 + col];
            red[kq * 256 + col] = a; __syncthreads();
            if (C.tid < 256) PEB[(l * 2 + kv) * 256 + col] = red[col] + red[256 + col];
            __syncthreads();
        }
    }
}

DI void norm_row(const Ctx& C, const float* xrow, const float* g, const float* sh, const float* sc, bf16* orow) {
    f32x4 v[4]; float s = 0.f;
#pragma unroll
    for (int j = 0; j < 4; ++j) { v[j] = *(const f32x4*)(xrow + 4 * C.lane + 256 * j); s += (v[j][0] * v[j][0] + v[j][1] * v[j][1]) + (v[j][2] * v[j][2] + v[j][3] * v[j][3]); }
    s = group_sum<64>(s); const float rstd = rsqrtf(s * (1.f / DM) + 1e-6f);
#pragma unroll
    for (int j = 0; j < 4; ++j) { const int k = 4 * C.lane + 256 * j; const f32x4 gg = *(const f32x4*)(g + k), a = *(const f32x4*)(sc + k), b = *(const f32x4*)(sh + k); f32x4 h;
#pragma unroll
        for (int i = 0; i < 4; ++i) h[i] = v[j][i] * rstd * gg[i] * (1.f + a[i]) + b[i];
        u32x2 o; o.x = pk2(h[0], h[1]); o.y = pk2(h[2], h[3]); *(u32x2*)(orow + k) = o; }
}
DI void norm1_phase(const Ctx& C, int l, const float* xin) {
    const float* MOD = WSP(float, WS_SMALL) + (size_t)l * 8 * 6144; bf16* H = WSP(bf16, WS_H);
    const int gw = C.bid * NWAVE + C.wave, NGW = C.G * NWAVE;
    for (int m = gw; m < NT; m += NGW) { const int b = m / NS; norm_row(C, xin + (size_t)m * DM, C.norm1_g + l * DM, MOD + b * 6144, MOD + b * 6144 + 1024, H + (size_t)m * DM); }
}

constexpr float QSCALE = 0.125f * 1.44269504089f;
DI void prep_phase(const Ctx& C, int l) {
    const bf16* PROJ = WSP(bf16, R_PROJ); float* SC = WSP(float, R_SC); bf16* LIN = WSP(bf16, R_LIN); bf16* YCAT = WSP(bf16, R_YCAT);
    bf16 *QC = WSP(bf16, R_QC), *KC = WSP(bf16, R_KC), *QN = WSP(bf16, R_QN), *QR = WSP(bf16, R_QR), *KCR = WSP(bf16, R_KCR), *VCR = WSP(bf16, R_VCR), *KS = WSP(bf16, R_KS), *KW = WSP(bf16, R_KW);
    float* GATE = WSP(float, R_GATE);
    const int lane = C.lane, gw = C.bid * NWAVE + C.wave, NGW = C.G * NWAVE;
    const int hh = lane >> 4, jj = lane & 15;
    const float inv0 = exp2f(-(float)(2 * jj) * (13.287712379549449f / 32.f)), inv1 = exp2f(-(float)(2 * jj + 1) * (13.287712379549449f / 32.f));
    for (int row = gw; row < NT; row += NGW) {
        const int s = row % NS; const bf16* pr = PROJ + (size_t)row * NPJ;
        {
            const int c0 = 16 * lane; float z[16];
            const u32x4 c0v = *(const u32x4*)(pr + c0), c1v = *(const u32x4*)(pr + c0 + 8);
            u32x4 p0v = (u32x4){0u, 0u, 0u, 0u}, p1v = p0v;
            if (s > 0) { p0v = *(const u32x4*)(pr - NPJ + c0); p1v = *(const u32x4*)(pr - NPJ + c0 + 8); }
            const float* mup = C.mu + (size_t)l * 1024 + c0;
            const unsigned cw[8] = {c0v.x, c0v.y, c0v.z, c0v.w, c1v.x, c1v.y, c1v.z, c1v.w}, pw[8] = {p0v.x, p0v.y, p0v.z, p0v.w, p1v.x, p1v.y, p1v.z, p1v.w};
#pragma unroll
            for (int q = 0; q < 4; ++q) { const f32x4 m4 = *(const f32x4*)(mup + 4 * q);
#pragma unroll
                for (int i = 0; i < 4; ++i) { const int e = 4 * q + i; const float cu = (e & 1) ? bfhi(cw[e >> 1]) : bflo(cw[e >> 1]), pv = (e & 1) ? bfhi(pw[e >> 1]) : bflo(pw[e >> 1]); z[e] = cu + (pv - cu) * m4[i]; } }
            const int cc = (c0 - 256) & 255; float kk[16]; float ss = 0.f;
#pragma unroll
            for (int q = 0; q < 4; ++q) { const f32x4 k4 = *(const f32x4*)(C.kkw + (size_t)l * 256 + cc + 4 * q);
#pragma unroll
                for (int i = 0; i < 4; ++i) { kk[4 * q + i] = z[4 * q + i] * k4[i]; ss += kk[4 * q + i] * kk[4 * q + i]; } }
            ss = group_sum<4>(ss); const float kinv = rsqrtf(ss + 1e-12f);
            if (lane < 48) {
                const int vec = lane < 16 ? 4 : (lane < 32 ? 1 : 5); float* dst = SC + ((size_t)vec * NT + row) * 256 + (c0 & 255);
#pragma unroll
                for (int q = 0; q < 4; ++q) *(f32x4*)(dst + 4 * q) = (f32x4){z[4 * q], z[4 * q + 1], z[4 * q + 2], z[4 * q + 3]};
                if (lane >= 16 && lane < 32) { float* d2 = SC + ((size_t)2 * NT + row) * 256 + cc;
#pragma unroll
                    for (int q = 0; q < 4; ++q) *(f32x4*)(d2 + 4 * q) = (f32x4){kk[4 * q] * kinv, kk[4 * q + 1] * kinv, kk[4 * q + 2] * kinv, kk[4 * q + 3] * kinv}; }
            } else {
                float t[16];
#pragma unroll
                for (int i = 0; i < 16; ++i) t[i] = lane < 52 ? tanhf(z[i]) : (lane < 56 ? z[i] : fsigmoid(z[i]));
                bf16* dst = LIN + (size_t)row * 256 + (c0 - 768);
                u32x4 o0, o1; o0.x = pk2(t[0], t[1]); o0.y = pk2(t[2], t[3]); o0.z = pk2(t[4], t[5]); o0.w = pk2(t[6], t[7]); o1.x = pk2(t[8], t[9]); o1.y = pk2(t[10], t[11]); o1.z = pk2(t[12], t[13]); o1.w = pk2(t[14], t[15]);
                *(u32x4*)dst = o0; *(u32x4*)(dst + 8) = o1;
            }
        }
        {
            const int ch = 4 * lane; float u[3][4];
#pragma unroll
            for (int d = 0; d < 3; ++d) {
                u32x2 cg = (u32x2){0u, 0u}, xi = cg;
                if (s >= d) { cg = *(const u32x2*)(pr - (size_t)d * NPJ + PJ_B + 256 + ch); xi = *(const u32x2*)(pr - (size_t)d * NPJ + PJ_B + 512 + ch); }
                u[d][0] = bflo(cg.x) * bflo(xi.x); u[d][1] = bfhi(cg.x) * bfhi(xi.x); u[d][2] = bflo(cg.y) * bflo(xi.y); u[d][3] = bfhi(cg.y) * bfhi(xi.y);
            }
            const u32x2 bgv = *(const u32x2*)(pr + PJ_B + ch); const float bg[4] = {bflo(bgv.x), bfhi(bgv.x), bflo(bgv.y), bfhi(bgv.y)};
            const float* cw = C.conv_w + (size_t)l * 3 * 256 + ch; const f32x4 w0 = *(const f32x4*)cw, w1 = *(const f32x4*)(cw + 256), w2 = *(const f32x4*)(cw + 512);
            float y[4]; float ss = 0.f;
#pragma unroll
            for (int i = 0; i < 4; ++i) { y[i] = bg[i] * (w0[i] * u[2][i] + w1[i] * u[1][i] + w2[i] * u[0][i]); ss += y[i] * y[i]; }
            ss = group_sum<16>(ss); const float rstd = rsqrtf(ss * (1.f / 64.f) + 1e-6f); const f32x4 og = *(const f32x4*)(C.onorm_g + (size_t)l * 768 + ch);
            u32x2 o; o.x = pk2(y[0] * rstd * og[0], y[1] * rstd * og[1]); o.y = pk2(y[2] * rstd * og[2], y[3] * rstd * og[3]);
            *(u32x2*)(YCAT + (size_t)row * DM + 256 + ch) = o;
        }
        const float posf = (float)C.pos[row]; float sn0, cs0, sn1, cs1; sincosf(posf * inv0, &sn0, &cs0); sincosf(posf * inv1, &sn1, &cs1);
#pragma unroll
        for (int qk = 0; qk < 2; ++qk) {
            const bf16* p = pr + PJ_C + qk * 256 + hh * 64 + 2 * jj; const unsigned a = *(const unsigned*)p, b = *(const unsigned*)(p + 32);
            float x1a = bflo(a), x1b = bfhi(a), x2a = bflo(b), x2b = bfhi(b);
            float ss = group_sum<16>(x1a * x1a + x1b * x1b + x2a * x2a + x2b * x2b); const float rstd = rsqrtf(ss * (1.f / 64.f) + 1e-6f);
            const float* g = (qk ? C.dil_k_g : C.dil_q_g) + (size_t)l * 64; const float sc = qk ? 1.f : QSCALE;
            x1a *= rstd * g[2 * jj] * sc; x1b *= rstd * g[2 * jj + 1] * sc; x2a *= rstd * g[32 + 2 * jj] * sc; x2b *= rstd * g[33 + 2 * jj] * sc;
            bf16* o = (qk ? KC : QC) + (size_t)row * 256 + hh * 64 + 2 * jj;
            *(unsigned*)o = pk2(x1a * cs0 - x2a * sn0, x1b * cs1 - x2b * sn1); *(unsigned*)(o + 32) = pk2(x2a * cs0 + x1a * sn0, x2b * cs1 + x1b * sn1);
        }
        {
            const bf16* p = pr + PJ_D + hh * 64 + 2 * jj; const unsigned a = *(const unsigned*)p, b = *(const unsigned*)(p + 32);
            float x1a = bflo(a), x1b = bfhi(a), x2a = bflo(b), x2b = bfhi(b);
            float ss = group_sum<16>(x1a * x1a + x1b * x1b + x2a * x2a + x2b * x2b); const float rstd = rsqrtf(ss * (1.f / 64.f) + 1e-6f) * QSCALE;
            const float* g = C.nsa_q_g + (size_t)l * 64;
            x1a *= rstd * g[2 * jj]; x1b *= rstd * g[2 * jj + 1]; x2a *= rstd * g[32 + 2 * jj]; x2b *= rstd * g[33 + 2 * jj];
            bf16* on = QN + (size_t)row * 256 + hh * 64 + 2 * jj; *(unsigned*)on = pk2(x1a, x1b); *(unsigned*)(on + 32) = pk2(x2a, x2b);
            bf16* o = QR + (size_t)row * 256 + hh * 64 + 2 * jj;
            *(unsigned*)o = pk2(x1a * cs0 - x2a * sn0, x1b * cs1 - x2b * sn1); *(unsigned*)(o + 32) = pk2(x2a * cs0 + x1a * sn0, x2b * cs1 + x1b * sn1);
        }
        {
            const int col = hh == 0 ? 2944 : (hh == 1 ? 3072 : (hh == 2 ? 2816 : 2880));
            const bf16* p = pr + col + 2 * jj; const unsigned a = *(const unsigned*)p, b = *(const unsigned*)(p + 32);
            float x1a = bflo(a), x1b = bfhi(a), x2a = bflo(b), x2b = bfhi(b);
            float ss = group_sum<16>(x1a * x1a + x1b * x1b + x2a * x2a + x2b * x2b); const float rstd = rsqrtf(ss * (1.f / 64.f) + 1e-6f);
            const float* g = (hh == 0 ? C.nsa_ks_g : C.nsa_kw_g) + (size_t)l * 64;
            const float n1a = x1a * rstd * g[2 * jj], n1b = x1b * rstd * g[2 * jj + 1], n2a = x2a * rstd * g[32 + 2 * jj], n2b = x2b * rstd * g[33 + 2 * jj];
            unsigned o1 = pk2(n1a * cs0 - n2a * sn0, n1b * cs1 - n2b * sn1), o2 = pk2(n2a * cs0 + n1a * sn0, n2b * cs1 + n1b * sn1);
            if (hh >= 2) { o1 = a; o2 = b; }
            bf16* o = (hh == 0 ? KS : (hh == 1 ? KW : (hh == 2 ? KCR : VCR))) + (size_t)row * 64 + 2 * jj;
            *(unsigned*)o = o1; *(unsigned*)(o + 32) = o2;
        }
        if (lane < 12) GATE[(size_t)row * 12 + lane] = fsigmoid(bf2f(pr[3200 + lane]));
    }
}
DI void scan_phase(const Ctx& C) {
    if (C.bid >= 64) return;
    const float* SC = WSP(float, R_SC); float* YA = WSP(float, R_YA);
    const int u = C.bid, b = u >> 3, h = (u >> 1) & 3, half = u & 1, tid = C.tid;
    LAS float* buf = (LAS float*)C.lds;
    LAS float* ybuf = buf + 2 * 12288;
    const int rl = (tid >> 3) & 31, cg = tid & 7, row = 32 * half + rl;
    f32x4 ld[6];
#define SCAN_LOAD(chunk) do { _Pragma("unroll") for (int i = 0; i < 6; ++i) { const int idx = tid + 512 * i, step = idx / 96, rem = idx % 96, vec = rem >> 4, f4 = rem & 15; \
        ld[i] = *(const f32x4*)(SC + ((size_t)vec * NT + (size_t)b * NS + (chunk) * 32 + step) * 256 + h * 64 + f4 * 4); } } while (0)
#define SCAN_STORE(slot) do { _Pragma("unroll") for (int i = 0; i < 6; ++i) *(LAS f32x4*)(buf + (slot) * 12288 + (tid + 512 * i) * 4) = ld[i]; } while (0)
    SCAN_LOAD(0); SCAN_STORE(0);
    float S[8];
#pragma unroll
    for (int c = 0; c < 8; ++c) S[c] = 0.f;
    for (int ck = 0; ck < 128; ++ck) {
        __syncthreads();
        if (ck + 1 < 128) SCAN_LOAD(ck + 1);
        if (tid >= 256) {
            if (ck > 0) {
#pragma unroll
                for (int i = 0; i < 4; ++i) { const int i2 = (tid - 256) + 256 * i, step = i2 >> 5, rr = i2 & 31;
                    YA[((size_t)b * NS + (ck - 1) * 32 + step) * 256 + h * 64 + 32 * half + rr] = ybuf[((ck - 1) & 1) * 1024 + i2]; }
            }
        } else {
            const LAS float* bp = buf + (ck & 1) * 12288; LAS float* yb = ybuf + (ck & 1) * 1024;
#pragma unroll 2
            for (int step = 0; step < 32; ++step) {
                const LAS float* sp = bp + step * 384 + 8 * cg;
                const f32x4 w0 = *(const LAS f32x4*)(sp), w1 = *(const LAS f32x4*)(sp + 4), k0 = *(const LAS f32x4*)(sp + 64), k1 = *(const LAS f32x4*)(sp + 68);
                const f32x4 q0 = *(const LAS f32x4*)(sp + 128), q1 = *(const LAS f32x4*)(sp + 132), b0 = *(const LAS f32x4*)(sp + 192), b1 = *(const LAS f32x4*)(sp + 196);
                const f32x4 r0 = *(const LAS f32x4*)(sp + 256), r1 = *(const LAS f32x4*)(sp + 260); const float v = bp[step * 384 + 320 + row];
                float d = (S[0] * q0[0] + S[1] * q0[1]) + (S[2] * q0[2] + S[3] * q0[3]) + (S[4] * q1[0] + S[5] * q1[1]) + (S[6] * q1[2] + S[7] * q1[3]);
                const float sa = -sum8(d);
#pragma unroll
                for (int c = 0; c < 4; ++c) { S[c] = S[c] * w0[c] + (sa * b0[c] + v * k0[c]); S[4 + c] = S[4 + c] * w1[c] + (sa * b1[c] + v * k1[c]); }
                float y = (S[0] * r0[0] + S[1] * r0[1]) + (S[2] * r0[2] + S[3] * r0[3]) + (S[4] * r1[0] + S[5] * r1[1]) + (S[6] * r1[2] + S[7] * r1[3]);
                y = sum8(y);
                if (cg == 0) yb[step * 32 + rl] = y;
            }
        }
        if (ck + 1 < 128) SCAN_STORE((ck + 1) & 1);
    }
    __syncthreads();
    if (tid >= 256) {
#pragma unroll
        for (int i = 0; i < 4; ++i) { const int i2 = (tid - 256) + 256 * i, step = i2 >> 5, rr = i2 & 31;
            YA[((size_t)b * NS + 127 * 32 + step) * 256 + h * 64 + 32 * half + rr] = ybuf[1024 + i2]; }
    }
#undef SCAN_LOAD
#undef SCAN_STORE
    __syncthreads();
}

constexpr int KROW = 144, VROW = 144, KT_BYTES = 64 * KROW, VT_BYTES = 64 * VROW;
#define MFMA16(a, b, c) __builtin_amdgcn_mfma_f32_16x16x32_bf16((a), (b), (c), 0, 0, 0)
template <int NQT> struct FA { f32x4 O[NQT][4]; float m[NQT], l[NQT]; };
template <int NQT> DI void fa_init(FA<NQT>& st) {
#pragma unroll
    for (int q = 0; q < NQT; ++q) { st.m[q] = -1e30f; st.l[q] = 0.f;
#pragma unroll
        for (int d = 0; d < 4; ++d) st.O[q][d] = (f32x4){0.f, 0.f, 0.f, 0.f}; }
}
DI bf16x8 pack8(const f32x4& a, const f32x4& b) { u32x4 w; w.x = pk2(a[0], a[1]); w.y = pk2(a[2], a[3]); w.z = pk2(b[0], b[1]); w.w = pk2(b[2], b[3]); return __builtin_bit_cast(bf16x8, w); }
template <int NQT, class MaskF>
DI void fa_tile(FA<NQT>& st, const bf16x8 (&Q)[NQT][2], const LAS uchar* Ks, const LAS uchar* Vts, int lane, const MaskF& allowed) {
    const int l15 = lane & 15, quad = lane >> 4;
    f32x4 S[NQT][4];
#pragma unroll
    for (int kt = 0; kt < 4; ++kt) {
        const bf16x8 k0 = *(const LAS bf16x8*)(Ks + (16 * kt + l15) * KROW + quad * 16), k1 = *(const LAS bf16x8*)(Ks + (16 * kt + l15) * KROW + 64 + quad * 16);
#pragma unroll
        for (int q = 0; q < NQT; ++q) { S[q][kt] = MFMA16(k0, Q[q][0], ((f32x4){0.f, 0.f, 0.f, 0.f})); S[q][kt] = MFMA16(k1, Q[q][1], S[q][kt]); }
    }
#pragma unroll
    for (int q = 0; q < NQT; ++q) {
        float mx = -1e30f;
#pragma unroll
        for (int kt = 0; kt < 4; ++kt)
#pragma unroll
            for (int j = 0; j < 4; ++j) { const float s = allowed(q, 16 * kt + 4 * quad + j) ? S[q][kt][j] : -1e30f; S[q][kt][j] = s; mx = fmaxf(mx, s); }
        mx = fmaxf(mx, __shfl_xor(mx, 16)); mx = fmaxf(mx, __shfl_xor(mx, 32));
        const float mn = fmaxf(st.m[q], mx), alpha = fexp2(st.m[q] - mn); st.m[q] = mn;
        float rs = 0.f;
#pragma unroll
        for (int kt = 0; kt < 4; ++kt)
#pragma unroll
            for (int j = 0; j < 4; ++j) { const float s = S[q][kt][j]; const float p = (s > -1e29f) ? fexp2(s - mn) : 0.f; S[q][kt][j] = p; rs += p; }
        st.l[q] = st.l[q] * alpha + rs;
#pragma unroll
        for (int d = 0; d < 4; ++d) st.O[q][d] = st.O[q][d] * alpha;
    }
#pragma unroll
    for (int ks = 0; ks < 2; ++ks) {
        bf16x8 pf[NQT];
#pragma unroll
        for (int q = 0; q < NQT; ++q) pf[q] = pack8(S[q][2 * ks], S[q][2 * ks + 1]);
#pragma unroll
        for (int d = 0; d < 4; ++d) {
            const LAS uchar* vp = Vts + (16 * d + l15) * VROW + (32 * ks + 4 * quad) * 2;
            const u32x2 lo = *(const LAS u32x2*)vp, hi = *(const LAS u32x2*)(vp + 32);
            const bf16x8 vf = __builtin_bit_cast(bf16x8, ((u32x4){lo.x, lo.y, hi.x, hi.y}));
#pragma unroll
            for (int q = 0; q < NQT; ++q) st.O[q][d] = MFMA16(vf, pf[q], st.O[q][d]);
        }
    }
}
template <int NQT> DI void fa_finish(FA<NQT>& st, float (&lse2)[NQT]) {
#pragma unroll
    for (int q = 0; q < NQT; ++q) { float l = st.l[q]; l += __shfl_xor(l, 16); l += __shfl_xor(l, 32); const float inv = l > 0.f ? 1.f / l : 0.f; lse2[q] = st.m[q] + __log2f(fmaxf(l, 1e-37f));
#pragma unroll
        for (int d = 0; d < 4; ++d) st.O[q][d] = st.O[q][d] * inv; }
}
DI void kv_store(LAS uchar* Ks, LAS uchar* Vts, int tid, const u32x4& kr, const u32x4& vr) {
    const int key = tid >> 3, ch = tid & 7;
    *(LAS u32x4*)(Ks + key * KROW + ch * 16) = kr;
#pragma unroll
    for (int i = 0; i < 4; ++i) { *(LAS unsigned short*)(Vts + (ch * 8 + 2 * i) * VROW + key * 2) = (unsigned short)(vr[i] & 0xffffu); *(LAS unsigned short*)(Vts + (ch * 8 + 2 * i + 1) * VROW + key * 2) = (unsigned short)(vr[i] >> 16); }
}
DI void q_load(bf16x8 (&Q)[2], const bf16* qrow, int quad) { Q[0] = *(const bf16x8*)(qrow + 8 * quad); Q[1] = *(const bf16x8*)(qrow + 32 + 8 * quad); }

struct DilMask { int qi[2]; int k0; DI bool operator()(int q, int key) const { const int ki = k0 + key, d = qi[q] - ki; return ki >= 0 && d >= 0 && d <= 128; } };
DI void dil_phase(const Ctx& C) {
    const bf16 *QC = WSP(bf16, R_QC), *KC = WSP(bf16, R_KC), *PROJ = WSP(bf16, R_PROJ); float* OC = WSP(float, R_OC); float* LSE = WSP(float, R_LSE);
    LAS uchar* Ks = C.lds; LAS uchar* Vts = C.lds + KT_BYTES;
    const int tid = C.tid, lane = C.lane, w = C.wave, l15 = lane & 15, quad = lane >> 4;
    for (int unit = C.bid; unit < 1536; unit += C.G) {
        const int cfg = unit / 512, r = unit % 512, dsh = 2 * cfg, d = 1 << dsh;
        const int b = r >> 6, h = (r >> 4) & 3, r2 = r & 15;
        const int nblk = 16 >> dsh, res = r2 / nblk, blk = r2 % nblk, i0 = blk * 256;
        const size_t tb = (size_t)b * NS;
        bf16x8 Q[2][2]; DilMask mk; FA<2> st; fa_init(st);
#pragma unroll
        for (int q = 0; q < 2; ++q) { mk.qi[q] = i0 + 32 * w + 16 * q + l15; q_load(Q[q], QC + (tb + res + (size_t)d * mk.qi[q]) * 256 + h * 64, quad); }
        const int jlo = w >> 1, jhi = (w >> 1) + 2;
        u32x4 kr, vr;
#define DIL_LOAD(j) do { const int ki = i0 - 128 + 64 * (j) + (tid >> 3); kr = (u32x4){0u, 0u, 0u, 0u}; vr = kr; \
        if (ki >= 0) { const size_t rowk = tb + res + (size_t)d * ki; kr = *(const u32x4*)(KC + rowk * 256 + h * 64 + (tid & 7) * 8); vr = *(const u32x4*)(PROJ + rowk * NPJ + PJ_C + 512 + h * 64 + (tid & 7) * 8); } } while (0)
        DIL_LOAD(0);
        for (int j = 0; j < 6; ++j) {
            __syncthreads(); kv_store(Ks, Vts, tid, kr, vr); __syncthreads();
            if (j + 1 < 6) DIL_LOAD(j + 1);
            if (j >= jlo && j <= jhi) { mk.k0 = i0 - 128 + 64 * j; fa_tile<2>(st, Q, Ks, Vts, lane, mk); }
        }
#undef DIL_LOAD
        float lse2[2]; fa_finish<2>(st, lse2);
#pragma unroll
        for (int q = 0; q < 2; ++q) { const size_t rowq = tb + res + (size_t)d * mk.qi[q]; float* o = OC + ((size_t)cfg * NT + rowq) * 256 + h * 64 + 4 * quad;
#pragma unroll
            for (int dt = 0; dt < 4; ++dt) *(f32x4*)(o + 16 * dt) = st.O[q][dt];
            if (quad == 0) LSE[((size_t)cfg * NT + rowq) * 4 + h] = lse2[q]; }
    }
    __syncthreads();
}

struct SwaMask { int t[2]; int k0; DI bool operator()(int q, int key) const { const int d = t[q] - (k0 + key); return d >= 0 && d <= 511; } };
struct SlcMask { int t[2]; int k0; bool sel[2]; DI bool operator()(int q, int key) const { return sel[q] && (k0 + key <= t[q]); } };
DI void swa_phase(const Ctx& C) {
    const bf16 *QR = WSP(bf16, R_QR), *KW = WSP(bf16, R_KW), *PROJ = WSP(bf16, R_PROJ); float* OS = WSP(float, R_OSWA);
    LAS uchar* Ks = C.lds; LAS uchar* Vts = C.lds + KT_BYTES;
    const int tid = C.tid, lane = C.lane, w = C.wave, l15 = lane & 15, quad = lane >> 4, head = l15 & 3;
    for (int unit = C.bid; unit < 512; unit += C.G) {
        const int b = unit >> 6, tbk = unit & 63, t0 = 64 * tbk; const size_t tb = (size_t)b * NS;
        bf16x8 Q[2][2]; SwaMask mk; FA<2> st; fa_init(st);
#pragma unroll
        for (int q = 0; q < 2; ++q) { mk.t[q] = t0 + 8 * w + 4 * q + (l15 >> 2); q_load(Q[q], QR + (tb + mk.t[q]) * 256 + head * 64, quad); }
        const int j0 = tbk >= 8 ? tbk - 8 : 0;
        u32x4 kr, vr;
#define SWA_LOAD(j) do { const size_t rowk = tb + 64 * (j) + (tid >> 3); kr = *(const u32x4*)(KW + rowk * 64 + (tid & 7) * 8); vr = *(const u32x4*)(PROJ + rowk * NPJ + 3136 + (tid & 7) * 8); } while (0)
        SWA_LOAD(j0);
        for (int j = j0; j <= tbk; ++j) {
            __syncthreads(); kv_store(Ks, Vts, tid, kr, vr); __syncthreads();
            if (j + 1 <= tbk) SWA_LOAD(j + 1);
            mk.k0 = 64 * j; fa_tile<2>(st, Q, Ks, Vts, lane, mk);
        }
#undef SWA_LOAD
        float lse2[2]; fa_finish<2>(st, lse2);
#pragma unroll
        for (int q = 0; q < 2; ++q) { float* o = OS + (tb + mk.t[q]) * 256 + head * 64 + 4 * quad;
#pragma unroll
            for (int dt = 0; dt < 4; ++dt) *(f32x4*)(o + 16 * dt) = st.O[q][dt]; }
    }
    __syncthreads();
}
DI void slc_phase(const Ctx& C) {
    const bf16 *QR = WSP(bf16, R_QR), *KSb = WSP(bf16, R_KS), *PROJ = WSP(bf16, R_PROJ); float* OS = WSP(float, R_OSLC); const unsigned long long* SELM = WSP(unsigned long long, R_SELM);
    LAS uchar* Ks = C.lds; LAS uchar* Vts = C.lds + KT_BYTES; LAS unsigned* uw = (LAS unsigned*)(C.lds + KT_BYTES + VT_BYTES);
    const int tid = C.tid, lane = C.lane, w = C.wave, l15 = lane & 15, quad = lane >> 4, head = l15 & 3;
    for (int unit = C.bid; unit < 512; unit += C.G) {
        const int b = unit >> 6, tbk = unit & 63, t0 = 64 * tbk; const size_t tb = (size_t)b * NS;
        __syncthreads();
        if (tid < 64) { const unsigned long long m = SELM[tb + t0 + tid]; unsigned lo = (unsigned)m, hi = (unsigned)(m >> 32);
#pragma unroll
            for (int o = 1; o < 64; o <<= 1) { lo |= __shfl_xor(lo, o); hi |= __shfl_xor(hi, o); }
            if (tid == 0) { uw[0] = lo; uw[1] = hi; } }
        __syncthreads();
        unsigned long long U = ((unsigned long long)uw[1] << 32) | uw[0];
        U &= (tbk == 63) ? ~0ull : ((2ull << tbk) - 1ull);
        bf16x8 Q[2][2]; SlcMask mk; FA<2> st; fa_init(st); unsigned long long msk[2];
#pragma unroll
        for (int q = 0; q < 2; ++q) { mk.t[q] = t0 + 8 * w + 4 * q + (l15 >> 2); msk[q] = SELM[tb + mk.t[q]]; q_load(Q[q], QR + (tb + mk.t[q]) * 256 + head * 64, quad); }
        unsigned wlo = (unsigned)(msk[0] | msk[1]), whi = (unsigned)((msk[0] | msk[1]) >> 32);
#pragma unroll
        for (int o = 1; o < 64; o <<= 1) { wlo |= __shfl_xor(wlo, o); whi |= __shfl_xor(whi, o); }
        const unsigned long long WM = ((unsigned long long)whi << 32) | wlo;
        u32x4 kr, vr;
#define SLC_LOAD(j) do { const size_t rowk = tb + 64 * (j) + (tid >> 3); kr = *(const u32x4*)(KSb + rowk * 64 + (tid & 7) * 8); vr = *(const u32x4*)(PROJ + rowk * NPJ + 3008 + (tid & 7) * 8); } while (0)
        int j = __builtin_ctzll(U); U &= U - 1ull;
        SLC_LOAD(j);
        for (;;) {
            __syncthreads(); kv_store(Ks, Vts, tid, kr, vr); __syncthreads();
            const int jn = U ? __builtin_ctzll(U) : -1; U &= U - 1ull;
            if (jn >= 0) SLC_LOAD(jn);
            if ((WM >> j) & 1ull) { mk.k0 = 64 * j; mk.sel[0] = (msk[0] >> j) & 1ull; mk.sel[1] = (msk[1] >> j) & 1ull; fa_tile<2>(st, Q, Ks, Vts, lane, mk); }
            if (jn < 0) break; j = jn;
        }
#undef SLC_LOAD
        float lse2[2]; fa_finish<2>(st, lse2);
#pragma unroll
        for (int q = 0; q < 2; ++q) { float* o = OS + (tb + mk.t[q]) * 256 + head * 64 + 4 * quad;
#pragma unroll
            for (int dt = 0; dt < 4; ++dt) *(f32x4*)(o + 16 * dt) = st.O[q][dt]; }
    }
    __syncthreads();
}
constexpr int VCROW = 528;
DI void cmp_phase(const Ctx& C, int l) {
    const bf16* QN = WSP(bf16, R_QN); const float* CMP = WSP(float, R_CMP); float* OCm = WSP(float, R_OCMP); float* IMP = WSP(float, R_IMP);
    LAS uchar* Kc = C.lds; LAS uchar* Vtc = C.lds + 256 * KROW;
    const int tid = C.tid, lane = C.lane, w = C.wave, l15 = lane & 15, quad = lane >> 4, head = l15 & 3;
    int bl = -1;
    for (int unit = C.bid; unit < 512; unit += C.G) {
        const int b = unit >> 6, tbk = unit & 63, t0 = 64 * tbk; const size_t tb = (size_t)b * NS;
        if (b != bl) {
            __syncthreads();
            { const int key = tid >> 1, hf = tid & 1; const float* kp = CMP + ((size_t)b * 256 + key) * 64 + 32 * hf; const float* vp = CMP + ((size_t)2048 + (size_t)b * 256 + key) * 64 + 32 * hf;
              float kv[32], vv[32]; float ss = 0.f;
#pragma unroll
              for (int i = 0; i < 8; ++i) { const f32x4 a = *(const f32x4*)(kp + 4 * i), c = *(const f32x4*)(vp + 4 * i);
#pragma unroll
                  for (int j = 0; j < 4; ++j) { kv[4 * i + j] = a[j]; vv[4 * i + j] = c[j]; ss += a[j] * a[j]; } }
              ss += __shfl_xor(ss, 1); const float rstd = rsqrtf(ss * (1.f / 64.f) + 1e-6f); const float* g = C.nsa_kc_g + (size_t)l * 64 + 32 * hf; const bool dead = (key == 255);
#pragma unroll
              for (int i = 0; i < 4; ++i) { u32x4 o;
                  o.x = pk2(kv[8 * i] * rstd * g[8 * i], kv[8 * i + 1] * rstd * g[8 * i + 1]); o.y = pk2(kv[8 * i + 2] * rstd * g[8 * i + 2], kv[8 * i + 3] * rstd * g[8 * i + 3]);
                  o.z = pk2(kv[8 * i + 4] * rstd * g[8 * i + 4], kv[8 * i + 5] * rstd * g[8 * i + 5]); o.w = pk2(kv[8 * i + 6] * rstd * g[8 * i + 6], kv[8 * i + 7] * rstd * g[8 * i + 7]);
                  if (dead) o = (u32x4){0u, 0u, 0u, 0u};
                  *(LAS u32x4*)(Kc + key * KROW + hf * 64 + i * 16) = o; }
#pragma unroll
              for (int i = 0; i < 32; ++i) *(LAS unsigned short*)(Vtc + (32 * hf + i) * VCROW + key * 2) = (unsigned short)(dead ? 0u : f2bf(vv[i]));
            }
            __syncthreads(); bl = b;
        }
        const int cmaxu = (t0 + 32) >> 4;
        const int ktmax = cmaxu >> 4;
#pragma unroll 1
        for (int q = 0; q < 2; ++q) {
            const int t = t0 + 8 * w + 4 * q + (l15 >> 2);
            bf16x8 Q[2]; q_load(Q, QN + (tb + t) * 256 + head * 64, quad);
            f32x4 S[16]; float mx = -1e30f;
#pragma unroll
            for (int kt = 0; kt < 16; ++kt) {
                if (kt <= ktmax) {
                    const bf16x8 k0 = *(const LAS bf16x8*)(Kc + (16 * kt + l15) * KROW + quad * 16), k1 = *(const LAS bf16x8*)(Kc + (16 * kt + l15) * KROW + 64 + quad * 16);
                    S[kt] = MFMA16(k0, Q[0], ((f32x4){0.f, 0.f, 0.f, 0.f})); S[kt] = MFMA16(k1, Q[1], S[kt]);
#pragma unroll
                    for (int j = 0; j < 4; ++j) { const int c = 16 * kt + 4 * quad + j; const float s = (16 * c + 31 <= t) ? S[kt][j] : -1e30f; S[kt][j] = s; mx = fmaxf(mx, s); }
                } else S[kt] = (f32x4){-1e30f, -1e30f, -1e30f, -1e30f};
            }
            mx = fmaxf(mx, __shfl_xor(mx, 16)); mx = fmaxf(mx, __shfl_xor(mx, 32));
            float ls = 0.f;
#pragma unroll
            for (int kt = 0; kt < 16; ++kt)
#pragma unroll
                for (int j = 0; j < 4; ++j) { const float s = S[kt][j]; const float p = (s > -1e29f) ? fexp2(s - mx) : 0.f; S[kt][j] = p; ls += p; }
            ls += __shfl_xor(ls, 16); ls += __shfl_xor(ls, 32);
            const float inv = ls > 0.f ? 1.f / ls : 0.f;
#pragma unroll
            for (int kt = 0; kt < 16; ++kt) S[kt] = S[kt] * inv;
#pragma unroll
            for (int kt = 0; kt < 16; ++kt) {
                const float send = (quad == 3) ? (kt > 0 ? S[kt > 0 ? kt - 1 : 0][3] : 0.f) : S[kt][3];
                const float prev = __shfl(send, (lane + 48) & 63);
                float v = ((quad == 0 && kt == 0) ? 0.f : prev) + 2.f * (S[kt][0] + S[kt][1] + S[kt][2]) + S[kt][3];
                v += __shfl_xor(v, 1); v += __shfl_xor(v, 2);
                if (head == 0) IMP[(tb + t) * 64 + 4 * kt + quad] = v;
            }
            f32x4 O[4];
#pragma unroll
            for (int d = 0; d < 4; ++d) O[d] = (f32x4){0.f, 0.f, 0.f, 0.f};
#pragma unroll
            for (int ks = 0; ks < 8; ++ks) {
                if (2 * ks <= ktmax) {
                    const bf16x8 pf = pack8(S[2 * ks], S[2 * ks + 1]);
#pragma unroll
                    for (int d = 0; d < 4; ++d) { const LAS uchar* vp = Vtc + (16 * d + l15) * VCROW + (32 * ks + 4 * quad) * 2;
                        const u32x2 lo = *(const LAS u32x2*)vp, hi = *(const LAS u32x2*)(vp + 32);
                        O[d] = MFMA16(__builtin_bit_cast(bf16x8, ((u32x4){lo.x, lo.y, hi.x, hi.y})), pf, O[d]); }
                }
            }
            float* o = OCm + (tb + t) * 256 + head * 64 + 4 * quad;
#pragma unroll
            for (int d = 0; d < 4; ++d) *(f32x4*)(o + 16 * d) = O[d];
        }
    }
    __syncthreads();
}

DI void topk_phase(const Ctx& C) {
    const float* IMP = WSP(float, R_IMP); unsigned long long* SELM = WSP(unsigned long long, R_SELM);
    for (int row = C.bid * NTHR + C.tid; row < NT; row += C.G * NTHR) {
        const int s = row % NS, cur = s >> 6; unsigned long long mask;
        if (cur <= 15) mask = (2ull << cur) - 1ull;
        else {
            mask = 1ull | (1ull << cur) | (1ull << (cur - 1));
            float v[64];
#pragma unroll
            for (int i = 0; i < 16; ++i) { const f32x4 a = *(const f32x4*)(IMP + (size_t)row * 64 + 4 * i);
#pragma unroll
                for (int j = 0; j < 4; ++j) { const int jb = 4 * i + j; v[jb] = (jb >= 1 && jb <= cur - 2) ? a[j] : -1.f; } }
#pragma unroll 1
            for (int r = 0; r < 13; ++r) {
                float bv = -0.5f; int bi = 0;
#pragma unroll
                for (int jb = 0; jb < 64; ++jb) if (v[jb] > bv) { bv = v[jb]; bi = jb; }
                mask |= 1ull << bi;
#pragma unroll
                for (int jb = 0; jb < 64; ++jb) v[jb] = (jb == bi) ? -1.f : v[jb];
            }
        }
        SELM[row] = mask;
    }
}

DI void fin_phase(const Ctx& C, int l) {
    const float* SC = WSP(float, R_SC); const float* YA = WSP(float, R_YA); const float* Gb = WSP(float, R_G); const float* OC = WSP(float, R_OC); const float* LSE = WSP(float, R_LSE);
    const float *OCm = WSP(float, R_OCMP), *OSl = WSP(float, R_OSLC), *OSw = WSP(float, R_OSWA), *GATE = WSP(float, R_GATE); bf16* YCAT = WSP(bf16, R_YCAT);
    const int lane = C.lane, gw = C.bid * NWAVE + C.wave, NGW = C.G * NWAVE, ch = 4 * lane, hh = lane >> 4;
    for (int row = gw; row < NT; row += NGW) {
        const size_t o = (size_t)row * 256 + ch;
        {
            const f32x4 y = *(const f32x4*)(YA + o), r = *(const f32x4*)(SC + (size_t)4 * NT * 256 + o), k = *(const f32x4*)(SC + (size_t)1 * NT * 256 + o), v = *(const f32x4*)(SC + (size_t)5 * NT * 256 + o), g = *(const f32x4*)(Gb + o);
            const f32x4 rk = *(const f32x4*)(C.rk + (size_t)l * 256 + ch), gw4 = *(const f32x4*)(C.gn_w + (size_t)l * 256 + ch), gb4 = *(const f32x4*)(C.gn_b + (size_t)l * 256 + ch);
            const float mu = group_sum<16>((y[0] + y[1]) + (y[2] + y[3])) * (1.f / 64.f);
            const f32x4 dy = y - mu; const float var = group_sum<16>((dy[0] * dy[0] + dy[1] * dy[1]) + (dy[2] * dy[2] + dy[3] * dy[3])) * (1.f / 64.f);
            const float rstd = rsqrtf(var + 64e-5f);
            const float dot = group_sum<16>((r[0] * k[0] * rk[0] + r[1] * k[1] * rk[1]) + (r[2] * k[2] * rk[2] + r[3] * k[3] * rk[3]));
            float out[4];
#pragma unroll
            for (int i = 0; i < 4; ++i) out[i] = ((dy[i] * rstd * gw4[i] + gb4[i]) + dot * v[i]) * g[i];
            u32x2 w; w.x = pk2(out[0], out[1]); w.y = pk2(out[2], out[3]); *(u32x2*)(YCAT + (size_t)row * DM + ch) = w;
        }
        {
            const float l0 = LSE[(size_t)row * 4 + hh], l1 = LSE[((size_t)NT + row) * 4 + hh], l2 = LSE[((size_t)2 * NT + row) * 4 + hh];
            const float mx = fmaxf(l0, fmaxf(l1, l2)); float w0 = fexp2(l0 - mx), w1 = fexp2(l1 - mx), w2 = fexp2(l2 - mx); const float inv = 1.f / (w0 + w1 + w2); w0 *= inv; w1 *= inv; w2 *= inv;
            const f32x4 a = *(const f32x4*)(OC + o), b = *(const f32x4*)(OC + (size_t)NT * 256 + o), c = *(const f32x4*)(OC + (size_t)2 * NT * 256 + o);
            const f32x4 y = a * w0 + b * w1 + c * w2;
            const float ss = group_sum<16>((y[0] * y[0] + y[1] * y[1]) + (y[2] * y[2] + y[3] * y[3])); const float rstd = rsqrtf(ss * (1.f / 64.f) + 1e-6f);
            const f32x4 og = *(const f32x4*)(C.onorm_g + (size_t)l * 768 + 256 + ch);
            u32x2 w; w.x = pk2(y[0] * rstd * og[0], y[1] * rstd * og[1]); w.y = pk2(y[2] * rstd * og[2], y[3] * rstd * og[3]); *(u32x2*)(YCAT + (size_t)row * DM + 512 + ch) = w;
        }
        {
            const float g0 = GATE[(size_t)row * 12 + hh * 3], g1 = GATE[(size_t)row * 12 + hh * 3 + 1], g2 = GATE[(size_t)row * 12 + hh * 3 + 2];
            const f32x4 a = *(const f32x4*)(OCm + o), b = *(const f32x4*)(OSl + o), c = *(const f32x4*)(OSw + o);
            const f32x4 y = a * g0 + b * g1 + c * g2;
            const float ss = group_sum<16>((y[0] * y[0] + y[1] * y[1]) + (y[2] * y[2] + y[3] * y[3])); const float rstd = rsqrtf(ss * (1.f / 64.f) + 1e-6f);
            const f32x4 og = *(const f32x4*)(C.onorm_g + (size_t)l * 768 + 512 + ch);
            u32x2 w; w.x = pk2(y[0] * rstd * og[0], y[1] * rstd * og[1]); w.y = pk2(y[2] * rstd * og[2], y[3] * rstd * og[3]); *(u32x2*)(YCAT + (size_t)row * DM + 768 + ch) = w;
        }
    }
}
#define MFMA_F32(a, b, c) __builtin_amdgcn_mfma_f32_16x16x4f32((a), (b), (c), 0, 0, 0)
DI void router_phase(const Ctx& C, int l) {
    const float* X = C.out; const float* MOD = WSP(float, WS_SMALL) + (size_t)l * 8 * 6144; bf16* H = WSP(bf16, WS_H);
    int* TOPE = WSP(int, WS_ROUTE); float* TOPG = (float*)(TOPE + NT * 4); unsigned* CNTB = WSP(unsigned, WS_CTL) + CW_CNT + l * 8192;
    LAS float* lg = (LAS float*)C.lds + C.wave * 512;
    LAS unsigned* hist = (LAS unsigned*)(C.lds + 16384);
    const int lane = C.lane, l15 = lane & 15, quad = lane >> 4, gw = C.bid * NWAVE + C.wave, NGW = C.G * NWAVE;
    if (C.tid < 32) hist[C.tid] = 0u;
    __syncthreads();
    const float* wr = C.w_router + (size_t)l * 1024 * 32; const float* g2 = C.norm2_g + (size_t)l * DM;
    for (int task = gw; task < NT / 16; task += NGW) {
        const int row0 = 16 * task, b = row0 / NS; const float* xr = X + (size_t)(row0 + l15) * DM + 4 * quad;
        const float* sh = MOD + (size_t)b * 6144 + 3072 + 4 * quad; const float* sc = sh + 1024;
        float ss = 0.f;
#pragma unroll 8
        for (int i = 0; i < 64; ++i) { const f32x4 a = *(const f32x4*)(xr + 16 * i); ss += (a[0] * a[0] + a[1] * a[1]) + (a[2] * a[2] + a[3] * a[3]); }
        ss += __shfl_xor(ss, 16); ss += __shfl_xor(ss, 32);
        const float rstd = rsqrtf(ss * (1.f / DM) + 1e-6f);
        f32x4 acc0 = (f32x4){0.f, 0.f, 0.f, 0.f}, acc1 = acc0;
        bf16* hrow = H + (size_t)(row0 + l15) * DM + 4 * quad;
#pragma unroll 2
        for (int i = 0; i < 64; ++i) {
            const f32x4 a = *(const f32x4*)(xr + 16 * i), g = *(const f32x4*)(g2 + 16 * i + 4 * quad), s1 = *(const f32x4*)(sc + 16 * i), s0 = *(const f32x4*)(sh + 16 * i);
            f32x4 h;
#pragma unroll
            for (int j = 0; j < 4; ++j) h[j] = a[j] * rstd * g[j] * (1.f + s1[j]) + s0[j];
            u32x2 o; o.x = pk2(h[0], h[1]); o.y = pk2(h[2], h[3]); *(u32x2*)(hrow + 16 * i) = o;
            const float* wp = wr + (size_t)(16 * i + 4 * quad) * 32 + l15;
#pragma unroll
            for (int j = 0; j < 4; ++j) { acc0 = MFMA_F32(h[j], wp[j * 32], acc0); acc1 = MFMA_F32(h[j], wp[j * 32 + 16], acc1); }
        }
        const float b0 = C.b_router[l * 32 + l15], b1 = C.b_router[l * 32 + 16 + l15];
#pragma unroll
        for (int j = 0; j < 4; ++j) { lg[(4 * quad + j) * 32 + l15] = acc0[j] + b0; lg[(4 * quad + j) * 32 + 16 + l15] = acc1[j] + b1; }
        asm volatile("s_waitcnt lgkmcnt(0)" ::: "memory");
        if (lane < 16) {
            float v[32];
#pragma unroll
            for (int i = 0; i < 8; ++i) { const f32x4 a = *(const LAS f32x4*)(lg + lane * 32 + 4 * i); v[4 * i] = a[0]; v[4 * i + 1] = a[1]; v[4 * i + 2] = a[2]; v[4 * i + 3] = a[3]; }
            float tv[4]; int ti[4];
#pragma unroll
            for (int r = 0; r < 4; ++r) { float bv = -3.0e38f; int bi = 0;
#pragma unroll
                for (int e = 0; e < 32; ++e) if (v[e] > bv) { bv = v[e]; bi = e; }
                tv[r] = bv; ti[r] = bi;
#pragma unroll
                for (int e = 0; e < 32; ++e) v[e] = (e == bi) ? -3.0e38f : v[e]; }
            const float e1 = __expf(tv[1] - tv[0]), e2 = __expf(tv[2] - tv[0]), e3 = __expf(tv[3] - tv[0]), inv = 1.f / (1.f + e1 + e2 + e3);
            const int row = row0 + lane;
            *(int4*)(TOPE + (size_t)row * 4) = make_int4(ti[0], ti[1], ti[2], ti[3]);
            *(f32x4*)(TOPG + (size_t)row * 4) = (f32x4){inv, e1 * inv, e2 * inv, e3 * inv};
#pragma unroll
            for (int r = 0; r < 4; ++r) __hip_atomic_fetch_add(&hist[ti[r]], 1u, __ATOMIC_RELAXED, __HIP_MEMORY_SCOPE_WORKGROUP);
        }
        asm volatile("s_waitcnt lgkmcnt(0)" ::: "memory");
    }
    __syncthreads();
    if (C.tid < 32) CNTB[C.bid * 32 + C.tid] = hist[C.tid];
}

DI void moe_tables(const Ctx& C, int l, LAS int* tab) {
    const unsigned* CNTB = WSP(unsigned, WS_CTL) + CW_CNT + l * 8192;
    __syncthreads();
    if (C.tid < 32) { unsigned tot = 0u, mine = 0u;
        for (int g = 0; g < C.G; ++g) { const unsigned c = CNTB[g * 32 + C.tid]; tot += c; mine += (g < C.bid) ? c : 0u; }
        tab[128 + C.tid] = (int)((tot + 255u) >> 8); tab[64 + C.tid] = (int)mine; }
    __syncthreads();
    if (C.tid == 0) { int s = 0; for (int e = 0; e < 32; ++e) { tab[e] = s; s += tab[128 + e]; } tab[32] = s; }
    __syncthreads();
}
DI void scatter_phase(const Ctx& C, int l) {
    const bf16* H = WSP(bf16, WS_H); bf16* XS = WSP(bf16, R_XS); const int* TOPE = WSP(int, WS_ROUTE); int* POS = (int*)(TOPE + NT * 8);
    LAS int* tab = (LAS int*)(C.lds + MISC_OFF + 64); LAS unsigned* cur = (LAS unsigned*)(C.lds + 16384);
    moe_tables(C, l, tab);
    if (C.tid < 32) cur[C.tid] = (unsigned)(tab[C.tid] * 256 + tab[64 + C.tid]);
    __syncthreads();
    const int lane = C.lane, gw = C.bid * NWAVE + C.wave, NGW = C.G * NWAVE;
    for (int task = gw; task < NT / 16; task += NGW) {
        const int row0 = 16 * task, tok = row0 + (lane >> 2);
        const int e = TOPE[(size_t)tok * 4 + (lane & 3)];
        const int slot = (int)__hip_atomic_fetch_add(&cur[e], 1u, __ATOMIC_RELAXED, __HIP_MEMORY_SCOPE_WORKGROUP);
        POS[(size_t)tok * 4 + (lane & 3)] = slot;
#pragma unroll 4
        for (int p = 0; p < 64; ++p) { const int dst = __shfl(slot, p); const bf16* src = H + (size_t)(row0 + (p >> 2)) * DM + lane * 8; bf16* d = XS + (size_t)dst * DM + lane * 8;
            const u32x4 a = *(const u32x4*)src, b2 = *(const u32x4*)(src + 512); *(u32x4*)d = a; *(u32x4*)(d + 512) = b2; }
    }
}
DI void combine_phase(const Ctx& C, int l) {
    const bf16* YB = WSP(bf16, R_YB); const int* TOPE = WSP(int, WS_ROUTE); const float* TOPG = (const float*)(TOPE + NT * 4); const int* POS = (const int*)(TOPE + NT * 8);
    const float* MOD = WSP(float, WS_SMALL) + (size_t)l * 8 * 6144; bf16* H = WSP(bf16, WS_H);
    const int lane = C.lane, gw = C.bid * NWAVE + C.wave, NGW = C.G * NWAVE;
    for (int row = gw; row < NT; row += NGW) {
        const int b = row / NS; const int4 ps = *(const int4*)(POS + (size_t)row * 4); const f32x4 gk = *(const f32x4*)(TOPG + (size_t)row * 4);
        const int pp[4] = {ps.x, ps.y, ps.z, ps.w};
        float* orow = C.out + (size_t)row * DM; const float* gt = MOD + (size_t)b * 6144 + 5120;
        f32x4 v[4]; float s = 0.f;
#pragma unroll
        for (int j = 0; j < 4; ++j) { const int k = 4 * lane + 256 * j; f32x4 a = (f32x4){0.f, 0.f, 0.f, 0.f};
#pragma unroll
            for (int q = 0; q < 4; ++q) { const u32x2 y = *(const u32x2*)(YB + (size_t)pp[q] * DM + k); a += (f32x4){bflo(y.x), bfhi(y.x), bflo(y.y), bfhi(y.y)} * gk[q]; }
            v[j] = *(const f32x4*)(orow + k) + *(const f32x4*)(gt + k) * a; *(f32x4*)(orow + k) = v[j];
            s += (v[j][0] * v[j][0] + v[j][1] * v[j][1]) + (v[j][2] * v[j][2] + v[j][3] * v[j][3]); }
        if (l + 1 < NLAYER) {
            s = group_sum<64>(s); const float rstd = rsqrtf(s * (1.f / DM) + 1e-6f); const float* M2 = MOD + 8 * 6144 + (size_t)b * 6144; const float* g = C.norm1_g + (size_t)(l + 1) * DM;
#pragma unroll
            for (int j = 0; j < 4; ++j) { const int k = 4 * lane + 256 * j; const f32x4 gg = *(const f32x4*)(g + k), a = *(const f32x4*)(M2 + 1024 + k), bb = *(const f32x4*)(M2 + k); f32x4 h;
#pragma unroll
                for (int i = 0; i < 4; ++i) h[i] = v[j][i] * rstd * gg[i] * (1.f + a[i]) + bb[i];
                u32x2 o; o.x = pk2(h[0], h[1]); o.y = pk2(h[2], h[3]); *(u32x2*)(H + (size_t)row * DM + k) = o; }
        }
    }
}
constexpr int PH_PER_LAYER = 17, PH_BASE = 2, N_PHASES = PH_BASE + NLAYER * PH_PER_LAYER;
#ifndef MK_ONE_LAUNCH
#define MK_ONE_LAUNCH 0
#endif
__global__ void __launch_bounds__(NTHR, 2) mk_fwd(Args args) {
    extern __shared__ __attribute__((aligned(16))) unsigned char lds_raw[];
    Ctx C;
    C.lds = (LAS unsigned char*)lds_raw; C.tid = threadIdx.x; C.lane = C.tid & 63; C.wave = __builtin_amdgcn_readfirstlane(C.tid >> 6); C.G = gridDim.x; C.bid = blockIdx.x;
    C.x = (const float*)args.in[0]; C.c = (const float*)args.in[1]; C.pos = (const int*)args.in[2]; C.w_ada = (const float*)args.in[3]; C.b_ada = (const float*)args.in[4];
    C.norm1_g = (const float*)args.in[5]; C.norm2_g = (const float*)args.in[6]; C.w_in = (const float*)args.in[7]; C.w_out = (const float*)args.in[8]; C.mu = (const float*)args.in[9];
    C.w0 = (const float*)args.in[10]; C.w2 = (const float*)args.in[11]; C.a0 = (const float*)args.in[12]; C.a2 = (const float*)args.in[13]; C.g2 = (const float*)args.in[14];
    C.kkw = (const float*)args.in[15]; C.ka = (const float*)args.in[16]; C.rk = (const float*)args.in[17]; C.gn_w = (const float*)args.in[18]; C.gn_b = (const float*)args.in[19];
    C.conv_w = (const float*)args.in[20]; C.dil_q_g = (const float*)args.in[21]; C.dil_k_g = (const float*)args.in[22]; C.nsa_q_g = (const float*)args.in[23]; C.nsa_kc_g = (const float*)args.in[24];
    C.nsa_ks_g = (const float*)args.in[25]; C.nsa_kw_g = (const float*)args.in[26]; C.pe_k = (const float*)args.in[27]; C.pe_v = (const float*)args.in[28]; C.wk1 = (const float*)args.in[29];
    C.wk2 = (const float*)args.in[30]; C.wv1 = (const float*)args.in[31]; C.wv2 = (const float*)args.in[32]; C.onorm_g = (const float*)args.in[33]; C.w_router = (const float*)args.in[34];
    C.b_router = (const float*)args.in[35]; C.w_gu = (const float*)args.in[36]; C.b_gu = (const float*)args.in[37]; C.w_down = (const float*)args.in[38]; C.b_down = (const float*)args.in[39];
    C.out = args.out; C.ws = args.ws;
    const int lo = args.ph_lo, hi = args.ph_hi;
    for (int u = C.tid; u < (LDS_BYTES - MISC_OFF) / 4; u += NTHR) ((LAS unsigned*)(C.lds + MISC_OFF))[u] = 0u;
    __syncthreads();
    XcdBarrier bar; bar.bar = WSP(unsigned, WS_CTL) + CW_BAR; bar.x = 0; bar.st = nullptr;
    if (hi - lo > 1) bar = xcd_barrier_post(WSP(unsigned, WS_CTL) + CW_BAR, (volatile LAS unsigned*)(C.lds + MISC_OFF));
#ifndef PHMASK
#define PHMASK 0xFFFFFFFFu
#endif
#define PHON(n) (((PHMASK) >> (n)) & 1u)
#define WSPP(T, off) ((T*)(P.ws + (off)))
#define IN(k) (lo <= (k) && (k) < hi)
#define SEAM(k) do { if (IN(k) && IN((k) + 1)) xcd_barrier(bar); } while (0)
#define PCTX Ctx P = C; asm volatile("" : "+v"(P.tid), "+v"(P.lane)); asm volatile("" : "+s"(P.ws), "+s"(P.out), "+s"(P.wave), "+s"(P.bid))
    if (PHON(17) && IN(0)) { PCTX; p0_prologue(P); }
    SEAM(0);
    if (PHON(18) && IN(1)) { PCTX; norm1_phase(P, 0, P.x); }
    SEAM(1);
    for (int l = 0; l < NLAYER; ++l) {
        const int pb = PH_BASE + PH_PER_LAYER * l;
        if (PHON(0) && IN(pb + 0)) { PCTX;
            pg8::Gemm g{WSPP(bf16, WS_H), WSPP(bf16, WS_WIN) + (size_t)l * NPJ * 1024, 1024, 1024}; pg8::StaticOrder S; S.init(NT / 256, NPJ / 256, P.G, P.bid);
            EpiProj E{WSPP(bf16, R_PROJ)}; pg8::gemm_phase(P.lds, P.tid, g, S, E);
        }
        SEAM(pb + 0);
        if (PHON(1) && IN(pb + 1)) { PCTX; prep_phase(P, l); }
        SEAM(pb + 1);
        if (PHON(2) && IN(pb + 2)) { PCTX;
#ifndef NO_LORA
            { pg8::Gemm g{WSPP(bf16, R_LIN), WSPP(bf16, WS_LORA) + (size_t)l * 768 * 256, 256, 256}; pg8::StaticOrder S; S.init(NT / 256, 3, P.G, P.bid);
              EpiLora E{WSPP(float, R_SC), WSPP(float, R_G), P.w0 + l * 256, P.a0 + l * 256, P.ka + l * 256}; pg8::gemm_phase(P.lds, P.tid, g, S, E); }
#endif
#ifndef NO_C1
            { pg8::Gemm g{WSPP(bf16, R_KCR), WSPP(bf16, WS_WK1) + (size_t)(l * 2) * 256 * 2048, 1024, 2048}; pg8::StaticOrder S; S.init(8, 1, P.G, P.bid);
              EpiC1 E{WSPP(bf16, R_CH1), (WSPP(float, WS_SMALL) + NLAYER * 8 * 6144 + l * 512)}; pg8::gemm_phase(P.lds, P.tid, g, S, E); }
            { pg8::Gemm g{WSPP(bf16, R_VCR), WSPP(bf16, WS_WK1) + (size_t)(l * 2 + 1) * 256 * 2048, 1024, 2048}; pg8::StaticOrder S; S.init(8, 1, P.G, (P.bid + 128) % P.G);
              EpiC1 E{WSPP(bf16, R_CH1) + 2048 * 256, (WSPP(float, WS_SMALL) + NLAYER * 8 * 6144 + l * 512 + 256)}; pg8::gemm_phase(P.lds, P.tid, g, S, E); }
#endif
        }
        SEAM(pb + 2);
        if (PHON(3) && IN(pb + 3)) { PCTX;
            { pg8::Gemm g{WSPP(bf16, R_CH1), WSPP(bf16, WS_WK2) + (size_t)(l * 2) * 256 * 256, 256, 256}; pg8::StaticOrder S; S.init(8, 1, P.G, P.bid);
              EpiC2 E{WSPP(float, R_CMP)}; pg8::gemm_phase(P.lds, P.tid, g, S, E); }
            { pg8::Gemm g{WSPP(bf16, R_CH1) + 2048 * 256, WSPP(bf16, WS_WK2) + (size_t)(l * 2 + 1) * 256 * 256, 256, 256}; pg8::StaticOrder S; S.init(8, 1, P.G, (P.bid + 128) % P.G);
              EpiC2 E{WSPP(float, R_CMP) + 2048 * 64}; pg8::gemm_phase(P.lds, P.tid, g, S, E); }
        }
        SEAM(pb + 3);
        if (PHON(4) && IN(pb + 4)) { PCTX; scan_phase(P); }
        SEAM(pb + 4);
        if (PHON(5) && IN(pb + 5)) { PCTX; dil_phase(P); }
        SEAM(pb + 5);
        if (PHON(6) && IN(pb + 6)) { PCTX; swa_phase(P); }
        SEAM(pb + 6);
        if (PHON(7) && IN(pb + 7)) { PCTX; cmp_phase(P, l); }
        SEAM(pb + 7);
        if (PHON(8) && IN(pb + 8)) { PCTX; topk_phase(P); }
        SEAM(pb + 8);
        if (PHON(9) && IN(pb + 9)) { PCTX; slc_phase(P); }
        SEAM(pb + 9);
        if (PHON(10) && IN(pb + 10)) { PCTX; fin_phase(P, l); }
        SEAM(pb + 10);
        if (PHON(11) && IN(pb + 11)) { PCTX;
            pg8::Gemm g{WSPP(bf16, R_YCAT), WSPP(bf16, WS_WOUT) + (size_t)l * 1024 * 1024, 1024, 1024}; pg8::StaticOrder S; S.init(NT / 256, 4, P.G, P.bid);
            EpiOut E{P.out, l == 0 ? P.x : (const float*)P.out, WSPP(float, WS_SMALL) + (size_t)l * 8 * 6144 + 2048}; pg8::gemm_phase(P.lds, P.tid, g, S, E);
        }
        SEAM(pb + 11);
        if (PHON(12) && IN(pb + 12)) { PCTX; router_phase(P, l); }
        SEAM(pb + 12);
        if (PHON(13) && IN(pb + 13)) { PCTX; scatter_phase(P, l); }
        SEAM(pb + 13);
        if (PHON(14) && IN(pb + 14)) { PCTX;
            LAS int* tab = (LAS int*)(P.lds + MISC_OFF + 64); moe_tables(P, l, tab);
            pg8::Gemm g{WSPP(bf16, R_XS), WSPP(bf16, WS_WGU) + (size_t)l * 32 * 2048 * 1024, 1024, 1024}; pg8::GroupedOrder S; S.init(tab[32], 8, P.G, P.bid); S.tstart = tab; S.nrow_e = 2048;
            EpiGU E{WSPP(bf16, R_ACT), P.b_gu + (size_t)l * 32 * 2048}; pg8::gemm_phase(P.lds, P.tid, g, S, E);
        }
        SEAM(pb + 14);
        if (PHON(15) && IN(pb + 15)) { PCTX;
            LAS int* tab = (LAS int*)(P.lds + MISC_OFF + 64); moe_tables(P, l, tab);
            pg8::Gemm g{WSPP(bf16, R_ACT), WSPP(bf16, WS_WDN) + (size_t)l * 32 * 1024 * 1024, 1024, 1024}; pg8::GroupedOrder S; S.init(tab[32], 4, P.G, P.bid); S.tstart = tab; S.nrow_e = 1024;
            EpiDN E{WSPP(bf16, R_YB), P.b_down + (size_t)l * 32 * 1024}; pg8::gemm_phase(P.lds, P.tid, g, S, E);
        }
        SEAM(pb + 15);
        if (PHON(16) && IN(pb + 16)) { PCTX; combine_phase(P, l); }
        SEAM(pb + 16);
    }
#undef IN
#undef SEAM
}

extern "C" void kernel_launch(void* const* d_in, const int* in_sizes, int n_in, void* d_out, int out_size, void* d_ws, size_t ws_size, hipStream_t stream) {
    static int grid = 0;
    if (grid == 0) {
        if (n_in != 40 || out_size != NT * DM || ws_size < WS_END) { fprintf(stderr, "kernel_launch: unexpected problem (n_in %d, out %d, ws %zu < %zu)\n", n_in, out_size, ws_size, (size_t)WS_END); grid = -1; return; }
        int dev = 0, cus = 0, per_cu = 0;
        if (hipGetDevice(&dev) != hipSuccess || hipDeviceGetAttribute(&cus, hipDeviceAttributeMultiprocessorCount, dev) != hipSuccess) { grid = -1; return; }
        if (hipFuncSetAttribute((const void*)mk_fwd, hipFuncAttributeMaxDynamicSharedMemorySize, LDS_BYTES) != hipSuccess) { fprintf(stderr, "kernel_launch: hipFuncSetAttribute failed\n"); grid = -1; return; }
        if (hipOccupancyMaxActiveBlocksPerMultiprocessor(&per_cu, (const void*)mk_fwd, NTHR, LDS_BYTES) != hipSuccess || per_cu < 1) fprintf(stderr, "kernel_launch: occupancy query says %d blocks per CU\n", per_cu);
        (void)hipGetLastError();
        grid = cus > 256 ? 256 : cus;
    }
    if (grid < 0) return;
    (void)hipMemsetAsync((char*)d_ws, 0, ZERO_BYTES, stream);
    Args a{};
    for (int i = 0; i < 40; ++i) a.in[i] = d_in[i];
    a.out = (float*)d_out; a.ws = (unsigned char*)d_ws;
#if MK_ONE_LAUNCH
    a.ph_lo = 0; a.ph_hi = N_PHASES;
    hipLaunchKernelGGL(mk_fwd, dim3(grid), dim3(NTHR), LDS_BYTES, stream, a);
#else
    for (int p = 0; p < N_PHASES; ++p) { a.ph_lo = p; a.ph_hi = p + 1; hipLaunchKernelGGL(mk_fwd, dim3(grid), dim3(NTHR), LDS_BYTES, stream, a); }
#endif
    const hipError_t le = hipPeekAtLastError();
    if (le != hipSuccess) fprintf(stderr, "kernel_launch: launch failed: %s\n", hipGetErrorName(le));
}
```

```cpp
#include <hip/hip_runtime.h>
#include <cstdio>
#include <cstdint>

#define DI __device__ __forceinline__
#define LAS __attribute__((address_space(3)))
#define GAS __attribute__((address_space(1)))
typedef unsigned short bf16;
typedef short bf16x8 __attribute__((ext_vector_type(8)));
typedef float f32x4 __attribute__((ext_vector_type(4)));
typedef float f32x2 __attribute__((ext_vector_type(2)));
typedef unsigned u32x4 __attribute__((ext_vector_type(4)));
typedef unsigned u32x2 __attribute__((ext_vector_type(2)));
typedef unsigned char uchar;

constexpr int NB = 8, NS = 4096, NT = NB * NS, DM = 1024, NPJ = 3328, NE = 32, FF = 1024, NLAYER = 2;
constexpr int PJ_A = 0, PJ_B = 1024, PJ_C = 1792, PJ_D = 2560;
constexpr int NR = NT * 4 + NE * 256;
constexpr int NTHR = 512, NWAVE = 8;

DI float bf2f(unsigned v) { return __builtin_bit_cast(float, v << 16); }
DI unsigned f2bf(float f) { unsigned u = __builtin_bit_cast(unsigned, f); return (u + 0x7fffu + ((u >> 16) & 1u)) >> 16; }
DI unsigned pk2(float lo, float hi) { return f2bf(lo) | (f2bf(hi) << 16); }
DI float bflo(unsigned w) { return __builtin_bit_cast(float, w << 16); }
DI float bfhi(unsigned w) { return __builtin_bit_cast(float, w & 0xffff0000u); }
DI float fexp2(float x) { return __builtin_amdgcn_exp2f(x); }
DI float fsigmoid(float x) { return 1.f / (1.f + __expf(-x)); }
DI float wsum_xor(float v, int o) { return v + __shfl_xor(v, o); }
template <int W> DI float group_sum(float v) {
#pragma unroll
    for (int o = 1; o < W; o <<= 1) v += __shfl_xor(v, o);
    return v;
}
DI float dpp_f(float x, const int ctrl_dummy);
template <int CTRL> DI float dppmov(float x) { return __builtin_bit_cast(float, __builtin_amdgcn_update_dpp(0, __builtin_bit_cast(int, x), CTRL, 0xF, 0xF, true)); }
DI float sum8(float x) { x += dppmov<0xB1>(x); x += dppmov<0x4E>(x); x += dppmov<0x141>(x); return x; }

#define XB_TMO      128
#define XB_XCNT(j)  (256  + 64 * (j))
#define XB_XSUB(j)  (1280 + 64 * (j))
#define XB_XGEN(j)  (2304 + 64 * (j))
#define XB_TOP      3328
#define XB_TOPGEN   3392
#define XCD_BAR_WORDS 3456
#define XB_SPIN_CAP (1u << 18)
DI unsigned xb_ld(unsigned* p)              { return __hip_atomic_load(p, __ATOMIC_RELAXED, __HIP_MEMORY_SCOPE_AGENT); }
DI unsigned xb_add(unsigned* p, unsigned v) { return __hip_atomic_fetch_add(p, v, __ATOMIC_RELAXED, __HIP_MEMORY_SCOPE_AGENT); }
DI unsigned xb_xcc_id() { return (unsigned)__builtin_amdgcn_s_getreg((3 << 11) | 20) & 0xFu; }
#define XB_SPIN(cond, bar) do { unsigned _sp = 0; while (cond) { __builtin_amdgcn_s_sleep(1); \
    if ((++_sp & 255u) == 0u) { if (xb_ld(&(bar)[XB_TMO])) break; if (_sp > XB_SPIN_CAP) { atomicAdd(&(bar)[XB_TMO], 1u); break; } } } } while (0)
struct XcdBarrier { unsigned* bar; unsigned x; volatile LAS unsigned* st; };
DI XcdBarrier xcd_barrier_post(unsigned* bar, volatile LAS unsigned* st) {
    XcdBarrier b; b.bar = bar; b.x = xb_xcc_id(); b.st = st;
    if (threadIdx.x == 0) (void)xb_add(&bar[XB_XCNT(b.x)], 1u);
    return b;
}
DI void xcd_barrier_complete(unsigned* bar, unsigned x, unsigned& nloc, unsigned& nx) {
    const unsigned G = gridDim.x * gridDim.y * gridDim.z;
    unsigned sum, cnt, mine, sp = 0u;
    for (;;) {
        sum = 0u; cnt = 0u; mine = 0u;
#pragma unroll
        for (unsigned j = 0; j < 16; ++j) { const unsigned c = xb_ld(&bar[XB_XCNT(j)]); sum += c; cnt += (c > 0u) ? 1u : 0u; mine = (j == x) ? c : mine; }
        if (sum == G) break;
        __builtin_amdgcn_s_sleep(1);
        if ((++sp & 255u) == 0u) { if (xb_ld(&bar[XB_TMO])) break; if (sp > XB_SPIN_CAP) { atomicAdd(&bar[XB_TMO], 1u); break; } }
    }
    nloc = mine > 0u ? mine : 1u; nx = cnt > 0u ? cnt : 1u;
}
DI void xcd_barrier(const XcdBarrier& b) {
    asm volatile("s_waitcnt vmcnt(0)" ::: "memory");
    __syncthreads();
    if (threadIdx.x == 0) {
        unsigned* bar = b.bar;
        __builtin_amdgcn_s_waitcnt(0);
        unsigned nloc = b.st[0], nx = b.st[1];
        if (nloc == 0u) { xcd_barrier_complete(bar, b.x, nloc, nx); b.st[0] = nloc; b.st[1] = nx; }
        const unsigned old = xb_add(&bar[XB_XSUB(b.x)], 1u);
        const unsigned gen = old / nloc;
        if (old + 1u == (gen + 1u) * nloc) {
            __builtin_amdgcn_fence(__ATOMIC_RELEASE, "agent");
            asm volatile("s_waitcnt vmcnt(0)" ::: "memory");
            const unsigned og = xb_add(&bar[XB_TOP], 1u);
            const unsigned tg = og / nx;
            if (og + 1u == (tg + 1u) * nx) xb_add(&bar[XB_TOPGEN], 1u);
            else XB_SPIN(xb_ld(&bar[XB_TOPGEN]) == tg, bar);
            __builtin_amdgcn_fence(__ATOMIC_ACQUIRE, "agent");
            xb_add(&bar[XB_XGEN(b.x)], 1u);
            asm volatile("s_waitcnt vmcnt(0)" ::: "memory");
        } else {
            XB_SPIN(xb_ld(&bar[XB_XGEN(b.x)]) == gen, bar);
            __builtin_amdgcn_fence(__ATOMIC_ACQUIRE, "agent");
            asm volatile("s_waitcnt vmcnt(0)" ::: "memory");
        }
    }
    __syncthreads();
}
namespace pg8 {
constexpr int BM = 256, BK = 64, HALF = 128, HTB = HALF * BK * 2, STAGE_BYTES = 8 * HTB, NXCD = 8, WGM = 8;
__host__ __device__ __forceinline__ int lds_byte(int r, int c) { const int st = (r >> 4) * 2 + (c >> 5), rr = r & 15, cc = c & 31, ob = rr * 64 + cc * 2; return st * 1024 + (ob ^ (((ob >> 9) & 1) << 5)); }
__host__ __device__ __forceinline__ void stage_rc(int b, int& R, int& C) { const int st = b / 1024, sb = b % 1024, swz = sb ^ (((sb >> 9) & 1) << 5); R = (st >> 1) * 16 + swz / 64; C = (st & 1) * 32 + (swz % 64) / 2; }
__host__ __device__ __forceinline__ int perm32(int rho) { const int n = rho >> 4, i = rho & 15; return 8 * (i >> 2) + 4 * n + (i & 3); }

struct Unit { int pm, pn, brow, e; };
struct Gemm { const bf16* A; const bf16* Bt; int lda, K; };

struct StaticOrder {
    int nM, nN, nwg, G, c;
    __device__ void init(int nM_, int nN_, int G_, int c_) { nM = nM_; nN = nN_; nwg = nM * nN; G = G_; c = c_; }
    __device__ bool tile(int i, int& pm, int& pn) const {
        const long L = (long)i * G + c; if (L >= nwg) return false;
        int wgid = (int)L; { const int q = nwg / NXCD, r = nwg % NXCD, xcd = wgid % NXCD, off = wgid / NXCD; wgid = (xcd < r ? xcd * (q + 1) : r * (q + 1) + (xcd - r) * q) + off; }
        const int nig = WGM * nN, gid = wgid / nig, fm = gid * WGM, gsz = (nM - fm) < WGM ? (nM - fm) : WGM;
        pm = fm + ((wgid % nig) % gsz); pn = (wgid % nig) / gsz; return true;
    }
    __device__ bool next(int i, Unit& u) const { if (!tile(i, u.pm, u.pn)) return false; u.brow = u.pn * BM; u.e = 0; return true; }
};
struct GroupedOrder : StaticOrder {
    const LAS int* tstart; int nrow_e;
    __device__ bool next(int i, Unit& u) const {
        if (!tile(i, u.pm, u.pn)) return false;
        int e = 0;
#pragma unroll 1
        for (int j = 16; j > 0; j >>= 1) if (tstart[e + j] <= u.pm) e += j;
        u.e = e; u.brow = e * nrow_e + u.pn * BM; return true;
    }
};
DI unsigned cvt_pk_bf16(float lo, float hi) { unsigned r; asm volatile("v_cvt_pk_bf16_f32 %0, %1, %2" : "=v"(r) : "v"(lo), "v"(hi)); return r; }

template <class Epi, class Sched>
DI void gemm_phase(LAS unsigned char* lds, const int tid, const Gemm g, const Sched& S, const Epi& E) {
    const int wid = __builtin_amdgcn_readfirstlane(tid >> 6), lane = tid & 63, wr = wid >> 2, wc = wid & 3, fr = lane & 15, fq = lane >> 4;
    int K = g.K, lda = g.lda; asm volatile("" : "+s"(K), "+s"(lda));
    const int nt = K / BK;
    unsigned voffA[2], voffB[2];
#pragma unroll
    for (int i = 0; i < 2; ++i) { int R, C; stage_rc(tid * 16 + i * 8192, R, C); const int Rb = Epi::PERM ? ((R & ~31) + perm32(R & 31)) : R;
        voffA[i] = (unsigned)(R * lda + C) * 2u; voffB[i] = (unsigned)(Rb * K + C) * 2u; }
    const size_t kstep = (size_t)(BK * 2);
    const size_t hstepA = (size_t)HALF * lda * 2, hstepB = (size_t)HALF * K * 2;
    const size_t tstepA = 2 * hstepA;
    const unsigned ldsw = (unsigned)wid * 1024u;
    const int aoff = lds_byte(wr * 64 + fr, fq * 8), boff = lds_byte(wc * 32 + fr, fq * 8);
#define PG8_SA(b, h) (((b) * 2 + (h)) * HTB)
#define PG8_SB(b, h) ((4 + (b) * 2 + (h)) * HTB)
#define PG8_STAGE(bufoff, gbase, voff) do { _Pragma("unroll") for (int _i = 0; _i < 2; ++_i) \
        __builtin_amdgcn_global_load_lds((const unsigned*)((const char*)(gbase) + (voff)[_i]), (LAS unsigned*)(lds + (bufoff) + ldsw + _i * 8192), 16, 0, 0); } while (0)
#define PG8_LDA(dst, b, h) do { _Pragma("unroll") for (int m = 0; m < 4; ++m) _Pragma("unroll") for (int k = 0; k < 2; ++k) dst[m][k] = *(const LAS bf16x8*)(lds + PG8_SA(b, h) + aoff + m * 2048 + k * 1024); } while (0)
#define PG8_LDB(dst, b, h) do { _Pragma("unroll") for (int n = 0; n < 2; ++n) _Pragma("unroll") for (int k = 0; k < 2; ++k) dst[n][k] = *(const LAS bf16x8*)(lds + PG8_SB(b, h) + boff + n * 2048 + k * 1024); } while (0)
#define PG8_MMA(ai, bj, At, Bt) do { __builtin_amdgcn_s_setprio(1); _Pragma("unroll") for (int m = 0; m < 4; ++m) _Pragma("unroll") for (int n = 0; n < 2; ++n) _Pragma("unroll") for (int k = 0; k < 2; ++k) \
        acc[ai][bj][m][n] = __builtin_amdgcn_mfma_f32_16x16x32_bf16(Bt[n][k], At[m][k], acc[ai][bj][m][n], 0, 0, 0); __builtin_amdgcn_s_setprio(0); } while (0)
#define PG8_WAIT_V(n) asm volatile("s_waitcnt vmcnt(" #n ")" ::: "memory")
#define PG8_WAIT_L(n) asm volatile("s_waitcnt lgkmcnt(" #n ")" ::: "memory")
#define PG8_BAR __builtin_amdgcn_s_barrier()
#define PG8_SCHED __builtin_amdgcn_sched_barrier(0)
    Unit cur, nxt; int ui = 0;
    if (!S.next(0, cur)) return;
    f32x4 acc[2][2][4][2];
#pragma unroll
    for (int a = 0; a < 2; ++a)
#pragma unroll
        for (int b = 0; b < 2; ++b)
#pragma unroll
            for (int m = 0; m < 4; ++m)
#pragma unroll
                for (int n = 0; n < 2; ++n) acc[a][b][m][n] = (f32x4){0.f, 0.f, 0.f, 0.f};
    bf16x8 At[4][2], B0[2][2], B1[2][2];
    const char* cA = (const char*)g.A + (size_t)cur.pm * tstepA; const char* cB = (const char*)g.Bt + (size_t)cur.brow * K * 2;
    PG8_STAGE(PG8_SB(0, 0), cB, voffB); PG8_STAGE(PG8_SB(0, 1), cB + hstepB, voffB); PG8_STAGE(PG8_SA(0, 0), cA, voffA); PG8_STAGE(PG8_SA(0, 1), cA + hstepA, voffA);
    if (wr == 1) PG8_BAR;
    PG8_WAIT_V(2); PG8_BAR;
    PG8_STAGE(PG8_SB(1, 0), cB + kstep, voffB); PG8_STAGE(PG8_SA(1, 0), cA + kstep, voffA); PG8_STAGE(PG8_SB(1, 1), cB + hstepB + kstep, voffB);
    PG8_WAIT_V(6); PG8_BAR;
    for (;;) {
        const bool has_next = S.next(ui + 1, nxt);
        const char* nA = has_next ? (const char*)g.A + (size_t)nxt.pm * tstepA : cA; const char* nB = has_next ? (const char*)g.Bt + (size_t)nxt.brow * K * 2 : cB;
#pragma unroll 1
        for (int t = 0; t < nt; t += 2) {
            const bool last = (t == nt - 2);
            const char* a1 = cA + (size_t)(t + 1) * kstep;
            const char* a2 = last ? nA : cA + (size_t)(t + 2) * kstep; const char* b2 = last ? nB : cB + (size_t)(t + 2) * kstep;
            const char* a3 = a2 + kstep; const char* b3 = b2 + kstep;
            PG8_LDB(B0, 0, 0); PG8_LDB(B1, 0, 1); PG8_SCHED; PG8_LDA(At, 0, 0); PG8_STAGE(PG8_SA(1, 1), a1 + hstepA, voffA);
            PG8_WAIT_V(8); PG8_WAIT_L(0); PG8_BAR; PG8_MMA(0, 0, At, B0); PG8_MMA(0, 1, At, B1); PG8_BAR; PG8_SCHED;
            PG8_LDA(At, 0, 1); PG8_STAGE(PG8_SB(0, 0), b2, voffB); PG8_STAGE(PG8_SB(0, 1), b2 + hstepB, voffB); PG8_STAGE(PG8_SA(0, 0), a2, voffA);
            PG8_WAIT_V(8); PG8_WAIT_L(0); PG8_BAR; PG8_MMA(1, 0, At, B0); PG8_MMA(1, 1, At, B1); PG8_BAR; PG8_SCHED;
            PG8_LDB(B0, 1, 0); PG8_LDB(B1, 1, 1); PG8_SCHED; PG8_LDA(At, 1, 0); PG8_STAGE(PG8_SA(0, 1), a2 + hstepA, voffA);
            PG8_WAIT_V(8); PG8_WAIT_L(0); PG8_BAR; PG8_MMA(0, 0, At, B0); PG8_MMA(0, 1, At, B1); PG8_BAR; PG8_SCHED;
            PG8_LDA(At, 1, 1); PG8_STAGE(PG8_SB(1, 0), b3, voffB); PG8_STAGE(PG8_SB(1, 1), b3 + hstepB, voffB); PG8_STAGE(PG8_SA(1, 0), a3, voffA);
            PG8_WAIT_V(8); PG8_WAIT_L(0); PG8_BAR; PG8_MMA(1, 0, At, B0); PG8_MMA(1, 1, At, B1); PG8_BAR; PG8_SCHED;
        }
        if (wr == 0) PG8_BAR;
        { int fr2 = fr, fq2 = fq; asm volatile("" : "+v"(fr2), "+v"(fq2)); E(acc, cur, wr, wc, fr2, fq2); }
        if (!has_next) break;
#pragma unroll
        for (int a = 0; a < 2; ++a)
#pragma unroll
            for (int b = 0; b < 2; ++b)
#pragma unroll
                for (int m = 0; m < 4; ++m)
#pragma unroll
                    for (int n = 0; n < 2; ++n) acc[a][b][m][n] = (f32x4){0.f, 0.f, 0.f, 0.f};
        cur = nxt; cA = nA; cB = nB; ++ui;
        if (wr == 1) PG8_BAR;
    }
    PG8_WAIT_V(0);
    PG8_BAR;
#undef PG8_SA
#undef PG8_SB
#undef PG8_STAGE
#undef PG8_LDA
#undef PG8_LDB
#undef PG8_MMA
#undef PG8_WAIT_V
#undef PG8_WAIT_L
#undef PG8_BAR
#undef PG8_SCHED
}
}
constexpr size_t MiB = 1u << 20;
constexpr size_t WS_CTL = 0;
constexpr size_t WS_LORA = 1 * MiB;
constexpr size_t WS_WK2 = 2 * MiB;
constexpr size_t ZERO_BYTES = 3 * MiB;
constexpr size_t WS_WIN = 3 * MiB;
constexpr size_t WS_WOUT = 17 * MiB;
constexpr size_t WS_WK1 = 21 * MiB;
constexpr size_t WS_SMALL = 25 * MiB;
constexpr size_t WS_ROUTE = 27 * MiB;
constexpr size_t WS_WGU = 32 * MiB;
constexpr size_t WS_WDN = 288 * MiB;
constexpr size_t WS_H = 416 * MiB;
constexpr size_t WS_R = 480 * MiB;
constexpr size_t R_PROJ = WS_R;
constexpr size_t R_SC = R_PROJ + 208 * MiB;
constexpr size_t R_LIN = R_SC + 192 * MiB;
constexpr size_t R_G = R_LIN + 16 * MiB;
constexpr size_t R_YA = R_G + 32 * MiB;
constexpr size_t R_YCAT = R_YA + 32 * MiB;
constexpr size_t R_QC = R_YCAT + 64 * MiB;
constexpr size_t R_KC = R_QC + 16 * MiB;
constexpr size_t R_OC = R_KC + 16 * MiB;
constexpr size_t R_LSE = R_OC + 96 * MiB;
constexpr size_t R_QN = R_LSE + 2 * MiB;
constexpr size_t R_QR = R_QN + 16 * MiB;
constexpr size_t R_KCR = R_QR + 16 * MiB;
constexpr size_t R_VCR = R_KCR + 5 * MiB;
constexpr size_t R_KS = R_VCR + 5 * MiB;
constexpr size_t R_KW = R_KS + 4 * MiB;
constexpr size_t R_GATE = R_KW + 4 * MiB;
constexpr size_t R_CH1 = R_GATE + 2 * MiB;
constexpr size_t R_CMP = R_CH1 + 2 * MiB;
constexpr size_t R_OCMP = R_CMP + 1 * MiB;
constexpr size_t R_OSLC = R_OCMP + 32 * MiB;
constexpr size_t R_OSWA = R_OSLC + 32 * MiB;
constexpr size_t R_IMP = R_OSWA + 32 * MiB;
constexpr size_t R_SELM = R_IMP + 8 * MiB;
constexpr size_t R_MIX_END = R_SELM + 1 * MiB;
constexpr size_t R_XS = WS_R;
constexpr size_t R_ACT = R_XS + 272 * MiB;
constexpr size_t R_YB = R_ACT + 272 * MiB;
constexpr size_t R_MOE_END = R_YB + 272 * MiB;
constexpr size_t WS_END = (R_MIX_END > R_MOE_END ? R_MIX_END : R_MOE_END);
static_assert((size_t)NR * 1024 * 2 <= 272 * MiB, "sorted buffers");
constexpr int CW_BAR = 4096;
constexpr int CW_CNT = 16384;
constexpr int CW_CUR = 16384 + 64;

constexpr int RING_BYTES = 131072;
constexpr int MISC_OFF = RING_BYTES;
constexpr int LDS_BYTES = 147456;

struct Args { const void* in[40]; float* out; unsigned char* ws; int ph_lo, ph_hi; };

struct Ctx {
    LAS unsigned char* lds; int tid, lane, wave, G, bid;
    const float *x, *c, *w_ada, *b_ada, *norm1_g, *norm2_g, *w_in, *w_out, *mu, *w0, *w2, *a0, *a2, *g2, *kkw, *ka, *rk, *gn_w, *gn_b, *conv_w, *dil_q_g, *dil_k_g,
        *nsa_q_g, *nsa_kc_g, *nsa_ks_g, *nsa_kw_g, *pe_k, *pe_v, *wk1, *wk2, *wv1, *wv2, *onorm_g, *w_router, *b_router, *w_gu, *b_gu, *w_down, *b_down;
    const int* pos;
    float* out; unsigned char* ws;
};
#define WSP(T, off) ((T*)(C.ws + (off)))

typedef f32x4 Acc[2][2][4][2];
struct EpiProj {
    static constexpr bool PERM = true; bf16* O;
    DI void operator()(const Acc& acc, const pg8::Unit& u, int wr, int wc, int fr, int fq) const {
        const int row0 = u.pm * 256 + wr * 64 + fr, col0 = u.pn * 256 + wc * 32 + 8 * fq;
#pragma unroll
        for (int ai = 0; ai < 2; ++ai)
#pragma unroll
            for (int m = 0; m < 4; ++m) { bf16* rowp = O + (size_t)(row0 + ai * 128 + m * 16) * NPJ + col0;
#pragma unroll
                for (int bj = 0; bj < 2; ++bj) { const f32x4 v0 = acc[ai][bj][m][0], v1 = acc[ai][bj][m][1]; u32x4 w;
                    w.x = pg8::cvt_pk_bf16(v0[0], v0[1]); w.y = pg8::cvt_pk_bf16(v0[2], v0[3]); w.z = pg8::cvt_pk_bf16(v1[0], v1[1]); w.w = pg8::cvt_pk_bf16(v1[2], v1[3]);
                    *(u32x4*)(rowp + bj * 128) = w; } }
    }
};
struct EpiLora {
    static constexpr bool PERM = false; float* SC; float* Gb; const float *w0, *a0, *ka;
    DI void operator()(const Acc& acc, const pg8::Unit& u, int wr, int wc, int fr, int fq) const {
        const int row0 = u.pm * 256 + wr * 64 + fr, col0 = wc * 32 + 4 * fq;
        if (u.pn == 0) {
#pragma unroll
            for (int bj = 0; bj < 2; ++bj)
#pragma unroll
                for (int n = 0; n < 2; ++n) { const int ch = col0 + bj * 128 + n * 16; const f32x4 b = *(const f32x4*)(w0 + ch);
#pragma unroll
                    for (int ai = 0; ai < 2; ++ai)
#pragma unroll
                        for (int m = 0; m < 4; ++m) { const size_t o = (size_t)(row0 + ai * 128 + m * 16) * 256 + ch; const f32x4 v = acc[ai][bj][m][n] + b; f32x4 r;
#pragma unroll
                            for (int j = 0; j < 4; ++j) r[j] = __expf(-0.606531f * fsigmoid(v[j]));
                            *(f32x4*)(SC + o) = r; } }
        } else if (u.pn == 1) {
#pragma unroll
            for (int bj = 0; bj < 2; ++bj)
#pragma unroll
                for (int n = 0; n < 2; ++n) { const int ch = col0 + bj * 128 + n * 16; const f32x4 b = *(const f32x4*)(a0 + ch), kav = *(const f32x4*)(ka + ch);
#pragma unroll
                    for (int ai = 0; ai < 2; ++ai)
#pragma unroll
                        for (int m = 0; m < 4; ++m) { __builtin_amdgcn_sched_barrier(0); const size_t o = (size_t)(row0 + ai * 128 + m * 16) * 256 + ch; const f32x4 v = acc[ai][bj][m][n] + b;
                            float* pk = SC + (size_t)1 * NT * 256 + o; const f32x4 kr = *(const f32x4*)pk, kn = *(const f32x4*)(SC + (size_t)2 * NT * 256 + o); f32x4 k2, bb;
#pragma unroll
                            for (int j = 0; j < 4; ++j) { const float a = fsigmoid(v[j]); k2[j] = kr[j] * (1.f + (a - 1.f) * kav[j]); bb[j] = kn[j] * a; }
                            *(f32x4*)pk = k2; *(f32x4*)(SC + (size_t)3 * NT * 256 + o) = bb; } }
        } else {
#pragma unroll
            for (int bj = 0; bj < 2; ++bj)
#pragma unroll
                for (int n = 0; n < 2; ++n) { const int ch = col0 + bj * 128 + n * 16;
#pragma unroll
                    for (int ai = 0; ai < 2; ++ai)
#pragma unroll
                        for (int m = 0; m < 4; ++m) { const size_t o = (size_t)(row0 + ai * 128 + m * 16) * 256 + ch; *(f32x4*)(Gb + o) = acc[ai][bj][m][n]; } }
        }
    }
};
DI float gelu_tanh(float x) { const float t = 0.7978845608f * (x + 0.044715f * x * x * x); const float e = __expf(2.f * t); const float th = 1.f - 2.f / (e + 1.f); return 0.5f * x * (1.f + th); }
struct EpiC1 {
    static constexpr bool PERM = true; bf16* O; const float* peb;
    DI void operator()(const Acc& acc, const pg8::Unit& u, int wr, int wc, int fr, int fq) const {
        const int row0 = u.pm * 256 + wr * 64 + fr, col0 = wc * 32 + 8 * fq;
#pragma unroll
        for (int bj = 0; bj < 2; ++bj) { const f32x4 b0 = *(const f32x4*)(peb + col0 + bj * 128), b1 = *(const f32x4*)(peb + col0 + bj * 128 + 4);
#pragma unroll
            for (int ai = 0; ai < 2; ++ai)
#pragma unroll
                for (int m = 0; m < 4; ++m) { bf16* p = O + (size_t)(row0 + ai * 128 + m * 16) * 256 + col0 + bj * 128; const f32x4 v0 = acc[ai][bj][m][0] + b0, v1 = acc[ai][bj][m][1] + b1; u32x4 w;
                    w.x = pk2(gelu_tanh(v0[0]), gelu_tanh(v0[1])); w.y = pk2(gelu_tanh(v0[2]), gelu_tanh(v0[3])); w.z = pk2(gelu_tanh(v1[0]), gelu_tanh(v1[1])); w.w = pk2(gelu_tanh(v1[2]), gelu_tanh(v1[3]));
                    *(u32x4*)p = w; } }
    }
};
struct EpiC2 {
    static constexpr bool PERM = false; float* O;
    DI void operator()(const Acc& acc, const pg8::Unit& u, int wr, int wc, int fr, int fq) const {
        if (wc >= 2) return;
        const int row0 = u.pm * 256 + wr * 64 + fr, col0 = wc * 32 + 4 * fq;
#pragma unroll
        for (int ai = 0; ai < 2; ++ai)
#pragma unroll
            for (int m = 0; m < 4; ++m)
#pragma unroll
                for (int n = 0; n < 2; ++n) *(f32x4*)(O + (size_t)(row0 + ai * 128 + m * 16) * 64 + col0 + n * 16) = acc[ai][0][m][n];
    }
};
struct EpiOut {
    static constexpr bool PERM = false; float* O; const float* xin; const float* gt;
    DI void operator()(const Acc& acc, const pg8::Unit& u, int wr, int wc, int fr, int fq) const {
        const int row0 = u.pm * 256 + wr * 64 + fr, col0 = u.pn * 256 + wc * 32 + 4 * fq; const int b = (u.pm * 256) / NS;
#pragma unroll
        for (int bj = 0; bj < 2; ++bj)
#pragma unroll
            for (int n = 0; n < 2; ++n) { const int col = col0 + bj * 128 + n * 16; const f32x4 g = *(const f32x4*)(gt + (size_t)b * 6144 + col);
#pragma unroll
                for (int ai = 0; ai < 2; ++ai)
#pragma unroll
                    for (int m = 0; m < 4; ++m) { const size_t o = (size_t)(row0 + ai * 128 + m * 16) * DM + col; *(f32x4*)(O + o) = *(const f32x4*)(xin + o) + g * acc[ai][bj][m][n]; } }
    }
};
struct EpiGU {
    static constexpr bool PERM = true; bf16* O; const float* bgu;
    DI void operator()(const Acc& acc, const pg8::Unit& u, int wr, int wc, int fr, int fq) const {
        const int row0 = u.pm * 256 + wr * 64 + fr, cc = u.pn * 128 + wc * 32 + 8 * fq; const float* bp = bgu + (size_t)u.e * 2048 + cc;
        const f32x4 g0 = *(const f32x4*)bp, g1 = *(const f32x4*)(bp + 4), u0 = *(const f32x4*)(bp + 1024), u1 = *(const f32x4*)(bp + 1028);
#pragma unroll
        for (int ai = 0; ai < 2; ++ai)
#pragma unroll
            for (int m = 0; m < 4; ++m) { bf16* p = O + (size_t)(row0 + ai * 128 + m * 16) * FF + cc; float r[8];
#pragma unroll
                for (int n = 0; n < 2; ++n) { const f32x4 gv = acc[ai][0][m][n] + (n ? g1 : g0), uv = acc[ai][1][m][n] + (n ? u1 : u0);
#pragma unroll
                    for (int j = 0; j < 4; ++j) { const float ga = fminf(gv[j], 7.f), up = fminf(fmaxf(uv[j], -7.f), 7.f); r[4 * n + j] = ga * fsigmoid(1.702f * ga) * (up + 1.f); } }
                u32x4 w; w.x = pk2(r[0], r[1]); w.y = pk2(r[2], r[3]); w.z = pk2(r[4], r[5]); w.w = pk2(r[6], r[7]); *(u32x4*)p = w; }
    }
};
struct EpiDN {
    static constexpr bool PERM = true; bf16* O; const float* bd;
    DI void operator()(const Acc& acc, const pg8::Unit& u, int wr, int wc, int fr, int fq) const {
        const int row0 = u.pm * 256 + wr * 64 + fr, col0 = u.pn * 256 + wc * 32 + 8 * fq; const float* bp = bd + (size_t)u.e * 1024 + col0;
#pragma unroll
        for (int bj = 0; bj < 2; ++bj) { const f32x4 b0 = *(const f32x4*)(bp + bj * 128), b1 = *(const f32x4*)(bp + bj * 128 + 4);
#pragma unroll
            for (int ai = 0; ai < 2; ++ai)
#pragma unroll
                for (int m = 0; m < 4; ++m) { bf16* p = O + (size_t)(row0 + ai * 128 + m * 16) * DM + col0 + bj * 128; const f32x4 v0 = acc[ai][bj][m][0] + b0, v1 = acc[ai][bj][m][1] + b1; u32x4 w;
                    w.x = pk2(v0[0], v0[1]); w.y = pk2(v0[2], v0[3]); w.z = pk2(v1[0], v1[1]); w.w = pk2(v1[2], v1[3]); *(u32x4*)p = w; } }
    }
};
DI void tr_item(const float* src, int ld_src, int scol0, int nvalid, int k0, bf16* dst, int ld_dst, int drow0, int dk0, LAS float* scr, int lane) {
#pragma unroll 8
    for (int i = 0; i < 32; ++i) { const int kk = 2 * i + (lane >> 5), j = lane & 31; scr[kk * 33 + j] = (j < nvalid) ? src[(size_t)(k0 + kk) * ld_src + scol0 + j] : 0.f; }
    asm volatile("s_waitcnt lgkmcnt(0)" ::: "memory");
    const int c = lane & 7;
#pragma unroll
    for (int jq = 0; jq < 4; ++jq) { const int n = (lane >> 3) + 8 * jq; const LAS float* s = scr + (8 * c) * 33 + n;
        u32x4 o; o.x = pk2(s[0 * 33], s[1 * 33]); o.y = pk2(s[2 * 33], s[3 * 33]); o.z = pk2(s[4 * 33], s[5 * 33]); o.w = pk2(s[6 * 33], s[7 * 33]);
        *(u32x4*)(dst + (size_t)(drow0 + n) * ld_dst + dk0 + k0 + 8 * c) = o; }
    asm volatile("s_waitcnt lgkmcnt(0)" ::: "memory");
}
DI void p0_prologue(const Ctx& C) {
    LAS float* scr = (LAS float*)(C.lds + C.wave * 16384);
    const int gw = C.bid * NWAVE + C.wave, NGW = C.G * NWAVE;
    constexpr int I_IN = 16 * 104, I_OUT = 16 * 32, I_GU = 32 * 16 * 64, I_DN = 32 * 16 * 32, I_LW = 8, I_LA = 8, I_LG = 16, I_K1 = 256, I_K2 = 8;
    constexpr int I_LAYER = I_IN + I_OUT + I_GU + I_DN + I_LW + I_LA + I_LG + 2 * I_K1 + 2 * I_K2;
    for (int it = gw; it < NLAYER * I_LAYER; it += NGW) {
        const int l = it / I_LAYER; int r = it % I_LAYER;
        if (r < I_GU) { const int e = r / 1024, r2 = r % 1024, kb = r2 / 64, nb = r2 % 64, n0 = 32 * nb, j = n0 / 256, i = n0 % 256;
            const int scol0 = (i < 128) ? 128 * j + i : 1024 + 128 * j + (i - 128);
            tr_item(C.w_gu + (size_t)(l * 32 + e) * 1024 * 2048, 2048, scol0, 32, 64 * kb, WSP(bf16, WS_WGU) + (size_t)(l * 32 + e) * 2048 * 1024, 1024, n0, 0, scr, C.lane); continue; } r -= I_GU;
        if (r < I_DN) { const int e = r / 512, r2 = r % 512, kb = r2 / 32, nb = r2 % 32;
            tr_item(C.w_down + (size_t)(l * 32 + e) * 1024 * 1024, 1024, 32 * nb, 32, 64 * kb, WSP(bf16, WS_WDN) + (size_t)(l * 32 + e) * 1024 * 1024, 1024, 32 * nb, 0, scr, C.lane); continue; } r -= I_DN;
        if (r < I_IN) { const int kb = r / 104, nb = r % 104, n0 = 32 * nb; int nv = 3212 - n0; nv = nv < 0 ? 0 : (nv > 32 ? 32 : nv);
            tr_item(C.w_in + (size_t)l * 1024 * 3212, 3212, n0, nv, 64 * kb, WSP(bf16, WS_WIN) + (size_t)l * NPJ * 1024, 1024, n0, 0, scr, C.lane); continue; } r -= I_IN;
        if (r < I_OUT) { const int kb = r / 32, nb = r % 32;
            tr_item(C.w_out + (size_t)l * 1024 * 1024, 1024, 32 * nb, 32, 64 * kb, WSP(bf16, WS_WOUT) + (size_t)l * 1024 * 1024, 1024, 32 * nb, 0, scr, C.lane); continue; } r -= I_OUT;
        bf16* lora = WSP(bf16, WS_LORA) + (size_t)l * 768 * 256;
        if (r < I_LW) { tr_item(C.w2 + (size_t)l * 64 * 256, 256, 32 * r, 32, 0, lora, 256, 32 * r, 0, scr, C.lane); continue; } r -= I_LW;
        if (r < I_LA) { tr_item(C.a2 + (size_t)l * 64 * 256, 256, 32 * r, 32, 0, lora, 256, 256 + 32 * r, 64, scr, C.lane); continue; } r -= I_LA;
        if (r < I_LG) { const int kb = r / 8, nb = r % 8; tr_item(C.g2 + (size_t)l * 128 * 256, 256, 32 * nb, 32, 64 * kb, lora, 256, 512 + 32 * nb, 128, scr, C.lane); continue; } r -= I_LG;
        if (r < 2 * I_K1) { const int kv = r / I_K1, r2 = r % I_K1, kb = r2 / 8, nb = r2 % 8;
            tr_item((kv ? C.wv1 : C.wk1) + (size_t)l * 2048 * 256, 256, 32 * nb, 32, 64 * kb, WSP(bf16, WS_WK1) + (size_t)(l * 2 + kv) * 256 * 2048, 2048, 32 * nb, 0, scr, C.lane); continue; } r -= 2 * I_K1;
        { const int kv = r / I_K2, r2 = r % I_K2, kb = r2 / 2, nb = r2 % 2;
            tr_item((kv ? C.wv2 : C.wk2) + (size_t)l * 256 * 64, 64, 32 * nb, 32, 64 * kb, WSP(bf16, WS_WK2) + (size_t)(l * 2 + kv) * 256 * 256, 256, 32 * nb, 0, scr, C.lane); }
    }
    __syncthreads();
    float* MOD = WSP(float, WS_SMALL); float* PEB = MOD + NLAYER * 8 * 6144;
    LAS float* sc = (LAS float*)C.lds;
    LAS float* red = sc + 8192;
    for (int it = C.bid; it < 192 + 4; it += C.G) {
        if (it < 192) {
            const int l = it / 96, n0 = (it % 96) * 64;
            for (int i = C.tid; i < 8192; i += NTHR) { const float v = C.c[i]; sc[i] = v / (1.f + __expf(-v)); }
            __syncthreads();
            const int kq = C.tid >> 6, col = C.tid & 63; float a[8];
#pragma unroll
            for (int b = 0; b < 8; ++b) a[b] = 0.f;
            const float* wp = C.w_ada + (size_t)l * 1024 * 6144 + n0 + col;
#pragma unroll 8
            for (int k = kq * 128; k < kq * 128 + 128; ++k) { const float w = wp[(size_t)k * 6144];
#pragma unroll
                for (int b = 0; b < 8; ++b) a[b] += sc[b * 1024 + k] * w; }
#pragma unroll
            for (int b = 0; b < 8; ++b) red[(kq * 8 + b) * 64 + col] = a[b];
            __syncthreads();
            { const int b = C.tid >> 6; float s = C.b_ada[(size_t)l * 6144 + n0 + col];
#pragma unroll
              for (int q = 0; q < 8; ++q) s += red[(q * 8 + b) * 64 + col];
              MOD[((size_t)l * 8 + b) * 6144 + n0 + col] = s; }
            __syncthreads();
        } else {
            const int l = (it - 192) / 2, kv = (it - 192) % 2; const float* pe = (kv ? C.pe_v : C.pe_k) + (size_t)l * 2048; const float* w1 = (kv ? C.wv1 : C.wk1) + (size_t)l * 2048 * 256;
            const int kq = C.tid >> 8, col = C.tid & 255; float a = 0.f;
#pragma unroll 8
            for (int k = kq * 1024; k < kq * 1024 + 1024; ++k) a += pe[k] * w1[(size_t)k * 256 + col];
            red[kq * 256 + col] = a; __syncthreads();
            if (C.tid < 256) PEB[(l * 2 + kv) * 256 + col] = red[col] + red[256 + col];
            __syncthreads();
        }
    }
}

DI void norm_row(const Ctx& C, const float* xrow, const float* g, const float* sh, const float* sc, bf16* orow) {
    f32x4 v[4]; float s = 0.f;
#pragma unroll
    for (int j = 0; j < 4; ++j) { v[j] = *(const f32x4*)(xrow + 4 * C.lane + 256 * j); s += (v[j][0] * v[j][0] + v[j][1] * v[j][1]) + (v[j][2] * v[j][2] + v[j][3] * v[j][3]); }
    s = group_sum<64>(s); const float rstd = rsqrtf(s * (1.f / DM) + 1e-6f);
#pragma unroll
    for (int j = 0; j < 4; ++j) { const int k = 4 * C.lane + 256 * j; const f32x4 gg = *(const f32x4*)(g + k), a = *(const f32x4*)(sc + k), b = *(const f32x4*)(sh + k); f32x4 h;
#pragma unroll
        for (int i = 0; i < 4; ++i) h[i] = v[j][i] * rstd * gg[i] * (1.f + a[i]) + b[i];
        u32x2 o; o.x = pk2(h[0], h[1]); o.y = pk2(h[2], h[3]); *(u32x2*)(orow + k) = o; }
}
DI void norm1_phase(const Ctx& C, int l, const float* xin) {
    const float* MOD = WSP(float, WS_SMALL) + (size_t)l * 8 * 6144; bf16* H = WSP(bf16, WS_H);
    const int gw = C.bid * NWAVE + C.wave, NGW = C.G * NWAVE;
    for (int m = gw; m < NT; m += NGW) { const int b = m / NS; norm_row(C, xin + (size_t)m * DM, C.norm1_g + l * DM, MOD + b * 6144, MOD + b * 6144 + 1024, H + (size_t)m * DM); }
}

constexpr float QSCALE = 0.125f * 1.44269504089f;
DI void prep_phase(const Ctx& C, int l) {
    const bf16* PROJ = WSP(bf16, R_PROJ); float* SC = WSP(float, R_SC); bf16* LIN = WSP(bf16, R_LIN); bf16* YCAT = WSP(bf16, R_YCAT);
    bf16 *QC = WSP(bf16, R_QC), *KC = WSP(bf16, R_KC), *QN = WSP(bf16, R_QN), *QR = WSP(bf16, R_QR), *KCR = WSP(bf16, R_KCR), *VCR = WSP(bf16, R_VCR), *KS = WSP(bf16, R_KS), *KW = WSP(bf16, R_KW);
    float* GATE = WSP(float, R_GATE);
    const int lane = C.lane, gw = C.bid * NWAVE + C.wave, NGW = C.G * NWAVE;
    const int hh = lane >> 4, jj = lane & 15;
    const float inv0 = exp2f(-(float)(2 * jj) * (13.287712379549449f / 32.f)), inv1 = exp2f(-(float)(2 * jj + 1) * (13.287712379549449f / 32.f));
    for (int row = gw; row < NT; row += NGW) {
        const int s = row % NS; const bf16* pr = PROJ + (size_t)row * NPJ;
        {
            const int c0 = 16 * lane; float z[16];
            const u32x4 c0v = *(const u32x4*)(pr + c0), c1v = *(const u32x4*)(pr + c0 + 8);
            u32x4 p0v = (u32x4){0u, 0u, 0u, 0u}, p1v = p0v;
            if (s > 0) { p0v = *(const u32x4*)(pr - NPJ + c0); p1v = *(const u32x4*)(pr - NPJ + c0 + 8); }
            const float* mup = C.mu + (size_t)l * 1024 + c0;
            const unsigned cw[8] = {c0v.x, c0v.y, c0v.z, c0v.w, c1v.x, c1v.y, c1v.z, c1v.w}, pw[8] = {p0v.x, p0v.y, p0v.z, p0v.w, p1v.x, p1v.y, p1v.z, p1v.w};
#pragma unroll
            for (int q = 0; q < 4; ++q) { const f32x4 m4 = *(const f32x4*)(mup + 4 * q);
#pragma unroll
                for (int i = 0; i < 4; ++i) { const int e = 4 * q + i; const float cu = (e & 1) ? bfhi(cw[e >> 1]) : bflo(cw[e >> 1]), pv = (e & 1) ? bfhi(pw[e >> 1]) : bflo(pw[e >> 1]); z[e] = cu + (pv - cu) * m4[i]; } }
            const int cc = (c0 - 256) & 255; float kk[16]; float ss = 0.f;
#pragma unroll
            for (int q = 0; q < 4; ++q) { const f32x4 k4 = *(const f32x4*)(C.kkw + (size_t)l * 256 + cc + 4 * q);
#pragma unroll
                for (int i = 0; i < 4; ++i) { kk[4 * q + i] = z[4 * q + i] * k4[i]; ss += kk[4 * q + i] * kk[4 * q + i]; } }
            ss = group_sum<4>(ss); const float kinv = rsqrtf(ss + 1e-12f);
            if (lane < 48) {
                const int vec = lane < 16 ? 4 : (lane < 32 ? 1 : 5); float* dst = SC + ((size_t)vec * NT + row) * 256 + (c0 & 255);
#pragma unroll
                for (int q = 0; q < 4; ++q) *(f32x4*)(dst + 4 * q) = (f32x4){z[4 * q], z[4 * q + 1], z[4 * q + 2], z[4 * q + 3]};
                if (lane >= 16 && lane < 32) { float* d2 = SC + ((size_t)2 * NT + row) * 256 + cc;
#pragma unroll
                    for (int q = 0; q < 4; ++q) *(f32x4*)(d2 + 4 * q) = (f32x4){kk[4 * q] * kinv, kk[4 * q + 1] * kinv, kk[4 * q + 2] * kinv, kk[4 * q + 3] * kinv}; }
            } else {
                float t[16];
#pragma unroll
                for (int i = 0; i < 16; ++i) t[i] = lane < 52 ? tanhf(z[i]) : (lane < 56 ? z[i] : fsigmoid(z[i]));
                bf16* dst = LIN + (size_t)row * 256 + (c0 - 768);
                u32x4 o0, o1; o0.x = pk2(t[0], t[1]); o0.y = pk2(t[2], t[3]); o0.z = pk2(t[4], t[5]); o0.w = pk2(t[6], t[7]); o1.x = pk2(t[8], t[9]); o1.y = pk2(t[10], t[11]); o1.z = pk2(t[12], t[13]); o1.w = pk2(t[14], t[15]);
                *(u32x4*)dst = o0; *(u32x4*)(dst + 8) = o1;
            }
        }
        {
            const int ch = 4 * lane; float u[3][4];
#pragma unroll
            for (int d = 0; d < 3; ++d) {
                u32x2 cg = (u32x2){0u, 0u}, xi = cg;
                if (s >= d) { cg = *(const u32x2*)(pr - (size_t)d * NPJ + PJ_B + 256 + ch); xi = *(const u32x2*)(pr - (size_t)d * NPJ + PJ_B + 512 + ch); }
                u[d][0] = bflo(cg.x) * bflo(xi.x); u[d][1] = bfhi(cg.x) * bfhi(xi.x); u[d][2] = bflo(cg.y) * bflo(xi.y); u[d][3] = bfhi(cg.y) * bfhi(xi.y);
            }
            const u32x2 bgv = *(const u32x2*)(pr + PJ_B + ch); const float bg[4] = {bflo(bgv.x), bfhi(bgv.x), bflo(bgv.y), bfhi(bgv.y)};
            const float* cw = C.conv_w + (size_t)l * 3 * 256 + ch; const f32x4 w0 = *(const f32x4*)cw, w1 = *(const f32x4*)(cw + 256), w2 = *(const f32x4*)(cw + 512);
            float y[4]; float ss = 0.f;
#pragma unroll
            for (int i = 0; i < 4; ++i) { y[i] = bg[i] * (w0[i] * u[2][i] + w1[i] * u[1][i] + w2[i] * u[0][i]); ss += y[i] * y[i]; }
            ss = group_sum<16>(ss); const float rstd = rsqrtf(ss * (1.f / 64.f) + 1e-6f); const f32x4 og = *(const f32x4*)(C.onorm_g + (size_t)l * 768 + ch);
            u32x2 o; o.x = pk2(y[0] * rstd * og[0], y[1] * rstd * og[1]); o.y = pk2(y[2] * rstd * og[2], y[3] * rstd * og[3]);
            *(u32x2*)(YCAT + (size_t)row * DM + 256 + ch) = o;
        }
        const float posf = (float)C.pos[row]; float sn0, cs0, sn1, cs1; sincosf(posf * inv0, &sn0, &cs0); sincosf(posf * inv1, &sn1, &cs1);
#pragma unroll
        for (int qk = 0; qk < 2; ++qk) {
            const bf16* p = pr + PJ_C + qk * 256 + hh * 64 + 2 * jj; const unsigned a = *(const unsigned*)p, b = *(const unsigned*)(p + 32);
            float x1a = bflo(a), x1b = bfhi(a), x2a = bflo(b), x2b = bfhi(b);
            float ss = group_sum<16>(x1a * x1a + x1b * x1b + x2a * x2a + x2b * x2b); const float rstd = rsqrtf(ss * (1.f / 64.f) + 1e-6f);
            const float* g = (qk ? C.dil_k_g : C.dil_q_g) + (size_t)l * 64; const float sc = qk ? 1.f : QSCALE;
            x1a *= rstd * g[2 * jj] * sc; x1b *= rstd * g[2 * jj + 1] * sc; x2a *= rstd * g[32 + 2 * jj] * sc; x2b *= rstd * g[33 + 2 * jj] * sc;
            bf16* o = (qk ? KC : QC) + (size_t)row * 256 + hh * 64 + 2 * jj;
            *(unsigned*)o = pk2(x1a * cs0 - x2a * sn0, x1b * cs1 - x2b * sn1); *(unsigned*)(o + 32) = pk2(x2a * cs0 + x1a * sn0, x2b * cs1 + x1b * sn1);
        }
        {
            const bf16* p = pr + PJ_D + hh * 64 + 2 * jj; const unsigned a = *(const unsigned*)p, b = *(const unsigned*)(p + 32);
            float x1a = bflo(a), x1b = bfhi(a), x2a = bflo(b), x2b = bfhi(b);
            float ss = group_sum<16>(x1a * x1a + x1b * x1b + x2a * x2a + x2b * x2b); const float rstd = rsqrtf(ss * (1.f / 64.f) + 1e-6f) * QSCALE;
            const float* g = C.nsa_q_g + (size_t)l * 64;
            x1a *= rstd * g[2 * jj]; x1b *= rstd * g[2 * jj + 1]; x2a *= rstd * g[32 + 2 * jj]; x2b *= rstd * g[33 + 2 * jj];
            bf16* on = QN + (size_t)row * 256 + hh * 64 + 2 * jj; *(unsigned*)on = pk2(x1a, x1b); *(unsigned*)(on + 32) = pk2(x2a, x2b);
            bf16* o = QR + (size_t)row * 256 + hh * 64 + 2 * jj;
            *(unsigned*)o = pk2(x1a * cs0 - x2a * sn0, x1b * cs1 - x2b * sn1); *(unsigned*)(o + 32) = pk2(x2a * cs0 + x1a * sn0, x2b * cs1 + x1b * sn1);
        }
        {
            const int col = hh == 0 ? 2944 : (hh == 1 ? 3072 : (hh == 2 ? 2816 : 2880));
            const bf16* p = pr + col + 2 * jj; const unsigned a = *(const unsigned*)p, b = *(const unsigned*)(p + 32);
            float x1a = bflo(a), x1b = bfhi(a), x2a = bflo(b), x2b = bfhi(b);
            float ss = group_sum<16>(x1a * x1a + x1b * x1b + x2a * x2a + x2b * x2b); const float rstd = rsqrtf(ss * (1.f / 64.f) + 1e-6f);
            const float* g = (hh == 0 ? C.nsa_ks_g : C.nsa_kw_g) + (size_t)l * 64;
            const float n1a = x1a * rstd * g[2 * jj], n1b = x1b * rstd * g[2 * jj + 1], n2a = x2a * rstd * g[32 + 2 * jj], n2b = x2b * rstd * g[33 + 2 * jj];
            unsigned o1 = pk2(n1a * cs0 - n2a * sn0, n1b * cs1 - n2b * sn1), o2 = pk2(n2a * cs0 + n1a * sn0, n2b * cs1 + n1b * sn1);
            if (hh >= 2) { o1 = a; o2 = b; }
            bf16* o = (hh == 0 ? KS : (hh == 1 ? KW : (hh == 2 ? KCR : VCR))) + (size_t)row * 64 + 2 * jj;
            *(unsigned*)o = o1; *(unsigned*)(o + 32) = o2;
        }
        if (lane < 12) GATE[(size_t)row * 12 + lane] = fsigmoid(bf2f(pr[3200 + lane]));
    }
}
DI void scan_phase(const Ctx& C) {
    if (C.bid >= 64) return;
    const float* SC = WSP(float, R_SC); float* YA = WSP(float, R_YA);
    const int u = C.bid, b = u >> 3, h = (u >> 1) & 3, half = u & 1, tid = C.tid;
    LAS float* buf = (LAS float*)C.lds;
    LAS float* ybuf = buf + 2 * 12288;
    const int rl = (tid >> 3) & 31, cg = tid & 7, row = 32 * half + rl;
    f32x4 ld[6];
#define SCAN_LOAD(chunk) do { _Pragma("unroll") for (int i = 0; i < 6; ++i) { const int idx = tid + 512 * i, step = idx / 96, rem = idx % 96, vec = rem >> 4, f4 = rem & 15; \
        ld[i] = *(const f32x4*)(SC + ((size_t)vec * NT + (size_t)b * NS + (chunk) * 32 + step) * 256 + h * 64 + f4 * 4); } } while (0)
#define SCAN_STORE(slot) do { _Pragma("unroll") for (int i = 0; i < 6; ++i) *(LAS f32x4*)(buf + (slot) * 12288 + (tid + 512 * i) * 4) = ld[i]; } while (0)
    SCAN_LOAD(0); SCAN_STORE(0);
    float S[8];
#pragma unroll
    for (int c = 0; c < 8; ++c) S[c] = 0.f;
    for (int ck = 0; ck < 128; ++ck) {
        __syncthreads();
        if (ck + 1 < 128) SCAN_LOAD(ck + 1);
        if (tid >= 256) {
            if (ck > 0) {
#pragma unroll
                for (int i = 0; i < 4; ++i) { const int i2 = (tid - 256) + 256 * i, step = i2 >> 5, rr = i2 & 31;
                    YA[((size_t)b * NS + (ck - 1) * 32 + step) * 256 + h * 64 + 32 * half + rr] = ybuf[((ck - 1) & 1) * 1024 + i2]; }
            }
        } else {
            const LAS float* bp = buf + (ck & 1) * 12288; LAS float* yb = ybuf + (ck & 1) * 1024;
#pragma unroll 2
            for (int step = 0; step < 32; ++step) {
                const LAS float* sp = bp + step * 384 + 8 * cg;
                const f32x4 w0 = *(const LAS f32x4*)(sp), w1 = *(const LAS f32x4*)(sp + 4), k0 = *(const LAS f32x4*)(sp + 64), k1 = *(const LAS f32x4*)(sp + 68);
                const f32x4 q0 = *(const LAS f32x4*)(sp + 128), q1 = *(const LAS f32x4*)(sp + 132), b0 = *(const LAS f32x4*)(sp + 192), b1 = *(const LAS f32x4*)(sp + 196);
                const f32x4 r0 = *(const LAS f32x4*)(sp + 256), r1 = *(const LAS f32x4*)(sp + 260); const float v = bp[step * 384 + 320 + row];
                float d = (S[0] * q0[0] + S[1] * q0[1]) + (S[2] * q0[2] + S[3] * q0[3]) + (S[4] * q1[0] + S[5] * q1[1]) + (S[6] * q1[2] + S[7] * q1[3]);
                const float sa = -sum8(d);
#pragma unroll
                for (int c = 0; c < 4; ++c) { S[c] = S[c] * w0[c] + (sa * b0[c] + v * k0[c]); S[4 + c] = S[4 + c] * w1[c] + (sa * b1[c] + v * k1[c]); }
                float y = (S[0] * r0[0] + S[1] * r0[1]) + (S[2] * r0[2] + S[3] * r0[3]) + (S[4] * r1[0] + S[5] * r1[1]) + (S[6] * r1[2] + S[7] * r1[3]);
                y = sum8(y);
                if (cg == 0) yb[step * 32 + rl] = y;
            }
        }
        if (ck + 1 < 128) SCAN_STORE((ck + 1) & 1);
    }
    __syncthreads();
    if (tid >= 256) {
#pragma unroll
        for (int i = 0; i < 4; ++i) { const int i2 = (tid - 256) + 256 * i, step = i2 >> 5, rr = i2 & 31;
            YA[((size_t)b * NS + 127 * 32 + step) * 256 + h * 64 + 32 * half + rr] = ybuf[1024 + i2]; }
    }
#undef SCAN_LOAD
#undef SCAN_STORE
    __syncthreads();
}

constexpr int KROW = 144, VROW = 144, KT_BYTES = 64 * KROW, VT_BYTES = 64 * VROW;
#define MFMA16(a, b, c) __builtin_amdgcn_mfma_f32_16x16x32_bf16((a), (b), (c), 0, 0, 0)
template <int NQT> struct FA { f32x4 O[NQT][4]; float m[NQT], l[NQT]; };
template <int NQT> DI void fa_init(FA<NQT>& st) {
#pragma unroll
    for (int q = 0; q < NQT; ++q) { st.m[q] = -1e30f; st.l[q] = 0.f;
#pragma unroll
        for (int d = 0; d < 4; ++d) st.O[q][d] = (f32x4){0.f, 0.f, 0.f, 0.f}; }
}
DI bf16x8 pack8(const f32x4& a, const f32x4& b) { u32x4 w; w.x = pk2(a[0], a[1]); w.y = pk2(a[2], a[3]); w.z = pk2(b[0], b[1]); w.w = pk2(b[2], b[3]); return __builtin_bit_cast(bf16x8, w); }
template <int NQT, class MaskF>
DI void fa_tile(FA<NQT>& st, const bf16x8 (&Q)[NQT][2], const LAS uchar* Ks, const LAS uchar* Vts, int lane, const MaskF& allowed) {
    const int l15 = lane & 15, quad = lane >> 4;
    f32x4 S[NQT][4];
#pragma unroll
    for (int kt = 0; kt < 4; ++kt) {
        const bf16x8 k0 = *(const LAS bf16x8*)(Ks + (16 * kt + l15) * KROW + quad * 16), k1 = *(const LAS bf16x8*)(Ks + (16 * kt + l15) * KROW + 64 + quad * 16);
#pragma unroll
        for (int q = 0; q < NQT; ++q) { S[q][kt] = MFMA16(k0, Q[q][0], ((f32x4){0.f, 0.f, 0.f, 0.f})); S[q][kt] = MFMA16(k1, Q[q][1], S[q][kt]); }
    }
#pragma unroll
    for (int q = 0; q < NQT; ++q) {
        float mx = -1e30f;
#pragma unroll
        for (int kt = 0; kt < 4; ++kt)
#pragma unroll
            for (int j = 0; j < 4; ++j) { const float s = allowed(q, 16 * kt + 4 * quad + j) ? S[q][kt][j] : -1e30f; S[q][kt][j] = s; mx = fmaxf(mx, s); }
        mx = fmaxf(mx, __shfl_xor(mx, 16)); mx = fmaxf(mx, __shfl_xor(mx, 32));
        const float mn = fmaxf(st.m[q], mx), alpha = fexp2(st.m[q] - mn); st.m[q] = mn;
        float rs = 0.f;
#pragma unroll
        for (int kt = 0; kt < 4; ++kt)
#pragma unroll
            for (int j = 0; j < 4; ++j) { const float s = S[q][kt][j]; const float p = (s > -1e29f) ? fexp2(s - mn) : 0.f; S[q][kt][j] = p; rs += p; }
        st.l[q] = st.l[q] * alpha + rs;
#pragma unroll
        for (int d = 0; d < 4; ++d) st.O[q][d] = st.O[q][d] * alpha;
    }
#pragma unroll
    for (int ks = 0; ks < 2; ++ks) {
        bf16x8 pf[NQT];
#pragma unroll
        for (int q = 0; q < NQT; ++q) pf[q] = pack8(S[q][2 * ks], S[q][2 * ks + 1]);
#pragma unroll
        for (int d = 0; d < 4; ++d) {
            const LAS uchar* vp = Vts + (16 * d + l15) * VROW + (32 * ks + 4 * quad) * 2;
            const u32x2 lo = *(const LAS u32x2*)vp, hi = *(const LAS u32x2*)(vp + 32);
            const bf16x8 vf = __builtin_bit_cast(bf16x8, ((u32x4){lo.x, lo.y, hi.x, hi.y}));
#pragma unroll
            for (int q = 0; q < NQT; ++q) st.O[q][d] = MFMA16(vf, pf[q], st.O[q][d]);
        }
    }
}
template <int NQT> DI void fa_finish(FA<NQT>& st, float (&lse2)[NQT]) {
#pragma unroll
    for (int q = 0; q < NQT; ++q) { float l = st.l[q]; l += __shfl_xor(l, 16); l += __shfl_xor(l, 32); const float inv = l > 0.f ? 1.f / l : 0.f; lse2[q] = st.m[q] + __log2f(fmaxf(l, 1e-37f));
#pragma unroll
        for (int d = 0; d < 4; ++d) st.O[q][d] = st.O[q][d] * inv; }
}
DI void kv_store(LAS uchar* Ks, LAS uchar* Vts, int tid, const u32x4& kr, const u32x4& vr) {
    const int key = tid >> 3, ch = tid & 7;
    *(LAS u32x4*)(Ks + key * KROW + ch * 16) = kr;
#pragma unroll
    for (int i = 0; i < 4; ++i) { *(LAS unsigned short*)(Vts + (ch * 8 + 2 * i) * VROW + key * 2) = (unsigned short)(vr[i] & 0xffffu); *(LAS unsigned short*)(Vts + (ch * 8 + 2 * i + 1) * VROW + key * 2) = (unsigned short)(vr[i] >> 16); }
}
DI void q_load(bf16x8 (&Q)[2], const bf16* qrow, int quad) { Q[0] = *(const bf16x8*)(qrow + 8 * quad); Q[1] = *(const bf16x8*)(qrow + 32 + 8 * quad); }

struct DilMask { int qi[2]; int k0; DI bool operator()(int q, int key) const { const int ki = k0 + key, d = qi[q] - ki; return ki >= 0 && d >= 0 && d <= 128; } };
DI void dil_phase(const Ctx& C) {
    const bf16 *QC = WSP(bf16, R_QC), *KC = WSP(bf16, R_KC), *PROJ = WSP(bf16, R_PROJ); float* OC = WSP(float, R_OC); float* LSE = WSP(float, R_LSE);
    LAS uchar* Ks = C.lds; LAS uchar* Vts = C.lds + KT_BYTES;
    const int tid = C.tid, lane = C.lane, w = C.wave, l15 = lane & 15, quad = lane >> 4;
    for (int unit = C.bid; unit < 1536; unit += C.G) {
        const int cfg = unit / 512, r = unit % 512, dsh = 2 * cfg, d = 1 << dsh;
        const int b = r >> 6, h = (r >> 4) & 3, r2 = r & 15;
        const int nblk = 16 >> dsh, res = r2 / nblk, blk = r2 % nblk, i0 = blk * 256;
        const size_t tb = (size_t)b * NS;
        bf16x8 Q[2][2]; DilMask mk; FA<2> st; fa_init(st);
#pragma unroll
        for (int q = 0; q < 2; ++q) { mk.qi[q] = i0 + 32 * w + 16 * q + l15; q_load(Q[q], QC + (tb + res + (size_t)d * mk.qi[q]) * 256 + h * 64, quad); }
        const int jlo = w >> 1, jhi = (w >> 1) + 2;
        u32x4 kr, vr;
#define DIL_LOAD(j) do { const int ki = i0 - 128 + 64 * (j) + (tid >> 3); kr = (u32x4){0u, 0u, 0u, 0u}; vr = kr; \
        if (ki >= 0) { const size_t rowk = tb + res + (size_t)d * ki; kr = *(const u32x4*)(KC + rowk * 256 + h * 64 + (tid & 7) * 8); vr = *(const u32x4*)(PROJ + rowk * NPJ + PJ_C + 512 + h * 64 + (tid & 7) * 8); } } while (0)
        DIL_LOAD(0);
        for (int j = 0; j < 6; ++j) {
            __syncthreads(); kv_store(Ks, Vts, tid, kr, vr); __syncthreads();
            if (j + 1 < 6) DIL_LOAD(j + 1);
            if (j >= jlo && j <= jhi) { mk.k0 = i0 - 128 + 64 * j; fa_tile<2>(st, Q, Ks, Vts, lane, mk); }
        }
#undef DIL_LOAD
        float lse2[2]; fa_finish<2>(st, lse2);
#pragma unroll
        for (int q = 0; q < 2; ++q) { const size_t rowq = tb + res + (size_t)d * mk.qi[q]; float* o = OC + ((size_t)cfg * NT + rowq) * 256 + h * 64 + 4 * quad;
#pragma unroll
            for (int dt = 0; dt < 4; ++dt) *(f32x4*)(o + 16 * dt) = st.O[q][dt];
            if (quad == 0) LSE[((size_t)cfg * NT + rowq) * 4 + h] = lse2[q]; }
    }
    __syncthreads();
}

struct SwaMask { int t[2]; int k0; DI bool operator()(int q, int key) const { const int d = t[q] - (k0 + key); return d >= 0 && d <= 511; } };
struct SlcMask { int t[2]; int k0; bool sel[2]; DI bool operator()(int q, int key) const { return sel[q] && (k0 + key <= t[q]); } };
DI void swa_phase(const Ctx& C) {
    const bf16 *QR = WSP(bf16, R_QR), *KW = WSP(bf16, R_KW), *PROJ = WSP(bf16, R_PROJ); float* OS = WSP(float, R_OSWA);
    LAS uchar* Ks = C.lds; LAS uchar* Vts = C.lds + KT_BYTES;
    const int tid = C.tid, lane = C.lane, w = C.wave, l15 = lane & 15, quad = lane >> 4, head = l15 & 3;
    for (int unit = C.bid; unit < 512; unit += C.G) {
        const int b = unit >> 6, tbk = unit & 63, t0 = 64 * tbk; const size_t tb = (size_t)b * NS;
        bf16x8 Q[2][2]; SwaMask mk; FA<2> st; fa_init(st);
#pragma unroll
        for (int q = 0; q < 2; ++q) { mk.t[q] = t0 + 8 * w + 4 * q + (l15 >> 2); q_load(Q[q], QR + (tb + mk.t[q]) * 256 + head * 64, quad); }
        const int j0 = tbk >= 8 ? tbk - 8 : 0;
        u32x4 kr, vr;
#define SWA_LOAD(j) do { const size_t rowk = tb + 64 * (j) + (tid >> 3); kr = *(const u32x4*)(KW + rowk * 64 + (tid & 7) * 8); vr = *(const u32x4*)(PROJ + rowk * NPJ + 3136 + (tid & 7) * 8); } while (0)
        SWA_LOAD(j0);
        for (int j = j0; j <= tbk; ++j) {
            __syncthreads(); kv_store(Ks, Vts, tid, kr, vr); __syncthreads();
            if (j + 1 <= tbk) SWA_LOAD(j + 1);
            mk.k0 = 64 * j; fa_tile<2>(st, Q, Ks, Vts, lane, mk);
        }
#undef SWA_LOAD
        float lse2[2]; fa_finish<2>(st, lse2);
#pragma unroll
        for (int q = 0; q < 2; ++q) { float* o = OS + (tb + mk.t[q]) * 256 + head * 64 + 4 * quad;
#pragma unroll
            for (int dt = 0; dt < 4; ++dt) *(f32x4*)(o + 16 * dt) = st.O[q][dt]; }
    }
    __syncthreads();
}
DI void slc_phase(const Ctx& C) {
    const bf16 *QR = WSP(bf16, R_QR), *KSb = WSP(bf16, R_KS), *PROJ = WSP(bf16, R_PROJ); float* OS = WSP(float, R_OSLC); const unsigned long long* SELM = WSP(unsigned long long, R_SELM);
    LAS uchar* Ks = C.lds; LAS uchar* Vts = C.lds + KT_BYTES; LAS unsigned* uw = (LAS unsigned*)(C.lds + KT_BYTES + VT_BYTES);
    const int tid = C.tid, lane = C.lane, w = C.wave, l15 = lane & 15, quad = lane >> 4, head = l15 & 3;
    for (int unit = C.bid; unit < 512; unit += C.G) {
        const int b = unit >> 6, tbk = unit & 63, t0 = 64 * tbk; const size_t tb = (size_t)b * NS;
        __syncthreads();
        if (tid < 64) { const unsigned long long m = SELM[tb + t0 + tid]; unsigned lo = (unsigned)m, hi = (unsigned)(m >> 32);
#pragma unroll
            for (int o = 1; o < 64; o <<= 1) { lo |= __shfl_xor(lo, o); hi |= __shfl_xor(hi, o); }
            if (tid == 0) { uw[0] = lo; uw[1] = hi; } }
        __syncthreads();
        unsigned long long U = ((unsigned long long)uw[1] << 32) | uw[0];
        U &= (tbk == 63) ? ~0ull : ((2ull << tbk) - 1ull);
        bf16x8 Q[2][2]; SlcMask mk; FA<2> st; fa_init(st); unsigned long long msk[2];
#pragma unroll
        for (int q = 0; q < 2; ++q) { mk.t[q] = t0 + 8 * w + 4 * q + (l15 >> 2); msk[q] = SELM[tb + mk.t[q]]; q_load(Q[q], QR + (tb + mk.t[q]) * 256 + head * 64, quad); }
        unsigned wlo = (unsigned)(msk[0] | msk[1]), whi = (unsigned)((msk[0] | msk[1]) >> 32);
#pragma unroll
        for (int o = 1; o < 64; o <<= 1) { wlo |= __shfl_xor(wlo, o); whi |= __shfl_xor(whi, o); }
        const unsigned long long WM = ((unsigned long long)whi << 32) | wlo;
        u32x4 kr, vr;
#define SLC_LOAD(j) do { const size_t rowk = tb + 64 * (j) + (tid >> 3); kr = *(const u32x4*)(KSb + rowk * 64 + (tid & 7) * 8); vr = *(const u32x4*)(PROJ + rowk * NPJ + 3008 + (tid & 7) * 8); } while (0)
        int j = __builtin_ctzll(U); U &= U - 1ull;
        SLC_LOAD(j);
        for (;;) {
            __syncthreads(); kv_store(Ks, Vts, tid, kr, vr); __syncthreads();
            const int jn = U ? __builtin_ctzll(U) : -1; U &= U - 1ull;
            if (jn >= 0) SLC_LOAD(jn);
            if ((WM >> j) & 1ull) { mk.k0 = 64 * j; mk.sel[0] = (msk[0] >> j) & 1ull; mk.sel[1] = (msk[1] >> j) & 1ull; fa_tile<2>(st, Q, Ks, Vts, lane, mk); }
            if (jn < 0) break; j = jn;
        }
#undef SLC_LOAD
        float lse2[2]; fa_finish<2>(st, lse2);
#pragma unroll
        for (int q = 0; q < 2; ++q) { float* o = OS + (tb + mk.t[q]) * 256 + head * 64 + 4 * quad;
#pragma unroll
            for (int dt = 0; dt < 4; ++dt) *(f32x4*)(o + 16 * dt) = st.O[q][dt]; }
    }
    __syncthreads();
}
constexpr int VCROW = 528;
DI void cmp_phase(const Ctx& C, int l) {
    const bf16* QN = WSP(bf16, R_QN); const float* CMP = WSP(float, R_CMP); float* OCm = WSP(float, R_OCMP); float* IMP = WSP(float, R_IMP);
    LAS uchar* Kc = C.lds; LAS uchar* Vtc = C.lds + 256 * KROW;
    const int tid = C.tid, lane = C.lane, w = C.wave, l15 = lane & 15, quad = lane >> 4, head = l15 & 3;
    int bl = -1;
    for (int unit = C.bid; unit < 512; unit += C.G) {
        const int b = unit >> 6, tbk = unit & 63, t0 = 64 * tbk; const size_t tb = (size_t)b * NS;
        if (b != bl) {
            __syncthreads();
            { const int key = tid >> 1, hf = tid & 1; const float* kp = CMP + ((size_t)b * 256 + key) * 64 + 32 * hf; const float* vp = CMP + ((size_t)2048 + (size_t)b * 256 + key) * 64 + 32 * hf;
              float kv[32], vv[32]; float ss = 0.f;
#pragma unroll
              for (int i = 0; i < 8; ++i) { const f32x4 a = *(const f32x4*)(kp + 4 * i), c = *(const f32x4*)(vp + 4 * i);
#pragma unroll
                  for (int j = 0; j < 4; ++j) { kv[4 * i + j] = a[j]; vv[4 * i + j] = c[j]; ss += a[j] * a[j]; } }
              ss += __shfl_xor(ss, 1); const float rstd = rsqrtf(ss * (1.f / 64.f) + 1e-6f); const float* g = C.nsa_kc_g + (size_t)l * 64 + 32 * hf; const bool dead = (key == 255);
#pragma unroll
              for (int i = 0; i < 4; ++i) { u32x4 o;
                  o.x = pk2(kv[8 * i] * rstd * g[8 * i], kv[8 * i + 1] * rstd * g[8 * i + 1]); o.y = pk2(kv[8 * i + 2] * rstd * g[8 * i + 2], kv[8 * i + 3] * rstd * g[8 * i + 3]);
                  o.z = pk2(kv[8 * i + 4] * rstd * g[8 * i + 4], kv[8 * i + 5] * rstd * g[8 * i + 5]); o.w = pk2(kv[8 * i + 6] * rstd * g[8 * i + 6], kv[8 * i + 7] * rstd * g[8 * i + 7]);
                  if (dead) o = (u32x4){0u, 0u, 0u, 0u};
                  *(LAS u32x4*)(Kc + key * KROW + hf * 64 + i * 16) = o; }
#pragma unroll
              for (int i = 0; i < 32; ++i) *(LAS unsigned short*)(Vtc + (32 * hf + i) * VCROW + key * 2) = (unsigned short)(dead ? 0u : f2bf(vv[i]));
            }
            __syncthreads(); bl = b;
        }
        const int cmaxu = (t0 + 32) >> 4;
        const int ktmax = cmaxu >> 4;
#pragma unroll 1
        for (int q = 0; q < 2; ++q) {
            const int t = t0 + 8 * w + 4 * q + (l15 >> 2);
            bf16x8 Q[2]; q_load(Q, QN + (tb + t) * 256 + head * 64, quad);
            f32x4 S[16]; float mx = -1e30f;
#pragma unroll
            for (int kt = 0; kt < 16; ++kt) {
                if (kt <= ktmax) {
                    const bf16x8 k0 = *(const LAS bf16x8*)(Kc + (16 * kt + l15) * KROW + quad * 16), k1 = *(const LAS bf16x8*)(Kc + (16 * kt + l15) * KROW + 64 + quad * 16);
                    S[kt] = MFMA16(k0, Q[0], ((f32x4){0.f, 0.f, 0.f, 0.f})); S[kt] = MFMA16(k1, Q[1], S[kt]);
#pragma unroll
                    for (int j = 0; j < 4; ++j) { const int c = 16 * kt + 4 * quad + j; const float s = (16 * c + 31 <= t) ? S[kt][j] : -1e30f; S[kt][j] = s; mx = fmaxf(mx, s); }
                } else S[kt] = (f32x4){-1e30f, -1e30f, -1e30f, -1e30f};
            }
            mx = fmaxf(mx, __shfl_xor(mx, 16)); mx = fmaxf(mx, __shfl_xor(mx, 32));
            float ls = 0.f;
#pragma unroll
            for (int kt = 0; kt < 16; ++kt)
#pragma unroll
                for (int j = 0; j < 4; ++j) { const float s = S[kt][j]; const float p = (s > -1e29f) ? fexp2(s - mx) : 0.f; S[kt][j] = p; ls += p; }
            ls += __shfl_xor(ls, 16); ls += __shfl_xor(ls, 32);
            const float inv = ls > 0.f ? 1.f / ls : 0.f;
#pragma unroll
            for (int kt = 0; kt < 16; ++kt) S[kt] = S[kt] * inv;
#pragma unroll
            for (int kt = 0; kt < 16; ++kt) {
                const float send = (quad == 3) ? (kt > 0 ? S[kt > 0 ? kt - 1 : 0][3] : 0.f) : S[kt][3];
                const float prev = __shfl(send, (lane + 48) & 63);
                float v = ((quad == 0 && kt == 0) ? 0.f : prev) + 2.f * (S[kt][0] + S[kt][1] + S[kt][2]) + S[kt][3];
                v += __shfl_xor(v, 1); v += __shfl_xor(v, 2);
                if (head == 0) IMP[(tb + t) * 64 + 4 * kt + quad] = v;
            }
            f32x4 O[4];
#pragma unroll
            for (int d = 0; d < 4; ++d) O[d] = (f32x4){0.f, 0.f, 0.f, 0.f};
#pragma unroll
            for (int ks = 0; ks < 8; ++ks) {
                if (2 * ks <= ktmax) {
                    const bf16x8 pf = pack8(S[2 * ks], S[2 * ks + 1]);
#pragma unroll
                    for (int d = 0; d < 4; ++d) { const LAS uchar* vp = Vtc + (16 * d + l15) * VCROW + (32 * ks + 4 * quad) * 2;
                        const u32x2 lo = *(const LAS u32x2*)vp, hi = *(const LAS u32x2*)(vp + 32);
                        O[d] = MFMA16(__builtin_bit_cast(bf16x8, ((u32x4){lo.x, lo.y, hi.x, hi.y})), pf, O[d]); }
                }
            }
            float* o = OCm + (tb + t) * 256 + head * 64 + 4 * quad;
#pragma unroll
            for (int d = 0; d < 4; ++d) *(f32x4*)(o + 16 * d) = O[d];
        }
    }
    __syncthreads();
}

DI void topk_phase(const Ctx& C) {
    const float* IMP = WSP(float, R_IMP); unsigned long long* SELM = WSP(unsigned long long, R_SELM);
    for (int row = C.bid * NTHR + C.tid; row < NT; row += C.G * NTHR) {
        const int s = row % NS, cur = s >> 6; unsigned long long mask;
        if (cur <= 15) mask = (2ull << cur) - 1ull;
        else {
            mask = 1ull | (1ull << cur) | (1ull << (cur - 1));
            float v[64];
#pragma unroll
            for (int i = 0; i < 16; ++i) { const f32x4 a = *(const f32x4*)(IMP + (size_t)row * 64 + 4 * i);
#pragma unroll
                for (int j = 0; j < 4; ++j) { const int jb = 4 * i + j; v[jb] = (jb >= 1 && jb <= cur - 2) ? a[j] : -1.f; } }
#pragma unroll 1
            for (int r = 0; r < 13; ++r) {
                float bv = -0.5f; int bi = 0;
#pragma unroll
                for (int jb = 0; jb < 64; ++jb) if (v[jb] > bv) { bv = v[jb]; bi = jb; }
                mask |= 1ull << bi;
#pragma unroll
                for (int jb = 0; jb < 64; ++jb) v[jb] = (jb == bi) ? -1.f : v[jb];
            }
        }
        SELM[row] = mask;
    }
}

DI void fin_phase(const Ctx& C, int l) {
    const float* SC = WSP(float, R_SC); const float* YA = WSP(float, R_YA); const float* Gb = WSP(float, R_G); const float* OC = WSP(float, R_OC); const float* LSE = WSP(float, R_LSE);
    const float *OCm = WSP(float, R_OCMP), *OSl = WSP(float, R_OSLC), *OSw = WSP(float, R_OSWA), *GATE = WSP(float, R_GATE); bf16* YCAT = WSP(bf16, R_YCAT);
    const int lane = C.lane, gw = C.bid * NWAVE + C.wave, NGW = C.G * NWAVE, ch = 4 * lane, hh = lane >> 4;
    for (int row = gw; row < NT; row += NGW) {
        const size_t o = (size_t)row * 256 + ch;
        {
            const f32x4 y = *(const f32x4*)(YA + o), r = *(const f32x4*)(SC + (size_t)4 * NT * 256 + o), k = *(const f32x4*)(SC + (size_t)1 * NT * 256 + o), v = *(const f32x4*)(SC + (size_t)5 * NT * 256 + o), g = *(const f32x4*)(Gb + o);
            const f32x4 rk = *(const f32x4*)(C.rk + (size_t)l * 256 + ch), gw4 = *(const f32x4*)(C.gn_w + (size_t)l * 256 + ch), gb4 = *(const f32x4*)(C.gn_b + (size_t)l * 256 + ch);
            const float mu = group_sum<16>((y[0] + y[1]) + (y[2] + y[3])) * (1.f / 64.f);
            const f32x4 dy = y - mu; const float var = group_sum<16>((dy[0] * dy[0] + dy[1] * dy[1]) + (dy[2] * dy[2] + dy[3] * dy[3])) * (1.f / 64.f);
            const float rstd = rsqrtf(var + 64e-5f);
            const float dot = group_sum<16>((r[0] * k[0] * rk[0] + r[1] * k[1] * rk[1]) + (r[2] * k[2] * rk[2] + r[3] * k[3] * rk[3]));
            float out[4];
#pragma unroll
            for (int i = 0; i < 4; ++i) out[i] = ((dy[i] * rstd * gw4[i] + gb4[i]) + dot * v[i]) * g[i];
            u32x2 w; w.x = pk2(out[0], out[1]); w.y = pk2(out[2], out[3]); *(u32x2*)(YCAT + (size_t)row * DM + ch) = w;
        }
        {
            const float l0 = LSE[(size_t)row * 4 + hh], l1 = LSE[((size_t)NT + row) * 4 + hh], l2 = LSE[((size_t)2 * NT + row) * 4 + hh];
            const float mx = fmaxf(l0, fmaxf(l1, l2)); float w0 = fexp2(l0 - mx), w1 = fexp2(l1 - mx), w2 = fexp2(l2 - mx); const float inv = 1.f / (w0 + w1 + w2); w0 *= inv; w1 *= inv; w2 *= inv;
            const f32x4 a = *(const f32x4*)(OC + o), b = *(const f32x4*)(OC + (size_t)NT * 256 + o), c = *(const f32x4*)(OC + (size_t)2 * NT * 256 + o);
            const f32x4 y = a * w0 + b * w1 + c * w2;
            const float ss = group_sum<16>((y[0] * y[0] + y[1] * y[1]) + (y[2] * y[2] + y[3] * y[3])); const float rstd = rsqrtf(ss * (1.f / 64.f) + 1e-6f);
            const f32x4 og = *(const f32x4*)(C.onorm_g + (size_t)l * 768 + 256 + ch);
            u32x2 w; w.x = pk2(y[0] * rstd * og[0], y[1] * rstd * og[1]); w.y = pk2(y[2] * rstd * og[2], y[3] * rstd * og[3]); *(u32x2*)(YCAT + (size_t)row * DM + 512 + ch) = w;
        }
        {
            const float g0 = GATE[(size_t)row * 12 + hh * 3], g1 = GATE[(size_t)row * 12 + hh * 3 + 1], g2 = GATE[(size_t)row * 12 + hh * 3 + 2];
            const f32x4 a = *(const f32x4*)(OCm + o), b = *(const f32x4*)(OSl + o), c = *(const f32x4*)(OSw + o);
            const f32x4 y = a * g0 + b * g1 + c * g2;
            const float ss = group_sum<16>((y[0] * y[0] + y[1] * y[1]) + (y[2] * y[2] + y[3] * y[3])); const float rstd = rsqrtf(ss * (1.f / 64.f) + 1e-6f);
            const f32x4 og = *(const f32x4*)(C.onorm_g + (size_t)l * 768 + 512 + ch);
            u32x2 w; w.x = pk2(y[0] * rstd * og[0], y[1] * rstd * og[1]); w.y = pk2(y[2] * rstd * og[2], y[3] * rstd * og[3]); *(u32x2*)(YCAT + (size_t)row * DM + 768 + ch) = w;
        }
    }
}
#define MFMA_F32(a, b, c) __builtin_amdgcn_mfma_f32_16x16x4f32((a), (b), (c), 0, 0, 0)
DI void router_phase(const Ctx& C, int l) {
    const float* X = C.out; const float* MOD = WSP(float, WS_SMALL) + (size_t)l * 8 * 6144; bf16* H = WSP(bf16, WS_H);
    int* TOPE = WSP(int, WS_ROUTE); float* TOPG = (float*)(TOPE + NT * 4); unsigned* CNTB = WSP(unsigned, WS_CTL) + CW_CNT + l * 8192;
    LAS float* lg = (LAS float*)C.lds + C.wave * 512;
    LAS unsigned* hist = (LAS unsigned*)(C.lds + 16384);
    const int lane = C.lane, l15 = lane & 15, quad = lane >> 4, gw = C.bid * NWAVE + C.wave, NGW = C.G * NWAVE;
    if (C.tid < 32) hist[C.tid] = 0u;
    __syncthreads();
    const float* wr = C.w_router + (size_t)l * 1024 * 32; const float* g2 = C.norm2_g + (size_t)l * DM;
    for (int task = gw; task < NT / 16; task += NGW) {
        const int row0 = 16 * task, b = row0 / NS; const float* xr = X + (size_t)(row0 + l15) * DM + 4 * quad;
        const float* sh = MOD + (size_t)b * 6144 + 3072 + 4 * quad; const float* sc = sh + 1024;
        float ss = 0.f;
#pragma unroll 8
        for (int i = 0; i < 64; ++i) { const f32x4 a = *(const f32x4*)(xr + 16 * i); ss += (a[0] * a[0] + a[1] * a[1]) + (a[2] * a[2] + a[3] * a[3]); }
        ss += __shfl_xor(ss, 16); ss += __shfl_xor(ss, 32);
        const float rstd = rsqrtf(ss * (1.f / DM) + 1e-6f);
        f32x4 acc0 = (f32x4){0.f, 0.f, 0.f, 0.f}, acc1 = acc0;
        bf16* hrow = H + (size_t)(row0 + l15) * DM + 4 * quad;
#pragma unroll 2
        for (int i = 0; i < 64; ++i) {
            const f32x4 a = *(const f32x4*)(xr + 16 * i), g = *(const f32x4*)(g2 + 16 * i + 4 * quad), s1 = *(const f32x4*)(sc + 16 * i), s0 = *(const f32x4*)(sh + 16 * i);
            f32x4 h;
#pragma unroll
            for (int j = 0; j < 4; ++j) h[j] = a[j] * rstd * g[j] * (1.f + s1[j]) + s0[j];
            u32x2 o; o.x = pk2(h[0], h[1]); o.y = pk2(h[2], h[3]); *(u32x2*)(hrow + 16 * i) = o;
            const float* wp = wr + (size_t)(16 * i + 4 * quad) * 32 + l15;
#pragma unroll
            for (int j = 0; j < 4; ++j) { acc0 = MFMA_F32(h[j], wp[j * 32], acc0); acc1 = MFMA_F32(h[j], wp[j * 32 + 16], acc1); }
        }
        const float b0 = C.b_router[l * 32 + l15], b1 = C.b_router[l * 32 + 16 + l15];
#pragma unroll
        for (int j = 0; j < 4; ++j) { lg[(4 * quad + j) * 32 + l15] = acc0[j] + b0; lg[(4 * quad + j) * 32 + 16 + l15] = acc1[j] + b1; }
        asm volatile("s_waitcnt lgkmcnt(0)" ::: "memory");
        if (lane < 16) {
            float v[32];
#pragma unroll
            for (int i = 0; i < 8; ++i) { const f32x4 a = *(const LAS f32x4*)(lg + lane * 32 + 4 * i); v[4 * i] = a[0]; v[4 * i + 1] = a[1]; v[4 * i + 2] = a[2]; v[4 * i + 3] = a[3]; }
            float tv[4]; int ti[4];
#pragma unroll
            for (int r = 0; r < 4; ++r) { float bv = -3.0e38f; int bi = 0;
#pragma unroll
                for (int e = 0; e < 32; ++e) if (v[e] > bv) { bv = v[e]; bi = e; }
                tv[r] = bv; ti[r] = bi;
#pragma unroll
                for (int e = 0; e < 32; ++e) v[e] = (e == bi) ? -3.0e38f : v[e]; }
            const float e1 = __expf(tv[1] - tv[0]), e2 = __expf(tv[2] - tv[0]), e3 = __expf(tv[3] - tv[0]), inv = 1.f / (1.f + e1 + e2 + e3);
            const int row = row0 + lane;
            *(int4*)(TOPE + (size_t)row * 4) = make_int4(ti[0], ti[1], ti[2], ti[3]);
            *(f32x4*)(TOPG + (size_t)row * 4) = (f32x4){inv, e1 * inv, e2 * inv, e3 * inv};
#pragma unroll
            for (int r = 0; r < 4; ++r) __hip_atomic_fetch_add(&hist[ti[r]], 1u, __ATOMIC_RELAXED, __HIP_MEMORY_SCOPE_WORKGROUP);
        }
        asm volatile("s_waitcnt lgkmcnt(0)" ::: "memory");
    }
    __syncthreads();
    if (C.tid < 32) CNTB[C.bid * 32 + C.tid] = hist[C.tid];
}

DI void moe_tables(const Ctx& C, int l, LAS int* tab) {
    const unsigned* CNTB = WSP(unsigned, WS_CTL) + CW_CNT + l * 8192;
    __syncthreads();
    if (C.tid < 32) { unsigned tot = 0u, mine = 0u;
        for (int g = 0; g < C.G; ++g) { const unsigned c = CNTB[g * 32 + C.tid]; tot += c; mine += (g < C.bid) ? c : 0u; }
        tab[128 + C.tid] = (int)((tot + 255u) >> 8); tab[64 + C.tid] = (int)mine; }
    __syncthreads();
    if (C.tid == 0) { int s = 0; for (int e = 0; e < 32; ++e) { tab[e] = s; s += tab[128 + e]; } tab[32] = s; }
    __syncthreads();
}
DI void scatter_phase(const Ctx& C, int l) {
    const bf16* H = WSP(bf16, WS_H); bf16* XS = WSP(bf16, R_XS); const int* TOPE = WSP(int, WS_ROUTE); int* POS = (int*)(TOPE + NT * 8);
    LAS int* tab = (LAS int*)(C.lds + MISC_OFF + 64); LAS unsigned* cur = (LAS unsigned*)(C.lds + 16384);
    moe_tables(C, l, tab);
    if (C.tid < 32) cur[C.tid] = (unsigned)(tab[C.tid] * 256 + tab[64 + C.tid]);
    __syncthreads();
    const int lane = C.lane, gw = C.bid * NWAVE + C.wave, NGW = C.G * NWAVE;
    for (int task = gw; task < NT / 16; task += NGW) {
        const int row0 = 16 * task, tok = row0 + (lane >> 2);
        const int e = TOPE[(size_t)tok * 4 + (lane & 3)];
        const int slot = (int)__hip_atomic_fetch_add(&cur[e], 1u, __ATOMIC_RELAXED, __HIP_MEMORY_SCOPE_WORKGROUP);
        POS[(size_t)tok * 4 + (lane & 3)] = slot;
#pragma unroll 4
        for (int p = 0; p < 64; ++p) { const int dst = __shfl(slot, p); const bf16* src = H + (size_t)(row0 + (p >> 2)) * DM + lane * 8; bf16* d = XS + (size_t)dst * DM + lane * 8;
            const u32x4 a = *(const u32x4*)src, b2 = *(const u32x4*)(src + 512); *(u32x4*)d = a; *(u32x4*)(d + 512) = b2; }
    }
}
DI void combine_phase(const Ctx& C, int l) {
    const bf16* YB = WSP(bf16, R_YB); const int* TOPE = WSP(int, WS_ROUTE); const float* TOPG = (const float*)(TOPE + NT * 4); const int* POS = (const int*)(TOPE + NT * 8);
    const float* MOD = WSP(float, WS_SMALL) + (size_t)l * 8 * 6144; bf16* H = WSP(bf16, WS_H);
    const int lane = C.lane, gw = C.bid * NWAVE + C.wave, NGW = C.G * NWAVE;
    for (int row = gw; row < NT; row += NGW) {
        const int b = row / NS; const int4 ps = *(const int4*)(POS + (size_t)row * 4); const f32x4 gk = *(const f32x4*)(TOPG + (size_t)row * 4);
        const int pp[4] = {ps.x, ps.y, ps.z, ps.w};
        float* orow = C.out + (size_t)row * DM; const float* gt = MOD + (size_t)b * 6144 + 5120;
        f32x4 v[4]; float s = 0.f;
#pragma unroll
        for (int j = 0; j < 4; ++j) { const int k = 4 * lane + 256 * j; f32x4 a = (f32x4){0.f, 0.f, 0.f, 0.f};
#pragma unroll
            for (int q = 0; q < 4; ++q) { const u32x2 y = *(const u32x2*)(YB + (size_t)pp[q] * DM + k); a += (f32x4){bflo(y.x), bfhi(y.x), bflo(y.y), bfhi(y.y)} * gk[q]; }
            v[j] = *(const f32x4*)(orow + k) + *(const f32x4*)(gt + k) * a; *(f32x4*)(orow + k) = v[j];
            s += (v[j][0] * v[j][0] + v[j][1] * v[j][1]) + (v[j][2] * v[j][2] + v[j][3] * v[j][3]); }
        if (l + 1 < NLAYER) {
            s = group_sum<64>(s); const float rstd = rsqrtf(s * (1.f / DM) + 1e-6f); const float* M2 = MOD + 8 * 6144 + (size_t)b * 6144; const float* g = C.norm1_g + (size_t)(l + 1) * DM;
#pragma unroll
            for (int j = 0; j < 4; ++j) { const int k = 4 * lane + 256 * j; const f32x4 gg = *(const f32x4*)(g + k), a = *(const f32x4*)(M2 + 1024 + k), bb = *(const f32x4*)(M2 + k); f32x4 h;
#pragma unroll
                for (int i = 0; i < 4; ++i) h[i] = v[j][i] * rstd * gg[i] * (1.f + a[i]) + bb[i];
                u32x2 o; o.x = pk2(h[0], h[1]); o.y = pk2(h[2], h[3]); *(u32x2*)(H + (size_t)row * DM + k) = o; }
        }
    }
}
constexpr int PH_PER_LAYER = 17, PH_BASE = 2, N_PHASES = PH_BASE + NLAYER * PH_PER_LAYER;
#ifndef MK_ONE_LAUNCH
#define MK_ONE_LAUNCH 1
#endif
__global__ void __launch_bounds__(NTHR, 2) mk_fwd(Args args) {
    extern __shared__ __attribute__((aligned(16))) unsigned char lds_raw[];
    Ctx C;
    C.lds = (LAS unsigned char*)lds_raw; C.tid = threadIdx.x; C.lane = C.tid & 63; C.wave = __builtin_amdgcn_readfirstlane(C.tid >> 6); C.G = gridDim.x; C.bid = blockIdx.x;
    C.x = (const float*)args.in[0]; C.c = (const float*)args.in[1]; C.pos = (const int*)args.in[2]; C.w_ada = (const float*)args.in[3]; C.b_ada = (const float*)args.in[4];
    C.norm1_g = (const float*)args.in[5]; C.norm2_g = (const float*)args.in[6]; C.w_in = (const float*)args.in[7]; C.w_out = (const float*)args.in[8]; C.mu = (const float*)args.in[9];
    C.w0 = (const float*)args.in[10]; C.w2 = (const float*)args.in[11]; C.a0 = (const float*)args.in[12]; C.a2 = (const float*)args.in[13]; C.g2 = (const float*)args.in[14];
    C.kkw = (const float*)args.in[15]; C.ka = (const float*)args.in[16]; C.rk = (const float*)args.in[17]; C.gn_w = (const float*)args.in[18]; C.gn_b = (const float*)args.in[19];
    C.conv_w = (const float*)args.in[20]; C.dil_q_g = (const float*)args.in[21]; C.dil_k_g = (const float*)args.in[22]; C.nsa_q_g = (const float*)args.in[23]; C.nsa_kc_g = (const float*)args.in[24];
    C.nsa_ks_g = (const float*)args.in[25]; C.nsa_kw_g = (const float*)args.in[26]; C.pe_k = (const float*)args.in[27]; C.pe_v = (const float*)args.in[28]; C.wk1 = (const float*)args.in[29];
    C.wk2 = (const float*)args.in[30]; C.wv1 = (const float*)args.in[31]; C.wv2 = (const float*)args.in[32]; C.onorm_g = (const float*)args.in[33]; C.w_router = (const float*)args.in[34];
    C.b_router = (const float*)args.in[35]; C.w_gu = (const float*)args.in[36]; C.b_gu = (const float*)args.in[37]; C.w_down = (const float*)args.in[38]; C.b_down = (const float*)args.in[39];
    C.out = args.out; C.ws = args.ws;
    const int lo = args.ph_lo, hi = args.ph_hi;
    for (int u = C.tid; u < (LDS_BYTES - MISC_OFF) / 4; u += NTHR) ((LAS unsigned*)(C.lds + MISC_OFF))[u] = 0u;
    __syncthreads();
    XcdBarrier bar; bar.bar = WSP(unsigned, WS_CTL) + CW_BAR; bar.x = 0; bar.st = nullptr;
    if (hi - lo > 1) bar = xcd_barrier_post(WSP(unsigned, WS_CTL) + CW_BAR, (volatile LAS unsigned*)(C.lds + MISC_OFF));
#ifndef PHMASK
#define PHMASK 0xFFFFFFFFu
#endif
#define PHON(n) (((PHMASK) >> (n)) & 1u)
#define WSPP(T, off) ((T*)(P.ws + (off)))
#define IN(k) (lo <= (k) && (k) < hi)
#define SEAM(k) do { if (IN(k) && IN((k) + 1)) xcd_barrier(bar); } while (0)
#define PCTX Ctx P = C; asm volatile("" : "+v"(P.tid), "+v"(P.lane)); asm volatile("" : "+s"(P.ws), "+s"(P.out), "+s"(P.wave), "+s"(P.bid))
    if (PHON(17) && IN(0)) { PCTX; p0_prologue(P); }
    SEAM(0);
    if (PHON(18) && IN(1)) { PCTX; norm1_phase(P, 0, P.x); }
    SEAM(1);
    for (int l = 0; l < NLAYER; ++l) {
        const int pb = PH_BASE + PH_PER_LAYER * l;
        if (PHON(0) && IN(pb + 0)) { PCTX;
            pg8::Gemm g{WSPP(bf16, WS_H), WSPP(bf16, WS_WIN) + (size_t)l * NPJ * 1024, 1024, 1024}; pg8::StaticOrder S; S.init(NT / 256, NPJ / 256, P.G, P.bid);
            EpiProj E{WSPP(bf16, R_PROJ)}; pg8::gemm_phase(P.lds, P.tid, g, S, E);
        }
        SEAM(pb + 0);
        if (PHON(1) && IN(pb + 1)) { PCTX; prep_phase(P, l); }
        SEAM(pb + 1);
        if (PHON(2) && IN(pb + 2)) { PCTX;
#ifndef NO_LORA
            { pg8::Gemm g{WSPP(bf16, R_LIN), WSPP(bf16, WS_LORA) + (size_t)l * 768 * 256, 256, 256}; pg8::StaticOrder S; S.init(NT / 256, 3, P.G, P.bid);
              EpiLora E{WSPP(float, R_SC), WSPP(float, R_G), P.w0 + l * 256, P.a0 + l * 256, P.ka + l * 256}; pg8::gemm_phase(P.lds, P.tid, g, S, E); }
#endif
#ifndef NO_C1
            { pg8::Gemm g{WSPP(bf16, R_KCR), WSPP(bf16, WS_WK1) + (size_t)(l * 2) * 256 * 2048, 1024, 2048}; pg8::StaticOrder S; S.init(8, 1, P.G, P.bid);
              EpiC1 E{WSPP(bf16, R_CH1), (WSPP(float, WS_SMALL) + NLAYER * 8 * 6144 + l * 512)}; pg8::gemm_phase(P.lds, P.tid, g, S, E); }
            { pg8::Gemm g{WSPP(bf16, R_VCR), WSPP(bf16, WS_WK1) + (size_t)(l * 2 + 1) * 256 * 2048, 1024, 2048}; pg8::StaticOrder S; S.init(8, 1, P.G, (P.bid + 128) % P.G);
              EpiC1 E{WSPP(bf16, R_CH1) + 2048 * 256, (WSPP(float, WS_SMALL) + NLAYER * 8 * 6144 + l * 512 + 256)}; pg8::gemm_phase(P.lds, P.tid, g, S, E); }
#endif
        }
        SEAM(pb + 2);
        if (PHON(3) && IN(pb + 3)) { PCTX;
            { pg8::Gemm g{WSPP(bf16, R_CH1), WSPP(bf16, WS_WK2) + (size_t)(l * 2) * 256 * 256, 256, 256}; pg8::StaticOrder S; S.init(8, 1, P.G, P.bid);
              EpiC2 E{WSPP(float, R_CMP)}; pg8::gemm_phase(P.lds, P.tid, g, S, E); }
            { pg8::Gemm g{WSPP(bf16, R_CH1) + 2048 * 256, WSPP(bf16, WS_WK2) + (size_t)(l * 2 + 1) * 256 * 256, 256, 256}; pg8::StaticOrder S; S.init(8, 1, P.G, (P.bid + 128) % P.G);
              EpiC2 E{WSPP(float, R_CMP) + 2048 * 64}; pg8::gemm_phase(P.lds, P.tid, g, S, E); }
        }
        SEAM(pb + 3);
        if (PHON(4) && IN(pb + 4)) { PCTX; scan_phase(P); }
        SEAM(pb + 4);
        if (PHON(5) && IN(pb + 5)) { PCTX; dil_phase(P); }
        SEAM(pb + 5);
        if (PHON(6) && IN(pb + 6)) { PCTX; swa_phase(P); }
        SEAM(pb + 6);
        if (PHON(7) && IN(pb + 7)) { PCTX; cmp_phase(P, l); }
        SEAM(pb + 7);
        if (PHON(8) && IN(pb + 8)) { PCTX; topk_phase(P); }
        SEAM(pb + 8);
        if (PHON(9) && IN(pb + 9)) { PCTX; slc_phase(P); }
        SEAM(pb + 9);
        if (PHON(10) && IN(pb + 10)) { PCTX; fin_phase(P, l); }
        SEAM(pb + 10);
        if (PHON(11) && IN(pb + 11)) { PCTX;
            pg8::Gemm g{WSPP(bf16, R_YCAT), WSPP(bf16, WS_WOUT) + (size_t)l * 1024 * 1024, 1024, 1024}; pg8::StaticOrder S; S.init(NT / 256, 4, P.G, P.bid);
            EpiOut E{P.out, l == 0 ? P.x : (const float*)P.out, WSPP(float, WS_SMALL) + (size_t)l * 8 * 6144 + 2048}; pg8::gemm_phase(P.lds, P.tid, g, S, E);
        }
        SEAM(pb + 11);
        if (PHON(12) && IN(pb + 12)) { PCTX; router_phase(P, l); }
        SEAM(pb + 12);
        if (PHON(13) && IN(pb + 13)) { PCTX; scatter_phase(P, l); }
        SEAM(pb + 13);
        if (PHON(14) && IN(pb + 14)) { PCTX;
            LAS int* tab = (LAS int*)(P.lds + MISC_OFF + 64); moe_tables(P, l, tab);
            pg8::Gemm g{WSPP(bf16, R_XS), WSPP(bf16, WS_WGU) + (size_t)l * 32 * 2048 * 1024, 1024, 1024}; pg8::GroupedOrder S; S.init(tab[32], 8, P.G, P.bid); S.tstart = tab; S.nrow_e = 2048;
            EpiGU E{WSPP(bf16, R_ACT), P.b_gu + (size_t)l * 32 * 2048}; pg8::gemm_phase(P.lds, P.tid, g, S, E);
        }
        SEAM(pb + 14);
        if (PHON(15) && IN(pb + 15)) { PCTX;
            LAS int* tab = (LAS int*)(P.lds + MISC_OFF + 64); moe_tables(P, l, tab);
            pg8::Gemm g{WSPP(bf16, R_ACT), WSPP(bf16, WS_WDN) + (size_t)l * 32 * 1024 * 1024, 1024, 1024}; pg8::GroupedOrder S; S.init(tab[32], 4, P.G, P.bid); S.tstart = tab; S.nrow_e = 1024;
            EpiDN E{WSPP(bf16, R_YB), P.b_down + (size_t)l * 32 * 1024}; pg8::gemm_phase(P.lds, P.tid, g, S, E);
        }
        SEAM(pb + 15);
        if (PHON(16) && IN(pb + 16)) { PCTX; combine_phase(P, l); }
        SEAM(pb + 16);
    }
#undef IN
#undef SEAM
}

extern "C" void kernel_launch(void* const* d_in, const int* in_sizes, int n_in, void* d_out, int out_size, void* d_ws, size_t ws_size, hipStream_t stream) {
    static int grid = 0;
    if (grid == 0) {
        if (n_in != 40 || out_size != NT * DM || ws_size < WS_END) { fprintf(stderr, "kernel_launch: unexpected problem (n_in %d, out %d, ws %zu < %zu)\n", n_in, out_size, ws_size, (size_t)WS_END); grid = -1; return; }
        int dev = 0, cus = 0, per_cu = 0;
        if (hipGetDevice(&dev) != hipSuccess || hipDeviceGetAttribute(&cus, hipDeviceAttributeMultiprocessorCount, dev) != hipSuccess) { grid = -1; return; }
        if (hipFuncSetAttribute((const void*)mk_fwd, hipFuncAttributeMaxDynamicSharedMemorySize, LDS_BYTES) != hipSuccess) { fprintf(stderr, "kernel_launch: hipFuncSetAttribute failed\n"); grid = -1; return; }
        if (hipOccupancyMaxActiveBlocksPerMultiprocessor(&per_cu, (const void*)mk_fwd, NTHR, LDS_BYTES) != hipSuccess || per_cu < 1) fprintf(stderr, "kernel_launch: occupancy query says %d blocks per CU\n", per_cu);
        (void)hipGetLastError();
        grid = cus > 256 ? 256 : cus;
    }
    if (grid < 0) return;
    (void)hipMemsetAsync((char*)d_ws, 0, ZERO_BYTES, stream);
    Args a{};
    for (int i = 0; i < 40; ++i) a.in[i] = d_in[i];
    a.out = (float*)d_out; a.ws = (unsigned char*)d_ws;
#if MK_ONE_LAUNCH
    a.ph_lo = 0; a.ph_hi = N_PHASES;
    hipLaunchKernelGGL(mk_fwd, dim3(grid), dim3(NTHR), LDS_BYTES, stream, a);
#else
    for (int p = 0; p < N_PHASES; ++p) { a.ph_lo = p; a.ph_hi = p + 1; hipLaunchKernelGGL(mk_fwd, dim3(grid), dim3(NTHR), LDS_BYTES, stream, a); }
#endif
    const hipError_t le = hipPeekAtLastError();
    if (le != hipSuccess) fprintf(stderr, "kernel_launch: launch failed: %s\n", hipGetErrorName(le));
}
```

```cpp
#include <hip/hip_runtime.h>
#include <cstdio>
#include <cstdint>

#define DI __device__ __forceinline__
#define LAS __attribute__((address_space(3)))
#define GAS __attribute__((address_space(1)))
typedef unsigned short bf16;
typedef short bf16x8 __attribute__((ext_vector_type(8)));
typedef float f32x4 __attribute__((ext_vector_type(4)));
typedef float f32x2 __attribute__((ext_vector_type(2)));
typedef unsigned u32x4 __attribute__((ext_vector_type(4)));
typedef unsigned u32x2 __attribute__((ext_vector_type(2)));
typedef unsigned char uchar;

constexpr int NB = 8, NS = 4096, NT = NB * NS, DM = 1024, NPJ = 3328, NE = 32, FF = 1024, NLAYER = 2;
constexpr int PJ_A = 0, PJ_B = 1024, PJ_C = 1792, PJ_D = 2560;
constexpr int NR = NT * 4 + NE * 256;
constexpr int NTHR = 512, NWAVE = 8;

DI float bf2f(unsigned v) { return __builtin_bit_cast(float, v << 16); }
DI unsigned f2bf(float f) { unsigned u = __builtin_bit_cast(unsigned, f); return (u + 0x7fffu + ((u >> 16) & 1u)) >> 16; }
DI unsigned pk2(float lo, float hi) { return f2bf(lo) | (f2bf(hi) << 16); }
DI float bflo(unsigned w) { return __builtin_bit_cast(float, w << 16); }
DI float bfhi(unsigned w) { return __builtin_bit_cast(float, w & 0xffff0000u); }
DI float fexp2(float x) { return __builtin_amdgcn_exp2f(x); }
DI float fsigmoid(float x) { return 1.f / (1.f + __expf(-x)); }
DI float wsum_xor(float v, int o) { return v + __shfl_xor(v, o); }
template <int W> DI float group_sum(float v) {
#pragma unroll
    for (int o = 1; o < W; o <<= 1) v += __shfl_xor(v, o);
    return v;
}
DI float dpp_f(float x, const int ctrl_dummy);
template <int CTRL> DI float dppmov(float x) { return __builtin_bit_cast(float, __builtin_amdgcn_update_dpp(0, __builtin_bit_cast(int, x), CTRL, 0xF, 0xF, true)); }
DI float sum8(float x) { x += dppmov<0xB1>(x); x += dppmov<0x4E>(x); x += dppmov<0x141>(x); return x; }

#define XB_TMO      128
#define XB_XCNT(j)  (256  + 64 * (j))
#define XB_XSUB(j)  (1280 + 64 * (j))
#define XB_XGEN(j)  (2304 + 64 * (j))
#define XB_TOP      3328
#define XB_TOPGEN   3392
#define XCD_BAR_WORDS 3456
#define XB_SPIN_CAP (1u << 18)
DI unsigned xb_ld(unsigned* p)              { return __hip_atomic_load(p, __ATOMIC_RELAXED, __HIP_MEMORY_SCOPE_AGENT); }
DI unsigned xb_add(unsigned* p, unsigned v) { return __hip_atomic_fetch_add(p, v, __ATOMIC_RELAXED, __HIP_MEMORY_SCOPE_AGENT); }
DI unsigned xb_xcc_id() { return (unsigned)__builtin_amdgcn_s_getreg((3 << 11) | 20) & 0xFu; }
#define XB_SPIN(cond, bar) do { unsigned _sp = 0; while (cond) { __builtin_amdgcn_s_sleep(1); \
    if ((++_sp & 255u) == 0u) { if (xb_ld(&(bar)[XB_TMO])) break; if (_sp > XB_SPIN_CAP) { atomicAdd(&(bar)[XB_TMO], 1u); break; } } } } while (0)
struct XcdBarrier { unsigned* bar; unsigned x; volatile LAS unsigned* st; };
DI XcdBarrier xcd_barrier_post(unsigned* bar, volatile LAS unsigned* st) {
    XcdBarrier b; b.bar = bar; b.x = xb_xcc_id(); b.st = st;
    if (threadIdx.x == 0) (void)xb_add(&bar[XB_XCNT(b.x)], 1u);
    return b;
}
DI void xcd_barrier_complete(unsigned* bar, unsigned x, unsigned& nloc, unsigned& nx) {
    const unsigned G = gridDim.x * gridDim.y * gridDim.z;
    unsigned sum, cnt, mine, sp = 0u;
    for (;;) {
        sum = 0u; cnt = 0u; mine = 0u;
#pragma unroll
        for (unsigned j = 0; j < 16; ++j) { const unsigned c = xb_ld(&bar[XB_XCNT(j)]); sum += c; cnt += (c > 0u) ? 1u : 0u; mine = (j == x) ? c : mine; }
        if (sum == G) break;
        __builtin_amdgcn_s_sleep(1);
        if ((++sp & 255u) == 0u) { if (xb_ld(&bar[XB_TMO])) break; if (sp > XB_SPIN_CAP) { atomicAdd(&bar[XB_TMO], 1u); break; } }
    }
    nloc = mine > 0u ? mine : 1u; nx = cnt > 0u ? cnt : 1u;
}
DI void xcd_barrier(const XcdBarrier& b) {
    asm volatile("s_waitcnt vmcnt(0)" ::: "memory");
    __syncthreads();
    if (threadIdx.x == 0) {
        unsigned* bar = b.bar;
        __builtin_amdgcn_s_waitcnt(0);
        unsigned nloc = b.st[0], nx = b.st[1];
        if (nloc == 0u) { xcd_barrier_complete(bar, b.x, nloc, nx); b.st[0] = nloc; b.st[1] = nx; }
        const unsigned old = xb_add(&bar[XB_XSUB(b.x)], 1u);
        const unsigned gen = old / nloc;
        if (old + 1u == (gen + 1u) * nloc) {
            __builtin_amdgcn_fence(__ATOMIC_RELEASE, "agent");
            asm volatile("s_waitcnt vmcnt(0)" ::: "memory");
            const unsigned og = xb_add(&bar[XB_TOP], 1u);
            const unsigned tg = og / nx;
            if (og + 1u == (tg + 1u) * nx) xb_add(&bar[XB_TOPGEN], 1u);
            else XB_SPIN(xb_ld(&bar[XB_TOPGEN]) == tg, bar);
            __builtin_amdgcn_fence(__ATOMIC_ACQUIRE, "agent");
            xb_add(&bar[XB_XGEN(b.x)], 1u);
            asm volatile("s_waitcnt vmcnt(0)" ::: "memory");
        } else {
            XB_SPIN(xb_ld(&bar[XB_XGEN(b.x)]) == gen, bar);
            __builtin_amdgcn_fence(__ATOMIC_ACQUIRE, "agent");
            asm volatile("s_waitcnt vmcnt(0)" ::: "memory");
        }
    }
    __syncthreads();
}
namespace pg8 {
constexpr int BM = 256, BK = 64, HALF = 128, HTB = HALF * BK * 2, STAGE_BYTES = 8 * HTB, NXCD = 8, WGM = 8;
__host__ __device__ __forceinline__ int lds_byte(int r, int c) { const int st = (r >> 4) * 2 + (c >> 5), rr = r & 15, cc = c & 31, ob = rr * 64 + cc * 2; return st * 1024 + (ob ^ (((ob >> 9) & 1) << 5)); }
__host__ __device__ __forceinline__ void stage_rc(int b, int& R, int& C) { const int st = b / 1024, sb = b % 1024, swz = sb ^ (((sb >> 9) & 1) << 5); R = (st >> 1) * 16 + swz / 64; C = (st & 1) * 32 + (swz % 64) / 2; }
__host__ __device__ __forceinline__ int perm32(int rho) { const int n = rho >> 4, i = rho & 15; return 8 * (i >> 2) + 4 * n + (i & 3); }

struct Unit { int pm, pn, brow, e; };
struct Gemm { const bf16* A; const bf16* Bt; int lda, K; };

struct StaticOrder {
    int nM, nN, nwg, G, c;
    __device__ void init(int nM_, int nN_, int G_, int c_) { nM = nM_; nN = nN_; nwg = nM * nN; G = G_; c = c_; }
    __device__ bool tile(int i, int& pm, int& pn) const {
        const long L = (long)i * G + c; if (L >= nwg) return false;
        int wgid = (int)L; { const int q = nwg / NXCD, r = nwg % NXCD, xcd = wgid % NXCD, off = wgid / NXCD; wgid = (xcd < r ? xcd * (q + 1) : r * (q + 1) + (xcd - r) * q) + off; }
        const int nig = WGM * nN, gid = wgid / nig, fm = gid * WGM, gsz = (nM - fm) < WGM ? (nM - fm) : WGM;
        pm = fm + ((wgid % nig) % gsz); pn = (wgid % nig) / gsz; return true;
    }
    __device__ bool next(int i, Unit& u) const { if (!tile(i, u.pm, u.pn)) return false; u.brow = u.pn * BM; u.e = 0; return true; }
};
struct GroupedOrder : StaticOrder {
    const LAS int* tstart; int nrow_e;
    __device__ bool next(int i, Unit& u) const {
        if (!tile(i, u.pm, u.pn)) return false;
        int e = 0;
#pragma unroll 1
        for (int j = 16; j > 0; j >>= 1) if (tstart[e + j] <= u.pm) e += j;
        u.e = e; u.brow = e * nrow_e + u.pn * BM; return true;
    }
};
DI unsigned cvt_pk_bf16(float lo, float hi) { unsigned r; asm volatile("v_cvt_pk_bf16_f32 %0, %1, %2" : "=v"(r) : "v"(lo), "v"(hi)); return r; }

template <class Epi, class Sched>
DI void gemm_phase(LAS unsigned char* lds, const int tid, const Gemm g, const Sched& S, const Epi& E) {
    const int wid = __builtin_amdgcn_readfirstlane(tid >> 6), lane = tid & 63, wr = wid >> 2, wc = wid & 3, fr = lane & 15, fq = lane >> 4;
    int K = g.K, lda = g.lda; asm volatile("" : "+s"(K), "+s"(lda));
    const int nt = K / BK;
    unsigned voffA[2], voffB[2];
#pragma unroll
    for (int i = 0; i < 2; ++i) { int R, C; stage_rc(tid * 16 + i * 8192, R, C); const int Rb = Epi::PERM ? ((R & ~31) + perm32(R & 31)) : R;
        voffA[i] = (unsigned)(R * lda + C) * 2u; voffB[i] = (unsigned)(Rb * K + C) * 2u; }
    const size_t kstep = (size_t)(BK * 2);
    const size_t hstepA = (size_t)HALF * lda * 2, hstepB = (size_t)HALF * K * 2;
    const size_t tstepA = 2 * hstepA;
    const unsigned ldsw = (unsigned)wid * 1024u;
    const int aoff = lds_byte(wr * 64 + fr, fq * 8), boff = lds_byte(wc * 32 + fr, fq * 8);
#define PG8_SA(b, h) (((b) * 2 + (h)) * HTB)
#define PG8_SB(b, h) ((4 + (b) * 2 + (h)) * HTB)
#define PG8_STAGE(bufoff, gbase, voff) do { _Pragma("unroll") for (int _i = 0; _i < 2; ++_i) \
        __builtin_amdgcn_global_load_lds((const unsigned*)((const char*)(gbase) + (voff)[_i]), (LAS unsigned*)(lds + (bufoff) + ldsw + _i * 8192), 16, 0, 0); } while (0)
#define PG8_LDA(dst, b, h) do { _Pragma("unroll") for (int m = 0; m < 4; ++m) _Pragma("unroll") for (int k = 0; k < 2; ++k) dst[m][k] = *(const LAS bf16x8*)(lds + PG8_SA(b, h) + aoff + m * 2048 + k * 1024); } while (0)
#define PG8_LDB(dst, b, h) do { _Pragma("unroll") for (int n = 0; n < 2; ++n) _Pragma("unroll") for (int k = 0; k < 2; ++k) dst[n][k] = *(const LAS bf16x8*)(lds + PG8_SB(b, h) + boff + n * 2048 + k * 1024); } while (0)
#define PG8_MMA(ai, bj, At, Bt) do { __builtin_amdgcn_s_setprio(1); _Pragma("unroll") for (int m = 0; m < 4; ++m) _Pragma("unroll") for (int n = 0; n < 2; ++n) _Pragma("unroll") for (int k = 0; k < 2; ++k) \
        acc[ai][bj][m][n] = __builtin_amdgcn_mfma_f32_16x16x32_bf16(Bt[n][k], At[m][k], acc[ai][bj][m][n], 0, 0, 0); __builtin_amdgcn_s_setprio(0); } while (0)
#define PG8_WAIT_V(n) asm volatile("s_waitcnt vmcnt(" #n ")" ::: "memory")
#define PG8_WAIT_L(n) asm volatile("s_waitcnt lgkmcnt(" #n ")" ::: "memory")
#define PG8_BAR __builtin_amdgcn_s_barrier()
#define PG8_SCHED __builtin_amdgcn_sched_barrier(0)
    Unit cur, nxt; int ui = 0;
    if (!S.next(0, cur)) return;
    f32x4 acc[2][2][4][2];
#pragma unroll
    for (int a = 0; a < 2; ++a)
#pragma unroll
        for (int b = 0; b < 2; ++b)
#pragma unroll
            for (int m = 0; m < 4; ++m)
#pragma unroll
                for (int n = 0; n < 2; ++n) acc[a][b][m][n] = (f32x4){0.f, 0.f, 0.f, 0.f};
    bf16x8 At[4][2], B0[2][2], B1[2][2];
    const char* cA = (const char*)g.A + (size_t)cur.pm * tstepA; const char* cB = (const char*)g.Bt + (size_t)cur.brow * K * 2;
    PG8_STAGE(PG8_SB(0, 0), cB, voffB); PG8_STAGE(PG8_SB(0, 1), cB + hstepB, voffB); PG8_STAGE(PG8_SA(0, 0), cA, voffA); PG8_STAGE(PG8_SA(0, 1), cA + hstepA, voffA);
    if (wr == 1) PG8_BAR;
    PG8_WAIT_V(2); PG8_BAR;
    PG8_STAGE(PG8_SB(1, 0), cB + kstep, voffB); PG8_STAGE(PG8_SA(1, 0), cA + kstep, voffA); PG8_STAGE(PG8_SB(1, 1), cB + hstepB + kstep, voffB);
    PG8_WAIT_V(6); PG8_BAR;
    for (;;) {
        const bool has_next = S.next(ui + 1, nxt);
        const char* nA = has_next ? (const char*)g.A + (size_t)nxt.pm * tstepA : cA; const char* nB = has_next ? (const char*)g.Bt + (size_t)nxt.brow * K * 2 : cB;
#pragma unroll 1
        for (int t = 0; t < nt; t += 2) {
            const bool last = (t == nt - 2);
            const char* a1 = cA + (size_t)(t + 1) * kstep;
            const char* a2 = last ? nA : cA + (size_t)(t + 2) * kstep; const char* b2 = last ? nB : cB + (size_t)(t + 2) * kstep;
            const char* a3 = a2 + kstep; const char* b3 = b2 + kstep;
            PG8_LDB(B0, 0, 0); PG8_LDB(B1, 0, 1); PG8_SCHED; PG8_LDA(At, 0, 0); PG8_STAGE(PG8_SA(1, 1), a1 + hstepA, voffA);
            PG8_WAIT_V(8); PG8_WAIT_L(0); PG8_BAR; PG8_MMA(0, 0, At, B0); PG8_MMA(0, 1, At, B1); PG8_BAR; PG8_SCHED;
            PG8_LDA(At, 0, 1); PG8_STAGE(PG8_SB(0, 0), b2, voffB); PG8_STAGE(PG8_SB(0, 1), b2 + hstepB, voffB); PG8_STAGE(PG8_SA(0, 0), a2, voffA);
            PG8_WAIT_V(8); PG8_WAIT_L(0); PG8_BAR; PG8_MMA(1, 0, At, B0); PG8_MMA(1, 1, At, B1); PG8_BAR; PG8_SCHED;
            PG8_LDB(B0, 1, 0); PG8_LDB(B1, 1, 1); PG8_SCHED; PG8_LDA(At, 1, 0); PG8_STAGE(PG8_SA(0, 1), a2 + hstepA, voffA);
            PG8_WAIT_V(8); PG8_WAIT_L(0); PG8_BAR; PG8_MMA(0, 0, At, B0); PG8_MMA(0, 1, At, B1); PG8_BAR; PG8_SCHED;
            PG8_LDA(At, 1, 1); PG8_STAGE(PG8_SB(1, 0), b3, voffB); PG8_STAGE(PG8_SB(1, 1), b3 + hstepB, voffB); PG8_STAGE(PG8_SA(1, 0), a3, voffA);
            PG8_WAIT_V(8); PG8_WAIT_L(0); PG8_BAR; PG8_MMA(1, 0, At, B0); PG8_MMA(1, 1, At, B1); PG8_BAR; PG8_SCHED;
        }
        if (wr == 0) PG8_BAR;
        { int fr2 = fr, fq2 = fq; asm volatile("" : "+v"(fr2), "+v"(fq2)); E(acc, cur, wr, wc, fr2, fq2); }
        if (!has_next) break;
#pragma unroll
        for (int a = 0; a < 2; ++a)
#pragma unroll
            for (int b = 0; b < 2; ++b)
#pragma unroll
                for (int m = 0; m < 4; ++m)
#pragma unroll
                    for (int n = 0; n < 2; ++n) acc[a][b][m][n] = (f32x4){0.f, 0.f, 0.f, 0.f};
        cur = nxt; cA = nA; cB = nB; ++ui;
        if (wr == 1) PG8_BAR;
    }
    PG8_WAIT_V(0);
    PG8_BAR;
#undef PG8_SA
#undef PG8_SB
#undef PG8_STAGE
#undef PG8_LDA
#undef PG8_LDB
#undef PG8_MMA
#undef PG8_WAIT_V
#undef PG8_WAIT_L
#undef PG8_BAR
#undef PG8_SCHED
}
}
constexpr size_t MiB = 1u << 20;
constexpr size_t WS_CTL = 0;
constexpr size_t WS_LORA = 1 * MiB;
constexpr size_t WS_WK2 = 2 * MiB;
constexpr size_t ZERO_BYTES = 3 * MiB;
constexpr size_t WS_WIN = 3 * MiB;
constexpr size_t WS_WOUT = 17 * MiB;
constexpr size_t WS_WK1 = 21 * MiB;
constexpr size_t WS_SMALL = 25 * MiB;
constexpr size_t WS_ROUTE = 27 * MiB;
constexpr size_t WS_WGU = 32 * MiB;
constexpr size_t WS_WDN = 288 * MiB;
constexpr size_t WS_H = 416 * MiB;
constexpr size_t WS_R = 480 * MiB;
constexpr size_t R_PROJ = WS_R;
constexpr size_t R_SC = R_PROJ + 208 * MiB;
constexpr size_t R_LIN = R_SC + 192 * MiB;
constexpr size_t R_G = R_LIN + 16 * MiB;
constexpr size_t R_YA = R_G + 32 * MiB;
constexpr size_t R_YCAT = R_YA + 32 * MiB;
constexpr size_t R_QC = R_YCAT + 64 * MiB;
constexpr size_t R_KC = R_QC + 16 * MiB;
constexpr size_t R_OC = R_KC + 16 * MiB;
constexpr size_t R_LSE = R_OC + 96 * MiB;
constexpr size_t R_QN = R_LSE + 2 * MiB;
constexpr size_t R_QR = R_QN + 16 * MiB;
constexpr size_t R_KCR = R_QR + 16 * MiB;
constexpr size_t R_VCR = R_KCR + 5 * MiB;
constexpr size_t R_KS = R_VCR + 5 * MiB;
constexpr size_t R_KW = R_KS + 4 * MiB;
constexpr size_t R_GATE = R_KW + 4 * MiB;
constexpr size_t R_CH1 = R_GATE + 2 * MiB;
constexpr size_t R_CMP = R_CH1 + 2 * MiB;
constexpr size_t R_OCMP = R_CMP + 1 * MiB;
constexpr size_t R_OSLC = R_OCMP + 32 * MiB;
constexpr size_t R_OSWA = R_OSLC + 32 * MiB;
constexpr size_t R_IMP = R_OSWA + 32 * MiB;
constexpr size_t R_SELM = R_IMP + 8 * MiB;
constexpr size_t R_MIX_END = R_SELM + 1 * MiB;
constexpr size_t R_XS = WS_R;
constexpr size_t R_ACT = R_XS + 272 * MiB;
constexpr size_t R_YB = R_ACT + 272 * MiB;
constexpr size_t R_MOE_END = R_YB + 272 * MiB;
constexpr size_t WS_END = (R_MIX_END > R_MOE_END ? R_MIX_END : R_MOE_END);
static_assert((size_t)NR * 1024 * 2 <= 272 * MiB, "sorted buffers");
constexpr int CW_BAR = 4096;
constexpr int CW_CNT = 16384;
constexpr int CW_CUR = 16384 + 64;

constexpr int RING_BYTES = 131072;
constexpr int MISC_OFF = RING_BYTES;
constexpr int LDS_BYTES = 147456;

struct Args { const void* in[40]; float* out; unsigned char* ws; int ph_lo, ph_hi; };

struct Ctx {
    LAS unsigned char* lds; int tid, lane, wave, G, bid;
    const float *x, *c, *w_ada, *b_ada, *norm1_g, *norm2_g, *w_in, *w_out, *mu, *w0, *w2, *a0, *a2, *g2, *kkw, *ka, *rk, *gn_w, *gn_b, *conv_w, *dil_q_g, *dil_k_g,
        *nsa_q_g, *nsa_kc_g, *nsa_ks_g, *nsa_kw_g, *pe_k, *pe_v, *wk1, *wk2, *wv1, *wv2, *onorm_g, *w_router, *b_router, *w_gu, *b_gu, *w_down, *b_down;
    const int* pos;
    float* out; unsigned char* ws;
};
#define WSP(T, off) ((T*)(C.ws + (off)))

typedef f32x4 Acc[2][2][4][2];
struct EpiProj {
    static constexpr bool PERM = true; bf16* O;
    DI void operator()(const Acc& acc, const pg8::Unit& u, int wr, int wc, int fr, int fq) const {
        const int row0 = u.pm * 256 + wr * 64 + fr, col0 = u.pn * 256 + wc * 32 + 8 * fq;
#pragma unroll
        for (int ai = 0; ai < 2; ++ai)
#pragma unroll
            for (int m = 0; m < 4; ++m) { bf16* rowp = O + (size_t)(row0 + ai * 128 + m * 16) * NPJ + col0;
#pragma unroll
                for (int bj = 0; bj < 2; ++bj) { const f32x4 v0 = acc[ai][bj][m][0], v1 = acc[ai][bj][m][1]; u32x4 w;
                    w.x = pg8::cvt_pk_bf16(v0[0], v0[1]); w.y = pg8::cvt_pk_bf16(v0[2], v0[3]); w.z = pg8::cvt_pk_bf16(v1[0], v1[1]); w.w = pg8::cvt_pk_bf16(v1[2], v1[3]);
                    *(u32x4*)(rowp + bj * 128) = w; } }
    }
};
struct EpiLora {
    static constexpr bool PERM = false; float* SC; float* Gb; const float *w0, *a0, *ka;
    DI void operator()(const Acc& acc, const pg8::Unit& u, int wr, int wc, int fr, int fq) const {
        const int row0 = u.pm * 256 + wr * 64 + fr, col0 = wc * 32 + 4 * fq;
        if (u.pn == 0) {
#pragma unroll
            for (int bj = 0; bj < 2; ++bj)
#pragma unroll
                for (int n = 0; n < 2; ++n) { const int ch = col0 + bj * 128 + n * 16; const f32x4 b = *(const f32x4*)(w0 + ch);
#pragma unroll
                    for (int ai = 0; ai < 2; ++ai)
#pragma unroll
                        for (int m = 0; m < 4; ++m) { const size_t o = (size_t)(row0 + ai * 128 + m * 16) * 256 + ch; const f32x4 v = acc[ai][bj][m][n] + b; f32x4 r;
#pragma unroll
                            for (int j = 0; j < 4; ++j) r[j] = __expf(-0.606531f * fsigmoid(v[j]));
                            *(f32x4*)(SC + o) = r; } }
        } else if (u.pn == 1) {
#pragma unroll
            for (int bj = 0; bj < 2; ++bj)
#pragma unroll
                for (int n = 0; n < 2; ++n) { const int ch = col0 + bj * 128 + n * 16; const f32x4 b = *(const f32x4*)(a0 + ch), kav = *(const f32x4*)(ka + ch);
#pragma unroll
                    for (int ai = 0; ai < 2; ++ai)
#pragma unroll
                        for (int m = 0; m < 4; ++m) { __builtin_amdgcn_sched_barrier(0); const size_t o = (size_t)(row0 + ai * 128 + m * 16) * 256 + ch; const f32x4 v = acc[ai][bj][m][n] + b;
                            float* pk = SC + (size_t)1 * NT * 256 + o; const f32x4 kr = *(const f32x4*)pk, kn = *(const f32x4*)(SC + (size_t)2 * NT * 256 + o); f32x4 k2, bb;
#pragma unroll
                            for (int j = 0; j < 4; ++j) { const float a = fsigmoid(v[j]); k2[j] = kr[j] * (1.f + (a - 1.f) * kav[j]); bb[j] = kn[j] * a; }
                            *(f32x4*)pk = k2; *(f32x4*)(SC + (size_t)3 * NT * 256 + o) = bb; } }
        } else {
#pragma unroll
            for (int bj = 0; bj < 2; ++bj)
#pragma unroll
                for (int n = 0; n < 2; ++n) { const int ch = col0 + bj * 128 + n * 16;
#pragma unroll
                    for (int ai = 0; ai < 2; ++ai)
#pragma unroll
                        for (int m = 0; m < 4; ++m) { const size_t o = (size_t)(row0 + ai * 128 + m * 16) * 256 + ch; *(f32x4*)(Gb + o) = acc[ai][bj][m][n]; } }
        }
    }
};
DI float gelu_tanh(float x) { const float t = 0.7978845608f * (x + 0.044715f * x * x * x); const float e = __expf(2.f * t); const float th = 1.f - 2.f / (e + 1.f); return 0.5f * x * (1.f + th); }
struct EpiC1 {
    static constexpr bool PERM = true; bf16* O; const float* peb;
    DI void operator()(const Acc& acc, const pg8::Unit& u, int wr, int wc, int fr, int fq) const {
        const int row0 = u.pm * 256 + wr * 64 + fr, col0 = wc * 32 + 8 * fq;
#pragma unroll
        for (int bj = 0; bj < 2; ++bj) { const f32x4 b0 = *(const f32x4*)(peb + col0 + bj * 128), b1 = *(const f32x4*)(peb + col0 + bj * 128 + 4);
#pragma unroll
            for (int ai = 0; ai < 2; ++ai)
#pragma unroll
                for (int m = 0; m < 4; ++m) { bf16* p = O + (size_t)(row0 + ai * 128 + m * 16) * 256 + col0 + bj * 128; const f32x4 v0 = acc[ai][bj][m][0] + b0, v1 = acc[ai][bj][m][1] + b1; u32x4 w;
                    w.x = pk2(gelu_tanh(v0[0]), gelu_tanh(v0[1])); w.y = pk2(gelu_tanh(v0[2]), gelu_tanh(v0[3])); w.z = pk2(gelu_tanh(v1[0]), gelu_tanh(v1[1])); w.w = pk2(gelu_tanh(v1[2]), gelu_tanh(v1[3]));
                    *(u32x4*)p = w; } }
    }
};
struct EpiC2 {
    static constexpr bool PERM = false; float* O;
    DI void operator()(const Acc& acc, const pg8::Unit& u, int wr, int wc, int fr, int fq) const {
        if (wc >= 2) return;
        const int row0 = u.pm * 256 + wr * 64 + fr, col0 = wc * 32 + 4 * fq;
#pragma unroll
        for (int ai = 0; ai < 2; ++ai)
#pragma unroll
            for (int m = 0; m < 4; ++m)
#pragma unroll
                for (int n = 0; n < 2; ++n) *(f32x4*)(O + (size_t)(row0 + ai * 128 + m * 16) * 64 + col0 + n * 16) = acc[ai][0][m][n];
    }
};
struct EpiOut {
    static constexpr bool PERM = false; float* O; const float* xin; const float* gt;
    DI void operator()(const Acc& acc, const pg8::Unit& u, int wr, int wc, int fr, int fq) const {
        const int row0 = u.pm * 256 + wr * 64 + fr, col0 = u.pn * 256 + wc * 32 + 4 * fq; const int b = (u.pm * 256) / NS;
#pragma unroll
        for (int bj = 0; bj < 2; ++bj)
#pragma unroll
            for (int n = 0; n < 2; ++n) { const int col = col0 + bj * 128 + n * 16; const f32x4 g = *(const f32x4*)(gt + (size_t)b * 6144 + col);
#pragma unroll
                for (int ai = 0; ai < 2; ++ai)
#pragma unroll
                    for (int m = 0; m < 4; ++m) { const size_t o = (size_t)(row0 + ai * 128 + m * 16) * DM + col; *(f32x4*)(O + o) = *(const f32x4*)(xin + o) + g * acc[ai][bj][m][n]; } }
    }
};
struct EpiGU {
    static constexpr bool PERM = true; bf16* O; const float* bgu;
    DI void operator()(const Acc& acc, const pg8::Unit& u, int wr, int wc, int fr, int fq) const {
        const int row0 = u.pm * 256 + wr * 64 + fr, cc = u.pn * 128 + wc * 32 + 8 * fq; const float* bp = bgu + (size_t)u.e * 2048 + cc;
        const f32x4 g0 = *(const f32x4*)bp, g1 = *(const f32x4*)(bp + 4), u0 = *(const f32x4*)(bp + 1024), u1 = *(const f32x4*)(bp + 1028);
#pragma unroll
        for (int ai = 0; ai < 2; ++ai)
#pragma unroll
            for (int m = 0; m < 4; ++m) { bf16* p = O + (size_t)(row0 + ai * 128 + m * 16) * FF + cc; float r[8];
#pragma unroll
                for (int n = 0; n < 2; ++n) { const f32x4 gv = acc[ai][0][m][n] + (n ? g1 : g0), uv = acc[ai][1][m][n] + (n ? u1 : u0);
#pragma unroll
                    for (int j = 0; j < 4; ++j) { const float ga = fminf(gv[j], 7.f), up = fminf(fmaxf(uv[j], -7.f), 7.f); r[4 * n + j] = ga * fsigmoid(1.702f * ga) * (up + 1.f); } }
                u32x4 w; w.x = pk2(r[0], r[1]); w.y = pk2(r[2], r[3]); w.z = pk2(r[4], r[5]); w.w = pk2(r[6], r[7]); *(u32x4*)p = w; }
    }
};
struct EpiDN {
    static constexpr bool PERM = true; bf16* O; const float* bd;
    DI void operator()(const Acc& acc, const pg8::Unit& u, int wr, int wc, int fr, int fq) const {
        const int row0 = u.pm * 256 + wr * 64 + fr, col0 = u.pn * 256 + wc * 32 + 8 * fq; const float* bp = bd + (size_t)u.e * 1024 + col0;
#pragma unroll
        for (int bj = 0; bj < 2; ++bj) { const f32x4 b0 = *(const f32x4*)(bp + bj * 128), b1 = *(const f32x4*)(bp + bj * 128 + 4);
#pragma unroll
            for (int ai = 0; ai < 2; ++ai)
#pragma unroll
                for (int m = 0; m < 4; ++m) { bf16* p = O + (size_t)(row0 + ai * 128 + m * 16) * DM + col0 + bj * 128; const f32x4 v0 = acc[ai][bj][m][0] + b0, v1 = acc[ai][bj][m][1] + b1; u32x4 w;
                    w.x = pk2(v0[0], v0[1]); w.y = pk2(v0[2], v0[3]); w.z = pk2(v1[0], v1[1]); w.w = pk2(v1[2], v1[3]); *(u32x4*)p = w; } }
    }
};
DI void tr_item(const float* src, int ld_src, int scol0, int nvalid, int k0, bf16* dst, int ld_dst, int drow0, int dk0, LAS float* scr, int lane) {
    const int n4 = (lane & 7) * 4, kr = lane >> 3; f32x4 v[8];
#pragma unroll
    for (int i = 0; i < 8; ++i) v[i] = (n4 < nvalid) ? *(const f32x4*)(src + (size_t)(k0 + kr + 8 * i) * ld_src + scol0 + n4) : (f32x4){0.f, 0.f, 0.f, 0.f};
#pragma unroll
    for (int i = 0; i < 8; ++i) { LAS float* s = scr + (kr + 8 * i) * 33 + n4; s[0] = v[i][0]; s[1] = v[i][1]; s[2] = v[i][2]; s[3] = v[i][3]; }
    asm volatile("s_waitcnt lgkmcnt(0)" ::: "memory");
    const int c = lane & 7;
#pragma unroll
    for (int jq = 0; jq < 4; ++jq) { const int n = (lane >> 3) + 8 * jq; const LAS float* s = scr + (8 * c) * 33 + n;
        u32x4 o; o.x = pk2(s[0 * 33], s[1 * 33]); o.y = pk2(s[2 * 33], s[3 * 33]); o.z = pk2(s[4 * 33], s[5 * 33]); o.w = pk2(s[6 * 33], s[7 * 33]);
        *(u32x4*)(dst + (size_t)(drow0 + n) * ld_dst + dk0 + k0 + 8 * c) = o; }
    asm volatile("s_waitcnt lgkmcnt(0)" ::: "memory");
}
DI void conv_item(const Ctx& C, int l, int r, LAS float* scr) {
    constexpr int I_GU = 32 * 16 * 64;
    if (r < I_GU) { const int e = r / 1024, r2 = r % 1024, kb = r2 / 64, nb = r2 % 64, n0 = 32 * nb, j = n0 / 256, i = n0 % 256;
        const int scol0 = (i < 128) ? 128 * j + i : 1024 + 128 * j + (i - 128);
        tr_item(C.w_gu + (size_t)(l * 32 + e) * 1024 * 2048, 2048, scol0, 32, 64 * kb, WSP(bf16, WS_WGU) + (size_t)(l * 32 + e) * 2048 * 1024, 1024, n0, 0, scr, C.lane); }
    else { r -= I_GU; const int e = r / 512, r2 = r % 512, kb = r2 / 32, nb = r2 % 32;
        tr_item(C.w_down + (size_t)(l * 32 + e) * 1024 * 1024, 1024, 32 * nb, 32, 64 * kb, WSP(bf16, WS_WDN) + (size_t)(l * 32 + e) * 1024 * 1024, 1024, 32 * nb, 0, scr, C.lane); }
}
DI void conv_ticket(const Ctx& C, int l, int tk) {
    LAS float* scr = (LAS float*)(C.lds + C.wave * 16384);
    __syncthreads();
#pragma unroll 1
    for (int i = 0; i < 8; ++i) conv_item(C, l, tk * 64 + C.wave * 8 + i, scr);
}
DI void p0_prologue(const Ctx& C) {
    LAS float* scr = (LAS float*)(C.lds + C.wave * 16384);
    const int gw = C.bid * NWAVE + C.wave, NGW = C.G * NWAVE;
    constexpr int I_IN = 16 * 104, I_OUT = 16 * 32, I_LW = 8, I_LA = 8, I_LG = 16, I_K1 = 256, I_K2 = 8;
    constexpr int I_LAYER = I_IN + I_OUT + I_LW + I_LA + I_LG + 2 * I_K1 + 2 * I_K2;
    for (int it = gw; it < NLAYER * I_LAYER; it += NGW) {
        const int l = it / I_LAYER; int r = it % I_LAYER;
        if (r < I_IN) { const int kb = r / 104, nb = r % 104, n0 = 32 * nb; int nv = 3212 - n0; nv = nv < 0 ? 0 : (nv > 32 ? 32 : nv);
            tr_item(C.w_in + (size_t)l * 1024 * 3212, 3212, n0, nv, 64 * kb, WSP(bf16, WS_WIN) + (size_t)l * NPJ * 1024, 1024, n0, 0, scr, C.lane); continue; } r -= I_IN;
        if (r < I_OUT) { const int kb = r / 32, nb = r % 32;
            tr_item(C.w_out + (size_t)l * 1024 * 1024, 1024, 32 * nb, 32, 64 * kb, WSP(bf16, WS_WOUT) + (size_t)l * 1024 * 1024, 1024, 32 * nb, 0, scr, C.lane); continue; } r -= I_OUT;
        bf16* lora = WSP(bf16, WS_LORA) + (size_t)l * 768 * 256;
        if (r < I_LW) { tr_item(C.w2 + (size_t)l * 64 * 256, 256, 32 * r, 32, 0, lora, 256, 32 * r, 0, scr, C.lane); continue; } r -= I_LW;
        if (r < I_LA) { tr_item(C.a2 + (size_t)l * 64 * 256, 256, 32 * r, 32, 0, lora, 256, 256 + 32 * r, 64, scr, C.lane); continue; } r -= I_LA;
        if (r < I_LG) { const int kb = r / 8, nb = r % 8; tr_item(C.g2 + (size_t)l * 128 * 256, 256, 32 * nb, 32, 64 * kb, lora, 256, 512 + 32 * nb, 128, scr, C.lane); continue; } r -= I_LG;
        if (r < 2 * I_K1) { const int kv = r / I_K1, r2 = r % I_K1, kb = r2 / 8, nb = r2 % 8;
            tr_item((kv ? C.wv1 : C.wk1) + (size_t)l * 2048 * 256, 256, 32 * nb, 32, 64 * kb, WSP(bf16, WS_WK1) + (size_t)(l * 2 + kv) * 256 * 2048, 2048, 32 * nb, 0, scr, C.lane); continue; } r -= 2 * I_K1;
        { const int kv = r / I_K2, r2 = r % I_K2, kb = r2 / 2, nb = r2 % 2;
            tr_item((kv ? C.wv2 : C.wk2) + (size_t)l * 256 * 64, 64, 32 * nb, 32, 64 * kb, WSP(bf16, WS_WK2) + (size_t)(l * 2 + kv) * 256 * 256, 256, 32 * nb, 0, scr, C.lane); }
    }
    __syncthreads();
    float* MOD = WSP(float, WS_SMALL); float* PEB = MOD + NLAYER * 8 * 6144;
    LAS float* sc = (LAS float*)C.lds;
    LAS float* red = sc + 8192;
    for (int it = C.bid; it < 192 + 4; it += C.G) {
        if (it < 192) {
            const int l = it / 96, n0 = (it % 96) * 64;
            for (int i = C.tid; i < 8192; i += NTHR) { const float v = C.c[i]; sc[i] = v / (1.f + __expf(-v)); }
            __syncthreads();
            const int kq = C.tid >> 6, col = C.tid & 63; float a[8];
#pragma unroll
            for (int b = 0; b < 8; ++b) a[b] = 0.f;
            const float* wp = C.w_ada + (size_t)l * 1024 * 6144 + n0 + col;
#pragma unroll 8
            for (int k = kq * 128; k < kq * 128 + 128; ++k) { const float w = wp[(size_t)k * 6144];
#pragma unroll
                for (int b = 0; b < 8; ++b) a[b] += sc[b * 1024 + k] * w; }
#pragma unroll
            for (int b = 0; b < 8; ++b) red[(kq * 8 + b) * 64 + col] = a[b];
            __syncthreads();
            { const int b = C.tid >> 6; float s = C.b_ada[(size_t)l * 6144 + n0 + col];
#pragma unroll
              for (int q = 0; q < 8; ++q) s += red[(q * 8 + b) * 64 + col];
              MOD[((size_t)l * 8 + b) * 6144 + n0 + col] = s; }
            __syncthreads();
        } else {
            const int l = (it - 192) / 2, kv = (it - 192) % 2; const float* pe = (kv ? C.pe_v : C.pe_k) + (size_t)l * 2048; const float* w1 = (kv ? C.wv1 : C.wk1) + (size_t)l * 2048 * 256;
            const int kq = C.tid >> 8, col = C.tid & 255; float a = 0.f;
#pragma unroll 8
            for (int k = kq * 1024; k < kq * 1024 + 1024; ++k) a += pe[k] * w1[(size_t)k * 256 + col];
            red[kq * 256 + col] = a; __syncthreads();
            if (C.tid < 256) PEB[(l * 2 + kv) * 256 + col] = red[col] + red[256 + col];
            __syncthreads();
        }
    }
}

DI void norm_row(const Ctx& C, const float* xrow, const float* g, const float* sh, const float* sc, bf16* orow) {
    f32x4 v[4]; float s = 0.f;
#pragma unroll
    for (int j = 0; j < 4; ++j) { v[j] = *(const f32x4*)(xrow + 4 * C.lane + 256 * j); s += (v[j][0] * v[j][0] + v[j][1] * v[j][1]) + (v[j][2] * v[j][2] + v[j][3] * v[j][3]); }
    s = group_sum<64>(s); const float rstd = rsqrtf(s * (1.f / DM) + 1e-6f);
#pragma unroll
    for (int j = 0; j < 4; ++j) { const int k = 4 * C.lane + 256 * j; const f32x4 gg = *(const f32x4*)(g + k), a = *(const f32x4*)(sc + k), b = *(const f32x4*)(sh + k); f32x4 h;
#pragma unroll
        for (int i = 0; i < 4; ++i) h[i] = v[j][i] * rstd * gg[i] * (1.f + a[i]) + b[i];
        u32x2 o; o.x = pk2(h[0], h[1]); o.y = pk2(h[2], h[3]); *(u32x2*)(orow + k) = o; }
}
DI void norm1_phase(const Ctx& C, int l, const float* xin) {
    const float* MOD = WSP(float, WS_SMALL) + (size_t)l * 8 * 6144; bf16* H = WSP(bf16, WS_H);
    const int gw = C.bid * NWAVE + C.wave, NGW = C.G * NWAVE;
    for (int m = gw; m < NT; m += NGW) { const int b = m / NS; norm_row(C, xin + (size_t)m * DM, C.norm1_g + l * DM, MOD + b * 6144, MOD + b * 6144 + 1024, H + (size_t)m * DM); }
}

constexpr float QSCALE = 0.125f * 1.44269504089f;
DI void prep_phase(const Ctx& C, int l) {
    const bf16* PROJ = WSP(bf16, R_PROJ); float* SC = WSP(float, R_SC); bf16* LIN = WSP(bf16, R_LIN); bf16* YCAT = WSP(bf16, R_YCAT);
    bf16 *QC = WSP(bf16, R_QC), *KC = WSP(bf16, R_KC), *QN = WSP(bf16, R_QN), *QR = WSP(bf16, R_QR), *KCR = WSP(bf16, R_KCR), *VCR = WSP(bf16, R_VCR), *KS = WSP(bf16, R_KS), *KW = WSP(bf16, R_KW);
    float* GATE = WSP(float, R_GATE);
    const int lane = C.lane, gw = C.bid * NWAVE + C.wave, NGW = C.G * NWAVE;
    const int hh = lane >> 4, jj = lane & 15;
    const float inv0 = exp2f(-(float)(2 * jj) * (13.287712379549449f / 32.f)), inv1 = exp2f(-(float)(2 * jj + 1) * (13.287712379549449f / 32.f));
    for (int row = gw; row < NT; row += NGW) {
        const int s = row % NS; const bf16* pr = PROJ + (size_t)row * NPJ;
        {
            const int c0 = 16 * lane; float z[16];
            const u32x4 c0v = *(const u32x4*)(pr + c0), c1v = *(const u32x4*)(pr + c0 + 8);
            u32x4 p0v = (u32x4){0u, 0u, 0u, 0u}, p1v = p0v;
            if (s > 0) { p0v = *(const u32x4*)(pr - NPJ + c0); p1v = *(const u32x4*)(pr - NPJ + c0 + 8); }
            const float* mup = C.mu + (size_t)l * 1024 + c0;
            const unsigned cw[8] = {c0v.x, c0v.y, c0v.z, c0v.w, c1v.x, c1v.y, c1v.z, c1v.w}, pw[8] = {p0v.x, p0v.y, p0v.z, p0v.w, p1v.x, p1v.y, p1v.z, p1v.w};
#pragma unroll
            for (int q = 0; q < 4; ++q) { const f32x4 m4 = *(const f32x4*)(mup + 4 * q);
#pragma unroll
                for (int i = 0; i < 4; ++i) { const int e = 4 * q + i; const float cu = (e & 1) ? bfhi(cw[e >> 1]) : bflo(cw[e >> 1]), pv = (e & 1) ? bfhi(pw[e >> 1]) : bflo(pw[e >> 1]); z[e] = cu + (pv - cu) * m4[i]; } }
            const int cc = (c0 - 256) & 255; float kk[16]; float ss = 0.f;
#pragma unroll
            for (int q = 0; q < 4; ++q) { const f32x4 k4 = *(const f32x4*)(C.kkw + (size_t)l * 256 + cc + 4 * q);
#pragma unroll
                for (int i = 0; i < 4; ++i) { kk[4 * q + i] = z[4 * q + i] * k4[i]; ss += kk[4 * q + i] * kk[4 * q + i]; } }
            ss = group_sum<4>(ss); const float kinv = rsqrtf(ss + 1e-12f);
            if (lane < 48) {
                const int vec = lane < 16 ? 4 : (lane < 32 ? 1 : 5); float* dst = SC + ((size_t)vec * NT + row) * 256 + (c0 & 255);
#pragma unroll
                for (int q = 0; q < 4; ++q) *(f32x4*)(dst + 4 * q) = (f32x4){z[4 * q], z[4 * q + 1], z[4 * q + 2], z[4 * q + 3]};
                if (lane >= 16 && lane < 32) { float* d2 = SC + ((size_t)2 * NT + row) * 256 + cc;
#pragma unroll
                    for (int q = 0; q < 4; ++q) *(f32x4*)(d2 + 4 * q) = (f32x4){kk[4 * q] * kinv, kk[4 * q + 1] * kinv, kk[4 * q + 2] * kinv, kk[4 * q + 3] * kinv}; }
            } else {
                float t[16];
#pragma unroll
                for (int i = 0; i < 16; ++i) { const float sg = fsigmoid(lane < 52 ? 2.f * z[i] : z[i]); t[i] = lane < 52 ? 2.f * sg - 1.f : (lane < 56 ? z[i] : sg); }
                bf16* dst = LIN + (size_t)row * 256 + (c0 - 768);
                u32x4 o0, o1; o0.x = pk2(t[0], t[1]); o0.y = pk2(t[2], t[3]); o0.z = pk2(t[4], t[5]); o0.w = pk2(t[6], t[7]); o1.x = pk2(t[8], t[9]); o1.y = pk2(t[10], t[11]); o1.z = pk2(t[12], t[13]); o1.w = pk2(t[14], t[15]);
                *(u32x4*)dst = o0; *(u32x4*)(dst + 8) = o1;
            }
        }
        {
            const int ch = 4 * lane; float u[3][4];
#pragma unroll
            for (int d = 0; d < 3; ++d) {
                u32x2 cg = (u32x2){0u, 0u}, xi = cg;
                if (s >= d) { cg = *(const u32x2*)(pr - (size_t)d * NPJ + PJ_B + 256 + ch); xi = *(const u32x2*)(pr - (size_t)d * NPJ + PJ_B + 512 + ch); }
                u[d][0] = bflo(cg.x) * bflo(xi.x); u[d][1] = bfhi(cg.x) * bfhi(xi.x); u[d][2] = bflo(cg.y) * bflo(xi.y); u[d][3] = bfhi(cg.y) * bfhi(xi.y);
            }
            const u32x2 bgv = *(const u32x2*)(pr + PJ_B + ch); const float bg[4] = {bflo(bgv.x), bfhi(bgv.x), bflo(bgv.y), bfhi(bgv.y)};
            const float* cw = C.conv_w + (size_t)l * 3 * 256 + ch; const f32x4 w0 = *(const f32x4*)cw, w1 = *(const f32x4*)(cw + 256), w2 = *(const f32x4*)(cw + 512);
            float y[4]; float ss = 0.f;
#pragma unroll
            for (int i = 0; i < 4; ++i) { y[i] = bg[i] * (w0[i] * u[2][i] + w1[i] * u[1][i] + w2[i] * u[0][i]); ss += y[i] * y[i]; }
            ss = group_sum<16>(ss); const float rstd = rsqrtf(ss * (1.f / 64.f) + 1e-6f); const f32x4 og = *(const f32x4*)(C.onorm_g + (size_t)l * 768 + ch);
            u32x2 o; o.x = pk2(y[0] * rstd * og[0], y[1] * rstd * og[1]); o.y = pk2(y[2] * rstd * og[2], y[3] * rstd * og[3]);
            *(u32x2*)(YCAT + (size_t)row * DM + 256 + ch) = o;
        }
        const float posf = (float)C.pos[row];
        const float x0 = __builtin_amdgcn_fractf((posf * inv0) * 0.15915494309189535f), x1 = __builtin_amdgcn_fractf((posf * inv1) * 0.15915494309189535f);
        const float sn0 = __builtin_amdgcn_sinf(x0), cs0 = __builtin_amdgcn_cosf(x0), sn1 = __builtin_amdgcn_sinf(x1), cs1 = __builtin_amdgcn_cosf(x1);
#pragma unroll
        for (int qk = 0; qk < 2; ++qk) {
            const bf16* p = pr + PJ_C + qk * 256 + hh * 64 + 2 * jj; const unsigned a = *(const unsigned*)p, b = *(const unsigned*)(p + 32);
            float x1a = bflo(a), x1b = bfhi(a), x2a = bflo(b), x2b = bfhi(b);
            float ss = group_sum<16>(x1a * x1a + x1b * x1b + x2a * x2a + x2b * x2b); const float rstd = rsqrtf(ss * (1.f / 64.f) + 1e-6f);
            const float* g = (qk ? C.dil_k_g : C.dil_q_g) + (size_t)l * 64; const float sc = qk ? 1.f : QSCALE;
            x1a *= rstd * g[2 * jj] * sc; x1b *= rstd * g[2 * jj + 1] * sc; x2a *= rstd * g[32 + 2 * jj] * sc; x2b *= rstd * g[33 + 2 * jj] * sc;
            bf16* o = (qk ? KC : QC) + (size_t)row * 256 + hh * 64 + 2 * jj;
            *(unsigned*)o = pk2(x1a * cs0 - x2a * sn0, x1b * cs1 - x2b * sn1); *(unsigned*)(o + 32) = pk2(x2a * cs0 + x1a * sn0, x2b * cs1 + x1b * sn1);
        }
        {
            const bf16* p = pr + PJ_D + hh * 64 + 2 * jj; const unsigned a = *(const unsigned*)p, b = *(const unsigned*)(p + 32);
            float x1a = bflo(a), x1b = bfhi(a), x2a = bflo(b), x2b = bfhi(b);
            float ss = group_sum<16>(x1a * x1a + x1b * x1b + x2a * x2a + x2b * x2b); const float rstd = rsqrtf(ss * (1.f / 64.f) + 1e-6f) * QSCALE;
            const float* g = C.nsa_q_g + (size_t)l * 64;
            x1a *= rstd * g[2 * jj]; x1b *= rstd * g[2 * jj + 1]; x2a *= rstd * g[32 + 2 * jj]; x2b *= rstd * g[33 + 2 * jj];
            bf16* on = QN + (size_t)row * 256 + hh * 64 + 2 * jj; *(unsigned*)on = pk2(x1a, x1b); *(unsigned*)(on + 32) = pk2(x2a, x2b);
            bf16* o = QR + (size_t)row * 256 + hh * 64 + 2 * jj;
            *(unsigned*)o = pk2(x1a * cs0 - x2a * sn0, x1b * cs1 - x2b * sn1); *(unsigned*)(o + 32) = pk2(x2a * cs0 + x1a * sn0, x2b * cs1 + x1b * sn1);
        }
        {
            const int col = hh == 0 ? 2944 : (hh == 1 ? 3072 : (hh == 2 ? 2816 : 2880));
            const bf16* p = pr + col + 2 * jj; const unsigned a = *(const unsigned*)p, b = *(const unsigned*)(p + 32);
            float x1a = bflo(a), x1b = bfhi(a), x2a = bflo(b), x2b = bfhi(b);
            float ss = group_sum<16>(x1a * x1a + x1b * x1b + x2a * x2a + x2b * x2b); const float rstd = rsqrtf(ss * (1.f / 64.f) + 1e-6f);
            const float* g = (hh == 0 ? C.nsa_ks_g : C.nsa_kw_g) + (size_t)l * 64;
            const float n1a = x1a * rstd * g[2 * jj], n1b = x1b * rstd * g[2 * jj + 1], n2a = x2a * rstd * g[32 + 2 * jj], n2b = x2b * rstd * g[33 + 2 * jj];
            unsigned o1 = pk2(n1a * cs0 - n2a * sn0, n1b * cs1 - n2b * sn1), o2 = pk2(n2a * cs0 + n1a * sn0, n2b * cs1 + n1b * sn1);
            if (hh >= 2) { o1 = a; o2 = b; }
            bf16* o = (hh == 0 ? KS : (hh == 1 ? KW : (hh == 2 ? KCR : VCR))) + (size_t)row * 64 + 2 * jj;
            *(unsigned*)o = o1; *(unsigned*)(o + 32) = o2;
        }
        if (lane < 12) GATE[(size_t)row * 12 + lane] = fsigmoid(bf2f(pr[3200 + lane]));
    }
}
constexpr int SCAN_TC = 16;
DI void scan_unit(const Ctx& C, int u) {
    const float* SC = WSP(float, R_SC); float* YA = WSP(float, R_YA);
    const int b = u >> 3, h = (u >> 1) & 3, half = u & 1, tid = C.tid;
    LAS float* buf = (LAS float*)C.lds;
    LAS float* yp = buf + 2 * 6144;
    const int rl = (tid >> 3) & 31, cg = tid & 7, row = 32 * half + rl;
    f32x4 ld[3];
#define SCAN_LOAD(chunk) do { _Pragma("unroll") for (int i = 0; i < 3; ++i) { const int idx = tid + 512 * i, step = idx / 96, rem = idx % 96, vec = rem >> 4, f4 = rem & 15; \
        ld[i] = *(const f32x4*)(SC + ((size_t)vec * NT + (size_t)b * NS + (chunk) * SCAN_TC + step) * 256 + h * 64 + f4 * 4); } } while (0)
#define SCAN_STORE(slot) do { _Pragma("unroll") for (int i = 0; i < 3; ++i) *(LAS f32x4*)(buf + (slot) * 6144 + (tid + 512 * i) * 4) = ld[i]; } while (0)
#define SCAN_FLUSH(chunk) do { _Pragma("unroll") for (int i = 0; i < 2; ++i) { const int i2 = (tid - 256) + 256 * i, step = i2 >> 5, rr = i2 & 31; const LAS float* pp = yp + ((chunk) & 1) * 4096 + step * 256 + rr * 8; \
        const f32x4 a = *(const LAS f32x4*)pp, c2 = *(const LAS f32x4*)(pp + 4); \
        YA[((size_t)b * NS + (chunk) * SCAN_TC + step) * 256 + h * 64 + 32 * half + rr] = ((a[0] + a[1]) + (a[2] + a[3])) + ((c2[0] + c2[1]) + (c2[2] + c2[3])); } } while (0)
    __syncthreads();
    SCAN_LOAD(0); SCAN_STORE(0);
    f32x2 S[4];
#pragma unroll
    for (int c = 0; c < 4; ++c) S[c] = (f32x2){0.f, 0.f};
    constexpr int NCH = NS / SCAN_TC;
    for (int ck = 0; ck < NCH; ++ck) {
        __syncthreads();
        if (ck + 1 < NCH) SCAN_LOAD(ck + 1);
        if (tid >= 256) { if (ck > 0) SCAN_FLUSH(ck - 1); }
        else {
            const LAS float* bp = buf + (ck & 1) * 6144; LAS float* yb = yp + (ck & 1) * 4096 + tid;
#pragma unroll 4
            for (int step = 0; step < SCAN_TC; ++step) {
                const LAS float* sp = bp + step * 384 + 8 * cg;
                const f32x4 w0 = *(const LAS f32x4*)(sp), w1 = *(const LAS f32x4*)(sp + 4), k0 = *(const LAS f32x4*)(sp + 64), k1 = *(const LAS f32x4*)(sp + 68);
                const f32x4 q0 = *(const LAS f32x4*)(sp + 128), q1 = *(const LAS f32x4*)(sp + 132), b0 = *(const LAS f32x4*)(sp + 192), b1 = *(const LAS f32x4*)(sp + 196);
                const f32x4 r0 = *(const LAS f32x4*)(sp + 256), r1 = *(const LAS f32x4*)(sp + 260); const float v = bp[step * 384 + 320 + row];
                f32x2 d2 = S[0] * (f32x2){q0[0], q0[1]}; d2 = S[1] * (f32x2){q0[2], q0[3]} + d2; d2 = S[2] * (f32x2){q1[0], q1[1]} + d2; d2 = S[3] * (f32x2){q1[2], q1[3]} + d2;
                const float sa = -sum8(d2[0] + d2[1]); const f32x2 sa2 = (f32x2){sa, sa}, v2 = (f32x2){v, v};
                S[0] = S[0] * (f32x2){w0[0], w0[1]} + (sa2 * (f32x2){b0[0], b0[1]} + v2 * (f32x2){k0[0], k0[1]});
                S[1] = S[1] * (f32x2){w0[2], w0[3]} + (sa2 * (f32x2){b0[2], b0[3]} + v2 * (f32x2){k0[2], k0[3]});
                S[2] = S[2] * (f32x2){w1[0], w1[1]} + (sa2 * (f32x2){b1[0], b1[1]} + v2 * (f32x2){k1[0], k1[1]});
                S[3] = S[3] * (f32x2){w1[2], w1[3]} + (sa2 * (f32x2){b1[2], b1[3]} + v2 * (f32x2){k1[2], k1[3]});
                f32x2 y2 = S[0] * (f32x2){r0[0], r0[1]}; y2 = S[1] * (f32x2){r0[2], r0[3]} + y2; y2 = S[2] * (f32x2){r1[0], r1[1]} + y2; y2 = S[3] * (f32x2){r1[2], r1[3]} + y2;
                yb[step * 256] = y2[0] + y2[1];
            }
        }
        if (ck + 1 < NCH) SCAN_STORE((ck + 1) & 1);
    }
    __syncthreads();
    if (tid >= 256) SCAN_FLUSH(NCH - 1);
#undef SCAN_LOAD
#undef SCAN_STORE
#undef SCAN_FLUSH
    __syncthreads();
}

constexpr int KROW = 144, KT_BYTES = 64 * KROW;
#define MFMA16(a, b, c) __builtin_amdgcn_mfma_f32_16x16x32_bf16((a), (b), (c), 0, 0, 0)
template <int NQT> struct FA { f32x4 O[NQT][4]; float m[NQT], l[NQT]; };
template <int NQT> DI void fa_init(FA<NQT>& st) {
#pragma unroll
    for (int q = 0; q < NQT; ++q) { st.m[q] = -1e30f; st.l[q] = 0.f;
#pragma unroll
        for (int d = 0; d < 4; ++d) st.O[q][d] = (f32x4){0.f, 0.f, 0.f, 0.f}; }
}
DI bf16x8 pack8(const f32x4& a, const f32x4& b) { u32x4 w; w.x = pk2(a[0], a[1]); w.y = pk2(a[2], a[3]); w.z = pk2(b[0], b[1]); w.w = pk2(b[2], b[3]); return __builtin_bit_cast(bf16x8, w); }
struct VFrag { u32x2 a[4], b[4]; };
DI void vt_issue(VFrag& f, unsigned vaddr) {
    asm volatile("ds_read_b64_tr_b16 %0, %8\n\tds_read_b64_tr_b16 %1, %8 offset:2304\n\tds_read_b64_tr_b16 %2, %8 offset:32\n\tds_read_b64_tr_b16 %3, %8 offset:2336\n\t"
                 "ds_read_b64_tr_b16 %4, %8 offset:64\n\tds_read_b64_tr_b16 %5, %8 offset:2368\n\tds_read_b64_tr_b16 %6, %8 offset:96\n\tds_read_b64_tr_b16 %7, %8 offset:2400"
                 : "=&v"(f.a[0]), "=&v"(f.b[0]), "=&v"(f.a[1]), "=&v"(f.b[1]), "=&v"(f.a[2]), "=&v"(f.b[2]), "=&v"(f.a[3]), "=&v"(f.b[3]) : "v"(vaddr) : "memory");
}
DI void vt_wait(VFrag& f) { asm volatile("s_waitcnt lgkmcnt(0)" : "+v"(f.a[0]), "+v"(f.b[0]), "+v"(f.a[1]), "+v"(f.b[1]), "+v"(f.a[2]), "+v"(f.b[2]), "+v"(f.a[3]), "+v"(f.b[3]) :: "memory"); }
DI bf16x8 vt_get(const VFrag& f, int d) { return __builtin_bit_cast(bf16x8, ((u32x4){f.a[d].x, f.a[d].y, f.b[d].x, f.b[d].y})); }
template <int NQT, bool MASKED, class MaskF>
DI void fa_tile(FA<NQT>& st, const bf16x8 (&Q)[NQT][2], const LAS uchar* Ks, const LAS uchar* Vs, int lane, const MaskF& allowed, const bool (&act)[NQT]) {
    const int l15 = lane & 15, quad = lane >> 4;
    f32x4 S[NQT][4];
#pragma unroll
    for (int kt = 0; kt < 4; ++kt) {
        const bf16x8 k0 = *(const LAS bf16x8*)(Ks + (16 * kt + l15) * KROW + quad * 16), k1 = *(const LAS bf16x8*)(Ks + (16 * kt + l15) * KROW + 64 + quad * 16);
#pragma unroll
        for (int q = 0; q < NQT; ++q) if (act[q]) { S[q][kt] = MFMA16(k0, Q[q][0], ((f32x4){0.f, 0.f, 0.f, 0.f})); S[q][kt] = MFMA16(k1, Q[q][1], S[q][kt]); }
    }
    const unsigned vaddr = (unsigned)(size_t)(Vs + (4 * quad + (l15 >> 2)) * KROW + 8 * (l15 & 3));
    VFrag v0, v1; vt_issue(v0, vaddr); vt_issue(v1, vaddr + 32 * KROW);
#pragma unroll
    for (int q = 0; q < NQT; ++q) if (act[q]) {
        float mx = -1e30f;
#pragma unroll
        for (int kt = 0; kt < 4; ++kt)
#pragma unroll
            for (int j = 0; j < 4; ++j) { if (MASKED) { const float s = allowed(q, 16 * kt + 4 * quad + j) ? S[q][kt][j] : -1e30f; S[q][kt][j] = s; } mx = fmaxf(mx, S[q][kt][j]); }
        mx = fmaxf(mx, __shfl_xor(mx, 16)); mx = fmaxf(mx, __shfl_xor(mx, 32));
        const float mn = fmaxf(st.m[q], mx), alpha = fexp2(st.m[q] - mn); st.m[q] = mn;
        float rs = 0.f;
#pragma unroll
        for (int kt = 0; kt < 4; ++kt)
#pragma unroll
            for (int j = 0; j < 4; ++j) { const float s = S[q][kt][j]; float p = fexp2(s - mn); if (MASKED) p = (s > -1e29f) ? p : 0.f; S[q][kt][j] = p; rs += p; }
        st.l[q] = st.l[q] * alpha + rs;
#pragma unroll
        for (int d = 0; d < 4; ++d) st.O[q][d] = st.O[q][d] * alpha;
    }
    vt_wait(v0); vt_wait(v1);
#pragma unroll
    for (int q = 0; q < NQT; ++q) if (act[q]) {
        const bf16x8 p0 = pack8(S[q][0], S[q][1]), p1 = pack8(S[q][2], S[q][3]);
#pragma unroll
        for (int d = 0; d < 4; ++d) { st.O[q][d] = MFMA16(vt_get(v0, d), p0, st.O[q][d]); st.O[q][d] = MFMA16(vt_get(v1, d), p1, st.O[q][d]); }
    }
}
template <int NQT> DI void fa_finish(FA<NQT>& st, float (&lse2)[NQT]) {
#pragma unroll
    for (int q = 0; q < NQT; ++q) { float l = st.l[q]; l += __shfl_xor(l, 16); l += __shfl_xor(l, 32); const float inv = l > 0.f ? 1.f / l : 0.f; lse2[q] = st.m[q] + __log2f(fmaxf(l, 1e-37f));
#pragma unroll
        for (int d = 0; d < 4; ++d) st.O[q][d] = st.O[q][d] * inv; }
}
DI void kv_store(LAS uchar* Ks, LAS uchar* Vs, int tid, const u32x4& kr, const u32x4& vr) {
    const int o = (tid >> 3) * KROW + (tid & 7) * 16; *(LAS u32x4*)(Ks + o) = kr; *(LAS u32x4*)(Vs + o) = vr;
}
DI void q_load(bf16x8 (&Q)[2], const bf16* qrow, int quad) { Q[0] = *(const bf16x8*)(qrow + 8 * quad); Q[1] = *(const bf16x8*)(qrow + 32 + 8 * quad); }

struct DilMask { int qi[2]; int k0; DI bool operator()(int q, int key) const { const int ki = k0 + key, d = qi[q] - ki; return ki >= 0 && d >= 0 && d <= 128; } };
DI void dil_unit(const Ctx& C, int unit, LAS uchar* Ks, LAS uchar* Vs) {
    const bf16 *QC = WSP(bf16, R_QC), *KC = WSP(bf16, R_KC), *PROJ = WSP(bf16, R_PROJ); float* OC = WSP(float, R_OC); float* LSE = WSP(float, R_LSE);
    int tid = C.tid, lane = C.lane; asm volatile("" : "+v"(tid), "+v"(lane));
    const int w = C.wave, l15 = lane & 15, quad = lane >> 4;
    const int cfg = unit / 512, r = unit % 512, dsh = 2 * cfg, d = 1 << dsh;
    const int b = r >> 6, h = (r >> 4) & 3, r2 = r & 15;
    const int nblk = 16 >> dsh, res = r2 / nblk, blk = r2 % nblk, i0 = blk * 256;
    const size_t tb = (size_t)b * NS;
    bf16x8 Q[2][2]; DilMask mk; FA<2> st; fa_init(st);
#pragma unroll
    for (int q = 0; q < 2; ++q) { mk.qi[q] = i0 + 32 * w + 16 * q + l15; q_load(Q[q], QC + (tb + res + (size_t)d * mk.qi[q]) * 256 + h * 64, quad); }
    const int jlo = w >> 1, jhi = (w >> 1) + 2;
    const bool act[2] = {true, true};
    u32x4 kr, vr;
#define DIL_LOAD(j) do { const int ki = i0 - 128 + 64 * (j) + (tid >> 3); kr = (u32x4){0u, 0u, 0u, 0u}; vr = kr; \
    if (ki >= 0) { const size_t rowk = tb + res + (size_t)d * ki; kr = *(const u32x4*)(KC + rowk * 256 + h * 64 + (tid & 7) * 8); vr = *(const u32x4*)(PROJ + rowk * NPJ + PJ_C + 512 + h * 64 + (tid & 7) * 8); } } while (0)
    DIL_LOAD(0);
    for (int j = 0; j < 6; ++j) {
        __syncthreads(); kv_store(Ks, Vs, tid, kr, vr); __syncthreads();
        if (j + 1 < 6) DIL_LOAD(j + 1);
        if (j >= jlo && j <= jhi) { mk.k0 = i0 - 128 + 64 * j; fa_tile<2, true>(st, Q, Ks, Vs, lane, mk, act); }
    }
#undef DIL_LOAD
    float lse2[2]; fa_finish<2>(st, lse2);
#pragma unroll
    for (int q = 0; q < 2; ++q) { const size_t rowq = tb + res + (size_t)d * mk.qi[q]; float* o = OC + ((size_t)cfg * NT + rowq) * 256 + h * 64 + 4 * quad;
#pragma unroll
        for (int dt = 0; dt < 4; ++dt) *(f32x4*)(o + 16 * dt) = st.O[q][dt];
        if (quad == 0) LSE[((size_t)cfg * NT + rowq) * 4 + h] = lse2[q]; }
}
constexpr int NSA_KC = 0, NSA_VC = 256 * KROW, NSA_KT = 2 * 256 * KROW, NSA_VT = NSA_KT + KT_BYTES, NSA_IMP = NSA_VT + KT_BYTES, NSA_SELM = NSA_IMP + 64 * 64 * 4, NSA_UW = NSA_SELM + 512;
static_assert(NSA_UW + 16 <= RING_BYTES, "NSA LDS map");
struct SwaMask { int t[2]; int k0; DI bool operator()(int q, int key) const { const int d = t[q] - (k0 + key); return d >= 0 && d <= 511; } };
struct SlcMask { int t[2]; int k0; bool sel[2]; DI bool operator()(int q, int key) const { return sel[q] && (k0 + key <= t[q]); } };
struct NoMask { DI bool operator()(int, int) const { return true; } };
DI void nsa_unit(const Ctx& C, int l, int b, int tbk, int& bl) {
    const bf16 *QN = WSP(bf16, R_QN), *QR = WSP(bf16, R_QR), *KSb = WSP(bf16, R_KS), *KWb = WSP(bf16, R_KW), *PROJ = WSP(bf16, R_PROJ); const float* CMP = WSP(float, R_CMP); const float* GATE = WSP(float, R_GATE);
    bf16* YCAT = WSP(bf16, R_YCAT);
    LAS uchar* Kc = C.lds + NSA_KC; LAS uchar* Vc = C.lds + NSA_VC; LAS uchar* Ks = C.lds + NSA_KT; LAS uchar* Vs = C.lds + NSA_VT;
    LAS float* imps = (LAS float*)(C.lds + NSA_IMP); LAS unsigned* selm = (LAS unsigned*)(C.lds + NSA_SELM); LAS unsigned* uw = (LAS unsigned*)(C.lds + NSA_UW);
    int tid = C.tid, lane = C.lane; asm volatile("" : "+v"(tid), "+v"(lane));
    const int w = C.wave, l15 = lane & 15, quad = lane >> 4, head = l15 & 3, t0 = 64 * tbk; const size_t tb = (size_t)b * NS;
    __syncthreads();
    if (b != bl) {
        const int key = tid >> 1, hf = tid & 1; const float* kp = CMP + ((size_t)b * 256 + key) * 64 + 32 * hf; const float* vp = CMP + ((size_t)2048 + (size_t)b * 256 + key) * 64 + 32 * hf;
        float kv[32], vv[32]; float ss = 0.f;
#pragma unroll
        for (int i = 0; i < 8; ++i) { const f32x4 a = *(const f32x4*)(kp + 4 * i), c = *(const f32x4*)(vp + 4 * i);
#pragma unroll
            for (int j = 0; j < 4; ++j) { kv[4 * i + j] = a[j]; vv[4 * i + j] = c[j]; ss += a[j] * a[j]; } }
        ss += __shfl_xor(ss, 1); const float rstd = rsqrtf(ss * (1.f / 64.f) + 1e-6f); const float* g = C.nsa_kc_g + (size_t)l * 64 + 32 * hf; const bool dead = (key == 255);
#pragma unroll
        for (int i = 0; i < 4; ++i) { u32x4 o, p;
            o.x = pk2(kv[8 * i] * rstd * g[8 * i], kv[8 * i + 1] * rstd * g[8 * i + 1]); o.y = pk2(kv[8 * i + 2] * rstd * g[8 * i + 2], kv[8 * i + 3] * rstd * g[8 * i + 3]);
            o.z = pk2(kv[8 * i + 4] * rstd * g[8 * i + 4], kv[8 * i + 5] * rstd * g[8 * i + 5]); o.w = pk2(kv[8 * i + 6] * rstd * g[8 * i + 6], kv[8 * i + 7] * rstd * g[8 * i + 7]);
            p.x = pk2(vv[8 * i], vv[8 * i + 1]); p.y = pk2(vv[8 * i + 2], vv[8 * i + 3]); p.z = pk2(vv[8 * i + 4], vv[8 * i + 5]); p.w = pk2(vv[8 * i + 6], vv[8 * i + 7]);
            if (dead) { o = (u32x4){0u, 0u, 0u, 0u}; p = o; }
            *(LAS u32x4*)(Kc + key * KROW + hf * 64 + i * 16) = o; *(LAS u32x4*)(Vc + key * KROW + hf * 64 + i * 16) = p; }
        bl = b;
        __syncthreads();
    }
    f32x4 Oc[2][4];
    const int cmaxu = (t0 + 32) >> 4, ktmax = cmaxu >> 4;
    const unsigned vaddr0 = (unsigned)(size_t)(Vc + (4 * quad + (l15 >> 2)) * KROW + 8 * (l15 & 3));
#pragma unroll
    for (int q = 0; q < 2; ++q) {
        const int t = t0 + 8 * w + 4 * q + (l15 >> 2);
        bf16x8 Q[2]; q_load(Q, QN + (tb + t) * 256 + head * 64, quad);
        f32x4 S[16]; float mx = -1e30f;
#pragma unroll
        for (int kt = 0; kt < 16; ++kt) {
            if (kt <= ktmax) {
                const bf16x8 k0 = *(const LAS bf16x8*)(Kc + (16 * kt + l15) * KROW + quad * 16), k1 = *(const LAS bf16x8*)(Kc + (16 * kt + l15) * KROW + 64 + quad * 16);
                S[kt] = MFMA16(k0, Q[0], ((f32x4){0.f, 0.f, 0.f, 0.f})); S[kt] = MFMA16(k1, Q[1], S[kt]);
#pragma unroll
                for (int j = 0; j < 4; ++j) { const int c = 16 * kt + 4 * quad + j; const float s = (16 * c + 31 <= t) ? S[kt][j] : -1e30f; S[kt][j] = s; mx = fmaxf(mx, s); }
            } else S[kt] = (f32x4){-1e30f, -1e30f, -1e30f, -1e30f};
        }
        mx = fmaxf(mx, __shfl_xor(mx, 16)); mx = fmaxf(mx, __shfl_xor(mx, 32));
        float ls = 0.f;
#pragma unroll
        for (int kt = 0; kt < 16; ++kt)
#pragma unroll
            for (int j = 0; j < 4; ++j) { const float s = S[kt][j]; const float p = (s > -1e29f) ? fexp2(s - mx) : 0.f; S[kt][j] = p; ls += p; }
        ls += __shfl_xor(ls, 16); ls += __shfl_xor(ls, 32);
        const float inv = ls > 0.f ? 1.f / ls : 0.f;
#pragma unroll
        for (int kt = 0; kt < 16; ++kt) S[kt] = S[kt] * inv;
#pragma unroll
        for (int kt = 0; kt < 16; ++kt) {
            const float send = (quad == 3) ? (kt > 0 ? S[kt > 0 ? kt - 1 : 0][3] : 0.f) : S[kt][3];
            const float prev = __shfl(send, (lane + 48) & 63);
            float v = ((quad == 0 && kt == 0) ? 0.f : prev) + 2.f * (S[kt][0] + S[kt][1] + S[kt][2]) + S[kt][3];
            v += __shfl_xor(v, 1); v += __shfl_xor(v, 2);
            if (head == 0) imps[(8 * w + 4 * q + (l15 >> 2)) * 64 + 4 * kt + quad] = v;
        }
#pragma unroll
        for (int d = 0; d < 4; ++d) Oc[q][d] = (f32x4){0.f, 0.f, 0.f, 0.f};
#pragma unroll
        for (int ks = 0; ks < 8; ++ks) {
            if (2 * ks <= ktmax) {
                VFrag vf; vt_issue(vf, vaddr0 + ks * 32 * KROW); const bf16x8 pf = pack8(S[2 * ks], S[2 * ks + 1]); vt_wait(vf);
#pragma unroll
                for (int d = 0; d < 4; ++d) Oc[q][d] = MFMA16(vt_get(vf, d), pf, Oc[q][d]);
            }
        }
    }
    {
        float* OCm = WSP(float, R_OCMP);
#pragma unroll
        for (int q = 0; q < 2; ++q) { float* o = OCm + (tb + t0 + 8 * w + 4 * q + (l15 >> 2)) * 256 + head * 64 + 4 * quad;
#pragma unroll
            for (int d = 0; d < 4; ++d) *(f32x4*)(o + 16 * d) = Oc[q][d]; }
    }
    __syncthreads();
    if (tid < 64) {
        const int cur = tbk; unsigned long long mask;
        if (cur <= 15) mask = (2ull << cur) - 1ull;
        else {
            mask = 1ull | (1ull << cur) | (1ull << (cur - 1));
            float v[64];
#pragma unroll
            for (int i = 0; i < 16; ++i) { const f32x4 a = *(const LAS f32x4*)(imps + tid * 64 + 4 * i);
#pragma unroll
                for (int j = 0; j < 4; ++j) { const int jb = 4 * i + j; v[jb] = (jb >= 1 && jb <= cur - 2) ? a[j] : -1.f; } }
#pragma unroll 1
            for (int r = 0; r < 13; ++r) {
                float bv = -0.5f; int bi = 0;
#pragma unroll
                for (int jb = 0; jb < 64; ++jb) if (v[jb] > bv) { bv = v[jb]; bi = jb; }
                mask |= 1ull << bi;
#pragma unroll
                for (int jb = 0; jb < 64; ++jb) v[jb] = (jb == bi) ? -1.f : v[jb];
            }
        }
        unsigned lo = (unsigned)mask, hi = (unsigned)(mask >> 32);
        selm[2 * tid] = lo; selm[2 * tid + 1] = hi;
#pragma unroll
        for (int o = 1; o < 64; o <<= 1) { lo |= __shfl_xor(lo, o); hi |= __shfl_xor(hi, o); }
        if (tid == 0) { uw[0] = lo; uw[1] = hi; }
    }
    __syncthreads();
    unsigned long long U = ((unsigned long long)uw[1] << 32) | uw[0];
    bf16x8 Q[2][2]; SlcMask mk; FA<2> st; fa_init(st); unsigned long long msk[2];
#pragma unroll
    for (int q = 0; q < 2; ++q) { const int tl = 8 * w + 4 * q + (l15 >> 2); mk.t[q] = t0 + tl; msk[q] = ((unsigned long long)selm[2 * tl + 1] << 32) | selm[2 * tl]; q_load(Q[q], QR + (tb + mk.t[q]) * 256 + head * 64, quad); }
    unsigned long long QM[2];
#pragma unroll
    for (int q = 0; q < 2; ++q) { unsigned lo = (unsigned)msk[q], hi = (unsigned)(msk[q] >> 32);
#pragma unroll
        for (int o = 1; o < 64; o <<= 1) { lo |= __shfl_xor(lo, o); hi |= __shfl_xor(hi, o); }
        QM[q] = ((unsigned long long)hi << 32) | lo; }
    u32x4 kr, vr;
#define SLC_LOAD(j) do { const size_t rowk = tb + 64 * (j) + (tid >> 3); kr = *(const u32x4*)(KSb + rowk * 64 + (tid & 7) * 8); vr = *(const u32x4*)(PROJ + rowk * NPJ + 3008 + (tid & 7) * 8); } while (0)
    {
        int j = __builtin_ctzll(U); U &= U - 1ull;
        SLC_LOAD(j);
        for (;;) {
            __syncthreads(); kv_store(Ks, Vs, tid, kr, vr); __syncthreads();
            const int jn = U ? __builtin_ctzll(U) : -1; U &= U - 1ull;
            if (jn >= 0) SLC_LOAD(jn);
            const bool act[2] = {(bool)((QM[0] >> j) & 1ull), (bool)((QM[1] >> j) & 1ull)};
            if (act[0] || act[1]) { mk.k0 = 64 * j; mk.sel[0] = (msk[0] >> j) & 1ull; mk.sel[1] = (msk[1] >> j) & 1ull; fa_tile<2, true>(st, Q, Ks, Vs, lane, mk, act); }
            if (jn < 0) break; j = jn;
        }
    }
#undef SLC_LOAD
    float lse2[2]; fa_finish<2>(st, lse2);
    {   float* OSl = WSP(float, R_OSLC);
#pragma unroll
        for (int q = 0; q < 2; ++q) { float* o = OSl + (tb + mk.t[q]) * 256 + head * 64 + 4 * quad;
#pragma unroll
            for (int d = 0; d < 4; ++d) *(f32x4*)(o + 16 * d) = st.O[q][d]; }
    }
    FA<2> sw; fa_init(sw); SwaMask mw; mw.t[0] = mk.t[0]; mw.t[1] = mk.t[1];
    {
        const int j0 = tbk >= 8 ? tbk - 8 : 0; const bool act[2] = {true, true};
#define SWA_LOAD(j) do { const size_t rowk = tb + 64 * (j) + (tid >> 3); kr = *(const u32x4*)(KWb + rowk * 64 + (tid & 7) * 8); vr = *(const u32x4*)(PROJ + rowk * NPJ + 3136 + (tid & 7) * 8); } while (0)
        SWA_LOAD(j0);
        for (int j = j0; j <= tbk; ++j) {
            __syncthreads(); kv_store(Ks, Vs, tid, kr, vr); __syncthreads();
            if (j + 1 <= tbk) SWA_LOAD(j + 1);
            mw.k0 = 64 * j;
            if (j == tbk || j == tbk - 8) fa_tile<2, true>(sw, Q, Ks, Vs, lane, mw, act);
            else fa_tile<2, false>(sw, Q, Ks, Vs, lane, NoMask(), act);
        }
#undef SWA_LOAD
    }
    fa_finish<2>(sw, lse2);
#pragma unroll
    for (int q = 0; q < 2; ++q) {
        const size_t row = tb + mk.t[q]; const float* gp = GATE + row * 12 + head * 3; const float g0 = gp[0], g1 = gp[1], g2 = gp[2];
        f32x4 o[4]; float ss = 0.f; const float* pc = WSP(float, R_OCMP) + row * 256 + head * 64 + 4 * quad; const float* ps = WSP(float, R_OSLC) + row * 256 + head * 64 + 4 * quad;
#pragma unroll
        for (int d = 0; d < 4; ++d) { o[d] = *(const f32x4*)(pc + 16 * d) * g0 + *(const f32x4*)(ps + 16 * d) * g1 + sw.O[q][d] * g2; ss += (o[d][0] * o[d][0] + o[d][1] * o[d][1]) + (o[d][2] * o[d][2] + o[d][3] * o[d][3]); }
        ss += __shfl_xor(ss, 16); ss += __shfl_xor(ss, 32);
        const float rstd = rsqrtf(ss * (1.f / 64.f) + 1e-6f); const float* og = C.onorm_g + (size_t)l * 768 + 512 + head * 64 + 4 * quad;
        bf16* yo = YCAT + row * DM + 768 + head * 64 + 4 * quad;
#pragma unroll
        for (int d = 0; d < 4; ++d) { const f32x4 g4 = *(const f32x4*)(og + 16 * d); u32x2 wv; wv.x = pk2(o[d][0] * rstd * g4[0], o[d][1] * rstd * g4[1]); wv.y = pk2(o[d][2] * rstd * g4[2], o[d][3] * rstd * g4[3]); *(u32x2*)(yo + 16 * d) = wv; }
    }
}

DI void fin_phase(const Ctx& C, int l) {
    const float* SC = WSP(float, R_SC); const float* YA = WSP(float, R_YA); const float* Gb = WSP(float, R_G); const float* OC = WSP(float, R_OC); const float* LSE = WSP(float, R_LSE);
    bf16* YCAT = WSP(bf16, R_YCAT);
    const int lane = C.lane, gw = C.bid * NWAVE + C.wave, NGW = C.G * NWAVE, ch = 4 * lane, hh = lane >> 4;
    for (int row = gw; row < NT; row += NGW) {
        const size_t o = (size_t)row * 256 + ch;
        {
            const f32x4 y = *(const f32x4*)(YA + o), r = *(const f32x4*)(SC + (size_t)4 * NT * 256 + o), k = *(const f32x4*)(SC + (size_t)1 * NT * 256 + o), v = *(const f32x4*)(SC + (size_t)5 * NT * 256 + o), g = *(const f32x4*)(Gb + o);
            const f32x4 rk = *(const f32x4*)(C.rk + (size_t)l * 256 + ch), gw4 = *(const f32x4*)(C.gn_w + (size_t)l * 256 + ch), gb4 = *(const f32x4*)(C.gn_b + (size_t)l * 256 + ch);
            const float mu = group_sum<16>((y[0] + y[1]) + (y[2] + y[3])) * (1.f / 64.f);
            const f32x4 dy = y - mu; const float var = group_sum<16>((dy[0] * dy[0] + dy[1] * dy[1]) + (dy[2] * dy[2] + dy[3] * dy[3])) * (1.f / 64.f);
            const float rstd = rsqrtf(var + 64e-5f);
            const float dot = group_sum<16>((r[0] * k[0] * rk[0] + r[1] * k[1] * rk[1]) + (r[2] * k[2] * rk[2] + r[3] * k[3] * rk[3]));
            float out[4];
#pragma unroll
            for (int i = 0; i < 4; ++i) out[i] = ((dy[i] * rstd * gw4[i] + gb4[i]) + dot * v[i]) * g[i];
            u32x2 w; w.x = pk2(out[0], out[1]); w.y = pk2(out[2], out[3]); *(u32x2*)(YCAT + (size_t)row * DM + ch) = w;
        }
        {
            const float l0 = LSE[(size_t)row * 4 + hh], l1 = LSE[((size_t)NT + row) * 4 + hh], l2 = LSE[((size_t)2 * NT + row) * 4 + hh];
            const float mx = fmaxf(l0, fmaxf(l1, l2)); float w0 = fexp2(l0 - mx), w1 = fexp2(l1 - mx), w2 = fexp2(l2 - mx); const float inv = 1.f / (w0 + w1 + w2); w0 *= inv; w1 *= inv; w2 *= inv;
            const f32x4 a = *(const f32x4*)(OC + o), b = *(const f32x4*)(OC + (size_t)NT * 256 + o), c = *(const f32x4*)(OC + (size_t)2 * NT * 256 + o);
            const f32x4 y = a * w0 + b * w1 + c * w2;
            const float ss = group_sum<16>((y[0] * y[0] + y[1] * y[1]) + (y[2] * y[2] + y[3] * y[3])); const float rstd = rsqrtf(ss * (1.f / 64.f) + 1e-6f);
            const f32x4 og = *(const f32x4*)(C.onorm_g + (size_t)l * 768 + 256 + ch);
            u32x2 w; w.x = pk2(y[0] * rstd * og[0], y[1] * rstd * og[1]); w.y = pk2(y[2] * rstd * og[2], y[3] * rstd * og[3]); *(u32x2*)(YCAT + (size_t)row * DM + 512 + ch) = w;
        }
    }
}

constexpr int CW_Q = 40000;
DI int q_next(const Ctx& C, unsigned* ctr, LAS int* slot) {
    __syncthreads();
    if (C.tid == 0) *slot = (int)__hip_atomic_fetch_add(ctr, 1u, __ATOMIC_RELAXED, __HIP_MEMORY_SCOPE_AGENT);
    __syncthreads();
    return *slot;
}
DI void conv_ticket(const Ctx& C, int l, int tk);
DI void mix_phase(const Ctx& C, int l) {
    unsigned* ctl = WSP(unsigned, WS_CTL) + CW_Q + 64 * 3 * l; LAS int* slot = (LAS int*)(C.lds + MISC_OFF + 1024);
    if (C.bid < 64) scan_unit(C, C.bid);
    int bl = -1;
    for (;;) { const int u = q_next(C, ctl, slot); if (u >= 512) break; nsa_unit(C, l, u & 7, 63 - (u >> 3), bl); }
    for (;;) { const int u = q_next(C, ctl + 64, slot); if (u >= 1536) break; dil_unit(C, u, C.lds, C.lds + KT_BYTES); }
    for (;;) { const int u = q_next(C, ctl + 128, slot); if (u >= 768) break; conv_ticket(C, l, u); }
    __syncthreads();
}
#define MFMA_F32(a, b, c) __builtin_amdgcn_mfma_f32_16x16x4f32((a), (b), (c), 0, 0, 0)
DI void router_phase(const Ctx& C, int l) {
    const float* X = C.out; const float* MOD = WSP(float, WS_SMALL) + (size_t)l * 8 * 6144; bf16* H = WSP(bf16, WS_H);
    int* TOPE = WSP(int, WS_ROUTE); float* TOPG = (float*)(TOPE + NT * 4); unsigned* CNTB = WSP(unsigned, WS_CTL) + CW_CNT + l * 8192;
    LAS float* lg = (LAS float*)C.lds + C.wave * 512;
    LAS unsigned* hist = (LAS unsigned*)(C.lds + 16384);
    const int lane = C.lane, l15 = lane & 15, quad = lane >> 4, gw = C.bid * NWAVE + C.wave, NGW = C.G * NWAVE;
    if (C.tid < 32) hist[C.tid] = 0u;
    __syncthreads();
    const float* wr = C.w_router + (size_t)l * 1024 * 32; const float* g2 = C.norm2_g + (size_t)l * DM;
    for (int task = gw; task < NT / 16; task += NGW) {
        const int row0 = 16 * task, b = row0 / NS; const float* xr = X + (size_t)(row0 + l15) * DM + 4 * quad;
        const float* sh = MOD + (size_t)b * 6144 + 3072 + 4 * quad; const float* sc = sh + 1024;
        float ss = 0.f;
#pragma unroll 8
        for (int i = 0; i < 64; ++i) { const f32x4 a = *(const f32x4*)(xr + 16 * i); ss += (a[0] * a[0] + a[1] * a[1]) + (a[2] * a[2] + a[3] * a[3]); }
        ss += __shfl_xor(ss, 16); ss += __shfl_xor(ss, 32);
        const float rstd = rsqrtf(ss * (1.f / DM) + 1e-6f);
        f32x4 acc0 = (f32x4){0.f, 0.f, 0.f, 0.f}, acc1 = acc0;
        bf16* hrow = H + (size_t)(row0 + l15) * DM + 4 * quad;
#pragma unroll 2
        for (int i = 0; i < 64; ++i) {
            const f32x4 a = *(const f32x4*)(xr + 16 * i), g = *(const f32x4*)(g2 + 16 * i + 4 * quad), s1 = *(const f32x4*)(sc + 16 * i), s0 = *(const f32x4*)(sh + 16 * i);
            f32x4 h;
#pragma unroll
            for (int j = 0; j < 4; ++j) h[j] = a[j] * rstd * g[j] * (1.f + s1[j]) + s0[j];
            u32x2 o; o.x = pk2(h[0], h[1]); o.y = pk2(h[2], h[3]); *(u32x2*)(hrow + 16 * i) = o;
            const float* wp = wr + (size_t)(16 * i + 4 * quad) * 32 + l15;
#pragma unroll
            for (int j = 0; j < 4; ++j) { acc0 = MFMA_F32(h[j], wp[j * 32], acc0); acc1 = MFMA_F32(h[j], wp[j * 32 + 16], acc1); }
        }
        const float b0 = C.b_router[l * 32 + l15], b1 = C.b_router[l * 32 + 16 + l15];
#pragma unroll
        for (int j = 0; j < 4; ++j) { lg[(4 * quad + j) * 32 + l15] = acc0[j] + b0; lg[(4 * quad + j) * 32 + 16 + l15] = acc1[j] + b1; }
        asm volatile("s_waitcnt lgkmcnt(0)" ::: "memory");
        if (lane < 16) {
            float v[32];
#pragma unroll
            for (int i = 0; i < 8; ++i) { const f32x4 a = *(const LAS f32x4*)(lg + lane * 32 + 4 * i); v[4 * i] = a[0]; v[4 * i + 1] = a[1]; v[4 * i + 2] = a[2]; v[4 * i + 3] = a[3]; }
            float tv[4]; int ti[4];
#pragma unroll
            for (int r = 0; r < 4; ++r) { float bv = -3.0e38f; int bi = 0;
#pragma unroll
                for (int e = 0; e < 32; ++e) if (v[e] > bv) { bv = v[e]; bi = e; }
                tv[r] = bv; ti[r] = bi;
#pragma unroll
                for (int e = 0; e < 32; ++e) v[e] = (e == bi) ? -3.0e38f : v[e]; }
            const float e1 = __expf(tv[1] - tv[0]), e2 = __expf(tv[2] - tv[0]), e3 = __expf(tv[3] - tv[0]), inv = 1.f / (1.f + e1 + e2 + e3);
            const int row = row0 + lane;
            *(int4*)(TOPE + (size_t)row * 4) = make_int4(ti[0], ti[1], ti[2], ti[3]);
            *(f32x4*)(TOPG + (size_t)row * 4) = (f32x4){inv, e1 * inv, e2 * inv, e3 * inv};
#pragma unroll
            for (int r = 0; r < 4; ++r) __hip_atomic_fetch_add(&hist[ti[r]], 1u, __ATOMIC_RELAXED, __HIP_MEMORY_SCOPE_WORKGROUP);
        }
        asm volatile("s_waitcnt lgkmcnt(0)" ::: "memory");
    }
    __syncthreads();
    if (C.tid < 32) CNTB[C.bid * 32 + C.tid] = hist[C.tid];
}

DI void moe_tables(const Ctx& C, int l, LAS int* tab) {
    const unsigned* CNTB = WSP(unsigned, WS_CTL) + CW_CNT + l * 8192;
    __syncthreads();
    if (C.tid < 32) { unsigned tot = 0u, mine = 0u;
        for (int g = 0; g < C.G; ++g) { const unsigned c = CNTB[g * 32 + C.tid]; tot += c; mine += (g < C.bid) ? c : 0u; }
        tab[128 + C.tid] = (int)((tot + 255u) >> 8); tab[64 + C.tid] = (int)mine; }
    __syncthreads();
    if (C.tid == 0) { int s = 0; for (int e = 0; e < 32; ++e) { tab[e] = s; s += tab[128 + e]; } tab[32] = s; }
    __syncthreads();
}
DI void scatter_phase(const Ctx& C, int l) {
    const bf16* H = WSP(bf16, WS_H); bf16* XS = WSP(bf16, R_XS); const int* TOPE = WSP(int, WS_ROUTE); int* POS = (int*)(TOPE + NT * 8);
    LAS int* tab = (LAS int*)(C.lds + MISC_OFF + 64); LAS unsigned* cur = (LAS unsigned*)(C.lds + 16384);
    moe_tables(C, l, tab);
    if (C.tid < 32) cur[C.tid] = (unsigned)(tab[C.tid] * 256 + tab[64 + C.tid]);
    __syncthreads();
    const int lane = C.lane, gw = C.bid * NWAVE + C.wave, NGW = C.G * NWAVE;
    for (int task = gw; task < NT / 16; task += NGW) {
        const int row0 = 16 * task, tok = row0 + (lane >> 2);
        const int e = TOPE[(size_t)tok * 4 + (lane & 3)];
        const int slot = (int)__hip_atomic_fetch_add(&cur[e], 1u, __ATOMIC_RELAXED, __HIP_MEMORY_SCOPE_WORKGROUP);
        POS[(size_t)tok * 4 + (lane & 3)] = slot;
#pragma unroll 4
        for (int p = 0; p < 64; ++p) { const int dst = __shfl(slot, p); const bf16* src = H + (size_t)(row0 + (p >> 2)) * DM + lane * 8; bf16* d = XS + (size_t)dst * DM + lane * 8;
            const u32x4 a = *(const u32x4*)src, b2 = *(const u32x4*)(src + 512); *(u32x4*)d = a; *(u32x4*)(d + 512) = b2; }
    }
}
DI void combine_phase(const Ctx& C, int l) {
    const bf16* YB = WSP(bf16, R_YB); const int* TOPE = WSP(int, WS_ROUTE); const float* TOPG = (const float*)(TOPE + NT * 4); const int* POS = (const int*)(TOPE + NT * 8);
    const float* MOD = WSP(float, WS_SMALL) + (size_t)l * 8 * 6144; bf16* H = WSP(bf16, WS_H);
    const int lane = C.lane, gw = C.bid * NWAVE + C.wave, NGW = C.G * NWAVE;
    for (int row = gw; row < NT; row += NGW) {
        const int b = row / NS; const int4 ps = *(const int4*)(POS + (size_t)row * 4); const f32x4 gk = *(const f32x4*)(TOPG + (size_t)row * 4);
        const int pp[4] = {ps.x, ps.y, ps.z, ps.w};
        float* orow = C.out + (size_t)row * DM; const float* gt = MOD + (size_t)b * 6144 + 5120;
        f32x4 v[4]; float s = 0.f;
#pragma unroll
        for (int j = 0; j < 4; ++j) { const int k = 4 * lane + 256 * j; f32x4 a = (f32x4){0.f, 0.f, 0.f, 0.f};
#pragma unroll
            for (int q = 0; q < 4; ++q) { const u32x2 y = *(const u32x2*)(YB + (size_t)pp[q] * DM + k); a += (f32x4){bflo(y.x), bfhi(y.x), bflo(y.y), bfhi(y.y)} * gk[q]; }
            v[j] = *(const f32x4*)(orow + k) + *(const f32x4*)(gt + k) * a; *(f32x4*)(orow + k) = v[j];
            s += (v[j][0] * v[j][0] + v[j][1] * v[j][1]) + (v[j][2] * v[j][2] + v[j][3] * v[j][3]); }
        if (l + 1 < NLAYER) {
            s = group_sum<64>(s); const float rstd = rsqrtf(s * (1.f / DM) + 1e-6f); const float* M2 = MOD + 8 * 6144 + (size_t)b * 6144; const float* g = C.norm1_g + (size_t)(l + 1) * DM;
#pragma unroll
            for (int j = 0; j < 4; ++j) { const int k = 4 * lane + 256 * j; const f32x4 gg = *(const f32x4*)(g + k), a = *(const f32x4*)(M2 + 1024 + k), bb = *(const f32x4*)(M2 + k); f32x4 h;
#pragma unroll
                for (int i = 0; i < 4; ++i) h[i] = v[j][i] * rstd * gg[i] * (1.f + a[i]) + bb[i];
                u32x2 o; o.x = pk2(h[0], h[1]); o.y = pk2(h[2], h[3]); *(u32x2*)(H + (size_t)row * DM + k) = o; }
        }
    }
}
constexpr int PH_PER_LAYER = 11, PH_BASE = 2, N_PHASES = PH_BASE + NLAYER * PH_PER_LAYER;
#ifndef MK_ONE_LAUNCH
#define MK_ONE_LAUNCH 1
#endif
__global__ void __launch_bounds__(NTHR, 2) mk_fwd(Args args) {
    extern __shared__ __attribute__((aligned(16))) unsigned char lds_raw[];
    Ctx C;
    C.lds = (LAS unsigned char*)lds_raw; C.tid = threadIdx.x; C.lane = C.tid & 63; C.wave = __builtin_amdgcn_readfirstlane(C.tid >> 6); C.G = gridDim.x; C.bid = blockIdx.x;
    C.x = (const float*)args.in[0]; C.c = (const float*)args.in[1]; C.pos = (const int*)args.in[2]; C.w_ada = (const float*)args.in[3]; C.b_ada = (const float*)args.in[4];
    C.norm1_g = (const float*)args.in[5]; C.norm2_g = (const float*)args.in[6]; C.w_in = (const float*)args.in[7]; C.w_out = (const float*)args.in[8]; C.mu = (const float*)args.in[9];
    C.w0 = (const float*)args.in[10]; C.w2 = (const float*)args.in[11]; C.a0 = (const float*)args.in[12]; C.a2 = (const float*)args.in[13]; C.g2 = (const float*)args.in[14];
    C.kkw = (const float*)args.in[15]; C.ka = (const float*)args.in[16]; C.rk = (const float*)args.in[17]; C.gn_w = (const float*)args.in[18]; C.gn_b = (const float*)args.in[19];
    C.conv_w = (const float*)args.in[20]; C.dil_q_g = (const float*)args.in[21]; C.dil_k_g = (const float*)args.in[22]; C.nsa_q_g = (const float*)args.in[23]; C.nsa_kc_g = (const float*)args.in[24];
    C.nsa_ks_g = (const float*)args.in[25]; C.nsa_kw_g = (const float*)args.in[26]; C.pe_k = (const float*)args.in[27]; C.pe_v = (const float*)args.in[28]; C.wk1 = (const float*)args.in[29];
    C.wk2 = (const float*)args.in[30]; C.wv1 = (const float*)args.in[31]; C.wv2 = (const float*)args.in[32]; C.onorm_g = (const float*)args.in[33]; C.w_router = (const float*)args.in[34];
    C.b_router = (const float*)args.in[35]; C.w_gu = (const float*)args.in[36]; C.b_gu = (const float*)args.in[37]; C.w_down = (const float*)args.in[38]; C.b_down = (const float*)args.in[39];
    C.out = args.out; C.ws = args.ws;
    const int lo = args.ph_lo, hi = args.ph_hi;
    for (int u = C.tid; u < (LDS_BYTES - MISC_OFF) / 4; u += NTHR) ((LAS unsigned*)(C.lds + MISC_OFF))[u] = 0u;
    __syncthreads();
    XcdBarrier bar; bar.bar = WSP(unsigned, WS_CTL) + CW_BAR; bar.x = 0; bar.st = nullptr;
    if (hi - lo > 1) bar = xcd_barrier_post(WSP(unsigned, WS_CTL) + CW_BAR, (volatile LAS unsigned*)(C.lds + MISC_OFF));
#ifndef PHMASK
#define PHMASK 0xFFFFFFFFu
#endif
#define PHON(n) (((PHMASK) >> (n)) & 1u)
#ifndef PHREP
#define PHREP 0u
#endif
#define NREP(n) (1 + (int)(((PHREP) >> (n)) & 1u))
#define WSPP(T, off) ((T*)(P.ws + (off)))
#define IN(k) (lo <= (k) && (k) < hi)
#define SEAM(k) do { if (IN(k) && IN((k) + 1)) xcd_barrier(bar); } while (0)
#define PCTX Ctx P = C; asm volatile("" : "+v"(P.tid), "+v"(P.lane)); asm volatile("" : "+s"(P.ws), "+s"(P.out), "+s"(P.wave), "+s"(P.bid))
    if (PHON(17) && IN(0)) for (int rep = 0; rep < NREP(17); ++rep) { PCTX; p0_prologue(P); __syncthreads(); }
    SEAM(0);
    if (PHON(18) && IN(1)) { PCTX; norm1_phase(P, 0, P.x); }
    SEAM(1);
    for (int l = 0; l < NLAYER; ++l) {
        const int pb = PH_BASE + PH_PER_LAYER * l;
        if (PHON(0) && IN(pb + 0)) for (int rep = 0; rep < NREP(0); ++rep) { PCTX;
            pg8::Gemm g{WSPP(bf16, WS_H), WSPP(bf16, WS_WIN) + (size_t)l * NPJ * 1024, 1024, 1024}; pg8::StaticOrder S; S.init(NT / 256, NPJ / 256, P.G, P.bid);
            EpiProj E{WSPP(bf16, R_PROJ)}; pg8::gemm_phase(P.lds, P.tid, g, S, E);
        }
        SEAM(pb + 0);
        if (PHON(1) && IN(pb + 1)) for (int rep = 0; rep < NREP(1); ++rep) { PCTX; prep_phase(P, l); __syncthreads(); }
        SEAM(pb + 1);
        if (PHON(2) && IN(pb + 2)) { PCTX;
            { pg8::Gemm g{WSPP(bf16, R_LIN), WSPP(bf16, WS_LORA) + (size_t)l * 768 * 256, 256, 256}; pg8::StaticOrder S; S.init(NT / 256, 3, P.G, P.bid);
              EpiLora E{WSPP(float, R_SC), WSPP(float, R_G), P.w0 + l * 256, P.a0 + l * 256, P.ka + l * 256}; pg8::gemm_phase(P.lds, P.tid, g, S, E); }
            { pg8::Gemm g{WSPP(bf16, R_KCR), WSPP(bf16, WS_WK1) + (size_t)(l * 2) * 256 * 2048, 1024, 2048}; pg8::StaticOrder S; S.init(8, 1, P.G, (P.bid + 64) % P.G);
              EpiC1 E{WSPP(bf16, R_CH1), (WSPP(float, WS_SMALL) + NLAYER * 8 * 6144 + l * 512)}; pg8::gemm_phase(P.lds, P.tid, g, S, E); }
            { pg8::Gemm g{WSPP(bf16, R_VCR), WSPP(bf16, WS_WK1) + (size_t)(l * 2 + 1) * 256 * 2048, 1024, 2048}; pg8::StaticOrder S; S.init(8, 1, P.G, (P.bid + 128) % P.G);
              EpiC1 E{WSPP(bf16, R_CH1) + 2048 * 256, (WSPP(float, WS_SMALL) + NLAYER * 8 * 6144 + l * 512 + 256)}; pg8::gemm_phase(P.lds, P.tid, g, S, E); }
            asm volatile("s_waitcnt vmcnt(0)" ::: "memory"); __syncthreads();
            { pg8::Gemm g{WSPP(bf16, R_CH1), WSPP(bf16, WS_WK2) + (size_t)(l * 2) * 256 * 256, 256, 256}; pg8::StaticOrder S; S.init(8, 1, P.G, (P.bid + 64) % P.G);
              EpiC2 E{WSPP(float, R_CMP)}; pg8::gemm_phase(P.lds, P.tid, g, S, E); }
            { pg8::Gemm g{WSPP(bf16, R_CH1) + 2048 * 256, WSPP(bf16, WS_WK2) + (size_t)(l * 2 + 1) * 256 * 256, 256, 256}; pg8::StaticOrder S; S.init(8, 1, P.G, (P.bid + 128) % P.G);
              EpiC2 E{WSPP(float, R_CMP) + 2048 * 64}; pg8::gemm_phase(P.lds, P.tid, g, S, E); }
        }
        SEAM(pb + 2);
        if (PHON(3) && IN(pb + 3)) { PCTX; mix_phase(P, l); }
        SEAM(pb + 3);
        if (PHON(4) && IN(pb + 4)) for (int rep = 0; rep < NREP(4); ++rep) { PCTX; fin_phase(P, l); __syncthreads(); }
        SEAM(pb + 4);
        if (PHON(5) && IN(pb + 5)) { PCTX;
            pg8::Gemm g{WSPP(bf16, R_YCAT), WSPP(bf16, WS_WOUT) + (size_t)l * 1024 * 1024, 1024, 1024}; pg8::StaticOrder S; S.init(NT / 256, 4, P.G, P.bid);
            EpiOut E{P.out, l == 0 ? P.x : (const float*)P.out, WSPP(float, WS_SMALL) + (size_t)l * 8 * 6144 + 2048}; pg8::gemm_phase(P.lds, P.tid, g, S, E);
        }
        SEAM(pb + 5);
        if (PHON(6) && IN(pb + 6)) for (int rep = 0; rep < NREP(6); ++rep) { PCTX; router_phase(P, l); __syncthreads(); }
        SEAM(pb + 6);
        if (PHON(7) && IN(pb + 7)) for (int rep = 0; rep < NREP(7); ++rep) { PCTX; scatter_phase(P, l); __syncthreads(); }
        SEAM(pb + 7);
        if (PHON(8) && IN(pb + 8)) for (int rep = 0; rep < NREP(8); ++rep) { PCTX;
            LAS int* tab = (LAS int*)(P.lds + MISC_OFF + 64); moe_tables(P, l, tab);
            pg8::Gemm g{WSPP(bf16, R_XS), WSPP(bf16, WS_WGU) + (size_t)l * 32 * 2048 * 1024, 1024, 1024}; pg8::GroupedOrder S; S.init(tab[32], 8, P.G, P.bid); S.tstart = tab; S.nrow_e = 2048;
            EpiGU E{WSPP(bf16, R_ACT), P.b_gu + (size_t)l * 32 * 2048}; pg8::gemm_phase(P.lds, P.tid, g, S, E);
        }
        SEAM(pb + 8);
        if (PHON(9) && IN(pb + 9)) for (int rep = 0; rep < NREP(9); ++rep) { PCTX;
            LAS int* tab = (LAS int*)(P.lds + MISC_OFF + 64); moe_tables(P, l, tab);
            pg8::Gemm g{WSPP(bf16, R_ACT), WSPP(bf16, WS_WDN) + (size_t)l * 32 * 1024 * 1024, 1024, 1024}; pg8::GroupedOrder S; S.init(tab[32], 4, P.G, P.bid); S.tstart = tab; S.nrow_e = 1024;
            EpiDN E{WSPP(bf16, R_YB), P.b_down + (size_t)l * 32 * 1024}; pg8::gemm_phase(P.lds, P.tid, g, S, E);
        }
        SEAM(pb + 9);
        if (PHON(10) && IN(pb + 10)) { PCTX; combine_phase(P, l); }
        SEAM(pb + 10);
    }
#undef IN
#undef SEAM
}

extern "C" void kernel_launch(void* const* d_in, const int* in_sizes, int n_in, void* d_out, int out_size, void* d_ws, size_t ws_size, hipStream_t stream) {
    static int grid = 0;
    if (grid == 0) {
        if (n_in != 40 || out_size != NT * DM || ws_size < WS_END) { fprintf(stderr, "kernel_launch: unexpected problem (n_in %d, out %d, ws %zu < %zu)\n", n_in, out_size, ws_size, (size_t)WS_END); grid = -1; return; }
        int dev = 0, cus = 0, per_cu = 0;
        if (hipGetDevice(&dev) != hipSuccess || hipDeviceGetAttribute(&cus, hipDeviceAttributeMultiprocessorCount, dev) != hipSuccess) { grid = -1; return; }
        if (hipFuncSetAttribute((const void*)mk_fwd, hipFuncAttributeMaxDynamicSharedMemorySize, LDS_BYTES) != hipSuccess) { fprintf(stderr, "kernel_launch: hipFuncSetAttribute failed\n"); grid = -1; return; }
        if (hipOccupancyMaxActiveBlocksPerMultiprocessor(&per_cu, (const void*)mk_fwd, NTHR, LDS_BYTES) != hipSuccess || per_cu < 1) fprintf(stderr, "kernel_launch: occupancy query says %d blocks per CU\n", per_cu);
        (void)hipGetLastError();
        grid = cus > 256 ? 256 : cus;
    }
    if (grid < 0) return;
    (void)hipMemsetAsync((char*)d_ws, 0, ZERO_BYTES, stream);
    Args a{};
    for (int i = 0; i < 40; ++i) a.in[i] = d_in[i];
    a.out = (float*)d_out; a.ws = (unsigned char*)d_ws;
#if MK_ONE_LAUNCH
    a.ph_lo = 0; a.ph_hi = N_PHASES;
    hipLaunchKernelGGL(mk_fwd, dim3(grid), dim3(NTHR), LDS_BYTES, stream, a);
#else
    for (int p = 0; p < N_PHASES; ++p) { a.ph_lo = p; a.ph_hi = p + 1; hipLaunchKernelGGL(mk_fwd, dim3(grid), dim3(NTHR), LDS_BYTES, stream, a); }
#endif
    const hipError_t le = hipPeekAtLastError();
    if (le != hipSuccess) fprintf(stderr, "kernel_launch: launch failed: %s\n", hipGetErrorName(le));
}
```

```cpp
#include <hip/hip_runtime.h>
#include <cstdio>
#include <cstdint>

#define DI __device__ __forceinline__
#define LAS __attribute__((address_space(3)))
#define GAS __attribute__((address_space(1)))
typedef unsigned short bf16;
typedef short bf16x8 __attribute__((ext_vector_type(8)));
typedef float f32x4 __attribute__((ext_vector_type(4)));
typedef float f32x2 __attribute__((ext_vector_type(2)));
typedef unsigned u32x4 __attribute__((ext_vector_type(4)));
typedef unsigned u32x2 __attribute__((ext_vector_type(2)));
typedef unsigned char uchar;

constexpr int NB = 8, NS = 4096, NT = NB * NS, DM = 1024, NPJ = 3328, NE = 32, FF = 1024, NLAYER = 2;
constexpr int PJ_A = 0, PJ_B = 1024, PJ_C = 1792, PJ_D = 2560;
constexpr int NR = NT * 4 + NE * 256;
constexpr int NTHR = 512, NWAVE = 8;

DI float bf2f(unsigned v) { return __builtin_bit_cast(float, v << 16); }
DI unsigned f2bf(float f) { unsigned u = __builtin_bit_cast(unsigned, f); return (u + 0x7fffu + ((u >> 16) & 1u)) >> 16; }
DI unsigned pk2(float lo, float hi) { return f2bf(lo) | (f2bf(hi) << 16); }
DI float bflo(unsigned w) { return __builtin_bit_cast(float, w << 16); }
DI float bfhi(unsigned w) { return __builtin_bit_cast(float, w & 0xffff0000u); }
DI float fexp2(float x) { return __builtin_amdgcn_exp2f(x); }
DI float fsigmoid(float x) { return 1.f / (1.f + __expf(-x)); }
DI float wsum_xor(float v, int o) { return v + __shfl_xor(v, o); }
template <int W> DI float group_sum(float v) {
#pragma unroll
    for (int o = 1; o < W; o <<= 1) v += __shfl_xor(v, o);
    return v;
}
DI float dpp_f(float x, const int ctrl_dummy);
template <int CTRL> DI float dppmov(float x) { return __builtin_bit_cast(float, __builtin_amdgcn_update_dpp(0, __builtin_bit_cast(int, x), CTRL, 0xF, 0xF, true)); }
DI float sum8(float x) { x += dppmov<0xB1>(x); x += dppmov<0x4E>(x); x += dppmov<0x141>(x); return x; }

#define XB_TMO      128
#define XB_XCNT(j)  (256  + 64 * (j))
#define XB_XSUB(j)  (1280 + 64 * (j))
#define XB_XGEN(j)  (2304 + 64 * (j))
#define XB_TOP      3328
#define XB_TOPGEN   3392
#define XCD_BAR_WORDS 3456
#define XB_SPIN_CAP (1u << 18)
DI unsigned xb_ld(unsigned* p)              { return __hip_atomic_load(p, __ATOMIC_RELAXED, __HIP_MEMORY_SCOPE_AGENT); }
DI unsigned xb_add(unsigned* p, unsigned v) { return __hip_atomic_fetch_add(p, v, __ATOMIC_RELAXED, __HIP_MEMORY_SCOPE_AGENT); }
DI unsigned xb_xcc_id() { return (unsigned)__builtin_amdgcn_s_getreg((3 << 11) | 20) & 0xFu; }
#define XB_SPIN(cond, bar) do { unsigned _sp = 0; while (cond) { __builtin_amdgcn_s_sleep(1); \
    if ((++_sp & 255u) == 0u) { if (xb_ld(&(bar)[XB_TMO])) break; if (_sp > XB_SPIN_CAP) { atomicAdd(&(bar)[XB_TMO], 1u); break; } } } } while (0)
struct XcdBarrier { unsigned* bar; unsigned x; volatile LAS unsigned* st; };
DI XcdBarrier xcd_barrier_post(unsigned* bar, volatile LAS unsigned* st) {
    XcdBarrier b; b.bar = bar; b.x = xb_xcc_id(); b.st = st;
    if (threadIdx.x == 0) (void)xb_add(&bar[XB_XCNT(b.x)], 1u);
    return b;
}
DI void xcd_barrier_complete(unsigned* bar, unsigned x, unsigned& nloc, unsigned& nx) {
    const unsigned G = gridDim.x * gridDim.y * gridDim.z;
    unsigned sum, cnt, mine, sp = 0u;
    for (;;) {
        sum = 0u; cnt = 0u; mine = 0u;
#pragma unroll
        for (unsigned j = 0; j < 16; ++j) { const unsigned c = xb_ld(&bar[XB_XCNT(j)]); sum += c; cnt += (c > 0u) ? 1u : 0u; mine = (j == x) ? c : mine; }
        if (sum == G) break;
        __builtin_amdgcn_s_sleep(1);
        if ((++sp & 255u) == 0u) { if (xb_ld(&bar[XB_TMO])) break; if (sp > XB_SPIN_CAP) { atomicAdd(&bar[XB_TMO], 1u); break; } }
    }
    nloc = mine > 0u ? mine : 1u; nx = cnt > 0u ? cnt : 1u;
}
DI void xcd_barrier(const XcdBarrier& b) {
    asm volatile("s_waitcnt vmcnt(0)" ::: "memory");
    __syncthreads();
    if (threadIdx.x == 0) {
        unsigned* bar = b.bar;
        __builtin_amdgcn_s_waitcnt(0);
        unsigned nloc = b.st[0], nx = b.st[1];
        if (nloc == 0u) { xcd_barrier_complete(bar, b.x, nloc, nx); b.st[0] = nloc; b.st[1] = nx; }
        const unsigned old = xb_add(&bar[XB_XSUB(b.x)], 1u);
        const unsigned gen = old / nloc;
        if (old + 1u == (gen + 1u) * nloc) {
            __builtin_amdgcn_fence(__ATOMIC_RELEASE, "agent");
            asm volatile("s_waitcnt vmcnt(0)" ::: "memory");
            const unsigned og = xb_add(&bar[XB_TOP], 1u);
            const unsigned tg = og / nx;
            if (og + 1u == (tg + 1u) * nx) xb_add(&bar[XB_TOPGEN], 1u);
            else XB_SPIN(xb_ld(&bar[XB_TOPGEN]) == tg, bar);
            __builtin_amdgcn_fence(__ATOMIC_ACQUIRE, "agent");
            xb_add(&bar[XB_XGEN(b.x)], 1u);
            asm volatile("s_waitcnt vmcnt(0)" ::: "memory");
        } else {
            XB_SPIN(xb_ld(&bar[XB_XGEN(b.x)]) == gen, bar);
            __builtin_amdgcn_fence(__ATOMIC_ACQUIRE, "agent");
            asm volatile("s_waitcnt vmcnt(0)" ::: "memory");
        }
    }
    __syncthreads();
}
namespace pg8 {
constexpr int BM = 256, BK = 64, HALF = 128, HTB = HALF * BK * 2, STAGE_BYTES = 8 * HTB, NXCD = 8, WGM = 8;
__host__ __device__ __forceinline__ int lds_byte(int r, int c) { const int st = (r >> 4) * 2 + (c >> 5), rr = r & 15, cc = c & 31, ob = rr * 64 + cc * 2; return st * 1024 + (ob ^ (((ob >> 9) & 1) << 5)); }
__host__ __device__ __forceinline__ void stage_rc(int b, int& R, int& C) { const int st = b / 1024, sb = b % 1024, swz = sb ^ (((sb >> 9) & 1) << 5); R = (st >> 1) * 16 + swz / 64; C = (st & 1) * 32 + (swz % 64) / 2; }
__host__ __device__ __forceinline__ int perm32(int rho) { const int n = rho >> 4, i = rho & 15; return 8 * (i >> 2) + 4 * n + (i & 3); }

struct Unit { int pm, pn, brow, e; };
struct Gemm { const bf16* A; const bf16* Bt; int lda, K; const int* rowmap; };

struct StaticOrder {
    int nM, nN, nwg, G, c;
    __device__ void init(int nM_, int nN_, int G_, int c_) { nM = nM_; nN = nN_; nwg = nM * nN; G = G_; c = c_; }
    __device__ bool tile(int i, int& pm, int& pn) const {
        const long L = (long)i * G + c; if (L >= nwg) return false;
        int wgid = (int)L; { const int q = nwg / NXCD, r = nwg % NXCD, xcd = wgid % NXCD, off = wgid / NXCD; wgid = (xcd < r ? xcd * (q + 1) : r * (q + 1) + (xcd - r) * q) + off; }
        const int nig = WGM * nN, gid = wgid / nig, fm = gid * WGM, gsz = (nM - fm) < WGM ? (nM - fm) : WGM;
        pm = fm + ((wgid % nig) % gsz); pn = (wgid % nig) / gsz; return true;
    }
    __device__ bool next(int i, Unit& u) const { if (!tile(i, u.pm, u.pn)) return false; u.brow = u.pn * BM; u.e = 0; return true; }
};
struct GroupedOrder : StaticOrder {
    const LAS int* tstart; int nrow_e;
    __device__ bool next(int i, Unit& u) const {
        if (!tile(i, u.pm, u.pn)) return false;
        int e = 0;
#pragma unroll 1
        for (int j = 16; j > 0; j >>= 1) if (tstart[e + j] <= u.pm) e += j;
        u.e = e; u.brow = e * nrow_e + u.pn * BM; return true;
    }
};
DI unsigned cvt_pk_bf16(float lo, float hi) { unsigned r; asm volatile("v_cvt_pk_bf16_f32 %0, %1, %2" : "=v"(r) : "v"(lo), "v"(hi)); return r; }

template <class Epi, class Sched, bool GATHER = false>
DI void gemm_phase(LAS unsigned char* lds, const int tid, const Gemm g, const Sched& S, const Epi& E) {
    const int wid = __builtin_amdgcn_readfirstlane(tid >> 6), lane = tid & 63, wr = wid >> 2, wc = wid & 3, fr = lane & 15, fq = lane >> 4;
    int K = g.K, lda = g.lda; asm volatile("" : "+s"(K), "+s"(lda));
    const int nt = K / BK;
    unsigned voffA[2], voffB[2]; int Ra[2], Ca[2];
#pragma unroll
    for (int i = 0; i < 2; ++i) { int R, C; stage_rc(tid * 16 + i * 8192, R, C); const int Rb = Epi::PERM ? ((R & ~31) + perm32(R & 31)) : R; Ra[i] = R; Ca[i] = C;
        voffA[i] = (unsigned)(R * lda + C) * 2u; voffB[i] = (unsigned)(Rb * K + C) * 2u; }
    unsigned vgc[2][2]; int rawn[2][2];
#define PG8_GLOAD(dst, pm_) do { _Pragma("unroll") for (int _h = 0; _h < 2; ++_h) _Pragma("unroll") for (int _i = 0; _i < 2; ++_i) { const int* _p = g.rowmap + (size_t)(pm_) * BM + _h * HALF + Ra[_i]; \
        asm volatile("global_load_dword %0, %1, off" : "=v"(dst[_h][_i]) : "v"(_p) : "memory"); } } while (0)
#define PG8_GCONV(vg, raw) do { _Pragma("unroll") for (int _h = 0; _h < 2; ++_h) _Pragma("unroll") for (int _i = 0; _i < 2; ++_i) { int _r = raw[_h][_i]; asm volatile("" : "+v"(_r)); \
        vg[_h][_i] = (unsigned)((_r & 32767) * lda + Ca[_i]) * 2u; } } while (0)
#define PG8_STAGE_A(bufoff, kptr, h, vg) do { if (GATHER) PG8_STAGE(bufoff, kptr, vg[h]); else PG8_STAGE(bufoff, (kptr) + (h) * hstepA, voffA); } while (0)
    const size_t kstep = (size_t)(BK * 2);
    const size_t hstepA = (size_t)HALF * lda * 2, hstepB = (size_t)HALF * K * 2;
    const size_t tstepA = 2 * hstepA;
    const unsigned ldsw = (unsigned)wid * 1024u;
    const int aoff = lds_byte(wr * 64 + fr, fq * 8), boff = lds_byte(wc * 32 + fr, fq * 8);
#define PG8_SA(b, h) (((b) * 2 + (h)) * HTB)
#define PG8_SB(b, h) ((4 + (b) * 2 + (h)) * HTB)
#define PG8_STAGE(bufoff, gbase, voff) do { _Pragma("unroll") for (int _i = 0; _i < 2; ++_i) \
        __builtin_amdgcn_global_load_lds((const unsigned*)((const char*)(gbase) + (voff)[_i]), (LAS unsigned*)(lds + (bufoff) + ldsw + _i * 8192), 16, 0, 0); } while (0)
#define PG8_LDA(dst, b, h) do { _Pragma("unroll") for (int m = 0; m < 4; ++m) _Pragma("unroll") for (int k = 0; k < 2; ++k) dst[m][k] = *(const LAS bf16x8*)(lds + PG8_SA(b, h) + aoff + m * 2048 + k * 1024); } while (0)
#define PG8_LDB(dst, b, h) do { _Pragma("unroll") for (int n = 0; n < 2; ++n) _Pragma("unroll") for (int k = 0; k < 2; ++k) dst[n][k] = *(const LAS bf16x8*)(lds + PG8_SB(b, h) + boff + n * 2048 + k * 1024); } while (0)
#define PG8_MMA(ai, bj, At, Bt) do { __builtin_amdgcn_s_setprio(1); _Pragma("unroll") for (int m = 0; m < 4; ++m) _Pragma("unroll") for (int n = 0; n < 2; ++n) _Pragma("unroll") for (int k = 0; k < 2; ++k) \
        acc[ai][bj][m][n] = __builtin_amdgcn_mfma_f32_16x16x32_bf16(Bt[n][k], At[m][k], acc[ai][bj][m][n], 0, 0, 0); __builtin_amdgcn_s_setprio(0); } while (0)
#define PG8_WAIT_V(n) asm volatile("s_waitcnt vmcnt(" #n ")" ::: "memory")
#define PG8_WAIT_L(n) asm volatile("s_waitcnt lgkmcnt(" #n ")" ::: "memory")
#define PG8_BAR __builtin_amdgcn_s_barrier()
#define PG8_SCHED __builtin_amdgcn_sched_barrier(0)
    Unit cur, nxt; int ui = 0;
    if (!S.next(0, cur)) return;
    f32x4 acc[2][2][4][2];
#pragma unroll
    for (int a = 0; a < 2; ++a)
#pragma unroll
        for (int b = 0; b < 2; ++b)
#pragma unroll
            for (int m = 0; m < 4; ++m)
#pragma unroll
                for (int n = 0; n < 2; ++n) acc[a][b][m][n] = (f32x4){0.f, 0.f, 0.f, 0.f};
    bf16x8 At[4][2], B0[2][2], B1[2][2];
    const char* cA = (const char*)g.A + (GATHER ? (size_t)0 : (size_t)cur.pm * tstepA); const char* cB = (const char*)g.Bt + (size_t)cur.brow * K * 2;
    if (GATHER) { PG8_GLOAD(rawn, cur.pm); asm volatile("s_waitcnt vmcnt(0)" : "+v"(rawn[0][0]), "+v"(rawn[0][1]), "+v"(rawn[1][0]), "+v"(rawn[1][1]) :: "memory"); PG8_GCONV(vgc, rawn); }
    PG8_STAGE(PG8_SB(0, 0), cB, voffB); PG8_STAGE(PG8_SB(0, 1), cB + hstepB, voffB); PG8_STAGE_A(PG8_SA(0, 0), cA, 0, vgc); PG8_STAGE_A(PG8_SA(0, 1), cA, 1, vgc);
    if (wr == 1) PG8_BAR;
    PG8_WAIT_V(2); PG8_BAR;
    PG8_STAGE(PG8_SB(1, 0), cB + kstep, voffB); PG8_STAGE_A(PG8_SA(1, 0), cA + kstep, 0, vgc); PG8_STAGE(PG8_SB(1, 1), cB + hstepB + kstep, voffB);
    PG8_WAIT_V(6); PG8_BAR;
    for (;;) {
        const bool has_next = S.next(ui + 1, nxt);
        const char* nA = (has_next && !GATHER) ? (const char*)g.A + (size_t)nxt.pm * tstepA : cA;
        if (GATHER && has_next) PG8_GLOAD(rawn, nxt.pm); const char* nB = has_next ? (const char*)g.Bt + (size_t)nxt.brow * K * 2 : cB;
#pragma unroll 1
        for (int t = 0; t < nt; t += 2) {
            const bool last = (t == nt - 2);
            const char* a1 = cA + (size_t)(t + 1) * kstep;
            const char* a2 = last ? nA : cA + (size_t)(t + 2) * kstep; const char* b2 = last ? nB : cB + (size_t)(t + 2) * kstep;
            const char* a3 = a2 + kstep; const char* b3 = b2 + kstep;
            unsigned vg2[2][2];
            if (GATHER) { if (last && has_next) { PG8_GCONV(vg2, rawn); } else { _Pragma("unroll") for (int _h = 0; _h < 2; ++_h) _Pragma("unroll") for (int _i = 0; _i < 2; ++_i) vg2[_h][_i] = vgc[_h][_i]; } }
            PG8_LDB(B0, 0, 0); PG8_LDB(B1, 0, 1); PG8_SCHED; PG8_LDA(At, 0, 0); PG8_STAGE_A(PG8_SA(1, 1), a1, 1, vgc);
            PG8_WAIT_V(8); PG8_WAIT_L(0); PG8_BAR; PG8_MMA(0, 0, At, B0); PG8_MMA(0, 1, At, B1); PG8_BAR; PG8_SCHED;
            PG8_LDA(At, 0, 1); PG8_STAGE(PG8_SB(0, 0), b2, voffB); PG8_STAGE(PG8_SB(0, 1), b2 + hstepB, voffB); PG8_STAGE_A(PG8_SA(0, 0), a2, 0, vg2);
            PG8_WAIT_V(8); PG8_WAIT_L(0); PG8_BAR; PG8_MMA(1, 0, At, B0); PG8_MMA(1, 1, At, B1); PG8_BAR; PG8_SCHED;
            PG8_LDB(B0, 1, 0); PG8_LDB(B1, 1, 1); PG8_SCHED; PG8_LDA(At, 1, 0); PG8_STAGE_A(PG8_SA(0, 1), a2, 1, vg2);
            PG8_WAIT_V(8); PG8_WAIT_L(0); PG8_BAR; PG8_MMA(0, 0, At, B0); PG8_MMA(0, 1, At, B1); PG8_BAR; PG8_SCHED;
            PG8_LDA(At, 1, 1); PG8_STAGE(PG8_SB(1, 0), b3, voffB); PG8_STAGE(PG8_SB(1, 1), b3 + hstepB, voffB); PG8_STAGE_A(PG8_SA(1, 0), a3, 0, vg2);
            PG8_WAIT_V(8); PG8_WAIT_L(0); PG8_BAR; PG8_MMA(1, 0, At, B0); PG8_MMA(1, 1, At, B1); PG8_BAR; PG8_SCHED;
        }
        if (wr == 0) PG8_BAR;
        { int fr2 = fr, fq2 = fq; asm volatile("" : "+v"(fr2), "+v"(fq2)); E(acc, cur, wr, wc, fr2, fq2); }
        if (!has_next) break;
#pragma unroll
        for (int a = 0; a < 2; ++a)
#pragma unroll
            for (int b = 0; b < 2; ++b)
#pragma unroll
                for (int m = 0; m < 4; ++m)
#pragma unroll
                    for (int n = 0; n < 2; ++n) acc[a][b][m][n] = (f32x4){0.f, 0.f, 0.f, 0.f};
        cur = nxt; cA = nA; cB = nB; ++ui;
        if (GATHER) PG8_GCONV(vgc, rawn);
        if (wr == 1) PG8_BAR;
    }
    PG8_WAIT_V(0);
    PG8_BAR;
#undef PG8_SA
#undef PG8_SB
#undef PG8_STAGE
#undef PG8_STAGE_A
#undef PG8_GLOAD
#undef PG8_GCONV
#undef PG8_LDA
#undef PG8_LDB
#undef PG8_MMA
#undef PG8_WAIT_V
#undef PG8_WAIT_L
#undef PG8_BAR
#undef PG8_SCHED
}
}
constexpr size_t MiB = 1u << 20;
constexpr size_t WS_CTL = 0;
constexpr size_t WS_LORA = 1 * MiB;
constexpr size_t WS_WK2 = 2 * MiB;
constexpr size_t ZERO_BYTES = 3 * MiB;
constexpr size_t WS_WIN = 3 * MiB;
constexpr size_t WS_WOUT = 17 * MiB;
constexpr size_t WS_WK1 = 21 * MiB;
constexpr size_t WS_SMALL = 25 * MiB;
constexpr size_t WS_ROUTE = 27 * MiB;
constexpr size_t WS_WGU = 32 * MiB;
constexpr size_t WS_WDN = 288 * MiB;
constexpr size_t WS_H = 416 * MiB;
constexpr size_t WS_R = 480 * MiB;
constexpr size_t R_PROJ = WS_R;
constexpr size_t R_SC = R_PROJ + 208 * MiB;
constexpr size_t R_LIN = R_SC + 192 * MiB;
constexpr size_t R_G = R_LIN + 16 * MiB;
constexpr size_t R_YA = R_G + 32 * MiB;
constexpr size_t R_YCAT = R_YA + 32 * MiB;
constexpr size_t R_QC = R_YCAT + 64 * MiB;
constexpr size_t R_KC = R_QC + 16 * MiB;
constexpr size_t R_OC = R_KC + 16 * MiB;
constexpr size_t R_LSE = R_OC + 96 * MiB;
constexpr size_t R_QN = R_LSE + 2 * MiB;
constexpr size_t R_QR = R_QN + 16 * MiB;
constexpr size_t R_KCR = R_QR + 16 * MiB;
constexpr size_t R_VCR = R_KCR + 5 * MiB;
constexpr size_t R_KS = R_VCR + 5 * MiB;
constexpr size_t R_KW = R_KS + 4 * MiB;
constexpr size_t R_GATE = R_KW + 4 * MiB;
constexpr size_t R_CH1 = R_GATE + 2 * MiB;
constexpr size_t R_CMP = R_CH1 + 2 * MiB;
constexpr size_t R_OCMP = R_CMP + 1 * MiB;
constexpr size_t R_OSLC = R_OCMP + 32 * MiB;
constexpr size_t R_OSWA = R_OSLC + 32 * MiB;
constexpr size_t R_IMP = R_OSWA + 32 * MiB;
constexpr size_t R_SELM = R_IMP + 8 * MiB;
constexpr size_t R_MIX_END = R_SELM + 1 * MiB;
constexpr size_t R_XS = WS_R;
constexpr size_t R_ACT = R_XS + 272 * MiB;
constexpr size_t R_YB = R_ACT + 272 * MiB;
constexpr size_t R_MOE_END = R_YB + 272 * MiB;
constexpr size_t WS_END = (R_MIX_END > R_MOE_END ? R_MIX_END : R_MOE_END);
static_assert((size_t)NR * 1024 * 2 <= 272 * MiB, "sorted buffers");
constexpr int CW_BAR = 4096;
constexpr int CW_CNT = 16384;
constexpr int CW_CUR = 16384 + 64;

constexpr int RING_BYTES = 131072;
constexpr int MISC_OFF = RING_BYTES;
constexpr int LDS_BYTES = 147456;

struct Args { const void* in[40]; float* out; unsigned char* ws; int ph_lo, ph_hi; };

struct Ctx {
    LAS unsigned char* lds; int tid, lane, wave, G, bid;
    const float *x, *c, *w_ada, *b_ada, *norm1_g, *norm2_g, *w_in, *w_out, *mu, *w0, *w2, *a0, *a2, *g2, *kkw, *ka, *rk, *gn_w, *gn_b, *conv_w, *dil_q_g, *dil_k_g,
        *nsa_q_g, *nsa_kc_g, *nsa_ks_g, *nsa_kw_g, *pe_k, *pe_v, *wk1, *wk2, *wv1, *wv2, *onorm_g, *w_router, *b_router, *w_gu, *b_gu, *w_down, *b_down;
    const int* pos;
    float* out; unsigned char* ws;
};
#define WSP(T, off) ((T*)(C.ws + (off)))

typedef f32x4 Acc[2][2][4][2];
struct EpiProj {
    static constexpr bool PERM = true; bf16* O;
    DI void operator()(const Acc& acc, const pg8::Unit& u, int wr, int wc, int fr, int fq) const {
        const int row0 = u.pm * 256 + wr * 64 + fr, col0 = u.pn * 256 + wc * 32 + 8 * fq;
#pragma unroll
        for (int ai = 0; ai < 2; ++ai)
#pragma unroll
            for (int m = 0; m < 4; ++m) { bf16* rowp = O + (size_t)(row0 + ai * 128 + m * 16) * NPJ + col0;
#pragma unroll
                for (int bj = 0; bj < 2; ++bj) { const f32x4 v0 = acc[ai][bj][m][0], v1 = acc[ai][bj][m][1]; u32x4 w;
                    w.x = pg8::cvt_pk_bf16(v0[0], v0[1]); w.y = pg8::cvt_pk_bf16(v0[2], v0[3]); w.z = pg8::cvt_pk_bf16(v1[0], v1[1]); w.w = pg8::cvt_pk_bf16(v1[2], v1[3]);
                    *(u32x4*)(rowp + bj * 128) = w; } }
    }
};
struct EpiLora {
    static constexpr bool PERM = false; float* SC; float* Gb; const float *w0, *a0, *ka;
    DI void operator()(const Acc& acc, const pg8::Unit& u, int wr, int wc, int fr, int fq) const {
        const int row0 = u.pm * 256 + wr * 64 + fr, col0 = wc * 32 + 4 * fq;
        if (u.pn == 0) {
#pragma unroll
            for (int bj = 0; bj < 2; ++bj)
#pragma unroll
                for (int n = 0; n < 2; ++n) { const int ch = col0 + bj * 128 + n * 16; const f32x4 b = *(const f32x4*)(w0 + ch);
#pragma unroll
                    for (int ai = 0; ai < 2; ++ai)
#pragma unroll
                        for (int m = 0; m < 4; ++m) { const size_t o = (size_t)(row0 + ai * 128 + m * 16) * 256 + ch; const f32x4 v = acc[ai][bj][m][n] + b; f32x4 r;
#pragma unroll
                            for (int j = 0; j < 4; ++j) r[j] = __expf(-0.606531f * fsigmoid(v[j]));
                            *(f32x4*)(SC + o) = r; } }
        } else if (u.pn == 1) {
#pragma unroll
            for (int bj = 0; bj < 2; ++bj)
#pragma unroll
                for (int n = 0; n < 2; ++n) { const int ch = col0 + bj * 128 + n * 16; const f32x4 b = *(const f32x4*)(a0 + ch), kav = *(const f32x4*)(ka + ch);
#pragma unroll
                    for (int ai = 0; ai < 2; ++ai)
#pragma unroll
                        for (int m = 0; m < 4; ++m) { __builtin_amdgcn_sched_barrier(0); const size_t o = (size_t)(row0 + ai * 128 + m * 16) * 256 + ch; const f32x4 v = acc[ai][bj][m][n] + b;
                            float* pk = SC + (size_t)1 * NT * 256 + o; const f32x4 kr = *(const f32x4*)pk, kn = *(const f32x4*)(SC + (size_t)2 * NT * 256 + o); f32x4 k2, bb;
#pragma unroll
                            for (int j = 0; j < 4; ++j) { const float a = fsigmoid(v[j]); k2[j] = kr[j] * (1.f + (a - 1.f) * kav[j]); bb[j] = kn[j] * a; }
                            *(f32x4*)pk = k2; *(f32x4*)(SC + (size_t)3 * NT * 256 + o) = bb; } }
        } else {
#pragma unroll
            for (int bj = 0; bj < 2; ++bj)
#pragma unroll
                for (int n = 0; n < 2; ++n) { const int ch = col0 + bj * 128 + n * 16;
#pragma unroll
                    for (int ai = 0; ai < 2; ++ai)
#pragma unroll
                        for (int m = 0; m < 4; ++m) { const size_t o = (size_t)(row0 + ai * 128 + m * 16) * 256 + ch; *(f32x4*)(Gb + o) = acc[ai][bj][m][n]; } }
        }
    }
};
DI float gelu_tanh(float x) { const float t = 0.7978845608f * (x + 0.044715f * x * x * x); const float e = __expf(2.f * t); const float th = 1.f - 2.f / (e + 1.f); return 0.5f * x * (1.f + th); }
struct EpiC1 {
    static constexpr bool PERM = true; bf16* O; const float* peb;
    DI void operator()(const Acc& acc, const pg8::Unit& u, int wr, int wc, int fr, int fq) const {
        const int row0 = u.pm * 256 + wr * 64 + fr, col0 = wc * 32 + 8 * fq;
#pragma unroll
        for (int bj = 0; bj < 2; ++bj) { const f32x4 b0 = *(const f32x4*)(peb + col0 + bj * 128), b1 = *(const f32x4*)(peb + col0 + bj * 128 + 4);
#pragma unroll
            for (int ai = 0; ai < 2; ++ai)
#pragma unroll
                for (int m = 0; m < 4; ++m) { bf16* p = O + (size_t)(row0 + ai * 128 + m * 16) * 256 + col0 + bj * 128; const f32x4 v0 = acc[ai][bj][m][0] + b0, v1 = acc[ai][bj][m][1] + b1; u32x4 w;
                    w.x = pk2(gelu_tanh(v0[0]), gelu_tanh(v0[1])); w.y = pk2(gelu_tanh(v0[2]), gelu_tanh(v0[3])); w.z = pk2(gelu_tanh(v1[0]), gelu_tanh(v1[1])); w.w = pk2(gelu_tanh(v1[2]), gelu_tanh(v1[3]));
                    *(u32x4*)p = w; } }
    }
};
struct EpiC2 {
    static constexpr bool PERM = false; float* O;
    DI void operator()(const Acc& acc, const pg8::Unit& u, int wr, int wc, int fr, int fq) const {
        if (wc >= 2) return;
        const int row0 = u.pm * 256 + wr * 64 + fr, col0 = wc * 32 + 4 * fq;
#pragma unroll
        for (int ai = 0; ai < 2; ++ai)
#pragma unroll
            for (int m = 0; m < 4; ++m)
#pragma unroll
                for (int n = 0; n < 2; ++n) *(f32x4*)(O + (size_t)(row0 + ai * 128 + m * 16) * 64 + col0 + n * 16) = acc[ai][0][m][n];
    }
};
struct EpiOut {
    static constexpr bool PERM = false; float* O; const float* xin; const float* gt;
    DI void operator()(const Acc& acc, const pg8::Unit& u, int wr, int wc, int fr, int fq) const {
        const int row0 = u.pm * 256 + wr * 64 + fr, col0 = u.pn * 256 + wc * 32 + 4 * fq; const int b = (u.pm * 256) / NS;
#pragma unroll
        for (int bj = 0; bj < 2; ++bj)
#pragma unroll
            for (int n = 0; n < 2; ++n) { const int col = col0 + bj * 128 + n * 16; const f32x4 g = *(const f32x4*)(gt + (size_t)b * 6144 + col);
#pragma unroll
                for (int ai = 0; ai < 2; ++ai)
#pragma unroll
                    for (int m = 0; m < 4; ++m) { const size_t o = (size_t)(row0 + ai * 128 + m * 16) * DM + col; *(f32x4*)(O + o) = *(const f32x4*)(xin + o) + g * acc[ai][bj][m][n]; } }
    }
};
struct EpiGU {
    static constexpr bool PERM = true; bf16* O; const float* bgu;
    DI void operator()(const Acc& acc, const pg8::Unit& u, int wr, int wc, int fr, int fq) const {
        const int row0 = u.pm * 256 + wr * 64 + fr, cc = u.pn * 128 + wc * 32 + 8 * fq; const float* bp = bgu + (size_t)u.e * 2048 + cc;
        const f32x4 g0 = *(const f32x4*)bp, g1 = *(const f32x4*)(bp + 4), u0 = *(const f32x4*)(bp + 1024), u1 = *(const f32x4*)(bp + 1028);
#pragma unroll
        for (int ai = 0; ai < 2; ++ai)
#pragma unroll
            for (int m = 0; m < 4; ++m) { bf16* p = O + (size_t)(row0 + ai * 128 + m * 16) * FF + cc; float r[8];
#pragma unroll
                for (int n = 0; n < 2; ++n) { const f32x4 gv = acc[ai][0][m][n] + (n ? g1 : g0), uv = acc[ai][1][m][n] + (n ? u1 : u0);
#pragma unroll
                    for (int j = 0; j < 4; ++j) { const float ga = fminf(gv[j], 7.f), up = fminf(fmaxf(uv[j], -7.f), 7.f); r[4 * n + j] = ga * fsigmoid(1.702f * ga) * (up + 1.f); } }
                u32x4 w; w.x = pk2(r[0], r[1]); w.y = pk2(r[2], r[3]); w.z = pk2(r[4], r[5]); w.w = pk2(r[6], r[7]); *(u32x4*)p = w; }
    }
};
struct EpiDN {
    static constexpr bool PERM = true; bf16* O; const float* bd;
    DI void operator()(const Acc& acc, const pg8::Unit& u, int wr, int wc, int fr, int fq) const {
        const int row0 = u.pm * 256 + wr * 64 + fr, col0 = u.pn * 256 + wc * 32 + 8 * fq; const float* bp = bd + (size_t)u.e * 1024 + col0;
#pragma unroll
        for (int bj = 0; bj < 2; ++bj) { const f32x4 b0 = *(const f32x4*)(bp + bj * 128), b1 = *(const f32x4*)(bp + bj * 128 + 4);
#pragma unroll
            for (int ai = 0; ai < 2; ++ai)
#pragma unroll
                for (int m = 0; m < 4; ++m) { bf16* p = O + (size_t)(row0 + ai * 128 + m * 16) * DM + col0 + bj * 128; const f32x4 v0 = acc[ai][bj][m][0] + b0, v1 = acc[ai][bj][m][1] + b1; u32x4 w;
                    w.x = pk2(v0[0], v0[1]); w.y = pk2(v0[2], v0[3]); w.z = pk2(v1[0], v1[1]); w.w = pk2(v1[2], v1[3]); *(u32x4*)p = w; } }
    }
};
DI void tr_item(const float* src, int ld_src, int scol0, int nvalid, int k0, bf16* dst, int ld_dst, int drow0, int dk0, LAS float* scr, int lane) {
    const int n4 = (lane & 7) * 4, kr = lane >> 3; f32x4 v[8];
#pragma unroll
    for (int i = 0; i < 8; ++i) v[i] = (n4 < nvalid) ? *(const f32x4*)(src + (size_t)(k0 + kr + 8 * i) * ld_src + scol0 + n4) : (f32x4){0.f, 0.f, 0.f, 0.f};
#pragma unroll
    for (int i = 0; i < 8; ++i) { LAS float* s = scr + (kr + 8 * i) * 33 + n4; s[0] = v[i][0]; s[1] = v[i][1]; s[2] = v[i][2]; s[3] = v[i][3]; }
    asm volatile("s_waitcnt lgkmcnt(0)" ::: "memory");
    const int c = lane & 7;
#pragma unroll
    for (int jq = 0; jq < 4; ++jq) { const int n = (lane >> 3) + 8 * jq; const LAS float* s = scr + (8 * c) * 33 + n;
        u32x4 o; o.x = pk2(s[0 * 33], s[1 * 33]); o.y = pk2(s[2 * 33], s[3 * 33]); o.z = pk2(s[4 * 33], s[5 * 33]); o.w = pk2(s[6 * 33], s[7 * 33]);
        *(u32x4*)(dst + (size_t)(drow0 + n) * ld_dst + dk0 + k0 + 8 * c) = o; }
    asm volatile("s_waitcnt lgkmcnt(0)" ::: "memory");
}
DI void conv_item(const Ctx& C, int l, int r, LAS float* scr) {
    constexpr int I_GU = 32 * 16 * 64;
    if (r < I_GU) { const int e = r / 1024, r2 = r % 1024, kb = r2 / 64, nb = r2 % 64, n0 = 32 * nb, j = n0 / 256, i = n0 % 256;
        const int scol0 = (i < 128) ? 128 * j + i : 1024 + 128 * j + (i - 128);
        tr_item(C.w_gu + (size_t)(l * 32 + e) * 1024 * 2048, 2048, scol0, 32, 64 * kb, WSP(bf16, WS_WGU) + (size_t)(l * 32 + e) * 2048 * 1024, 1024, n0, 0, scr, C.lane); }
    else { r -= I_GU; const int e = r / 512, r2 = r % 512, kb = r2 / 32, nb = r2 % 32;
        tr_item(C.w_down + (size_t)(l * 32 + e) * 1024 * 1024, 1024, 32 * nb, 32, 64 * kb, WSP(bf16, WS_WDN) + (size_t)(l * 32 + e) * 1024 * 1024, 1024, 32 * nb, 0, scr, C.lane); }
}
DI void conv_ticket(const Ctx& C, int l, int tk) {
    LAS float* scr = (LAS float*)(C.lds + C.wave * 16384);
    __syncthreads();
#pragma unroll 1
    for (int i = 0; i < 8; ++i) conv_item(C, l, tk * 64 + C.wave * 8 + i, scr);
}
DI void p0_prologue(const Ctx& C) {
    LAS float* scr = (LAS float*)(C.lds + C.wave * 16384);
    const int gw = C.bid * NWAVE + C.wave, NGW = C.G * NWAVE;
    constexpr int I_IN = 16 * 104, I_OUT = 16 * 32, I_LW = 8, I_LA = 8, I_LG = 16, I_K1 = 256, I_K2 = 8;
    constexpr int I_LAYER = I_IN + I_OUT + I_LW + I_LA + I_LG + 2 * I_K1 + 2 * I_K2;
    for (int it = gw; it < NLAYER * I_LAYER; it += NGW) {
        const int l = it / I_LAYER; int r = it % I_LAYER;
        if (r < I_IN) { const int kb = r / 104, nb = r % 104, n0 = 32 * nb; int nv = 3212 - n0; nv = nv < 0 ? 0 : (nv > 32 ? 32 : nv);
            tr_item(C.w_in + (size_t)l * 1024 * 3212, 3212, n0, nv, 64 * kb, WSP(bf16, WS_WIN) + (size_t)l * NPJ * 1024, 1024, n0, 0, scr, C.lane); continue; } r -= I_IN;
        if (r < I_OUT) { const int kb = r / 32, nb = r % 32;
            tr_item(C.w_out + (size_t)l * 1024 * 1024, 1024, 32 * nb, 32, 64 * kb, WSP(bf16, WS_WOUT) + (size_t)l * 1024 * 1024, 1024, 32 * nb, 0, scr, C.lane); continue; } r -= I_OUT;
        bf16* lora = WSP(bf16, WS_LORA) + (size_t)l * 768 * 256;
        if (r < I_LW) { tr_item(C.w2 + (size_t)l * 64 * 256, 256, 32 * r, 32, 0, lora, 256, 32 * r, 0, scr, C.lane); continue; } r -= I_LW;
        if (r < I_LA) { tr_item(C.a2 + (size_t)l * 64 * 256, 256, 32 * r, 32, 0, lora, 256, 256 + 32 * r, 64, scr, C.lane); continue; } r -= I_LA;
        if (r < I_LG) { const int kb = r / 8, nb = r % 8; tr_item(C.g2 + (size_t)l * 128 * 256, 256, 32 * nb, 32, 64 * kb, lora, 256, 512 + 32 * nb, 128, scr, C.lane); continue; } r -= I_LG;
        if (r < 2 * I_K1) { const int kv = r / I_K1, r2 = r % I_K1, kb = r2 / 8, nb = r2 % 8;
            tr_item((kv ? C.wv1 : C.wk1) + (size_t)l * 2048 * 256, 256, 32 * nb, 32, 64 * kb, WSP(bf16, WS_WK1) + (size_t)(l * 2 + kv) * 256 * 2048, 2048, 32 * nb, 0, scr, C.lane); continue; } r -= 2 * I_K1;
        { const int kv = r / I_K2, r2 = r % I_K2, kb = r2 / 2, nb = r2 % 2;
            tr_item((kv ? C.wv2 : C.wk2) + (size_t)l * 256 * 64, 64, 32 * nb, 32, 64 * kb, WSP(bf16, WS_WK2) + (size_t)(l * 2 + kv) * 256 * 256, 256, 32 * nb, 0, scr, C.lane); }
    }
    __syncthreads();
    float* MOD = WSP(float, WS_SMALL); float* PEB = MOD + NLAYER * 8 * 6144;
    LAS float* sc = (LAS float*)C.lds;
    LAS float* red = sc + 8192;
    for (int it = C.bid; it < 192 + 4; it += C.G) {
        if (it < 192) {
            const int l = it / 96, n0 = (it % 96) * 64;
            for (int i = C.tid; i < 8192; i += NTHR) { const float v = C.c[i]; sc[i] = v / (1.f + __expf(-v)); }
            __syncthreads();
            const int kq = C.tid >> 6, col = C.tid & 63; float a[8];
#pragma unroll
            for (int b = 0; b < 8; ++b) a[b] = 0.f;
            const float* wp = C.w_ada + (size_t)l * 1024 * 6144 + n0 + col;
#pragma unroll 8
            for (int k = kq * 128; k < kq * 128 + 128; ++k) { const float w = wp[(size_t)k * 6144];
#pragma unroll
                for (int b = 0; b < 8; ++b) a[b] += sc[b * 1024 + k] * w; }
#pragma unroll
            for (int b = 0; b < 8; ++b) red[(kq * 8 + b) * 64 + col] = a[b];
            __syncthreads();
            { const int b = C.tid >> 6; float s = C.b_ada[(size_t)l * 6144 + n0 + col];
#pragma unroll
              for (int q = 0; q < 8; ++q) s += red[(q * 8 + b) * 64 + col];
              MOD[((size_t)l * 8 + b) * 6144 + n0 + col] = s; }
            __syncthreads();
        } else {
            const int l = (it - 192) / 2, kv = (it - 192) % 2; const float* pe = (kv ? C.pe_v : C.pe_k) + (size_t)l * 2048; const float* w1 = (kv ? C.wv1 : C.wk1) + (size_t)l * 2048 * 256;
            const int kq = C.tid >> 8, col = C.tid & 255; float a = 0.f;
#pragma unroll 8
            for (int k = kq * 1024; k < kq * 1024 + 1024; ++k) a += pe[k] * w1[(size_t)k * 256 + col];
            red[kq * 256 + col] = a; __syncthreads();
            if (C.tid < 256) PEB[(l * 2 + kv) * 256 + col] = red[col] + red[256 + col];
            __syncthreads();
        }
    }
}

DI void norm_row(const Ctx& C, const float* xrow, const float* g, const float* sh, const float* sc, bf16* orow) {
    f32x4 v[4]; float s = 0.f;
#pragma unroll
    for (int j = 0; j < 4; ++j) { v[j] = *(const f32x4*)(xrow + 4 * C.lane + 256 * j); s += (v[j][0] * v[j][0] + v[j][1] * v[j][1]) + (v[j][2] * v[j][2] + v[j][3] * v[j][3]); }
    s = group_sum<64>(s); const float rstd = rsqrtf(s * (1.f / DM) + 1e-6f);
#pragma unroll
    for (int j = 0; j < 4; ++j) { const int k = 4 * C.lane + 256 * j; const f32x4 gg = *(const f32x4*)(g + k), a = *(const f32x4*)(sc + k), b = *(const f32x4*)(sh + k); f32x4 h;
#pragma unroll
        for (int i = 0; i < 4; ++i) h[i] = v[j][i] * rstd * gg[i] * (1.f + a[i]) + b[i];
        u32x2 o; o.x = pk2(h[0], h[1]); o.y = pk2(h[2], h[3]); *(u32x2*)(orow + k) = o; }
}
DI void norm1_phase(const Ctx& C, int l, const float* xin) {
    const float* MOD = WSP(float, WS_SMALL) + (size_t)l * 8 * 6144; bf16* H = WSP(bf16, WS_H);
    const int gw = C.bid * NWAVE + C.wave, NGW = C.G * NWAVE;
    for (int m = gw; m < NT; m += NGW) { const int b = m / NS; norm_row(C, xin + (size_t)m * DM, C.norm1_g + l * DM, MOD + b * 6144, MOD + b * 6144 + 1024, H + (size_t)m * DM); }
}

constexpr float QSCALE = 0.125f * 1.44269504089f;
DI void prep_phase(const Ctx& C, int l) {
    const bf16* PROJ = WSP(bf16, R_PROJ); float* SC = WSP(float, R_SC); bf16* LIN = WSP(bf16, R_LIN); bf16* YCAT = WSP(bf16, R_YCAT);
    bf16 *QC = WSP(bf16, R_QC), *KC = WSP(bf16, R_KC), *QN = WSP(bf16, R_QN), *QR = WSP(bf16, R_QR), *KCR = WSP(bf16, R_KCR), *VCR = WSP(bf16, R_VCR), *KS = WSP(bf16, R_KS), *KW = WSP(bf16, R_KW);
    float* GATE = WSP(float, R_GATE);
    const int lane = C.lane, gw = C.bid * NWAVE + C.wave, NGW = C.G * NWAVE;
    const int hh = lane >> 4, jj = lane & 15;
    const float inv0 = exp2f(-(float)(2 * jj) * (13.287712379549449f / 32.f)), inv1 = exp2f(-(float)(2 * jj + 1) * (13.287712379549449f / 32.f));
    for (int row = gw; row < NT; row += NGW) {
        const int s = row % NS; const bf16* pr = PROJ + (size_t)row * NPJ;
        {
            const int c0 = 16 * lane; float z[16];
            const u32x4 c0v = *(const u32x4*)(pr + c0), c1v = *(const u32x4*)(pr + c0 + 8);
            u32x4 p0v = (u32x4){0u, 0u, 0u, 0u}, p1v = p0v;
            if (s > 0) { p0v = *(const u32x4*)(pr - NPJ + c0); p1v = *(const u32x4*)(pr - NPJ + c0 + 8); }
            const float* mup = C.mu + (size_t)l * 1024 + c0;
            const unsigned cw[8] = {c0v.x, c0v.y, c0v.z, c0v.w, c1v.x, c1v.y, c1v.z, c1v.w}, pw[8] = {p0v.x, p0v.y, p0v.z, p0v.w, p1v.x, p1v.y, p1v.z, p1v.w};
#pragma unroll
            for (int q = 0; q < 4; ++q) { const f32x4 m4 = *(const f32x4*)(mup + 4 * q);
#pragma unroll
                for (int i = 0; i < 4; ++i) { const int e = 4 * q + i; const float cu = (e & 1) ? bfhi(cw[e >> 1]) : bflo(cw[e >> 1]), pv = (e & 1) ? bfhi(pw[e >> 1]) : bflo(pw[e >> 1]); z[e] = cu + (pv - cu) * m4[i]; } }
            const int cc = (c0 - 256) & 255; float kk[16]; float ss = 0.f;
#pragma unroll
            for (int q = 0; q < 4; ++q) { const f32x4 k4 = *(const f32x4*)(C.kkw + (size_t)l * 256 + cc + 4 * q);
#pragma unroll
                for (int i = 0; i < 4; ++i) { kk[4 * q + i] = z[4 * q + i] * k4[i]; ss += kk[4 * q + i] * kk[4 * q + i]; } }
            ss = group_sum<4>(ss); const float kinv = rsqrtf(ss + 1e-12f);
            if (lane < 48) {
                const int vec = lane < 16 ? 4 : (lane < 32 ? 1 : 5); float* dst = SC + ((size_t)vec * NT + row) * 256 + (c0 & 255);
#pragma unroll
                for (int q = 0; q < 4; ++q) *(f32x4*)(dst + 4 * q) = (f32x4){z[4 * q], z[4 * q + 1], z[4 * q + 2], z[4 * q + 3]};
                if (lane >= 16 && lane < 32) { float* d2 = SC + ((size_t)2 * NT + row) * 256 + cc;
#pragma unroll
                    for (int q = 0; q < 4; ++q) *(f32x4*)(d2 + 4 * q) = (f32x4){kk[4 * q] * kinv, kk[4 * q + 1] * kinv, kk[4 * q + 2] * kinv, kk[4 * q + 3] * kinv}; }
            } else {
                float t[16];
#pragma unroll
                for (int i = 0; i < 16; ++i) { const float sg = fsigmoid(lane < 52 ? 2.f * z[i] : z[i]); t[i] = lane < 52 ? 2.f * sg - 1.f : (lane < 56 ? z[i] : sg); }
                bf16* dst = LIN + (size_t)row * 256 + (c0 - 768);
                u32x4 o0, o1; o0.x = pk2(t[0], t[1]); o0.y = pk2(t[2], t[3]); o0.z = pk2(t[4], t[5]); o0.w = pk2(t[6], t[7]); o1.x = pk2(t[8], t[9]); o1.y = pk2(t[10], t[11]); o1.z = pk2(t[12], t[13]); o1.w = pk2(t[14], t[15]);
                *(u32x4*)dst = o0; *(u32x4*)(dst + 8) = o1;
            }
        }
        {
            const int ch = 4 * lane; float u[3][4];
#pragma unroll
            for (int d = 0; d < 3; ++d) {
                u32x2 cg = (u32x2){0u, 0u}, xi = cg;
                if (s >= d) { cg = *(const u32x2*)(pr - (size_t)d * NPJ + PJ_B + 256 + ch); xi = *(const u32x2*)(pr - (size_t)d * NPJ + PJ_B + 512 + ch); }
                u[d][0] = bflo(cg.x) * bflo(xi.x); u[d][1] = bfhi(cg.x) * bfhi(xi.x); u[d][2] = bflo(cg.y) * bflo(xi.y); u[d][3] = bfhi(cg.y) * bfhi(xi.y);
            }
            const u32x2 bgv = *(const u32x2*)(pr + PJ_B + ch); const float bg[4] = {bflo(bgv.x), bfhi(bgv.x), bflo(bgv.y), bfhi(bgv.y)};
            const float* cw = C.conv_w + (size_t)l * 3 * 256 + ch; const f32x4 w0 = *(const f32x4*)cw, w1 = *(const f32x4*)(cw + 256), w2 = *(const f32x4*)(cw + 512);
            float y[4]; float ss = 0.f;
#pragma unroll
            for (int i = 0; i < 4; ++i) { y[i] = bg[i] * (w0[i] * u[2][i] + w1[i] * u[1][i] + w2[i] * u[0][i]); ss += y[i] * y[i]; }
            ss = group_sum<16>(ss); const float rstd = rsqrtf(ss * (1.f / 64.f) + 1e-6f); const f32x4 og = *(const f32x4*)(C.onorm_g + (size_t)l * 768 + ch);
            u32x2 o; o.x = pk2(y[0] * rstd * og[0], y[1] * rstd * og[1]); o.y = pk2(y[2] * rstd * og[2], y[3] * rstd * og[3]);
            *(u32x2*)(YCAT + (size_t)row * DM + 256 + ch) = o;
        }
        const float posf = (float)C.pos[row];
        const float x0 = __builtin_amdgcn_fractf((posf * inv0) * 0.15915494309189535f), x1 = __builtin_amdgcn_fractf((posf * inv1) * 0.15915494309189535f);
        const float sn0 = __builtin_amdgcn_sinf(x0), cs0 = __builtin_amdgcn_cosf(x0), sn1 = __builtin_amdgcn_sinf(x1), cs1 = __builtin_amdgcn_cosf(x1);
#pragma unroll
        for (int qk = 0; qk < 2; ++qk) {
            const bf16* p = pr + PJ_C + qk * 256 + hh * 64 + 2 * jj; const unsigned a = *(const unsigned*)p, b = *(const unsigned*)(p + 32);
            float x1a = bflo(a), x1b = bfhi(a), x2a = bflo(b), x2b = bfhi(b);
            float ss = group_sum<16>(x1a * x1a + x1b * x1b + x2a * x2a + x2b * x2b); const float rstd = rsqrtf(ss * (1.f / 64.f) + 1e-6f);
            const float* g = (qk ? C.dil_k_g : C.dil_q_g) + (size_t)l * 64; const float sc = qk ? 1.f : QSCALE;
            x1a *= rstd * g[2 * jj] * sc; x1b *= rstd * g[2 * jj + 1] * sc; x2a *= rstd * g[32 + 2 * jj] * sc; x2b *= rstd * g[33 + 2 * jj] * sc;
            bf16* o = (qk ? KC : QC) + (size_t)row * 256 + hh * 64 + 2 * jj;
            *(unsigned*)o = pk2(x1a * cs0 - x2a * sn0, x1b * cs1 - x2b * sn1); *(unsigned*)(o + 32) = pk2(x2a * cs0 + x1a * sn0, x2b * cs1 + x1b * sn1);
        }
        {
            const bf16* p = pr + PJ_D + hh * 64 + 2 * jj; const unsigned a = *(const unsigned*)p, b = *(const unsigned*)(p + 32);
            float x1a = bflo(a), x1b = bfhi(a), x2a = bflo(b), x2b = bfhi(b);
            float ss = group_sum<16>(x1a * x1a + x1b * x1b + x2a * x2a + x2b * x2b); const float rstd = rsqrtf(ss * (1.f / 64.f) + 1e-6f) * QSCALE;
            const float* g = C.nsa_q_g + (size_t)l * 64;
            x1a *= rstd * g[2 * jj]; x1b *= rstd * g[2 * jj + 1]; x2a *= rstd * g[32 + 2 * jj]; x2b *= rstd * g[33 + 2 * jj];
            bf16* on = QN + (size_t)row * 256 + hh * 64 + 2 * jj; *(unsigned*)on = pk2(x1a, x1b); *(unsigned*)(on + 32) = pk2(x2a, x2b);
            bf16* o = QR + (size_t)row * 256 + hh * 64 + 2 * jj;
            *(unsigned*)o = pk2(x1a * cs0 - x2a * sn0, x1b * cs1 - x2b * sn1); *(unsigned*)(o + 32) = pk2(x2a * cs0 + x1a * sn0, x2b * cs1 + x1b * sn1);
        }
        {
            const int col = hh == 0 ? 2944 : (hh == 1 ? 3072 : (hh == 2 ? 2816 : 2880));
            const bf16* p = pr + col + 2 * jj; const unsigned a = *(const unsigned*)p, b = *(const unsigned*)(p + 32);
            float x1a = bflo(a), x1b = bfhi(a), x2a = bflo(b), x2b = bfhi(b);
            float ss = group_sum<16>(x1a * x1a + x1b * x1b + x2a * x2a + x2b * x2b); const float rstd = rsqrtf(ss * (1.f / 64.f) + 1e-6f);
            const float* g = (hh == 0 ? C.nsa_ks_g : C.nsa_kw_g) + (size_t)l * 64;
            const float n1a = x1a * rstd * g[2 * jj], n1b = x1b * rstd * g[2 * jj + 1], n2a = x2a * rstd * g[32 + 2 * jj], n2b = x2b * rstd * g[33 + 2 * jj];
            unsigned o1 = pk2(n1a * cs0 - n2a * sn0, n1b * cs1 - n2b * sn1), o2 = pk2(n2a * cs0 + n1a * sn0, n2b * cs1 + n1b * sn1);
            if (hh >= 2) { o1 = a; o2 = b; }
            bf16* o = (hh == 0 ? KS : (hh == 1 ? KW : (hh == 2 ? KCR : VCR))) + (size_t)row * 64 + 2 * jj;
            *(unsigned*)o = o1; *(unsigned*)(o + 32) = o2;
        }
        if (lane < 12) GATE[(size_t)row * 12 + lane] = fsigmoid(bf2f(pr[3200 + lane]));
    }
}
constexpr int SCAN_TC = 16;
DI void scan_unit(const Ctx& C, int u) {
    const float* SC = WSP(float, R_SC); float* YA = WSP(float, R_YA);
    const int b = u >> 3, h = (u >> 1) & 3, half = u & 1, tid = C.tid;
    LAS float* buf = (LAS float*)C.lds;
    LAS float* yp = buf + 2 * 6144;
    const int rl = (tid >> 3) & 31, cg = tid & 7, row = 32 * half + rl;
    f32x4 ld[3];
#define SCAN_LOAD(chunk) do { _Pragma("unroll") for (int i = 0; i < 3; ++i) { const int idx = tid + 512 * i, step = idx / 96, rem = idx % 96, vec = rem >> 4, f4 = rem & 15; \
        ld[i] = *(const f32x4*)(SC + ((size_t)vec * NT + (size_t)b * NS + (chunk) * SCAN_TC + step) * 256 + h * 64 + f4 * 4); } } while (0)
#define SCAN_STORE(slot) do { _Pragma("unroll") for (int i = 0; i < 3; ++i) *(LAS f32x4*)(buf + (slot) * 6144 + (tid + 512 * i) * 4) = ld[i]; } while (0)
#define SCAN_FLUSH(chunk) do { _Pragma("unroll") for (int i = 0; i < 2; ++i) { const int i2 = (tid - 256) + 256 * i, step = i2 >> 5, rr = i2 & 31; const LAS float* pp = yp + ((chunk) & 1) * 4096 + step * 256 + rr * 8; \
        const f32x4 a = *(const LAS f32x4*)pp, c2 = *(const LAS f32x4*)(pp + 4); \
        YA[((size_t)b * NS + (chunk) * SCAN_TC + step) * 256 + h * 64 + 32 * half + rr] = ((a[0] + a[1]) + (a[2] + a[3])) + ((c2[0] + c2[1]) + (c2[2] + c2[3])); } } while (0)
    __syncthreads();
    SCAN_LOAD(0); SCAN_STORE(0);
    f32x2 S[4];
#pragma unroll
    for (int c = 0; c < 4; ++c) S[c] = (f32x2){0.f, 0.f};
    constexpr int NCH = NS / SCAN_TC;
    for (int ck = 0; ck < NCH; ++ck) {
        __syncthreads();
        if (ck + 1 < NCH) SCAN_LOAD(ck + 1);
        if (tid >= 256) { if (ck > 0) SCAN_FLUSH(ck - 1); }
        else {
            const LAS float* bp = buf + (ck & 1) * 6144; LAS float* yb = yp + (ck & 1) * 4096 + tid;
#define SCAN_LDS(X, step) do { const LAS float* sp = bp + (step) * 384 + 8 * cg; X.w0 = *(const LAS f32x4*)(sp); X.w1 = *(const LAS f32x4*)(sp + 4); X.k0 = *(const LAS f32x4*)(sp + 64); X.k1 = *(const LAS f32x4*)(sp + 68); \
                X.q0 = *(const LAS f32x4*)(sp + 128); X.q1 = *(const LAS f32x4*)(sp + 132); X.b0 = *(const LAS f32x4*)(sp + 192); X.b1 = *(const LAS f32x4*)(sp + 196); \
                X.r0 = *(const LAS f32x4*)(sp + 256); X.r1 = *(const LAS f32x4*)(sp + 260); X.v = bp[(step) * 384 + 320 + row]; } while (0)
#define SCAN_STEP(X, step) do { \
                f32x2 d2 = S[0] * (f32x2){X.q0[0], X.q0[1]}; d2 = S[1] * (f32x2){X.q0[2], X.q0[3]} + d2; d2 = S[2] * (f32x2){X.q1[0], X.q1[1]} + d2; d2 = S[3] * (f32x2){X.q1[2], X.q1[3]} + d2; \
                const float sa = -sum8(d2[0] + d2[1]); const f32x2 sa2 = (f32x2){sa, sa}, v2 = (f32x2){X.v, X.v}; \
                S[0] = S[0] * (f32x2){X.w0[0], X.w0[1]} + (sa2 * (f32x2){X.b0[0], X.b0[1]} + v2 * (f32x2){X.k0[0], X.k0[1]}); \
                S[1] = S[1] * (f32x2){X.w0[2], X.w0[3]} + (sa2 * (f32x2){X.b0[2], X.b0[3]} + v2 * (f32x2){X.k0[2], X.k0[3]}); \
                S[2] = S[2] * (f32x2){X.w1[0], X.w1[1]} + (sa2 * (f32x2){X.b1[0], X.b1[1]} + v2 * (f32x2){X.k1[0], X.k1[1]}); \
                S[3] = S[3] * (f32x2){X.w1[2], X.w1[3]} + (sa2 * (f32x2){X.b1[2], X.b1[3]} + v2 * (f32x2){X.k1[2], X.k1[3]}); \
                f32x2 y2 = S[0] * (f32x2){X.r0[0], X.r0[1]}; y2 = S[1] * (f32x2){X.r0[2], X.r0[3]} + y2; y2 = S[2] * (f32x2){X.r1[0], X.r1[1]} + y2; y2 = S[3] * (f32x2){X.r1[2], X.r1[3]} + y2; \
                yb[(step) * 256] = y2[0] + y2[1]; } while (0)
            struct StepIn { f32x4 w0, w1, k0, k1, q0, q1, b0, b1, r0, r1; float v; } A, B;
            SCAN_LDS(A, 0);
#pragma unroll 2
            for (int step = 0; step < SCAN_TC; step += 2) {
                SCAN_LDS(B, step + 1);
                __builtin_amdgcn_sched_barrier(0);
                SCAN_STEP(A, step);
                __builtin_amdgcn_sched_barrier(0);
                if (step + 2 < SCAN_TC) SCAN_LDS(A, step + 2);
                __builtin_amdgcn_sched_barrier(0);
                SCAN_STEP(B, step + 1);
                __builtin_amdgcn_sched_barrier(0);
            }
#undef SCAN_LDS
#undef SCAN_STEP
        }
        if (ck + 1 < NCH) SCAN_STORE((ck + 1) & 1);
    }
    __syncthreads();
    if (tid >= 256) SCAN_FLUSH(NCH - 1);
#undef SCAN_LOAD
#undef SCAN_STORE
#undef SCAN_FLUSH
    __syncthreads();
}

constexpr int KROW = 144, KT_BYTES = 64 * KROW;
#define MFMA16(a, b, c) __builtin_amdgcn_mfma_f32_16x16x32_bf16((a), (b), (c), 0, 0, 0)
template <int NQT> struct FA { f32x4 O[NQT][4]; float m[NQT], l[NQT]; };
template <int NQT> DI void fa_init(FA<NQT>& st) {
#pragma unroll
    for (int q = 0; q < NQT; ++q) { st.m[q] = -1e30f; st.l[q] = 0.f;
#pragma unroll
        for (int d = 0; d < 4; ++d) st.O[q][d] = (f32x4){0.f, 0.f, 0.f, 0.f}; }
}
DI bf16x8 pack8(const f32x4& a, const f32x4& b) { u32x4 w; w.x = pk2(a[0], a[1]); w.y = pk2(a[2], a[3]); w.z = pk2(b[0], b[1]); w.w = pk2(b[2], b[3]); return __builtin_bit_cast(bf16x8, w); }
struct VFrag { u32x2 a[4], b[4]; };
DI void vt_issue(VFrag& f, unsigned vaddr) {
    asm volatile("ds_read_b64_tr_b16 %0, %8\n\tds_read_b64_tr_b16 %1, %8 offset:2304\n\tds_read_b64_tr_b16 %2, %8 offset:32\n\tds_read_b64_tr_b16 %3, %8 offset:2336\n\t"
                 "ds_read_b64_tr_b16 %4, %8 offset:64\n\tds_read_b64_tr_b16 %5, %8 offset:2368\n\tds_read_b64_tr_b16 %6, %8 offset:96\n\tds_read_b64_tr_b16 %7, %8 offset:2400"
                 : "=&v"(f.a[0]), "=&v"(f.b[0]), "=&v"(f.a[1]), "=&v"(f.b[1]), "=&v"(f.a[2]), "=&v"(f.b[2]), "=&v"(f.a[3]), "=&v"(f.b[3]) : "v"(vaddr) : "memory");
}
DI void vt_wait(VFrag& f) { asm volatile("s_waitcnt lgkmcnt(0)" : "+v"(f.a[0]), "+v"(f.b[0]), "+v"(f.a[1]), "+v"(f.b[1]), "+v"(f.a[2]), "+v"(f.b[2]), "+v"(f.a[3]), "+v"(f.b[3]) :: "memory"); }
DI bf16x8 vt_get(const VFrag& f, int d) { return __builtin_bit_cast(bf16x8, ((u32x4){f.a[d].x, f.a[d].y, f.b[d].x, f.b[d].y})); }
template <int NQT, bool MASKED, class MaskF>
DI void fa_tile(FA<NQT>& st, const bf16x8 (&Q)[NQT][2], const LAS uchar* Ks, const LAS uchar* Vs, int lane, const MaskF& allowed, const bool (&act)[NQT]) {
    const int l15 = lane & 15, quad = lane >> 4;
    f32x4 S[NQT][4];
#pragma unroll
    for (int kt = 0; kt < 4; ++kt) {
        const bf16x8 k0 = *(const LAS bf16x8*)(Ks + (16 * kt + l15) * KROW + quad * 16), k1 = *(const LAS bf16x8*)(Ks + (16 * kt + l15) * KROW + 64 + quad * 16);
#pragma unroll
        for (int q = 0; q < NQT; ++q) if (act[q]) { S[q][kt] = MFMA16(k0, Q[q][0], ((f32x4){0.f, 0.f, 0.f, 0.f})); S[q][kt] = MFMA16(k1, Q[q][1], S[q][kt]); }
    }
    const unsigned vaddr = (unsigned)(size_t)(Vs + (4 * quad + (l15 >> 2)) * KROW + 8 * (l15 & 3));
    VFrag v0, v1; vt_issue(v0, vaddr); vt_issue(v1, vaddr + 32 * KROW);
#pragma unroll
    for (int q = 0; q < NQT; ++q) if (act[q]) {
        float mx = -1e30f;
#pragma unroll
        for (int kt = 0; kt < 4; ++kt)
#pragma unroll
            for (int j = 0; j < 4; ++j) { if (MASKED) { const float s = allowed(q, 16 * kt + 4 * quad + j) ? S[q][kt][j] : -1e30f; S[q][kt][j] = s; } mx = fmaxf(mx, S[q][kt][j]); }
        mx = fmaxf(mx, __shfl_xor(mx, 16)); mx = fmaxf(mx, __shfl_xor(mx, 32));
        const float mn = fmaxf(st.m[q], mx), alpha = fexp2(st.m[q] - mn); st.m[q] = mn;
        float rs = 0.f;
#pragma unroll
        for (int kt = 0; kt < 4; ++kt)
#pragma unroll
            for (int j = 0; j < 4; ++j) { const float s = S[q][kt][j]; float p = fexp2(s - mn); if (MASKED) p = (s > -1e29f) ? p : 0.f; S[q][kt][j] = p; rs += p; }
        st.l[q] = st.l[q] * alpha + rs;
#pragma unroll
        for (int d = 0; d < 4; ++d) st.O[q][d] = st.O[q][d] * alpha;
    }
    vt_wait(v0); vt_wait(v1);
#pragma unroll
    for (int q = 0; q < NQT; ++q) if (act[q]) {
        const bf16x8 p0 = pack8(S[q][0], S[q][1]), p1 = pack8(S[q][2], S[q][3]);
#pragma unroll
        for (int d = 0; d < 4; ++d) { st.O[q][d] = MFMA16(vt_get(v0, d), p0, st.O[q][d]); st.O[q][d] = MFMA16(vt_get(v1, d), p1, st.O[q][d]); }
    }
}
template <int NQT> DI void fa_finish(FA<NQT>& st, float (&lse2)[NQT]) {
#pragma unroll
    for (int q = 0; q < NQT; ++q) { float l = st.l[q]; l += __shfl_xor(l, 16); l += __shfl_xor(l, 32); const float inv = l > 0.f ? 1.f / l : 0.f; lse2[q] = st.m[q] + __log2f(fmaxf(l, 1e-37f));
#pragma unroll
        for (int d = 0; d < 4; ++d) st.O[q][d] = st.O[q][d] * inv; }
}
DI void kv_store(LAS uchar* Ks, LAS uchar* Vs, int tid, const u32x4& kr, const u32x4& vr) {
    const int o = (tid >> 3) * KROW + (tid & 7) * 16; *(LAS u32x4*)(Ks + o) = kr; *(LAS u32x4*)(Vs + o) = vr;
}
DI void q_load(bf16x8 (&Q)[2], const bf16* qrow, int quad) { Q[0] = *(const bf16x8*)(qrow + 8 * quad); Q[1] = *(const bf16x8*)(qrow + 32 + 8 * quad); }

struct DilMask { int qi[2]; int k0; DI bool operator()(int q, int key) const { const int ki = k0 + key, d = qi[q] - ki; return ki >= 0 && d >= 0 && d <= 128; } };
DI void dil_unit(const Ctx& C, int unit, LAS uchar* Ks, LAS uchar* Vs) {
    const bf16 *QC = WSP(bf16, R_QC), *KC = WSP(bf16, R_KC), *PROJ = WSP(bf16, R_PROJ); float* OC = WSP(float, R_OC); float* LSE = WSP(float, R_LSE);
    int tid = C.tid, lane = C.lane; asm volatile("" : "+v"(tid), "+v"(lane));
    const int w = C.wave, l15 = lane & 15, quad = lane >> 4;
    const int cfg = unit / 512, r = unit % 512, dsh = 2 * cfg, d = 1 << dsh;
    const int b = r >> 6, h = (r >> 4) & 3, r2 = r & 15;
    const int nblk = 16 >> dsh, res = r2 / nblk, blk = r2 % nblk, i0 = blk * 256;
    const size_t tb = (size_t)b * NS;
    bf16x8 Q[2][2]; DilMask mk; FA<2> st; fa_init(st);
#pragma unroll
    for (int q = 0; q < 2; ++q) { mk.qi[q] = i0 + 32 * w + 16 * q + l15; q_load(Q[q], QC + (tb + res + (size_t)d * mk.qi[q]) * 256 + h * 64, quad); }
    const int jlo = w >> 1, jhi = (w >> 1) + 2;
    const bool act[2] = {true, true};
    u32x4 kr, vr;
#define DIL_LOAD(j) do { const int ki = i0 - 128 + 64 * (j) + (tid >> 3); kr = (u32x4){0u, 0u, 0u, 0u}; vr = kr; \
    if (ki >= 0) { const size_t rowk = tb + res + (size_t)d * ki; kr = *(const u32x4*)(KC + rowk * 256 + h * 64 + (tid & 7) * 8); vr = *(const u32x4*)(PROJ + rowk * NPJ + PJ_C + 512 + h * 64 + (tid & 7) * 8); } } while (0)
    DIL_LOAD(0);
    for (int j = 0; j < 6; ++j) {
        __syncthreads(); kv_store(Ks, Vs, tid, kr, vr); __syncthreads();
        if (j + 1 < 6) DIL_LOAD(j + 1);
        if (j >= jlo && j <= jhi) { mk.k0 = i0 - 128 + 64 * j; fa_tile<2, true>(st, Q, Ks, Vs, lane, mk, act); }
    }
#undef DIL_LOAD
    float lse2[2]; fa_finish<2>(st, lse2);
#pragma unroll
    for (int q = 0; q < 2; ++q) { const size_t rowq = tb + res + (size_t)d * mk.qi[q]; float* o = OC + ((size_t)cfg * NT + rowq) * 256 + h * 64 + 4 * quad;
#pragma unroll
        for (int dt = 0; dt < 4; ++dt) *(f32x4*)(o + 16 * dt) = st.O[q][dt];
        if (quad == 0) LSE[((size_t)cfg * NT + rowq) * 4 + h] = lse2[q]; }
}
constexpr int NSA_KC = 0, NSA_VC = 256 * KROW, NSA_KT = 2 * 256 * KROW, NSA_VT = NSA_KT + KT_BYTES, NSA_IMP = NSA_VT + KT_BYTES, NSA_SELM = NSA_IMP + 64 * 64 * 4, NSA_UW = NSA_SELM + 512;
static_assert(NSA_UW + 16 <= RING_BYTES, "NSA LDS map");
struct SwaMask { int t[2]; int k0; DI bool operator()(int q, int key) const { const int d = t[q] - (k0 + key); return d >= 0 && d <= 511; } };
struct SlcMask { int t[2]; int k0; bool sel[2]; DI bool operator()(int q, int key) const { return sel[q] && (k0 + key <= t[q]); } };
struct NoMask { DI bool operator()(int, int) const { return true; } };
DI void nsa_unit(const Ctx& C, int l, int b, int tbk, int& bl) {
    const bf16 *QN = WSP(bf16, R_QN), *QR = WSP(bf16, R_QR), *KSb = WSP(bf16, R_KS), *KWb = WSP(bf16, R_KW), *PROJ = WSP(bf16, R_PROJ); const float* CMP = WSP(float, R_CMP); const float* GATE = WSP(float, R_GATE);
    bf16* YCAT = WSP(bf16, R_YCAT);
    LAS uchar* Kc = C.lds + NSA_KC; LAS uchar* Vc = C.lds + NSA_VC; LAS uchar* Ks = C.lds + NSA_KT; LAS uchar* Vs = C.lds + NSA_VT;
    LAS float* imps = (LAS float*)(C.lds + NSA_IMP); LAS unsigned* selm = (LAS unsigned*)(C.lds + NSA_SELM); LAS unsigned* uw = (LAS unsigned*)(C.lds + NSA_UW);
    int tid = C.tid, lane = C.lane; asm volatile("" : "+v"(tid), "+v"(lane));
    const int w = C.wave, l15 = lane & 15, quad = lane >> 4, head = l15 & 3, t0 = 64 * tbk; const size_t tb = (size_t)b * NS;
    __syncthreads();
    if (b != bl) {
        const int key = tid >> 1, hf = tid & 1; const float* kp = CMP + ((size_t)b * 256 + key) * 64 + 32 * hf; const float* vp = CMP + ((size_t)2048 + (size_t)b * 256 + key) * 64 + 32 * hf;
        float kv[32], vv[32]; float ss = 0.f;
#pragma unroll
        for (int i = 0; i < 8; ++i) { const f32x4 a = *(const f32x4*)(kp + 4 * i), c = *(const f32x4*)(vp + 4 * i);
#pragma unroll
            for (int j = 0; j < 4; ++j) { kv[4 * i + j] = a[j]; vv[4 * i + j] = c[j]; ss += a[j] * a[j]; } }
        ss += __shfl_xor(ss, 1); const float rstd = rsqrtf(ss * (1.f / 64.f) + 1e-6f); const float* g = C.nsa_kc_g + (size_t)l * 64 + 32 * hf; const bool dead = (key == 255);
#pragma unroll
        for (int i = 0; i < 4; ++i) { u32x4 o, p;
            o.x = pk2(kv[8 * i] * rstd * g[8 * i], kv[8 * i + 1] * rstd * g[8 * i + 1]); o.y = pk2(kv[8 * i + 2] * rstd * g[8 * i + 2], kv[8 * i + 3] * rstd * g[8 * i + 3]);
            o.z = pk2(kv[8 * i + 4] * rstd * g[8 * i + 4], kv[8 * i + 5] * rstd * g[8 * i + 5]); o.w = pk2(kv[8 * i + 6] * rstd * g[8 * i + 6], kv[8 * i + 7] * rstd * g[8 * i + 7]);
            p.x = pk2(vv[8 * i], vv[8 * i + 1]); p.y = pk2(vv[8 * i + 2], vv[8 * i + 3]); p.z = pk2(vv[8 * i + 4], vv[8 * i + 5]); p.w = pk2(vv[8 * i + 6], vv[8 * i + 7]);
            if (dead) { o = (u32x4){0u, 0u, 0u, 0u}; p = o; }
            *(LAS u32x4*)(Kc + key * KROW + hf * 64 + i * 16) = o; *(LAS u32x4*)(Vc + key * KROW + hf * 64 + i * 16) = p; }
        bl = b;
        __syncthreads();
    }
    f32x4 Oc[2][4];
    const int cmaxu = (t0 + 32) >> 4, ktmax = cmaxu >> 4;
    const unsigned vaddr0 = (unsigned)(size_t)(Vc + (4 * quad + (l15 >> 2)) * KROW + 8 * (l15 & 3));
#pragma unroll
    for (int q = 0; q < 2; ++q) {
        const int t = t0 + 8 * w + 4 * q + (l15 >> 2);
        bf16x8 Q[2]; q_load(Q, QN + (tb + t) * 256 + head * 64, quad);
        f32x4 S[16]; float mx = -1e30f;
#pragma unroll
        for (int kt = 0; kt < 16; ++kt) {
            if (kt <= ktmax) {
                const bf16x8 k0 = *(const LAS bf16x8*)(Kc + (16 * kt + l15) * KROW + quad * 16), k1 = *(const LAS bf16x8*)(Kc + (16 * kt + l15) * KROW + 64 + quad * 16);
                S[kt] = MFMA16(k0, Q[0], ((f32x4){0.f, 0.f, 0.f, 0.f})); S[kt] = MFMA16(k1, Q[1], S[kt]);
#pragma unroll
                for (int j = 0; j < 4; ++j) { const int c = 16 * kt + 4 * quad + j; const float s = (16 * c + 31 <= t) ? S[kt][j] : -1e30f; S[kt][j] = s; mx = fmaxf(mx, s); }
            } else S[kt] = (f32x4){-1e30f, -1e30f, -1e30f, -1e30f};
        }
        mx = fmaxf(mx, __shfl_xor(mx, 16)); mx = fmaxf(mx, __shfl_xor(mx, 32));
        float ls = 0.f;
#pragma unroll
        for (int kt = 0; kt < 16; ++kt)
#pragma unroll
            for (int j = 0; j < 4; ++j) { const float s = S[kt][j]; const float p = (s > -1e29f) ? fexp2(s - mx) : 0.f; S[kt][j] = p; ls += p; }
        ls += __shfl_xor(ls, 16); ls += __shfl_xor(ls, 32);
        const float inv = ls > 0.f ? 1.f / ls : 0.f;
#pragma unroll
        for (int kt = 0; kt < 16; ++kt) S[kt] = S[kt] * inv;
#pragma unroll
        for (int kt = 0; kt < 16; ++kt) {
            const float send = (quad == 3) ? (kt > 0 ? S[kt > 0 ? kt - 1 : 0][3] : 0.f) : S[kt][3];
            const float prev = __shfl(send, (lane + 48) & 63);
            float v = ((quad == 0 && kt == 0) ? 0.f : prev) + 2.f * (S[kt][0] + S[kt][1] + S[kt][2]) + S[kt][3];
            v += __shfl_xor(v, 1); v += __shfl_xor(v, 2);
            if (head == 0) imps[(8 * w + 4 * q + (l15 >> 2)) * 64 + 4 * kt + quad] = v;
        }
#pragma unroll
        for (int d = 0; d < 4; ++d) Oc[q][d] = (f32x4){0.f, 0.f, 0.f, 0.f};
#pragma unroll
        for (int ks = 0; ks < 8; ++ks) {
            if (2 * ks <= ktmax) {
                VFrag vf; vt_issue(vf, vaddr0 + ks * 32 * KROW); const bf16x8 pf = pack8(S[2 * ks], S[2 * ks + 1]); vt_wait(vf);
#pragma unroll
                for (int d = 0; d < 4; ++d) Oc[q][d] = MFMA16(vt_get(vf, d), pf, Oc[q][d]);
            }
        }
    }
    {
        float* OCm = WSP(float, R_OCMP);
#pragma unroll
        for (int q = 0; q < 2; ++q) { float* o = OCm + (tb + t0 + 8 * w + 4 * q + (l15 >> 2)) * 256 + head * 64 + 4 * quad;
#pragma unroll
            for (int d = 0; d < 4; ++d) *(f32x4*)(o + 16 * d) = Oc[q][d]; }
    }
    __syncthreads();
    if (tid < 64) {
        const int cur = tbk; unsigned long long mask;
        if (cur <= 15) mask = (2ull << cur) - 1ull;
        else {
            mask = 1ull | (1ull << cur) | (1ull << (cur - 1));
            float v[64];
#pragma unroll
            for (int i = 0; i < 16; ++i) { const f32x4 a = *(const LAS f32x4*)(imps + tid * 64 + 4 * i);
#pragma unroll
                for (int j = 0; j < 4; ++j) { const int jb = 4 * i + j; v[jb] = (jb >= 1 && jb <= cur - 2) ? a[j] : -1.f; } }
#pragma unroll 1
            for (int r = 0; r < 13; ++r) {
                float bv = -0.5f; int bi = 0;
#pragma unroll
                for (int jb = 0; jb < 64; ++jb) if (v[jb] > bv) { bv = v[jb]; bi = jb; }
                mask |= 1ull << bi;
#pragma unroll
                for (int jb = 0; jb < 64; ++jb) v[jb] = (jb == bi) ? -1.f : v[jb];
            }
        }
        unsigned lo = (unsigned)mask, hi = (unsigned)(mask >> 32);
        selm[2 * tid] = lo; selm[2 * tid + 1] = hi;
#pragma unroll
        for (int o = 1; o < 64; o <<= 1) { lo |= __shfl_xor(lo, o); hi |= __shfl_xor(hi, o); }
        if (tid == 0) { uw[0] = lo; uw[1] = hi; }
    }
    __syncthreads();
    unsigned long long U = ((unsigned long long)uw[1] << 32) | uw[0];
    bf16x8 Q[2][2]; SlcMask mk; FA<2> st; fa_init(st); unsigned long long msk[2];
#pragma unroll
    for (int q = 0; q < 2; ++q) { const int tl = 8 * w + 4 * q + (l15 >> 2); mk.t[q] = t0 + tl; msk[q] = ((unsigned long long)selm[2 * tl + 1] << 32) | selm[2 * tl]; q_load(Q[q], QR + (tb + mk.t[q]) * 256 + head * 64, quad); }
    unsigned long long QM[2];
#pragma unroll
    for (int q = 0; q < 2; ++q) { unsigned lo = (unsigned)msk[q], hi = (unsigned)(msk[q] >> 32);
#pragma unroll
        for (int o = 1; o < 64; o <<= 1) { lo |= __shfl_xor(lo, o); hi |= __shfl_xor(hi, o); }
        QM[q] = ((unsigned long long)hi << 32) | lo; }
    u32x4 kr, vr;
#define SLC_LOAD(j) do { const size_t rowk = tb + 64 * (j) + (tid >> 3); kr = *(const u32x4*)(KSb + rowk * 64 + (tid & 7) * 8); vr = *(const u32x4*)(PROJ + rowk * NPJ + 3008 + (tid & 7) * 8); } while (0)
    {
        int j = __builtin_ctzll(U); U &= U - 1ull;
        SLC_LOAD(j);
        for (;;) {
            __syncthreads(); kv_store(Ks, Vs, tid, kr, vr); __syncthreads();
            const int jn = U ? __builtin_ctzll(U) : -1; U &= U - 1ull;
            if (jn >= 0) SLC_LOAD(jn);
            const bool act[2] = {(bool)((QM[0] >> j) & 1ull), (bool)((QM[1] >> j) & 1ull)};
            if (act[0] || act[1]) { mk.k0 = 64 * j; mk.sel[0] = (msk[0] >> j) & 1ull; mk.sel[1] = (msk[1] >> j) & 1ull; fa_tile<2, true>(st, Q, Ks, Vs, lane, mk, act); }
            if (jn < 0) break; j = jn;
        }
    }
#undef SLC_LOAD
    float lse2[2]; fa_finish<2>(st, lse2);
    {   float* OSl = WSP(float, R_OSLC);
#pragma unroll
        for (int q = 0; q < 2; ++q) { float* o = OSl + (tb + mk.t[q]) * 256 + head * 64 + 4 * quad;
#pragma unroll
            for (int d = 0; d < 4; ++d) *(f32x4*)(o + 16 * d) = st.O[q][d]; }
    }
    FA<2> sw; fa_init(sw); SwaMask mw; mw.t[0] = mk.t[0]; mw.t[1] = mk.t[1];
    {
        const int j0 = tbk >= 8 ? tbk - 8 : 0; const bool act[2] = {true, true};
#define SWA_LOAD(j) do { const size_t rowk = tb + 64 * (j) + (tid >> 3); kr = *(const u32x4*)(KWb + rowk * 64 + (tid & 7) * 8); vr = *(const u32x4*)(PROJ + rowk * NPJ + 3136 + (tid & 7) * 8); } while (0)
        SWA_LOAD(j0);
        for (int j = j0; j <= tbk; ++j) {
            __syncthreads(); kv_store(Ks, Vs, tid, kr, vr); __syncthreads();
            if (j + 1 <= tbk) SWA_LOAD(j + 1);
            mw.k0 = 64 * j;
            if (j == tbk || j == tbk - 8) fa_tile<2, true>(sw, Q, Ks, Vs, lane, mw, act);
            else fa_tile<2, false>(sw, Q, Ks, Vs, lane, NoMask(), act);
        }
#undef SWA_LOAD
    }
    fa_finish<2>(sw, lse2);
#pragma unroll
    for (int q = 0; q < 2; ++q) {
        const size_t row = tb + mk.t[q]; const float* gp = GATE + row * 12 + head * 3; const float g0 = gp[0], g1 = gp[1], g2 = gp[2];
        f32x4 o[4]; float ss = 0.f; const float* pc = WSP(float, R_OCMP) + row * 256 + head * 64 + 4 * quad; const float* ps = WSP(float, R_OSLC) + row * 256 + head * 64 + 4 * quad;
#pragma unroll
        for (int d = 0; d < 4; ++d) { o[d] = *(const f32x4*)(pc + 16 * d) * g0 + *(const f32x4*)(ps + 16 * d) * g1 + sw.O[q][d] * g2; ss += (o[d][0] * o[d][0] + o[d][1] * o[d][1]) + (o[d][2] * o[d][2] + o[d][3] * o[d][3]); }
        ss += __shfl_xor(ss, 16); ss += __shfl_xor(ss, 32);
        const float rstd = rsqrtf(ss * (1.f / 64.f) + 1e-6f); const float* og = C.onorm_g + (size_t)l * 768 + 512 + head * 64 + 4 * quad;
        bf16* yo = YCAT + row * DM + 768 + head * 64 + 4 * quad;
#pragma unroll
        for (int d = 0; d < 4; ++d) { const f32x4 g4 = *(const f32x4*)(og + 16 * d); u32x2 wv; wv.x = pk2(o[d][0] * rstd * g4[0], o[d][1] * rstd * g4[1]); wv.y = pk2(o[d][2] * rstd * g4[2], o[d][3] * rstd * g4[3]); *(u32x2*)(yo + 16 * d) = wv; }
    }
}

DI void fin_phase(const Ctx& C, int l) {
    const float* SC = WSP(float, R_SC); const float* YA = WSP(float, R_YA); const float* Gb = WSP(float, R_G); const float* OC = WSP(float, R_OC); const float* LSE = WSP(float, R_LSE);
    bf16* YCAT = WSP(bf16, R_YCAT);
    const int lane = C.lane, gw = C.bid * NWAVE + C.wave, NGW = C.G * NWAVE, ch = 4 * lane, hh = lane >> 4;
    for (int row = gw; row < NT; row += NGW) {
        const size_t o = (size_t)row * 256 + ch;
        {
            const f32x4 y = *(const f32x4*)(YA + o), r = *(const f32x4*)(SC + (size_t)4 * NT * 256 + o), k = *(const f32x4*)(SC + (size_t)1 * NT * 256 + o), v = *(const f32x4*)(SC + (size_t)5 * NT * 256 + o), g = *(const f32x4*)(Gb + o);
            const f32x4 rk = *(const f32x4*)(C.rk + (size_t)l * 256 + ch), gw4 = *(const f32x4*)(C.gn_w + (size_t)l * 256 + ch), gb4 = *(const f32x4*)(C.gn_b + (size_t)l * 256 + ch);
            const float mu = group_sum<16>((y[0] + y[1]) + (y[2] + y[3])) * (1.f / 64.f);
            const f32x4 dy = y - mu; const float var = group_sum<16>((dy[0] * dy[0] + dy[1] * dy[1]) + (dy[2] * dy[2] + dy[3] * dy[3])) * (1.f / 64.f);
            const float rstd = rsqrtf(var + 64e-5f);
            const float dot = group_sum<16>((r[0] * k[0] * rk[0] + r[1] * k[1] * rk[1]) + (r[2] * k[2] * rk[2] + r[3] * k[3] * rk[3]));
            float out[4];
#pragma unroll
            for (int i = 0; i < 4; ++i) out[i] = ((dy[i] * rstd * gw4[i] + gb4[i]) + dot * v[i]) * g[i];
            u32x2 w; w.x = pk2(out[0], out[1]); w.y = pk2(out[2], out[3]); *(u32x2*)(YCAT + (size_t)row * DM + ch) = w;
        }
        {
            const float l0 = LSE[(size_t)row * 4 + hh], l1 = LSE[((size_t)NT + row) * 4 + hh], l2 = LSE[((size_t)2 * NT + row) * 4 + hh];
            const float mx = fmaxf(l0, fmaxf(l1, l2)); float w0 = fexp2(l0 - mx), w1 = fexp2(l1 - mx), w2 = fexp2(l2 - mx); const float inv = 1.f / (w0 + w1 + w2); w0 *= inv; w1 *= inv; w2 *= inv;
            const f32x4 a = *(const f32x4*)(OC + o), b = *(const f32x4*)(OC + (size_t)NT * 256 + o), c = *(const f32x4*)(OC + (size_t)2 * NT * 256 + o);
            const f32x4 y = a * w0 + b * w1 + c * w2;
            const float ss = group_sum<16>((y[0] * y[0] + y[1] * y[1]) + (y[2] * y[2] + y[3] * y[3])); const float rstd = rsqrtf(ss * (1.f / 64.f) + 1e-6f);
            const f32x4 og = *(const f32x4*)(C.onorm_g + (size_t)l * 768 + 256 + ch);
            u32x2 w; w.x = pk2(y[0] * rstd * og[0], y[1] * rstd * og[1]); w.y = pk2(y[2] * rstd * og[2], y[3] * rstd * og[3]); *(u32x2*)(YCAT + (size_t)row * DM + 512 + ch) = w;
        }
    }
}

constexpr int CW_Q = 40000;
DI int q_next(const Ctx& C, unsigned* ctr, LAS int* slot) {
    __syncthreads();
    if (C.tid == 0) *slot = (int)__hip_atomic_fetch_add(ctr, 1u, __ATOMIC_RELAXED, __HIP_MEMORY_SCOPE_AGENT);
    __syncthreads();
    return *slot;
}
DI void conv_ticket(const Ctx& C, int l, int tk);
DI void mix_phase(const Ctx& C, int l) {
    unsigned* ctl = WSP(unsigned, WS_CTL) + CW_Q + 64 * 3 * l; LAS int* slot = (LAS int*)(C.lds + MISC_OFF + 1024);
#ifndef PROBE_SCAN2
#define PROBE_SCAN2 0
#endif
#ifndef PROBE_ATT2
#define PROBE_ATT2 0
#endif
    if (C.bid < 64) { scan_unit(C, C.bid); if (PROBE_SCAN2) scan_unit(C, C.bid); }
    int bl = -1;
    for (;;) { const int u = q_next(C, ctl, slot); if (u >= 512 * (1 + PROBE_ATT2)) break; nsa_unit(C, l, u & 7, 63 - ((u & 511) >> 3), bl); }
    for (;;) { const int u = q_next(C, ctl + 64, slot); if (u >= 1536 * (1 + PROBE_ATT2)) break; dil_unit(C, u % 1536, C.lds, C.lds + KT_BYTES); }
    for (;;) { const int u = q_next(C, ctl + 128, slot); if (u >= 768) break; conv_ticket(C, l, u); }
    __syncthreads();
}
#define MFMA_F32(a, b, c) __builtin_amdgcn_mfma_f32_16x16x4f32((a), (b), (c), 0, 0, 0)
DI void router_phase(const Ctx& C, int l) {
    const float* X = C.out; const float* MOD = WSP(float, WS_SMALL) + (size_t)l * 8 * 6144; bf16* H = WSP(bf16, WS_H);
    int* TOPE = WSP(int, WS_ROUTE); float* TOPG = (float*)(TOPE + NT * 4); unsigned* CNTB = WSP(unsigned, WS_CTL) + CW_CNT + l * 8192;
    LAS float* lg = (LAS float*)C.lds + C.wave * 512;
    LAS unsigned* hist = (LAS unsigned*)(C.lds + 16384);
    const int lane = C.lane, l15 = lane & 15, quad = lane >> 4, gw = C.bid * NWAVE + C.wave, NGW = C.G * NWAVE;
    if (C.tid < 32) hist[C.tid] = 0u;
    __syncthreads();
    const float* wr = C.w_router + (size_t)l * 1024 * 32; const float* g2 = C.norm2_g + (size_t)l * DM;
    for (int task = gw; task < NT / 16; task += NGW) {
        const int row0 = 16 * task, b = row0 / NS; const float* xr = X + (size_t)(row0 + l15) * DM + 4 * quad;
        const float* sh = MOD + (size_t)b * 6144 + 3072 + 4 * quad; const float* sc = sh + 1024;
        float ss = 0.f;
#pragma unroll 8
        for (int i = 0; i < 64; ++i) { const f32x4 a = *(const f32x4*)(xr + 16 * i); ss += (a[0] * a[0] + a[1] * a[1]) + (a[2] * a[2] + a[3] * a[3]); }
        ss += __shfl_xor(ss, 16); ss += __shfl_xor(ss, 32);
        const float rstd = rsqrtf(ss * (1.f / DM) + 1e-6f);
        f32x4 acc0 = (f32x4){0.f, 0.f, 0.f, 0.f}, acc1 = acc0;
        bf16* hrow = H + (size_t)(row0 + l15) * DM + 4 * quad;
#pragma unroll 2
        for (int i = 0; i < 64; ++i) {
            const f32x4 a = *(const f32x4*)(xr + 16 * i), g = *(const f32x4*)(g2 + 16 * i + 4 * quad), s1 = *(const f32x4*)(sc + 16 * i), s0 = *(const f32x4*)(sh + 16 * i);
            f32x4 h;
#pragma unroll
            for (int j = 0; j < 4; ++j) h[j] = a[j] * rstd * g[j] * (1.f + s1[j]) + s0[j];
            u32x2 o; o.x = pk2(h[0], h[1]); o.y = pk2(h[2], h[3]); *(u32x2*)(hrow + 16 * i) = o;
            const float* wp = wr + (size_t)(16 * i + 4 * quad) * 32 + l15;
#pragma unroll
            for (int j = 0; j < 4; ++j) { acc0 = MFMA_F32(h[j], wp[j * 32], acc0); acc1 = MFMA_F32(h[j], wp[j * 32 + 16], acc1); }
        }
        const float b0 = C.b_router[l * 32 + l15], b1 = C.b_router[l * 32 + 16 + l15];
#pragma unroll
        for (int j = 0; j < 4; ++j) { lg[(4 * quad + j) * 32 + l15] = acc0[j] + b0; lg[(4 * quad + j) * 32 + 16 + l15] = acc1[j] + b1; }
        asm volatile("s_waitcnt lgkmcnt(0)" ::: "memory");
        if (lane < 16) {
            float v[32];
#pragma unroll
            for (int i = 0; i < 8; ++i) { const f32x4 a = *(const LAS f32x4*)(lg + lane * 32 + 4 * i); v[4 * i] = a[0]; v[4 * i + 1] = a[1]; v[4 * i + 2] = a[2]; v[4 * i + 3] = a[3]; }
            float tv[4]; int ti[4];
#pragma unroll
            for (int r = 0; r < 4; ++r) { float bv = -3.0e38f; int bi = 0;
#pragma unroll
                for (int e = 0; e < 32; ++e) if (v[e] > bv) { bv = v[e]; bi = e; }
                tv[r] = bv; ti[r] = bi;
#pragma unroll
                for (int e = 0; e < 32; ++e) v[e] = (e == bi) ? -3.0e38f : v[e]; }
            const float e1 = __expf(tv[1] - tv[0]), e2 = __expf(tv[2] - tv[0]), e3 = __expf(tv[3] - tv[0]), inv = 1.f / (1.f + e1 + e2 + e3);
            const int row = row0 + lane;
            *(int4*)(TOPE + (size_t)row * 4) = make_int4(ti[0], ti[1], ti[2], ti[3]);
            *(f32x4*)(TOPG + (size_t)row * 4) = (f32x4){inv, e1 * inv, e2 * inv, e3 * inv};
#pragma unroll
            for (int r = 0; r < 4; ++r) __hip_atomic_fetch_add(&hist[ti[r]], 1u, __ATOMIC_RELAXED, __HIP_MEMORY_SCOPE_WORKGROUP);
        }
        asm volatile("s_waitcnt lgkmcnt(0)" ::: "memory");
    }
    __syncthreads();
    if (C.tid < 32) CNTB[C.bid * 32 + C.tid] = hist[C.tid];
}

DI void moe_tables(const Ctx& C, int l, LAS int* tab) {
    const unsigned* CNTB = WSP(unsigned, WS_CTL) + CW_CNT + l * 8192;
    __syncthreads();
    if (C.tid < 32) { unsigned tot = 0u, mine = 0u;
        for (int g = 0; g < C.G; ++g) { const unsigned c = CNTB[g * 32 + C.tid]; tot += c; mine += (g < C.bid) ? c : 0u; }
        tab[128 + C.tid] = (int)((tot + 255u) >> 8); tab[64 + C.tid] = (int)mine; }
    __syncthreads();
    if (C.tid == 0) { int s = 0; for (int e = 0; e < 32; ++e) { tab[e] = s; s += tab[128 + e]; } tab[32] = s; }
    __syncthreads();
}
DI void scatter_phase(const Ctx& C, int l) {
    const int* TOPE = WSP(int, WS_ROUTE); int* POS = (int*)(TOPE + NT * 8); int* ROWMAP = (int*)(TOPE + NT * 12);
    LAS int* tab = (LAS int*)(C.lds + MISC_OFF + 64); LAS unsigned* cur = (LAS unsigned*)(C.lds + 16384);
    moe_tables(C, l, tab);
    if (C.tid < 32) cur[C.tid] = (unsigned)(tab[C.tid] * 256 + tab[64 + C.tid]);
    __syncthreads();
    const int lane = C.lane, gw = C.bid * NWAVE + C.wave, NGW = C.G * NWAVE;
    for (int task = gw; task < NT / 16; task += NGW) {
        const int row0 = 16 * task, tok = row0 + (lane >> 2);
        const int e = TOPE[(size_t)tok * 4 + (lane & 3)];
        const int slot = (int)__hip_atomic_fetch_add(&cur[e], 1u, __ATOMIC_RELAXED, __HIP_MEMORY_SCOPE_WORKGROUP);
        POS[(size_t)tok * 4 + (lane & 3)] = slot; ROWMAP[slot] = tok;
    }
}
DI void combine_phase(const Ctx& C, int l) {
    const bf16* YB = WSP(bf16, R_YB); const int* TOPE = WSP(int, WS_ROUTE); const float* TOPG = (const float*)(TOPE + NT * 4); const int* POS = (const int*)(TOPE + NT * 8);
    const float* MOD = WSP(float, WS_SMALL) + (size_t)l * 8 * 6144; bf16* H = WSP(bf16, WS_H);
    const int lane = C.lane, gw = C.bid * NWAVE + C.wave, NGW = C.G * NWAVE;
    for (int row = gw; row < NT; row += NGW) {
        const int b = row / NS; const int4 ps = *(const int4*)(POS + (size_t)row * 4); const f32x4 gk = *(const f32x4*)(TOPG + (size_t)row * 4);
        const int pp[4] = {ps.x, ps.y, ps.z, ps.w};
        float* orow = C.out + (size_t)row * DM; const float* gt = MOD + (size_t)b * 6144 + 5120;
        f32x4 v[4]; float s = 0.f;
#pragma unroll
        for (int j = 0; j < 4; ++j) { const int k = 4 * lane + 256 * j; f32x4 a = (f32x4){0.f, 0.f, 0.f, 0.f};
#pragma unroll
            for (int q = 0; q < 4; ++q) { const u32x2 y = *(const u32x2*)(YB + (size_t)pp[q] * DM + k); a += (f32x4){bflo(y.x), bfhi(y.x), bflo(y.y), bfhi(y.y)} * gk[q]; }
            v[j] = *(const f32x4*)(orow + k) + *(const f32x4*)(gt + k) * a; *(f32x4*)(orow + k) = v[j];
            s += (v[j][0] * v[j][0] + v[j][1] * v[j][1]) + (v[j][2] * v[j][2] + v[j][3] * v[j][3]); }
        if (l + 1 < NLAYER) {
            s = group_sum<64>(s); const float rstd = rsqrtf(s * (1.f / DM) + 1e-6f); const float* M2 = MOD + 8 * 6144 + (size_t)b * 6144; const float* g = C.norm1_g + (size_t)(l + 1) * DM;
#pragma unroll
            for (int j = 0; j < 4; ++j) { const int k = 4 * lane + 256 * j; const f32x4 gg = *(const f32x4*)(g + k), a = *(const f32x4*)(M2 + 1024 + k), bb = *(const f32x4*)(M2 + k); f32x4 h;
#pragma unroll
                for (int i = 0; i < 4; ++i) h[i] = v[j][i] * rstd * gg[i] * (1.f + a[i]) + bb[i];
                u32x2 o; o.x = pk2(h[0], h[1]); o.y = pk2(h[2], h[3]); *(u32x2*)(H + (size_t)row * DM + k) = o; }
        }
    }
}
constexpr int PH_PER_LAYER = 11, PH_BASE = 2, N_PHASES = PH_BASE + NLAYER * PH_PER_LAYER;
#ifndef MK_ONE_LAUNCH
#define MK_ONE_LAUNCH 1
#endif
__global__ void __launch_bounds__(NTHR, 2) mk_fwd(Args args) {
    extern __shared__ __attribute__((aligned(16))) unsigned char lds_raw[];
    Ctx C;
    C.lds = (LAS unsigned char*)lds_raw; C.tid = threadIdx.x; C.lane = C.tid & 63; C.wave = __builtin_amdgcn_readfirstlane(C.tid >> 6); C.G = gridDim.x; C.bid = blockIdx.x;
    C.x = (const float*)args.in[0]; C.c = (const float*)args.in[1]; C.pos = (const int*)args.in[2]; C.w_ada = (const float*)args.in[3]; C.b_ada = (const float*)args.in[4];
    C.norm1_g = (const float*)args.in[5]; C.norm2_g = (const float*)args.in[6]; C.w_in = (const float*)args.in[7]; C.w_out = (const float*)args.in[8]; C.mu = (const float*)args.in[9];
    C.w0 = (const float*)args.in[10]; C.w2 = (const float*)args.in[11]; C.a0 = (const float*)args.in[12]; C.a2 = (const float*)args.in[13]; C.g2 = (const float*)args.in[14];
    C.kkw = (const float*)args.in[15]; C.ka = (const float*)args.in[16]; C.rk = (const float*)args.in[17]; C.gn_w = (const float*)args.in[18]; C.gn_b = (const float*)args.in[19];
    C.conv_w = (const float*)args.in[20]; C.dil_q_g = (const float*)args.in[21]; C.dil_k_g = (const float*)args.in[22]; C.nsa_q_g = (const float*)args.in[23]; C.nsa_kc_g = (const float*)args.in[24];
    C.nsa_ks_g = (const float*)args.in[25]; C.nsa_kw_g = (const float*)args.in[26]; C.pe_k = (const float*)args.in[27]; C.pe_v = (const float*)args.in[28]; C.wk1 = (const float*)args.in[29];
    C.wk2 = (const float*)args.in[30]; C.wv1 = (const float*)args.in[31]; C.wv2 = (const float*)args.in[32]; C.onorm_g = (const float*)args.in[33]; C.w_router = (const float*)args.in[34];
    C.b_router = (const float*)args.in[35]; C.w_gu = (const float*)args.in[36]; C.b_gu = (const float*)args.in[37]; C.w_down = (const float*)args.in[38]; C.b_down = (const float*)args.in[39];
    C.out = args.out; C.ws = args.ws;
    const int lo = args.ph_lo, hi = args.ph_hi;
    for (int u = C.tid; u < (LDS_BYTES - MISC_OFF) / 4; u += NTHR) ((LAS unsigned*)(C.lds + MISC_OFF))[u] = 0u;
    __syncthreads();
    XcdBarrier bar; bar.bar = WSP(unsigned, WS_CTL) + CW_BAR; bar.x = 0; bar.st = nullptr;
    if (hi - lo > 1) bar = xcd_barrier_post(WSP(unsigned, WS_CTL) + CW_BAR, (volatile LAS unsigned*)(C.lds + MISC_OFF));
#ifndef PHMASK
#define PHMASK 0xFFFFFFFFu
#endif
#define PHON(n) (((PHMASK) >> (n)) & 1u)
#ifndef PHREP
#define PHREP 0u
#endif
#define NREP(n) (1 + (int)(((PHREP) >> (n)) & 1u))
#define WSPP(T, off) ((T*)(P.ws + (off)))
#define IN(k) (lo <= (k) && (k) < hi)
#define SEAM(k) do { if (IN(k) && IN((k) + 1)) xcd_barrier(bar); } while (0)
#define PCTX Ctx P = C; asm volatile("" : "+v"(P.tid), "+v"(P.lane)); asm volatile("" : "+s"(P.ws), "+s"(P.out), "+s"(P.wave), "+s"(P.bid))
    if (PHON(17) && IN(0)) for (int rep = 0; rep < NREP(17); ++rep) { PCTX; p0_prologue(P); __syncthreads(); }
    SEAM(0);
    if (PHON(18) && IN(1)) { PCTX; norm1_phase(P, 0, P.x); }
    SEAM(1);
    for (int l = 0; l < NLAYER; ++l) {
        const int pb = PH_BASE + PH_PER_LAYER * l;
        if (PHON(0) && IN(pb + 0)) for (int rep = 0; rep < NREP(0); ++rep) { PCTX;
            pg8::Gemm g{WSPP(bf16, WS_H), WSPP(bf16, WS_WIN) + (size_t)l * NPJ * 1024, 1024, 1024}; pg8::StaticOrder S; S.init(NT / 256, NPJ / 256, P.G, P.bid);
            EpiProj E{WSPP(bf16, R_PROJ)}; pg8::gemm_phase(P.lds, P.tid, g, S, E);
        }
        SEAM(pb + 0);
        if (PHON(1) && IN(pb + 1)) for (int rep = 0; rep < NREP(1); ++rep) { PCTX; prep_phase(P, l); __syncthreads(); }
        SEAM(pb + 1);
        if (PHON(2) && IN(pb + 2)) { PCTX;
            { pg8::Gemm g{WSPP(bf16, R_LIN), WSPP(bf16, WS_LORA) + (size_t)l * 768 * 256, 256, 256}; pg8::StaticOrder S; S.init(NT / 256, 3, P.G, P.bid);
              EpiLora E{WSPP(float, R_SC), WSPP(float, R_G), P.w0 + l * 256, P.a0 + l * 256, P.ka + l * 256}; pg8::gemm_phase(P.lds, P.tid, g, S, E); }
            { pg8::Gemm g{WSPP(bf16, R_KCR), WSPP(bf16, WS_WK1) + (size_t)(l * 2) * 256 * 2048, 1024, 2048}; pg8::StaticOrder S; S.init(8, 1, P.G, (P.bid + 64) % P.G);
              EpiC1 E{WSPP(bf16, R_CH1), (WSPP(float, WS_SMALL) + NLAYER * 8 * 6144 + l * 512)}; pg8::gemm_phase(P.lds, P.tid, g, S, E); }
            { pg8::Gemm g{WSPP(bf16, R_VCR), WSPP(bf16, WS_WK1) + (size_t)(l * 2 + 1) * 256 * 2048, 1024, 2048}; pg8::StaticOrder S; S.init(8, 1, P.G, (P.bid + 128) % P.G);
              EpiC1 E{WSPP(bf16, R_CH1) + 2048 * 256, (WSPP(float, WS_SMALL) + NLAYER * 8 * 6144 + l * 512 + 256)}; pg8::gemm_phase(P.lds, P.tid, g, S, E); }
            asm volatile("s_waitcnt vmcnt(0)" ::: "memory"); __syncthreads();
            { pg8::Gemm g{WSPP(bf16, R_CH1), WSPP(bf16, WS_WK2) + (size_t)(l * 2) * 256 * 256, 256, 256}; pg8::StaticOrder S; S.init(8, 1, P.G, (P.bid + 64) % P.G);
              EpiC2 E{WSPP(float, R_CMP)}; pg8::gemm_phase(P.lds, P.tid, g, S, E); }
            { pg8::Gemm g{WSPP(bf16, R_CH1) + 2048 * 256, WSPP(bf16, WS_WK2) + (size_t)(l * 2 + 1) * 256 * 256, 256, 256}; pg8::StaticOrder S; S.init(8, 1, P.G, (P.bid + 128) % P.G);
              EpiC2 E{WSPP(float, R_CMP) + 2048 * 64}; pg8::gemm_phase(P.lds, P.tid, g, S, E); }
        }
        SEAM(pb + 2);
        if (PHON(3) && IN(pb + 3)) { PCTX; mix_phase(P, l); }
        SEAM(pb + 3);
        if (PHON(4) && IN(pb + 4)) for (int rep = 0; rep < NREP(4); ++rep) { PCTX; fin_phase(P, l); __syncthreads(); }
        SEAM(pb + 4);
        if (PHON(5) && IN(pb + 5)) { PCTX;
            pg8::Gemm g{WSPP(bf16, R_YCAT), WSPP(bf16, WS_WOUT) + (size_t)l * 1024 * 1024, 1024, 1024}; pg8::StaticOrder S; S.init(NT / 256, 4, P.G, P.bid);
            EpiOut E{P.out, l == 0 ? P.x : (const float*)P.out, WSPP(float, WS_SMALL) + (size_t)l * 8 * 6144 + 2048}; pg8::gemm_phase(P.lds, P.tid, g, S, E);
        }
        SEAM(pb + 5);
        if (PHON(6) && IN(pb + 6)) for (int rep = 0; rep < NREP(6); ++rep) { PCTX; router_phase(P, l); __syncthreads(); }
        SEAM(pb + 6);
        if (PHON(7) && IN(pb + 7)) for (int rep = 0; rep < NREP(7); ++rep) { PCTX; scatter_phase(P, l); __syncthreads(); }
        SEAM(pb + 7);
        if (PHON(8) && IN(pb + 8)) for (int rep = 0; rep < NREP(8); ++rep) { PCTX;
            LAS int* tab = (LAS int*)(P.lds + MISC_OFF + 64); moe_tables(P, l, tab);
            pg8::Gemm g{WSPP(bf16, WS_H), WSPP(bf16, WS_WGU) + (size_t)l * 32 * 2048 * 1024, 1024, 1024, WSPP(int, WS_ROUTE) + NT * 12}; pg8::GroupedOrder S; S.init(tab[32], 8, P.G, P.bid); S.tstart = tab; S.nrow_e = 2048;
            EpiGU E{WSPP(bf16, R_ACT), P.b_gu + (size_t)l * 32 * 2048}; pg8::gemm_phase<EpiGU, pg8::GroupedOrder, true>(P.lds, P.tid, g, S, E);
        }
        SEAM(pb + 8);
        if (PHON(9) && IN(pb + 9)) for (int rep = 0; rep < NREP(9); ++rep) { PCTX;
            LAS int* tab = (LAS int*)(P.lds + MISC_OFF + 64); moe_tables(P, l, tab);
            pg8::Gemm g{WSPP(bf16, R_ACT), WSPP(bf16, WS_WDN) + (size_t)l * 32 * 1024 * 1024, 1024, 1024}; pg8::GroupedOrder S; S.init(tab[32], 4, P.G, P.bid); S.tstart = tab; S.nrow_e = 1024;
            EpiDN E{WSPP(bf16, R_YB), P.b_down + (size_t)l * 32 * 1024}; pg8::gemm_phase(P.lds, P.tid, g, S, E);
        }
        SEAM(pb + 9);
        if (PHON(10) && IN(pb + 10)) { PCTX; combine_phase(P, l); }
        SEAM(pb + 10);
    }
#undef IN
#undef SEAM
}

extern "C" void kernel_launch(void* const* d_in, const int* in_sizes, int n_in, void* d_out, int out_size, void* d_ws, size_t ws_size, hipStream_t stream) {
    static int grid = 0;
    if (grid == 0) {
        if (n_in != 40 || out_size != NT * DM || ws_size < WS_END) { fprintf(stderr, "kernel_launch: unexpected problem (n_in %d, out %d, ws %zu < %zu)\n", n_in, out_size, ws_size, (size_t)WS_END); grid = -1; return; }
        int dev = 0, cus = 0, per_cu = 0;
        if (hipGetDevice(&dev) != hipSuccess || hipDeviceGetAttribute(&cus, hipDeviceAttributeMultiprocessorCount, dev) != hipSuccess) { grid = -1; return; }
        if (hipFuncSetAttribute((const void*)mk_fwd, hipFuncAttributeMaxDynamicSharedMemorySize, LDS_BYTES) != hipSuccess) { fprintf(stderr, "kernel_launch: hipFuncSetAttribute failed\n"); grid = -1; return; }
        if (hipOccupancyMaxActiveBlocksPerMultiprocessor(&per_cu, (const void*)mk_fwd, NTHR, LDS_BYTES) != hipSuccess || per_cu < 1) fprintf(stderr, "kernel_launch: occupancy query says %d blocks per CU\n", per_cu);
        (void)hipGetLastError();
        grid = cus > 256 ? 256 : cus;
    }
    if (grid < 0) return;
    (void)hipMemsetAsync((char*)d_ws, 0, ZERO_BYTES, stream);
    Args a{};
    for (int i = 0; i < 40; ++i) a.in[i] = d_in[i];
    a.out = (float*)d_out; a.ws = (unsigned char*)d_ws;
#if MK_ONE_LAUNCH
    a.ph_lo = 0; a.ph_hi = N_PHASES;
    hipLaunchKernelGGL(mk_fwd, dim3(grid), dim3(NTHR), LDS_BYTES, stream, a);
#else
    for (int p = 0; p < N_PHASES; ++p) { a.ph_lo = p; a.ph_hi = p + 1; hipLaunchKernelGGL(mk_fwd, dim3(grid), dim3(NTHR), LDS_BYTES, stream, a); }
#endif
    const hipError_t le = hipPeekAtLastError();
    if (le != hipSuccess) fprintf(stderr, "kernel_launch: launch failed: %s\n", hipGetErrorName(le));
}
```

```cpp
#include <hip/hip_runtime.h>
#include <cstdio>
#include <cstdint>

#define DI __device__ __forceinline__
#define LAS __attribute__((address_space(3)))
#define GAS __attribute__((address_space(1)))
typedef unsigned short bf16;
typedef short bf16x8 __attribute__((ext_vector_type(8)));
typedef float f32x4 __attribute__((ext_vector_type(4)));
typedef float f32x2 __attribute__((ext_vector_type(2)));
typedef unsigned u32x4 __attribute__((ext_vector_type(4)));
typedef unsigned u32x2 __attribute__((ext_vector_type(2)));
typedef unsigned char uchar;

constexpr int NB = 8, NS = 4096, NT = NB * NS, DM = 1024, NPJ = 3328, NE = 32, FF = 1024, NLAYER = 2;
constexpr int PJ_A = 0, PJ_B = 1024, PJ_C = 1792, PJ_D = 2560;
constexpr int NR = NT * 4 + NE * 256;
constexpr int NTHR = 512, NWAVE = 8;

DI float bf2f(unsigned v) { return __builtin_bit_cast(float, v << 16); }
DI unsigned f2bf(float f) { unsigned u = __builtin_bit_cast(unsigned, f); return (u + 0x7fffu + ((u >> 16) & 1u)) >> 16; }
DI unsigned pk2(float lo, float hi) { return f2bf(lo) | (f2bf(hi) << 16); }
DI float bflo(unsigned w) { return __builtin_bit_cast(float, w << 16); }
DI float bfhi(unsigned w) { return __builtin_bit_cast(float, w & 0xffff0000u); }
DI float fexp2(float x) { return __builtin_amdgcn_exp2f(x); }
DI float fsigmoid(float x) { return 1.f / (1.f + __expf(-x)); }
DI float wsum_xor(float v, int o) { return v + __shfl_xor(v, o); }
template <int W> DI float group_sum(float v) {
#pragma unroll
    for (int o = 1; o < W; o <<= 1) v += __shfl_xor(v, o);
    return v;
}
DI float dpp_f(float x, const int ctrl_dummy);
template <int CTRL> DI float dppmov(float x) { return __builtin_bit_cast(float, __builtin_amdgcn_update_dpp(0, __builtin_bit_cast(int, x), CTRL, 0xF, 0xF, true)); }
DI float sum8(float x) { x += dppmov<0xB1>(x); x += dppmov<0x4E>(x); x += dppmov<0x141>(x); return x; }

#define XB_TMO      128
#define XB_XCNT(j)  (256  + 64 * (j))
#define XB_XSUB(j)  (1280 + 64 * (j))
#define XB_XGEN(j)  (2304 + 64 * (j))
#define XB_TOP      3328
#define XB_TOPGEN   3392
#define XCD_BAR_WORDS 3456
#define XB_SPIN_CAP (1u << 18)
DI unsigned xb_ld(unsigned* p)              { return __hip_atomic_load(p, __ATOMIC_RELAXED, __HIP_MEMORY_SCOPE_AGENT); }
DI unsigned xb_add(unsigned* p, unsigned v) { return __hip_atomic_fetch_add(p, v, __ATOMIC_RELAXED, __HIP_MEMORY_SCOPE_AGENT); }
DI unsigned xb_xcc_id() { return (unsigned)__builtin_amdgcn_s_getreg((3 << 11) | 20) & 0xFu; }
#define XB_SPIN(cond, bar) do { unsigned _sp = 0; while (cond) { __builtin_amdgcn_s_sleep(1); \
    if ((++_sp & 255u) == 0u) { if (xb_ld(&(bar)[XB_TMO])) break; if (_sp > XB_SPIN_CAP) { atomicAdd(&(bar)[XB_TMO], 1u); break; } } } } while (0)
struct XcdBarrier { unsigned* bar; unsigned x; volatile LAS unsigned* st; };
DI XcdBarrier xcd_barrier_post(unsigned* bar, volatile LAS unsigned* st) {
    XcdBarrier b; b.bar = bar; b.x = xb_xcc_id(); b.st = st;
    if (threadIdx.x == 0) (void)xb_add(&bar[XB_XCNT(b.x)], 1u);
    return b;
}
DI void xcd_barrier_complete(unsigned* bar, unsigned x, unsigned& nloc, unsigned& nx) {
    const unsigned G = gridDim.x * gridDim.y * gridDim.z;
    unsigned sum, cnt, mine, sp = 0u;
    for (;;) {
        sum = 0u; cnt = 0u; mine = 0u;
#pragma unroll
        for (unsigned j = 0; j < 16; ++j) { const unsigned c = xb_ld(&bar[XB_XCNT(j)]); sum += c; cnt += (c > 0u) ? 1u : 0u; mine = (j == x) ? c : mine; }
        if (sum == G) break;
        __builtin_amdgcn_s_sleep(1);
        if ((++sp & 255u) == 0u) { if (xb_ld(&bar[XB_TMO])) break; if (sp > XB_SPIN_CAP) { atomicAdd(&bar[XB_TMO], 1u); break; } }
    }
    nloc = mine > 0u ? mine : 1u; nx = cnt > 0u ? cnt : 1u;
}
DI void xcd_barrier(const XcdBarrier& b) {
    asm volatile("s_waitcnt vmcnt(0)" ::: "memory");
    __syncthreads();
    if (threadIdx.x == 0) {
        unsigned* bar = b.bar;
        __builtin_amdgcn_s_waitcnt(0);
        unsigned nloc = b.st[0], nx = b.st[1];
        if (nloc == 0u) { xcd_barrier_complete(bar, b.x, nloc, nx); b.st[0] = nloc; b.st[1] = nx; }
        const unsigned old = xb_add(&bar[XB_XSUB(b.x)], 1u);
        const unsigned gen = old / nloc;
        if (old + 1u == (gen + 1u) * nloc) {
            __builtin_amdgcn_fence(__ATOMIC_RELEASE, "agent");
            asm volatile("s_waitcnt vmcnt(0)" ::: "memory");
            const unsigned og = xb_add(&bar[XB_TOP], 1u);
            const unsigned tg = og / nx;
            if (og + 1u == (tg + 1u) * nx) xb_add(&bar[XB_TOPGEN], 1u);
            else XB_SPIN(xb_ld(&bar[XB_TOPGEN]) == tg, bar);
            __builtin_amdgcn_fence(__ATOMIC_ACQUIRE, "agent");
            xb_add(&bar[XB_XGEN(b.x)], 1u);
            asm volatile("s_waitcnt vmcnt(0)" ::: "memory");
        } else {
            XB_SPIN(xb_ld(&bar[XB_XGEN(b.x)]) == gen, bar);
            __builtin_amdgcn_fence(__ATOMIC_ACQUIRE, "agent");
            asm volatile("s_waitcnt vmcnt(0)" ::: "memory");
        }
    }
    __syncthreads();
}
namespace pg8 {
constexpr int BM = 256, BK = 64, HALF = 128, HTB = HALF * BK * 2, STAGE_BYTES = 8 * HTB, NXCD = 8, WGM = 8;
__host__ __device__ __forceinline__ int lds_byte(int r, int c) { const int st = (r >> 4) * 2 + (c >> 5), rr = r & 15, cc = c & 31, ob = rr * 64 + cc * 2; return st * 1024 + (ob ^ (((ob >> 9) & 1) << 5)); }
__host__ __device__ __forceinline__ void stage_rc(int b, int& R, int& C) { const int st = b / 1024, sb = b % 1024, swz = sb ^ (((sb >> 9) & 1) << 5); R = (st >> 1) * 16 + swz / 64; C = (st & 1) * 32 + (swz % 64) / 2; }
__host__ __device__ __forceinline__ int perm32(int rho) { const int n = rho >> 4, i = rho & 15; return 8 * (i >> 2) + 4 * n + (i & 3); }

struct Unit { int pm, pn, brow, e; };
struct Gemm { const bf16* A; const bf16* Bt; int lda, K; const int* rowmap; int rowmask; };

struct StaticOrder {
    int nM, nN, nwg, G, c;
    __device__ void init(int nM_, int nN_, int G_, int c_) { nM = nM_; nN = nN_; nwg = nM * nN; G = G_; c = c_; }
    __device__ bool tile(int i, int& pm, int& pn) const {
        const long L = (long)i * G + c; if (L >= nwg) return false;
        int wgid = (int)L; { const int q = nwg / NXCD, r = nwg % NXCD, xcd = wgid % NXCD, off = wgid / NXCD; wgid = (xcd < r ? xcd * (q + 1) : r * (q + 1) + (xcd - r) * q) + off; }
        const int nig = WGM * nN, gid = wgid / nig, fm = gid * WGM, gsz = (nM - fm) < WGM ? (nM - fm) : WGM;
        pm = fm + ((wgid % nig) % gsz); pn = (wgid % nig) / gsz; return true;
    }
    __device__ bool next(int i, Unit& u) const { if (!tile(i, u.pm, u.pn)) return false; u.brow = u.pn * BM; u.e = 0; return true; }
};
struct GroupedOrder : StaticOrder {
    const LAS int* tstart; int nrow_e;
    __device__ bool next(int i, Unit& u) const {
        if (!tile(i, u.pm, u.pn)) return false;
        int e = 0;
#pragma unroll 1
        for (int j = 16; j > 0; j >>= 1) if (tstart[e + j] <= u.pm) e += j;
        u.e = e; u.brow = e * nrow_e + u.pn * BM; return true;
    }
};
DI unsigned cvt_pk_bf16(float lo, float hi) { unsigned r; asm volatile("v_cvt_pk_bf16_f32 %0, %1, %2" : "=v"(r) : "v"(lo), "v"(hi)); return r; }

template <class Epi, class Sched, bool GATHER = false, bool FP8 = false>
DI void gemm_phase(LAS unsigned char* lds, const int tid, const Gemm g, const Sched& S, const Epi& E) {
    const int wid = __builtin_amdgcn_readfirstlane(tid >> 6), lane = tid & 63, wr = wid >> 2, wc = wid & 3, fr = lane & 15, fq = lane >> 4;
    int K = g.K, lda = g.lda; asm volatile("" : "+s"(K), "+s"(lda));
    const int nt = K / BK;
    unsigned voffA[2], voffB[2]; int Ra[2], Ca[2];
#pragma unroll
    for (int i = 0; i < 2; ++i) { int R, C; stage_rc(tid * 16 + i * 8192, R, C); const int Rb = Epi::PERM ? ((R & ~31) + perm32(R & 31)) : R; Ra[i] = R; Ca[i] = C;
        voffA[i] = (unsigned)(R * lda + C) * 2u; voffB[i] = (unsigned)(Rb * K + C) * 2u; }
    unsigned vgc[2][2]; int rawn[2][2];
#define PG8_GLOAD(dst, pm_) do { _Pragma("unroll") for (int _h = 0; _h < 2; ++_h) _Pragma("unroll") for (int _i = 0; _i < 2; ++_i) { const int* _p = g.rowmap + (size_t)(pm_) * BM + _h * HALF + Ra[_i]; \
        asm volatile("global_load_dword %0, %1, off" : "=v"(dst[_h][_i]) : "v"(_p) : "memory"); } } while (0)
#define PG8_GCONV(vg, raw) do { _Pragma("unroll") for (int _h = 0; _h < 2; ++_h) _Pragma("unroll") for (int _i = 0; _i < 2; ++_i) { int _r = raw[_h][_i]; asm volatile("" : "+v"(_r)); \
        vg[_h][_i] = (unsigned)((_r & g.rowmask) * lda + Ca[_i]) * 2u; } } while (0)
#define PG8_STAGE_A(bufoff, kptr, h, vg) do { if (GATHER) PG8_STAGE(bufoff, kptr, vg[h]); else PG8_STAGE(bufoff, (kptr) + (h) * hstepA, voffA); } while (0)
    const size_t kstep = (size_t)(BK * 2);
    const size_t hstepA = (size_t)HALF * lda * 2, hstepB = (size_t)HALF * K * 2;
    const size_t tstepA = 2 * hstepA;
    const unsigned ldsw = (unsigned)wid * 1024u;
    const int aoff = lds_byte(wr * 64 + fr, fq * 8), boff = lds_byte(wc * 32 + fr, fq * 8);
#define PG8_SA(b, h) (((b) * 2 + (h)) * HTB)
#define PG8_SB(b, h) ((4 + (b) * 2 + (h)) * HTB)
#define PG8_STAGE(bufoff, gbase, voff) do { _Pragma("unroll") for (int _i = 0; _i < 2; ++_i) \
        __builtin_amdgcn_global_load_lds((const unsigned*)((const char*)(gbase) + (voff)[_i]), (LAS unsigned*)(lds + (bufoff) + ldsw + _i * 8192), 16, 0, 0); } while (0)
#define PG8_LDA(dst, b, h) do { _Pragma("unroll") for (int m = 0; m < 4; ++m) { const v4i_ lo_ = *(const LAS v4i_*)(lds + PG8_SA(b, h) + aoff + m * 2048), hi_ = *(const LAS v4i_*)(lds + PG8_SA(b, h) + aoff + m * 2048 + 1024); \
        dst[m] = __builtin_shufflevector(lo_, hi_, 0, 1, 2, 3, 4, 5, 6, 7); } } while (0)
#define PG8_LDB(dst, b, h) do { _Pragma("unroll") for (int n = 0; n < 2; ++n) { const v4i_ lo_ = *(const LAS v4i_*)(lds + PG8_SB(b, h) + boff + n * 2048), hi_ = *(const LAS v4i_*)(lds + PG8_SB(b, h) + boff + n * 2048 + 1024); \
        dst[n] = __builtin_shufflevector(lo_, hi_, 0, 1, 2, 3, 4, 5, 6, 7); } } while (0)
#define PG8_MMA(ai, bj, At, Bt) do { __builtin_amdgcn_s_setprio(1); _Pragma("unroll") for (int m = 0; m < 4; ++m) _Pragma("unroll") for (int n = 0; n < 2; ++n) { \
        if (FP8) acc[ai][bj][m][n] = __builtin_amdgcn_mfma_scale_f32_16x16x128_f8f6f4(Bt[n], At[m], acc[ai][bj][m][n], 0, 0, 0, 0x7F7F7F7F, 0, 0x7F7F7F7F); \
        else { const v8i_ b_ = Bt[n], a_ = At[m]; \
            acc[ai][bj][m][n] = __builtin_amdgcn_mfma_f32_16x16x32_bf16(__builtin_bit_cast(bf16x8, __builtin_shufflevector(b_, b_, 0, 1, 2, 3)), __builtin_bit_cast(bf16x8, __builtin_shufflevector(a_, a_, 0, 1, 2, 3)), acc[ai][bj][m][n], 0, 0, 0); \
            acc[ai][bj][m][n] = __builtin_amdgcn_mfma_f32_16x16x32_bf16(__builtin_bit_cast(bf16x8, __builtin_shufflevector(b_, b_, 4, 5, 6, 7)), __builtin_bit_cast(bf16x8, __builtin_shufflevector(a_, a_, 4, 5, 6, 7)), acc[ai][bj][m][n], 0, 0, 0); } } \
        __builtin_amdgcn_s_setprio(0); } while (0)
#define PG8_WAIT_V(n) asm volatile("s_waitcnt vmcnt(" #n ")" ::: "memory")
#define PG8_WAIT_L(n) asm volatile("s_waitcnt lgkmcnt(" #n ")" ::: "memory")
#define PG8_BAR __builtin_amdgcn_s_barrier()
#define PG8_SCHED __builtin_amdgcn_sched_barrier(0)
    Unit cur, nxt; int ui = 0;
    if (!S.next(0, cur)) return;
    f32x4 acc[2][2][4][2];
#pragma unroll
    for (int a = 0; a < 2; ++a)
#pragma unroll
        for (int b = 0; b < 2; ++b)
#pragma unroll
            for (int m = 0; m < 4; ++m)
#pragma unroll
                for (int n = 0; n < 2; ++n) acc[a][b][m][n] = (f32x4){0.f, 0.f, 0.f, 0.f};
    typedef int v8i_ __attribute__((ext_vector_type(8))); typedef int v4i_ __attribute__((ext_vector_type(4)));
    v8i_ At[4], B0[2], B1[2];
    const char* cA = (const char*)g.A + (GATHER ? (size_t)0 : (size_t)cur.pm * tstepA); const char* cB = (const char*)g.Bt + (size_t)cur.brow * K * 2;
    if (GATHER) { PG8_GLOAD(rawn, cur.pm); asm volatile("s_waitcnt vmcnt(0)" : "+v"(rawn[0][0]), "+v"(rawn[0][1]), "+v"(rawn[1][0]), "+v"(rawn[1][1]) :: "memory"); PG8_GCONV(vgc, rawn); }
    PG8_STAGE(PG8_SB(0, 0), cB, voffB); PG8_STAGE(PG8_SB(0, 1), cB + hstepB, voffB); PG8_STAGE_A(PG8_SA(0, 0), cA, 0, vgc); PG8_STAGE_A(PG8_SA(0, 1), cA, 1, vgc);
    if (wr == 1) PG8_BAR;
    PG8_WAIT_V(2); PG8_BAR;
    PG8_STAGE(PG8_SB(1, 0), cB + kstep, voffB); PG8_STAGE_A(PG8_SA(1, 0), cA + kstep, 0, vgc); PG8_STAGE(PG8_SB(1, 1), cB + hstepB + kstep, voffB);
    PG8_WAIT_V(6); PG8_BAR;
    for (;;) {
        const bool has_next = S.next(ui + 1, nxt);
        const char* nA = (has_next && !GATHER) ? (const char*)g.A + (size_t)nxt.pm * tstepA : cA;
        if (GATHER && has_next) PG8_GLOAD(rawn, nxt.pm); const char* nB = has_next ? (const char*)g.Bt + (size_t)nxt.brow * K * 2 : cB;
#pragma unroll 1
        for (int t = 0; t < nt; t += 2) {
            const bool last = (t == nt - 2);
            const char* a1 = cA + (size_t)(t + 1) * kstep;
            const char* a2 = last ? nA : cA + (size_t)(t + 2) * kstep; const char* b2 = last ? nB : cB + (size_t)(t + 2) * kstep;
            const char* a3 = a2 + kstep; const char* b3 = b2 + kstep;
            PG8_LDB(B0, 0, 0); PG8_LDB(B1, 0, 1); PG8_SCHED; PG8_LDA(At, 0, 0); PG8_STAGE_A(PG8_SA(1, 1), a1, 1, vgc);
            if (GATHER) { if (last && has_next) PG8_GCONV(vgc, rawn); }
            PG8_WAIT_V(8); PG8_WAIT_L(0); PG8_BAR; PG8_MMA(0, 0, At, B0); PG8_MMA(0, 1, At, B1); PG8_BAR; PG8_SCHED;
            PG8_LDA(At, 0, 1); PG8_STAGE(PG8_SB(0, 0), b2, voffB); PG8_STAGE(PG8_SB(0, 1), b2 + hstepB, voffB); PG8_STAGE_A(PG8_SA(0, 0), a2, 0, vgc);
            PG8_WAIT_V(8); PG8_WAIT_L(0); PG8_BAR; PG8_MMA(1, 0, At, B0); PG8_MMA(1, 1, At, B1); PG8_BAR; PG8_SCHED;
            PG8_LDB(B0, 1, 0); PG8_LDB(B1, 1, 1); PG8_SCHED; PG8_LDA(At, 1, 0); PG8_STAGE_A(PG8_SA(0, 1), a2, 1, vgc);
            PG8_WAIT_V(8); PG8_WAIT_L(0); PG8_BAR; PG8_MMA(0, 0, At, B0); PG8_MMA(0, 1, At, B1); PG8_BAR; PG8_SCHED;
            PG8_LDA(At, 1, 1); PG8_STAGE(PG8_SB(1, 0), b3, voffB); PG8_STAGE(PG8_SB(1, 1), b3 + hstepB, voffB); PG8_STAGE_A(PG8_SA(1, 0), a3, 0, vgc);
            PG8_WAIT_V(8); PG8_WAIT_L(0); PG8_BAR; PG8_MMA(1, 0, At, B0); PG8_MMA(1, 1, At, B1); PG8_BAR; PG8_SCHED;
        }
        if (wr == 0) PG8_BAR;
        { int fr2 = fr, fq2 = fq; asm volatile("" : "+v"(fr2), "+v"(fq2)); E(acc, cur, wr, wc, fr2, fq2); }
        if (!has_next) break;
#pragma unroll
        for (int a = 0; a < 2; ++a)
#pragma unroll
            for (int b = 0; b < 2; ++b)
#pragma unroll
                for (int m = 0; m < 4; ++m)
#pragma unroll
                    for (int n = 0; n < 2; ++n) acc[a][b][m][n] = (f32x4){0.f, 0.f, 0.f, 0.f};
        cur = nxt; cA = nA; cB = nB; ++ui;
        if (wr == 1) PG8_BAR;
    }
    PG8_WAIT_V(0);
    PG8_BAR;
#undef PG8_SA
#undef PG8_SB
#undef PG8_STAGE
#undef PG8_STAGE_A
#undef PG8_GLOAD
#undef PG8_GCONV
#undef PG8_LDA
#undef PG8_LDB
#undef PG8_MMA
#undef PG8_WAIT_V
#undef PG8_WAIT_L
#undef PG8_BAR
#undef PG8_SCHED
}
}
constexpr size_t MiB = 1u << 20;
constexpr size_t WS_CTL = 0;
constexpr size_t WS_LORA = 1 * MiB;
constexpr size_t WS_WK2 = 2 * MiB;
constexpr size_t ZERO_BYTES = 3 * MiB;
constexpr size_t WS_WIN = 3 * MiB;
constexpr size_t WS_WOUT = 17 * MiB;
constexpr size_t WS_WK1 = 21 * MiB;
constexpr size_t WS_SMALL = 25 * MiB;
constexpr size_t WS_ROUTE = 27 * MiB;
constexpr size_t WS_WGU = 32 * MiB;
constexpr size_t WS_WDN = 288 * MiB;
constexpr size_t WS_H = 416 * MiB;
constexpr size_t WS_R = 480 * MiB;
constexpr size_t R_PROJ = WS_R;
constexpr size_t R_SC = R_PROJ + 208 * MiB;
constexpr size_t R_LIN = R_SC + 192 * MiB;
constexpr size_t R_G = R_LIN + 16 * MiB;
constexpr size_t R_YA = R_G + 32 * MiB;
constexpr size_t R_YCAT = R_YA + 32 * MiB;
constexpr size_t R_QC = R_YCAT + 64 * MiB;
constexpr size_t R_KC = R_QC + 16 * MiB;
constexpr size_t R_OC = R_KC + 16 * MiB;
constexpr size_t R_LSE = R_OC + 96 * MiB;
constexpr size_t R_QN = R_LSE + 2 * MiB;
constexpr size_t R_QR = R_QN + 16 * MiB;
constexpr size_t R_KCR = R_QR + 16 * MiB;
constexpr size_t R_VCR = R_KCR + 5 * MiB;
constexpr size_t R_KS = R_VCR + 5 * MiB;
constexpr size_t R_KW = R_KS + 4 * MiB;
constexpr size_t R_GATE = R_KW + 4 * MiB;
constexpr size_t R_CH1 = R_GATE + 2 * MiB;
constexpr size_t R_CMP = R_CH1 + 2 * MiB;
constexpr size_t R_OCMP = R_CMP + 1 * MiB;
constexpr size_t R_OSLC = R_OCMP + 32 * MiB;
constexpr size_t R_OSWA = R_OSLC + 32 * MiB;
constexpr size_t R_IMP = R_OSWA + 32 * MiB;
constexpr size_t R_SELM = R_IMP + 8 * MiB;
constexpr size_t R_MIX_END = R_SELM + 1 * MiB;
constexpr size_t R_XS = WS_R;
constexpr size_t R_ACT = R_XS + 272 * MiB;
constexpr size_t R_YB = R_ACT + 272 * MiB;
constexpr size_t R_MOE_END = R_YB + 272 * MiB;
constexpr size_t WS_END = (R_MIX_END > R_MOE_END ? R_MIX_END : R_MOE_END);
static_assert((size_t)NR * 1024 * 2 <= 272 * MiB, "sorted buffers");
constexpr int CW_BAR = 4096;
constexpr int CW_CNT = 16384;
constexpr int CW_CUR = 16384 + 64;

constexpr int RING_BYTES = 131072;
constexpr int MISC_OFF = RING_BYTES;
constexpr int LDS_BYTES = 147456;

struct Args { const void* in[40]; float* out; unsigned char* ws; int ph_lo, ph_hi; };

struct Ctx {
    LAS unsigned char* lds; int tid, lane, wave, G, bid;
    const float *x, *c, *w_ada, *b_ada, *norm1_g, *norm2_g, *w_in, *w_out, *mu, *w0, *w2, *a0, *a2, *g2, *kkw, *ka, *rk, *gn_w, *gn_b, *conv_w, *dil_q_g, *dil_k_g,
        *nsa_q_g, *nsa_kc_g, *nsa_ks_g, *nsa_kw_g, *pe_k, *pe_v, *wk1, *wk2, *wv1, *wv2, *onorm_g, *w_router, *b_router, *w_gu, *b_gu, *w_down, *b_down;
    const int* pos;
    float* out; unsigned char* ws;
};
#define WSP(T, off) ((T*)(C.ws + (off)))

typedef f32x4 Acc[2][2][4][2];
struct EpiProj {
    static constexpr bool PERM = true; bf16* O;
    DI void operator()(const Acc& acc, const pg8::Unit& u, int wr, int wc, int fr, int fq) const {
        const int row0 = u.pm * 256 + wr * 64 + fr, col0 = u.pn * 256 + wc * 32 + 8 * fq;
#pragma unroll
        for (int ai = 0; ai < 2; ++ai)
#pragma unroll
            for (int m = 0; m < 4; ++m) { bf16* rowp = O + (size_t)(row0 + ai * 128 + m * 16) * NPJ + col0;
#pragma unroll
                for (int bj = 0; bj < 2; ++bj) { const f32x4 v0 = acc[ai][bj][m][0], v1 = acc[ai][bj][m][1]; u32x4 w;
                    w.x = pg8::cvt_pk_bf16(v0[0], v0[1]); w.y = pg8::cvt_pk_bf16(v0[2], v0[3]); w.z = pg8::cvt_pk_bf16(v1[0], v1[1]); w.w = pg8::cvt_pk_bf16(v1[2], v1[3]);
                    *(u32x4*)(rowp + bj * 128) = w; } }
    }
};
struct EpiLora {
    static constexpr bool PERM = false; float* SC; float* Gb; const float *w0, *a0, *ka;
    DI void operator()(const Acc& acc, const pg8::Unit& u, int wr, int wc, int fr, int fq) const {
        const int row0 = u.pm * 256 + wr * 64 + fr, col0 = wc * 32 + 4 * fq;
        if (u.pn == 0) {
#pragma unroll
            for (int bj = 0; bj < 2; ++bj)
#pragma unroll
                for (int n = 0; n < 2; ++n) { const int ch = col0 + bj * 128 + n * 16; const f32x4 b = *(const f32x4*)(w0 + ch);
#pragma unroll
                    for (int ai = 0; ai < 2; ++ai)
#pragma unroll
                        for (int m = 0; m < 4; ++m) { const size_t o = (size_t)(row0 + ai * 128 + m * 16) * 256 + ch; const f32x4 v = acc[ai][bj][m][n] + b; f32x4 r;
#pragma unroll
                            for (int j = 0; j < 4; ++j) r[j] = __expf(-0.606531f * fsigmoid(v[j]));
                            *(f32x4*)(SC + o) = r; } }
        } else if (u.pn == 1) {
#pragma unroll
            for (int bj = 0; bj < 2; ++bj)
#pragma unroll
                for (int n = 0; n < 2; ++n) { const int ch = col0 + bj * 128 + n * 16; const f32x4 b = *(const f32x4*)(a0 + ch), kav = *(const f32x4*)(ka + ch);
#pragma unroll
                    for (int ai = 0; ai < 2; ++ai)
#pragma unroll
                        for (int m = 0; m < 4; ++m) { __builtin_amdgcn_sched_barrier(0); const size_t o = (size_t)(row0 + ai * 128 + m * 16) * 256 + ch; const f32x4 v = acc[ai][bj][m][n] + b;
                            float* pk = SC + (size_t)1 * NT * 256 + o; const f32x4 kr = *(const f32x4*)pk, kn = *(const f32x4*)(SC + (size_t)2 * NT * 256 + o); f32x4 k2, bb;
#pragma unroll
                            for (int j = 0; j < 4; ++j) { const float a = fsigmoid(v[j]); k2[j] = kr[j] * (1.f + (a - 1.f) * kav[j]); bb[j] = kn[j] * a; }
                            *(f32x4*)pk = k2; *(f32x4*)(SC + (size_t)3 * NT * 256 + o) = bb; } }
        } else {
#pragma unroll
            for (int bj = 0; bj < 2; ++bj)
#pragma unroll
                for (int n = 0; n < 2; ++n) { const int ch = col0 + bj * 128 + n * 16;
#pragma unroll
                    for (int ai = 0; ai < 2; ++ai)
#pragma unroll
                        for (int m = 0; m < 4; ++m) { const size_t o = (size_t)(row0 + ai * 128 + m * 16) * 256 + ch; *(f32x4*)(Gb + o) = acc[ai][bj][m][n]; } }
        }
    }
};
DI float gelu_tanh(float x) { const float t = 0.7978845608f * (x + 0.044715f * x * x * x); const float e = __expf(2.f * t); const float th = 1.f - 2.f / (e + 1.f); return 0.5f * x * (1.f + th); }
struct EpiC1 {
    static constexpr bool PERM = true; bf16* O; const float* peb;
    DI void operator()(const Acc& acc, const pg8::Unit& u, int wr, int wc, int fr, int fq) const {
        const int row0 = u.pm * 256 + wr * 64 + fr, col0 = wc * 32 + 8 * fq;
#pragma unroll
        for (int bj = 0; bj < 2; ++bj) { const f32x4 b0 = *(const f32x4*)(peb + col0 + bj * 128), b1 = *(const f32x4*)(peb + col0 + bj * 128 + 4);
#pragma unroll
            for (int ai = 0; ai < 2; ++ai)
#pragma unroll
                for (int m = 0; m < 4; ++m) { bf16* p = O + (size_t)(row0 + ai * 128 + m * 16) * 256 + col0 + bj * 128; const f32x4 v0 = acc[ai][bj][m][0] + b0, v1 = acc[ai][bj][m][1] + b1; u32x4 w;
                    w.x = pk2(gelu_tanh(v0[0]), gelu_tanh(v0[1])); w.y = pk2(gelu_tanh(v0[2]), gelu_tanh(v0[3])); w.z = pk2(gelu_tanh(v1[0]), gelu_tanh(v1[1])); w.w = pk2(gelu_tanh(v1[2]), gelu_tanh(v1[3]));
                    *(u32x4*)p = w; } }
    }
};
struct EpiC2 {
    static constexpr bool PERM = false; float* O;
    DI void operator()(const Acc& acc, const pg8::Unit& u, int wr, int wc, int fr, int fq) const {
        if (wc >= 2) return;
        const int row0 = u.pm * 256 + wr * 64 + fr, col0 = wc * 32 + 4 * fq;
#pragma unroll
        for (int ai = 0; ai < 2; ++ai)
#pragma unroll
            for (int m = 0; m < 4; ++m)
#pragma unroll
                for (int n = 0; n < 2; ++n) *(f32x4*)(O + (size_t)(row0 + ai * 128 + m * 16) * 64 + col0 + n * 16) = acc[ai][0][m][n];
    }
};
struct EpiOut {
    static constexpr bool PERM = false; float* O; const float* xin; const float* gt;
    DI void operator()(const Acc& acc, const pg8::Unit& u, int wr, int wc, int fr, int fq) const {
        const int row0 = u.pm * 256 + wr * 64 + fr, col0 = u.pn * 256 + wc * 32 + 4 * fq; const int b = (u.pm * 256) / NS;
#pragma unroll
        for (int bj = 0; bj < 2; ++bj)
#pragma unroll
            for (int n = 0; n < 2; ++n) { const int col = col0 + bj * 128 + n * 16; const f32x4 g = *(const f32x4*)(gt + (size_t)b * 6144 + col);
#pragma unroll
                for (int ai = 0; ai < 2; ++ai)
#pragma unroll
                    for (int m = 0; m < 4; ++m) { const size_t o = (size_t)(row0 + ai * 128 + m * 16) * DM + col; *(f32x4*)(O + o) = *(const f32x4*)(xin + o) + g * acc[ai][bj][m][n]; } }
    }
};
struct EpiGU {
    static constexpr bool PERM = true; bf16* O; const float* bgu;
    DI void operator()(const Acc& acc, const pg8::Unit& u, int wr, int wc, int fr, int fq) const {
        const int row0 = u.pm * 256 + wr * 64 + fr, cc = u.pn * 128 + wc * 32 + 8 * fq; const float* bp = bgu + (size_t)u.e * 2048 + cc;
        const f32x4 g0 = *(const f32x4*)bp, g1 = *(const f32x4*)(bp + 4), u0 = *(const f32x4*)(bp + 1024), u1 = *(const f32x4*)(bp + 1028);
#pragma unroll
        for (int ai = 0; ai < 2; ++ai)
#pragma unroll
            for (int m = 0; m < 4; ++m) { bf16* p = O + (size_t)(row0 + ai * 128 + m * 16) * FF + cc; float r[8];
#pragma unroll
                for (int n = 0; n < 2; ++n) { const f32x4 gv = acc[ai][0][m][n] + (n ? g1 : g0), uv = acc[ai][1][m][n] + (n ? u1 : u0);
#pragma unroll
                    for (int j = 0; j < 4; ++j) { const float ga = fminf(gv[j], 7.f), up = fminf(fmaxf(uv[j], -7.f), 7.f); r[4 * n + j] = ga * fsigmoid(1.702f * ga) * (up + 1.f); } }
                u32x4 w; w.x = pk2(r[0], r[1]); w.y = pk2(r[2], r[3]); w.z = pk2(r[4], r[5]); w.w = pk2(r[6], r[7]); *(u32x4*)p = w; }
    }
};
struct EpiDN {
    static constexpr bool PERM = true; bf16* O; const float* bd;
    DI void operator()(const Acc& acc, const pg8::Unit& u, int wr, int wc, int fr, int fq) const {
        const int row0 = u.pm * 256 + wr * 64 + fr, col0 = u.pn * 256 + wc * 32 + 8 * fq; const float* bp = bd + (size_t)u.e * 1024 + col0;
#pragma unroll
        for (int bj = 0; bj < 2; ++bj) { const f32x4 b0 = *(const f32x4*)(bp + bj * 128), b1 = *(const f32x4*)(bp + bj * 128 + 4);
#pragma unroll
            for (int ai = 0; ai < 2; ++ai)
#pragma unroll
                for (int m = 0; m < 4; ++m) { bf16* p = O + (size_t)(row0 + ai * 128 + m * 16) * DM + col0 + bj * 128; const f32x4 v0 = acc[ai][bj][m][0] + b0, v1 = acc[ai][bj][m][1] + b1; u32x4 w;
                    w.x = pk2(v0[0], v0[1]); w.y = pk2(v0[2], v0[3]); w.z = pk2(v1[0], v1[1]); w.w = pk2(v1[2], v1[3]); *(u32x4*)p = w; } }
    }
};
DI float clamp8(float x) { return fminf(fmaxf(x, -448.f), 448.f); }
DI unsigned pk4_fp8(float a, float b, float c, float d) { unsigned w = 0u; w = __builtin_amdgcn_cvt_pk_fp8_f32(clamp8(a), clamp8(b), w, false); w = __builtin_amdgcn_cvt_pk_fp8_f32(clamp8(c), clamp8(d), w, true); return w; }
constexpr float W8_SCALE = 32.f, W8_INV = 1.f / 32.f;
struct EpiGU8 {
    static constexpr bool PERM = true; unsigned char* O; const float* bgu;
    DI void operator()(const Acc& acc, const pg8::Unit& u, int wr, int wc, int fr, int fq) const {
        const int row0 = u.pm * 256 + wr * 64 + fr, cc = u.pn * 128 + wc * 32 + 8 * fq; const float* bp = bgu + (size_t)u.e * 2048 + cc;
        const f32x4 g0 = *(const f32x4*)bp, g1 = *(const f32x4*)(bp + 4), u0 = *(const f32x4*)(bp + 1024), u1 = *(const f32x4*)(bp + 1028);
#pragma unroll
        for (int ai = 0; ai < 2; ++ai)
#pragma unroll
            for (int m = 0; m < 4; ++m) { unsigned char* p = O + (size_t)(row0 + ai * 128 + m * 16) * FF + cc; float r[8];
#pragma unroll
                for (int n = 0; n < 2; ++n) { const f32x4 gv = acc[ai][0][m][n] * W8_INV + (n ? g1 : g0), uv = acc[ai][1][m][n] * W8_INV + (n ? u1 : u0);
#pragma unroll
                    for (int j = 0; j < 4; ++j) { const float ga = fminf(gv[j], 7.f), up = fminf(fmaxf(uv[j], -7.f), 7.f); r[4 * n + j] = ga * fsigmoid(1.702f * ga) * (up + 1.f); } }
                u32x2 w; w.x = pk4_fp8(r[0], r[1], r[2], r[3]); w.y = pk4_fp8(r[4], r[5], r[6], r[7]); *(u32x2*)p = w; }
    }
};
struct EpiDN8 {
    static constexpr bool PERM = true; bf16* O; const float* bd;
    DI void operator()(const Acc& acc, const pg8::Unit& u, int wr, int wc, int fr, int fq) const {
        const int row0 = u.pm * 256 + wr * 64 + fr, col0 = u.pn * 256 + wc * 32 + 8 * fq; const float* bp = bd + (size_t)u.e * 1024 + col0;
#pragma unroll
        for (int bj = 0; bj < 2; ++bj) { const f32x4 b0 = *(const f32x4*)(bp + bj * 128), b1 = *(const f32x4*)(bp + bj * 128 + 4);
#pragma unroll
            for (int ai = 0; ai < 2; ++ai)
#pragma unroll
                for (int m = 0; m < 4; ++m) { bf16* p = O + (size_t)(row0 + ai * 128 + m * 16) * DM + col0 + bj * 128; const f32x4 v0 = acc[ai][bj][m][0] * W8_INV + b0, v1 = acc[ai][bj][m][1] * W8_INV + b1; u32x4 w;
                    w.x = pk2(v0[0], v0[1]); w.y = pk2(v0[2], v0[3]); w.z = pk2(v1[0], v1[1]); w.w = pk2(v1[2], v1[3]); *(u32x4*)p = w; } }
    }
};
DI void tr_item(const float* src, int ld_src, int scol0, int nvalid, int k0, bf16* dst, int ld_dst, int drow0, int dk0, LAS float* scr, int lane) {
    const int n4 = (lane & 7) * 4, kr = lane >> 3; f32x4 v[8];
#pragma unroll
    for (int i = 0; i < 8; ++i) v[i] = (n4 < nvalid) ? *(const f32x4*)(src + (size_t)(k0 + kr + 8 * i) * ld_src + scol0 + n4) : (f32x4){0.f, 0.f, 0.f, 0.f};
#pragma unroll
    for (int i = 0; i < 8; ++i) { LAS float* s = scr + (kr + 8 * i) * 33 + n4; s[0] = v[i][0]; s[1] = v[i][1]; s[2] = v[i][2]; s[3] = v[i][3]; }
    asm volatile("s_waitcnt lgkmcnt(0)" ::: "memory");
    const int c = lane & 7;
#pragma unroll
    for (int jq = 0; jq < 4; ++jq) { const int n = (lane >> 3) + 8 * jq; const LAS float* s = scr + (8 * c) * 33 + n;
        u32x4 o; o.x = pk2(s[0 * 33], s[1 * 33]); o.y = pk2(s[2 * 33], s[3 * 33]); o.z = pk2(s[4 * 33], s[5 * 33]); o.w = pk2(s[6 * 33], s[7 * 33]);
        *(u32x4*)(dst + (size_t)(drow0 + n) * ld_dst + dk0 + k0 + 8 * c) = o; }
    asm volatile("s_waitcnt lgkmcnt(0)" ::: "memory");
}
DI void tr_item8(const float* src, int ld_src, int scol0, int k0, unsigned char* dst, int ld_dst, int drow0, LAS float* scr, int lane) {
    const int n4 = (lane & 7) * 4, kr = lane >> 3; f32x4 v[8];
#pragma unroll
    for (int i = 0; i < 8; ++i) v[i] = *(const f32x4*)(src + (size_t)(k0 + kr + 8 * i) * ld_src + scol0 + n4);
#pragma unroll
    for (int i = 0; i < 8; ++i) { LAS float* s = scr + (kr + 8 * i) * 33 + n4; s[0] = v[i][0]; s[1] = v[i][1]; s[2] = v[i][2]; s[3] = v[i][3]; }
    asm volatile("s_waitcnt lgkmcnt(0)" ::: "memory");
    const int c = lane & 7;
#pragma unroll
    for (int jq = 0; jq < 4; ++jq) { const int n = (lane >> 3) + 8 * jq; const LAS float* s = scr + (8 * c) * 33 + n;
        u32x2 o; o.x = pk4_fp8(s[0 * 33] * W8_SCALE, s[1 * 33] * W8_SCALE, s[2 * 33] * W8_SCALE, s[3 * 33] * W8_SCALE); o.y = pk4_fp8(s[4 * 33] * W8_SCALE, s[5 * 33] * W8_SCALE, s[6 * 33] * W8_SCALE, s[7 * 33] * W8_SCALE);
        *(u32x2*)(dst + (size_t)(drow0 + n) * ld_dst + k0 + 8 * c) = o; }
    asm volatile("s_waitcnt lgkmcnt(0)" ::: "memory");
}
DI void conv_item(const Ctx& C, int l, int r, LAS float* scr) {
    constexpr int I_GU = 32 * 16 * 64;
    if (r < I_GU) { const int e = r / 1024, r2 = r % 1024, kb = r2 / 64, nb = r2 % 64, n0 = 32 * nb, j = n0 / 256, i = n0 % 256;
        const int scol0 = (i < 128) ? 128 * j + i : 1024 + 128 * j + (i - 128);
        tr_item8(C.w_gu + (size_t)(l * 32 + e) * 1024 * 2048, 2048, scol0, 64 * kb, WSP(unsigned char, WS_WGU) + (size_t)(l * 32 + e) * 2048 * 1024, 1024, n0, scr, C.lane); }
    else { r -= I_GU; const int e = r / 512, r2 = r % 512, kb = r2 / 32, nb = r2 % 32;
        tr_item8(C.w_down + (size_t)(l * 32 + e) * 1024 * 1024, 1024, 32 * nb, 64 * kb, WSP(unsigned char, WS_WDN) + (size_t)(l * 32 + e) * 1024 * 1024, 1024, 32 * nb, scr, C.lane); }
}
DI void conv_ticket(const Ctx& C, int l, int tk) {
    LAS float* scr = (LAS float*)(C.lds + C.wave * 16384);
    __syncthreads();
#pragma unroll 1
    for (int i = 0; i < 8; ++i) conv_item(C, l, tk * 64 + C.wave * 8 + i, scr);
}
DI void p0_prologue(const Ctx& C) {
    LAS float* scr = (LAS float*)(C.lds + C.wave * 16384);
    const int gw = C.bid * NWAVE + C.wave, NGW = C.G * NWAVE;
    constexpr int I_IN = 16 * 104, I_OUT = 16 * 32, I_LW = 8, I_LA = 8, I_LG = 16, I_K1 = 256, I_K2 = 8;
    constexpr int I_LAYER = I_IN + I_OUT + I_LW + I_LA + I_LG + 2 * I_K1 + 2 * I_K2;
    for (int it = gw; it < NLAYER * I_LAYER; it += NGW) {
        const int l = it / I_LAYER; int r = it % I_LAYER;
        if (r < I_IN) { const int kb = r / 104, nb = r % 104, n0 = 32 * nb; int nv = 3212 - n0; nv = nv < 0 ? 0 : (nv > 32 ? 32 : nv);
            tr_item(C.w_in + (size_t)l * 1024 * 3212, 3212, n0, nv, 64 * kb, WSP(bf16, WS_WIN) + (size_t)l * NPJ * 1024, 1024, n0, 0, scr, C.lane); continue; } r -= I_IN;
        if (r < I_OUT) { const int kb = r / 32, nb = r % 32;
            tr_item(C.w_out + (size_t)l * 1024 * 1024, 1024, 32 * nb, 32, 64 * kb, WSP(bf16, WS_WOUT) + (size_t)l * 1024 * 1024, 1024, 32 * nb, 0, scr, C.lane); continue; } r -= I_OUT;
        bf16* lora = WSP(bf16, WS_LORA) + (size_t)l * 768 * 256;
        if (r < I_LW) { tr_item(C.w2 + (size_t)l * 64 * 256, 256, 32 * r, 32, 0, lora, 256, 32 * r, 0, scr, C.lane); continue; } r -= I_LW;
        if (r < I_LA) { tr_item(C.a2 + (size_t)l * 64 * 256, 256, 32 * r, 32, 0, lora, 256, 256 + 32 * r, 64, scr, C.lane); continue; } r -= I_LA;
        if (r < I_LG) { const int kb = r / 8, nb = r % 8; tr_item(C.g2 + (size_t)l * 128 * 256, 256, 32 * nb, 32, 64 * kb, lora, 256, 512 + 32 * nb, 128, scr, C.lane); continue; } r -= I_LG;
        if (r < 2 * I_K1) { const int kv = r / I_K1, r2 = r % I_K1, kb = r2 / 8, nb = r2 % 8;
            tr_item((kv ? C.wv1 : C.wk1) + (size_t)l * 2048 * 256, 256, 32 * nb, 32, 64 * kb, WSP(bf16, WS_WK1) + (size_t)(l * 2 + kv) * 256 * 2048, 2048, 32 * nb, 0, scr, C.lane); continue; } r -= 2 * I_K1;
        { const int kv = r / I_K2, r2 = r % I_K2, kb = r2 / 2, nb = r2 % 2;
            tr_item((kv ? C.wv2 : C.wk2) + (size_t)l * 256 * 64, 64, 32 * nb, 32, 64 * kb, WSP(bf16, WS_WK2) + (size_t)(l * 2 + kv) * 256 * 256, 256, 32 * nb, 0, scr, C.lane); }
    }
    { int* idm = WSP(int, WS_ROUTE) + NT * 12 + NR; for (int i = C.bid * NTHR + C.tid; i < NR; i += C.G * NTHR) idm[i] = i; }
    __syncthreads();
    float* MOD = WSP(float, WS_SMALL); float* PEB = MOD + NLAYER * 8 * 6144;
    LAS float* sc = (LAS float*)C.lds;
    LAS float* red = sc + 8192;
    for (int it = C.bid; it < 192 + 4; it += C.G) {
        if (it < 192) {
            const int l = it / 96, n0 = (it % 96) * 64;
            for (int i = C.tid; i < 8192; i += NTHR) { const float v = C.c[i]; sc[i] = v / (1.f + __expf(-v)); }
            __syncthreads();
            const int kq = C.tid >> 6, col = C.tid & 63; float a[8];
#pragma unroll
            for (int b = 0; b < 8; ++b) a[b] = 0.f;
            const float* wp = C.w_ada + (size_t)l * 1024 * 6144 + n0 + col;
#pragma unroll 8
            for (int k = kq * 128; k < kq * 128 + 128; ++k) { const float w = wp[(size_t)k * 6144];
#pragma unroll
                for (int b = 0; b < 8; ++b) a[b] += sc[b * 1024 + k] * w; }
#pragma unroll
            for (int b = 0; b < 8; ++b) red[(kq * 8 + b) * 64 + col] = a[b];
            __syncthreads();
            { const int b = C.tid >> 6; float s = C.b_ada[(size_t)l * 6144 + n0 + col];
#pragma unroll
              for (int q = 0; q < 8; ++q) s += red[(q * 8 + b) * 64 + col];
              MOD[((size_t)l * 8 + b) * 6144 + n0 + col] = s; }
            __syncthreads();
        } else {
            const int l = (it - 192) / 2, kv = (it - 192) % 2; const float* pe = (kv ? C.pe_v : C.pe_k) + (size_t)l * 2048; const float* w1 = (kv ? C.wv1 : C.wk1) + (size_t)l * 2048 * 256;
            const int kq = C.tid >> 8, col = C.tid & 255; float a = 0.f;
#pragma unroll 8
            for (int k = kq * 1024; k < kq * 1024 + 1024; ++k) a += pe[k] * w1[(size_t)k * 256 + col];
            red[kq * 256 + col] = a; __syncthreads();
            if (C.tid < 256) PEB[(l * 2 + kv) * 256 + col] = red[col] + red[256 + col];
            __syncthreads();
        }
    }
}

DI void norm_row(const Ctx& C, const float* xrow, const float* g, const float* sh, const float* sc, bf16* orow) {
    f32x4 v[4]; float s = 0.f;
#pragma unroll
    for (int j = 0; j < 4; ++j) { v[j] = *(const f32x4*)(xrow + 4 * C.lane + 256 * j); s += (v[j][0] * v[j][0] + v[j][1] * v[j][1]) + (v[j][2] * v[j][2] + v[j][3] * v[j][3]); }
    s = group_sum<64>(s); const float rstd = rsqrtf(s * (1.f / DM) + 1e-6f);
#pragma unroll
    for (int j = 0; j < 4; ++j) { const int k = 4 * C.lane + 256 * j; const f32x4 gg = *(const f32x4*)(g + k), a = *(const f32x4*)(sc + k), b = *(const f32x4*)(sh + k); f32x4 h;
#pragma unroll
        for (int i = 0; i < 4; ++i) h[i] = v[j][i] * rstd * gg[i] * (1.f + a[i]) + b[i];
        u32x2 o; o.x = pk2(h[0], h[1]); o.y = pk2(h[2], h[3]); *(u32x2*)(orow + k) = o; }
}
DI void norm1_phase(const Ctx& C, int l, const float* xin) {
    const float* MOD = WSP(float, WS_SMALL) + (size_t)l * 8 * 6144; bf16* H = WSP(bf16, WS_H);
    const int gw = C.bid * NWAVE + C.wave, NGW = C.G * NWAVE;
    for (int m = gw; m < NT; m += NGW) { const int b = m / NS; norm_row(C, xin + (size_t)m * DM, C.norm1_g + l * DM, MOD + b * 6144, MOD + b * 6144 + 1024, H + (size_t)m * DM); }
}

constexpr float QSCALE = 0.125f * 1.44269504089f;
DI void prep_phase(const Ctx& C, int l) {
    const bf16* PROJ = WSP(bf16, R_PROJ); float* SC = WSP(float, R_SC); bf16* LIN = WSP(bf16, R_LIN); bf16* YCAT = WSP(bf16, R_YCAT);
    bf16 *QC = WSP(bf16, R_QC), *KC = WSP(bf16, R_KC), *QN = WSP(bf16, R_QN), *QR = WSP(bf16, R_QR), *KCR = WSP(bf16, R_KCR), *VCR = WSP(bf16, R_VCR), *KS = WSP(bf16, R_KS), *KW = WSP(bf16, R_KW);
    float* GATE = WSP(float, R_GATE);
    const int lane = C.lane, gw = C.bid * NWAVE + C.wave, NGW = C.G * NWAVE;
    const int hh = lane >> 4, jj = lane & 15;
    const float inv0 = exp2f(-(float)(2 * jj) * (13.287712379549449f / 32.f)), inv1 = exp2f(-(float)(2 * jj + 1) * (13.287712379549449f / 32.f));
    for (int row = gw; row < NT; row += NGW) {
        const int s = row % NS; const bf16* pr = PROJ + (size_t)row * NPJ;
        {
            const int c0 = 16 * lane; float z[16];
            const u32x4 c0v = *(const u32x4*)(pr + c0), c1v = *(const u32x4*)(pr + c0 + 8);
            u32x4 p0v = (u32x4){0u, 0u, 0u, 0u}, p1v = p0v;
            if (s > 0) { p0v = *(const u32x4*)(pr - NPJ + c0); p1v = *(const u32x4*)(pr - NPJ + c0 + 8); }
            const float* mup = C.mu + (size_t)l * 1024 + c0;
            const unsigned cw[8] = {c0v.x, c0v.y, c0v.z, c0v.w, c1v.x, c1v.y, c1v.z, c1v.w}, pw[8] = {p0v.x, p0v.y, p0v.z, p0v.w, p1v.x, p1v.y, p1v.z, p1v.w};
#pragma unroll
            for (int q = 0; q < 4; ++q) { const f32x4 m4 = *(const f32x4*)(mup + 4 * q);
#pragma unroll
                for (int i = 0; i < 4; ++i) { const int e = 4 * q + i; const float cu = (e & 1) ? bfhi(cw[e >> 1]) : bflo(cw[e >> 1]), pv = (e & 1) ? bfhi(pw[e >> 1]) : bflo(pw[e >> 1]); z[e] = cu + (pv - cu) * m4[i]; } }
            const int cc = (c0 - 256) & 255; float kk[16]; float ss = 0.f;
#pragma unroll
            for (int q = 0; q < 4; ++q) { const f32x4 k4 = *(const f32x4*)(C.kkw + (size_t)l * 256 + cc + 4 * q);
#pragma unroll
                for (int i = 0; i < 4; ++i) { kk[4 * q + i] = z[4 * q + i] * k4[i]; ss += kk[4 * q + i] * kk[4 * q + i]; } }
            ss = group_sum<4>(ss); const float kinv = rsqrtf(ss + 1e-12f);
            if (lane < 48) {
                const int vec = lane < 16 ? 4 : (lane < 32 ? 1 : 5); float* dst = SC + ((size_t)vec * NT + row) * 256 + (c0 & 255);
#pragma unroll
                for (int q = 0; q < 4; ++q) *(f32x4*)(dst + 4 * q) = (f32x4){z[4 * q], z[4 * q + 1], z[4 * q + 2], z[4 * q + 3]};
                if (lane >= 16 && lane < 32) { float* d2 = SC + ((size_t)2 * NT + row) * 256 + cc;
#pragma unroll
                    for (int q = 0; q < 4; ++q) *(f32x4*)(d2 + 4 * q) = (f32x4){kk[4 * q] * kinv, kk[4 * q + 1] * kinv, kk[4 * q + 2] * kinv, kk[4 * q + 3] * kinv}; }
            } else {
                float t[16];
#pragma unroll
                for (int i = 0; i < 16; ++i) { const float sg = fsigmoid(lane < 52 ? 2.f * z[i] : z[i]); t[i] = lane < 52 ? 2.f * sg - 1.f : (lane < 56 ? z[i] : sg); }
                bf16* dst = LIN + (size_t)row * 256 + (c0 - 768);
                u32x4 o0, o1; o0.x = pk2(t[0], t[1]); o0.y = pk2(t[2], t[3]); o0.z = pk2(t[4], t[5]); o0.w = pk2(t[6], t[7]); o1.x = pk2(t[8], t[9]); o1.y = pk2(t[10], t[11]); o1.z = pk2(t[12], t[13]); o1.w = pk2(t[14], t[15]);
                *(u32x4*)dst = o0; *(u32x4*)(dst + 8) = o1;
            }
        }
        {
            const int ch = 4 * lane; float u[3][4];
#pragma unroll
            for (int d = 0; d < 3; ++d) {
                u32x2 cg = (u32x2){0u, 0u}, xi = cg;
                if (s >= d) { cg = *(const u32x2*)(pr - (size_t)d * NPJ + PJ_B + 256 + ch); xi = *(const u32x2*)(pr - (size_t)d * NPJ + PJ_B + 512 + ch); }
                u[d][0] = bflo(cg.x) * bflo(xi.x); u[d][1] = bfhi(cg.x) * bfhi(xi.x); u[d][2] = bflo(cg.y) * bflo(xi.y); u[d][3] = bfhi(cg.y) * bfhi(xi.y);
            }
            const u32x2 bgv = *(const u32x2*)(pr + PJ_B + ch); const float bg[4] = {bflo(bgv.x), bfhi(bgv.x), bflo(bgv.y), bfhi(bgv.y)};
            const float* cw = C.conv_w + (size_t)l * 3 * 256 + ch; const f32x4 w0 = *(const f32x4*)cw, w1 = *(const f32x4*)(cw + 256), w2 = *(const f32x4*)(cw + 512);
            float y[4]; float ss = 0.f;
#pragma unroll
            for (int i = 0; i < 4; ++i) { y[i] = bg[i] * (w0[i] * u[2][i] + w1[i] * u[1][i] + w2[i] * u[0][i]); ss += y[i] * y[i]; }
            ss = group_sum<16>(ss); const float rstd = rsqrtf(ss * (1.f / 64.f) + 1e-6f); const f32x4 og = *(const f32x4*)(C.onorm_g + (size_t)l * 768 + ch);
            u32x2 o; o.x = pk2(y[0] * rstd * og[0], y[1] * rstd * og[1]); o.y = pk2(y[2] * rstd * og[2], y[3] * rstd * og[3]);
            *(u32x2*)(YCAT + (size_t)row * DM + 256 + ch) = o;
        }
        const float posf = (float)C.pos[row];
        const float x0 = __builtin_amdgcn_fractf((posf * inv0) * 0.15915494309189535f), x1 = __builtin_amdgcn_fractf((posf * inv1) * 0.15915494309189535f);
        const float sn0 = __builtin_amdgcn_sinf(x0), cs0 = __builtin_amdgcn_cosf(x0), sn1 = __builtin_amdgcn_sinf(x1), cs1 = __builtin_amdgcn_cosf(x1);
#pragma unroll
        for (int qk = 0; qk < 2; ++qk) {
            const bf16* p = pr + PJ_C + qk * 256 + hh * 64 + 2 * jj; const unsigned a = *(const unsigned*)p, b = *(const unsigned*)(p + 32);
            float x1a = bflo(a), x1b = bfhi(a), x2a = bflo(b), x2b = bfhi(b);
            float ss = group_sum<16>(x1a * x1a + x1b * x1b + x2a * x2a + x2b * x2b); const float rstd = rsqrtf(ss * (1.f / 64.f) + 1e-6f);
            const float* g = (qk ? C.dil_k_g : C.dil_q_g) + (size_t)l * 64; const float sc = qk ? 1.f : QSCALE;
            x1a *= rstd * g[2 * jj] * sc; x1b *= rstd * g[2 * jj + 1] * sc; x2a *= rstd * g[32 + 2 * jj] * sc; x2b *= rstd * g[33 + 2 * jj] * sc;
            bf16* o = (qk ? KC : QC) + (size_t)row * 256 + hh * 64 + 2 * jj;
            *(unsigned*)o = pk2(x1a * cs0 - x2a * sn0, x1b * cs1 - x2b * sn1); *(unsigned*)(o + 32) = pk2(x2a * cs0 + x1a * sn0, x2b * cs1 + x1b * sn1);
        }
        {
            const bf16* p = pr + PJ_D + hh * 64 + 2 * jj; const unsigned a = *(const unsigned*)p, b = *(const unsigned*)(p + 32);
            float x1a = bflo(a), x1b = bfhi(a), x2a = bflo(b), x2b = bfhi(b);
            float ss = group_sum<16>(x1a * x1a + x1b * x1b + x2a * x2a + x2b * x2b); const float rstd = rsqrtf(ss * (1.f / 64.f) + 1e-6f) * QSCALE;
            const float* g = C.nsa_q_g + (size_t)l * 64;
            x1a *= rstd * g[2 * jj]; x1b *= rstd * g[2 * jj + 1]; x2a *= rstd * g[32 + 2 * jj]; x2b *= rstd * g[33 + 2 * jj];
            bf16* on = QN + (size_t)row * 256 + hh * 64 + 2 * jj; *(unsigned*)on = pk2(x1a, x1b); *(unsigned*)(on + 32) = pk2(x2a, x2b);
            bf16* o = QR + (size_t)row * 256 + hh * 64 + 2 * jj;
            *(unsigned*)o = pk2(x1a * cs0 - x2a * sn0, x1b * cs1 - x2b * sn1); *(unsigned*)(o + 32) = pk2(x2a * cs0 + x1a * sn0, x2b * cs1 + x1b * sn1);
        }
        {
            const int col = hh == 0 ? 2944 : (hh == 1 ? 3072 : (hh == 2 ? 2816 : 2880));
            const bf16* p = pr + col + 2 * jj; const unsigned a = *(const unsigned*)p, b = *(const unsigned*)(p + 32);
            float x1a = bflo(a), x1b = bfhi(a), x2a = bflo(b), x2b = bfhi(b);
            float ss = group_sum<16>(x1a * x1a + x1b * x1b + x2a * x2a + x2b * x2b); const float rstd = rsqrtf(ss * (1.f / 64.f) + 1e-6f);
            const float* g = (hh == 0 ? C.nsa_ks_g : C.nsa_kw_g) + (size_t)l * 64;
            const float n1a = x1a * rstd * g[2 * jj], n1b = x1b * rstd * g[2 * jj + 1], n2a = x2a * rstd * g[32 + 2 * jj], n2b = x2b * rstd * g[33 + 2 * jj];
            unsigned o1 = pk2(n1a * cs0 - n2a * sn0, n1b * cs1 - n2b * sn1), o2 = pk2(n2a * cs0 + n1a * sn0, n2b * cs1 + n1b * sn1);
            if (hh >= 2) { o1 = a; o2 = b; }
            bf16* o = (hh == 0 ? KS : (hh == 1 ? KW : (hh == 2 ? KCR : VCR))) + (size_t)row * 64 + 2 * jj;
            *(unsigned*)o = o1; *(unsigned*)(o + 32) = o2;
        }
        if (lane < 12) GATE[(size_t)row * 12 + lane] = fsigmoid(bf2f(pr[3200 + lane]));
    }
}
constexpr int SCAN_TC = 16;
DI void scan_unit(const Ctx& C, int u) {
    const float* SC = WSP(float, R_SC); float* YA = WSP(float, R_YA);
    const int b = u >> 3, h = (u >> 1) & 3, half = u & 1, tid = C.tid;
    LAS float* buf = (LAS float*)C.lds;
    LAS float* yp = buf + 2 * 6144;
    const int rl = (tid >> 3) & 31, cg = tid & 7, row = 32 * half + rl;
    f32x4 ld[3];
#define SCAN_LOAD(chunk) do { _Pragma("unroll") for (int i = 0; i < 3; ++i) { const int idx = tid + 512 * i, step = idx / 96, rem = idx % 96, vec = rem >> 4, f4 = rem & 15; \
        ld[i] = *(const f32x4*)(SC + ((size_t)vec * NT + (size_t)b * NS + (chunk) * SCAN_TC + step) * 256 + h * 64 + f4 * 4); } } while (0)
#define SCAN_STORE(slot) do { _Pragma("unroll") for (int i = 0; i < 3; ++i) *(LAS f32x4*)(buf + (slot) * 6144 + (tid + 512 * i) * 4) = ld[i]; } while (0)
#define SCAN_FLUSH(chunk) do { _Pragma("unroll") for (int i = 0; i < 2; ++i) { const int i2 = (tid - 256) + 256 * i, step = i2 >> 5, rr = i2 & 31; const LAS float* pp = yp + ((chunk) & 1) * 4096 + step * 256 + rr * 8; \
        const f32x4 a = *(const LAS f32x4*)pp, c2 = *(const LAS f32x4*)(pp + 4); \
        YA[((size_t)b * NS + (chunk) * SCAN_TC + step) * 256 + h * 64 + 32 * half + rr] = ((a[0] + a[1]) + (a[2] + a[3])) + ((c2[0] + c2[1]) + (c2[2] + c2[3])); } } while (0)
    __syncthreads();
    SCAN_LOAD(0); SCAN_STORE(0);
    f32x2 S[4];
#pragma unroll
    for (int c = 0; c < 4; ++c) S[c] = (f32x2){0.f, 0.f};
    constexpr int NCH = NS / SCAN_TC;
    for (int ck = 0; ck < NCH; ++ck) {
        __syncthreads();
        if (ck + 1 < NCH) SCAN_LOAD(ck + 1);
        if (tid >= 256) { if (ck > 0) SCAN_FLUSH(ck - 1); }
        else {
            const LAS float* bp = buf + (ck & 1) * 6144; LAS float* yb = yp + (ck & 1) * 4096 + tid;
#define SCAN_LDS(X, step) do { const LAS float* sp = bp + (step) * 384 + 8 * cg; X.w0 = *(const LAS f32x4*)(sp); X.w1 = *(const LAS f32x4*)(sp + 4); X.k0 = *(const LAS f32x4*)(sp + 64); X.k1 = *(const LAS f32x4*)(sp + 68); \
                X.q0 = *(const LAS f32x4*)(sp + 128); X.q1 = *(const LAS f32x4*)(sp + 132); X.b0 = *(const LAS f32x4*)(sp + 192); X.b1 = *(const LAS f32x4*)(sp + 196); \
                X.r0 = *(const LAS f32x4*)(sp + 256); X.r1 = *(const LAS f32x4*)(sp + 260); X.v = bp[(step) * 384 + 320 + row]; } while (0)
#define SCAN_STEP(X, step) do { \
                f32x2 d2 = S[0] * (f32x2){X.q0[0], X.q0[1]}; d2 = S[1] * (f32x2){X.q0[2], X.q0[3]} + d2; d2 = S[2] * (f32x2){X.q1[0], X.q1[1]} + d2; d2 = S[3] * (f32x2){X.q1[2], X.q1[3]} + d2; \
                const float sa = -sum8(d2[0] + d2[1]); const f32x2 sa2 = (f32x2){sa, sa}, v2 = (f32x2){X.v, X.v}; \
                S[0] = S[0] * (f32x2){X.w0[0], X.w0[1]} + (sa2 * (f32x2){X.b0[0], X.b0[1]} + v2 * (f32x2){X.k0[0], X.k0[1]}); \
                S[1] = S[1] * (f32x2){X.w0[2], X.w0[3]} + (sa2 * (f32x2){X.b0[2], X.b0[3]} + v2 * (f32x2){X.k0[2], X.k0[3]}); \
                S[2] = S[2] * (f32x2){X.w1[0], X.w1[1]} + (sa2 * (f32x2){X.b1[0], X.b1[1]} + v2 * (f32x2){X.k1[0], X.k1[1]}); \
                S[3] = S[3] * (f32x2){X.w1[2], X.w1[3]} + (sa2 * (f32x2){X.b1[2], X.b1[3]} + v2 * (f32x2){X.k1[2], X.k1[3]}); \
                f32x2 y2 = S[0] * (f32x2){X.r0[0], X.r0[1]}; y2 = S[1] * (f32x2){X.r0[2], X.r0[3]} + y2; y2 = S[2] * (f32x2){X.r1[0], X.r1[1]} + y2; y2 = S[3] * (f32x2){X.r1[2], X.r1[3]} + y2; \
                yb[(step) * 256] = y2[0] + y2[1]; } while (0)
            struct StepIn { f32x4 w0, w1, k0, k1, q0, q1, b0, b1, r0, r1; float v; } A, B;
            SCAN_LDS(A, 0);
#pragma unroll 2
            for (int step = 0; step < SCAN_TC; step += 2) {
                SCAN_LDS(B, step + 1);
                __builtin_amdgcn_sched_barrier(0);
                SCAN_STEP(A, step);
                __builtin_amdgcn_sched_barrier(0);
                if (step + 2 < SCAN_TC) SCAN_LDS(A, step + 2);
                __builtin_amdgcn_sched_barrier(0);
                SCAN_STEP(B, step + 1);
                __builtin_amdgcn_sched_barrier(0);
            }
#undef SCAN_LDS
#undef SCAN_STEP
        }
        if (ck + 1 < NCH) SCAN_STORE((ck + 1) & 1);
    }
    __syncthreads();
    if (tid >= 256) SCAN_FLUSH(NCH - 1);
#undef SCAN_LOAD
#undef SCAN_STORE
#undef SCAN_FLUSH
    __syncthreads();
}

constexpr int KROW = 144, KT_BYTES = 64 * KROW;
#define MFMA16(a, b, c) __builtin_amdgcn_mfma_f32_16x16x32_bf16((a), (b), (c), 0, 0, 0)
template <int NQT> struct FA { f32x4 O[NQT][4]; float m[NQT], l[NQT]; };
template <int NQT> DI void fa_init(FA<NQT>& st) {
#pragma unroll
    for (int q = 0; q < NQT; ++q) { st.m[q] = -1e30f; st.l[q] = 0.f;
#pragma unroll
        for (int d = 0; d < 4; ++d) st.O[q][d] = (f32x4){0.f, 0.f, 0.f, 0.f}; }
}
DI bf16x8 pack8(const f32x4& a, const f32x4& b) { u32x4 w; w.x = pk2(a[0], a[1]); w.y = pk2(a[2], a[3]); w.z = pk2(b[0], b[1]); w.w = pk2(b[2], b[3]); return __builtin_bit_cast(bf16x8, w); }
struct VFrag { u32x2 a[4], b[4]; };
DI void vt_issue(VFrag& f, unsigned vaddr) {
    asm volatile("ds_read_b64_tr_b16 %0, %8\n\tds_read_b64_tr_b16 %1, %8 offset:2304\n\tds_read_b64_tr_b16 %2, %8 offset:32\n\tds_read_b64_tr_b16 %3, %8 offset:2336\n\t"
                 "ds_read_b64_tr_b16 %4, %8 offset:64\n\tds_read_b64_tr_b16 %5, %8 offset:2368\n\tds_read_b64_tr_b16 %6, %8 offset:96\n\tds_read_b64_tr_b16 %7, %8 offset:2400"
                 : "=&v"(f.a[0]), "=&v"(f.b[0]), "=&v"(f.a[1]), "=&v"(f.b[1]), "=&v"(f.a[2]), "=&v"(f.b[2]), "=&v"(f.a[3]), "=&v"(f.b[3]) : "v"(vaddr) : "memory");
}
DI void vt_wait(VFrag& f) { asm volatile("s_waitcnt lgkmcnt(0)" : "+v"(f.a[0]), "+v"(f.b[0]), "+v"(f.a[1]), "+v"(f.b[1]), "+v"(f.a[2]), "+v"(f.b[2]), "+v"(f.a[3]), "+v"(f.b[3]) :: "memory"); }
DI bf16x8 vt_get(const VFrag& f, int d) { return __builtin_bit_cast(bf16x8, ((u32x4){f.a[d].x, f.a[d].y, f.b[d].x, f.b[d].y})); }
template <int NQT, bool MASKED, class MaskF>
DI void fa_tile(FA<NQT>& st, const bf16x8 (&Q)[NQT][2], const LAS uchar* Ks, const LAS uchar* Vs, int lane, const MaskF& allowed, const bool (&act)[NQT]) {
    const int l15 = lane & 15, quad = lane >> 4;
    f32x4 S[NQT][4];
#pragma unroll
    for (int kt = 0; kt < 4; ++kt) {
        const bf16x8 k0 = *(const LAS bf16x8*)(Ks + (16 * kt + l15) * KROW + quad * 16), k1 = *(const LAS bf16x8*)(Ks + (16 * kt + l15) * KROW + 64 + quad * 16);
#pragma unroll
        for (int q = 0; q < NQT; ++q) if (act[q]) { S[q][kt] = MFMA16(k0, Q[q][0], ((f32x4){0.f, 0.f, 0.f, 0.f})); S[q][kt] = MFMA16(k1, Q[q][1], S[q][kt]); }
    }
    const unsigned vaddr = (unsigned)(size_t)(Vs + (4 * quad + (l15 >> 2)) * KROW + 8 * (l15 & 3));
    VFrag v0, v1; vt_issue(v0, vaddr); vt_issue(v1, vaddr + 32 * KROW);
#pragma unroll
    for (int q = 0; q < NQT; ++q) if (act[q]) {
        float mx = -1e30f;
#pragma unroll
        for (int kt = 0; kt < 4; ++kt)
#pragma unroll
            for (int j = 0; j < 4; ++j) { if (MASKED) { const float s = allowed(q, 16 * kt + 4 * quad + j) ? S[q][kt][j] : -1e30f; S[q][kt][j] = s; } mx = fmaxf(mx, S[q][kt][j]); }
        mx = fmaxf(mx, __shfl_xor(mx, 16)); mx = fmaxf(mx, __shfl_xor(mx, 32));
        const float mn = fmaxf(st.m[q], mx), alpha = fexp2(st.m[q] - mn); st.m[q] = mn;
        float rs = 0.f;
#pragma unroll
        for (int kt = 0; kt < 4; ++kt)
#pragma unroll
            for (int j = 0; j < 4; ++j) { const float s = S[q][kt][j]; float p = fexp2(s - mn); if (MASKED) p = (s > -1e29f) ? p : 0.f; S[q][kt][j] = p; rs += p; }
        st.l[q] = st.l[q] * alpha + rs;
#pragma unroll
        for (int d = 0; d < 4; ++d) st.O[q][d] = st.O[q][d] * alpha;
    }
    vt_wait(v0); vt_wait(v1);
#pragma unroll
    for (int q = 0; q < NQT; ++q) if (act[q]) {
        const bf16x8 p0 = pack8(S[q][0], S[q][1]), p1 = pack8(S[q][2], S[q][3]);
#pragma unroll
        for (int d = 0; d < 4; ++d) { st.O[q][d] = MFMA16(vt_get(v0, d), p0, st.O[q][d]); st.O[q][d] = MFMA16(vt_get(v1, d), p1, st.O[q][d]); }
    }
}
template <int NQT> DI void fa_finish(FA<NQT>& st, float (&lse2)[NQT]) {
#pragma unroll
    for (int q = 0; q < NQT; ++q) { float l = st.l[q]; l += __shfl_xor(l, 16); l += __shfl_xor(l, 32); const float inv = l > 0.f ? 1.f / l : 0.f; lse2[q] = st.m[q] + __log2f(fmaxf(l, 1e-37f));
#pragma unroll
        for (int d = 0; d < 4; ++d) st.O[q][d] = st.O[q][d] * inv; }
}
DI void kv_store(LAS uchar* Ks, LAS uchar* Vs, int tid, const u32x4& kr, const u32x4& vr) {
    const int o = (tid >> 3) * KROW + (tid & 7) * 16; *(LAS u32x4*)(Ks + o) = kr; *(LAS u32x4*)(Vs + o) = vr;
}
DI void q_load(bf16x8 (&Q)[2], const bf16* qrow, int quad) { Q[0] = *(const bf16x8*)(qrow + 8 * quad); Q[1] = *(const bf16x8*)(qrow + 32 + 8 * quad); }

struct DilMask { int qi[2]; int k0; DI bool operator()(int q, int key) const { const int ki = k0 + key, d = qi[q] - ki; return ki >= 0 && d >= 0 && d <= 128; } };
DI void dil_unit(const Ctx& C, int unit, LAS uchar* Ks, LAS uchar* Vs) {
    const bf16 *QC = WSP(bf16, R_QC), *KC = WSP(bf16, R_KC), *PROJ = WSP(bf16, R_PROJ); float* OC = WSP(float, R_OC); float* LSE = WSP(float, R_LSE);
    int tid = C.tid, lane = C.lane; asm volatile("" : "+v"(tid), "+v"(lane));
    const int w = C.wave, l15 = lane & 15, quad = lane >> 4;
    const int cfg = unit / 512, r = unit % 512, dsh = 2 * cfg, d = 1 << dsh;
    const int b = r >> 6, h = (r >> 4) & 3, r2 = r & 15;
    const int nblk = 16 >> dsh, res = r2 / nblk, blk = r2 % nblk, i0 = blk * 256;
    const size_t tb = (size_t)b * NS;
    bf16x8 Q[2][2]; DilMask mk; FA<2> st; fa_init(st);
#pragma unroll
    for (int q = 0; q < 2; ++q) { mk.qi[q] = i0 + 32 * w + 16 * q + l15; q_load(Q[q], QC + (tb + res + (size_t)d * mk.qi[q]) * 256 + h * 64, quad); }
    const int jlo = w >> 1, jhi = (w >> 1) + 2;
    const bool act[2] = {true, true};
    u32x4 kr, vr;
#define DIL_LOAD(j) do { const int ki = i0 - 128 + 64 * (j) + (tid >> 3); kr = (u32x4){0u, 0u, 0u, 0u}; vr = kr; \
    if (ki >= 0) { const size_t rowk = tb + res + (size_t)d * ki; kr = *(const u32x4*)(KC + rowk * 256 + h * 64 + (tid & 7) * 8); vr = *(const u32x4*)(PROJ + rowk * NPJ + PJ_C + 512 + h * 64 + (tid & 7) * 8); } } while (0)
    DIL_LOAD(0);
    for (int j = 0; j < 6; ++j) {
        __syncthreads(); kv_store(Ks, Vs, tid, kr, vr); __syncthreads();
        if (j + 1 < 6) DIL_LOAD(j + 1);
        if (j >= jlo && j <= jhi) { mk.k0 = i0 - 128 + 64 * j; fa_tile<2, true>(st, Q, Ks, Vs, lane, mk, act); }
    }
#undef DIL_LOAD
    float lse2[2]; fa_finish<2>(st, lse2);
#pragma unroll
    for (int q = 0; q < 2; ++q) { const size_t rowq = tb + res + (size_t)d * mk.qi[q]; float* o = OC + ((size_t)cfg * NT + rowq) * 256 + h * 64 + 4 * quad;
#pragma unroll
        for (int dt = 0; dt < 4; ++dt) *(f32x4*)(o + 16 * dt) = st.O[q][dt];
        if (quad == 0) LSE[((size_t)cfg * NT + rowq) * 4 + h] = lse2[q]; }
}
constexpr int NSA_KC = 0, NSA_VC = 256 * KROW, NSA_KT = 2 * 256 * KROW, NSA_VT = NSA_KT + KT_BYTES, NSA_IMP = NSA_VT + KT_BYTES, NSA_SELM = NSA_IMP + 64 * 64 * 4, NSA_UW = NSA_SELM + 512;
static_assert(NSA_UW + 16 <= RING_BYTES, "NSA LDS map");
struct SwaMask { int t[2]; int k0; DI bool operator()(int q, int key) const { const int d = t[q] - (k0 + key); return d >= 0 && d <= 511; } };
struct SlcMask { int t[2]; int k0; bool sel[2]; DI bool operator()(int q, int key) const { return sel[q] && (k0 + key <= t[q]); } };
struct NoMask { DI bool operator()(int, int) const { return true; } };
DI void nsa_unit(const Ctx& C, int l, int b, int tbk, int& bl) {
    const bf16 *QN = WSP(bf16, R_QN), *QR = WSP(bf16, R_QR), *KSb = WSP(bf16, R_KS), *KWb = WSP(bf16, R_KW), *PROJ = WSP(bf16, R_PROJ); const float* CMP = WSP(float, R_CMP); const float* GATE = WSP(float, R_GATE);
    bf16* YCAT = WSP(bf16, R_YCAT);
    LAS uchar* Kc = C.lds + NSA_KC; LAS uchar* Vc = C.lds + NSA_VC; LAS uchar* Ks = C.lds + NSA_KT; LAS uchar* Vs = C.lds + NSA_VT;
    LAS float* imps = (LAS float*)(C.lds + NSA_IMP); LAS unsigned* selm = (LAS unsigned*)(C.lds + NSA_SELM); LAS unsigned* uw = (LAS unsigned*)(C.lds + NSA_UW);
    int tid = C.tid, lane = C.lane; asm volatile("" : "+v"(tid), "+v"(lane));
    const int w = C.wave, l15 = lane & 15, quad = lane >> 4, head = l15 & 3, t0 = 64 * tbk; const size_t tb = (size_t)b * NS;
    __syncthreads();
    if (b != bl) {
        const int key = tid >> 1, hf = tid & 1; const float* kp = CMP + ((size_t)b * 256 + key) * 64 + 32 * hf; const float* vp = CMP + ((size_t)2048 + (size_t)b * 256 + key) * 64 + 32 * hf;
        float kv[32], vv[32]; float ss = 0.f;
#pragma unroll
        for (int i = 0; i < 8; ++i) { const f32x4 a = *(const f32x4*)(kp + 4 * i), c = *(const f32x4*)(vp + 4 * i);
#pragma unroll
            for (int j = 0; j < 4; ++j) { kv[4 * i + j] = a[j]; vv[4 * i + j] = c[j]; ss += a[j] * a[j]; } }
        ss += __shfl_xor(ss, 1); const float rstd = rsqrtf(ss * (1.f / 64.f) + 1e-6f); const float* g = C.nsa_kc_g + (size_t)l * 64 + 32 * hf; const bool dead = (key == 255);
#pragma unroll
        for (int i = 0; i < 4; ++i) { u32x4 o, p;
            o.x = pk2(kv[8 * i] * rstd * g[8 * i], kv[8 * i + 1] * rstd * g[8 * i + 1]); o.y = pk2(kv[8 * i + 2] * rstd * g[8 * i + 2], kv[8 * i + 3] * rstd * g[8 * i + 3]);
            o.z = pk2(kv[8 * i + 4] * rstd * g[8 * i + 4], kv[8 * i + 5] * rstd * g[8 * i + 5]); o.w = pk2(kv[8 * i + 6] * rstd * g[8 * i + 6], kv[8 * i + 7] * rstd * g[8 * i + 7]);
            p.x = pk2(vv[8 * i], vv[8 * i + 1]); p.y = pk2(vv[8 * i + 2], vv[8 * i + 3]); p.z = pk2(vv[8 * i + 4], vv[8 * i + 5]); p.w = pk2(vv[8 * i + 6], vv[8 * i + 7]);
            if (dead) { o = (u32x4){0u, 0u, 0u, 0u}; p = o; }
            *(LAS u32x4*)(Kc + key * KROW + hf * 64 + i * 16) = o; *(LAS u32x4*)(Vc + key * KROW + hf * 64 + i * 16) = p; }
        bl = b;
        __syncthreads();
    }
    f32x4 Oc[2][4];
    const int cmaxu = (t0 + 32) >> 4, ktmax = cmaxu >> 4;
    const unsigned vaddr0 = (unsigned)(size_t)(Vc + (4 * quad + (l15 >> 2)) * KROW + 8 * (l15 & 3));
#pragma unroll
    for (int q = 0; q < 2; ++q) {
        const int t = t0 + 8 * w + 4 * q + (l15 >> 2);
        bf16x8 Q[2]; q_load(Q, QN + (tb + t) * 256 + head * 64, quad);
        f32x4 S[16]; float mx = -1e30f;
#pragma unroll
        for (int kt = 0; kt < 16; ++kt) {
            if (kt <= ktmax) {
                const bf16x8 k0 = *(const LAS bf16x8*)(Kc + (16 * kt + l15) * KROW + quad * 16), k1 = *(const LAS bf16x8*)(Kc + (16 * kt + l15) * KROW + 64 + quad * 16);
                S[kt] = MFMA16(k0, Q[0], ((f32x4){0.f, 0.f, 0.f, 0.f})); S[kt] = MFMA16(k1, Q[1], S[kt]);
#pragma unroll
                for (int j = 0; j < 4; ++j) { const int c = 16 * kt + 4 * quad + j; const float s = (16 * c + 31 <= t) ? S[kt][j] : -1e30f; S[kt][j] = s; mx = fmaxf(mx, s); }
            } else S[kt] = (f32x4){-1e30f, -1e30f, -1e30f, -1e30f};
        }
        mx = fmaxf(mx, __shfl_xor(mx, 16)); mx = fmaxf(mx, __shfl_xor(mx, 32));
        float ls = 0.f;
#pragma unroll
        for (int kt = 0; kt < 16; ++kt)
#pragma unroll
            for (int j = 0; j < 4; ++j) { const float s = S[kt][j]; const float p = (s > -1e29f) ? fexp2(s - mx) : 0.f; S[kt][j] = p; ls += p; }
        ls += __shfl_xor(ls, 16); ls += __shfl_xor(ls, 32);
        const float inv = ls > 0.f ? 1.f / ls : 0.f;
#pragma unroll
        for (int kt = 0; kt < 16; ++kt) S[kt] = S[kt] * inv;
#pragma unroll
        for (int kt = 0; kt < 16; ++kt) {
            const float send = (quad == 3) ? (kt > 0 ? S[kt > 0 ? kt - 1 : 0][3] : 0.f) : S[kt][3];
            const float prev = __shfl(send, (lane + 48) & 63);
            float v = ((quad == 0 && kt == 0) ? 0.f : prev) + 2.f * (S[kt][0] + S[kt][1] + S[kt][2]) + S[kt][3];
            v += __shfl_xor(v, 1); v += __shfl_xor(v, 2);
            if (head == 0) imps[(8 * w + 4 * q + (l15 >> 2)) * 64 + 4 * kt + quad] = v;
        }
#pragma unroll
        for (int d = 0; d < 4; ++d) Oc[q][d] = (f32x4){0.f, 0.f, 0.f, 0.f};
#pragma unroll
        for (int ks = 0; ks < 8; ++ks) {
            if (2 * ks <= ktmax) {
                VFrag vf; vt_issue(vf, vaddr0 + ks * 32 * KROW); const bf16x8 pf = pack8(S[2 * ks], S[2 * ks + 1]); vt_wait(vf);
#pragma unroll
                for (int d = 0; d < 4; ++d) Oc[q][d] = MFMA16(vt_get(vf, d), pf, Oc[q][d]);
            }
        }
    }
    {
        float* OCm = WSP(float, R_OCMP);
#pragma unroll
        for (int q = 0; q < 2; ++q) { float* o = OCm + (tb + t0 + 8 * w + 4 * q + (l15 >> 2)) * 256 + head * 64 + 4 * quad;
#pragma unroll
            for (int d = 0; d < 4; ++d) *(f32x4*)(o + 16 * d) = Oc[q][d]; }
    }
    __syncthreads();
    if (tid < 64) {
        const int cur = tbk; unsigned long long mask;
        if (cur <= 15) mask = (2ull << cur) - 1ull;
        else {
            mask = 1ull | (1ull << cur) | (1ull << (cur - 1));
            float v[64];
#pragma unroll
            for (int i = 0; i < 16; ++i) { const f32x4 a = *(const LAS f32x4*)(imps + tid * 64 + 4 * i);
#pragma unroll
                for (int j = 0; j < 4; ++j) { const int jb = 4 * i + j; v[jb] = (jb >= 1 && jb <= cur - 2) ? a[j] : -1.f; } }
#pragma unroll 1
            for (int r = 0; r < 13; ++r) {
                float bv = -0.5f; int bi = 0;
#pragma unroll
                for (int jb = 0; jb < 64; ++jb) if (v[jb] > bv) { bv = v[jb]; bi = jb; }
                mask |= 1ull << bi;
#pragma unroll
                for (int jb = 0; jb < 64; ++jb) v[jb] = (jb == bi) ? -1.f : v[jb];
            }
        }
        unsigned lo = (unsigned)mask, hi = (unsigned)(mask >> 32);
        selm[2 * tid] = lo; selm[2 * tid + 1] = hi;
#pragma unroll
        for (int o = 1; o < 64; o <<= 1) { lo |= __shfl_xor(lo, o); hi |= __shfl_xor(hi, o); }
        if (tid == 0) { uw[0] = lo; uw[1] = hi; }
    }
    __syncthreads();
    unsigned long long U = ((unsigned long long)uw[1] << 32) | uw[0];
    bf16x8 Q[2][2]; SlcMask mk; FA<2> st; fa_init(st); unsigned long long msk[2];
#pragma unroll
    for (int q = 0; q < 2; ++q) { const int tl = 8 * w + 4 * q + (l15 >> 2); mk.t[q] = t0 + tl; msk[q] = ((unsigned long long)selm[2 * tl + 1] << 32) | selm[2 * tl]; q_load(Q[q], QR + (tb + mk.t[q]) * 256 + head * 64, quad); }
    unsigned long long QM[2];
#pragma unroll
    for (int q = 0; q < 2; ++q) { unsigned lo = (unsigned)msk[q], hi = (unsigned)(msk[q] >> 32);
#pragma unroll
        for (int o = 1; o < 64; o <<= 1) { lo |= __shfl_xor(lo, o); hi |= __shfl_xor(hi, o); }
        QM[q] = ((unsigned long long)hi << 32) | lo; }
    u32x4 kr, vr;
#define SLC_LOAD(j) do { const size_t rowk = tb + 64 * (j) + (tid >> 3); kr = *(const u32x4*)(KSb + rowk * 64 + (tid & 7) * 8); vr = *(const u32x4*)(PROJ + rowk * NPJ + 3008 + (tid & 7) * 8); } while (0)
    {
        int j = __builtin_ctzll(U); U &= U - 1ull;
        SLC_LOAD(j);
        for (;;) {
            __syncthreads(); kv_store(Ks, Vs, tid, kr, vr); __syncthreads();
            const int jn = U ? __builtin_ctzll(U) : -1; U &= U - 1ull;
            if (jn >= 0) SLC_LOAD(jn);
            const bool act[2] = {(bool)((QM[0] >> j) & 1ull), (bool)((QM[1] >> j) & 1ull)};
            if (act[0] || act[1]) { mk.k0 = 64 * j; mk.sel[0] = (msk[0] >> j) & 1ull; mk.sel[1] = (msk[1] >> j) & 1ull; fa_tile<2, true>(st, Q, Ks, Vs, lane, mk, act); }
            if (jn < 0) break; j = jn;
        }
    }
#undef SLC_LOAD
    float lse2[2]; fa_finish<2>(st, lse2);
    {   float* OSl = WSP(float, R_OSLC);
#pragma unroll
        for (int q = 0; q < 2; ++q) { float* o = OSl + (tb + mk.t[q]) * 256 + head * 64 + 4 * quad;
#pragma unroll
            for (int d = 0; d < 4; ++d) *(f32x4*)(o + 16 * d) = st.O[q][d]; }
    }
    FA<2> sw; fa_init(sw); SwaMask mw; mw.t[0] = mk.t[0]; mw.t[1] = mk.t[1];
    {
        const int j0 = tbk >= 8 ? tbk - 8 : 0; const bool act[2] = {true, true};
#define SWA_LOAD(j) do { const size_t rowk = tb + 64 * (j) + (tid >> 3); kr = *(const u32x4*)(KWb + rowk * 64 + (tid & 7) * 8); vr = *(const u32x4*)(PROJ + rowk * NPJ + 3136 + (tid & 7) * 8); } while (0)
        SWA_LOAD(j0);
        for (int j = j0; j <= tbk; ++j) {
            __syncthreads(); kv_store(Ks, Vs, tid, kr, vr); __syncthreads();
            if (j + 1 <= tbk) SWA_LOAD(j + 1);
            mw.k0 = 64 * j;
            if (j == tbk || j == tbk - 8) fa_tile<2, true>(sw, Q, Ks, Vs, lane, mw, act);
            else fa_tile<2, false>(sw, Q, Ks, Vs, lane, NoMask(), act);
        }
#undef SWA_LOAD
    }
    fa_finish<2>(sw, lse2);
#pragma unroll
    for (int q = 0; q < 2; ++q) {
        const size_t row = tb + mk.t[q]; const float* gp = GATE + row * 12 + head * 3; const float g0 = gp[0], g1 = gp[1], g2 = gp[2];
        f32x4 o[4]; float ss = 0.f; const float* pc = WSP(float, R_OCMP) + row * 256 + head * 64 + 4 * quad; const float* ps = WSP(float, R_OSLC) + row * 256 + head * 64 + 4 * quad;
#pragma unroll
        for (int d = 0; d < 4; ++d) { o[d] = *(const f32x4*)(pc + 16 * d) * g0 + *(const f32x4*)(ps + 16 * d) * g1 + sw.O[q][d] * g2; ss += (o[d][0] * o[d][0] + o[d][1] * o[d][1]) + (o[d][2] * o[d][2] + o[d][3] * o[d][3]); }
        ss += __shfl_xor(ss, 16); ss += __shfl_xor(ss, 32);
        const float rstd = rsqrtf(ss * (1.f / 64.f) + 1e-6f); const float* og = C.onorm_g + (size_t)l * 768 + 512 + head * 64 + 4 * quad;
        bf16* yo = YCAT + row * DM + 768 + head * 64 + 4 * quad;
#pragma unroll
        for (int d = 0; d < 4; ++d) { const f32x4 g4 = *(const f32x4*)(og + 16 * d); u32x2 wv; wv.x = pk2(o[d][0] * rstd * g4[0], o[d][1] * rstd * g4[1]); wv.y = pk2(o[d][2] * rstd * g4[2], o[d][3] * rstd * g4[3]); *(u32x2*)(yo + 16 * d) = wv; }
    }
}

DI void fin_phase(const Ctx& C, int l) {
    const float* SC = WSP(float, R_SC); const float* YA = WSP(float, R_YA); const float* Gb = WSP(float, R_G); const float* OC = WSP(float, R_OC); const float* LSE = WSP(float, R_LSE);
    bf16* YCAT = WSP(bf16, R_YCAT);
    const int lane = C.lane, gw = C.bid * NWAVE + C.wave, NGW = C.G * NWAVE, ch = 4 * lane, hh = lane >> 4;
    for (int row = gw; row < NT; row += NGW) {
        const size_t o = (size_t)row * 256 + ch;
        {
            const f32x4 y = *(const f32x4*)(YA + o), r = *(const f32x4*)(SC + (size_t)4 * NT * 256 + o), k = *(const f32x4*)(SC + (size_t)1 * NT * 256 + o), v = *(const f32x4*)(SC + (size_t)5 * NT * 256 + o), g = *(const f32x4*)(Gb + o);
            const f32x4 rk = *(const f32x4*)(C.rk + (size_t)l * 256 + ch), gw4 = *(const f32x4*)(C.gn_w + (size_t)l * 256 + ch), gb4 = *(const f32x4*)(C.gn_b + (size_t)l * 256 + ch);
            const float mu = group_sum<16>((y[0] + y[1]) + (y[2] + y[3])) * (1.f / 64.f);
            const f32x4 dy = y - mu; const float var = group_sum<16>((dy[0] * dy[0] + dy[1] * dy[1]) + (dy[2] * dy[2] + dy[3] * dy[3])) * (1.f / 64.f);
            const float rstd = rsqrtf(var + 64e-5f);
            const float dot = group_sum<16>((r[0] * k[0] * rk[0] + r[1] * k[1] * rk[1]) + (r[2] * k[2] * rk[2] + r[3] * k[3] * rk[3]));
            float out[4];
#pragma unroll
            for (int i = 0; i < 4; ++i) out[i] = ((dy[i] * rstd * gw4[i] + gb4[i]) + dot * v[i]) * g[i];
            u32x2 w; w.x = pk2(out[0], out[1]); w.y = pk2(out[2], out[3]); *(u32x2*)(YCAT + (size_t)row * DM + ch) = w;
        }
        {
            const float l0 = LSE[(size_t)row * 4 + hh], l1 = LSE[((size_t)NT + row) * 4 + hh], l2 = LSE[((size_t)2 * NT + row) * 4 + hh];
            const float mx = fmaxf(l0, fmaxf(l1, l2)); float w0 = fexp2(l0 - mx), w1 = fexp2(l1 - mx), w2 = fexp2(l2 - mx); const float inv = 1.f / (w0 + w1 + w2); w0 *= inv; w1 *= inv; w2 *= inv;
            const f32x4 a = *(const f32x4*)(OC + o), b = *(const f32x4*)(OC + (size_t)NT * 256 + o), c = *(const f32x4*)(OC + (size_t)2 * NT * 256 + o);
            const f32x4 y = a * w0 + b * w1 + c * w2;
            const float ss = group_sum<16>((y[0] * y[0] + y[1] * y[1]) + (y[2] * y[2] + y[3] * y[3])); const float rstd = rsqrtf(ss * (1.f / 64.f) + 1e-6f);
            const f32x4 og = *(const f32x4*)(C.onorm_g + (size_t)l * 768 + 256 + ch);
            u32x2 w; w.x = pk2(y[0] * rstd * og[0], y[1] * rstd * og[1]); w.y = pk2(y[2] * rstd * og[2], y[3] * rstd * og[3]); *(u32x2*)(YCAT + (size_t)row * DM + 512 + ch) = w;
        }
    }
}

constexpr int CW_Q = 40000;
DI int q_next(const Ctx& C, unsigned* ctr, LAS int* slot) {
    __syncthreads();
    if (C.tid == 0) *slot = (int)__hip_atomic_fetch_add(ctr, 1u, __ATOMIC_RELAXED, __HIP_MEMORY_SCOPE_AGENT);
    __syncthreads();
    return *slot;
}
DI void conv_ticket(const Ctx& C, int l, int tk);
DI void mix_phase(const Ctx& C, int l) {
    unsigned* ctl = WSP(unsigned, WS_CTL) + CW_Q + 64 * 3 * l; LAS int* slot = (LAS int*)(C.lds + MISC_OFF + 1024);
#ifndef PROBE_SCAN2
#define PROBE_SCAN2 0
#endif
#ifndef PROBE_ATT2
#define PROBE_ATT2 0
#endif
    if (C.bid < 64) { scan_unit(C, C.bid); if (PROBE_SCAN2) scan_unit(C, C.bid); }
    int bl = -1;
    for (;;) { const int u = q_next(C, ctl, slot); if (u >= 512 * (1 + PROBE_ATT2)) break; nsa_unit(C, l, u & 7, 63 - ((u & 511) >> 3), bl); }
    for (;;) { const int u = q_next(C, ctl + 64, slot); if (u >= 1536 * (1 + PROBE_ATT2)) break; dil_unit(C, u % 1536, C.lds, C.lds + KT_BYTES); }
    for (;;) { const int u = q_next(C, ctl + 128, slot); if (u >= 768) break; conv_ticket(C, l, u); }
    __syncthreads();
}
#define MFMA_F32(a, b, c) __builtin_amdgcn_mfma_f32_16x16x4f32((a), (b), (c), 0, 0, 0)
DI void router_phase(const Ctx& C, int l) {
    const float* X = C.out; const float* MOD = WSP(float, WS_SMALL) + (size_t)l * 8 * 6144; unsigned char* H8 = WSP(unsigned char, R_XS);
    int* TOPE = WSP(int, WS_ROUTE); float* TOPG = (float*)(TOPE + NT * 4); unsigned* CNTB = WSP(unsigned, WS_CTL) + CW_CNT + l * 8192;
    LAS float* lg = (LAS float*)C.lds + C.wave * 512;
    LAS unsigned* hist = (LAS unsigned*)(C.lds + 16384);
    LAS float* rs = (LAS float*)(C.lds + 16384 + 256) + C.wave * 16;
    const int lane = C.lane, l15 = lane & 15, quad = lane >> 4, gw = C.bid * NWAVE + C.wave, NGW = C.G * NWAVE;
    if (C.tid < 32) hist[C.tid] = 0u;
    __syncthreads();
    const float* wr = C.w_router + (size_t)l * 1024 * 32; const float* g2 = C.norm2_g + (size_t)l * DM;
    for (int task = gw; task < NT / 16; task += NGW) {
        const int row0 = 16 * task, b = row0 / NS;
        const float* shb = MOD + (size_t)b * 6144 + 3072; const float* scb = shb + 1024;
        {
            f32x4 gg[4], sa[4], sb[4];
#pragma unroll
            for (int j = 0; j < 4; ++j) { const int k = 4 * lane + 256 * j; const f32x4 g = *(const f32x4*)(g2 + k), a = *(const f32x4*)(scb + k); gg[j] = g * (a + 1.f); sb[j] = *(const f32x4*)(shb + k); }
#pragma unroll 2
            for (int r = 0; r < 16; ++r) {
                const float* xr = X + (size_t)(row0 + r) * DM + 4 * lane; f32x4 v[4]; float ss = 0.f;
#pragma unroll
                for (int j = 0; j < 4; ++j) { v[j] = *(const f32x4*)(xr + 256 * j); ss += (v[j][0] * v[j][0] + v[j][1] * v[j][1]) + (v[j][2] * v[j][2] + v[j][3] * v[j][3]); }
                ss = group_sum<64>(ss); const float rstd = rsqrtf(ss * (1.f / DM) + 1e-6f);
                if (lane == 0) rs[r] = rstd;
                unsigned char* hp = H8 + (size_t)(row0 + r) * DM + 4 * lane;
#pragma unroll
                for (int j = 0; j < 4; ++j) { const f32x4 h = v[j] * rstd * gg[j] + sb[j]; *(unsigned*)(hp + 256 * j) = pk4_fp8(h[0], h[1], h[2], h[3]); }
            }
        }
        const float* xr = X + (size_t)(row0 + l15) * DM + 4 * quad; const float* sh = shb + 4 * quad; const float* sc = scb + 4 * quad;
        asm volatile("s_waitcnt lgkmcnt(0)" ::: "memory");
        const float rstd = rs[l15];
        f32x4 acc0 = (f32x4){0.f, 0.f, 0.f, 0.f}, acc1 = acc0;
#pragma unroll 2
        for (int i = 0; i < 64; ++i) {
            const f32x4 a = *(const f32x4*)(xr + 16 * i), g = *(const f32x4*)(g2 + 16 * i + 4 * quad), s1 = *(const f32x4*)(sc + 16 * i), s0 = *(const f32x4*)(sh + 16 * i);
            f32x4 h;
#pragma unroll
            for (int j = 0; j < 4; ++j) h[j] = a[j] * rstd * g[j] * (1.f + s1[j]) + s0[j];
            const float* wp = wr + (size_t)(16 * i + 4 * quad) * 32 + l15;
#pragma unroll
            for (int j = 0; j < 4; ++j) { acc0 = MFMA_F32(h[j], wp[j * 32], acc0); acc1 = MFMA_F32(h[j], wp[j * 32 + 16], acc1); }
        }
        const float b0 = C.b_router[l * 32 + l15], b1 = C.b_router[l * 32 + 16 + l15];
#pragma unroll
        for (int j = 0; j < 4; ++j) { lg[(4 * quad + j) * 32 + l15] = acc0[j] + b0; lg[(4 * quad + j) * 32 + 16 + l15] = acc1[j] + b1; }
        asm volatile("s_waitcnt lgkmcnt(0)" ::: "memory");
        if (lane < 16) {
            float v[32];
#pragma unroll
            for (int i = 0; i < 8; ++i) { const f32x4 a = *(const LAS f32x4*)(lg + lane * 32 + 4 * i); v[4 * i] = a[0]; v[4 * i + 1] = a[1]; v[4 * i + 2] = a[2]; v[4 * i + 3] = a[3]; }
            float tv[4]; int ti[4];
#pragma unroll
            for (int r = 0; r < 4; ++r) { float bv = -3.0e38f; int bi = 0;
#pragma unroll
                for (int e = 0; e < 32; ++e) if (v[e] > bv) { bv = v[e]; bi = e; }
                tv[r] = bv; ti[r] = bi;
#pragma unroll
                for (int e = 0; e < 32; ++e) v[e] = (e == bi) ? -3.0e38f : v[e]; }
            const float e1 = __expf(tv[1] - tv[0]), e2 = __expf(tv[2] - tv[0]), e3 = __expf(tv[3] - tv[0]), inv = 1.f / (1.f + e1 + e2 + e3);
            const int row = row0 + lane;
            *(int4*)(TOPE + (size_t)row * 4) = make_int4(ti[0], ti[1], ti[2], ti[3]);
            *(f32x4*)(TOPG + (size_t)row * 4) = (f32x4){inv, e1 * inv, e2 * inv, e3 * inv};
#pragma unroll
            for (int r = 0; r < 4; ++r) __hip_atomic_fetch_add(&hist[ti[r]], 1u, __ATOMIC_RELAXED, __HIP_MEMORY_SCOPE_WORKGROUP);
        }
        asm volatile("s_waitcnt lgkmcnt(0)" ::: "memory");
    }
    __syncthreads();
    if (C.tid < 32) CNTB[C.bid * 32 + C.tid] = hist[C.tid];
}

DI void moe_tables(const Ctx& C, int l, LAS int* tab) {
    const unsigned* CNTB = WSP(unsigned, WS_CTL) + CW_CNT + l * 8192;
    __syncthreads();
    if (C.tid < 32) { unsigned tot = 0u, mine = 0u;
        for (int g = 0; g < C.G; ++g) { const unsigned c = CNTB[g * 32 + C.tid]; tot += c; mine += (g < C.bid) ? c : 0u; }
        tab[128 + C.tid] = (int)((tot + 255u) >> 8); tab[64 + C.tid] = (int)mine; }
    __syncthreads();
    if (C.tid == 0) { int s = 0; for (int e = 0; e < 32; ++e) { tab[e] = s; s += tab[128 + e]; } tab[32] = s; }
    __syncthreads();
}
DI void scatter_phase(const Ctx& C, int l) {
    const int* TOPE = WSP(int, WS_ROUTE); int* POS = (int*)(TOPE + NT * 8); int* ROWMAP = (int*)(TOPE + NT * 12);
    LAS int* tab = (LAS int*)(C.lds + MISC_OFF + 64); LAS unsigned* cur = (LAS unsigned*)(C.lds + 16384);
    moe_tables(C, l, tab);
    if (C.tid < 32) cur[C.tid] = (unsigned)(tab[C.tid] * 256 + tab[64 + C.tid]);
    __syncthreads();
    const int lane = C.lane, gw = C.bid * NWAVE + C.wave, NGW = C.G * NWAVE;
    for (int task = gw; task < NT / 16; task += NGW) {
        const int row0 = 16 * task, tok = row0 + (lane >> 2);
        const int e = TOPE[(size_t)tok * 4 + (lane & 3)];
        const int slot = (int)__hip_atomic_fetch_add(&cur[e], 1u, __ATOMIC_RELAXED, __HIP_MEMORY_SCOPE_WORKGROUP);
        POS[(size_t)tok * 4 + (lane & 3)] = slot; ROWMAP[slot] = tok;
    }
}
DI void combine_phase(const Ctx& C, int l) {
    const bf16* YB = WSP(bf16, R_YB); const int* TOPE = WSP(int, WS_ROUTE); const float* TOPG = (const float*)(TOPE + NT * 4); const int* POS = (const int*)(TOPE + NT * 8);
    const float* MOD = WSP(float, WS_SMALL) + (size_t)l * 8 * 6144; bf16* H = WSP(bf16, WS_H);
    const int lane = C.lane, gw = C.bid * NWAVE + C.wave, NGW = C.G * NWAVE;
    for (int row = gw; row < NT; row += NGW) {
        const int b = row / NS; const int4 ps = *(const int4*)(POS + (size_t)row * 4); const f32x4 gk = *(const f32x4*)(TOPG + (size_t)row * 4);
        const int pp[4] = {ps.x, ps.y, ps.z, ps.w};
        float* orow = C.out + (size_t)row * DM; const float* gt = MOD + (size_t)b * 6144 + 5120;
        f32x4 v[4]; float s = 0.f;
#pragma unroll
        for (int j = 0; j < 4; ++j) { const int k = 4 * lane + 256 * j; f32x4 a = (f32x4){0.f, 0.f, 0.f, 0.f};
#pragma unroll
            for (int q = 0; q < 4; ++q) { const u32x2 y = *(const u32x2*)(YB + (size_t)pp[q] * DM + k); a += (f32x4){bflo(y.x), bfhi(y.x), bflo(y.y), bfhi(y.y)} * gk[q]; }
            v[j] = *(const f32x4*)(orow + k) + *(const f32x4*)(gt + k) * a; *(f32x4*)(orow + k) = v[j];
            s += (v[j][0] * v[j][0] + v[j][1] * v[j][1]) + (v[j][2] * v[j][2] + v[j][3] * v[j][3]); }
        if (l + 1 < NLAYER) {
            s = group_sum<64>(s); const float rstd = rsqrtf(s * (1.f / DM) + 1e-6f); const float* M2 = MOD + 8 * 6144 + (size_t)b * 6144; const float* g = C.norm1_g + (size_t)(l + 1) * DM;
#pragma unroll
            for (int j = 0; j < 4; ++j) { const int k = 4 * lane + 256 * j; const f32x4 gg = *(const f32x4*)(g + k), a = *(const f32x4*)(M2 + 1024 + k), bb = *(const f32x4*)(M2 + k); f32x4 h;
#pragma unroll
                for (int i = 0; i < 4; ++i) h[i] = v[j][i] * rstd * gg[i] * (1.f + a[i]) + bb[i];
                u32x2 o; o.x = pk2(h[0], h[1]); o.y = pk2(h[2], h[3]); *(u32x2*)(H + (size_t)row * DM + k) = o; }
        }
    }
}
constexpr int PH_PER_LAYER = 11, PH_BASE = 2, N_PHASES = PH_BASE + NLAYER * PH_PER_LAYER;
#ifndef MK_ONE_LAUNCH
#define MK_ONE_LAUNCH 1
#endif
__global__ void __launch_bounds__(NTHR, 2) mk_fwd(Args args) {
    extern __shared__ __attribute__((aligned(16))) unsigned char lds_raw[];
    Ctx C;
    C.lds = (LAS unsigned char*)lds_raw; C.tid = threadIdx.x; C.lane = C.tid & 63; C.wave = __builtin_amdgcn_readfirstlane(C.tid >> 6); C.G = gridDim.x; C.bid = blockIdx.x;
    C.x = (const float*)args.in[0]; C.c = (const float*)args.in[1]; C.pos = (const int*)args.in[2]; C.w_ada = (const float*)args.in[3]; C.b_ada = (const float*)args.in[4];
    C.norm1_g = (const float*)args.in[5]; C.norm2_g = (const float*)args.in[6]; C.w_in = (const float*)args.in[7]; C.w_out = (const float*)args.in[8]; C.mu = (const float*)args.in[9];
    C.w0 = (const float*)args.in[10]; C.w2 = (const float*)args.in[11]; C.a0 = (const float*)args.in[12]; C.a2 = (const float*)args.in[13]; C.g2 = (const float*)args.in[14];
    C.kkw = (const float*)args.in[15]; C.ka = (const float*)args.in[16]; C.rk = (const float*)args.in[17]; C.gn_w = (const float*)args.in[18]; C.gn_b = (const float*)args.in[19];
    C.conv_w = (const float*)args.in[20]; C.dil_q_g = (const float*)args.in[21]; C.dil_k_g = (const float*)args.in[22]; C.nsa_q_g = (const float*)args.in[23]; C.nsa_kc_g = (const float*)args.in[24];
    C.nsa_ks_g = (const float*)args.in[25]; C.nsa_kw_g = (const float*)args.in[26]; C.pe_k = (const float*)args.in[27]; C.pe_v = (const float*)args.in[28]; C.wk1 = (const float*)args.in[29];
    C.wk2 = (const float*)args.in[30]; C.wv1 = (const float*)args.in[31]; C.wv2 = (const float*)args.in[32]; C.onorm_g = (const float*)args.in[33]; C.w_router = (const float*)args.in[34];
    C.b_router = (const float*)args.in[35]; C.w_gu = (const float*)args.in[36]; C.b_gu = (const float*)args.in[37]; C.w_down = (const float*)args.in[38]; C.b_down = (const float*)args.in[39];
    C.out = args.out; C.ws = args.ws;
    const int lo = args.ph_lo, hi = args.ph_hi;
    for (int u = C.tid; u < (LDS_BYTES - MISC_OFF) / 4; u += NTHR) ((LAS unsigned*)(C.lds + MISC_OFF))[u] = 0u;
    __syncthreads();
    XcdBarrier bar; bar.bar = WSP(unsigned, WS_CTL) + CW_BAR; bar.x = 0; bar.st = nullptr;
    if (hi - lo > 1) bar = xcd_barrier_post(WSP(unsigned, WS_CTL) + CW_BAR, (volatile LAS unsigned*)(C.lds + MISC_OFF));
#ifndef PHMASK
#define PHMASK 0xFFFFFFFFu
#endif
#define PHON(n) (((PHMASK) >> (n)) & 1u)
#ifndef PHREP
#define PHREP 0u
#endif
#define NREP(n) (1 + (int)(((PHREP) >> (n)) & 1u))
#define WSPP(T, off) ((T*)(P.ws + (off)))
#define IN(k) (lo <= (k) && (k) < hi)
#define SEAM(k) do { if (IN(k) && IN((k) + 1)) xcd_barrier(bar); } while (0)
#define PCTX Ctx P = C; asm volatile("" : "+v"(P.tid), "+v"(P.lane)); asm volatile("" : "+s"(P.ws), "+s"(P.out), "+s"(P.wave), "+s"(P.bid))
    if (PHON(17) && IN(0)) for (int rep = 0; rep < NREP(17); ++rep) { PCTX; p0_prologue(P); __syncthreads(); }
    SEAM(0);
    if (PHON(18) && IN(1)) { PCTX; norm1_phase(P, 0, P.x); }
    SEAM(1);
    for (int l = 0; l < NLAYER; ++l) {
        const int pb = PH_BASE + PH_PER_LAYER * l;
        if (PHON(0) && IN(pb + 0)) for (int rep = 0; rep < NREP(0); ++rep) { PCTX;
            pg8::Gemm g{WSPP(bf16, WS_H), WSPP(bf16, WS_WIN) + (size_t)l * NPJ * 1024, 1024, 1024}; pg8::StaticOrder S; S.init(NT / 256, NPJ / 256, P.G, P.bid);
            EpiProj E{WSPP(bf16, R_PROJ)}; pg8::gemm_phase(P.lds, P.tid, g, S, E);
        }
        SEAM(pb + 0);
        if (PHON(1) && IN(pb + 1)) for (int rep = 0; rep < NREP(1); ++rep) { PCTX; prep_phase(P, l); __syncthreads(); }
        SEAM(pb + 1);
        if (PHON(2) && IN(pb + 2)) { PCTX;
            { pg8::Gemm g{WSPP(bf16, R_LIN), WSPP(bf16, WS_LORA) + (size_t)l * 768 * 256, 256, 256}; pg8::StaticOrder S; S.init(NT / 256, 3, P.G, P.bid);
              EpiLora E{WSPP(float, R_SC), WSPP(float, R_G), P.w0 + l * 256, P.a0 + l * 256, P.ka + l * 256}; pg8::gemm_phase(P.lds, P.tid, g, S, E); }
            { pg8::Gemm g{WSPP(bf16, R_KCR), WSPP(bf16, WS_WK1) + (size_t)(l * 2) * 256 * 2048, 1024, 2048}; pg8::StaticOrder S; S.init(8, 1, P.G, (P.bid + 64) % P.G);
              EpiC1 E{WSPP(bf16, R_CH1), (WSPP(float, WS_SMALL) + NLAYER * 8 * 6144 + l * 512)}; pg8::gemm_phase(P.lds, P.tid, g, S, E); }
            { pg8::Gemm g{WSPP(bf16, R_VCR), WSPP(bf16, WS_WK1) + (size_t)(l * 2 + 1) * 256 * 2048, 1024, 2048}; pg8::StaticOrder S; S.init(8, 1, P.G, (P.bid + 128) % P.G);
              EpiC1 E{WSPP(bf16, R_CH1) + 2048 * 256, (WSPP(float, WS_SMALL) + NLAYER * 8 * 6144 + l * 512 + 256)}; pg8::gemm_phase(P.lds, P.tid, g, S, E); }
            asm volatile("s_waitcnt vmcnt(0)" ::: "memory"); __syncthreads();
            { pg8::Gemm g{WSPP(bf16, R_CH1), WSPP(bf16, WS_WK2) + (size_t)(l * 2) * 256 * 256, 256, 256}; pg8::StaticOrder S; S.init(8, 1, P.G, (P.bid + 64) % P.G);
              EpiC2 E{WSPP(float, R_CMP)}; pg8::gemm_phase(P.lds, P.tid, g, S, E); }
            { pg8::Gemm g{WSPP(bf16, R_CH1) + 2048 * 256, WSPP(bf16, WS_WK2) + (size_t)(l * 2 + 1) * 256 * 256, 256, 256}; pg8::StaticOrder S; S.init(8, 1, P.G, (P.bid + 128) % P.G);
              EpiC2 E{WSPP(float, R_CMP) + 2048 * 64}; pg8::gemm_phase(P.lds, P.tid, g, S, E); }
        }
        SEAM(pb + 2);
        if (PHON(3) && IN(pb + 3)) { PCTX; mix_phase(P, l); }
        SEAM(pb + 3);
        if (PHON(4) && IN(pb + 4)) for (int rep = 0; rep < NREP(4); ++rep) { PCTX; fin_phase(P, l); __syncthreads(); }
        SEAM(pb + 4);
        if (PHON(5) && IN(pb + 5)) { PCTX;
            pg8::Gemm g{WSPP(bf16, R_YCAT), WSPP(bf16, WS_WOUT) + (size_t)l * 1024 * 1024, 1024, 1024}; pg8::StaticOrder S; S.init(NT / 256, 4, P.G, P.bid);
            EpiOut E{P.out, l == 0 ? P.x : (const float*)P.out, WSPP(float, WS_SMALL) + (size_t)l * 8 * 6144 + 2048}; pg8::gemm_phase(P.lds, P.tid, g, S, E);
        }
        SEAM(pb + 5);
        if (PHON(6) && IN(pb + 6)) for (int rep = 0; rep < NREP(6); ++rep) { PCTX; router_phase(P, l); __syncthreads(); }
        SEAM(pb + 6);
        if (PHON(7) && IN(pb + 7)) for (int rep = 0; rep < NREP(7); ++rep) { PCTX; scatter_phase(P, l); __syncthreads(); }
        SEAM(pb + 7);
        if (PHON(8) && IN(pb + 8)) for (int rep = 0; rep < NREP(8); ++rep) { PCTX;
            LAS int* tab = (LAS int*)(P.lds + MISC_OFF + 64); moe_tables(P, l, tab);
            pg8::Gemm g{WSPP(bf16, R_XS), WSPP(bf16, WS_WGU) + (size_t)l * 32 * 2048 * 512, 512, 512, WSPP(int, WS_ROUTE) + NT * 12, 32767};
            pg8::GroupedOrder S; S.init(tab[32], 8, P.G, P.bid); S.tstart = tab; S.nrow_e = 2048;
            EpiGU8 E{WSPP(unsigned char, R_ACT), P.b_gu + (size_t)l * 32 * 2048}; pg8::gemm_phase<EpiGU8, pg8::GroupedOrder, true, true>(P.lds, P.tid, g, S, E);
        }
        SEAM(pb + 8);
        if (PHON(9) && IN(pb + 9)) for (int rep = 0; rep < NREP(9); ++rep) { PCTX;
            LAS int* tab = (LAS int*)(P.lds + MISC_OFF + 64); moe_tables(P, l, tab);
            pg8::Gemm g{WSPP(bf16, R_ACT), WSPP(bf16, WS_WDN) + (size_t)l * 32 * 1024 * 512, 512, 512, WSPP(int, WS_ROUTE) + NT * 12 + NR, 0x3FFFF}; pg8::GroupedOrder S; S.init(tab[32], 4, P.G, P.bid); S.tstart = tab; S.nrow_e = 1024;
            EpiDN8 E{WSPP(bf16, R_YB), P.b_down + (size_t)l * 32 * 1024}; pg8::gemm_phase<EpiDN8, pg8::GroupedOrder, true, true>(P.lds, P.tid, g, S, E);
        }
        SEAM(pb + 9);
        if (PHON(10) && IN(pb + 10)) { PCTX; combine_phase(P, l); }
        SEAM(pb + 10);
    }
#undef IN
#undef SEAM
}

extern "C" void kernel_launch(void* const* d_in, const int* in_sizes, int n_in, void* d_out, int out_size, void* d_ws, size_t ws_size, hipStream_t stream) {
    static int grid = 0;
    if (grid == 0) {
        if (n_in != 40 || out_size != NT * DM || ws_size < WS_END) { fprintf(stderr, "kernel_launch: unexpected problem (n_in %d, out %d, ws %zu < %zu)\n", n_in, out_size, ws_size, (size_t)WS_END); grid = -1; return; }
        int dev = 0, cus = 0, per_cu = 0;
        if (hipGetDevice(&dev) != hipSuccess || hipDeviceGetAttribute(&cus, hipDeviceAttributeMultiprocessorCount, dev) != hipSuccess) { grid = -1; return; }
        if (hipFuncSetAttribute((const void*)mk_fwd, hipFuncAttributeMaxDynamicSharedMemorySize, LDS_BYTES) != hipSuccess) { fprintf(stderr, "kernel_launch: hipFuncSetAttribute failed\n"); grid = -1; return; }
        if (hipOccupancyMaxActiveBlocksPerMultiprocessor(&per_cu, (const void*)mk_fwd, NTHR, LDS_BYTES) != hipSuccess || per_cu < 1) fprintf(stderr, "kernel_launch: occupancy query says %d blocks per CU\n", per_cu);
        (void)hipGetLastError();
        grid = cus > 256 ? 256 : cus;
    }
    if (grid < 0) return;
    (void)hipMemsetAsync((char*)d_ws, 0, ZERO_BYTES, stream);
    Args a{};
    for (int i = 0; i < 40; ++i) a.in[i] = d_in[i];
    a.out = (float*)d_out; a.ws = (unsigned char*)d_ws;
#if MK_ONE_LAUNCH
    a.ph_lo = 0; a.ph_hi = N_PHASES;
    hipLaunchKernelGGL(mk_fwd, dim3(grid), dim3(NTHR), LDS_BYTES, stream, a);
#else
    for (int p = 0; p < N_PHASES; ++p) { a.ph_lo = p; a.ph_hi = p + 1; hipLaunchKernelGGL(mk_fwd, dim3(grid), dim3(NTHR), LDS_BYTES, stream, a); }
#endif
    const hipError_t le = hipPeekAtLastError();
    if (le != hipSuccess) fprintf(stderr, "kernel_launch: launch failed: %s\n", hipGetErrorName(le));
}
```

```cpp
#include <hip/hip_runtime.h>
#include <cstdio>
#include <cstdint>

#define DI __device__ __forceinline__
#define LAS __attribute__((address_space(3)))
#define GAS __attribute__((address_space(1)))
typedef unsigned short bf16;
typedef short bf16x8 __attribute__((ext_vector_type(8)));
typedef float f32x4 __attribute__((ext_vector_type(4)));
typedef float f32x2 __attribute__((ext_vector_type(2)));
typedef unsigned u32x4 __attribute__((ext_vector_type(4)));
typedef unsigned u32x2 __attribute__((ext_vector_type(2)));
typedef unsigned char uchar;

#ifndef PROBE_TS
#define PROBE_TS 0
#endif
#ifndef PROBE_SCAN2
#define PROBE_SCAN2 0
#endif
#ifndef PROBE_ATT2
#define PROBE_ATT2 0
#endif
#ifndef PROBE_CONV2
#define PROBE_CONV2 0
#endif
#ifndef PROBE_TS_A
#define PROBE_TS_A 6
#endif
#ifndef PROBE_TS_B
#define PROBE_TS_B 6
#endif
constexpr int NB = 8, NS = 4096, NT = NB * NS, DM = 1024, NPJ = 3328, NE = 32, FF = 1024, NLAYER = 2;
constexpr int PJ_A = 0, PJ_B = 1024, PJ_C = 1792, PJ_D = 2560;
constexpr int NR = NT * 4 + NE * 256;
constexpr int NTHR = 512, NWAVE = 8;

DI float bf2f(unsigned v) { return __builtin_bit_cast(float, v << 16); }
DI unsigned f2bf(float f) { unsigned u = __builtin_bit_cast(unsigned, f); return (u + 0x7fffu + ((u >> 16) & 1u)) >> 16; }
DI unsigned pk2(float lo, float hi) { return f2bf(lo) | (f2bf(hi) << 16); }
DI float bflo(unsigned w) { return __builtin_bit_cast(float, w << 16); }
DI float bfhi(unsigned w) { return __builtin_bit_cast(float, w & 0xffff0000u); }
DI float fexp2(float x) { return __builtin_amdgcn_exp2f(x); }
DI float fsigmoid(float x) { return 1.f / (1.f + __expf(-x)); }
DI float wsum_xor(float v, int o) { return v + __shfl_xor(v, o); }
template <int W> DI float group_sum(float v) {
#pragma unroll
    for (int o = 1; o < W; o <<= 1) v += __shfl_xor(v, o);
    return v;
}
DI float dpp_f(float x, const int ctrl_dummy);
template <int CTRL> DI float dppmov(float x) { return __builtin_bit_cast(float, __builtin_amdgcn_update_dpp(0, __builtin_bit_cast(int, x), CTRL, 0xF, 0xF, true)); }
DI float sum8(float x) { x += dppmov<0xB1>(x); x += dppmov<0x4E>(x); x += dppmov<0x141>(x); return x; }

#define XB_TMO      128
#define XB_XCNT(j)  (256  + 64 * (j))
#define XB_XSUB(j)  (1280 + 64 * (j))
#define XB_XGEN(j)  (2304 + 64 * (j))
#define XB_TOP      3328
#define XB_TOPGEN   3392
#define XCD_BAR_WORDS 3456
#define XB_SPIN_CAP (1u << 18)
DI unsigned xb_ld(unsigned* p)              { return __hip_atomic_load(p, __ATOMIC_RELAXED, __HIP_MEMORY_SCOPE_AGENT); }
DI unsigned xb_add(unsigned* p, unsigned v) { return __hip_atomic_fetch_add(p, v, __ATOMIC_RELAXED, __HIP_MEMORY_SCOPE_AGENT); }
DI unsigned xb_xcc_id() { return (unsigned)__builtin_amdgcn_s_getreg((3 << 11) | 20) & 0xFu; }
#define XB_SPIN(cond, bar) do { unsigned _sp = 0; while (cond) { __builtin_amdgcn_s_sleep(1); \
    if ((++_sp & 255u) == 0u) { if (xb_ld(&(bar)[XB_TMO])) break; if (_sp > XB_SPIN_CAP) { atomicAdd(&(bar)[XB_TMO], 1u); break; } } } } while (0)
struct XcdBarrier { unsigned* bar; unsigned x; volatile LAS unsigned* st; };
DI XcdBarrier xcd_barrier_post(unsigned* bar, volatile LAS unsigned* st) {
    XcdBarrier b; b.bar = bar; b.x = xb_xcc_id(); b.st = st;
    if (threadIdx.x == 0) (void)xb_add(&bar[XB_XCNT(b.x)], 1u);
    return b;
}
DI void xcd_barrier_complete(unsigned* bar, unsigned x, unsigned& nloc, unsigned& nx) {
    const unsigned G = gridDim.x * gridDim.y * gridDim.z;
    unsigned sum, cnt, mine, sp = 0u;
    for (;;) {
        sum = 0u; cnt = 0u; mine = 0u;
#pragma unroll
        for (unsigned j = 0; j < 16; ++j) { const unsigned c = xb_ld(&bar[XB_XCNT(j)]); sum += c; cnt += (c > 0u) ? 1u : 0u; mine = (j == x) ? c : mine; }
        if (sum == G) break;
        __builtin_amdgcn_s_sleep(1);
        if ((++sp & 255u) == 0u) { if (xb_ld(&bar[XB_TMO])) break; if (sp > XB_SPIN_CAP) { atomicAdd(&bar[XB_TMO], 1u); break; } }
    }
    nloc = mine > 0u ? mine : 1u; nx = cnt > 0u ? cnt : 1u;
}
DI void xcd_barrier(const XcdBarrier& b) {
    asm volatile("s_waitcnt vmcnt(0)" ::: "memory");
    __syncthreads();
    if (threadIdx.x == 0) {
        unsigned* bar = b.bar;
        __builtin_amdgcn_s_waitcnt(0);
        unsigned nloc = b.st[0], nx = b.st[1];
        if (nloc == 0u) { xcd_barrier_complete(bar, b.x, nloc, nx); b.st[0] = nloc; b.st[1] = nx; }
        const unsigned old = xb_add(&bar[XB_XSUB(b.x)], 1u);
        const unsigned gen = old / nloc;
        if (old + 1u == (gen + 1u) * nloc) {
            __builtin_amdgcn_fence(__ATOMIC_RELEASE, "agent");
            asm volatile("s_waitcnt vmcnt(0)" ::: "memory");
            const unsigned og = xb_add(&bar[XB_TOP], 1u);
            const unsigned tg = og / nx;
            if (og + 1u == (tg + 1u) * nx) xb_add(&bar[XB_TOPGEN], 1u);
            else XB_SPIN(xb_ld(&bar[XB_TOPGEN]) == tg, bar);
            __builtin_amdgcn_fence(__ATOMIC_ACQUIRE, "agent");
            xb_add(&bar[XB_XGEN(b.x)], 1u);
            asm volatile("s_waitcnt vmcnt(0)" ::: "memory");
        } else {
            XB_SPIN(xb_ld(&bar[XB_XGEN(b.x)]) == gen, bar);
            __builtin_amdgcn_fence(__ATOMIC_ACQUIRE, "agent");
            asm volatile("s_waitcnt vmcnt(0)" ::: "memory");
        }
    }
    __syncthreads();
}
namespace pg8 {
constexpr int BM = 256, BK = 64, HALF = 128, HTB = HALF * BK * 2, STAGE_BYTES = 8 * HTB, NXCD = 8, WGM = 8;
__host__ __device__ __forceinline__ int lds_byte(int r, int c) { const int st = (r >> 4) * 2 + (c >> 5), rr = r & 15, cc = c & 31, ob = rr * 64 + cc * 2; return st * 1024 + (ob ^ (((ob >> 9) & 1) << 5)); }
__host__ __device__ __forceinline__ void stage_rc(int b, int& R, int& C) { const int st = b / 1024, sb = b % 1024, swz = sb ^ (((sb >> 9) & 1) << 5); R = (st >> 1) * 16 + swz / 64; C = (st & 1) * 32 + (swz % 64) / 2; }
__host__ __device__ __forceinline__ int perm32(int rho) { const int n = rho >> 4, i = rho & 15; return 8 * (i >> 2) + 4 * n + (i & 3); }

struct Unit { int pm, pn, brow, e; };
struct Gemm { const bf16* A; const bf16* Bt; int lda, K; const int* rowmap; int rowmask; };

struct StaticOrder {
    int nM, nN, nwg, G, c;
    __device__ void init(int nM_, int nN_, int G_, int c_) { nM = nM_; nN = nN_; nwg = nM * nN; G = G_; c = c_; }
    __device__ bool tile(int i, int& pm, int& pn) const {
        const long L = (long)i * G + c; if (L >= nwg) return false;
        int wgid = (int)L; { const int q = nwg / NXCD, r = nwg % NXCD, xcd = wgid % NXCD, off = wgid / NXCD; wgid = (xcd < r ? xcd * (q + 1) : r * (q + 1) + (xcd - r) * q) + off; }
        const int nig = WGM * nN, gid = wgid / nig, fm = gid * WGM, gsz = (nM - fm) < WGM ? (nM - fm) : WGM;
        pm = fm + ((wgid % nig) % gsz); pn = (wgid % nig) / gsz; return true;
    }
    __device__ bool next(int i, Unit& u) const { if (!tile(i, u.pm, u.pn)) return false; u.brow = u.pn * BM; u.e = 0; return true; }
};
struct GroupedOrder : StaticOrder {
    const LAS int* tstart; int nrow_e;
    __device__ bool next(int i, Unit& u) const {
        if (!tile(i, u.pm, u.pn)) return false;
        int e = 0;
#pragma unroll 1
        for (int j = 16; j > 0; j >>= 1) if (tstart[e + j] <= u.pm) e += j;
        u.e = e; u.brow = e * nrow_e + u.pn * BM; return true;
    }
};
DI unsigned cvt_pk_bf16(float lo, float hi) { unsigned r; asm volatile("v_cvt_pk_bf16_f32 %0, %1, %2" : "=v"(r) : "v"(lo), "v"(hi)); return r; }

template <class Epi, class Sched, bool GATHER = false, bool FP8 = false>
DI void gemm_phase(LAS unsigned char* lds, const int tid, const Gemm g, const Sched& S, const Epi& E) {
    const int wid = __builtin_amdgcn_readfirstlane(tid >> 6), lane = tid & 63, wr = wid >> 2, wc = wid & 3, fr = lane & 15, fq = lane >> 4;
    int K = g.K, lda = g.lda; asm volatile("" : "+s"(K), "+s"(lda));
    const int nt = K / BK;
    unsigned voffA[2], voffB[2]; int Ra[2], Ca[2];
#pragma unroll
    for (int i = 0; i < 2; ++i) { int R, C; stage_rc(tid * 16 + i * 8192, R, C); const int Rb = Epi::PERM ? ((R & ~31) + perm32(R & 31)) : R; Ra[i] = R; Ca[i] = C;
        voffA[i] = (unsigned)(R * lda + C) * 2u; voffB[i] = (unsigned)(Rb * K + C) * 2u; }
    unsigned vgc[2][2]; int rawn[2][2];
#define PG8_GLOAD(dst, pm_) do { _Pragma("unroll") for (int _h = 0; _h < 2; ++_h) _Pragma("unroll") for (int _i = 0; _i < 2; ++_i) { const int* _p = g.rowmap + (size_t)(pm_) * BM + _h * HALF + Ra[_i]; \
        asm volatile("global_load_dword %0, %1, off" : "=v"(dst[_h][_i]) : "v"(_p) : "memory"); } } while (0)
#define PG8_GCONV(vg, raw) do { _Pragma("unroll") for (int _h = 0; _h < 2; ++_h) _Pragma("unroll") for (int _i = 0; _i < 2; ++_i) { int _r = raw[_h][_i]; asm volatile("" : "+v"(_r)); \
        vg[_h][_i] = (unsigned)((_r & g.rowmask) * lda + Ca[_i]) * 2u; } } while (0)
#define PG8_STAGE_A(bufoff, kptr, h, vg) do { if (GATHER) PG8_STAGE(bufoff, kptr, vg[h]); else PG8_STAGE(bufoff, (kptr) + (h) * hstepA, voffA); } while (0)
    const size_t kstep = (size_t)(BK * 2);
    const size_t hstepA = (size_t)HALF * lda * 2, hstepB = (size_t)HALF * K * 2;
    const size_t tstepA = 2 * hstepA;
    const unsigned ldsw = (unsigned)wid * 1024u;
    const int aoff = lds_byte(wr * 64 + fr, fq * 8), boff = lds_byte(wc * 32 + fr, fq * 8);
#define PG8_SA(b, h) (((b) * 2 + (h)) * HTB)
#define PG8_SB(b, h) ((4 + (b) * 2 + (h)) * HTB)
#define PG8_STAGE(bufoff, gbase, voff) do { _Pragma("unroll") for (int _i = 0; _i < 2; ++_i) \
        __builtin_amdgcn_global_load_lds((const unsigned*)((const char*)(gbase) + (voff)[_i]), (LAS unsigned*)(lds + (bufoff) + ldsw + _i * 8192), 16, 0, 0); } while (0)
#define PG8_LDA(dst, b, h) do { _Pragma("unroll") for (int m = 0; m < 4; ++m) { const v4i_ lo_ = *(const LAS v4i_*)(lds + PG8_SA(b, h) + aoff + m * 2048), hi_ = *(const LAS v4i_*)(lds + PG8_SA(b, h) + aoff + m * 2048 + 1024); \
        dst[m] = __builtin_shufflevector(lo_, hi_, 0, 1, 2, 3, 4, 5, 6, 7); } } while (0)
#define PG8_LDB(dst, b, h) do { _Pragma("unroll") for (int n = 0; n < 2; ++n) { const v4i_ lo_ = *(const LAS v4i_*)(lds + PG8_SB(b, h) + boff + n * 2048), hi_ = *(const LAS v4i_*)(lds + PG8_SB(b, h) + boff + n * 2048 + 1024); \
        dst[n] = __builtin_shufflevector(lo_, hi_, 0, 1, 2, 3, 4, 5, 6, 7); } } while (0)
#define PG8_MMA(ai, bj, At, Bt) do { __builtin_amdgcn_s_setprio(1); _Pragma("unroll") for (int m = 0; m < 4; ++m) _Pragma("unroll") for (int n = 0; n < 2; ++n) { \
        if (FP8) acc[ai][bj][m][n] = __builtin_amdgcn_mfma_scale_f32_16x16x128_f8f6f4(Bt[n], At[m], acc[ai][bj][m][n], 0, 0, 0, 0x7F7F7F7F, 0, 0x7F7F7F7F); \
        else { const v8i_ b_ = Bt[n], a_ = At[m]; \
            acc[ai][bj][m][n] = __builtin_amdgcn_mfma_f32_16x16x32_bf16(__builtin_bit_cast(bf16x8, __builtin_shufflevector(b_, b_, 0, 1, 2, 3)), __builtin_bit_cast(bf16x8, __builtin_shufflevector(a_, a_, 0, 1, 2, 3)), acc[ai][bj][m][n], 0, 0, 0); \
            acc[ai][bj][m][n] = __builtin_amdgcn_mfma_f32_16x16x32_bf16(__builtin_bit_cast(bf16x8, __builtin_shufflevector(b_, b_, 4, 5, 6, 7)), __builtin_bit_cast(bf16x8, __builtin_shufflevector(a_, a_, 4, 5, 6, 7)), acc[ai][bj][m][n], 0, 0, 0); } } \
        __builtin_amdgcn_s_setprio(0); } while (0)
#define PG8_WAIT_V(n) asm volatile("s_waitcnt vmcnt(" #n ")" ::: "memory")
#define PG8_WAIT_L(n) asm volatile("s_waitcnt lgkmcnt(" #n ")" ::: "memory")
#define PG8_BAR __builtin_amdgcn_s_barrier()
#define PG8_SCHED __builtin_amdgcn_sched_barrier(0)
    Unit cur, nxt; int ui = 0;
    if (!S.next(0, cur)) return;
    f32x4 acc[2][2][4][2];
#pragma unroll
    for (int a = 0; a < 2; ++a)
#pragma unroll
        for (int b = 0; b < 2; ++b)
#pragma unroll
            for (int m = 0; m < 4; ++m)
#pragma unroll
                for (int n = 0; n < 2; ++n) acc[a][b][m][n] = (f32x4){0.f, 0.f, 0.f, 0.f};
    typedef int v8i_ __attribute__((ext_vector_type(8))); typedef int v4i_ __attribute__((ext_vector_type(4)));
    v8i_ At[4], B0[2], B1[2];
    const char* cA = (const char*)g.A + (GATHER ? (size_t)0 : (size_t)cur.pm * tstepA); const char* cB = (const char*)g.Bt + (size_t)cur.brow * K * 2;
    if (GATHER) { PG8_GLOAD(rawn, cur.pm); asm volatile("s_waitcnt vmcnt(0)" : "+v"(rawn[0][0]), "+v"(rawn[0][1]), "+v"(rawn[1][0]), "+v"(rawn[1][1]) :: "memory"); PG8_GCONV(vgc, rawn); }
    PG8_STAGE(PG8_SB(0, 0), cB, voffB); PG8_STAGE(PG8_SB(0, 1), cB + hstepB, voffB); PG8_STAGE_A(PG8_SA(0, 0), cA, 0, vgc); PG8_STAGE_A(PG8_SA(0, 1), cA, 1, vgc);
    if (wr == 1) PG8_BAR;
    PG8_WAIT_V(2); PG8_BAR;
    PG8_STAGE(PG8_SB(1, 0), cB + kstep, voffB); PG8_STAGE_A(PG8_SA(1, 0), cA + kstep, 0, vgc); PG8_STAGE(PG8_SB(1, 1), cB + hstepB + kstep, voffB);
    PG8_WAIT_V(6); PG8_BAR;
    for (;;) {
        const bool has_next = S.next(ui + 1, nxt);
        const char* nA = (has_next && !GATHER) ? (const char*)g.A + (size_t)nxt.pm * tstepA : cA;
        if (GATHER && has_next) PG8_GLOAD(rawn, nxt.pm); const char* nB = has_next ? (const char*)g.Bt + (size_t)nxt.brow * K * 2 : cB;
#pragma unroll 1
        for (int t = 0; t < nt; t += 2) {
            const bool last = (t == nt - 2);
            const char* a1 = cA + (size_t)(t + 1) * kstep;
            const char* a2 = last ? nA : cA + (size_t)(t + 2) * kstep; const char* b2 = last ? nB : cB + (size_t)(t + 2) * kstep;
            const char* a3 = a2 + kstep; const char* b3 = b2 + kstep;
            PG8_LDB(B0, 0, 0); PG8_LDB(B1, 0, 1); PG8_SCHED; PG8_LDA(At, 0, 0); PG8_STAGE_A(PG8_SA(1, 1), a1, 1, vgc);
            if (GATHER) { if (last && has_next) PG8_GCONV(vgc, rawn); }
            PG8_WAIT_V(8); PG8_WAIT_L(0); PG8_BAR; PG8_MMA(0, 0, At, B0); PG8_MMA(0, 1, At, B1); PG8_BAR; PG8_SCHED;
            PG8_LDA(At, 0, 1); PG8_STAGE(PG8_SB(0, 0), b2, voffB); PG8_STAGE(PG8_SB(0, 1), b2 + hstepB, voffB); PG8_STAGE_A(PG8_SA(0, 0), a2, 0, vgc);
            PG8_WAIT_V(8); PG8_WAIT_L(0); PG8_BAR; PG8_MMA(1, 0, At, B0); PG8_MMA(1, 1, At, B1); PG8_BAR; PG8_SCHED;
            PG8_LDB(B0, 1, 0); PG8_LDB(B1, 1, 1); PG8_SCHED; PG8_LDA(At, 1, 0); PG8_STAGE_A(PG8_SA(0, 1), a2, 1, vgc);
            PG8_WAIT_V(8); PG8_WAIT_L(0); PG8_BAR; PG8_MMA(0, 0, At, B0); PG8_MMA(0, 1, At, B1); PG8_BAR; PG8_SCHED;
            PG8_LDA(At, 1, 1); PG8_STAGE(PG8_SB(1, 0), b3, voffB); PG8_STAGE(PG8_SB(1, 1), b3 + hstepB, voffB); PG8_STAGE_A(PG8_SA(1, 0), a3, 0, vgc);
            PG8_WAIT_V(8); PG8_WAIT_L(0); PG8_BAR; PG8_MMA(1, 0, At, B0); PG8_MMA(1, 1, At, B1); PG8_BAR; PG8_SCHED;
        }
        if (wr == 0) PG8_BAR;
        { int fr2 = fr, fq2 = fq; asm volatile("" : "+v"(fr2), "+v"(fq2)); E(acc, cur, wr, wc, fr2, fq2); }
        if (!has_next) break;
#pragma unroll
        for (int a = 0; a < 2; ++a)
#pragma unroll
            for (int b = 0; b < 2; ++b)
#pragma unroll
                for (int m = 0; m < 4; ++m)
#pragma unroll
                    for (int n = 0; n < 2; ++n) acc[a][b][m][n] = (f32x4){0.f, 0.f, 0.f, 0.f};
        cur = nxt; cA = nA; cB = nB; ++ui;
        if (wr == 1) PG8_BAR;
    }
    PG8_WAIT_V(0);
    PG8_BAR;
#undef PG8_SA
#undef PG8_SB
#undef PG8_STAGE
#undef PG8_STAGE_A
#undef PG8_GLOAD
#undef PG8_GCONV
#undef PG8_LDA
#undef PG8_LDB
#undef PG8_MMA
#undef PG8_WAIT_V
#undef PG8_WAIT_L
#undef PG8_BAR
#undef PG8_SCHED
}
}
constexpr size_t MiB = 1u << 20;
constexpr size_t WS_CTL = 0;
constexpr size_t WS_LORA = 1 * MiB;
constexpr size_t WS_WK2 = 2 * MiB;
constexpr size_t ZERO_BYTES = 3 * MiB;
constexpr size_t WS_WIN = 3 * MiB;
constexpr size_t WS_WOUT = 17 * MiB;
constexpr size_t WS_WK1 = 21 * MiB;
constexpr size_t WS_SMALL = 25 * MiB;
constexpr size_t WS_ROUTE = 27 * MiB;
constexpr size_t WS_WGU = 32 * MiB;
constexpr size_t WS_WDN = 288 * MiB;
constexpr size_t WS_H = 416 * MiB;
constexpr size_t WS_R = 480 * MiB;
constexpr size_t R_PROJ = WS_R;
constexpr size_t R_SC = R_PROJ + 208 * MiB;
constexpr size_t R_LIN = R_SC + 192 * MiB;
constexpr size_t R_G = R_LIN + 16 * MiB;
constexpr size_t R_YA = R_G + 32 * MiB;
constexpr size_t R_YCAT = R_YA + 32 * MiB;
constexpr size_t R_QC = R_YCAT + 64 * MiB;
constexpr size_t R_KC = R_QC + 16 * MiB;
constexpr size_t R_OC = R_KC + 16 * MiB;
constexpr size_t R_LSE = R_OC + 96 * MiB;
constexpr size_t R_QN = R_LSE + 2 * MiB;
constexpr size_t R_QR = R_QN + 16 * MiB;
constexpr size_t R_KCR = R_QR + 16 * MiB;
constexpr size_t R_VCR = R_KCR + 5 * MiB;
constexpr size_t R_KS = R_VCR + 5 * MiB;
constexpr size_t R_KW = R_KS + 4 * MiB;
constexpr size_t R_GATE = R_KW + 4 * MiB;
constexpr size_t R_CH1 = R_GATE + 2 * MiB;
constexpr size_t R_CMP = R_CH1 + 2 * MiB;
constexpr size_t R_OCMP = R_CMP + 1 * MiB;
constexpr size_t R_OSLC = R_OCMP + 32 * MiB;
constexpr size_t R_OSWA = R_OSLC + 32 * MiB;
constexpr size_t R_SCANU = R_OSWA;
constexpr size_t R_SCANS = R_OSWA + 16 * MiB;
constexpr size_t R_IMP = R_OSWA + 32 * MiB;
constexpr size_t R_SELM = R_IMP + 8 * MiB;
constexpr size_t R_MIX_END = R_SELM + 1 * MiB;
constexpr size_t R_XS = WS_R;
constexpr size_t R_ACT = R_XS + 272 * MiB;
constexpr size_t R_YB = R_ACT + 272 * MiB;
constexpr size_t R_MOE_END = R_YB + 272 * MiB;
constexpr size_t WS_END = (R_MIX_END > R_MOE_END ? R_MIX_END : R_MOE_END);
static_assert((size_t)NR * 1024 * 2 <= 272 * MiB, "sorted buffers");
constexpr int CW_BAR = 4096;
constexpr int CW_CNT = 16384;
constexpr int CW_CUR = 16384 + 64;

constexpr int RING_BYTES = 131072;
constexpr int MISC_OFF = RING_BYTES;
constexpr int LDS_BYTES = 147456;

struct Args { const void* in[40]; float* out; unsigned char* ws; int ph_lo, ph_hi; };

struct Ctx {
    LAS unsigned char* lds; int tid, lane, wave, G, bid;
    const float *x, *c, *w_ada, *b_ada, *norm1_g, *norm2_g, *w_in, *w_out, *mu, *w0, *w2, *a0, *a2, *g2, *kkw, *ka, *rk, *gn_w, *gn_b, *conv_w, *dil_q_g, *dil_k_g,
        *nsa_q_g, *nsa_kc_g, *nsa_ks_g, *nsa_kw_g, *pe_k, *pe_v, *wk1, *wk2, *wv1, *wv2, *onorm_g, *w_router, *b_router, *w_gu, *b_gu, *w_down, *b_down;
    const int* pos;
    float* out; unsigned char* ws;
};
#define WSP(T, off) ((T*)(C.ws + (off)))

typedef f32x4 Acc[2][2][4][2];
struct EpiProj {
    static constexpr bool PERM = true; bf16* O;
    DI void operator()(const Acc& acc, const pg8::Unit& u, int wr, int wc, int fr, int fq) const {
        const int row0 = u.pm * 256 + wr * 64 + fr, col0 = u.pn * 256 + wc * 32 + 8 * fq;
#pragma unroll
        for (int ai = 0; ai < 2; ++ai)
#pragma unroll
            for (int m = 0; m < 4; ++m) { bf16* rowp = O + (size_t)(row0 + ai * 128 + m * 16) * NPJ + col0;
#pragma unroll
                for (int bj = 0; bj < 2; ++bj) { const f32x4 v0 = acc[ai][bj][m][0], v1 = acc[ai][bj][m][1]; u32x4 w;
                    w.x = pg8::cvt_pk_bf16(v0[0], v0[1]); w.y = pg8::cvt_pk_bf16(v0[2], v0[3]); w.z = pg8::cvt_pk_bf16(v1[0], v1[1]); w.w = pg8::cvt_pk_bf16(v1[2], v1[3]);
                    *(u32x4*)(rowp + bj * 128) = w; } }
    }
};
struct EpiLora {
    static constexpr bool PERM = false; float* SC; float* Gb; const float *w0, *a0, *ka; float* SCo;
    DI void operator()(const Acc& acc, const pg8::Unit& u, int wr, int wc, int fr, int fq) const {
        const int row0 = u.pm * 256 + wr * 64 + fr, col0 = wc * 32 + 4 * fq;
        if (u.pn == 0) {
#pragma unroll
            for (int bj = 0; bj < 2; ++bj)
#pragma unroll
                for (int n = 0; n < 2; ++n) { const int ch = col0 + bj * 128 + n * 16; const f32x4 b = *(const f32x4*)(w0 + ch);
#pragma unroll
                    for (int ai = 0; ai < 2; ++ai)
#pragma unroll
                        for (int m = 0; m < 4; ++m) { const size_t o = (size_t)(row0 + ai * 128 + m * 16) * 256 + ch; const f32x4 v = acc[ai][bj][m][n] + b; f32x4 r;
#pragma unroll
                            for (int j = 0; j < 4; ++j) r[j] = __expf(-0.606531f * fsigmoid(v[j]));
                            *(f32x4*)(SCo + o) = r; } }
        } else if (u.pn == 1) {
#pragma unroll
            for (int bj = 0; bj < 2; ++bj)
#pragma unroll
                for (int n = 0; n < 2; ++n) { const int ch = col0 + bj * 128 + n * 16; const f32x4 b = *(const f32x4*)(a0 + ch), kav = *(const f32x4*)(ka + ch);
#pragma unroll
                    for (int ai = 0; ai < 2; ++ai)
#pragma unroll
                        for (int m = 0; m < 4; ++m) { __builtin_amdgcn_sched_barrier(0); const size_t o = (size_t)(row0 + ai * 128 + m * 16) * 256 + ch; const f32x4 v = acc[ai][bj][m][n] + b;
                            float* pk = SC + (size_t)1 * NT * 256 + o; const f32x4 kr = *(const f32x4*)pk, kn = *(const f32x4*)(SC + (size_t)2 * NT * 256 + o); f32x4 k2, bb;
#pragma unroll
                            for (int j = 0; j < 4; ++j) { const float a = fsigmoid(v[j]); k2[j] = kr[j] * (1.f + (a - 1.f) * kav[j]); bb[j] = kn[j] * a; }
                            *(f32x4*)(SCo + (size_t)1 * NT * 256 + o) = k2; *(f32x4*)(SCo + (size_t)3 * NT * 256 + o) = bb; } }
        } else {
#pragma unroll
            for (int bj = 0; bj < 2; ++bj)
#pragma unroll
                for (int n = 0; n < 2; ++n) { const int ch = col0 + bj * 128 + n * 16;
#pragma unroll
                    for (int ai = 0; ai < 2; ++ai)
#pragma unroll
                        for (int m = 0; m < 4; ++m) { const size_t o = (size_t)(row0 + ai * 128 + m * 16) * 256 + ch; *(f32x4*)(Gb + o) = acc[ai][bj][m][n]; } }
        }
    }
};
DI float gelu_tanh(float x) { const float t = 0.7978845608f * (x + 0.044715f * x * x * x); const float e = __expf(2.f * t); const float th = 1.f - 2.f / (e + 1.f); return 0.5f * x * (1.f + th); }
struct EpiC1 {
    static constexpr bool PERM = true; bf16* O; const float* peb;
    DI void operator()(const Acc& acc, const pg8::Unit& u, int wr, int wc, int fr, int fq) const {
        const int row0 = u.pm * 256 + wr * 64 + fr, col0 = wc * 32 + 8 * fq;
#pragma unroll
        for (int bj = 0; bj < 2; ++bj) { const f32x4 b0 = *(const f32x4*)(peb + col0 + bj * 128), b1 = *(const f32x4*)(peb + col0 + bj * 128 + 4);
#pragma unroll
            for (int ai = 0; ai < 2; ++ai)
#pragma unroll
                for (int m = 0; m < 4; ++m) { bf16* p = O + (size_t)(row0 + ai * 128 + m * 16) * 256 + col0 + bj * 128; const f32x4 v0 = acc[ai][bj][m][0] + b0, v1 = acc[ai][bj][m][1] + b1; u32x4 w;
                    w.x = pk2(gelu_tanh(v0[0]), gelu_tanh(v0[1])); w.y = pk2(gelu_tanh(v0[2]), gelu_tanh(v0[3])); w.z = pk2(gelu_tanh(v1[0]), gelu_tanh(v1[1])); w.w = pk2(gelu_tanh(v1[2]), gelu_tanh(v1[3]));
                    *(u32x4*)p = w; } }
    }
};
struct EpiC2 {
    static constexpr bool PERM = false; float* O;
    DI void operator()(const Acc& acc, const pg8::Unit& u, int wr, int wc, int fr, int fq) const {
        if (wc >= 2) return;
        const int row0 = u.pm * 256 + wr * 64 + fr, col0 = wc * 32 + 4 * fq;
#pragma unroll
        for (int ai = 0; ai < 2; ++ai)
#pragma unroll
            for (int m = 0; m < 4; ++m)
#pragma unroll
                for (int n = 0; n < 2; ++n) *(f32x4*)(O + (size_t)(row0 + ai * 128 + m * 16) * 64 + col0 + n * 16) = acc[ai][0][m][n];
    }
};
struct EpiOut {
    static constexpr bool PERM = false; float* O; const float* xin; const float* gt;
    DI void operator()(const Acc& acc, const pg8::Unit& u, int wr, int wc, int fr, int fq) const {
        const int row0 = u.pm * 256 + wr * 64 + fr, col0 = u.pn * 256 + wc * 32 + 4 * fq; const int b = (u.pm * 256) / NS;
#pragma unroll
        for (int bj = 0; bj < 2; ++bj)
#pragma unroll
            for (int n = 0; n < 2; ++n) { const int col = col0 + bj * 128 + n * 16; const f32x4 g = *(const f32x4*)(gt + (size_t)b * 6144 + col);
#pragma unroll
                for (int ai = 0; ai < 2; ++ai)
#pragma unroll
                    for (int m = 0; m < 4; ++m) { const size_t o = (size_t)(row0 + ai * 128 + m * 16) * DM + col; *(f32x4*)(O + o) = *(const f32x4*)(xin + o) + g * acc[ai][bj][m][n]; } }
    }
};
struct EpiGU {
    static constexpr bool PERM = true; bf16* O; const float* bgu;
    DI void operator()(const Acc& acc, const pg8::Unit& u, int wr, int wc, int fr, int fq) const {
        const int row0 = u.pm * 256 + wr * 64 + fr, cc = u.pn * 128 + wc * 32 + 8 * fq; const float* bp = bgu + (size_t)u.e * 2048 + cc;
        const f32x4 g0 = *(const f32x4*)bp, g1 = *(const f32x4*)(bp + 4), u0 = *(const f32x4*)(bp + 1024), u1 = *(const f32x4*)(bp + 1028);
#pragma unroll
        for (int ai = 0; ai < 2; ++ai)
#pragma unroll
            for (int m = 0; m < 4; ++m) { bf16* p = O + (size_t)(row0 + ai * 128 + m * 16) * FF + cc; float r[8];
#pragma unroll
                for (int n = 0; n < 2; ++n) { const f32x4 gv = acc[ai][0][m][n] + (n ? g1 : g0), uv = acc[ai][1][m][n] + (n ? u1 : u0);
#pragma unroll
                    for (int j = 0; j < 4; ++j) { const float ga = fminf(gv[j], 7.f), up = fminf(fmaxf(uv[j], -7.f), 7.f); r[4 * n + j] = ga * fsigmoid(1.702f * ga) * (up + 1.f); } }
                u32x4 w; w.x = pk2(r[0], r[1]); w.y = pk2(r[2], r[3]); w.z = pk2(r[4], r[5]); w.w = pk2(r[6], r[7]); *(u32x4*)p = w; }
    }
};
struct EpiDN {
    static constexpr bool PERM = true; bf16* O; const float* bd;
    DI void operator()(const Acc& acc, const pg8::Unit& u, int wr, int wc, int fr, int fq) const {
        const int row0 = u.pm * 256 + wr * 64 + fr, col0 = u.pn * 256 + wc * 32 + 8 * fq; const float* bp = bd + (size_t)u.e * 1024 + col0;
#pragma unroll
        for (int bj = 0; bj < 2; ++bj) { const f32x4 b0 = *(const f32x4*)(bp + bj * 128), b1 = *(const f32x4*)(bp + bj * 128 + 4);
#pragma unroll
            for (int ai = 0; ai < 2; ++ai)
#pragma unroll
                for (int m = 0; m < 4; ++m) { bf16* p = O + (size_t)(row0 + ai * 128 + m * 16) * DM + col0 + bj * 128; const f32x4 v0 = acc[ai][bj][m][0] + b0, v1 = acc[ai][bj][m][1] + b1; u32x4 w;
                    w.x = pk2(v0[0], v0[1]); w.y = pk2(v0[2], v0[3]); w.z = pk2(v1[0], v1[1]); w.w = pk2(v1[2], v1[3]); *(u32x4*)p = w; } }
    }
};
DI float clamp8(float x) { return fminf(fmaxf(x, -448.f), 448.f); }
DI unsigned pk4_fp8(float a, float b, float c, float d) { unsigned w = 0u; w = __builtin_amdgcn_cvt_pk_fp8_f32(clamp8(a), clamp8(b), w, false); w = __builtin_amdgcn_cvt_pk_fp8_f32(clamp8(c), clamp8(d), w, true); return w; }
constexpr float W8_SCALE = 32.f, W8_INV = 1.f / 32.f;
struct EpiGU8 {
    static constexpr bool PERM = true; unsigned char* O; const float* bgu;
    DI void operator()(const Acc& acc, const pg8::Unit& u, int wr, int wc, int fr, int fq) const {
        const int row0 = u.pm * 256 + wr * 64 + fr, cc = u.pn * 128 + wc * 32 + 8 * fq; const float* bp = bgu + (size_t)u.e * 2048 + cc;
        const f32x4 g0 = *(const f32x4*)bp, g1 = *(const f32x4*)(bp + 4), u0 = *(const f32x4*)(bp + 1024), u1 = *(const f32x4*)(bp + 1028);
#pragma unroll
        for (int ai = 0; ai < 2; ++ai)
#pragma unroll
            for (int m = 0; m < 4; ++m) { unsigned char* p = O + (size_t)(row0 + ai * 128 + m * 16) * FF + cc; float r[8];
#pragma unroll
                for (int n = 0; n < 2; ++n) { const f32x4 gv = acc[ai][0][m][n] * W8_INV + (n ? g1 : g0), uv = acc[ai][1][m][n] * W8_INV + (n ? u1 : u0);
#pragma unroll
                    for (int j = 0; j < 4; ++j) { const float ga = fminf(gv[j], 7.f), up = fminf(fmaxf(uv[j], -7.f), 7.f); r[4 * n + j] = ga * fsigmoid(1.702f * ga) * (up + 1.f); } }
                u32x2 w; w.x = pk4_fp8(r[0], r[1], r[2], r[3]); w.y = pk4_fp8(r[4], r[5], r[6], r[7]); *(u32x2*)p = w; }
    }
};
struct EpiDN8 {
    static constexpr bool PERM = true; bf16* O; const float* bd;
    DI void operator()(const Acc& acc, const pg8::Unit& u, int wr, int wc, int fr, int fq) const {
        const int row0 = u.pm * 256 + wr * 64 + fr, col0 = u.pn * 256 + wc * 32 + 8 * fq; const float* bp = bd + (size_t)u.e * 1024 + col0;
#pragma unroll
        for (int bj = 0; bj < 2; ++bj) { const f32x4 b0 = *(const f32x4*)(bp + bj * 128), b1 = *(const f32x4*)(bp + bj * 128 + 4);
#pragma unroll
            for (int ai = 0; ai < 2; ++ai)
#pragma unroll
                for (int m = 0; m < 4; ++m) { bf16* p = O + (size_t)(row0 + ai * 128 + m * 16) * DM + col0 + bj * 128; const f32x4 v0 = acc[ai][bj][m][0] * W8_INV + b0, v1 = acc[ai][bj][m][1] * W8_INV + b1; u32x4 w;
                    w.x = pk2(v0[0], v0[1]); w.y = pk2(v0[2], v0[3]); w.z = pk2(v1[0], v1[1]); w.w = pk2(v1[2], v1[3]); *(u32x4*)p = w; } }
    }
};
DI void tr_item(const float* src, int ld_src, int scol0, int nvalid, int k0, bf16* dst, int ld_dst, int drow0, int dk0, LAS float* scr, int lane) {
    const int n4 = (lane & 7) * 4, kr = lane >> 3; f32x4 v[8];
#pragma unroll
    for (int i = 0; i < 8; ++i) v[i] = (n4 < nvalid) ? *(const f32x4*)(src + (size_t)(k0 + kr + 8 * i) * ld_src + scol0 + n4) : (f32x4){0.f, 0.f, 0.f, 0.f};
#pragma unroll
    for (int i = 0; i < 8; ++i) { LAS float* s = scr + (kr + 8 * i) * 33 + n4; s[0] = v[i][0]; s[1] = v[i][1]; s[2] = v[i][2]; s[3] = v[i][3]; }
    asm volatile("s_waitcnt lgkmcnt(0)" ::: "memory");
    const int c = lane & 7;
#pragma unroll
    for (int jq = 0; jq < 4; ++jq) { const int n = (lane >> 3) + 8 * jq; const LAS float* s = scr + (8 * c) * 33 + n;
        u32x4 o; o.x = pk2(s[0 * 33], s[1 * 33]); o.y = pk2(s[2 * 33], s[3 * 33]); o.z = pk2(s[4 * 33], s[5 * 33]); o.w = pk2(s[6 * 33], s[7 * 33]);
        *(u32x4*)(dst + (size_t)(drow0 + n) * ld_dst + dk0 + k0 + 8 * c) = o; }
    asm volatile("s_waitcnt lgkmcnt(0)" ::: "memory");
}
DI void tr_item8(const float* src, int ld_src, int scol0, int k0, unsigned char* dst, int ld_dst, int drow0, LAS float* scr, int lane) {
    const int n4 = (lane & 7) * 4, kr = lane >> 3; f32x4 v[8];
#pragma unroll
    for (int i = 0; i < 8; ++i) v[i] = *(const f32x4*)(src + (size_t)(k0 + kr + 8 * i) * ld_src + scol0 + n4);
#pragma unroll
    for (int i = 0; i < 8; ++i) { LAS float* s = scr + (kr + 8 * i) * 33 + n4; s[0] = v[i][0]; s[1] = v[i][1]; s[2] = v[i][2]; s[3] = v[i][3]; }
    asm volatile("s_waitcnt lgkmcnt(0)" ::: "memory");
    const int c = lane & 7;
#pragma unroll
    for (int jq = 0; jq < 4; ++jq) { const int n = (lane >> 3) + 8 * jq; const LAS float* s = scr + (8 * c) * 33 + n;
        u32x2 o; o.x = pk4_fp8(s[0 * 33] * W8_SCALE, s[1 * 33] * W8_SCALE, s[2 * 33] * W8_SCALE, s[3 * 33] * W8_SCALE); o.y = pk4_fp8(s[4 * 33] * W8_SCALE, s[5 * 33] * W8_SCALE, s[6 * 33] * W8_SCALE, s[7 * 33] * W8_SCALE);
        *(u32x2*)(dst + (size_t)(drow0 + n) * ld_dst + k0 + 8 * c) = o; }
    asm volatile("s_waitcnt lgkmcnt(0)" ::: "memory");
}
DI void conv_item(const Ctx& C, int l, int r, LAS float* scr) {
    constexpr int I_GU = 32 * 16 * 64;
    if (r < I_GU) { const int e = r / 1024, r2 = r % 1024, kb = r2 / 64, nb = r2 % 64, n0 = 32 * nb, j = n0 / 256, i = n0 % 256;
        const int scol0 = (i < 128) ? 128 * j + i : 1024 + 128 * j + (i - 128);
        tr_item8(C.w_gu + (size_t)(l * 32 + e) * 1024 * 2048, 2048, scol0, 64 * kb, WSP(unsigned char, WS_WGU) + (size_t)(l * 32 + e) * 2048 * 1024, 1024, n0, scr, C.lane); }
    else { r -= I_GU; const int e = r / 512, r2 = r % 512, kb = r2 / 32, nb = r2 % 32;
        tr_item8(C.w_down + (size_t)(l * 32 + e) * 1024 * 1024, 1024, 32 * nb, 64 * kb, WSP(unsigned char, WS_WDN) + (size_t)(l * 32 + e) * 1024 * 1024, 1024, 32 * nb, scr, C.lane); }
}
DI void conv_ticket(const Ctx& C, int l, int tk) {
    LAS float* scr = (LAS float*)(C.lds + C.wave * 16384);
    __syncthreads();
#pragma unroll 1
    for (int i = 0; i < 8; ++i) conv_item(C, l, tk * 64 + C.wave * 8 + i, scr);
}
DI void p0_prologue(const Ctx& C) {
    LAS float* scr = (LAS float*)(C.lds + C.wave * 16384);
    const int gw = C.bid * NWAVE + C.wave, NGW = C.G * NWAVE;
    constexpr int I_IN = 16 * 104, I_OUT = 16 * 32, I_LW = 8, I_LA = 8, I_LG = 16, I_K1 = 256, I_K2 = 8;
    constexpr int I_LAYER = I_IN + I_OUT + I_LW + I_LA + I_LG + 2 * I_K1 + 2 * I_K2;
    for (int it = gw; it < NLAYER * I_LAYER; it += NGW) {
        const int l = it / I_LAYER; int r = it % I_LAYER;
        if (r < I_IN) { const int kb = r / 104, nb = r % 104, n0 = 32 * nb; int nv = 3212 - n0; nv = nv < 0 ? 0 : (nv > 32 ? 32 : nv);
            tr_item(C.w_in + (size_t)l * 1024 * 3212, 3212, n0, nv, 64 * kb, WSP(bf16, WS_WIN) + (size_t)l * NPJ * 1024, 1024, n0, 0, scr, C.lane); continue; } r -= I_IN;
        if (r < I_OUT) { const int kb = r / 32, nb = r % 32;
            tr_item(C.w_out + (size_t)l * 1024 * 1024, 1024, 32 * nb, 32, 64 * kb, WSP(bf16, WS_WOUT) + (size_t)l * 1024 * 1024, 1024, 32 * nb, 0, scr, C.lane); continue; } r -= I_OUT;
        bf16* lora = WSP(bf16, WS_LORA) + (size_t)l * 768 * 256;
        if (r < I_LW) { tr_item(C.w2 + (size_t)l * 64 * 256, 256, 32 * r, 32, 0, lora, 256, 32 * r, 0, scr, C.lane); continue; } r -= I_LW;
        if (r < I_LA) { tr_item(C.a2 + (size_t)l * 64 * 256, 256, 32 * r, 32, 0, lora, 256, 256 + 32 * r, 64, scr, C.lane); continue; } r -= I_LA;
        if (r < I_LG) { const int kb = r / 8, nb = r % 8; tr_item(C.g2 + (size_t)l * 128 * 256, 256, 32 * nb, 32, 64 * kb, lora, 256, 512 + 32 * nb, 128, scr, C.lane); continue; } r -= I_LG;
        if (r < 2 * I_K1) { const int kv = r / I_K1, r2 = r % I_K1, kb = r2 / 8, nb = r2 % 8;
            tr_item((kv ? C.wv1 : C.wk1) + (size_t)l * 2048 * 256, 256, 32 * nb, 32, 64 * kb, WSP(bf16, WS_WK1) + (size_t)(l * 2 + kv) * 256 * 2048, 2048, 32 * nb, 0, scr, C.lane); continue; } r -= 2 * I_K1;
        { const int kv = r / I_K2, r2 = r % I_K2, kb = r2 / 2, nb = r2 % 2;
            tr_item((kv ? C.wv2 : C.wk2) + (size_t)l * 256 * 64, 64, 32 * nb, 32, 64 * kb, WSP(bf16, WS_WK2) + (size_t)(l * 2 + kv) * 256 * 256, 256, 32 * nb, 0, scr, C.lane); }
    }
    { int* idm = WSP(int, WS_ROUTE) + NT * 12 + NR; for (int i = C.bid * NTHR + C.tid; i < NR; i += C.G * NTHR) idm[i] = i; }
    __syncthreads();
    float* MOD = WSP(float, WS_SMALL); float* PEB = MOD + NLAYER * 8 * 6144;
    LAS float* sc = (LAS float*)C.lds;
    LAS float* red = sc + 8192;
    for (int it = C.bid; it < 192 + 4; it += C.G) {
        if (it < 192) {
            const int l = it / 96, n0 = (it % 96) * 64;
            for (int i = C.tid; i < 8192; i += NTHR) { const float v = C.c[i]; sc[i] = v / (1.f + __expf(-v)); }
            __syncthreads();
            const int kq = C.tid >> 6, col = C.tid & 63; float a[8];
#pragma unroll
            for (int b = 0; b < 8; ++b) a[b] = 0.f;
            const float* wp = C.w_ada + (size_t)l * 1024 * 6144 + n0 + col;
#pragma unroll 8
            for (int k = kq * 128; k < kq * 128 + 128; ++k) { const float w = wp[(size_t)k * 6144];
#pragma unroll
                for (int b = 0; b < 8; ++b) a[b] += sc[b * 1024 + k] * w; }
#pragma unroll
            for (int b = 0; b < 8; ++b) red[(kq * 8 + b) * 64 + col] = a[b];
            __syncthreads();
            { const int b = C.tid >> 6; float s = C.b_ada[(size_t)l * 6144 + n0 + col];
#pragma unroll
              for (int q = 0; q < 8; ++q) s += red[(q * 8 + b) * 64 + col];
              MOD[((size_t)l * 8 + b) * 6144 + n0 + col] = s; }
            __syncthreads();
        } else {
            const int l = (it - 192) / 2, kv = (it - 192) % 2; const float* pe = (kv ? C.pe_v : C.pe_k) + (size_t)l * 2048; const float* w1 = (kv ? C.wv1 : C.wk1) + (size_t)l * 2048 * 256;
            const int kq = C.tid >> 8, col = C.tid & 255; float a = 0.f;
#pragma unroll 8
            for (int k = kq * 1024; k < kq * 1024 + 1024; ++k) a += pe[k] * w1[(size_t)k * 256 + col];
            red[kq * 256 + col] = a; __syncthreads();
            if (C.tid < 256) PEB[(l * 2 + kv) * 256 + col] = red[col] + red[256 + col];
            __syncthreads();
        }
    }
}

DI void norm_row(const Ctx& C, const float* xrow, const float* g, const float* sh, const float* sc, bf16* orow) {
    f32x4 v[4]; float s = 0.f;
#pragma unroll
    for (int j = 0; j < 4; ++j) { v[j] = *(const f32x4*)(xrow + 4 * C.lane + 256 * j); s += (v[j][0] * v[j][0] + v[j][1] * v[j][1]) + (v[j][2] * v[j][2] + v[j][3] * v[j][3]); }
    s = group_sum<64>(s); const float rstd = rsqrtf(s * (1.f / DM) + 1e-6f);
#pragma unroll
    for (int j = 0; j < 4; ++j) { const int k = 4 * C.lane + 256 * j; const f32x4 gg = *(const f32x4*)(g + k), a = *(const f32x4*)(sc + k), b = *(const f32x4*)(sh + k); f32x4 h;
#pragma unroll
        for (int i = 0; i < 4; ++i) h[i] = v[j][i] * rstd * gg[i] * (1.f + a[i]) + b[i];
        u32x2 o; o.x = pk2(h[0], h[1]); o.y = pk2(h[2], h[3]); *(u32x2*)(orow + k) = o; }
}
DI void norm1_phase(const Ctx& C, int l, const float* xin) {
    const float* MOD = WSP(float, WS_SMALL) + (size_t)l * 8 * 6144; bf16* H = WSP(bf16, WS_H);
    const int gw = C.bid * NWAVE + C.wave, NGW = C.G * NWAVE;
    for (int m = gw; m < NT; m += NGW) { const int b = m / NS; norm_row(C, xin + (size_t)m * DM, C.norm1_g + l * DM, MOD + b * 6144, MOD + b * 6144 + 1024, H + (size_t)m * DM); }
}

constexpr float QSCALE = 0.125f * 1.44269504089f;
DI void prep_phase(const Ctx& C, int l) {
    const bf16* PROJ = WSP(bf16, R_PROJ); float* SC = WSP(float, R_SC); bf16* LIN = WSP(bf16, R_LIN); bf16* YCAT = WSP(bf16, R_YCAT);
    bf16 *QC = WSP(bf16, R_QC), *KC = WSP(bf16, R_KC), *QN = WSP(bf16, R_QN), *QR = WSP(bf16, R_QR), *KCR = WSP(bf16, R_KCR), *VCR = WSP(bf16, R_VCR), *KS = WSP(bf16, R_KS), *KW = WSP(bf16, R_KW);
    float* GATE = WSP(float, R_GATE);
    const int lane = C.lane, gw = C.bid * NWAVE + C.wave, NGW = C.G * NWAVE;
    const int hh = lane >> 4, jj = lane & 15;
    const float inv0 = exp2f(-(float)(2 * jj) * (13.287712379549449f / 32.f)) * 0.15915494309189535f, inv1 = exp2f(-(float)(2 * jj + 1) * (13.287712379549449f / 32.f)) * 0.15915494309189535f;
    for (int task = gw; task < NT / 16; task += NGW) {
        const int row0 = 16 * task, s0 = row0 % NS;
        {
            const int c0 = 16 * lane, cc = (c0 - 256) & 255; float mu16[16], kw16[16];
#pragma unroll
            for (int q = 0; q < 4; ++q) { const f32x4 m4 = *(const f32x4*)(C.mu + (size_t)l * 1024 + c0 + 4 * q), k4 = *(const f32x4*)(C.kkw + (size_t)l * 256 + cc + 4 * q);
#pragma unroll
                for (int i = 0; i < 4; ++i) { mu16[4 * q + i] = m4[i]; kw16[4 * q + i] = k4[i]; } }
#pragma unroll 2
            for (int r = 0; r < 16; ++r) {
                const int row = row0 + r; const bf16* pr = PROJ + (size_t)row * NPJ; float z[16];
                const u32x4 c0v = *(const u32x4*)(pr + c0), c1v = *(const u32x4*)(pr + c0 + 8);
                u32x4 p0v = (u32x4){0u, 0u, 0u, 0u}, p1v = p0v;
                if (s0 + r > 0) { p0v = *(const u32x4*)(pr - NPJ + c0); p1v = *(const u32x4*)(pr - NPJ + c0 + 8); }
                const unsigned cw[8] = {c0v.x, c0v.y, c0v.z, c0v.w, c1v.x, c1v.y, c1v.z, c1v.w}, pw[8] = {p0v.x, p0v.y, p0v.z, p0v.w, p1v.x, p1v.y, p1v.z, p1v.w};
#pragma unroll
                for (int e = 0; e < 16; ++e) { const float cu = (e & 1) ? bfhi(cw[e >> 1]) : bflo(cw[e >> 1]), pv = (e & 1) ? bfhi(pw[e >> 1]) : bflo(pw[e >> 1]); z[e] = cu + (pv - cu) * mu16[e]; }
                float kk[16]; float ss = 0.f;
#pragma unroll
                for (int e = 0; e < 16; ++e) { kk[e] = z[e] * kw16[e]; ss += kk[e] * kk[e]; }
                ss = group_sum<4>(ss); const float kinv = rsqrtf(ss + 1e-12f);
                if (lane < 48) {
                    const int vec = lane < 16 ? 4 : (lane < 32 ? 1 : 5); float* dst = SC + ((size_t)vec * NT + row) * 256 + (c0 & 255);
#pragma unroll
                    for (int q = 0; q < 4; ++q) *(f32x4*)(dst + 4 * q) = (f32x4){z[4 * q], z[4 * q + 1], z[4 * q + 2], z[4 * q + 3]};
                    if (lane >= 16 && lane < 32) { float* d2 = SC + ((size_t)2 * NT + row) * 256 + cc;
#pragma unroll
                        for (int q = 0; q < 4; ++q) *(f32x4*)(d2 + 4 * q) = (f32x4){kk[4 * q] * kinv, kk[4 * q + 1] * kinv, kk[4 * q + 2] * kinv, kk[4 * q + 3] * kinv}; }
                } else {
                    float t[16];
#pragma unroll
                    for (int i = 0; i < 16; ++i) { const float sg = fsigmoid(lane < 52 ? 2.f * z[i] : z[i]); t[i] = lane < 52 ? 2.f * sg - 1.f : (lane < 56 ? z[i] : sg); }
                    bf16* dst = LIN + (size_t)row * 256 + (c0 - 768);
                    u32x4 o0, o1; o0.x = pk2(t[0], t[1]); o0.y = pk2(t[2], t[3]); o0.z = pk2(t[4], t[5]); o0.w = pk2(t[6], t[7]); o1.x = pk2(t[8], t[9]); o1.y = pk2(t[10], t[11]); o1.z = pk2(t[12], t[13]); o1.w = pk2(t[14], t[15]);
                    *(u32x4*)dst = o0; *(u32x4*)(dst + 8) = o1;
                }
            }
        }
        {
            const int ch = 4 * lane; const float* cw = C.conv_w + (size_t)l * 3 * 256 + ch; const f32x4 w0 = *(const f32x4*)cw, w1 = *(const f32x4*)(cw + 256), w2 = *(const f32x4*)(cw + 512);
            const f32x4 og = *(const f32x4*)(C.onorm_g + (size_t)l * 768 + ch);
#pragma unroll 2
            for (int r = 0; r < 16; ++r) {
                const int row = row0 + r, s = s0 + r; const bf16* pr = PROJ + (size_t)row * NPJ; float u[3][4];
#pragma unroll
                for (int d = 0; d < 3; ++d) {
                    u32x2 cg = (u32x2){0u, 0u}, xi = cg;
                    if (s >= d) { cg = *(const u32x2*)(pr - (size_t)d * NPJ + PJ_B + 256 + ch); xi = *(const u32x2*)(pr - (size_t)d * NPJ + PJ_B + 512 + ch); }
                    u[d][0] = bflo(cg.x) * bflo(xi.x); u[d][1] = bfhi(cg.x) * bfhi(xi.x); u[d][2] = bflo(cg.y) * bflo(xi.y); u[d][3] = bfhi(cg.y) * bfhi(xi.y);
                }
                const u32x2 bgv = *(const u32x2*)(pr + PJ_B + ch); const float bg[4] = {bflo(bgv.x), bfhi(bgv.x), bflo(bgv.y), bfhi(bgv.y)};
                float y[4]; float ss = 0.f;
#pragma unroll
                for (int i = 0; i < 4; ++i) { y[i] = bg[i] * (w0[i] * u[2][i] + w1[i] * u[1][i] + w2[i] * u[0][i]); ss += y[i] * y[i]; }
                ss = group_sum<16>(ss); const float rstd = rsqrtf(ss * (1.f / 64.f) + 1e-6f);
                u32x2 o; o.x = pk2(y[0] * rstd * og[0], y[1] * rstd * og[1]); o.y = pk2(y[2] * rstd * og[2], y[3] * rstd * og[3]);
                *(u32x2*)(YCAT + (size_t)row * DM + 256 + ch) = o;
            }
        }
        {
            const float* gq = C.dil_q_g + (size_t)l * 64; const float* gk = C.dil_k_g + (size_t)l * 64; const float* gn = C.nsa_q_g + (size_t)l * 64; const float* gv = (hh == 0 ? C.nsa_ks_g : C.nsa_kw_g) + (size_t)l * 64;
            float Gq[4], Gk[4], Gn[4], Gv[4];
#pragma unroll
            for (int i = 0; i < 4; ++i) { const int d = (i >> 1) * 32 + 2 * jj + (i & 1); Gq[i] = gq[d] * QSCALE; Gk[i] = gk[d]; Gn[i] = gn[d] * QSCALE; Gv[i] = gv[d]; }
            const int vcol = hh == 0 ? 2944 : (hh == 1 ? 3072 : (hh == 2 ? 2816 : 2880));
            bf16* vdst = (hh == 0 ? KS : (hh == 1 ? KW : (hh == 2 ? KCR : VCR)));
#pragma unroll 2
            for (int r = 0; r < 16; ++r) {
                const int row = row0 + r; const bf16* pr = PROJ + (size_t)row * NPJ;
                const float posf = (float)C.pos[row];
                const float x0 = __builtin_amdgcn_fractf(posf * inv0), x1 = __builtin_amdgcn_fractf(posf * inv1);
                const float sn0 = __builtin_amdgcn_sinf(x0), cs0 = __builtin_amdgcn_cosf(x0), sn1 = __builtin_amdgcn_sinf(x1), cs1 = __builtin_amdgcn_cosf(x1);
                const unsigned qa = *(const unsigned*)(pr + PJ_C + hh * 64 + 2 * jj), qb = *(const unsigned*)(pr + PJ_C + hh * 64 + 32 + 2 * jj);
                const unsigned ka = *(const unsigned*)(pr + PJ_C + 256 + hh * 64 + 2 * jj), kb = *(const unsigned*)(pr + PJ_C + 256 + hh * 64 + 32 + 2 * jj);
                const unsigned na = *(const unsigned*)(pr + PJ_D + hh * 64 + 2 * jj), nb = *(const unsigned*)(pr + PJ_D + hh * 64 + 32 + 2 * jj);
                const unsigned va = *(const unsigned*)(pr + vcol + 2 * jj), vb = *(const unsigned*)(pr + vcol + 32 + 2 * jj);
                float gate_in = 0.f; if (lane < 12) gate_in = bf2f(pr[3200 + lane]);
#define ROPE_NORM(a, b, G, o1, o2, n1a, n1b, n2a, n2b) \
                float n1a = bflo(a), n1b = bfhi(a), n2a = bflo(b), n2b = bfhi(b); { const float ss_ = group_sum<16>(n1a * n1a + n1b * n1b + n2a * n2a + n2b * n2b); const float rs_ = rsqrtf(ss_ * (1.f / 64.f) + 1e-6f); \
                    n1a *= rs_ * G[0]; n1b *= rs_ * G[1]; n2a *= rs_ * G[2]; n2b *= rs_ * G[3]; } \
                const unsigned o1 = pk2(n1a * cs0 - n2a * sn0, n1b * cs1 - n2b * sn1), o2 = pk2(n2a * cs0 + n1a * sn0, n2b * cs1 + n1b * sn1);
                ROPE_NORM(qa, qb, Gq, q1, q2, q1a, q1b, q2a, q2b)
                ROPE_NORM(ka, kb, Gk, k1, k2, k1a, k1b, k2a, k2b)
                ROPE_NORM(na, nb, Gn, r1, r2, r1a, r1b, r2a, r2b)
                ROPE_NORM(va, vb, Gv, v1, v2, v1a, v1b, v2a, v2b)
#undef ROPE_NORM
                bf16* o = QC + (size_t)row * 256 + hh * 64 + 2 * jj; *(unsigned*)o = q1; *(unsigned*)(o + 32) = q2;
                o = KC + (size_t)row * 256 + hh * 64 + 2 * jj; *(unsigned*)o = k1; *(unsigned*)(o + 32) = k2;
                o = QN + (size_t)row * 256 + hh * 64 + 2 * jj; *(unsigned*)o = pk2(r1a, r1b); *(unsigned*)(o + 32) = pk2(r2a, r2b);
                o = QR + (size_t)row * 256 + hh * 64 + 2 * jj; *(unsigned*)o = r1; *(unsigned*)(o + 32) = r2;
                o = vdst + (size_t)row * 64 + 2 * jj; *(unsigned*)o = (hh >= 2) ? va : v1; *(unsigned*)(o + 32) = (hh >= 2) ? vb : v2;
                if (lane < 12) GATE[(size_t)row * 12 + lane] = fsigmoid(gate_in);
            }
        }
    }
}
constexpr int SCAN_TC = 16;
DI void scan_unit8(const Ctx& C, int u) {
    const float* SC = WSP(float, R_SC); float* YA = WSP(float, R_YA); float* UB = WSP(float, R_SCANU); float* SMT = WSP(float, R_SCANS);
    const int pair = u / 3, kind = u % 3, b = pair >> 2, h = pair & 3, tid = C.tid;
    LAS float* buf = (LAS float*)C.lds;
    LAS float* ybuf = buf + 2 * 6144;
    const int row = tid >> 3, cg = tid & 7, tbase = kind == 0 ? 0 : NS / 2;
    const float vm = kind == 2 ? 0.f : 1.f;
    f32x4 ld[3];
#define SCAN_LOAD(chunk) do { _Pragma("unroll") for (int i = 0; i < 3; ++i) { const int idx = tid + 512 * i, step = idx / 96, rem = idx % 96, vec = rem >> 4, f4 = rem & 15; \
        ld[i] = *(const f32x4*)(SC + ((size_t)vec * NT + (size_t)b * NS + tbase + (chunk) * SCAN_TC + step) * 256 + h * 64 + f4 * 4); } } while (0)
#define SCAN_STORE(slot) do { _Pragma("unroll") for (int i = 0; i < 3; ++i) *(LAS f32x4*)(buf + (slot) * 6144 + (tid + 512 * i) * 4) = ld[i]; } while (0)
#define SCAN_FLUSH(chunk) do { _Pragma("unroll") for (int i = 0; i < 2; ++i) { const int i2 = tid + 512 * i, step = i2 >> 6, rr = i2 & 63; const float yv = ybuf[((chunk) & 1) * 1024 + i2]; \
        if (kind == 2) UB[((size_t)b * (NS / 2) + (chunk) * SCAN_TC + step) * 256 + h * 64 + rr] = yv; else YA[((size_t)b * NS + tbase + (chunk) * SCAN_TC + step) * 256 + h * 64 + rr] = yv; } } while (0)
    __syncthreads();
    SCAN_LOAD(0); SCAN_STORE(0); SCAN_LOAD(1);
    f32x2 S[4];
#pragma unroll
    for (int c = 0; c < 4; ++c) { S[c][0] = (kind == 2 && row == 8 * cg + 2 * c) ? 1.f : 0.f; S[c][1] = (kind == 2 && row == 8 * cg + 2 * c + 1) ? 1.f : 0.f; }
    constexpr int NCH = (NS / 2) / SCAN_TC;
    for (int ck = 0; ck < NCH; ++ck) {
        __syncthreads();
        if (ck + 1 < NCH) SCAN_STORE((ck + 1) & 1);
        if (ck + 2 < NCH) SCAN_LOAD(ck + 2);
        {
            const LAS float* bp = buf + (ck & 1) * 6144; LAS float* yb = ybuf + (ck & 1) * 1024 + row;
#define SCAN_LDS(X, step) do { const LAS float* sp = bp + (step) * 384 + 8 * cg; X.w0 = *(const LAS f32x4*)(sp); X.w1 = *(const LAS f32x4*)(sp + 4); X.k0 = *(const LAS f32x4*)(sp + 64); X.k1 = *(const LAS f32x4*)(sp + 68); \
                X.q0 = *(const LAS f32x4*)(sp + 128); X.q1 = *(const LAS f32x4*)(sp + 132); X.b0 = *(const LAS f32x4*)(sp + 192); X.b1 = *(const LAS f32x4*)(sp + 196); \
                X.r0 = *(const LAS f32x4*)(sp + 256); X.r1 = *(const LAS f32x4*)(sp + 260); X.v = bp[(step) * 384 + 320 + row] * vm; } while (0)
#define SCAN_STEP(X, step) do { \
                f32x2 d2 = S[0] * (f32x2){X.q0[0], X.q0[1]}; d2 = S[1] * (f32x2){X.q0[2], X.q0[3]} + d2; d2 = S[2] * (f32x2){X.q1[0], X.q1[1]} + d2; d2 = S[3] * (f32x2){X.q1[2], X.q1[3]} + d2; \
                const float sa = -sum8(d2[0] + d2[1]); const f32x2 sa2 = (f32x2){sa, sa}, v2 = (f32x2){X.v, X.v}; \
                S[0] = S[0] * (f32x2){X.w0[0], X.w0[1]} + (sa2 * (f32x2){X.b0[0], X.b0[1]} + v2 * (f32x2){X.k0[0], X.k0[1]}); \
                S[1] = S[1] * (f32x2){X.w0[2], X.w0[3]} + (sa2 * (f32x2){X.b0[2], X.b0[3]} + v2 * (f32x2){X.k0[2], X.k0[3]}); \
                S[2] = S[2] * (f32x2){X.w1[0], X.w1[1]} + (sa2 * (f32x2){X.b1[0], X.b1[1]} + v2 * (f32x2){X.k1[0], X.k1[1]}); \
                S[3] = S[3] * (f32x2){X.w1[2], X.w1[3]} + (sa2 * (f32x2){X.b1[2], X.b1[3]} + v2 * (f32x2){X.k1[2], X.k1[3]}); \
                f32x2 y2 = S[0] * (f32x2){X.r0[0], X.r0[1]}; y2 = S[1] * (f32x2){X.r0[2], X.r0[3]} + y2; y2 = S[2] * (f32x2){X.r1[0], X.r1[1]} + y2; y2 = S[3] * (f32x2){X.r1[2], X.r1[3]} + y2; \
                const float yy = sum8(y2[0] + y2[1]); if (cg == 0) yb[(step) * 64] = yy; } while (0)
            struct StepIn { f32x4 w0, w1, k0, k1, q0, q1, b0, b1, r0, r1; float v; } A, B;
            SCAN_LDS(A, 0);
#pragma unroll 2
            for (int step = 0; step < SCAN_TC; step += 2) {
                SCAN_LDS(B, step + 1);
                __builtin_amdgcn_sched_barrier(0);
                SCAN_STEP(A, step);
                __builtin_amdgcn_sched_barrier(0);
                if (step + 2 < SCAN_TC) SCAN_LDS(A, step + 2);
                __builtin_amdgcn_sched_barrier(0);
                SCAN_STEP(B, step + 1);
                __builtin_amdgcn_sched_barrier(0);
            }
#undef SCAN_LDS
#undef SCAN_STEP
        }
        if (ck > 0) SCAN_FLUSH(ck - 1);
    }
    __syncthreads();
    SCAN_FLUSH(NCH - 1);
    if (kind == 0) {
        float* o = SMT + (size_t)pair * 4096 + row;
#pragma unroll
        for (int c = 0; c < 4; ++c) { o[(8 * cg + 2 * c) * 64] = S[c][0]; o[(8 * cg + 2 * c + 1) * 64] = S[c][1]; }
    }
#undef SCAN_LOAD
#undef SCAN_STORE
#undef SCAN_FLUSH
    __syncthreads();
}

constexpr int KROW = 144, KT_BYTES = 64 * KROW;
#define MFMA16(a, b, c) __builtin_amdgcn_mfma_f32_16x16x32_bf16((a), (b), (c), 0, 0, 0)
template <int NQT> struct FA { f32x4 O[NQT][4]; float l[NQT]; float negM; };
template <int NQT> DI void fa_init(FA<NQT>& st) {
#pragma unroll
    for (int q = 0; q < NQT; ++q) { st.l[q] = 0.f;
#pragma unroll
        for (int d = 0; d < 4; ++d) st.O[q][d] = (f32x4){0.f, 0.f, 0.f, 0.f}; }
}
DI bf16x8 pack8(const f32x4& a, const f32x4& b) { u32x4 w; w.x = pk2(a[0], a[1]); w.y = pk2(a[2], a[3]); w.z = pk2(b[0], b[1]); w.w = pk2(b[2], b[3]); return __builtin_bit_cast(bf16x8, w); }
struct VFrag { u32x2 a[4], b[4]; };
DI void vt_issue(VFrag& f, unsigned vaddr) {
    asm volatile("ds_read_b64_tr_b16 %0, %8\n\tds_read_b64_tr_b16 %1, %8 offset:2304\n\tds_read_b64_tr_b16 %2, %8 offset:32\n\tds_read_b64_tr_b16 %3, %8 offset:2336\n\t"
                 "ds_read_b64_tr_b16 %4, %8 offset:64\n\tds_read_b64_tr_b16 %5, %8 offset:2368\n\tds_read_b64_tr_b16 %6, %8 offset:96\n\tds_read_b64_tr_b16 %7, %8 offset:2400"
                 : "=&v"(f.a[0]), "=&v"(f.b[0]), "=&v"(f.a[1]), "=&v"(f.b[1]), "=&v"(f.a[2]), "=&v"(f.b[2]), "=&v"(f.a[3]), "=&v"(f.b[3]) : "v"(vaddr) : "memory");
}
DI void vt_wait(VFrag& f) { asm volatile("s_waitcnt lgkmcnt(0)" : "+v"(f.a[0]), "+v"(f.b[0]), "+v"(f.a[1]), "+v"(f.b[1]), "+v"(f.a[2]), "+v"(f.b[2]), "+v"(f.a[3]), "+v"(f.b[3]) :: "memory"); }
DI bf16x8 vt_get(const VFrag& f, int d) { return __builtin_bit_cast(bf16x8, ((u32x4){f.a[d].x, f.a[d].y, f.b[d].x, f.b[d].y})); }
template <int NQT, bool MASKED, class MaskF>
DI void fa_tile(FA<NQT>& st, const bf16x8 (&Q)[NQT][2], const LAS uchar* Ks, const LAS uchar* Vs, int lane, const MaskF& allowed, const bool (&act)[NQT]) {
    const int l15 = lane & 15, quad = lane >> 4;
    f32x4 S[NQT][4]; const f32x4 sinit = (f32x4){st.negM, st.negM, st.negM, st.negM};
#pragma unroll
    for (int kt = 0; kt < 4; ++kt) {
        const bf16x8 k0 = *(const LAS bf16x8*)(Ks + (16 * kt + l15) * KROW + quad * 16), k1 = *(const LAS bf16x8*)(Ks + (16 * kt + l15) * KROW + 64 + quad * 16);
#pragma unroll
        for (int q = 0; q < NQT; ++q) if (act[q]) { S[q][kt] = MFMA16(k0, Q[q][0], sinit); S[q][kt] = MFMA16(k1, Q[q][1], S[q][kt]); }
    }
    const unsigned vaddr = (unsigned)(size_t)(Vs + (4 * quad + (l15 >> 2)) * KROW + 8 * (l15 & 3));
    VFrag v0, v1; vt_issue(v0, vaddr); vt_issue(v1, vaddr + 32 * KROW);
#pragma unroll
    for (int q = 0; q < NQT; ++q) if (act[q]) {
        float rs = 0.f;
#pragma unroll
        for (int kt = 0; kt < 4; ++kt)
#pragma unroll
            for (int j = 0; j < 4; ++j) { float p = fexp2(S[q][kt][j]); if (MASKED) p = allowed(q, 16 * kt + 4 * quad + j) ? p : 0.f; S[q][kt][j] = p; rs += p; }
        st.l[q] += rs;
    }
    vt_wait(v0); vt_wait(v1);
#pragma unroll
    for (int q = 0; q < NQT; ++q) if (act[q]) {
        const bf16x8 p0 = pack8(S[q][0], S[q][1]), p1 = pack8(S[q][2], S[q][3]);
#pragma unroll
        for (int d = 0; d < 4; ++d) { st.O[q][d] = MFMA16(vt_get(v0, d), p0, st.O[q][d]); st.O[q][d] = MFMA16(vt_get(v1, d), p1, st.O[q][d]); }
    }
}
template <int NQT> DI void fa_finish(FA<NQT>& st, float (&lse2)[NQT]) {
#pragma unroll
    for (int q = 0; q < NQT; ++q) { float l = st.l[q]; l += __shfl_xor(l, 16); l += __shfl_xor(l, 32); const float inv = l > 0.f ? 1.f / l : 0.f; lse2[q] = __log2f(fmaxf(l, 1e-37f));
#pragma unroll
        for (int d = 0; d < 4; ++d) st.O[q][d] = st.O[q][d] * inv; }
}
DI float score_bound(const float* gq, const float* gk, int lane) {
    float a = fabsf(gq[lane & 63]), b = fabsf(gk[lane & 63]);
#pragma unroll
    for (int o = 1; o < 64; o <<= 1) { a = fmaxf(a, __shfl_xor(a, o)); b = fmaxf(b, __shfl_xor(b, o)); }
    return 64.f * a * b * QSCALE * 1.02f + 0.5f;
}
DI void kv_store(LAS uchar* Ks, LAS uchar* Vs, int tid, const u32x4& kr, const u32x4& vr) {
    const int o = (tid >> 3) * KROW + (tid & 7) * 16; *(LAS u32x4*)(Ks + o) = kr; *(LAS u32x4*)(Vs + o) = vr;
}
DI void q_load(bf16x8 (&Q)[2], const bf16* qrow, int quad) { Q[0] = *(const bf16x8*)(qrow + 8 * quad); Q[1] = *(const bf16x8*)(qrow + 32 + 8 * quad); }

struct DilMask { int qi[2]; int k0; DI bool operator()(int q, int key) const { const int ki = k0 + key, d = qi[q] - ki; return ki >= 0 && d >= 0 && d <= 128; } };
DI void dil_unit(const Ctx& C, int unit, LAS uchar* Ks, LAS uchar* Vs, float negM_bound) {
    const bf16 *QC = WSP(bf16, R_QC), *KC = WSP(bf16, R_KC), *PROJ = WSP(bf16, R_PROJ); float* OC = WSP(float, R_OC); float* LSE = WSP(float, R_LSE);
    int tid = C.tid, lane = C.lane; asm volatile("" : "+v"(tid), "+v"(lane));
    const int w = C.wave, l15 = lane & 15, quad = lane >> 4;
    const int cfg = unit / 512, r = unit % 512, dsh = 2 * cfg, d = 1 << dsh;
    const int b = r >> 6, h = (r >> 4) & 3, r2 = r & 15;
    const int nblk = 16 >> dsh, res = r2 / nblk, blk = r2 % nblk, i0 = blk * 256;
    const size_t tb = (size_t)b * NS;
    bf16x8 Q[2][2]; DilMask mk; FA<2> st; fa_init(st); st.negM = -negM_bound;
#pragma unroll
    for (int q = 0; q < 2; ++q) { mk.qi[q] = i0 + 32 * w + 16 * q + l15; q_load(Q[q], QC + (tb + res + (size_t)d * mk.qi[q]) * 256 + h * 64, quad); }
    const int jlo = w >> 1, jhi = (w >> 1) + 2;
    const bool act[2] = {true, true};
    u32x4 kr, vr;
#define DIL_LOAD(j) do { const int ki = i0 - 128 + 64 * (j) + (tid >> 3); kr = (u32x4){0u, 0u, 0u, 0u}; vr = kr; \
    if (ki >= 0) { const size_t rowk = tb + res + (size_t)d * ki; kr = *(const u32x4*)(KC + rowk * 256 + h * 64 + (tid & 7) * 8); vr = *(const u32x4*)(PROJ + rowk * NPJ + PJ_C + 512 + h * 64 + (tid & 7) * 8); } } while (0)
    DIL_LOAD(0); __syncthreads(); kv_store(Ks, Vs, tid, kr, vr); DIL_LOAD(1);
    for (int j = 0; j < 6; ++j) {
        __syncthreads();
        if (j + 1 < 6) kv_store(Ks + ((j + 1) & 1) * 2 * KT_BYTES, Vs + ((j + 1) & 1) * 2 * KT_BYTES, tid, kr, vr);
        if (j + 2 < 6) DIL_LOAD(j + 2);
        if (j >= jlo && j <= jhi) { mk.k0 = i0 - 128 + 64 * j; fa_tile<2, true>(st, Q, Ks + (j & 1) * 2 * KT_BYTES, Vs + (j & 1) * 2 * KT_BYTES, lane, mk, act); }
    }
#undef DIL_LOAD
    float lse2[2]; fa_finish<2>(st, lse2);
#pragma unroll
    for (int q = 0; q < 2; ++q) { const size_t rowq = tb + res + (size_t)d * mk.qi[q]; float* o = OC + ((size_t)cfg * NT + rowq) * 256 + h * 64 + 4 * quad;
#pragma unroll
        for (int dt = 0; dt < 4; ++dt) *(f32x4*)(o + 16 * dt) = st.O[q][dt];
        if (quad == 0) LSE[((size_t)cfg * NT + rowq) * 4 + h] = lse2[q]; }
}
constexpr int NSA_KC = 0, NSA_VC = 256 * KROW, NSA_KT = 2 * 256 * KROW, NSA_VT = NSA_KT + KT_BYTES, NSA_IMP = NSA_KT + 4 * KT_BYTES,
    NSA_SELM = NSA_IMP + 64 * 64 * 4, NSA_UW = NSA_SELM + 512;
static_assert(NSA_UW + 16 <= RING_BYTES, "NSA LDS map");
struct SwaMask { int t[2]; int k0; DI bool operator()(int q, int key) const { const int d = t[q] - (k0 + key); return d >= 0 && d <= 511; } };
struct SlcMask { int t[2]; int k0; bool sel[2]; DI bool operator()(int q, int key) const { return sel[q] && (k0 + key <= t[q]); } };
struct NoMask { DI bool operator()(int, int) const { return true; } };
DI void nsa_unit(const Ctx& C, int l, int b, int tbk, int& bl, float bnd_cmp, float bnd_slc, float bnd_swa) {
    const bf16 *QN = WSP(bf16, R_QN), *QR = WSP(bf16, R_QR), *KSb = WSP(bf16, R_KS), *KWb = WSP(bf16, R_KW), *PROJ = WSP(bf16, R_PROJ); const float* CMP = WSP(float, R_CMP); const float* GATE = WSP(float, R_GATE);
    bf16* YCAT = WSP(bf16, R_YCAT);
    LAS uchar* Kc = C.lds + NSA_KC; LAS uchar* Vc = C.lds + NSA_VC; LAS uchar* Ks = C.lds + NSA_KT; LAS uchar* Vs = C.lds + NSA_VT;
    LAS float* imps = (LAS float*)(C.lds + NSA_IMP); LAS unsigned* selm = (LAS unsigned*)(C.lds + NSA_SELM); LAS unsigned* uw = (LAS unsigned*)(C.lds + NSA_UW);
    int tid = C.tid, lane = C.lane; asm volatile("" : "+v"(tid), "+v"(lane));
    const int w = C.wave, l15 = lane & 15, quad = lane >> 4, head = l15 & 3, t0 = 64 * tbk; const size_t tb = (size_t)b * NS;
    __syncthreads();
    if (b != bl) {
        const int key = tid >> 1, hf = tid & 1; const float* kp = CMP + ((size_t)b * 256 + key) * 64 + 32 * hf; const float* vp = CMP + ((size_t)2048 + (size_t)b * 256 + key) * 64 + 32 * hf;
        float kv[32], vv[32]; float ss = 0.f;
#pragma unroll
        for (int i = 0; i < 8; ++i) { const f32x4 a = *(const f32x4*)(kp + 4 * i), c = *(const f32x4*)(vp + 4 * i);
#pragma unroll
            for (int j = 0; j < 4; ++j) { kv[4 * i + j] = a[j]; vv[4 * i + j] = c[j]; ss += a[j] * a[j]; } }
        ss += __shfl_xor(ss, 1); const float rstd = rsqrtf(ss * (1.f / 64.f) + 1e-6f); const float* g = C.nsa_kc_g + (size_t)l * 64 + 32 * hf; const bool dead = (key == 255);
#pragma unroll
        for (int i = 0; i < 4; ++i) { u32x4 o, p;
            o.x = pk2(kv[8 * i] * rstd * g[8 * i], kv[8 * i + 1] * rstd * g[8 * i + 1]); o.y = pk2(kv[8 * i + 2] * rstd * g[8 * i + 2], kv[8 * i + 3] * rstd * g[8 * i + 3]);
            o.z = pk2(kv[8 * i + 4] * rstd * g[8 * i + 4], kv[8 * i + 5] * rstd * g[8 * i + 5]); o.w = pk2(kv[8 * i + 6] * rstd * g[8 * i + 6], kv[8 * i + 7] * rstd * g[8 * i + 7]);
            p.x = pk2(vv[8 * i], vv[8 * i + 1]); p.y = pk2(vv[8 * i + 2], vv[8 * i + 3]); p.z = pk2(vv[8 * i + 4], vv[8 * i + 5]); p.w = pk2(vv[8 * i + 6], vv[8 * i + 7]);
            if (dead) { o = (u32x4){0u, 0u, 0u, 0u}; p = o; }
            *(LAS u32x4*)(Kc + key * KROW + hf * 64 + i * 16) = o; *(LAS u32x4*)(Vc + key * KROW + hf * 64 + i * 16) = p; }
        bl = b;
        __syncthreads();
    }
    f32x4 Oc[2][4];
    const int cmaxu = (t0 + 32) >> 4, ktmax = cmaxu >> 4;
    const unsigned vaddr0 = (unsigned)(size_t)(Vc + (4 * quad + (l15 >> 2)) * KROW + 8 * (l15 & 3));
#pragma unroll
    for (int q = 0; q < 2; ++q) {
        const int t = t0 + 8 * w + 4 * q + (l15 >> 2);
        bf16x8 Q[2]; q_load(Q, QN + (tb + t) * 256 + head * 64, quad);
        f32x4 S[16]; const f32x4 sinit = (f32x4){-bnd_cmp, -bnd_cmp, -bnd_cmp, -bnd_cmp}; float ls = 0.f;
#pragma unroll
        for (int kt = 0; kt < 16; ++kt) {
            if (kt <= ktmax) {
                const bf16x8 k0 = *(const LAS bf16x8*)(Kc + (16 * kt + l15) * KROW + quad * 16), k1 = *(const LAS bf16x8*)(Kc + (16 * kt + l15) * KROW + 64 + quad * 16);
                S[kt] = MFMA16(k0, Q[0], sinit); S[kt] = MFMA16(k1, Q[1], S[kt]);
#pragma unroll
                for (int j = 0; j < 4; ++j) { const int c = 16 * kt + 4 * quad + j; const float p = (16 * c + 31 <= t) ? fexp2(S[kt][j]) : 0.f; S[kt][j] = p; ls += p; }
            } else S[kt] = (f32x4){0.f, 0.f, 0.f, 0.f};
        }
        ls += __shfl_xor(ls, 16); ls += __shfl_xor(ls, 32);
        const float inv = ls > 0.f ? 1.f / ls : 0.f;
#pragma unroll
        for (int kt = 0; kt < 16; ++kt) S[kt] = S[kt] * inv;
#pragma unroll
        for (int kt = 0; kt < 16; ++kt) {
            const float send = (quad == 3) ? (kt > 0 ? S[kt > 0 ? kt - 1 : 0][3] : 0.f) : S[kt][3];
            const float prev = __shfl(send, (lane + 48) & 63);
            float v = ((quad == 0 && kt == 0) ? 0.f : prev) + 2.f * (S[kt][0] + S[kt][1] + S[kt][2]) + S[kt][3];
            v += __shfl_xor(v, 1); v += __shfl_xor(v, 2);
            if (head == 0) imps[(8 * w + 4 * q + (l15 >> 2)) * 64 + 4 * kt + quad] = v;
        }
#pragma unroll
        for (int d = 0; d < 4; ++d) Oc[q][d] = (f32x4){0.f, 0.f, 0.f, 0.f};
#pragma unroll
        for (int ks = 0; ks < 8; ++ks) {
            if (2 * ks <= ktmax) {
                VFrag vf; vt_issue(vf, vaddr0 + ks * 32 * KROW); const bf16x8 pf = pack8(S[2 * ks], S[2 * ks + 1]); vt_wait(vf);
#pragma unroll
                for (int d = 0; d < 4; ++d) Oc[q][d] = MFMA16(vt_get(vf, d), pf, Oc[q][d]);
            }
        }
    }
    {
        float* OCm = WSP(float, R_OCMP);
#pragma unroll
        for (int q = 0; q < 2; ++q) { float* o = OCm + (tb + t0 + 8 * w + 4 * q + (l15 >> 2)) * 256 + head * 64 + 4 * quad;
#pragma unroll
            for (int d = 0; d < 4; ++d) *(f32x4*)(o + 16 * d) = Oc[q][d]; }
    }
    __syncthreads();
    if (tid < 64) {
        const int cur = tbk; unsigned long long mask;
        if (cur <= 15) mask = (2ull << cur) - 1ull;
        else {
            mask = 1ull | (1ull << cur) | (1ull << (cur - 1));
            float v[64];
#pragma unroll
            for (int i = 0; i < 16; ++i) { const f32x4 a = *(const LAS f32x4*)(imps + tid * 64 + 4 * i);
#pragma unroll
                for (int j = 0; j < 4; ++j) { const int jb = 4 * i + j; v[jb] = (jb >= 1 && jb <= cur - 2) ? a[j] : -1.f; } }
#pragma unroll 1
            for (int r = 0; r < 13; ++r) {
                float bv = -0.5f; int bi = 0;
#pragma unroll
                for (int jb = 0; jb < 64; ++jb) if (v[jb] > bv) { bv = v[jb]; bi = jb; }
                mask |= 1ull << bi;
#pragma unroll
                for (int jb = 0; jb < 64; ++jb) v[jb] = (jb == bi) ? -1.f : v[jb];
            }
        }
        unsigned lo = (unsigned)mask, hi = (unsigned)(mask >> 32);
        selm[2 * tid] = lo; selm[2 * tid + 1] = hi;
#pragma unroll
        for (int o = 1; o < 64; o <<= 1) { lo |= __shfl_xor(lo, o); hi |= __shfl_xor(hi, o); }
        if (tid == 0) { uw[0] = lo; uw[1] = hi; }
    }
    __syncthreads();
    unsigned long long U = ((unsigned long long)uw[1] << 32) | uw[0];
    bf16x8 Q[2][2]; SlcMask mk; FA<2> st; fa_init(st); st.negM = -bnd_slc; unsigned long long msk[2];
#pragma unroll
    for (int q = 0; q < 2; ++q) { const int tl = 8 * w + 4 * q + (l15 >> 2); mk.t[q] = t0 + tl; msk[q] = ((unsigned long long)selm[2 * tl + 1] << 32) | selm[2 * tl]; q_load(Q[q], QR + (tb + mk.t[q]) * 256 + head * 64, quad); }
    unsigned long long QM[2];
#pragma unroll
    for (int q = 0; q < 2; ++q) { unsigned lo = (unsigned)msk[q], hi = (unsigned)(msk[q] >> 32);
#pragma unroll
        for (int o = 1; o < 64; o <<= 1) { lo |= __shfl_xor(lo, o); hi |= __shfl_xor(hi, o); }
        QM[q] = ((unsigned long long)hi << 32) | lo; }
    u32x4 kr, vr;
#define SLC_LOAD(j) do { const size_t rowk = tb + 64 * (j) + (tid >> 3); kr = *(const u32x4*)(KSb + rowk * 64 + (tid & 7) * 8); vr = *(const u32x4*)(PROJ + rowk * NPJ + 3008 + (tid & 7) * 8); } while (0)
    {
        int j = __builtin_ctzll(U); U &= U - 1ull;
        int jn = U ? __builtin_ctzll(U) : -1; U &= U - 1ull;
        SLC_LOAD(j); __syncthreads(); kv_store(Ks, Vs, tid, kr, vr); if (jn >= 0) SLC_LOAD(jn);
        for (int it = 0;; ++it) {
            __syncthreads();
            const int jnn = U ? __builtin_ctzll(U) : -1; U &= U - 1ull;
            if (jn >= 0) kv_store(Ks + ((it + 1) & 1) * 2 * KT_BYTES, Vs + ((it + 1) & 1) * 2 * KT_BYTES, tid, kr, vr);
            if (jnn >= 0) SLC_LOAD(jnn);
            const bool act[2] = {(bool)((QM[0] >> j) & 1ull), (bool)((QM[1] >> j) & 1ull)};
            if (act[0] || act[1]) { mk.k0 = 64 * j; mk.sel[0] = (msk[0] >> j) & 1ull; mk.sel[1] = (msk[1] >> j) & 1ull; fa_tile<2, true>(st, Q, Ks + (it & 1) * 2 * KT_BYTES, Vs + (it & 1) * 2 * KT_BYTES, lane, mk, act); }
            if (jn < 0) break; j = jn; jn = jnn;
        }
    }
#undef SLC_LOAD
    float lse2[2]; fa_finish<2>(st, lse2);
    {   float* OSl = WSP(float, R_OSLC);
#pragma unroll
        for (int q = 0; q < 2; ++q) { float* o = OSl + (tb + mk.t[q]) * 256 + head * 64 + 4 * quad;
#pragma unroll
            for (int d = 0; d < 4; ++d) *(f32x4*)(o + 16 * d) = st.O[q][d]; }
    }
    FA<2> sw; fa_init(sw); sw.negM = -bnd_swa; SwaMask mw; mw.t[0] = mk.t[0]; mw.t[1] = mk.t[1];
    {
        const int j0 = tbk >= 8 ? tbk - 8 : 0; const bool act[2] = {true, true};
#define SWA_LOAD(j) do { const size_t rowk = tb + 64 * (j) + (tid >> 3); kr = *(const u32x4*)(KWb + rowk * 64 + (tid & 7) * 8); vr = *(const u32x4*)(PROJ + rowk * NPJ + 3136 + (tid & 7) * 8); } while (0)
        SWA_LOAD(j0); __syncthreads(); kv_store(Ks, Vs, tid, kr, vr); if (j0 + 1 <= tbk) SWA_LOAD(j0 + 1);
        for (int j = j0; j <= tbk; ++j) {
            const int pb_ = (j - j0) & 1;
            __syncthreads();
            if (j + 1 <= tbk) kv_store(Ks + (pb_ ^ 1) * 2 * KT_BYTES, Vs + (pb_ ^ 1) * 2 * KT_BYTES, tid, kr, vr);
            if (j + 2 <= tbk) SWA_LOAD(j + 2);
            mw.k0 = 64 * j;
            if (j == tbk || j == tbk - 8) fa_tile<2, true>(sw, Q, Ks + pb_ * 2 * KT_BYTES, Vs + pb_ * 2 * KT_BYTES, lane, mw, act);
            else fa_tile<2, false>(sw, Q, Ks + pb_ * 2 * KT_BYTES, Vs + pb_ * 2 * KT_BYTES, lane, NoMask(), act);
        }
#undef SWA_LOAD
    }
    fa_finish<2>(sw, lse2);
#pragma unroll
    for (int q = 0; q < 2; ++q) {
        const size_t row = tb + mk.t[q]; const float* gp = GATE + row * 12 + head * 3; const float g0 = gp[0], g1 = gp[1], g2 = gp[2];
        f32x4 o[4]; float ss = 0.f; const float* pc = WSP(float, R_OCMP) + row * 256 + head * 64 + 4 * quad; const float* ps = WSP(float, R_OSLC) + row * 256 + head * 64 + 4 * quad;
#pragma unroll
        for (int d = 0; d < 4; ++d) { o[d] = *(const f32x4*)(pc + 16 * d) * g0 + *(const f32x4*)(ps + 16 * d) * g1 + sw.O[q][d] * g2; ss += (o[d][0] * o[d][0] + o[d][1] * o[d][1]) + (o[d][2] * o[d][2] + o[d][3] * o[d][3]); }
        ss += __shfl_xor(ss, 16); ss += __shfl_xor(ss, 32);
        const float rstd = rsqrtf(ss * (1.f / 64.f) + 1e-6f); const float* og = C.onorm_g + (size_t)l * 768 + 512 + head * 64 + 4 * quad;
        bf16* yo = YCAT + row * DM + 768 + head * 64 + 4 * quad;
#pragma unroll
        for (int d = 0; d < 4; ++d) { const f32x4 g4 = *(const f32x4*)(og + 16 * d); u32x2 wv; wv.x = pk2(o[d][0] * rstd * g4[0], o[d][1] * rstd * g4[1]); wv.y = pk2(o[d][2] * rstd * g4[2], o[d][3] * rstd * g4[3]); *(u32x2*)(yo + 16 * d) = wv; }
    }
}

DI void fin_phase(const Ctx& C, int l) {
    const float* SC = WSP(float, R_SC); const float* YA = WSP(float, R_YA); const float* Gb = WSP(float, R_G); const float* OC = WSP(float, R_OC); const float* LSE = WSP(float, R_LSE);
    const float* UB = WSP(float, R_SCANU); const float* SMT = WSP(float, R_SCANS); bf16* YCAT = WSP(bf16, R_YCAT);
    const int lane = C.lane, ch = 4 * lane, hh = lane >> 4;
    LAS float* sm = (LAS float*)C.lds;
    LAS float* us = sm + 4 * 4096 + C.wave * 256;
    int bl = -1;
    for (int grp = C.bid; grp < NT / 128; grp += C.G) {
        const int b = (grp * 128) / NS;
        if (b != bl) { __syncthreads(); for (int i = C.tid; i < 4096; i += NTHR) *(LAS f32x4*)(sm + 4 * i) = *(const f32x4*)(SMT + (size_t)b * 4 * 4096 + 4 * i); bl = b; __syncthreads(); }
        const bool fix = ((grp * 128) % NS) >= NS / 2;
#pragma unroll 2
        for (int r = 0; r < 16; ++r) {
            const int row = grp * 128 + C.wave * 16 + r, s = row % NS;
            const size_t o = (size_t)row * 256 + ch;
            {
                f32x4 y = *(const f32x4*)(YA + o); const f32x4 rr = *(const f32x4*)(SC + (size_t)4 * NT * 256 + o), k = *(const f32x4*)(SC + (size_t)1 * NT * 256 + o), v = *(const f32x4*)(SC + (size_t)5 * NT * 256 + o), g = *(const f32x4*)(Gb + o);
                if (fix) {
                    *(LAS f32x4*)(us + ch) = *(const f32x4*)(UB + ((size_t)b * (NS / 2) + (s - NS / 2)) * 256 + ch);
                    asm volatile("s_waitcnt lgkmcnt(0)" ::: "memory");
                    const LAS float* sp = sm + hh * 4096 + 4 * (lane & 15); const LAS float* up = us + hh * 64;
#pragma unroll 8
                    for (int j4 = 0; j4 < 16; ++j4) { const f32x4 u4 = *(const LAS f32x4*)(up + 4 * j4);
#pragma unroll
                        for (int jj = 0; jj < 4; ++jj) y += *(const LAS f32x4*)(sp + (4 * j4 + jj) * 64) * u4[jj]; }
                    asm volatile("s_waitcnt lgkmcnt(0)" ::: "memory");
                }
                const f32x4 rk = *(const f32x4*)(C.rk + (size_t)l * 256 + ch), gw4 = *(const f32x4*)(C.gn_w + (size_t)l * 256 + ch), gb4 = *(const f32x4*)(C.gn_b + (size_t)l * 256 + ch);
                const float mu = group_sum<16>((y[0] + y[1]) + (y[2] + y[3])) * (1.f / 64.f);
                const f32x4 dy = y - mu; const float var = group_sum<16>((dy[0] * dy[0] + dy[1] * dy[1]) + (dy[2] * dy[2] + dy[3] * dy[3])) * (1.f / 64.f);
                const float rstd = rsqrtf(var + 64e-5f);
                const float dot = group_sum<16>((rr[0] * k[0] * rk[0] + rr[1] * k[1] * rk[1]) + (rr[2] * k[2] * rk[2] + rr[3] * k[3] * rk[3]));
                float out[4];
#pragma unroll
                for (int i = 0; i < 4; ++i) out[i] = ((dy[i] * rstd * gw4[i] + gb4[i]) + dot * v[i]) * g[i];
                u32x2 w; w.x = pk2(out[0], out[1]); w.y = pk2(out[2], out[3]); *(u32x2*)(YCAT + (size_t)row * DM + ch) = w;
            }
            {
                const float l0 = LSE[(size_t)row * 4 + hh], l1 = LSE[((size_t)NT + row) * 4 + hh], l2 = LSE[((size_t)2 * NT + row) * 4 + hh];
                const float mx = fmaxf(l0, fmaxf(l1, l2)); float w0 = fexp2(l0 - mx), w1 = fexp2(l1 - mx), w2 = fexp2(l2 - mx); const float inv = 1.f / (w0 + w1 + w2); w0 *= inv; w1 *= inv; w2 *= inv;
                const f32x4 a = *(const f32x4*)(OC + o), bq = *(const f32x4*)(OC + (size_t)NT * 256 + o), c = *(const f32x4*)(OC + (size_t)2 * NT * 256 + o);
                const f32x4 y = a * w0 + bq * w1 + c * w2;
                const float ss = group_sum<16>((y[0] * y[0] + y[1] * y[1]) + (y[2] * y[2] + y[3] * y[3])); const float rstd = rsqrtf(ss * (1.f / 64.f) + 1e-6f);
                const f32x4 og = *(const f32x4*)(C.onorm_g + (size_t)l * 768 + 256 + ch);
                u32x2 w; w.x = pk2(y[0] * rstd * og[0], y[1] * rstd * og[1]); w.y = pk2(y[2] * rstd * og[2], y[3] * rstd * og[3]); *(u32x2*)(YCAT + (size_t)row * DM + 512 + ch) = w;
            }
        }
    }
    __syncthreads();
}

constexpr int CW_Q = 40000;
DI int q_next(const Ctx& C, unsigned* ctr, LAS int* slot) {
    __syncthreads();
    if (C.tid == 0) *slot = (int)__hip_atomic_fetch_add(ctr, 1u, __ATOMIC_RELAXED, __HIP_MEMORY_SCOPE_AGENT);
    __syncthreads();
    return *slot;
}
DI void conv_ticket(const Ctx& C, int l, int tk);
#ifndef PROBE_TS
#define PROBE_TS 0
#endif
constexpr int CW_TS = 50000;
DI void ts_mark(const Ctx& C, int l, int ev) {
#if PROBE_TS
    if (l == 0 && C.tid == 0) { unsigned* w = WSP(unsigned, WS_CTL) + CW_TS; const unsigned t = (unsigned)__builtin_amdgcn_s_memrealtime();
        if (ev == 0) { if (C.bid == 0) __hip_atomic_store(w, t, __ATOMIC_RELAXED, __HIP_MEMORY_SCOPE_AGENT); }
        else if (ev == 6) atomicMax(w + 6, ~t); else atomicMax(w + ev, t); }
#endif
}
DI void mix_phase(const Ctx& C, int l, int rep) {
    unsigned* ctl = WSP(unsigned, WS_CTL) + CW_Q + 64 * 3 * (l + 2 * rep); LAS int* slot = (LAS int*)(C.lds + MISC_OFF + 1024);
    ts_mark(C, l, 0);
    if (C.bid < 96) { scan_unit8(C, C.bid); if (PROBE_SCAN2) scan_unit8(C, C.bid); ts_mark(C, l, 4); }
    int bl = -1;
    const float bnd_cmp = score_bound(C.nsa_q_g + (size_t)l * 64, C.nsa_kc_g + (size_t)l * 64, C.lane), bnd_slc = score_bound(C.nsa_q_g + (size_t)l * 64, C.nsa_ks_g + (size_t)l * 64, C.lane),
                bnd_swa = score_bound(C.nsa_q_g + (size_t)l * 64, C.nsa_kw_g + (size_t)l * 64, C.lane), bnd_dil = score_bound(C.dil_q_g + (size_t)l * 64, C.dil_k_g + (size_t)l * 64, C.lane);
    bool conv_left = true;
#define CONV_ONE() do { if (conv_left) { const int t_ = q_next(C, ctl + 128, slot); if (t_ >= 768 * (1 + PROBE_CONV2)) conv_left = false; else { conv_ticket(C, l, t_ % 768); bl = -1; } } } while (0)
    for (;;) { const int u = q_next(C, ctl, slot); if (u >= 512 * (1 + PROBE_ATT2)) break; nsa_unit(C, l, u & 7, 63 - ((u & 511) >> 3), bl, bnd_cmp, bnd_slc, bnd_swa); CONV_ONE(); }
    ts_mark(C, l, 1);
    for (int n = 0;; ++n) { const int u = q_next(C, ctl + 64, slot); if (u >= 1536 * (1 + PROBE_ATT2)) break; dil_unit(C, u % 1536, C.lds, C.lds + KT_BYTES, bnd_dil); if ((n & 3) == 3) CONV_ONE(); }
    ts_mark(C, l, 2);
    while (conv_left) CONV_ONE();
#undef CONV_ONE
    ts_mark(C, l, 3); if (C.bid >= 96) ts_mark(C, l, 6);
    __syncthreads();
}
#define MFMA_F32(a, b, c) __builtin_amdgcn_mfma_f32_16x16x4f32((a), (b), (c), 0, 0, 0)
DI void router_phase(const Ctx& C, int l) {
    const float* X = C.out; const float* MOD = WSP(float, WS_SMALL) + (size_t)l * 8 * 6144; unsigned char* H8 = WSP(unsigned char, R_XS);
    int* TOPE = WSP(int, WS_ROUTE); float* TOPG = (float*)(TOPE + NT * 4); unsigned* CNTB = WSP(unsigned, WS_CTL) + CW_CNT + l * 8192;
    LAS float* lg = (LAS float*)C.lds + C.wave * 512;
    LAS unsigned* hist = (LAS unsigned*)(C.lds + 16384);
    LAS float* rs = (LAS float*)(C.lds + 16384 + 256) + C.wave * 16;
    const int lane = C.lane, l15 = lane & 15, quad = lane >> 4, gw = C.bid * NWAVE + C.wave, NGW = C.G * NWAVE;
    if (C.tid < 32) hist[C.tid] = 0u;
    __syncthreads();
    const float* wr = C.w_router + (size_t)l * 1024 * 32; const float* g2 = C.norm2_g + (size_t)l * DM;
    for (int task = gw; task < NT / 16; task += NGW) {
        const int row0 = 16 * task, b = row0 / NS;
        const float* shb = MOD + (size_t)b * 6144 + 3072; const float* scb = shb + 1024;
        {
            f32x4 gg[4], sa[4], sb[4];
#pragma unroll
            for (int j = 0; j < 4; ++j) { const int k = 4 * lane + 256 * j; const f32x4 g = *(const f32x4*)(g2 + k), a = *(const f32x4*)(scb + k); gg[j] = g * (a + 1.f); sb[j] = *(const f32x4*)(shb + k); }
#pragma unroll 2
            for (int r = 0; r < 16; ++r) {
                const float* xr = X + (size_t)(row0 + r) * DM + 4 * lane; f32x4 v[4]; float ss = 0.f;
#pragma unroll
                for (int j = 0; j < 4; ++j) { v[j] = *(const f32x4*)(xr + 256 * j); ss += (v[j][0] * v[j][0] + v[j][1] * v[j][1]) + (v[j][2] * v[j][2] + v[j][3] * v[j][3]); }
                ss = group_sum<64>(ss); const float rstd = rsqrtf(ss * (1.f / DM) + 1e-6f);
                if (lane == 0) rs[r] = rstd;
                unsigned char* hp = H8 + (size_t)(row0 + r) * DM + 4 * lane;
#pragma unroll
                for (int j = 0; j < 4; ++j) { const f32x4 h = v[j] * rstd * gg[j] + sb[j]; *(unsigned*)(hp + 256 * j) = pk4_fp8(h[0], h[1], h[2], h[3]); }
            }
        }
        const float* xr = X + (size_t)(row0 + l15) * DM + 4 * quad; const float* sh = shb + 4 * quad; const float* sc = scb + 4 * quad;
        asm volatile("s_waitcnt lgkmcnt(0)" ::: "memory");
        const float rstd = rs[l15];
        f32x4 acc0 = (f32x4){0.f, 0.f, 0.f, 0.f}, acc1 = acc0;
#pragma unroll 2
        for (int i = 0; i < 64; ++i) {
            const f32x4 a = *(const f32x4*)(xr + 16 * i), g = *(const f32x4*)(g2 + 16 * i + 4 * quad), s1 = *(const f32x4*)(sc + 16 * i), s0 = *(const f32x4*)(sh + 16 * i);
            f32x4 h;
#pragma unroll
            for (int j = 0; j < 4; ++j) h[j] = a[j] * rstd * g[j] * (1.f + s1[j]) + s0[j];
            const float* wp = wr + (size_t)(16 * i + 4 * quad) * 32 + l15;
#pragma unroll
            for (int j = 0; j < 4; ++j) { acc0 = MFMA_F32(h[j], wp[j * 32], acc0); acc1 = MFMA_F32(h[j], wp[j * 32 + 16], acc1); }
        }
        const float b0 = C.b_router[l * 32 + l15], b1 = C.b_router[l * 32 + 16 + l15];
#pragma unroll
        for (int j = 0; j < 4; ++j) { lg[(4 * quad + j) * 32 + l15] = acc0[j] + b0; lg[(4 * quad + j) * 32 + 16 + l15] = acc1[j] + b1; }
        asm volatile("s_waitcnt lgkmcnt(0)" ::: "memory");
        if (lane < 16) {
            float v[32];
#pragma unroll
            for (int i = 0; i < 8; ++i) { const f32x4 a = *(const LAS f32x4*)(lg + lane * 32 + 4 * i); v[4 * i] = a[0]; v[4 * i + 1] = a[1]; v[4 * i + 2] = a[2]; v[4 * i + 3] = a[3]; }
            float tv[4]; int ti[4];
#pragma unroll
            for (int r = 0; r < 4; ++r) { float bv = -3.0e38f; int bi = 0;
#pragma unroll
                for (int e = 0; e < 32; ++e) if (v[e] > bv) { bv = v[e]; bi = e; }
                tv[r] = bv; ti[r] = bi;
#pragma unroll
                for (int e = 0; e < 32; ++e) v[e] = (e == bi) ? -3.0e38f : v[e]; }
            const float e1 = __expf(tv[1] - tv[0]), e2 = __expf(tv[2] - tv[0]), e3 = __expf(tv[3] - tv[0]), inv = 1.f / (1.f + e1 + e2 + e3);
            const int row = row0 + lane;
            *(int4*)(TOPE + (size_t)row * 4) = make_int4(ti[0], ti[1], ti[2], ti[3]);
            *(f32x4*)(TOPG + (size_t)row * 4) = (f32x4){inv, e1 * inv, e2 * inv, e3 * inv};
#pragma unroll
            for (int r = 0; r < 4; ++r) __hip_atomic_fetch_add(&hist[ti[r]], 1u, __ATOMIC_RELAXED, __HIP_MEMORY_SCOPE_WORKGROUP);
        }
        asm volatile("s_waitcnt lgkmcnt(0)" ::: "memory");
    }
    __syncthreads();
    if (C.tid < 32) CNTB[C.bid * 32 + C.tid] = hist[C.tid];
}

DI void moe_tables(const Ctx& C, int l, LAS int* tab) {
    const unsigned* CNTB = WSP(unsigned, WS_CTL) + CW_CNT + l * 8192;
    __syncthreads();
    if (C.tid < 32) { unsigned tot = 0u, mine = 0u;
        for (int g = 0; g < C.G; ++g) { const unsigned c = CNTB[g * 32 + C.tid]; tot += c; mine += (g < C.bid) ? c : 0u; }
        tab[128 + C.tid] = (int)((tot + 255u) >> 8); tab[64 + C.tid] = (int)mine; }
    __syncthreads();
    if (C.tid == 0) { int s = 0; for (int e = 0; e < 32; ++e) { tab[e] = s; s += tab[128 + e]; } tab[32] = s; }
    __syncthreads();
}
DI void scatter_phase(const Ctx& C, int l) {
    const int* TOPE = WSP(int, WS_ROUTE); int* POS = (int*)(TOPE + NT * 8); int* ROWMAP = (int*)(TOPE + NT * 12);
    LAS int* tab = (LAS int*)(C.lds + MISC_OFF + 64); LAS unsigned* cur = (LAS unsigned*)(C.lds + 16384);
    moe_tables(C, l, tab);
    if (C.tid < 32) cur[C.tid] = (unsigned)(tab[C.tid] * 256 + tab[64 + C.tid]);
    __syncthreads();
    const int lane = C.lane, gw = C.bid * NWAVE + C.wave, NGW = C.G * NWAVE;
    for (int task = gw; task < NT / 16; task += NGW) {
        const int row0 = 16 * task, tok = row0 + (lane >> 2);
        const int e = TOPE[(size_t)tok * 4 + (lane & 3)];
        const int slot = (int)__hip_atomic_fetch_add(&cur[e], 1u, __ATOMIC_RELAXED, __HIP_MEMORY_SCOPE_WORKGROUP);
        POS[(size_t)tok * 4 + (lane & 3)] = slot; ROWMAP[slot] = tok;
    }
}
DI void combine_phase(const Ctx& C, int l, float* dst) {
    const bf16* YB = WSP(bf16, R_YB); const int* TOPE = WSP(int, WS_ROUTE); const float* TOPG = (const float*)(TOPE + NT * 4); const int* POS = (const int*)(TOPE + NT * 8);
    const float* MOD = WSP(float, WS_SMALL) + (size_t)l * 8 * 6144; bf16* H = WSP(bf16, WS_H);
    const int lane = C.lane, gw = C.bid * NWAVE + C.wave, NGW = C.G * NWAVE;
    for (int task = gw; task < NT / 16; task += NGW) {
        const int row0 = 16 * task, b = row0 / NS; const float* gt = MOD + (size_t)b * 6144 + 5120 + 8 * lane;
        f32x4 g4[4], gg[4], sb[4];
#pragma unroll
        for (int j = 0; j < 2; ++j) { g4[2 * j] = *(const f32x4*)(gt + 512 * j); g4[2 * j + 1] = *(const f32x4*)(gt + 512 * j + 4); }
        if (l + 1 < NLAYER) { const float* M2 = MOD + 8 * 6144 + (size_t)b * 6144 + 8 * lane; const float* g = C.norm1_g + (size_t)(l + 1) * DM + 8 * lane;
#pragma unroll
            for (int j = 0; j < 2; ++j)
#pragma unroll
                for (int hlf = 0; hlf < 2; ++hlf) { const int o = 512 * j + 4 * hlf; gg[2 * j + hlf] = *(const f32x4*)(g + o) * (*(const f32x4*)(M2 + 1024 + o) + 1.f); sb[2 * j + hlf] = *(const f32x4*)(M2 + o); } }
#pragma unroll 2
        for (int r = 0; r < 16; ++r) {
            const int row = row0 + r; const int4 ps = *(const int4*)(POS + (size_t)row * 4); const f32x4 gk = *(const f32x4*)(TOPG + (size_t)row * 4);
            const int pp[4] = {ps.x, ps.y, ps.z, ps.w};
            const float* orow = C.out + (size_t)row * DM + 8 * lane; float* drow = dst + (size_t)row * DM + 8 * lane;
            u32x4 y[4][2]; f32x4 x[4];
#pragma unroll
            for (int q = 0; q < 4; ++q)
#pragma unroll
                for (int j = 0; j < 2; ++j) y[q][j] = *(const u32x4*)(YB + (size_t)pp[q] * DM + 8 * lane + 512 * j);
#pragma unroll
            for (int j = 0; j < 2; ++j) { x[2 * j] = *(const f32x4*)(orow + 512 * j); x[2 * j + 1] = *(const f32x4*)(orow + 512 * j + 4); }
            f32x4 v[4]; float s = 0.f;
#pragma unroll
            for (int j = 0; j < 2; ++j) { f32x4 a0 = (f32x4){0.f, 0.f, 0.f, 0.f}, a1 = a0;
#pragma unroll
                for (int q = 0; q < 4; ++q) { const u32x4 w = y[q][j]; a0 += (f32x4){bflo(w.x), bfhi(w.x), bflo(w.y), bfhi(w.y)} * gk[q]; a1 += (f32x4){bflo(w.z), bfhi(w.z), bflo(w.w), bfhi(w.w)} * gk[q]; }
                v[2 * j] = x[2 * j] + g4[2 * j] * a0; v[2 * j + 1] = x[2 * j + 1] + g4[2 * j + 1] * a1;
#if PROBE_TS
                if (l + 1 == NLAYER) { const unsigned* w = WSP(unsigned, WS_CTL) + CW_TS; const unsigned t0 = w[0]; const unsigned ea = (PROBE_TS_A == 6) ? ~w[6] : w[PROBE_TS_A], eb = (PROBE_TS_B == 6) ? ~w[6] : w[PROBE_TS_B];
                    const float A = (PROBE_TS_A == 7) ? 1.f : (float)((ea - t0) / 4000u) * 0.04f, B = (float)(eb - t0) * 1e-3f;
                    v[2 * j] = v[2 * j] + A; v[2 * j + 1] = v[2 * j + 1] + A; (void)B; }
#endif
                *(f32x4*)(drow + 512 * j) = v[2 * j]; *(f32x4*)(drow + 512 * j + 4) = v[2 * j + 1]; }
#pragma unroll
            for (int i = 0; i < 4; ++i) s += (v[i][0] * v[i][0] + v[i][1] * v[i][1]) + (v[i][2] * v[i][2] + v[i][3] * v[i][3]);
            if (l + 1 < NLAYER) {
                s = group_sum<64>(s); const float rstd = rsqrtf(s * (1.f / DM) + 1e-6f); bf16* hrow = H + (size_t)row * DM + 8 * lane;
#pragma unroll
                for (int j = 0; j < 2; ++j) { const f32x4 h0 = v[2 * j] * rstd * gg[2 * j] + sb[2 * j], h1 = v[2 * j + 1] * rstd * gg[2 * j + 1] + sb[2 * j + 1]; u32x4 o;
                    o.x = pk2(h0[0], h0[1]); o.y = pk2(h0[2], h0[3]); o.z = pk2(h1[0], h1[1]); o.w = pk2(h1[2], h1[3]); *(u32x4*)(hrow + 512 * j) = o; }
            }
        }
    }
}
constexpr int PH_PER_LAYER = 11, PH_BASE = 2, N_PHASES = PH_BASE + NLAYER * PH_PER_LAYER;
#ifndef MK_ONE_LAUNCH
#define MK_ONE_LAUNCH 1
#endif
__global__ void __launch_bounds__(NTHR, 2) mk_fwd(Args args) {
    extern __shared__ __attribute__((aligned(16))) unsigned char lds_raw[];
    Ctx C;
    C.lds = (LAS unsigned char*)lds_raw; C.tid = threadIdx.x; C.lane = C.tid & 63; C.wave = __builtin_amdgcn_readfirstlane(C.tid >> 6); C.G = gridDim.x; C.bid = blockIdx.x;
    C.x = (const float*)args.in[0]; C.c = (const float*)args.in[1]; C.pos = (const int*)args.in[2]; C.w_ada = (const float*)args.in[3]; C.b_ada = (const float*)args.in[4];
    C.norm1_g = (const float*)args.in[5]; C.norm2_g = (const float*)args.in[6]; C.w_in = (const float*)args.in[7]; C.w_out = (const float*)args.in[8]; C.mu = (const float*)args.in[9];
    C.w0 = (const float*)args.in[10]; C.w2 = (const float*)args.in[11]; C.a0 = (const float*)args.in[12]; C.a2 = (const float*)args.in[13]; C.g2 = (const float*)args.in[14];
    C.kkw = (const float*)args.in[15]; C.ka = (const float*)args.in[16]; C.rk = (const float*)args.in[17]; C.gn_w = (const float*)args.in[18]; C.gn_b = (const float*)args.in[19];
    C.conv_w = (const float*)args.in[20]; C.dil_q_g = (const float*)args.in[21]; C.dil_k_g = (const float*)args.in[22]; C.nsa_q_g = (const float*)args.in[23]; C.nsa_kc_g = (const float*)args.in[24];
    C.nsa_ks_g = (const float*)args.in[25]; C.nsa_kw_g = (const float*)args.in[26]; C.pe_k = (const float*)args.in[27]; C.pe_v = (const float*)args.in[28]; C.wk1 = (const float*)args.in[29];
    C.wk2 = (const float*)args.in[30]; C.wv1 = (const float*)args.in[31]; C.wv2 = (const float*)args.in[32]; C.onorm_g = (const float*)args.in[33]; C.w_router = (const float*)args.in[34];
    C.b_router = (const float*)args.in[35]; C.w_gu = (const float*)args.in[36]; C.b_gu = (const float*)args.in[37]; C.w_down = (const float*)args.in[38]; C.b_down = (const float*)args.in[39];
    C.out = args.out; C.ws = args.ws;
    const int lo = args.ph_lo, hi = args.ph_hi;
    for (int u = C.tid; u < (LDS_BYTES - MISC_OFF) / 4; u += NTHR) ((LAS unsigned*)(C.lds + MISC_OFF))[u] = 0u;
    __syncthreads();
    XcdBarrier bar; bar.bar = WSP(unsigned, WS_CTL) + CW_BAR; bar.x = 0; bar.st = nullptr;
    if (hi - lo > 1) bar = xcd_barrier_post(WSP(unsigned, WS_CTL) + CW_BAR, (volatile LAS unsigned*)(C.lds + MISC_OFF));
#ifndef PHMASK
#define PHMASK 0xFFFFFFFFu
#endif
#define PHON(n) (((PHMASK) >> (n)) & 1u)
#ifndef PHREP
#define PHREP 0u
#endif
#define NREP(n) (1 + (int)(((PHREP) >> (n)) & 1u))
#define WSPP(T, off) ((T*)(P.ws + (off)))
#define IN(k) (lo <= (k) && (k) < hi)
#define SEAM(k) do { if (IN(k) && IN((k) + 1)) xcd_barrier(bar); } while (0)
#define PCTX Ctx P = C; asm volatile("" : "+v"(P.tid), "+v"(P.lane)); asm volatile("" : "+s"(P.ws), "+s"(P.out), "+s"(P.wave), "+s"(P.bid))
    if (PHON(17) && IN(0)) for (int rep = 0; rep < NREP(17); ++rep) { PCTX; p0_prologue(P); __syncthreads(); }
    SEAM(0);
#ifndef PROBE_BARS
#define PROBE_BARS 0
#endif
    if (hi - lo > 1) for (int i = 0; i < PROBE_BARS; ++i) xcd_barrier(bar);
    if (PHON(18) && IN(1)) { PCTX; norm1_phase(P, 0, P.x); }
    SEAM(1);
    for (int l = 0; l < NLAYER; ++l) {
        const int pb = PH_BASE + PH_PER_LAYER * l;
        if (PHON(0) && IN(pb + 0)) for (int rep = 0; rep < NREP(0); ++rep) { PCTX;
            pg8::Gemm g{WSPP(bf16, WS_H), WSPP(bf16, WS_WIN) + (size_t)l * NPJ * 1024, 1024, 1024}; pg8::StaticOrder S; S.init(NT / 256, NPJ / 256, P.G, P.bid);
            EpiProj E{WSPP(bf16, R_PROJ)}; pg8::gemm_phase(P.lds, P.tid, g, S, E);
        }
        SEAM(pb + 0);
        if (PHON(1) && IN(pb + 1)) for (int rep = 0; rep < NREP(1); ++rep) { PCTX; prep_phase(P, l); __syncthreads(); }
        SEAM(pb + 1);
        if (PHON(2) && IN(pb + 2)) for (int rep = 0; rep < NREP(2); ++rep) { PCTX;
            { pg8::Gemm g{WSPP(bf16, R_LIN), WSPP(bf16, WS_LORA) + (size_t)l * 768 * 256, 256, 256}; pg8::StaticOrder S; S.init(NT / 256, 3, P.G, P.bid);
              EpiLora E{WSPP(float, R_SC), WSPP(float, R_G), P.w0 + l * 256, P.a0 + l * 256, P.ka + l * 256, (rep + 1 < NREP(2)) ? WSPP(float, WS_END) : WSPP(float, R_SC)}; pg8::gemm_phase(P.lds, P.tid, g, S, E); }
            { pg8::Gemm g{WSPP(bf16, R_KCR), WSPP(bf16, WS_WK1) + (size_t)(l * 2) * 256 * 2048, 1024, 2048}; pg8::StaticOrder S; S.init(8, 1, P.G, (P.bid + 64) % P.G);
              EpiC1 E{WSPP(bf16, R_CH1), (WSPP(float, WS_SMALL) + NLAYER * 8 * 6144 + l * 512)}; pg8::gemm_phase(P.lds, P.tid, g, S, E); }
            { pg8::Gemm g{WSPP(bf16, R_VCR), WSPP(bf16, WS_WK1) + (size_t)(l * 2 + 1) * 256 * 2048, 1024, 2048}; pg8::StaticOrder S; S.init(8, 1, P.G, (P.bid + 128) % P.G);
              EpiC1 E{WSPP(bf16, R_CH1) + 2048 * 256, (WSPP(float, WS_SMALL) + NLAYER * 8 * 6144 + l * 512 + 256)}; pg8::gemm_phase(P.lds, P.tid, g, S, E); }
            asm volatile("s_waitcnt vmcnt(0)" ::: "memory"); __syncthreads();
            { pg8::Gemm g{WSPP(bf16, R_CH1), WSPP(bf16, WS_WK2) + (size_t)(l * 2) * 256 * 256, 256, 256}; pg8::StaticOrder S; S.init(8, 1, P.G, (P.bid + 64) % P.G);
              EpiC2 E{WSPP(float, R_CMP)}; pg8::gemm_phase(P.lds, P.tid, g, S, E); }
            { pg8::Gemm g{WSPP(bf16, R_CH1) + 2048 * 256, WSPP(bf16, WS_WK2) + (size_t)(l * 2 + 1) * 256 * 256, 256, 256}; pg8::StaticOrder S; S.init(8, 1, P.G, (P.bid + 128) % P.G);
              EpiC2 E{WSPP(float, R_CMP) + 2048 * 64}; pg8::gemm_phase(P.lds, P.tid, g, S, E); }
        }
        SEAM(pb + 2);
        if (PHON(3) && IN(pb + 3)) for (int rep = 0; rep < NREP(3); ++rep) { PCTX; mix_phase(P, l, rep); }
        SEAM(pb + 3);
        if (PHON(4) && IN(pb + 4)) for (int rep = 0; rep < NREP(4); ++rep) { PCTX; fin_phase(P, l); __syncthreads(); }
        SEAM(pb + 4);
        if (PHON(5) && IN(pb + 5)) for (int rep = 0; rep < NREP(5); ++rep) { PCTX;
            pg8::Gemm g{WSPP(bf16, R_YCAT), WSPP(bf16, WS_WOUT) + (size_t)l * 1024 * 1024, 1024, 1024}; pg8::StaticOrder S; S.init(NT / 256, 4, P.G, P.bid);
            EpiOut E{(rep + 1 < NREP(5)) ? WSPP(float, WS_END) : P.out, l == 0 ? P.x : (const float*)P.out, WSPP(float, WS_SMALL) + (size_t)l * 8 * 6144 + 2048}; pg8::gemm_phase(P.lds, P.tid, g, S, E);
        }
        SEAM(pb + 5);
        if (PHON(6) && IN(pb + 6)) for (int rep = 0; rep < NREP(6); ++rep) { PCTX; router_phase(P, l); __syncthreads(); }
        SEAM(pb + 6);
        if (PHON(7) && IN(pb + 7)) for (int rep = 0; rep < NREP(7); ++rep) { PCTX; scatter_phase(P, l); __syncthreads(); }
        SEAM(pb + 7);
        if (PHON(8) && IN(pb + 8)) for (int rep = 0; rep < NREP(8); ++rep) { PCTX;
            LAS int* tab = (LAS int*)(P.lds + MISC_OFF + 64); moe_tables(P, l, tab);
            pg8::Gemm g{WSPP(bf16, R_XS), WSPP(bf16, WS_WGU) + (size_t)l * 32 * 2048 * 512, 512, 512, WSPP(int, WS_ROUTE) + NT * 12, 32767};
            pg8::GroupedOrder S; S.init(tab[32], 8, P.G, P.bid); S.tstart = tab; S.nrow_e = 2048;
            EpiGU8 E{WSPP(unsigned char, R_ACT), P.b_gu + (size_t)l * 32 * 2048}; pg8::gemm_phase<EpiGU8, pg8::GroupedOrder, true, true>(P.lds, P.tid, g, S, E);
        }
        SEAM(pb + 8);
        if (PHON(9) && IN(pb + 9)) for (int rep = 0; rep < NREP(9); ++rep) { PCTX;
            LAS int* tab = (LAS int*)(P.lds + MISC_OFF + 64); moe_tables(P, l, tab);
            pg8::Gemm g{WSPP(bf16, R_ACT), WSPP(bf16, WS_WDN) + (size_t)l * 32 * 1024 * 512, 512, 512, WSPP(int, WS_ROUTE) + NT * 12 + NR, 0x3FFFF}; pg8::GroupedOrder S; S.init(tab[32], 4, P.G, P.bid); S.tstart = tab; S.nrow_e = 1024;
            EpiDN8 E{WSPP(bf16, R_YB), P.b_down + (size_t)l * 32 * 1024}; pg8::gemm_phase<EpiDN8, pg8::GroupedOrder, true, true>(P.lds, P.tid, g, S, E);
        }
        SEAM(pb + 9);
        if (PHON(10) && IN(pb + 10)) for (int rep = 0; rep < NREP(10); ++rep) { PCTX; combine_phase(P, l, (rep + 1 < NREP(10)) ? WSPP(float, WS_END) : P.out); __syncthreads(); }
        SEAM(pb + 10);
    }
#undef IN
#undef SEAM
}

extern "C" void kernel_launch(void* const* d_in, const int* in_sizes, int n_in, void* d_out, int out_size, void* d_ws, size_t ws_size, hipStream_t stream) {
    static int grid = 0;
    if (grid == 0) {
        if (n_in != 40 || out_size != NT * DM || ws_size < WS_END + 256 * MiB) { fprintf(stderr, "kernel_launch: unexpected problem (n_in %d, out %d, ws %zu < %zu)\n", n_in, out_size, ws_size, (size_t)WS_END); grid = -1; return; }
        int dev = 0, cus = 0, per_cu = 0;
        if (hipGetDevice(&dev) != hipSuccess || hipDeviceGetAttribute(&cus, hipDeviceAttributeMultiprocessorCount, dev) != hipSuccess) { grid = -1; return; }
        if (hipFuncSetAttribute((const void*)mk_fwd, hipFuncAttributeMaxDynamicSharedMemorySize, LDS_BYTES) != hipSuccess) { fprintf(stderr, "kernel_launch: hipFuncSetAttribute failed\n"); grid = -1; return; }
        if (hipOccupancyMaxActiveBlocksPerMultiprocessor(&per_cu, (const void*)mk_fwd, NTHR, LDS_BYTES) != hipSuccess || per_cu < 1) fprintf(stderr, "kernel_launch: occupancy query says %d blocks per CU\n", per_cu);
        (void)hipGetLastError();
        grid = cus > 256 ? 256 : cus;
    }
    if (grid < 0) return;
    (void)hipMemsetAsync((char*)d_ws, 0, ZERO_BYTES, stream);
    Args a{};
    for (int i = 0; i < 40; ++i) a.in[i] = d_in[i];
    a.out = (float*)d_out; a.ws = (unsigned char*)d_ws;
#if MK_ONE_LAUNCH
    a.ph_lo = 0; a.ph_hi = N_PHASES;
    hipLaunchKernelGGL(mk_fwd, dim3(grid), dim3(NTHR), LDS_BYTES, stream, a);
#else
    for (int p = 0; p < N_PHASES; ++p) { a.ph_lo = p; a.ph_hi = p + 1; hipLaunchKernelGGL(mk_fwd, dim3(grid), dim3(NTHR), LDS_BYTES, stream, a); }
#endif
    const hipError_t le = hipPeekAtLastError();
    if (le != hipSuccess) fprintf(stderr, "kernel_launch: launch failed: %s\n", hipGetErrorName(le));
}
```

```cpp
#include <hip/hip_runtime.h>
#include <cstdio>
#include <cstdint>

#define DI __device__ __forceinline__
#define LAS __attribute__((address_space(3)))
#define GAS __attribute__((address_space(1)))
typedef unsigned short bf16;
typedef short bf16x8 __attribute__((ext_vector_type(8)));
typedef float f32x4 __attribute__((ext_vector_type(4)));
typedef float f32x2 __attribute__((ext_vector_type(2)));
typedef unsigned u32x4 __attribute__((ext_vector_type(4)));
typedef unsigned u32x2 __attribute__((ext_vector_type(2)));
typedef unsigned char uchar;

#ifndef PROBE_TS
#define PROBE_TS 0
#endif
#ifndef PROBE_SCAN2
#define PROBE_SCAN2 0
#endif
#ifndef PROBE_ATT2
#define PROBE_ATT2 0
#endif
#ifndef PROBE_CONV2
#define PROBE_CONV2 0
#endif
#ifndef PROBE_TS_A
#define PROBE_TS_A 6
#endif
#ifndef PROBE_TS_B
#define PROBE_TS_B 6
#endif
constexpr int NB = 8, NS = 4096, NT = NB * NS, DM = 1024, NPJ = 3328, NE = 32, FF = 1024, NLAYER = 2;
constexpr int PJ_A = 0, PJ_B = 1024, PJ_C = 1792, PJ_D = 2560;
constexpr int NR = NT * 4 + NE * 256;
constexpr int NTHR = 512, NWAVE = 8;

DI float bf2f(unsigned v) { return __builtin_bit_cast(float, v << 16); }
DI unsigned f2bf(float f) { unsigned u = __builtin_bit_cast(unsigned, f); return (u + 0x7fffu + ((u >> 16) & 1u)) >> 16; }
DI unsigned pk2(float lo, float hi) { return f2bf(lo) | (f2bf(hi) << 16); }
DI float bflo(unsigned w) { return __builtin_bit_cast(float, w << 16); }
DI float bfhi(unsigned w) { return __builtin_bit_cast(float, w & 0xffff0000u); }
DI float fexp2(float x) { return __builtin_amdgcn_exp2f(x); }
DI float fsigmoid(float x) { return 1.f / (1.f + __expf(-x)); }
DI float wsum_xor(float v, int o) { return v + __shfl_xor(v, o); }
template <int W> DI float group_sum(float v) {
#pragma unroll
    for (int o = 1; o < W; o <<= 1) v += __shfl_xor(v, o);
    return v;
}
DI float dpp_f(float x, const int ctrl_dummy);
template <int CTRL> DI float dppmov(float x) { return __builtin_bit_cast(float, __builtin_amdgcn_update_dpp(0, __builtin_bit_cast(int, x), CTRL, 0xF, 0xF, true)); }
DI float sum8(float x) { x += dppmov<0xB1>(x); x += dppmov<0x4E>(x); x += dppmov<0x141>(x); return x; }

#define XB_TMO      128
#define XB_XCNT(j)  (256  + 64 * (j))
#define XB_XSUB(j)  (1280 + 64 * (j))
#define XB_XGEN(j)  (2304 + 64 * (j))
#define XB_TOP      3328
#define XB_TOPGEN   3392
#define XCD_BAR_WORDS 3456
#define XB_SPIN_CAP (1u << 18)
DI unsigned xb_ld(unsigned* p)              { return __hip_atomic_load(p, __ATOMIC_RELAXED, __HIP_MEMORY_SCOPE_AGENT); }
DI unsigned xb_add(unsigned* p, unsigned v) { return __hip_atomic_fetch_add(p, v, __ATOMIC_RELAXED, __HIP_MEMORY_SCOPE_AGENT); }
DI unsigned xb_xcc_id() { return (unsigned)__builtin_amdgcn_s_getreg((3 << 11) | 20) & 0xFu; }
#define XB_SPIN(cond, bar) do { unsigned _sp = 0; while (cond) { __builtin_amdgcn_s_sleep(1); \
    if ((++_sp & 255u) == 0u) { if (xb_ld(&(bar)[XB_TMO])) break; if (_sp > XB_SPIN_CAP) { atomicAdd(&(bar)[XB_TMO], 1u); break; } } } } while (0)
struct XcdBarrier { unsigned* bar; unsigned x; volatile LAS unsigned* st; };
DI XcdBarrier xcd_barrier_post(unsigned* bar, volatile LAS unsigned* st) {
    XcdBarrier b; b.bar = bar; b.x = xb_xcc_id(); b.st = st;
    if (threadIdx.x == 0) (void)xb_add(&bar[XB_XCNT(b.x)], 1u);
    return b;
}
DI void xcd_barrier_complete(unsigned* bar, unsigned x, unsigned& nloc, unsigned& nx) {
    const unsigned G = gridDim.x * gridDim.y * gridDim.z;
    unsigned sum, cnt, mine, sp = 0u;
    for (;;) {
        sum = 0u; cnt = 0u; mine = 0u;
#pragma unroll
        for (unsigned j = 0; j < 16; ++j) { const unsigned c = xb_ld(&bar[XB_XCNT(j)]); sum += c; cnt += (c > 0u) ? 1u : 0u; mine = (j == x) ? c : mine; }
        if (sum == G) break;
        __builtin_amdgcn_s_sleep(1);
        if ((++sp & 255u) == 0u) { if (xb_ld(&bar[XB_TMO])) break; if (sp > XB_SPIN_CAP) { atomicAdd(&bar[XB_TMO], 1u); break; } }
    }
    nloc = mine > 0u ? mine : 1u; nx = cnt > 0u ? cnt : 1u;
}
DI void xcd_barrier(const XcdBarrier& b) {
    asm volatile("s_waitcnt vmcnt(0)" ::: "memory");
    __syncthreads();
    if (threadIdx.x == 0) {
        unsigned* bar = b.bar;
        __builtin_amdgcn_s_waitcnt(0);
        unsigned nloc = b.st[0], nx = b.st[1];
        if (nloc == 0u) { xcd_barrier_complete(bar, b.x, nloc, nx); b.st[0] = nloc; b.st[1] = nx; }
        const unsigned old = xb_add(&bar[XB_XSUB(b.x)], 1u);
        const unsigned gen = old / nloc;
        if (old + 1u == (gen + 1u) * nloc) {
            __builtin_amdgcn_fence(__ATOMIC_RELEASE, "agent");
            asm volatile("s_waitcnt vmcnt(0)" ::: "memory");
            const unsigned og = xb_add(&bar[XB_TOP], 1u);
            const unsigned tg = og / nx;
            if (og + 1u == (tg + 1u) * nx) xb_add(&bar[XB_TOPGEN], 1u);
            else XB_SPIN(xb_ld(&bar[XB_TOPGEN]) == tg, bar);
            __builtin_amdgcn_fence(__ATOMIC_ACQUIRE, "agent");
            xb_add(&bar[XB_XGEN(b.x)], 1u);
            asm volatile("s_waitcnt vmcnt(0)" ::: "memory");
        } else {
            XB_SPIN(xb_ld(&bar[XB_XGEN(b.x)]) == gen, bar);
            __builtin_amdgcn_fence(__ATOMIC_ACQUIRE, "agent");
            asm volatile("s_waitcnt vmcnt(0)" ::: "memory");
        }
    }
    __syncthreads();
}
namespace pg8 {
constexpr int BM = 256, BK = 64, HALF = 128, HTB = HALF * BK * 2, STAGE_BYTES = 8 * HTB, NXCD = 8, WGM = 8;
__host__ __device__ __forceinline__ int lds_byte(int r, int c) { const int st = (r >> 4) * 2 + (c >> 5), rr = r & 15, cc = c & 31, ob = rr * 64 + cc * 2; return st * 1024 + (ob ^ (((ob >> 9) & 1) << 5)); }
__host__ __device__ __forceinline__ void stage_rc(int b, int& R, int& C) { const int st = b / 1024, sb = b % 1024, swz = sb ^ (((sb >> 9) & 1) << 5); R = (st >> 1) * 16 + swz / 64; C = (st & 1) * 32 + (swz % 64) / 2; }
__host__ __device__ __forceinline__ int perm32(int rho) { const int n = rho >> 4, i = rho & 15; return 8 * (i >> 2) + 4 * n + (i & 3); }

struct Unit { int pm, pn, brow, e; };
struct Gemm { const bf16* A; const bf16* Bt; int lda, K; const int* rowmap; int rowmask; };

struct StaticOrder {
    int nM, nN, nwg, G, c;
    __device__ void init(int nM_, int nN_, int G_, int c_) { nM = nM_; nN = nN_; nwg = nM * nN; G = G_; c = c_; }
    __device__ bool tile(int i, int& pm, int& pn) const {
        const long L = (long)i * G + c; if (L >= nwg) return false;
        int wgid = (int)L; { const int q = nwg / NXCD, r = nwg % NXCD, xcd = wgid % NXCD, off = wgid / NXCD; wgid = (xcd < r ? xcd * (q + 1) : r * (q + 1) + (xcd - r) * q) + off; }
        const int nig = WGM * nN, gid = wgid / nig, fm = gid * WGM, gsz = (nM - fm) < WGM ? (nM - fm) : WGM;
        pm = fm + ((wgid % nig) % gsz); pn = (wgid % nig) / gsz; return true;
    }
    __device__ bool next(int i, Unit& u) const { if (!tile(i, u.pm, u.pn)) return false; u.brow = u.pn * BM; u.e = 0; return true; }
};
struct GroupedOrder : StaticOrder {
    const LAS int* tstart; int nrow_e;
    __device__ bool next(int i, Unit& u) const {
        if (!tile(i, u.pm, u.pn)) return false;
        int e = 0;
#pragma unroll 1
        for (int j = 16; j > 0; j >>= 1) if (tstart[e + j] <= u.pm) e += j;
        u.e = e; u.brow = e * nrow_e + u.pn * BM; return true;
    }
};
DI unsigned cvt_pk_bf16(float lo, float hi) { unsigned r; asm volatile("v_cvt_pk_bf16_f32 %0, %1, %2" : "=v"(r) : "v"(lo), "v"(hi)); return r; }

template <class Epi, class Sched, bool GATHER = false, bool FP8 = false>
DI void gemm_phase(LAS unsigned char* lds, const int tid, const Gemm g, const Sched& S, const Epi& E) {
    const int wid = __builtin_amdgcn_readfirstlane(tid >> 6), lane = tid & 63, wr = wid >> 2, wc = wid & 3, fr = lane & 15, fq = lane >> 4;
    int K = g.K, lda = g.lda; asm volatile("" : "+s"(K), "+s"(lda));
    const int nt = K / BK;
    unsigned voffA[2], voffB[2]; int Ra[2], Ca[2];
#pragma unroll
    for (int i = 0; i < 2; ++i) { int R, C; stage_rc(tid * 16 + i * 8192, R, C); const int Rb = Epi::PERM ? ((R & ~31) + perm32(R & 31)) : R; Ra[i] = R; Ca[i] = C;
        voffA[i] = (unsigned)(R * lda + C) * 2u; voffB[i] = (unsigned)(Rb * K + C) * 2u; }
    unsigned vgc[2][2]; int rawn[2][2];
#define PG8_GLOAD(dst, pm_) do { _Pragma("unroll") for (int _h = 0; _h < 2; ++_h) _Pragma("unroll") for (int _i = 0; _i < 2; ++_i) { const int* _p = g.rowmap + (size_t)(pm_) * BM + _h * HALF + Ra[_i]; \
        asm volatile("global_load_dword %0, %1, off" : "=v"(dst[_h][_i]) : "v"(_p) : "memory"); } } while (0)
#define PG8_GCONV(vg, raw) do { _Pragma("unroll") for (int _h = 0; _h < 2; ++_h) _Pragma("unroll") for (int _i = 0; _i < 2; ++_i) { int _r = raw[_h][_i]; asm volatile("" : "+v"(_r)); \
        vg[_h][_i] = (unsigned)((_r & g.rowmask) * lda + Ca[_i]) * 2u; } } while (0)
#define PG8_STAGE_A(bufoff, kptr, h, vg) do { if (GATHER) PG8_STAGE(bufoff, kptr, vg[h]); else PG8_STAGE(bufoff, (kptr) + (h) * hstepA, voffA); } while (0)
    const size_t kstep = (size_t)(BK * 2);
    const size_t hstepA = (size_t)HALF * lda * 2, hstepB = (size_t)HALF * K * 2;
    const size_t tstepA = 2 * hstepA;
    const unsigned ldsw = (unsigned)wid * 1024u;
    const int aoff = lds_byte(wr * 64 + fr, fq * 8), boff = lds_byte(wc * 32 + fr, fq * 8);
#define PG8_SA(b, h) (((b) * 2 + (h)) * HTB)
#define PG8_SB(b, h) ((4 + (b) * 2 + (h)) * HTB)
#define PG8_STAGE(bufoff, gbase, voff) do { _Pragma("unroll") for (int _i = 0; _i < 2; ++_i) \
        __builtin_amdgcn_global_load_lds((const unsigned*)((const char*)(gbase) + (voff)[_i]), (LAS unsigned*)(lds + (bufoff) + ldsw + _i * 8192), 16, 0, 0); } while (0)
#define PG8_LDA(dst, b, h) do { _Pragma("unroll") for (int m = 0; m < 4; ++m) { const v4i_ lo_ = *(const LAS v4i_*)(lds + PG8_SA(b, h) + aoff + m * 2048), hi_ = *(const LAS v4i_*)(lds + PG8_SA(b, h) + aoff + m * 2048 + 1024); \
        dst[m] = __builtin_shufflevector(lo_, hi_, 0, 1, 2, 3, 4, 5, 6, 7); } } while (0)
#define PG8_LDB(dst, b, h) do { _Pragma("unroll") for (int n = 0; n < 2; ++n) { const v4i_ lo_ = *(const LAS v4i_*)(lds + PG8_SB(b, h) + boff + n * 2048), hi_ = *(const LAS v4i_*)(lds + PG8_SB(b, h) + boff + n * 2048 + 1024); \
        dst[n] = __builtin_shufflevector(lo_, hi_, 0, 1, 2, 3, 4, 5, 6, 7); } } while (0)
#define PG8_MMA(ai, bj, At, Bt) do { __builtin_amdgcn_s_setprio(1); _Pragma("unroll") for (int m = 0; m < 4; ++m) _Pragma("unroll") for (int n = 0; n < 2; ++n) { \
        if (FP8) acc[ai][bj][m][n] = __builtin_amdgcn_mfma_scale_f32_16x16x128_f8f6f4(Bt[n], At[m], acc[ai][bj][m][n], 0, 0, 0, 0x7F7F7F7F, 0, 0x7F7F7F7F); \
        else { const v8i_ b_ = Bt[n], a_ = At[m]; \
            acc[ai][bj][m][n] = __builtin_amdgcn_mfma_f32_16x16x32_bf16(__builtin_bit_cast(bf16x8, __builtin_shufflevector(b_, b_, 0, 1, 2, 3)), __builtin_bit_cast(bf16x8, __builtin_shufflevector(a_, a_, 0, 1, 2, 3)), acc[ai][bj][m][n], 0, 0, 0); \
            acc[ai][bj][m][n] = __builtin_amdgcn_mfma_f32_16x16x32_bf16(__builtin_bit_cast(bf16x8, __builtin_shufflevector(b_, b_, 4, 5, 6, 7)), __builtin_bit_cast(bf16x8, __builtin_shufflevector(a_, a_, 4, 5, 6, 7)), acc[ai][bj][m][n], 0, 0, 0); } } \
        __builtin_amdgcn_s_setprio(0); } while (0)
#define PG8_WAIT_V(n) asm volatile("s_waitcnt vmcnt(" #n ")" ::: "memory")
#define PG8_WAIT_L(n) asm volatile("s_waitcnt lgkmcnt(" #n ")" ::: "memory")
#define PG8_BAR __builtin_amdgcn_s_barrier()
#define PG8_SCHED __builtin_amdgcn_sched_barrier(0)
    Unit cur, nxt; int ui = 0;
    if (!S.next(0, cur)) return;
    f32x4 acc[2][2][4][2];
#pragma unroll
    for (int a = 0; a < 2; ++a)
#pragma unroll
        for (int b = 0; b < 2; ++b)
#pragma unroll
            for (int m = 0; m < 4; ++m)
#pragma unroll
                for (int n = 0; n < 2; ++n) acc[a][b][m][n] = (f32x4){0.f, 0.f, 0.f, 0.f};
    typedef int v8i_ __attribute__((ext_vector_type(8))); typedef int v4i_ __attribute__((ext_vector_type(4)));
    v8i_ At[4], B0[2], B1[2];
    const char* cA = (const char*)g.A + (GATHER ? (size_t)0 : (size_t)cur.pm * tstepA); const char* cB = (const char*)g.Bt + (size_t)cur.brow * K * 2;
    if (GATHER) { PG8_GLOAD(rawn, cur.pm); asm volatile("s_waitcnt vmcnt(0)" : "+v"(rawn[0][0]), "+v"(rawn[0][1]), "+v"(rawn[1][0]), "+v"(rawn[1][1]) :: "memory"); PG8_GCONV(vgc, rawn); }
    PG8_STAGE(PG8_SB(0, 0), cB, voffB); PG8_STAGE(PG8_SB(0, 1), cB + hstepB, voffB); PG8_STAGE_A(PG8_SA(0, 0), cA, 0, vgc); PG8_STAGE_A(PG8_SA(0, 1), cA, 1, vgc);
    if (wr == 1) PG8_BAR;
    PG8_WAIT_V(2); PG8_BAR;
    PG8_STAGE(PG8_SB(1, 0), cB + kstep, voffB); PG8_STAGE_A(PG8_SA(1, 0), cA + kstep, 0, vgc); PG8_STAGE(PG8_SB(1, 1), cB + hstepB + kstep, voffB);
    PG8_WAIT_V(6); PG8_BAR;
    for (;;) {
        const bool has_next = S.next(ui + 1, nxt);
        const char* nA = (has_next && !GATHER) ? (const char*)g.A + (size_t)nxt.pm * tstepA : cA;
        if (GATHER && has_next) PG8_GLOAD(rawn, nxt.pm); const char* nB = has_next ? (const char*)g.Bt + (size_t)nxt.brow * K * 2 : cB;
#pragma unroll 1
        for (int t = 0; t < nt; t += 2) {
            const bool last = (t == nt - 2);
            const char* a1 = cA + (size_t)(t + 1) * kstep;
            const char* a2 = last ? nA : cA + (size_t)(t + 2) * kstep; const char* b2 = last ? nB : cB + (size_t)(t + 2) * kstep;
            const char* a3 = a2 + kstep; const char* b3 = b2 + kstep;
            PG8_LDB(B0, 0, 0); PG8_LDB(B1, 0, 1); PG8_SCHED; PG8_LDA(At, 0, 0); PG8_STAGE_A(PG8_SA(1, 1), a1, 1, vgc);
            if (GATHER) { if (last && has_next) PG8_GCONV(vgc, rawn); }
            PG8_WAIT_V(8); PG8_WAIT_L(0); PG8_BAR; PG8_MMA(0, 0, At, B0); PG8_MMA(0, 1, At, B1); PG8_BAR; PG8_SCHED;
            PG8_LDA(At, 0, 1); PG8_STAGE(PG8_SB(0, 0), b2, voffB); PG8_STAGE(PG8_SB(0, 1), b2 + hstepB, voffB); PG8_STAGE_A(PG8_SA(0, 0), a2, 0, vgc);
            PG8_WAIT_V(8); PG8_WAIT_L(0); PG8_BAR; PG8_MMA(1, 0, At, B0); PG8_MMA(1, 1, At, B1); PG8_BAR; PG8_SCHED;
            PG8_LDB(B0, 1, 0); PG8_LDB(B1, 1, 1); PG8_SCHED; PG8_LDA(At, 1, 0); PG8_STAGE_A(PG8_SA(0, 1), a2, 1, vgc);
            PG8_WAIT_V(8); PG8_WAIT_L(0); PG8_BAR; PG8_MMA(0, 0, At, B0); PG8_MMA(0, 1, At, B1); PG8_BAR; PG8_SCHED;
            PG8_LDA(At, 1, 1); PG8_STAGE(PG8_SB(1, 0), b3, voffB); PG8_STAGE(PG8_SB(1, 1), b3 + hstepB, voffB); PG8_STAGE_A(PG8_SA(1, 0), a3, 0, vgc);
            PG8_WAIT_V(8); PG8_WAIT_L(0); PG8_BAR; PG8_MMA(1, 0, At, B0); PG8_MMA(1, 1, At, B1); PG8_BAR; PG8_SCHED;
        }
        if (wr == 0) PG8_BAR;
        { int fr2 = fr, fq2 = fq; asm volatile("" : "+v"(fr2), "+v"(fq2)); E(acc, cur, wr, wc, fr2, fq2); }
        if (!has_next) break;
#pragma unroll
        for (int a = 0; a < 2; ++a)
#pragma unroll
            for (int b = 0; b < 2; ++b)
#pragma unroll
                for (int m = 0; m < 4; ++m)
#pragma unroll
                    for (int n = 0; n < 2; ++n) acc[a][b][m][n] = (f32x4){0.f, 0.f, 0.f, 0.f};
        cur = nxt; cA = nA; cB = nB; ++ui;
        if (wr == 1) PG8_BAR;
    }
    PG8_WAIT_V(0);
    PG8_BAR;
#undef PG8_SA
#undef PG8_SB
#undef PG8_STAGE
#undef PG8_STAGE_A
#undef PG8_GLOAD
#undef PG8_GCONV
#undef PG8_LDA
#undef PG8_LDB
#undef PG8_MMA
#undef PG8_WAIT_V
#undef PG8_WAIT_L
#undef PG8_BAR
#undef PG8_SCHED
}
}
constexpr size_t MiB = 1u << 20;
constexpr size_t WS_CTL = 0;
constexpr size_t WS_LORA = 1 * MiB;
constexpr size_t WS_WK2 = 2 * MiB;
constexpr size_t ZERO_BYTES = 3 * MiB;
constexpr size_t WS_WIN = 3 * MiB;
constexpr size_t WS_WOUT = 17 * MiB;
constexpr size_t WS_WK1 = 21 * MiB;
constexpr size_t WS_SMALL = 25 * MiB;
constexpr size_t WS_ROUTE = 27 * MiB;
constexpr size_t WS_WGU = 32 * MiB;
constexpr size_t WS_WDN = 288 * MiB;
constexpr size_t WS_H = 416 * MiB;
constexpr size_t WS_R = 480 * MiB;
constexpr size_t R_PROJ = WS_R;
constexpr size_t R_SC = R_PROJ + 208 * MiB;
constexpr size_t R_LIN = R_SC + 192 * MiB;
constexpr size_t R_G = R_LIN + 16 * MiB;
constexpr size_t R_YA = R_G + 32 * MiB;
constexpr size_t R_YCAT = R_YA + 32 * MiB;
constexpr size_t R_QC = R_YCAT + 64 * MiB;
constexpr size_t R_KC = R_QC + 16 * MiB;
constexpr size_t R_OC = R_KC + 16 * MiB;
constexpr size_t R_LSE = R_OC + 96 * MiB;
constexpr size_t R_QN = R_LSE + 2 * MiB;
constexpr size_t R_QR = R_QN + 16 * MiB;
constexpr size_t R_KCR = R_QR + 16 * MiB;
constexpr size_t R_VCR = R_KCR + 5 * MiB;
constexpr size_t R_KS = R_VCR + 5 * MiB;
constexpr size_t R_KW = R_KS + 4 * MiB;
constexpr size_t R_GATE = R_KW + 4 * MiB;
constexpr size_t R_CH1 = R_GATE + 2 * MiB;
constexpr size_t R_CMP = R_CH1 + 2 * MiB;
constexpr size_t R_OCMP = R_CMP + 1 * MiB;
constexpr size_t R_OSLC = R_OCMP + 32 * MiB;
constexpr size_t R_OSWA = R_OSLC + 32 * MiB;
constexpr size_t R_SCANU = R_OSWA;
constexpr size_t R_SCANS = R_OSWA + 16 * MiB;
constexpr size_t R_IMP = R_OSWA + 32 * MiB;
constexpr size_t R_SELM = R_IMP + 8 * MiB;
constexpr size_t R_MIX_END = R_SELM + 1 * MiB;
constexpr size_t R_XS = WS_R;
constexpr size_t R_ACT = R_XS + 272 * MiB;
constexpr size_t R_YB = R_ACT + 272 * MiB;
constexpr size_t R_MOE_END = R_YB + 272 * MiB;
constexpr size_t WS_END = (R_MIX_END > R_MOE_END ? R_MIX_END : R_MOE_END);
static_assert((size_t)NR * 1024 * 2 <= 272 * MiB, "sorted buffers");
constexpr int CW_BAR = 4096;
constexpr int CW_CNT = 16384;
constexpr int CW_CUR = 16384 + 64;

constexpr int RING_BYTES = 131072;
constexpr int MISC_OFF = RING_BYTES;
constexpr int LDS_BYTES = 155648;

struct Args { const void* in[40]; float* out; unsigned char* ws; int ph_lo, ph_hi; };

struct Ctx {
    LAS unsigned char* lds; int tid, lane, wave, G, bid;
    const float *x, *c, *w_ada, *b_ada, *norm1_g, *norm2_g, *w_in, *w_out, *mu, *w0, *w2, *a0, *a2, *g2, *kkw, *ka, *rk, *gn_w, *gn_b, *conv_w, *dil_q_g, *dil_k_g,
        *nsa_q_g, *nsa_kc_g, *nsa_ks_g, *nsa_kw_g, *pe_k, *pe_v, *wk1, *wk2, *wv1, *wv2, *onorm_g, *w_router, *b_router, *w_gu, *b_gu, *w_down, *b_down;
    const int* pos;
    float* out; unsigned char* ws;
};
#define WSP(T, off) ((T*)(C.ws + (off)))

typedef f32x4 Acc[2][2][4][2];
struct EpiProj {
    static constexpr bool PERM = true; bf16* O;
    DI void operator()(const Acc& acc, const pg8::Unit& u, int wr, int wc, int fr, int fq) const {
        const int row0 = u.pm * 256 + wr * 64 + fr, col0 = u.pn * 256 + wc * 32 + 8 * fq;
#pragma unroll
        for (int ai = 0; ai < 2; ++ai)
#pragma unroll
            for (int m = 0; m < 4; ++m) { bf16* rowp = O + (size_t)(row0 + ai * 128 + m * 16) * NPJ + col0;
#pragma unroll
                for (int bj = 0; bj < 2; ++bj) { const f32x4 v0 = acc[ai][bj][m][0], v1 = acc[ai][bj][m][1]; u32x4 w;
                    w.x = pg8::cvt_pk_bf16(v0[0], v0[1]); w.y = pg8::cvt_pk_bf16(v0[2], v0[3]); w.z = pg8::cvt_pk_bf16(v1[0], v1[1]); w.w = pg8::cvt_pk_bf16(v1[2], v1[3]);
                    *(u32x4*)(rowp + bj * 128) = w; } }
    }
};
struct EpiLora {
    static constexpr bool PERM = false; float* SC; float* Gb; const float *w0, *a0, *ka; float* SCo;
    DI void operator()(const Acc& acc, const pg8::Unit& u, int wr, int wc, int fr, int fq) const {
        const int row0 = u.pm * 256 + wr * 64 + fr, col0 = wc * 32 + 4 * fq;
        if (u.pn == 0) {
#pragma unroll
            for (int bj = 0; bj < 2; ++bj)
#pragma unroll
                for (int n = 0; n < 2; ++n) { const int ch = col0 + bj * 128 + n * 16; const f32x4 b = *(const f32x4*)(w0 + ch);
#pragma unroll
                    for (int ai = 0; ai < 2; ++ai)
#pragma unroll
                        for (int m = 0; m < 4; ++m) { const size_t o = (size_t)(row0 + ai * 128 + m * 16) * 256 + ch; const f32x4 v = acc[ai][bj][m][n] + b; f32x4 r;
#pragma unroll
                            for (int j = 0; j < 4; ++j) r[j] = __expf(-0.606531f * fsigmoid(v[j]));
                            *(f32x4*)(SCo + o) = r; } }
        } else if (u.pn == 1) {
#pragma unroll
            for (int bj = 0; bj < 2; ++bj)
#pragma unroll
                for (int n = 0; n < 2; ++n) { const int ch = col0 + bj * 128 + n * 16; const f32x4 b = *(const f32x4*)(a0 + ch), kav = *(const f32x4*)(ka + ch);
#pragma unroll
                    for (int ai = 0; ai < 2; ++ai)
#pragma unroll
                        for (int m = 0; m < 4; ++m) { __builtin_amdgcn_sched_barrier(0); const size_t o = (size_t)(row0 + ai * 128 + m * 16) * 256 + ch; const f32x4 v = acc[ai][bj][m][n] + b;
                            float* pk = SC + (size_t)1 * NT * 256 + o; const f32x4 kr = *(const f32x4*)pk, kn = *(const f32x4*)(SC + (size_t)2 * NT * 256 + o); f32x4 k2, bb;
#pragma unroll
                            for (int j = 0; j < 4; ++j) { const float a = fsigmoid(v[j]); k2[j] = kr[j] * (1.f + (a - 1.f) * kav[j]); bb[j] = kn[j] * a; }
                            *(f32x4*)(SCo + (size_t)1 * NT * 256 + o) = k2; *(f32x4*)(SCo + (size_t)3 * NT * 256 + o) = bb; } }
        } else {
#pragma unroll
            for (int bj = 0; bj < 2; ++bj)
#pragma unroll
                for (int n = 0; n < 2; ++n) { const int ch = col0 + bj * 128 + n * 16;
#pragma unroll
                    for (int ai = 0; ai < 2; ++ai)
#pragma unroll
                        for (int m = 0; m < 4; ++m) { const size_t o = (size_t)(row0 + ai * 128 + m * 16) * 256 + ch; *(f32x4*)(Gb + o) = acc[ai][bj][m][n]; } }
        }
    }
};
DI float gelu_tanh(float x) { const float t = 0.7978845608f * (x + 0.044715f * x * x * x); const float e = __expf(2.f * t); const float th = 1.f - 2.f / (e + 1.f); return 0.5f * x * (1.f + th); }
struct EpiC1 {
    static constexpr bool PERM = true; bf16* O; const float* peb;
    DI void operator()(const Acc& acc, const pg8::Unit& u, int wr, int wc, int fr, int fq) const {
        const int row0 = u.pm * 256 + wr * 64 + fr, col0 = wc * 32 + 8 * fq;
#pragma unroll
        for (int bj = 0; bj < 2; ++bj) { const f32x4 b0 = *(const f32x4*)(peb + col0 + bj * 128), b1 = *(const f32x4*)(peb + col0 + bj * 128 + 4);
#pragma unroll
            for (int ai = 0; ai < 2; ++ai)
#pragma unroll
                for (int m = 0; m < 4; ++m) { bf16* p = O + (size_t)(row0 + ai * 128 + m * 16) * 256 + col0 + bj * 128; const f32x4 v0 = acc[ai][bj][m][0] + b0, v1 = acc[ai][bj][m][1] + b1; u32x4 w;
                    w.x = pk2(gelu_tanh(v0[0]), gelu_tanh(v0[1])); w.y = pk2(gelu_tanh(v0[2]), gelu_tanh(v0[3])); w.z = pk2(gelu_tanh(v1[0]), gelu_tanh(v1[1])); w.w = pk2(gelu_tanh(v1[2]), gelu_tanh(v1[3]));
                    *(u32x4*)p = w; } }
    }
};
struct EpiC2 {
    static constexpr bool PERM = false; float* O;
    DI void operator()(const Acc& acc, const pg8::Unit& u, int wr, int wc, int fr, int fq) const {
        if (wc >= 2) return;
        const int row0 = u.pm * 256 + wr * 64 + fr, col0 = wc * 32 + 4 * fq;
#pragma unroll
        for (int ai = 0; ai < 2; ++ai)
#pragma unroll
            for (int m = 0; m < 4; ++m)
#pragma unroll
                for (int n = 0; n < 2; ++n) *(f32x4*)(O + (size_t)(row0 + ai * 128 + m * 16) * 64 + col0 + n * 16) = acc[ai][0][m][n];
    }
};
struct EpiOut {
    static constexpr bool PERM = false; float* O; const float* xin; const float* gt;
    DI void operator()(const Acc& acc, const pg8::Unit& u, int wr, int wc, int fr, int fq) const {
        const int row0 = u.pm * 256 + wr * 64 + fr, col0 = u.pn * 256 + wc * 32 + 4 * fq; const int b = (u.pm * 256) / NS;
#pragma unroll
        for (int bj = 0; bj < 2; ++bj)
#pragma unroll
            for (int n = 0; n < 2; ++n) { const int col = col0 + bj * 128 + n * 16; const f32x4 g = *(const f32x4*)(gt + (size_t)b * 6144 + col);
#pragma unroll
                for (int ai = 0; ai < 2; ++ai)
#pragma unroll
                    for (int m = 0; m < 4; ++m) { const size_t o = (size_t)(row0 + ai * 128 + m * 16) * DM + col; *(f32x4*)(O + o) = *(const f32x4*)(xin + o) + g * acc[ai][bj][m][n]; } }
    }
};
struct EpiGU {
    static constexpr bool PERM = true; bf16* O; const float* bgu;
    DI void operator()(const Acc& acc, const pg8::Unit& u, int wr, int wc, int fr, int fq) const {
        const int row0 = u.pm * 256 + wr * 64 + fr, cc = u.pn * 128 + wc * 32 + 8 * fq; const float* bp = bgu + (size_t)u.e * 2048 + cc;
        const f32x4 g0 = *(const f32x4*)bp, g1 = *(const f32x4*)(bp + 4), u0 = *(const f32x4*)(bp + 1024), u1 = *(const f32x4*)(bp + 1028);
#pragma unroll
        for (int ai = 0; ai < 2; ++ai)
#pragma unroll
            for (int m = 0; m < 4; ++m) { bf16* p = O + (size_t)(row0 + ai * 128 + m * 16) * FF + cc; float r[8];
#pragma unroll
                for (int n = 0; n < 2; ++n) { const f32x4 gv = acc[ai][0][m][n] + (n ? g1 : g0), uv = acc[ai][1][m][n] + (n ? u1 : u0);
#pragma unroll
                    for (int j = 0; j < 4; ++j) { const float ga = fminf(gv[j], 7.f), up = fminf(fmaxf(uv[j], -7.f), 7.f); r[4 * n + j] = ga * fsigmoid(1.702f * ga) * (up + 1.f); } }
                u32x4 w; w.x = pk2(r[0], r[1]); w.y = pk2(r[2], r[3]); w.z = pk2(r[4], r[5]); w.w = pk2(r[6], r[7]); *(u32x4*)p = w; }
    }
};
struct EpiDN {
    static constexpr bool PERM = true; bf16* O; const float* bd;
    DI void operator()(const Acc& acc, const pg8::Unit& u, int wr, int wc, int fr, int fq) const {
        const int row0 = u.pm * 256 + wr * 64 + fr, col0 = u.pn * 256 + wc * 32 + 8 * fq; const float* bp = bd + (size_t)u.e * 1024 + col0;
#pragma unroll
        for (int bj = 0; bj < 2; ++bj) { const f32x4 b0 = *(const f32x4*)(bp + bj * 128), b1 = *(const f32x4*)(bp + bj * 128 + 4);
#pragma unroll
            for (int ai = 0; ai < 2; ++ai)
#pragma unroll
                for (int m = 0; m < 4; ++m) { bf16* p = O + (size_t)(row0 + ai * 128 + m * 16) * DM + col0 + bj * 128; const f32x4 v0 = acc[ai][bj][m][0] + b0, v1 = acc[ai][bj][m][1] + b1; u32x4 w;
                    w.x = pk2(v0[0], v0[1]); w.y = pk2(v0[2], v0[3]); w.z = pk2(v1[0], v1[1]); w.w = pk2(v1[2], v1[3]); *(u32x4*)p = w; } }
    }
};
DI float clamp8(float x) { return fminf(fmaxf(x, -448.f), 448.f); }
DI unsigned pk4_fp8(float a, float b, float c, float d) { unsigned w = 0u; w = __builtin_amdgcn_cvt_pk_fp8_f32(clamp8(a), clamp8(b), w, false); w = __builtin_amdgcn_cvt_pk_fp8_f32(clamp8(c), clamp8(d), w, true); return w; }
constexpr float W8_SCALE = 32.f, W8_INV = 1.f / 32.f;
struct EpiGU8 {
    static constexpr bool PERM = true; unsigned char* O; const float* bgu;
    DI void operator()(const Acc& acc, const pg8::Unit& u, int wr, int wc, int fr, int fq) const {
        const int row0 = u.pm * 256 + wr * 64 + fr, cc = u.pn * 128 + wc * 32 + 8 * fq; const float* bp = bgu + (size_t)u.e * 2048 + cc;
        const f32x4 g0 = *(const f32x4*)bp, g1 = *(const f32x4*)(bp + 4), u0 = *(const f32x4*)(bp + 1024), u1 = *(const f32x4*)(bp + 1028);
#pragma unroll
        for (int ai = 0; ai < 2; ++ai)
#pragma unroll
            for (int m = 0; m < 4; ++m) { unsigned char* p = O + (size_t)(row0 + ai * 128 + m * 16) * FF + cc; float r[8];
#pragma unroll
                for (int n = 0; n < 2; ++n) { const f32x4 gv = acc[ai][0][m][n] * W8_INV + (n ? g1 : g0), uv = acc[ai][1][m][n] * W8_INV + (n ? u1 : u0);
#pragma unroll
                    for (int j = 0; j < 4; ++j) { const float ga = fminf(gv[j], 7.f), up = fminf(fmaxf(uv[j], -7.f), 7.f); r[4 * n + j] = ga * fsigmoid(1.702f * ga) * (up + 1.f); } }
                u32x2 w; w.x = pk4_fp8(r[0], r[1], r[2], r[3]); w.y = pk4_fp8(r[4], r[5], r[6], r[7]); *(u32x2*)p = w; }
    }
};
struct EpiDN8 {
    static constexpr bool PERM = true; bf16* O; const float* bd;
    DI void operator()(const Acc& acc, const pg8::Unit& u, int wr, int wc, int fr, int fq) const {
        const int row0 = u.pm * 256 + wr * 64 + fr, col0 = u.pn * 256 + wc * 32 + 8 * fq; const float* bp = bd + (size_t)u.e * 1024 + col0;
#pragma unroll
        for (int bj = 0; bj < 2; ++bj) { const f32x4 b0 = *(const f32x4*)(bp + bj * 128), b1 = *(const f32x4*)(bp + bj * 128 + 4);
#pragma unroll
            for (int ai = 0; ai < 2; ++ai)
#pragma unroll
                for (int m = 0; m < 4; ++m) { bf16* p = O + (size_t)(row0 + ai * 128 + m * 16) * DM + col0 + bj * 128; const f32x4 v0 = acc[ai][bj][m][0] * W8_INV + b0, v1 = acc[ai][bj][m][1] * W8_INV + b1; u32x4 w;
                    w.x = pk2(v0[0], v0[1]); w.y = pk2(v0[2], v0[3]); w.z = pk2(v1[0], v1[1]); w.w = pk2(v1[2], v1[3]); *(u32x4*)p = w; } }
    }
};
DI void tr_item(const float* src, int ld_src, int scol0, int nvalid, int k0, bf16* dst, int ld_dst, int drow0, int dk0, LAS float* scr, int lane) {
    const int n4 = (lane & 7) * 4, kr = lane >> 3; f32x4 v[8];
#pragma unroll
    for (int i = 0; i < 8; ++i) v[i] = (n4 < nvalid) ? *(const f32x4*)(src + (size_t)(k0 + kr + 8 * i) * ld_src + scol0 + n4) : (f32x4){0.f, 0.f, 0.f, 0.f};
#pragma unroll
    for (int i = 0; i < 8; ++i) { LAS float* s = scr + (kr + 8 * i) * 33 + n4; s[0] = v[i][0]; s[1] = v[i][1]; s[2] = v[i][2]; s[3] = v[i][3]; }
    asm volatile("s_waitcnt lgkmcnt(0)" ::: "memory");
    const int c = lane & 7;
#pragma unroll
    for (int jq = 0; jq < 4; ++jq) { const int n = (lane >> 3) + 8 * jq; const LAS float* s = scr + (8 * c) * 33 + n;
        u32x4 o; o.x = pk2(s[0 * 33], s[1 * 33]); o.y = pk2(s[2 * 33], s[3 * 33]); o.z = pk2(s[4 * 33], s[5 * 33]); o.w = pk2(s[6 * 33], s[7 * 33]);
        *(u32x4*)(dst + (size_t)(drow0 + n) * ld_dst + dk0 + k0 + 8 * c) = o; }
    asm volatile("s_waitcnt lgkmcnt(0)" ::: "memory");
}
DI void tr_item8(const float* src, int ld_src, int scol0, int k0, unsigned char* dst, int ld_dst, int drow0, LAS float* scr, int lane) {
    const int n4 = (lane & 7) * 4, kr = lane >> 3; f32x4 v[8];
#pragma unroll
    for (int i = 0; i < 8; ++i) v[i] = *(const f32x4*)(src + (size_t)(k0 + kr + 8 * i) * ld_src + scol0 + n4);
#pragma unroll
    for (int i = 0; i < 8; ++i) { LAS float* s = scr + (kr + 8 * i) * 33 + n4; s[0] = v[i][0]; s[1] = v[i][1]; s[2] = v[i][2]; s[3] = v[i][3]; }
    asm volatile("s_waitcnt lgkmcnt(0)" ::: "memory");
    const int c = lane & 7;
#pragma unroll
    for (int jq = 0; jq < 4; ++jq) { const int n = (lane >> 3) + 8 * jq; const LAS float* s = scr + (8 * c) * 33 + n;
        u32x2 o; o.x = pk4_fp8(s[0 * 33] * W8_SCALE, s[1 * 33] * W8_SCALE, s[2 * 33] * W8_SCALE, s[3 * 33] * W8_SCALE); o.y = pk4_fp8(s[4 * 33] * W8_SCALE, s[5 * 33] * W8_SCALE, s[6 * 33] * W8_SCALE, s[7 * 33] * W8_SCALE);
        *(u32x2*)(dst + (size_t)(drow0 + n) * ld_dst + k0 + 8 * c) = o; }
    asm volatile("s_waitcnt lgkmcnt(0)" ::: "memory");
}
DI void conv_item(const Ctx& C, int l, int r, LAS float* scr) {
    constexpr int I_GU = 32 * 16 * 64;
    if (r < I_GU) { const int e = r / 1024, r2 = r % 1024, kb = r2 / 64, nb = r2 % 64, n0 = 32 * nb, j = n0 / 256, i = n0 % 256;
        const int scol0 = (i < 128) ? 128 * j + i : 1024 + 128 * j + (i - 128);
        tr_item8(C.w_gu + (size_t)(l * 32 + e) * 1024 * 2048, 2048, scol0, 64 * kb, WSP(unsigned char, WS_WGU) + (size_t)(l * 32 + e) * 2048 * 1024, 1024, n0, scr, C.lane); }
    else { r -= I_GU; const int e = r / 512, r2 = r % 512, kb = r2 / 32, nb = r2 % 32;
        tr_item8(C.w_down + (size_t)(l * 32 + e) * 1024 * 1024, 1024, 32 * nb, 64 * kb, WSP(unsigned char, WS_WDN) + (size_t)(l * 32 + e) * 1024 * 1024, 1024, 32 * nb, scr, C.lane); }
}
DI void conv_ticket(const Ctx& C, int l, int tk) {
    LAS float* scr = (LAS float*)(C.lds + C.wave * 16384);
    __syncthreads();
#pragma unroll 1
    for (int i = 0; i < 8; ++i) conv_item(C, l, tk * 64 + C.wave * 8 + i, scr);
}
DI void p0_prologue(const Ctx& C) {
    LAS float* scr = (LAS float*)(C.lds + C.wave * 16384);
    const int gw = C.bid * NWAVE + C.wave, NGW = C.G * NWAVE;
    constexpr int I_IN = 16 * 104, I_OUT = 16 * 32, I_LW = 8, I_LA = 8, I_LG = 16, I_K1 = 256, I_K2 = 8;
    constexpr int I_LAYER = I_IN + I_OUT + I_LW + I_LA + I_LG + 2 * I_K1 + 2 * I_K2;
    for (int it = gw; it < NLAYER * I_LAYER; it += NGW) {
        const int l = it / I_LAYER; int r = it % I_LAYER;
        if (r < I_IN) { const int kb = r / 104, nb = r % 104, n0 = 32 * nb; int nv = 3212 - n0; nv = nv < 0 ? 0 : (nv > 32 ? 32 : nv);
            tr_item(C.w_in + (size_t)l * 1024 * 3212, 3212, n0, nv, 64 * kb, WSP(bf16, WS_WIN) + (size_t)l * NPJ * 1024, 1024, n0, 0, scr, C.lane); continue; } r -= I_IN;
        if (r < I_OUT) { const int kb = r / 32, nb = r % 32;
            tr_item(C.w_out + (size_t)l * 1024 * 1024, 1024, 32 * nb, 32, 64 * kb, WSP(bf16, WS_WOUT) + (size_t)l * 1024 * 1024, 1024, 32 * nb, 0, scr, C.lane); continue; } r -= I_OUT;
        bf16* lora = WSP(bf16, WS_LORA) + (size_t)l * 768 * 256;
        if (r < I_LW) { tr_item(C.w2 + (size_t)l * 64 * 256, 256, 32 * r, 32, 0, lora, 256, 32 * r, 0, scr, C.lane); continue; } r -= I_LW;
        if (r < I_LA) { tr_item(C.a2 + (size_t)l * 64 * 256, 256, 32 * r, 32, 0, lora, 256, 256 + 32 * r, 64, scr, C.lane); continue; } r -= I_LA;
        if (r < I_LG) { const int kb = r / 8, nb = r % 8; tr_item(C.g2 + (size_t)l * 128 * 256, 256, 32 * nb, 32, 64 * kb, lora, 256, 512 + 32 * nb, 128, scr, C.lane); continue; } r -= I_LG;
        if (r < 2 * I_K1) { const int kv = r / I_K1, r2 = r % I_K1, kb = r2 / 8, nb = r2 % 8;
            tr_item((kv ? C.wv1 : C.wk1) + (size_t)l * 2048 * 256, 256, 32 * nb, 32, 64 * kb, WSP(bf16, WS_WK1) + (size_t)(l * 2 + kv) * 256 * 2048, 2048, 32 * nb, 0, scr, C.lane); continue; } r -= 2 * I_K1;
        { const int kv = r / I_K2, r2 = r % I_K2, kb = r2 / 2, nb = r2 % 2;
            tr_item((kv ? C.wv2 : C.wk2) + (size_t)l * 256 * 64, 64, 32 * nb, 32, 64 * kb, WSP(bf16, WS_WK2) + (size_t)(l * 2 + kv) * 256 * 256, 256, 32 * nb, 0, scr, C.lane); }
    }
    { int* idm = WSP(int, WS_ROUTE) + NT * 12 + NR; for (int i = C.bid * NTHR + C.tid; i < NR; i += C.G * NTHR) idm[i] = i; }
    __syncthreads();
    float* MOD = WSP(float, WS_SMALL); float* PEB = MOD + NLAYER * 8 * 6144;
    LAS float* sc = (LAS float*)C.lds;
    LAS float* red = sc + 8192;
    for (int it = C.bid; it < 192 + 4; it += C.G) {
        if (it < 192) {
            const int l = it / 96, n0 = (it % 96) * 64;
            for (int i = C.tid; i < 8192; i += NTHR) { const float v = C.c[i]; sc[i] = v / (1.f + __expf(-v)); }
            __syncthreads();
            const int kq = C.tid >> 6, col = C.tid & 63; float a[8];
#pragma unroll
            for (int b = 0; b < 8; ++b) a[b] = 0.f;
            const float* wp = C.w_ada + (size_t)l * 1024 * 6144 + n0 + col;
#pragma unroll 8
            for (int k = kq * 128; k < kq * 128 + 128; ++k) { const float w = wp[(size_t)k * 6144];
#pragma unroll
                for (int b = 0; b < 8; ++b) a[b] += sc[b * 1024 + k] * w; }
#pragma unroll
            for (int b = 0; b < 8; ++b) red[(kq * 8 + b) * 64 + col] = a[b];
            __syncthreads();
            { const int b = C.tid >> 6; float s = C.b_ada[(size_t)l * 6144 + n0 + col];
#pragma unroll
              for (int q = 0; q < 8; ++q) s += red[(q * 8 + b) * 64 + col];
              MOD[((size_t)l * 8 + b) * 6144 + n0 + col] = s; }
            __syncthreads();
        } else {
            const int l = (it - 192) / 2, kv = (it - 192) % 2; const float* pe = (kv ? C.pe_v : C.pe_k) + (size_t)l * 2048; const float* w1 = (kv ? C.wv1 : C.wk1) + (size_t)l * 2048 * 256;
            const int kq = C.tid >> 8, col = C.tid & 255; float a = 0.f;
#pragma unroll 8
            for (int k = kq * 1024; k < kq * 1024 + 1024; ++k) a += pe[k] * w1[(size_t)k * 256 + col];
            red[kq * 256 + col] = a; __syncthreads();
            if (C.tid < 256) PEB[(l * 2 + kv) * 256 + col] = red[col] + red[256 + col];
            __syncthreads();
        }
    }
}

DI void norm_row(const Ctx& C, const float* xrow, const float* g, const float* sh, const float* sc, bf16* orow) {
    f32x4 v[4]; float s = 0.f;
#pragma unroll
    for (int j = 0; j < 4; ++j) { v[j] = *(const f32x4*)(xrow + 4 * C.lane + 256 * j); s += (v[j][0] * v[j][0] + v[j][1] * v[j][1]) + (v[j][2] * v[j][2] + v[j][3] * v[j][3]); }
    s = group_sum<64>(s); const float rstd = rsqrtf(s * (1.f / DM) + 1e-6f);
#pragma unroll
    for (int j = 0; j < 4; ++j) { const int k = 4 * C.lane + 256 * j; const f32x4 gg = *(const f32x4*)(g + k), a = *(const f32x4*)(sc + k), b = *(const f32x4*)(sh + k); f32x4 h;
#pragma unroll
        for (int i = 0; i < 4; ++i) h[i] = v[j][i] * rstd * gg[i] * (1.f + a[i]) + b[i];
        u32x2 o; o.x = pk2(h[0], h[1]); o.y = pk2(h[2], h[3]); *(u32x2*)(orow + k) = o; }
}
DI void norm1_phase(const Ctx& C, int l, const float* xin) {
    const float* MOD = WSP(float, WS_SMALL) + (size_t)l * 8 * 6144; bf16* H = WSP(bf16, WS_H);
    const int gw = C.bid * NWAVE + C.wave, NGW = C.G * NWAVE;
    for (int m = gw; m < NT; m += NGW) { const int b = m / NS; norm_row(C, xin + (size_t)m * DM, C.norm1_g + l * DM, MOD + b * 6144, MOD + b * 6144 + 1024, H + (size_t)m * DM); }
}

constexpr float QSCALE = 0.125f * 1.44269504089f;
DI void prep_phase(const Ctx& C, int l) {
    const bf16* PROJ = WSP(bf16, R_PROJ); float* SC = WSP(float, R_SC); bf16* LIN = WSP(bf16, R_LIN); bf16* YCAT = WSP(bf16, R_YCAT);
    bf16 *QC = WSP(bf16, R_QC), *KC = WSP(bf16, R_KC), *QN = WSP(bf16, R_QN), *QR = WSP(bf16, R_QR), *KCR = WSP(bf16, R_KCR), *VCR = WSP(bf16, R_VCR), *KS = WSP(bf16, R_KS), *KW = WSP(bf16, R_KW);
    float* GATE = WSP(float, R_GATE);
    const int lane = C.lane, gw = C.bid * NWAVE + C.wave, NGW = C.G * NWAVE;
    const int hh = lane >> 4, jj = lane & 15;
    const float inv0 = exp2f(-(float)(2 * jj) * (13.287712379549449f / 32.f)) * 0.15915494309189535f, inv1 = exp2f(-(float)(2 * jj + 1) * (13.287712379549449f / 32.f)) * 0.15915494309189535f;
    for (int task = gw; task < NT / 16; task += NGW) {
        const int row0 = 16 * task, s0 = row0 % NS;
        {
            const int c0 = 16 * lane, cc = (c0 - 256) & 255; float mu16[16], kw16[16];
#pragma unroll
            for (int q = 0; q < 4; ++q) { const f32x4 m4 = *(const f32x4*)(C.mu + (size_t)l * 1024 + c0 + 4 * q), k4 = *(const f32x4*)(C.kkw + (size_t)l * 256 + cc + 4 * q);
#pragma unroll
                for (int i = 0; i < 4; ++i) { mu16[4 * q + i] = m4[i]; kw16[4 * q + i] = k4[i]; } }
#pragma unroll 2
            for (int r = 0; r < 16; ++r) {
                const int row = row0 + r; const bf16* pr = PROJ + (size_t)row * NPJ; float z[16];
                const u32x4 c0v = *(const u32x4*)(pr + c0), c1v = *(const u32x4*)(pr + c0 + 8);
                u32x4 p0v = (u32x4){0u, 0u, 0u, 0u}, p1v = p0v;
                if (s0 + r > 0) { p0v = *(const u32x4*)(pr - NPJ + c0); p1v = *(const u32x4*)(pr - NPJ + c0 + 8); }
                const unsigned cw[8] = {c0v.x, c0v.y, c0v.z, c0v.w, c1v.x, c1v.y, c1v.z, c1v.w}, pw[8] = {p0v.x, p0v.y, p0v.z, p0v.w, p1v.x, p1v.y, p1v.z, p1v.w};
#pragma unroll
                for (int e = 0; e < 16; ++e) { const float cu = (e & 1) ? bfhi(cw[e >> 1]) : bflo(cw[e >> 1]), pv = (e & 1) ? bfhi(pw[e >> 1]) : bflo(pw[e >> 1]); z[e] = cu + (pv - cu) * mu16[e]; }
                float kk[16]; float ss = 0.f;
#pragma unroll
                for (int e = 0; e < 16; ++e) { kk[e] = z[e] * kw16[e]; ss += kk[e] * kk[e]; }
                ss = group_sum<4>(ss); const float kinv = rsqrtf(ss + 1e-12f);
                if (lane < 48) {
                    const int vec = lane < 16 ? 4 : (lane < 32 ? 1 : 5); float* dst = SC + ((size_t)vec * NT + row) * 256 + (c0 & 255);
#pragma unroll
                    for (int q = 0; q < 4; ++q) *(f32x4*)(dst + 4 * q) = (f32x4){z[4 * q], z[4 * q + 1], z[4 * q + 2], z[4 * q + 3]};
                    if (lane >= 16 && lane < 32) { float* d2 = SC + ((size_t)2 * NT + row) * 256 + cc;
#pragma unroll
                        for (int q = 0; q < 4; ++q) *(f32x4*)(d2 + 4 * q) = (f32x4){kk[4 * q] * kinv, kk[4 * q + 1] * kinv, kk[4 * q + 2] * kinv, kk[4 * q + 3] * kinv}; }
                } else {
                    float t[16];
#pragma unroll
                    for (int i = 0; i < 16; ++i) { const float sg = fsigmoid(lane < 52 ? 2.f * z[i] : z[i]); t[i] = lane < 52 ? 2.f * sg - 1.f : (lane < 56 ? z[i] : sg); }
                    bf16* dst = LIN + (size_t)row * 256 + (c0 - 768);
                    u32x4 o0, o1; o0.x = pk2(t[0], t[1]); o0.y = pk2(t[2], t[3]); o0.z = pk2(t[4], t[5]); o0.w = pk2(t[6], t[7]); o1.x = pk2(t[8], t[9]); o1.y = pk2(t[10], t[11]); o1.z = pk2(t[12], t[13]); o1.w = pk2(t[14], t[15]);
                    *(u32x4*)dst = o0; *(u32x4*)(dst + 8) = o1;
                }
            }
        }
        {
            const int ch = 4 * lane; const float* cw = C.conv_w + (size_t)l * 3 * 256 + ch; const f32x4 w0 = *(const f32x4*)cw, w1 = *(const f32x4*)(cw + 256), w2 = *(const f32x4*)(cw + 512);
            const f32x4 og = *(const f32x4*)(C.onorm_g + (size_t)l * 768 + ch);
#pragma unroll 2
            for (int r = 0; r < 16; ++r) {
                const int row = row0 + r, s = s0 + r; const bf16* pr = PROJ + (size_t)row * NPJ; float u[3][4];
#pragma unroll
                for (int d = 0; d < 3; ++d) {
                    u32x2 cg = (u32x2){0u, 0u}, xi = cg;
                    if (s >= d) { cg = *(const u32x2*)(pr - (size_t)d * NPJ + PJ_B + 256 + ch); xi = *(const u32x2*)(pr - (size_t)d * NPJ + PJ_B + 512 + ch); }
                    u[d][0] = bflo(cg.x) * bflo(xi.x); u[d][1] = bfhi(cg.x) * bfhi(xi.x); u[d][2] = bflo(cg.y) * bflo(xi.y); u[d][3] = bfhi(cg.y) * bfhi(xi.y);
                }
                const u32x2 bgv = *(const u32x2*)(pr + PJ_B + ch); const float bg[4] = {bflo(bgv.x), bfhi(bgv.x), bflo(bgv.y), bfhi(bgv.y)};
                float y[4]; float ss = 0.f;
#pragma unroll
                for (int i = 0; i < 4; ++i) { y[i] = bg[i] * (w0[i] * u[2][i] + w1[i] * u[1][i] + w2[i] * u[0][i]); ss += y[i] * y[i]; }
                ss = group_sum<16>(ss); const float rstd = rsqrtf(ss * (1.f / 64.f) + 1e-6f);
                u32x2 o; o.x = pk2(y[0] * rstd * og[0], y[1] * rstd * og[1]); o.y = pk2(y[2] * rstd * og[2], y[3] * rstd * og[3]);
                *(u32x2*)(YCAT + (size_t)row * DM + 256 + ch) = o;
            }
        }
        {
            const float* gq = C.dil_q_g + (size_t)l * 64; const float* gk = C.dil_k_g + (size_t)l * 64; const float* gn = C.nsa_q_g + (size_t)l * 64; const float* gv = (hh == 0 ? C.nsa_ks_g : C.nsa_kw_g) + (size_t)l * 64;
            float Gq[4], Gk[4], Gn[4], Gv[4];
#pragma unroll
            for (int i = 0; i < 4; ++i) { const int d = (i >> 1) * 32 + 2 * jj + (i & 1); Gq[i] = gq[d] * QSCALE; Gk[i] = gk[d]; Gn[i] = gn[d] * QSCALE; Gv[i] = gv[d]; }
            const int vcol = hh == 0 ? 2944 : (hh == 1 ? 3072 : (hh == 2 ? 2816 : 2880));
            bf16* vdst = (hh == 0 ? KS : (hh == 1 ? KW : (hh == 2 ? KCR : VCR)));
#pragma unroll 2
            for (int r = 0; r < 16; ++r) {
                const int row = row0 + r; const bf16* pr = PROJ + (size_t)row * NPJ;
                const float posf = (float)C.pos[row];
                const float x0 = __builtin_amdgcn_fractf(posf * inv0), x1 = __builtin_amdgcn_fractf(posf * inv1);
                const float sn0 = __builtin_amdgcn_sinf(x0), cs0 = __builtin_amdgcn_cosf(x0), sn1 = __builtin_amdgcn_sinf(x1), cs1 = __builtin_amdgcn_cosf(x1);
                const unsigned qa = *(const unsigned*)(pr + PJ_C + hh * 64 + 2 * jj), qb = *(const unsigned*)(pr + PJ_C + hh * 64 + 32 + 2 * jj);
                const unsigned ka = *(const unsigned*)(pr + PJ_C + 256 + hh * 64 + 2 * jj), kb = *(const unsigned*)(pr + PJ_C + 256 + hh * 64 + 32 + 2 * jj);
                const unsigned na = *(const unsigned*)(pr + PJ_D + hh * 64 + 2 * jj), nb = *(const unsigned*)(pr + PJ_D + hh * 64 + 32 + 2 * jj);
                const unsigned va = *(const unsigned*)(pr + vcol + 2 * jj), vb = *(const unsigned*)(pr + vcol + 32 + 2 * jj);
                float gate_in = 0.f; if (lane < 12) gate_in = bf2f(pr[3200 + lane]);
#define ROPE_NORM(a, b, G, o1, o2, n1a, n1b, n2a, n2b) \
                float n1a = bflo(a), n1b = bfhi(a), n2a = bflo(b), n2b = bfhi(b); { const float ss_ = group_sum<16>(n1a * n1a + n1b * n1b + n2a * n2a + n2b * n2b); const float rs_ = rsqrtf(ss_ * (1.f / 64.f) + 1e-6f); \
                    n1a *= rs_ * G[0]; n1b *= rs_ * G[1]; n2a *= rs_ * G[2]; n2b *= rs_ * G[3]; } \
                const unsigned o1 = pk2(n1a * cs0 - n2a * sn0, n1b * cs1 - n2b * sn1), o2 = pk2(n2a * cs0 + n1a * sn0, n2b * cs1 + n1b * sn1);
                ROPE_NORM(qa, qb, Gq, q1, q2, q1a, q1b, q2a, q2b)
                ROPE_NORM(ka, kb, Gk, k1, k2, k1a, k1b, k2a, k2b)
                ROPE_NORM(na, nb, Gn, r1, r2, r1a, r1b, r2a, r2b)
                ROPE_NORM(va, vb, Gv, v1, v2, v1a, v1b, v2a, v2b)
#undef ROPE_NORM
                bf16* o = QC + (size_t)row * 256 + hh * 64 + 2 * jj; *(unsigned*)o = q1; *(unsigned*)(o + 32) = q2;
                o = KC + (size_t)row * 256 + hh * 64 + 2 * jj; *(unsigned*)o = k1; *(unsigned*)(o + 32) = k2;
                o = QN + (size_t)row * 256 + hh * 64 + 2 * jj; *(unsigned*)o = pk2(r1a, r1b); *(unsigned*)(o + 32) = pk2(r2a, r2b);
                o = QR + (size_t)row * 256 + hh * 64 + 2 * jj; *(unsigned*)o = r1; *(unsigned*)(o + 32) = r2;
                o = vdst + (size_t)row * 64 + 2 * jj; *(unsigned*)o = (hh >= 2) ? va : v1; *(unsigned*)(o + 32) = (hh >= 2) ? vb : v2;
                if (lane < 12) GATE[(size_t)row * 12 + lane] = fsigmoid(gate_in);
            }
        }
    }
}
constexpr int SCAN_TC = 16;
DI void scan_unit8(const Ctx& C, int u) {
    const float* SC = WSP(float, R_SC); float* YA = WSP(float, R_YA); float* UB = WSP(float, R_SCANU); float* SMT = WSP(float, R_SCANS);
    const int pair = u / 3, kind = u % 3, b = pair >> 2, h = pair & 3, tid = C.tid;
    LAS float* buf = (LAS float*)C.lds;
    LAS float* ybuf = buf + 2 * 6144;
    const int row = tid >> 3, cg = tid & 7, tbase = kind == 0 ? 0 : NS / 2;
    const float vm = kind == 2 ? 0.f : 1.f;
    f32x4 ldA[3], ldB[3];
#define SCAN_LOAD(ld, chunk) do { _Pragma("unroll") for (int i = 0; i < 3; ++i) { const int idx = tid + 512 * i, step = idx / 96, rem = idx % 96, vec = rem >> 4, f4 = rem & 15; \
        ld[i] = *(const f32x4*)(SC + ((size_t)vec * NT + (size_t)b * NS + tbase + (chunk) * SCAN_TC + step) * 256 + h * 64 + f4 * 4); } } while (0)
#define SCAN_STORE(ld, slot) do { _Pragma("unroll") for (int i = 0; i < 3; ++i) *(LAS f32x4*)(buf + (slot) * 6144 + (tid + 512 * i) * 4) = ld[i]; } while (0)
#define SCAN_FLUSH(chunk) do { _Pragma("unroll") for (int i = 0; i < 2; ++i) { const int i2 = tid + 512 * i, step = i2 >> 6, rr = i2 & 63; const float yv = ybuf[((chunk) & 1) * 1024 + i2]; \
        if (kind == 2) UB[((size_t)b * (NS / 2) + (chunk) * SCAN_TC + step) * 256 + h * 64 + rr] = yv; else YA[((size_t)b * NS + tbase + (chunk) * SCAN_TC + step) * 256 + h * 64 + rr] = yv; } } while (0)
    __syncthreads();
    SCAN_LOAD(ldA, 0); SCAN_STORE(ldA, 0); SCAN_LOAD(ldB, 1); SCAN_LOAD(ldA, 2);
    f32x2 S[4];
#pragma unroll
    for (int c = 0; c < 4; ++c) { S[c][0] = (kind == 2 && row == 8 * cg + 2 * c) ? 1.f : 0.f; S[c][1] = (kind == 2 && row == 8 * cg + 2 * c + 1) ? 1.f : 0.f; }
    constexpr int NCH = (NS / 2) / SCAN_TC;
#pragma unroll 2
    for (int ck = 0; ck < NCH; ++ck) {
        __syncthreads();
        if (ck & 1) { if (ck + 1 < NCH) SCAN_STORE(ldA, (ck + 1) & 1); if (ck + 3 < NCH) SCAN_LOAD(ldA, ck + 3); }
        else        { if (ck + 1 < NCH) SCAN_STORE(ldB, (ck + 1) & 1); if (ck + 3 < NCH) SCAN_LOAD(ldB, ck + 3); }
        {
            const LAS float* bp = buf + (ck & 1) * 6144; LAS float* yb = ybuf + (ck & 1) * 1024 + row;
#define SCAN_LDS(X, step) do { const LAS float* sp = bp + (step) * 384 + 8 * cg; X.w0 = *(const LAS f32x4*)(sp); X.w1 = *(const LAS f32x4*)(sp + 4); X.k0 = *(const LAS f32x4*)(sp + 64); X.k1 = *(const LAS f32x4*)(sp + 68); \
                X.q0 = *(const LAS f32x4*)(sp + 128); X.q1 = *(const LAS f32x4*)(sp + 132); X.b0 = *(const LAS f32x4*)(sp + 192); X.b1 = *(const LAS f32x4*)(sp + 196); \
                X.r0 = *(const LAS f32x4*)(sp + 256); X.r1 = *(const LAS f32x4*)(sp + 260); X.v = bp[(step) * 384 + 320 + row] * vm; } while (0)
#define SCAN_STEP(X, step) do { \
                f32x2 d2 = S[0] * (f32x2){X.q0[0], X.q0[1]}; d2 = S[1] * (f32x2){X.q0[2], X.q0[3]} + d2; d2 = S[2] * (f32x2){X.q1[0], X.q1[1]} + d2; d2 = S[3] * (f32x2){X.q1[2], X.q1[3]} + d2; \
                const float sa = -sum8(d2[0] + d2[1]); const f32x2 sa2 = (f32x2){sa, sa}, v2 = (f32x2){X.v, X.v}; \
                S[0] = S[0] * (f32x2){X.w0[0], X.w0[1]} + (sa2 * (f32x2){X.b0[0], X.b0[1]} + v2 * (f32x2){X.k0[0], X.k0[1]}); \
                S[1] = S[1] * (f32x2){X.w0[2], X.w0[3]} + (sa2 * (f32x2){X.b0[2], X.b0[3]} + v2 * (f32x2){X.k0[2], X.k0[3]}); \
                S[2] = S[2] * (f32x2){X.w1[0], X.w1[1]} + (sa2 * (f32x2){X.b1[0], X.b1[1]} + v2 * (f32x2){X.k1[0], X.k1[1]}); \
                S[3] = S[3] * (f32x2){X.w1[2], X.w1[3]} + (sa2 * (f32x2){X.b1[2], X.b1[3]} + v2 * (f32x2){X.k1[2], X.k1[3]}); \
                f32x2 y2 = S[0] * (f32x2){X.r0[0], X.r0[1]}; y2 = S[1] * (f32x2){X.r0[2], X.r0[3]} + y2; y2 = S[2] * (f32x2){X.r1[0], X.r1[1]} + y2; y2 = S[3] * (f32x2){X.r1[2], X.r1[3]} + y2; \
                const float yy = sum8(y2[0] + y2[1]); if (cg == 0) yb[(step) * 64] = yy; } while (0)
            struct StepIn { f32x4 w0, w1, k0, k1, q0, q1, b0, b1, r0, r1; float v; } A, B;
            SCAN_LDS(A, 0);
#pragma unroll 2
            for (int step = 0; step < SCAN_TC; step += 2) {
                SCAN_LDS(B, step + 1);
                __builtin_amdgcn_sched_barrier(0);
                SCAN_STEP(A, step);
                __builtin_amdgcn_sched_barrier(0);
                if (step + 2 < SCAN_TC) SCAN_LDS(A, step + 2);
                __builtin_amdgcn_sched_barrier(0);
                SCAN_STEP(B, step + 1);
                __builtin_amdgcn_sched_barrier(0);
            }
#undef SCAN_LDS
#undef SCAN_STEP
        }
        if (ck > 0) SCAN_FLUSH(ck - 1);
    }
    __syncthreads();
    SCAN_FLUSH(NCH - 1);
    if (kind == 0) {
        float* o = SMT + (size_t)pair * 4096 + row;
#pragma unroll
        for (int c = 0; c < 4; ++c) { o[(8 * cg + 2 * c) * 64] = S[c][0]; o[(8 * cg + 2 * c + 1) * 64] = S[c][1]; }
    }
#undef SCAN_LOAD
#undef SCAN_STORE
#undef SCAN_FLUSH
    __syncthreads();
}

constexpr int KROW = 144, KT_BYTES = 64 * KROW;
#define MFMA16(a, b, c) __builtin_amdgcn_mfma_f32_16x16x32_bf16((a), (b), (c), 0, 0, 0)
template <int NQT> struct FA { f32x4 O[NQT][4]; float l[NQT]; float negM; };
template <int NQT> DI void fa_init(FA<NQT>& st) {
#pragma unroll
    for (int q = 0; q < NQT; ++q) { st.l[q] = 0.f;
#pragma unroll
        for (int d = 0; d < 4; ++d) st.O[q][d] = (f32x4){0.f, 0.f, 0.f, 0.f}; }
}
DI bf16x8 pack8(const f32x4& a, const f32x4& b) { u32x4 w; w.x = pk2(a[0], a[1]); w.y = pk2(a[2], a[3]); w.z = pk2(b[0], b[1]); w.w = pk2(b[2], b[3]); return __builtin_bit_cast(bf16x8, w); }
struct VFrag { u32x2 a[4], b[4]; };
DI void vt_issue(VFrag& f, unsigned vaddr) {
    asm volatile("ds_read_b64_tr_b16 %0, %8\n\tds_read_b64_tr_b16 %1, %8 offset:2304\n\tds_read_b64_tr_b16 %2, %8 offset:32\n\tds_read_b64_tr_b16 %3, %8 offset:2336\n\t"
                 "ds_read_b64_tr_b16 %4, %8 offset:64\n\tds_read_b64_tr_b16 %5, %8 offset:2368\n\tds_read_b64_tr_b16 %6, %8 offset:96\n\tds_read_b64_tr_b16 %7, %8 offset:2400"
                 : "=&v"(f.a[0]), "=&v"(f.b[0]), "=&v"(f.a[1]), "=&v"(f.b[1]), "=&v"(f.a[2]), "=&v"(f.b[2]), "=&v"(f.a[3]), "=&v"(f.b[3]) : "v"(vaddr) : "memory");
}
DI void vt_wait(VFrag& f) { asm volatile("s_waitcnt lgkmcnt(0)" : "+v"(f.a[0]), "+v"(f.b[0]), "+v"(f.a[1]), "+v"(f.b[1]), "+v"(f.a[2]), "+v"(f.b[2]), "+v"(f.a[3]), "+v"(f.b[3]) :: "memory"); }
DI bf16x8 vt_get(const VFrag& f, int d) { return __builtin_bit_cast(bf16x8, ((u32x4){f.a[d].x, f.a[d].y, f.b[d].x, f.b[d].y})); }
template <int NQT, bool MASKED, class MaskF>
DI void fa_tile(FA<NQT>& st, const bf16x8 (&Q)[NQT][2], const LAS uchar* Ks, const LAS uchar* Vs, int lane, const MaskF& allowed, const bool (&act)[NQT]) {
    const int l15 = lane & 15, quad = lane >> 4;
    f32x4 S[NQT][4]; const f32x4 sinit = (f32x4){st.negM, st.negM, st.negM, st.negM};
#pragma unroll
    for (int kt = 0; kt < 4; ++kt) {
        const bf16x8 k0 = *(const LAS bf16x8*)(Ks + (16 * kt + l15) * KROW + quad * 16), k1 = *(const LAS bf16x8*)(Ks + (16 * kt + l15) * KROW + 64 + quad * 16);
#pragma unroll
        for (int q = 0; q < NQT; ++q) if (act[q]) { S[q][kt] = MFMA16(k0, Q[q][0], sinit); S[q][kt] = MFMA16(k1, Q[q][1], S[q][kt]); }
    }
    const unsigned vaddr = (unsigned)(size_t)(Vs + (4 * quad + (l15 >> 2)) * KROW + 8 * (l15 & 3));
    VFrag v0, v1; vt_issue(v0, vaddr); vt_issue(v1, vaddr + 32 * KROW);
#pragma unroll
    for (int q = 0; q < NQT; ++q) if (act[q]) {
        float rs = 0.f;
#pragma unroll
        for (int kt = 0; kt < 4; ++kt)
#pragma unroll
            for (int j = 0; j < 4; ++j) { float p = fexp2(S[q][kt][j]); if (MASKED) p = allowed(q, 16 * kt + 4 * quad + j) ? p : 0.f; S[q][kt][j] = p; rs += p; }
        st.l[q] += rs;
    }
    vt_wait(v0); vt_wait(v1);
#pragma unroll
    for (int q = 0; q < NQT; ++q) if (act[q]) {
        const bf16x8 p0 = pack8(S[q][0], S[q][1]), p1 = pack8(S[q][2], S[q][3]);
#pragma unroll
        for (int d = 0; d < 4; ++d) { st.O[q][d] = MFMA16(vt_get(v0, d), p0, st.O[q][d]); st.O[q][d] = MFMA16(vt_get(v1, d), p1, st.O[q][d]); }
    }
}
template <int NQT> DI void fa_finish(FA<NQT>& st, float (&lse2)[NQT]) {
#pragma unroll
    for (int q = 0; q < NQT; ++q) { float l = st.l[q]; l += __shfl_xor(l, 16); l += __shfl_xor(l, 32); const float inv = l > 0.f ? 1.f / l : 0.f; lse2[q] = __log2f(fmaxf(l, 1e-37f));
#pragma unroll
        for (int d = 0; d < 4; ++d) st.O[q][d] = st.O[q][d] * inv; }
}
DI float score_bound(const float* gq, const float* gk, int lane) {
    float a = fabsf(gq[lane & 63]), b = fabsf(gk[lane & 63]);
#pragma unroll
    for (int o = 1; o < 64; o <<= 1) { a = fmaxf(a, __shfl_xor(a, o)); b = fmaxf(b, __shfl_xor(b, o)); }
    return 64.f * a * b * QSCALE * 1.02f + 0.5f;
}
DI void kv_store(LAS uchar* Ks, LAS uchar* Vs, int tid, const u32x4& kr, const u32x4& vr) {
    const int o = (tid >> 3) * KROW + (tid & 7) * 16; *(LAS u32x4*)(Ks + o) = kr; *(LAS u32x4*)(Vs + o) = vr;
}
DI void q_load(bf16x8 (&Q)[2], const bf16* qrow, int quad) { Q[0] = *(const bf16x8*)(qrow + 8 * quad); Q[1] = *(const bf16x8*)(qrow + 32 + 8 * quad); }

struct DilMask { int qi[2]; int k0; DI bool operator()(int q, int key) const { const int ki = k0 + key, d = qi[q] - ki; return ki >= 0 && d >= 0 && d <= 128; } };
DI void dil_unit(const Ctx& C, int unit, LAS uchar* Ks, LAS uchar* Vs, float negM_bound) {
    const bf16 *QC = WSP(bf16, R_QC), *KC = WSP(bf16, R_KC), *PROJ = WSP(bf16, R_PROJ); float* OC = WSP(float, R_OC); float* LSE = WSP(float, R_LSE);
    int tid = C.tid, lane = C.lane; asm volatile("" : "+v"(tid), "+v"(lane));
    const int w = C.wave, l15 = lane & 15, quad = lane >> 4;
    const int cfg = unit / 512, r = unit % 512, dsh = 2 * cfg, d = 1 << dsh;
    const int b = r >> 6, h = (r >> 4) & 3, r2 = r & 15;
    const int nblk = 16 >> dsh, res = r2 / nblk, blk = r2 % nblk, i0 = blk * 256;
    const size_t tb = (size_t)b * NS;
    bf16x8 Q[2][2]; DilMask mk; FA<2> st; fa_init(st); st.negM = -negM_bound;
#pragma unroll
    for (int q = 0; q < 2; ++q) { mk.qi[q] = i0 + 32 * w + 16 * q + l15; q_load(Q[q], QC + (tb + res + (size_t)d * mk.qi[q]) * 256 + h * 64, quad); }
    const int jlo = w >> 1, jhi = (w >> 1) + 2;
    const bool act[2] = {true, true};
    u32x4 kr, vr;
#define DIL_LOAD(j) do { const int ki = i0 - 128 + 64 * (j) + (tid >> 3); kr = (u32x4){0u, 0u, 0u, 0u}; vr = kr; \
    if (ki >= 0) { const size_t rowk = tb + res + (size_t)d * ki; kr = *(const u32x4*)(KC + rowk * 256 + h * 64 + (tid & 7) * 8); vr = *(const u32x4*)(PROJ + rowk * NPJ + PJ_C + 512 + h * 64 + (tid & 7) * 8); } } while (0)
    DIL_LOAD(0); __syncthreads(); kv_store(Ks, Vs, tid, kr, vr); DIL_LOAD(1);
    for (int j = 0; j < 6; ++j) {
        __syncthreads();
        if (j + 1 < 6) kv_store(Ks + ((j + 1) & 1) * 2 * KT_BYTES, Vs + ((j + 1) & 1) * 2 * KT_BYTES, tid, kr, vr);
        if (j + 2 < 6) DIL_LOAD(j + 2);
        if (j >= jlo && j <= jhi) { mk.k0 = i0 - 128 + 64 * j; fa_tile<2, true>(st, Q, Ks + (j & 1) * 2 * KT_BYTES, Vs + (j & 1) * 2 * KT_BYTES, lane, mk, act); }
    }
#undef DIL_LOAD
    float lse2[2]; fa_finish<2>(st, lse2);
#pragma unroll
    for (int q = 0; q < 2; ++q) { const size_t rowq = tb + res + (size_t)d * mk.qi[q]; float* o = OC + ((size_t)cfg * NT + rowq) * 256 + h * 64 + 4 * quad;
#pragma unroll
        for (int dt = 0; dt < 4; ++dt) *(f32x4*)(o + 16 * dt) = st.O[q][dt];
        if (quad == 0) LSE[((size_t)cfg * NT + rowq) * 4 + h] = lse2[q]; }
}
constexpr int NSA_KC = 0, NSA_VC = 256 * KROW, NSA_KT = 2 * 256 * KROW, NSA_VT = NSA_KT + KT_BYTES, NSA_IMP = NSA_KT + 4 * KT_BYTES,
    NSA_SELM = NSA_IMP + 64 * 64 * 4, NSA_UW = NSA_SELM + 512;
static_assert(NSA_UW + 16 <= RING_BYTES, "NSA LDS map");
struct SwaMask { int t[2]; int k0; DI bool operator()(int q, int key) const { const int d = t[q] - (k0 + key); return d >= 0 && d <= 511; } };
struct SlcMask { int t[2]; int k0; bool sel[2]; DI bool operator()(int q, int key) const { return sel[q] && (k0 + key <= t[q]); } };
struct NoMask { DI bool operator()(int, int) const { return true; } };
DI void nsa_unit(const Ctx& C, int l, int b, int tbk, int& bl, float bnd_cmp, float bnd_slc, float bnd_swa) {
    const bf16 *QN = WSP(bf16, R_QN), *QR = WSP(bf16, R_QR), *KSb = WSP(bf16, R_KS), *KWb = WSP(bf16, R_KW), *PROJ = WSP(bf16, R_PROJ); const float* CMP = WSP(float, R_CMP); const float* GATE = WSP(float, R_GATE);
    bf16* YCAT = WSP(bf16, R_YCAT);
    LAS uchar* Kc = C.lds + NSA_KC; LAS uchar* Vc = C.lds + NSA_VC; LAS uchar* Ks = C.lds + NSA_KT; LAS uchar* Vs = C.lds + NSA_VT;
    LAS float* imps = (LAS float*)(C.lds + NSA_IMP); LAS unsigned* selm = (LAS unsigned*)(C.lds + NSA_SELM); LAS unsigned* uw = (LAS unsigned*)(C.lds + NSA_UW);
    int tid = C.tid, lane = C.lane; asm volatile("" : "+v"(tid), "+v"(lane));
    const int w = C.wave, l15 = lane & 15, quad = lane >> 4, head = l15 & 3, t0 = 64 * tbk; const size_t tb = (size_t)b * NS;
    __syncthreads();
    if (b != bl) {
        const int key = tid >> 1, hf = tid & 1; const float* kp = CMP + ((size_t)b * 256 + key) * 64 + 32 * hf; const float* vp = CMP + ((size_t)2048 + (size_t)b * 256 + key) * 64 + 32 * hf;
        float kv[32], vv[32]; float ss = 0.f;
#pragma unroll
        for (int i = 0; i < 8; ++i) { const f32x4 a = *(const f32x4*)(kp + 4 * i), c = *(const f32x4*)(vp + 4 * i);
#pragma unroll
            for (int j = 0; j < 4; ++j) { kv[4 * i + j] = a[j]; vv[4 * i + j] = c[j]; ss += a[j] * a[j]; } }
        ss += __shfl_xor(ss, 1); const float rstd = rsqrtf(ss * (1.f / 64.f) + 1e-6f); const float* g = C.nsa_kc_g + (size_t)l * 64 + 32 * hf; const bool dead = (key == 255);
#pragma unroll
        for (int i = 0; i < 4; ++i) { u32x4 o, p;
            o.x = pk2(kv[8 * i] * rstd * g[8 * i], kv[8 * i + 1] * rstd * g[8 * i + 1]); o.y = pk2(kv[8 * i + 2] * rstd * g[8 * i + 2], kv[8 * i + 3] * rstd * g[8 * i + 3]);
            o.z = pk2(kv[8 * i + 4] * rstd * g[8 * i + 4], kv[8 * i + 5] * rstd * g[8 * i + 5]); o.w = pk2(kv[8 * i + 6] * rstd * g[8 * i + 6], kv[8 * i + 7] * rstd * g[8 * i + 7]);
            p.x = pk2(vv[8 * i], vv[8 * i + 1]); p.y = pk2(vv[8 * i + 2], vv[8 * i + 3]); p.z = pk2(vv[8 * i + 4], vv[8 * i + 5]); p.w = pk2(vv[8 * i + 6], vv[8 * i + 7]);
            if (dead) { o = (u32x4){0u, 0u, 0u, 0u}; p = o; }
            *(LAS u32x4*)(Kc + key * KROW + hf * 64 + i * 16) = o; *(LAS u32x4*)(Vc + key * KROW + hf * 64 + i * 16) = p; }
        bl = b;
        __syncthreads();
    }
    f32x4 Oc[2][4];
    const int cmaxu = (t0 + 32) >> 4, ktmax = cmaxu >> 4;
    const unsigned vaddr0 = (unsigned)(size_t)(Vc + (4 * quad + (l15 >> 2)) * KROW + 8 * (l15 & 3));
#pragma unroll
    for (int q = 0; q < 2; ++q) {
        const int t = t0 + 8 * w + 4 * q + (l15 >> 2);
        bf16x8 Q[2]; q_load(Q, QN + (tb + t) * 256 + head * 64, quad);
        f32x4 S[16]; const f32x4 sinit = (f32x4){-bnd_cmp, -bnd_cmp, -bnd_cmp, -bnd_cmp}; float ls = 0.f;
#pragma unroll
        for (int kt = 0; kt < 16; ++kt) {
            if (kt <= ktmax) {
                const bf16x8 k0 = *(const LAS bf16x8*)(Kc + (16 * kt + l15) * KROW + quad * 16), k1 = *(const LAS bf16x8*)(Kc + (16 * kt + l15) * KROW + 64 + quad * 16);
                S[kt] = MFMA16(k0, Q[0], sinit); S[kt] = MFMA16(k1, Q[1], S[kt]);
#pragma unroll
                for (int j = 0; j < 4; ++j) { const int c = 16 * kt + 4 * quad + j; const float p = (16 * c + 31 <= t) ? fexp2(S[kt][j]) : 0.f; S[kt][j] = p; ls += p; }
            } else S[kt] = (f32x4){0.f, 0.f, 0.f, 0.f};
        }
        ls += __shfl_xor(ls, 16); ls += __shfl_xor(ls, 32);
        const float inv = ls > 0.f ? 1.f / ls : 0.f;
#pragma unroll
        for (int kt = 0; kt < 16; ++kt) S[kt] = S[kt] * inv;
#pragma unroll
        for (int kt = 0; kt < 16; ++kt) {
            const float send = (quad == 3) ? (kt > 0 ? S[kt > 0 ? kt - 1 : 0][3] : 0.f) : S[kt][3];
            const float prev = __shfl(send, (lane + 48) & 63);
            float v = ((quad == 0 && kt == 0) ? 0.f : prev) + 2.f * (S[kt][0] + S[kt][1] + S[kt][2]) + S[kt][3];
            v += __shfl_xor(v, 1); v += __shfl_xor(v, 2);
            if (head == 0) imps[(8 * w + 4 * q + (l15 >> 2)) * 64 + 4 * kt + quad] = v;
        }
#pragma unroll
        for (int d = 0; d < 4; ++d) Oc[q][d] = (f32x4){0.f, 0.f, 0.f, 0.f};
#pragma unroll
        for (int ks = 0; ks < 8; ++ks) {
            if (2 * ks <= ktmax) {
                VFrag vf; vt_issue(vf, vaddr0 + ks * 32 * KROW); const bf16x8 pf = pack8(S[2 * ks], S[2 * ks + 1]); vt_wait(vf);
#pragma unroll
                for (int d = 0; d < 4; ++d) Oc[q][d] = MFMA16(vt_get(vf, d), pf, Oc[q][d]);
            }
        }
    }
    {
        float* OCm = WSP(float, R_OCMP);
#pragma unroll
        for (int q = 0; q < 2; ++q) { float* o = OCm + (tb + t0 + 8 * w + 4 * q + (l15 >> 2)) * 256 + head * 64 + 4 * quad;
#pragma unroll
            for (int d = 0; d < 4; ++d) *(f32x4*)(o + 16 * d) = Oc[q][d]; }
    }
    __syncthreads();
    if (tid < 64) {
        const int cur = tbk; unsigned long long mask;
        if (cur <= 15) mask = (2ull << cur) - 1ull;
        else {
            mask = 1ull | (1ull << cur) | (1ull << (cur - 1));
            float v[64];
#pragma unroll
            for (int i = 0; i < 16; ++i) { const f32x4 a = *(const LAS f32x4*)(imps + tid * 64 + 4 * i);
#pragma unroll
                for (int j = 0; j < 4; ++j) { const int jb = 4 * i + j; v[jb] = (jb >= 1 && jb <= cur - 2) ? a[j] : -1.f; } }
#pragma unroll 1
            for (int r = 0; r < 13; ++r) {
                float bv = -0.5f; int bi = 0;
#pragma unroll
                for (int jb = 0; jb < 64; ++jb) if (v[jb] > bv) { bv = v[jb]; bi = jb; }
                mask |= 1ull << bi;
#pragma unroll
                for (int jb = 0; jb < 64; ++jb) v[jb] = (jb == bi) ? -1.f : v[jb];
            }
        }
        unsigned lo = (unsigned)mask, hi = (unsigned)(mask >> 32);
        selm[2 * tid] = lo; selm[2 * tid + 1] = hi;
#pragma unroll
        for (int o = 1; o < 64; o <<= 1) { lo |= __shfl_xor(lo, o); hi |= __shfl_xor(hi, o); }
        if (tid == 0) { uw[0] = lo; uw[1] = hi; }
    }
    __syncthreads();
    unsigned long long U = ((unsigned long long)uw[1] << 32) | uw[0];
    bf16x8 Q[2][2]; SlcMask mk; FA<2> st; fa_init(st); st.negM = -bnd_slc; unsigned long long msk[2];
#pragma unroll
    for (int q = 0; q < 2; ++q) { const int tl = 8 * w + 4 * q + (l15 >> 2); mk.t[q] = t0 + tl; msk[q] = ((unsigned long long)selm[2 * tl + 1] << 32) | selm[2 * tl]; q_load(Q[q], QR + (tb + mk.t[q]) * 256 + head * 64, quad); }
    unsigned long long QM[2];
#pragma unroll
    for (int q = 0; q < 2; ++q) { unsigned lo = (unsigned)msk[q], hi = (unsigned)(msk[q] >> 32);
#pragma unroll
        for (int o = 1; o < 64; o <<= 1) { lo |= __shfl_xor(lo, o); hi |= __shfl_xor(hi, o); }
        QM[q] = ((unsigned long long)hi << 32) | lo; }
    u32x4 kr, vr;
#define SLC_LOAD(j) do { const size_t rowk = tb + 64 * (j) + (tid >> 3); kr = *(const u32x4*)(KSb + rowk * 64 + (tid & 7) * 8); vr = *(const u32x4*)(PROJ + rowk * NPJ + 3008 + (tid & 7) * 8); } while (0)
    {
        int j = __builtin_ctzll(U); U &= U - 1ull;
        int jn = U ? __builtin_ctzll(U) : -1; U &= U - 1ull;
        SLC_LOAD(j); __syncthreads(); kv_store(Ks, Vs, tid, kr, vr); if (jn >= 0) SLC_LOAD(jn);
        for (int it = 0;; ++it) {
            __syncthreads();
            const int jnn = U ? __builtin_ctzll(U) : -1; U &= U - 1ull;
            if (jn >= 0) kv_store(Ks + ((it + 1) & 1) * 2 * KT_BYTES, Vs + ((it + 1) & 1) * 2 * KT_BYTES, tid, kr, vr);
            if (jnn >= 0) SLC_LOAD(jnn);
            const bool act[2] = {(bool)((QM[0] >> j) & 1ull), (bool)((QM[1] >> j) & 1ull)};
            if (act[0] || act[1]) { mk.k0 = 64 * j; mk.sel[0] = (msk[0] >> j) & 1ull; mk.sel[1] = (msk[1] >> j) & 1ull; fa_tile<2, true>(st, Q, Ks + (it & 1) * 2 * KT_BYTES, Vs + (it & 1) * 2 * KT_BYTES, lane, mk, act); }
            if (jn < 0) break; j = jn; jn = jnn;
        }
    }
#undef SLC_LOAD
    float lse2[2]; fa_finish<2>(st, lse2);
    {   float* OSl = WSP(float, R_OSLC);
#pragma unroll
        for (int q = 0; q < 2; ++q) { float* o = OSl + (tb + mk.t[q]) * 256 + head * 64 + 4 * quad;
#pragma unroll
            for (int d = 0; d < 4; ++d) *(f32x4*)(o + 16 * d) = st.O[q][d]; }
    }
    FA<2> sw; fa_init(sw); sw.negM = -bnd_swa; SwaMask mw; mw.t[0] = mk.t[0]; mw.t[1] = mk.t[1];
    {
        const int j0 = tbk >= 8 ? tbk - 8 : 0; const bool act[2] = {true, true};
#define SWA_LOAD(j) do { const size_t rowk = tb + 64 * (j) + (tid >> 3); kr = *(const u32x4*)(KWb + rowk * 64 + (tid & 7) * 8); vr = *(const u32x4*)(PROJ + rowk * NPJ + 3136 + (tid & 7) * 8); } while (0)
        SWA_LOAD(j0); __syncthreads(); kv_store(Ks, Vs, tid, kr, vr); if (j0 + 1 <= tbk) SWA_LOAD(j0 + 1);
        for (int j = j0; j <= tbk; ++j) {
            const int pb_ = (j - j0) & 1;
            __syncthreads();
            if (j + 1 <= tbk) kv_store(Ks + (pb_ ^ 1) * 2 * KT_BYTES, Vs + (pb_ ^ 1) * 2 * KT_BYTES, tid, kr, vr);
            if (j + 2 <= tbk) SWA_LOAD(j + 2);
            mw.k0 = 64 * j;
            if (j == tbk || j == tbk - 8) fa_tile<2, true>(sw, Q, Ks + pb_ * 2 * KT_BYTES, Vs + pb_ * 2 * KT_BYTES, lane, mw, act);
            else fa_tile<2, false>(sw, Q, Ks + pb_ * 2 * KT_BYTES, Vs + pb_ * 2 * KT_BYTES, lane, NoMask(), act);
        }
#undef SWA_LOAD
    }
    fa_finish<2>(sw, lse2);
#pragma unroll
    for (int q = 0; q < 2; ++q) {
        const size_t row = tb + mk.t[q]; const float* gp = GATE + row * 12 + head * 3; const float g0 = gp[0], g1 = gp[1], g2 = gp[2];
        f32x4 o[4]; float ss = 0.f; const float* pc = WSP(float, R_OCMP) + row * 256 + head * 64 + 4 * quad; const float* ps = WSP(float, R_OSLC) + row * 256 + head * 64 + 4 * quad;
#pragma unroll
        for (int d = 0; d < 4; ++d) { o[d] = *(const f32x4*)(pc + 16 * d) * g0 + *(const f32x4*)(ps + 16 * d) * g1 + sw.O[q][d] * g2; ss += (o[d][0] * o[d][0] + o[d][1] * o[d][1]) + (o[d][2] * o[d][2] + o[d][3] * o[d][3]); }
        ss += __shfl_xor(ss, 16); ss += __shfl_xor(ss, 32);
        const float rstd = rsqrtf(ss * (1.f / 64.f) + 1e-6f); const float* og = C.onorm_g + (size_t)l * 768 + 512 + head * 64 + 4 * quad;
        bf16* yo = YCAT + row * DM + 768 + head * 64 + 4 * quad;
#pragma unroll
        for (int d = 0; d < 4; ++d) { const f32x4 g4 = *(const f32x4*)(og + 16 * d); u32x2 wv; wv.x = pk2(o[d][0] * rstd * g4[0], o[d][1] * rstd * g4[1]); wv.y = pk2(o[d][2] * rstd * g4[2], o[d][3] * rstd * g4[3]); *(u32x2*)(yo + 16 * d) = wv; }
    }
}

DI void fin_phase(const Ctx& C, int l) {
    const float* SC = WSP(float, R_SC); const float* YA = WSP(float, R_YA); const float* Gb = WSP(float, R_G); const float* OC = WSP(float, R_OC); const float* LSE = WSP(float, R_LSE);
    const float* UB = WSP(float, R_SCANU); const float* SMT = WSP(float, R_SCANS); bf16* YCAT = WSP(bf16, R_YCAT);
    const int lane = C.lane, ch = 4 * lane, hh = lane >> 4;
    LAS float* sm = (LAS float*)C.lds;
    LAS float* us = sm + 4 * 4096 + C.wave * 256;
    int bl = -1;
    for (int it = C.bid; it < NT / 128; it += C.G) {
        const int b = it >> 5, kk = it & 31;
        if (b != bl) { __syncthreads(); for (int i = C.tid; i < 4096; i += NTHR) *(LAS f32x4*)(sm + 4 * i) = *(const f32x4*)(SMT + (size_t)b * 4 * 4096 + 4 * i); bl = b; __syncthreads(); }
#pragma unroll 1
      for (int hf = 0; hf < 2; ++hf) {
        const int rbase = b * NS + hf * (NS / 2) + 64 * kk + C.wave * 8;
        const bool fix = hf == 1;
#pragma unroll 2
        for (int r = 0; r < 8; ++r) {
            const int row = rbase + r, s = row % NS;
            const size_t o = (size_t)row * 256 + ch;
            {
                f32x4 y = *(const f32x4*)(YA + o); const f32x4 rr = *(const f32x4*)(SC + (size_t)4 * NT * 256 + o), k = *(const f32x4*)(SC + (size_t)1 * NT * 256 + o), v = *(const f32x4*)(SC + (size_t)5 * NT * 256 + o), g = *(const f32x4*)(Gb + o);
                if (fix) {
                    *(LAS f32x4*)(us + ch) = *(const f32x4*)(UB + ((size_t)b * (NS / 2) + (s - NS / 2)) * 256 + ch);
                    asm volatile("s_waitcnt lgkmcnt(0)" ::: "memory");
                    const LAS float* sp = sm + hh * 4096 + 4 * (lane & 15); const LAS float* up = us + hh * 64;
#pragma unroll 8
                    for (int j4 = 0; j4 < 16; ++j4) { const f32x4 u4 = *(const LAS f32x4*)(up + 4 * j4);
#pragma unroll
                        for (int jj = 0; jj < 4; ++jj) y += *(const LAS f32x4*)(sp + (4 * j4 + jj) * 64) * u4[jj]; }
                    asm volatile("s_waitcnt lgkmcnt(0)" ::: "memory");
                }
                const f32x4 rk = *(const f32x4*)(C.rk + (size_t)l * 256 + ch), gw4 = *(const f32x4*)(C.gn_w + (size_t)l * 256 + ch), gb4 = *(const f32x4*)(C.gn_b + (size_t)l * 256 + ch);
                const float mu = group_sum<16>((y[0] + y[1]) + (y[2] + y[3])) * (1.f / 64.f);
                const f32x4 dy = y - mu; const float var = group_sum<16>((dy[0] * dy[0] + dy[1] * dy[1]) + (dy[2] * dy[2] + dy[3] * dy[3])) * (1.f / 64.f);
                const float rstd = rsqrtf(var + 64e-5f);
                const float dot = group_sum<16>((rr[0] * k[0] * rk[0] + rr[1] * k[1] * rk[1]) + (rr[2] * k[2] * rk[2] + rr[3] * k[3] * rk[3]));
                float out[4];
#pragma unroll
                for (int i = 0; i < 4; ++i) out[i] = ((dy[i] * rstd * gw4[i] + gb4[i]) + dot * v[i]) * g[i];
                u32x2 w; w.x = pk2(out[0], out[1]); w.y = pk2(out[2], out[3]); *(u32x2*)(YCAT + (size_t)row * DM + ch) = w;
            }
            {
                const float l0 = LSE[(size_t)row * 4 + hh], l1 = LSE[((size_t)NT + row) * 4 + hh], l2 = LSE[((size_t)2 * NT + row) * 4 + hh];
                const float mx = fmaxf(l0, fmaxf(l1, l2)); float w0 = fexp2(l0 - mx), w1 = fexp2(l1 - mx), w2 = fexp2(l2 - mx); const float inv = 1.f / (w0 + w1 + w2); w0 *= inv; w1 *= inv; w2 *= inv;
                const f32x4 a = *(const f32x4*)(OC + o), bq = *(const f32x4*)(OC + (size_t)NT * 256 + o), c = *(const f32x4*)(OC + (size_t)2 * NT * 256 + o);
                const f32x4 y = a * w0 + bq * w1 + c * w2;
                const float ss = group_sum<16>((y[0] * y[0] + y[1] * y[1]) + (y[2] * y[2] + y[3] * y[3])); const float rstd = rsqrtf(ss * (1.f / 64.f) + 1e-6f);
                const f32x4 og = *(const f32x4*)(C.onorm_g + (size_t)l * 768 + 256 + ch);
                u32x2 w; w.x = pk2(y[0] * rstd * og[0], y[1] * rstd * og[1]); w.y = pk2(y[2] * rstd * og[2], y[3] * rstd * og[3]); *(u32x2*)(YCAT + (size_t)row * DM + 512 + ch) = w;
            }
        }
      }
    }
    __syncthreads();
}

constexpr int CW_Q = 40000;
DI int q_next(const Ctx& C, unsigned* ctr, LAS int* slot) {
    __syncthreads();
    if (C.tid == 0) *slot = (int)__hip_atomic_fetch_add(ctr, 1u, __ATOMIC_RELAXED, __HIP_MEMORY_SCOPE_AGENT);
    __syncthreads();
    return *slot;
}
DI void conv_ticket(const Ctx& C, int l, int tk);
#ifndef PROBE_TS
#define PROBE_TS 0
#endif
constexpr int CW_TS = 50000;
DI void ts_mark(const Ctx& C, int l, int ev) {
#if PROBE_TS
    if (l == 0 && C.tid == 0) { unsigned* w = WSP(unsigned, WS_CTL) + CW_TS; const unsigned t = (unsigned)__builtin_amdgcn_s_memrealtime();
        if (ev == 0) { if (C.bid == 0) __hip_atomic_store(w, t, __ATOMIC_RELAXED, __HIP_MEMORY_SCOPE_AGENT); }
        else if (ev == 6) atomicMax(w + 6, ~t); else atomicMax(w + ev, t); }
#endif
}
DI void mix_phase(const Ctx& C, int l, int rep) {
    unsigned* ctl = WSP(unsigned, WS_CTL) + CW_Q + 64 * 3 * (l + 2 * rep); LAS int* slot = (LAS int*)(C.lds + MISC_OFF + 1024);
    ts_mark(C, l, 0);
    if (C.bid < 96) { scan_unit8(C, C.bid); if (PROBE_SCAN2) scan_unit8(C, C.bid); ts_mark(C, l, 4); }
    int bl = -1;
    const float bnd_cmp = score_bound(C.nsa_q_g + (size_t)l * 64, C.nsa_kc_g + (size_t)l * 64, C.lane), bnd_slc = score_bound(C.nsa_q_g + (size_t)l * 64, C.nsa_ks_g + (size_t)l * 64, C.lane),
                bnd_swa = score_bound(C.nsa_q_g + (size_t)l * 64, C.nsa_kw_g + (size_t)l * 64, C.lane), bnd_dil = score_bound(C.dil_q_g + (size_t)l * 64, C.dil_k_g + (size_t)l * 64, C.lane);
    bool conv_left = true;
#define CONV_ONE() do { if (conv_left) { const int t_ = q_next(C, ctl + 128, slot); if (t_ >= 768 * (1 + PROBE_CONV2)) conv_left = false; else { conv_ticket(C, l, t_ % 768); bl = -1; } } } while (0)
    for (;;) { const int u = q_next(C, ctl, slot); if (u >= 512 * (1 + PROBE_ATT2)) break; nsa_unit(C, l, u & 7, 63 - ((u & 511) >> 3), bl, bnd_cmp, bnd_slc, bnd_swa); CONV_ONE(); }
    ts_mark(C, l, 1);
    for (int n = 0;; ++n) { const int u = q_next(C, ctl + 64, slot); if (u >= 1536 * (1 + PROBE_ATT2)) break; dil_unit(C, u % 1536, C.lds, C.lds + KT_BYTES, bnd_dil); if ((n & 3) == 3) CONV_ONE(); }
    ts_mark(C, l, 2);
    while (conv_left) CONV_ONE();
#undef CONV_ONE
    ts_mark(C, l, 3); if (C.bid >= 96) ts_mark(C, l, 6);
    __syncthreads();
}
#define MFMA_F32(a, b, c) __builtin_amdgcn_mfma_f32_16x16x4f32((a), (b), (c), 0, 0, 0)
DI void router_phase(const Ctx& C, int l) {
    const float* X = C.out; const float* MOD = WSP(float, WS_SMALL) + (size_t)l * 8 * 6144; unsigned char* H8 = WSP(unsigned char, R_XS);
    int* TOPE = WSP(int, WS_ROUTE); float* TOPG = (float*)(TOPE + NT * 4); unsigned* CNTB = WSP(unsigned, WS_CTL) + CW_CNT + l * 8192;
    LAS float* wl = (LAS float*)C.lds;
    LAS float* lg = (LAS float*)(C.lds + MISC_OFF + 8192) + C.wave * 512;
    LAS unsigned* hist = (LAS unsigned*)(C.lds + MISC_OFF + 6144);
    LAS float* rs = (LAS float*)(C.lds + MISC_OFF + 6400) + C.wave * 16;
    const int lane = C.lane, l15 = lane & 15, quad = lane >> 4, gw = C.bid * NWAVE + C.wave, NGW = C.G * NWAVE;
    const float* wr = C.w_router + (size_t)l * 1024 * 32; const float* g2 = C.norm2_g + (size_t)l * DM;
    __syncthreads();
    if (C.tid < 32) hist[C.tid] = 0u;
    for (int i = C.tid; i < 8192; i += NTHR) { const int k = i >> 3, e4 = (i & 7) * 4; const f32x4 v = *(const f32x4*)(wr + (size_t)k * 32 + e4); LAS float* d = wl + ((k >> 2) * 32 + e4) * 4 + (k & 3);
        d[0] = v[0]; d[4] = v[1]; d[8] = v[2]; d[12] = v[3]; }
    __syncthreads();
    for (int task = gw; task < NT / 16; task += NGW) {
        const int row0 = 16 * task, b = row0 / NS;
        const float* shb = MOD + (size_t)b * 6144 + 3072; const float* scb = shb + 1024;
        {
            f32x4 gg[4], sa[4], sb[4];
#pragma unroll
            for (int j = 0; j < 4; ++j) { const int k = 4 * lane + 256 * j; const f32x4 g = *(const f32x4*)(g2 + k), a = *(const f32x4*)(scb + k); gg[j] = g * (a + 1.f); sb[j] = *(const f32x4*)(shb + k); }
#pragma unroll 2
            for (int r = 0; r < 16; ++r) {
                const float* xr = X + (size_t)(row0 + r) * DM + 4 * lane; f32x4 v[4]; float ss = 0.f;
#pragma unroll
                for (int j = 0; j < 4; ++j) { v[j] = *(const f32x4*)(xr + 256 * j); ss += (v[j][0] * v[j][0] + v[j][1] * v[j][1]) + (v[j][2] * v[j][2] + v[j][3] * v[j][3]); }
                ss = group_sum<64>(ss); const float rstd = rsqrtf(ss * (1.f / DM) + 1e-6f);
                if (lane == 0) rs[r] = rstd;
                unsigned char* hp = H8 + (size_t)(row0 + r) * DM + 4 * lane;
#pragma unroll
                for (int j = 0; j < 4; ++j) { const f32x4 h = v[j] * rstd * gg[j] + sb[j]; *(unsigned*)(hp + 256 * j) = pk4_fp8(h[0], h[1], h[2], h[3]); }
            }
        }
        const float* xr = X + (size_t)(row0 + l15) * DM + 4 * quad; const float* sh = shb + 4 * quad; const float* sc = scb + 4 * quad;
        asm volatile("s_waitcnt lgkmcnt(0)" ::: "memory");
        const float rstd = rs[l15];
        f32x4 acc0 = (f32x4){0.f, 0.f, 0.f, 0.f}, acc1 = acc0;
#pragma unroll 2
        for (int i = 0; i < 64; ++i) {
            const f32x4 a = *(const f32x4*)(xr + 16 * i), g = *(const f32x4*)(g2 + 16 * i + 4 * quad), s1 = *(const f32x4*)(sc + 16 * i), s0 = *(const f32x4*)(sh + 16 * i);
            f32x4 h;
#pragma unroll
            for (int j = 0; j < 4; ++j) h[j] = a[j] * rstd * g[j] * (1.f + s1[j]) + s0[j];
            const LAS float* wp = wl + ((4 * i + quad) * 32 + l15) * 4; const f32x4 w0 = *(const LAS f32x4*)wp, w1 = *(const LAS f32x4*)(wp + 64);
#pragma unroll
            for (int j = 0; j < 4; ++j) { acc0 = MFMA_F32(h[j], w0[j], acc0); acc1 = MFMA_F32(h[j], w1[j], acc1); }
        }
        const float b0 = C.b_router[l * 32 + l15], b1 = C.b_router[l * 32 + 16 + l15];
#pragma unroll
        for (int j = 0; j < 4; ++j) { lg[(4 * quad + j) * 32 + l15] = acc0[j] + b0; lg[(4 * quad + j) * 32 + 16 + l15] = acc1[j] + b1; }
        asm volatile("s_waitcnt lgkmcnt(0)" ::: "memory");
        if (lane < 16) {
            float v[32];
#pragma unroll
            for (int i = 0; i < 8; ++i) { const f32x4 a = *(const LAS f32x4*)(lg + lane * 32 + 4 * i); v[4 * i] = a[0]; v[4 * i + 1] = a[1]; v[4 * i + 2] = a[2]; v[4 * i + 3] = a[3]; }
            float tv[4]; int ti[4];
#pragma unroll
            for (int r = 0; r < 4; ++r) { float bv = -3.0e38f; int bi = 0;
#pragma unroll
                for (int e = 0; e < 32; ++e) if (v[e] > bv) { bv = v[e]; bi = e; }
                tv[r] = bv; ti[r] = bi;
#pragma unroll
                for (int e = 0; e < 32; ++e) v[e] = (e == bi) ? -3.0e38f : v[e]; }
            const float e1 = __expf(tv[1] - tv[0]), e2 = __expf(tv[2] - tv[0]), e3 = __expf(tv[3] - tv[0]), inv = 1.f / (1.f + e1 + e2 + e3);
            const int row = row0 + lane;
            *(int4*)(TOPE + (size_t)row * 4) = make_int4(ti[0], ti[1], ti[2], ti[3]);
            *(f32x4*)(TOPG + (size_t)row * 4) = (f32x4){inv, e1 * inv, e2 * inv, e3 * inv};
#pragma unroll
            for (int r = 0; r < 4; ++r) __hip_atomic_fetch_add(&hist[ti[r]], 1u, __ATOMIC_RELAXED, __HIP_MEMORY_SCOPE_WORKGROUP);
        }
        asm volatile("s_waitcnt lgkmcnt(0)" ::: "memory");
    }
    __syncthreads();
    if (C.tid < 32) CNTB[C.bid * 32 + C.tid] = hist[C.tid];
}

DI void moe_tables(const Ctx& C, int l, LAS int* tab) {
    const unsigned* CNTB = WSP(unsigned, WS_CTL) + CW_CNT + l * 8192;
    LAS unsigned* part = (LAS unsigned*)(tab + 192);
    __syncthreads();
    { const int e = C.tid & 31, pt = C.tid >> 5; unsigned tot = 0u, mine = 0u;
        const int g0 = pt * ((C.G + 15) >> 4), g1 = min(C.G, g0 + ((C.G + 15) >> 4));
#pragma unroll 16
        for (int g = g0; g < g1; ++g) { const unsigned c = CNTB[g * 32 + e]; tot += c; mine += (g < C.bid) ? c : 0u; }
        part[(pt * 2) * 32 + e] = tot; part[(pt * 2 + 1) * 32 + e] = mine; }
    __syncthreads();
    if (C.tid < 32) { unsigned tot = 0u, mine = 0u;
#pragma unroll
        for (int pt = 0; pt < 16; ++pt) { tot += part[(pt * 2) * 32 + C.tid]; mine += part[(pt * 2 + 1) * 32 + C.tid]; }
        tab[128 + C.tid] = (int)((tot + 255u) >> 8); tab[64 + C.tid] = (int)mine; }
    __syncthreads();
    if (C.tid == 0) { int s = 0; for (int e = 0; e < 32; ++e) { tab[e] = s; s += tab[128 + e]; } tab[32] = s; }
    __syncthreads();
}
DI void scatter_phase(const Ctx& C, int l) {
    const int* TOPE = WSP(int, WS_ROUTE); int* POS = (int*)(TOPE + NT * 8); int* ROWMAP = (int*)(TOPE + NT * 12);
    LAS int* tab = (LAS int*)(C.lds + MISC_OFF + 64); LAS unsigned* cur = (LAS unsigned*)(C.lds + 16384);
    moe_tables(C, l, tab);
    if (C.tid < 32) cur[C.tid] = (unsigned)(tab[C.tid] * 256 + tab[64 + C.tid]);
    __syncthreads();
    const int lane = C.lane, gw = C.bid * NWAVE + C.wave, NGW = C.G * NWAVE;
    for (int task = gw; task < NT / 16; task += NGW) {
        const int row0 = 16 * task, tok = row0 + (lane >> 2);
        const int e = TOPE[(size_t)tok * 4 + (lane & 3)];
        const int slot = (int)__hip_atomic_fetch_add(&cur[e], 1u, __ATOMIC_RELAXED, __HIP_MEMORY_SCOPE_WORKGROUP);
        POS[(size_t)tok * 4 + (lane & 3)] = slot; ROWMAP[slot] = tok;
    }
}
DI void combine_phase(const Ctx& C, int l, float* dst) {
    const bf16* YB = WSP(bf16, R_YB); const int* TOPE = WSP(int, WS_ROUTE); const float* TOPG = (const float*)(TOPE + NT * 4); const int* POS = (const int*)(TOPE + NT * 8);
    const float* MOD = WSP(float, WS_SMALL) + (size_t)l * 8 * 6144; bf16* H = WSP(bf16, WS_H);
    const int lane = C.lane, gw = C.bid * NWAVE + C.wave, NGW = C.G * NWAVE;
    for (int task = gw; task < NT / 16; task += NGW) {
        const int row0 = 16 * task, b = row0 / NS; const float* gt = MOD + (size_t)b * 6144 + 5120 + 8 * lane;
        f32x4 g4[4], gg[4], sb[4];
#pragma unroll
        for (int j = 0; j < 2; ++j) { g4[2 * j] = *(const f32x4*)(gt + 512 * j); g4[2 * j + 1] = *(const f32x4*)(gt + 512 * j + 4); }
        if (l + 1 < NLAYER) { const float* M2 = MOD + 8 * 6144 + (size_t)b * 6144 + 8 * lane; const float* g = C.norm1_g + (size_t)(l + 1) * DM + 8 * lane;
#pragma unroll
            for (int j = 0; j < 2; ++j)
#pragma unroll
                for (int hlf = 0; hlf < 2; ++hlf) { const int o = 512 * j + 4 * hlf; gg[2 * j + hlf] = *(const f32x4*)(g + o) * (*(const f32x4*)(M2 + 1024 + o) + 1.f); sb[2 * j + hlf] = *(const f32x4*)(M2 + o); } }
#pragma unroll 2
        for (int r = 0; r < 16; ++r) {
            const int row = row0 + r; const int4 ps = *(const int4*)(POS + (size_t)row * 4); const f32x4 gk = *(const f32x4*)(TOPG + (size_t)row * 4);
            const int pp[4] = {ps.x, ps.y, ps.z, ps.w};
            const float* orow = C.out + (size_t)row * DM + 8 * lane; float* drow = dst + (size_t)row * DM + 8 * lane;
            u32x4 y[4][2]; f32x4 x[4];
#pragma unroll
            for (int q = 0; q < 4; ++q)
#pragma unroll
                for (int j = 0; j < 2; ++j) y[q][j] = *(const u32x4*)(YB + (size_t)pp[q] * DM + 8 * lane + 512 * j);
#pragma unroll
            for (int j = 0; j < 2; ++j) { x[2 * j] = *(const f32x4*)(orow + 512 * j); x[2 * j + 1] = *(const f32x4*)(orow + 512 * j + 4); }
            f32x4 v[4]; float s = 0.f;
#pragma unroll
            for (int j = 0; j < 2; ++j) { f32x4 a0 = (f32x4){0.f, 0.f, 0.f, 0.f}, a1 = a0;
#pragma unroll
                for (int q = 0; q < 4; ++q) { const u32x4 w = y[q][j]; a0 += (f32x4){bflo(w.x), bfhi(w.x), bflo(w.y), bfhi(w.y)} * gk[q]; a1 += (f32x4){bflo(w.z), bfhi(w.z), bflo(w.w), bfhi(w.w)} * gk[q]; }
                v[2 * j] = x[2 * j] + g4[2 * j] * a0; v[2 * j + 1] = x[2 * j + 1] + g4[2 * j + 1] * a1;
#if PROBE_TS
                if (l + 1 == NLAYER) { const unsigned* w = WSP(unsigned, WS_CTL) + CW_TS; const unsigned t0 = w[0]; const unsigned ea = (PROBE_TS_A == 6) ? ~w[6] : w[PROBE_TS_A], eb = (PROBE_TS_B == 6) ? ~w[6] : w[PROBE_TS_B];
                    const float A = (PROBE_TS_A == 7) ? 1.f : (float)((ea - t0) / 4000u) * 0.04f, B = (float)(eb - t0) * 1e-3f;
                    v[2 * j] = v[2 * j] + A; v[2 * j + 1] = v[2 * j + 1] + A; (void)B; }
#endif
                *(f32x4*)(drow + 512 * j) = v[2 * j]; *(f32x4*)(drow + 512 * j + 4) = v[2 * j + 1]; }
#pragma unroll
            for (int i = 0; i < 4; ++i) s += (v[i][0] * v[i][0] + v[i][1] * v[i][1]) + (v[i][2] * v[i][2] + v[i][3] * v[i][3]);
            if (l + 1 < NLAYER) {
                s = group_sum<64>(s); const float rstd = rsqrtf(s * (1.f / DM) + 1e-6f); bf16* hrow = H + (size_t)row * DM + 8 * lane;
#pragma unroll
                for (int j = 0; j < 2; ++j) { const f32x4 h0 = v[2 * j] * rstd * gg[2 * j] + sb[2 * j], h1 = v[2 * j + 1] * rstd * gg[2 * j + 1] + sb[2 * j + 1]; u32x4 o;
                    o.x = pk2(h0[0], h0[1]); o.y = pk2(h0[2], h0[3]); o.z = pk2(h1[0], h1[1]); o.w = pk2(h1[2], h1[3]); *(u32x4*)(hrow + 512 * j) = o; }
            }
        }
    }
}
constexpr int PH_PER_LAYER = 11, PH_BASE = 2, N_PHASES = PH_BASE + NLAYER * PH_PER_LAYER;
#ifndef MK_ONE_LAUNCH
#define MK_ONE_LAUNCH 1
#endif
__global__ void __launch_bounds__(NTHR, 2) mk_fwd(Args args) {
    extern __shared__ __attribute__((aligned(16))) unsigned char lds_raw[];
    Ctx C;
    C.lds = (LAS unsigned char*)lds_raw; C.tid = threadIdx.x; C.lane = C.tid & 63; C.wave = __builtin_amdgcn_readfirstlane(C.tid >> 6); C.G = gridDim.x; C.bid = blockIdx.x;
    C.x = (const float*)args.in[0]; C.c = (const float*)args.in[1]; C.pos = (const int*)args.in[2]; C.w_ada = (const float*)args.in[3]; C.b_ada = (const float*)args.in[4];
    C.norm1_g = (const float*)args.in[5]; C.norm2_g = (const float*)args.in[6]; C.w_in = (const float*)args.in[7]; C.w_out = (const float*)args.in[8]; C.mu = (const float*)args.in[9];
    C.w0 = (const float*)args.in[10]; C.w2 = (const float*)args.in[11]; C.a0 = (const float*)args.in[12]; C.a2 = (const float*)args.in[13]; C.g2 = (const float*)args.in[14];
    C.kkw = (const float*)args.in[15]; C.ka = (const float*)args.in[16]; C.rk = (const float*)args.in[17]; C.gn_w = (const float*)args.in[18]; C.gn_b = (const float*)args.in[19];
    C.conv_w = (const float*)args.in[20]; C.dil_q_g = (const float*)args.in[21]; C.dil_k_g = (const float*)args.in[22]; C.nsa_q_g = (const float*)args.in[23]; C.nsa_kc_g = (const float*)args.in[24];
    C.nsa_ks_g = (const float*)args.in[25]; C.nsa_kw_g = (const float*)args.in[26]; C.pe_k = (const float*)args.in[27]; C.pe_v = (const float*)args.in[28]; C.wk1 = (const float*)args.in[29];
    C.wk2 = (const float*)args.in[30]; C.wv1 = (const float*)args.in[31]; C.wv2 = (const float*)args.in[32]; C.onorm_g = (const float*)args.in[33]; C.w_router = (const float*)args.in[34];
    C.b_router = (const float*)args.in[35]; C.w_gu = (const float*)args.in[36]; C.b_gu = (const float*)args.in[37]; C.w_down = (const float*)args.in[38]; C.b_down = (const float*)args.in[39];
    C.out = args.out; C.ws = args.ws;
    const int lo = args.ph_lo, hi = args.ph_hi;
    for (int u = C.tid; u < (LDS_BYTES - MISC_OFF) / 4; u += NTHR) ((LAS unsigned*)(C.lds + MISC_OFF))[u] = 0u;
    __syncthreads();
    XcdBarrier bar; bar.bar = WSP(unsigned, WS_CTL) + CW_BAR; bar.x = 0; bar.st = nullptr;
    if (hi - lo > 1) bar = xcd_barrier_post(WSP(unsigned, WS_CTL) + CW_BAR, (volatile LAS unsigned*)(C.lds + MISC_OFF));
#ifndef PHMASK
#define PHMASK 0xFFFFFFFFu
#endif
#define PHON(n) (((PHMASK) >> (n)) & 1u)
#ifndef PHREP
#define PHREP 0u
#endif
#define NREP(n) (1 + (int)(((PHREP) >> (n)) & 1u))
#define WSPP(T, off) ((T*)(P.ws + (off)))
#define IN(k) (lo <= (k) && (k) < hi)
#define SEAM(k) do { if (IN(k) && IN((k) + 1)) xcd_barrier(bar); } while (0)
#define PCTX Ctx P = C; asm volatile("" : "+v"(P.tid), "+v"(P.lane)); asm volatile("" : "+s"(P.ws), "+s"(P.out), "+s"(P.wave), "+s"(P.bid))
    if (PHON(17) && IN(0)) for (int rep = 0; rep < NREP(17); ++rep) { PCTX; p0_prologue(P); __syncthreads(); }
    SEAM(0);
#ifndef PROBE_BARS
#define PROBE_BARS 0
#endif
    if (hi - lo > 1) for (int i = 0; i < PROBE_BARS; ++i) xcd_barrier(bar);
    if (PHON(18) && IN(1)) { PCTX; norm1_phase(P, 0, P.x); }
    SEAM(1);
    for (int l = 0; l < NLAYER; ++l) {
        const int pb = PH_BASE + PH_PER_LAYER * l;
        if (PHON(0) && IN(pb + 0)) for (int rep = 0; rep < NREP(0); ++rep) { PCTX;
            pg8::Gemm g{WSPP(bf16, WS_H), WSPP(bf16, WS_WIN) + (size_t)l * NPJ * 1024, 1024, 1024}; pg8::StaticOrder S; S.init(NT / 256, NPJ / 256, P.G, P.bid);
            EpiProj E{WSPP(bf16, R_PROJ)}; pg8::gemm_phase(P.lds, P.tid, g, S, E);
        }
        SEAM(pb + 0);
        if (PHON(1) && IN(pb + 1)) for (int rep = 0; rep < NREP(1); ++rep) { PCTX; prep_phase(P, l); __syncthreads(); }
        SEAM(pb + 1);
        if (PHON(2) && IN(pb + 2)) for (int rep = 0; rep < NREP(2); ++rep) { PCTX;
            { pg8::Gemm g{WSPP(bf16, R_LIN), WSPP(bf16, WS_LORA) + (size_t)l * 768 * 256, 256, 256}; pg8::StaticOrder S; S.init(NT / 256, 3, P.G, P.bid);
              EpiLora E{WSPP(float, R_SC), WSPP(float, R_G), P.w0 + l * 256, P.a0 + l * 256, P.ka + l * 256, (rep + 1 < NREP(2)) ? WSPP(float, WS_END) : WSPP(float, R_SC)}; pg8::gemm_phase(P.lds, P.tid, g, S, E); }
            { pg8::Gemm g{WSPP(bf16, R_KCR), WSPP(bf16, WS_WK1) + (size_t)(l * 2) * 256 * 2048, 1024, 2048}; pg8::StaticOrder S; S.init(8, 1, P.G, (P.bid + 64) % P.G);
              EpiC1 E{WSPP(bf16, R_CH1), (WSPP(float, WS_SMALL) + NLAYER * 8 * 6144 + l * 512)}; pg8::gemm_phase(P.lds, P.tid, g, S, E); }
            { pg8::Gemm g{WSPP(bf16, R_VCR), WSPP(bf16, WS_WK1) + (size_t)(l * 2 + 1) * 256 * 2048, 1024, 2048}; pg8::StaticOrder S; S.init(8, 1, P.G, (P.bid + 128) % P.G);
              EpiC1 E{WSPP(bf16, R_CH1) + 2048 * 256, (WSPP(float, WS_SMALL) + NLAYER * 8 * 6144 + l * 512 + 256)}; pg8::gemm_phase(P.lds, P.tid, g, S, E); }
            asm volatile("s_waitcnt vmcnt(0)" ::: "memory"); __syncthreads();
            { pg8::Gemm g{WSPP(bf16, R_CH1), WSPP(bf16, WS_WK2) + (size_t)(l * 2) * 256 * 256, 256, 256}; pg8::StaticOrder S; S.init(8, 1, P.G, (P.bid + 64) % P.G);
              EpiC2 E{WSPP(float, R_CMP)}; pg8::gemm_phase(P.lds, P.tid, g, S, E); }
            { pg8::Gemm g{WSPP(bf16, R_CH1) + 2048 * 256, WSPP(bf16, WS_WK2) + (size_t)(l * 2 + 1) * 256 * 256, 256, 256}; pg8::StaticOrder S; S.init(8, 1, P.G, (P.bid + 128) % P.G);
              EpiC2 E{WSPP(float, R_CMP) + 2048 * 64}; pg8::gemm_phase(P.lds, P.tid, g, S, E); }
        }
        SEAM(pb + 2);
        if (PHON(3) && IN(pb + 3)) for (int rep = 0; rep < NREP(3); ++rep) { PCTX; mix_phase(P, l, rep); }
        SEAM(pb + 3);
        if (PHON(4) && IN(pb + 4)) for (int rep = 0; rep < NREP(4); ++rep) { PCTX; fin_phase(P, l); __syncthreads(); }
        SEAM(pb + 4);
        if (PHON(5) && IN(pb + 5)) for (int rep = 0; rep < NREP(5); ++rep) { PCTX;
            pg8::Gemm g{WSPP(bf16, R_YCAT), WSPP(bf16, WS_WOUT) + (size_t)l * 1024 * 1024, 1024, 1024}; pg8::StaticOrder S; S.init(NT / 256, 4, P.G, P.bid);
            EpiOut E{(rep + 1 < NREP(5)) ? WSPP(float, WS_END) : P.out, l == 0 ? P.x : (const float*)P.out, WSPP(float, WS_SMALL) + (size_t)l * 8 * 6144 + 2048}; pg8::gemm_phase(P.lds, P.tid, g, S, E);
        }
        SEAM(pb + 5);
        if (PHON(6) && IN(pb + 6)) for (int rep = 0; rep < NREP(6); ++rep) { PCTX; router_phase(P, l); __syncthreads(); }
        SEAM(pb + 6);
        if (PHON(7) && IN(pb + 7)) for (int rep = 0; rep < NREP(7); ++rep) { PCTX; scatter_phase(P, l); __syncthreads(); }
        SEAM(pb + 7);
        if (PHON(8) && IN(pb + 8)) for (int rep = 0; rep < NREP(8); ++rep) { PCTX;
            LAS int* tab = (LAS int*)(P.lds + MISC_OFF + 64); moe_tables(P, l, tab);
            pg8::Gemm g{WSPP(bf16, R_XS), WSPP(bf16, WS_WGU) + (size_t)l * 32 * 2048 * 512, 512, 512, WSPP(int, WS_ROUTE) + NT * 12, 32767};
            pg8::GroupedOrder S; S.init(tab[32], 8, P.G, P.bid); S.tstart = tab; S.nrow_e = 2048;
            EpiGU8 E{WSPP(unsigned char, R_ACT), P.b_gu + (size_t)l * 32 * 2048}; pg8::gemm_phase<EpiGU8, pg8::GroupedOrder, true, true>(P.lds, P.tid, g, S, E);
        }
        SEAM(pb + 8);
        if (PHON(9) && IN(pb + 9)) for (int rep = 0; rep < NREP(9); ++rep) { PCTX;
            LAS int* tab = (LAS int*)(P.lds + MISC_OFF + 64); moe_tables(P, l, tab);
            pg8::Gemm g{WSPP(bf16, R_ACT), WSPP(bf16, WS_WDN) + (size_t)l * 32 * 1024 * 512, 512, 512, WSPP(int, WS_ROUTE) + NT * 12 + NR, 0x3FFFF}; pg8::GroupedOrder S; S.init(tab[32], 4, P.G, P.bid); S.tstart = tab; S.nrow_e = 1024;
            EpiDN8 E{WSPP(bf16, R_YB), P.b_down + (size_t)l * 32 * 1024}; pg8::gemm_phase<EpiDN8, pg8::GroupedOrder, true, true>(P.lds, P.tid, g, S, E);
        }
        SEAM(pb + 9);
        if (PHON(10) && IN(pb + 10)) for (int rep = 0; rep < NREP(10); ++rep) { PCTX; combine_phase(P, l, (rep + 1 < NREP(10)) ? WSPP(float, WS_END) : P.out); __syncthreads(); }
        SEAM(pb + 10);
    }
#undef IN
#undef SEAM
}

extern "C" void kernel_launch(void* const* d_in, const int* in_sizes, int n_in, void* d_out, int out_size, void* d_ws, size_t ws_size, hipStream_t stream) {
    static int grid = 0;
    if (grid == 0) {
        if (n_in != 40 || out_size != NT * DM || ws_size < WS_END + 256 * MiB) { fprintf(stderr, "kernel_launch: unexpected problem (n_in %d, out %d, ws %zu < %zu)\n", n_in, out_size, ws_size, (size_t)WS_END); grid = -1; return; }
        int dev = 0, cus = 0, per_cu = 0;
        if (hipGetDevice(&dev) != hipSuccess || hipDeviceGetAttribute(&cus, hipDeviceAttributeMultiprocessorCount, dev) != hipSuccess) { grid = -1; return; }
        if (hipFuncSetAttribute((const void*)mk_fwd, hipFuncAttributeMaxDynamicSharedMemorySize, LDS_BYTES) != hipSuccess) { fprintf(stderr, "kernel_launch: hipFuncSetAttribute failed\n"); grid = -1; return; }
        if (hipOccupancyMaxActiveBlocksPerMultiprocessor(&per_cu, (const void*)mk_fwd, NTHR, LDS_BYTES) != hipSuccess || per_cu < 1) fprintf(stderr, "kernel_launch: occupancy query says %d blocks per CU\n", per_cu);
        (void)hipGetLastError();
        grid = cus > 256 ? 256 : cus;
    }
    if (grid < 0) return;
    (void)hipMemsetAsync((char*)d_ws, 0, ZERO_BYTES, stream);
    Args a{};
    for (int i = 0; i < 40; ++i) a.in[i] = d_in[i];
    a.out = (float*)d_out; a.ws = (unsigned char*)d_ws;
#if MK_ONE_LAUNCH
    a.ph_lo = 0; a.ph_hi = N_PHASES;
    hipLaunchKernelGGL(mk_fwd, dim3(grid), dim3(NTHR), LDS_BYTES, stream, a);
#else
    for (int p = 0; p < N_PHASES; ++p) { a.ph_lo = p; a.ph_hi = p + 1; hipLaunchKernelGGL(mk_fwd, dim3(grid), dim3(NTHR), LDS_BYTES, stream, a); }
#endif
    const hipError_t le = hipPeekAtLastError();
    if (le != hipSuccess) fprintf(stderr, "kernel_launch: launch failed: %s\n", hipGetErrorName(le));
}
```

```cpp
#include <hip/hip_runtime.h>
#include <cstdio>
#include <cstdint>

#define DI __device__ __forceinline__
#define LAS __attribute__((address_space(3)))
#define GAS __attribute__((address_space(1)))
typedef unsigned short bf16;
typedef short bf16x8 __attribute__((ext_vector_type(8)));
typedef float f32x4 __attribute__((ext_vector_type(4)));
typedef float f32x2 __attribute__((ext_vector_type(2)));
typedef unsigned u32x4 __attribute__((ext_vector_type(4)));
typedef unsigned u32x2 __attribute__((ext_vector_type(2)));
typedef unsigned char uchar;

#ifndef PROBE_TS
#define PROBE_TS 0
#endif
#ifndef PROBE_SCAN2
#define PROBE_SCAN2 0
#endif
#ifndef PROBE_ATT2
#define PROBE_ATT2 0
#endif
#ifndef PROBE_CONV2
#define PROBE_CONV2 0
#endif
#ifndef PROBE_TS_A
#define PROBE_TS_A 6
#endif
#ifndef PROBE_TS_B
#define PROBE_TS_B 6
#endif
constexpr int NB = 8, NS = 4096, NT = NB * NS, DM = 1024, NPJ = 3328, NE = 32, FF = 1024, NLAYER = 2;
constexpr int PJ_A = 0, PJ_B = 1024, PJ_C = 1792, PJ_D = 2560;
constexpr int NR = NT * 4 + NE * 256;
constexpr int NTHR = 512, NWAVE = 8;

DI float bf2f(unsigned v) { return __builtin_bit_cast(float, v << 16); }
DI unsigned f2bf(float f) { unsigned u = __builtin_bit_cast(unsigned, f); return (u + 0x7fffu + ((u >> 16) & 1u)) >> 16; }
DI unsigned pk2(float lo, float hi) { return f2bf(lo) | (f2bf(hi) << 16); }
DI float bflo(unsigned w) { return __builtin_bit_cast(float, w << 16); }
DI float bfhi(unsigned w) { return __builtin_bit_cast(float, w & 0xffff0000u); }
DI float fexp2(float x) { return __builtin_amdgcn_exp2f(x); }
DI float fsigmoid(float x) { return __builtin_amdgcn_rcpf(1.f + __builtin_amdgcn_exp2f(-1.44269504089f * x)); }
DI float wsum_xor(float v, int o) { return v + __shfl_xor(v, o); }
template <int CTRL> DI float dppmov(float x) { return __builtin_bit_cast(float, __builtin_amdgcn_update_dpp(0, __builtin_bit_cast(int, x), CTRL, 0xF, 0xF, true)); }
template <int W> DI float group_sum(float v) {
    if (W >= 2) v += dppmov<0xB1>(v);
    if (W >= 4) v += dppmov<0x4E>(v);
    if (W >= 8) v += dppmov<0x141>(v);
    if (W >= 16) v += dppmov<0x140>(v);
    if (W >= 32) v += __shfl_xor(v, 16);
    if (W >= 64) v += __shfl_xor(v, 32);
    return v;
}
DI float sum8(float x) { x += dppmov<0xB1>(x); x += dppmov<0x4E>(x); x += dppmov<0x141>(x); return x; }

#define XB_TMO      128
#define XB_XCNT(j)  (256  + 64 * (j))
#define XB_XSUB(j)  (1280 + 64 * (j))
#define XB_XGEN(j)  (2304 + 64 * (j))
#define XB_TOP      3328
#define XB_TOPGEN   3392
#define XCD_BAR_WORDS 3456
#define XB_SPIN_CAP (1u << 18)
DI unsigned xb_ld(unsigned* p)              { return __hip_atomic_load(p, __ATOMIC_RELAXED, __HIP_MEMORY_SCOPE_AGENT); }
DI unsigned xb_add(unsigned* p, unsigned v) { return __hip_atomic_fetch_add(p, v, __ATOMIC_RELAXED, __HIP_MEMORY_SCOPE_AGENT); }
DI unsigned xb_xcc_id() { return (unsigned)__builtin_amdgcn_s_getreg((3 << 11) | 20) & 0xFu; }
#define XB_SPIN(cond, bar) do { unsigned _sp = 0; while (cond) { __builtin_amdgcn_s_sleep(1); \
    if ((++_sp & 255u) == 0u) { if (xb_ld(&(bar)[XB_TMO])) break; if (_sp > XB_SPIN_CAP) { atomicAdd(&(bar)[XB_TMO], 1u); break; } } } } while (0)
struct XcdBarrier { unsigned* bar; unsigned x; volatile LAS unsigned* st; };
DI XcdBarrier xcd_barrier_post(unsigned* bar, volatile LAS unsigned* st) {
    XcdBarrier b; b.bar = bar; b.x = xb_xcc_id(); b.st = st;
    if (threadIdx.x == 0) (void)xb_add(&bar[XB_XCNT(b.x)], 1u);
    return b;
}
DI void xcd_barrier_complete(unsigned* bar, unsigned x, unsigned& nloc, unsigned& nx) {
    const unsigned G = gridDim.x * gridDim.y * gridDim.z;
    unsigned sum, cnt, mine, sp = 0u;
    for (;;) {
        sum = 0u; cnt = 0u; mine = 0u;
#pragma unroll
        for (unsigned j = 0; j < 16; ++j) { const unsigned c = xb_ld(&bar[XB_XCNT(j)]); sum += c; cnt += (c > 0u) ? 1u : 0u; mine = (j == x) ? c : mine; }
        if (sum == G) break;
        __builtin_amdgcn_s_sleep(1);
        if ((++sp & 255u) == 0u) { if (xb_ld(&bar[XB_TMO])) break; if (sp > XB_SPIN_CAP) { atomicAdd(&bar[XB_TMO], 1u); break; } }
    }
    nloc = mine > 0u ? mine : 1u; nx = cnt > 0u ? cnt : 1u;
}
DI void xcd_barrier(const XcdBarrier& b) {
    asm volatile("s_waitcnt vmcnt(0)" ::: "memory");
    __syncthreads();
    if (threadIdx.x == 0) {
        unsigned* bar = b.bar;
        __builtin_amdgcn_s_waitcnt(0);
        unsigned nloc = b.st[0], nx = b.st[1];
        if (nloc == 0u) { xcd_barrier_complete(bar, b.x, nloc, nx); b.st[0] = nloc; b.st[1] = nx; }
        const unsigned old = xb_add(&bar[XB_XSUB(b.x)], 1u);
        const unsigned gen = old / nloc;
        if (old + 1u == (gen + 1u) * nloc) {
            __builtin_amdgcn_fence(__ATOMIC_RELEASE, "agent");
            asm volatile("s_waitcnt vmcnt(0)" ::: "memory");
            const unsigned og = xb_add(&bar[XB_TOP], 1u);
            const unsigned tg = og / nx;
            if (og + 1u == (tg + 1u) * nx) xb_add(&bar[XB_TOPGEN], 1u);
            else XB_SPIN(xb_ld(&bar[XB_TOPGEN]) == tg, bar);
            __builtin_amdgcn_fence(__ATOMIC_ACQUIRE, "agent");
            xb_add(&bar[XB_XGEN(b.x)], 1u);
            asm volatile("s_waitcnt vmcnt(0)" ::: "memory");
        } else {
            XB_SPIN(xb_ld(&bar[XB_XGEN(b.x)]) == gen, bar);
            __builtin_amdgcn_fence(__ATOMIC_ACQUIRE, "agent");
            asm volatile("s_waitcnt vmcnt(0)" ::: "memory");
        }
    }
    __syncthreads();
}
namespace pg8 {
constexpr int BM = 256, BK = 64, HALF = 128, HTB = HALF * BK * 2, STAGE_BYTES = 8 * HTB, NXCD = 8, WGM = 8;
__host__ __device__ __forceinline__ int lds_byte(int r, int c) { const int st = (r >> 4) * 2 + (c >> 5), rr = r & 15, cc = c & 31, ob = rr * 64 + cc * 2; return st * 1024 + (ob ^ (((ob >> 9) & 1) << 5)); }
__host__ __device__ __forceinline__ void stage_rc(int b, int& R, int& C) { const int st = b / 1024, sb = b % 1024, swz = sb ^ (((sb >> 9) & 1) << 5); R = (st >> 1) * 16 + swz / 64; C = (st & 1) * 32 + (swz % 64) / 2; }
__host__ __device__ __forceinline__ int perm32(int rho) { const int n = rho >> 4, i = rho & 15; return 8 * (i >> 2) + 4 * n + (i & 3); }

struct Unit { int pm, pn, brow, e; };
struct Gemm { const bf16* A; const bf16* Bt; int lda, K; const int* rowmap; int rowmask; };

struct StaticOrder {
    int nM, nN, nwg, G, c;
    __device__ void init(int nM_, int nN_, int G_, int c_) { nM = nM_; nN = nN_; nwg = nM * nN; G = G_; c = c_; }
    __device__ bool tile(int i, int& pm, int& pn) const {
        const long L = (long)i * G + c; if (L >= nwg) return false;
        int wgid = (int)L; { const int q = nwg / NXCD, r = nwg % NXCD, xcd = wgid % NXCD, off = wgid / NXCD; wgid = (xcd < r ? xcd * (q + 1) : r * (q + 1) + (xcd - r) * q) + off; }
        const int nig = WGM * nN, gid = wgid / nig, fm = gid * WGM, gsz = (nM - fm) < WGM ? (nM - fm) : WGM;
        pm = fm + ((wgid % nig) % gsz); pn = (wgid % nig) / gsz; return true;
    }
    __device__ bool next(int i, Unit& u) const { if (!tile(i, u.pm, u.pn)) return false; u.brow = u.pn * BM; u.e = 0; return true; }
};
struct GroupedOrder : StaticOrder {
    const LAS int* tstart; int nrow_e;
    __device__ bool next(int i, Unit& u) const {
        if (!tile(i, u.pm, u.pn)) return false;
        int e = 0;
#pragma unroll 1
        for (int j = 16; j > 0; j >>= 1) if (tstart[e + j] <= u.pm) e += j;
        u.e = e; u.brow = e * nrow_e + u.pn * BM; return true;
    }
};
DI unsigned cvt_pk_bf16(float lo, float hi) { unsigned r; asm volatile("v_cvt_pk_bf16_f32 %0, %1, %2" : "=v"(r) : "v"(lo), "v"(hi)); return r; }

template <class Epi, class Sched, bool GATHER = false, bool FP8 = false>
DI void gemm_phase(LAS unsigned char* lds, const int tid, const Gemm g, const Sched& S, const Epi& E) {
    const int wid = __builtin_amdgcn_readfirstlane(tid >> 6), lane = tid & 63, wr = wid >> 2, wc = wid & 3, fr = lane & 15, fq = lane >> 4;
    int K = g.K, lda = g.lda; asm volatile("" : "+s"(K), "+s"(lda));
    const int nt = K / BK;
    unsigned voffA[2], voffB[2]; int Ra[2], Ca[2];
#pragma unroll
    for (int i = 0; i < 2; ++i) { int R, C; stage_rc(tid * 16 + i * 8192, R, C); const int Rb = Epi::PERM ? ((R & ~31) + perm32(R & 31)) : R; Ra[i] = R; Ca[i] = C;
        voffA[i] = (unsigned)(R * lda + C) * 2u; voffB[i] = (unsigned)(Rb * K + C) * 2u; }
    unsigned vgc[2][2]; int rawn[2][2];
#define PG8_GLOAD(dst, pm_) do { _Pragma("unroll") for (int _h = 0; _h < 2; ++_h) _Pragma("unroll") for (int _i = 0; _i < 2; ++_i) { const int* _p = g.rowmap + (size_t)(pm_) * BM + _h * HALF + Ra[_i]; \
        asm volatile("global_load_dword %0, %1, off" : "=v"(dst[_h][_i]) : "v"(_p) : "memory"); } } while (0)
#define PG8_GCONV(vg, raw) do { _Pragma("unroll") for (int _h = 0; _h < 2; ++_h) _Pragma("unroll") for (int _i = 0; _i < 2; ++_i) { int _r = raw[_h][_i]; asm volatile("" : "+v"(_r)); \
        vg[_h][_i] = (unsigned)((_r & g.rowmask) * lda + Ca[_i]) * 2u; } } while (0)
#define PG8_STAGE_A(bufoff, kptr, h, vg) do { if (GATHER) PG8_STAGE(bufoff, kptr, vg[h]); else PG8_STAGE(bufoff, (kptr) + (h) * hstepA, voffA); } while (0)
    const size_t kstep = (size_t)(BK * 2);
    const size_t hstepA = (size_t)HALF * lda * 2, hstepB = (size_t)HALF * K * 2;
    const size_t tstepA = 2 * hstepA;
    const unsigned ldsw = (unsigned)wid * 1024u;
    const int aoff = lds_byte(wr * 64 + fr, fq * 8), boff = lds_byte(wc * 32 + fr, fq * 8);
#define PG8_SA(b, h) (((b) * 2 + (h)) * HTB)
#define PG8_SB(b, h) ((4 + (b) * 2 + (h)) * HTB)
#define PG8_STAGE(bufoff, gbase, voff) do { _Pragma("unroll") for (int _i = 0; _i < 2; ++_i) \
        __builtin_amdgcn_global_load_lds((const unsigned*)((const char*)(gbase) + (voff)[_i]), (LAS unsigned*)(lds + (bufoff) + ldsw + _i * 8192), 16, 0, 0); } while (0)
#define PG8_LDA(dst, b, h) do { _Pragma("unroll") for (int m = 0; m < 4; ++m) { const v4i_ lo_ = *(const LAS v4i_*)(lds + PG8_SA(b, h) + aoff + m * 2048), hi_ = *(const LAS v4i_*)(lds + PG8_SA(b, h) + aoff + m * 2048 + 1024); \
        dst[m] = __builtin_shufflevector(lo_, hi_, 0, 1, 2, 3, 4, 5, 6, 7); } } while (0)
#define PG8_LDB(dst, b, h) do { _Pragma("unroll") for (int n = 0; n < 2; ++n) { const v4i_ lo_ = *(const LAS v4i_*)(lds + PG8_SB(b, h) + boff + n * 2048), hi_ = *(const LAS v4i_*)(lds + PG8_SB(b, h) + boff + n * 2048 + 1024); \
        dst[n] = __builtin_shufflevector(lo_, hi_, 0, 1, 2, 3, 4, 5, 6, 7); } } while (0)
#define PG8_MMA(ai, bj, At, Bt) do { __builtin_amdgcn_s_setprio(1); _Pragma("unroll") for (int m = 0; m < 4; ++m) _Pragma("unroll") for (int n = 0; n < 2; ++n) { \
        if (FP8) acc[ai][bj][m][n] = __builtin_amdgcn_mfma_scale_f32_16x16x128_f8f6f4(Bt[n], At[m], acc[ai][bj][m][n], 0, 0, 0, 0x7F7F7F7F, 0, 0x7F7F7F7F); \
        else { const v8i_ b_ = Bt[n], a_ = At[m]; \
            acc[ai][bj][m][n] = __builtin_amdgcn_mfma_f32_16x16x32_bf16(__builtin_bit_cast(bf16x8, __builtin_shufflevector(b_, b_, 0, 1, 2, 3)), __builtin_bit_cast(bf16x8, __builtin_shufflevector(a_, a_, 0, 1, 2, 3)), acc[ai][bj][m][n], 0, 0, 0); \
            acc[ai][bj][m][n] = __builtin_amdgcn_mfma_f32_16x16x32_bf16(__builtin_bit_cast(bf16x8, __builtin_shufflevector(b_, b_, 4, 5, 6, 7)), __builtin_bit_cast(bf16x8, __builtin_shufflevector(a_, a_, 4, 5, 6, 7)), acc[ai][bj][m][n], 0, 0, 0); } } \
        __builtin_amdgcn_s_setprio(0); } while (0)
#define PG8_WAIT_V(n) asm volatile("s_waitcnt vmcnt(" #n ")" ::: "memory")
#define PG8_WAIT_L(n) asm volatile("s_waitcnt lgkmcnt(" #n ")" ::: "memory")
#define PG8_BAR __builtin_amdgcn_s_barrier()
#define PG8_SCHED __builtin_amdgcn_sched_barrier(0)
    Unit cur, nxt; int ui = 0;
    if (!S.next(0, cur)) return;
    f32x4 acc[2][2][4][2];
#pragma unroll
    for (int a = 0; a < 2; ++a)
#pragma unroll
        for (int b = 0; b < 2; ++b)
#pragma unroll
            for (int m = 0; m < 4; ++m)
#pragma unroll
                for (int n = 0; n < 2; ++n) acc[a][b][m][n] = (f32x4){0.f, 0.f, 0.f, 0.f};
    typedef int v8i_ __attribute__((ext_vector_type(8))); typedef int v4i_ __attribute__((ext_vector_type(4)));
    v8i_ At[4], B0[2], B1[2];
    const char* cA = (const char*)g.A + (GATHER ? (size_t)0 : (size_t)cur.pm * tstepA); const char* cB = (const char*)g.Bt + (size_t)cur.brow * K * 2;
    if (GATHER) { PG8_GLOAD(rawn, cur.pm); asm volatile("s_waitcnt vmcnt(0)" : "+v"(rawn[0][0]), "+v"(rawn[0][1]), "+v"(rawn[1][0]), "+v"(rawn[1][1]) :: "memory"); PG8_GCONV(vgc, rawn); }
    PG8_STAGE(PG8_SB(0, 0), cB, voffB); PG8_STAGE(PG8_SB(0, 1), cB + hstepB, voffB); PG8_STAGE_A(PG8_SA(0, 0), cA, 0, vgc); PG8_STAGE_A(PG8_SA(0, 1), cA, 1, vgc);
    if (wr == 1) PG8_BAR;
    PG8_WAIT_V(2); PG8_BAR;
    PG8_STAGE(PG8_SB(1, 0), cB + kstep, voffB); PG8_STAGE_A(PG8_SA(1, 0), cA + kstep, 0, vgc); PG8_STAGE(PG8_SB(1, 1), cB + hstepB + kstep, voffB);
    PG8_WAIT_V(6); PG8_BAR;
    for (;;) {
        const bool has_next = S.next(ui + 1, nxt);
        const char* nA = (has_next && !GATHER) ? (const char*)g.A + (size_t)nxt.pm * tstepA : cA;
        if (GATHER && has_next) PG8_GLOAD(rawn, nxt.pm); const char* nB = has_next ? (const char*)g.Bt + (size_t)nxt.brow * K * 2 : cB;
#pragma unroll 1
        for (int t = 0; t < nt; t += 2) {
            const bool last = (t == nt - 2);
            const char* a1 = cA + (size_t)(t + 1) * kstep;
            const char* a2 = last ? nA : cA + (size_t)(t + 2) * kstep; const char* b2 = last ? nB : cB + (size_t)(t + 2) * kstep;
            const char* a3 = a2 + kstep; const char* b3 = b2 + kstep;
            PG8_LDB(B0, 0, 0); PG8_LDB(B1, 0, 1); PG8_SCHED; PG8_LDA(At, 0, 0); PG8_STAGE_A(PG8_SA(1, 1), a1, 1, vgc);
            if (GATHER) { if (last && has_next) PG8_GCONV(vgc, rawn); }
            PG8_WAIT_V(8); PG8_WAIT_L(0); PG8_BAR; PG8_MMA(0, 0, At, B0); PG8_MMA(0, 1, At, B1); PG8_BAR; PG8_SCHED;
            PG8_LDA(At, 0, 1); PG8_STAGE(PG8_SB(0, 0), b2, voffB); PG8_STAGE(PG8_SB(0, 1), b2 + hstepB, voffB); PG8_STAGE_A(PG8_SA(0, 0), a2, 0, vgc);
            PG8_WAIT_V(8); PG8_WAIT_L(0); PG8_BAR; PG8_MMA(1, 0, At, B0); PG8_MMA(1, 1, At, B1); PG8_BAR; PG8_SCHED;
            PG8_LDB(B0, 1, 0); PG8_LDB(B1, 1, 1); PG8_SCHED; PG8_LDA(At, 1, 0); PG8_STAGE_A(PG8_SA(0, 1), a2, 1, vgc);
            PG8_WAIT_V(8); PG8_WAIT_L(0); PG8_BAR; PG8_MMA(0, 0, At, B0); PG8_MMA(0, 1, At, B1); PG8_BAR; PG8_SCHED;
            PG8_LDA(At, 1, 1); PG8_STAGE(PG8_SB(1, 0), b3, voffB); PG8_STAGE(PG8_SB(1, 1), b3 + hstepB, voffB); PG8_STAGE_A(PG8_SA(1, 0), a3, 0, vgc);
            PG8_WAIT_V(8); PG8_WAIT_L(0); PG8_BAR; PG8_MMA(1, 0, At, B0); PG8_MMA(1, 1, At, B1); PG8_BAR; PG8_SCHED;
        }
        if (wr == 0) PG8_BAR;
        { int fr2 = fr, fq2 = fq; asm volatile("" : "+v"(fr2), "+v"(fq2)); E(acc, cur, wr, wc, fr2, fq2); }
        if (!has_next) break;
#pragma unroll
        for (int a = 0; a < 2; ++a)
#pragma unroll
            for (int b = 0; b < 2; ++b)
#pragma unroll
                for (int m = 0; m < 4; ++m)
#pragma unroll
                    for (int n = 0; n < 2; ++n) acc[a][b][m][n] = (f32x4){0.f, 0.f, 0.f, 0.f};
        cur = nxt; cA = nA; cB = nB; ++ui;
        if (wr == 1) PG8_BAR;
    }
    PG8_WAIT_V(0);
    PG8_BAR;
#undef PG8_SA
#undef PG8_SB
#undef PG8_STAGE
#undef PG8_STAGE_A
#undef PG8_GLOAD
#undef PG8_GCONV
#undef PG8_LDA
#undef PG8_LDB
#undef PG8_MMA
#undef PG8_WAIT_V
#undef PG8_WAIT_L
#undef PG8_BAR
#undef PG8_SCHED
}
}
constexpr size_t MiB = 1u << 20;
constexpr size_t WS_CTL = 0;
constexpr size_t WS_LORA = 1 * MiB;
constexpr size_t WS_WK2 = 2 * MiB;
constexpr size_t ZERO_BYTES = 3 * MiB;
constexpr size_t WS_WIN = 3 * MiB;
constexpr size_t WS_WOUT = 17 * MiB;
constexpr size_t WS_WK1 = 21 * MiB;
constexpr size_t WS_SMALL = 25 * MiB;
constexpr size_t WS_ROUTE = 27 * MiB;
constexpr size_t WS_WGU = 32 * MiB;
constexpr size_t WS_WDN = 288 * MiB;
constexpr size_t WS_H = 416 * MiB;
constexpr size_t WS_R = 480 * MiB;
constexpr size_t R_PROJ = WS_R;
constexpr size_t R_SC = R_PROJ + 208 * MiB;
constexpr size_t R_LIN = R_SC + 192 * MiB;
constexpr size_t R_G = R_LIN + 16 * MiB;
constexpr size_t R_YA = R_G + 32 * MiB;
constexpr size_t R_YCAT = R_YA + 32 * MiB;
constexpr size_t R_QC = R_YCAT + 64 * MiB;
constexpr size_t R_KC = R_QC + 16 * MiB;
constexpr size_t R_OC = R_KC + 16 * MiB;
constexpr size_t R_LSE = R_OC + 96 * MiB;
constexpr size_t R_QN = R_LSE + 2 * MiB;
constexpr size_t R_QR = R_QN + 16 * MiB;
constexpr size_t R_KCR = R_QR + 16 * MiB;
constexpr size_t R_VCR = R_KCR + 5 * MiB;
constexpr size_t R_KS = R_VCR + 5 * MiB;
constexpr size_t R_KW = R_KS + 4 * MiB;
constexpr size_t R_GATE = R_KW + 4 * MiB;
constexpr size_t R_CH1 = R_GATE + 2 * MiB;
constexpr size_t R_CMP = R_CH1 + 2 * MiB;
constexpr size_t R_OCMP = R_CMP + 1 * MiB;
constexpr size_t R_OSLC = R_OCMP + 32 * MiB;
constexpr size_t R_OSWA = R_OSLC + 32 * MiB;
constexpr size_t R_SCANU = R_OSWA;
constexpr size_t R_SCANS = R_OSWA + 16 * MiB;
constexpr size_t R_IMP = R_OSWA + 32 * MiB;
constexpr size_t R_SELM = R_IMP + 8 * MiB;
constexpr size_t R_MIX_END = R_SELM + 1 * MiB;
constexpr size_t R_XS = WS_R;
constexpr size_t R_ACT = R_XS + 272 * MiB;
constexpr size_t R_YB = R_ACT + 272 * MiB;
constexpr size_t R_MOE_END = R_YB + 272 * MiB;
constexpr size_t WS_END = (R_MIX_END > R_MOE_END ? R_MIX_END : R_MOE_END);
static_assert((size_t)NR * 1024 * 2 <= 272 * MiB, "sorted buffers");
constexpr int CW_BAR = 4096;
constexpr int CW_CNT = 16384;
constexpr int CW_CUR = 16384 + 64;

constexpr int RING_BYTES = 131072;
constexpr int MISC_OFF = RING_BYTES;
constexpr int LDS_BYTES = 155648;

struct Args { const void* in[40]; float* out; unsigned char* ws; int ph_lo, ph_hi; };

struct Ctx {
    LAS unsigned char* lds; int tid, lane, wave, G, bid;
    const float *x, *c, *w_ada, *b_ada, *norm1_g, *norm2_g, *w_in, *w_out, *mu, *w0, *w2, *a0, *a2, *g2, *kkw, *ka, *rk, *gn_w, *gn_b, *conv_w, *dil_q_g, *dil_k_g,
        *nsa_q_g, *nsa_kc_g, *nsa_ks_g, *nsa_kw_g, *pe_k, *pe_v, *wk1, *wk2, *wv1, *wv2, *onorm_g, *w_router, *b_router, *w_gu, *b_gu, *w_down, *b_down;
    const int* pos;
    float* out; unsigned char* ws;
};
#define WSP(T, off) ((T*)(C.ws + (off)))

typedef f32x4 Acc[2][2][4][2];
struct EpiProj {
    static constexpr bool PERM = true; bf16* O;
    DI void operator()(const Acc& acc, const pg8::Unit& u, int wr, int wc, int fr, int fq) const {
        const int row0 = u.pm * 256 + wr * 64 + fr, col0 = u.pn * 256 + wc * 32 + 8 * fq;
#pragma unroll
        for (int ai = 0; ai < 2; ++ai)
#pragma unroll
            for (int m = 0; m < 4; ++m) { bf16* rowp = O + (size_t)(row0 + ai * 128 + m * 16) * NPJ + col0;
#pragma unroll
                for (int bj = 0; bj < 2; ++bj) { const f32x4 v0 = acc[ai][bj][m][0], v1 = acc[ai][bj][m][1]; u32x4 w;
                    w.x = pg8::cvt_pk_bf16(v0[0], v0[1]); w.y = pg8::cvt_pk_bf16(v0[2], v0[3]); w.z = pg8::cvt_pk_bf16(v1[0], v1[1]); w.w = pg8::cvt_pk_bf16(v1[2], v1[3]);
                    *(u32x4*)(rowp + bj * 128) = w; } }
    }
};
struct EpiLora {
    static constexpr bool PERM = false; float* SC; float* Gb; const float *w0, *a0, *ka; float* SCo;
    DI void operator()(const Acc& acc, const pg8::Unit& u, int wr, int wc, int fr, int fq) const {
        const int row0 = u.pm * 256 + wr * 64 + fr, col0 = wc * 32 + 4 * fq;
        if (u.pn == 0) {
#pragma unroll
            for (int bj = 0; bj < 2; ++bj)
#pragma unroll
                for (int n = 0; n < 2; ++n) { const int ch = col0 + bj * 128 + n * 16; const f32x4 b = *(const f32x4*)(w0 + ch);
#pragma unroll
                    for (int ai = 0; ai < 2; ++ai)
#pragma unroll
                        for (int m = 0; m < 4; ++m) { const size_t o = (size_t)(row0 + ai * 128 + m * 16) * 256 + ch; const f32x4 v = acc[ai][bj][m][n] + b; f32x4 r;
#pragma unroll
                            for (int j = 0; j < 4; ++j) r[j] = __expf(-0.606531f * fsigmoid(v[j]));
                            *(f32x4*)(SCo + o) = r; } }
        } else if (u.pn == 1) {
#pragma unroll
            for (int bj = 0; bj < 2; ++bj)
#pragma unroll
                for (int n = 0; n < 2; ++n) { const int ch = col0 + bj * 128 + n * 16; const f32x4 b = *(const f32x4*)(a0 + ch), kav = *(const f32x4*)(ka + ch);
#pragma unroll
                    for (int ai = 0; ai < 2; ++ai)
#pragma unroll
                        for (int m = 0; m < 4; ++m) { __builtin_amdgcn_sched_barrier(0); const size_t o = (size_t)(row0 + ai * 128 + m * 16) * 256 + ch; const f32x4 v = acc[ai][bj][m][n] + b;
                            float* pk = SC + (size_t)1 * NT * 256 + o; const f32x4 kr = *(const f32x4*)pk, kn = *(const f32x4*)(SC + (size_t)2 * NT * 256 + o); f32x4 k2, bb;
#pragma unroll
                            for (int j = 0; j < 4; ++j) { const float a = fsigmoid(v[j]); k2[j] = kr[j] * (1.f + (a - 1.f) * kav[j]); bb[j] = kn[j] * a; }
                            *(f32x4*)(SCo + (size_t)1 * NT * 256 + o) = k2; *(f32x4*)(SCo + (size_t)3 * NT * 256 + o) = bb; } }
        } else {
#pragma unroll
            for (int bj = 0; bj < 2; ++bj)
#pragma unroll
                for (int n = 0; n < 2; ++n) { const int ch = col0 + bj * 128 + n * 16;
#pragma unroll
                    for (int ai = 0; ai < 2; ++ai)
#pragma unroll
                        for (int m = 0; m < 4; ++m) { const size_t o = (size_t)(row0 + ai * 128 + m * 16) * 256 + ch; *(f32x4*)(Gb + o) = acc[ai][bj][m][n]; } }
        }
    }
};
DI float gelu_tanh(float x) { const float t = 0.7978845608f * (x + 0.044715f * x * x * x); return x * fsigmoid(2.f * t); }
struct EpiC1 {
    static constexpr bool PERM = true; bf16* O; const float* peb;
    DI void operator()(const Acc& acc, const pg8::Unit& u, int wr, int wc, int fr, int fq) const {
        const int row0 = u.pm * 256 + wr * 64 + fr, col0 = wc * 32 + 8 * fq;
#pragma unroll
        for (int bj = 0; bj < 2; ++bj) { const f32x4 b0 = *(const f32x4*)(peb + col0 + bj * 128), b1 = *(const f32x4*)(peb + col0 + bj * 128 + 4);
#pragma unroll
            for (int ai = 0; ai < 2; ++ai)
#pragma unroll
                for (int m = 0; m < 4; ++m) { bf16* p = O + (size_t)(row0 + ai * 128 + m * 16) * 256 + col0 + bj * 128; const f32x4 v0 = acc[ai][bj][m][0] + b0, v1 = acc[ai][bj][m][1] + b1; u32x4 w;
                    w.x = pk2(gelu_tanh(v0[0]), gelu_tanh(v0[1])); w.y = pk2(gelu_tanh(v0[2]), gelu_tanh(v0[3])); w.z = pk2(gelu_tanh(v1[0]), gelu_tanh(v1[1])); w.w = pk2(gelu_tanh(v1[2]), gelu_tanh(v1[3]));
                    *(u32x4*)p = w; } }
    }
};
struct EpiC2 {
    static constexpr bool PERM = false; float* O;
    DI void operator()(const Acc& acc, const pg8::Unit& u, int wr, int wc, int fr, int fq) const {
        if (wc >= 2) return;
        const int row0 = u.pm * 256 + wr * 64 + fr, col0 = wc * 32 + 4 * fq;
#pragma unroll
        for (int ai = 0; ai < 2; ++ai)
#pragma unroll
            for (int m = 0; m < 4; ++m)
#pragma unroll
                for (int n = 0; n < 2; ++n) *(f32x4*)(O + (size_t)(row0 + ai * 128 + m * 16) * 64 + col0 + n * 16) = acc[ai][0][m][n];
    }
};
struct EpiOut {
    static constexpr bool PERM = false; float* O; const float* xin; const float* gt;
    DI void operator()(const Acc& acc, const pg8::Unit& u, int wr, int wc, int fr, int fq) const {
        const int row0 = u.pm * 256 + wr * 64 + fr, col0 = u.pn * 256 + wc * 32 + 4 * fq; const int b = (u.pm * 256) / NS;
#pragma unroll
        for (int bj = 0; bj < 2; ++bj)
#pragma unroll
            for (int n = 0; n < 2; ++n) { const int col = col0 + bj * 128 + n * 16; const f32x4 g = *(const f32x4*)(gt + (size_t)b * 6144 + col);
#pragma unroll
                for (int ai = 0; ai < 2; ++ai)
#pragma unroll
                    for (int m = 0; m < 4; ++m) { const size_t o = (size_t)(row0 + ai * 128 + m * 16) * DM + col; *(f32x4*)(O + o) = *(const f32x4*)(xin + o) + g * acc[ai][bj][m][n]; } }
    }
};
struct EpiGU {
    static constexpr bool PERM = true; bf16* O; const float* bgu;
    DI void operator()(const Acc& acc, const pg8::Unit& u, int wr, int wc, int fr, int fq) const {
        const int row0 = u.pm * 256 + wr * 64 + fr, cc = u.pn * 128 + wc * 32 + 8 * fq; const float* bp = bgu + (size_t)u.e * 2048 + cc;
        const f32x4 g0 = *(const f32x4*)bp, g1 = *(const f32x4*)(bp + 4), u0 = *(const f32x4*)(bp + 1024), u1 = *(const f32x4*)(bp + 1028);
#pragma unroll
        for (int ai = 0; ai < 2; ++ai)
#pragma unroll
            for (int m = 0; m < 4; ++m) { bf16* p = O + (size_t)(row0 + ai * 128 + m * 16) * FF + cc; float r[8];
#pragma unroll
                for (int n = 0; n < 2; ++n) { const f32x4 gv = acc[ai][0][m][n] + (n ? g1 : g0), uv = acc[ai][1][m][n] + (n ? u1 : u0);
#pragma unroll
                    for (int j = 0; j < 4; ++j) { const float ga = fminf(gv[j], 7.f), up = fminf(fmaxf(uv[j], -7.f), 7.f); r[4 * n + j] = ga * fsigmoid(1.702f * ga) * (up + 1.f); } }
                u32x4 w; w.x = pk2(r[0], r[1]); w.y = pk2(r[2], r[3]); w.z = pk2(r[4], r[5]); w.w = pk2(r[6], r[7]); *(u32x4*)p = w; }
    }
};
struct EpiDN {
    static constexpr bool PERM = true; bf16* O; const float* bd;
    DI void operator()(const Acc& acc, const pg8::Unit& u, int wr, int wc, int fr, int fq) const {
        const int row0 = u.pm * 256 + wr * 64 + fr, col0 = u.pn * 256 + wc * 32 + 8 * fq; const float* bp = bd + (size_t)u.e * 1024 + col0;
#pragma unroll
        for (int bj = 0; bj < 2; ++bj) { const f32x4 b0 = *(const f32x4*)(bp + bj * 128), b1 = *(const f32x4*)(bp + bj * 128 + 4);
#pragma unroll
            for (int ai = 0; ai < 2; ++ai)
#pragma unroll
                for (int m = 0; m < 4; ++m) { bf16* p = O + (size_t)(row0 + ai * 128 + m * 16) * DM + col0 + bj * 128; const f32x4 v0 = acc[ai][bj][m][0] + b0, v1 = acc[ai][bj][m][1] + b1; u32x4 w;
                    w.x = pk2(v0[0], v0[1]); w.y = pk2(v0[2], v0[3]); w.z = pk2(v1[0], v1[1]); w.w = pk2(v1[2], v1[3]); *(u32x4*)p = w; } }
    }
};
DI float clamp8(float x) { return fminf(fmaxf(x, -448.f), 448.f); }
DI unsigned pk4_fp8_nc(float a, float b, float c, float d) { unsigned w = 0u; w = __builtin_amdgcn_cvt_pk_fp8_f32(a, b, w, false); w = __builtin_amdgcn_cvt_pk_fp8_f32(c, d, w, true); return w; }
DI unsigned pk4_fp8(float a, float b, float c, float d) { unsigned w = 0u; w = __builtin_amdgcn_cvt_pk_fp8_f32(clamp8(a), clamp8(b), w, false); w = __builtin_amdgcn_cvt_pk_fp8_f32(clamp8(c), clamp8(d), w, true); return w; }
constexpr float W8_SCALE = 32.f, W8_INV = 1.f / 32.f;
struct EpiGU8 {
    static constexpr bool PERM = true; unsigned char* O; const float* bgu;
    DI void operator()(const Acc& acc, const pg8::Unit& u, int wr, int wc, int fr, int fq) const {
        const int row0 = u.pm * 256 + wr * 64 + fr, cc = u.pn * 128 + wc * 32 + 8 * fq; const float* bp = bgu + (size_t)u.e * 2048 + cc;
        const f32x4 g0 = *(const f32x4*)bp, g1 = *(const f32x4*)(bp + 4), u0 = *(const f32x4*)(bp + 1024), u1 = *(const f32x4*)(bp + 1028);
#pragma unroll
        for (int ai = 0; ai < 2; ++ai)
#pragma unroll
            for (int m = 0; m < 4; ++m) { unsigned char* p = O + (size_t)(row0 + ai * 128 + m * 16) * FF + cc; float r[8];
#pragma unroll
                for (int n = 0; n < 2; ++n) { const f32x4 gv = acc[ai][0][m][n] * W8_INV + (n ? g1 : g0), uv = acc[ai][1][m][n] * W8_INV + (n ? u1 : u0);
#pragma unroll
                    for (int j = 0; j < 4; ++j) { const float ga = fminf(gv[j], 7.f), up = __builtin_amdgcn_fmed3f(uv[j], -7.f, 7.f); const float sg = __builtin_amdgcn_rcpf(1.f + __builtin_amdgcn_exp2f(-2.45546695959f * ga)); r[4 * n + j] = (ga * sg) * (up + 1.f); } }
                u32x2 w; w.x = pk4_fp8_nc(r[0], r[1], r[2], r[3]); w.y = pk4_fp8_nc(r[4], r[5], r[6], r[7]); *(u32x2*)p = w; }
    }
};
struct EpiDN8 {
    static constexpr bool PERM = true; bf16* O; const float* bd;
    DI void operator()(const Acc& acc, const pg8::Unit& u, int wr, int wc, int fr, int fq) const {
        const int row0 = u.pm * 256 + wr * 64 + fr, col0 = u.pn * 256 + wc * 32 + 8 * fq; const float* bp = bd + (size_t)u.e * 1024 + col0;
#pragma unroll
        for (int bj = 0; bj < 2; ++bj) { const f32x4 b0 = *(const f32x4*)(bp + bj * 128), b1 = *(const f32x4*)(bp + bj * 128 + 4);
#pragma unroll
            for (int ai = 0; ai < 2; ++ai)
#pragma unroll
                for (int m = 0; m < 4; ++m) { bf16* p = O + (size_t)(row0 + ai * 128 + m * 16) * DM + col0 + bj * 128; const f32x4 v0 = acc[ai][bj][m][0] * W8_INV + b0, v1 = acc[ai][bj][m][1] * W8_INV + b1; u32x4 w;
                    w.x = pk2(v0[0], v0[1]); w.y = pk2(v0[2], v0[3]); w.z = pk2(v1[0], v1[1]); w.w = pk2(v1[2], v1[3]); *(u32x4*)p = w; } }
    }
};
DI void tr_item(const float* src, int ld_src, int scol0, int nvalid, int k0, bf16* dst, int ld_dst, int drow0, int dk0, LAS float* scr, int lane) {
    const int n4 = (lane & 7) * 4, kr = lane >> 3; f32x4 v[8];
#pragma unroll
    for (int i = 0; i < 8; ++i) v[i] = (n4 < nvalid) ? *(const f32x4*)(src + (size_t)(k0 + kr + 8 * i) * ld_src + scol0 + n4) : (f32x4){0.f, 0.f, 0.f, 0.f};
#pragma unroll
    for (int i = 0; i < 8; ++i) { LAS float* s = scr + (kr + 8 * i) * 33 + n4; s[0] = v[i][0]; s[1] = v[i][1]; s[2] = v[i][2]; s[3] = v[i][3]; }
    asm volatile("s_waitcnt lgkmcnt(0)" ::: "memory");
    const int c = lane & 7;
#pragma unroll
    for (int jq = 0; jq < 4; ++jq) { const int n = (lane >> 3) + 8 * jq; const LAS float* s = scr + (8 * c) * 33 + n;
        u32x4 o; o.x = pk2(s[0 * 33], s[1 * 33]); o.y = pk2(s[2 * 33], s[3 * 33]); o.z = pk2(s[4 * 33], s[5 * 33]); o.w = pk2(s[6 * 33], s[7 * 33]);
        *(u32x4*)(dst + (size_t)(drow0 + n) * ld_dst + dk0 + k0 + 8 * c) = o; }
    asm volatile("s_waitcnt lgkmcnt(0)" ::: "memory");
}
DI void tr_item8(const float* src, int ld_src, int scol0, int k0, unsigned char* dst, int ld_dst, int drow0, LAS float* scr, int lane) {
    const int n4 = (lane & 7) * 4, kr = lane >> 3; f32x4 v[8];
#pragma unroll
    for (int i = 0; i < 8; ++i) v[i] = *(const f32x4*)(src + (size_t)(k0 + kr + 8 * i) * ld_src + scol0 + n4);
#pragma unroll
    for (int i = 0; i < 8; ++i) { LAS float* s = scr + (kr + 8 * i) * 33 + n4; s[0] = v[i][0]; s[1] = v[i][1]; s[2] = v[i][2]; s[3] = v[i][3]; }
    asm volatile("s_waitcnt lgkmcnt(0)" ::: "memory");
    const int c = lane & 7;
#pragma unroll
    for (int jq = 0; jq < 4; ++jq) { const int n = (lane >> 3) + 8 * jq; const LAS float* s = scr + (8 * c) * 33 + n;
        u32x2 o; o.x = pk4_fp8(s[0 * 33] * W8_SCALE, s[1 * 33] * W8_SCALE, s[2 * 33] * W8_SCALE, s[3 * 33] * W8_SCALE); o.y = pk4_fp8(s[4 * 33] * W8_SCALE, s[5 * 33] * W8_SCALE, s[6 * 33] * W8_SCALE, s[7 * 33] * W8_SCALE);
        *(u32x2*)(dst + (size_t)(drow0 + n) * ld_dst + k0 + 8 * c) = o; }
    asm volatile("s_waitcnt lgkmcnt(0)" ::: "memory");
}
DI void conv_item(const Ctx& C, int l, int r, LAS float* scr) {
    constexpr int I_GU = 32 * 16 * 64;
    if (r < I_GU) { const int e = r / 1024, r2 = r % 1024, kb = r2 / 64, nb = r2 % 64, n0 = 32 * nb, j = n0 / 256, i = n0 % 256;
        const int scol0 = (i < 128) ? 128 * j + i : 1024 + 128 * j + (i - 128);
        tr_item8(C.w_gu + (size_t)(l * 32 + e) * 1024 * 2048, 2048, scol0, 64 * kb, WSP(unsigned char, WS_WGU) + (size_t)(l * 32 + e) * 2048 * 1024, 1024, n0, scr, C.lane); }
    else { r -= I_GU; const int e = r / 512, r2 = r % 512, kb = r2 / 32, nb = r2 % 32;
        tr_item8(C.w_down + (size_t)(l * 32 + e) * 1024 * 1024, 1024, 32 * nb, 64 * kb, WSP(unsigned char, WS_WDN) + (size_t)(l * 32 + e) * 1024 * 1024, 1024, 32 * nb, scr, C.lane); }
}
DI void conv_ticket(const Ctx& C, int l, int tk) {
    LAS float* scr = (LAS float*)(C.lds + C.wave * 16384);
    __syncthreads();
#pragma unroll 1
    for (int i = 0; i < 8; ++i) conv_item(C, l, tk * 64 + C.wave * 8 + i, scr);
}
DI void p0_prologue(const Ctx& C) {
    LAS float* scr = (LAS float*)(C.lds + C.wave * 16384);
    const int gw = C.bid * NWAVE + C.wave, NGW = C.G * NWAVE;
    constexpr int I_IN = 16 * 104, I_OUT = 16 * 32, I_LW = 8, I_LA = 8, I_LG = 16, I_K1 = 256, I_K2 = 8;
    constexpr int I_LAYER = I_IN + I_OUT + I_LW + I_LA + I_LG + 2 * I_K1 + 2 * I_K2;
    for (int it = gw; it < NLAYER * I_LAYER; it += NGW) {
        const int l = it / I_LAYER; int r = it % I_LAYER;
        if (r < I_IN) { const int kb = r / 104, nb = r % 104, n0 = 32 * nb; int nv = 3212 - n0; nv = nv < 0 ? 0 : (nv > 32 ? 32 : nv);
            tr_item(C.w_in + (size_t)l * 1024 * 3212, 3212, n0, nv, 64 * kb, WSP(bf16, WS_WIN) + (size_t)l * NPJ * 1024, 1024, n0, 0, scr, C.lane); continue; } r -= I_IN;
        if (r < I_OUT) { const int kb = r / 32, nb = r % 32;
            tr_item(C.w_out + (size_t)l * 1024 * 1024, 1024, 32 * nb, 32, 64 * kb, WSP(bf16, WS_WOUT) + (size_t)l * 1024 * 1024, 1024, 32 * nb, 0, scr, C.lane); continue; } r -= I_OUT;
        bf16* lora = WSP(bf16, WS_LORA) + (size_t)l * 768 * 256;
        if (r < I_LW) { tr_item(C.w2 + (size_t)l * 64 * 256, 256, 32 * r, 32, 0, lora, 256, 32 * r, 0, scr, C.lane); continue; } r -= I_LW;
        if (r < I_LA) { tr_item(C.a2 + (size_t)l * 64 * 256, 256, 32 * r, 32, 0, lora, 256, 256 + 32 * r, 64, scr, C.lane); continue; } r -= I_LA;
        if (r < I_LG) { const int kb = r / 8, nb = r % 8; tr_item(C.g2 + (size_t)l * 128 * 256, 256, 32 * nb, 32, 64 * kb, lora, 256, 512 + 32 * nb, 128, scr, C.lane); continue; } r -= I_LG;
        if (r < 2 * I_K1) { const int kv = r / I_K1, r2 = r % I_K1, kb = r2 / 8, nb = r2 % 8;
            tr_item((kv ? C.wv1 : C.wk1) + (size_t)l * 2048 * 256, 256, 32 * nb, 32, 64 * kb, WSP(bf16, WS_WK1) + (size_t)(l * 2 + kv) * 256 * 2048, 2048, 32 * nb, 0, scr, C.lane); continue; } r -= 2 * I_K1;
        { const int kv = r / I_K2, r2 = r % I_K2, kb = r2 / 2, nb = r2 % 2;
            tr_item((kv ? C.wv2 : C.wk2) + (size_t)l * 256 * 64, 64, 32 * nb, 32, 64 * kb, WSP(bf16, WS_WK2) + (size_t)(l * 2 + kv) * 256 * 256, 256, 32 * nb, 0, scr, C.lane); }
    }
    { int* idm = WSP(int, WS_ROUTE) + NT * 12 + NR; for (int i = C.bid * NTHR + C.tid; i < NR; i += C.G * NTHR) idm[i] = i; }
    __syncthreads();
    float* MOD = WSP(float, WS_SMALL); float* PEB = MOD + NLAYER * 8 * 6144;
    LAS float* sc = (LAS float*)C.lds;
    LAS float* red = sc + 8192;
    for (int it = C.bid; it < 192 + 32; it += C.G) {
        if (it < 192) {
            const int l = it / 96, n0 = (it % 96) * 64;
            for (int i = C.tid; i < 8192; i += NTHR) { const float v = C.c[i]; sc[i] = v * fsigmoid(v); }
            __syncthreads();
            const int kq = C.tid >> 6, col = C.tid & 63; float a[8];
#pragma unroll
            for (int b = 0; b < 8; ++b) a[b] = 0.f;
            const float* wp = C.w_ada + (size_t)l * 1024 * 6144 + n0 + col;
#pragma unroll 8
            for (int k = kq * 128; k < kq * 128 + 128; ++k) { const float w = wp[(size_t)k * 6144];
#pragma unroll
                for (int b = 0; b < 8; ++b) a[b] += sc[b * 1024 + k] * w; }
#pragma unroll
            for (int b = 0; b < 8; ++b) red[(kq * 8 + b) * 64 + col] = a[b];
            __syncthreads();
            { const int b = C.tid >> 6; float s = C.b_ada[(size_t)l * 6144 + n0 + col];
#pragma unroll
              for (int q = 0; q < 8; ++q) s += red[(q * 8 + b) * 64 + col];
              MOD[((size_t)l * 8 + b) * 6144 + n0 + col] = s; }
            __syncthreads();
        } else {
            const int r = it - 192, l = r >> 4, kv = (r >> 3) & 1, c0 = (r & 7) * 32; const float* pe = (kv ? C.pe_v : C.pe_k) + (size_t)l * 2048; const float* w1 = (kv ? C.wv1 : C.wk1) + (size_t)l * 2048 * 256;
            const int kq = C.tid >> 5, col = C.tid & 31; float a = 0.f;
#pragma unroll 16
            for (int k = kq * 128; k < kq * 128 + 128; ++k) a += pe[k] * w1[(size_t)k * 256 + c0 + col];
            red[kq * 32 + col] = a; __syncthreads();
            if (C.tid < 32) { float s = 0.f;
#pragma unroll
                for (int q = 0; q < 16; ++q) s += red[q * 32 + C.tid];
                PEB[(l * 2 + kv) * 256 + c0 + C.tid] = s; }
            __syncthreads();
        }
    }
}

DI void norm_row(const Ctx& C, const float* xrow, const float* g, const float* sh, const float* sc, bf16* orow) {
    f32x4 v[4]; float s = 0.f;
#pragma unroll
    for (int j = 0; j < 4; ++j) { v[j] = *(const f32x4*)(xrow + 4 * C.lane + 256 * j); s += (v[j][0] * v[j][0] + v[j][1] * v[j][1]) + (v[j][2] * v[j][2] + v[j][3] * v[j][3]); }
    s = group_sum<64>(s); const float rstd = rsqrtf(s * (1.f / DM) + 1e-6f);
#pragma unroll
    for (int j = 0; j < 4; ++j) { const int k = 4 * C.lane + 256 * j; const f32x4 gg = *(const f32x4*)(g + k), a = *(const f32x4*)(sc + k), b = *(const f32x4*)(sh + k); f32x4 h;
#pragma unroll
        for (int i = 0; i < 4; ++i) h[i] = v[j][i] * rstd * gg[i] * (1.f + a[i]) + b[i];
        u32x2 o; o.x = pk2(h[0], h[1]); o.y = pk2(h[2], h[3]); *(u32x2*)(orow + k) = o; }
}
DI void norm1_phase(const Ctx& C, int l, const float* xin) {
    const float* MOD = WSP(float, WS_SMALL) + (size_t)l * 8 * 6144; bf16* H = WSP(bf16, WS_H);
    const int gw = C.bid * NWAVE + C.wave, NGW = C.G * NWAVE;
    for (int m = gw; m < NT; m += NGW) { const int b = m / NS; norm_row(C, xin + (size_t)m * DM, C.norm1_g + l * DM, MOD + b * 6144, MOD + b * 6144 + 1024, H + (size_t)m * DM); }
}

constexpr float QSCALE = 0.125f * 1.44269504089f;
DI void prep_phase(const Ctx& C, int l) {
    const bf16* PROJ = WSP(bf16, R_PROJ); float* SC = WSP(float, R_SC); bf16* LIN = WSP(bf16, R_LIN); bf16* YCAT = WSP(bf16, R_YCAT);
    bf16 *QC = WSP(bf16, R_QC), *KC = WSP(bf16, R_KC), *QN = WSP(bf16, R_QN), *QR = WSP(bf16, R_QR), *KCR = WSP(bf16, R_KCR), *VCR = WSP(bf16, R_VCR), *KS = WSP(bf16, R_KS), *KW = WSP(bf16, R_KW);
    float* GATE = WSP(float, R_GATE);
    const int lane = C.lane, gw = C.bid * NWAVE + C.wave, NGW = C.G * NWAVE;
    const int hh = lane >> 4, jj = lane & 15;
    const float inv0 = exp2f(-(float)(2 * jj) * (13.287712379549449f / 32.f)) * 0.15915494309189535f, inv1 = exp2f(-(float)(2 * jj + 1) * (13.287712379549449f / 32.f)) * 0.15915494309189535f;
    for (int task = gw; task < NT / 16; task += NGW) {
        const int row0 = 16 * task, s0 = row0 % NS;
        {
            const int c0 = 16 * lane, cc = (c0 - 256) & 255; float mu16[16], kw16[16];
#pragma unroll
            for (int q = 0; q < 4; ++q) { const f32x4 m4 = *(const f32x4*)(C.mu + (size_t)l * 1024 + c0 + 4 * q), k4 = *(const f32x4*)(C.kkw + (size_t)l * 256 + cc + 4 * q);
#pragma unroll
                for (int i = 0; i < 4; ++i) { mu16[4 * q + i] = m4[i]; kw16[4 * q + i] = k4[i]; } }
#pragma unroll 2
            for (int r = 0; r < 16; ++r) {
                const int row = row0 + r; const bf16* pr = PROJ + (size_t)row * NPJ; float z[16];
                const u32x4 c0v = *(const u32x4*)(pr + c0), c1v = *(const u32x4*)(pr + c0 + 8);
                u32x4 p0v = (u32x4){0u, 0u, 0u, 0u}, p1v = p0v;
                if (s0 + r > 0) { p0v = *(const u32x4*)(pr - NPJ + c0); p1v = *(const u32x4*)(pr - NPJ + c0 + 8); }
                const unsigned cw[8] = {c0v.x, c0v.y, c0v.z, c0v.w, c1v.x, c1v.y, c1v.z, c1v.w}, pw[8] = {p0v.x, p0v.y, p0v.z, p0v.w, p1v.x, p1v.y, p1v.z, p1v.w};
#pragma unroll
                for (int e = 0; e < 16; ++e) { const float cu = (e & 1) ? bfhi(cw[e >> 1]) : bflo(cw[e >> 1]), pv = (e & 1) ? bfhi(pw[e >> 1]) : bflo(pw[e >> 1]); z[e] = cu + (pv - cu) * mu16[e]; }
                float kk[16]; float ss = 0.f;
#pragma unroll
                for (int e = 0; e < 16; ++e) { kk[e] = z[e] * kw16[e]; ss += kk[e] * kk[e]; }
                ss = group_sum<4>(ss); const float kinv = rsqrtf(ss + 1e-12f);
                if (lane < 48) {
                    const int vec = lane < 16 ? 4 : (lane < 32 ? 1 : 5); float* dst = SC + ((size_t)vec * NT + row) * 256 + (c0 & 255);
#pragma unroll
                    for (int q = 0; q < 4; ++q) *(f32x4*)(dst + 4 * q) = (f32x4){z[4 * q], z[4 * q + 1], z[4 * q + 2], z[4 * q + 3]};
                    if (lane >= 16 && lane < 32) { float* d2 = SC + ((size_t)2 * NT + row) * 256 + cc;
#pragma unroll
                        for (int q = 0; q < 4; ++q) *(f32x4*)(d2 + 4 * q) = (f32x4){kk[4 * q] * kinv, kk[4 * q + 1] * kinv, kk[4 * q + 2] * kinv, kk[4 * q + 3] * kinv}; }
                } else {
                    float t[16];
#pragma unroll
                    for (int i = 0; i < 16; ++i) { const float sg = fsigmoid(lane < 52 ? 2.f * z[i] : z[i]); t[i] = lane < 52 ? 2.f * sg - 1.f : (lane < 56 ? z[i] : sg); }
                    bf16* dst = LIN + (size_t)row * 256 + (c0 - 768);
                    u32x4 o0, o1; o0.x = pk2(t[0], t[1]); o0.y = pk2(t[2], t[3]); o0.z = pk2(t[4], t[5]); o0.w = pk2(t[6], t[7]); o1.x = pk2(t[8], t[9]); o1.y = pk2(t[10], t[11]); o1.z = pk2(t[12], t[13]); o1.w = pk2(t[14], t[15]);
                    *(u32x4*)dst = o0; *(u32x4*)(dst + 8) = o1;
                }
            }
        }
        {
            const int ch = 4 * lane; const float* cw = C.conv_w + (size_t)l * 3 * 256 + ch; const f32x4 w0 = *(const f32x4*)cw, w1 = *(const f32x4*)(cw + 256), w2 = *(const f32x4*)(cw + 512);
            const f32x4 og = *(const f32x4*)(C.onorm_g + (size_t)l * 768 + ch);
#pragma unroll 2
            for (int r = 0; r < 16; ++r) {
                const int row = row0 + r, s = s0 + r; const bf16* pr = PROJ + (size_t)row * NPJ; float u[3][4];
#pragma unroll
                for (int d = 0; d < 3; ++d) {
                    u32x2 cg = (u32x2){0u, 0u}, xi = cg;
                    if (s >= d) { cg = *(const u32x2*)(pr - (size_t)d * NPJ + PJ_B + 256 + ch); xi = *(const u32x2*)(pr - (size_t)d * NPJ + PJ_B + 512 + ch); }
                    u[d][0] = bflo(cg.x) * bflo(xi.x); u[d][1] = bfhi(cg.x) * bfhi(xi.x); u[d][2] = bflo(cg.y) * bflo(xi.y); u[d][3] = bfhi(cg.y) * bfhi(xi.y);
                }
                const u32x2 bgv = *(const u32x2*)(pr + PJ_B + ch); const float bg[4] = {bflo(bgv.x), bfhi(bgv.x), bflo(bgv.y), bfhi(bgv.y)};
                float y[4]; float ss = 0.f;
#pragma unroll
                for (int i = 0; i < 4; ++i) { y[i] = bg[i] * (w0[i] * u[2][i] + w1[i] * u[1][i] + w2[i] * u[0][i]); ss += y[i] * y[i]; }
                ss = group_sum<16>(ss); const float rstd = rsqrtf(ss * (1.f / 64.f) + 1e-6f);
                u32x2 o; o.x = pk2(y[0] * rstd * og[0], y[1] * rstd * og[1]); o.y = pk2(y[2] * rstd * og[2], y[3] * rstd * og[3]);
                *(u32x2*)(YCAT + (size_t)row * DM + 256 + ch) = o;
            }
        }
        {
            const float* gq = C.dil_q_g + (size_t)l * 64; const float* gk = C.dil_k_g + (size_t)l * 64; const float* gn = C.nsa_q_g + (size_t)l * 64; const float* gv = (hh == 0 ? C.nsa_ks_g : C.nsa_kw_g) + (size_t)l * 64;
            float Gq[4], Gk[4], Gn[4], Gv[4];
#pragma unroll
            for (int i = 0; i < 4; ++i) { const int d = (i >> 1) * 32 + 2 * jj + (i & 1); Gq[i] = gq[d] * QSCALE; Gk[i] = gk[d]; Gn[i] = gn[d] * QSCALE; Gv[i] = gv[d]; }
            const int vcol = hh == 0 ? 2944 : (hh == 1 ? 3072 : (hh == 2 ? 2816 : 2880));
            bf16* vdst = (hh == 0 ? KS : (hh == 1 ? KW : (hh == 2 ? KCR : VCR)));
#pragma unroll 2
            for (int r = 0; r < 16; ++r) {
                const int row = row0 + r; const bf16* pr = PROJ + (size_t)row * NPJ;
                const float posf = (float)C.pos[row];
                const float x0 = __builtin_amdgcn_fractf(posf * inv0), x1 = __builtin_amdgcn_fractf(posf * inv1);
                const float sn0 = __builtin_amdgcn_sinf(x0), cs0 = __builtin_amdgcn_cosf(x0), sn1 = __builtin_amdgcn_sinf(x1), cs1 = __builtin_amdgcn_cosf(x1);
                const unsigned qa = *(const unsigned*)(pr + PJ_C + hh * 64 + 2 * jj), qb = *(const unsigned*)(pr + PJ_C + hh * 64 + 32 + 2 * jj);
                const unsigned ka = *(const unsigned*)(pr + PJ_C + 256 + hh * 64 + 2 * jj), kb = *(const unsigned*)(pr + PJ_C + 256 + hh * 64 + 32 + 2 * jj);
                const unsigned na = *(const unsigned*)(pr + PJ_D + hh * 64 + 2 * jj), nb = *(const unsigned*)(pr + PJ_D + hh * 64 + 32 + 2 * jj);
                const unsigned va = *(const unsigned*)(pr + vcol + 2 * jj), vb = *(const unsigned*)(pr + vcol + 32 + 2 * jj);
                float gate_in = 0.f; if (lane < 12) gate_in = bf2f(pr[3200 + lane]);
#define ROPE_NORM(a, b, G, o1, o2, n1a, n1b, n2a, n2b) \
                float n1a = bflo(a), n1b = bfhi(a), n2a = bflo(b), n2b = bfhi(b); { const float ss_ = group_sum<16>(n1a * n1a + n1b * n1b + n2a * n2a + n2b * n2b); const float rs_ = rsqrtf(ss_ * (1.f / 64.f) + 1e-6f); \
                    n1a *= rs_ * G[0]; n1b *= rs_ * G[1]; n2a *= rs_ * G[2]; n2b *= rs_ * G[3]; } \
                const unsigned o1 = pk2(n1a * cs0 - n2a * sn0, n1b * cs1 - n2b * sn1), o2 = pk2(n2a * cs0 + n1a * sn0, n2b * cs1 + n1b * sn1);
                ROPE_NORM(qa, qb, Gq, q1, q2, q1a, q1b, q2a, q2b)
                ROPE_NORM(ka, kb, Gk, k1, k2, k1a, k1b, k2a, k2b)
                ROPE_NORM(na, nb, Gn, r1, r2, r1a, r1b, r2a, r2b)
                ROPE_NORM(va, vb, Gv, v1, v2, v1a, v1b, v2a, v2b)
#undef ROPE_NORM
                bf16* o = QC + (size_t)row * 256 + hh * 64 + 2 * jj; *(unsigned*)o = q1; *(unsigned*)(o + 32) = q2;
                o = KC + (size_t)row * 256 + hh * 64 + 2 * jj; *(unsigned*)o = k1; *(unsigned*)(o + 32) = k2;
                o = QN + (size_t)row * 256 + hh * 64 + 2 * jj; *(unsigned*)o = pk2(r1a, r1b); *(unsigned*)(o + 32) = pk2(r2a, r2b);
                o = QR + (size_t)row * 256 + hh * 64 + 2 * jj; *(unsigned*)o = r1; *(unsigned*)(o + 32) = r2;
                o = vdst + (size_t)row * 64 + 2 * jj; *(unsigned*)o = (hh >= 2) ? va : v1; *(unsigned*)(o + 32) = (hh >= 2) ? vb : v2;
                if (lane < 12) GATE[(size_t)row * 12 + lane] = fsigmoid(gate_in);
            }
        }
    }
}
constexpr int SCAN_TC = 16;
DI void scan_unit8(const Ctx& C, int u) {
    const float* SC = WSP(float, R_SC); float* YA = WSP(float, R_YA); float* UB = WSP(float, R_SCANU); float* SMT = WSP(float, R_SCANS);
    const int pair = u / 3, kind = u % 3, b = pair >> 2, h = pair & 3, tid = C.tid;
    LAS float* buf = (LAS float*)C.lds;
    LAS float* ybuf = buf + 2 * 6144;
    const int row = tid >> 3, cg = tid & 7, tbase = kind == 0 ? 0 : NS / 2;
    const float vm = kind == 2 ? 0.f : 1.f;
    f32x4 ldA[3], ldB[3];
#define SCAN_LOAD(ld, chunk) do { _Pragma("unroll") for (int i = 0; i < 3; ++i) { const int idx = tid + 512 * i, step = idx / 96, rem = idx % 96, vec = rem >> 4, f4 = rem & 15; \
        ld[i] = *(const f32x4*)(SC + ((size_t)vec * NT + (size_t)b * NS + tbase + (chunk) * SCAN_TC + step) * 256 + h * 64 + f4 * 4); } } while (0)
#define SCAN_STORE(ld, slot) do { _Pragma("unroll") for (int i = 0; i < 3; ++i) *(LAS f32x4*)(buf + (slot) * 6144 + (tid + 512 * i) * 4) = ld[i]; } while (0)
#define SCAN_FLUSH(chunk) do { _Pragma("unroll") for (int i = 0; i < 2; ++i) { const int i2 = tid + 512 * i, step = i2 >> 6, rr = i2 & 63; const LAS float* pp_ = ybuf + ((chunk) & 1) * 8192 + step * 512 + rr * 8; \
        const f32x4 pa_ = *(const LAS f32x4*)pp_, pb_ = *(const LAS f32x4*)(pp_ + 4); const float yv = ((pa_[0] + pa_[1]) + (pa_[2] + pa_[3])) + ((pb_[0] + pb_[1]) + (pb_[2] + pb_[3])); \
        if (kind == 2) UB[((size_t)b * (NS / 2) + (chunk) * SCAN_TC + step) * 256 + h * 64 + rr] = yv; else YA[((size_t)b * NS + tbase + (chunk) * SCAN_TC + step) * 256 + h * 64 + rr] = yv; } } while (0)
    __syncthreads();
    SCAN_LOAD(ldA, 0); SCAN_STORE(ldA, 0); SCAN_LOAD(ldB, 1); SCAN_LOAD(ldA, 2);
    f32x2 S[4];
#pragma unroll
    for (int c = 0; c < 4; ++c) { S[c][0] = (kind == 2 && row == 8 * cg + 2 * c) ? 1.f : 0.f; S[c][1] = (kind == 2 && row == 8 * cg + 2 * c + 1) ? 1.f : 0.f; }
    constexpr int NCH = (NS / 2) / SCAN_TC;
#pragma unroll 2
    for (int ck = 0; ck < NCH; ++ck) {
        __syncthreads();
        if (ck & 1) { if (ck + 1 < NCH) SCAN_STORE(ldA, (ck + 1) & 1); if (ck + 3 < NCH) SCAN_LOAD(ldA, ck + 3); }
        else        { if (ck + 1 < NCH) SCAN_STORE(ldB, (ck + 1) & 1); if (ck + 3 < NCH) SCAN_LOAD(ldB, ck + 3); }
        {
            const LAS float* bp = buf + (ck & 1) * 6144; LAS float* yb = ybuf + (ck & 1) * 8192 + tid;
#define SCAN_LDS(X, step) do { const LAS float* sp = bp + (step) * 384 + 8 * cg; X.w0 = *(const LAS f32x4*)(sp); X.w1 = *(const LAS f32x4*)(sp + 4); X.k0 = *(const LAS f32x4*)(sp + 64); X.k1 = *(const LAS f32x4*)(sp + 68); \
                X.q0 = *(const LAS f32x4*)(sp + 128); X.q1 = *(const LAS f32x4*)(sp + 132); X.b0 = *(const LAS f32x4*)(sp + 192); X.b1 = *(const LAS f32x4*)(sp + 196); \
                X.r0 = *(const LAS f32x4*)(sp + 256); X.r1 = *(const LAS f32x4*)(sp + 260); X.v = bp[(step) * 384 + 320 + row] * vm; } while (0)
#define SCAN_STEP(X, step) do { \
                f32x2 d2 = S[0] * (f32x2){X.q0[0], X.q0[1]}; d2 = S[1] * (f32x2){X.q0[2], X.q0[3]} + d2; d2 = S[2] * (f32x2){X.q1[0], X.q1[1]} + d2; d2 = S[3] * (f32x2){X.q1[2], X.q1[3]} + d2; \
                const float sa = -sum8(d2[0] + d2[1]); const f32x2 sa2 = (f32x2){sa, sa}, v2 = (f32x2){X.v, X.v}; \
                S[0] = S[0] * (f32x2){X.w0[0], X.w0[1]} + (sa2 * (f32x2){X.b0[0], X.b0[1]} + v2 * (f32x2){X.k0[0], X.k0[1]}); \
                S[1] = S[1] * (f32x2){X.w0[2], X.w0[3]} + (sa2 * (f32x2){X.b0[2], X.b0[3]} + v2 * (f32x2){X.k0[2], X.k0[3]}); \
                S[2] = S[2] * (f32x2){X.w1[0], X.w1[1]} + (sa2 * (f32x2){X.b1[0], X.b1[1]} + v2 * (f32x2){X.k1[0], X.k1[1]}); \
                S[3] = S[3] * (f32x2){X.w1[2], X.w1[3]} + (sa2 * (f32x2){X.b1[2], X.b1[3]} + v2 * (f32x2){X.k1[2], X.k1[3]}); \
                f32x2 y2 = S[0] * (f32x2){X.r0[0], X.r0[1]}; y2 = S[1] * (f32x2){X.r0[2], X.r0[3]} + y2; y2 = S[2] * (f32x2){X.r1[0], X.r1[1]} + y2; y2 = S[3] * (f32x2){X.r1[2], X.r1[3]} + y2; \
                yb[(step) * 512] = y2[0] + y2[1]; } while (0)
            struct StepIn { f32x4 w0, w1, k0, k1, q0, q1, b0, b1, r0, r1; float v; } A, B;
            SCAN_LDS(A, 0);
#pragma unroll 2
            for (int step = 0; step < SCAN_TC; step += 2) {
                SCAN_LDS(B, step + 1);
                __builtin_amdgcn_sched_barrier(0);
                SCAN_STEP(A, step);
                __builtin_amdgcn_sched_barrier(0);
                if (step + 2 < SCAN_TC) SCAN_LDS(A, step + 2);
                __builtin_amdgcn_sched_barrier(0);
                SCAN_STEP(B, step + 1);
                __builtin_amdgcn_sched_barrier(0);
            }
#undef SCAN_LDS
#undef SCAN_STEP
        }
        if (ck > 0) SCAN_FLUSH(ck - 1);
    }
    __syncthreads();
    SCAN_FLUSH(NCH - 1);
    if (kind == 0) {
        float* o = SMT + (size_t)pair * 4096 + row;
#pragma unroll
        for (int c = 0; c < 4; ++c) { o[(8 * cg + 2 * c) * 64] = S[c][0]; o[(8 * cg + 2 * c + 1) * 64] = S[c][1]; }
    }
#undef SCAN_LOAD
#undef SCAN_STORE
#undef SCAN_FLUSH
    __syncthreads();
}

constexpr int KROW = 144, KT_BYTES = 64 * KROW;
#define MFMA16(a, b, c) __builtin_amdgcn_mfma_f32_16x16x32_bf16((a), (b), (c), 0, 0, 0)
template <int NQT> struct FA { f32x4 O[NQT][4]; float l[NQT]; float negM; };
template <int NQT> DI void fa_init(FA<NQT>& st) {
#pragma unroll
    for (int q = 0; q < NQT; ++q) { st.l[q] = 0.f;
#pragma unroll
        for (int d = 0; d < 4; ++d) st.O[q][d] = (f32x4){0.f, 0.f, 0.f, 0.f}; }
}
DI bf16x8 pack8(const f32x4& a, const f32x4& b) { u32x4 w; w.x = pk2(a[0], a[1]); w.y = pk2(a[2], a[3]); w.z = pk2(b[0], b[1]); w.w = pk2(b[2], b[3]); return __builtin_bit_cast(bf16x8, w); }
struct VFrag { u32x2 a[4], b[4]; };
DI void vt_issue(VFrag& f, unsigned vaddr) {
    asm volatile("ds_read_b64_tr_b16 %0, %8\n\tds_read_b64_tr_b16 %1, %8 offset:2304\n\tds_read_b64_tr_b16 %2, %8 offset:32\n\tds_read_b64_tr_b16 %3, %8 offset:2336\n\t"
                 "ds_read_b64_tr_b16 %4, %8 offset:64\n\tds_read_b64_tr_b16 %5, %8 offset:2368\n\tds_read_b64_tr_b16 %6, %8 offset:96\n\tds_read_b64_tr_b16 %7, %8 offset:2400"
                 : "=&v"(f.a[0]), "=&v"(f.b[0]), "=&v"(f.a[1]), "=&v"(f.b[1]), "=&v"(f.a[2]), "=&v"(f.b[2]), "=&v"(f.a[3]), "=&v"(f.b[3]) : "v"(vaddr) : "memory");
}
DI void vt_wait(VFrag& f) { asm volatile("s_waitcnt lgkmcnt(0)" : "+v"(f.a[0]), "+v"(f.b[0]), "+v"(f.a[1]), "+v"(f.b[1]), "+v"(f.a[2]), "+v"(f.b[2]), "+v"(f.a[3]), "+v"(f.b[3]) :: "memory"); }
DI bf16x8 vt_get(const VFrag& f, int d) { return __builtin_bit_cast(bf16x8, ((u32x4){f.a[d].x, f.a[d].y, f.b[d].x, f.b[d].y})); }
template <int NQT, bool MASKED, class MaskF>
DI void fa_tile(FA<NQT>& st, const bf16x8 (&Q)[NQT][2], const LAS uchar* Ks, const LAS uchar* Vs, int lane, const MaskF& allowed, const bool (&act)[NQT]) {
    const int l15 = lane & 15, quad = lane >> 4;
    f32x4 S[NQT][4]; const f32x4 sinit = (f32x4){st.negM, st.negM, st.negM, st.negM};
#pragma unroll
    for (int kt = 0; kt < 4; ++kt) {
        const bf16x8 k0 = *(const LAS bf16x8*)(Ks + (16 * kt + l15) * KROW + quad * 16), k1 = *(const LAS bf16x8*)(Ks + (16 * kt + l15) * KROW + 64 + quad * 16);
#pragma unroll
        for (int q = 0; q < NQT; ++q) if (act[q]) { S[q][kt] = MFMA16(k0, Q[q][0], sinit); S[q][kt] = MFMA16(k1, Q[q][1], S[q][kt]); }
    }
    const unsigned vaddr = (unsigned)(size_t)(Vs + (4 * quad + (l15 >> 2)) * KROW + 8 * (l15 & 3));
    VFrag v0, v1; vt_issue(v0, vaddr); vt_issue(v1, vaddr + 32 * KROW);
#pragma unroll
    for (int q = 0; q < NQT; ++q) if (act[q]) {
        float rs = 0.f;
#pragma unroll
        for (int kt = 0; kt < 4; ++kt)
#pragma unroll
            for (int j = 0; j < 4; ++j) { float p = fexp2(S[q][kt][j]); if (MASKED) p = allowed(q, 16 * kt + 4 * quad + j) ? p : 0.f; S[q][kt][j] = p; rs += p; }
        st.l[q] += rs;
    }
    vt_wait(v0); vt_wait(v1);
#pragma unroll
    for (int q = 0; q < NQT; ++q) if (act[q]) {
        const bf16x8 p0 = pack8(S[q][0], S[q][1]), p1 = pack8(S[q][2], S[q][3]);
#pragma unroll
        for (int d = 0; d < 4; ++d) { st.O[q][d] = MFMA16(vt_get(v0, d), p0, st.O[q][d]); st.O[q][d] = MFMA16(vt_get(v1, d), p1, st.O[q][d]); }
    }
}
template <int NQT> DI void fa_finish(FA<NQT>& st, float (&lse2)[NQT]) {
#pragma unroll
    for (int q = 0; q < NQT; ++q) { float l = st.l[q]; l += __shfl_xor(l, 16); l += __shfl_xor(l, 32); const float inv = l > 0.f ? 1.f / l : 0.f; lse2[q] = __log2f(fmaxf(l, 1e-37f));
#pragma unroll
        for (int d = 0; d < 4; ++d) st.O[q][d] = st.O[q][d] * inv; }
}
DI float score_bound(const float* gq, const float* gk, int lane) {
    float a = fabsf(gq[lane & 63]), b = fabsf(gk[lane & 63]);
#pragma unroll
    for (int o = 1; o < 64; o <<= 1) { a = fmaxf(a, __shfl_xor(a, o)); b = fmaxf(b, __shfl_xor(b, o)); }
    return 64.f * a * b * QSCALE * 1.02f + 0.5f;
}
DI void kv_store(LAS uchar* Ks, LAS uchar* Vs, int tid, const u32x4& kr, const u32x4& vr) {
    const int o = (tid >> 3) * KROW + (tid & 7) * 16; *(LAS u32x4*)(Ks + o) = kr; *(LAS u32x4*)(Vs + o) = vr;
}
DI void q_load(bf16x8 (&Q)[2], const bf16* qrow, int quad) { Q[0] = *(const bf16x8*)(qrow + 8 * quad); Q[1] = *(const bf16x8*)(qrow + 32 + 8 * quad); }

struct DilMask { int qi[2]; int k0; DI bool operator()(int q, int key) const { const int ki = k0 + key, d = qi[q] - ki; return ki >= 0 && d >= 0 && d <= 128; } };
DI void dil_unit(const Ctx& C, int unit, LAS uchar* Ks, LAS uchar* Vs, float negM_bound) {
    const bf16 *QC = WSP(bf16, R_QC), *KC = WSP(bf16, R_KC), *PROJ = WSP(bf16, R_PROJ); float* OC = WSP(float, R_OC); float* LSE = WSP(float, R_LSE);
    int tid = C.tid, lane = C.lane; asm volatile("" : "+v"(tid), "+v"(lane));
    const int w = C.wave, l15 = lane & 15, quad = lane >> 4;
    const int cfg = unit / 512, r = unit % 512, dsh = 2 * cfg, d = 1 << dsh;
    const int b = r >> 6, h = (r >> 4) & 3, r2 = r & 15;
    const int nblk = 16 >> dsh, res = r2 / nblk, blk = r2 % nblk, i0 = blk * 256;
    const size_t tb = (size_t)b * NS;
    bf16x8 Q[2][2]; DilMask mk; FA<2> st; fa_init(st); st.negM = -negM_bound;
#pragma unroll
    for (int q = 0; q < 2; ++q) { mk.qi[q] = i0 + 32 * w + 16 * q + l15; q_load(Q[q], QC + (tb + res + (size_t)d * mk.qi[q]) * 256 + h * 64, quad); }
    const int jlo = w >> 1, jhi = (w >> 1) + 2;
    const bool act[2] = {true, true};
    u32x4 kr, vr;
#define DIL_LOAD(j) do { const int ki = i0 - 128 + 64 * (j) + (tid >> 3); kr = (u32x4){0u, 0u, 0u, 0u}; vr = kr; \
    if (ki >= 0) { const size_t rowk = tb + res + (size_t)d * ki; kr = *(const u32x4*)(KC + rowk * 256 + h * 64 + (tid & 7) * 8); vr = *(const u32x4*)(PROJ + rowk * NPJ + PJ_C + 512 + h * 64 + (tid & 7) * 8); } } while (0)
    DIL_LOAD(0); __syncthreads(); kv_store(Ks, Vs, tid, kr, vr); DIL_LOAD(1);
    for (int j = 0; j < 6; ++j) {
        __syncthreads();
        if (j + 1 < 6) kv_store(Ks + ((j + 1) & 1) * 2 * KT_BYTES, Vs + ((j + 1) & 1) * 2 * KT_BYTES, tid, kr, vr);
        if (j + 2 < 6) DIL_LOAD(j + 2);
        if (j >= jlo && j <= jhi) { mk.k0 = i0 - 128 + 64 * j; fa_tile<2, true>(st, Q, Ks + (j & 1) * 2 * KT_BYTES, Vs + (j & 1) * 2 * KT_BYTES, lane, mk, act); }
    }
#undef DIL_LOAD
    float lse2[2]; fa_finish<2>(st, lse2);
#pragma unroll
    for (int q = 0; q < 2; ++q) { const size_t rowq = tb + res + (size_t)d * mk.qi[q]; float* o = OC + ((size_t)cfg * NT + rowq) * 256 + h * 64 + 4 * quad;
#pragma unroll
        for (int dt = 0; dt < 4; ++dt) *(f32x4*)(o + 16 * dt) = st.O[q][dt];
        if (quad == 0) LSE[((size_t)cfg * NT + rowq) * 4 + h] = lse2[q]; }
}
constexpr int NSA_KC = 0, NSA_VC = 256 * KROW, NSA_KT = 2 * 256 * KROW, NSA_VT = NSA_KT + KT_BYTES, NSA_IMP = NSA_KT + 4 * KT_BYTES,
    NSA_SELM = NSA_IMP + 64 * 64 * 4, NSA_UW = NSA_SELM + 512;
static_assert(NSA_UW + 16 <= RING_BYTES, "NSA LDS map");
struct SwaMask { int t[2]; int k0; DI bool operator()(int q, int key) const { const int d = t[q] - (k0 + key); return d >= 0 && d <= 511; } };
struct SlcMask { int t[2]; int k0; bool sel[2]; DI bool operator()(int q, int key) const { return sel[q] && (k0 + key <= t[q]); } };
struct NoMask { DI bool operator()(int, int) const { return true; } };
DI void nsa_unit(const Ctx& C, int l, int b, int tbk, int& bl, float bnd_cmp, float bnd_slc, float bnd_swa) {
    const bf16 *QN = WSP(bf16, R_QN), *QR = WSP(bf16, R_QR), *KSb = WSP(bf16, R_KS), *KWb = WSP(bf16, R_KW), *PROJ = WSP(bf16, R_PROJ); const float* CMP = WSP(float, R_CMP); const float* GATE = WSP(float, R_GATE);
    bf16* YCAT = WSP(bf16, R_YCAT);
    LAS uchar* Kc = C.lds + NSA_KC; LAS uchar* Vc = C.lds + NSA_VC; LAS uchar* Ks = C.lds + NSA_KT; LAS uchar* Vs = C.lds + NSA_VT;
    LAS float* imps = (LAS float*)(C.lds + NSA_IMP); LAS unsigned* selm = (LAS unsigned*)(C.lds + NSA_SELM); LAS unsigned* uw = (LAS unsigned*)(C.lds + NSA_UW);
    int tid = C.tid, lane = C.lane; asm volatile("" : "+v"(tid), "+v"(lane));
    const int w = C.wave, l15 = lane & 15, quad = lane >> 4, head = l15 & 3, t0 = 64 * tbk; const size_t tb = (size_t)b * NS;
    __syncthreads();
    if (b != bl) {
        const int key = tid >> 1, hf = tid & 1; const float* kp = CMP + ((size_t)b * 256 + key) * 64 + 32 * hf; const float* vp = CMP + ((size_t)2048 + (size_t)b * 256 + key) * 64 + 32 * hf;
        float kv[32], vv[32]; float ss = 0.f;
#pragma unroll
        for (int i = 0; i < 8; ++i) { const f32x4 a = *(const f32x4*)(kp + 4 * i), c = *(const f32x4*)(vp + 4 * i);
#pragma unroll
            for (int j = 0; j < 4; ++j) { kv[4 * i + j] = a[j]; vv[4 * i + j] = c[j]; ss += a[j] * a[j]; } }
        ss += __shfl_xor(ss, 1); const float rstd = rsqrtf(ss * (1.f / 64.f) + 1e-6f); const float* g = C.nsa_kc_g + (size_t)l * 64 + 32 * hf; const bool dead = (key == 255);
#pragma unroll
        for (int i = 0; i < 4; ++i) { u32x4 o, p;
            o.x = pk2(kv[8 * i] * rstd * g[8 * i], kv[8 * i + 1] * rstd * g[8 * i + 1]); o.y = pk2(kv[8 * i + 2] * rstd * g[8 * i + 2], kv[8 * i + 3] * rstd * g[8 * i + 3]);
            o.z = pk2(kv[8 * i + 4] * rstd * g[8 * i + 4], kv[8 * i + 5] * rstd * g[8 * i + 5]); o.w = pk2(kv[8 * i + 6] * rstd * g[8 * i + 6], kv[8 * i + 7] * rstd * g[8 * i + 7]);
            p.x = pk2(vv[8 * i], vv[8 * i + 1]); p.y = pk2(vv[8 * i + 2], vv[8 * i + 3]); p.z = pk2(vv[8 * i + 4], vv[8 * i + 5]); p.w = pk2(vv[8 * i + 6], vv[8 * i + 7]);
            if (dead) { o = (u32x4){0u, 0u, 0u, 0u}; p = o; }
            *(LAS u32x4*)(Kc + key * KROW + hf * 64 + i * 16) = o; *(LAS u32x4*)(Vc + key * KROW + hf * 64 + i * 16) = p; }
        bl = b;
        __syncthreads();
    }
    f32x4 Oc[2][4];
    const int cmaxu = (t0 + 32) >> 4, ktmax = cmaxu >> 4;
    const unsigned vaddr0 = (unsigned)(size_t)(Vc + (4 * quad + (l15 >> 2)) * KROW + 8 * (l15 & 3));
#pragma unroll
    for (int q = 0; q < 2; ++q) {
        const int t = t0 + 8 * w + 4 * q + (l15 >> 2);
        bf16x8 Q[2]; q_load(Q, QN + (tb + t) * 256 + head * 64, quad);
        f32x4 S[16]; const f32x4 sinit = (f32x4){-bnd_cmp, -bnd_cmp, -bnd_cmp, -bnd_cmp}; float ls = 0.f;
#pragma unroll
        for (int kt = 0; kt < 16; ++kt) {
            if (kt <= ktmax) {
                const bf16x8 k0 = *(const LAS bf16x8*)(Kc + (16 * kt + l15) * KROW + quad * 16), k1 = *(const LAS bf16x8*)(Kc + (16 * kt + l15) * KROW + 64 + quad * 16);
                S[kt] = MFMA16(k0, Q[0], sinit); S[kt] = MFMA16(k1, Q[1], S[kt]);
#pragma unroll
                for (int j = 0; j < 4; ++j) { const int c = 16 * kt + 4 * quad + j; const float p = (16 * c + 31 <= t) ? fexp2(S[kt][j]) : 0.f; S[kt][j] = p; ls += p; }
            } else S[kt] = (f32x4){0.f, 0.f, 0.f, 0.f};
        }
        ls += __shfl_xor(ls, 16); ls += __shfl_xor(ls, 32);
        const float inv = ls > 0.f ? 1.f / ls : 0.f;
#pragma unroll
        for (int kt = 0; kt < 16; ++kt) S[kt] = S[kt] * inv;
#pragma unroll
        for (int kt = 0; kt < 16; ++kt) {
            const float send = (quad == 3) ? (kt > 0 ? S[kt > 0 ? kt - 1 : 0][3] : 0.f) : S[kt][3];
            const float prev = __shfl(send, (lane + 48) & 63);
            float v = ((quad == 0 && kt == 0) ? 0.f : prev) + 2.f * (S[kt][0] + S[kt][1] + S[kt][2]) + S[kt][3];
            v = group_sum<4>(v);
            if (head == 0) imps[(8 * w + 4 * q + (l15 >> 2)) * 64 + 4 * kt + quad] = v;
        }
#pragma unroll
        for (int d = 0; d < 4; ++d) Oc[q][d] = (f32x4){0.f, 0.f, 0.f, 0.f};
#pragma unroll
        for (int ks = 0; ks < 8; ++ks) {
            if (2 * ks <= ktmax) {
                VFrag vf; vt_issue(vf, vaddr0 + ks * 32 * KROW); const bf16x8 pf = pack8(S[2 * ks], S[2 * ks + 1]); vt_wait(vf);
#pragma unroll
                for (int d = 0; d < 4; ++d) Oc[q][d] = MFMA16(vt_get(vf, d), pf, Oc[q][d]);
            }
        }
    }
    {
        float* OCm = WSP(float, R_OCMP);
#pragma unroll
        for (int q = 0; q < 2; ++q) { float* o = OCm + (tb + t0 + 8 * w + 4 * q + (l15 >> 2)) * 256 + head * 64 + 4 * quad;
#pragma unroll
            for (int d = 0; d < 4; ++d) *(f32x4*)(o + 16 * d) = Oc[q][d]; }
    }
    __syncthreads();
    if (tid < 64) {
        const int cur = tbk; unsigned long long mask;
        if (cur <= 15) mask = (2ull << cur) - 1ull;
        else {
            mask = 1ull | (1ull << cur) | (1ull << (cur - 1));
            float v[64];
#pragma unroll
            for (int i = 0; i < 16; ++i) { const f32x4 a = *(const LAS f32x4*)(imps + tid * 64 + 4 * i);
#pragma unroll
                for (int j = 0; j < 4; ++j) { const int jb = 4 * i + j; v[jb] = (jb >= 1 && jb <= cur - 2) ? a[j] : -1.f; } }
#pragma unroll 1
            for (int r = 0; r < 13; ++r) {
                float bv = -0.5f; int bi = 0;
#pragma unroll
                for (int jb = 0; jb < 64; ++jb) if (v[jb] > bv) { bv = v[jb]; bi = jb; }
                mask |= 1ull << bi;
#pragma unroll
                for (int jb = 0; jb < 64; ++jb) v[jb] = (jb == bi) ? -1.f : v[jb];
            }
        }
        unsigned lo = (unsigned)mask, hi = (unsigned)(mask >> 32);
        selm[2 * tid] = lo; selm[2 * tid + 1] = hi;
#pragma unroll
        for (int o = 1; o < 64; o <<= 1) { lo |= __shfl_xor(lo, o); hi |= __shfl_xor(hi, o); }
        if (tid == 0) { uw[0] = lo; uw[1] = hi; }
    }
    __syncthreads();
    unsigned long long U = ((unsigned long long)uw[1] << 32) | uw[0];
    bf16x8 Q[2][2]; SlcMask mk; FA<2> st; fa_init(st); st.negM = -bnd_slc; unsigned long long msk[2];
#pragma unroll
    for (int q = 0; q < 2; ++q) { const int tl = 8 * w + 4 * q + (l15 >> 2); mk.t[q] = t0 + tl; msk[q] = ((unsigned long long)selm[2 * tl + 1] << 32) | selm[2 * tl]; q_load(Q[q], QR + (tb + mk.t[q]) * 256 + head * 64, quad); }
    unsigned long long QM[2];
#pragma unroll
    for (int q = 0; q < 2; ++q) { unsigned lo = (unsigned)msk[q], hi = (unsigned)(msk[q] >> 32);
#pragma unroll
        for (int o = 1; o < 64; o <<= 1) { lo |= __shfl_xor(lo, o); hi |= __shfl_xor(hi, o); }
        QM[q] = ((unsigned long long)hi << 32) | lo; }
#ifndef PROBE_SLC2
#define PROBE_SLC2 0
#endif
#ifndef PROBE_SWA2
#define PROBE_SWA2 0
#endif
    u32x4 kr, vr; const unsigned long long U0 = U;
    for (int prep_ = 0; prep_ <= PROBE_SLC2; ++prep_) { U = U0; if (prep_ < PROBE_SLC2) { fa_init(st); }
#define SLC_LOAD(j) do { const size_t rowk = tb + 64 * (j) + (tid >> 3); kr = *(const u32x4*)(KSb + rowk * 64 + (tid & 7) * 8); vr = *(const u32x4*)(PROJ + rowk * NPJ + 3008 + (tid & 7) * 8); } while (0)
    {
        int j = __builtin_ctzll(U); U &= U - 1ull;
        int jn = U ? __builtin_ctzll(U) : -1; U &= U - 1ull;
        SLC_LOAD(j); __syncthreads(); kv_store(Ks, Vs, tid, kr, vr); if (jn >= 0) SLC_LOAD(jn);
        for (int it = 0;; ++it) {
            __syncthreads();
            const int jnn = U ? __builtin_ctzll(U) : -1; U &= U - 1ull;
            if (jn >= 0) kv_store(Ks + ((it + 1) & 1) * 2 * KT_BYTES, Vs + ((it + 1) & 1) * 2 * KT_BYTES, tid, kr, vr);
            if (jnn >= 0) SLC_LOAD(jnn);
            const bool act[2] = {(bool)((QM[0] >> j) & 1ull), (bool)((QM[1] >> j) & 1ull)};
            if (act[0] || act[1]) { mk.k0 = 64 * j; mk.sel[0] = (msk[0] >> j) & 1ull; mk.sel[1] = (msk[1] >> j) & 1ull; fa_tile<2, true>(st, Q, Ks + (it & 1) * 2 * KT_BYTES, Vs + (it & 1) * 2 * KT_BYTES, lane, mk, act); }
            if (jn < 0) break; j = jn; jn = jnn;
        }
    }
#undef SLC_LOAD
    }
    float lse2[2]; fa_finish<2>(st, lse2);
    {   float* OSl = WSP(float, R_OSLC);
#pragma unroll
        for (int q = 0; q < 2; ++q) { float* o = OSl + (tb + mk.t[q]) * 256 + head * 64 + 4 * quad;
#pragma unroll
            for (int d = 0; d < 4; ++d) *(f32x4*)(o + 16 * d) = st.O[q][d]; }
    }
    FA<2> sw; fa_init(sw); sw.negM = -bnd_swa; SwaMask mw; mw.t[0] = mk.t[0]; mw.t[1] = mk.t[1];
    for (int prep_ = 0; prep_ <= PROBE_SWA2; ++prep_) { if (prep_ < PROBE_SWA2) fa_init(sw);
    {
        const int j0 = tbk >= 8 ? tbk - 8 : 0; const bool act[2] = {true, true};
#define SWA_LOAD(j) do { const size_t rowk = tb + 64 * (j) + (tid >> 3); kr = *(const u32x4*)(KWb + rowk * 64 + (tid & 7) * 8); vr = *(const u32x4*)(PROJ + rowk * NPJ + 3136 + (tid & 7) * 8); } while (0)
        SWA_LOAD(j0); __syncthreads(); kv_store(Ks, Vs, tid, kr, vr); if (j0 + 1 <= tbk) SWA_LOAD(j0 + 1);
        for (int j = j0; j <= tbk; ++j) {
            const int pb_ = (j - j0) & 1;
            __syncthreads();
            if (j + 1 <= tbk) kv_store(Ks + (pb_ ^ 1) * 2 * KT_BYTES, Vs + (pb_ ^ 1) * 2 * KT_BYTES, tid, kr, vr);
            if (j + 2 <= tbk) SWA_LOAD(j + 2);
            mw.k0 = 64 * j;
            if (j == tbk || j == tbk - 8) fa_tile<2, true>(sw, Q, Ks + pb_ * 2 * KT_BYTES, Vs + pb_ * 2 * KT_BYTES, lane, mw, act);
            else fa_tile<2, false>(sw, Q, Ks + pb_ * 2 * KT_BYTES, Vs + pb_ * 2 * KT_BYTES, lane, NoMask(), act);
        }
#undef SWA_LOAD
    }
    }
    fa_finish<2>(sw, lse2);
#pragma unroll
    for (int q = 0; q < 2; ++q) {
        const size_t row = tb + mk.t[q]; const float* gp = GATE + row * 12 + head * 3; const float g0 = gp[0], g1 = gp[1], g2 = gp[2];
        f32x4 o[4]; float ss = 0.f; const float* pc = WSP(float, R_OCMP) + row * 256 + head * 64 + 4 * quad; const float* ps = WSP(float, R_OSLC) + row * 256 + head * 64 + 4 * quad;
#pragma unroll
        for (int d = 0; d < 4; ++d) { o[d] = *(const f32x4*)(pc + 16 * d) * g0 + *(const f32x4*)(ps + 16 * d) * g1 + sw.O[q][d] * g2; ss += (o[d][0] * o[d][0] + o[d][1] * o[d][1]) + (o[d][2] * o[d][2] + o[d][3] * o[d][3]); }
        ss += __shfl_xor(ss, 16); ss += __shfl_xor(ss, 32);
        const float rstd = rsqrtf(ss * (1.f / 64.f) + 1e-6f); const float* og = C.onorm_g + (size_t)l * 768 + 512 + head * 64 + 4 * quad;
        bf16* yo = YCAT + row * DM + 768 + head * 64 + 4 * quad;
#pragma unroll
        for (int d = 0; d < 4; ++d) { const f32x4 g4 = *(const f32x4*)(og + 16 * d); u32x2 wv; wv.x = pk2(o[d][0] * rstd * g4[0], o[d][1] * rstd * g4[1]); wv.y = pk2(o[d][2] * rstd * g4[2], o[d][3] * rstd * g4[3]); *(u32x2*)(yo + 16 * d) = wv; }
    }
}

DI void fin_phase(const Ctx& C, int l) {
    const float* SC = WSP(float, R_SC); const float* YA = WSP(float, R_YA); const float* Gb = WSP(float, R_G); const float* OC = WSP(float, R_OC); const float* LSE = WSP(float, R_LSE);
    const float* UB = WSP(float, R_SCANU); const float* SMT = WSP(float, R_SCANS); bf16* YCAT = WSP(bf16, R_YCAT);
    const int lane = C.lane, ch = 4 * lane, hh = lane >> 4;
    LAS float* sm = (LAS float*)C.lds;
    LAS float* us = sm + 4 * 4096 + C.wave * 256;
    int bl = -1;
    for (int it = C.bid; it < NT / 128; it += C.G) {
        const int b = it >> 5, kk = it & 31;
        if (b != bl) { __syncthreads(); for (int i = C.tid; i < 4096; i += NTHR) *(LAS f32x4*)(sm + 4 * i) = *(const f32x4*)(SMT + (size_t)b * 4 * 4096 + 4 * i); bl = b; __syncthreads(); }
#pragma unroll 1
      for (int hf = 0; hf < 2; ++hf) {
        const int rbase = b * NS + hf * (NS / 2) + 64 * kk + C.wave * 8;
        const bool fix = hf == 1;
#pragma unroll 2
        for (int r = 0; r < 8; ++r) {
            const int row = rbase + r, s = row % NS;
            const size_t o = (size_t)row * 256 + ch;
            {
                f32x4 y = *(const f32x4*)(YA + o); const f32x4 rr = *(const f32x4*)(SC + (size_t)4 * NT * 256 + o), k = *(const f32x4*)(SC + (size_t)1 * NT * 256 + o), v = *(const f32x4*)(SC + (size_t)5 * NT * 256 + o), g = *(const f32x4*)(Gb + o);
                if (fix) {
                    *(LAS f32x4*)(us + ch) = *(const f32x4*)(UB + ((size_t)b * (NS / 2) + (s - NS / 2)) * 256 + ch);
                    asm volatile("s_waitcnt lgkmcnt(0)" ::: "memory");
                    const LAS float* sp = sm + hh * 4096 + 4 * (lane & 15); const LAS float* up = us + hh * 64;
#pragma unroll 8
                    for (int j4 = 0; j4 < 16; ++j4) { const f32x4 u4 = *(const LAS f32x4*)(up + 4 * j4);
#pragma unroll
                        for (int jj = 0; jj < 4; ++jj) y += *(const LAS f32x4*)(sp + (4 * j4 + jj) * 64) * u4[jj]; }
                    asm volatile("s_waitcnt lgkmcnt(0)" ::: "memory");
                }
                const f32x4 rk = *(const f32x4*)(C.rk + (size_t)l * 256 + ch), gw4 = *(const f32x4*)(C.gn_w + (size_t)l * 256 + ch), gb4 = *(const f32x4*)(C.gn_b + (size_t)l * 256 + ch);
                const float mu = group_sum<16>((y[0] + y[1]) + (y[2] + y[3])) * (1.f / 64.f);
                const f32x4 dy = y - mu; const float var = group_sum<16>((dy[0] * dy[0] + dy[1] * dy[1]) + (dy[2] * dy[2] + dy[3] * dy[3])) * (1.f / 64.f);
                const float rstd = rsqrtf(var + 64e-5f);
                const float dot = group_sum<16>((rr[0] * k[0] * rk[0] + rr[1] * k[1] * rk[1]) + (rr[2] * k[2] * rk[2] + rr[3] * k[3] * rk[3]));
                float out[4];
#pragma unroll
                for (int i = 0; i < 4; ++i) out[i] = ((dy[i] * rstd * gw4[i] + gb4[i]) + dot * v[i]) * g[i];
                u32x2 w; w.x = pk2(out[0], out[1]); w.y = pk2(out[2], out[3]); *(u32x2*)(YCAT + (size_t)row * DM + ch) = w;
            }
            {
                const float l0 = LSE[(size_t)row * 4 + hh], l1 = LSE[((size_t)NT + row) * 4 + hh], l2 = LSE[((size_t)2 * NT + row) * 4 + hh];
                const float mx = fmaxf(l0, fmaxf(l1, l2)); float w0 = fexp2(l0 - mx), w1 = fexp2(l1 - mx), w2 = fexp2(l2 - mx); const float inv = 1.f / (w0 + w1 + w2); w0 *= inv; w1 *= inv; w2 *= inv;
                const f32x4 a = *(const f32x4*)(OC + o), bq = *(const f32x4*)(OC + (size_t)NT * 256 + o), c = *(const f32x4*)(OC + (size_t)2 * NT * 256 + o);
                const f32x4 y = a * w0 + bq * w1 + c * w2;
                const float ss = group_sum<16>((y[0] * y[0] + y[1] * y[1]) + (y[2] * y[2] + y[3] * y[3])); const float rstd = rsqrtf(ss * (1.f / 64.f) + 1e-6f);
                const f32x4 og = *(const f32x4*)(C.onorm_g + (size_t)l * 768 + 256 + ch);
                u32x2 w; w.x = pk2(y[0] * rstd * og[0], y[1] * rstd * og[1]); w.y = pk2(y[2] * rstd * og[2], y[3] * rstd * og[3]); *(u32x2*)(YCAT + (size_t)row * DM + 512 + ch) = w;
            }
        }
      }
    }
    __syncthreads();
}

constexpr int CW_Q = 40000;
DI int q_next(const Ctx& C, unsigned* ctr, LAS int* slot) {
    __syncthreads();
    if (C.tid == 0) *slot = (int)__hip_atomic_fetch_add(ctr, 1u, __ATOMIC_RELAXED, __HIP_MEMORY_SCOPE_AGENT);
    __syncthreads();
    return *slot;
}
DI void conv_ticket(const Ctx& C, int l, int tk);
#ifndef PROBE_TS
#define PROBE_TS 0
#endif
constexpr int CW_TS = 50000;
DI void ts_mark(const Ctx& C, int l, int ev) {
#if PROBE_TS
    if (l == 0 && C.tid == 0) { unsigned* w = WSP(unsigned, WS_CTL) + CW_TS; const unsigned t = (unsigned)__builtin_amdgcn_s_memrealtime();
        if (ev == 0) { if (C.bid == 0) __hip_atomic_store(w, t, __ATOMIC_RELAXED, __HIP_MEMORY_SCOPE_AGENT); }
        else if (ev == 6) atomicMax(w + 6, ~t); else atomicMax(w + ev, t); }
#endif
}
DI void mix_phase(const Ctx& C, int l, int rep) {
    unsigned* ctl = WSP(unsigned, WS_CTL) + CW_Q + 64 * 3 * (l + 2 * rep); LAS int* slot = (LAS int*)(C.lds + MISC_OFF + 1024);
    ts_mark(C, l, 0);
#ifndef PROBE_SPLIT
#define PROBE_SPLIT 0
#endif
    if (C.bid < 96) { scan_unit8(C, C.bid); if (PROBE_SCAN2) scan_unit8(C, C.bid); ts_mark(C, l, 4); }
    if (PROBE_SPLIT) { asm volatile("s_waitcnt vmcnt(0)" ::: "memory"); __syncthreads(); { XcdBarrier bar2; bar2.bar = WSP(unsigned, WS_CTL) + CW_BAR; bar2.x = xb_xcc_id(); bar2.st = (volatile LAS unsigned*)(C.lds + MISC_OFF); xcd_barrier(bar2); } }
    int bl = -1;
    const float bnd_cmp = score_bound(C.nsa_q_g + (size_t)l * 64, C.nsa_kc_g + (size_t)l * 64, C.lane), bnd_slc = score_bound(C.nsa_q_g + (size_t)l * 64, C.nsa_ks_g + (size_t)l * 64, C.lane),
                bnd_swa = score_bound(C.nsa_q_g + (size_t)l * 64, C.nsa_kw_g + (size_t)l * 64, C.lane), bnd_dil = score_bound(C.dil_q_g + (size_t)l * 64, C.dil_k_g + (size_t)l * 64, C.lane);
    bool conv_left = true;
#define CONV_ONE() do { if (conv_left) { const int t_ = q_next(C, ctl + 128, slot); if (t_ >= 768 * (1 + PROBE_CONV2)) conv_left = false; else { conv_ticket(C, l, t_ % 768); bl = -1; } } } while (0)
    for (;;) { const int u = q_next(C, ctl, slot); if (u >= 512 * (1 + PROBE_ATT2)) break; nsa_unit(C, l, u & 7, 63 - ((u & 511) >> 3), bl, bnd_cmp, bnd_slc, bnd_swa); CONV_ONE(); }
    ts_mark(C, l, 1);
    for (int n = 0;; ++n) { const int u = q_next(C, ctl + 64, slot); if (u >= 1536 * (1 + PROBE_ATT2)) break; dil_unit(C, u % 1536, C.lds, C.lds + KT_BYTES, bnd_dil); if ((n & 3) == 3) CONV_ONE(); }
    ts_mark(C, l, 2);
    while (conv_left) CONV_ONE();
#undef CONV_ONE
    ts_mark(C, l, 3); if (C.bid >= 96) ts_mark(C, l, 6);
    __syncthreads();
}
#define MFMA_F32(a, b, c) __builtin_amdgcn_mfma_f32_16x16x4f32((a), (b), (c), 0, 0, 0)
DI void router_phase(const Ctx& C, int l) {
    const float* X = C.out; const float* MOD = WSP(float, WS_SMALL) + (size_t)l * 8 * 6144; unsigned char* H8 = WSP(unsigned char, R_XS);
    int* TOPE = WSP(int, WS_ROUTE); float* TOPG = (float*)(TOPE + NT * 4); unsigned* CNTB = WSP(unsigned, WS_CTL) + CW_CNT + l * 8192;
    LAS float* wl = (LAS float*)C.lds;
    LAS float* lg = (LAS float*)(C.lds + MISC_OFF + 8192) + C.wave * 512;
    LAS unsigned* hist = (LAS unsigned*)(C.lds + MISC_OFF + 6144);
    LAS float* rs = (LAS float*)(C.lds + MISC_OFF + 6400) + C.wave * 16;
    const int lane = C.lane, l15 = lane & 15, quad = lane >> 4, gw = C.bid * NWAVE + C.wave, NGW = C.G * NWAVE;
    const float* wr = C.w_router + (size_t)l * 1024 * 32; const float* g2 = C.norm2_g + (size_t)l * DM;
    __syncthreads();
    if (C.tid < 32) hist[C.tid] = 0u;
    for (int i = C.tid; i < 8192; i += NTHR) { const int k = i >> 3, e4 = (i & 7) * 4; const f32x4 v = *(const f32x4*)(wr + (size_t)k * 32 + e4); LAS float* d = wl + ((k >> 2) * 32 + e4) * 4 + (k & 3);
        d[0] = v[0]; d[4] = v[1]; d[8] = v[2]; d[12] = v[3]; }
    __syncthreads();
    for (int task = gw; task < NT / 16; task += NGW) {
        const int row0 = 16 * task, b = row0 / NS;
        const float* shb = MOD + (size_t)b * 6144 + 3072; const float* scb = shb + 1024;
        {
            f32x4 gg[4], sa[4], sb[4];
#pragma unroll
            for (int j = 0; j < 4; ++j) { const int k = 4 * lane + 256 * j; const f32x4 g = *(const f32x4*)(g2 + k), a = *(const f32x4*)(scb + k); gg[j] = g * (a + 1.f); sb[j] = *(const f32x4*)(shb + k); }
#pragma unroll 2
            for (int r = 0; r < 16; ++r) {
                const float* xr = X + (size_t)(row0 + r) * DM + 4 * lane; f32x4 v[4]; float ss = 0.f;
#pragma unroll
                for (int j = 0; j < 4; ++j) { v[j] = *(const f32x4*)(xr + 256 * j); ss += (v[j][0] * v[j][0] + v[j][1] * v[j][1]) + (v[j][2] * v[j][2] + v[j][3] * v[j][3]); }
                ss = group_sum<64>(ss); const float rstd = rsqrtf(ss * (1.f / DM) + 1e-6f);
                if (lane == 0) rs[r] = rstd;
                unsigned char* hp = H8 + (size_t)(row0 + r) * DM + 4 * lane;
#pragma unroll
                for (int j = 0; j < 4; ++j) { const f32x4 h = v[j] * rstd * gg[j] + sb[j]; *(unsigned*)(hp + 256 * j) = pk4_fp8(h[0], h[1], h[2], h[3]); }
            }
        }
        const float* xr = X + (size_t)(row0 + l15) * DM + 4 * quad; const float* sh = shb + 4 * quad; const float* sc = scb + 4 * quad;
        asm volatile("s_waitcnt lgkmcnt(0)" ::: "memory");
        const float rstd = rs[l15];
        f32x4 acc0 = (f32x4){0.f, 0.f, 0.f, 0.f}, acc1 = acc0;
#pragma unroll 2
        for (int i = 0; i < 64; ++i) {
            const f32x4 a = *(const f32x4*)(xr + 16 * i), g = *(const f32x4*)(g2 + 16 * i + 4 * quad), s1 = *(const f32x4*)(sc + 16 * i), s0 = *(const f32x4*)(sh + 16 * i);
            f32x4 h;
#pragma unroll
            for (int j = 0; j < 4; ++j) h[j] = a[j] * rstd * g[j] * (1.f + s1[j]) + s0[j];
            const LAS float* wp = wl + ((4 * i + quad) * 32 + l15) * 4; const f32x4 w0 = *(const LAS f32x4*)wp, w1 = *(const LAS f32x4*)(wp + 64);
#pragma unroll
            for (int j = 0; j < 4; ++j) { acc0 = MFMA_F32(h[j], w0[j], acc0); acc1 = MFMA_F32(h[j], w1[j], acc1); }
        }
        const float b0 = C.b_router[l * 32 + l15], b1 = C.b_router[l * 32 + 16 + l15];
#pragma unroll
        for (int j = 0; j < 4; ++j) { lg[(4 * quad + j) * 32 + l15] = acc0[j] + b0; lg[(4 * quad + j) * 32 + 16 + l15] = acc1[j] + b1; }
        asm volatile("s_waitcnt lgkmcnt(0)" ::: "memory");
        if (lane < 16) {
            float v[32];
#pragma unroll
            for (int i = 0; i < 8; ++i) { const f32x4 a = *(const LAS f32x4*)(lg + lane * 32 + 4 * i); v[4 * i] = a[0]; v[4 * i + 1] = a[1]; v[4 * i + 2] = a[2]; v[4 * i + 3] = a[3]; }
            float tv[4]; int ti[4];
#pragma unroll
            for (int r = 0; r < 4; ++r) { float bv = -3.0e38f; int bi = 0;
#pragma unroll
                for (int e = 0; e < 32; ++e) if (v[e] > bv) { bv = v[e]; bi = e; }
                tv[r] = bv; ti[r] = bi;
#pragma unroll
                for (int e = 0; e < 32; ++e) v[e] = (e == bi) ? -3.0e38f : v[e]; }
            const float e1 = __expf(tv[1] - tv[0]), e2 = __expf(tv[2] - tv[0]), e3 = __expf(tv[3] - tv[0]), inv = 1.f / (1.f + e1 + e2 + e3);
            const int row = row0 + lane;
            *(int4*)(TOPE + (size_t)row * 4) = make_int4(ti[0], ti[1], ti[2], ti[3]);
            *(f32x4*)(TOPG + (size_t)row * 4) = (f32x4){inv, e1 * inv, e2 * inv, e3 * inv};
#pragma unroll
            for (int r = 0; r < 4; ++r) __hip_atomic_fetch_add(&hist[ti[r]], 1u, __ATOMIC_RELAXED, __HIP_MEMORY_SCOPE_WORKGROUP);
        }
        asm volatile("s_waitcnt lgkmcnt(0)" ::: "memory");
    }
    __syncthreads();
    if (C.tid < 32) CNTB[C.bid * 32 + C.tid] = hist[C.tid];
}

DI void moe_tables(const Ctx& C, int l, LAS int* tab) {
    const unsigned* CNTB = WSP(unsigned, WS_CTL) + CW_CNT + l * 8192;
    LAS unsigned* part = (LAS unsigned*)(tab + 192);
    __syncthreads();
    { const int e = C.tid & 31, pt = C.tid >> 5; unsigned tot = 0u, mine = 0u;
        const int g0 = pt * ((C.G + 15) >> 4), g1 = min(C.G, g0 + ((C.G + 15) >> 4));
#pragma unroll 16
        for (int g = g0; g < g1; ++g) { const unsigned c = CNTB[g * 32 + e]; tot += c; mine += (g < C.bid) ? c : 0u; }
        part[(pt * 2) * 32 + e] = tot; part[(pt * 2 + 1) * 32 + e] = mine; }
    __syncthreads();
    if (C.tid < 32) { unsigned tot = 0u, mine = 0u;
#pragma unroll
        for (int pt = 0; pt < 16; ++pt) { tot += part[(pt * 2) * 32 + C.tid]; mine += part[(pt * 2 + 1) * 32 + C.tid]; }
        tab[128 + C.tid] = (int)((tot + 255u) >> 8); tab[64 + C.tid] = (int)mine; }
    __syncthreads();
    if (C.tid == 0) { int s = 0; for (int e = 0; e < 32; ++e) { tab[e] = s; s += tab[128 + e]; } tab[32] = s; }
    __syncthreads();
}
DI void scatter_phase(const Ctx& C, int l) {
    const int* TOPE = WSP(int, WS_ROUTE); int* POS = (int*)(TOPE + NT * 8); int* ROWMAP = (int*)(TOPE + NT * 12);
    LAS int* tab = (LAS int*)(C.lds + MISC_OFF + 64); LAS unsigned* cur = (LAS unsigned*)(C.lds + 16384);
    moe_tables(C, l, tab);
    if (C.tid < 32) cur[C.tid] = (unsigned)(tab[C.tid] * 256 + tab[64 + C.tid]);
    __syncthreads();
    const int lane = C.lane, gw = C.bid * NWAVE + C.wave, NGW = C.G * NWAVE;
    for (int task = gw; task < NT / 16; task += NGW) {
        const int row0 = 16 * task, tok = row0 + (lane >> 2);
        const int e = TOPE[(size_t)tok * 4 + (lane & 3)];
        const int slot = (int)__hip_atomic_fetch_add(&cur[e], 1u, __ATOMIC_RELAXED, __HIP_MEMORY_SCOPE_WORKGROUP);
        POS[(size_t)tok * 4 + (lane & 3)] = slot; ROWMAP[slot] = tok;
    }
}
DI void combine_phase(const Ctx& C, int l, float* dst) {
    const bf16* YB = WSP(bf16, R_YB); const int* TOPE = WSP(int, WS_ROUTE); const float* TOPG = (const float*)(TOPE + NT * 4); const int* POS = (const int*)(TOPE + NT * 8);
    const float* MOD = WSP(float, WS_SMALL) + (size_t)l * 8 * 6144; bf16* H = WSP(bf16, WS_H);
    const int lane = C.lane, gw = C.bid * NWAVE + C.wave, NGW = C.G * NWAVE;
    for (int task = gw; task < NT / 16; task += NGW) {
        const int row0 = 16 * task, b = row0 / NS; const float* gt = MOD + (size_t)b * 6144 + 5120 + 8 * lane;
        f32x4 g4[4], gg[4], sb[4];
#pragma unroll
        for (int j = 0; j < 2; ++j) { g4[2 * j] = *(const f32x4*)(gt + 512 * j); g4[2 * j + 1] = *(const f32x4*)(gt + 512 * j + 4); }
        if (l + 1 < NLAYER) { const float* M2 = MOD + 8 * 6144 + (size_t)b * 6144 + 8 * lane; const float* g = C.norm1_g + (size_t)(l + 1) * DM + 8 * lane;
#pragma unroll
            for (int j = 0; j < 2; ++j)
#pragma unroll
                for (int hlf = 0; hlf < 2; ++hlf) { const int o = 512 * j + 4 * hlf; gg[2 * j + hlf] = *(const f32x4*)(g + o) * (*(const f32x4*)(M2 + 1024 + o) + 1.f); sb[2 * j + hlf] = *(const f32x4*)(M2 + o); } }
#pragma unroll 2
        for (int r = 0; r < 16; ++r) {
            const int row = row0 + r; const int4 ps = *(const int4*)(POS + (size_t)row * 4); const f32x4 gk = *(const f32x4*)(TOPG + (size_t)row * 4);
            const int pp[4] = {ps.x, ps.y, ps.z, ps.w};
            const float* orow = C.out + (size_t)row * DM + 8 * lane; float* drow = dst + (size_t)row * DM + 8 * lane;
            u32x4 y[4][2]; f32x4 x[4];
#pragma unroll
            for (int q = 0; q < 4; ++q)
#pragma unroll
                for (int j = 0; j < 2; ++j) y[q][j] = *(const u32x4*)(YB + (size_t)pp[q] * DM + 8 * lane + 512 * j);
#pragma unroll
            for (int j = 0; j < 2; ++j) { x[2 * j] = *(const f32x4*)(orow + 512 * j); x[2 * j + 1] = *(const f32x4*)(orow + 512 * j + 4); }
            f32x4 v[4]; float s = 0.f;
#pragma unroll
            for (int j = 0; j < 2; ++j) { f32x4 a0 = (f32x4){0.f, 0.f, 0.f, 0.f}, a1 = a0;
#pragma unroll
                for (int q = 0; q < 4; ++q) { const u32x4 w = y[q][j]; a0 += (f32x4){bflo(w.x), bfhi(w.x), bflo(w.y), bfhi(w.y)} * gk[q]; a1 += (f32x4){bflo(w.z), bfhi(w.z), bflo(w.w), bfhi(w.w)} * gk[q]; }
                v[2 * j] = x[2 * j] + g4[2 * j] * a0; v[2 * j + 1] = x[2 * j + 1] + g4[2 * j + 1] * a1;
#if PROBE_TS
                if (l + 1 == NLAYER) { const unsigned* w = WSP(unsigned, WS_CTL) + CW_TS; const unsigned t0 = w[0]; const unsigned ea = (PROBE_TS_A == 6) ? ~w[6] : w[PROBE_TS_A], eb = (PROBE_TS_B == 6) ? ~w[6] : w[PROBE_TS_B];
                    const float A = (PROBE_TS_A == 7) ? 1.f : (float)((ea - t0) / 4000u) * 0.04f, B = (float)(eb - t0) * 1e-3f;
                    v[2 * j] = v[2 * j] + A; v[2 * j + 1] = v[2 * j + 1] + A; (void)B; }
#endif
                *(f32x4*)(drow + 512 * j) = v[2 * j]; *(f32x4*)(drow + 512 * j + 4) = v[2 * j + 1]; }
#pragma unroll
            for (int i = 0; i < 4; ++i) s += (v[i][0] * v[i][0] + v[i][1] * v[i][1]) + (v[i][2] * v[i][2] + v[i][3] * v[i][3]);
            if (l + 1 < NLAYER) {
                s = group_sum<64>(s); const float rstd = rsqrtf(s * (1.f / DM) + 1e-6f); bf16* hrow = H + (size_t)row * DM + 8 * lane;
#pragma unroll
                for (int j = 0; j < 2; ++j) { const f32x4 h0 = v[2 * j] * rstd * gg[2 * j] + sb[2 * j], h1 = v[2 * j + 1] * rstd * gg[2 * j + 1] + sb[2 * j + 1]; u32x4 o;
                    o.x = pk2(h0[0], h0[1]); o.y = pk2(h0[2], h0[3]); o.z = pk2(h1[0], h1[1]); o.w = pk2(h1[2], h1[3]); *(u32x4*)(hrow + 512 * j) = o; }
            }
        }
    }
}
constexpr int PH_PER_LAYER = 11, PH_BASE = 2, N_PHASES = PH_BASE + NLAYER * PH_PER_LAYER;
#ifndef MK_ONE_LAUNCH
#define MK_ONE_LAUNCH 1
#endif
__global__ void __launch_bounds__(NTHR, 2) mk_fwd(Args args) {
    extern __shared__ __attribute__((aligned(16))) unsigned char lds_raw[];
    Ctx C;
    C.lds = (LAS unsigned char*)lds_raw; C.tid = threadIdx.x; C.lane = C.tid & 63; C.wave = __builtin_amdgcn_readfirstlane(C.tid >> 6); C.G = gridDim.x; C.bid = blockIdx.x;
    C.x = (const float*)args.in[0]; C.c = (const float*)args.in[1]; C.pos = (const int*)args.in[2]; C.w_ada = (const float*)args.in[3]; C.b_ada = (const float*)args.in[4];
    C.norm1_g = (const float*)args.in[5]; C.norm2_g = (const float*)args.in[6]; C.w_in = (const float*)args.in[7]; C.w_out = (const float*)args.in[8]; C.mu = (const float*)args.in[9];
    C.w0 = (const float*)args.in[10]; C.w2 = (const float*)args.in[11]; C.a0 = (const float*)args.in[12]; C.a2 = (const float*)args.in[13]; C.g2 = (const float*)args.in[14];
    C.kkw = (const float*)args.in[15]; C.ka = (const float*)args.in[16]; C.rk = (const float*)args.in[17]; C.gn_w = (const float*)args.in[18]; C.gn_b = (const float*)args.in[19];
    C.conv_w = (const float*)args.in[20]; C.dil_q_g = (const float*)args.in[21]; C.dil_k_g = (const float*)args.in[22]; C.nsa_q_g = (const float*)args.in[23]; C.nsa_kc_g = (const float*)args.in[24];
    C.nsa_ks_g = (const float*)args.in[25]; C.nsa_kw_g = (const float*)args.in[26]; C.pe_k = (const float*)args.in[27]; C.pe_v = (const float*)args.in[28]; C.wk1 = (const float*)args.in[29];
    C.wk2 = (const float*)args.in[30]; C.wv1 = (const float*)args.in[31]; C.wv2 = (const float*)args.in[32]; C.onorm_g = (const float*)args.in[33]; C.w_router = (const float*)args.in[34];
    C.b_router = (const float*)args.in[35]; C.w_gu = (const float*)args.in[36]; C.b_gu = (const float*)args.in[37]; C.w_down = (const float*)args.in[38]; C.b_down = (const float*)args.in[39];
    C.out = args.out; C.ws = args.ws;
    const int lo = args.ph_lo, hi = args.ph_hi;
    for (int u = C.tid; u < (LDS_BYTES - MISC_OFF) / 4; u += NTHR) ((LAS unsigned*)(C.lds + MISC_OFF))[u] = 0u;
    __syncthreads();
    XcdBarrier bar; bar.bar = WSP(unsigned, WS_CTL) + CW_BAR; bar.x = 0; bar.st = nullptr;
    if (hi - lo > 1) bar = xcd_barrier_post(WSP(unsigned, WS_CTL) + CW_BAR, (volatile LAS unsigned*)(C.lds + MISC_OFF));
#ifndef PHMASK
#define PHMASK 0xFFFFFFFFu
#endif
#define PHON(n) (((PHMASK) >> (n)) & 1u)
#ifndef PHREP
#define PHREP 0u
#endif
#define NREP(n) (1 + (int)(((PHREP) >> (n)) & 1u))
#define WSPP(T, off) ((T*)(P.ws + (off)))
#define IN(k) (lo <= (k) && (k) < hi)
#define SEAM(k) do { if (IN(k) && IN((k) + 1)) xcd_barrier(bar); } while (0)
#define PCTX Ctx P = C; asm volatile("" : "+v"(P.tid), "+v"(P.lane)); asm volatile("" : "+s"(P.ws), "+s"(P.out), "+s"(P.wave), "+s"(P.bid))
    if (PHON(17) && IN(0)) for (int rep = 0; rep < NREP(17); ++rep) { PCTX; p0_prologue(P); __syncthreads(); }
    SEAM(0);
#ifndef PROBE_BARS
#define PROBE_BARS 0
#endif
    if (hi - lo > 1) for (int i = 0; i < PROBE_BARS; ++i) xcd_barrier(bar);
    if (PHON(18) && IN(1)) { PCTX; norm1_phase(P, 0, P.x); }
    SEAM(1);
    for (int l = 0; l < NLAYER; ++l) {
        const int pb = PH_BASE + PH_PER_LAYER * l;
        if (PHON(0) && IN(pb + 0)) for (int rep = 0; rep < NREP(0); ++rep) { PCTX;
            pg8::Gemm g{WSPP(bf16, WS_H), WSPP(bf16, WS_WIN) + (size_t)l * NPJ * 1024, 1024, 1024}; pg8::StaticOrder S; S.init(NT / 256, NPJ / 256, P.G, P.bid);
            EpiProj E{WSPP(bf16, R_PROJ)}; pg8::gemm_phase(P.lds, P.tid, g, S, E);
        }
        SEAM(pb + 0);
        if (PHON(1) && IN(pb + 1)) for (int rep = 0; rep < NREP(1); ++rep) { PCTX; prep_phase(P, l); __syncthreads(); }
        SEAM(pb + 1);
        if (PHON(2) && IN(pb + 2)) for (int rep = 0; rep < NREP(2); ++rep) { PCTX;
            { pg8::Gemm g{WSPP(bf16, R_LIN), WSPP(bf16, WS_LORA) + (size_t)l * 768 * 256, 256, 256}; pg8::StaticOrder S; S.init(NT / 256, 3, P.G, P.bid);
              EpiLora E{WSPP(float, R_SC), WSPP(float, R_G), P.w0 + l * 256, P.a0 + l * 256, P.ka + l * 256, (rep + 1 < NREP(2)) ? WSPP(float, WS_END) : WSPP(float, R_SC)}; pg8::gemm_phase(P.lds, P.tid, g, S, E); }
            { pg8::Gemm g{WSPP(bf16, R_KCR), WSPP(bf16, WS_WK1) + (size_t)(l * 2) * 256 * 2048, 1024, 2048}; pg8::StaticOrder S; S.init(8, 1, P.G, (P.bid + 64) % P.G);
              EpiC1 E{WSPP(bf16, R_CH1), (WSPP(float, WS_SMALL) + NLAYER * 8 * 6144 + l * 512)}; pg8::gemm_phase(P.lds, P.tid, g, S, E); }
            { pg8::Gemm g{WSPP(bf16, R_VCR), WSPP(bf16, WS_WK1) + (size_t)(l * 2 + 1) * 256 * 2048, 1024, 2048}; pg8::StaticOrder S; S.init(8, 1, P.G, (P.bid + 128) % P.G);
              EpiC1 E{WSPP(bf16, R_CH1) + 2048 * 256, (WSPP(float, WS_SMALL) + NLAYER * 8 * 6144 + l * 512 + 256)}; pg8::gemm_phase(P.lds, P.tid, g, S, E); }
            asm volatile("s_waitcnt vmcnt(0)" ::: "memory"); __syncthreads();
            { pg8::Gemm g{WSPP(bf16, R_CH1), WSPP(bf16, WS_WK2) + (size_t)(l * 2) * 256 * 256, 256, 256}; pg8::StaticOrder S; S.init(8, 1, P.G, (P.bid + 64) % P.G);
              EpiC2 E{WSPP(float, R_CMP)}; pg8::gemm_phase(P.lds, P.tid, g, S, E); }
            { pg8::Gemm g{WSPP(bf16, R_CH1) + 2048 * 256, WSPP(bf16, WS_WK2) + (size_t)(l * 2 + 1) * 256 * 256, 256, 256}; pg8::StaticOrder S; S.init(8, 1, P.G, (P.bid + 128) % P.G);
              EpiC2 E{WSPP(float, R_CMP) + 2048 * 64}; pg8::gemm_phase(P.lds, P.tid, g, S, E); }
        }
        SEAM(pb + 2);
        if (PHON(3) && IN(pb + 3)) for (int rep = 0; rep < NREP(3); ++rep) { PCTX; mix_phase(P, l, rep); }
        SEAM(pb + 3);
        if (PHON(4) && IN(pb + 4)) for (int rep = 0; rep < NREP(4); ++rep) { PCTX; fin_phase(P, l); __syncthreads(); }
        SEAM(pb + 4);
        if (PHON(5) && IN(pb + 5)) for (int rep = 0; rep < NREP(5); ++rep) { PCTX;
            pg8::Gemm g{WSPP(bf16, R_YCAT), WSPP(bf16, WS_WOUT) + (size_t)l * 1024 * 1024, 1024, 1024}; pg8::StaticOrder S; S.init(NT / 256, 4, P.G, P.bid);
            EpiOut E{(rep + 1 < NREP(5)) ? WSPP(float, WS_END) : P.out, l == 0 ? P.x : (const float*)P.out, WSPP(float, WS_SMALL) + (size_t)l * 8 * 6144 + 2048}; pg8::gemm_phase(P.lds, P.tid, g, S, E);
        }
        SEAM(pb + 5);
        if (PHON(6) && IN(pb + 6)) for (int rep = 0; rep < NREP(6); ++rep) { PCTX; router_phase(P, l); __syncthreads(); }
        SEAM(pb + 6);
        if (PHON(7) && IN(pb + 7)) for (int rep = 0; rep < NREP(7); ++rep) { PCTX; scatter_phase(P, l); __syncthreads(); }
        SEAM(pb + 7);
        if (PHON(8) && IN(pb + 8)) for (int rep = 0; rep < NREP(8); ++rep) { PCTX;
            LAS int* tab = (LAS int*)(P.lds + MISC_OFF + 64); moe_tables(P, l, tab);
            pg8::Gemm g{WSPP(bf16, R_XS), WSPP(bf16, WS_WGU) + (size_t)l * 32 * 2048 * 512, 512, 512, WSPP(int, WS_ROUTE) + NT * 12, 32767};
            pg8::GroupedOrder S; S.init(tab[32], 8, P.G, P.bid); S.tstart = tab; S.nrow_e = 2048;
            EpiGU8 E{WSPP(unsigned char, R_ACT), P.b_gu + (size_t)l * 32 * 2048}; pg8::gemm_phase<EpiGU8, pg8::GroupedOrder, true, true>(P.lds, P.tid, g, S, E);
        }
        SEAM(pb + 8);
        if (PHON(9) && IN(pb + 9)) for (int rep = 0; rep < NREP(9); ++rep) { PCTX;
            LAS int* tab = (LAS int*)(P.lds + MISC_OFF + 64); moe_tables(P, l, tab);
            pg8::Gemm g{WSPP(bf16, R_ACT), WSPP(bf16, WS_WDN) + (size_t)l * 32 * 1024 * 512, 512, 512, WSPP(int, WS_ROUTE) + NT * 12 + NR, 0x3FFFF}; pg8::GroupedOrder S; S.init(tab[32], 4, P.G, P.bid); S.tstart = tab; S.nrow_e = 1024;
            EpiDN8 E{WSPP(bf16, R_YB), P.b_down + (size_t)l * 32 * 1024}; pg8::gemm_phase<EpiDN8, pg8::GroupedOrder, true, true>(P.lds, P.tid, g, S, E);
        }
        SEAM(pb + 9);
        if (PHON(10) && IN(pb + 10)) for (int rep = 0; rep < NREP(10); ++rep) { PCTX; combine_phase(P, l, (rep + 1 < NREP(10)) ? WSPP(float, WS_END) : P.out); __syncthreads(); }
        SEAM(pb + 10);
    }
#undef IN
#undef SEAM
}

extern "C" void kernel_launch(void* const* d_in, const int* in_sizes, int n_in, void* d_out, int out_size, void* d_ws, size_t ws_size, hipStream_t stream) {
    static int grid = 0;
    if (grid == 0) {
        if (n_in != 40 || out_size != NT * DM || ws_size < WS_END + 256 * MiB) { fprintf(stderr, "kernel_launch: unexpected problem (n_in %d, out %d, ws %zu < %zu)\n", n_in, out_size, ws_size, (size_t)WS_END); grid = -1; return; }
        int dev = 0, cus = 0, per_cu = 0;
        if (hipGetDevice(&dev) != hipSuccess || hipDeviceGetAttribute(&cus, hipDeviceAttributeMultiprocessorCount, dev) != hipSuccess) { grid = -1; return; }
        if (hipFuncSetAttribute((const void*)mk_fwd, hipFuncAttributeMaxDynamicSharedMemorySize, LDS_BYTES) != hipSuccess) { fprintf(stderr, "kernel_launch: hipFuncSetAttribute failed\n"); grid = -1; return; }
        if (hipOccupancyMaxActiveBlocksPerMultiprocessor(&per_cu, (const void*)mk_fwd, NTHR, LDS_BYTES) != hipSuccess || per_cu < 1) fprintf(stderr, "kernel_launch: occupancy query says %d blocks per CU\n", per_cu);
        (void)hipGetLastError();
        grid = cus > 256 ? 256 : cus;
    }
    if (grid < 0) return;
    (void)hipMemsetAsync((char*)d_ws, 0, ZERO_BYTES, stream);
    Args a{};
    for (int i = 0; i < 40; ++i) a.in[i] = d_in[i];
    a.out = (float*)d_out; a.ws = (unsigned char*)d_ws;
#if MK_ONE_LAUNCH
    a.ph_lo = 0; a.ph_hi = N_PHASES;
    hipLaunchKernelGGL(mk_fwd, dim3(grid), dim3(NTHR), LDS_BYTES, stream, a);
#else
    for (int p = 0; p < N_PHASES; ++p) { a.ph_lo = p; a.ph_hi = p + 1; hipLaunchKernelGGL(mk_fwd, dim3(grid), dim3(NTHR), LDS_BYTES, stream, a); }
#endif
    const hipError_t le = hipPeekAtLastError();
    if (le != hipSuccess) fprintf(stderr, "kernel_launch: launch failed: %s\n", hipGetErrorName(le));
}
```

```cpp
#include <hip/hip_runtime.h>
#include <cstdio>
#include <cstdint>

#define DI __device__ __forceinline__
#define LAS __attribute__((address_space(3)))
#define GAS __attribute__((address_space(1)))
typedef unsigned short bf16;
typedef short bf16x8 __attribute__((ext_vector_type(8)));
typedef float f32x4 __attribute__((ext_vector_type(4)));
typedef float f32x2 __attribute__((ext_vector_type(2)));
typedef unsigned u32x4 __attribute__((ext_vector_type(4)));
typedef unsigned u32x2 __attribute__((ext_vector_type(2)));
typedef unsigned char uchar;

#ifndef PROBE_TS
#define PROBE_TS 0
#endif
#ifndef PROBE_SCAN2
#define PROBE_SCAN2 0
#endif
#ifndef PROBE_ATT2
#define PROBE_ATT2 0
#endif
#ifndef PROBE_CONV2
#define PROBE_CONV2 0
#endif
#ifndef INPROJ_FP8
#define INPROJ_FP8 0
#endif
#ifndef PROBE_TS_A
#define PROBE_TS_A 6
#endif
#ifndef PROBE_TS_B
#define PROBE_TS_B 6
#endif
constexpr int NB = 8, NS = 4096, NT = NB * NS, DM = 1024, NPJ = 3328, NE = 32, FF = 1024, NLAYER = 2;
constexpr int PJ_A = 0, PJ_B = 1024, PJ_C = 1792, PJ_D = 2560;
constexpr int NR = NT * 4 + NE * 256;
constexpr int NTHR = 512, NWAVE = 8;

DI float bf2f(unsigned v) { return __builtin_bit_cast(float, v << 16); }
DI unsigned f2bf(float f) { unsigned u = __builtin_bit_cast(unsigned, f); return (u + 0x7fffu + ((u >> 16) & 1u)) >> 16; }
DI unsigned pk2(float lo, float hi) { return f2bf(lo) | (f2bf(hi) << 16); }
DI float bflo(unsigned w) { return __builtin_bit_cast(float, w << 16); }
DI float bfhi(unsigned w) { return __builtin_bit_cast(float, w & 0xffff0000u); }
DI float fexp2(float x) { return __builtin_amdgcn_exp2f(x); }
DI float fsigmoid(float x) { return __builtin_amdgcn_rcpf(1.f + __builtin_amdgcn_exp2f(-1.44269504089f * x)); }
DI float wsum_xor(float v, int o) { return v + __shfl_xor(v, o); }
template <int CTRL> DI float dppmov(float x) { return __builtin_bit_cast(float, __builtin_amdgcn_update_dpp(0, __builtin_bit_cast(int, x), CTRL, 0xF, 0xF, true)); }
template <int W> DI float group_sum(float v) {
    if (W >= 2) v += dppmov<0xB1>(v);
    if (W >= 4) v += dppmov<0x4E>(v);
    if (W >= 8) v += dppmov<0x141>(v);
    if (W >= 16) v += dppmov<0x140>(v);
    if (W >= 32) v += __shfl_xor(v, 16);
    if (W >= 64) v += __shfl_xor(v, 32);
    return v;
}
DI float sum8(float x) { x += dppmov<0xB1>(x); x += dppmov<0x4E>(x); x += dppmov<0x141>(x); return x; }

#define XB_TMO      128
#define XB_XCNT(j)  (256  + 64 * (j))
#define XB_XSUB(j)  (1280 + 64 * (j))
#define XB_XGEN(j)  (2304 + 64 * (j))
#define XB_TOP      3328
#define XB_TOPGEN   3392
#define XCD_BAR_WORDS 3456
#define XB_SPIN_CAP (1u << 18)
DI unsigned xb_ld(unsigned* p)              { return __hip_atomic_load(p, __ATOMIC_RELAXED, __HIP_MEMORY_SCOPE_AGENT); }
DI unsigned xb_add(unsigned* p, unsigned v) { return __hip_atomic_fetch_add(p, v, __ATOMIC_RELAXED, __HIP_MEMORY_SCOPE_AGENT); }
DI unsigned xb_xcc_id() { return (unsigned)__builtin_amdgcn_s_getreg((3 << 11) | 20) & 0xFu; }
#define XB_SPIN(cond, bar) do { unsigned _sp = 0; while (cond) { __builtin_amdgcn_s_sleep(1); \
    if ((++_sp & 255u) == 0u) { if (xb_ld(&(bar)[XB_TMO])) break; if (_sp > XB_SPIN_CAP) { atomicAdd(&(bar)[XB_TMO], 1u); break; } } } } while (0)
struct XcdBarrier { unsigned* bar; unsigned x; volatile LAS unsigned* st; };
DI XcdBarrier xcd_barrier_post(unsigned* bar, volatile LAS unsigned* st) {
    XcdBarrier b; b.bar = bar; b.x = xb_xcc_id(); b.st = st;
    if (threadIdx.x == 0) (void)xb_add(&bar[XB_XCNT(b.x)], 1u);
    return b;
}
DI void xcd_barrier_complete(unsigned* bar, unsigned x, unsigned& nloc, unsigned& nx) {
    const unsigned G = gridDim.x * gridDim.y * gridDim.z;
    unsigned sum, cnt, mine, sp = 0u;
    for (;;) {
        sum = 0u; cnt = 0u; mine = 0u;
#pragma unroll
        for (unsigned j = 0; j < 16; ++j) { const unsigned c = xb_ld(&bar[XB_XCNT(j)]); sum += c; cnt += (c > 0u) ? 1u : 0u; mine = (j == x) ? c : mine; }
        if (sum == G) break;
        __builtin_amdgcn_s_sleep(1);
        if ((++sp & 255u) == 0u) { if (xb_ld(&bar[XB_TMO])) break; if (sp > XB_SPIN_CAP) { atomicAdd(&bar[XB_TMO], 1u); break; } }
    }
    nloc = mine > 0u ? mine : 1u; nx = cnt > 0u ? cnt : 1u;
}
DI void xcd_barrier(const XcdBarrier& b) {
    asm volatile("s_waitcnt vmcnt(0)" ::: "memory");
    __syncthreads();
    if (threadIdx.x == 0) {
        unsigned* bar = b.bar;
        __builtin_amdgcn_s_waitcnt(0);
        unsigned nloc = b.st[0], nx = b.st[1];
        if (nloc == 0u) { xcd_barrier_complete(bar, b.x, nloc, nx); b.st[0] = nloc; b.st[1] = nx; }
        const unsigned old = xb_add(&bar[XB_XSUB(b.x)], 1u);
        const unsigned gen = old / nloc;
        if (old + 1u == (gen + 1u) * nloc) {
            __builtin_amdgcn_fence(__ATOMIC_RELEASE, "agent");
            asm volatile("s_waitcnt vmcnt(0)" ::: "memory");
            const unsigned og = xb_add(&bar[XB_TOP], 1u);
            const unsigned tg = og / nx;
            if (og + 1u == (tg + 1u) * nx) xb_add(&bar[XB_TOPGEN], 1u);
            else XB_SPIN(xb_ld(&bar[XB_TOPGEN]) == tg, bar);
            __builtin_amdgcn_fence(__ATOMIC_ACQUIRE, "agent");
            xb_add(&bar[XB_XGEN(b.x)], 1u);
            asm volatile("s_waitcnt vmcnt(0)" ::: "memory");
        } else {
            XB_SPIN(xb_ld(&bar[XB_XGEN(b.x)]) == gen, bar);
            __builtin_amdgcn_fence(__ATOMIC_ACQUIRE, "agent");
            asm volatile("s_waitcnt vmcnt(0)" ::: "memory");
        }
    }
    __syncthreads();
}
namespace pg8 {
constexpr int BM = 256, BK = 64, HALF = 128, HTB = HALF * BK * 2, STAGE_BYTES = 8 * HTB, NXCD = 8, WGM = 8;
__host__ __device__ __forceinline__ int lds_byte(int r, int c) { const int st = (r >> 4) * 2 + (c >> 5), rr = r & 15, cc = c & 31, ob = rr * 64 + cc * 2; return st * 1024 + (ob ^ (((ob >> 9) & 1) << 5)); }
__host__ __device__ __forceinline__ void stage_rc(int b, int& R, int& C) { const int st = b / 1024, sb = b % 1024, swz = sb ^ (((sb >> 9) & 1) << 5); R = (st >> 1) * 16 + swz / 64; C = (st & 1) * 32 + (swz % 64) / 2; }
__host__ __device__ __forceinline__ int perm32(int rho) { const int n = rho >> 4, i = rho & 15; return 8 * (i >> 2) + 4 * n + (i & 3); }

struct Unit { int pm, pn, brow, e; };
struct Gemm { const bf16* A; const bf16* Bt; int lda, K; const int* rowmap; int rowmask; };

struct StaticOrder {
    int nM, nN, nwg, G, c;
    __device__ void init(int nM_, int nN_, int G_, int c_) { nM = nM_; nN = nN_; nwg = nM * nN; G = G_; c = c_; }
    __device__ bool tile(int i, int& pm, int& pn) const {
        const long L = (long)i * G + c; if (L >= nwg) return false;
        int wgid = (int)L; { const int q = nwg / NXCD, r = nwg % NXCD, xcd = wgid % NXCD, off = wgid / NXCD; wgid = (xcd < r ? xcd * (q + 1) : r * (q + 1) + (xcd - r) * q) + off; }
        const int nig = WGM * nN, gid = wgid / nig, fm = gid * WGM, gsz = (nM - fm) < WGM ? (nM - fm) : WGM;
        pm = fm + ((wgid % nig) % gsz); pn = (wgid % nig) / gsz; return true;
    }
    __device__ bool next(int i, Unit& u) const { if (!tile(i, u.pm, u.pn)) return false; u.brow = u.pn * BM; u.e = 0; return true; }
};
struct GroupedOrder : StaticOrder {
    const LAS int* tstart; int nrow_e;
    __device__ bool next(int i, Unit& u) const {
        if (!tile(i, u.pm, u.pn)) return false;
        int e = 0;
#pragma unroll 1
        for (int j = 16; j > 0; j >>= 1) if (tstart[e + j] <= u.pm) e += j;
        u.e = e; u.brow = e * nrow_e + u.pn * BM; return true;
    }
};
DI unsigned cvt_pk_bf16(float lo, float hi) { unsigned r; asm volatile("v_cvt_pk_bf16_f32 %0, %1, %2" : "=v"(r) : "v"(lo), "v"(hi)); return r; }

template <class Epi, class Sched, bool GATHER = false, bool FP8 = false>
DI void gemm_phase(LAS unsigned char* lds, const int tid, const Gemm g, const Sched& S, const Epi& E) {
    const int wid = __builtin_amdgcn_readfirstlane(tid >> 6), lane = tid & 63, wr = wid >> 2, wc = wid & 3, fr = lane & 15, fq = lane >> 4;
    int K = g.K, lda = g.lda; asm volatile("" : "+s"(K), "+s"(lda));
    const int nt = K / BK;
    unsigned voffA[2], voffB[2]; int Ra[2], Ca[2];
#pragma unroll
    for (int i = 0; i < 2; ++i) { int R, C; stage_rc(tid * 16 + i * 8192, R, C); const int Rb = Epi::PERM ? ((R & ~31) + perm32(R & 31)) : R; Ra[i] = R; Ca[i] = C;
        voffA[i] = (unsigned)(R * lda + C) * 2u; voffB[i] = (unsigned)(Rb * K + C) * 2u; }
    unsigned vgc[2][2]; int rawn[2][2];
#define PG8_GLOAD(dst, pm_) do { _Pragma("unroll") for (int _h = 0; _h < 2; ++_h) _Pragma("unroll") for (int _i = 0; _i < 2; ++_i) { const int* _p = g.rowmap + (size_t)(pm_) * BM + _h * HALF + Ra[_i]; \
        asm volatile("global_load_dword %0, %1, off" : "=v"(dst[_h][_i]) : "v"(_p) : "memory"); } } while (0)
#define PG8_GCONV(vg, raw) do { _Pragma("unroll") for (int _h = 0; _h < 2; ++_h) _Pragma("unroll") for (int _i = 0; _i < 2; ++_i) { int _r = raw[_h][_i]; asm volatile("" : "+v"(_r)); \
        vg[_h][_i] = (unsigned)((_r & g.rowmask) * lda + Ca[_i]) * 2u; } } while (0)
#define PG8_STAGE_A(bufoff, kptr, h, vg) do { if (GATHER) PG8_STAGE(bufoff, kptr, vg[h]); else PG8_STAGE(bufoff, (kptr) + (h) * hstepA, voffA); } while (0)
    const size_t kstep = (size_t)(BK * 2);
    const size_t hstepA = (size_t)HALF * lda * 2, hstepB = (size_t)HALF * K * 2;
    const size_t tstepA = 2 * hstepA;
    const unsigned ldsw = (unsigned)wid * 1024u;
    const int aoff = lds_byte(wr * 64 + fr, fq * 8), boff = lds_byte(wc * 32 + fr, fq * 8);
#define PG8_SA(b, h) (((b) * 2 + (h)) * HTB)
#define PG8_SB(b, h) ((4 + (b) * 2 + (h)) * HTB)
#define PG8_STAGE(bufoff, gbase, voff) do { _Pragma("unroll") for (int _i = 0; _i < 2; ++_i) \
        __builtin_amdgcn_global_load_lds((const unsigned*)((const char*)(gbase) + (voff)[_i]), (LAS unsigned*)(lds + (bufoff) + ldsw + _i * 8192), 16, 0, 0); } while (0)
#define PG8_LDA(dst, b, h) do { _Pragma("unroll") for (int m = 0; m < 4; ++m) { const v4i_ lo_ = *(const LAS v4i_*)(lds + PG8_SA(b, h) + aoff + m * 2048), hi_ = *(const LAS v4i_*)(lds + PG8_SA(b, h) + aoff + m * 2048 + 1024); \
        dst[m] = __builtin_shufflevector(lo_, hi_, 0, 1, 2, 3, 4, 5, 6, 7); } } while (0)
#define PG8_LDB(dst, b, h) do { _Pragma("unroll") for (int n = 0; n < 2; ++n) { const v4i_ lo_ = *(const LAS v4i_*)(lds + PG8_SB(b, h) + boff + n * 2048), hi_ = *(const LAS v4i_*)(lds + PG8_SB(b, h) + boff + n * 2048 + 1024); \
        dst[n] = __builtin_shufflevector(lo_, hi_, 0, 1, 2, 3, 4, 5, 6, 7); } } while (0)
#define PG8_MMA(ai, bj, At, Bt) do { __builtin_amdgcn_s_setprio(1); _Pragma("unroll") for (int m = 0; m < 4; ++m) _Pragma("unroll") for (int n = 0; n < 2; ++n) { \
        if (FP8) acc[ai][bj][m][n] = __builtin_amdgcn_mfma_scale_f32_16x16x128_f8f6f4(Bt[n], At[m], acc[ai][bj][m][n], 0, 0, 0, 0x7F7F7F7F, 0, 0x7F7F7F7F); \
        else { const v8i_ b_ = Bt[n], a_ = At[m]; \
            acc[ai][bj][m][n] = __builtin_amdgcn_mfma_f32_16x16x32_bf16(__builtin_bit_cast(bf16x8, __builtin_shufflevector(b_, b_, 0, 1, 2, 3)), __builtin_bit_cast(bf16x8, __builtin_shufflevector(a_, a_, 0, 1, 2, 3)), acc[ai][bj][m][n], 0, 0, 0); \
            acc[ai][bj][m][n] = __builtin_amdgcn_mfma_f32_16x16x32_bf16(__builtin_bit_cast(bf16x8, __builtin_shufflevector(b_, b_, 4, 5, 6, 7)), __builtin_bit_cast(bf16x8, __builtin_shufflevector(a_, a_, 4, 5, 6, 7)), acc[ai][bj][m][n], 0, 0, 0); } } \
        __builtin_amdgcn_s_setprio(0); } while (0)
#define PG8_WAIT_V(n) asm volatile("s_waitcnt vmcnt(" #n ")" ::: "memory")
#define PG8_WAIT_L(n) asm volatile("s_waitcnt lgkmcnt(" #n ")" ::: "memory")
#define PG8_BAR __builtin_amdgcn_s_barrier()
#define PG8_SCHED __builtin_amdgcn_sched_barrier(0)
    Unit cur, nxt; int ui = 0;
    if (!S.next(0, cur)) return;
    f32x4 acc[2][2][4][2];
#pragma unroll
    for (int a = 0; a < 2; ++a)
#pragma unroll
        for (int b = 0; b < 2; ++b)
#pragma unroll
            for (int m = 0; m < 4; ++m)
#pragma unroll
                for (int n = 0; n < 2; ++n) acc[a][b][m][n] = (f32x4){0.f, 0.f, 0.f, 0.f};
    typedef int v8i_ __attribute__((ext_vector_type(8))); typedef int v4i_ __attribute__((ext_vector_type(4)));
    v8i_ At[4], B0[2], B1[2];
    const char* cA = (const char*)g.A + (GATHER ? (size_t)0 : (size_t)cur.pm * tstepA); const char* cB = (const char*)g.Bt + (size_t)cur.brow * K * 2;
    if (GATHER) { PG8_GLOAD(rawn, cur.pm); asm volatile("s_waitcnt vmcnt(0)" : "+v"(rawn[0][0]), "+v"(rawn[0][1]), "+v"(rawn[1][0]), "+v"(rawn[1][1]) :: "memory"); PG8_GCONV(vgc, rawn); }
    PG8_STAGE(PG8_SB(0, 0), cB, voffB); PG8_STAGE(PG8_SB(0, 1), cB + hstepB, voffB); PG8_STAGE_A(PG8_SA(0, 0), cA, 0, vgc); PG8_STAGE_A(PG8_SA(0, 1), cA, 1, vgc);
    if (wr == 1) PG8_BAR;
    PG8_WAIT_V(2); PG8_BAR;
    PG8_STAGE(PG8_SB(1, 0), cB + kstep, voffB); PG8_STAGE_A(PG8_SA(1, 0), cA + kstep, 0, vgc); PG8_STAGE(PG8_SB(1, 1), cB + hstepB + kstep, voffB);
    PG8_WAIT_V(6); PG8_BAR;
    for (;;) {
        const bool has_next = S.next(ui + 1, nxt);
        const char* nA = (has_next && !GATHER) ? (const char*)g.A + (size_t)nxt.pm * tstepA : cA;
        if (GATHER && has_next) PG8_GLOAD(rawn, nxt.pm); const char* nB = has_next ? (const char*)g.Bt + (size_t)nxt.brow * K * 2 : cB;
#pragma unroll 1
        for (int t = 0; t < nt; t += 2) {
            const bool last = (t == nt - 2);
            const char* a1 = cA + (size_t)(t + 1) * kstep;
            const char* a2 = last ? nA : cA + (size_t)(t + 2) * kstep; const char* b2 = last ? nB : cB + (size_t)(t + 2) * kstep;
            const char* a3 = a2 + kstep; const char* b3 = b2 + kstep;
            PG8_LDB(B0, 0, 0); PG8_LDB(B1, 0, 1); PG8_SCHED; PG8_LDA(At, 0, 0); PG8_STAGE_A(PG8_SA(1, 1), a1, 1, vgc);
            if (GATHER) { if (last && has_next) PG8_GCONV(vgc, rawn); }
            PG8_WAIT_V(8); PG8_WAIT_L(0); PG8_BAR; PG8_MMA(0, 0, At, B0); PG8_MMA(0, 1, At, B1); PG8_BAR; PG8_SCHED;
            PG8_LDA(At, 0, 1); PG8_STAGE(PG8_SB(0, 0), b2, voffB); PG8_STAGE(PG8_SB(0, 1), b2 + hstepB, voffB); PG8_STAGE_A(PG8_SA(0, 0), a2, 0, vgc);
            PG8_WAIT_V(8); PG8_WAIT_L(0); PG8_BAR; PG8_MMA(1, 0, At, B0); PG8_MMA(1, 1, At, B1); PG8_BAR; PG8_SCHED;
            PG8_LDB(B0, 1, 0); PG8_LDB(B1, 1, 1); PG8_SCHED; PG8_LDA(At, 1, 0); PG8_STAGE_A(PG8_SA(0, 1), a2, 1, vgc);
            PG8_WAIT_V(8); PG8_WAIT_L(0); PG8_BAR; PG8_MMA(0, 0, At, B0); PG8_MMA(0, 1, At, B1); PG8_BAR; PG8_SCHED;
            PG8_LDA(At, 1, 1); PG8_STAGE(PG8_SB(1, 0), b3, voffB); PG8_STAGE(PG8_SB(1, 1), b3 + hstepB, voffB); PG8_STAGE_A(PG8_SA(1, 0), a3, 0, vgc);
            PG8_WAIT_V(8); PG8_WAIT_L(0); PG8_BAR; PG8_MMA(1, 0, At, B0); PG8_MMA(1, 1, At, B1); PG8_BAR; PG8_SCHED;
        }
        if (wr == 0) PG8_BAR;
        { int fr2 = fr, fq2 = fq; asm volatile("" : "+v"(fr2), "+v"(fq2)); E(acc, cur, wr, wc, fr2, fq2); }
        if (!has_next) break;
#pragma unroll
        for (int a = 0; a < 2; ++a)
#pragma unroll
            for (int b = 0; b < 2; ++b)
#pragma unroll
                for (int m = 0; m < 4; ++m)
#pragma unroll
                    for (int n = 0; n < 2; ++n) acc[a][b][m][n] = (f32x4){0.f, 0.f, 0.f, 0.f};
        cur = nxt; cA = nA; cB = nB; ++ui;
        if (wr == 1) PG8_BAR;
    }
    PG8_WAIT_V(0);
    PG8_BAR;
#undef PG8_SA
#undef PG8_SB
#undef PG8_STAGE
#undef PG8_STAGE_A
#undef PG8_GLOAD
#undef PG8_GCONV
#undef PG8_LDA
#undef PG8_LDB
#undef PG8_MMA
#undef PG8_WAIT_V
#undef PG8_WAIT_L
#undef PG8_BAR
#undef PG8_SCHED
}
}
constexpr size_t MiB = 1u << 20;
constexpr size_t WS_CTL = 0;
constexpr size_t WS_LORA = 1 * MiB;
constexpr size_t WS_WK2 = 2 * MiB;
constexpr size_t ZERO_BYTES = 3 * MiB;
constexpr size_t WS_WIN = 3 * MiB;
constexpr size_t WS_WOUT = 17 * MiB;
constexpr size_t WS_WK1 = 21 * MiB;
constexpr size_t WS_SMALL = 25 * MiB;
constexpr size_t WS_ROUTE = 27 * MiB;
constexpr size_t WS_WGU = 32 * MiB;
constexpr size_t WS_WDN = 288 * MiB;
constexpr size_t WS_H = 416 * MiB;
constexpr size_t WS_R = 480 * MiB;
constexpr size_t R_PROJ = WS_R;
constexpr size_t R_SC = R_PROJ + 208 * MiB;
constexpr size_t R_SCH = R_SC + 32 * MiB;
constexpr size_t R_LIN = R_SC + 192 * MiB;
constexpr size_t R_G = R_LIN + 16 * MiB;
constexpr size_t R_YA = R_G + 32 * MiB;
constexpr size_t R_YCAT = R_YA + 32 * MiB;
constexpr size_t R_QC = R_YCAT + 64 * MiB;
constexpr size_t R_KC = R_QC + 16 * MiB;
constexpr size_t R_OC = R_KC + 16 * MiB;
constexpr size_t R_LSE = R_OC + 96 * MiB;
constexpr size_t R_QN = R_LSE + 2 * MiB;
constexpr size_t R_QR = R_QN + 16 * MiB;
constexpr size_t R_KCR = R_QR + 16 * MiB;
constexpr size_t R_VCR = R_KCR + 5 * MiB;
constexpr size_t R_KS = R_VCR + 5 * MiB;
constexpr size_t R_KW = R_KS + 4 * MiB;
constexpr size_t R_GATE = R_KW + 4 * MiB;
constexpr size_t R_CH1 = R_GATE + 2 * MiB;
constexpr size_t R_CMP = R_CH1 + 2 * MiB;
constexpr size_t R_OCMP = R_CMP + 1 * MiB;
constexpr size_t R_OSLC = R_OCMP + 32 * MiB;
constexpr size_t R_OSWA = R_OSLC + 32 * MiB;
constexpr size_t R_SCANU = R_OSWA;
constexpr size_t R_SCANS = R_OSWA + 16 * MiB;
constexpr size_t R_IMP = R_OSWA + 32 * MiB;
constexpr size_t R_SELM = R_IMP + 8 * MiB;
constexpr size_t R_MIX_END = R_SELM + 1 * MiB;
constexpr size_t R_XS = WS_R;
constexpr size_t R_ACT = R_XS + 272 * MiB;
constexpr size_t R_YB = R_ACT + 272 * MiB;
constexpr size_t R_MOE_END = R_YB + 272 * MiB;
constexpr size_t WS_END = (R_MIX_END > R_MOE_END ? R_MIX_END : R_MOE_END);
static_assert((size_t)NR * 1024 * 2 <= 272 * MiB, "sorted buffers");
constexpr int CW_BAR = 4096;
constexpr int CW_CNT = 16384;
constexpr int CW_CUR = 16384 + 64;

constexpr int RING_BYTES = 131072;
constexpr int MISC_OFF = RING_BYTES;
constexpr int LDS_BYTES = 155648;

struct Args { const void* in[40]; float* out; unsigned char* ws; int ph_lo, ph_hi; };

struct Ctx {
    LAS unsigned char* lds; int tid, lane, wave, G, bid;
    const float *x, *c, *w_ada, *b_ada, *norm1_g, *norm2_g, *w_in, *w_out, *mu, *w0, *w2, *a0, *a2, *g2, *kkw, *ka, *rk, *gn_w, *gn_b, *conv_w, *dil_q_g, *dil_k_g,
        *nsa_q_g, *nsa_kc_g, *nsa_ks_g, *nsa_kw_g, *pe_k, *pe_v, *wk1, *wk2, *wv1, *wv2, *onorm_g, *w_router, *b_router, *w_gu, *b_gu, *w_down, *b_down;
    const int* pos;
    float* out; unsigned char* ws;
};
#define WSP(T, off) ((T*)(C.ws + (off)))

typedef f32x4 Acc[2][2][4][2];
struct EpiProj {
    static constexpr bool PERM = true; bf16* O; float scale;
    DI void operator()(const Acc& acc, const pg8::Unit& u, int wr, int wc, int fr, int fq) const {
        const int row0 = u.pm * 256 + wr * 64 + fr, col0 = u.pn * 256 + wc * 32 + 8 * fq;
#pragma unroll
        for (int ai = 0; ai < 2; ++ai)
#pragma unroll
            for (int m = 0; m < 4; ++m) { bf16* rowp = O + (size_t)(row0 + ai * 128 + m * 16) * NPJ + col0;
#pragma unroll
                for (int bj = 0; bj < 2; ++bj) { const f32x4 v0 = acc[ai][bj][m][0] * scale, v1 = acc[ai][bj][m][1] * scale; u32x4 w;
                    w.x = pg8::cvt_pk_bf16(v0[0], v0[1]); w.y = pg8::cvt_pk_bf16(v0[2], v0[3]); w.z = pg8::cvt_pk_bf16(v1[0], v1[1]); w.w = pg8::cvt_pk_bf16(v1[2], v1[3]);
                    *(u32x4*)(rowp + bj * 128) = w; } }
    }
};
struct EpiLora {
    static constexpr bool PERM = false; float* Wp; bf16* SCH; bf16* Gb; const float *w0, *a0, *ka; bf16* SCo; float* Wo;
    DI void operator()(const Acc& acc, const pg8::Unit& u, int wr, int wc, int fr, int fq) const {
        const int row0 = u.pm * 256 + wr * 64 + fr, col0 = wc * 32 + 4 * fq;
        if (u.pn == 0) {
#pragma unroll
            for (int bj = 0; bj < 2; ++bj)
#pragma unroll
                for (int n = 0; n < 2; ++n) { const int ch = col0 + bj * 128 + n * 16; const f32x4 b = *(const f32x4*)(w0 + ch);
#pragma unroll
                    for (int ai = 0; ai < 2; ++ai)
#pragma unroll
                        for (int m = 0; m < 4; ++m) { const size_t o = (size_t)(row0 + ai * 128 + m * 16) * 256 + ch; const f32x4 v = acc[ai][bj][m][n] + b; f32x4 r;
#pragma unroll
                            for (int j = 0; j < 4; ++j) r[j] = fexp2(-0.875040829f * fsigmoid(v[j]));
                            *(f32x4*)(Wo + o) = r; } }
        } else if (u.pn == 1) {
#pragma unroll
            for (int bj = 0; bj < 2; ++bj)
#pragma unroll
                for (int n = 0; n < 2; ++n) { const int ch = col0 + bj * 128 + n * 16; const f32x4 b = *(const f32x4*)(a0 + ch), kav = *(const f32x4*)(ka + ch);
#pragma unroll
                    for (int ai = 0; ai < 2; ++ai)
#pragma unroll
                        for (int m = 0; m < 4; ++m) { __builtin_amdgcn_sched_barrier(0); const size_t o = (size_t)(row0 + ai * 128 + m * 16) * 256 + ch; const f32x4 v = acc[ai][bj][m][n] + b;
                            const u32x2 kr = *(const u32x2*)(SCH + o), kn = *(const u32x2*)(SCH + (size_t)NT * 256 + o);
                            const float krf[4] = {bflo(kr.x), bfhi(kr.x), bflo(kr.y), bfhi(kr.y)}, knf[4] = {bflo(kn.x), bfhi(kn.x), bflo(kn.y), bfhi(kn.y)}; float k2[4], bb[4];
#pragma unroll
                            for (int j = 0; j < 4; ++j) { const float a = fsigmoid(v[j]); k2[j] = krf[j] * (1.f + (a - 1.f) * kav[j]); bb[j] = knf[j] * a; }
                            u32x2 o1, o2; o1.x = pk2(k2[0], k2[1]); o1.y = pk2(k2[2], k2[3]); o2.x = pk2(bb[0], bb[1]); o2.y = pk2(bb[2], bb[3]);
                            *(u32x2*)(SCo + o) = o1; *(u32x2*)(SCo + (size_t)2 * NT * 256 + o) = o2; } }
        } else {
#pragma unroll
            for (int bj = 0; bj < 2; ++bj)
#pragma unroll
                for (int n = 0; n < 2; ++n) { const int ch = col0 + bj * 128 + n * 16;
#pragma unroll
                    for (int ai = 0; ai < 2; ++ai)
#pragma unroll
                        for (int m = 0; m < 4; ++m) { const size_t o = (size_t)(row0 + ai * 128 + m * 16) * 256 + ch; const f32x4 v = acc[ai][bj][m][n]; u32x2 w; w.x = pk2(v[0], v[1]); w.y = pk2(v[2], v[3]); *(u32x2*)(Gb + o) = w; } }
        }
    }
};
DI float gelu_tanh(float x) { const float t = 0.7978845608f * (x + 0.044715f * x * x * x); return x * fsigmoid(2.f * t); }
struct EpiC1 {
    static constexpr bool PERM = true; bf16* O; const float* peb;
    DI void operator()(const Acc& acc, const pg8::Unit& u, int wr, int wc, int fr, int fq) const {
        const int row0 = u.pm * 256 + wr * 64 + fr, col0 = wc * 32 + 8 * fq;
#pragma unroll
        for (int bj = 0; bj < 2; ++bj) { const f32x4 b0 = *(const f32x4*)(peb + col0 + bj * 128), b1 = *(const f32x4*)(peb + col0 + bj * 128 + 4);
#pragma unroll
            for (int ai = 0; ai < 2; ++ai)
#pragma unroll
                for (int m = 0; m < 4; ++m) { bf16* p = O + (size_t)(row0 + ai * 128 + m * 16) * 256 + col0 + bj * 128; const f32x4 v0 = acc[ai][bj][m][0] + b0, v1 = acc[ai][bj][m][1] + b1; u32x4 w;
                    w.x = pk2(gelu_tanh(v0[0]), gelu_tanh(v0[1])); w.y = pk2(gelu_tanh(v0[2]), gelu_tanh(v0[3])); w.z = pk2(gelu_tanh(v1[0]), gelu_tanh(v1[1])); w.w = pk2(gelu_tanh(v1[2]), gelu_tanh(v1[3]));
                    *(u32x4*)p = w; } }
    }
};
struct EpiC2 {
    static constexpr bool PERM = false; float* O;
    DI void operator()(const Acc& acc, const pg8::Unit& u, int wr, int wc, int fr, int fq) const {
        if (wc >= 2) return;
        const int row0 = u.pm * 256 + wr * 64 + fr, col0 = wc * 32 + 4 * fq;
#pragma unroll
        for (int ai = 0; ai < 2; ++ai)
#pragma unroll
            for (int m = 0; m < 4; ++m)
#pragma unroll
                for (int n = 0; n < 2; ++n) *(f32x4*)(O + (size_t)(row0 + ai * 128 + m * 16) * 64 + col0 + n * 16) = acc[ai][0][m][n];
    }
};
struct EpiOut {
    static constexpr bool PERM = false; float* O; const float* xin; const float* gt;
    DI void operator()(const Acc& acc, const pg8::Unit& u, int wr, int wc, int fr, int fq) const {
        const int row0 = u.pm * 256 + wr * 64 + fr, col0 = u.pn * 256 + wc * 32 + 4 * fq; const int b = (u.pm * 256) / NS;
#pragma unroll
        for (int bj = 0; bj < 2; ++bj)
#pragma unroll
            for (int n = 0; n < 2; ++n) { const int col = col0 + bj * 128 + n * 16; const f32x4 g = *(const f32x4*)(gt + (size_t)b * 6144 + col);
#pragma unroll
                for (int ai = 0; ai < 2; ++ai)
#pragma unroll
                    for (int m = 0; m < 4; ++m) { const size_t o = (size_t)(row0 + ai * 128 + m * 16) * DM + col; *(f32x4*)(O + o) = *(const f32x4*)(xin + o) + g * acc[ai][bj][m][n]; } }
    }
};
struct EpiGU {
    static constexpr bool PERM = true; bf16* O; const float* bgu;
    DI void operator()(const Acc& acc, const pg8::Unit& u, int wr, int wc, int fr, int fq) const {
        const int row0 = u.pm * 256 + wr * 64 + fr, cc = u.pn * 128 + wc * 32 + 8 * fq; const float* bp = bgu + (size_t)u.e * 2048 + cc;
        const f32x4 g0 = *(const f32x4*)bp, g1 = *(const f32x4*)(bp + 4), u0 = *(const f32x4*)(bp + 1024), u1 = *(const f32x4*)(bp + 1028);
#pragma unroll
        for (int ai = 0; ai < 2; ++ai)
#pragma unroll
            for (int m = 0; m < 4; ++m) { bf16* p = O + (size_t)(row0 + ai * 128 + m * 16) * FF + cc; float r[8];
#pragma unroll
                for (int n = 0; n < 2; ++n) { const f32x4 gv = acc[ai][0][m][n] + (n ? g1 : g0), uv = acc[ai][1][m][n] + (n ? u1 : u0);
#pragma unroll
                    for (int j = 0; j < 4; ++j) { const float ga = fminf(gv[j], 7.f), up = fminf(fmaxf(uv[j], -7.f), 7.f); r[4 * n + j] = ga * fsigmoid(1.702f * ga) * (up + 1.f); } }
                u32x4 w; w.x = pk2(r[0], r[1]); w.y = pk2(r[2], r[3]); w.z = pk2(r[4], r[5]); w.w = pk2(r[6], r[7]); *(u32x4*)p = w; }
    }
};
struct EpiDN {
    static constexpr bool PERM = true; bf16* O; const float* bd;
    DI void operator()(const Acc& acc, const pg8::Unit& u, int wr, int wc, int fr, int fq) const {
        const int row0 = u.pm * 256 + wr * 64 + fr, col0 = u.pn * 256 + wc * 32 + 8 * fq; const float* bp = bd + (size_t)u.e * 1024 + col0;
#pragma unroll
        for (int bj = 0; bj < 2; ++bj) { const f32x4 b0 = *(const f32x4*)(bp + bj * 128), b1 = *(const f32x4*)(bp + bj * 128 + 4);
#pragma unroll
            for (int ai = 0; ai < 2; ++ai)
#pragma unroll
                for (int m = 0; m < 4; ++m) { bf16* p = O + (size_t)(row0 + ai * 128 + m * 16) * DM + col0 + bj * 128; const f32x4 v0 = acc[ai][bj][m][0] + b0, v1 = acc[ai][bj][m][1] + b1; u32x4 w;
                    w.x = pk2(v0[0], v0[1]); w.y = pk2(v0[2], v0[3]); w.z = pk2(v1[0], v1[1]); w.w = pk2(v1[2], v1[3]); *(u32x4*)p = w; } }
    }
};
DI float clamp8(float x) { return fminf(fmaxf(x, -448.f), 448.f); }
DI unsigned pk4_fp8_nc(float a, float b, float c, float d) { unsigned w = 0u; w = __builtin_amdgcn_cvt_pk_fp8_f32(a, b, w, false); w = __builtin_amdgcn_cvt_pk_fp8_f32(c, d, w, true); return w; }
DI unsigned pk4_fp8(float a, float b, float c, float d) { unsigned w = 0u; w = __builtin_amdgcn_cvt_pk_fp8_f32(clamp8(a), clamp8(b), w, false); w = __builtin_amdgcn_cvt_pk_fp8_f32(clamp8(c), clamp8(d), w, true); return w; }
constexpr float W8_SCALE = 32.f, W8_INV = 1.f / 32.f;
struct EpiGU8 {
    static constexpr bool PERM = true; unsigned char* O; const float* bgu;
    DI void operator()(const Acc& acc, const pg8::Unit& u, int wr, int wc, int fr, int fq) const {
        const int row0 = u.pm * 256 + wr * 64 + fr, cc = u.pn * 128 + wc * 32 + 8 * fq; const float* bp = bgu + (size_t)u.e * 2048 + cc;
        const f32x4 g0 = *(const f32x4*)bp, g1 = *(const f32x4*)(bp + 4), u0 = *(const f32x4*)(bp + 1024), u1 = *(const f32x4*)(bp + 1028);
#pragma unroll
        for (int ai = 0; ai < 2; ++ai)
#pragma unroll
            for (int m = 0; m < 4; ++m) { unsigned char* p = O + (size_t)(row0 + ai * 128 + m * 16) * FF + cc; float r[8];
#pragma unroll
                for (int n = 0; n < 2; ++n) { const f32x4 gv = acc[ai][0][m][n] * W8_INV + (n ? g1 : g0), uv = acc[ai][1][m][n] * W8_INV + (n ? u1 : u0);
#pragma unroll
                    for (int j = 0; j < 4; ++j) { const float ga = fminf(gv[j], 7.f), up = __builtin_amdgcn_fmed3f(uv[j], -7.f, 7.f); const float sg = __builtin_amdgcn_rcpf(1.f + __builtin_amdgcn_exp2f(-2.45546695959f * ga)); r[4 * n + j] = (ga * sg) * (up + 1.f); } }
                u32x2 w; w.x = pk4_fp8_nc(r[0], r[1], r[2], r[3]); w.y = pk4_fp8_nc(r[4], r[5], r[6], r[7]); *(u32x2*)p = w; }
    }
};
struct EpiDN8 {
    static constexpr bool PERM = true; bf16* O; const float* bd;
    DI void operator()(const Acc& acc, const pg8::Unit& u, int wr, int wc, int fr, int fq) const {
        const int row0 = u.pm * 256 + wr * 64 + fr, col0 = u.pn * 256 + wc * 32 + 8 * fq; const float* bp = bd + (size_t)u.e * 1024 + col0;
#pragma unroll
        for (int bj = 0; bj < 2; ++bj) { const f32x4 b0 = *(const f32x4*)(bp + bj * 128), b1 = *(const f32x4*)(bp + bj * 128 + 4);
#pragma unroll
            for (int ai = 0; ai < 2; ++ai)
#pragma unroll
                for (int m = 0; m < 4; ++m) { bf16* p = O + (size_t)(row0 + ai * 128 + m * 16) * DM + col0 + bj * 128; const f32x4 v0 = acc[ai][bj][m][0] * W8_INV + b0, v1 = acc[ai][bj][m][1] * W8_INV + b1; u32x4 w;
                    w.x = pk2(v0[0], v0[1]); w.y = pk2(v0[2], v0[3]); w.z = pk2(v1[0], v1[1]); w.w = pk2(v1[2], v1[3]); *(u32x4*)p = w; } }
    }
};
DI void tr_item(const float* src, int ld_src, int scol0, int nvalid, int k0, bf16* dst, int ld_dst, int drow0, int dk0, LAS float* scr, int lane) {
    const int n4 = (lane & 7) * 4, kr = lane >> 3; f32x4 v[8];
#pragma unroll
    for (int i = 0; i < 8; ++i) v[i] = (n4 < nvalid) ? *(const f32x4*)(src + (size_t)(k0 + kr + 8 * i) * ld_src + scol0 + n4) : (f32x4){0.f, 0.f, 0.f, 0.f};
#pragma unroll
    for (int i = 0; i < 8; ++i) { LAS float* s = scr + (kr + 8 * i) * 33 + n4; s[0] = v[i][0]; s[1] = v[i][1]; s[2] = v[i][2]; s[3] = v[i][3]; }
    asm volatile("s_waitcnt lgkmcnt(0)" ::: "memory");
    const int c = lane & 7;
#pragma unroll
    for (int jq = 0; jq < 4; ++jq) { const int n = (lane >> 3) + 8 * jq; const LAS float* s = scr + (8 * c) * 33 + n;
        u32x4 o; o.x = pk2(s[0 * 33], s[1 * 33]); o.y = pk2(s[2 * 33], s[3 * 33]); o.z = pk2(s[4 * 33], s[5 * 33]); o.w = pk2(s[6 * 33], s[7 * 33]);
        *(u32x4*)(dst + (size_t)(drow0 + n) * ld_dst + dk0 + k0 + 8 * c) = o; }
    asm volatile("s_waitcnt lgkmcnt(0)" ::: "memory");
}
DI void tr_item8(const float* src, int ld_src, int scol0, int k0, unsigned char* dst, int ld_dst, int drow0, LAS float* scr, int lane, int nvalid = 32) {
    const int n4 = (lane & 7) * 4, kr = lane >> 3; f32x4 v[8];
#pragma unroll
    for (int i = 0; i < 8; ++i) v[i] = (n4 < nvalid) ? *(const f32x4*)(src + (size_t)(k0 + kr + 8 * i) * ld_src + scol0 + n4) : (f32x4){0.f, 0.f, 0.f, 0.f};
#pragma unroll
    for (int i = 0; i < 8; ++i) { LAS float* s = scr + (kr + 8 * i) * 33 + n4; s[0] = v[i][0]; s[1] = v[i][1]; s[2] = v[i][2]; s[3] = v[i][3]; }
    asm volatile("s_waitcnt lgkmcnt(0)" ::: "memory");
    const int c = lane & 7;
#pragma unroll
    for (int jq = 0; jq < 4; ++jq) { const int n = (lane >> 3) + 8 * jq; const LAS float* s = scr + (8 * c) * 33 + n;
        u32x2 o; o.x = pk4_fp8(s[0 * 33] * W8_SCALE, s[1 * 33] * W8_SCALE, s[2 * 33] * W8_SCALE, s[3 * 33] * W8_SCALE); o.y = pk4_fp8(s[4 * 33] * W8_SCALE, s[5 * 33] * W8_SCALE, s[6 * 33] * W8_SCALE, s[7 * 33] * W8_SCALE);
        *(u32x2*)(dst + (size_t)(drow0 + n) * ld_dst + k0 + 8 * c) = o; }
    asm volatile("s_waitcnt lgkmcnt(0)" ::: "memory");
}
DI void conv_item(const Ctx& C, int l, int r, LAS float* scr) {
    constexpr int I_GU = 32 * 16 * 64;
    if (r < I_GU) { const int e = r / 1024, r2 = r % 1024, kb = r2 / 64, nb = r2 % 64, n0 = 32 * nb, j = n0 / 256, i = n0 % 256;
        const int scol0 = (i < 128) ? 128 * j + i : 1024 + 128 * j + (i - 128);
        tr_item8(C.w_gu + (size_t)(l * 32 + e) * 1024 * 2048, 2048, scol0, 64 * kb, WSP(unsigned char, WS_WGU) + (size_t)(l * 32 + e) * 2048 * 1024, 1024, n0, scr, C.lane); }
    else { r -= I_GU; const int e = r / 512, r2 = r % 512, kb = r2 / 32, nb = r2 % 32;
        tr_item8(C.w_down + (size_t)(l * 32 + e) * 1024 * 1024, 1024, 32 * nb, 64 * kb, WSP(unsigned char, WS_WDN) + (size_t)(l * 32 + e) * 1024 * 1024, 1024, 32 * nb, scr, C.lane); }
}
DI void conv_ticket(const Ctx& C0, int l, int tk) {
    Ctx C = C0; asm volatile("" : "+v"(C.lane), "+v"(C.tid));
    LAS float* scr = (LAS float*)(C.lds + C.wave * 16384);
    __syncthreads();
#pragma unroll 1
    for (int i = 0; i < 8; ++i) conv_item(C, l, tk * 64 + C.wave * 8 + i, scr);
}
DI void p0_prologue(const Ctx& C) {
    LAS float* scr = (LAS float*)(C.lds + C.wave * 16384);
    const int gw = C.bid * NWAVE + C.wave, NGW = C.G * NWAVE;
    constexpr int I_IN = 16 * 104, I_OUT = 16 * 32, I_LW = 8, I_LA = 8, I_LG = 16, I_K1 = 256, I_K2 = 8;
    constexpr int I_LAYER = I_IN + I_OUT + I_LW + I_LA + I_LG + 2 * I_K1 + 2 * I_K2;
    for (int it = gw; it < NLAYER * I_LAYER; it += NGW) {
        const int l = it / I_LAYER; int r = it % I_LAYER;
        if (r < I_IN) { const int kb = r / 104, nb = r % 104, n0 = 32 * nb; int nv = 3212 - n0; nv = nv < 0 ? 0 : (nv > 32 ? 32 : nv);
            if (INPROJ_FP8) tr_item8(C.w_in + (size_t)l * 1024 * 3212, 3212, n0, 64 * kb, WSP(unsigned char, WS_WIN) + (size_t)l * NPJ * 1024, 1024, n0, scr, C.lane, nv);
            else tr_item(C.w_in + (size_t)l * 1024 * 3212, 3212, n0, nv, 64 * kb, WSP(bf16, WS_WIN) + (size_t)l * NPJ * 1024, 1024, n0, 0, scr, C.lane); continue; } r -= I_IN;
        if (r < I_OUT) { const int kb = r / 32, nb = r % 32;
            tr_item(C.w_out + (size_t)l * 1024 * 1024, 1024, 32 * nb, 32, 64 * kb, WSP(bf16, WS_WOUT) + (size_t)l * 1024 * 1024, 1024, 32 * nb, 0, scr, C.lane); continue; } r -= I_OUT;
        bf16* lora = WSP(bf16, WS_LORA) + (size_t)l * 768 * 256;
        if (r < I_LW) { tr_item(C.w2 + (size_t)l * 64 * 256, 256, 32 * r, 32, 0, lora, 256, 32 * r, 0, scr, C.lane); continue; } r -= I_LW;
        if (r < I_LA) { tr_item(C.a2 + (size_t)l * 64 * 256, 256, 32 * r, 32, 0, lora, 256, 256 + 32 * r, 64, scr, C.lane); continue; } r -= I_LA;
        if (r < I_LG) { const int kb = r / 8, nb = r % 8; tr_item(C.g2 + (size_t)l * 128 * 256, 256, 32 * nb, 32, 64 * kb, lora, 256, 512 + 32 * nb, 128, scr, C.lane); continue; } r -= I_LG;
        if (r < 2 * I_K1) { const int kv = r / I_K1, r2 = r % I_K1, kb = r2 / 8, nb = r2 % 8;
            tr_item((kv ? C.wv1 : C.wk1) + (size_t)l * 2048 * 256, 256, 32 * nb, 32, 64 * kb, WSP(bf16, WS_WK1) + (size_t)(l * 2 + kv) * 256 * 2048, 2048, 32 * nb, 0, scr, C.lane); continue; } r -= 2 * I_K1;
        { const int kv = r / I_K2, r2 = r % I_K2, kb = r2 / 2, nb = r2 % 2;
            tr_item((kv ? C.wv2 : C.wk2) + (size_t)l * 256 * 64, 64, 32 * nb, 32, 64 * kb, WSP(bf16, WS_WK2) + (size_t)(l * 2 + kv) * 256 * 256, 256, 32 * nb, 0, scr, C.lane); }
    }
    { int* idm = WSP(int, WS_ROUTE) + NT * 12 + NR; for (int i = C.bid * NTHR + C.tid; i < NR; i += C.G * NTHR) idm[i] = i; }
    __syncthreads();
    float* MOD = WSP(float, WS_SMALL); float* PEB = MOD + NLAYER * 8 * 6144;
    LAS float* sc = (LAS float*)C.lds;
    LAS float* red = sc + 8192;
    for (int it = C.bid; it < 192 + 32; it += C.G) {
        if (it < 192) {
            const int l = it / 96, n0 = (it % 96) * 64;
            for (int i = C.tid; i < 8192; i += NTHR) { const float v = C.c[i]; sc[i] = v * fsigmoid(v); }
            __syncthreads();
            const int kq = C.tid >> 6, col = C.tid & 63; float a[8];
#pragma unroll
            for (int b = 0; b < 8; ++b) a[b] = 0.f;
            const float* wp = C.w_ada + (size_t)l * 1024 * 6144 + n0 + col;
#pragma unroll 32
            for (int k = kq * 128; k < kq * 128 + 128; ++k) { const float w = wp[(size_t)k * 6144];
#pragma unroll
                for (int b = 0; b < 8; ++b) a[b] += sc[b * 1024 + k] * w; }
#pragma unroll
            for (int b = 0; b < 8; ++b) red[(kq * 8 + b) * 64 + col] = a[b];
            __syncthreads();
            { const int b = C.tid >> 6; float s = C.b_ada[(size_t)l * 6144 + n0 + col];
#pragma unroll
              for (int q = 0; q < 8; ++q) s += red[(q * 8 + b) * 64 + col];
              MOD[((size_t)l * 8 + b) * 6144 + n0 + col] = s; }
            __syncthreads();
        } else {
            const int r = it - 192, l = r >> 4, kv = (r >> 3) & 1, c0 = (r & 7) * 32; const float* pe = (kv ? C.pe_v : C.pe_k) + (size_t)l * 2048; const float* w1 = (kv ? C.wv1 : C.wk1) + (size_t)l * 2048 * 256;
            const int kq = C.tid >> 5, col = C.tid & 31; float a = 0.f;
#pragma unroll 16
            for (int k = kq * 128; k < kq * 128 + 128; ++k) a += pe[k] * w1[(size_t)k * 256 + c0 + col];
            red[kq * 32 + col] = a; __syncthreads();
            if (C.tid < 32) { float s = 0.f;
#pragma unroll
                for (int q = 0; q < 16; ++q) s += red[q * 32 + C.tid];
                PEB[(l * 2 + kv) * 256 + c0 + C.tid] = s; }
            __syncthreads();
        }
    }
}

DI void norm_row(const Ctx& C, const float* xrow, const float* g, const float* sh, const float* sc, bf16* orow) {
    f32x4 v[4]; float s = 0.f;
#pragma unroll
    for (int j = 0; j < 4; ++j) { v[j] = *(const f32x4*)(xrow + 4 * C.lane + 256 * j); s += (v[j][0] * v[j][0] + v[j][1] * v[j][1]) + (v[j][2] * v[j][2] + v[j][3] * v[j][3]); }
    s = group_sum<64>(s); const float rstd = rsqrtf(s * (1.f / DM) + 1e-6f);
#pragma unroll
    for (int j = 0; j < 4; ++j) { const int k = 4 * C.lane + 256 * j; const f32x4 gg = *(const f32x4*)(g + k), a = *(const f32x4*)(sc + k), b = *(const f32x4*)(sh + k); f32x4 h;
#pragma unroll
        for (int i = 0; i < 4; ++i) h[i] = v[j][i] * rstd * gg[i] * (1.f + a[i]) + b[i];
        if (INPROJ_FP8) *(unsigned*)((unsigned char*)orow + k) = pk4_fp8(h[0], h[1], h[2], h[3]);
        else { u32x2 o; o.x = pk2(h[0], h[1]); o.y = pk2(h[2], h[3]); *(u32x2*)(orow + k) = o; } }
}
DI void norm1_phase(const Ctx& C, int l, const float* xin) {
    const float* MOD = WSP(float, WS_SMALL) + (size_t)l * 8 * 6144; bf16* H = WSP(bf16, WS_H);
    const int gw = C.bid * NWAVE + C.wave, NGW = C.G * NWAVE;
    for (int m = gw; m < NT; m += NGW) { const int b = m / NS; norm_row(C, xin + (size_t)m * DM, C.norm1_g + l * DM, MOD + b * 6144, MOD + b * 6144 + 1024, INPROJ_FP8 ? (bf16*)((unsigned char*)H + (size_t)m * DM) : H + (size_t)m * DM); }
}

constexpr float QSCALE = 0.125f * 1.44269504089f;
DI void prep_phase(const Ctx& C, int l) {
    const bf16* PROJ = WSP(bf16, R_PROJ); bf16* SCH = WSP(bf16, R_SCH); bf16* LIN = WSP(bf16, R_LIN); bf16* YCAT = WSP(bf16, R_YCAT);
    bf16 *QC = WSP(bf16, R_QC), *KC = WSP(bf16, R_KC), *QN = WSP(bf16, R_QN), *QR = WSP(bf16, R_QR), *KCR = WSP(bf16, R_KCR), *VCR = WSP(bf16, R_VCR), *KS = WSP(bf16, R_KS), *KW = WSP(bf16, R_KW);
    float* GATE = WSP(float, R_GATE);
    const int lane = C.lane, gw = C.bid * NWAVE + C.wave, NGW = C.G * NWAVE;
    const int hh = lane >> 4, jj = lane & 15;
    const float inv0 = exp2f(-(float)(2 * jj) * (13.287712379549449f / 32.f)) * 0.15915494309189535f, inv1 = exp2f(-(float)(2 * jj + 1) * (13.287712379549449f / 32.f)) * 0.15915494309189535f;
    for (int task = gw; task < NT / 16; task += NGW) {
        const int row0 = 16 * task, s0 = row0 % NS;
        {
            const int c0 = 16 * lane, cc = (c0 - 256) & 255; float mu16[16], kw16[16];
#pragma unroll
            for (int q = 0; q < 4; ++q) { const f32x4 m4 = *(const f32x4*)(C.mu + (size_t)l * 1024 + c0 + 4 * q), k4 = *(const f32x4*)(C.kkw + (size_t)l * 256 + cc + 4 * q);
#pragma unroll
                for (int i = 0; i < 4; ++i) { mu16[4 * q + i] = m4[i]; kw16[4 * q + i] = k4[i]; } }
#pragma unroll 2
            for (int r = 0; r < 16; ++r) {
                const int row = row0 + r; const bf16* pr = PROJ + (size_t)row * NPJ; float z[16];
                const u32x4 c0v = *(const u32x4*)(pr + c0), c1v = *(const u32x4*)(pr + c0 + 8);
                u32x4 p0v = (u32x4){0u, 0u, 0u, 0u}, p1v = p0v;
                if (s0 + r > 0) { p0v = *(const u32x4*)(pr - NPJ + c0); p1v = *(const u32x4*)(pr - NPJ + c0 + 8); }
                const unsigned cw[8] = {c0v.x, c0v.y, c0v.z, c0v.w, c1v.x, c1v.y, c1v.z, c1v.w}, pw[8] = {p0v.x, p0v.y, p0v.z, p0v.w, p1v.x, p1v.y, p1v.z, p1v.w};
#pragma unroll
                for (int e = 0; e < 16; ++e) { const float cu = (e & 1) ? bfhi(cw[e >> 1]) : bflo(cw[e >> 1]), pv = (e & 1) ? bfhi(pw[e >> 1]) : bflo(pw[e >> 1]); z[e] = cu + (pv - cu) * mu16[e]; }
                float kk[16]; float ss = 0.f;
#pragma unroll
                for (int e = 0; e < 16; ++e) { kk[e] = z[e] * kw16[e]; ss += kk[e] * kk[e]; }
                ss = group_sum<4>(ss); const float kinv = rsqrtf(ss + 1e-12f);
                if (lane < 48) {
                    const int pl = lane < 16 ? 3 : (lane < 32 ? 0 : 4); bf16* dst = SCH + ((size_t)pl * NT + row) * 256 + (c0 & 255);
                    u32x4 o0, o1; o0.x = pk2(z[0], z[1]); o0.y = pk2(z[2], z[3]); o0.z = pk2(z[4], z[5]); o0.w = pk2(z[6], z[7]); o1.x = pk2(z[8], z[9]); o1.y = pk2(z[10], z[11]); o1.z = pk2(z[12], z[13]); o1.w = pk2(z[14], z[15]);
                    *(u32x4*)dst = o0; *(u32x4*)(dst + 8) = o1;
                    if (lane >= 16 && lane < 32) { bf16* d2 = SCH + ((size_t)1 * NT + row) * 256 + cc;
                        u32x4 q0, q1; q0.x = pk2(kk[0] * kinv, kk[1] * kinv); q0.y = pk2(kk[2] * kinv, kk[3] * kinv); q0.z = pk2(kk[4] * kinv, kk[5] * kinv); q0.w = pk2(kk[6] * kinv, kk[7] * kinv);
                        q1.x = pk2(kk[8] * kinv, kk[9] * kinv); q1.y = pk2(kk[10] * kinv, kk[11] * kinv); q1.z = pk2(kk[12] * kinv, kk[13] * kinv); q1.w = pk2(kk[14] * kinv, kk[15] * kinv);
                        *(u32x4*)d2 = q0; *(u32x4*)(d2 + 8) = q1; }
                } else {
                    float t[16];
#pragma unroll
                    for (int i = 0; i < 16; ++i) { const float sg = fsigmoid(lane < 52 ? 2.f * z[i] : z[i]); t[i] = lane < 52 ? 2.f * sg - 1.f : (lane < 56 ? z[i] : sg); }
                    bf16* dst = LIN + (size_t)row * 256 + (c0 - 768);
                    u32x4 o0, o1; o0.x = pk2(t[0], t[1]); o0.y = pk2(t[2], t[3]); o0.z = pk2(t[4], t[5]); o0.w = pk2(t[6], t[7]); o1.x = pk2(t[8], t[9]); o1.y = pk2(t[10], t[11]); o1.z = pk2(t[12], t[13]); o1.w = pk2(t[14], t[15]);
                    *(u32x4*)dst = o0; *(u32x4*)(dst + 8) = o1;
                }
            }
        }
        {
            const int ch = 4 * lane; const float* cw = C.conv_w + (size_t)l * 3 * 256 + ch; const f32x4 w0 = *(const f32x4*)cw, w1 = *(const f32x4*)(cw + 256), w2 = *(const f32x4*)(cw + 512);
            const f32x4 og = *(const f32x4*)(C.onorm_g + (size_t)l * 768 + ch);
#pragma unroll 2
            for (int r = 0; r < 16; ++r) {
                const int row = row0 + r, s = s0 + r; const bf16* pr = PROJ + (size_t)row * NPJ; float u[3][4];
#pragma unroll
                for (int d = 0; d < 3; ++d) {
                    u32x2 cg = (u32x2){0u, 0u}, xi = cg;
                    if (s >= d) { cg = *(const u32x2*)(pr - (size_t)d * NPJ + PJ_B + 256 + ch); xi = *(const u32x2*)(pr - (size_t)d * NPJ + PJ_B + 512 + ch); }
                    u[d][0] = bflo(cg.x) * bflo(xi.x); u[d][1] = bfhi(cg.x) * bfhi(xi.x); u[d][2] = bflo(cg.y) * bflo(xi.y); u[d][3] = bfhi(cg.y) * bfhi(xi.y);
                }
                const u32x2 bgv = *(const u32x2*)(pr + PJ_B + ch); const float bg[4] = {bflo(bgv.x), bfhi(bgv.x), bflo(bgv.y), bfhi(bgv.y)};
                float y[4]; float ss = 0.f;
#pragma unroll
                for (int i = 0; i < 4; ++i) { y[i] = bg[i] * (w0[i] * u[2][i] + w1[i] * u[1][i] + w2[i] * u[0][i]); ss += y[i] * y[i]; }
                ss = group_sum<16>(ss); const float rstd = rsqrtf(ss * (1.f / 64.f) + 1e-6f);
                u32x2 o; o.x = pk2(y[0] * rstd * og[0], y[1] * rstd * og[1]); o.y = pk2(y[2] * rstd * og[2], y[3] * rstd * og[3]);
                *(u32x2*)(YCAT + (size_t)row * DM + 256 + ch) = o;
            }
        }
        {
            const float* gq = C.dil_q_g + (size_t)l * 64; const float* gk = C.dil_k_g + (size_t)l * 64; const float* gn = C.nsa_q_g + (size_t)l * 64; const float* gv = (hh == 0 ? C.nsa_ks_g : C.nsa_kw_g) + (size_t)l * 64;
            float Gq[4], Gk[4], Gn[4], Gv[4];
#pragma unroll
            for (int i = 0; i < 4; ++i) { const int d = (i >> 1) * 32 + 2 * jj + (i & 1); Gq[i] = gq[d] * QSCALE; Gk[i] = gk[d]; Gn[i] = gn[d] * QSCALE; Gv[i] = gv[d]; }
            const int vcol = hh == 0 ? 2944 : (hh == 1 ? 3072 : (hh == 2 ? 2816 : 2880));
            bf16* vdst = (hh == 0 ? KS : (hh == 1 ? KW : (hh == 2 ? KCR : VCR)));
#pragma unroll 2
            for (int r = 0; r < 16; ++r) {
                const int row = row0 + r; const bf16* pr = PROJ + (size_t)row * NPJ;
                const float posf = (float)C.pos[row];
                const float x0 = __builtin_amdgcn_fractf(posf * inv0), x1 = __builtin_amdgcn_fractf(posf * inv1);
                const float sn0 = __builtin_amdgcn_sinf(x0), cs0 = __builtin_amdgcn_cosf(x0), sn1 = __builtin_amdgcn_sinf(x1), cs1 = __builtin_amdgcn_cosf(x1);
                const unsigned qa = *(const unsigned*)(pr + PJ_C + hh * 64 + 2 * jj), qb = *(const unsigned*)(pr + PJ_C + hh * 64 + 32 + 2 * jj);
                const unsigned ka = *(const unsigned*)(pr + PJ_C + 256 + hh * 64 + 2 * jj), kb = *(const unsigned*)(pr + PJ_C + 256 + hh * 64 + 32 + 2 * jj);
                const unsigned na = *(const unsigned*)(pr + PJ_D + hh * 64 + 2 * jj), nb = *(const unsigned*)(pr + PJ_D + hh * 64 + 32 + 2 * jj);
                const unsigned va = *(const unsigned*)(pr + vcol + 2 * jj), vb = *(const unsigned*)(pr + vcol + 32 + 2 * jj);
                float gate_in = 0.f; if (lane < 12) gate_in = bf2f(pr[3200 + lane]);
#define ROPE_NORM(a, b, G, o1, o2, n1a, n1b, n2a, n2b) \
                float n1a = bflo(a), n1b = bfhi(a), n2a = bflo(b), n2b = bfhi(b); { const float ss_ = group_sum<16>(n1a * n1a + n1b * n1b + n2a * n2a + n2b * n2b); const float rs_ = rsqrtf(ss_ * (1.f / 64.f) + 1e-6f); \
                    n1a *= rs_ * G[0]; n1b *= rs_ * G[1]; n2a *= rs_ * G[2]; n2b *= rs_ * G[3]; } \
                const unsigned o1 = pk2(n1a * cs0 - n2a * sn0, n1b * cs1 - n2b * sn1), o2 = pk2(n2a * cs0 + n1a * sn0, n2b * cs1 + n1b * sn1);
                ROPE_NORM(qa, qb, Gq, q1, q2, q1a, q1b, q2a, q2b)
                ROPE_NORM(ka, kb, Gk, k1, k2, k1a, k1b, k2a, k2b)
                ROPE_NORM(na, nb, Gn, r1, r2, r1a, r1b, r2a, r2b)
                ROPE_NORM(va, vb, Gv, v1, v2, v1a, v1b, v2a, v2b)
#undef ROPE_NORM
                bf16* o = QC + (size_t)row * 256 + hh * 64 + 2 * jj; *(unsigned*)o = q1; *(unsigned*)(o + 32) = q2;
                o = KC + (size_t)row * 256 + hh * 64 + 2 * jj; *(unsigned*)o = k1; *(unsigned*)(o + 32) = k2;
                o = QN + (size_t)row * 256 + hh * 64 + 2 * jj; *(unsigned*)o = pk2(r1a, r1b); *(unsigned*)(o + 32) = pk2(r2a, r2b);
                o = QR + (size_t)row * 256 + hh * 64 + 2 * jj; *(unsigned*)o = r1; *(unsigned*)(o + 32) = r2;
                o = vdst + (size_t)row * 64 + 2 * jj; *(unsigned*)o = (hh >= 2) ? va : v1; *(unsigned*)(o + 32) = (hh >= 2) ? vb : v2;
                if (lane < 12) GATE[(size_t)row * 12 + lane] = fsigmoid(gate_in);
            }
        }
    }
}
constexpr int SCAN_TC = 16;
DI void scan_unit8(const Ctx& C, int u) {
    const float* Wp = WSP(float, R_SC); const bf16* SCH = WSP(bf16, R_SCH); float* YA = WSP(float, R_YA); float* UB = WSP(float, R_SCANU); float* SMT = WSP(float, R_SCANS);
    const int pair = u / 3, kind = u % 3, b = pair >> 2, h = pair & 3, tid = C.tid;
    LAS float* buf = (LAS float*)C.lds;
    LAS float* ybuf = buf + 2 * 6144;
    const int row = tid >> 3, cg = tid & 7, tbase = kind == 0 ? 0 : NS / 2;
    const float vm = kind == 2 ? 0.f : 1.f;
    u32x4 ldA[2], ldB[2];
#define SCAN_LOAD(ld, chunk) do { _Pragma("unroll") for (int i = 0; i < 2; ++i) { const int p_ = tid + 512 * i; if (p_ < 896) { const int step = p_ / 56, r_ = p_ % 56; const size_t row_ = (size_t)b * NS + tbase + (chunk) * SCAN_TC + step; \
        if (r_ < 16) ld[i] = *(const u32x4*)(Wp + row_ * 256 + h * 64 + r_ * 4); else { const int v5 = (r_ - 16) >> 3, c_ = (r_ - 16) & 7; ld[i] = *(const u32x4*)(SCH + ((size_t)v5 * NT + row_) * 256 + h * 64 + c_ * 8); } } } } while (0)
#define SCAN_STORE(ld, slot) do { _Pragma("unroll") for (int i = 0; i < 2; ++i) { const int p_ = tid + 512 * i; if (p_ < 896) { const int step = p_ / 56, r_ = p_ % 56; LAS float* d_ = buf + (slot) * 6144 + step * 384; \
        if (r_ < 16) *(LAS u32x4*)(d_ + r_ * 4) = ld[i]; else { const int v5 = (r_ - 16) >> 3, c_ = (r_ - 16) & 7; LAS float* e_ = d_ + (1 + v5) * 64 + c_ * 8; const u32x4 x_ = ld[i]; \
            *(LAS f32x4*)e_ = (f32x4){bflo(x_.x), bfhi(x_.x), bflo(x_.y), bfhi(x_.y)}; *(LAS f32x4*)(e_ + 4) = (f32x4){bflo(x_.z), bfhi(x_.z), bflo(x_.w), bfhi(x_.w)}; } } } } while (0)
#define SCAN_FLUSH(chunk) do { _Pragma("unroll") for (int i = 0; i < 2; ++i) { const int i2 = tid + 512 * i, step = i2 >> 6, rr = i2 & 63; const LAS float* pp_ = ybuf + ((chunk) & 1) * 8192 + step * 512 + rr * 8; \
        const f32x4 pa_ = *(const LAS f32x4*)pp_, pb_ = *(const LAS f32x4*)(pp_ + 4); const float yv = ((pa_[0] + pa_[1]) + (pa_[2] + pa_[3])) + ((pb_[0] + pb_[1]) + (pb_[2] + pb_[3])); \
        if (kind == 2) UB[((size_t)b * (NS / 2) + (chunk) * SCAN_TC + step) * 256 + h * 64 + rr] = yv; else YA[((size_t)b * NS + tbase + (chunk) * SCAN_TC + step) * 256 + h * 64 + rr] = yv; } } while (0)
    __syncthreads();
    SCAN_LOAD(ldA, 0); SCAN_STORE(ldA, 0); SCAN_LOAD(ldB, 1); SCAN_LOAD(ldA, 2);
    f32x2 S[4];
#pragma unroll
    for (int c = 0; c < 4; ++c) { S[c][0] = (kind == 2 && row == 8 * cg + 2 * c) ? 1.f : 0.f; S[c][1] = (kind == 2 && row == 8 * cg + 2 * c + 1) ? 1.f : 0.f; }
    constexpr int NCH = (NS / 2) / SCAN_TC;
#pragma unroll 2
    for (int ck = 0; ck < NCH; ++ck) {
        __syncthreads();
        if (ck & 1) { if (ck + 1 < NCH) SCAN_STORE(ldA, (ck + 1) & 1); if (ck + 3 < NCH) SCAN_LOAD(ldA, ck + 3); }
        else        { if (ck + 1 < NCH) SCAN_STORE(ldB, (ck + 1) & 1); if (ck + 3 < NCH) SCAN_LOAD(ldB, ck + 3); }
        {
            const LAS float* bp = buf + (ck & 1) * 6144; LAS float* yb = ybuf + (ck & 1) * 8192 + tid;
#define SCAN_LDS(X, step) do { const LAS float* sp = bp + (step) * 384 + 8 * cg; X.w0 = *(const LAS f32x4*)(sp); X.w1 = *(const LAS f32x4*)(sp + 4); X.k0 = *(const LAS f32x4*)(sp + 64); X.k1 = *(const LAS f32x4*)(sp + 68); \
                X.q0 = *(const LAS f32x4*)(sp + 128); X.q1 = *(const LAS f32x4*)(sp + 132); X.b0 = *(const LAS f32x4*)(sp + 192); X.b1 = *(const LAS f32x4*)(sp + 196); \
                X.r0 = *(const LAS f32x4*)(sp + 256); X.r1 = *(const LAS f32x4*)(sp + 260); X.v = bp[(step) * 384 + 320 + row] * vm; } while (0)
#define SCAN_STEP(X, step) do { \
                f32x2 d2 = S[0] * (f32x2){X.q0[0], X.q0[1]}; d2 = S[1] * (f32x2){X.q0[2], X.q0[3]} + d2; d2 = S[2] * (f32x2){X.q1[0], X.q1[1]} + d2; d2 = S[3] * (f32x2){X.q1[2], X.q1[3]} + d2; \
                const float sa = -sum8(d2[0] + d2[1]); const f32x2 sa2 = (f32x2){sa, sa}, v2 = (f32x2){X.v, X.v}; \
                S[0] = S[0] * (f32x2){X.w0[0], X.w0[1]} + (sa2 * (f32x2){X.b0[0], X.b0[1]} + v2 * (f32x2){X.k0[0], X.k0[1]}); \
                S[1] = S[1] * (f32x2){X.w0[2], X.w0[3]} + (sa2 * (f32x2){X.b0[2], X.b0[3]} + v2 * (f32x2){X.k0[2], X.k0[3]}); \
                S[2] = S[2] * (f32x2){X.w1[0], X.w1[1]} + (sa2 * (f32x2){X.b1[0], X.b1[1]} + v2 * (f32x2){X.k1[0], X.k1[1]}); \
                S[3] = S[3] * (f32x2){X.w1[2], X.w1[3]} + (sa2 * (f32x2){X.b1[2], X.b1[3]} + v2 * (f32x2){X.k1[2], X.k1[3]}); \
                f32x2 y2 = S[0] * (f32x2){X.r0[0], X.r0[1]}; y2 = S[1] * (f32x2){X.r0[2], X.r0[3]} + y2; y2 = S[2] * (f32x2){X.r1[0], X.r1[1]} + y2; y2 = S[3] * (f32x2){X.r1[2], X.r1[3]} + y2; \
                yb[(step) * 512] = y2[0] + y2[1]; } while (0)
            struct StepIn { f32x4 w0, w1, k0, k1, q0, q1, b0, b1, r0, r1; float v; } A, B;
            SCAN_LDS(A, 0);
#pragma unroll 2
            for (int step = 0; step < SCAN_TC; step += 2) {
                SCAN_LDS(B, step + 1);
                __builtin_amdgcn_sched_barrier(0);
                SCAN_STEP(A, step);
                __builtin_amdgcn_sched_barrier(0);
                if (step + 2 < SCAN_TC) SCAN_LDS(A, step + 2);
                __builtin_amdgcn_sched_barrier(0);
                SCAN_STEP(B, step + 1);
                __builtin_amdgcn_sched_barrier(0);
            }
#undef SCAN_LDS
#undef SCAN_STEP
        }
        if (ck > 0) SCAN_FLUSH(ck - 1);
    }
    __syncthreads();
    SCAN_FLUSH(NCH - 1);
    if (kind == 0) {
        float* o = SMT + (size_t)pair * 4096 + row;
#pragma unroll
        for (int c = 0; c < 4; ++c) { o[(8 * cg + 2 * c) * 64] = S[c][0]; o[(8 * cg + 2 * c + 1) * 64] = S[c][1]; }
    }
#undef SCAN_LOAD
#undef SCAN_STORE
#undef SCAN_FLUSH
    __syncthreads();
}

constexpr int KROW = 144, KT_BYTES = 64 * KROW;
#define MFMA16(a, b, c) __builtin_amdgcn_mfma_f32_16x16x32_bf16((a), (b), (c), 0, 0, 0)
template <int NQT> struct FA { f32x4 O[NQT][4]; float l[NQT]; float negM; };
template <int NQT> DI void fa_init(FA<NQT>& st) {
#pragma unroll
    for (int q = 0; q < NQT; ++q) { st.l[q] = 0.f;
#pragma unroll
        for (int d = 0; d < 4; ++d) st.O[q][d] = (f32x4){0.f, 0.f, 0.f, 0.f}; }
}
DI bf16x8 pack8(const f32x4& a, const f32x4& b) { u32x4 w; w.x = pk2(a[0], a[1]); w.y = pk2(a[2], a[3]); w.z = pk2(b[0], b[1]); w.w = pk2(b[2], b[3]); return __builtin_bit_cast(bf16x8, w); }
struct VFrag { u32x2 a[4], b[4]; };
DI void vt_issue(VFrag& f, unsigned vaddr) {
    asm volatile("ds_read_b64_tr_b16 %0, %8\n\tds_read_b64_tr_b16 %1, %8 offset:2304\n\tds_read_b64_tr_b16 %2, %8 offset:32\n\tds_read_b64_tr_b16 %3, %8 offset:2336\n\t"
                 "ds_read_b64_tr_b16 %4, %8 offset:64\n\tds_read_b64_tr_b16 %5, %8 offset:2368\n\tds_read_b64_tr_b16 %6, %8 offset:96\n\tds_read_b64_tr_b16 %7, %8 offset:2400"
                 : "=&v"(f.a[0]), "=&v"(f.b[0]), "=&v"(f.a[1]), "=&v"(f.b[1]), "=&v"(f.a[2]), "=&v"(f.b[2]), "=&v"(f.a[3]), "=&v"(f.b[3]) : "v"(vaddr) : "memory");
}
DI void vt_wait(VFrag& f) { asm volatile("s_waitcnt lgkmcnt(0)" : "+v"(f.a[0]), "+v"(f.b[0]), "+v"(f.a[1]), "+v"(f.b[1]), "+v"(f.a[2]), "+v"(f.b[2]), "+v"(f.a[3]), "+v"(f.b[3]) :: "memory"); }
DI bf16x8 vt_get(const VFrag& f, int d) { return __builtin_bit_cast(bf16x8, ((u32x4){f.a[d].x, f.a[d].y, f.b[d].x, f.b[d].y})); }
template <int NQT, bool MASKED, class MaskF>
DI void fa_tile(FA<NQT>& st, const bf16x8 (&Q)[NQT][2], const LAS uchar* Ks, const LAS uchar* Vs, int lane, const MaskF& allowed, const bool (&act)[NQT]) {
    const int l15 = lane & 15, quad = lane >> 4;
    float nm_ = st.negM; asm volatile("" : "+v"(nm_));
    f32x4 S[NQT][4]; const f32x4 sinit = (f32x4){nm_, nm_, nm_, nm_};
#pragma unroll
    for (int kt = 0; kt < 4; ++kt) {
        const bf16x8 k0 = *(const LAS bf16x8*)(Ks + (16 * kt + l15) * KROW + quad * 16), k1 = *(const LAS bf16x8*)(Ks + (16 * kt + l15) * KROW + 64 + quad * 16);
#pragma unroll
        for (int q = 0; q < NQT; ++q) if (act[q]) { S[q][kt] = MFMA16(k0, Q[q][0], sinit); S[q][kt] = MFMA16(k1, Q[q][1], S[q][kt]); }
    }
    const unsigned vaddr = (unsigned)(size_t)(Vs + (4 * quad + (l15 >> 2)) * KROW + 8 * (l15 & 3));
    VFrag v0, v1; vt_issue(v0, vaddr);
#pragma unroll
    for (int q = 0; q < NQT; ++q) if (act[q]) {
        float rs = 0.f;
#pragma unroll
        for (int kt = 0; kt < 4; ++kt)
#pragma unroll
            for (int j = 0; j < 4; ++j) { float p = fexp2(S[q][kt][j]); if (MASKED) p = allowed(q, 16 * kt + 4 * quad + j) ? p : 0.f; S[q][kt][j] = p; rs += p; }
        st.l[q] += rs;
    }
    vt_wait(v0); vt_issue(v1, vaddr + 32 * KROW);
#pragma unroll
    for (int q = 0; q < NQT; ++q) if (act[q]) {
        const bf16x8 p0 = pack8(S[q][0], S[q][1]);
#pragma unroll
        for (int d = 0; d < 4; ++d) st.O[q][d] = MFMA16(vt_get(v0, d), p0, st.O[q][d]);
    }
    vt_wait(v1);
#pragma unroll
    for (int q = 0; q < NQT; ++q) if (act[q]) {
        const bf16x8 p1 = pack8(S[q][2], S[q][3]);
#pragma unroll
        for (int d = 0; d < 4; ++d) st.O[q][d] = MFMA16(vt_get(v1, d), p1, st.O[q][d]);
    }
}
template <int NQT> DI void fa_finish(FA<NQT>& st, float (&lse2)[NQT]) {
#pragma unroll
    for (int q = 0; q < NQT; ++q) { float l = st.l[q]; l += __shfl_xor(l, 16); l += __shfl_xor(l, 32); const float inv = l > 0.f ? 1.f / l : 0.f; lse2[q] = __log2f(fmaxf(l, 1e-37f));
#pragma unroll
        for (int d = 0; d < 4; ++d) st.O[q][d] = st.O[q][d] * inv; }
}
DI float score_bound(const float* gq, const float* gk, int lane) {
    float a = fabsf(gq[lane & 63]), b = fabsf(gk[lane & 63]);
#pragma unroll
    for (int o = 1; o < 64; o <<= 1) { a = fmaxf(a, __shfl_xor(a, o)); b = fmaxf(b, __shfl_xor(b, o)); }
    return __builtin_bit_cast(float, __builtin_amdgcn_readfirstlane(__builtin_bit_cast(int, 64.f * a * b * QSCALE * 1.02f + 0.5f)));
}
DI void kv_store(LAS uchar* Ks, LAS uchar* Vs, int tid, const u32x4& kr, const u32x4& vr) {
    const int o = (tid >> 3) * KROW + (tid & 7) * 16; *(LAS u32x4*)(Ks + o) = kr; *(LAS u32x4*)(Vs + o) = vr;
}
DI void q_load(bf16x8 (&Q)[2], const bf16* qrow, int quad) { Q[0] = *(const bf16x8*)(qrow + 8 * quad); Q[1] = *(const bf16x8*)(qrow + 32 + 8 * quad); }

struct DilMask { int qi[2]; int k0; DI bool operator()(int q, int key) const { const int ki = k0 + key, d = qi[q] - ki; return ki >= 0 && (unsigned)d <= 128u; } };
DI void dil_unit(const Ctx& C, int unit, LAS uchar* lds0, LAS uchar*  , float negM_bound) {
    const bf16 *QC = WSP(bf16, R_QC), *KC = WSP(bf16, R_KC), *PROJ = WSP(bf16, R_PROJ); float* OC = WSP(float, R_OC); float* LSE = WSP(float, R_LSE);
    int tid = C.tid, lane = C.lane; asm volatile("" : "+v"(tid), "+v"(lane));
    const int w = C.wave, l15 = lane & 15, quad = lane >> 4, wq = w & 3;
    const int cfg = unit / 512, r = unit % 512, dsh = 2 * cfg, d = 1 << dsh;
    const int b = r >> 6, hp = (r >> 5) & 1, r2 = r & 31;
    const int nblk = 32 >> dsh, res = r2 / nblk, blk = r2 % nblk, i0 = blk * 128, h = 2 * hp + (w >> 2);
    const size_t tb = (size_t)b * NS;
    bf16x8 Q[2][2]; DilMask mk; FA<2> st; fa_init(st); st.negM = -negM_bound;
#pragma unroll
    for (int q = 0; q < 2; ++q) { mk.qi[q] = i0 + 32 * wq + 16 * q + l15; q_load(Q[q], QC + (tb + res + (size_t)d * mk.qi[q]) * 256 + h * 64, quad); }
    const int jlo = wq >> 1, jhi = (wq >> 1) + 2;
    const bool act[2] = {true, true};
    u32x4 kr0, vr0, kr1, vr1;
#define DIL_LOAD(j) do { const int ki = i0 - 128 + 64 * (j) + (tid >> 3); kr0 = (u32x4){0u, 0u, 0u, 0u}; vr0 = kr0; kr1 = kr0; vr1 = kr0; \
    if (ki >= 0) { const size_t rowk = tb + res + (size_t)d * ki; const bf16* kp = KC + rowk * 256 + 128 * hp + (tid & 7) * 8; const bf16* vp = PROJ + rowk * NPJ + PJ_C + 512 + 128 * hp + (tid & 7) * 8; \
        kr0 = *(const u32x4*)kp; kr1 = *(const u32x4*)(kp + 64); vr0 = *(const u32x4*)vp; vr1 = *(const u32x4*)(vp + 64); } } while (0)
#define DIL_STORE(p) do { LAS uchar* b_ = lds0 + (p) * 4 * KT_BYTES; kv_store(b_, b_ + KT_BYTES, tid, kr0, vr0); kv_store(b_ + 2 * KT_BYTES, b_ + 3 * KT_BYTES, tid, kr1, vr1); } while (0)
    DIL_LOAD(0); __syncthreads(); DIL_STORE(0); DIL_LOAD(1);
    for (int j = 0; j < 4; ++j) {
        __syncthreads();
        if (j + 1 < 4) DIL_STORE((j + 1) & 1);
        if (j + 2 < 4) DIL_LOAD(j + 2);
        if (j >= jlo && j <= jhi) { mk.k0 = i0 - 128 + 64 * j; const LAS uchar* kb = lds0 + (j & 1) * 4 * KT_BYTES + (w >> 2) * 2 * KT_BYTES; fa_tile<2, true>(st, Q, kb, kb + KT_BYTES, lane, mk, act); }
    }
#undef DIL_LOAD
#undef DIL_STORE
    float lse2[2]; fa_finish<2>(st, lse2);
#pragma unroll
    for (int q = 0; q < 2; ++q) { const size_t rowq = tb + res + (size_t)d * mk.qi[q]; float* o = OC + ((size_t)cfg * NT + rowq) * 256 + h * 64 + 4 * quad;
#pragma unroll
        for (int dt = 0; dt < 4; ++dt) *(f32x4*)(o + 16 * dt) = st.O[q][dt];
        if (quad == 0) LSE[((size_t)cfg * NT + rowq) * 4 + h] = lse2[q]; }
}
constexpr int NSA_KC = 0, NSA_VC = 256 * KROW, NSA_KT = 2 * 256 * KROW, NSA_VT = NSA_KT + KT_BYTES, NSA_IMP = NSA_KT + 4 * KT_BYTES,
    NSA_SELM = NSA_IMP + 64 * 64 * 4, NSA_UW = NSA_SELM + 512;
static_assert(NSA_UW + 16 <= RING_BYTES, "NSA LDS map");
DI void cmp_mlp_wait(const Ctx& C, int l);
struct SwaMask { int t[2]; int k0; DI bool operator()(int q, int key) const { const int d = t[q] - (k0 + key); return (unsigned)d <= 511u; } };
struct SlcMask { int t[2]; int k0; bool sel[2]; DI bool operator()(int q, int key) const { return sel[q] && (k0 + key <= t[q]); } };
struct NoMask { DI bool operator()(int, int) const { return true; } };
DI void nsa_unit(const Ctx& C, int l, int b, int tbk, int& bl, bool& cmp_ready, float bnd_cmp, float bnd_slc, float bnd_swa) {
    const bf16 *QN = WSP(bf16, R_QN), *QR = WSP(bf16, R_QR), *KSb = WSP(bf16, R_KS), *KWb = WSP(bf16, R_KW), *PROJ = WSP(bf16, R_PROJ); const float* CMP = WSP(float, R_CMP); const float* GATE = WSP(float, R_GATE);
    bf16* YCAT = WSP(bf16, R_YCAT);
    LAS uchar* Kc = C.lds + NSA_KC; LAS uchar* Vc = C.lds + NSA_VC; LAS uchar* Ks = C.lds + NSA_KT; LAS uchar* Vs = C.lds + NSA_VT;
    LAS float* imps = (LAS float*)(C.lds + NSA_IMP); LAS unsigned* selm = (LAS unsigned*)(C.lds + NSA_SELM); LAS unsigned* uw = (LAS unsigned*)(C.lds + NSA_UW);
    int tid = C.tid, lane = C.lane; asm volatile("" : "+v"(tid), "+v"(lane));
    const int w = C.wave, l15 = lane & 15, quad = lane >> 4, head = l15 & 3, t0 = 64 * tbk; const size_t tb = (size_t)b * NS;
    __syncthreads();
    if (b != bl) {
        if (!cmp_ready) { cmp_mlp_wait(C, l); cmp_ready = true; }
        const int key = tid >> 1, hf = tid & 1; const float* kp = CMP + ((size_t)b * 256 + key) * 64 + 32 * hf; const float* vp = CMP + ((size_t)2048 + (size_t)b * 256 + key) * 64 + 32 * hf;
        float kv[32], vv[32]; float ss = 0.f;
#pragma unroll
        for (int i = 0; i < 8; ++i) { const f32x4 a = *(const f32x4*)(kp + 4 * i), c = *(const f32x4*)(vp + 4 * i);
#pragma unroll
            for (int j = 0; j < 4; ++j) { kv[4 * i + j] = a[j]; vv[4 * i + j] = c[j]; ss += a[j] * a[j]; } }
        ss += __shfl_xor(ss, 1); const float rstd = rsqrtf(ss * (1.f / 64.f) + 1e-6f); const float* g = C.nsa_kc_g + (size_t)l * 64 + 32 * hf; const bool dead = (key == 255);
#pragma unroll
        for (int i = 0; i < 4; ++i) { u32x4 o, p;
            o.x = pk2(kv[8 * i] * rstd * g[8 * i], kv[8 * i + 1] * rstd * g[8 * i + 1]); o.y = pk2(kv[8 * i + 2] * rstd * g[8 * i + 2], kv[8 * i + 3] * rstd * g[8 * i + 3]);
            o.z = pk2(kv[8 * i + 4] * rstd * g[8 * i + 4], kv[8 * i + 5] * rstd * g[8 * i + 5]); o.w = pk2(kv[8 * i + 6] * rstd * g[8 * i + 6], kv[8 * i + 7] * rstd * g[8 * i + 7]);
            p.x = pk2(vv[8 * i], vv[8 * i + 1]); p.y = pk2(vv[8 * i + 2], vv[8 * i + 3]); p.z = pk2(vv[8 * i + 4], vv[8 * i + 5]); p.w = pk2(vv[8 * i + 6], vv[8 * i + 7]);
            if (dead) { o = (u32x4){0u, 0u, 0u, 0u}; p = o; }
            *(LAS u32x4*)(Kc + key * KROW + hf * 64 + i * 16) = o; *(LAS u32x4*)(Vc + key * KROW + hf * 64 + i * 16) = p; }
        bl = b;
        __syncthreads();
    }
    f32x4 Oc[2][4];
    const int cmaxu = (t0 + 32) >> 4, ktmax = cmaxu >> 4;
    const unsigned vaddr0 = (unsigned)(size_t)(Vc + (4 * quad + (l15 >> 2)) * KROW + 8 * (l15 & 3));
#pragma unroll
    for (int q = 0; q < 2; ++q) {
        const int t = t0 + 8 * w + 4 * q + (l15 >> 2);
        bf16x8 Q[2]; q_load(Q, QN + (tb + t) * 256 + head * 64, quad);
        float nm_ = -bnd_cmp; asm volatile("" : "+v"(nm_)); f32x4 S[16]; const f32x4 sinit = (f32x4){nm_, nm_, nm_, nm_}; float ls = 0.f;
#pragma unroll
        for (int kt = 0; kt < 16; ++kt) {
            if (kt <= ktmax) {
                const bf16x8 k0 = *(const LAS bf16x8*)(Kc + (16 * kt + l15) * KROW + quad * 16), k1 = *(const LAS bf16x8*)(Kc + (16 * kt + l15) * KROW + 64 + quad * 16);
                S[kt] = MFMA16(k0, Q[0], sinit); S[kt] = MFMA16(k1, Q[1], S[kt]);
#pragma unroll
                for (int j = 0; j < 4; ++j) { const int c = 16 * kt + 4 * quad + j; const float p = (16 * c + 31 <= t) ? fexp2(S[kt][j]) : 0.f; S[kt][j] = p; ls += p; }
            } else S[kt] = (f32x4){0.f, 0.f, 0.f, 0.f};
        }
        ls += __shfl_xor(ls, 16); ls += __shfl_xor(ls, 32);
        const float inv = ls > 0.f ? 1.f / ls : 0.f;
#pragma unroll
        for (int kt = 0; kt < 16; ++kt) S[kt] = S[kt] * inv;
#pragma unroll
        for (int kt = 0; kt < 16; ++kt) {
            const float send = (quad == 3) ? (kt > 0 ? S[kt > 0 ? kt - 1 : 0][3] : 0.f) : S[kt][3];
            const float prev = __shfl(send, (lane + 48) & 63);
            float v = ((quad == 0 && kt == 0) ? 0.f : prev) + 2.f * (S[kt][0] + S[kt][1] + S[kt][2]) + S[kt][3];
            v = group_sum<4>(v);
            if (head == 0) imps[(8 * w + 4 * q + (l15 >> 2)) * 64 + 4 * kt + quad] = v;
        }
#pragma unroll
        for (int d = 0; d < 4; ++d) Oc[q][d] = (f32x4){0.f, 0.f, 0.f, 0.f};
#pragma unroll
        for (int ks = 0; ks < 8; ++ks) {
            if (2 * ks <= ktmax) {
                VFrag vf; vt_issue(vf, vaddr0 + ks * 32 * KROW); const bf16x8 pf = pack8(S[2 * ks], S[2 * ks + 1]); vt_wait(vf);
#pragma unroll
                for (int d = 0; d < 4; ++d) Oc[q][d] = MFMA16(vt_get(vf, d), pf, Oc[q][d]);
            }
        }
    }
    {
        float* OCm = WSP(float, R_OCMP);
#pragma unroll
        for (int q = 0; q < 2; ++q) { float* o = OCm + (tb + t0 + 8 * w + 4 * q + (l15 >> 2)) * 256 + head * 64 + 4 * quad;
#pragma unroll
            for (int d = 0; d < 4; ++d) *(f32x4*)(o + 16 * d) = Oc[q][d]; }
    }
    __syncthreads();
    if (tid < 64) {
        const int cur = tbk; unsigned long long mask;
        if (cur <= 15) mask = (2ull << cur) - 1ull;
        else {
            mask = 1ull | (1ull << cur) | (1ull << (cur - 1));
            float v[64];
#pragma unroll
            for (int i = 0; i < 16; ++i) { const f32x4 a = *(const LAS f32x4*)(imps + tid * 64 + 4 * i);
#pragma unroll
                for (int j = 0; j < 4; ++j) { const int jb = 4 * i + j; v[jb] = (jb >= 1 && jb <= cur - 2) ? a[j] : -1.f; } }
#pragma unroll 1
            for (int r = 0; r < 13; ++r) {
                float bv = -0.5f; int bi = 0;
#pragma unroll
                for (int jb = 0; jb < 64; ++jb) if (v[jb] > bv) { bv = v[jb]; bi = jb; }
                mask |= 1ull << bi;
#pragma unroll
                for (int jb = 0; jb < 64; ++jb) v[jb] = (jb == bi) ? -1.f : v[jb];
            }
        }
        unsigned lo = (unsigned)mask, hi = (unsigned)(mask >> 32);
        selm[2 * tid] = lo; selm[2 * tid + 1] = hi;
#pragma unroll
        for (int o = 1; o < 64; o <<= 1) { lo |= __shfl_xor(lo, o); hi |= __shfl_xor(hi, o); }
        if (tid == 0) { uw[0] = lo; uw[1] = hi; }
    }
    __syncthreads();
    unsigned long long U = ((unsigned long long)uw[1] << 32) | uw[0];
    bf16x8 Q[2][2]; SlcMask mk; FA<2> st; fa_init(st); st.negM = -bnd_slc; unsigned long long msk[2];
#pragma unroll
    for (int q = 0; q < 2; ++q) { const int tl = 8 * w + 4 * q + (l15 >> 2); mk.t[q] = t0 + tl; msk[q] = ((unsigned long long)selm[2 * tl + 1] << 32) | selm[2 * tl]; q_load(Q[q], QR + (tb + mk.t[q]) * 256 + head * 64, quad); }
    unsigned long long QM[2];
#pragma unroll
    for (int q = 0; q < 2; ++q) { unsigned lo = (unsigned)msk[q], hi = (unsigned)(msk[q] >> 32);
#pragma unroll
        for (int o = 1; o < 64; o <<= 1) { lo |= __shfl_xor(lo, o); hi |= __shfl_xor(hi, o); }
        QM[q] = ((unsigned long long)hi << 32) | lo; }
#ifndef PROBE_SLC2
#define PROBE_SLC2 0
#endif
#ifndef PROBE_SWA2
#define PROBE_SWA2 0
#endif
    u32x4 kr, vr; const unsigned long long U0 = U;
    for (int prep_ = 0; prep_ <= PROBE_SLC2; ++prep_) { U = U0; if (prep_ < PROBE_SLC2) { fa_init(st); }
#define SLC_LOAD(j) do { const size_t rowk = tb + 64 * (j) + (tid >> 3); kr = *(const u32x4*)(KSb + rowk * 64 + (tid & 7) * 8); vr = *(const u32x4*)(PROJ + rowk * NPJ + 3008 + (tid & 7) * 8); } while (0)
    {
        int j = __builtin_ctzll(U); U &= U - 1ull;
        int jn = U ? __builtin_ctzll(U) : -1; U &= U - 1ull;
        SLC_LOAD(j); __syncthreads(); kv_store(Ks, Vs, tid, kr, vr); if (jn >= 0) SLC_LOAD(jn);
        for (int it = 0;; ++it) {
            __syncthreads();
            const int jnn = U ? __builtin_ctzll(U) : -1; U &= U - 1ull;
            if (jn >= 0) kv_store(Ks + ((it + 1) & 1) * 2 * KT_BYTES, Vs + ((it + 1) & 1) * 2 * KT_BYTES, tid, kr, vr);
            if (jnn >= 0) SLC_LOAD(jnn);
            const bool act[2] = {(bool)((QM[0] >> j) & 1ull), (bool)((QM[1] >> j) & 1ull)};
            if (act[0] || act[1]) { mk.k0 = 64 * j; mk.sel[0] = (msk[0] >> j) & 1ull; mk.sel[1] = (msk[1] >> j) & 1ull; fa_tile<2, true>(st, Q, Ks + (it & 1) * 2 * KT_BYTES, Vs + (it & 1) * 2 * KT_BYTES, lane, mk, act); }
            if (jn < 0) break; j = jn; jn = jnn;
        }
    }
#undef SLC_LOAD
    }
    float lse2[2]; fa_finish<2>(st, lse2);
    {   float* OSl = WSP(float, R_OSLC);
#pragma unroll
        for (int q = 0; q < 2; ++q) { float* o = OSl + (tb + mk.t[q]) * 256 + head * 64 + 4 * quad;
#pragma unroll
            for (int d = 0; d < 4; ++d) *(f32x4*)(o + 16 * d) = st.O[q][d]; }
    }
    FA<2> sw; fa_init(sw); sw.negM = -bnd_swa; SwaMask mw; mw.t[0] = mk.t[0]; mw.t[1] = mk.t[1];
    for (int prep_ = 0; prep_ <= PROBE_SWA2; ++prep_) { if (prep_ < PROBE_SWA2) fa_init(sw);
    {
        const int j0 = tbk >= 8 ? tbk - 8 : 0; const bool act[2] = {true, true};
#define SWA_LOAD(j) do { const size_t rowk = tb + 64 * (j) + (tid >> 3); kr = *(const u32x4*)(KWb + rowk * 64 + (tid & 7) * 8); vr = *(const u32x4*)(PROJ + rowk * NPJ + 3136 + (tid & 7) * 8); } while (0)
        SWA_LOAD(j0); __syncthreads(); kv_store(Ks, Vs, tid, kr, vr); if (j0 + 1 <= tbk) SWA_LOAD(j0 + 1);
        for (int j = j0; j <= tbk; ++j) {
            const int pb_ = (j - j0) & 1;
            __syncthreads();
            if (j + 1 <= tbk) kv_store(Ks + (pb_ ^ 1) * 2 * KT_BYTES, Vs + (pb_ ^ 1) * 2 * KT_BYTES, tid, kr, vr);
            if (j + 2 <= tbk) SWA_LOAD(j + 2);
            mw.k0 = 64 * j;
            if (j == tbk || j == tbk - 8) fa_tile<2, true>(sw, Q, Ks + pb_ * 2 * KT_BYTES, Vs + pb_ * 2 * KT_BYTES, lane, mw, act);
            else fa_tile<2, false>(sw, Q, Ks + pb_ * 2 * KT_BYTES, Vs + pb_ * 2 * KT_BYTES, lane, NoMask(), act);
        }
#undef SWA_LOAD
    }
    }
    fa_finish<2>(sw, lse2);
#pragma unroll
    for (int q = 0; q < 2; ++q) {
        const size_t row = tb + mk.t[q]; const float* gp = GATE + row * 12 + head * 3; const float g0 = gp[0], g1 = gp[1], g2 = gp[2];
        f32x4 o[4]; float ss = 0.f; const float* pc = WSP(float, R_OCMP) + row * 256 + head * 64 + 4 * quad; const float* ps = WSP(float, R_OSLC) + row * 256 + head * 64 + 4 * quad;
#pragma unroll
        for (int d = 0; d < 4; ++d) { o[d] = *(const f32x4*)(pc + 16 * d) * g0 + *(const f32x4*)(ps + 16 * d) * g1 + sw.O[q][d] * g2; ss += (o[d][0] * o[d][0] + o[d][1] * o[d][1]) + (o[d][2] * o[d][2] + o[d][3] * o[d][3]); }
        ss += __shfl_xor(ss, 16); ss += __shfl_xor(ss, 32);
        const float rstd = rsqrtf(ss * (1.f / 64.f) + 1e-6f); const float* og = C.onorm_g + (size_t)l * 768 + 512 + head * 64 + 4 * quad;
        bf16* yo = YCAT + row * DM + 768 + head * 64 + 4 * quad;
#pragma unroll
        for (int d = 0; d < 4; ++d) { const f32x4 g4 = *(const f32x4*)(og + 16 * d); u32x2 wv; wv.x = pk2(o[d][0] * rstd * g4[0], o[d][1] * rstd * g4[1]); wv.y = pk2(o[d][2] * rstd * g4[2], o[d][3] * rstd * g4[3]); *(u32x2*)(yo + 16 * d) = wv; }
    }
}

DI void fin_phase(const Ctx& C, int l) {
    const bf16* SCH = WSP(bf16, R_SCH); const float* YA = WSP(float, R_YA); const bf16* Gb = WSP(bf16, R_G); const float* OC = WSP(float, R_OC); const float* LSE = WSP(float, R_LSE);
    const float* UB = WSP(float, R_SCANU); const float* SMT = WSP(float, R_SCANS); bf16* YCAT = WSP(bf16, R_YCAT);
    const int lane = C.lane, ch = 4 * lane, hh = lane >> 4;
    LAS float* sm = (LAS float*)C.lds;
    LAS float* us = sm + 4 * 4096 + C.wave * 256;
    int bl = -1;
    for (int it = C.bid; it < NT / 128; it += C.G) {
        const int b = it >> 5, kk = it & 31;
        if (b != bl) { __syncthreads(); for (int i = C.tid; i < 4096; i += NTHR) *(LAS f32x4*)(sm + 4 * i) = *(const f32x4*)(SMT + (size_t)b * 4 * 4096 + 4 * i); bl = b; __syncthreads(); }
#pragma unroll 1
      for (int hf = 0; hf < 2; ++hf) {
        const int rbase = b * NS + hf * (NS / 2) + 64 * kk + C.wave * 8;
        const bool fix = hf == 1;
#pragma unroll 2
        for (int r = 0; r < 8; ++r) {
            const int row = rbase + r, s = row % NS;
            const size_t o = (size_t)row * 256 + ch;
            {
                f32x4 y = *(const f32x4*)(YA + o); const u32x2 rr_ = *(const u32x2*)(SCH + (size_t)3 * NT * 256 + o), k_ = *(const u32x2*)(SCH + o), v_ = *(const u32x2*)(SCH + (size_t)4 * NT * 256 + o), g_ = *(const u32x2*)(Gb + o);
                const f32x4 rr = (f32x4){bflo(rr_.x), bfhi(rr_.x), bflo(rr_.y), bfhi(rr_.y)}, k = (f32x4){bflo(k_.x), bfhi(k_.x), bflo(k_.y), bfhi(k_.y)}, v = (f32x4){bflo(v_.x), bfhi(v_.x), bflo(v_.y), bfhi(v_.y)}, g = (f32x4){bflo(g_.x), bfhi(g_.x), bflo(g_.y), bfhi(g_.y)};
                if (fix) {
                    *(LAS f32x4*)(us + ch) = *(const f32x4*)(UB + ((size_t)b * (NS / 2) + (s - NS / 2)) * 256 + ch);
                    asm volatile("s_waitcnt lgkmcnt(0)" ::: "memory");
                    const LAS float* sp = sm + hh * 4096 + 4 * (lane & 15); const LAS float* up = us + hh * 64;
#pragma unroll 8
                    for (int j4 = 0; j4 < 16; ++j4) { const f32x4 u4 = *(const LAS f32x4*)(up + 4 * j4);
#pragma unroll
                        for (int jj = 0; jj < 4; ++jj) y += *(const LAS f32x4*)(sp + (4 * j4 + jj) * 64) * u4[jj]; }
                    asm volatile("s_waitcnt lgkmcnt(0)" ::: "memory");
                }
                const f32x4 rk = *(const f32x4*)(C.rk + (size_t)l * 256 + ch), gw4 = *(const f32x4*)(C.gn_w + (size_t)l * 256 + ch), gb4 = *(const f32x4*)(C.gn_b + (size_t)l * 256 + ch);
                const float mu = group_sum<16>((y[0] + y[1]) + (y[2] + y[3])) * (1.f / 64.f);
                const f32x4 dy = y - mu; const float var = group_sum<16>((dy[0] * dy[0] + dy[1] * dy[1]) + (dy[2] * dy[2] + dy[3] * dy[3])) * (1.f / 64.f);
                const float rstd = rsqrtf(var + 64e-5f);
                const float dot = group_sum<16>((rr[0] * k[0] * rk[0] + rr[1] * k[1] * rk[1]) + (rr[2] * k[2] * rk[2] + rr[3] * k[3] * rk[3]));
                float out[4];
#pragma unroll
                for (int i = 0; i < 4; ++i) out[i] = ((dy[i] * rstd * gw4[i] + gb4[i]) + dot * v[i]) * g[i];
                u32x2 w; w.x = pk2(out[0], out[1]); w.y = pk2(out[2], out[3]); *(u32x2*)(YCAT + (size_t)row * DM + ch) = w;
            }
            {
                const float l0 = LSE[(size_t)row * 4 + hh], l1 = LSE[((size_t)NT + row) * 4 + hh], l2 = LSE[((size_t)2 * NT + row) * 4 + hh];
                const float mx = fmaxf(l0, fmaxf(l1, l2)); float w0 = fexp2(l0 - mx), w1 = fexp2(l1 - mx), w2 = fexp2(l2 - mx); const float inv = 1.f / (w0 + w1 + w2); w0 *= inv; w1 *= inv; w2 *= inv;
                const f32x4 a = *(const f32x4*)(OC + o), bq = *(const f32x4*)(OC + (size_t)NT * 256 + o), c = *(const f32x4*)(OC + (size_t)2 * NT * 256 + o);
                const f32x4 y = a * w0 + bq * w1 + c * w2;
                const float ss = group_sum<16>((y[0] * y[0] + y[1] * y[1]) + (y[2] * y[2] + y[3] * y[3])); const float rstd = rsqrtf(ss * (1.f / 64.f) + 1e-6f);
                const f32x4 og = *(const f32x4*)(C.onorm_g + (size_t)l * 768 + 256 + ch);
                u32x2 w; w.x = pk2(y[0] * rstd * og[0], y[1] * rstd * og[1]); w.y = pk2(y[2] * rstd * og[2], y[3] * rstd * og[3]); *(u32x2*)(YCAT + (size_t)row * DM + 512 + ch) = w;
            }
        }
      }
    }
    __syncthreads();
}

constexpr int CW_Q = 40000;
DI int q_next(const Ctx& C, unsigned* ctr, LAS int* slot) {
    __syncthreads();
    if (C.tid == 0) *slot = (int)__hip_atomic_fetch_add(ctr, 1u, __ATOMIC_RELAXED, __HIP_MEMORY_SCOPE_AGENT);
    __syncthreads();
    return *slot;
}
DI void conv_ticket(const Ctx& C, int l, int tk);
constexpr int CW_CD = 41000;
DI void cmp_mlp_unit(const Ctx& C, int l, int cb) {
    const int kv = cb >> 3;
    { pg8::Gemm g{kv ? WSP(bf16, R_VCR) : WSP(bf16, R_KCR), WSP(bf16, WS_WK1) + (size_t)(l * 2 + kv) * 256 * 2048, 1024, 2048}; pg8::StaticOrder S; S.init(8, 1, 8, cb & 7);
      EpiC1 E{WSP(bf16, R_CH1) + (size_t)kv * 2048 * 256, (WSP(float, WS_SMALL) + NLAYER * 8 * 6144 + l * 512 + kv * 256)}; pg8::gemm_phase(C.lds, C.tid, g, S, E); }
    asm volatile("s_waitcnt vmcnt(0)" ::: "memory"); __syncthreads();
    { pg8::Gemm g{WSP(bf16, R_CH1) + (size_t)kv * 2048 * 256, WSP(bf16, WS_WK2) + (size_t)(l * 2 + kv) * 256 * 256, 256, 256}; pg8::StaticOrder S; S.init(8, 1, 8, cb & 7);
      EpiC2 E{WSP(float, R_CMP) + (size_t)kv * 2048 * 64}; pg8::gemm_phase(C.lds, C.tid, g, S, E); }
    asm volatile("s_waitcnt vmcnt(0)" ::: "memory"); __syncthreads();
    if (C.tid == 0) { __builtin_amdgcn_fence(__ATOMIC_RELEASE, "agent"); asm volatile("s_waitcnt vmcnt(0)" ::: "memory");
        __hip_atomic_fetch_add(WSP(unsigned, WS_CTL) + CW_CD + 64 * l, 1u, __ATOMIC_RELAXED, __HIP_MEMORY_SCOPE_AGENT); }
}
DI void cmp_mlp_wait(const Ctx& C, int l) {
    if (C.tid == 0) { unsigned* c = WSP(unsigned, WS_CTL) + CW_CD + 64 * l; unsigned sp = 0u;
        while (__hip_atomic_load(c, __ATOMIC_RELAXED, __HIP_MEMORY_SCOPE_AGENT) < 16u) { __builtin_amdgcn_s_sleep(8); if (++sp > (1u << 21)) break; }
        __builtin_amdgcn_fence(__ATOMIC_ACQUIRE, "agent"); asm volatile("s_waitcnt vmcnt(0)" ::: "memory"); }
    __syncthreads();
}
#ifndef PROBE_TS
#define PROBE_TS 0
#endif
constexpr int CW_TS = 50000;
DI void ts_mark(const Ctx& C, int l, int ev) {
#if PROBE_TS
    if (l == 0 && C.tid == 0) { unsigned* w = WSP(unsigned, WS_CTL) + CW_TS; const unsigned t = (unsigned)__builtin_amdgcn_s_memrealtime();
        if (ev == 0) { if (C.bid == 0) __hip_atomic_store(w, t, __ATOMIC_RELAXED, __HIP_MEMORY_SCOPE_AGENT); }
        else if (ev == 6) atomicMax(w + 6, ~t); else atomicMax(w + ev, t); }
#endif
}
DI void mix_phase(const Ctx& C, int l, int rep) {
    unsigned* ctl = WSP(unsigned, WS_CTL) + CW_Q + 64 * 3 * (l + 2 * rep); LAS int* slot = (LAS int*)(C.lds + MISC_OFF + 1024);
    ts_mark(C, l, 0);
#ifndef PROBE_SPLIT
#define PROBE_SPLIT 0
#endif
    if (C.bid < 96) { scan_unit8(C, C.bid); if (PROBE_SCAN2) scan_unit8(C, C.bid); ts_mark(C, l, 4); }
    else if (C.bid < 112) cmp_mlp_unit(C, l, C.bid - 96);
    bool cmp_ready = false;
    if (PROBE_SPLIT) { asm volatile("s_waitcnt vmcnt(0)" ::: "memory"); __syncthreads(); { XcdBarrier bar2; bar2.bar = WSP(unsigned, WS_CTL) + CW_BAR; bar2.x = xb_xcc_id(); bar2.st = (volatile LAS unsigned*)(C.lds + MISC_OFF); xcd_barrier(bar2); } }
    int bl = -1;
    const float bnd_cmp = score_bound(C.nsa_q_g + (size_t)l * 64, C.nsa_kc_g + (size_t)l * 64, C.lane), bnd_slc = score_bound(C.nsa_q_g + (size_t)l * 64, C.nsa_ks_g + (size_t)l * 64, C.lane),
                bnd_swa = score_bound(C.nsa_q_g + (size_t)l * 64, C.nsa_kw_g + (size_t)l * 64, C.lane), bnd_dil = score_bound(C.dil_q_g + (size_t)l * 64, C.dil_k_g + (size_t)l * 64, C.lane);
    bool conv_left = true;
#define CONV_ONE() do { if (conv_left) { const int t_ = q_next(C, ctl + 128, slot); if (t_ >= 768 * (1 + PROBE_CONV2)) conv_left = false; else { conv_ticket(C, l, t_ % 768); bl = -1; } } } while (0)
    for (;;) { const int u = q_next(C, ctl, slot); if (u >= 512 * (1 + PROBE_ATT2)) break; nsa_unit(C, l, u & 7, 63 - ((u & 511) >> 3), bl, cmp_ready, bnd_cmp, bnd_slc, bnd_swa); CONV_ONE(); }
    ts_mark(C, l, 1);
    for (int n = 0;; ++n) { const int u = q_next(C, ctl + 64, slot); if (u >= 1536 * (1 + PROBE_ATT2)) break; dil_unit(C, u % 1536, C.lds, C.lds + KT_BYTES, bnd_dil); if ((n & 3) == 3) CONV_ONE(); }
    ts_mark(C, l, 2);
    while (conv_left) CONV_ONE();
#undef CONV_ONE
    ts_mark(C, l, 3); if (C.bid >= 96) ts_mark(C, l, 6);
    __syncthreads();
}
#define MFMA_F32(a, b, c) __builtin_amdgcn_mfma_f32_16x16x4f32((a), (b), (c), 0, 0, 0)
DI void router_phase(const Ctx& C, int l) {
    const float* X = C.out; const float* MOD = WSP(float, WS_SMALL) + (size_t)l * 8 * 6144; unsigned char* H8 = WSP(unsigned char, R_XS);
    int* TOPE = WSP(int, WS_ROUTE); float* TOPG = (float*)(TOPE + NT * 4); unsigned* CNTB = WSP(unsigned, WS_CTL) + CW_CNT + l * 8192;
    LAS float* wl = (LAS float*)C.lds;
    LAS float* lg = (LAS float*)(C.lds + MISC_OFF + 8192) + C.wave * 512;
    LAS unsigned* hist = (LAS unsigned*)(C.lds + MISC_OFF + 6144);
    LAS float* rs = (LAS float*)(C.lds + MISC_OFF + 6400) + C.wave * 16;
    const int lane = C.lane, l15 = lane & 15, quad = lane >> 4, gw = C.bid * NWAVE + C.wave, NGW = C.G * NWAVE;
    const float* wr = C.w_router + (size_t)l * 1024 * 32; const float* g2 = C.norm2_g + (size_t)l * DM;
    __syncthreads();
    if (C.tid < 32) hist[C.tid] = 0u;
    for (int i = C.tid; i < 8192; i += NTHR) { const int k = i >> 3, e4 = (i & 7) * 4; const f32x4 v = *(const f32x4*)(wr + (size_t)k * 32 + e4); LAS float* d = wl + ((k >> 2) * 32 + e4) * 4 + (k & 3);
        d[0] = v[0]; d[4] = v[1]; d[8] = v[2]; d[12] = v[3]; }
    __syncthreads();
    for (int task = gw; task < NT / 16; task += NGW) {
        const int row0 = 16 * task, b = row0 / NS;
        const float* shb = MOD + (size_t)b * 6144 + 3072; const float* scb = shb + 1024;
        {
            f32x4 gg[4], sa[4], sb[4];
#pragma unroll
            for (int j = 0; j < 4; ++j) { const int k = 4 * lane + 256 * j; const f32x4 g = *(const f32x4*)(g2 + k), a = *(const f32x4*)(scb + k); gg[j] = g * (a + 1.f); sb[j] = *(const f32x4*)(shb + k); }
#pragma unroll 2
            for (int r = 0; r < 16; ++r) {
                const float* xr = X + (size_t)(row0 + r) * DM + 4 * lane; f32x4 v[4]; float ss = 0.f;
#pragma unroll
                for (int j = 0; j < 4; ++j) { v[j] = *(const f32x4*)(xr + 256 * j); ss += (v[j][0] * v[j][0] + v[j][1] * v[j][1]) + (v[j][2] * v[j][2] + v[j][3] * v[j][3]); }
                ss = group_sum<64>(ss); const float rstd = rsqrtf(ss * (1.f / DM) + 1e-6f);
                if (lane == 0) rs[r] = rstd;
                unsigned char* hp = H8 + (size_t)(row0 + r) * DM + 4 * lane;
#pragma unroll
                for (int j = 0; j < 4; ++j) { const f32x4 h = v[j] * rstd * gg[j] + sb[j]; *(unsigned*)(hp + 256 * j) = pk4_fp8(h[0], h[1], h[2], h[3]); }
            }
        }
        const float* xr = X + (size_t)(row0 + l15) * DM + 4 * quad; const float* sh = shb + 4 * quad; const float* sc = scb + 4 * quad;
        asm volatile("s_waitcnt lgkmcnt(0)" ::: "memory");
        const float rstd = rs[l15];
        f32x4 acc0 = (f32x4){0.f, 0.f, 0.f, 0.f}, acc1 = acc0;
#pragma unroll 2
        for (int i = 0; i < 64; ++i) {
            const f32x4 a = *(const f32x4*)(xr + 16 * i), g = *(const f32x4*)(g2 + 16 * i + 4 * quad), s1 = *(const f32x4*)(sc + 16 * i), s0 = *(const f32x4*)(sh + 16 * i);
            f32x4 h;
#pragma unroll
            for (int j = 0; j < 4; ++j) h[j] = a[j] * rstd * g[j] * (1.f + s1[j]) + s0[j];
            const LAS float* wp = wl + ((4 * i + quad) * 32 + l15) * 4; const f32x4 w0 = *(const LAS f32x4*)wp, w1 = *(const LAS f32x4*)(wp + 64);
#pragma unroll
            for (int j = 0; j < 4; ++j) { acc0 = MFMA_F32(h[j], w0[j], acc0); acc1 = MFMA_F32(h[j], w1[j], acc1); }
        }
        const float b0 = C.b_router[l * 32 + l15], b1 = C.b_router[l * 32 + 16 + l15];
#pragma unroll
        for (int j = 0; j < 4; ++j) { lg[(4 * quad + j) * 32 + l15] = acc0[j] + b0; lg[(4 * quad + j) * 32 + 16 + l15] = acc1[j] + b1; }
        asm volatile("s_waitcnt lgkmcnt(0)" ::: "memory");
        if (lane < 16) {
            float v[32];
#pragma unroll
            for (int i = 0; i < 8; ++i) { const f32x4 a = *(const LAS f32x4*)(lg + lane * 32 + 4 * i); v[4 * i] = a[0]; v[4 * i + 1] = a[1]; v[4 * i + 2] = a[2]; v[4 * i + 3] = a[3]; }
            float tv[4]; int ti[4];
#pragma unroll
            for (int r = 0; r < 4; ++r) { float bv = -3.0e38f; int bi = 0;
#pragma unroll
                for (int e = 0; e < 32; ++e) if (v[e] > bv) { bv = v[e]; bi = e; }
                tv[r] = bv; ti[r] = bi;
#pragma unroll
                for (int e = 0; e < 32; ++e) v[e] = (e == bi) ? -3.0e38f : v[e]; }
            const float e1 = __expf(tv[1] - tv[0]), e2 = __expf(tv[2] - tv[0]), e3 = __expf(tv[3] - tv[0]), inv = 1.f / (1.f + e1 + e2 + e3);
            const int row = row0 + lane;
            *(int4*)(TOPE + (size_t)row * 4) = make_int4(ti[0], ti[1], ti[2], ti[3]);
            *(f32x4*)(TOPG + (size_t)row * 4) = (f32x4){inv, e1 * inv, e2 * inv, e3 * inv};
#pragma unroll
            for (int r = 0; r < 4; ++r) __hip_atomic_fetch_add(&hist[ti[r]], 1u, __ATOMIC_RELAXED, __HIP_MEMORY_SCOPE_WORKGROUP);
        }
        asm volatile("s_waitcnt lgkmcnt(0)" ::: "memory");
    }
    __syncthreads();
    if (C.tid < 32) CNTB[C.bid * 32 + C.tid] = hist[C.tid];
}

DI void moe_tables(const Ctx& C, int l, LAS int* tab) {
    const unsigned* CNTB = WSP(unsigned, WS_CTL) + CW_CNT + l * 8192;
    LAS unsigned* part = (LAS unsigned*)(tab + 192);
    __syncthreads();
    { const int e = C.tid & 31, pt = C.tid >> 5; unsigned tot = 0u, mine = 0u;
        const int g0 = pt * ((C.G + 15) >> 4), g1 = min(C.G, g0 + ((C.G + 15) >> 4));
#pragma unroll 16
        for (int g = g0; g < g1; ++g) { const unsigned c = CNTB[g * 32 + e]; tot += c; mine += (g < C.bid) ? c : 0u; }
        part[(pt * 2) * 32 + e] = tot; part[(pt * 2 + 1) * 32 + e] = mine; }
    __syncthreads();
    if (C.tid < 32) { unsigned tot = 0u, mine = 0u;
#pragma unroll
        for (int pt = 0; pt < 16; ++pt) { tot += part[(pt * 2) * 32 + C.tid]; mine += part[(pt * 2 + 1) * 32 + C.tid]; }
        tab[128 + C.tid] = (int)((tot + 255u) >> 8); tab[64 + C.tid] = (int)mine; }
    __syncthreads();
    if (C.tid == 0) { int s = 0; for (int e = 0; e < 32; ++e) { tab[e] = s; s += tab[128 + e]; } tab[32] = s; }
    __syncthreads();
}
DI void scatter_phase(const Ctx& C, int l) {
    const int* TOPE = WSP(int, WS_ROUTE); int* POS = (int*)(TOPE + NT * 8); int* ROWMAP = (int*)(TOPE + NT * 12);
    LAS int* tab = (LAS int*)(C.lds + MISC_OFF + 64); LAS unsigned* cur = (LAS unsigned*)(C.lds + 16384);
    moe_tables(C, l, tab);
    if (C.tid < 32) cur[C.tid] = (unsigned)(tab[C.tid] * 256 + tab[64 + C.tid]);
    __syncthreads();
    const int lane = C.lane, gw = C.bid * NWAVE + C.wave, NGW = C.G * NWAVE;
    for (int task = gw; task < NT / 16; task += NGW) {
        const int row0 = 16 * task, tok = row0 + (lane >> 2);
        const int e = TOPE[(size_t)tok * 4 + (lane & 3)];
        const int slot = (int)__hip_atomic_fetch_add(&cur[e], 1u, __ATOMIC_RELAXED, __HIP_MEMORY_SCOPE_WORKGROUP);
        POS[(size_t)tok * 4 + (lane & 3)] = slot; ROWMAP[slot] = tok;
    }
}
DI void combine_phase(const Ctx& C, int l, float* dst) {
    const bf16* YB = WSP(bf16, R_YB); const int* TOPE = WSP(int, WS_ROUTE); const float* TOPG = (const float*)(TOPE + NT * 4); const int* POS = (const int*)(TOPE + NT * 8);
    const float* MOD = WSP(float, WS_SMALL) + (size_t)l * 8 * 6144; bf16* H = WSP(bf16, WS_H);
    const int lane = C.lane, gw = C.bid * NWAVE + C.wave, NGW = C.G * NWAVE;
    for (int task = gw; task < NT / 16; task += NGW) {
        const int row0 = 16 * task, b = row0 / NS; const float* gt = MOD + (size_t)b * 6144 + 5120 + 8 * lane;
        f32x4 g4[4], gg[4], sb[4];
#pragma unroll
        for (int j = 0; j < 2; ++j) { g4[2 * j] = *(const f32x4*)(gt + 512 * j); g4[2 * j + 1] = *(const f32x4*)(gt + 512 * j + 4); }
        if (l + 1 < NLAYER) { const float* M2 = MOD + 8 * 6144 + (size_t)b * 6144 + 8 * lane; const float* g = C.norm1_g + (size_t)(l + 1) * DM + 8 * lane;
#pragma unroll
            for (int j = 0; j < 2; ++j)
#pragma unroll
                for (int hlf = 0; hlf < 2; ++hlf) { const int o = 512 * j + 4 * hlf; gg[2 * j + hlf] = *(const f32x4*)(g + o) * (*(const f32x4*)(M2 + 1024 + o) + 1.f); sb[2 * j + hlf] = *(const f32x4*)(M2 + o); } }
#pragma unroll 2
        for (int r = 0; r < 16; ++r) {
            const int row = row0 + r; const int4 ps = *(const int4*)(POS + (size_t)row * 4); const f32x4 gk = *(const f32x4*)(TOPG + (size_t)row * 4);
            const int pp[4] = {ps.x, ps.y, ps.z, ps.w};
            const float* orow = C.out + (size_t)row * DM + 8 * lane; float* drow = dst + (size_t)row * DM + 8 * lane;
            u32x4 y[4][2]; f32x4 x[4];
#pragma unroll
            for (int q = 0; q < 4; ++q)
#pragma unroll
                for (int j = 0; j < 2; ++j) y[q][j] = *(const u32x4*)(YB + (size_t)pp[q] * DM + 8 * lane + 512 * j);
#pragma unroll
            for (int j = 0; j < 2; ++j) { x[2 * j] = *(const f32x4*)(orow + 512 * j); x[2 * j + 1] = *(const f32x4*)(orow + 512 * j + 4); }
            f32x4 v[4]; float s = 0.f;
#pragma unroll
            for (int j = 0; j < 2; ++j) { f32x4 a0 = (f32x4){0.f, 0.f, 0.f, 0.f}, a1 = a0;
#pragma unroll
                for (int q = 0; q < 4; ++q) { const u32x4 w = y[q][j]; a0 += (f32x4){bflo(w.x), bfhi(w.x), bflo(w.y), bfhi(w.y)} * gk[q]; a1 += (f32x4){bflo(w.z), bfhi(w.z), bflo(w.w), bfhi(w.w)} * gk[q]; }
                v[2 * j] = x[2 * j] + g4[2 * j] * a0; v[2 * j + 1] = x[2 * j + 1] + g4[2 * j + 1] * a1;
#if PROBE_TS
                if (l + 1 == NLAYER) { const unsigned* w = WSP(unsigned, WS_CTL) + CW_TS; const unsigned t0 = w[0]; const unsigned ea = (PROBE_TS_A == 6) ? ~w[6] : w[PROBE_TS_A], eb = (PROBE_TS_B == 6) ? ~w[6] : w[PROBE_TS_B];
                    const float A = (PROBE_TS_A == 7) ? 1.f : (float)((ea - t0) / 4000u) * 0.04f, B = (float)(eb - t0) * 1e-3f;
                    v[2 * j] = v[2 * j] + A; v[2 * j + 1] = v[2 * j + 1] + A; (void)B; }
#endif
                *(f32x4*)(drow + 512 * j) = v[2 * j]; *(f32x4*)(drow + 512 * j + 4) = v[2 * j + 1]; }
#pragma unroll
            for (int i = 0; i < 4; ++i) s += (v[i][0] * v[i][0] + v[i][1] * v[i][1]) + (v[i][2] * v[i][2] + v[i][3] * v[i][3]);
            if (l + 1 < NLAYER) {
                s = group_sum<64>(s); const float rstd = rsqrtf(s * (1.f / DM) + 1e-6f); bf16* hrow = H + (size_t)row * DM + 8 * lane;
#pragma unroll
                for (int j = 0; j < 2; ++j) { const f32x4 h0 = v[2 * j] * rstd * gg[2 * j] + sb[2 * j], h1 = v[2 * j + 1] * rstd * gg[2 * j + 1] + sb[2 * j + 1]; u32x4 o;
                    if (INPROJ_FP8) { u32x2 o8; o8.x = pk4_fp8(h0[0], h0[1], h0[2], h0[3]); o8.y = pk4_fp8(h1[0], h1[1], h1[2], h1[3]); *(u32x2*)((unsigned char*)H + (size_t)row * DM + 8 * lane + 512 * j) = o8; }
                    else { o.x = pk2(h0[0], h0[1]); o.y = pk2(h0[2], h0[3]); o.z = pk2(h1[0], h1[1]); o.w = pk2(h1[2], h1[3]); *(u32x4*)(hrow + 512 * j) = o; } }
            }
        }
    }
}
constexpr int PH_PER_LAYER = 11, PH_BASE = 2, N_PHASES = PH_BASE + NLAYER * PH_PER_LAYER;
#ifndef MK_ONE_LAUNCH
#define MK_ONE_LAUNCH 1
#endif
__global__ void __launch_bounds__(NTHR, 2) mk_fwd(Args args) {
    extern __shared__ __attribute__((aligned(16))) unsigned char lds_raw[];
    Ctx C;
    C.lds = (LAS unsigned char*)lds_raw; C.tid = threadIdx.x; C.lane = C.tid & 63; C.wave = __builtin_amdgcn_readfirstlane(C.tid >> 6); C.G = gridDim.x; C.bid = blockIdx.x;
    C.x = (const float*)args.in[0]; C.c = (const float*)args.in[1]; C.pos = (const int*)args.in[2]; C.w_ada = (const float*)args.in[3]; C.b_ada = (const float*)args.in[4];
    C.norm1_g = (const float*)args.in[5]; C.norm2_g = (const float*)args.in[6]; C.w_in = (const float*)args.in[7]; C.w_out = (const float*)args.in[8]; C.mu = (const float*)args.in[9];
    C.w0 = (const float*)args.in[10]; C.w2 = (const float*)args.in[11]; C.a0 = (const float*)args.in[12]; C.a2 = (const float*)args.in[13]; C.g2 = (const float*)args.in[14];
    C.kkw = (const float*)args.in[15]; C.ka = (const float*)args.in[16]; C.rk = (const float*)args.in[17]; C.gn_w = (const float*)args.in[18]; C.gn_b = (const float*)args.in[19];
    C.conv_w = (const float*)args.in[20]; C.dil_q_g = (const float*)args.in[21]; C.dil_k_g = (const float*)args.in[22]; C.nsa_q_g = (const float*)args.in[23]; C.nsa_kc_g = (const float*)args.in[24];
    C.nsa_ks_g = (const float*)args.in[25]; C.nsa_kw_g = (const float*)args.in[26]; C.pe_k = (const float*)args.in[27]; C.pe_v = (const float*)args.in[28]; C.wk1 = (const float*)args.in[29];
    C.wk2 = (const float*)args.in[30]; C.wv1 = (const float*)args.in[31]; C.wv2 = (const float*)args.in[32]; C.onorm_g = (const float*)args.in[33]; C.w_router = (const float*)args.in[34];
    C.b_router = (const float*)args.in[35]; C.w_gu = (const float*)args.in[36]; C.b_gu = (const float*)args.in[37]; C.w_down = (const float*)args.in[38]; C.b_down = (const float*)args.in[39];
    C.out = args.out; C.ws = args.ws;
    const int lo = args.ph_lo, hi = args.ph_hi;
    for (int u = C.tid; u < (LDS_BYTES - MISC_OFF) / 4; u += NTHR) ((LAS unsigned*)(C.lds + MISC_OFF))[u] = 0u;
    __syncthreads();
    XcdBarrier bar; bar.bar = WSP(unsigned, WS_CTL) + CW_BAR; bar.x = 0; bar.st = nullptr;
    if (hi - lo > 1) bar = xcd_barrier_post(WSP(unsigned, WS_CTL) + CW_BAR, (volatile LAS unsigned*)(C.lds + MISC_OFF));
#ifndef PHMASK
#define PHMASK 0xFFFFFFFFu
#endif
#define PHON(n) (((PHMASK) >> (n)) & 1u)
#ifndef PHREP
#define PHREP 0u
#endif
#define NREP(n) (1 + (int)(((PHREP) >> (n)) & 1u))
#define WSPP(T, off) ((T*)(P.ws + (off)))
#define IN(k) (lo <= (k) && (k) < hi)
#define SEAM(k) do { if (IN(k) && IN((k) + 1)) xcd_barrier(bar); } while (0)
#define PCTX Ctx P = C; asm volatile("" : "+v"(P.tid), "+v"(P.lane)); asm volatile("" : "+s"(P.ws), "+s"(P.out), "+s"(P.wave), "+s"(P.bid))
    if (PHON(17) && IN(0)) for (int rep = 0; rep < NREP(17); ++rep) { PCTX; p0_prologue(P); __syncthreads(); }
    SEAM(0);
#ifndef PROBE_BARS
#define PROBE_BARS 0
#endif
    if (hi - lo > 1) for (int i = 0; i < PROBE_BARS; ++i) xcd_barrier(bar);
    if (PHON(18) && IN(1)) { PCTX; norm1_phase(P, 0, P.x); }
    SEAM(1);
    for (int l = 0; l < NLAYER; ++l) {
        const int pb = PH_BASE + PH_PER_LAYER * l;
        if (PHON(0) && IN(pb + 0)) for (int rep = 0; rep < NREP(0); ++rep) { PCTX;
            pg8::StaticOrder S; S.init(NT / 256, NPJ / 256, P.G, P.bid);
            if (INPROJ_FP8) { pg8::Gemm g{WSPP(bf16, WS_H), WSPP(bf16, WS_WIN) + (size_t)l * NPJ * 512, 512, 512, WSPP(int, WS_ROUTE) + NT * 12 + NR, 0x3FFFF}; EpiProj E{WSPP(bf16, R_PROJ), W8_INV}; pg8::gemm_phase<EpiProj, pg8::StaticOrder, true, true>(P.lds, P.tid, g, S, E); }
            else { pg8::Gemm g{WSPP(bf16, WS_H), WSPP(bf16, WS_WIN) + (size_t)l * NPJ * 1024, 1024, 1024}; EpiProj E{WSPP(bf16, R_PROJ), 1.f}; pg8::gemm_phase(P.lds, P.tid, g, S, E); }
        }
        SEAM(pb + 0);
        if (PHON(1) && IN(pb + 1)) for (int rep = 0; rep < NREP(1); ++rep) { PCTX; prep_phase(P, l); __syncthreads(); }
        SEAM(pb + 1);
        if (PHON(2) && IN(pb + 2)) for (int rep = 0; rep < NREP(2); ++rep) { PCTX;
            { pg8::Gemm g{WSPP(bf16, R_LIN), WSPP(bf16, WS_LORA) + (size_t)l * 768 * 256, 256, 256}; pg8::StaticOrder S; S.init(NT / 256, 3, P.G, P.bid);
              EpiLora E{WSPP(float, R_SC), WSPP(bf16, R_SCH), WSPP(bf16, R_G), P.w0 + l * 256, P.a0 + l * 256, P.ka + l * 256, (rep + 1 < NREP(2)) ? WSPP(bf16, WS_END) : WSPP(bf16, R_SCH), (rep + 1 < NREP(2)) ? WSPP(float, WS_END) + 64 * MiB : WSPP(float, R_SC)}; pg8::gemm_phase(P.lds, P.tid, g, S, E); }
        }
        SEAM(pb + 2);
        if (PHON(3) && IN(pb + 3)) for (int rep = 0; rep < NREP(3); ++rep) { PCTX; mix_phase(P, l, rep); }
        SEAM(pb + 3);
        if (PHON(4) && IN(pb + 4)) for (int rep = 0; rep < NREP(4); ++rep) { PCTX; fin_phase(P, l); __syncthreads(); }
        SEAM(pb + 4);
        if (PHON(5) && IN(pb + 5)) for (int rep = 0; rep < NREP(5); ++rep) { PCTX;
            pg8::Gemm g{WSPP(bf16, R_YCAT), WSPP(bf16, WS_WOUT) + (size_t)l * 1024 * 1024, 1024, 1024}; pg8::StaticOrder S; S.init(NT / 256, 4, P.G, P.bid);
            EpiOut E{(rep + 1 < NREP(5)) ? WSPP(float, WS_END) : P.out, l == 0 ? P.x : (const float*)P.out, WSPP(float, WS_SMALL) + (size_t)l * 8 * 6144 + 2048}; pg8::gemm_phase(P.lds, P.tid, g, S, E);
        }
        SEAM(pb + 5);
        if (PHON(6) && IN(pb + 6)) for (int rep = 0; rep < NREP(6); ++rep) { PCTX; router_phase(P, l); __syncthreads(); }
        SEAM(pb + 6);
        if (PHON(7) && IN(pb + 7)) for (int rep = 0; rep < NREP(7); ++rep) { PCTX; scatter_phase(P, l); __syncthreads(); }
        SEAM(pb + 7);
        if (PHON(8) && IN(pb + 8)) for (int rep = 0; rep < NREP(8); ++rep) { PCTX;
            LAS int* tab = (LAS int*)(P.lds + MISC_OFF + 64); moe_tables(P, l, tab);
            pg8::Gemm g{WSPP(bf16, R_XS), WSPP(bf16, WS_WGU) + (size_t)l * 32 * 2048 * 512, 512, 512, WSPP(int, WS_ROUTE) + NT * 12, 32767};
            pg8::GroupedOrder S; S.init(tab[32], 8, P.G, P.bid); S.tstart = tab; S.nrow_e = 2048;
            EpiGU8 E{WSPP(unsigned char, R_ACT), P.b_gu + (size_t)l * 32 * 2048}; pg8::gemm_phase<EpiGU8, pg8::GroupedOrder, true, true>(P.lds, P.tid, g, S, E);
        }
        SEAM(pb + 8);
        if (PHON(9) && IN(pb + 9)) for (int rep = 0; rep < NREP(9); ++rep) { PCTX;
            LAS int* tab = (LAS int*)(P.lds + MISC_OFF + 64); moe_tables(P, l, tab);
            pg8::Gemm g{WSPP(bf16, R_ACT), WSPP(bf16, WS_WDN) + (size_t)l * 32 * 1024 * 512, 512, 512, WSPP(int, WS_ROUTE) + NT * 12 + NR, 0x3FFFF}; pg8::GroupedOrder S; S.init(tab[32], 4, P.G, P.bid); S.tstart = tab; S.nrow_e = 1024;
            EpiDN8 E{WSPP(bf16, R_YB), P.b_down + (size_t)l * 32 * 1024}; pg8::gemm_phase<EpiDN8, pg8::GroupedOrder, true, true>(P.lds, P.tid, g, S, E);
        }
        SEAM(pb + 9);
        if (PHON(10) && IN(pb + 10)) for (int rep = 0; rep < NREP(10); ++rep) { PCTX; combine_phase(P, l, (rep + 1 < NREP(10)) ? WSPP(float, WS_END) : P.out); __syncthreads(); }
        SEAM(pb + 10);
    }
#undef IN
#undef SEAM
}

extern "C" void kernel_launch(void* const* d_in, const int* in_sizes, int n_in, void* d_out, int out_size, void* d_ws, size_t ws_size, hipStream_t stream) {
    static int grid = 0;
    if (grid == 0) {
        if (n_in != 40 || out_size != NT * DM || ws_size < WS_END + 256 * MiB) { fprintf(stderr, "kernel_launch: unexpected problem (n_in %d, out %d, ws %zu < %zu)\n", n_in, out_size, ws_size, (size_t)WS_END); grid = -1; return; }
        int dev = 0, cus = 0, per_cu = 0;
        if (hipGetDevice(&dev) != hipSuccess || hipDeviceGetAttribute(&cus, hipDeviceAttributeMultiprocessorCount, dev) != hipSuccess) { grid = -1; return; }
        if (hipFuncSetAttribute((const void*)mk_fwd, hipFuncAttributeMaxDynamicSharedMemorySize, LDS_BYTES) != hipSuccess) { fprintf(stderr, "kernel_launch: hipFuncSetAttribute failed\n"); grid = -1; return; }
        if (hipOccupancyMaxActiveBlocksPerMultiprocessor(&per_cu, (const void*)mk_fwd, NTHR, LDS_BYTES) != hipSuccess || per_cu < 1) fprintf(stderr, "kernel_launch: occupancy query says %d blocks per CU\n", per_cu);
        (void)hipGetLastError();
        grid = cus > 256 ? 256 : cus;
    }
    if (grid < 0) return;
    (void)hipMemsetAsync((char*)d_ws, 0, ZERO_BYTES, stream);
    Args a{};
    for (int i = 0; i < 40; ++i) a.in[i] = d_in[i];
    a.out = (float*)d_out; a.ws = (unsigned char*)d_ws;
#if MK_ONE_LAUNCH
    a.ph_lo = 0; a.ph_hi = N_PHASES;
    hipLaunchKernelGGL(mk_fwd, dim3(grid), dim3(NTHR), LDS_BYTES, stream, a);
#else
    for (int p = 0; p < N_PHASES; ++p) { a.ph_lo = p; a.ph_hi = p + 1; hipLaunchKernelGGL(mk_fwd, dim3(grid), dim3(NTHR), LDS_BYTES, stream, a); }
#endif
    const hipError_t le = hipPeekAtLastError();
    if (le != hipSuccess) fprintf(stderr, "kernel_launch: launch failed: %s\n", hipGetErrorName(le));
}
```

```cpp
#include <hip/hip_runtime.h>
#include <cstdio>
#include <cstdint>

#define DI __device__ __forceinline__
#define LAS __attribute__((address_space(3)))
#define GAS __attribute__((address_space(1)))
typedef unsigned short bf16;
typedef short bf16x8 __attribute__((ext_vector_type(8)));
typedef float f32x4 __attribute__((ext_vector_type(4)));
typedef float f32x2 __attribute__((ext_vector_type(2)));
typedef unsigned u32x4 __attribute__((ext_vector_type(4)));
typedef unsigned u32x2 __attribute__((ext_vector_type(2)));
typedef unsigned char uchar;

#ifndef PROBE_SCAN2
#define PROBE_SCAN2 0
#endif
#ifndef PROBE_ATT2
#define PROBE_ATT2 0
#endif
#ifndef PROBE_CONV2
#define PROBE_CONV2 0
#endif
#ifndef INPROJ_FP8
#define INPROJ_FP8 0
#endif
constexpr int NB = 8, NS = 4096, NT = NB * NS, DM = 1024, NPJ = 3328, NE = 32, FF = 1024, NLAYER = 2;
constexpr int PJ_A = 0, PJ_B = 1024, PJ_C = 1792, PJ_D = 2560;
constexpr int NR = NT * 4 + NE * 256;
constexpr int NTHR = 512, NWAVE = 8;

DI float bf2f(unsigned v) { return __builtin_bit_cast(float, v << 16); }
DI unsigned f2bf(float f) { unsigned u = __builtin_bit_cast(unsigned, f); return (u + 0x7fffu + ((u >> 16) & 1u)) >> 16; }
DI unsigned pk2(float lo, float hi) { return f2bf(lo) | (f2bf(hi) << 16); }
DI float bflo(unsigned w) { return __builtin_bit_cast(float, w << 16); }
DI float bfhi(unsigned w) { return __builtin_bit_cast(float, w & 0xffff0000u); }
DI float fexp2(float x) { return __builtin_amdgcn_exp2f(x); }
DI float fsigmoid(float x) { return __builtin_amdgcn_rcpf(1.f + __builtin_amdgcn_exp2f(-1.44269504089f * x)); }
DI float wsum_xor(float v, int o) { return v + __shfl_xor(v, o); }
template <int CTRL> DI float dppmov(float x) { return __builtin_bit_cast(float, __builtin_amdgcn_update_dpp(0, __builtin_bit_cast(int, x), CTRL, 0xF, 0xF, true)); }
template <int W> DI float group_sum(float v) {
    if (W >= 2) v += dppmov<0xB1>(v);
    if (W >= 4) v += dppmov<0x4E>(v);
    if (W >= 8) v += dppmov<0x141>(v);
    if (W >= 16) v += dppmov<0x140>(v);
    if (W >= 32) v += __shfl_xor(v, 16);
    if (W >= 64) v += __shfl_xor(v, 32);
    return v;
}
DI float sum8(float x) { x += dppmov<0xB1>(x); x += dppmov<0x4E>(x); x += dppmov<0x141>(x); return x; }

#define XB_TMO      128
#define XB_XCNT(j)  (256  + 64 * (j))
#define XB_XSUB(j)  (1280 + 64 * (j))
#define XB_XGEN(j)  (2304 + 64 * (j))
#define XB_TOP      3328
#define XB_TOPGEN   3392
#define XCD_BAR_WORDS 3456
#define XB_SPIN_CAP (1u << 18)
DI unsigned xb_ld(unsigned* p)              { return __hip_atomic_load(p, __ATOMIC_RELAXED, __HIP_MEMORY_SCOPE_AGENT); }
DI unsigned xb_add(unsigned* p, unsigned v) { return __hip_atomic_fetch_add(p, v, __ATOMIC_RELAXED, __HIP_MEMORY_SCOPE_AGENT); }
DI unsigned xb_xcc_id() { return (unsigned)__builtin_amdgcn_s_getreg((3 << 11) | 20) & 0xFu; }
#define XB_SPIN(cond, bar) do { unsigned _sp = 0; while (cond) { __builtin_amdgcn_s_sleep(1); \
    if ((++_sp & 255u) == 0u) { if (xb_ld(&(bar)[XB_TMO])) break; if (_sp > XB_SPIN_CAP) { atomicAdd(&(bar)[XB_TMO], 1u); break; } } } } while (0)
struct XcdBarrier { unsigned* bar; unsigned x; volatile LAS unsigned* st; };
DI XcdBarrier xcd_barrier_post(unsigned* bar, volatile LAS unsigned* st) {
    XcdBarrier b; b.bar = bar; b.x = xb_xcc_id(); b.st = st;
    if (threadIdx.x == 0) (void)xb_add(&bar[XB_XCNT(b.x)], 1u);
    return b;
}
DI void xcd_barrier_complete(unsigned* bar, unsigned x, unsigned& nloc, unsigned& nx) {
    const unsigned G = gridDim.x * gridDim.y * gridDim.z;
    unsigned sum, cnt, mine, sp = 0u;
    for (;;) {
        sum = 0u; cnt = 0u; mine = 0u;
#pragma unroll
        for (unsigned j = 0; j < 16; ++j) { const unsigned c = xb_ld(&bar[XB_XCNT(j)]); sum += c; cnt += (c > 0u) ? 1u : 0u; mine = (j == x) ? c : mine; }
        if (sum == G) break;
        __builtin_amdgcn_s_sleep(1);
        if ((++sp & 255u) == 0u) { if (xb_ld(&bar[XB_TMO])) break; if (sp > XB_SPIN_CAP) { atomicAdd(&bar[XB_TMO], 1u); break; } }
    }
    nloc = mine > 0u ? mine : 1u; nx = cnt > 0u ? cnt : 1u;
}
DI void xcd_barrier(const XcdBarrier& b) {
    asm volatile("s_waitcnt vmcnt(0)" ::: "memory");
    __syncthreads();
    if (threadIdx.x == 0) {
        unsigned* bar = b.bar;
        __builtin_amdgcn_s_waitcnt(0);
        unsigned nloc = b.st[0], nx = b.st[1];
        if (nloc == 0u) { xcd_barrier_complete(bar, b.x, nloc, nx); b.st[0] = nloc; b.st[1] = nx; }
        const unsigned old = xb_add(&bar[XB_XSUB(b.x)], 1u);
        const unsigned gen = old / nloc;
        if (old + 1u == (gen + 1u) * nloc) {
            __builtin_amdgcn_fence(__ATOMIC_RELEASE, "agent");
            asm volatile("s_waitcnt vmcnt(0)" ::: "memory");
            const unsigned og = xb_add(&bar[XB_TOP], 1u);
            const unsigned tg = og / nx;
            if (og + 1u == (tg + 1u) * nx) xb_add(&bar[XB_TOPGEN], 1u);
            else XB_SPIN(xb_ld(&bar[XB_TOPGEN]) == tg, bar);
            __builtin_amdgcn_fence(__ATOMIC_ACQUIRE, "agent");
            xb_add(&bar[XB_XGEN(b.x)], 1u);
            asm volatile("s_waitcnt vmcnt(0)" ::: "memory");
        } else {
            XB_SPIN(xb_ld(&bar[XB_XGEN(b.x)]) == gen, bar);
            __builtin_amdgcn_fence(__ATOMIC_ACQUIRE, "agent");
            asm volatile("s_waitcnt vmcnt(0)" ::: "memory");
        }
    }
    __syncthreads();
}
namespace pg8 {
constexpr int BM = 256, BK = 64, HALF = 128, HTB = HALF * BK * 2, STAGE_BYTES = 8 * HTB, NXCD = 8, WGM = 8;
__host__ __device__ __forceinline__ int lds_byte(int r, int c) { const int st = (r >> 4) * 2 + (c >> 5), rr = r & 15, cc = c & 31, ob = rr * 64 + cc * 2; return st * 1024 + (ob ^ (((ob >> 9) & 1) << 5)); }
__host__ __device__ __forceinline__ void stage_rc(int b, int& R, int& C) { const int st = b / 1024, sb = b % 1024, swz = sb ^ (((sb >> 9) & 1) << 5); R = (st >> 1) * 16 + swz / 64; C = (st & 1) * 32 + (swz % 64) / 2; }
__host__ __device__ __forceinline__ int perm32(int rho) { const int n = rho >> 4, i = rho & 15; return 8 * (i >> 2) + 4 * n + (i & 3); }

struct Unit { int pm, pn, brow, e; };
struct Gemm { const bf16* A; const bf16* Bt; int lda, K; const int* rowmap; int rowmask; };

struct StaticOrder {
    int nM, nN, nwg, G, c;
    __device__ void init(int nM_, int nN_, int G_, int c_) { nM = nM_; nN = nN_; nwg = nM * nN; G = G_; c = c_; }
    __device__ bool tile(int i, int& pm, int& pn) const {
        const long L = (long)i * G + c; if (L >= nwg) return false;
        int wgid = (int)L; { const int q = nwg / NXCD, r = nwg % NXCD, xcd = wgid % NXCD, off = wgid / NXCD; wgid = (xcd < r ? xcd * (q + 1) : r * (q + 1) + (xcd - r) * q) + off; }
        const int nig = WGM * nN, gid = wgid / nig, fm = gid * WGM, gsz = (nM - fm) < WGM ? (nM - fm) : WGM;
        pm = fm + ((wgid % nig) % gsz); pn = (wgid % nig) / gsz; return true;
    }
    __device__ bool next(int i, Unit& u) const { if (!tile(i, u.pm, u.pn)) return false; u.brow = u.pn * BM; u.e = 0; return true; }
};
struct GroupedOrder : StaticOrder {
    const LAS int* tstart; int nrow_e;
    __device__ bool next(int i, Unit& u) const {
        if (!tile(i, u.pm, u.pn)) return false;
        int e = 0;
#pragma unroll 1
        for (int j = 16; j > 0; j >>= 1) if (tstart[e + j] <= u.pm) e += j;
        u.e = e; u.brow = e * nrow_e + u.pn * BM; return true;
    }
};
DI unsigned cvt_pk_bf16(float lo, float hi) { unsigned r; asm volatile("v_cvt_pk_bf16_f32 %0, %1, %2" : "=v"(r) : "v"(lo), "v"(hi)); return r; }

template <class Epi, class Sched, bool GATHER = false, bool FP8 = false>
DI void gemm_phase(LAS unsigned char* lds, const int tid, const Gemm g, const Sched& S, const Epi& E) {
    const int wid = __builtin_amdgcn_readfirstlane(tid >> 6), lane = tid & 63, wr = wid >> 2, wc = wid & 3, fr = lane & 15, fq = lane >> 4;
    int K = g.K, lda = g.lda; asm volatile("" : "+s"(K), "+s"(lda));
    const int nt = K / BK;
    unsigned voffA[2], voffB[2]; int Ra[2], Ca[2];
#pragma unroll
    for (int i = 0; i < 2; ++i) { int R, C; stage_rc(tid * 16 + i * 8192, R, C); const int Rb = Epi::PERM ? ((R & ~31) + perm32(R & 31)) : R; Ra[i] = R; Ca[i] = C;
        voffA[i] = (unsigned)(R * lda + C) * 2u; voffB[i] = (unsigned)(Rb * K + C) * 2u; }
    unsigned vgc[2][2]; int rawn[2][2];
#define PG8_GLOAD(dst, pm_) do { _Pragma("unroll") for (int _h = 0; _h < 2; ++_h) _Pragma("unroll") for (int _i = 0; _i < 2; ++_i) { const int* _p = g.rowmap + (size_t)(pm_) * BM + _h * HALF + Ra[_i]; \
        asm volatile("global_load_dword %0, %1, off" : "=v"(dst[_h][_i]) : "v"(_p) : "memory"); } } while (0)
#define PG8_GCONV(vg, raw) do { _Pragma("unroll") for (int _h = 0; _h < 2; ++_h) _Pragma("unroll") for (int _i = 0; _i < 2; ++_i) { int _r = raw[_h][_i]; asm volatile("" : "+v"(_r)); \
        vg[_h][_i] = (unsigned)((_r & g.rowmask) * lda + Ca[_i]) * 2u; } } while (0)
#define PG8_STAGE_A(bufoff, kptr, h, vg) do { if (GATHER) PG8_STAGE(bufoff, kptr, vg[h]); else PG8_STAGE(bufoff, (kptr) + (h) * hstepA, voffA); } while (0)
    const size_t kstep = (size_t)(BK * 2);
    const size_t hstepA = (size_t)HALF * lda * 2, hstepB = (size_t)HALF * K * 2;
    const size_t tstepA = 2 * hstepA;
    const unsigned ldsw = (unsigned)wid * 1024u;
    const int aoff = lds_byte(wr * 64 + fr, fq * 8), boff = lds_byte(wc * 32 + fr, fq * 8);
#define PG8_SA(b, h) (((b) * 2 + (h)) * HTB)
#define PG8_SB(b, h) ((4 + (b) * 2 + (h)) * HTB)
#define PG8_STAGE(bufoff, gbase, voff) do { _Pragma("unroll") for (int _i = 0; _i < 2; ++_i) \
        __builtin_amdgcn_global_load_lds((const unsigned*)((const char*)(gbase) + (voff)[_i]), (LAS unsigned*)(lds + (bufoff) + ldsw + _i * 8192), 16, 0, 0); } while (0)
#define PG8_LDA(dst, b, h) do { _Pragma("unroll") for (int m = 0; m < 4; ++m) { const v4i_ lo_ = *(const LAS v4i_*)(lds + PG8_SA(b, h) + aoff + m * 2048), hi_ = *(const LAS v4i_*)(lds + PG8_SA(b, h) + aoff + m * 2048 + 1024); \
        dst[m] = __builtin_shufflevector(lo_, hi_, 0, 1, 2, 3, 4, 5, 6, 7); } } while (0)
#define PG8_LDB(dst, b, h) do { _Pragma("unroll") for (int n = 0; n < 2; ++n) { const v4i_ lo_ = *(const LAS v4i_*)(lds + PG8_SB(b, h) + boff + n * 2048), hi_ = *(const LAS v4i_*)(lds + PG8_SB(b, h) + boff + n * 2048 + 1024); \
        dst[n] = __builtin_shufflevector(lo_, hi_, 0, 1, 2, 3, 4, 5, 6, 7); } } while (0)
#define PG8_MMA(ai, bj, At, Bt) do { __builtin_amdgcn_s_setprio(1); _Pragma("unroll") for (int m = 0; m < 4; ++m) _Pragma("unroll") for (int n = 0; n < 2; ++n) { \
        if (FP8) acc[ai][bj][m][n] = __builtin_amdgcn_mfma_scale_f32_16x16x128_f8f6f4(Bt[n], At[m], acc[ai][bj][m][n], 0, 0, 0, 0x7F7F7F7F, 0, 0x7F7F7F7F); \
        else { const v8i_ b_ = Bt[n], a_ = At[m]; \
            acc[ai][bj][m][n] = __builtin_amdgcn_mfma_f32_16x16x32_bf16(__builtin_bit_cast(bf16x8, __builtin_shufflevector(b_, b_, 0, 1, 2, 3)), __builtin_bit_cast(bf16x8, __builtin_shufflevector(a_, a_, 0, 1, 2, 3)), acc[ai][bj][m][n], 0, 0, 0); \
            acc[ai][bj][m][n] = __builtin_amdgcn_mfma_f32_16x16x32_bf16(__builtin_bit_cast(bf16x8, __builtin_shufflevector(b_, b_, 4, 5, 6, 7)), __builtin_bit_cast(bf16x8, __builtin_shufflevector(a_, a_, 4, 5, 6, 7)), acc[ai][bj][m][n], 0, 0, 0); } } \
        __builtin_amdgcn_s_setprio(0); } while (0)
#define PG8_WAIT_V(n) asm volatile("s_waitcnt vmcnt(" #n ")" ::: "memory")
#define PG8_WAIT_L(n) asm volatile("s_waitcnt lgkmcnt(" #n ")" ::: "memory")
#define PG8_BAR __builtin_amdgcn_s_barrier()
#define PG8_SCHED __builtin_amdgcn_sched_barrier(0)
    Unit cur, nxt; int ui = 0;
    if (!S.next(0, cur)) return;
    f32x4 acc[2][2][4][2];
#pragma unroll
    for (int a = 0; a < 2; ++a)
#pragma unroll
        for (int b = 0; b < 2; ++b)
#pragma unroll
            for (int m = 0; m < 4; ++m)
#pragma unroll
                for (int n = 0; n < 2; ++n) acc[a][b][m][n] = (f32x4){0.f, 0.f, 0.f, 0.f};
    typedef int v8i_ __attribute__((ext_vector_type(8))); typedef int v4i_ __attribute__((ext_vector_type(4)));
    v8i_ At[4], B0[2], B1[2];
    const char* cA = (const char*)g.A + (GATHER ? (size_t)0 : (size_t)cur.pm * tstepA); const char* cB = (const char*)g.Bt + (size_t)cur.brow * K * 2;
    if (GATHER) { PG8_GLOAD(rawn, cur.pm); asm volatile("s_waitcnt vmcnt(0)" : "+v"(rawn[0][0]), "+v"(rawn[0][1]), "+v"(rawn[1][0]), "+v"(rawn[1][1]) :: "memory"); PG8_GCONV(vgc, rawn); }
    PG8_STAGE(PG8_SB(0, 0), cB, voffB); PG8_STAGE(PG8_SB(0, 1), cB + hstepB, voffB); PG8_STAGE_A(PG8_SA(0, 0), cA, 0, vgc); PG8_STAGE_A(PG8_SA(0, 1), cA, 1, vgc);
    if (wr == 1) PG8_BAR;
    PG8_WAIT_V(2); PG8_BAR;
    PG8_STAGE(PG8_SB(1, 0), cB + kstep, voffB); PG8_STAGE_A(PG8_SA(1, 0), cA + kstep, 0, vgc); PG8_STAGE(PG8_SB(1, 1), cB + hstepB + kstep, voffB);
    PG8_WAIT_V(6); PG8_BAR;
    for (;;) {
        const bool has_next = S.next(ui + 1, nxt);
        const char* nA = (has_next && !GATHER) ? (const char*)g.A + (size_t)nxt.pm * tstepA : cA;
        if (GATHER && has_next) PG8_GLOAD(rawn, nxt.pm); const char* nB = has_next ? (const char*)g.Bt + (size_t)nxt.brow * K * 2 : cB;
#pragma unroll 1
        for (int t = 0; t < nt; t += 2) {
            const bool last = (t == nt - 2);
            const char* a1 = cA + (size_t)(t + 1) * kstep;
            const char* a2 = last ? nA : cA + (size_t)(t + 2) * kstep; const char* b2 = last ? nB : cB + (size_t)(t + 2) * kstep;
            const char* a3 = a2 + kstep; const char* b3 = b2 + kstep;
            PG8_LDB(B0, 0, 0); PG8_LDB(B1, 0, 1); PG8_SCHED; PG8_LDA(At, 0, 0); PG8_STAGE_A(PG8_SA(1, 1), a1, 1, vgc);
            if (GATHER) { if (last && has_next) PG8_GCONV(vgc, rawn); }
            PG8_WAIT_V(8); PG8_WAIT_L(0); PG8_BAR; PG8_MMA(0, 0, At, B0); PG8_MMA(0, 1, At, B1); PG8_BAR; PG8_SCHED;
            PG8_LDA(At, 0, 1); PG8_STAGE(PG8_SB(0, 0), b2, voffB); PG8_STAGE(PG8_SB(0, 1), b2 + hstepB, voffB); PG8_STAGE_A(PG8_SA(0, 0), a2, 0, vgc);
            PG8_WAIT_V(8); PG8_WAIT_L(0); PG8_BAR; PG8_MMA(1, 0, At, B0); PG8_MMA(1, 1, At, B1); PG8_BAR; PG8_SCHED;
            PG8_LDB(B0, 1, 0); PG8_LDB(B1, 1, 1); PG8_SCHED; PG8_LDA(At, 1, 0); PG8_STAGE_A(PG8_SA(0, 1), a2, 1, vgc);
            PG8_WAIT_V(8); PG8_WAIT_L(0); PG8_BAR; PG8_MMA(0, 0, At, B0); PG8_MMA(0, 1, At, B1); PG8_BAR; PG8_SCHED;
            PG8_LDA(At, 1, 1); PG8_STAGE(PG8_SB(1, 0), b3, voffB); PG8_STAGE(PG8_SB(1, 1), b3 + hstepB, voffB); PG8_STAGE_A(PG8_SA(1, 0), a3, 0, vgc);
            PG8_WAIT_V(8); PG8_WAIT_L(0); PG8_BAR; PG8_MMA(1, 0, At, B0); PG8_MMA(1, 1, At, B1); PG8_BAR; PG8_SCHED;
        }
        if (wr == 0) PG8_BAR;
        { int fr2 = fr, fq2 = fq; asm volatile("" : "+v"(fr2), "+v"(fq2)); E(acc, cur, wr, wc, fr2, fq2); }
        if (!has_next) break;
#pragma unroll
        for (int a = 0; a < 2; ++a)
#pragma unroll
            for (int b = 0; b < 2; ++b)
#pragma unroll
                for (int m = 0; m < 4; ++m)
#pragma unroll
                    for (int n = 0; n < 2; ++n) acc[a][b][m][n] = (f32x4){0.f, 0.f, 0.f, 0.f};
        cur = nxt; cA = nA; cB = nB; ++ui;
        if (wr == 1) PG8_BAR;
    }
    PG8_WAIT_V(0);
    PG8_BAR;
#undef PG8_SA
#undef PG8_SB
#undef PG8_STAGE
#undef PG8_STAGE_A
#undef PG8_GLOAD
#undef PG8_GCONV
#undef PG8_LDA
#undef PG8_LDB
#undef PG8_MMA
#undef PG8_WAIT_V
#undef PG8_WAIT_L
#undef PG8_BAR
#undef PG8_SCHED
}
}
constexpr size_t MiB = 1u << 20;
constexpr size_t WS_CTL = 0;
constexpr size_t WS_LORA = 1 * MiB;
constexpr size_t WS_WK2 = 2 * MiB;
constexpr size_t ZERO_BYTES = 3 * MiB;
constexpr size_t WS_WIN = 3 * MiB;
constexpr size_t WS_WOUT = 17 * MiB;
constexpr size_t WS_WK1 = 21 * MiB;
constexpr size_t WS_SMALL = 25 * MiB;
constexpr size_t WS_ROUTE = 27 * MiB;
constexpr size_t WS_WGU = 32 * MiB;
constexpr size_t WS_WDN = 288 * MiB;
constexpr size_t WS_H = 416 * MiB;
constexpr size_t WS_R = 480 * MiB;
constexpr size_t R_PROJ = WS_R;
constexpr size_t R_SC = R_PROJ + 208 * MiB;
constexpr size_t R_SCH = R_SC + 32 * MiB;
constexpr size_t R_LIN = R_SC + 192 * MiB;
constexpr size_t R_G = R_LIN + 16 * MiB;
constexpr size_t R_YA = R_G + 32 * MiB;
constexpr size_t R_YCAT = R_YA + 32 * MiB;
constexpr size_t R_QC = R_YCAT + 64 * MiB;
constexpr size_t R_KC = R_QC + 16 * MiB;
constexpr size_t R_OC = R_KC + 16 * MiB;
constexpr size_t R_LSE = R_OC + 96 * MiB;
constexpr size_t R_QN = R_LSE + 2 * MiB;
constexpr size_t R_QR = R_QN + 16 * MiB;
constexpr size_t R_KCR = R_QR + 16 * MiB;
constexpr size_t R_VCR = R_KCR + 5 * MiB;
constexpr size_t R_KS = R_VCR + 5 * MiB;
constexpr size_t R_KW = R_KS + 4 * MiB;
constexpr size_t R_GATE = R_KW + 4 * MiB;
constexpr size_t R_CH1 = R_GATE + 2 * MiB;
constexpr size_t R_CMP = R_CH1 + 2 * MiB;
constexpr size_t R_OCMP = R_CMP + 1 * MiB;
constexpr size_t R_OSLC = R_OCMP + 32 * MiB;
constexpr size_t R_OSWA = R_OSLC + 32 * MiB;
constexpr size_t R_SCANU = R_OSWA;
constexpr size_t R_SCANS = R_OSWA + 16 * MiB;
constexpr size_t R_IMP = R_OSWA + 32 * MiB;
constexpr size_t R_SELM = R_IMP + 8 * MiB;
constexpr size_t R_MIX_END = R_SELM + 1 * MiB;
constexpr size_t R_XS = WS_R;
constexpr size_t R_ACT = R_XS + 272 * MiB;
constexpr size_t R_YB = R_ACT + 272 * MiB;
constexpr size_t R_MOE_END = R_YB + 272 * MiB;
constexpr size_t WS_END = (R_MIX_END > R_MOE_END ? R_MIX_END : R_MOE_END);
static_assert((size_t)NR * 1024 * 2 <= 272 * MiB, "sorted buffers");
constexpr int CW_BAR = 4096;
constexpr int CW_CNT = 16384;
constexpr int CW_CUR = 16384 + 64;

constexpr int RING_BYTES = 131072;
constexpr int MISC_OFF = RING_BYTES;
constexpr int LDS_BYTES = 155648;

struct Args { const void* in[40]; float* out; unsigned char* ws; int ph_lo, ph_hi; };

struct Ctx {
    LAS unsigned char* lds; int tid, lane, wave, G, bid;
    const float *x, *c, *w_ada, *b_ada, *norm1_g, *norm2_g, *w_in, *w_out, *mu, *w0, *w2, *a0, *a2, *g2, *kkw, *ka, *rk, *gn_w, *gn_b, *conv_w, *dil_q_g, *dil_k_g,
        *nsa_q_g, *nsa_kc_g, *nsa_ks_g, *nsa_kw_g, *pe_k, *pe_v, *wk1, *wk2, *wv1, *wv2, *onorm_g, *w_router, *b_router, *w_gu, *b_gu, *w_down, *b_down;
    const int* pos;
    float* out; unsigned char* ws;
};
#define WSP(T, off) ((T*)(C.ws + (off)))

typedef f32x4 Acc[2][2][4][2];
struct EpiProj {
    static constexpr bool PERM = true; bf16* O; float scale;
    DI void operator()(const Acc& acc, const pg8::Unit& u, int wr, int wc, int fr, int fq) const {
        const int row0 = u.pm * 256 + wr * 64 + fr, col0 = u.pn * 256 + wc * 32 + 8 * fq;
#pragma unroll
        for (int ai = 0; ai < 2; ++ai)
#pragma unroll
            for (int m = 0; m < 4; ++m) { bf16* rowp = O + (size_t)(row0 + ai * 128 + m * 16) * NPJ + col0;
#pragma unroll
                for (int bj = 0; bj < 2; ++bj) { const f32x4 v0 = acc[ai][bj][m][0] * scale, v1 = acc[ai][bj][m][1] * scale; u32x4 w;
                    w.x = pg8::cvt_pk_bf16(v0[0], v0[1]); w.y = pg8::cvt_pk_bf16(v0[2], v0[3]); w.z = pg8::cvt_pk_bf16(v1[0], v1[1]); w.w = pg8::cvt_pk_bf16(v1[2], v1[3]);
                    *(u32x4*)(rowp + bj * 128) = w; } }
    }
};
struct EpiLora {
    static constexpr bool PERM = false; float* Wp; bf16* SCH; bf16* Gb; const float *w0, *a0, *ka; bf16* SCo; float* Wo;
    DI void operator()(const Acc& acc, const pg8::Unit& u, int wr, int wc, int fr, int fq) const {
        const int row0 = u.pm * 256 + wr * 64 + fr, col0 = wc * 32 + 4 * fq;
        if (u.pn == 0) {
#pragma unroll
            for (int bj = 0; bj < 2; ++bj)
#pragma unroll
                for (int n = 0; n < 2; ++n) { const int ch = col0 + bj * 128 + n * 16; const f32x4 b = *(const f32x4*)(w0 + ch);
#pragma unroll
                    for (int ai = 0; ai < 2; ++ai)
#pragma unroll
                        for (int m = 0; m < 4; ++m) { const size_t o = (size_t)(row0 + ai * 128 + m * 16) * 256 + ch; const f32x4 v = acc[ai][bj][m][n] + b; f32x4 r;
#pragma unroll
                            for (int j = 0; j < 4; ++j) r[j] = fexp2(-0.875040829f * fsigmoid(v[j]));
                            *(f32x4*)(Wo + o) = r; } }
        } else if (u.pn == 1) {
#pragma unroll
            for (int bj = 0; bj < 2; ++bj)
#pragma unroll
                for (int n = 0; n < 2; ++n) { const int ch = col0 + bj * 128 + n * 16; const f32x4 b = *(const f32x4*)(a0 + ch), kav = *(const f32x4*)(ka + ch);
#pragma unroll
                    for (int ai = 0; ai < 2; ++ai)
#pragma unroll
                        for (int m = 0; m < 4; ++m) { __builtin_amdgcn_sched_barrier(0); const size_t o = (size_t)(row0 + ai * 128 + m * 16) * 256 + ch; const f32x4 v = acc[ai][bj][m][n] + b;
                            const u32x2 kr = *(const u32x2*)(SCH + o), kn = *(const u32x2*)(SCH + (size_t)NT * 256 + o);
                            const float krf[4] = {bflo(kr.x), bfhi(kr.x), bflo(kr.y), bfhi(kr.y)}, knf[4] = {bflo(kn.x), bfhi(kn.x), bflo(kn.y), bfhi(kn.y)}; float k2[4], bb[4];
#pragma unroll
                            for (int j = 0; j < 4; ++j) { const float a = fsigmoid(v[j]); k2[j] = krf[j] * (1.f + (a - 1.f) * kav[j]); bb[j] = knf[j] * a; }
                            u32x2 o1, o2; o1.x = pk2(k2[0], k2[1]); o1.y = pk2(k2[2], k2[3]); o2.x = pk2(bb[0], bb[1]); o2.y = pk2(bb[2], bb[3]);
                            *(u32x2*)(SCo + o) = o1; *(u32x2*)(SCo + (size_t)2 * NT * 256 + o) = o2; } }
        } else {
#pragma unroll
            for (int bj = 0; bj < 2; ++bj)
#pragma unroll
                for (int n = 0; n < 2; ++n) { const int ch = col0 + bj * 128 + n * 16;
#pragma unroll
                    for (int ai = 0; ai < 2; ++ai)
#pragma unroll
                        for (int m = 0; m < 4; ++m) { const size_t o = (size_t)(row0 + ai * 128 + m * 16) * 256 + ch; const f32x4 v = acc[ai][bj][m][n]; u32x2 w; w.x = pk2(v[0], v[1]); w.y = pk2(v[2], v[3]); *(u32x2*)(Gb + o) = w; } }
        }
    }
};
DI float gelu_tanh(float x) { const float t = 0.7978845608f * (x + 0.044715f * x * x * x); return x * fsigmoid(2.f * t); }
struct EpiC1 {
    static constexpr bool PERM = true; bf16* O; const float* peb;
    DI void operator()(const Acc& acc, const pg8::Unit& u, int wr, int wc, int fr, int fq) const {
        const int row0 = u.pm * 256 + wr * 64 + fr, col0 = wc * 32 + 8 * fq;
#pragma unroll
        for (int bj = 0; bj < 2; ++bj) { const f32x4 b0 = *(const f32x4*)(peb + col0 + bj * 128), b1 = *(const f32x4*)(peb + col0 + bj * 128 + 4);
#pragma unroll
            for (int ai = 0; ai < 2; ++ai)
#pragma unroll
                for (int m = 0; m < 4; ++m) { bf16* p = O + (size_t)(row0 + ai * 128 + m * 16) * 256 + col0 + bj * 128; const f32x4 v0 = acc[ai][bj][m][0] + b0, v1 = acc[ai][bj][m][1] + b1; u32x4 w;
                    w.x = pk2(gelu_tanh(v0[0]), gelu_tanh(v0[1])); w.y = pk2(gelu_tanh(v0[2]), gelu_tanh(v0[3])); w.z = pk2(gelu_tanh(v1[0]), gelu_tanh(v1[1])); w.w = pk2(gelu_tanh(v1[2]), gelu_tanh(v1[3]));
                    *(u32x4*)p = w; } }
    }
};
struct EpiC2 {
    static constexpr bool PERM = false; float* O;
    DI void operator()(const Acc& acc, const pg8::Unit& u, int wr, int wc, int fr, int fq) const {
        if (wc >= 2) return;
        const int row0 = u.pm * 256 + wr * 64 + fr, col0 = wc * 32 + 4 * fq;
#pragma unroll
        for (int ai = 0; ai < 2; ++ai)
#pragma unroll
            for (int m = 0; m < 4; ++m)
#pragma unroll
                for (int n = 0; n < 2; ++n) *(f32x4*)(O + (size_t)(row0 + ai * 128 + m * 16) * 64 + col0 + n * 16) = acc[ai][0][m][n];
    }
};
struct EpiOut {
    static constexpr bool PERM = false; float* O; const float* xin; const float* gt;
    DI void operator()(const Acc& acc, const pg8::Unit& u, int wr, int wc, int fr, int fq) const {
        const int row0 = u.pm * 256 + wr * 64 + fr, col0 = u.pn * 256 + wc * 32 + 4 * fq; const int b = (u.pm * 256) / NS;
#pragma unroll
        for (int bj = 0; bj < 2; ++bj)
#pragma unroll
            for (int n = 0; n < 2; ++n) { const int col = col0 + bj * 128 + n * 16; const f32x4 g = *(const f32x4*)(gt + (size_t)b * 6144 + col);
#pragma unroll
                for (int ai = 0; ai < 2; ++ai)
#pragma unroll
                    for (int m = 0; m < 4; ++m) { const size_t o = (size_t)(row0 + ai * 128 + m * 16) * DM + col; *(f32x4*)(O + o) = *(const f32x4*)(xin + o) + g * acc[ai][bj][m][n]; } }
    }
};
struct EpiGU {
    static constexpr bool PERM = true; bf16* O; const float* bgu;
    DI void operator()(const Acc& acc, const pg8::Unit& u, int wr, int wc, int fr, int fq) const {
        const int row0 = u.pm * 256 + wr * 64 + fr, cc = u.pn * 128 + wc * 32 + 8 * fq; const float* bp = bgu + (size_t)u.e * 2048 + cc;
        const f32x4 g0 = *(const f32x4*)bp, g1 = *(const f32x4*)(bp + 4), u0 = *(const f32x4*)(bp + 1024), u1 = *(const f32x4*)(bp + 1028);
#pragma unroll
        for (int ai = 0; ai < 2; ++ai)
#pragma unroll
            for (int m = 0; m < 4; ++m) { bf16* p = O + (size_t)(row0 + ai * 128 + m * 16) * FF + cc; float r[8];
#pragma unroll
                for (int n = 0; n < 2; ++n) { const f32x4 gv = acc[ai][0][m][n] + (n ? g1 : g0), uv = acc[ai][1][m][n] + (n ? u1 : u0);
#pragma unroll
                    for (int j = 0; j < 4; ++j) { const float ga = fminf(gv[j], 7.f), up = fminf(fmaxf(uv[j], -7.f), 7.f); r[4 * n + j] = ga * fsigmoid(1.702f * ga) * (up + 1.f); } }
                u32x4 w; w.x = pk2(r[0], r[1]); w.y = pk2(r[2], r[3]); w.z = pk2(r[4], r[5]); w.w = pk2(r[6], r[7]); *(u32x4*)p = w; }
    }
};
struct EpiDN {
    static constexpr bool PERM = true; bf16* O; const float* bd;
    DI void operator()(const Acc& acc, const pg8::Unit& u, int wr, int wc, int fr, int fq) const {
        const int row0 = u.pm * 256 + wr * 64 + fr, col0 = u.pn * 256 + wc * 32 + 8 * fq; const float* bp = bd + (size_t)u.e * 1024 + col0;
#pragma unroll
        for (int bj = 0; bj < 2; ++bj) { const f32x4 b0 = *(const f32x4*)(bp + bj * 128), b1 = *(const f32x4*)(bp + bj * 128 + 4);
#pragma unroll
            for (int ai = 0; ai < 2; ++ai)
#pragma unroll
                for (int m = 0; m < 4; ++m) { bf16* p = O + (size_t)(row0 + ai * 128 + m * 16) * DM + col0 + bj * 128; const f32x4 v0 = acc[ai][bj][m][0] + b0, v1 = acc[ai][bj][m][1] + b1; u32x4 w;
                    w.x = pk2(v0[0], v0[1]); w.y = pk2(v0[2], v0[3]); w.z = pk2(v1[0], v1[1]); w.w = pk2(v1[2], v1[3]); *(u32x4*)p = w; } }
    }
};
DI float clamp8(float x) { return fminf(fmaxf(x, -448.f), 448.f); }
DI unsigned pk4_fp8_nc(float a, float b, float c, float d) { unsigned w = 0u; w = __builtin_amdgcn_cvt_pk_fp8_f32(a, b, w, false); w = __builtin_amdgcn_cvt_pk_fp8_f32(c, d, w, true); return w; }
DI unsigned pk4_fp8(float a, float b, float c, float d) { unsigned w = 0u; w = __builtin_amdgcn_cvt_pk_fp8_f32(clamp8(a), clamp8(b), w, false); w = __builtin_amdgcn_cvt_pk_fp8_f32(clamp8(c), clamp8(d), w, true); return w; }
constexpr float W8_SCALE = 32.f, W8_INV = 1.f / 32.f;
struct EpiGU8 {
    static constexpr bool PERM = true; unsigned char* O; const float* bgu;
    DI void operator()(const Acc& acc, const pg8::Unit& u, int wr, int wc, int fr, int fq) const {
        const int row0 = u.pm * 256 + wr * 64 + fr, cc = u.pn * 128 + wc * 32 + 8 * fq; const float* bp = bgu + (size_t)u.e * 2048 + cc;
        const f32x4 g0 = *(const f32x4*)bp, g1 = *(const f32x4*)(bp + 4), u0 = *(const f32x4*)(bp + 1024), u1 = *(const f32x4*)(bp + 1028);
#pragma unroll
        for (int ai = 0; ai < 2; ++ai)
#pragma unroll
            for (int m = 0; m < 4; ++m) { unsigned char* p = O + (size_t)(row0 + ai * 128 + m * 16) * FF + cc; float r[8];
#pragma unroll
                for (int n = 0; n < 2; ++n) { const f32x4 gv = acc[ai][0][m][n] * W8_INV + (n ? g1 : g0), uv = acc[ai][1][m][n] * W8_INV + (n ? u1 : u0);
#pragma unroll
                    for (int j = 0; j < 4; ++j) { const float ga = fminf(gv[j], 7.f), up = __builtin_amdgcn_fmed3f(uv[j], -7.f, 7.f); const float sg = __builtin_amdgcn_rcpf(1.f + __builtin_amdgcn_exp2f(-2.45546695959f * ga)); r[4 * n + j] = (ga * sg) * (up + 1.f); } }
                u32x2 w; w.x = pk4_fp8_nc(r[0], r[1], r[2], r[3]); w.y = pk4_fp8_nc(r[4], r[5], r[6], r[7]); *(u32x2*)p = w; }
    }
};
struct EpiDN8 {
    static constexpr bool PERM = true; bf16* O; const float* bd;
    DI void operator()(const Acc& acc, const pg8::Unit& u, int wr, int wc, int fr, int fq) const {
        const int row0 = u.pm * 256 + wr * 64 + fr, col0 = u.pn * 256 + wc * 32 + 8 * fq; const float* bp = bd + (size_t)u.e * 1024 + col0;
#pragma unroll
        for (int bj = 0; bj < 2; ++bj) { const f32x4 b0 = *(const f32x4*)(bp + bj * 128), b1 = *(const f32x4*)(bp + bj * 128 + 4);
#pragma unroll
            for (int ai = 0; ai < 2; ++ai)
#pragma unroll
                for (int m = 0; m < 4; ++m) { bf16* p = O + (size_t)(row0 + ai * 128 + m * 16) * DM + col0 + bj * 128; const f32x4 v0 = acc[ai][bj][m][0] * W8_INV + b0, v1 = acc[ai][bj][m][1] * W8_INV + b1; u32x4 w;
                    w.x = pk2(v0[0], v0[1]); w.y = pk2(v0[2], v0[3]); w.z = pk2(v1[0], v1[1]); w.w = pk2(v1[2], v1[3]); *(u32x4*)p = w; } }
    }
};
DI void tr_item(const float* src, int ld_src, int scol0, int nvalid, int k0, bf16* dst, int ld_dst, int drow0, int dk0, LAS float* scr, int lane) {
    const int n4 = (lane & 7) * 4, kr = lane >> 3; f32x4 v[8];
#pragma unroll
    for (int i = 0; i < 8; ++i) v[i] = (n4 < nvalid) ? *(const f32x4*)(src + (size_t)(k0 + kr + 8 * i) * ld_src + scol0 + n4) : (f32x4){0.f, 0.f, 0.f, 0.f};
#pragma unroll
    for (int i = 0; i < 8; ++i) { LAS float* s = scr + (kr + 8 * i) * 33 + n4; s[0] = v[i][0]; s[1] = v[i][1]; s[2] = v[i][2]; s[3] = v[i][3]; }
    asm volatile("s_waitcnt lgkmcnt(0)" ::: "memory");
    const int c = lane & 7;
#pragma unroll
    for (int jq = 0; jq < 4; ++jq) { const int n = (lane >> 3) + 8 * jq; const LAS float* s = scr + (8 * c) * 33 + n;
        u32x4 o; o.x = pk2(s[0 * 33], s[1 * 33]); o.y = pk2(s[2 * 33], s[3 * 33]); o.z = pk2(s[4 * 33], s[5 * 33]); o.w = pk2(s[6 * 33], s[7 * 33]);
        *(u32x4*)(dst + (size_t)(drow0 + n) * ld_dst + dk0 + k0 + 8 * c) = o; }
    asm volatile("s_waitcnt lgkmcnt(0)" ::: "memory");
}
DI void tr_item8(const float* src, int ld_src, int scol0, int k0, unsigned char* dst, int ld_dst, int drow0, LAS float* scr, int lane, int nvalid = 32) {
    const int n4 = (lane & 7) * 4, kr = lane >> 3; f32x4 v[8];
#pragma unroll
    for (int i = 0; i < 8; ++i) v[i] = (n4 < nvalid) ? *(const f32x4*)(src + (size_t)(k0 + kr + 8 * i) * ld_src + scol0 + n4) : (f32x4){0.f, 0.f, 0.f, 0.f};
#pragma unroll
    for (int i = 0; i < 8; ++i) { LAS float* s = scr + (kr + 8 * i) * 33 + n4; s[0] = v[i][0]; s[1] = v[i][1]; s[2] = v[i][2]; s[3] = v[i][3]; }
    asm volatile("s_waitcnt lgkmcnt(0)" ::: "memory");
    const int c = lane & 7;
#pragma unroll
    for (int jq = 0; jq < 4; ++jq) { const int n = (lane >> 3) + 8 * jq; const LAS float* s = scr + (8 * c) * 33 + n;
        u32x2 o; o.x = pk4_fp8(s[0 * 33] * W8_SCALE, s[1 * 33] * W8_SCALE, s[2 * 33] * W8_SCALE, s[3 * 33] * W8_SCALE); o.y = pk4_fp8(s[4 * 33] * W8_SCALE, s[5 * 33] * W8_SCALE, s[6 * 33] * W8_SCALE, s[7 * 33] * W8_SCALE);
        *(u32x2*)(dst + (size_t)(drow0 + n) * ld_dst + k0 + 8 * c) = o; }
    asm volatile("s_waitcnt lgkmcnt(0)" ::: "memory");
}
DI void conv_item(const Ctx& C, int l, int r, LAS float* scr) {
    constexpr int I_GU = 32 * 16 * 64;
    if (r < I_GU) { const int e = r / 1024, r2 = r % 1024, kb = r2 / 64, nb = r2 % 64, n0 = 32 * nb, j = n0 / 256, i = n0 % 256;
        const int scol0 = (i < 128) ? 128 * j + i : 1024 + 128 * j + (i - 128);
        tr_item8(C.w_gu + (size_t)(l * 32 + e) * 1024 * 2048, 2048, scol0, 64 * kb, WSP(unsigned char, WS_WGU) + (size_t)(l * 32 + e) * 2048 * 1024, 1024, n0, scr, C.lane); }
    else { r -= I_GU; const int e = r / 512, r2 = r % 512, kb = r2 / 32, nb = r2 % 32;
        tr_item8(C.w_down + (size_t)(l * 32 + e) * 1024 * 1024, 1024, 32 * nb, 64 * kb, WSP(unsigned char, WS_WDN) + (size_t)(l * 32 + e) * 1024 * 1024, 1024, 32 * nb, scr, C.lane); }
}
DI void conv_ticket(const Ctx& C0, int l, int tk) {
    Ctx C = C0; asm volatile("" : "+v"(C.lane), "+v"(C.tid));
    LAS float* scr = (LAS float*)(C.lds + C.wave * 16384);
    __syncthreads();
#pragma unroll 1
    for (int i = 0; i < 8; ++i) conv_item(C, l, tk * 64 + C.wave * 8 + i, scr);
}
DI void p0_prologue(const Ctx& C) {
    LAS float* scr = (LAS float*)(C.lds + C.wave * 16384);
    const int gw = C.bid * NWAVE + C.wave, NGW = C.G * NWAVE;
    constexpr int I_IN = 16 * 104, I_OUT = 16 * 32, I_LW = 8, I_LA = 8, I_LG = 16, I_K1 = 256, I_K2 = 8;
    constexpr int I_LAYER = I_IN + I_OUT + I_LW + I_LA + I_LG + 2 * I_K1 + 2 * I_K2;
    for (int it = gw; it < NLAYER * I_LAYER; it += NGW) {
        const int l = it / I_LAYER; int r = it % I_LAYER;
        if (r < I_IN) { const int kb = r / 104, nb = r % 104, n0 = 32 * nb; int nv = 3212 - n0; nv = nv < 0 ? 0 : (nv > 32 ? 32 : nv);
            if (INPROJ_FP8) tr_item8(C.w_in + (size_t)l * 1024 * 3212, 3212, n0, 64 * kb, WSP(unsigned char, WS_WIN) + (size_t)l * NPJ * 1024, 1024, n0, scr, C.lane, nv);
            else tr_item(C.w_in + (size_t)l * 1024 * 3212, 3212, n0, nv, 64 * kb, WSP(bf16, WS_WIN) + (size_t)l * NPJ * 1024, 1024, n0, 0, scr, C.lane); continue; } r -= I_IN;
        if (r < I_OUT) { const int kb = r / 32, nb = r % 32;
            tr_item(C.w_out + (size_t)l * 1024 * 1024, 1024, 32 * nb, 32, 64 * kb, WSP(bf16, WS_WOUT) + (size_t)l * 1024 * 1024, 1024, 32 * nb, 0, scr, C.lane); continue; } r -= I_OUT;
        bf16* lora = WSP(bf16, WS_LORA) + (size_t)l * 768 * 256;
        if (r < I_LW) { tr_item(C.w2 + (size_t)l * 64 * 256, 256, 32 * r, 32, 0, lora, 256, 32 * r, 0, scr, C.lane); continue; } r -= I_LW;
        if (r < I_LA) { tr_item(C.a2 + (size_t)l * 64 * 256, 256, 32 * r, 32, 0, lora, 256, 256 + 32 * r, 64, scr, C.lane); continue; } r -= I_LA;
        if (r < I_LG) { const int kb = r / 8, nb = r % 8; tr_item(C.g2 + (size_t)l * 128 * 256, 256, 32 * nb, 32, 64 * kb, lora, 256, 512 + 32 * nb, 128, scr, C.lane); continue; } r -= I_LG;
        if (r < 2 * I_K1) { const int kv = r / I_K1, r2 = r % I_K1, kb = r2 / 8, nb = r2 % 8;
            tr_item((kv ? C.wv1 : C.wk1) + (size_t)l * 2048 * 256, 256, 32 * nb, 32, 64 * kb, WSP(bf16, WS_WK1) + (size_t)(l * 2 + kv) * 256 * 2048, 2048, 32 * nb, 0, scr, C.lane); continue; } r -= 2 * I_K1;
        { const int kv = r / I_K2, r2 = r % I_K2, kb = r2 / 2, nb = r2 % 2;
            tr_item((kv ? C.wv2 : C.wk2) + (size_t)l * 256 * 64, 64, 32 * nb, 32, 64 * kb, WSP(bf16, WS_WK2) + (size_t)(l * 2 + kv) * 256 * 256, 256, 32 * nb, 0, scr, C.lane); }
    }
    { int* idm = WSP(int, WS_ROUTE) + NT * 12 + NR; for (int i = C.bid * NTHR + C.tid; i < NR; i += C.G * NTHR) idm[i] = i; }
    __syncthreads();
    float* MOD = WSP(float, WS_SMALL); float* PEB = MOD + NLAYER * 8 * 6144;
    LAS float* sc = (LAS float*)C.lds;
    LAS float* red = sc + 8192;
    for (int it = C.bid; it < 192 + 32; it += C.G) {
        if (it < 192) {
            const int l = it / 96, n0 = (it % 96) * 64;
            for (int i = C.tid; i < 8192; i += NTHR) { const float v = C.c[i]; sc[i] = v * fsigmoid(v); }
            __syncthreads();
            const int kq = C.tid >> 6, col = C.tid & 63; float a[8];
#pragma unroll
            for (int b = 0; b < 8; ++b) a[b] = 0.f;
            const float* wp = C.w_ada + (size_t)l * 1024 * 6144 + n0 + col;
#pragma unroll 32
            for (int k = kq * 128; k < kq * 128 + 128; ++k) { const float w = wp[(size_t)k * 6144];
#pragma unroll
                for (int b = 0; b < 8; ++b) a[b] += sc[b * 1024 + k] * w; }
#pragma unroll
            for (int b = 0; b < 8; ++b) red[(kq * 8 + b) * 64 + col] = a[b];
            __syncthreads();
            { const int b = C.tid >> 6; float s = C.b_ada[(size_t)l * 6144 + n0 + col];
#pragma unroll
              for (int q = 0; q < 8; ++q) s += red[(q * 8 + b) * 64 + col];
              MOD[((size_t)l * 8 + b) * 6144 + n0 + col] = s; }
            __syncthreads();
        } else {
            const int r = it - 192, l = r >> 4, kv = (r >> 3) & 1, c0 = (r & 7) * 32; const float* pe = (kv ? C.pe_v : C.pe_k) + (size_t)l * 2048; const float* w1 = (kv ? C.wv1 : C.wk1) + (size_t)l * 2048 * 256;
            const int kq = C.tid >> 5, col = C.tid & 31; float a = 0.f;
#pragma unroll 16
            for (int k = kq * 128; k < kq * 128 + 128; ++k) a += pe[k] * w1[(size_t)k * 256 + c0 + col];
            red[kq * 32 + col] = a; __syncthreads();
            if (C.tid < 32) { float s = 0.f;
#pragma unroll
                for (int q = 0; q < 16; ++q) s += red[q * 32 + C.tid];
                PEB[(l * 2 + kv) * 256 + c0 + C.tid] = s; }
            __syncthreads();
        }
    }
}

DI void norm_row(const Ctx& C, const float* xrow, const float* g, const float* sh, const float* sc, bf16* orow) {
    f32x4 v[4]; float s = 0.f;
#pragma unroll
    for (int j = 0; j < 4; ++j) { v[j] = *(const f32x4*)(xrow + 4 * C.lane + 256 * j); s += (v[j][0] * v[j][0] + v[j][1] * v[j][1]) + (v[j][2] * v[j][2] + v[j][3] * v[j][3]); }
    s = group_sum<64>(s); const float rstd = rsqrtf(s * (1.f / DM) + 1e-6f);
#pragma unroll
    for (int j = 0; j < 4; ++j) { const int k = 4 * C.lane + 256 * j; const f32x4 gg = *(const f32x4*)(g + k), a = *(const f32x4*)(sc + k), b = *(const f32x4*)(sh + k); f32x4 h;
#pragma unroll
        for (int i = 0; i < 4; ++i) h[i] = v[j][i] * rstd * gg[i] * (1.f + a[i]) + b[i];
        if (INPROJ_FP8) *(unsigned*)((unsigned char*)orow + k) = pk4_fp8(h[0], h[1], h[2], h[3]);
        else { u32x2 o; o.x = pk2(h[0], h[1]); o.y = pk2(h[2], h[3]); *(u32x2*)(orow + k) = o; } }
}
DI void norm1_phase(const Ctx& C, int l, const float* xin) {
    const float* MOD = WSP(float, WS_SMALL) + (size_t)l * 8 * 6144; bf16* H = WSP(bf16, WS_H);
    const int gw = C.bid * NWAVE + C.wave, NGW = C.G * NWAVE;
    for (int m = gw; m < NT; m += NGW) { const int b = m / NS; norm_row(C, xin + (size_t)m * DM, C.norm1_g + l * DM, MOD + b * 6144, MOD + b * 6144 + 1024, INPROJ_FP8 ? (bf16*)((unsigned char*)H + (size_t)m * DM) : H + (size_t)m * DM); }
}

constexpr float QSCALE = 0.125f * 1.44269504089f;
DI void prep_phase(const Ctx& C, int l) {
    const bf16* PROJ = WSP(bf16, R_PROJ); bf16* SCH = WSP(bf16, R_SCH); bf16* LIN = WSP(bf16, R_LIN); bf16* YCAT = WSP(bf16, R_YCAT);
    bf16 *QC = WSP(bf16, R_QC), *KC = WSP(bf16, R_KC), *QN = WSP(bf16, R_QN), *QR = WSP(bf16, R_QR), *KCR = WSP(bf16, R_KCR), *VCR = WSP(bf16, R_VCR), *KS = WSP(bf16, R_KS), *KW = WSP(bf16, R_KW);
    float* GATE = WSP(float, R_GATE);
    const int lane = C.lane, gw = C.bid * NWAVE + C.wave, NGW = C.G * NWAVE;
    const int hh = lane >> 4, jj = lane & 15;
    const float inv0 = exp2f(-(float)(2 * jj) * (13.287712379549449f / 32.f)) * 0.15915494309189535f, inv1 = exp2f(-(float)(2 * jj + 1) * (13.287712379549449f / 32.f)) * 0.15915494309189535f;
    for (int task = gw; task < NT / 16; task += NGW) {
        const int row0 = 16 * task, s0 = row0 % NS;
        {
            const int c0 = 16 * lane, cc = (c0 - 256) & 255; float mu16[16], kw16[16];
#pragma unroll
            for (int q = 0; q < 4; ++q) { const f32x4 m4 = *(const f32x4*)(C.mu + (size_t)l * 1024 + c0 + 4 * q), k4 = *(const f32x4*)(C.kkw + (size_t)l * 256 + cc + 4 * q);
#pragma unroll
                for (int i = 0; i < 4; ++i) { mu16[4 * q + i] = m4[i]; kw16[4 * q + i] = k4[i]; } }
#pragma unroll 2
            for (int r = 0; r < 16; ++r) {
                const int row = row0 + r; const bf16* pr = PROJ + (size_t)row * NPJ; float z[16];
                const u32x4 c0v = *(const u32x4*)(pr + c0), c1v = *(const u32x4*)(pr + c0 + 8);
                u32x4 p0v = (u32x4){0u, 0u, 0u, 0u}, p1v = p0v;
                if (s0 + r > 0) { p0v = *(const u32x4*)(pr - NPJ + c0); p1v = *(const u32x4*)(pr - NPJ + c0 + 8); }
                const unsigned cw[8] = {c0v.x, c0v.y, c0v.z, c0v.w, c1v.x, c1v.y, c1v.z, c1v.w}, pw[8] = {p0v.x, p0v.y, p0v.z, p0v.w, p1v.x, p1v.y, p1v.z, p1v.w};
#pragma unroll
                for (int e = 0; e < 16; ++e) { const float cu = (e & 1) ? bfhi(cw[e >> 1]) : bflo(cw[e >> 1]), pv = (e & 1) ? bfhi(pw[e >> 1]) : bflo(pw[e >> 1]); z[e] = cu + (pv - cu) * mu16[e]; }
                float kk[16]; float ss = 0.f;
#pragma unroll
                for (int e = 0; e < 16; ++e) { kk[e] = z[e] * kw16[e]; ss += kk[e] * kk[e]; }
                ss = group_sum<4>(ss); const float kinv = rsqrtf(ss + 1e-12f);
                if (lane < 48) {
                    const int pl = lane < 16 ? 3 : (lane < 32 ? 0 : 4); bf16* dst = SCH + ((size_t)pl * NT + row) * 256 + (c0 & 255);
                    u32x4 o0, o1; o0.x = pk2(z[0], z[1]); o0.y = pk2(z[2], z[3]); o0.z = pk2(z[4], z[5]); o0.w = pk2(z[6], z[7]); o1.x = pk2(z[8], z[9]); o1.y = pk2(z[10], z[11]); o1.z = pk2(z[12], z[13]); o1.w = pk2(z[14], z[15]);
                    *(u32x4*)dst = o0; *(u32x4*)(dst + 8) = o1;
                    if (lane >= 16 && lane < 32) { bf16* d2 = SCH + ((size_t)1 * NT + row) * 256 + cc;
                        u32x4 q0, q1; q0.x = pk2(kk[0] * kinv, kk[1] * kinv); q0.y = pk2(kk[2] * kinv, kk[3] * kinv); q0.z = pk2(kk[4] * kinv, kk[5] * kinv); q0.w = pk2(kk[6] * kinv, kk[7] * kinv);
                        q1.x = pk2(kk[8] * kinv, kk[9] * kinv); q1.y = pk2(kk[10] * kinv, kk[11] * kinv); q1.z = pk2(kk[12] * kinv, kk[13] * kinv); q1.w = pk2(kk[14] * kinv, kk[15] * kinv);
                        *(u32x4*)d2 = q0; *(u32x4*)(d2 + 8) = q1; }
                } else {
                    float t[16];
#pragma unroll
                    for (int i = 0; i < 16; ++i) { const float sg = fsigmoid(lane < 52 ? 2.f * z[i] : z[i]); t[i] = lane < 52 ? 2.f * sg - 1.f : (lane < 56 ? z[i] : sg); }
                    bf16* dst = LIN + (size_t)row * 256 + (c0 - 768);
                    u32x4 o0, o1; o0.x = pk2(t[0], t[1]); o0.y = pk2(t[2], t[3]); o0.z = pk2(t[4], t[5]); o0.w = pk2(t[6], t[7]); o1.x = pk2(t[8], t[9]); o1.y = pk2(t[10], t[11]); o1.z = pk2(t[12], t[13]); o1.w = pk2(t[14], t[15]);
                    *(u32x4*)dst = o0; *(u32x4*)(dst + 8) = o1;
                }
            }
        }
        {
            const int ch = 4 * lane; const float* cw = C.conv_w + (size_t)l * 3 * 256 + ch; const f32x4 w0 = *(const f32x4*)cw, w1 = *(const f32x4*)(cw + 256), w2 = *(const f32x4*)(cw + 512);
            const f32x4 og = *(const f32x4*)(C.onorm_g + (size_t)l * 768 + ch);
#pragma unroll 2
            for (int r = 0; r < 16; ++r) {
                const int row = row0 + r, s = s0 + r; const bf16* pr = PROJ + (size_t)row * NPJ; float u[3][4];
#pragma unroll
                for (int d = 0; d < 3; ++d) {
                    u32x2 cg = (u32x2){0u, 0u}, xi = cg;
                    if (s >= d) { cg = *(const u32x2*)(pr - (size_t)d * NPJ + PJ_B + 256 + ch); xi = *(const u32x2*)(pr - (size_t)d * NPJ + PJ_B + 512 + ch); }
                    u[d][0] = bflo(cg.x) * bflo(xi.x); u[d][1] = bfhi(cg.x) * bfhi(xi.x); u[d][2] = bflo(cg.y) * bflo(xi.y); u[d][3] = bfhi(cg.y) * bfhi(xi.y);
                }
                const u32x2 bgv = *(const u32x2*)(pr + PJ_B + ch); const float bg[4] = {bflo(bgv.x), bfhi(bgv.x), bflo(bgv.y), bfhi(bgv.y)};
                float y[4]; float ss = 0.f;
#pragma unroll
                for (int i = 0; i < 4; ++i) { y[i] = bg[i] * (w0[i] * u[2][i] + w1[i] * u[1][i] + w2[i] * u[0][i]); ss += y[i] * y[i]; }
                ss = group_sum<16>(ss); const float rstd = rsqrtf(ss * (1.f / 64.f) + 1e-6f);
                u32x2 o; o.x = pk2(y[0] * rstd * og[0], y[1] * rstd * og[1]); o.y = pk2(y[2] * rstd * og[2], y[3] * rstd * og[3]);
                *(u32x2*)(YCAT + (size_t)row * DM + 256 + ch) = o;
            }
        }
        {
            const float* gq = C.dil_q_g + (size_t)l * 64; const float* gk = C.dil_k_g + (size_t)l * 64; const float* gn = C.nsa_q_g + (size_t)l * 64; const float* gv = (hh == 0 ? C.nsa_ks_g : C.nsa_kw_g) + (size_t)l * 64;
            float Gq[4], Gk[4], Gn[4], Gv[4];
#pragma unroll
            for (int i = 0; i < 4; ++i) { const int d = (i >> 1) * 32 + 2 * jj + (i & 1); Gq[i] = gq[d] * QSCALE; Gk[i] = gk[d]; Gn[i] = gn[d] * QSCALE; Gv[i] = gv[d]; }
            const int vcol = hh == 0 ? 2944 : (hh == 1 ? 3072 : (hh == 2 ? 2816 : 2880));
            bf16* vdst = (hh == 0 ? KS : (hh == 1 ? KW : (hh == 2 ? KCR : VCR)));
#pragma unroll 2
            for (int r = 0; r < 16; ++r) {
                const int row = row0 + r; const bf16* pr = PROJ + (size_t)row * NPJ;
                const float posf = (float)C.pos[row];
                const float x0 = __builtin_amdgcn_fractf(posf * inv0), x1 = __builtin_amdgcn_fractf(posf * inv1);
                const float sn0 = __builtin_amdgcn_sinf(x0), cs0 = __builtin_amdgcn_cosf(x0), sn1 = __builtin_amdgcn_sinf(x1), cs1 = __builtin_amdgcn_cosf(x1);
                const unsigned qa = *(const unsigned*)(pr + PJ_C + hh * 64 + 2 * jj), qb = *(const unsigned*)(pr + PJ_C + hh * 64 + 32 + 2 * jj);
                const unsigned ka = *(const unsigned*)(pr + PJ_C + 256 + hh * 64 + 2 * jj), kb = *(const unsigned*)(pr + PJ_C + 256 + hh * 64 + 32 + 2 * jj);
                const unsigned na = *(const unsigned*)(pr + PJ_D + hh * 64 + 2 * jj), nb = *(const unsigned*)(pr + PJ_D + hh * 64 + 32 + 2 * jj);
                const unsigned va = *(const unsigned*)(pr + vcol + 2 * jj), vb = *(const unsigned*)(pr + vcol + 32 + 2 * jj);
                float gate_in = 0.f; if (lane < 12) gate_in = bf2f(pr[3200 + lane]);
#define ROPE_NORM(a, b, G, o1, o2, n1a, n1b, n2a, n2b) \
                float n1a = bflo(a), n1b = bfhi(a), n2a = bflo(b), n2b = bfhi(b); { const float ss_ = group_sum<16>(n1a * n1a + n1b * n1b + n2a * n2a + n2b * n2b); const float rs_ = rsqrtf(ss_ * (1.f / 64.f) + 1e-6f); \
                    n1a *= rs_ * G[0]; n1b *= rs_ * G[1]; n2a *= rs_ * G[2]; n2b *= rs_ * G[3]; } \
                const unsigned o1 = pk2(n1a * cs0 - n2a * sn0, n1b * cs1 - n2b * sn1), o2 = pk2(n2a * cs0 + n1a * sn0, n2b * cs1 + n1b * sn1);
                ROPE_NORM(qa, qb, Gq, q1, q2, q1a, q1b, q2a, q2b)
                ROPE_NORM(ka, kb, Gk, k1, k2, k1a, k1b, k2a, k2b)
                ROPE_NORM(na, nb, Gn, r1, r2, r1a, r1b, r2a, r2b)
                ROPE_NORM(va, vb, Gv, v1, v2, v1a, v1b, v2a, v2b)
#undef ROPE_NORM
                bf16* o = QC + (size_t)row * 256 + hh * 64 + 2 * jj; *(unsigned*)o = q1; *(unsigned*)(o + 32) = q2;
                o = KC + (size_t)row * 256 + hh * 64 + 2 * jj; *(unsigned*)o = k1; *(unsigned*)(o + 32) = k2;
                o = QN + (size_t)row * 256 + hh * 64 + 2 * jj; *(unsigned*)o = pk2(r1a, r1b); *(unsigned*)(o + 32) = pk2(r2a, r2b);
                o = QR + (size_t)row * 256 + hh * 64 + 2 * jj; *(unsigned*)o = r1; *(unsigned*)(o + 32) = r2;
                o = vdst + (size_t)row * 64 + 2 * jj; *(unsigned*)o = (hh >= 2) ? va : v1; *(unsigned*)(o + 32) = (hh >= 2) ? vb : v2;
                if (lane < 12) GATE[(size_t)row * 12 + lane] = fsigmoid(gate_in);
            }
        }
    }
}
constexpr int SCAN_TC = 16;
DI void scan_unit8(const Ctx& C, int u) {
    const float* Wp = WSP(float, R_SC); const bf16* SCH = WSP(bf16, R_SCH); float* YA = WSP(float, R_YA); float* UB = WSP(float, R_SCANU); float* SMT = WSP(float, R_SCANS);
    const int pair = u / 3, kind = u % 3, b = pair >> 2, h = pair & 3, tid = C.tid;
    LAS float* buf = (LAS float*)C.lds;
    LAS float* ybuf = buf + 2 * 6144;
    const int row = tid >> 3, cg = tid & 7, tbase = kind == 0 ? 0 : NS / 2;
    const float vm = kind == 2 ? 0.f : 1.f;
    u32x4 ldA[2], ldB[2];
#define SCAN_LOAD(ld, chunk) do { _Pragma("unroll") for (int i = 0; i < 2; ++i) { const int p_ = tid + 512 * i; if (p_ < 896) { const int step = p_ / 56, r_ = p_ % 56; const size_t row_ = (size_t)b * NS + tbase + (chunk) * SCAN_TC + step; \
        if (r_ < 16) ld[i] = *(const u32x4*)(Wp + row_ * 256 + h * 64 + r_ * 4); else { const int v5 = (r_ - 16) >> 3, c_ = (r_ - 16) & 7; ld[i] = *(const u32x4*)(SCH + ((size_t)v5 * NT + row_) * 256 + h * 64 + c_ * 8); } } } } while (0)
#define SCAN_STORE(ld, slot) do { _Pragma("unroll") for (int i = 0; i < 2; ++i) { const int p_ = tid + 512 * i; if (p_ < 896) { const int step = p_ / 56, r_ = p_ % 56; LAS float* d_ = buf + (slot) * 6144 + step * 384; \
        if (r_ < 16) *(LAS u32x4*)(d_ + r_ * 4) = ld[i]; else { const int v5 = (r_ - 16) >> 3, c_ = (r_ - 16) & 7; LAS float* e_ = d_ + (1 + v5) * 64 + c_ * 8; const u32x4 x_ = ld[i]; \
            *(LAS f32x4*)e_ = (f32x4){bflo(x_.x), bfhi(x_.x), bflo(x_.y), bfhi(x_.y)}; *(LAS f32x4*)(e_ + 4) = (f32x4){bflo(x_.z), bfhi(x_.z), bflo(x_.w), bfhi(x_.w)}; } } } } while (0)
#define SCAN_FLUSH(chunk) do { _Pragma("unroll") for (int i = 0; i < 2; ++i) { const int i2 = tid + 512 * i, step = i2 >> 6, rr = i2 & 63; const LAS float* pp_ = ybuf + ((chunk) & 1) * 8192 + step * 512 + rr * 8; \
        const f32x4 pa_ = *(const LAS f32x4*)pp_, pb_ = *(const LAS f32x4*)(pp_ + 4); const float yv = ((pa_[0] + pa_[1]) + (pa_[2] + pa_[3])) + ((pb_[0] + pb_[1]) + (pb_[2] + pb_[3])); \
        if (kind == 2) UB[((size_t)b * (NS / 2) + (chunk) * SCAN_TC + step) * 256 + h * 64 + rr] = yv; else YA[((size_t)b * NS + tbase + (chunk) * SCAN_TC + step) * 256 + h * 64 + rr] = yv; } } while (0)
    __syncthreads();
    SCAN_LOAD(ldA, 0); SCAN_STORE(ldA, 0); SCAN_LOAD(ldB, 1); SCAN_LOAD(ldA, 2);
    f32x2 S[4];
#pragma unroll
    for (int c = 0; c < 4; ++c) { S[c][0] = (kind == 2 && row == 8 * cg + 2 * c) ? 1.f : 0.f; S[c][1] = (kind == 2 && row == 8 * cg + 2 * c + 1) ? 1.f : 0.f; }
    constexpr int NCH = (NS / 2) / SCAN_TC;
#pragma unroll 2
    for (int ck = 0; ck < NCH; ++ck) {
        __syncthreads();
        if (ck & 1) { if (ck + 1 < NCH) SCAN_STORE(ldA, (ck + 1) & 1); if (ck + 3 < NCH) SCAN_LOAD(ldA, ck + 3); }
        else        { if (ck + 1 < NCH) SCAN_STORE(ldB, (ck + 1) & 1); if (ck + 3 < NCH) SCAN_LOAD(ldB, ck + 3); }
        {
            const LAS float* bp = buf + (ck & 1) * 6144; LAS float* yb = ybuf + (ck & 1) * 8192 + tid;
#define SCAN_LDS(X, step) do { const LAS float* sp = bp + (step) * 384 + 8 * cg; X.w0 = *(const LAS f32x4*)(sp); X.w1 = *(const LAS f32x4*)(sp + 4); X.k0 = *(const LAS f32x4*)(sp + 64); X.k1 = *(const LAS f32x4*)(sp + 68); \
                X.q0 = *(const LAS f32x4*)(sp + 128); X.q1 = *(const LAS f32x4*)(sp + 132); X.b0 = *(const LAS f32x4*)(sp + 192); X.b1 = *(const LAS f32x4*)(sp + 196); \
                X.r0 = *(const LAS f32x4*)(sp + 256); X.r1 = *(const LAS f32x4*)(sp + 260); X.v = bp[(step) * 384 + 320 + row] * vm; } while (0)
#define SCAN_STEP(X, step) do { \
                f32x2 d2 = S[0] * (f32x2){X.q0[0], X.q0[1]}; d2 = S[1] * (f32x2){X.q0[2], X.q0[3]} + d2; d2 = S[2] * (f32x2){X.q1[0], X.q1[1]} + d2; d2 = S[3] * (f32x2){X.q1[2], X.q1[3]} + d2; \
                const float sa = -sum8(d2[0] + d2[1]); const f32x2 sa2 = (f32x2){sa, sa}, v2 = (f32x2){X.v, X.v}; \
                S[0] = S[0] * (f32x2){X.w0[0], X.w0[1]} + (sa2 * (f32x2){X.b0[0], X.b0[1]} + v2 * (f32x2){X.k0[0], X.k0[1]}); \
                S[1] = S[1] * (f32x2){X.w0[2], X.w0[3]} + (sa2 * (f32x2){X.b0[2], X.b0[3]} + v2 * (f32x2){X.k0[2], X.k0[3]}); \
                S[2] = S[2] * (f32x2){X.w1[0], X.w1[1]} + (sa2 * (f32x2){X.b1[0], X.b1[1]} + v2 * (f32x2){X.k1[0], X.k1[1]}); \
                S[3] = S[3] * (f32x2){X.w1[2], X.w1[3]} + (sa2 * (f32x2){X.b1[2], X.b1[3]} + v2 * (f32x2){X.k1[2], X.k1[3]}); \
                f32x2 y2 = S[0] * (f32x2){X.r0[0], X.r0[1]}; y2 = S[1] * (f32x2){X.r0[2], X.r0[3]} + y2; y2 = S[2] * (f32x2){X.r1[0], X.r1[1]} + y2; y2 = S[3] * (f32x2){X.r1[2], X.r1[3]} + y2; \
                yb[(step) * 512] = y2[0] + y2[1]; } while (0)
            struct StepIn { f32x4 w0, w1, k0, k1, q0, q1, b0, b1, r0, r1; float v; } A, B;
            SCAN_LDS(A, 0);
#pragma unroll 2
            for (int step = 0; step < SCAN_TC; step += 2) {
                SCAN_LDS(B, step + 1);
                __builtin_amdgcn_sched_barrier(0);
                SCAN_STEP(A, step);
                __builtin_amdgcn_sched_barrier(0);
                if (step + 2 < SCAN_TC) SCAN_LDS(A, step + 2);
                __builtin_amdgcn_sched_barrier(0);
                SCAN_STEP(B, step + 1);
                __builtin_amdgcn_sched_barrier(0);
            }
#undef SCAN_LDS
#undef SCAN_STEP
        }
        if (ck > 0) SCAN_FLUSH(ck - 1);
    }
    __syncthreads();
    SCAN_FLUSH(NCH - 1);
    if (kind == 0) {
        float* o = SMT + (size_t)pair * 4096 + row;
#pragma unroll
        for (int c = 0; c < 4; ++c) { o[(8 * cg + 2 * c) * 64] = S[c][0]; o[(8 * cg + 2 * c + 1) * 64] = S[c][1]; }
    }
#undef SCAN_LOAD
#undef SCAN_STORE
#undef SCAN_FLUSH
    __syncthreads();
}

constexpr int KROW = 144, KT_BYTES = 64 * KROW;
#define MFMA16(a, b, c) __builtin_amdgcn_mfma_f32_16x16x32_bf16((a), (b), (c), 0, 0, 0)
template <int NQT> struct FA { f32x4 O[NQT][4]; float l[NQT]; float negM; };
template <int NQT> DI void fa_init(FA<NQT>& st) {
#pragma unroll
    for (int q = 0; q < NQT; ++q) { st.l[q] = 0.f;
#pragma unroll
        for (int d = 0; d < 4; ++d) st.O[q][d] = (f32x4){0.f, 0.f, 0.f, 0.f}; }
}
DI bf16x8 pack8(const f32x4& a, const f32x4& b) { u32x4 w; w.x = pk2(a[0], a[1]); w.y = pk2(a[2], a[3]); w.z = pk2(b[0], b[1]); w.w = pk2(b[2], b[3]); return __builtin_bit_cast(bf16x8, w); }
struct VFrag { u32x2 a[4], b[4]; };
DI void vt_issue(VFrag& f, unsigned vaddr) {
    asm volatile("ds_read_b64_tr_b16 %0, %8\n\tds_read_b64_tr_b16 %1, %8 offset:2304\n\tds_read_b64_tr_b16 %2, %8 offset:32\n\tds_read_b64_tr_b16 %3, %8 offset:2336\n\t"
                 "ds_read_b64_tr_b16 %4, %8 offset:64\n\tds_read_b64_tr_b16 %5, %8 offset:2368\n\tds_read_b64_tr_b16 %6, %8 offset:96\n\tds_read_b64_tr_b16 %7, %8 offset:2400"
                 : "=&v"(f.a[0]), "=&v"(f.b[0]), "=&v"(f.a[1]), "=&v"(f.b[1]), "=&v"(f.a[2]), "=&v"(f.b[2]), "=&v"(f.a[3]), "=&v"(f.b[3]) : "v"(vaddr) : "memory");
}
DI void vt_wait(VFrag& f) { asm volatile("s_waitcnt lgkmcnt(0)" : "+v"(f.a[0]), "+v"(f.b[0]), "+v"(f.a[1]), "+v"(f.b[1]), "+v"(f.a[2]), "+v"(f.b[2]), "+v"(f.a[3]), "+v"(f.b[3]) :: "memory"); }
DI bf16x8 vt_get(const VFrag& f, int d) { return __builtin_bit_cast(bf16x8, ((u32x4){f.a[d].x, f.a[d].y, f.b[d].x, f.b[d].y})); }
template <int NQT, bool MASKED, class MaskF>
DI void fa_tile(FA<NQT>& st, const bf16x8 (&Q)[NQT][2], const LAS uchar* Ks, const LAS uchar* Vs, int lane, const MaskF& allowed, const bool (&act)[NQT]) {
    const int l15 = lane & 15, quad = lane >> 4;
    float nm_ = st.negM; asm volatile("" : "+v"(nm_));
    f32x4 S[NQT][4]; const f32x4 sinit = (f32x4){nm_, nm_, nm_, nm_};
#pragma unroll
    for (int kt = 0; kt < 4; ++kt) {
        const bf16x8 k0 = *(const LAS bf16x8*)(Ks + (16 * kt + l15) * KROW + quad * 16), k1 = *(const LAS bf16x8*)(Ks + (16 * kt + l15) * KROW + 64 + quad * 16);
#pragma unroll
        for (int q = 0; q < NQT; ++q) if (act[q]) { S[q][kt] = MFMA16(k0, Q[q][0], sinit); S[q][kt] = MFMA16(k1, Q[q][1], S[q][kt]); }
    }
    const unsigned vaddr = (unsigned)(size_t)(Vs + (4 * quad + (l15 >> 2)) * KROW + 8 * (l15 & 3));
    VFrag v0, v1; vt_issue(v0, vaddr);
#pragma unroll
    for (int q = 0; q < NQT; ++q) if (act[q]) {
        float rs = 0.f;
#pragma unroll
        for (int kt = 0; kt < 4; ++kt)
#pragma unroll
            for (int j = 0; j < 4; ++j) { float p = fexp2(S[q][kt][j]); if (MASKED) p = allowed(q, 16 * kt + 4 * quad + j) ? p : 0.f; S[q][kt][j] = p; rs += p; }
        st.l[q] += rs;
    }
    vt_wait(v0); vt_issue(v1, vaddr + 32 * KROW);
#pragma unroll
    for (int q = 0; q < NQT; ++q) if (act[q]) {
        const bf16x8 p0 = pack8(S[q][0], S[q][1]);
#pragma unroll
        for (int d = 0; d < 4; ++d) st.O[q][d] = MFMA16(vt_get(v0, d), p0, st.O[q][d]);
    }
    vt_wait(v1);
#pragma unroll
    for (int q = 0; q < NQT; ++q) if (act[q]) {
        const bf16x8 p1 = pack8(S[q][2], S[q][3]);
#pragma unroll
        for (int d = 0; d < 4; ++d) st.O[q][d] = MFMA16(vt_get(v1, d), p1, st.O[q][d]);
    }
}
template <int NQT> DI void fa_finish(FA<NQT>& st, float (&lse2)[NQT]) {
#pragma unroll
    for (int q = 0; q < NQT; ++q) { float l = st.l[q]; l += __shfl_xor(l, 16); l += __shfl_xor(l, 32); const float inv = l > 0.f ? 1.f / l : 0.f; lse2[q] = __log2f(fmaxf(l, 1e-37f));
#pragma unroll
        for (int d = 0; d < 4; ++d) st.O[q][d] = st.O[q][d] * inv; }
}
DI float score_bound(const float* gq, const float* gk, int lane) {
    float a = fabsf(gq[lane & 63]), b = fabsf(gk[lane & 63]);
#pragma unroll
    for (int o = 1; o < 64; o <<= 1) { a = fmaxf(a, __shfl_xor(a, o)); b = fmaxf(b, __shfl_xor(b, o)); }
    return __builtin_bit_cast(float, __builtin_amdgcn_readfirstlane(__builtin_bit_cast(int, 64.f * a * b * QSCALE * 1.02f + 0.5f)));
}
DI void kv_store(LAS uchar* Ks, LAS uchar* Vs, int tid, const u32x4& kr, const u32x4& vr) {
    const int o = (tid >> 3) * KROW + (tid & 7) * 16; *(LAS u32x4*)(Ks + o) = kr; *(LAS u32x4*)(Vs + o) = vr;
}
DI void q_load(bf16x8 (&Q)[2], const bf16* qrow, int quad) { Q[0] = *(const bf16x8*)(qrow + 8 * quad); Q[1] = *(const bf16x8*)(qrow + 32 + 8 * quad); }

struct DilMask { int qi[2]; int k0; DI bool operator()(int q, int key) const { const int ki = k0 + key, d = qi[q] - ki; return ki >= 0 && (unsigned)d <= 128u; } };
DI void dil_unit(const Ctx& C, int unit, LAS uchar* lds0, LAS uchar*  , float negM_bound) {
    const bf16 *QC = WSP(bf16, R_QC), *KC = WSP(bf16, R_KC), *PROJ = WSP(bf16, R_PROJ); float* OC = WSP(float, R_OC); float* LSE = WSP(float, R_LSE);
    int tid = C.tid, lane = C.lane; asm volatile("" : "+v"(tid), "+v"(lane));
    const int w = C.wave, l15 = lane & 15, quad = lane >> 4, wq = w & 3;
    const int cfg = unit / 512, r = unit % 512, dsh = 2 * cfg, d = 1 << dsh;
    const int b = r >> 6, hp = (r >> 5) & 1, r2 = r & 31;
    const int nblk = 32 >> dsh, res = r2 / nblk, blk = r2 % nblk, i0 = blk * 128, h = 2 * hp + (w >> 2);
    const size_t tb = (size_t)b * NS;
    bf16x8 Q[2][2]; DilMask mk; FA<2> st; fa_init(st); st.negM = -negM_bound;
#pragma unroll
    for (int q = 0; q < 2; ++q) { mk.qi[q] = i0 + 32 * wq + 16 * q + l15; q_load(Q[q], QC + (tb + res + (size_t)d * mk.qi[q]) * 256 + h * 64, quad); }
    const int jlo = wq >> 1, jhi = (wq >> 1) + 2;
    const bool act[2] = {true, true};
    u32x4 kr0, vr0, kr1, vr1;
#define DIL_LOAD(j) do { const int ki = i0 - 128 + 64 * (j) + (tid >> 3); kr0 = (u32x4){0u, 0u, 0u, 0u}; vr0 = kr0; kr1 = kr0; vr1 = kr0; \
    if (ki >= 0) { const size_t rowk = tb + res + (size_t)d * ki; const bf16* kp = KC + rowk * 256 + 128 * hp + (tid & 7) * 8; const bf16* vp = PROJ + rowk * NPJ + PJ_C + 512 + 128 * hp + (tid & 7) * 8; \
        kr0 = *(const u32x4*)kp; kr1 = *(const u32x4*)(kp + 64); vr0 = *(const u32x4*)vp; vr1 = *(const u32x4*)(vp + 64); } } while (0)
#define DIL_STORE(p) do { LAS uchar* b_ = lds0 + (p) * 4 * KT_BYTES; kv_store(b_, b_ + KT_BYTES, tid, kr0, vr0); kv_store(b_ + 2 * KT_BYTES, b_ + 3 * KT_BYTES, tid, kr1, vr1); } while (0)
    DIL_LOAD(0); __syncthreads(); DIL_STORE(0); DIL_LOAD(1);
    for (int j = 0; j < 4; ++j) {
        __syncthreads();
        if (j + 1 < 4) DIL_STORE((j + 1) & 1);
        if (j + 2 < 4) DIL_LOAD(j + 2);
        if (j >= jlo && j <= jhi) { mk.k0 = i0 - 128 + 64 * j; const LAS uchar* kb = lds0 + (j & 1) * 4 * KT_BYTES + (w >> 2) * 2 * KT_BYTES; fa_tile<2, true>(st, Q, kb, kb + KT_BYTES, lane, mk, act); }
    }
#undef DIL_LOAD
#undef DIL_STORE
    float lse2[2]; fa_finish<2>(st, lse2);
#pragma unroll
    for (int q = 0; q < 2; ++q) { const size_t rowq = tb + res + (size_t)d * mk.qi[q]; float* o = OC + ((size_t)cfg * NT + rowq) * 256 + h * 64 + 4 * quad;
#pragma unroll
        for (int dt = 0; dt < 4; ++dt) *(f32x4*)(o + 16 * dt) = st.O[q][dt];
        if (quad == 0) LSE[((size_t)cfg * NT + rowq) * 4 + h] = lse2[q]; }
}
constexpr int NSA_KC = 0, NSA_VC = 256 * KROW, NSA_KT = 2 * 256 * KROW, NSA_VT = NSA_KT + KT_BYTES, NSA_IMP = NSA_KT + 4 * KT_BYTES,
    NSA_SELM = NSA_IMP + 64 * 64 * 4, NSA_UW = NSA_SELM + 512;
static_assert(NSA_UW + 16 <= RING_BYTES, "NSA LDS map");
DI void cmp_mlp_wait(const Ctx& C, int l);
struct SwaMask { int t[2]; int k0; DI bool operator()(int q, int key) const { const int d = t[q] - (k0 + key); return (unsigned)d <= 511u; } };
struct SlcMask { int t[2]; int k0; bool sel[2]; DI bool operator()(int q, int key) const { return sel[q] && (k0 + key <= t[q]); } };
struct NoMask { DI bool operator()(int, int) const { return true; } };
DI void nsa_unit(const Ctx& C, int l, int b, int tbk, int& bl, bool& cmp_ready, float bnd_cmp, float bnd_slc, float bnd_swa) {
    const bf16 *QN = WSP(bf16, R_QN), *QR = WSP(bf16, R_QR), *KSb = WSP(bf16, R_KS), *KWb = WSP(bf16, R_KW), *PROJ = WSP(bf16, R_PROJ); const float* CMP = WSP(float, R_CMP); const float* GATE = WSP(float, R_GATE);
    bf16* YCAT = WSP(bf16, R_YCAT);
    LAS uchar* Kc = C.lds + NSA_KC; LAS uchar* Vc = C.lds + NSA_VC; LAS uchar* Ks = C.lds + NSA_KT; LAS uchar* Vs = C.lds + NSA_VT;
    LAS float* imps = (LAS float*)(C.lds + NSA_IMP); LAS unsigned* selm = (LAS unsigned*)(C.lds + NSA_SELM); LAS unsigned* uw = (LAS unsigned*)(C.lds + NSA_UW);
    int tid = C.tid, lane = C.lane; asm volatile("" : "+v"(tid), "+v"(lane));
    const int w = C.wave, l15 = lane & 15, quad = lane >> 4, head = l15 & 3, t0 = 64 * tbk; const size_t tb = (size_t)b * NS;
    __syncthreads();
    if (b != bl) {
        if (!cmp_ready) { cmp_mlp_wait(C, l); cmp_ready = true; }
        const int key = tid >> 1, hf = tid & 1; const float* kp = CMP + ((size_t)b * 256 + key) * 64 + 32 * hf; const float* vp = CMP + ((size_t)2048 + (size_t)b * 256 + key) * 64 + 32 * hf;
        float kv[32], vv[32]; float ss = 0.f;
#pragma unroll
        for (int i = 0; i < 8; ++i) { const f32x4 a = *(const f32x4*)(kp + 4 * i), c = *(const f32x4*)(vp + 4 * i);
#pragma unroll
            for (int j = 0; j < 4; ++j) { kv[4 * i + j] = a[j]; vv[4 * i + j] = c[j]; ss += a[j] * a[j]; } }
        ss += __shfl_xor(ss, 1); const float rstd = rsqrtf(ss * (1.f / 64.f) + 1e-6f); const float* g = C.nsa_kc_g + (size_t)l * 64 + 32 * hf; const bool dead = (key == 255);
#pragma unroll
        for (int i = 0; i < 4; ++i) { u32x4 o, p;
            o.x = pk2(kv[8 * i] * rstd * g[8 * i], kv[8 * i + 1] * rstd * g[8 * i + 1]); o.y = pk2(kv[8 * i + 2] * rstd * g[8 * i + 2], kv[8 * i + 3] * rstd * g[8 * i + 3]);
            o.z = pk2(kv[8 * i + 4] * rstd * g[8 * i + 4], kv[8 * i + 5] * rstd * g[8 * i + 5]); o.w = pk2(kv[8 * i + 6] * rstd * g[8 * i + 6], kv[8 * i + 7] * rstd * g[8 * i + 7]);
            p.x = pk2(vv[8 * i], vv[8 * i + 1]); p.y = pk2(vv[8 * i + 2], vv[8 * i + 3]); p.z = pk2(vv[8 * i + 4], vv[8 * i + 5]); p.w = pk2(vv[8 * i + 6], vv[8 * i + 7]);
            if (dead) { o = (u32x4){0u, 0u, 0u, 0u}; p = o; }
            *(LAS u32x4*)(Kc + key * KROW + hf * 64 + i * 16) = o; *(LAS u32x4*)(Vc + key * KROW + hf * 64 + i * 16) = p; }
        bl = b;
        __syncthreads();
    }
    f32x4 Oc[2][4];
    const int cmaxu = (t0 + 32) >> 4, ktmax = cmaxu >> 4;
    const unsigned vaddr0 = (unsigned)(size_t)(Vc + (4 * quad + (l15 >> 2)) * KROW + 8 * (l15 & 3));
#pragma unroll
    for (int q = 0; q < 2; ++q) {
        const int t = t0 + 8 * w + 4 * q + (l15 >> 2);
        bf16x8 Q[2]; q_load(Q, QN + (tb + t) * 256 + head * 64, quad);
        float nm_ = -bnd_cmp; asm volatile("" : "+v"(nm_)); f32x4 S[16]; const f32x4 sinit = (f32x4){nm_, nm_, nm_, nm_}; float ls = 0.f;
#pragma unroll
        for (int kt = 0; kt < 16; ++kt) {
            if (kt <= ktmax) {
                const bf16x8 k0 = *(const LAS bf16x8*)(Kc + (16 * kt + l15) * KROW + quad * 16), k1 = *(const LAS bf16x8*)(Kc + (16 * kt + l15) * KROW + 64 + quad * 16);
                S[kt] = MFMA16(k0, Q[0], sinit); S[kt] = MFMA16(k1, Q[1], S[kt]);
#pragma unroll
                for (int j = 0; j < 4; ++j) { const int c = 16 * kt + 4 * quad + j; const float p = (16 * c + 31 <= t) ? fexp2(S[kt][j]) : 0.f; S[kt][j] = p; ls += p; }
            } else S[kt] = (f32x4){0.f, 0.f, 0.f, 0.f};
        }
        ls += __shfl_xor(ls, 16); ls += __shfl_xor(ls, 32);
        const float inv = ls > 0.f ? 1.f / ls : 0.f;
#pragma unroll
        for (int kt = 0; kt < 16; ++kt) S[kt] = S[kt] * inv;
#pragma unroll
        for (int kt = 0; kt < 16; ++kt) {
            const float send = (quad == 3) ? (kt > 0 ? S[kt > 0 ? kt - 1 : 0][3] : 0.f) : S[kt][3];
            const float prev = __shfl(send, (lane + 48) & 63);
            float v = ((quad == 0 && kt == 0) ? 0.f : prev) + 2.f * (S[kt][0] + S[kt][1] + S[kt][2]) + S[kt][3];
            v = group_sum<4>(v);
            if (head == 0) imps[(8 * w + 4 * q + (l15 >> 2)) * 64 + 4 * kt + quad] = v;
        }
#pragma unroll
        for (int d = 0; d < 4; ++d) Oc[q][d] = (f32x4){0.f, 0.f, 0.f, 0.f};
#pragma unroll
        for (int ks = 0; ks < 8; ++ks) {
            if (2 * ks <= ktmax) {
                VFrag vf; vt_issue(vf, vaddr0 + ks * 32 * KROW); const bf16x8 pf = pack8(S[2 * ks], S[2 * ks + 1]); vt_wait(vf);
#pragma unroll
                for (int d = 0; d < 4; ++d) Oc[q][d] = MFMA16(vt_get(vf, d), pf, Oc[q][d]);
            }
        }
    }
    {
        float* OCm = WSP(float, R_OCMP);
#pragma unroll
        for (int q = 0; q < 2; ++q) { float* o = OCm + (tb + t0 + 8 * w + 4 * q + (l15 >> 2)) * 256 + head * 64 + 4 * quad;
#pragma unroll
            for (int d = 0; d < 4; ++d) *(f32x4*)(o + 16 * d) = Oc[q][d]; }
    }
    __syncthreads();
    if (tid < 64) {
        const int cur = tbk; unsigned long long mask;
        if (cur <= 15) mask = (2ull << cur) - 1ull;
        else {
            mask = 1ull | (1ull << cur) | (1ull << (cur - 1));
            float v[64];
#pragma unroll
            for (int i = 0; i < 16; ++i) { const f32x4 a = *(const LAS f32x4*)(imps + tid * 64 + 4 * i);
#pragma unroll
                for (int j = 0; j < 4; ++j) { const int jb = 4 * i + j; v[jb] = (jb >= 1 && jb <= cur - 2) ? a[j] : -1.f; } }
#pragma unroll 1
            for (int r = 0; r < 13; ++r) {
                float bv = -0.5f; int bi = 0;
#pragma unroll
                for (int jb = 0; jb < 64; ++jb) if (v[jb] > bv) { bv = v[jb]; bi = jb; }
                mask |= 1ull << bi;
#pragma unroll
                for (int jb = 0; jb < 64; ++jb) v[jb] = (jb == bi) ? -1.f : v[jb];
            }
        }
        unsigned lo = (unsigned)mask, hi = (unsigned)(mask >> 32);
        selm[2 * tid] = lo; selm[2 * tid + 1] = hi;
#pragma unroll
        for (int o = 1; o < 64; o <<= 1) { lo |= __shfl_xor(lo, o); hi |= __shfl_xor(hi, o); }
        if (tid == 0) { uw[0] = lo; uw[1] = hi; }
    }
    __syncthreads();
    unsigned long long U = ((unsigned long long)uw[1] << 32) | uw[0];
    bf16x8 Q[2][2]; SlcMask mk; FA<2> st; fa_init(st); st.negM = -bnd_slc; unsigned long long msk[2];
#pragma unroll
    for (int q = 0; q < 2; ++q) { const int tl = 8 * w + 4 * q + (l15 >> 2); mk.t[q] = t0 + tl; msk[q] = ((unsigned long long)selm[2 * tl + 1] << 32) | selm[2 * tl]; q_load(Q[q], QR + (tb + mk.t[q]) * 256 + head * 64, quad); }
    unsigned long long QM[2];
#pragma unroll
    for (int q = 0; q < 2; ++q) { unsigned lo = (unsigned)msk[q], hi = (unsigned)(msk[q] >> 32);
#pragma unroll
        for (int o = 1; o < 64; o <<= 1) { lo |= __shfl_xor(lo, o); hi |= __shfl_xor(hi, o); }
        QM[q] = ((unsigned long long)hi << 32) | lo; }
#ifndef PROBE_SLC2
#define PROBE_SLC2 0
#endif
#ifndef PROBE_SWA2
#define PROBE_SWA2 0
#endif
    u32x4 kr, vr; const unsigned long long U0 = U;
    for (int prep_ = 0; prep_ <= PROBE_SLC2; ++prep_) { U = U0; if (prep_ < PROBE_SLC2) { fa_init(st); }
#define SLC_LOAD(j) do { const size_t rowk = tb + 64 * (j) + (tid >> 3); kr = *(const u32x4*)(KSb + rowk * 64 + (tid & 7) * 8); vr = *(const u32x4*)(PROJ + rowk * NPJ + 3008 + (tid & 7) * 8); } while (0)
    {
        int j = __builtin_ctzll(U); U &= U - 1ull;
        int jn = U ? __builtin_ctzll(U) : -1; U &= U - 1ull;
        SLC_LOAD(j); __syncthreads(); kv_store(Ks, Vs, tid, kr, vr); if (jn >= 0) SLC_LOAD(jn);
        for (int it = 0;; ++it) {
            __syncthreads();
            const int jnn = U ? __builtin_ctzll(U) : -1; U &= U - 1ull;
            if (jn >= 0) kv_store(Ks + ((it + 1) & 1) * 2 * KT_BYTES, Vs + ((it + 1) & 1) * 2 * KT_BYTES, tid, kr, vr);
            if (jnn >= 0) SLC_LOAD(jnn);
            const bool act[2] = {(bool)((QM[0] >> j) & 1ull), (bool)((QM[1] >> j) & 1ull)};
            if (act[0] || act[1]) { mk.k0 = 64 * j; mk.sel[0] = (msk[0] >> j) & 1ull; mk.sel[1] = (msk[1] >> j) & 1ull; fa_tile<2, true>(st, Q, Ks + (it & 1) * 2 * KT_BYTES, Vs + (it & 1) * 2 * KT_BYTES, lane, mk, act); }
            if (jn < 0) break; j = jn; jn = jnn;
        }
    }
#undef SLC_LOAD
    }
    float lse2[2]; fa_finish<2>(st, lse2);
    {   float* OSl = WSP(float, R_OSLC);
#pragma unroll
        for (int q = 0; q < 2; ++q) { float* o = OSl + (tb + mk.t[q]) * 256 + head * 64 + 4 * quad;
#pragma unroll
            for (int d = 0; d < 4; ++d) *(f32x4*)(o + 16 * d) = st.O[q][d]; }
    }
    FA<2> sw; fa_init(sw); sw.negM = -bnd_swa; SwaMask mw; mw.t[0] = mk.t[0]; mw.t[1] = mk.t[1];
    for (int prep_ = 0; prep_ <= PROBE_SWA2; ++prep_) { if (prep_ < PROBE_SWA2) fa_init(sw);
    {
        const int j0 = tbk >= 8 ? tbk - 8 : 0; const bool act[2] = {true, true};
#define SWA_LOAD(j) do { const size_t rowk = tb + 64 * (j) + (tid >> 3); kr = *(const u32x4*)(KWb + rowk * 64 + (tid & 7) * 8); vr = *(const u32x4*)(PROJ + rowk * NPJ + 3136 + (tid & 7) * 8); } while (0)
        SWA_LOAD(j0); __syncthreads(); kv_store(Ks, Vs, tid, kr, vr); if (j0 + 1 <= tbk) SWA_LOAD(j0 + 1);
        for (int j = j0; j <= tbk; ++j) {
            const int pb_ = (j - j0) & 1;
            __syncthreads();
            if (j + 1 <= tbk) kv_store(Ks + (pb_ ^ 1) * 2 * KT_BYTES, Vs + (pb_ ^ 1) * 2 * KT_BYTES, tid, kr, vr);
            if (j + 2 <= tbk) SWA_LOAD(j + 2);
            mw.k0 = 64 * j;
            if (j == tbk || j == tbk - 8) fa_tile<2, true>(sw, Q, Ks + pb_ * 2 * KT_BYTES, Vs + pb_ * 2 * KT_BYTES, lane, mw, act);
            else fa_tile<2, false>(sw, Q, Ks + pb_ * 2 * KT_BYTES, Vs + pb_ * 2 * KT_BYTES, lane, NoMask(), act);
        }
#undef SWA_LOAD
    }
    }
    fa_finish<2>(sw, lse2);
#pragma unroll
    for (int q = 0; q < 2; ++q) {
        const size_t row = tb + mk.t[q]; const float* gp = GATE + row * 12 + head * 3; const float g0 = gp[0], g1 = gp[1], g2 = gp[2];
        f32x4 o[4]; float ss = 0.f; const float* pc = WSP(float, R_OCMP) + row * 256 + head * 64 + 4 * quad; const float* ps = WSP(float, R_OSLC) + row * 256 + head * 64 + 4 * quad;
#pragma unroll
        for (int d = 0; d < 4; ++d) { o[d] = *(const f32x4*)(pc + 16 * d) * g0 + *(const f32x4*)(ps + 16 * d) * g1 + sw.O[q][d] * g2; ss += (o[d][0] * o[d][0] + o[d][1] * o[d][1]) + (o[d][2] * o[d][2] + o[d][3] * o[d][3]); }
        ss += __shfl_xor(ss, 16); ss += __shfl_xor(ss, 32);
        const float rstd = rsqrtf(ss * (1.f / 64.f) + 1e-6f); const float* og = C.onorm_g + (size_t)l * 768 + 512 + head * 64 + 4 * quad;
        bf16* yo = YCAT + row * DM + 768 + head * 64 + 4 * quad;
#pragma unroll
        for (int d = 0; d < 4; ++d) { const f32x4 g4 = *(const f32x4*)(og + 16 * d); u32x2 wv; wv.x = pk2(o[d][0] * rstd * g4[0], o[d][1] * rstd * g4[1]); wv.y = pk2(o[d][2] * rstd * g4[2], o[d][3] * rstd * g4[3]); *(u32x2*)(yo + 16 * d) = wv; }
    }
}

DI void fin_phase(const Ctx& C, int l) {
    const bf16* SCH = WSP(bf16, R_SCH); const float* YA = WSP(float, R_YA); const bf16* Gb = WSP(bf16, R_G); const float* OC = WSP(float, R_OC); const float* LSE = WSP(float, R_LSE);
    const float* UB = WSP(float, R_SCANU); const float* SMT = WSP(float, R_SCANS); bf16* YCAT = WSP(bf16, R_YCAT);
    const int lane = C.lane, ch = 4 * lane, hh = lane >> 4;
    LAS float* sm = (LAS float*)C.lds;
    LAS float* us = sm + 4 * 4096 + C.wave * 256;
    int bl = -1;
    for (int it = C.bid; it < NT / 128; it += C.G) {
        const int b = it >> 5, kk = it & 31;
        if (b != bl) { __syncthreads(); for (int i = C.tid; i < 4096; i += NTHR) *(LAS f32x4*)(sm + 4 * i) = *(const f32x4*)(SMT + (size_t)b * 4 * 4096 + 4 * i); bl = b; __syncthreads(); }
#pragma unroll 1
      for (int hf = 0; hf < 2; ++hf) {
        const int rbase = b * NS + hf * (NS / 2) + 64 * kk + C.wave * 8;
        const bool fix = hf == 1;
#pragma unroll 2
        for (int r = 0; r < 8; ++r) {
            const int row = rbase + r, s = row % NS;
            const size_t o = (size_t)row * 256 + ch;
            {
                f32x4 y = *(const f32x4*)(YA + o); const u32x2 rr_ = *(const u32x2*)(SCH + (size_t)3 * NT * 256 + o), k_ = *(const u32x2*)(SCH + o), v_ = *(const u32x2*)(SCH + (size_t)4 * NT * 256 + o), g_ = *(const u32x2*)(Gb + o);
                const f32x4 rr = (f32x4){bflo(rr_.x), bfhi(rr_.x), bflo(rr_.y), bfhi(rr_.y)}, k = (f32x4){bflo(k_.x), bfhi(k_.x), bflo(k_.y), bfhi(k_.y)}, v = (f32x4){bflo(v_.x), bfhi(v_.x), bflo(v_.y), bfhi(v_.y)}, g = (f32x4){bflo(g_.x), bfhi(g_.x), bflo(g_.y), bfhi(g_.y)};
                if (fix) {
                    *(LAS f32x4*)(us + ch) = *(const f32x4*)(UB + ((size_t)b * (NS / 2) + (s - NS / 2)) * 256 + ch);
                    asm volatile("s_waitcnt lgkmcnt(0)" ::: "memory");
                    const LAS float* sp = sm + hh * 4096 + 4 * (lane & 15); const LAS float* up = us + hh * 64;
#pragma unroll 8
                    for (int j4 = 0; j4 < 16; ++j4) { const f32x4 u4 = *(const LAS f32x4*)(up + 4 * j4);
#pragma unroll
                        for (int jj = 0; jj < 4; ++jj) y += *(const LAS f32x4*)(sp + (4 * j4 + jj) * 64) * u4[jj]; }
                    asm volatile("s_waitcnt lgkmcnt(0)" ::: "memory");
                }
                const f32x4 rk = *(const f32x4*)(C.rk + (size_t)l * 256 + ch), gw4 = *(const f32x4*)(C.gn_w + (size_t)l * 256 + ch), gb4 = *(const f32x4*)(C.gn_b + (size_t)l * 256 + ch);
                const float mu = group_sum<16>((y[0] + y[1]) + (y[2] + y[3])) * (1.f / 64.f);
                const f32x4 dy = y - mu; const float var = group_sum<16>((dy[0] * dy[0] + dy[1] * dy[1]) + (dy[2] * dy[2] + dy[3] * dy[3])) * (1.f / 64.f);
                const float rstd = rsqrtf(var + 64e-5f);
                const float dot = group_sum<16>((rr[0] * k[0] * rk[0] + rr[1] * k[1] * rk[1]) + (rr[2] * k[2] * rk[2] + rr[3] * k[3] * rk[3]));
                float out[4];
#pragma unroll
                for (int i = 0; i < 4; ++i) out[i] = ((dy[i] * rstd * gw4[i] + gb4[i]) + dot * v[i]) * g[i];
                u32x2 w; w.x = pk2(out[0], out[1]); w.y = pk2(out[2], out[3]); *(u32x2*)(YCAT + (size_t)row * DM + ch) = w;
            }
            {
                const float l0 = LSE[(size_t)row * 4 + hh], l1 = LSE[((size_t)NT + row) * 4 + hh], l2 = LSE[((size_t)2 * NT + row) * 4 + hh];
                const float mx = fmaxf(l0, fmaxf(l1, l2)); float w0 = fexp2(l0 - mx), w1 = fexp2(l1 - mx), w2 = fexp2(l2 - mx); const float inv = 1.f / (w0 + w1 + w2); w0 *= inv; w1 *= inv; w2 *= inv;
                const f32x4 a = *(const f32x4*)(OC + o), bq = *(const f32x4*)(OC + (size_t)NT * 256 + o), c = *(const f32x4*)(OC + (size_t)2 * NT * 256 + o);
                const f32x4 y = a * w0 + bq * w1 + c * w2;
                const float ss = group_sum<16>((y[0] * y[0] + y[1] * y[1]) + (y[2] * y[2] + y[3] * y[3])); const float rstd = rsqrtf(ss * (1.f / 64.f) + 1e-6f);
                const f32x4 og = *(const f32x4*)(C.onorm_g + (size_t)l * 768 + 256 + ch);
                u32x2 w; w.x = pk2(y[0] * rstd * og[0], y[1] * rstd * og[1]); w.y = pk2(y[2] * rstd * og[2], y[3] * rstd * og[3]); *(u32x2*)(YCAT + (size_t)row * DM + 512 + ch) = w;
            }
        }
      }
    }
    __syncthreads();
}

constexpr int CW_Q = 40000;
DI int q_next(const Ctx& C, unsigned* ctr, LAS int* slot) {
    __syncthreads();
    if (C.tid == 0) *slot = (int)__hip_atomic_fetch_add(ctr, 1u, __ATOMIC_RELAXED, __HIP_MEMORY_SCOPE_AGENT);
    __syncthreads();
    return *slot;
}
DI void conv_ticket(const Ctx& C, int l, int tk);
constexpr int CW_CD = 41000;
DI void cmp_mlp_unit(const Ctx& C, int l, int cb) {
    const int kv = cb >> 3;
    { pg8::Gemm g{kv ? WSP(bf16, R_VCR) : WSP(bf16, R_KCR), WSP(bf16, WS_WK1) + (size_t)(l * 2 + kv) * 256 * 2048, 1024, 2048}; pg8::StaticOrder S; S.init(8, 1, 8, cb & 7);
      EpiC1 E{WSP(bf16, R_CH1) + (size_t)kv * 2048 * 256, (WSP(float, WS_SMALL) + NLAYER * 8 * 6144 + l * 512 + kv * 256)}; pg8::gemm_phase(C.lds, C.tid, g, S, E); }
    asm volatile("s_waitcnt vmcnt(0)" ::: "memory"); __syncthreads();
    { pg8::Gemm g{WSP(bf16, R_CH1) + (size_t)kv * 2048 * 256, WSP(bf16, WS_WK2) + (size_t)(l * 2 + kv) * 256 * 256, 256, 256}; pg8::StaticOrder S; S.init(8, 1, 8, cb & 7);
      EpiC2 E{WSP(float, R_CMP) + (size_t)kv * 2048 * 64}; pg8::gemm_phase(C.lds, C.tid, g, S, E); }
    asm volatile("s_waitcnt vmcnt(0)" ::: "memory"); __syncthreads();
    if (C.tid == 0) { __builtin_amdgcn_fence(__ATOMIC_RELEASE, "agent"); asm volatile("s_waitcnt vmcnt(0)" ::: "memory");
        __hip_atomic_fetch_add(WSP(unsigned, WS_CTL) + CW_CD + 64 * l, 1u, __ATOMIC_RELAXED, __HIP_MEMORY_SCOPE_AGENT); }
}
DI void cmp_mlp_wait(const Ctx& C, int l) {
    if (C.tid == 0) { unsigned* c = WSP(unsigned, WS_CTL) + CW_CD + 64 * l; unsigned sp = 0u;
        while (__hip_atomic_load(c, __ATOMIC_RELAXED, __HIP_MEMORY_SCOPE_AGENT) < 16u) { __builtin_amdgcn_s_sleep(8); if (++sp > (1u << 21)) break; }
        __builtin_amdgcn_fence(__ATOMIC_ACQUIRE, "agent"); asm volatile("s_waitcnt vmcnt(0)" ::: "memory"); }
    __syncthreads();
}
DI void mix_phase(const Ctx& C, int l, int rep) {
    unsigned* ctl = WSP(unsigned, WS_CTL) + CW_Q + 64 * 3 * (l + 2 * rep); LAS int* slot = (LAS int*)(C.lds + MISC_OFF + 1024);
#ifndef PROBE_SPLIT
#define PROBE_SPLIT 0
#endif
    if (C.bid < 96) { scan_unit8(C, C.bid); if (PROBE_SCAN2) scan_unit8(C, C.bid); }
    else if (C.bid < 112) cmp_mlp_unit(C, l, C.bid - 96);
    bool cmp_ready = false;
    if (PROBE_SPLIT) { asm volatile("s_waitcnt vmcnt(0)" ::: "memory"); __syncthreads(); { XcdBarrier bar2; bar2.bar = WSP(unsigned, WS_CTL) + CW_BAR; bar2.x = xb_xcc_id(); bar2.st = (volatile LAS unsigned*)(C.lds + MISC_OFF); xcd_barrier(bar2); } }
    int bl = -1;
    const float bnd_cmp = score_bound(C.nsa_q_g + (size_t)l * 64, C.nsa_kc_g + (size_t)l * 64, C.lane), bnd_slc = score_bound(C.nsa_q_g + (size_t)l * 64, C.nsa_ks_g + (size_t)l * 64, C.lane),
                bnd_swa = score_bound(C.nsa_q_g + (size_t)l * 64, C.nsa_kw_g + (size_t)l * 64, C.lane), bnd_dil = score_bound(C.dil_q_g + (size_t)l * 64, C.dil_k_g + (size_t)l * 64, C.lane);
    bool conv_left = true;
#define CONV_ONE() do { if (conv_left) { const int t_ = q_next(C, ctl + 128, slot); if (t_ >= 768 * (1 + PROBE_CONV2)) conv_left = false; else { conv_ticket(C, l, t_ % 768); bl = -1; } } } while (0)
    for (;;) { const int u = q_next(C, ctl, slot); if (u >= 512 * (1 + PROBE_ATT2)) break; nsa_unit(C, l, u & 7, 63 - ((u & 511) >> 3), bl, cmp_ready, bnd_cmp, bnd_slc, bnd_swa); CONV_ONE(); }
    for (int n = 0;; ++n) { const int u = q_next(C, ctl + 64, slot); if (u >= 1536 * (1 + PROBE_ATT2)) break; dil_unit(C, u % 1536, C.lds, C.lds + KT_BYTES, bnd_dil); if ((n & 3) == 3) CONV_ONE(); }
    while (conv_left) CONV_ONE();
#undef CONV_ONE if (C.bid >= 96)
    __syncthreads();
}
#define MFMA_F32(a, b, c) __builtin_amdgcn_mfma_f32_16x16x4f32((a), (b), (c), 0, 0, 0)
DI void router_phase(const Ctx& C, int l) {
    const float* X = C.out; const float* MOD = WSP(float, WS_SMALL) + (size_t)l * 8 * 6144; unsigned char* H8 = WSP(unsigned char, R_XS);
    int* TOPE = WSP(int, WS_ROUTE); float* TOPG = (float*)(TOPE + NT * 4); unsigned* CNTB = WSP(unsigned, WS_CTL) + CW_CNT + l * 8192;
    LAS float* wl = (LAS float*)C.lds;
    LAS float* lg = (LAS float*)(C.lds + MISC_OFF + 8192) + C.wave * 512;
    LAS unsigned* hist = (LAS unsigned*)(C.lds + MISC_OFF + 6144);
    LAS float* rs = (LAS float*)(C.lds + MISC_OFF + 6400) + C.wave * 16;
    const int lane = C.lane, l15 = lane & 15, quad = lane >> 4, gw = C.bid * NWAVE + C.wave, NGW = C.G * NWAVE;
    const float* wr = C.w_router + (size_t)l * 1024 * 32; const float* g2 = C.norm2_g + (size_t)l * DM;
    __syncthreads();
    if (C.tid < 32) hist[C.tid] = 0u;
    for (int i = C.tid; i < 8192; i += NTHR) { const int k = i >> 3, e4 = (i & 7) * 4; const f32x4 v = *(const f32x4*)(wr + (size_t)k * 32 + e4); LAS float* d = wl + ((k >> 2) * 32 + e4) * 4 + (k & 3);
        d[0] = v[0]; d[4] = v[1]; d[8] = v[2]; d[12] = v[3]; }
    __syncthreads();
    for (int task = gw; task < NT / 16; task += NGW) {
        const int row0 = 16 * task, b = row0 / NS;
        const float* shb = MOD + (size_t)b * 6144 + 3072; const float* scb = shb + 1024;
        {
            f32x4 gg[4], sa[4], sb[4];
#pragma unroll
            for (int j = 0; j < 4; ++j) { const int k = 4 * lane + 256 * j; const f32x4 g = *(const f32x4*)(g2 + k), a = *(const f32x4*)(scb + k); gg[j] = g * (a + 1.f); sb[j] = *(const f32x4*)(shb + k); }
#pragma unroll 2
            for (int r = 0; r < 16; ++r) {
                const float* xr = X + (size_t)(row0 + r) * DM + 4 * lane; f32x4 v[4]; float ss = 0.f;
#pragma unroll
                for (int j = 0; j < 4; ++j) { v[j] = *(const f32x4*)(xr + 256 * j); ss += (v[j][0] * v[j][0] + v[j][1] * v[j][1]) + (v[j][2] * v[j][2] + v[j][3] * v[j][3]); }
                ss = group_sum<64>(ss); const float rstd = rsqrtf(ss * (1.f / DM) + 1e-6f);
                if (lane == 0) rs[r] = rstd;
                unsigned char* hp = H8 + (size_t)(row0 + r) * DM + 4 * lane;
#pragma unroll
                for (int j = 0; j < 4; ++j) { const f32x4 h = v[j] * rstd * gg[j] + sb[j]; *(unsigned*)(hp + 256 * j) = pk4_fp8(h[0], h[1], h[2], h[3]); }
            }
        }
        const float* xr = X + (size_t)(row0 + l15) * DM + 4 * quad; const float* sh = shb + 4 * quad; const float* sc = scb + 4 * quad;
        asm volatile("s_waitcnt lgkmcnt(0)" ::: "memory");
        const float rstd = rs[l15];
        f32x4 acc0 = (f32x4){0.f, 0.f, 0.f, 0.f}, acc1 = acc0;
#pragma unroll 2
        for (int i = 0; i < 64; ++i) {
            const f32x4 a = *(const f32x4*)(xr + 16 * i), g = *(const f32x4*)(g2 + 16 * i + 4 * quad), s1 = *(const f32x4*)(sc + 16 * i), s0 = *(const f32x4*)(sh + 16 * i);
            f32x4 h;
#pragma unroll
            for (int j = 0; j < 4; ++j) h[j] = a[j] * rstd * g[j] * (1.f + s1[j]) + s0[j];
            const LAS float* wp = wl + ((4 * i + quad) * 32 + l15) * 4; const f32x4 w0 = *(const LAS f32x4*)wp, w1 = *(const LAS f32x4*)(wp + 64);
#pragma unroll
            for (int j = 0; j < 4; ++j) { acc0 = MFMA_F32(h[j], w0[j], acc0); acc1 = MFMA_F32(h[j], w1[j], acc1); }
        }
        const float b0 = C.b_router[l * 32 + l15], b1 = C.b_router[l * 32 + 16 + l15];
#pragma unroll
        for (int j = 0; j < 4; ++j) { lg[(4 * quad + j) * 32 + l15] = acc0[j] + b0; lg[(4 * quad + j) * 32 + 16 + l15] = acc1[j] + b1; }
        asm volatile("s_waitcnt lgkmcnt(0)" ::: "memory");
        if (lane < 16) {
            float v[32];
#pragma unroll
            for (int i = 0; i < 8; ++i) { const f32x4 a = *(const LAS f32x4*)(lg + lane * 32 + 4 * i); v[4 * i] = a[0]; v[4 * i + 1] = a[1]; v[4 * i + 2] = a[2]; v[4 * i + 3] = a[3]; }
            float tv[4]; int ti[4];
#pragma unroll
            for (int r = 0; r < 4; ++r) { float bv = -3.0e38f; int bi = 0;
#pragma unroll
                for (int e = 0; e < 32; ++e) if (v[e] > bv) { bv = v[e]; bi = e; }
                tv[r] = bv; ti[r] = bi;
#pragma unroll
                for (int e = 0; e < 32; ++e) v[e] = (e == bi) ? -3.0e38f : v[e]; }
            const float e1 = __expf(tv[1] - tv[0]), e2 = __expf(tv[2] - tv[0]), e3 = __expf(tv[3] - tv[0]), inv = 1.f / (1.f + e1 + e2 + e3);
            const int row = row0 + lane;
            *(int4*)(TOPE + (size_t)row * 4) = make_int4(ti[0], ti[1], ti[2], ti[3]);
            *(f32x4*)(TOPG + (size_t)row * 4) = (f32x4){inv, e1 * inv, e2 * inv, e3 * inv};
#pragma unroll
            for (int r = 0; r < 4; ++r) __hip_atomic_fetch_add(&hist[ti[r]], 1u, __ATOMIC_RELAXED, __HIP_MEMORY_SCOPE_WORKGROUP);
        }
        asm volatile("s_waitcnt lgkmcnt(0)" ::: "memory");
    }
    __syncthreads();
    if (C.tid < 32) CNTB[C.bid * 32 + C.tid] = hist[C.tid];
}

DI void moe_tables(const Ctx& C, int l, LAS int* tab) {
    const unsigned* CNTB = WSP(unsigned, WS_CTL) + CW_CNT + l * 8192;
    LAS unsigned* part = (LAS unsigned*)(tab + 192);
    __syncthreads();
    { const int e = C.tid & 31, pt = C.tid >> 5; unsigned tot = 0u, mine = 0u;
        const int g0 = pt * ((C.G + 15) >> 4), g1 = min(C.G, g0 + ((C.G + 15) >> 4));
#pragma unroll 16
        for (int g = g0; g < g1; ++g) { const unsigned c = CNTB[g * 32 + e]; tot += c; mine += (g < C.bid) ? c : 0u; }
        part[(pt * 2) * 32 + e] = tot; part[(pt * 2 + 1) * 32 + e] = mine; }
    __syncthreads();
    if (C.tid < 32) { unsigned tot = 0u, mine = 0u;
#pragma unroll
        for (int pt = 0; pt < 16; ++pt) { tot += part[(pt * 2) * 32 + C.tid]; mine += part[(pt * 2 + 1) * 32 + C.tid]; }
        tab[128 + C.tid] = (int)((tot + 255u) >> 8); tab[64 + C.tid] = (int)mine; }
    __syncthreads();
    if (C.tid == 0) { int s = 0; for (int e = 0; e < 32; ++e) { tab[e] = s; s += tab[128 + e]; } tab[32] = s; }
    __syncthreads();
}
DI void scatter_phase(const Ctx& C, int l) {
    const int* TOPE = WSP(int, WS_ROUTE); int* POS = (int*)(TOPE + NT * 8); int* ROWMAP = (int*)(TOPE + NT * 12);
    LAS int* tab = (LAS int*)(C.lds + MISC_OFF + 64); LAS unsigned* cur = (LAS unsigned*)(C.lds + 16384);
    moe_tables(C, l, tab);
    if (C.tid < 32) cur[C.tid] = (unsigned)(tab[C.tid] * 256 + tab[64 + C.tid]);
    __syncthreads();
    const int lane = C.lane, gw = C.bid * NWAVE + C.wave, NGW = C.G * NWAVE;
    for (int task = gw; task < NT / 16; task += NGW) {
        const int row0 = 16 * task, tok = row0 + (lane >> 2);
        const int e = TOPE[(size_t)tok * 4 + (lane & 3)];
        const int slot = (int)__hip_atomic_fetch_add(&cur[e], 1u, __ATOMIC_RELAXED, __HIP_MEMORY_SCOPE_WORKGROUP);
        POS[(size_t)tok * 4 + (lane & 3)] = slot; ROWMAP[slot] = tok;
    }
}
DI void combine_phase(const Ctx& C, int l, float* dst) {
    const bf16* YB = WSP(bf16, R_YB); const int* TOPE = WSP(int, WS_ROUTE); const float* TOPG = (const float*)(TOPE + NT * 4); const int* POS = (const int*)(TOPE + NT * 8);
    const float* MOD = WSP(float, WS_SMALL) + (size_t)l * 8 * 6144; bf16* H = WSP(bf16, WS_H);
    const int lane = C.lane, gw = C.bid * NWAVE + C.wave, NGW = C.G * NWAVE;
    for (int task = gw; task < NT / 16; task += NGW) {
        const int row0 = 16 * task, b = row0 / NS; const float* gt = MOD + (size_t)b * 6144 + 5120 + 8 * lane;
        f32x4 g4[4], gg[4], sb[4];
#pragma unroll
        for (int j = 0; j < 2; ++j) { g4[2 * j] = *(const f32x4*)(gt + 512 * j); g4[2 * j + 1] = *(const f32x4*)(gt + 512 * j + 4); }
        if (l + 1 < NLAYER) { const float* M2 = MOD + 8 * 6144 + (size_t)b * 6144 + 8 * lane; const float* g = C.norm1_g + (size_t)(l + 1) * DM + 8 * lane;
#pragma unroll
            for (int j = 0; j < 2; ++j)
#pragma unroll
                for (int hlf = 0; hlf < 2; ++hlf) { const int o = 512 * j + 4 * hlf; gg[2 * j + hlf] = *(const f32x4*)(g + o) * (*(const f32x4*)(M2 + 1024 + o) + 1.f); sb[2 * j + hlf] = *(const f32x4*)(M2 + o); } }
#pragma unroll 2
        for (int r = 0; r < 16; ++r) {
            const int row = row0 + r; const int4 ps = *(const int4*)(POS + (size_t)row * 4); const f32x4 gk = *(const f32x4*)(TOPG + (size_t)row * 4);
            const int pp[4] = {ps.x, ps.y, ps.z, ps.w};
            const float* orow = C.out + (size_t)row * DM + 8 * lane; float* drow = dst + (size_t)row * DM + 8 * lane;
            u32x4 y[4][2]; f32x4 x[4];
#pragma unroll
            for (int q = 0; q < 4; ++q)
#pragma unroll
                for (int j = 0; j < 2; ++j) y[q][j] = *(const u32x4*)(YB + (size_t)pp[q] * DM + 8 * lane + 512 * j);
#pragma unroll
            for (int j = 0; j < 2; ++j) { x[2 * j] = *(const f32x4*)(orow + 512 * j); x[2 * j + 1] = *(const f32x4*)(orow + 512 * j + 4); }
            f32x4 v[4]; float s = 0.f;
#pragma unroll
            for (int j = 0; j < 2; ++j) { f32x4 a0 = (f32x4){0.f, 0.f, 0.f, 0.f}, a1 = a0;
#pragma unroll
                for (int q = 0; q < 4; ++q) { const u32x4 w = y[q][j]; a0 += (f32x4){bflo(w.x), bfhi(w.x), bflo(w.y), bfhi(w.y)} * gk[q]; a1 += (f32x4){bflo(w.z), bfhi(w.z), bflo(w.w), bfhi(w.w)} * gk[q]; }
                v[2 * j] = x[2 * j] + g4[2 * j] * a0; v[2 * j + 1] = x[2 * j + 1] + g4[2 * j + 1] * a1;
                *(f32x4*)(drow + 512 * j) = v[2 * j]; *(f32x4*)(drow + 512 * j + 4) = v[2 * j + 1]; }
#pragma unroll
            for (int i = 0; i < 4; ++i) s += (v[i][0] * v[i][0] + v[i][1] * v[i][1]) + (v[i][2] * v[i][2] + v[i][3] * v[i][3]);
            if (l + 1 < NLAYER) {
                s = group_sum<64>(s); const float rstd = rsqrtf(s * (1.f / DM) + 1e-6f); bf16* hrow = H + (size_t)row * DM + 8 * lane;
#pragma unroll
                for (int j = 0; j < 2; ++j) { const f32x4 h0 = v[2 * j] * rstd * gg[2 * j] + sb[2 * j], h1 = v[2 * j + 1] * rstd * gg[2 * j + 1] + sb[2 * j + 1]; u32x4 o;
                    if (INPROJ_FP8) { u32x2 o8; o8.x = pk4_fp8(h0[0], h0[1], h0[2], h0[3]); o8.y = pk4_fp8(h1[0], h1[1], h1[2], h1[3]); *(u32x2*)((unsigned char*)H + (size_t)row * DM + 8 * lane + 512 * j) = o8; }
                    else { o.x = pk2(h0[0], h0[1]); o.y = pk2(h0[2], h0[3]); o.z = pk2(h1[0], h1[1]); o.w = pk2(h1[2], h1[3]); *(u32x4*)(hrow + 512 * j) = o; } }
            }
        }
    }
}
constexpr int PH_PER_LAYER = 11, PH_BASE = 2, N_PHASES = PH_BASE + NLAYER * PH_PER_LAYER;
#ifndef MK_ONE_LAUNCH
#define MK_ONE_LAUNCH 1
#endif
__global__ void __launch_bounds__(NTHR, 2) mk_fwd(Args args) {
    extern __shared__ __attribute__((aligned(16))) unsigned char lds_raw[];
    Ctx C;
    C.lds = (LAS unsigned char*)lds_raw; C.tid = threadIdx.x; C.lane = C.tid & 63; C.wave = __builtin_amdgcn_readfirstlane(C.tid >> 6); C.G = gridDim.x; C.bid = blockIdx.x;
    C.x = (const float*)args.in[0]; C.c = (const float*)args.in[1]; C.pos = (const int*)args.in[2]; C.w_ada = (const float*)args.in[3]; C.b_ada = (const float*)args.in[4];
    C.norm1_g = (const float*)args.in[5]; C.norm2_g = (const float*)args.in[6]; C.w_in = (const float*)args.in[7]; C.w_out = (const float*)args.in[8]; C.mu = (const float*)args.in[9];
    C.w0 = (const float*)args.in[10]; C.w2 = (const float*)args.in[11]; C.a0 = (const float*)args.in[12]; C.a2 = (const float*)args.in[13]; C.g2 = (const float*)args.in[14];
    C.kkw = (const float*)args.in[15]; C.ka = (const float*)args.in[16]; C.rk = (const float*)args.in[17]; C.gn_w = (const float*)args.in[18]; C.gn_b = (const float*)args.in[19];
    C.conv_w = (const float*)args.in[20]; C.dil_q_g = (const float*)args.in[21]; C.dil_k_g = (const float*)args.in[22]; C.nsa_q_g = (const float*)args.in[23]; C.nsa_kc_g = (const float*)args.in[24];
    C.nsa_ks_g = (const float*)args.in[25]; C.nsa_kw_g = (const float*)args.in[26]; C.pe_k = (const float*)args.in[27]; C.pe_v = (const float*)args.in[28]; C.wk1 = (const float*)args.in[29];
    C.wk2 = (const float*)args.in[30]; C.wv1 = (const float*)args.in[31]; C.wv2 = (const float*)args.in[32]; C.onorm_g = (const float*)args.in[33]; C.w_router = (const float*)args.in[34];
    C.b_router = (const float*)args.in[35]; C.w_gu = (const float*)args.in[36]; C.b_gu = (const float*)args.in[37]; C.w_down = (const float*)args.in[38]; C.b_down = (const float*)args.in[39];
    C.out = args.out; C.ws = args.ws;
    const int lo = args.ph_lo, hi = args.ph_hi;
    for (int u = C.tid; u < (LDS_BYTES - MISC_OFF) / 4; u += NTHR) ((LAS unsigned*)(C.lds + MISC_OFF))[u] = 0u;
    __syncthreads();
    XcdBarrier bar; bar.bar = WSP(unsigned, WS_CTL) + CW_BAR; bar.x = 0; bar.st = nullptr;
    if (hi - lo > 1) bar = xcd_barrier_post(WSP(unsigned, WS_CTL) + CW_BAR, (volatile LAS unsigned*)(C.lds + MISC_OFF));
#ifndef PHMASK
#define PHMASK 0xFFFFFFFFu
#endif
#define PHON(n) (((PHMASK) >> (n)) & 1u)
#ifndef PHREP
#define PHREP 0u
#endif
#define NREP(n) (1 + (int)(((PHREP) >> (n)) & 1u))
#define WSPP(T, off) ((T*)(P.ws + (off)))
#define IN(k) (lo <= (k) && (k) < hi)
#define SEAM(k) do { if (IN(k) && IN((k) + 1)) xcd_barrier(bar); } while (0)
#define PCTX Ctx P = C; asm volatile("" : "+v"(P.tid), "+v"(P.lane)); asm volatile("" : "+s"(P.ws), "+s"(P.out), "+s"(P.wave), "+s"(P.bid))
    if (PHON(17) && IN(0)) for (int rep = 0; rep < NREP(17); ++rep) { PCTX; p0_prologue(P); __syncthreads(); }
    SEAM(0);
#ifndef PROBE_BARS
#define PROBE_BARS 0
#endif
    if (hi - lo > 1) for (int i = 0; i < PROBE_BARS; ++i) xcd_barrier(bar);
    if (PHON(18) && IN(1)) { PCTX; norm1_phase(P, 0, P.x); }
    SEAM(1);
    for (int l = 0; l < NLAYER; ++l) {
        const int pb = PH_BASE + PH_PER_LAYER * l;
        if (PHON(0) && IN(pb + 0)) for (int rep = 0; rep < NREP(0); ++rep) { PCTX;
            pg8::StaticOrder S; S.init(NT / 256, NPJ / 256, P.G, P.bid);
            if (INPROJ_FP8) { pg8::Gemm g{WSPP(bf16, WS_H), WSPP(bf16, WS_WIN) + (size_t)l * NPJ * 512, 512, 512, WSPP(int, WS_ROUTE) + NT * 12 + NR, 0x3FFFF}; EpiProj E{WSPP(bf16, R_PROJ), W8_INV}; pg8::gemm_phase<EpiProj, pg8::StaticOrder, true, true>(P.lds, P.tid, g, S, E); }
            else { pg8::Gemm g{WSPP(bf16, WS_H), WSPP(bf16, WS_WIN) + (size_t)l * NPJ * 1024, 1024, 1024}; EpiProj E{WSPP(bf16, R_PROJ), 1.f}; pg8::gemm_phase(P.lds, P.tid, g, S, E); }
        }
        SEAM(pb + 0);
        if (PHON(1) && IN(pb + 1)) for (int rep = 0; rep < NREP(1); ++rep) { PCTX; prep_phase(P, l); __syncthreads(); }
        SEAM(pb + 1);
        if (PHON(2) && IN(pb + 2)) for (int rep = 0; rep < NREP(2); ++rep) { PCTX;
            { pg8::Gemm g{WSPP(bf16, R_LIN), WSPP(bf16, WS_LORA) + (size_t)l * 768 * 256, 256, 256}; pg8::StaticOrder S; S.init(NT / 256, 3, P.G, P.bid);
              EpiLora E{WSPP(float, R_SC), WSPP(bf16, R_SCH), WSPP(bf16, R_G), P.w0 + l * 256, P.a0 + l * 256, P.ka + l * 256, (rep + 1 < NREP(2)) ? WSPP(bf16, WS_END) : WSPP(bf16, R_SCH), (rep + 1 < NREP(2)) ? WSPP(float, WS_END) + 64 * MiB : WSPP(float, R_SC)}; pg8::gemm_phase(P.lds, P.tid, g, S, E); }
        }
        SEAM(pb + 2);
        if (PHON(3) && IN(pb + 3)) for (int rep = 0; rep < NREP(3); ++rep) { PCTX; mix_phase(P, l, rep); }
        SEAM(pb + 3);
        if (PHON(4) && IN(pb + 4)) for (int rep = 0; rep < NREP(4); ++rep) { PCTX; fin_phase(P, l); __syncthreads(); }
        SEAM(pb + 4);
        if (PHON(5) && IN(pb + 5)) for (int rep = 0; rep < NREP(5); ++rep) { PCTX;
            pg8::Gemm g{WSPP(bf16, R_YCAT), WSPP(bf16, WS_WOUT) + (size_t)l * 1024 * 1024, 1024, 1024}; pg8::StaticOrder S; S.init(NT / 256, 4, P.G, P.bid);
            EpiOut E{(rep + 1 < NREP(5)) ? WSPP(float, WS_END) : P.out, l == 0 ? P.x : (const float*)P.out, WSPP(float, WS_SMALL) + (size_t)l * 8 * 6144 + 2048}; pg8::gemm_phase(P.lds, P.tid, g, S, E);
        }
        SEAM(pb + 5);
        if (PHON(6) && IN(pb + 6)) for (int rep = 0; rep < NREP(6); ++rep) { PCTX; router_phase(P, l); __syncthreads(); }
        SEAM(pb + 6);
        if (PHON(7) && IN(pb + 7)) for (int rep = 0; rep < NREP(7); ++rep) { PCTX; scatter_phase(P, l); __syncthreads(); }
        SEAM(pb + 7);
        if (PHON(8) && IN(pb + 8)) for (int rep = 0; rep < NREP(8); ++rep) { PCTX;
            LAS int* tab = (LAS int*)(P.lds + MISC_OFF + 64); moe_tables(P, l, tab);
            pg8::Gemm g{WSPP(bf16, R_XS), WSPP(bf16, WS_WGU) + (size_t)l * 32 * 2048 * 512, 512, 512, WSPP(int, WS_ROUTE) + NT * 12, 32767};
            pg8::GroupedOrder S; S.init(tab[32], 8, P.G, P.bid); S.tstart = tab; S.nrow_e = 2048;
            EpiGU8 E{WSPP(unsigned char, R_ACT), P.b_gu + (size_t)l * 32 * 2048}; pg8::gemm_phase<EpiGU8, pg8::GroupedOrder, true, true>(P.lds, P.tid, g, S, E);
        }
        SEAM(pb + 8);
        if (PHON(9) && IN(pb + 9)) for (int rep = 0; rep < NREP(9); ++rep) { PCTX;
            LAS int* tab = (LAS int*)(P.lds + MISC_OFF + 64); moe_tables(P, l, tab);
            pg8::Gemm g{WSPP(bf16, R_ACT), WSPP(bf16, WS_WDN) + (size_t)l * 32 * 1024 * 512, 512, 512, WSPP(int, WS_ROUTE) + NT * 12 + NR, 0x3FFFF}; pg8::GroupedOrder S; S.init(tab[32], 4, P.G, P.bid); S.tstart = tab; S.nrow_e = 1024;
            EpiDN8 E{WSPP(bf16, R_YB), P.b_down + (size_t)l * 32 * 1024}; pg8::gemm_phase<EpiDN8, pg8::GroupedOrder, true, true>(P.lds, P.tid, g, S, E);
        }
        SEAM(pb + 9);
        if (PHON(10) && IN(pb + 10)) for (int rep = 0; rep < NREP(10); ++rep) { PCTX; combine_phase(P, l, (rep + 1 < NREP(10)) ? WSPP(float, WS_END) : P.out); __syncthreads(); }
        SEAM(pb + 10);
    }
#undef IN
#undef SEAM
}

extern "C" void kernel_launch(void* const* d_in, const int* in_sizes, int n_in, void* d_out, int out_size, void* d_ws, size_t ws_size, hipStream_t stream) {
    static int grid = 0;
    if (grid == 0) {
        if (n_in != 40 || out_size != NT * DM || ws_size < WS_END + 256 * MiB) { fprintf(stderr, "kernel_launch: unexpected problem (n_in %d, out %d, ws %zu < %zu)\n", n_in, out_size, ws_size, (size_t)WS_END); grid = -1; return; }
        int dev = 0, cus = 0, per_cu = 0;
        if (hipGetDevice(&dev) != hipSuccess || hipDeviceGetAttribute(&cus, hipDeviceAttributeMultiprocessorCount, dev) != hipSuccess) { grid = -1; return; }
        if (hipFuncSetAttribute((const void*)mk_fwd, hipFuncAttributeMaxDynamicSharedMemorySize, LDS_BYTES) != hipSuccess) { fprintf(stderr, "kernel_launch: hipFuncSetAttribute failed\n"); grid = -1; return; }
        if (hipOccupancyMaxActiveBlocksPerMultiprocessor(&per_cu, (const void*)mk_fwd, NTHR, LDS_BYTES) != hipSuccess || per_cu < 1) fprintf(stderr, "kernel_launch: occupancy query says %d blocks per CU\n", per_cu);
        (void)hipGetLastError();
        grid = cus > 256 ? 256 : cus;
    }
    if (grid < 0) return;
    (void)hipMemsetAsync((char*)d_ws, 0, ZERO_BYTES, stream);
    Args a{};
    for (int i = 0; i < 40; ++i) a.in[i] = d_in[i];
    a.out = (float*)d_out; a.ws = (unsigned char*)d_ws;
#if MK_ONE_LAUNCH
    a.ph_lo = 0; a.ph_hi = N_PHASES;
    hipLaunchKernelGGL(mk_fwd, dim3(grid), dim3(NTHR), LDS_BYTES, stream, a);
#else
    for (int p = 0; p < N_PHASES; ++p) { a.ph_lo = p; a.ph_hi = p + 1; hipLaunchKernelGGL(mk_fwd, dim3(grid), dim3(NTHR), LDS_BYTES, stream, a); }
#endif
    const hipError_t le = hipPeekAtLastError();
    if (le != hipSuccess) fprintf(stderr, "kernel_launch: launch failed: %s\n", hipGetErrorName(le));
}
```

```cpp
#include <hip/hip_runtime.h>
#include <cstdio>
#include <cstdint>

#define DI __device__ __forceinline__
#define LAS __attribute__((address_space(3)))
#define GAS __attribute__((address_space(1)))
typedef unsigned short bf16;
typedef short bf16x8 __attribute__((ext_vector_type(8)));
typedef float f32x4 __attribute__((ext_vector_type(4)));
typedef float f32x2 __attribute__((ext_vector_type(2)));
typedef unsigned u32x4 __attribute__((ext_vector_type(4)));
typedef unsigned u32x2 __attribute__((ext_vector_type(2)));
typedef unsigned char uchar;

#ifndef PROBE_SCAN2
#define PROBE_SCAN2 0
#endif
#ifndef PROBE_ATT2
#define PROBE_ATT2 0
#endif
#ifndef PROBE_CONV2
#define PROBE_CONV2 0
#endif
#ifndef INPROJ_FP8
#define INPROJ_FP8 0
#endif
constexpr int NB = 8, NS = 4096, NT = NB * NS, DM = 1024, NPJ = 3328, NE = 32, FF = 1024, NLAYER = 2;
constexpr int PJ_A = 0, PJ_B = 1024, PJ_C = 1792, PJ_D = 2560;
constexpr int NR = NT * 4 + NE * 256;
constexpr int NTHR = 512, NWAVE = 8;

DI float bf2f(unsigned v) { return __builtin_bit_cast(float, v << 16); }
DI unsigned f2bf(float f) { unsigned u = __builtin_bit_cast(unsigned, f); return (u + 0x7fffu + ((u >> 16) & 1u)) >> 16; }
DI unsigned pk2(float lo, float hi) { return f2bf(lo) | (f2bf(hi) << 16); }
DI float bflo(unsigned w) { return __builtin_bit_cast(float, w << 16); }
DI float bfhi(unsigned w) { return __builtin_bit_cast(float, w & 0xffff0000u); }
DI float fexp2(float x) { return __builtin_amdgcn_exp2f(x); }
DI float fsigmoid(float x) { return __builtin_amdgcn_rcpf(1.f + __builtin_amdgcn_exp2f(-1.44269504089f * x)); }
DI float wsum_xor(float v, int o) { return v + __shfl_xor(v, o); }
template <int CTRL> DI float dppmov(float x) { return __builtin_bit_cast(float, __builtin_amdgcn_update_dpp(0, __builtin_bit_cast(int, x), CTRL, 0xF, 0xF, true)); }
template <int W> DI float group_sum(float v) {
    if (W >= 2) v += dppmov<0xB1>(v);
    if (W >= 4) v += dppmov<0x4E>(v);
    if (W >= 8) v += dppmov<0x141>(v);
    if (W >= 16) v += dppmov<0x140>(v);
    if (W >= 32) v += __shfl_xor(v, 16);
    if (W >= 64) v += __shfl_xor(v, 32);
    return v;
}
DI float sum8(float x) { x += dppmov<0xB1>(x); x += dppmov<0x4E>(x); x += dppmov<0x141>(x); return x; }

#define XB_TMO      128
#define XB_XCNT(j)  (256  + 64 * (j))
#define XB_XSUB(j)  (1280 + 64 * (j))
#define XB_XGEN(j)  (2304 + 64 * (j))
#define XB_TOP      3328
#define XB_TOPGEN   3392
#define XCD_BAR_WORDS 3456
#define XB_SPIN_CAP (1u << 18)
DI unsigned xb_ld(unsigned* p)              { return __hip_atomic_load(p, __ATOMIC_RELAXED, __HIP_MEMORY_SCOPE_AGENT); }
DI unsigned xb_add(unsigned* p, unsigned v) { return __hip_atomic_fetch_add(p, v, __ATOMIC_RELAXED, __HIP_MEMORY_SCOPE_AGENT); }
DI unsigned xb_xcc_id() { return (unsigned)__builtin_amdgcn_s_getreg((3 << 11) | 20) & 0xFu; }
#define XB_SPIN(cond, bar) do { unsigned _sp = 0; while (cond) { __builtin_amdgcn_s_sleep(1); \
    if ((++_sp & 255u) == 0u) { if (xb_ld(&(bar)[XB_TMO])) break; if (_sp > XB_SPIN_CAP) { atomicAdd(&(bar)[XB_TMO], 1u); break; } } } } while (0)
struct XcdBarrier { unsigned* bar; unsigned x; volatile LAS unsigned* st; };
DI XcdBarrier xcd_barrier_post(unsigned* bar, volatile LAS unsigned* st) {
    XcdBarrier b; b.bar = bar; b.x = xb_xcc_id(); b.st = st;
    if (threadIdx.x == 0) (void)xb_add(&bar[XB_XCNT(b.x)], 1u);
    return b;
}
DI void xcd_barrier_complete(unsigned* bar, unsigned x, unsigned& nloc, unsigned& nx) {
    const unsigned G = gridDim.x * gridDim.y * gridDim.z;
    unsigned sum, cnt, mine, sp = 0u;
    for (;;) {
        sum = 0u; cnt = 0u; mine = 0u;
#pragma unroll
        for (unsigned j = 0; j < 16; ++j) { const unsigned c = xb_ld(&bar[XB_XCNT(j)]); sum += c; cnt += (c > 0u) ? 1u : 0u; mine = (j == x) ? c : mine; }
        if (sum == G) break;
        __builtin_amdgcn_s_sleep(1);
        if ((++sp & 255u) == 0u) { if (xb_ld(&bar[XB_TMO])) break; if (sp > XB_SPIN_CAP) { atomicAdd(&bar[XB_TMO], 1u); break; } }
    }
    nloc = mine > 0u ? mine : 1u; nx = cnt > 0u ? cnt : 1u;
}
DI void xcd_barrier(const XcdBarrier& b) {
    asm volatile("s_waitcnt vmcnt(0)" ::: "memory");
    __syncthreads();
    if (threadIdx.x == 0) {
        unsigned* bar = b.bar;
        __builtin_amdgcn_s_waitcnt(0);
        unsigned nloc = b.st[0], nx = b.st[1];
        if (nloc == 0u) { xcd_barrier_complete(bar, b.x, nloc, nx); b.st[0] = nloc; b.st[1] = nx; }
        const unsigned old = xb_add(&bar[XB_XSUB(b.x)], 1u);
        const unsigned gen = old / nloc;
        if (old + 1u == (gen + 1u) * nloc) {
            __builtin_amdgcn_fence(__ATOMIC_RELEASE, "agent");
            asm volatile("s_waitcnt vmcnt(0)" ::: "memory");
            const unsigned og = xb_add(&bar[XB_TOP], 1u);
            const unsigned tg = og / nx;
            if (og + 1u == (tg + 1u) * nx) xb_add(&bar[XB_TOPGEN], 1u);
            else XB_SPIN(xb_ld(&bar[XB_TOPGEN]) == tg, bar);
            __builtin_amdgcn_fence(__ATOMIC_ACQUIRE, "agent");
            xb_add(&bar[XB_XGEN(b.x)], 1u);
            asm volatile("s_waitcnt vmcnt(0)" ::: "memory");
        } else {
            XB_SPIN(xb_ld(&bar[XB_XGEN(b.x)]) == gen, bar);
            __builtin_amdgcn_fence(__ATOMIC_ACQUIRE, "agent");
            asm volatile("s_waitcnt vmcnt(0)" ::: "memory");
        }
    }
    __syncthreads();
}
namespace pg8 {
constexpr int BM = 256, BK = 64, HALF = 128, HTB = HALF * BK * 2, STAGE_BYTES = 8 * HTB, NXCD = 8, WGM = 8;
__host__ __device__ __forceinline__ int lds_byte(int r, int c) { const int st = (r >> 4) * 2 + (c >> 5), rr = r & 15, cc = c & 31, ob = rr * 64 + cc * 2; return st * 1024 + (ob ^ (((ob >> 9) & 1) << 5)); }
__host__ __device__ __forceinline__ void stage_rc(int b, int& R, int& C) { const int st = b / 1024, sb = b % 1024, swz = sb ^ (((sb >> 9) & 1) << 5); R = (st >> 1) * 16 + swz / 64; C = (st & 1) * 32 + (swz % 64) / 2; }
__host__ __device__ __forceinline__ int perm32(int rho) { const int n = rho >> 4, i = rho & 15; return 8 * (i >> 2) + 4 * n + (i & 3); }

struct Unit { int pm, pn, brow, e; };
struct Gemm { const bf16* A; const bf16* Bt; int lda, K; const int* rowmap; int rowmask; };

struct StaticOrder {
    int nM, nN, nwg, G, c;
    __device__ void init(int nM_, int nN_, int G_, int c_) { nM = nM_; nN = nN_; nwg = nM * nN; G = G_; c = c_; }
    __device__ bool tile(int i, int& pm, int& pn) const {
        const long L = (long)i * G + c; if (L >= nwg) return false;
        int wgid = (int)L; { const int q = nwg / NXCD, r = nwg % NXCD, xcd = wgid % NXCD, off = wgid / NXCD; wgid = (xcd < r ? xcd * (q + 1) : r * (q + 1) + (xcd - r) * q) + off; }
        const int nig = WGM * nN, gid = wgid / nig, fm = gid * WGM, gsz = (nM - fm) < WGM ? (nM - fm) : WGM;
        pm = fm + ((wgid % nig) % gsz); pn = (wgid % nig) / gsz; return true;
    }
    __device__ bool next(int i, Unit& u) const { if (!tile(i, u.pm, u.pn)) return false; u.brow = u.pn * BM; u.e = 0; return true; }
};
struct GroupedOrder : StaticOrder {
    const LAS int* tstart; int nrow_e;
    __device__ bool next(int i, Unit& u) const {
        if (!tile(i, u.pm, u.pn)) return false;
        int e = 0;
#pragma unroll 1
        for (int j = 16; j > 0; j >>= 1) if (tstart[e + j] <= u.pm) e += j;
        u.e = e; u.brow = e * nrow_e + u.pn * BM; return true;
    }
};
DI unsigned cvt_pk_bf16(float lo, float hi) { unsigned r; asm volatile("v_cvt_pk_bf16_f32 %0, %1, %2" : "=v"(r) : "v"(lo), "v"(hi)); return r; }

template <class Epi, class Sched, bool GATHER = false, bool FP8 = false>
DI void gemm_phase(LAS unsigned char* lds, const int tid, const Gemm g, const Sched& S, const Epi& E) {
    const int wid = __builtin_amdgcn_readfirstlane(tid >> 6), lane = tid & 63, wr = wid >> 2, wc = wid & 3, fr = lane & 15, fq = lane >> 4;
    int K = g.K, lda = g.lda; asm volatile("" : "+s"(K), "+s"(lda));
    const int nt = K / BK;
    unsigned voffA[2], voffB[2]; int Ra[2], Ca[2];
#pragma unroll
    for (int i = 0; i < 2; ++i) { int R, C; stage_rc(tid * 16 + i * 8192, R, C); const int Rb = Epi::PERM ? ((R & ~31) + perm32(R & 31)) : R; Ra[i] = R; Ca[i] = C;
        voffA[i] = (unsigned)(R * lda + C) * 2u; voffB[i] = (unsigned)(Rb * K + C) * 2u; }
    unsigned vgc[2][2]; int rawn[2][2];
#define PG8_GLOAD(dst, pm_) do { _Pragma("unroll") for (int _h = 0; _h < 2; ++_h) _Pragma("unroll") for (int _i = 0; _i < 2; ++_i) { const int* _p = g.rowmap + (size_t)(pm_) * BM + _h * HALF + Ra[_i]; \
        asm volatile("global_load_dword %0, %1, off" : "=v"(dst[_h][_i]) : "v"(_p) : "memory"); } } while (0)
#define PG8_GCONV(vg, raw) do { _Pragma("unroll") for (int _h = 0; _h < 2; ++_h) _Pragma("unroll") for (int _i = 0; _i < 2; ++_i) { int _r = raw[_h][_i]; asm volatile("" : "+v"(_r)); \
        vg[_h][_i] = (unsigned)((_r & g.rowmask) * lda + Ca[_i]) * 2u; } } while (0)
#define PG8_STAGE_A(bufoff, kptr, h, vg) do { if (GATHER) PG8_STAGE(bufoff, kptr, vg[h]); else PG8_STAGE(bufoff, (kptr) + (h) * hstepA, voffA); } while (0)
    const size_t kstep = (size_t)(BK * 2);
    const size_t hstepA = (size_t)HALF * lda * 2, hstepB = (size_t)HALF * K * 2;
    const size_t tstepA = 2 * hstepA;
    const unsigned ldsw = (unsigned)wid * 1024u;
    const int aoff = lds_byte(wr * 64 + fr, fq * 8), boff = lds_byte(wc * 32 + fr, fq * 8);
#define PG8_SA(b, h) (((b) * 2 + (h)) * HTB)
#define PG8_SB(b, h) ((4 + (b) * 2 + (h)) * HTB)
#define PG8_STAGE(bufoff, gbase, voff) do { _Pragma("unroll") for (int _i = 0; _i < 2; ++_i) \
        __builtin_amdgcn_global_load_lds((const unsigned*)((const char*)(gbase) + (voff)[_i]), (LAS unsigned*)(lds + (bufoff) + ldsw + _i * 8192), 16, 0, 0); } while (0)
#define PG8_LDA(dst, b, h) do { _Pragma("unroll") for (int m = 0; m < 4; ++m) { const v4i_ lo_ = *(const LAS v4i_*)(lds + PG8_SA(b, h) + aoff + m * 2048), hi_ = *(const LAS v4i_*)(lds + PG8_SA(b, h) + aoff + m * 2048 + 1024); \
        dst[m] = __builtin_shufflevector(lo_, hi_, 0, 1, 2, 3, 4, 5, 6, 7); } } while (0)
#define PG8_LDB(dst, b, h) do { _Pragma("unroll") for (int n = 0; n < 2; ++n) { const v4i_ lo_ = *(const LAS v4i_*)(lds + PG8_SB(b, h) + boff + n * 2048), hi_ = *(const LAS v4i_*)(lds + PG8_SB(b, h) + boff + n * 2048 + 1024); \
        dst[n] = __builtin_shufflevector(lo_, hi_, 0, 1, 2, 3, 4, 5, 6, 7); } } while (0)
#define PG8_MMA(ai, bj, At, Bt) do { __builtin_amdgcn_s_setprio(1); _Pragma("unroll") for (int m = 0; m < 4; ++m) _Pragma("unroll") for (int n = 0; n < 2; ++n) { \
        if (FP8) acc[ai][bj][m][n] = __builtin_amdgcn_mfma_scale_f32_16x16x128_f8f6f4(Bt[n], At[m], acc[ai][bj][m][n], 0, 0, 0, 0x7F7F7F7F, 0, 0x7F7F7F7F); \
        else { const v8i_ b_ = Bt[n], a_ = At[m]; \
            acc[ai][bj][m][n] = __builtin_amdgcn_mfma_f32_16x16x32_bf16(__builtin_bit_cast(bf16x8, __builtin_shufflevector(b_, b_, 0, 1, 2, 3)), __builtin_bit_cast(bf16x8, __builtin_shufflevector(a_, a_, 0, 1, 2, 3)), acc[ai][bj][m][n], 0, 0, 0); \
            acc[ai][bj][m][n] = __builtin_amdgcn_mfma_f32_16x16x32_bf16(__builtin_bit_cast(bf16x8, __builtin_shufflevector(b_, b_, 4, 5, 6, 7)), __builtin_bit_cast(bf16x8, __builtin_shufflevector(a_, a_, 4, 5, 6, 7)), acc[ai][bj][m][n], 0, 0, 0); } } \
        __builtin_amdgcn_s_setprio(0); } while (0)
#define PG8_WAIT_V(n) asm volatile("s_waitcnt vmcnt(" #n ")" ::: "memory")
#define PG8_WAIT_L(n) asm volatile("s_waitcnt lgkmcnt(" #n ")" ::: "memory")
#define PG8_BAR __builtin_amdgcn_s_barrier()
#define PG8_SCHED __builtin_amdgcn_sched_barrier(0)
    Unit cur, nxt; int ui = 0;
    if (!S.next(0, cur)) return;
    f32x4 acc[2][2][4][2];
#pragma unroll
    for (int a = 0; a < 2; ++a)
#pragma unroll
        for (int b = 0; b < 2; ++b)
#pragma unroll
            for (int m = 0; m < 4; ++m)
#pragma unroll
                for (int n = 0; n < 2; ++n) acc[a][b][m][n] = (f32x4){0.f, 0.f, 0.f, 0.f};
    typedef int v8i_ __attribute__((ext_vector_type(8))); typedef int v4i_ __attribute__((ext_vector_type(4)));
    v8i_ At[4], B0[2], B1[2];
    const char* cA = (const char*)g.A + (GATHER ? (size_t)0 : (size_t)cur.pm * tstepA); const char* cB = (const char*)g.Bt + (size_t)cur.brow * K * 2;
    if (GATHER) { PG8_GLOAD(rawn, cur.pm); asm volatile("s_waitcnt vmcnt(0)" : "+v"(rawn[0][0]), "+v"(rawn[0][1]), "+v"(rawn[1][0]), "+v"(rawn[1][1]) :: "memory"); PG8_GCONV(vgc, rawn); }
    PG8_STAGE(PG8_SB(0, 0), cB, voffB); PG8_STAGE(PG8_SB(0, 1), cB + hstepB, voffB); PG8_STAGE_A(PG8_SA(0, 0), cA, 0, vgc); PG8_STAGE_A(PG8_SA(0, 1), cA, 1, vgc);
    if (wr == 1) PG8_BAR;
    PG8_WAIT_V(2); PG8_BAR;
    PG8_STAGE(PG8_SB(1, 0), cB + kstep, voffB); PG8_STAGE_A(PG8_SA(1, 0), cA + kstep, 0, vgc); PG8_STAGE(PG8_SB(1, 1), cB + hstepB + kstep, voffB);
    PG8_WAIT_V(6); PG8_BAR;
    for (;;) {
        const bool has_next = S.next(ui + 1, nxt);
        const char* nA = (has_next && !GATHER) ? (const char*)g.A + (size_t)nxt.pm * tstepA : cA;
        if (GATHER && has_next) PG8_GLOAD(rawn, nxt.pm); const char* nB = has_next ? (const char*)g.Bt + (size_t)nxt.brow * K * 2 : cB;
#pragma unroll 1
        for (int t = 0; t < nt; t += 2) {
            const bool last = (t == nt - 2);
            const char* a1 = cA + (size_t)(t + 1) * kstep;
            const char* a2 = last ? nA : cA + (size_t)(t + 2) * kstep; const char* b2 = last ? nB : cB + (size_t)(t + 2) * kstep;
            const char* a3 = a2 + kstep; const char* b3 = b2 + kstep;
            PG8_LDB(B0, 0, 0); PG8_LDB(B1, 0, 1); PG8_SCHED; PG8_LDA(At, 0, 0); PG8_STAGE_A(PG8_SA(1, 1), a1, 1, vgc);
            if (GATHER) { if (last && has_next) PG8_GCONV(vgc, rawn); }
            PG8_WAIT_V(8); PG8_WAIT_L(0); PG8_BAR; PG8_MMA(0, 0, At, B0); PG8_MMA(0, 1, At, B1); PG8_BAR; PG8_SCHED;
            PG8_LDA(At, 0, 1); PG8_STAGE(PG8_SB(0, 0), b2, voffB); PG8_STAGE(PG8_SB(0, 1), b2 + hstepB, voffB); PG8_STAGE_A(PG8_SA(0, 0), a2, 0, vgc);
            PG8_WAIT_V(8); PG8_WAIT_L(0); PG8_BAR; PG8_MMA(1, 0, At, B0); PG8_MMA(1, 1, At, B1); PG8_BAR; PG8_SCHED;
            PG8_LDB(B0, 1, 0); PG8_LDB(B1, 1, 1); PG8_SCHED; PG8_LDA(At, 1, 0); PG8_STAGE_A(PG8_SA(0, 1), a2, 1, vgc);
            PG8_WAIT_V(8); PG8_WAIT_L(0); PG8_BAR; PG8_MMA(0, 0, At, B0); PG8_MMA(0, 1, At, B1); PG8_BAR; PG8_SCHED;
            PG8_LDA(At, 1, 1); PG8_STAGE(PG8_SB(1, 0), b3, voffB); PG8_STAGE(PG8_SB(1, 1), b3 + hstepB, voffB); PG8_STAGE_A(PG8_SA(1, 0), a3, 0, vgc);
            PG8_WAIT_V(8); PG8_WAIT_L(0); PG8_BAR; PG8_MMA(1, 0, At, B0); PG8_MMA(1, 1, At, B1); PG8_BAR; PG8_SCHED;
        }
        if (wr == 0) PG8_BAR;
        { int fr2 = fr, fq2 = fq; asm volatile("" : "+v"(fr2), "+v"(fq2)); E(acc, cur, wr, wc, fr2, fq2); }
        if (!has_next) break;
#pragma unroll
        for (int a = 0; a < 2; ++a)
#pragma unroll
            for (int b = 0; b < 2; ++b)
#pragma unroll
                for (int m = 0; m < 4; ++m)
#pragma unroll
                    for (int n = 0; n < 2; ++n) acc[a][b][m][n] = (f32x4){0.f, 0.f, 0.f, 0.f};
        cur = nxt; cA = nA; cB = nB; ++ui;
        if (wr == 1) PG8_BAR;
    }
    PG8_WAIT_V(0);
    PG8_BAR;
#undef PG8_SA
#undef PG8_SB
#undef PG8_STAGE
#undef PG8_STAGE_A
#undef PG8_GLOAD
#undef PG8_GCONV
#undef PG8_LDA
#undef PG8_LDB
#undef PG8_MMA
#undef PG8_WAIT_V
#undef PG8_WAIT_L
#undef PG8_BAR
#undef PG8_SCHED
}
}
constexpr size_t MiB = 1u << 20;
constexpr size_t WS_CTL = 0;
constexpr size_t WS_LORA = 1 * MiB;
constexpr size_t WS_WK2 = 2 * MiB;
constexpr size_t ZERO_BYTES = 3 * MiB;
constexpr size_t WS_WIN = 3 * MiB;
constexpr size_t WS_WOUT = 17 * MiB;
constexpr size_t WS_WK1 = 21 * MiB;
constexpr size_t WS_SMALL = 25 * MiB;
constexpr size_t WS_ROUTE = 27 * MiB;
constexpr size_t WS_WGU = 32 * MiB;
constexpr size_t WS_WDN = 288 * MiB;
constexpr size_t WS_H = 416 * MiB;
constexpr size_t WS_R = 480 * MiB;
constexpr size_t R_PROJ = WS_R;
constexpr size_t R_SC = R_PROJ + 208 * MiB;
constexpr size_t R_SCH = R_SC + 32 * MiB;
constexpr size_t R_LIN = R_SC + 192 * MiB;
constexpr size_t R_G = R_LIN + 16 * MiB;
constexpr size_t R_YA = R_G + 32 * MiB;
constexpr size_t R_YCAT = R_YA + 32 * MiB;
constexpr size_t R_QC = R_YCAT + 64 * MiB;
constexpr size_t R_KC = R_QC + 16 * MiB;
constexpr size_t R_OC = R_KC + 16 * MiB;
constexpr size_t R_LSE = R_OC + 96 * MiB;
constexpr size_t R_QN = R_LSE + 2 * MiB;
constexpr size_t R_QR = R_QN + 16 * MiB;
constexpr size_t R_KCR = R_QR + 16 * MiB;
constexpr size_t R_VCR = R_KCR + 5 * MiB;
constexpr size_t R_KS = R_VCR + 5 * MiB;
constexpr size_t R_KW = R_KS + 4 * MiB;
constexpr size_t R_GATE = R_KW + 4 * MiB;
constexpr size_t R_CH1 = R_GATE + 2 * MiB;
constexpr size_t R_CMP = R_CH1 + 2 * MiB;
constexpr size_t R_OCMP = R_CMP + 1 * MiB;
constexpr size_t R_OSLC = R_OCMP + 32 * MiB;
constexpr size_t R_OSWA = R_OSLC + 32 * MiB;
constexpr size_t R_SCANU = R_OSWA;
constexpr size_t R_SCANS = R_OSWA + 16 * MiB;
constexpr size_t R_IMP = R_OSWA + 32 * MiB;
constexpr size_t R_SELM = R_IMP + 8 * MiB;
constexpr size_t R_MIX_END = R_SELM + 1 * MiB;
constexpr size_t R_XS = WS_R;
constexpr size_t R_ACT = R_XS + 272 * MiB;
constexpr size_t R_YB = R_ACT + 272 * MiB;
constexpr size_t R_MOE_END = R_YB + 272 * MiB;
constexpr size_t WS_END = (R_MIX_END > R_MOE_END ? R_MIX_END : R_MOE_END);
static_assert((size_t)NR * 1024 * 2 <= 272 * MiB, "sorted buffers");
constexpr int CW_BAR = 4096;
constexpr int CW_CNT = 16384;
constexpr int CW_CUR = 16384 + 64;

constexpr int RING_BYTES = 131072;
constexpr int MISC_OFF = RING_BYTES;
constexpr int LDS_BYTES = 155648;

struct Args { const void* in[40]; float* out; unsigned char* ws; int ph_lo, ph_hi; };

struct Ctx {
    LAS unsigned char* lds; int tid, lane, wave, G, bid;
    const float *x, *c, *w_ada, *b_ada, *norm1_g, *norm2_g, *w_in, *w_out, *mu, *w0, *w2, *a0, *a2, *g2, *kkw, *ka, *rk, *gn_w, *gn_b, *conv_w, *dil_q_g, *dil_k_g,
        *nsa_q_g, *nsa_kc_g, *nsa_ks_g, *nsa_kw_g, *pe_k, *pe_v, *wk1, *wk2, *wv1, *wv2, *onorm_g, *w_router, *b_router, *w_gu, *b_gu, *w_down, *b_down;
    const int* pos;
    float* out; unsigned char* ws;
};
#define WSP(T, off) ((T*)(C.ws + (off)))

typedef f32x4 Acc[2][2][4][2];
struct EpiProj {
    static constexpr bool PERM = true; bf16* O; float scale;
    DI void operator()(const Acc& acc, const pg8::Unit& u, int wr, int wc, int fr, int fq) const {
        const int row0 = u.pm * 256 + wr * 64 + fr, col0 = u.pn * 256 + wc * 32 + 8 * fq;
#pragma unroll
        for (int ai = 0; ai < 2; ++ai)
#pragma unroll
            for (int m = 0; m < 4; ++m) { bf16* rowp = O + (size_t)(row0 + ai * 128 + m * 16) * NPJ + col0;
#pragma unroll
                for (int bj = 0; bj < 2; ++bj) { const f32x4 v0 = acc[ai][bj][m][0] * scale, v1 = acc[ai][bj][m][1] * scale; u32x4 w;
                    w.x = pg8::cvt_pk_bf16(v0[0], v0[1]); w.y = pg8::cvt_pk_bf16(v0[2], v0[3]); w.z = pg8::cvt_pk_bf16(v1[0], v1[1]); w.w = pg8::cvt_pk_bf16(v1[2], v1[3]);
                    *(u32x4*)(rowp + bj * 128) = w; } }
    }
};
struct EpiLora {
    static constexpr bool PERM = false; float* Wp; bf16* SCH; bf16* Gb; const float *w0, *a0, *ka; bf16* SCo; float* Wo;
    DI void operator()(const Acc& acc, const pg8::Unit& u, int wr, int wc, int fr, int fq) const {
        const int row0 = u.pm * 256 + wr * 64 + fr, col0 = wc * 32 + 4 * fq;
        if (u.pn == 0) {
#pragma unroll
            for (int bj = 0; bj < 2; ++bj)
#pragma unroll
                for (int n = 0; n < 2; ++n) { const int ch = col0 + bj * 128 + n * 16; const f32x4 b = *(const f32x4*)(w0 + ch);
#pragma unroll
                    for (int ai = 0; ai < 2; ++ai)
#pragma unroll
                        for (int m = 0; m < 4; ++m) { const size_t o = (size_t)(row0 + ai * 128 + m * 16) * 256 + ch; const f32x4 v = acc[ai][bj][m][n] + b; f32x4 r;
#pragma unroll
                            for (int j = 0; j < 4; ++j) r[j] = fexp2(-0.875040829f * fsigmoid(v[j]));
                            *(f32x4*)(Wo + o) = r; } }
        } else if (u.pn == 1) {
#pragma unroll
            for (int bj = 0; bj < 2; ++bj)
#pragma unroll
                for (int n = 0; n < 2; ++n) { const int ch = col0 + bj * 128 + n * 16; const f32x4 b = *(const f32x4*)(a0 + ch), kav = *(const f32x4*)(ka + ch);
#pragma unroll
                    for (int ai = 0; ai < 2; ++ai)
#pragma unroll
                        for (int m = 0; m < 4; ++m) { __builtin_amdgcn_sched_barrier(0); const size_t o = (size_t)(row0 + ai * 128 + m * 16) * 256 + ch; const f32x4 v = acc[ai][bj][m][n] + b;
                            const u32x2 kr = *(const u32x2*)(SCH + o), kn = *(const u32x2*)(SCH + (size_t)NT * 256 + o);
                            const float krf[4] = {bflo(kr.x), bfhi(kr.x), bflo(kr.y), bfhi(kr.y)}, knf[4] = {bflo(kn.x), bfhi(kn.x), bflo(kn.y), bfhi(kn.y)}; float k2[4], bb[4];
#pragma unroll
                            for (int j = 0; j < 4; ++j) { const float a = fsigmoid(v[j]); k2[j] = krf[j] * (1.f + (a - 1.f) * kav[j]); bb[j] = knf[j] * a; }
                            u32x2 o1, o2; o1.x = pk2(k2[0], k2[1]); o1.y = pk2(k2[2], k2[3]); o2.x = pk2(bb[0], bb[1]); o2.y = pk2(bb[2], bb[3]);
                            *(u32x2*)(SCo + o) = o1; *(u32x2*)(SCo + (size_t)2 * NT * 256 + o) = o2; } }
        } else {
#pragma unroll
            for (int bj = 0; bj < 2; ++bj)
#pragma unroll
                for (int n = 0; n < 2; ++n) { const int ch = col0 + bj * 128 + n * 16;
#pragma unroll
                    for (int ai = 0; ai < 2; ++ai)
#pragma unroll
                        for (int m = 0; m < 4; ++m) { const size_t o = (size_t)(row0 + ai * 128 + m * 16) * 256 + ch; const f32x4 v = acc[ai][bj][m][n]; u32x2 w; w.x = pk2(v[0], v[1]); w.y = pk2(v[2], v[3]); *(u32x2*)(Gb + o) = w; } }
        }
    }
};
DI float gelu_tanh(float x) { const float t = 0.7978845608f * (x + 0.044715f * x * x * x); return x * fsigmoid(2.f * t); }
struct EpiC1 {
    static constexpr bool PERM = true; bf16* O; const float* peb;
    DI void operator()(const Acc& acc, const pg8::Unit& u, int wr, int wc, int fr, int fq) const {
        const int row0 = u.pm * 256 + wr * 64 + fr, col0 = wc * 32 + 8 * fq;
#pragma unroll
        for (int bj = 0; bj < 2; ++bj) { const f32x4 b0 = *(const f32x4*)(peb + col0 + bj * 128), b1 = *(const f32x4*)(peb + col0 + bj * 128 + 4);
#pragma unroll
            for (int ai = 0; ai < 2; ++ai)
#pragma unroll
                for (int m = 0; m < 4; ++m) { bf16* p = O + (size_t)(row0 + ai * 128 + m * 16) * 256 + col0 + bj * 128; const f32x4 v0 = acc[ai][bj][m][0] + b0, v1 = acc[ai][bj][m][1] + b1; u32x4 w;
                    w.x = pk2(gelu_tanh(v0[0]), gelu_tanh(v0[1])); w.y = pk2(gelu_tanh(v0[2]), gelu_tanh(v0[3])); w.z = pk2(gelu_tanh(v1[0]), gelu_tanh(v1[1])); w.w = pk2(gelu_tanh(v1[2]), gelu_tanh(v1[3]));
                    *(u32x4*)p = w; } }
    }
};
struct EpiC2 {
    static constexpr bool PERM = false; float* O;
    DI void operator()(const Acc& acc, const pg8::Unit& u, int wr, int wc, int fr, int fq) const {
        if (wc >= 2) return;
        const int row0 = u.pm * 256 + wr * 64 + fr, col0 = wc * 32 + 4 * fq;
#pragma unroll
        for (int ai = 0; ai < 2; ++ai)
#pragma unroll
            for (int m = 0; m < 4; ++m)
#pragma unroll
                for (int n = 0; n < 2; ++n) *(f32x4*)(O + (size_t)(row0 + ai * 128 + m * 16) * 64 + col0 + n * 16) = acc[ai][0][m][n];
    }
};
struct EpiOut {
    static constexpr bool PERM = false; float* O; const float* xin; const float* gt;
    DI void operator()(const Acc& acc, const pg8::Unit& u, int wr, int wc, int fr, int fq) const {
        const int row0 = u.pm * 256 + wr * 64 + fr, col0 = u.pn * 256 + wc * 32 + 4 * fq; const int b = (u.pm * 256) / NS;
#pragma unroll
        for (int bj = 0; bj < 2; ++bj)
#pragma unroll
            for (int n = 0; n < 2; ++n) { const int col = col0 + bj * 128 + n * 16; const f32x4 g = *(const f32x4*)(gt + (size_t)b * 6144 + col);
#pragma unroll
                for (int ai = 0; ai < 2; ++ai)
#pragma unroll
                    for (int m = 0; m < 4; ++m) { const size_t o = (size_t)(row0 + ai * 128 + m * 16) * DM + col; *(f32x4*)(O + o) = *(const f32x4*)(xin + o) + g * acc[ai][bj][m][n]; } }
    }
};
struct EpiGU {
    static constexpr bool PERM = true; bf16* O; const float* bgu;
    DI void operator()(const Acc& acc, const pg8::Unit& u, int wr, int wc, int fr, int fq) const {
        const int row0 = u.pm * 256 + wr * 64 + fr, cc = u.pn * 128 + wc * 32 + 8 * fq; const float* bp = bgu + (size_t)u.e * 2048 + cc;
        const f32x4 g0 = *(const f32x4*)bp, g1 = *(const f32x4*)(bp + 4), u0 = *(const f32x4*)(bp + 1024), u1 = *(const f32x4*)(bp + 1028);
#pragma unroll
        for (int ai = 0; ai < 2; ++ai)
#pragma unroll
            for (int m = 0; m < 4; ++m) { bf16* p = O + (size_t)(row0 + ai * 128 + m * 16) * FF + cc; float r[8];
#pragma unroll
                for (int n = 0; n < 2; ++n) { const f32x4 gv = acc[ai][0][m][n] + (n ? g1 : g0), uv = acc[ai][1][m][n] + (n ? u1 : u0);
#pragma unroll
                    for (int j = 0; j < 4; ++j) { const float ga = fminf(gv[j], 7.f), up = fminf(fmaxf(uv[j], -7.f), 7.f); r[4 * n + j] = ga * fsigmoid(1.702f * ga) * (up + 1.f); } }
                u32x4 w; w.x = pk2(r[0], r[1]); w.y = pk2(r[2], r[3]); w.z = pk2(r[4], r[5]); w.w = pk2(r[6], r[7]); *(u32x4*)p = w; }
    }
};
struct EpiDN {
    static constexpr bool PERM = true; bf16* O; const float* bd;
    DI void operator()(const Acc& acc, const pg8::Unit& u, int wr, int wc, int fr, int fq) const {
        const int row0 = u.pm * 256 + wr * 64 + fr, col0 = u.pn * 256 + wc * 32 + 8 * fq; const float* bp = bd + (size_t)u.e * 1024 + col0;
#pragma unroll
        for (int bj = 0; bj < 2; ++bj) { const f32x4 b0 = *(const f32x4*)(bp + bj * 128), b1 = *(const f32x4*)(bp + bj * 128 + 4);
#pragma unroll
            for (int ai = 0; ai < 2; ++ai)
#pragma unroll
                for (int m = 0; m < 4; ++m) { bf16* p = O + (size_t)(row0 + ai * 128 + m * 16) * DM + col0 + bj * 128; const f32x4 v0 = acc[ai][bj][m][0] + b0, v1 = acc[ai][bj][m][1] + b1; u32x4 w;
                    w.x = pk2(v0[0], v0[1]); w.y = pk2(v0[2], v0[3]); w.z = pk2(v1[0], v1[1]); w.w = pk2(v1[2], v1[3]); *(u32x4*)p = w; } }
    }
};
DI float clamp8(float x) { return fminf(fmaxf(x, -448.f), 448.f); }
DI unsigned pk4_fp8_nc(float a, float b, float c, float d) { unsigned w = 0u; w = __builtin_amdgcn_cvt_pk_fp8_f32(a, b, w, false); w = __builtin_amdgcn_cvt_pk_fp8_f32(c, d, w, true); return w; }
DI unsigned pk4_fp8(float a, float b, float c, float d) { unsigned w = 0u; w = __builtin_amdgcn_cvt_pk_fp8_f32(clamp8(a), clamp8(b), w, false); w = __builtin_amdgcn_cvt_pk_fp8_f32(clamp8(c), clamp8(d), w, true); return w; }
constexpr float W8_SCALE = 32.f, W8_INV = 1.f / 32.f;
struct EpiGU8 {
    static constexpr bool PERM = true; unsigned char* O; const float* bgu;
    DI void operator()(const Acc& acc, const pg8::Unit& u, int wr, int wc, int fr, int fq) const {
        const int row0 = u.pm * 256 + wr * 64 + fr, cc = u.pn * 128 + wc * 32 + 8 * fq; const float* bp = bgu + (size_t)u.e * 2048 + cc;
        const f32x4 g0 = *(const f32x4*)bp, g1 = *(const f32x4*)(bp + 4), u0 = *(const f32x4*)(bp + 1024), u1 = *(const f32x4*)(bp + 1028);
#pragma unroll
        for (int ai = 0; ai < 2; ++ai)
#pragma unroll
            for (int m = 0; m < 4; ++m) { unsigned char* p = O + (size_t)(row0 + ai * 128 + m * 16) * FF + cc; float r[8];
#pragma unroll
                for (int n = 0; n < 2; ++n) { const f32x4 gv = acc[ai][0][m][n] * W8_INV + (n ? g1 : g0), uv = acc[ai][1][m][n] * W8_INV + (n ? u1 : u0);
#pragma unroll
                    for (int j = 0; j < 4; ++j) { const float ga = fminf(gv[j], 7.f), up = __builtin_amdgcn_fmed3f(uv[j], -7.f, 7.f); const float sg = __builtin_amdgcn_rcpf(1.f + __builtin_amdgcn_exp2f(-2.45546695959f * ga)); r[4 * n + j] = (ga * sg) * (up + 1.f); } }
                u32x2 w; w.x = pk4_fp8_nc(r[0], r[1], r[2], r[3]); w.y = pk4_fp8_nc(r[4], r[5], r[6], r[7]); *(u32x2*)p = w; }
    }
};
struct EpiDN8 {
    static constexpr bool PERM = true; bf16* O; const float* bd;
    DI void operator()(const Acc& acc, const pg8::Unit& u, int wr, int wc, int fr, int fq) const {
        const int row0 = u.pm * 256 + wr * 64 + fr, col0 = u.pn * 256 + wc * 32 + 8 * fq; const float* bp = bd + (size_t)u.e * 1024 + col0;
#pragma unroll
        for (int bj = 0; bj < 2; ++bj) { const f32x4 b0 = *(const f32x4*)(bp + bj * 128), b1 = *(const f32x4*)(bp + bj * 128 + 4);
#pragma unroll
            for (int ai = 0; ai < 2; ++ai)
#pragma unroll
                for (int m = 0; m < 4; ++m) { bf16* p = O + (size_t)(row0 + ai * 128 + m * 16) * DM + col0 + bj * 128; const f32x4 v0 = acc[ai][bj][m][0] * W8_INV + b0, v1 = acc[ai][bj][m][1] * W8_INV + b1; u32x4 w;
                    w.x = pk2(v0[0], v0[1]); w.y = pk2(v0[2], v0[3]); w.z = pk2(v1[0], v1[1]); w.w = pk2(v1[2], v1[3]); *(u32x4*)p = w; } }
    }
};
DI void tr_item(const float* src, int ld_src, int scol0, int nvalid, int k0, bf16* dst, int ld_dst, int drow0, int dk0, LAS float* scr, int lane) {
    const int n4 = (lane & 7) * 4, kr = lane >> 3; f32x4 v[8];
#pragma unroll
    for (int i = 0; i < 8; ++i) v[i] = (n4 < nvalid) ? *(const f32x4*)(src + (size_t)(k0 + kr + 8 * i) * ld_src + scol0 + n4) : (f32x4){0.f, 0.f, 0.f, 0.f};
#pragma unroll
    for (int i = 0; i < 8; ++i) { LAS float* s = scr + (kr + 8 * i) * 33 + n4; s[0] = v[i][0]; s[1] = v[i][1]; s[2] = v[i][2]; s[3] = v[i][3]; }
    asm volatile("s_waitcnt lgkmcnt(0)" ::: "memory");
    const int c = lane & 7;
#pragma unroll
    for (int jq = 0; jq < 4; ++jq) { const int n = (lane >> 3) + 8 * jq; const LAS float* s = scr + (8 * c) * 33 + n;
        u32x4 o; o.x = pk2(s[0 * 33], s[1 * 33]); o.y = pk2(s[2 * 33], s[3 * 33]); o.z = pk2(s[4 * 33], s[5 * 33]); o.w = pk2(s[6 * 33], s[7 * 33]);
        *(u32x4*)(dst + (size_t)(drow0 + n) * ld_dst + dk0 + k0 + 8 * c) = o; }
    asm volatile("s_waitcnt lgkmcnt(0)" ::: "memory");
}
DI void tr_item8(const float* src, int ld_src, int scol0, int k0, unsigned char* dst, int ld_dst, int drow0, LAS float* scr, int lane, int nvalid = 32) {
    const int n4 = (lane & 7) * 4, kr = lane >> 3; f32x4 v[8];
#pragma unroll
    for (int i = 0; i < 8; ++i) v[i] = (n4 < nvalid) ? *(const f32x4*)(src + (size_t)(k0 + kr + 8 * i) * ld_src + scol0 + n4) : (f32x4){0.f, 0.f, 0.f, 0.f};
#pragma unroll
    for (int i = 0; i < 8; ++i) { LAS float* s = scr + (kr + 8 * i) * 33 + n4; s[0] = v[i][0]; s[1] = v[i][1]; s[2] = v[i][2]; s[3] = v[i][3]; }
    asm volatile("s_waitcnt lgkmcnt(0)" ::: "memory");
    const int c = lane & 7;
#pragma unroll
    for (int jq = 0; jq < 4; ++jq) { const int n = (lane >> 3) + 8 * jq; const LAS float* s = scr + (8 * c) * 33 + n;
        u32x2 o; o.x = pk4_fp8(s[0 * 33] * W8_SCALE, s[1 * 33] * W8_SCALE, s[2 * 33] * W8_SCALE, s[3 * 33] * W8_SCALE); o.y = pk4_fp8(s[4 * 33] * W8_SCALE, s[5 * 33] * W8_SCALE, s[6 * 33] * W8_SCALE, s[7 * 33] * W8_SCALE);
        *(u32x2*)(dst + (size_t)(drow0 + n) * ld_dst + k0 + 8 * c) = o; }
    asm volatile("s_waitcnt lgkmcnt(0)" ::: "memory");
}
DI void conv_item(const Ctx& C, int l, int r, LAS float* scr) {
    constexpr int I_GU = 32 * 16 * 64;
    if (r < I_GU) { const int e = r / 1024, r2 = r % 1024, kb = r2 / 64, nb = r2 % 64, n0 = 32 * nb, j = n0 / 256, i = n0 % 256;
        const int scol0 = (i < 128) ? 128 * j + i : 1024 + 128 * j + (i - 128);
        tr_item8(C.w_gu + (size_t)(l * 32 + e) * 1024 * 2048, 2048, scol0, 64 * kb, WSP(unsigned char, WS_WGU) + (size_t)(l * 32 + e) * 2048 * 1024, 1024, n0, scr, C.lane); }
    else { r -= I_GU; const int e = r / 512, r2 = r % 512, kb = r2 / 32, nb = r2 % 32;
        tr_item8(C.w_down + (size_t)(l * 32 + e) * 1024 * 1024, 1024, 32 * nb, 64 * kb, WSP(unsigned char, WS_WDN) + (size_t)(l * 32 + e) * 1024 * 1024, 1024, 32 * nb, scr, C.lane); }
}
DI void conv_ticket(const Ctx& C0, int l, int tk) {
    Ctx C = C0; asm volatile("" : "+v"(C.lane), "+v"(C.tid));
    LAS float* scr = (LAS float*)(C.lds + C.wave * 16384);
    __syncthreads();
#pragma unroll 1
    for (int i = 0; i < 8; ++i) conv_item(C, l, tk * 64 + C.wave * 8 + i, scr);
}
DI void p0_prologue(const Ctx& C) {
    LAS float* scr = (LAS float*)(C.lds + C.wave * 16384);
    const int gw = C.bid * NWAVE + C.wave, NGW = C.G * NWAVE;
    constexpr int I_IN = 16 * 104, I_OUT = 16 * 32, I_LW = 8, I_LA = 8, I_LG = 16, I_K1 = 256, I_K2 = 8;
    constexpr int I_LAYER = I_IN + I_OUT + I_LW + I_LA + I_LG + 2 * I_K1 + 2 * I_K2;
    for (int it = gw; it < NLAYER * I_LAYER; it += NGW) {
        const int l = it / I_LAYER; int r = it % I_LAYER;
        if (r < I_IN) { const int kb = r / 104, nb = r % 104, n0 = 32 * nb; int nv = 3212 - n0; nv = nv < 0 ? 0 : (nv > 32 ? 32 : nv);
            if (INPROJ_FP8) tr_item8(C.w_in + (size_t)l * 1024 * 3212, 3212, n0, 64 * kb, WSP(unsigned char, WS_WIN) + (size_t)l * NPJ * 1024, 1024, n0, scr, C.lane, nv);
            else tr_item(C.w_in + (size_t)l * 1024 * 3212, 3212, n0, nv, 64 * kb, WSP(bf16, WS_WIN) + (size_t)l * NPJ * 1024, 1024, n0, 0, scr, C.lane); continue; } r -= I_IN;
        if (r < I_OUT) { const int kb = r / 32, nb = r % 32;
            tr_item(C.w_out + (size_t)l * 1024 * 1024, 1024, 32 * nb, 32, 64 * kb, WSP(bf16, WS_WOUT) + (size_t)l * 1024 * 1024, 1024, 32 * nb, 0, scr, C.lane); continue; } r -= I_OUT;
        bf16* lora = WSP(bf16, WS_LORA) + (size_t)l * 768 * 256;
        if (r < I_LW) { tr_item(C.w2 + (size_t)l * 64 * 256, 256, 32 * r, 32, 0, lora, 256, 32 * r, 0, scr, C.lane); continue; } r -= I_LW;
        if (r < I_LA) { tr_item(C.a2 + (size_t)l * 64 * 256, 256, 32 * r, 32, 0, lora, 256, 256 + 32 * r, 64, scr, C.lane); continue; } r -= I_LA;
        if (r < I_LG) { const int kb = r / 8, nb = r % 8; tr_item(C.g2 + (size_t)l * 128 * 256, 256, 32 * nb, 32, 64 * kb, lora, 256, 512 + 32 * nb, 128, scr, C.lane); continue; } r -= I_LG;
        if (r < 2 * I_K1) { const int kv = r / I_K1, r2 = r % I_K1, kb = r2 / 8, nb = r2 % 8;
            tr_item((kv ? C.wv1 : C.wk1) + (size_t)l * 2048 * 256, 256, 32 * nb, 32, 64 * kb, WSP(bf16, WS_WK1) + (size_t)(l * 2 + kv) * 256 * 2048, 2048, 32 * nb, 0, scr, C.lane); continue; } r -= 2 * I_K1;
        { const int kv = r / I_K2, r2 = r % I_K2, kb = r2 / 2, nb = r2 % 2;
            tr_item((kv ? C.wv2 : C.wk2) + (size_t)l * 256 * 64, 64, 32 * nb, 32, 64 * kb, WSP(bf16, WS_WK2) + (size_t)(l * 2 + kv) * 256 * 256, 256, 32 * nb, 0, scr, C.lane); }
    }
    { int* idm = WSP(int, WS_ROUTE) + NT * 12 + NR; for (int i = C.bid * NTHR + C.tid; i < NR; i += C.G * NTHR) idm[i] = i; }
    __syncthreads();
    float* MOD = WSP(float, WS_SMALL); float* PEB = MOD + NLAYER * 8 * 6144;
    LAS float* sc = (LAS float*)C.lds;
    LAS float* red = sc + 8192;
    for (int it = C.bid; it < 192 + 32; it += C.G) {
        if (it < 192) {
            const int l = it / 96, n0 = (it % 96) * 64;
            for (int i = C.tid; i < 8192; i += NTHR) { const float v = C.c[i]; sc[i] = v * fsigmoid(v); }
            __syncthreads();
            const int kq = C.tid >> 6, col = C.tid & 63; float a[8];
#pragma unroll
            for (int b = 0; b < 8; ++b) a[b] = 0.f;
            const float* wp = C.w_ada + (size_t)l * 1024 * 6144 + n0 + col;
#pragma unroll 32
            for (int k = kq * 128; k < kq * 128 + 128; ++k) { const float w = wp[(size_t)k * 6144];
#pragma unroll
                for (int b = 0; b < 8; ++b) a[b] += sc[b * 1024 + k] * w; }
#pragma unroll
            for (int b = 0; b < 8; ++b) red[(kq * 8 + b) * 64 + col] = a[b];
            __syncthreads();
            { const int b = C.tid >> 6; float s = C.b_ada[(size_t)l * 6144 + n0 + col];
#pragma unroll
              for (int q = 0; q < 8; ++q) s += red[(q * 8 + b) * 64 + col];
              MOD[((size_t)l * 8 + b) * 6144 + n0 + col] = s; }
            __syncthreads();
        } else {
            const int r = it - 192, l = r >> 4, kv = (r >> 3) & 1, c0 = (r & 7) * 32; const float* pe = (kv ? C.pe_v : C.pe_k) + (size_t)l * 2048; const float* w1 = (kv ? C.wv1 : C.wk1) + (size_t)l * 2048 * 256;
            const int kq = C.tid >> 5, col = C.tid & 31; float a = 0.f;
#pragma unroll 16
            for (int k = kq * 128; k < kq * 128 + 128; ++k) a += pe[k] * w1[(size_t)k * 256 + c0 + col];
            red[kq * 32 + col] = a; __syncthreads();
            if (C.tid < 32) { float s = 0.f;
#pragma unroll
                for (int q = 0; q < 16; ++q) s += red[q * 32 + C.tid];
                PEB[(l * 2 + kv) * 256 + c0 + C.tid] = s; }
            __syncthreads();
        }
    }
}

DI void norm_row(const Ctx& C, const float* xrow, const float* g, const float* sh, const float* sc, bf16* orow) {
    f32x4 v[4]; float s = 0.f;
#pragma unroll
    for (int j = 0; j < 4; ++j) { v[j] = *(const f32x4*)(xrow + 4 * C.lane + 256 * j); s += (v[j][0] * v[j][0] + v[j][1] * v[j][1]) + (v[j][2] * v[j][2] + v[j][3] * v[j][3]); }
    s = group_sum<64>(s); const float rstd = rsqrtf(s * (1.f / DM) + 1e-6f);
#pragma unroll
    for (int j = 0; j < 4; ++j) { const int k = 4 * C.lane + 256 * j; const f32x4 gg = *(const f32x4*)(g + k), a = *(const f32x4*)(sc + k), b = *(const f32x4*)(sh + k); f32x4 h;
#pragma unroll
        for (int i = 0; i < 4; ++i) h[i] = v[j][i] * rstd * gg[i] * (1.f + a[i]) + b[i];
        if (INPROJ_FP8) *(unsigned*)((unsigned char*)orow + k) = pk4_fp8(h[0], h[1], h[2], h[3]);
        else { u32x2 o; o.x = pk2(h[0], h[1]); o.y = pk2(h[2], h[3]); *(u32x2*)(orow + k) = o; } }
}
DI void norm1_phase(const Ctx& C, int l, const float* xin) {
    const float* MOD = WSP(float, WS_SMALL) + (size_t)l * 8 * 6144; bf16* H = WSP(bf16, WS_H);
    const int gw = C.bid * NWAVE + C.wave, NGW = C.G * NWAVE;
    for (int m = gw; m < NT; m += NGW) { const int b = m / NS; norm_row(C, xin + (size_t)m * DM, C.norm1_g + l * DM, MOD + b * 6144, MOD + b * 6144 + 1024, INPROJ_FP8 ? (bf16*)((unsigned char*)H + (size_t)m * DM) : H + (size_t)m * DM); }
}

constexpr float QSCALE = 0.125f * 1.44269504089f;
DI void prep_phase(const Ctx& C, int l) {
    const bf16* PROJ = WSP(bf16, R_PROJ); bf16* SCH = WSP(bf16, R_SCH); bf16* LIN = WSP(bf16, R_LIN); bf16* YCAT = WSP(bf16, R_YCAT);
    bf16 *QC = WSP(bf16, R_QC), *KC = WSP(bf16, R_KC), *QN = WSP(bf16, R_QN), *QR = WSP(bf16, R_QR), *KCR = WSP(bf16, R_KCR), *VCR = WSP(bf16, R_VCR), *KS = WSP(bf16, R_KS), *KW = WSP(bf16, R_KW);
    float* GATE = WSP(float, R_GATE);
    const int lane = C.lane, gw = C.bid * NWAVE + C.wave, NGW = C.G * NWAVE;
    const int hh = lane >> 4, jj = lane & 15;
    const float inv0 = exp2f(-(float)(2 * jj) * (13.287712379549449f / 32.f)) * 0.15915494309189535f, inv1 = exp2f(-(float)(2 * jj + 1) * (13.287712379549449f / 32.f)) * 0.15915494309189535f;
    for (int task = gw; task < NT / 16; task += NGW) {
        const int row0 = 16 * task, s0 = row0 % NS;
        {
            const int c0 = 16 * lane, cc = (c0 - 256) & 255; float mu16[16], kw16[16];
#pragma unroll
            for (int q = 0; q < 4; ++q) { const f32x4 m4 = *(const f32x4*)(C.mu + (size_t)l * 1024 + c0 + 4 * q), k4 = *(const f32x4*)(C.kkw + (size_t)l * 256 + cc + 4 * q);
#pragma unroll
                for (int i = 0; i < 4; ++i) { mu16[4 * q + i] = m4[i]; kw16[4 * q + i] = k4[i]; } }
#pragma unroll 2
            for (int r = 0; r < 16; ++r) {
                const int row = row0 + r; const bf16* pr = PROJ + (size_t)row * NPJ; float z[16];
                const u32x4 c0v = *(const u32x4*)(pr + c0), c1v = *(const u32x4*)(pr + c0 + 8);
                u32x4 p0v = (u32x4){0u, 0u, 0u, 0u}, p1v = p0v;
                if (s0 + r > 0) { p0v = *(const u32x4*)(pr - NPJ + c0); p1v = *(const u32x4*)(pr - NPJ + c0 + 8); }
                const unsigned cw[8] = {c0v.x, c0v.y, c0v.z, c0v.w, c1v.x, c1v.y, c1v.z, c1v.w}, pw[8] = {p0v.x, p0v.y, p0v.z, p0v.w, p1v.x, p1v.y, p1v.z, p1v.w};
#pragma unroll
                for (int e = 0; e < 16; ++e) { const float cu = (e & 1) ? bfhi(cw[e >> 1]) : bflo(cw[e >> 1]), pv = (e & 1) ? bfhi(pw[e >> 1]) : bflo(pw[e >> 1]); z[e] = cu + (pv - cu) * mu16[e]; }
                float kk[16]; float ss = 0.f;
#pragma unroll
                for (int e = 0; e < 16; ++e) { kk[e] = z[e] * kw16[e]; ss += kk[e] * kk[e]; }
                ss = group_sum<4>(ss); const float kinv = rsqrtf(ss + 1e-12f);
                if (lane < 48) {
                    const int pl = lane < 16 ? 3 : (lane < 32 ? 0 : 4); bf16* dst = SCH + ((size_t)pl * NT + row) * 256 + (c0 & 255);
                    u32x4 o0, o1; o0.x = pk2(z[0], z[1]); o0.y = pk2(z[2], z[3]); o0.z = pk2(z[4], z[5]); o0.w = pk2(z[6], z[7]); o1.x = pk2(z[8], z[9]); o1.y = pk2(z[10], z[11]); o1.z = pk2(z[12], z[13]); o1.w = pk2(z[14], z[15]);
                    *(u32x4*)dst = o0; *(u32x4*)(dst + 8) = o1;
                    if (lane >= 16 && lane < 32) { bf16* d2 = SCH + ((size_t)1 * NT + row) * 256 + cc;
                        u32x4 q0, q1; q0.x = pk2(kk[0] * kinv, kk[1] * kinv); q0.y = pk2(kk[2] * kinv, kk[3] * kinv); q0.z = pk2(kk[4] * kinv, kk[5] * kinv); q0.w = pk2(kk[6] * kinv, kk[7] * kinv);
                        q1.x = pk2(kk[8] * kinv, kk[9] * kinv); q1.y = pk2(kk[10] * kinv, kk[11] * kinv); q1.z = pk2(kk[12] * kinv, kk[13] * kinv); q1.w = pk2(kk[14] * kinv, kk[15] * kinv);
                        *(u32x4*)d2 = q0; *(u32x4*)(d2 + 8) = q1; }
                } else {
                    float t[16];
#pragma unroll
                    for (int i = 0; i < 16; ++i) { const float sg = fsigmoid(lane < 52 ? 2.f * z[i] : z[i]); t[i] = lane < 52 ? 2.f * sg - 1.f : (lane < 56 ? z[i] : sg); }
                    bf16* dst = LIN + (size_t)row * 256 + (c0 - 768);
                    u32x4 o0, o1; o0.x = pk2(t[0], t[1]); o0.y = pk2(t[2], t[3]); o0.z = pk2(t[4], t[5]); o0.w = pk2(t[6], t[7]); o1.x = pk2(t[8], t[9]); o1.y = pk2(t[10], t[11]); o1.z = pk2(t[12], t[13]); o1.w = pk2(t[14], t[15]);
                    *(u32x4*)dst = o0; *(u32x4*)(dst + 8) = o1;
                }
            }
        }
        {
            const int ch = 4 * lane; const float* cw = C.conv_w + (size_t)l * 3 * 256 + ch; const f32x4 w0 = *(const f32x4*)cw, w1 = *(const f32x4*)(cw + 256), w2 = *(const f32x4*)(cw + 512);
            const f32x4 og = *(const f32x4*)(C.onorm_g + (size_t)l * 768 + ch);
#pragma unroll 2
            for (int r = 0; r < 16; ++r) {
                const int row = row0 + r, s = s0 + r; const bf16* pr = PROJ + (size_t)row * NPJ; float u[3][4];
#pragma unroll
                for (int d = 0; d < 3; ++d) {
                    u32x2 cg = (u32x2){0u, 0u}, xi = cg;
                    if (s >= d) { cg = *(const u32x2*)(pr - (size_t)d * NPJ + PJ_B + 256 + ch); xi = *(const u32x2*)(pr - (size_t)d * NPJ + PJ_B + 512 + ch); }
                    u[d][0] = bflo(cg.x) * bflo(xi.x); u[d][1] = bfhi(cg.x) * bfhi(xi.x); u[d][2] = bflo(cg.y) * bflo(xi.y); u[d][3] = bfhi(cg.y) * bfhi(xi.y);
                }
                const u32x2 bgv = *(const u32x2*)(pr + PJ_B + ch); const float bg[4] = {bflo(bgv.x), bfhi(bgv.x), bflo(bgv.y), bfhi(bgv.y)};
                float y[4]; float ss = 0.f;
#pragma unroll
                for (int i = 0; i < 4; ++i) { y[i] = bg[i] * (w0[i] * u[2][i] + w1[i] * u[1][i] + w2[i] * u[0][i]); ss += y[i] * y[i]; }
                ss = group_sum<16>(ss); const float rstd = rsqrtf(ss * (1.f / 64.f) + 1e-6f);
                u32x2 o; o.x = pk2(y[0] * rstd * og[0], y[1] * rstd * og[1]); o.y = pk2(y[2] * rstd * og[2], y[3] * rstd * og[3]);
                *(u32x2*)(YCAT + (size_t)row * DM + 256 + ch) = o;
            }
        }
        {
            const float* gq = C.dil_q_g + (size_t)l * 64; const float* gk = C.dil_k_g + (size_t)l * 64; const float* gn = C.nsa_q_g + (size_t)l * 64; const float* gv = (hh == 0 ? C.nsa_ks_g : C.nsa_kw_g) + (size_t)l * 64;
            float Gq[4], Gk[4], Gn[4], Gv[4];
#pragma unroll
            for (int i = 0; i < 4; ++i) { const int d = (i >> 1) * 32 + 2 * jj + (i & 1); Gq[i] = gq[d] * QSCALE; Gk[i] = gk[d]; Gn[i] = gn[d] * QSCALE; Gv[i] = gv[d]; }
            const int vcol = hh == 0 ? 2944 : (hh == 1 ? 3072 : (hh == 2 ? 2816 : 2880));
            bf16* vdst = (hh == 0 ? KS : (hh == 1 ? KW : (hh == 2 ? KCR : VCR)));
#pragma unroll 2
            for (int r = 0; r < 16; ++r) {
                const int row = row0 + r; const bf16* pr = PROJ + (size_t)row * NPJ;
                const float posf = (float)C.pos[row];
                const float x0 = __builtin_amdgcn_fractf(posf * inv0), x1 = __builtin_amdgcn_fractf(posf * inv1);
                const float sn0 = __builtin_amdgcn_sinf(x0), cs0 = __builtin_amdgcn_cosf(x0), sn1 = __builtin_amdgcn_sinf(x1), cs1 = __builtin_amdgcn_cosf(x1);
                const unsigned qa = *(const unsigned*)(pr + PJ_C + hh * 64 + 2 * jj), qb = *(const unsigned*)(pr + PJ_C + hh * 64 + 32 + 2 * jj);
                const unsigned ka = *(const unsigned*)(pr + PJ_C + 256 + hh * 64 + 2 * jj), kb = *(const unsigned*)(pr + PJ_C + 256 + hh * 64 + 32 + 2 * jj);
                const unsigned na = *(const unsigned*)(pr + PJ_D + hh * 64 + 2 * jj), nb = *(const unsigned*)(pr + PJ_D + hh * 64 + 32 + 2 * jj);
                const unsigned va = *(const unsigned*)(pr + vcol + 2 * jj), vb = *(const unsigned*)(pr + vcol + 32 + 2 * jj);
                float gate_in = 0.f; if (lane < 12) gate_in = bf2f(pr[3200 + lane]);
#define ROPE_NORM(a, b, G, o1, o2, n1a, n1b, n2a, n2b) \
                float n1a = bflo(a), n1b = bfhi(a), n2a = bflo(b), n2b = bfhi(b); { const float ss_ = group_sum<16>(n1a * n1a + n1b * n1b + n2a * n2a + n2b * n2b); const float rs_ = rsqrtf(ss_ * (1.f / 64.f) + 1e-6f); \
                    n1a *= rs_ * G[0]; n1b *= rs_ * G[1]; n2a *= rs_ * G[2]; n2b *= rs_ * G[3]; } \
                const unsigned o1 = pk2(n1a * cs0 - n2a * sn0, n1b * cs1 - n2b * sn1), o2 = pk2(n2a * cs0 + n1a * sn0, n2b * cs1 + n1b * sn1);
                ROPE_NORM(qa, qb, Gq, q1, q2, q1a, q1b, q2a, q2b)
                ROPE_NORM(ka, kb, Gk, k1, k2, k1a, k1b, k2a, k2b)
                ROPE_NORM(na, nb, Gn, r1, r2, r1a, r1b, r2a, r2b)
                ROPE_NORM(va, vb, Gv, v1, v2, v1a, v1b, v2a, v2b)
#undef ROPE_NORM
                bf16* o = QC + (size_t)row * 256 + hh * 64 + 2 * jj; *(unsigned*)o = q1; *(unsigned*)(o + 32) = q2;
                o = KC + (size_t)row * 256 + hh * 64 + 2 * jj; *(unsigned*)o = k1; *(unsigned*)(o + 32) = k2;
                o = QN + (size_t)row * 256 + hh * 64 + 2 * jj; *(unsigned*)o = pk2(r1a, r1b); *(unsigned*)(o + 32) = pk2(r2a, r2b);
                o = QR + (size_t)row * 256 + hh * 64 + 2 * jj; *(unsigned*)o = r1; *(unsigned*)(o + 32) = r2;
                o = vdst + (size_t)row * 64 + 2 * jj; *(unsigned*)o = (hh >= 2) ? va : v1; *(unsigned*)(o + 32) = (hh >= 2) ? vb : v2;
                if (lane < 12) GATE[(size_t)row * 12 + lane] = fsigmoid(gate_in);
            }
        }
    }
}
constexpr int SCAN_TC = 16;
DI void scan_unit8(const Ctx& C, int u) {
    const float* Wp = WSP(float, R_SC); const bf16* SCH = WSP(bf16, R_SCH); float* YA = WSP(float, R_YA); float* UB = WSP(float, R_SCANU); float* SMT = WSP(float, R_SCANS);
    const int pair = u / 3, kind = u % 3, b = pair >> 2, h = pair & 3, tid = C.tid;
    LAS float* buf = (LAS float*)C.lds;
    LAS float* ybuf = buf + 2 * 6144;
    const int row = tid >> 3, cg = tid & 7, tbase = kind == 0 ? 0 : NS / 2;
    const float vm = kind == 2 ? 0.f : 1.f;
    u32x4 ldA[2], ldB[2];
#define SCAN_LOAD(ld, chunk) do { _Pragma("unroll") for (int i = 0; i < 2; ++i) { const int p_ = tid + 512 * i; if (p_ < 896) { const int step = p_ / 56, r_ = p_ % 56; const size_t row_ = (size_t)b * NS + tbase + (chunk) * SCAN_TC + step; \
        if (r_ < 16) ld[i] = *(const u32x4*)(Wp + row_ * 256 + h * 64 + r_ * 4); else { const int v5 = (r_ - 16) >> 3, c_ = (r_ - 16) & 7; ld[i] = *(const u32x4*)(SCH + ((size_t)v5 * NT + row_) * 256 + h * 64 + c_ * 8); } } } } while (0)
#define SCAN_STORE(ld, slot) do { _Pragma("unroll") for (int i = 0; i < 2; ++i) { const int p_ = tid + 512 * i; if (p_ < 896) { const int step = p_ / 56, r_ = p_ % 56; LAS float* d_ = buf + (slot) * 6144 + step * 384; \
        if (r_ < 16) *(LAS u32x4*)(d_ + r_ * 4) = ld[i]; else { const int v5 = (r_ - 16) >> 3, c_ = (r_ - 16) & 7; LAS float* e_ = d_ + (1 + v5) * 64 + c_ * 8; const u32x4 x_ = ld[i]; \
            *(LAS f32x4*)e_ = (f32x4){bflo(x_.x), bfhi(x_.x), bflo(x_.y), bfhi(x_.y)}; *(LAS f32x4*)(e_ + 4) = (f32x4){bflo(x_.z), bfhi(x_.z), bflo(x_.w), bfhi(x_.w)}; } } } } while (0)
#define SCAN_FLUSH(chunk) do { _Pragma("unroll") for (int i = 0; i < 2; ++i) { const int i2 = tid + 512 * i, step = i2 >> 6, rr = i2 & 63; const LAS float* pp_ = ybuf + ((chunk) & 1) * 8192 + step * 512 + rr * 8; \
        const f32x4 pa_ = *(const LAS f32x4*)pp_, pb_ = *(const LAS f32x4*)(pp_ + 4); const float yv = ((pa_[0] + pa_[1]) + (pa_[2] + pa_[3])) + ((pb_[0] + pb_[1]) + (pb_[2] + pb_[3])); \
        if (kind == 2) UB[((size_t)b * (NS / 2) + (chunk) * SCAN_TC + step) * 256 + h * 64 + rr] = yv; else YA[((size_t)b * NS + tbase + (chunk) * SCAN_TC + step) * 256 + h * 64 + rr] = yv; } } while (0)
    __syncthreads();
    SCAN_LOAD(ldA, 0); SCAN_STORE(ldA, 0); SCAN_LOAD(ldB, 1); SCAN_LOAD(ldA, 2);
    f32x2 S[4];
#pragma unroll
    for (int c = 0; c < 4; ++c) { S[c][0] = (kind == 2 && row == 8 * cg + 2 * c) ? 1.f : 0.f; S[c][1] = (kind == 2 && row == 8 * cg + 2 * c + 1) ? 1.f : 0.f; }
    constexpr int NCH = (NS / 2) / SCAN_TC;
#pragma unroll 2
    for (int ck = 0; ck < NCH; ++ck) {
        __syncthreads();
        if (ck & 1) { if (ck + 1 < NCH) SCAN_STORE(ldA, (ck + 1) & 1); if (ck + 3 < NCH) SCAN_LOAD(ldA, ck + 3); }
        else        { if (ck + 1 < NCH) SCAN_STORE(ldB, (ck + 1) & 1); if (ck + 3 < NCH) SCAN_LOAD(ldB, ck + 3); }
        {
            const LAS float* bp = buf + (ck & 1) * 6144; LAS float* yb = ybuf + (ck & 1) * 8192 + tid;
#define SCAN_LDS(X, step) do { const LAS float* sp = bp + (step) * 384 + 8 * cg; X.w0 = *(const LAS f32x4*)(sp); X.w1 = *(const LAS f32x4*)(sp + 4); X.k0 = *(const LAS f32x4*)(sp + 64); X.k1 = *(const LAS f32x4*)(sp + 68); \
                X.q0 = *(const LAS f32x4*)(sp + 128); X.q1 = *(const LAS f32x4*)(sp + 132); X.b0 = *(const LAS f32x4*)(sp + 192); X.b1 = *(const LAS f32x4*)(sp + 196); \
                X.r0 = *(const LAS f32x4*)(sp + 256); X.r1 = *(const LAS f32x4*)(sp + 260); X.v = bp[(step) * 384 + 320 + row] * vm; } while (0)
#define SCAN_STEP(X, step) do { \
                f32x2 d2 = S[0] * (f32x2){X.q0[0], X.q0[1]}; d2 = S[1] * (f32x2){X.q0[2], X.q0[3]} + d2; d2 = S[2] * (f32x2){X.q1[0], X.q1[1]} + d2; d2 = S[3] * (f32x2){X.q1[2], X.q1[3]} + d2; \
                const float sa = -sum8(d2[0] + d2[1]); const f32x2 sa2 = (f32x2){sa, sa}, v2 = (f32x2){X.v, X.v}; \
                S[0] = S[0] * (f32x2){X.w0[0], X.w0[1]} + (sa2 * (f32x2){X.b0[0], X.b0[1]} + v2 * (f32x2){X.k0[0], X.k0[1]}); \
                S[1] = S[1] * (f32x2){X.w0[2], X.w0[3]} + (sa2 * (f32x2){X.b0[2], X.b0[3]} + v2 * (f32x2){X.k0[2], X.k0[3]}); \
                S[2] = S[2] * (f32x2){X.w1[0], X.w1[1]} + (sa2 * (f32x2){X.b1[0], X.b1[1]} + v2 * (f32x2){X.k1[0], X.k1[1]}); \
                S[3] = S[3] * (f32x2){X.w1[2], X.w1[3]} + (sa2 * (f32x2){X.b1[2], X.b1[3]} + v2 * (f32x2){X.k1[2], X.k1[3]}); \
                f32x2 y2 = S[0] * (f32x2){X.r0[0], X.r0[1]}; y2 = S[1] * (f32x2){X.r0[2], X.r0[3]} + y2; y2 = S[2] * (f32x2){X.r1[0], X.r1[1]} + y2; y2 = S[3] * (f32x2){X.r1[2], X.r1[3]} + y2; \
                yb[(step) * 512] = y2[0] + y2[1]; } while (0)
            struct StepIn { f32x4 w0, w1, k0, k1, q0, q1, b0, b1, r0, r1; float v; } A, B;
            SCAN_LDS(A, 0);
#pragma unroll 2
            for (int step = 0; step < SCAN_TC; step += 2) {
                SCAN_LDS(B, step + 1);
                __builtin_amdgcn_sched_barrier(0);
                SCAN_STEP(A, step);
                __builtin_amdgcn_sched_barrier(0);
                if (step + 2 < SCAN_TC) SCAN_LDS(A, step + 2);
                __builtin_amdgcn_sched_barrier(0);
                SCAN_STEP(B, step + 1);
                __builtin_amdgcn_sched_barrier(0);
            }
#undef SCAN_LDS
#undef SCAN_STEP
        }
        if (ck > 0) SCAN_FLUSH(ck - 1);
    }
    __syncthreads();
    SCAN_FLUSH(NCH - 1);
    if (kind == 0) {
        float* o = SMT + (size_t)pair * 4096 + row;
#pragma unroll
        for (int c = 0; c < 4; ++c) { o[(8 * cg + 2 * c) * 64] = S[c][0]; o[(8 * cg + 2 * c + 1) * 64] = S[c][1]; }
    }
#undef SCAN_LOAD
#undef SCAN_STORE
#undef SCAN_FLUSH
    __syncthreads();
}

constexpr int KROW = 144, KT_BYTES = 64 * KROW;
#define MFMA16(a, b, c) __builtin_amdgcn_mfma_f32_16x16x32_bf16((a), (b), (c), 0, 0, 0)
template <int NQT> struct FA { f32x4 O[NQT][4]; float l[NQT]; float negM; };
template <int NQT> DI void fa_init(FA<NQT>& st) {
#pragma unroll
    for (int q = 0; q < NQT; ++q) { st.l[q] = 0.f;
#pragma unroll
        for (int d = 0; d < 4; ++d) st.O[q][d] = (f32x4){0.f, 0.f, 0.f, 0.f}; }
}
DI bf16x8 pack8(const f32x4& a, const f32x4& b) { u32x4 w; w.x = pk2(a[0], a[1]); w.y = pk2(a[2], a[3]); w.z = pk2(b[0], b[1]); w.w = pk2(b[2], b[3]); return __builtin_bit_cast(bf16x8, w); }
struct VFrag { u32x2 a[4], b[4]; };
DI void vt_issue(VFrag& f, unsigned vaddr) {
    asm volatile("ds_read_b64_tr_b16 %0, %8\n\tds_read_b64_tr_b16 %1, %8 offset:2304\n\tds_read_b64_tr_b16 %2, %8 offset:32\n\tds_read_b64_tr_b16 %3, %8 offset:2336\n\t"
                 "ds_read_b64_tr_b16 %4, %8 offset:64\n\tds_read_b64_tr_b16 %5, %8 offset:2368\n\tds_read_b64_tr_b16 %6, %8 offset:96\n\tds_read_b64_tr_b16 %7, %8 offset:2400"
                 : "=&v"(f.a[0]), "=&v"(f.b[0]), "=&v"(f.a[1]), "=&v"(f.b[1]), "=&v"(f.a[2]), "=&v"(f.b[2]), "=&v"(f.a[3]), "=&v"(f.b[3]) : "v"(vaddr) : "memory");
}
DI void vt_wait(VFrag& f) { asm volatile("s_waitcnt lgkmcnt(0)" : "+v"(f.a[0]), "+v"(f.b[0]), "+v"(f.a[1]), "+v"(f.b[1]), "+v"(f.a[2]), "+v"(f.b[2]), "+v"(f.a[3]), "+v"(f.b[3]) :: "memory"); }
DI bf16x8 vt_get(const VFrag& f, int d) { return __builtin_bit_cast(bf16x8, ((u32x4){f.a[d].x, f.a[d].y, f.b[d].x, f.b[d].y})); }
template <int NQT, bool MASKED, class MaskF>
DI void fa_tile(FA<NQT>& st, const bf16x8 (&Q)[NQT][2], const LAS uchar* Ks, const LAS uchar* Vs, int lane, const MaskF& allowed, const bool (&act)[NQT]) {
    const int l15 = lane & 15, quad = lane >> 4;
    float nm_ = st.negM; asm volatile("" : "+v"(nm_));
    f32x4 S[NQT][4]; const f32x4 sinit = (f32x4){nm_, nm_, nm_, nm_};
#pragma unroll
    for (int kt = 0; kt < 4; ++kt) {
        const bf16x8 k0 = *(const LAS bf16x8*)(Ks + (16 * kt + l15) * KROW + quad * 16), k1 = *(const LAS bf16x8*)(Ks + (16 * kt + l15) * KROW + 64 + quad * 16);
#pragma unroll
        for (int q = 0; q < NQT; ++q) if (act[q]) { S[q][kt] = MFMA16(k0, Q[q][0], sinit); S[q][kt] = MFMA16(k1, Q[q][1], S[q][kt]); }
    }
    const unsigned vaddr = (unsigned)(size_t)(Vs + (4 * quad + (l15 >> 2)) * KROW + 8 * (l15 & 3));
    VFrag v0, v1; vt_issue(v0, vaddr);
#pragma unroll
    for (int q = 0; q < NQT; ++q) if (act[q]) {
        float rs = 0.f;
#pragma unroll
        for (int kt = 0; kt < 4; ++kt)
#pragma unroll
            for (int j = 0; j < 4; ++j) { float p = fexp2(S[q][kt][j]); if (MASKED) p = allowed(q, 16 * kt + 4 * quad + j) ? p : 0.f; S[q][kt][j] = p; rs += p; }
        st.l[q] += rs;
    }
    vt_wait(v0); vt_issue(v1, vaddr + 32 * KROW);
#pragma unroll
    for (int q = 0; q < NQT; ++q) if (act[q]) {
        const bf16x8 p0 = pack8(S[q][0], S[q][1]);
#pragma unroll
        for (int d = 0; d < 4; ++d) st.O[q][d] = MFMA16(vt_get(v0, d), p0, st.O[q][d]);
    }
    vt_wait(v1);
#pragma unroll
    for (int q = 0; q < NQT; ++q) if (act[q]) {
        const bf16x8 p1 = pack8(S[q][2], S[q][3]);
#pragma unroll
        for (int d = 0; d < 4; ++d) st.O[q][d] = MFMA16(vt_get(v1, d), p1, st.O[q][d]);
    }
}
template <int NQT> DI void fa_finish(FA<NQT>& st, float (&lse2)[NQT]) {
#pragma unroll
    for (int q = 0; q < NQT; ++q) { float l = st.l[q]; l += __shfl_xor(l, 16); l += __shfl_xor(l, 32); const float inv = l > 0.f ? 1.f / l : 0.f; lse2[q] = __log2f(fmaxf(l, 1e-37f));
#pragma unroll
        for (int d = 0; d < 4; ++d) st.O[q][d] = st.O[q][d] * inv; }
}
DI float score_bound(const float* gq, const float* gk, int lane) {
    float a = fabsf(gq[lane & 63]), b = fabsf(gk[lane & 63]);
#pragma unroll
    for (int o = 1; o < 64; o <<= 1) { a = fmaxf(a, __shfl_xor(a, o)); b = fmaxf(b, __shfl_xor(b, o)); }
    return __builtin_bit_cast(float, __builtin_amdgcn_readfirstlane(__builtin_bit_cast(int, 64.f * a * b * QSCALE * 1.02f + 0.5f)));
}
DI void kv_store(LAS uchar* Ks, LAS uchar* Vs, int tid, const u32x4& kr, const u32x4& vr) {
    const int o = (tid >> 3) * KROW + (tid & 7) * 16; *(LAS u32x4*)(Ks + o) = kr; *(LAS u32x4*)(Vs + o) = vr;
}
DI void q_load(bf16x8 (&Q)[2], const bf16* qrow, int quad) { Q[0] = *(const bf16x8*)(qrow + 8 * quad); Q[1] = *(const bf16x8*)(qrow + 32 + 8 * quad); }

struct DilMask { int qi[2]; int k0; DI bool operator()(int q, int key) const { const int ki = k0 + key, d = qi[q] - ki; return ki >= 0 && (unsigned)d <= 128u; } };
DI void dil_unit(const Ctx& C, int unit, LAS uchar* lds0, LAS uchar*  , float negM_bound) {
    const bf16 *QC = WSP(bf16, R_QC), *KC = WSP(bf16, R_KC), *PROJ = WSP(bf16, R_PROJ); float* OC = WSP(float, R_OC); float* LSE = WSP(float, R_LSE);
    int tid = C.tid, lane = C.lane; asm volatile("" : "+v"(tid), "+v"(lane));
    const int w = C.wave, l15 = lane & 15, quad = lane >> 4, wq = w & 3;
    const int cfg = unit / 512, r = unit % 512, dsh = 2 * cfg, d = 1 << dsh;
    const int b = r >> 6, hp = (r >> 5) & 1, r2 = r & 31;
    const int nblk = 32 >> dsh, res = r2 / nblk, blk = r2 % nblk, i0 = blk * 128, h = 2 * hp + (w >> 2);
    const size_t tb = (size_t)b * NS;
    bf16x8 Q[2][2]; DilMask mk; FA<2> st; fa_init(st); st.negM = -negM_bound;
#pragma unroll
    for (int q = 0; q < 2; ++q) { mk.qi[q] = i0 + 32 * wq + 16 * q + l15; q_load(Q[q], QC + (tb + res + (size_t)d * mk.qi[q]) * 256 + h * 64, quad); }
    const int jlo = wq >> 1, jhi = (wq >> 1) + 2;
    const bool act[2] = {true, true};
    u32x4 kr0, vr0, kr1, vr1;
#define DIL_LOAD(j) do { const int ki = i0 - 128 + 64 * (j) + (tid >> 3); kr0 = (u32x4){0u, 0u, 0u, 0u}; vr0 = kr0; kr1 = kr0; vr1 = kr0; \
    if (ki >= 0) { const size_t rowk = tb + res + (size_t)d * ki; const bf16* kp = KC + rowk * 256 + 128 * hp + (tid & 7) * 8; const bf16* vp = PROJ + rowk * NPJ + PJ_C + 512 + 128 * hp + (tid & 7) * 8; \
        kr0 = *(const u32x4*)kp; kr1 = *(const u32x4*)(kp + 64); vr0 = *(const u32x4*)vp; vr1 = *(const u32x4*)(vp + 64); } } while (0)
#define DIL_STORE(p) do { LAS uchar* b_ = lds0 + (p) * 4 * KT_BYTES; kv_store(b_, b_ + KT_BYTES, tid, kr0, vr0); kv_store(b_ + 2 * KT_BYTES, b_ + 3 * KT_BYTES, tid, kr1, vr1); } while (0)
    DIL_LOAD(0); __syncthreads(); DIL_STORE(0); DIL_LOAD(1);
    for (int j = 0; j < 4; ++j) {
        __syncthreads();
        if (j + 1 < 4) DIL_STORE((j + 1) & 1);
        if (j + 2 < 4) DIL_LOAD(j + 2);
        if (j >= jlo && j <= jhi) { mk.k0 = i0 - 128 + 64 * j; const LAS uchar* kb = lds0 + (j & 1) * 4 * KT_BYTES + (w >> 2) * 2 * KT_BYTES; fa_tile<2, true>(st, Q, kb, kb + KT_BYTES, lane, mk, act); }
    }
#undef DIL_LOAD
#undef DIL_STORE
    float lse2[2]; fa_finish<2>(st, lse2);
#pragma unroll
    for (int q = 0; q < 2; ++q) { const size_t rowq = tb + res + (size_t)d * mk.qi[q]; float* o = OC + ((size_t)cfg * NT + rowq) * 256 + h * 64 + 4 * quad;
#pragma unroll
        for (int dt = 0; dt < 4; ++dt) *(f32x4*)(o + 16 * dt) = st.O[q][dt];
        if (quad == 0) LSE[((size_t)cfg * NT + rowq) * 4 + h] = lse2[q]; }
}
constexpr int NSA_KC = 0, NSA_VC = 256 * KROW, NSA_KT = 2 * 256 * KROW, NSA_VT = NSA_KT + KT_BYTES, NSA_IMP = NSA_KT + 4 * KT_BYTES,
    NSA_SELM = NSA_IMP + 64 * 64 * 4, NSA_UW = NSA_SELM + 512;
static_assert(NSA_UW + 16 <= RING_BYTES, "NSA LDS map");
DI void cmp_mlp_wait(const Ctx& C, int l);
struct SwaMask { int t[2]; int k0; DI bool operator()(int q, int key) const { const int d = t[q] - (k0 + key); return (unsigned)d <= 511u; } };
struct SlcMask { int t[2]; int k0; bool sel[2]; DI bool operator()(int q, int key) const { return sel[q] && (k0 + key <= t[q]); } };
struct NoMask { DI bool operator()(int, int) const { return true; } };
DI void nsa_unit(const Ctx& C, int l, int b, int tbk, int& bl, bool& cmp_ready, float bnd_cmp, float bnd_slc, float bnd_swa) {
    const bf16 *QN = WSP(bf16, R_QN), *QR = WSP(bf16, R_QR), *KSb = WSP(bf16, R_KS), *KWb = WSP(bf16, R_KW), *PROJ = WSP(bf16, R_PROJ); const float* CMP = WSP(float, R_CMP); const float* GATE = WSP(float, R_GATE);
    bf16* YCAT = WSP(bf16, R_YCAT);
    LAS uchar* Kc = C.lds + NSA_KC; LAS uchar* Vc = C.lds + NSA_VC; LAS uchar* Ks = C.lds + NSA_KT; LAS uchar* Vs = C.lds + NSA_VT;
    LAS float* imps = (LAS float*)(C.lds + NSA_IMP); LAS unsigned* selm = (LAS unsigned*)(C.lds + NSA_SELM); LAS unsigned* uw = (LAS unsigned*)(C.lds + NSA_UW);
    int tid = C.tid, lane = C.lane; asm volatile("" : "+v"(tid), "+v"(lane));
    const int w = C.wave, l15 = lane & 15, quad = lane >> 4, head = l15 & 3, t0 = 64 * tbk; const size_t tb = (size_t)b * NS;
    __syncthreads();
    if (b != bl) {
        if (!cmp_ready) { cmp_mlp_wait(C, l); cmp_ready = true; }
        const int key = tid >> 1, hf = tid & 1; const float* kp = CMP + ((size_t)b * 256 + key) * 64 + 32 * hf; const float* vp = CMP + ((size_t)2048 + (size_t)b * 256 + key) * 64 + 32 * hf;
        float kv[32], vv[32]; float ss = 0.f;
#pragma unroll
        for (int i = 0; i < 8; ++i) { const f32x4 a = *(const f32x4*)(kp + 4 * i), c = *(const f32x4*)(vp + 4 * i);
#pragma unroll
            for (int j = 0; j < 4; ++j) { kv[4 * i + j] = a[j]; vv[4 * i + j] = c[j]; ss += a[j] * a[j]; } }
        ss += __shfl_xor(ss, 1); const float rstd = rsqrtf(ss * (1.f / 64.f) + 1e-6f); const float* g = C.nsa_kc_g + (size_t)l * 64 + 32 * hf; const bool dead = (key == 255);
#pragma unroll
        for (int i = 0; i < 4; ++i) { u32x4 o, p;
            o.x = pk2(kv[8 * i] * rstd * g[8 * i], kv[8 * i + 1] * rstd * g[8 * i + 1]); o.y = pk2(kv[8 * i + 2] * rstd * g[8 * i + 2], kv[8 * i + 3] * rstd * g[8 * i + 3]);
            o.z = pk2(kv[8 * i + 4] * rstd * g[8 * i + 4], kv[8 * i + 5] * rstd * g[8 * i + 5]); o.w = pk2(kv[8 * i + 6] * rstd * g[8 * i + 6], kv[8 * i + 7] * rstd * g[8 * i + 7]);
            p.x = pk2(vv[8 * i], vv[8 * i + 1]); p.y = pk2(vv[8 * i + 2], vv[8 * i + 3]); p.z = pk2(vv[8 * i + 4], vv[8 * i + 5]); p.w = pk2(vv[8 * i + 6], vv[8 * i + 7]);
            if (dead) { o = (u32x4){0u, 0u, 0u, 0u}; p = o; }
            *(LAS u32x4*)(Kc + key * KROW + hf * 64 + i * 16) = o; *(LAS u32x4*)(Vc + key * KROW + hf * 64 + i * 16) = p; }
        bl = b;
        __syncthreads();
    }
    f32x4 Oc[2][4];
    const int cmaxu = (t0 + 32) >> 4, ktmax = cmaxu >> 4;
    const unsigned vaddr0 = (unsigned)(size_t)(Vc + (4 * quad + (l15 >> 2)) * KROW + 8 * (l15 & 3));
#pragma unroll
    for (int q = 0; q < 2; ++q) {
        const int t = t0 + 8 * w + 4 * q + (l15 >> 2);
        bf16x8 Q[2]; q_load(Q, QN + (tb + t) * 256 + head * 64, quad);
        float nm_ = -bnd_cmp; asm volatile("" : "+v"(nm_)); f32x4 S[16]; const f32x4 sinit = (f32x4){nm_, nm_, nm_, nm_}; float ls = 0.f;
#pragma unroll
        for (int kt = 0; kt < 16; ++kt) {
            if (kt <= ktmax) {
                const bf16x8 k0 = *(const LAS bf16x8*)(Kc + (16 * kt + l15) * KROW + quad * 16), k1 = *(const LAS bf16x8*)(Kc + (16 * kt + l15) * KROW + 64 + quad * 16);
                S[kt] = MFMA16(k0, Q[0], sinit); S[kt] = MFMA16(k1, Q[1], S[kt]);
#pragma unroll
                for (int j = 0; j < 4; ++j) { const int c = 16 * kt + 4 * quad + j; const float p = (16 * c + 31 <= t) ? fexp2(S[kt][j]) : 0.f; S[kt][j] = p; ls += p; }
            } else S[kt] = (f32x4){0.f, 0.f, 0.f, 0.f};
        }
        ls += __shfl_xor(ls, 16); ls += __shfl_xor(ls, 32);
        const float inv = ls > 0.f ? 1.f / ls : 0.f;
#pragma unroll
        for (int kt = 0; kt < 16; ++kt) S[kt] = S[kt] * inv;
#pragma unroll
        for (int kt = 0; kt < 16; ++kt) {
            const float send = (quad == 3) ? (kt > 0 ? S[kt > 0 ? kt - 1 : 0][3] : 0.f) : S[kt][3];
            const float prev = __shfl(send, (lane + 48) & 63);
            float v = ((quad == 0 && kt == 0) ? 0.f : prev) + 2.f * (S[kt][0] + S[kt][1] + S[kt][2]) + S[kt][3];
            v = group_sum<4>(v);
            if (head == 0) imps[(8 * w + 4 * q + (l15 >> 2)) * 64 + 4 * kt + quad] = v;
        }
#pragma unroll
        for (int d = 0; d < 4; ++d) Oc[q][d] = (f32x4){0.f, 0.f, 0.f, 0.f};
#pragma unroll
        for (int ks = 0; ks < 8; ++ks) {
            if (2 * ks <= ktmax) {
                VFrag vf; vt_issue(vf, vaddr0 + ks * 32 * KROW); const bf16x8 pf = pack8(S[2 * ks], S[2 * ks + 1]); vt_wait(vf);
#pragma unroll
                for (int d = 0; d < 4; ++d) Oc[q][d] = MFMA16(vt_get(vf, d), pf, Oc[q][d]);
            }
        }
    }
    {
        float* OCm = WSP(float, R_OCMP);
#pragma unroll
        for (int q = 0; q < 2; ++q) { float* o = OCm + (tb + t0 + 8 * w + 4 * q + (l15 >> 2)) * 256 + head * 64 + 4 * quad;
#pragma unroll
            for (int d = 0; d < 4; ++d) *(f32x4*)(o + 16 * d) = Oc[q][d]; }
    }
    __syncthreads();
    if (tid < 64) {
        const int cur = tbk; unsigned long long mask;
        if (cur <= 15) mask = (2ull << cur) - 1ull;
        else {
            mask = 1ull | (1ull << cur) | (1ull << (cur - 1));
            float v[64];
#pragma unroll
            for (int i = 0; i < 16; ++i) { const f32x4 a = *(const LAS f32x4*)(imps + tid * 64 + 4 * i);
#pragma unroll
                for (int j = 0; j < 4; ++j) { const int jb = 4 * i + j; v[jb] = (jb >= 1 && jb <= cur - 2) ? a[j] : -1.f; } }
#pragma unroll 1
            for (int r = 0; r < 13; ++r) {
                float bv = -0.5f; int bi = 0;
#pragma unroll
                for (int jb = 0; jb < 64; ++jb) if (v[jb] > bv) { bv = v[jb]; bi = jb; }
                mask |= 1ull << bi;
#pragma unroll
                for (int jb = 0; jb < 64; ++jb) v[jb] = (jb == bi) ? -1.f : v[jb];
            }
        }
        unsigned lo = (unsigned)mask, hi = (unsigned)(mask >> 32);
        selm[2 * tid] = lo; selm[2 * tid + 1] = hi;
#pragma unroll
        for (int o = 1; o < 64; o <<= 1) { lo |= __shfl_xor(lo, o); hi |= __shfl_xor(hi, o); }
        if (tid == 0) { uw[0] = lo; uw[1] = hi; }
    }
    __syncthreads();
    unsigned long long U = ((unsigned long long)uw[1] << 32) | uw[0];
    bf16x8 Q[2][2]; SlcMask mk; FA<2> st; fa_init(st); st.negM = -bnd_slc; unsigned long long msk[2];
#pragma unroll
    for (int q = 0; q < 2; ++q) { const int tl = 8 * w + 4 * q + (l15 >> 2); mk.t[q] = t0 + tl; msk[q] = ((unsigned long long)selm[2 * tl + 1] << 32) | selm[2 * tl]; q_load(Q[q], QR + (tb + mk.t[q]) * 256 + head * 64, quad); }
    unsigned long long QM[2];
#pragma unroll
    for (int q = 0; q < 2; ++q) { unsigned lo = (unsigned)msk[q], hi = (unsigned)(msk[q] >> 32);
#pragma unroll
        for (int o = 1; o < 64; o <<= 1) { lo |= __shfl_xor(lo, o); hi |= __shfl_xor(hi, o); }
        QM[q] = ((unsigned long long)hi << 32) | lo; }
#ifndef PROBE_SLC2
#define PROBE_SLC2 0
#endif
#ifndef PROBE_SWA2
#define PROBE_SWA2 0
#endif
    u32x4 kr, vr; const unsigned long long U0 = U;
    for (int prep_ = 0; prep_ <= PROBE_SLC2; ++prep_) { U = U0; if (prep_ < PROBE_SLC2) { fa_init(st); }
#define SLC_LOAD(j) do { const size_t rowk = tb + 64 * (j) + (tid >> 3); kr = *(const u32x4*)(KSb + rowk * 64 + (tid & 7) * 8); vr = *(const u32x4*)(PROJ + rowk * NPJ + 3008 + (tid & 7) * 8); } while (0)
    {
        int j = __builtin_ctzll(U); U &= U - 1ull;
        int jn = U ? __builtin_ctzll(U) : -1; U &= U - 1ull;
        SLC_LOAD(j); __syncthreads(); kv_store(Ks, Vs, tid, kr, vr); if (jn >= 0) SLC_LOAD(jn);
        for (int it = 0;; ++it) {
            __syncthreads();
            const int jnn = U ? __builtin_ctzll(U) : -1; U &= U - 1ull;
            if (jn >= 0) kv_store(Ks + ((it + 1) & 1) * 2 * KT_BYTES, Vs + ((it + 1) & 1) * 2 * KT_BYTES, tid, kr, vr);
            if (jnn >= 0) SLC_LOAD(jnn);
            const bool act[2] = {(bool)((QM[0] >> j) & 1ull), (bool)((QM[1] >> j) & 1ull)};
            if (act[0] || act[1]) { mk.k0 = 64 * j; mk.sel[0] = (msk[0] >> j) & 1ull; mk.sel[1] = (msk[1] >> j) & 1ull; fa_tile<2, true>(st, Q, Ks + (it & 1) * 2 * KT_BYTES, Vs + (it & 1) * 2 * KT_BYTES, lane, mk, act); }
            if (jn < 0) break; j = jn; jn = jnn;
        }
    }
#undef SLC_LOAD
    }
    float lse2[2]; fa_finish<2>(st, lse2);
    {   float* OSl = WSP(float, R_OSLC);
#pragma unroll
        for (int q = 0; q < 2; ++q) { float* o = OSl + (tb + mk.t[q]) * 256 + head * 64 + 4 * quad;
#pragma unroll
            for (int d = 0; d < 4; ++d) *(f32x4*)(o + 16 * d) = st.O[q][d]; }
    }
    FA<2> sw; fa_init(sw); sw.negM = -bnd_swa; SwaMask mw; mw.t[0] = mk.t[0]; mw.t[1] = mk.t[1];
    for (int prep_ = 0; prep_ <= PROBE_SWA2; ++prep_) { if (prep_ < PROBE_SWA2) fa_init(sw);
    {
        const int j0 = tbk >= 8 ? tbk - 8 : 0; const bool act[2] = {true, true};
#define SWA_LOAD(j) do { const size_t rowk = tb + 64 * (j) + (tid >> 3); kr = *(const u32x4*)(KWb + rowk * 64 + (tid & 7) * 8); vr = *(const u32x4*)(PROJ + rowk * NPJ + 3136 + (tid & 7) * 8); } while (0)
        SWA_LOAD(j0); __syncthreads(); kv_store(Ks, Vs, tid, kr, vr); if (j0 + 1 <= tbk) SWA_LOAD(j0 + 1);
        for (int j = j0; j <= tbk; ++j) {
            const int pb_ = (j - j0) & 1;
            __syncthreads();
            if (j + 1 <= tbk) kv_store(Ks + (pb_ ^ 1) * 2 * KT_BYTES, Vs + (pb_ ^ 1) * 2 * KT_BYTES, tid, kr, vr);
            if (j + 2 <= tbk) SWA_LOAD(j + 2);
            mw.k0 = 64 * j;
            if (j == tbk || j == tbk - 8) fa_tile<2, true>(sw, Q, Ks + pb_ * 2 * KT_BYTES, Vs + pb_ * 2 * KT_BYTES, lane, mw, act);
            else fa_tile<2, false>(sw, Q, Ks + pb_ * 2 * KT_BYTES, Vs + pb_ * 2 * KT_BYTES, lane, NoMask(), act);
        }
#undef SWA_LOAD
    }
    }
    fa_finish<2>(sw, lse2);
#pragma unroll
    for (int q = 0; q < 2; ++q) {
        const size_t row = tb + mk.t[q]; const float* gp = GATE + row * 12 + head * 3; const float g0 = gp[0], g1 = gp[1], g2 = gp[2];
        f32x4 o[4]; float ss = 0.f; const float* pc = WSP(float, R_OCMP) + row * 256 + head * 64 + 4 * quad; const float* ps = WSP(float, R_OSLC) + row * 256 + head * 64 + 4 * quad;
#pragma unroll
        for (int d = 0; d < 4; ++d) { o[d] = *(const f32x4*)(pc + 16 * d) * g0 + *(const f32x4*)(ps + 16 * d) * g1 + sw.O[q][d] * g2; ss += (o[d][0] * o[d][0] + o[d][1] * o[d][1]) + (o[d][2] * o[d][2] + o[d][3] * o[d][3]); }
        ss += __shfl_xor(ss, 16); ss += __shfl_xor(ss, 32);
        const float rstd = rsqrtf(ss * (1.f / 64.f) + 1e-6f); const float* og = C.onorm_g + (size_t)l * 768 + 512 + head * 64 + 4 * quad;
        bf16* yo = YCAT + row * DM + 768 + head * 64 + 4 * quad;
#pragma unroll
        for (int d = 0; d < 4; ++d) { const f32x4 g4 = *(const f32x4*)(og + 16 * d); u32x2 wv; wv.x = pk2(o[d][0] * rstd * g4[0], o[d][1] * rstd * g4[1]); wv.y = pk2(o[d][2] * rstd * g4[2], o[d][3] * rstd * g4[3]); *(u32x2*)(yo + 16 * d) = wv; }
    }
}

DI void fin_phase(const Ctx& C, int l) {
    const bf16* SCH = WSP(bf16, R_SCH); const float* YA = WSP(float, R_YA); const bf16* Gb = WSP(bf16, R_G); const float* OC = WSP(float, R_OC); const float* LSE = WSP(float, R_LSE);
    const float* UB = WSP(float, R_SCANU); const float* SMT = WSP(float, R_SCANS); bf16* YCAT = WSP(bf16, R_YCAT);
    const int lane = C.lane, ch = 4 * lane, hh = lane >> 4;
    LAS float* sm = (LAS float*)C.lds;
    LAS float* us = sm + 4 * 4096 + C.wave * 512;
    const f32x4 rk = *(const f32x4*)(C.rk + (size_t)l * 256 + ch), gw4 = *(const f32x4*)(C.gn_w + (size_t)l * 256 + ch), gb4 = *(const f32x4*)(C.gn_b + (size_t)l * 256 + ch);
    const f32x4 og = *(const f32x4*)(C.onorm_g + (size_t)l * 768 + 256 + ch);
    int bl = -1;
    for (int it = C.bid; it < NT / 128; it += C.G) {
        const int b = it >> 5, kk = it & 31;
        if (b != bl) { __syncthreads(); for (int i = C.tid; i < 4096; i += NTHR) *(LAS f32x4*)(sm + 4 * i) = *(const f32x4*)(SMT + (size_t)b * 4 * 4096 + 4 * i); bl = b; __syncthreads(); }
#pragma unroll 4
        for (int r = 0; r < 16; ++r) {
            const int row = b * NS + (r >> 3) * (NS / 2) + 64 * kk + C.wave * 8 + (r & 7); const size_t o = (size_t)row * 256 + ch;
            const float l0 = LSE[(size_t)row * 4 + hh], l1 = LSE[((size_t)NT + row) * 4 + hh], l2 = LSE[((size_t)2 * NT + row) * 4 + hh];
            const f32x4 a = *(const f32x4*)(OC + o), bq = *(const f32x4*)(OC + (size_t)NT * 256 + o), c = *(const f32x4*)(OC + (size_t)2 * NT * 256 + o);
            const float mx = fmaxf(l0, fmaxf(l1, l2)); float w0 = fexp2(l0 - mx), w1 = fexp2(l1 - mx), w2 = fexp2(l2 - mx); const float inv = __builtin_amdgcn_rcpf(w0 + w1 + w2); w0 *= inv; w1 *= inv; w2 *= inv;
            const f32x4 y = a * w0 + bq * w1 + c * w2;
            const float ss = group_sum<16>((y[0] * y[0] + y[1] * y[1]) + (y[2] * y[2] + y[3] * y[3])); const float rstd = rsqrtf(ss * (1.f / 64.f) + 1e-6f);
            u32x2 w; w.x = pk2(y[0] * rstd * og[0], y[1] * rstd * og[1]); w.y = pk2(y[2] * rstd * og[2], y[3] * rstd * og[3]); *(u32x2*)(YCAT + (size_t)row * DM + 512 + ch) = w;
        }
#pragma unroll 1
        for (int hf = 0; hf < 2; ++hf) {
#pragma unroll 2
            for (int r = 0; r < 8; ++r) {
                const int row = b * NS + hf * (NS / 2) + 64 * kk + C.wave * 8 + r, s = row % NS; const size_t o = (size_t)row * 256 + ch;
                f32x4 y = *(const f32x4*)(YA + o); const u32x2 rr_ = *(const u32x2*)(SCH + (size_t)3 * NT * 256 + o), k_ = *(const u32x2*)(SCH + o), v_ = *(const u32x2*)(SCH + (size_t)4 * NT * 256 + o), g_ = *(const u32x2*)(Gb + o);
                const f32x4 rr = (f32x4){bflo(rr_.x), bfhi(rr_.x), bflo(rr_.y), bfhi(rr_.y)}, k = (f32x4){bflo(k_.x), bfhi(k_.x), bflo(k_.y), bfhi(k_.y)}, v = (f32x4){bflo(v_.x), bfhi(v_.x), bflo(v_.y), bfhi(v_.y)}, g = (f32x4){bflo(g_.x), bfhi(g_.x), bflo(g_.y), bfhi(g_.y)};
                if (hf == 1) {
                    LAS float* ub = us + (r & 1) * 256;
                    *(LAS f32x4*)(ub + ch) = *(const f32x4*)(UB + ((size_t)b * (NS / 2) + (s - NS / 2)) * 256 + ch);
                    asm volatile("s_waitcnt lgkmcnt(0)" ::: "memory");
                    const LAS float* sp = sm + hh * 4096 + 4 * (lane & 15); const LAS float* up = ub + hh * 64;
#pragma unroll 8
                    for (int j4 = 0; j4 < 16; ++j4) { const f32x4 u4 = *(const LAS f32x4*)(up + 4 * j4);
#pragma unroll
                        for (int jj = 0; jj < 4; ++jj) y += *(const LAS f32x4*)(sp + (4 * j4 + jj) * 64) * u4[jj]; }
                }
                const float mu = group_sum<16>((y[0] + y[1]) + (y[2] + y[3])) * (1.f / 64.f);
                const f32x4 dy = y - mu; const float var = group_sum<16>((dy[0] * dy[0] + dy[1] * dy[1]) + (dy[2] * dy[2] + dy[3] * dy[3])) * (1.f / 64.f);
                const float rstd = rsqrtf(var + 64e-5f);
                const float dot = group_sum<16>((rr[0] * k[0] * rk[0] + rr[1] * k[1] * rk[1]) + (rr[2] * k[2] * rk[2] + rr[3] * k[3] * rk[3]));
                float out[4];
#pragma unroll
                for (int i = 0; i < 4; ++i) out[i] = ((dy[i] * rstd * gw4[i] + gb4[i]) + dot * v[i]) * g[i];
                u32x2 w; w.x = pk2(out[0], out[1]); w.y = pk2(out[2], out[3]); *(u32x2*)(YCAT + (size_t)row * DM + ch) = w;
            }
        }
    }
    __syncthreads();
}

constexpr int CW_Q = 40000;
DI int q_next(const Ctx& C, unsigned* ctr, LAS int* slot) {
    __syncthreads();
    if (C.tid == 0) *slot = (int)__hip_atomic_fetch_add(ctr, 1u, __ATOMIC_RELAXED, __HIP_MEMORY_SCOPE_AGENT);
    __syncthreads();
    return *slot;
}
DI void conv_ticket(const Ctx& C, int l, int tk);
constexpr int CW_CD = 41000;
DI void cmp_mlp_unit(const Ctx& C, int l, int cb) {
    const int kv = cb >> 3;
    { pg8::Gemm g{kv ? WSP(bf16, R_VCR) : WSP(bf16, R_KCR), WSP(bf16, WS_WK1) + (size_t)(l * 2 + kv) * 256 * 2048, 1024, 2048}; pg8::StaticOrder S; S.init(8, 1, 8, cb & 7);
      EpiC1 E{WSP(bf16, R_CH1) + (size_t)kv * 2048 * 256, (WSP(float, WS_SMALL) + NLAYER * 8 * 6144 + l * 512 + kv * 256)}; pg8::gemm_phase(C.lds, C.tid, g, S, E); }
    asm volatile("s_waitcnt vmcnt(0)" ::: "memory"); __syncthreads();
    { pg8::Gemm g{WSP(bf16, R_CH1) + (size_t)kv * 2048 * 256, WSP(bf16, WS_WK2) + (size_t)(l * 2 + kv) * 256 * 256, 256, 256}; pg8::StaticOrder S; S.init(8, 1, 8, cb & 7);
      EpiC2 E{WSP(float, R_CMP) + (size_t)kv * 2048 * 64}; pg8::gemm_phase(C.lds, C.tid, g, S, E); }
    asm volatile("s_waitcnt vmcnt(0)" ::: "memory"); __syncthreads();
    if (C.tid == 0) { __builtin_amdgcn_fence(__ATOMIC_RELEASE, "agent"); asm volatile("s_waitcnt vmcnt(0)" ::: "memory");
        __hip_atomic_fetch_add(WSP(unsigned, WS_CTL) + CW_CD + 64 * l, 1u, __ATOMIC_RELAXED, __HIP_MEMORY_SCOPE_AGENT); }
}
DI void cmp_mlp_wait(const Ctx& C, int l) {
    if (C.tid == 0) { unsigned* c = WSP(unsigned, WS_CTL) + CW_CD + 64 * l; unsigned sp = 0u;
        while (__hip_atomic_load(c, __ATOMIC_RELAXED, __HIP_MEMORY_SCOPE_AGENT) < 16u) { __builtin_amdgcn_s_sleep(8); if (++sp > (1u << 21)) break; }
        __builtin_amdgcn_fence(__ATOMIC_ACQUIRE, "agent"); asm volatile("s_waitcnt vmcnt(0)" ::: "memory"); }
    __syncthreads();
}
DI void mix_phase(const Ctx& C, int l, int rep) {
    unsigned* ctl = WSP(unsigned, WS_CTL) + CW_Q + 64 * 3 * (l + 2 * rep); LAS int* slot = (LAS int*)(C.lds + MISC_OFF + 1024);
#ifndef PROBE_SPLIT
#define PROBE_SPLIT 0
#endif
    if (C.bid < 96) { scan_unit8(C, C.bid); if (PROBE_SCAN2) scan_unit8(C, C.bid); }
    else if (C.bid < 112) cmp_mlp_unit(C, l, C.bid - 96);
    bool cmp_ready = false;
    if (PROBE_SPLIT) { asm volatile("s_waitcnt vmcnt(0)" ::: "memory"); __syncthreads(); { XcdBarrier bar2; bar2.bar = WSP(unsigned, WS_CTL) + CW_BAR; bar2.x = xb_xcc_id(); bar2.st = (volatile LAS unsigned*)(C.lds + MISC_OFF); xcd_barrier(bar2); } }
    int bl = -1;
    const float bnd_cmp = score_bound(C.nsa_q_g + (size_t)l * 64, C.nsa_kc_g + (size_t)l * 64, C.lane), bnd_slc = score_bound(C.nsa_q_g + (size_t)l * 64, C.nsa_ks_g + (size_t)l * 64, C.lane),
                bnd_swa = score_bound(C.nsa_q_g + (size_t)l * 64, C.nsa_kw_g + (size_t)l * 64, C.lane), bnd_dil = score_bound(C.dil_q_g + (size_t)l * 64, C.dil_k_g + (size_t)l * 64, C.lane);
    bool conv_left = true;
#define CONV_ONE() do { if (conv_left) { const int t_ = q_next(C, ctl + 128, slot); if (t_ >= 768 * (1 + PROBE_CONV2)) conv_left = false; else { conv_ticket(C, l, t_ % 768); bl = -1; } } } while (0)
    for (;;) { const int u = q_next(C, ctl, slot); if (u >= 512 * (1 + PROBE_ATT2)) break; nsa_unit(C, l, u & 7, 63 - ((u & 511) >> 3), bl, cmp_ready, bnd_cmp, bnd_slc, bnd_swa); CONV_ONE(); }
    for (int n = 0;; ++n) { const int u = q_next(C, ctl + 64, slot); if (u >= 1536 * (1 + PROBE_ATT2)) break; dil_unit(C, u % 1536, C.lds, C.lds + KT_BYTES, bnd_dil); if ((n & 3) == 3) CONV_ONE(); }
    while (conv_left) CONV_ONE();
#undef CONV_ONE if (C.bid >= 96)
    __syncthreads();
}
#define MFMA_F32(a, b, c) __builtin_amdgcn_mfma_f32_16x16x4f32((a), (b), (c), 0, 0, 0)
DI void router_phase(const Ctx& C, int l) {
    const float* X = C.out; const float* MOD = WSP(float, WS_SMALL) + (size_t)l * 8 * 6144; unsigned char* H8 = WSP(unsigned char, R_XS);
    int* TOPE = WSP(int, WS_ROUTE); float* TOPG = (float*)(TOPE + NT * 4); unsigned* CNTB = WSP(unsigned, WS_CTL) + CW_CNT + l * 8192;
    LAS float* wl = (LAS float*)C.lds;
    LAS float* lg = (LAS float*)(C.lds + MISC_OFF + 8192) + C.wave * 512;
    LAS unsigned* hist = (LAS unsigned*)(C.lds + MISC_OFF + 6144);
    LAS float* rs = (LAS float*)(C.lds + MISC_OFF + 6400) + C.wave * 16;
    const int lane = C.lane, l15 = lane & 15, quad = lane >> 4, gw = C.bid * NWAVE + C.wave, NGW = C.G * NWAVE;
    const float* wr = C.w_router + (size_t)l * 1024 * 32; const float* g2 = C.norm2_g + (size_t)l * DM;
    __syncthreads();
    if (C.tid < 32) hist[C.tid] = 0u;
    for (int i = C.tid; i < 8192; i += NTHR) { const int k = i >> 3, e4 = (i & 7) * 4; const f32x4 v = *(const f32x4*)(wr + (size_t)k * 32 + e4); LAS float* d = wl + ((k >> 2) * 32 + e4) * 4 + (k & 3);
        d[0] = v[0]; d[4] = v[1]; d[8] = v[2]; d[12] = v[3]; }
    __syncthreads();
    for (int task = gw; task < NT / 16; task += NGW) {
        const int row0 = 16 * task, b = row0 / NS;
        const float* shb = MOD + (size_t)b * 6144 + 3072; const float* scb = shb + 1024;
        {
            f32x4 gg[4], sa[4], sb[4];
#pragma unroll
            for (int j = 0; j < 4; ++j) { const int k = 4 * lane + 256 * j; const f32x4 g = *(const f32x4*)(g2 + k), a = *(const f32x4*)(scb + k); gg[j] = g * (a + 1.f); sb[j] = *(const f32x4*)(shb + k); }
#pragma unroll 4
            for (int r = 0; r < 16; ++r) {
                const float* xr = X + (size_t)(row0 + r) * DM + 4 * lane; f32x4 v[4]; float ss = 0.f;
#pragma unroll
                for (int j = 0; j < 4; ++j) { v[j] = *(const f32x4*)(xr + 256 * j); ss += (v[j][0] * v[j][0] + v[j][1] * v[j][1]) + (v[j][2] * v[j][2] + v[j][3] * v[j][3]); }
                ss = group_sum<64>(ss); const float rstd = rsqrtf(ss * (1.f / DM) + 1e-6f);
                if (lane == 0) rs[r] = rstd;
                unsigned char* hp = H8 + (size_t)(row0 + r) * DM + 4 * lane;
#pragma unroll
                for (int j = 0; j < 4; ++j) { const f32x4 h = v[j] * rstd * gg[j] + sb[j]; *(unsigned*)(hp + 256 * j) = pk4_fp8(h[0], h[1], h[2], h[3]); }
            }
        }
        const float* xr = X + (size_t)(row0 + l15) * DM + 4 * quad; const float* sh = shb + 4 * quad; const float* sc = scb + 4 * quad;
        asm volatile("s_waitcnt lgkmcnt(0)" ::: "memory");
        const float rstd = rs[l15];
        f32x4 acc0 = (f32x4){0.f, 0.f, 0.f, 0.f}, acc1 = acc0;
#pragma unroll 2
        for (int i = 0; i < 64; ++i) {
            const f32x4 a = *(const f32x4*)(xr + 16 * i), g = *(const f32x4*)(g2 + 16 * i + 4 * quad), s1 = *(const f32x4*)(sc + 16 * i), s0 = *(const f32x4*)(sh + 16 * i);
            f32x4 h;
#pragma unroll
            for (int j = 0; j < 4; ++j) h[j] = a[j] * rstd * g[j] * (1.f + s1[j]) + s0[j];
            const LAS float* wp = wl + ((4 * i + quad) * 32 + l15) * 4; const f32x4 w0 = *(const LAS f32x4*)wp, w1 = *(const LAS f32x4*)(wp + 64);
#pragma unroll
            for (int j = 0; j < 4; ++j) { acc0 = MFMA_F32(h[j], w0[j], acc0); acc1 = MFMA_F32(h[j], w1[j], acc1); }
        }
        const float b0 = C.b_router[l * 32 + l15], b1 = C.b_router[l * 32 + 16 + l15];
#pragma unroll
        for (int j = 0; j < 4; ++j) { lg[(4 * quad + j) * 32 + l15] = acc0[j] + b0; lg[(4 * quad + j) * 32 + 16 + l15] = acc1[j] + b1; }
        asm volatile("s_waitcnt lgkmcnt(0)" ::: "memory");
        if (lane < 16) {
            float v[32];
#pragma unroll
            for (int i = 0; i < 8; ++i) { const f32x4 a = *(const LAS f32x4*)(lg + lane * 32 + 4 * i); v[4 * i] = a[0]; v[4 * i + 1] = a[1]; v[4 * i + 2] = a[2]; v[4 * i + 3] = a[3]; }
            float tv[4]; int ti[4];
#pragma unroll
            for (int r = 0; r < 4; ++r) { float bv = -3.0e38f; int bi = 0;
#pragma unroll
                for (int e = 0; e < 32; ++e) if (v[e] > bv) { bv = v[e]; bi = e; }
                tv[r] = bv; ti[r] = bi;
#pragma unroll
                for (int e = 0; e < 32; ++e) v[e] = (e == bi) ? -3.0e38f : v[e]; }
            const float e1 = __expf(tv[1] - tv[0]), e2 = __expf(tv[2] - tv[0]), e3 = __expf(tv[3] - tv[0]), inv = 1.f / (1.f + e1 + e2 + e3);
            const int row = row0 + lane;
            *(int4*)(TOPE + (size_t)row * 4) = make_int4(ti[0], ti[1], ti[2], ti[3]);
            *(f32x4*)(TOPG + (size_t)row * 4) = (f32x4){inv, e1 * inv, e2 * inv, e3 * inv};
#pragma unroll
            for (int r = 0; r < 4; ++r) __hip_atomic_fetch_add(&hist[ti[r]], 1u, __ATOMIC_RELAXED, __HIP_MEMORY_SCOPE_WORKGROUP);
        }
        asm volatile("s_waitcnt lgkmcnt(0)" ::: "memory");
    }
    __syncthreads();
    if (C.tid < 32) CNTB[C.bid * 32 + C.tid] = hist[C.tid];
}

DI void moe_tables(const Ctx& C, int l, LAS int* tab) {
    const unsigned* CNTB = WSP(unsigned, WS_CTL) + CW_CNT + l * 8192;
    LAS unsigned* part = (LAS unsigned*)(tab + 192);
    __syncthreads();
    { const int e = C.tid & 31, pt = C.tid >> 5; unsigned tot = 0u, mine = 0u;
        const int g0 = pt * ((C.G + 15) >> 4), g1 = min(C.G, g0 + ((C.G + 15) >> 4));
#pragma unroll 16
        for (int g = g0; g < g1; ++g) { const unsigned c = CNTB[g * 32 + e]; tot += c; mine += (g < C.bid) ? c : 0u; }
        part[(pt * 2) * 32 + e] = tot; part[(pt * 2 + 1) * 32 + e] = mine; }
    __syncthreads();
    if (C.tid < 32) { unsigned tot = 0u, mine = 0u;
#pragma unroll
        for (int pt = 0; pt < 16; ++pt) { tot += part[(pt * 2) * 32 + C.tid]; mine += part[(pt * 2 + 1) * 32 + C.tid]; }
        tab[128 + C.tid] = (int)((tot + 255u) >> 8); tab[64 + C.tid] = (int)mine; }
    __syncthreads();
    if (C.tid == 0) { int s = 0; for (int e = 0; e < 32; ++e) { tab[e] = s; s += tab[128 + e]; } tab[32] = s; }
    __syncthreads();
}
DI void scatter_phase(const Ctx& C, int l) {
    const int* TOPE = WSP(int, WS_ROUTE); int* POS = (int*)(TOPE + NT * 8); int* ROWMAP = (int*)(TOPE + NT * 12);
    LAS int* tab = (LAS int*)(C.lds + MISC_OFF + 64); LAS unsigned* cur = (LAS unsigned*)(C.lds + 16384);
    moe_tables(C, l, tab);
    if (C.tid < 32) cur[C.tid] = (unsigned)(tab[C.tid] * 256 + tab[64 + C.tid]);
    __syncthreads();
    const int lane = C.lane, gw = C.bid * NWAVE + C.wave, NGW = C.G * NWAVE;
    for (int task = gw; task < NT / 16; task += NGW) {
        const int row0 = 16 * task, tok = row0 + (lane >> 2);
        const int e = TOPE[(size_t)tok * 4 + (lane & 3)];
        const int slot = (int)__hip_atomic_fetch_add(&cur[e], 1u, __ATOMIC_RELAXED, __HIP_MEMORY_SCOPE_WORKGROUP);
        POS[(size_t)tok * 4 + (lane & 3)] = slot; ROWMAP[slot] = tok;
    }
}
DI void combine_phase(const Ctx& C, int l, float* dst) {
    const bf16* YB = WSP(bf16, R_YB); const int* TOPE = WSP(int, WS_ROUTE); const float* TOPG = (const float*)(TOPE + NT * 4); const int* POS = (const int*)(TOPE + NT * 8);
    const float* MOD = WSP(float, WS_SMALL) + (size_t)l * 8 * 6144; bf16* H = WSP(bf16, WS_H);
    const int lane = C.lane, gw = C.bid * NWAVE + C.wave, NGW = C.G * NWAVE;
    for (int task = gw; task < NT / 16; task += NGW) {
        const int row0 = 16 * task, b = row0 / NS; const float* gt = MOD + (size_t)b * 6144 + 5120 + 8 * lane;
        f32x4 g4[4], gg[4], sb[4];
#pragma unroll
        for (int j = 0; j < 2; ++j) { g4[2 * j] = *(const f32x4*)(gt + 512 * j); g4[2 * j + 1] = *(const f32x4*)(gt + 512 * j + 4); }
        if (l + 1 < NLAYER) { const float* M2 = MOD + 8 * 6144 + (size_t)b * 6144 + 8 * lane; const float* g = C.norm1_g + (size_t)(l + 1) * DM + 8 * lane;
#pragma unroll
            for (int j = 0; j < 2; ++j)
#pragma unroll
                for (int hlf = 0; hlf < 2; ++hlf) { const int o = 512 * j + 4 * hlf; gg[2 * j + hlf] = *(const f32x4*)(g + o) * (*(const f32x4*)(M2 + 1024 + o) + 1.f); sb[2 * j + hlf] = *(const f32x4*)(M2 + o); } }
#pragma unroll 2
        for (int r = 0; r < 16; ++r) {
            const int row = row0 + r; const int4 ps = *(const int4*)(POS + (size_t)row * 4); const f32x4 gk = *(const f32x4*)(TOPG + (size_t)row * 4);
            const int pp[4] = {ps.x, ps.y, ps.z, ps.w};
            const float* orow = C.out + (size_t)row * DM + 8 * lane; float* drow = dst + (size_t)row * DM + 8 * lane;
            u32x4 y[4][2]; f32x4 x[4];
#pragma unroll
            for (int q = 0; q < 4; ++q)
#pragma unroll
                for (int j = 0; j < 2; ++j) y[q][j] = *(const u32x4*)(YB + (size_t)pp[q] * DM + 8 * lane + 512 * j);
#pragma unroll
            for (int j = 0; j < 2; ++j) { x[2 * j] = *(const f32x4*)(orow + 512 * j); x[2 * j + 1] = *(const f32x4*)(orow + 512 * j + 4); }
            f32x4 v[4]; float s = 0.f;
#pragma unroll
            for (int j = 0; j < 2; ++j) { f32x4 a0 = (f32x4){0.f, 0.f, 0.f, 0.f}, a1 = a0;
#pragma unroll
                for (int q = 0; q < 4; ++q) { const u32x4 w = y[q][j]; a0 += (f32x4){bflo(w.x), bfhi(w.x), bflo(w.y), bfhi(w.y)} * gk[q]; a1 += (f32x4){bflo(w.z), bfhi(w.z), bflo(w.w), bfhi(w.w)} * gk[q]; }
                v[2 * j] = x[2 * j] + g4[2 * j] * a0; v[2 * j + 1] = x[2 * j + 1] + g4[2 * j + 1] * a1;
                *(f32x4*)(drow + 512 * j) = v[2 * j]; *(f32x4*)(drow + 512 * j + 4) = v[2 * j + 1]; }
#pragma unroll
            for (int i = 0; i < 4; ++i) s += (v[i][0] * v[i][0] + v[i][1] * v[i][1]) + (v[i][2] * v[i][2] + v[i][3] * v[i][3]);
            if (l + 1 < NLAYER) {
                s = group_sum<64>(s); const float rstd = rsqrtf(s * (1.f / DM) + 1e-6f); bf16* hrow = H + (size_t)row * DM + 8 * lane;
#pragma unroll
                for (int j = 0; j < 2; ++j) { const f32x4 h0 = v[2 * j] * rstd * gg[2 * j] + sb[2 * j], h1 = v[2 * j + 1] * rstd * gg[2 * j + 1] + sb[2 * j + 1]; u32x4 o;
                    if (INPROJ_FP8) { u32x2 o8; o8.x = pk4_fp8(h0[0], h0[1], h0[2], h0[3]); o8.y = pk4_fp8(h1[0], h1[1], h1[2], h1[3]); *(u32x2*)((unsigned char*)H + (size_t)row * DM + 8 * lane + 512 * j) = o8; }
                    else { o.x = pk2(h0[0], h0[1]); o.y = pk2(h0[2], h0[3]); o.z = pk2(h1[0], h1[1]); o.w = pk2(h1[2], h1[3]); *(u32x4*)(hrow + 512 * j) = o; } }
            }
        }
    }
}
constexpr int PH_PER_LAYER = 11, PH_BASE = 2, N_PHASES = PH_BASE + NLAYER * PH_PER_LAYER;
#ifndef MK_ONE_LAUNCH
#define MK_ONE_LAUNCH 1
#endif
__global__ void __launch_bounds__(NTHR, 2) mk_fwd(Args args) {
    extern __shared__ __attribute__((aligned(16))) unsigned char lds_raw[];
    Ctx C;
    C.lds = (LAS unsigned char*)lds_raw; C.tid = threadIdx.x; C.lane = C.tid & 63; C.wave = __builtin_amdgcn_readfirstlane(C.tid >> 6); C.G = gridDim.x; C.bid = blockIdx.x;
    C.x = (const float*)args.in[0]; C.c = (const float*)args.in[1]; C.pos = (const int*)args.in[2]; C.w_ada = (const float*)args.in[3]; C.b_ada = (const float*)args.in[4];
    C.norm1_g = (const float*)args.in[5]; C.norm2_g = (const float*)args.in[6]; C.w_in = (const float*)args.in[7]; C.w_out = (const float*)args.in[8]; C.mu = (const float*)args.in[9];
    C.w0 = (const float*)args.in[10]; C.w2 = (const float*)args.in[11]; C.a0 = (const float*)args.in[12]; C.a2 = (const float*)args.in[13]; C.g2 = (const float*)args.in[14];
    C.kkw = (const float*)args.in[15]; C.ka = (const float*)args.in[16]; C.rk = (const float*)args.in[17]; C.gn_w = (const float*)args.in[18]; C.gn_b = (const float*)args.in[19];
    C.conv_w = (const float*)args.in[20]; C.dil_q_g = (const float*)args.in[21]; C.dil_k_g = (const float*)args.in[22]; C.nsa_q_g = (const float*)args.in[23]; C.nsa_kc_g = (const float*)args.in[24];
    C.nsa_ks_g = (const float*)args.in[25]; C.nsa_kw_g = (const float*)args.in[26]; C.pe_k = (const float*)args.in[27]; C.pe_v = (const float*)args.in[28]; C.wk1 = (const float*)args.in[29];
    C.wk2 = (const float*)args.in[30]; C.wv1 = (const float*)args.in[31]; C.wv2 = (const float*)args.in[32]; C.onorm_g = (const float*)args.in[33]; C.w_router = (const float*)args.in[34];
    C.b_router = (const float*)args.in[35]; C.w_gu = (const float*)args.in[36]; C.b_gu = (const float*)args.in[37]; C.w_down = (const float*)args.in[38]; C.b_down = (const float*)args.in[39];
    C.out = args.out; C.ws = args.ws;
    const int lo = args.ph_lo, hi = args.ph_hi;
    for (int u = C.tid; u < (LDS_BYTES - MISC_OFF) / 4; u += NTHR) ((LAS unsigned*)(C.lds + MISC_OFF))[u] = 0u;
    __syncthreads();
    XcdBarrier bar; bar.bar = WSP(unsigned, WS_CTL) + CW_BAR; bar.x = 0; bar.st = nullptr;
    if (hi - lo > 1) bar = xcd_barrier_post(WSP(unsigned, WS_CTL) + CW_BAR, (volatile LAS unsigned*)(C.lds + MISC_OFF));
#ifndef PHMASK
#define PHMASK 0xFFFFFFFFu
#endif
#define PHON(n) (((PHMASK) >> (n)) & 1u)
#ifndef PHREP
#define PHREP 0u
#endif
#define NREP(n) (1 + (int)(((PHREP) >> (n)) & 1u))
#define WSPP(T, off) ((T*)(P.ws + (off)))
#define IN(k) (lo <= (k) && (k) < hi)
#define SEAM(k) do { if (IN(k) && IN((k) + 1)) xcd_barrier(bar); } while (0)
#define PCTX Ctx P = C; asm volatile("" : "+v"(P.tid), "+v"(P.lane)); asm volatile("" : "+s"(P.ws), "+s"(P.out), "+s"(P.wave), "+s"(P.bid))
    if (PHON(17) && IN(0)) for (int rep = 0; rep < NREP(17); ++rep) { PCTX; p0_prologue(P); __syncthreads(); }
    SEAM(0);
#ifndef PROBE_BARS
#define PROBE_BARS 0
#endif
    if (hi - lo > 1) for (int i = 0; i < PROBE_BARS; ++i) xcd_barrier(bar);
    if (PHON(18) && IN(1)) { PCTX; norm1_phase(P, 0, P.x); }
    SEAM(1);
    for (int l = 0; l < NLAYER; ++l) {
        const int pb = PH_BASE + PH_PER_LAYER * l;
        if (PHON(0) && IN(pb + 0)) for (int rep = 0; rep < NREP(0); ++rep) { PCTX;
            pg8::StaticOrder S; S.init(NT / 256, NPJ / 256, P.G, P.bid);
            if (INPROJ_FP8) { pg8::Gemm g{WSPP(bf16, WS_H), WSPP(bf16, WS_WIN) + (size_t)l * NPJ * 512, 512, 512, WSPP(int, WS_ROUTE) + NT * 12 + NR, 0x3FFFF}; EpiProj E{WSPP(bf16, R_PROJ), W8_INV}; pg8::gemm_phase<EpiProj, pg8::StaticOrder, true, true>(P.lds, P.tid, g, S, E); }
            else { pg8::Gemm g{WSPP(bf16, WS_H), WSPP(bf16, WS_WIN) + (size_t)l * NPJ * 1024, 1024, 1024}; EpiProj E{WSPP(bf16, R_PROJ), 1.f}; pg8::gemm_phase(P.lds, P.tid, g, S, E); }
        }
        SEAM(pb + 0);
        if (PHON(1) && IN(pb + 1)) for (int rep = 0; rep < NREP(1); ++rep) { PCTX; prep_phase(P, l); __syncthreads(); }
        SEAM(pb + 1);
        if (PHON(2) && IN(pb + 2)) for (int rep = 0; rep < NREP(2); ++rep) { PCTX;
            { pg8::Gemm g{WSPP(bf16, R_LIN), WSPP(bf16, WS_LORA) + (size_t)l * 768 * 256, 256, 256}; pg8::StaticOrder S; S.init(NT / 256, 3, P.G, P.bid);
              EpiLora E{WSPP(float, R_SC), WSPP(bf16, R_SCH), WSPP(bf16, R_G), P.w0 + l * 256, P.a0 + l * 256, P.ka + l * 256, (rep + 1 < NREP(2)) ? WSPP(bf16, WS_END) : WSPP(bf16, R_SCH), (rep + 1 < NREP(2)) ? WSPP(float, WS_END) + 64 * MiB : WSPP(float, R_SC)}; pg8::gemm_phase(P.lds, P.tid, g, S, E); }
        }
        SEAM(pb + 2);
        if (PHON(3) && IN(pb + 3)) for (int rep = 0; rep < NREP(3); ++rep) { PCTX; mix_phase(P, l, rep); }
        SEAM(pb + 3);
        if (PHON(4) && IN(pb + 4)) for (int rep = 0; rep < NREP(4); ++rep) { PCTX; fin_phase(P, l); __syncthreads(); }
        SEAM(pb + 4);
        if (PHON(5) && IN(pb + 5)) for (int rep = 0; rep < NREP(5); ++rep) { PCTX;
            pg8::Gemm g{WSPP(bf16, R_YCAT), WSPP(bf16, WS_WOUT) + (size_t)l * 1024 * 1024, 1024, 1024}; pg8::StaticOrder S; S.init(NT / 256, 4, P.G, P.bid);
            EpiOut E{(rep + 1 < NREP(5)) ? WSPP(float, WS_END) : P.out, l == 0 ? P.x : (const float*)P.out, WSPP(float, WS_SMALL) + (size_t)l * 8 * 6144 + 2048}; pg8::gemm_phase(P.lds, P.tid, g, S, E);
        }
        SEAM(pb + 5);
        if (PHON(6) && IN(pb + 6)) for (int rep = 0; rep < NREP(6); ++rep) { PCTX; router_phase(P, l); __syncthreads(); }
        SEAM(pb + 6);
        if (PHON(7) && IN(pb + 7)) for (int rep = 0; rep < NREP(7); ++rep) { PCTX; scatter_phase(P, l); __syncthreads(); }
        SEAM(pb + 7);
        if (PHON(8) && IN(pb + 8)) for (int rep = 0; rep < NREP(8); ++rep) { PCTX;
            LAS int* tab = (LAS int*)(P.lds + MISC_OFF + 64); moe_tables(P, l, tab);
            pg8::Gemm g{WSPP(bf16, R_XS), WSPP(bf16, WS_WGU) + (size_t)l * 32 * 2048 * 512, 512, 512, WSPP(int, WS_ROUTE) + NT * 12, 32767};
            pg8::GroupedOrder S; S.init(tab[32], 8, P.G, P.bid); S.tstart = tab; S.nrow_e = 2048;
            EpiGU8 E{WSPP(unsigned char, R_ACT), P.b_gu + (size_t)l * 32 * 2048}; pg8::gemm_phase<EpiGU8, pg8::GroupedOrder, true, true>(P.lds, P.tid, g, S, E);
        }
        SEAM(pb + 8);
        if (PHON(9) && IN(pb + 9)) for (int rep = 0; rep < NREP(9); ++rep) { PCTX;
            LAS int* tab = (LAS int*)(P.lds + MISC_OFF + 64); moe_tables(P, l, tab);
            pg8::Gemm g{WSPP(bf16, R_ACT), WSPP(bf16, WS_WDN) + (size_t)l * 32 * 1024 * 512, 512, 512, WSPP(int, WS_ROUTE) + NT * 12 + NR, 0x3FFFF}; pg8::GroupedOrder S; S.init(tab[32], 4, P.G, P.bid); S.tstart = tab; S.nrow_e = 1024;
            EpiDN8 E{WSPP(bf16, R_YB), P.b_down + (size_t)l * 32 * 1024}; pg8::gemm_phase<EpiDN8, pg8::GroupedOrder, true, true>(P.lds, P.tid, g, S, E);
        }
        SEAM(pb + 9);
        if (PHON(10) && IN(pb + 10)) for (int rep = 0; rep < NREP(10); ++rep) { PCTX; combine_phase(P, l, (rep + 1 < NREP(10)) ? WSPP(float, WS_END) : P.out); __syncthreads(); }
        SEAM(pb + 10);
    }
#undef IN
#undef SEAM
}

extern "C" void kernel_launch(void* const* d_in, const int* in_sizes, int n_in, void* d_out, int out_size, void* d_ws, size_t ws_size, hipStream_t stream) {
    static int grid = 0;
    if (grid == 0) {
        if (n_in != 40 || out_size != NT * DM || ws_size < WS_END + 256 * MiB) { fprintf(stderr, "kernel_launch: unexpected problem (n_in %d, out %d, ws %zu < %zu)\n", n_in, out_size, ws_size, (size_t)WS_END); grid = -1; return; }
        int dev = 0, cus = 0, per_cu = 0;
        if (hipGetDevice(&dev) != hipSuccess || hipDeviceGetAttribute(&cus, hipDeviceAttributeMultiprocessorCount, dev) != hipSuccess) { grid = -1; return; }
        if (hipFuncSetAttribute((const void*)mk_fwd, hipFuncAttributeMaxDynamicSharedMemorySize, LDS_BYTES) != hipSuccess) { fprintf(stderr, "kernel_launch: hipFuncSetAttribute failed\n"); grid = -1; return; }
        if (hipOccupancyMaxActiveBlocksPerMultiprocessor(&per_cu, (const void*)mk_fwd, NTHR, LDS_BYTES) != hipSuccess || per_cu < 1) fprintf(stderr, "kernel_launch: occupancy query says %d blocks per CU\n", per_cu);
        (void)hipGetLastError();
        grid = cus > 256 ? 256 : cus;
    }
    if (grid < 0) return;
    (void)hipMemsetAsync((char*)d_ws, 0, ZERO_BYTES, stream);
    Args a{};
    for (int i = 0; i < 40; ++i) a.in[i] = d_in[i];
    a.out = (float*)d_out; a.ws = (unsigned char*)d_ws;
#if MK_ONE_LAUNCH
    a.ph_lo = 0; a.ph_hi = N_PHASES;
    hipLaunchKernelGGL(mk_fwd, dim3(grid), dim3(NTHR), LDS_BYTES, stream, a);
#else
    for (int p = 0; p < N_PHASES; ++p) { a.ph_lo = p; a.ph_hi = p + 1; hipLaunchKernelGGL(mk_fwd, dim3(grid), dim3(NTHR), LDS_BYTES, stream, a); }
#endif
    const hipError_t le = hipPeekAtLastError();
    if (le != hipSuccess) fprintf(stderr, "kernel_launch: launch failed: %s\n", hipGetErrorName(le));
}
```

```cpp
#include <hip/hip_runtime.h>
#include <cstdio>
#include <cstdint>

#define DI __device__ __forceinline__
#define LAS __attribute__((address_space(3)))
#define GAS __attribute__((address_space(1)))
typedef unsigned short bf16;
typedef short bf16x8 __attribute__((ext_vector_type(8)));
typedef float f32x4 __attribute__((ext_vector_type(4)));
typedef float f32x2 __attribute__((ext_vector_type(2)));
typedef unsigned u32x4 __attribute__((ext_vector_type(4)));
typedef unsigned u32x2 __attribute__((ext_vector_type(2)));
typedef unsigned char uchar;

#ifndef PROBE_SCAN2
#define PROBE_SCAN2 0
#endif
#ifndef PROBE_ATT2
#define PROBE_ATT2 0
#endif
#ifndef PROBE_CONV2
#define PROBE_CONV2 0
#endif
#ifndef INPROJ_FP8
#define INPROJ_FP8 0
#endif
constexpr int NB = 8, NS = 4096, NT = NB * NS, DM = 1024, NPJ = 3328, NE = 32, FF = 1024, NLAYER = 2;
constexpr int PJ_A = 0, PJ_B = 1024, PJ_C = 1792, PJ_D = 2560;
constexpr int NR = NT * 4 + NE * 256;
constexpr int NTHR = 512, NWAVE = 8;

DI float bf2f(unsigned v) { return __builtin_bit_cast(float, v << 16); }
DI unsigned f2bf(float f) { unsigned u = __builtin_bit_cast(unsigned, f); return (u + 0x7fffu + ((u >> 16) & 1u)) >> 16; }
DI unsigned pk2(float lo, float hi) { return f2bf(lo) | (f2bf(hi) << 16); }
DI float bflo(unsigned w) { return __builtin_bit_cast(float, w << 16); }
DI float bfhi(unsigned w) { return __builtin_bit_cast(float, w & 0xffff0000u); }
DI float fexp2(float x) { return __builtin_amdgcn_exp2f(x); }
DI float fsigmoid(float x) { return __builtin_amdgcn_rcpf(1.f + __builtin_amdgcn_exp2f(-1.44269504089f * x)); }
DI float wsum_xor(float v, int o) { return v + __shfl_xor(v, o); }
template <int CTRL> DI float dppmov(float x) { return __builtin_bit_cast(float, __builtin_amdgcn_update_dpp(0, __builtin_bit_cast(int, x), CTRL, 0xF, 0xF, true)); }
template <int W> DI float group_sum(float v) {
    if (W >= 2) v += dppmov<0xB1>(v);
    if (W >= 4) v += dppmov<0x4E>(v);
    if (W >= 8) v += dppmov<0x141>(v);
    if (W >= 16) v += dppmov<0x140>(v);
    if (W >= 32) v += __shfl_xor(v, 16);
    if (W >= 64) v += __shfl_xor(v, 32);
    return v;
}
DI float sum8(float x) { x += dppmov<0xB1>(x); x += dppmov<0x4E>(x); x += dppmov<0x141>(x); return x; }

#define XB_TMO      128
#define XB_XCNT(j)  (256  + 64 * (j))
#define XB_XSUB(j)  (1280 + 64 * (j))
#define XB_XGEN(j)  (2304 + 64 * (j))
#define XB_TOP      3328
#define XB_TOPGEN   3392
#define XCD_BAR_WORDS 3456
#define XB_SPIN_CAP (1u << 18)
DI unsigned xb_ld(unsigned* p)              { return __hip_atomic_load(p, __ATOMIC_RELAXED, __HIP_MEMORY_SCOPE_AGENT); }
DI unsigned xb_add(unsigned* p, unsigned v) { return __hip_atomic_fetch_add(p, v, __ATOMIC_RELAXED, __HIP_MEMORY_SCOPE_AGENT); }
DI unsigned xb_xcc_id() { return (unsigned)__builtin_amdgcn_s_getreg((3 << 11) | 20) & 0xFu; }
#define XB_SPIN(cond, bar) do { unsigned _sp = 0; while (cond) { __builtin_amdgcn_s_sleep(1); \
    if ((++_sp & 255u) == 0u) { if (xb_ld(&(bar)[XB_TMO])) break; if (_sp > XB_SPIN_CAP) { atomicAdd(&(bar)[XB_TMO], 1u); break; } } } } while (0)
struct XcdBarrier { unsigned* bar; unsigned x; volatile LAS unsigned* st; };
DI XcdBarrier xcd_barrier_post(unsigned* bar, volatile LAS unsigned* st) {
    XcdBarrier b; b.bar = bar; b.x = xb_xcc_id(); b.st = st;
    if (threadIdx.x == 0) (void)xb_add(&bar[XB_XCNT(b.x)], 1u);
    return b;
}
DI void xcd_barrier_complete(unsigned* bar, unsigned x, unsigned& nloc, unsigned& nx) {
    const unsigned G = gridDim.x * gridDim.y * gridDim.z;
    unsigned sum, cnt, mine, sp = 0u;
    for (;;) {
        sum = 0u; cnt = 0u; mine = 0u;
#pragma unroll
        for (unsigned j = 0; j < 16; ++j) { const unsigned c = xb_ld(&bar[XB_XCNT(j)]); sum += c; cnt += (c > 0u) ? 1u : 0u; mine = (j == x) ? c : mine; }
        if (sum == G) break;
        __builtin_amdgcn_s_sleep(1);
        if ((++sp & 255u) == 0u) { if (xb_ld(&bar[XB_TMO])) break; if (sp > XB_SPIN_CAP) { atomicAdd(&bar[XB_TMO], 1u); break; } }
    }
    nloc = mine > 0u ? mine : 1u; nx = cnt > 0u ? cnt : 1u;
}
DI void xcd_barrier(const XcdBarrier& b) {
    asm volatile("s_waitcnt vmcnt(0)" ::: "memory");
    __syncthreads();
    if (threadIdx.x == 0) {
        unsigned* bar = b.bar;
        __builtin_amdgcn_s_waitcnt(0);
        unsigned nloc = b.st[0], nx = b.st[1];
        if (nloc == 0u) { xcd_barrier_complete(bar, b.x, nloc, nx); b.st[0] = nloc; b.st[1] = nx; }
        const unsigned old = xb_add(&bar[XB_XSUB(b.x)], 1u);
        const unsigned gen = old / nloc;
        if (old + 1u == (gen + 1u) * nloc) {
            __builtin_amdgcn_fence(__ATOMIC_RELEASE, "agent");
            asm volatile("s_waitcnt vmcnt(0)" ::: "memory");
            const unsigned og = xb_add(&bar[XB_TOP], 1u);
            const unsigned tg = og / nx;
            if (og + 1u == (tg + 1u) * nx) xb_add(&bar[XB_TOPGEN], 1u);
            else XB_SPIN(xb_ld(&bar[XB_TOPGEN]) == tg, bar);
            __builtin_amdgcn_fence(__ATOMIC_ACQUIRE, "agent");
            xb_add(&bar[XB_XGEN(b.x)], 1u);
            asm volatile("s_waitcnt vmcnt(0)" ::: "memory");
        } else {
            XB_SPIN(xb_ld(&bar[XB_XGEN(b.x)]) == gen, bar);
            __builtin_amdgcn_fence(__ATOMIC_ACQUIRE, "agent");
            asm volatile("s_waitcnt vmcnt(0)" ::: "memory");
        }
    }
    __syncthreads();
}
namespace pg8 {
constexpr int BM = 256, BK = 64, HALF = 128, HTB = HALF * BK * 2, STAGE_BYTES = 8 * HTB, NXCD = 8, WGM = 8;
__host__ __device__ __forceinline__ int lds_byte(int r, int c) { const int st = (r >> 4) * 2 + (c >> 5), rr = r & 15, cc = c & 31, ob = rr * 64 + cc * 2; return st * 1024 + (ob ^ (((ob >> 9) & 1) << 5)); }
__host__ __device__ __forceinline__ void stage_rc(int b, int& R, int& C) { const int st = b / 1024, sb = b % 1024, swz = sb ^ (((sb >> 9) & 1) << 5); R = (st >> 1) * 16 + swz / 64; C = (st & 1) * 32 + (swz % 64) / 2; }
__host__ __device__ __forceinline__ int perm32(int rho) { const int n = rho >> 4, i = rho & 15; return 8 * (i >> 2) + 4 * n + (i & 3); }

struct Unit { int pm, pn, brow, e; };
struct Gemm { const bf16* A; const bf16* Bt; int lda, K; const int* rowmap; int rowmask; };

struct StaticOrder {
    int nM, nN, nwg, G, c;
    __device__ void init(int nM_, int nN_, int G_, int c_) { nM = nM_; nN = nN_; nwg = nM * nN; G = G_; c = c_; }
    __device__ bool tile(int i, int& pm, int& pn) const {
        const long L = (long)i * G + c; if (L >= nwg) return false;
        int wgid = (int)L; { const int q = nwg / NXCD, r = nwg % NXCD, xcd = wgid % NXCD, off = wgid / NXCD; wgid = (xcd < r ? xcd * (q + 1) : r * (q + 1) + (xcd - r) * q) + off; }
        const int nig = WGM * nN, gid = wgid / nig, fm = gid * WGM, gsz = (nM - fm) < WGM ? (nM - fm) : WGM;
        pm = fm + ((wgid % nig) % gsz); pn = (wgid % nig) / gsz; return true;
    }
    __device__ bool next(int i, Unit& u) const { if (!tile(i, u.pm, u.pn)) return false; u.brow = u.pn * BM; u.e = 0; return true; }
};
struct GroupedOrder : StaticOrder {
    const LAS int* tstart; int nrow_e;
    __device__ bool next(int i, Unit& u) const {
        if (!tile(i, u.pm, u.pn)) return false;
        int e = 0;
#pragma unroll 1
        for (int j = 16; j > 0; j >>= 1) if (tstart[e + j] <= u.pm) e += j;
        u.e = e; u.brow = e * nrow_e + u.pn * BM; return true;
    }
};
DI unsigned cvt_pk_bf16(float lo, float hi) { unsigned r; asm volatile("v_cvt_pk_bf16_f32 %0, %1, %2" : "=v"(r) : "v"(lo), "v"(hi)); return r; }

template <class Epi, class Sched, bool GATHER = false, bool FP8 = false>
DI void gemm_phase(LAS unsigned char* lds, const int tid, const Gemm g, const Sched& S, const Epi& E) {
    const int wid = __builtin_amdgcn_readfirstlane(tid >> 6), lane = tid & 63, wr = wid >> 2, wc = wid & 3, fr = lane & 15, fq = lane >> 4;
    int K = g.K, lda = g.lda; asm volatile("" : "+s"(K), "+s"(lda));
    const int nt = K / BK;
    unsigned voffA[2], voffB[2]; int Ra[2], Ca[2];
#pragma unroll
    for (int i = 0; i < 2; ++i) { int R, C; stage_rc(tid * 16 + i * 8192, R, C); const int Rb = Epi::PERM ? ((R & ~31) + perm32(R & 31)) : R; Ra[i] = R; Ca[i] = C;
        voffA[i] = (unsigned)(R * lda + C) * 2u; voffB[i] = (unsigned)(Rb * K + C) * 2u; }
    unsigned vgc[2][2]; int rawn[2][2];
#define PG8_GLOAD(dst, pm_) do { _Pragma("unroll") for (int _h = 0; _h < 2; ++_h) _Pragma("unroll") for (int _i = 0; _i < 2; ++_i) { const int* _p = g.rowmap + (size_t)(pm_) * BM + _h * HALF + Ra[_i]; \
        asm volatile("global_load_dword %0, %1, off" : "=v"(dst[_h][_i]) : "v"(_p) : "memory"); } } while (0)
#define PG8_GCONV(vg, raw) do { _Pragma("unroll") for (int _h = 0; _h < 2; ++_h) _Pragma("unroll") for (int _i = 0; _i < 2; ++_i) { int _r = raw[_h][_i]; asm volatile("" : "+v"(_r)); \
        vg[_h][_i] = (unsigned)((_r & g.rowmask) * lda + Ca[_i]) * 2u; } } while (0)
#define PG8_STAGE_A(bufoff, kptr, h, vg) do { if (GATHER) PG8_STAGE(bufoff, kptr, vg[h]); else PG8_STAGE(bufoff, (kptr) + (h) * hstepA, voffA); } while (0)
    const size_t kstep = (size_t)(BK * 2);
    const size_t hstepA = (size_t)HALF * lda * 2, hstepB = (size_t)HALF * K * 2;
    const size_t tstepA = 2 * hstepA;
    const unsigned ldsw = (unsigned)wid * 1024u;
    const int aoff = lds_byte(wr * 64 + fr, fq * 8), boff = lds_byte(wc * 32 + fr, fq * 8);
#define PG8_SA(b, h) (((b) * 2 + (h)) * HTB)
#define PG8_SB(b, h) ((4 + (b) * 2 + (h)) * HTB)
#define PG8_STAGE(bufoff, gbase, voff) do { _Pragma("unroll") for (int _i = 0; _i < 2; ++_i) \
        __builtin_amdgcn_global_load_lds((const unsigned*)((const char*)(gbase) + (voff)[_i]), (LAS unsigned*)(lds + (bufoff) + ldsw + _i * 8192), 16, 0, 0); } while (0)
#define PG8_LDA(dst, b, h) do { _Pragma("unroll") for (int m = 0; m < 4; ++m) { const v4i_ lo_ = *(const LAS v4i_*)(lds + PG8_SA(b, h) + aoff + m * 2048), hi_ = *(const LAS v4i_*)(lds + PG8_SA(b, h) + aoff + m * 2048 + 1024); \
        dst[m] = __builtin_shufflevector(lo_, hi_, 0, 1, 2, 3, 4, 5, 6, 7); } } while (0)
#define PG8_LDB(dst, b, h) do { _Pragma("unroll") for (int n = 0; n < 2; ++n) { const v4i_ lo_ = *(const LAS v4i_*)(lds + PG8_SB(b, h) + boff + n * 2048), hi_ = *(const LAS v4i_*)(lds + PG8_SB(b, h) + boff + n * 2048 + 1024); \
        dst[n] = __builtin_shufflevector(lo_, hi_, 0, 1, 2, 3, 4, 5, 6, 7); } } while (0)
#define PG8_MMA(ai, bj, At, Bt) do { __builtin_amdgcn_s_setprio(1); _Pragma("unroll") for (int m = 0; m < 4; ++m) _Pragma("unroll") for (int n = 0; n < 2; ++n) { \
        if (FP8) acc[ai][bj][m][n] = __builtin_amdgcn_mfma_scale_f32_16x16x128_f8f6f4(Bt[n], At[m], acc[ai][bj][m][n], 0, 0, 0, 0x7F7F7F7F, 0, 0x7F7F7F7F); \
        else { const v8i_ b_ = Bt[n], a_ = At[m]; \
            acc[ai][bj][m][n] = __builtin_amdgcn_mfma_f32_16x16x32_bf16(__builtin_bit_cast(bf16x8, __builtin_shufflevector(b_, b_, 0, 1, 2, 3)), __builtin_bit_cast(bf16x8, __builtin_shufflevector(a_, a_, 0, 1, 2, 3)), acc[ai][bj][m][n], 0, 0, 0); \
            acc[ai][bj][m][n] = __builtin_amdgcn_mfma_f32_16x16x32_bf16(__builtin_bit_cast(bf16x8, __builtin_shufflevector(b_, b_, 4, 5, 6, 7)), __builtin_bit_cast(bf16x8, __builtin_shufflevector(a_, a_, 4, 5, 6, 7)), acc[ai][bj][m][n], 0, 0, 0); } } \
        __builtin_amdgcn_s_setprio(0); } while (0)
#define PG8_WAIT_V(n) asm volatile("s_waitcnt vmcnt(" #n ")" ::: "memory")
#define PG8_WAIT_L(n) asm volatile("s_waitcnt lgkmcnt(" #n ")" ::: "memory")
#define PG8_BAR __builtin_amdgcn_s_barrier()
#define PG8_SCHED __builtin_amdgcn_sched_barrier(0)
    Unit cur, nxt; int ui = 0;
    if (!S.next(0, cur)) return;
    f32x4 acc[2][2][4][2];
#pragma unroll
    for (int a = 0; a < 2; ++a)
#pragma unroll
        for (int b = 0; b < 2; ++b)
#pragma unroll
            for (int m = 0; m < 4; ++m)
#pragma unroll
                for (int n = 0; n < 2; ++n) acc[a][b][m][n] = (f32x4){0.f, 0.f, 0.f, 0.f};
    typedef int v8i_ __attribute__((ext_vector_type(8))); typedef int v4i_ __attribute__((ext_vector_type(4)));
    v8i_ At[4], B0[2], B1[2];
    const char* cA = (const char*)g.A + (GATHER ? (size_t)0 : (size_t)cur.pm * tstepA); const char* cB = (const char*)g.Bt + (size_t)cur.brow * K * 2;
    if (GATHER) { PG8_GLOAD(rawn, cur.pm); asm volatile("s_waitcnt vmcnt(0)" : "+v"(rawn[0][0]), "+v"(rawn[0][1]), "+v"(rawn[1][0]), "+v"(rawn[1][1]) :: "memory"); PG8_GCONV(vgc, rawn); }
    PG8_STAGE(PG8_SB(0, 0), cB, voffB); PG8_STAGE(PG8_SB(0, 1), cB + hstepB, voffB); PG8_STAGE_A(PG8_SA(0, 0), cA, 0, vgc); PG8_STAGE_A(PG8_SA(0, 1), cA, 1, vgc);
    if (wr == 1) PG8_BAR;
    PG8_WAIT_V(2); PG8_BAR;
    PG8_STAGE(PG8_SB(1, 0), cB + kstep, voffB); PG8_STAGE_A(PG8_SA(1, 0), cA + kstep, 0, vgc); PG8_STAGE(PG8_SB(1, 1), cB + hstepB + kstep, voffB);
    PG8_WAIT_V(6); PG8_BAR;
    for (;;) {
        const bool has_next = S.next(ui + 1, nxt);
        const char* nA = (has_next && !GATHER) ? (const char*)g.A + (size_t)nxt.pm * tstepA : cA;
        if (GATHER && has_next) PG8_GLOAD(rawn, nxt.pm); const char* nB = has_next ? (const char*)g.Bt + (size_t)nxt.brow * K * 2 : cB;
#pragma unroll 1
        for (int t = 0; t < nt; t += 2) {
            const bool last = (t == nt - 2);
            const char* a1 = cA + (size_t)(t + 1) * kstep;
            const char* a2 = last ? nA : cA + (size_t)(t + 2) * kstep; const char* b2 = last ? nB : cB + (size_t)(t + 2) * kstep;
            const char* a3 = a2 + kstep; const char* b3 = b2 + kstep;
            PG8_LDB(B0, 0, 0); PG8_LDB(B1, 0, 1); PG8_SCHED; PG8_LDA(At, 0, 0); PG8_STAGE_A(PG8_SA(1, 1), a1, 1, vgc);
            if (GATHER) { if (last && has_next) PG8_GCONV(vgc, rawn); }
            PG8_WAIT_V(8); PG8_WAIT_L(0); PG8_BAR; PG8_MMA(0, 0, At, B0); PG8_MMA(0, 1, At, B1); PG8_BAR; PG8_SCHED;
            PG8_LDA(At, 0, 1); PG8_STAGE(PG8_SB(0, 0), b2, voffB); PG8_STAGE(PG8_SB(0, 1), b2 + hstepB, voffB); PG8_STAGE_A(PG8_SA(0, 0), a2, 0, vgc);
            PG8_WAIT_V(8); PG8_WAIT_L(0); PG8_BAR; PG8_MMA(1, 0, At, B0); PG8_MMA(1, 1, At, B1); PG8_BAR; PG8_SCHED;
            PG8_LDB(B0, 1, 0); PG8_LDB(B1, 1, 1); PG8_SCHED; PG8_LDA(At, 1, 0); PG8_STAGE_A(PG8_SA(0, 1), a2, 1, vgc);
            PG8_WAIT_V(8); PG8_WAIT_L(0); PG8_BAR; PG8_MMA(0, 0, At, B0); PG8_MMA(0, 1, At, B1); PG8_BAR; PG8_SCHED;
            PG8_LDA(At, 1, 1); PG8_STAGE(PG8_SB(1, 0), b3, voffB); PG8_STAGE(PG8_SB(1, 1), b3 + hstepB, voffB); PG8_STAGE_A(PG8_SA(1, 0), a3, 0, vgc);
            PG8_WAIT_V(8); PG8_WAIT_L(0); PG8_BAR; PG8_MMA(1, 0, At, B0); PG8_MMA(1, 1, At, B1); PG8_BAR; PG8_SCHED;
        }
        if (wr == 0) PG8_BAR;
        { int fr2 = fr, fq2 = fq; asm volatile("" : "+v"(fr2), "+v"(fq2)); E(acc, cur, wr, wc, fr2, fq2); }
        if (!has_next) break;
#pragma unroll
        for (int a = 0; a < 2; ++a)
#pragma unroll
            for (int b = 0; b < 2; ++b)
#pragma unroll
                for (int m = 0; m < 4; ++m)
#pragma unroll
                    for (int n = 0; n < 2; ++n) acc[a][b][m][n] = (f32x4){0.f, 0.f, 0.f, 0.f};
        cur = nxt; cA = nA; cB = nB; ++ui;
        if (wr == 1) PG8_BAR;
    }
    PG8_WAIT_V(0);
    PG8_BAR;
#undef PG8_SA
#undef PG8_SB
#undef PG8_STAGE
#undef PG8_STAGE_A
#undef PG8_GLOAD
#undef PG8_GCONV
#undef PG8_LDA
#undef PG8_LDB
#undef PG8_MMA
#undef PG8_WAIT_V
#undef PG8_WAIT_L
#undef PG8_BAR
#undef PG8_SCHED
}
}
constexpr size_t MiB = 1u << 20;
constexpr size_t WS_CTL = 0;
constexpr size_t WS_LORA = 1 * MiB;
constexpr size_t WS_WK2 = 2 * MiB;
constexpr size_t ZERO_BYTES = 3 * MiB;
constexpr size_t WS_WIN = 3 * MiB;
constexpr size_t WS_WOUT = 17 * MiB;
constexpr size_t WS_WK1 = 21 * MiB;
constexpr size_t WS_SMALL = 25 * MiB;
constexpr size_t WS_ROUTE = 27 * MiB;
constexpr size_t WS_WGU = 32 * MiB;
constexpr size_t WS_WDN = 288 * MiB;
constexpr size_t WS_H = 416 * MiB;
constexpr size_t WS_R = 480 * MiB;
constexpr size_t R_PROJ = WS_R;
constexpr size_t R_SC = R_PROJ + 208 * MiB;
constexpr size_t R_SCH = R_SC + 32 * MiB;
constexpr size_t R_LIN = R_SC + 192 * MiB;
constexpr size_t R_G = R_LIN + 16 * MiB;
constexpr size_t R_YA = R_G + 32 * MiB;
constexpr size_t R_YCAT = R_YA + 32 * MiB;
constexpr size_t R_QC = R_YCAT + 64 * MiB;
constexpr size_t R_KC = R_QC + 16 * MiB;
constexpr size_t R_OC = R_KC + 16 * MiB;
constexpr size_t R_LSE = R_OC + 96 * MiB;
constexpr size_t R_QN = R_LSE + 2 * MiB;
constexpr size_t R_QR = R_QN + 16 * MiB;
constexpr size_t R_KCR = R_QR + 16 * MiB;
constexpr size_t R_VCR = R_KCR + 5 * MiB;
constexpr size_t R_KS = R_VCR + 5 * MiB;
constexpr size_t R_KW = R_KS + 4 * MiB;
constexpr size_t R_GATE = R_KW + 4 * MiB;
constexpr size_t R_CH1 = R_GATE + 2 * MiB;
constexpr size_t R_CMP = R_CH1 + 2 * MiB;
constexpr size_t R_OCMP = R_CMP + 1 * MiB;
constexpr size_t R_OSLC = R_OCMP + 32 * MiB;
constexpr size_t R_OSWA = R_OSLC + 32 * MiB;
constexpr size_t R_SCANU = R_OSWA;
constexpr size_t R_SCANS = R_OSWA + 16 * MiB;
constexpr size_t R_IMP = R_OSWA + 32 * MiB;
constexpr size_t R_SELM = R_IMP + 8 * MiB;
constexpr size_t R_MIX_END = R_SELM + 1 * MiB;
constexpr size_t R_XS = WS_R;
constexpr size_t R_ACT = R_XS + 272 * MiB;
constexpr size_t R_YB = R_ACT + 272 * MiB;
constexpr size_t R_MOE_END = R_YB + 272 * MiB;
constexpr size_t WS_END = (R_MIX_END > R_MOE_END ? R_MIX_END : R_MOE_END);
static_assert((size_t)NR * 1024 * 2 <= 272 * MiB, "sorted buffers");
constexpr int CW_BAR = 4096;
constexpr int CW_CNT = 16384;
constexpr int CW_CUR = 16384 + 64;

constexpr int RING_BYTES = 131072;
constexpr int MISC_OFF = RING_BYTES;
constexpr int LDS_BYTES = 155648;

struct Args { const void* in[40]; float* out; unsigned char* ws; int ph_lo, ph_hi; };

struct Ctx {
    LAS unsigned char* lds; int tid, lane, wave, G, bid;
    const float *x, *c, *w_ada, *b_ada, *norm1_g, *norm2_g, *w_in, *w_out, *mu, *w0, *w2, *a0, *a2, *g2, *kkw, *ka, *rk, *gn_w, *gn_b, *conv_w, *dil_q_g, *dil_k_g,
        *nsa_q_g, *nsa_kc_g, *nsa_ks_g, *nsa_kw_g, *pe_k, *pe_v, *wk1, *wk2, *wv1, *wv2, *onorm_g, *w_router, *b_router, *w_gu, *b_gu, *w_down, *b_down;
    const int* pos;
    float* out; unsigned char* ws;
};
#define WSP(T, off) ((T*)(C.ws + (off)))

typedef f32x4 Acc[2][2][4][2];
struct EpiProj {
    static constexpr bool PERM = true; bf16* O; float scale;
    DI void operator()(const Acc& acc, const pg8::Unit& u, int wr, int wc, int fr, int fq) const {
        const int row0 = u.pm * 256 + wr * 64 + fr, col0 = u.pn * 256 + wc * 32 + 8 * fq;
#pragma unroll
        for (int ai = 0; ai < 2; ++ai)
#pragma unroll
            for (int m = 0; m < 4; ++m) { bf16* rowp = O + (size_t)(row0 + ai * 128 + m * 16) * NPJ + col0;
#pragma unroll
                for (int bj = 0; bj < 2; ++bj) { const f32x4 v0 = acc[ai][bj][m][0] * scale, v1 = acc[ai][bj][m][1] * scale; u32x4 w;
                    w.x = pg8::cvt_pk_bf16(v0[0], v0[1]); w.y = pg8::cvt_pk_bf16(v0[2], v0[3]); w.z = pg8::cvt_pk_bf16(v1[0], v1[1]); w.w = pg8::cvt_pk_bf16(v1[2], v1[3]);
                    *(u32x4*)(rowp + bj * 128) = w; } }
    }
};
struct EpiLora {
    static constexpr bool PERM = false; float* Wp; bf16* SCH; bf16* Gb; const float *w0, *a0, *ka; bf16* SCo; float* Wo;
    DI void operator()(const Acc& acc, const pg8::Unit& u, int wr, int wc, int fr, int fq) const {
        const int row0 = u.pm * 256 + wr * 64 + fr, col0 = wc * 32 + 4 * fq;
        if (u.pn == 0) {
#pragma unroll
            for (int bj = 0; bj < 2; ++bj)
#pragma unroll
                for (int n = 0; n < 2; ++n) { const int ch = col0 + bj * 128 + n * 16; const f32x4 b = *(const f32x4*)(w0 + ch);
#pragma unroll
                    for (int ai = 0; ai < 2; ++ai)
#pragma unroll
                        for (int m = 0; m < 4; ++m) { const size_t o = (size_t)(row0 + ai * 128 + m * 16) * 256 + ch; const f32x4 v = acc[ai][bj][m][n] + b; f32x4 r;
#pragma unroll
                            for (int j = 0; j < 4; ++j) r[j] = fexp2(-0.875040829f * fsigmoid(v[j]));
                            *(f32x4*)(Wo + o) = r; } }
        } else if (u.pn == 1) {
#pragma unroll
            for (int bj = 0; bj < 2; ++bj)
#pragma unroll
                for (int n = 0; n < 2; ++n) { const int ch = col0 + bj * 128 + n * 16; const f32x4 b = *(const f32x4*)(a0 + ch), kav = *(const f32x4*)(ka + ch);
#pragma unroll
                    for (int ai = 0; ai < 2; ++ai)
#pragma unroll
                        for (int m = 0; m < 4; ++m) { __builtin_amdgcn_sched_barrier(0); const size_t o = (size_t)(row0 + ai * 128 + m * 16) * 256 + ch; const f32x4 v = acc[ai][bj][m][n] + b;
                            const u32x2 kr = *(const u32x2*)(SCH + o), kn = *(const u32x2*)(SCH + (size_t)NT * 256 + o);
                            const float krf[4] = {bflo(kr.x), bfhi(kr.x), bflo(kr.y), bfhi(kr.y)}, knf[4] = {bflo(kn.x), bfhi(kn.x), bflo(kn.y), bfhi(kn.y)}; float k2[4], bb[4];
#pragma unroll
                            for (int j = 0; j < 4; ++j) { const float a = fsigmoid(v[j]); k2[j] = krf[j] * (1.f + (a - 1.f) * kav[j]); bb[j] = knf[j] * a; }
                            u32x2 o1, o2; o1.x = pk2(k2[0], k2[1]); o1.y = pk2(k2[2], k2[3]); o2.x = pk2(bb[0], bb[1]); o2.y = pk2(bb[2], bb[3]);
                            *(u32x2*)(SCo + o) = o1; *(u32x2*)(SCo + (size_t)2 * NT * 256 + o) = o2; } }
        } else {
#pragma unroll
            for (int bj = 0; bj < 2; ++bj)
#pragma unroll
                for (int n = 0; n < 2; ++n) { const int ch = col0 + bj * 128 + n * 16;
#pragma unroll
                    for (int ai = 0; ai < 2; ++ai)
#pragma unroll
                        for (int m = 0; m < 4; ++m) { const size_t o = (size_t)(row0 + ai * 128 + m * 16) * 256 + ch; const f32x4 v = acc[ai][bj][m][n]; u32x2 w; w.x = pk2(v[0], v[1]); w.y = pk2(v[2], v[3]); *(u32x2*)(Gb + o) = w; } }
        }
    }
};
DI float gelu_tanh(float x) { const float t = 0.7978845608f * (x + 0.044715f * x * x * x); return x * fsigmoid(2.f * t); }
struct EpiC1 {
    static constexpr bool PERM = true; bf16* O; const float* peb;
    DI void operator()(const Acc& acc, const pg8::Unit& u, int wr, int wc, int fr, int fq) const {
        const int row0 = u.pm * 256 + wr * 64 + fr, col0 = wc * 32 + 8 * fq;
#pragma unroll
        for (int bj = 0; bj < 2; ++bj) { const f32x4 b0 = *(const f32x4*)(peb + col0 + bj * 128), b1 = *(const f32x4*)(peb + col0 + bj * 128 + 4);
#pragma unroll
            for (int ai = 0; ai < 2; ++ai)
#pragma unroll
                for (int m = 0; m < 4; ++m) { bf16* p = O + (size_t)(row0 + ai * 128 + m * 16) * 256 + col0 + bj * 128; const f32x4 v0 = acc[ai][bj][m][0] + b0, v1 = acc[ai][bj][m][1] + b1; u32x4 w;
                    w.x = pk2(gelu_tanh(v0[0]), gelu_tanh(v0[1])); w.y = pk2(gelu_tanh(v0[2]), gelu_tanh(v0[3])); w.z = pk2(gelu_tanh(v1[0]), gelu_tanh(v1[1])); w.w = pk2(gelu_tanh(v1[2]), gelu_tanh(v1[3]));
                    *(u32x4*)p = w; } }
    }
};
struct EpiC2 {
    static constexpr bool PERM = false; float* O;
    DI void operator()(const Acc& acc, const pg8::Unit& u, int wr, int wc, int fr, int fq) const {
        if (wc >= 2) return;
        const int row0 = u.pm * 256 + wr * 64 + fr, col0 = wc * 32 + 4 * fq;
#pragma unroll
        for (int ai = 0; ai < 2; ++ai)
#pragma unroll
            for (int m = 0; m < 4; ++m)
#pragma unroll
                for (int n = 0; n < 2; ++n) *(f32x4*)(O + (size_t)(row0 + ai * 128 + m * 16) * 64 + col0 + n * 16) = acc[ai][0][m][n];
    }
};
struct EpiOut {
    static constexpr bool PERM = false; float* O; const float* xin; const float* gt;
    DI void operator()(const Acc& acc, const pg8::Unit& u, int wr, int wc, int fr, int fq) const {
        const int row0 = u.pm * 256 + wr * 64 + fr, col0 = u.pn * 256 + wc * 32 + 4 * fq; const int b = (u.pm * 256) / NS;
#pragma unroll
        for (int bj = 0; bj < 2; ++bj)
#pragma unroll
            for (int n = 0; n < 2; ++n) { const int col = col0 + bj * 128 + n * 16; const f32x4 g = *(const f32x4*)(gt + (size_t)b * 6144 + col);
#pragma unroll
                for (int ai = 0; ai < 2; ++ai)
#pragma unroll
                    for (int m = 0; m < 4; ++m) { const size_t o = (size_t)(row0 + ai * 128 + m * 16) * DM + col; *(f32x4*)(O + o) = *(const f32x4*)(xin + o) + g * acc[ai][bj][m][n]; } }
    }
};
struct EpiGU {
    static constexpr bool PERM = true; bf16* O; const float* bgu;
    DI void operator()(const Acc& acc, const pg8::Unit& u, int wr, int wc, int fr, int fq) const {
        const int row0 = u.pm * 256 + wr * 64 + fr, cc = u.pn * 128 + wc * 32 + 8 * fq; const float* bp = bgu + (size_t)u.e * 2048 + cc;
        const f32x4 g0 = *(const f32x4*)bp, g1 = *(const f32x4*)(bp + 4), u0 = *(const f32x4*)(bp + 1024), u1 = *(const f32x4*)(bp + 1028);
#pragma unroll
        for (int ai = 0; ai < 2; ++ai)
#pragma unroll
            for (int m = 0; m < 4; ++m) { bf16* p = O + (size_t)(row0 + ai * 128 + m * 16) * FF + cc; float r[8];
#pragma unroll
                for (int n = 0; n < 2; ++n) { const f32x4 gv = acc[ai][0][m][n] + (n ? g1 : g0), uv = acc[ai][1][m][n] + (n ? u1 : u0);
#pragma unroll
                    for (int j = 0; j < 4; ++j) { const float ga = fminf(gv[j], 7.f), up = fminf(fmaxf(uv[j], -7.f), 7.f); r[4 * n + j] = ga * fsigmoid(1.702f * ga) * (up + 1.f); } }
                u32x4 w; w.x = pk2(r[0], r[1]); w.y = pk2(r[2], r[3]); w.z = pk2(r[4], r[5]); w.w = pk2(r[6], r[7]); *(u32x4*)p = w; }
    }
};
struct EpiDN {
    static constexpr bool PERM = true; bf16* O; const float* bd;
    DI void operator()(const Acc& acc, const pg8::Unit& u, int wr, int wc, int fr, int fq) const {
        const int row0 = u.pm * 256 + wr * 64 + fr, col0 = u.pn * 256 + wc * 32 + 8 * fq; const float* bp = bd + (size_t)u.e * 1024 + col0;
#pragma unroll
        for (int bj = 0; bj < 2; ++bj) { const f32x4 b0 = *(const f32x4*)(bp + bj * 128), b1 = *(const f32x4*)(bp + bj * 128 + 4);
#pragma unroll
            for (int ai = 0; ai < 2; ++ai)
#pragma unroll
                for (int m = 0; m < 4; ++m) { bf16* p = O + (size_t)(row0 + ai * 128 + m * 16) * DM + col0 + bj * 128; const f32x4 v0 = acc[ai][bj][m][0] + b0, v1 = acc[ai][bj][m][1] + b1; u32x4 w;
                    w.x = pk2(v0[0], v0[1]); w.y = pk2(v0[2], v0[3]); w.z = pk2(v1[0], v1[1]); w.w = pk2(v1[2], v1[3]); *(u32x4*)p = w; } }
    }
};
DI float clamp8(float x) { return fminf(fmaxf(x, -448.f), 448.f); }
DI unsigned pk4_fp8_nc(float a, float b, float c, float d) { unsigned w = 0u; w = __builtin_amdgcn_cvt_pk_fp8_f32(a, b, w, false); w = __builtin_amdgcn_cvt_pk_fp8_f32(c, d, w, true); return w; }
DI unsigned pk4_fp8(float a, float b, float c, float d) { unsigned w = 0u; w = __builtin_amdgcn_cvt_pk_fp8_f32(clamp8(a), clamp8(b), w, false); w = __builtin_amdgcn_cvt_pk_fp8_f32(clamp8(c), clamp8(d), w, true); return w; }
constexpr float W8_SCALE = 32.f, W8_INV = 1.f / 32.f;
struct EpiGU8 {
    static constexpr bool PERM = true; unsigned char* O; const float* bgu;
    DI void operator()(const Acc& acc, const pg8::Unit& u, int wr, int wc, int fr, int fq) const {
        const int row0 = u.pm * 256 + wr * 64 + fr, cc = u.pn * 128 + wc * 32 + 8 * fq; const float* bp = bgu + (size_t)u.e * 2048 + cc;
        const f32x4 g0 = *(const f32x4*)bp, g1 = *(const f32x4*)(bp + 4), u0 = *(const f32x4*)(bp + 1024), u1 = *(const f32x4*)(bp + 1028);
#pragma unroll
        for (int ai = 0; ai < 2; ++ai)
#pragma unroll
            for (int m = 0; m < 4; ++m) { unsigned char* p = O + (size_t)(row0 + ai * 128 + m * 16) * FF + cc; float r[8];
#pragma unroll
                for (int n = 0; n < 2; ++n) { const f32x4 gv = acc[ai][0][m][n] * W8_INV + (n ? g1 : g0), uv = acc[ai][1][m][n] * W8_INV + (n ? u1 : u0);
#pragma unroll
                    for (int j = 0; j < 4; ++j) { const float ga = fminf(gv[j], 7.f), up = __builtin_amdgcn_fmed3f(uv[j], -7.f, 7.f); const float sg = __builtin_amdgcn_rcpf(1.f + __builtin_amdgcn_exp2f(-2.45546695959f * ga)); r[4 * n + j] = (ga * sg) * (up + 1.f); } }
                u32x2 w; w.x = pk4_fp8_nc(r[0], r[1], r[2], r[3]); w.y = pk4_fp8_nc(r[4], r[5], r[6], r[7]); *(u32x2*)p = w; }
    }
};
#ifndef YB_FP8
#define YB_FP8 1
#endif
struct EpiDN8 {
    static constexpr bool PERM = true; bf16* O; const float* bd;
    DI void operator()(const Acc& acc, const pg8::Unit& u, int wr, int wc, int fr, int fq) const {
        const int row0 = u.pm * 256 + wr * 64 + fr, col0 = u.pn * 256 + wc * 32 + 8 * fq; const float* bp = bd + (size_t)u.e * 1024 + col0;
#pragma unroll
        for (int bj = 0; bj < 2; ++bj) { const f32x4 b0 = *(const f32x4*)(bp + bj * 128), b1 = *(const f32x4*)(bp + bj * 128 + 4);
#pragma unroll
            for (int ai = 0; ai < 2; ++ai)
#pragma unroll
                for (int m = 0; m < 4; ++m) { const size_t oo = (size_t)(row0 + ai * 128 + m * 16) * DM + col0 + bj * 128; const f32x4 v0 = acc[ai][bj][m][0] * W8_INV + b0, v1 = acc[ai][bj][m][1] * W8_INV + b1;
                    if (YB_FP8) { u32x2 w; w.x = pk4_fp8(v0[0], v0[1], v0[2], v0[3]); w.y = pk4_fp8(v1[0], v1[1], v1[2], v1[3]); *(u32x2*)((unsigned char*)O + oo) = w; }
                    else { u32x4 w; w.x = pk2(v0[0], v0[1]); w.y = pk2(v0[2], v0[3]); w.z = pk2(v1[0], v1[1]); w.w = pk2(v1[2], v1[3]); *(u32x4*)(O + oo) = w; } } }
    }
};
DI void tr_item(const float* src, int ld_src, int scol0, int nvalid, int k0, bf16* dst, int ld_dst, int drow0, int dk0, LAS float* scr, int lane) {
    const int n4 = (lane & 7) * 4, kr = lane >> 3; f32x4 v[8];
#pragma unroll
    for (int i = 0; i < 8; ++i) v[i] = (n4 < nvalid) ? *(const f32x4*)(src + (size_t)(k0 + kr + 8 * i) * ld_src + scol0 + n4) : (f32x4){0.f, 0.f, 0.f, 0.f};
#pragma unroll
    for (int i = 0; i < 8; ++i) { LAS float* s = scr + (kr + 8 * i) * 33 + n4; s[0] = v[i][0]; s[1] = v[i][1]; s[2] = v[i][2]; s[3] = v[i][3]; }
    asm volatile("s_waitcnt lgkmcnt(0)" ::: "memory");
    const int c = lane & 7;
#pragma unroll
    for (int jq = 0; jq < 4; ++jq) { const int n = (lane >> 3) + 8 * jq; const LAS float* s = scr + (8 * c) * 33 + n;
        u32x4 o; o.x = pk2(s[0 * 33], s[1 * 33]); o.y = pk2(s[2 * 33], s[3 * 33]); o.z = pk2(s[4 * 33], s[5 * 33]); o.w = pk2(s[6 * 33], s[7 * 33]);
        *(u32x4*)(dst + (size_t)(drow0 + n) * ld_dst + dk0 + k0 + 8 * c) = o; }
    asm volatile("s_waitcnt lgkmcnt(0)" ::: "memory");
}
DI void tr_item8(const float* src, int ld_src, int scol0, int k0, unsigned char* dst, int ld_dst, int drow0, LAS float* scr, int lane, int nvalid = 32) {
    const int n4 = (lane & 7) * 4, kr = lane >> 3; f32x4 v[8];
#pragma unroll
    for (int i = 0; i < 8; ++i) v[i] = (n4 < nvalid) ? *(const f32x4*)(src + (size_t)(k0 + kr + 8 * i) * ld_src + scol0 + n4) : (f32x4){0.f, 0.f, 0.f, 0.f};
#pragma unroll
    for (int i = 0; i < 8; ++i) { LAS float* s = scr + (kr + 8 * i) * 33 + n4; s[0] = v[i][0]; s[1] = v[i][1]; s[2] = v[i][2]; s[3] = v[i][3]; }
    asm volatile("s_waitcnt lgkmcnt(0)" ::: "memory");
    const int c = lane & 7;
#pragma unroll
    for (int jq = 0; jq < 4; ++jq) { const int n = (lane >> 3) + 8 * jq; const LAS float* s = scr + (8 * c) * 33 + n;
        u32x2 o; o.x = pk4_fp8(s[0 * 33] * W8_SCALE, s[1 * 33] * W8_SCALE, s[2 * 33] * W8_SCALE, s[3 * 33] * W8_SCALE); o.y = pk4_fp8(s[4 * 33] * W8_SCALE, s[5 * 33] * W8_SCALE, s[6 * 33] * W8_SCALE, s[7 * 33] * W8_SCALE);
        *(u32x2*)(dst + (size_t)(drow0 + n) * ld_dst + k0 + 8 * c) = o; }
    asm volatile("s_waitcnt lgkmcnt(0)" ::: "memory");
}
DI void conv_item(const Ctx& C, int l, int r, LAS float* scr) {
    constexpr int I_GU = 32 * 16 * 64;
    if (r < I_GU) { const int e = r / 1024, r2 = r % 1024, kb = r2 / 64, nb = r2 % 64, n0 = 32 * nb, j = n0 / 256, i = n0 % 256;
        const int scol0 = (i < 128) ? 128 * j + i : 1024 + 128 * j + (i - 128);
        tr_item8(C.w_gu + (size_t)(l * 32 + e) * 1024 * 2048, 2048, scol0, 64 * kb, WSP(unsigned char, WS_WGU) + (size_t)(l * 32 + e) * 2048 * 1024, 1024, n0, scr, C.lane); }
    else { r -= I_GU; const int e = r / 512, r2 = r % 512, kb = r2 / 32, nb = r2 % 32;
        tr_item8(C.w_down + (size_t)(l * 32 + e) * 1024 * 1024, 1024, 32 * nb, 64 * kb, WSP(unsigned char, WS_WDN) + (size_t)(l * 32 + e) * 1024 * 1024, 1024, 32 * nb, scr, C.lane); }
}
DI void conv_ticket(const Ctx& C0, int l, int tk) {
    Ctx C = C0; asm volatile("" : "+v"(C.lane), "+v"(C.tid));
    LAS float* scr = (LAS float*)(C.lds + C.wave * 16384);
    __syncthreads();
#pragma unroll 1
    for (int i = 0; i < 8; ++i) conv_item(C, l, tk * 64 + C.wave * 8 + i, scr);
}
DI void p0_prologue(const Ctx& C) {
    LAS float* scr = (LAS float*)(C.lds + C.wave * 16384);
    const int gw = C.bid * NWAVE + C.wave, NGW = C.G * NWAVE;
    constexpr int I_IN = 16 * 104, I_OUT = 16 * 32, I_LW = 8, I_LA = 8, I_LG = 16, I_K1 = 256, I_K2 = 8;
    constexpr int I_LAYER = I_IN + I_OUT + I_LW + I_LA + I_LG + 2 * I_K1 + 2 * I_K2;
    for (int it = gw; it < NLAYER * I_LAYER; it += NGW) {
        const int l = it / I_LAYER; int r = it % I_LAYER;
        if (r < I_IN) { const int kb = r / 104, nb = r % 104, n0 = 32 * nb; int nv = 3212 - n0; nv = nv < 0 ? 0 : (nv > 32 ? 32 : nv);
            if (INPROJ_FP8) tr_item8(C.w_in + (size_t)l * 1024 * 3212, 3212, n0, 64 * kb, WSP(unsigned char, WS_WIN) + (size_t)l * NPJ * 1024, 1024, n0, scr, C.lane, nv);
            else tr_item(C.w_in + (size_t)l * 1024 * 3212, 3212, n0, nv, 64 * kb, WSP(bf16, WS_WIN) + (size_t)l * NPJ * 1024, 1024, n0, 0, scr, C.lane); continue; } r -= I_IN;
        if (r < I_OUT) { const int kb = r / 32, nb = r % 32;
            tr_item(C.w_out + (size_t)l * 1024 * 1024, 1024, 32 * nb, 32, 64 * kb, WSP(bf16, WS_WOUT) + (size_t)l * 1024 * 1024, 1024, 32 * nb, 0, scr, C.lane); continue; } r -= I_OUT;
        bf16* lora = WSP(bf16, WS_LORA) + (size_t)l * 768 * 256;
        if (r < I_LW) { tr_item(C.w2 + (size_t)l * 64 * 256, 256, 32 * r, 32, 0, lora, 256, 32 * r, 0, scr, C.lane); continue; } r -= I_LW;
        if (r < I_LA) { tr_item(C.a2 + (size_t)l * 64 * 256, 256, 32 * r, 32, 0, lora, 256, 256 + 32 * r, 64, scr, C.lane); continue; } r -= I_LA;
        if (r < I_LG) { const int kb = r / 8, nb = r % 8; tr_item(C.g2 + (size_t)l * 128 * 256, 256, 32 * nb, 32, 64 * kb, lora, 256, 512 + 32 * nb, 128, scr, C.lane); continue; } r -= I_LG;
        if (r < 2 * I_K1) { const int kv = r / I_K1, r2 = r % I_K1, kb = r2 / 8, nb = r2 % 8;
            tr_item((kv ? C.wv1 : C.wk1) + (size_t)l * 2048 * 256, 256, 32 * nb, 32, 64 * kb, WSP(bf16, WS_WK1) + (size_t)(l * 2 + kv) * 256 * 2048, 2048, 32 * nb, 0, scr, C.lane); continue; } r -= 2 * I_K1;
        { const int kv = r / I_K2, r2 = r % I_K2, kb = r2 / 2, nb = r2 % 2;
            tr_item((kv ? C.wv2 : C.wk2) + (size_t)l * 256 * 64, 64, 32 * nb, 32, 64 * kb, WSP(bf16, WS_WK2) + (size_t)(l * 2 + kv) * 256 * 256, 256, 32 * nb, 0, scr, C.lane); }
    }
    { int* idm = WSP(int, WS_ROUTE) + NT * 12 + NR; for (int i = C.bid * NTHR + C.tid; i < NR; i += C.G * NTHR) idm[i] = i; }
    __syncthreads();
    float* MOD = WSP(float, WS_SMALL); float* PEB = MOD + NLAYER * 8 * 6144;
    LAS float* sc = (LAS float*)C.lds;
    LAS float* red = sc + 8192;
    for (int it = C.bid; it < 192 + 32; it += C.G) {
        if (it < 192) {
            const int l = it / 96, n0 = (it % 96) * 64;
            for (int i = C.tid; i < 8192; i += NTHR) { const float v = C.c[i]; sc[i] = v * fsigmoid(v); }
            __syncthreads();
            const int kq = C.tid >> 6, col = C.tid & 63; float a[8];
#pragma unroll
            for (int b = 0; b < 8; ++b) a[b] = 0.f;
            const float* wp = C.w_ada + (size_t)l * 1024 * 6144 + n0 + col;
#pragma unroll 32
            for (int k = kq * 128; k < kq * 128 + 128; ++k) { const float w = wp[(size_t)k * 6144];
#pragma unroll
                for (int b = 0; b < 8; ++b) a[b] += sc[b * 1024 + k] * w; }
#pragma unroll
            for (int b = 0; b < 8; ++b) red[(kq * 8 + b) * 64 + col] = a[b];
            __syncthreads();
            { const int b = C.tid >> 6; float s = C.b_ada[(size_t)l * 6144 + n0 + col];
#pragma unroll
              for (int q = 0; q < 8; ++q) s += red[(q * 8 + b) * 64 + col];
              MOD[((size_t)l * 8 + b) * 6144 + n0 + col] = s; }
            __syncthreads();
        } else {
            const int r = it - 192, l = r >> 4, kv = (r >> 3) & 1, c0 = (r & 7) * 32; const float* pe = (kv ? C.pe_v : C.pe_k) + (size_t)l * 2048; const float* w1 = (kv ? C.wv1 : C.wk1) + (size_t)l * 2048 * 256;
            const int kq = C.tid >> 5, col = C.tid & 31; float a = 0.f;
#pragma unroll 16
            for (int k = kq * 128; k < kq * 128 + 128; ++k) a += pe[k] * w1[(size_t)k * 256 + c0 + col];
            red[kq * 32 + col] = a; __syncthreads();
            if (C.tid < 32) { float s = 0.f;
#pragma unroll
                for (int q = 0; q < 16; ++q) s += red[q * 32 + C.tid];
                PEB[(l * 2 + kv) * 256 + c0 + C.tid] = s; }
            __syncthreads();
        }
    }
}

DI void norm_row(const Ctx& C, const float* xrow, const float* g, const float* sh, const float* sc, bf16* orow) {
    f32x4 v[4]; float s = 0.f;
#pragma unroll
    for (int j = 0; j < 4; ++j) { v[j] = *(const f32x4*)(xrow + 4 * C.lane + 256 * j); s += (v[j][0] * v[j][0] + v[j][1] * v[j][1]) + (v[j][2] * v[j][2] + v[j][3] * v[j][3]); }
    s = group_sum<64>(s); const float rstd = rsqrtf(s * (1.f / DM) + 1e-6f);
#pragma unroll
    for (int j = 0; j < 4; ++j) { const int k = 4 * C.lane + 256 * j; const f32x4 gg = *(const f32x4*)(g + k), a = *(const f32x4*)(sc + k), b = *(const f32x4*)(sh + k); f32x4 h;
#pragma unroll
        for (int i = 0; i < 4; ++i) h[i] = v[j][i] * rstd * gg[i] * (1.f + a[i]) + b[i];
        if (INPROJ_FP8) *(unsigned*)((unsigned char*)orow + k) = pk4_fp8(h[0], h[1], h[2], h[3]);
        else { u32x2 o; o.x = pk2(h[0], h[1]); o.y = pk2(h[2], h[3]); *(u32x2*)(orow + k) = o; } }
}
DI void norm1_phase(const Ctx& C, int l, const float* xin) {
    const float* MOD = WSP(float, WS_SMALL) + (size_t)l * 8 * 6144; bf16* H = WSP(bf16, WS_H);
    const int gw = C.bid * NWAVE + C.wave, NGW = C.G * NWAVE;
    for (int m = gw; m < NT; m += NGW) { const int b = m / NS; norm_row(C, xin + (size_t)m * DM, C.norm1_g + l * DM, MOD + b * 6144, MOD + b * 6144 + 1024, INPROJ_FP8 ? (bf16*)((unsigned char*)H + (size_t)m * DM) : H + (size_t)m * DM); }
}

constexpr float QSCALE = 0.125f * 1.44269504089f;
DI void prep_phase(const Ctx& C, int l) {
    const bf16* PROJ = WSP(bf16, R_PROJ); bf16* SCH = WSP(bf16, R_SCH); bf16* LIN = WSP(bf16, R_LIN); bf16* YCAT = WSP(bf16, R_YCAT);
    bf16 *QC = WSP(bf16, R_QC), *KC = WSP(bf16, R_KC), *QN = WSP(bf16, R_QN), *QR = WSP(bf16, R_QR), *KCR = WSP(bf16, R_KCR), *VCR = WSP(bf16, R_VCR), *KS = WSP(bf16, R_KS), *KW = WSP(bf16, R_KW);
    float* GATE = WSP(float, R_GATE);
    const int lane = C.lane, gw = C.bid * NWAVE + C.wave, NGW = C.G * NWAVE;
    const int hh = lane >> 4, jj = lane & 15;
    const float inv0 = exp2f(-(float)(2 * jj) * (13.287712379549449f / 32.f)) * 0.15915494309189535f, inv1 = exp2f(-(float)(2 * jj + 1) * (13.287712379549449f / 32.f)) * 0.15915494309189535f;
    for (int task = gw; task < NT / 16; task += NGW) {
        const int row0 = 16 * task, s0 = row0 % NS;
        {
            const int c0 = 16 * lane, cc = (c0 - 256) & 255; float mu16[16], kw16[16];
#pragma unroll
            for (int q = 0; q < 4; ++q) { const f32x4 m4 = *(const f32x4*)(C.mu + (size_t)l * 1024 + c0 + 4 * q), k4 = *(const f32x4*)(C.kkw + (size_t)l * 256 + cc + 4 * q);
#pragma unroll
                for (int i = 0; i < 4; ++i) { mu16[4 * q + i] = m4[i]; kw16[4 * q + i] = k4[i]; } }
#pragma unroll 2
            for (int r = 0; r < 16; ++r) {
                const int row = row0 + r; const bf16* pr = PROJ + (size_t)row * NPJ; float z[16];
                const u32x4 c0v = *(const u32x4*)(pr + c0), c1v = *(const u32x4*)(pr + c0 + 8);
                u32x4 p0v = (u32x4){0u, 0u, 0u, 0u}, p1v = p0v;
                if (s0 + r > 0) { p0v = *(const u32x4*)(pr - NPJ + c0); p1v = *(const u32x4*)(pr - NPJ + c0 + 8); }
                const unsigned cw[8] = {c0v.x, c0v.y, c0v.z, c0v.w, c1v.x, c1v.y, c1v.z, c1v.w}, pw[8] = {p0v.x, p0v.y, p0v.z, p0v.w, p1v.x, p1v.y, p1v.z, p1v.w};
#pragma unroll
                for (int e = 0; e < 16; ++e) { const float cu = (e & 1) ? bfhi(cw[e >> 1]) : bflo(cw[e >> 1]), pv = (e & 1) ? bfhi(pw[e >> 1]) : bflo(pw[e >> 1]); z[e] = cu + (pv - cu) * mu16[e]; }
                float kk[16]; float ss = 0.f;
#pragma unroll
                for (int e = 0; e < 16; ++e) { kk[e] = z[e] * kw16[e]; ss += kk[e] * kk[e]; }
                ss = group_sum<4>(ss); const float kinv = rsqrtf(ss + 1e-12f);
                if (lane < 48) {
                    const int pl = lane < 16 ? 3 : (lane < 32 ? 0 : 4); bf16* dst = SCH + ((size_t)pl * NT + row) * 256 + (c0 & 255);
                    u32x4 o0, o1; o0.x = pk2(z[0], z[1]); o0.y = pk2(z[2], z[3]); o0.z = pk2(z[4], z[5]); o0.w = pk2(z[6], z[7]); o1.x = pk2(z[8], z[9]); o1.y = pk2(z[10], z[11]); o1.z = pk2(z[12], z[13]); o1.w = pk2(z[14], z[15]);
                    *(u32x4*)dst = o0; *(u32x4*)(dst + 8) = o1;
                    if (lane >= 16 && lane < 32) { bf16* d2 = SCH + ((size_t)1 * NT + row) * 256 + cc;
                        u32x4 q0, q1; q0.x = pk2(kk[0] * kinv, kk[1] * kinv); q0.y = pk2(kk[2] * kinv, kk[3] * kinv); q0.z = pk2(kk[4] * kinv, kk[5] * kinv); q0.w = pk2(kk[6] * kinv, kk[7] * kinv);
                        q1.x = pk2(kk[8] * kinv, kk[9] * kinv); q1.y = pk2(kk[10] * kinv, kk[11] * kinv); q1.z = pk2(kk[12] * kinv, kk[13] * kinv); q1.w = pk2(kk[14] * kinv, kk[15] * kinv);
                        *(u32x4*)d2 = q0; *(u32x4*)(d2 + 8) = q1; }
                } else {
                    float t[16];
#pragma unroll
                    for (int i = 0; i < 16; ++i) { const float sg = fsigmoid(lane < 52 ? 2.f * z[i] : z[i]); t[i] = lane < 52 ? 2.f * sg - 1.f : (lane < 56 ? z[i] : sg); }
                    bf16* dst = LIN + (size_t)row * 256 + (c0 - 768);
                    u32x4 o0, o1; o0.x = pk2(t[0], t[1]); o0.y = pk2(t[2], t[3]); o0.z = pk2(t[4], t[5]); o0.w = pk2(t[6], t[7]); o1.x = pk2(t[8], t[9]); o1.y = pk2(t[10], t[11]); o1.z = pk2(t[12], t[13]); o1.w = pk2(t[14], t[15]);
                    *(u32x4*)dst = o0; *(u32x4*)(dst + 8) = o1;
                }
            }
        }
        {
            const int ch = 4 * lane; const float* cw = C.conv_w + (size_t)l * 3 * 256 + ch; const f32x4 w0 = *(const f32x4*)cw, w1 = *(const f32x4*)(cw + 256), w2 = *(const f32x4*)(cw + 512);
            const f32x4 og = *(const f32x4*)(C.onorm_g + (size_t)l * 768 + ch);
#pragma unroll 2
            for (int r = 0; r < 16; ++r) {
                const int row = row0 + r, s = s0 + r; const bf16* pr = PROJ + (size_t)row * NPJ; float u[3][4];
#pragma unroll
                for (int d = 0; d < 3; ++d) {
                    u32x2 cg = (u32x2){0u, 0u}, xi = cg;
                    if (s >= d) { cg = *(const u32x2*)(pr - (size_t)d * NPJ + PJ_B + 256 + ch); xi = *(const u32x2*)(pr - (size_t)d * NPJ + PJ_B + 512 + ch); }
                    u[d][0] = bflo(cg.x) * bflo(xi.x); u[d][1] = bfhi(cg.x) * bfhi(xi.x); u[d][2] = bflo(cg.y) * bflo(xi.y); u[d][3] = bfhi(cg.y) * bfhi(xi.y);
                }
                const u32x2 bgv = *(const u32x2*)(pr + PJ_B + ch); const float bg[4] = {bflo(bgv.x), bfhi(bgv.x), bflo(bgv.y), bfhi(bgv.y)};
                float y[4]; float ss = 0.f;
#pragma unroll
                for (int i = 0; i < 4; ++i) { y[i] = bg[i] * (w0[i] * u[2][i] + w1[i] * u[1][i] + w2[i] * u[0][i]); ss += y[i] * y[i]; }
                ss = group_sum<16>(ss); const float rstd = rsqrtf(ss * (1.f / 64.f) + 1e-6f);
                u32x2 o; o.x = pk2(y[0] * rstd * og[0], y[1] * rstd * og[1]); o.y = pk2(y[2] * rstd * og[2], y[3] * rstd * og[3]);
                *(u32x2*)(YCAT + (size_t)row * DM + 256 + ch) = o;
            }
        }
        {
            const float* gq = C.dil_q_g + (size_t)l * 64; const float* gk = C.dil_k_g + (size_t)l * 64; const float* gn = C.nsa_q_g + (size_t)l * 64; const float* gv = (hh == 0 ? C.nsa_ks_g : C.nsa_kw_g) + (size_t)l * 64;
            float Gq[4], Gk[4], Gn[4], Gv[4];
#pragma unroll
            for (int i = 0; i < 4; ++i) { const int d = (i >> 1) * 32 + 2 * jj + (i & 1); Gq[i] = gq[d] * QSCALE; Gk[i] = gk[d]; Gn[i] = gn[d] * QSCALE; Gv[i] = gv[d]; }
            const int vcol = hh == 0 ? 2944 : (hh == 1 ? 3072 : (hh == 2 ? 2816 : 2880));
            bf16* vdst = (hh == 0 ? KS : (hh == 1 ? KW : (hh == 2 ? KCR : VCR)));
#pragma unroll 2
            for (int r = 0; r < 16; ++r) {
                const int row = row0 + r; const bf16* pr = PROJ + (size_t)row * NPJ;
                const float posf = (float)C.pos[row];
                const float x0 = __builtin_amdgcn_fractf(posf * inv0), x1 = __builtin_amdgcn_fractf(posf * inv1);
                const float sn0 = __builtin_amdgcn_sinf(x0), cs0 = __builtin_amdgcn_cosf(x0), sn1 = __builtin_amdgcn_sinf(x1), cs1 = __builtin_amdgcn_cosf(x1);
                const unsigned qa = *(const unsigned*)(pr + PJ_C + hh * 64 + 2 * jj), qb = *(const unsigned*)(pr + PJ_C + hh * 64 + 32 + 2 * jj);
                const unsigned ka = *(const unsigned*)(pr + PJ_C + 256 + hh * 64 + 2 * jj), kb = *(const unsigned*)(pr + PJ_C + 256 + hh * 64 + 32 + 2 * jj);
                const unsigned na = *(const unsigned*)(pr + PJ_D + hh * 64 + 2 * jj), nb = *(const unsigned*)(pr + PJ_D + hh * 64 + 32 + 2 * jj);
                const unsigned va = *(const unsigned*)(pr + vcol + 2 * jj), vb = *(const unsigned*)(pr + vcol + 32 + 2 * jj);
                float gate_in = 0.f; if (lane < 12) gate_in = bf2f(pr[3200 + lane]);
#define ROPE_NORM(a, b, G, o1, o2, n1a, n1b, n2a, n2b) \
                float n1a = bflo(a), n1b = bfhi(a), n2a = bflo(b), n2b = bfhi(b); { const float ss_ = group_sum<16>(n1a * n1a + n1b * n1b + n2a * n2a + n2b * n2b); const float rs_ = rsqrtf(ss_ * (1.f / 64.f) + 1e-6f); \
                    n1a *= rs_ * G[0]; n1b *= rs_ * G[1]; n2a *= rs_ * G[2]; n2b *= rs_ * G[3]; } \
                const unsigned o1 = pk2(n1a * cs0 - n2a * sn0, n1b * cs1 - n2b * sn1), o2 = pk2(n2a * cs0 + n1a * sn0, n2b * cs1 + n1b * sn1);
                ROPE_NORM(qa, qb, Gq, q1, q2, q1a, q1b, q2a, q2b)
                ROPE_NORM(ka, kb, Gk, k1, k2, k1a, k1b, k2a, k2b)
                ROPE_NORM(na, nb, Gn, r1, r2, r1a, r1b, r2a, r2b)
                ROPE_NORM(va, vb, Gv, v1, v2, v1a, v1b, v2a, v2b)
#undef ROPE_NORM
                bf16* o = QC + (size_t)row * 256 + hh * 64 + 2 * jj; *(unsigned*)o = q1; *(unsigned*)(o + 32) = q2;
                o = KC + (size_t)row * 256 + hh * 64 + 2 * jj; *(unsigned*)o = k1; *(unsigned*)(o + 32) = k2;
                o = QN + (size_t)row * 256 + hh * 64 + 2 * jj; *(unsigned*)o = pk2(r1a, r1b); *(unsigned*)(o + 32) = pk2(r2a, r2b);
                o = QR + (size_t)row * 256 + hh * 64 + 2 * jj; *(unsigned*)o = r1; *(unsigned*)(o + 32) = r2;
                o = vdst + (size_t)row * 64 + 2 * jj; *(unsigned*)o = (hh >= 2) ? va : v1; *(unsigned*)(o + 32) = (hh >= 2) ? vb : v2;
                if (lane < 12) GATE[(size_t)row * 12 + lane] = fsigmoid(gate_in);
            }
        }
    }
}
constexpr int SCAN_TC = 16;
DI void scan_unit8(const Ctx& C, int u) {
    const float* Wp = WSP(float, R_SC); const bf16* SCH = WSP(bf16, R_SCH); float* YA = WSP(float, R_YA); float* UB = WSP(float, R_SCANU); float* SMT = WSP(float, R_SCANS);
    const int pair = u / 3, kind = u % 3, b = pair >> 2, h = pair & 3, tid = C.tid;
    LAS float* buf = (LAS float*)C.lds;
    LAS float* ybuf = buf + 2 * 6144;
    const int row = tid >> 3, cg = tid & 7, tbase = kind == 0 ? 0 : NS / 2;
    const float vm = kind == 2 ? 0.f : 1.f;
    u32x4 ldA[2], ldB[2];
#define SCAN_LOAD(ld, chunk) do { _Pragma("unroll") for (int i = 0; i < 2; ++i) { const int p_ = tid + 512 * i; if (p_ < 896) { const int step = p_ / 56, r_ = p_ % 56; const size_t row_ = (size_t)b * NS + tbase + (chunk) * SCAN_TC + step; \
        if (r_ < 16) ld[i] = *(const u32x4*)(Wp + row_ * 256 + h * 64 + r_ * 4); else { const int v5 = (r_ - 16) >> 3, c_ = (r_ - 16) & 7; ld[i] = *(const u32x4*)(SCH + ((size_t)v5 * NT + row_) * 256 + h * 64 + c_ * 8); } } } } while (0)
#define SCAN_STORE(ld, slot) do { _Pragma("unroll") for (int i = 0; i < 2; ++i) { const int p_ = tid + 512 * i; if (p_ < 896) { const int step = p_ / 56, r_ = p_ % 56; LAS float* d_ = buf + (slot) * 6144 + step * 384; \
        if (r_ < 16) *(LAS u32x4*)(d_ + r_ * 4) = ld[i]; else { const int v5 = (r_ - 16) >> 3, c_ = (r_ - 16) & 7; LAS float* e_ = d_ + (1 + v5) * 64 + c_ * 8; const u32x4 x_ = ld[i]; \
            *(LAS f32x4*)e_ = (f32x4){bflo(x_.x), bfhi(x_.x), bflo(x_.y), bfhi(x_.y)}; *(LAS f32x4*)(e_ + 4) = (f32x4){bflo(x_.z), bfhi(x_.z), bflo(x_.w), bfhi(x_.w)}; } } } } while (0)
#define SCAN_FLUSH(chunk) do { _Pragma("unroll") for (int i = 0; i < 2; ++i) { const int i2 = tid + 512 * i, step = i2 >> 6, rr = i2 & 63; const LAS float* pp_ = ybuf + ((chunk) & 1) * 8192 + step * 512 + rr * 8; \
        const f32x4 pa_ = *(const LAS f32x4*)pp_, pb_ = *(const LAS f32x4*)(pp_ + 4); const float yv = ((pa_[0] + pa_[1]) + (pa_[2] + pa_[3])) + ((pb_[0] + pb_[1]) + (pb_[2] + pb_[3])); \
        if (kind == 2) UB[((size_t)b * (NS / 2) + (chunk) * SCAN_TC + step) * 256 + h * 64 + rr] = yv; else YA[((size_t)b * NS + tbase + (chunk) * SCAN_TC + step) * 256 + h * 64 + rr] = yv; } } while (0)
    __syncthreads();
    SCAN_LOAD(ldA, 0); SCAN_STORE(ldA, 0); SCAN_LOAD(ldB, 1); SCAN_LOAD(ldA, 2);
    f32x2 S[4];
#pragma unroll
    for (int c = 0; c < 4; ++c) { S[c][0] = (kind == 2 && row == 8 * cg + 2 * c) ? 1.f : 0.f; S[c][1] = (kind == 2 && row == 8 * cg + 2 * c + 1) ? 1.f : 0.f; }
    constexpr int NCH = (NS / 2) / SCAN_TC;
#pragma unroll 2
    for (int ck = 0; ck < NCH; ++ck) {
        __syncthreads();
        if (ck & 1) { if (ck + 1 < NCH) SCAN_STORE(ldA, (ck + 1) & 1); if (ck + 3 < NCH) SCAN_LOAD(ldA, ck + 3); }
        else        { if (ck + 1 < NCH) SCAN_STORE(ldB, (ck + 1) & 1); if (ck + 3 < NCH) SCAN_LOAD(ldB, ck + 3); }
        {
            const LAS float* bp = buf + (ck & 1) * 6144; LAS float* yb = ybuf + (ck & 1) * 8192 + tid;
#define SCAN_LDS(X, step) do { const LAS float* sp = bp + (step) * 384 + 8 * cg; X.w0 = *(const LAS f32x4*)(sp); X.w1 = *(const LAS f32x4*)(sp + 4); X.k0 = *(const LAS f32x4*)(sp + 64); X.k1 = *(const LAS f32x4*)(sp + 68); \
                X.q0 = *(const LAS f32x4*)(sp + 128); X.q1 = *(const LAS f32x4*)(sp + 132); X.b0 = *(const LAS f32x4*)(sp + 192); X.b1 = *(const LAS f32x4*)(sp + 196); \
                X.r0 = *(const LAS f32x4*)(sp + 256); X.r1 = *(const LAS f32x4*)(sp + 260); X.v = bp[(step) * 384 + 320 + row] * vm; } while (0)
#define SCAN_STEP(X, step) do { \
                f32x2 d2 = S[0] * (f32x2){X.q0[0], X.q0[1]}; d2 = S[1] * (f32x2){X.q0[2], X.q0[3]} + d2; d2 = S[2] * (f32x2){X.q1[0], X.q1[1]} + d2; d2 = S[3] * (f32x2){X.q1[2], X.q1[3]} + d2; \
                const float sa = -sum8(d2[0] + d2[1]); const f32x2 sa2 = (f32x2){sa, sa}, v2 = (f32x2){X.v, X.v}; \
                S[0] = S[0] * (f32x2){X.w0[0], X.w0[1]} + (sa2 * (f32x2){X.b0[0], X.b0[1]} + v2 * (f32x2){X.k0[0], X.k0[1]}); \
                S[1] = S[1] * (f32x2){X.w0[2], X.w0[3]} + (sa2 * (f32x2){X.b0[2], X.b0[3]} + v2 * (f32x2){X.k0[2], X.k0[3]}); \
                S[2] = S[2] * (f32x2){X.w1[0], X.w1[1]} + (sa2 * (f32x2){X.b1[0], X.b1[1]} + v2 * (f32x2){X.k1[0], X.k1[1]}); \
                S[3] = S[3] * (f32x2){X.w1[2], X.w1[3]} + (sa2 * (f32x2){X.b1[2], X.b1[3]} + v2 * (f32x2){X.k1[2], X.k1[3]}); \
                f32x2 y2 = S[0] * (f32x2){X.r0[0], X.r0[1]}; y2 = S[1] * (f32x2){X.r0[2], X.r0[3]} + y2; y2 = S[2] * (f32x2){X.r1[0], X.r1[1]} + y2; y2 = S[3] * (f32x2){X.r1[2], X.r1[3]} + y2; \
                yb[(step) * 512] = y2[0] + y2[1]; } while (0)
            struct StepIn { f32x4 w0, w1, k0, k1, q0, q1, b0, b1, r0, r1; float v; } A, B;
            SCAN_LDS(A, 0);
#pragma unroll 2
            for (int step = 0; step < SCAN_TC; step += 2) {
                SCAN_LDS(B, step + 1);
                __builtin_amdgcn_sched_barrier(0);
                SCAN_STEP(A, step);
                __builtin_amdgcn_sched_barrier(0);
                if (step + 2 < SCAN_TC) SCAN_LDS(A, step + 2);
                __builtin_amdgcn_sched_barrier(0);
                SCAN_STEP(B, step + 1);
                __builtin_amdgcn_sched_barrier(0);
            }
#undef SCAN_LDS
#undef SCAN_STEP
        }
        if (ck > 0) SCAN_FLUSH(ck - 1);
    }
    __syncthreads();
    SCAN_FLUSH(NCH - 1);
    if (kind == 0) {
        float* o = SMT + (size_t)pair * 4096 + row;
#pragma unroll
        for (int c = 0; c < 4; ++c) { o[(8 * cg + 2 * c) * 64] = S[c][0]; o[(8 * cg + 2 * c + 1) * 64] = S[c][1]; }
    }
#undef SCAN_LOAD
#undef SCAN_STORE
#undef SCAN_FLUSH
    __syncthreads();
}

constexpr int KROW = 144, KT_BYTES = 64 * KROW;
#define MFMA16(a, b, c) __builtin_amdgcn_mfma_f32_16x16x32_bf16((a), (b), (c), 0, 0, 0)
template <int NQT> struct FA { f32x4 O[NQT][4]; float l[NQT]; float negM; };
template <int NQT> DI void fa_init(FA<NQT>& st) {
#pragma unroll
    for (int q = 0; q < NQT; ++q) { st.l[q] = 0.f;
#pragma unroll
        for (int d = 0; d < 4; ++d) st.O[q][d] = (f32x4){0.f, 0.f, 0.f, 0.f}; }
}
DI bf16x8 pack8(const f32x4& a, const f32x4& b) { u32x4 w; w.x = pk2(a[0], a[1]); w.y = pk2(a[2], a[3]); w.z = pk2(b[0], b[1]); w.w = pk2(b[2], b[3]); return __builtin_bit_cast(bf16x8, w); }
struct VFrag { u32x2 a[4], b[4]; };
DI void vt_issue(VFrag& f, unsigned vaddr) {
    asm volatile("ds_read_b64_tr_b16 %0, %8\n\tds_read_b64_tr_b16 %1, %8 offset:2304\n\tds_read_b64_tr_b16 %2, %8 offset:32\n\tds_read_b64_tr_b16 %3, %8 offset:2336\n\t"
                 "ds_read_b64_tr_b16 %4, %8 offset:64\n\tds_read_b64_tr_b16 %5, %8 offset:2368\n\tds_read_b64_tr_b16 %6, %8 offset:96\n\tds_read_b64_tr_b16 %7, %8 offset:2400"
                 : "=&v"(f.a[0]), "=&v"(f.b[0]), "=&v"(f.a[1]), "=&v"(f.b[1]), "=&v"(f.a[2]), "=&v"(f.b[2]), "=&v"(f.a[3]), "=&v"(f.b[3]) : "v"(vaddr) : "memory");
}
DI void vt_wait(VFrag& f) { asm volatile("s_waitcnt lgkmcnt(0)" : "+v"(f.a[0]), "+v"(f.b[0]), "+v"(f.a[1]), "+v"(f.b[1]), "+v"(f.a[2]), "+v"(f.b[2]), "+v"(f.a[3]), "+v"(f.b[3]) :: "memory"); }
DI bf16x8 vt_get(const VFrag& f, int d) { return __builtin_bit_cast(bf16x8, ((u32x4){f.a[d].x, f.a[d].y, f.b[d].x, f.b[d].y})); }
template <int NQT, bool MASKED, class MaskF>
DI void fa_tile(FA<NQT>& st, const bf16x8 (&Q)[NQT][2], const LAS uchar* Ks, const LAS uchar* Vs, int lane, const MaskF& allowed, const bool (&act)[NQT]) {
    const int l15 = lane & 15, quad = lane >> 4;
    float nm_ = st.negM; asm volatile("" : "+v"(nm_));
    f32x4 S[NQT][4]; const f32x4 sinit = (f32x4){nm_, nm_, nm_, nm_};
#pragma unroll
    for (int kt = 0; kt < 4; ++kt) {
        const bf16x8 k0 = *(const LAS bf16x8*)(Ks + (16 * kt + l15) * KROW + quad * 16), k1 = *(const LAS bf16x8*)(Ks + (16 * kt + l15) * KROW + 64 + quad * 16);
#pragma unroll
        for (int q = 0; q < NQT; ++q) if (act[q]) { S[q][kt] = MFMA16(k0, Q[q][0], sinit); S[q][kt] = MFMA16(k1, Q[q][1], S[q][kt]); }
    }
    const unsigned vaddr = (unsigned)(size_t)(Vs + (4 * quad + (l15 >> 2)) * KROW + 8 * (l15 & 3));
    VFrag v0, v1; vt_issue(v0, vaddr);
#pragma unroll
    for (int q = 0; q < NQT; ++q) if (act[q]) {
        float rs = 0.f;
#pragma unroll
        for (int kt = 0; kt < 4; ++kt)
#pragma unroll
            for (int j = 0; j < 4; ++j) { float p = fexp2(S[q][kt][j]); if (MASKED) p = allowed(q, 16 * kt + 4 * quad + j) ? p : 0.f; S[q][kt][j] = p; rs += p; }
        st.l[q] += rs;
    }
    vt_wait(v0); vt_issue(v1, vaddr + 32 * KROW);
#pragma unroll
    for (int q = 0; q < NQT; ++q) if (act[q]) {
        const bf16x8 p0 = pack8(S[q][0], S[q][1]);
#pragma unroll
        for (int d = 0; d < 4; ++d) st.O[q][d] = MFMA16(vt_get(v0, d), p0, st.O[q][d]);
    }
    vt_wait(v1);
#pragma unroll
    for (int q = 0; q < NQT; ++q) if (act[q]) {
        const bf16x8 p1 = pack8(S[q][2], S[q][3]);
#pragma unroll
        for (int d = 0; d < 4; ++d) st.O[q][d] = MFMA16(vt_get(v1, d), p1, st.O[q][d]);
    }
}
template <int NQT> DI void fa_finish(FA<NQT>& st, float (&lse2)[NQT]) {
#pragma unroll
    for (int q = 0; q < NQT; ++q) { float l = st.l[q]; l += __shfl_xor(l, 16); l += __shfl_xor(l, 32); const float inv = l > 0.f ? 1.f / l : 0.f; lse2[q] = __log2f(fmaxf(l, 1e-37f));
#pragma unroll
        for (int d = 0; d < 4; ++d) st.O[q][d] = st.O[q][d] * inv; }
}
DI float score_bound(const float* gq, const float* gk, int lane) {
    float a = fabsf(gq[lane & 63]), b = fabsf(gk[lane & 63]);
#pragma unroll
    for (int o = 1; o < 64; o <<= 1) { a = fmaxf(a, __shfl_xor(a, o)); b = fmaxf(b, __shfl_xor(b, o)); }
    return __builtin_bit_cast(float, __builtin_amdgcn_readfirstlane(__builtin_bit_cast(int, 64.f * a * b * QSCALE * 1.02f + 0.5f)));
}
DI void kv_store(LAS uchar* Ks, LAS uchar* Vs, int tid, const u32x4& kr, const u32x4& vr) {
    const int o = (tid >> 3) * KROW + (tid & 7) * 16; *(LAS u32x4*)(Ks + o) = kr; *(LAS u32x4*)(Vs + o) = vr;
}
DI void q_load(bf16x8 (&Q)[2], const bf16* qrow, int quad) { Q[0] = *(const bf16x8*)(qrow + 8 * quad); Q[1] = *(const bf16x8*)(qrow + 32 + 8 * quad); }

struct DilMask { int qi[2]; int k0; DI bool operator()(int q, int key) const { const int ki = k0 + key, d = qi[q] - ki; return ki >= 0 && (unsigned)d <= 128u; } };
DI void dil_unit(const Ctx& C, int unit, LAS uchar* lds0, LAS uchar*  , float negM_bound) {
    const bf16 *QC = WSP(bf16, R_QC), *KC = WSP(bf16, R_KC), *PROJ = WSP(bf16, R_PROJ); float* OC = WSP(float, R_OC); float* LSE = WSP(float, R_LSE);
    int tid = C.tid, lane = C.lane; asm volatile("" : "+v"(tid), "+v"(lane));
    const int w = C.wave, l15 = lane & 15, quad = lane >> 4, wq = w & 3;
    const int cfg = unit / 512, r = unit % 512, dsh = 2 * cfg, d = 1 << dsh;
    const int b = r >> 6, hp = (r >> 5) & 1, r2 = r & 31;
    const int nblk = 32 >> dsh, res = r2 / nblk, blk = r2 % nblk, i0 = blk * 128, h = 2 * hp + (w >> 2);
    const size_t tb = (size_t)b * NS;
    bf16x8 Q[2][2]; DilMask mk; FA<2> st; fa_init(st); st.negM = -negM_bound;
#pragma unroll
    for (int q = 0; q < 2; ++q) { mk.qi[q] = i0 + 32 * wq + 16 * q + l15; q_load(Q[q], QC + (tb + res + (size_t)d * mk.qi[q]) * 256 + h * 64, quad); }
    const int jlo = wq >> 1, jhi = (wq >> 1) + 2;
    const bool act[2] = {true, true};
    u32x4 kr0, vr0, kr1, vr1;
#define DIL_LOAD(j) do { const int ki = i0 - 128 + 64 * (j) + (tid >> 3); kr0 = (u32x4){0u, 0u, 0u, 0u}; vr0 = kr0; kr1 = kr0; vr1 = kr0; \
    if (ki >= 0) { const size_t rowk = tb + res + (size_t)d * ki; const bf16* kp = KC + rowk * 256 + 128 * hp + (tid & 7) * 8; const bf16* vp = PROJ + rowk * NPJ + PJ_C + 512 + 128 * hp + (tid & 7) * 8; \
        kr0 = *(const u32x4*)kp; kr1 = *(const u32x4*)(kp + 64); vr0 = *(const u32x4*)vp; vr1 = *(const u32x4*)(vp + 64); } } while (0)
#define DIL_STORE(p) do { LAS uchar* b_ = lds0 + (p) * 4 * KT_BYTES; kv_store(b_, b_ + KT_BYTES, tid, kr0, vr0); kv_store(b_ + 2 * KT_BYTES, b_ + 3 * KT_BYTES, tid, kr1, vr1); } while (0)
    DIL_LOAD(0); __syncthreads(); DIL_STORE(0); DIL_LOAD(1);
    for (int j = 0; j < 4; ++j) {
        __syncthreads();
        if (j + 1 < 4) DIL_STORE((j + 1) & 1);
        if (j + 2 < 4) DIL_LOAD(j + 2);
        if (j >= jlo && j <= jhi) { mk.k0 = i0 - 128 + 64 * j; const LAS uchar* kb = lds0 + (j & 1) * 4 * KT_BYTES + (w >> 2) * 2 * KT_BYTES; fa_tile<2, true>(st, Q, kb, kb + KT_BYTES, lane, mk, act); }
    }
#undef DIL_LOAD
#undef DIL_STORE
    float lse2[2]; fa_finish<2>(st, lse2);
#pragma unroll
    for (int q = 0; q < 2; ++q) { const size_t rowq = tb + res + (size_t)d * mk.qi[q]; bf16* o = (bf16*)OC + ((size_t)cfg * NT + rowq) * 256 + h * 64 + 4 * quad;
#pragma unroll
        for (int dt = 0; dt < 4; ++dt) { u32x2 w_; w_.x = pk2(st.O[q][dt][0], st.O[q][dt][1]); w_.y = pk2(st.O[q][dt][2], st.O[q][dt][3]); *(u32x2*)(o + 16 * dt) = w_; }
        if (quad == 0) LSE[((size_t)cfg * NT + rowq) * 4 + h] = lse2[q]; }
}
constexpr int NSA_KC = 0, NSA_VC = 256 * KROW, NSA_KT = 2 * 256 * KROW, NSA_VT = NSA_KT + KT_BYTES, NSA_IMP = NSA_KT + 4 * KT_BYTES,
    NSA_SELM = NSA_IMP + 64 * 64 * 4, NSA_UW = NSA_SELM + 512;
static_assert(NSA_UW + 16 <= RING_BYTES, "NSA LDS map");
DI void cmp_mlp_wait(const Ctx& C, int l);
struct SwaMask { int t[2]; int k0; DI bool operator()(int q, int key) const { const int d = t[q] - (k0 + key); return (unsigned)d <= 511u; } };
struct SlcMask { int t[2]; int k0; bool sel[2]; DI bool operator()(int q, int key) const { return sel[q] && (k0 + key <= t[q]); } };
struct NoMask { DI bool operator()(int, int) const { return true; } };
DI void nsa_unit(const Ctx& C, int l, int b, int tbk, int& bl, bool& cmp_ready, float bnd_cmp, float bnd_slc, float bnd_swa) {
    const bf16 *QN = WSP(bf16, R_QN), *QR = WSP(bf16, R_QR), *KSb = WSP(bf16, R_KS), *KWb = WSP(bf16, R_KW), *PROJ = WSP(bf16, R_PROJ); const float* CMP = WSP(float, R_CMP); const float* GATE = WSP(float, R_GATE);
    bf16* YCAT = WSP(bf16, R_YCAT);
    LAS uchar* Kc = C.lds + NSA_KC; LAS uchar* Vc = C.lds + NSA_VC; LAS uchar* Ks = C.lds + NSA_KT; LAS uchar* Vs = C.lds + NSA_VT;
    LAS float* imps = (LAS float*)(C.lds + NSA_IMP); LAS unsigned* selm = (LAS unsigned*)(C.lds + NSA_SELM); LAS unsigned* uw = (LAS unsigned*)(C.lds + NSA_UW);
    int tid = C.tid, lane = C.lane; asm volatile("" : "+v"(tid), "+v"(lane));
    const int w = C.wave, l15 = lane & 15, quad = lane >> 4, head = l15 & 3, t0 = 64 * tbk; const size_t tb = (size_t)b * NS;
    __syncthreads();
    if (b != bl) {
        if (!cmp_ready) { cmp_mlp_wait(C, l); cmp_ready = true; }
        const int key = tid >> 1, hf = tid & 1; const float* kp = CMP + ((size_t)b * 256 + key) * 64 + 32 * hf; const float* vp = CMP + ((size_t)2048 + (size_t)b * 256 + key) * 64 + 32 * hf;
        float kv[32], vv[32]; float ss = 0.f;
#pragma unroll
        for (int i = 0; i < 8; ++i) { const f32x4 a = *(const f32x4*)(kp + 4 * i), c = *(const f32x4*)(vp + 4 * i);
#pragma unroll
            for (int j = 0; j < 4; ++j) { kv[4 * i + j] = a[j]; vv[4 * i + j] = c[j]; ss += a[j] * a[j]; } }
        ss += __shfl_xor(ss, 1); const float rstd = rsqrtf(ss * (1.f / 64.f) + 1e-6f); const float* g = C.nsa_kc_g + (size_t)l * 64 + 32 * hf; const bool dead = (key == 255);
#pragma unroll
        for (int i = 0; i < 4; ++i) { u32x4 o, p;
            o.x = pk2(kv[8 * i] * rstd * g[8 * i], kv[8 * i + 1] * rstd * g[8 * i + 1]); o.y = pk2(kv[8 * i + 2] * rstd * g[8 * i + 2], kv[8 * i + 3] * rstd * g[8 * i + 3]);
            o.z = pk2(kv[8 * i + 4] * rstd * g[8 * i + 4], kv[8 * i + 5] * rstd * g[8 * i + 5]); o.w = pk2(kv[8 * i + 6] * rstd * g[8 * i + 6], kv[8 * i + 7] * rstd * g[8 * i + 7]);
            p.x = pk2(vv[8 * i], vv[8 * i + 1]); p.y = pk2(vv[8 * i + 2], vv[8 * i + 3]); p.z = pk2(vv[8 * i + 4], vv[8 * i + 5]); p.w = pk2(vv[8 * i + 6], vv[8 * i + 7]);
            if (dead) { o = (u32x4){0u, 0u, 0u, 0u}; p = o; }
            *(LAS u32x4*)(Kc + key * KROW + hf * 64 + i * 16) = o; *(LAS u32x4*)(Vc + key * KROW + hf * 64 + i * 16) = p; }
        bl = b;
        __syncthreads();
    }
    f32x4 Oc[2][4];
    const int cmaxu = (t0 + 32) >> 4, ktmax = cmaxu >> 4;
    const unsigned vaddr0 = (unsigned)(size_t)(Vc + (4 * quad + (l15 >> 2)) * KROW + 8 * (l15 & 3));
#pragma unroll
    for (int q = 0; q < 2; ++q) {
        const int t = t0 + 8 * w + 4 * q + (l15 >> 2);
        bf16x8 Q[2]; q_load(Q, QN + (tb + t) * 256 + head * 64, quad);
        float nm_ = -bnd_cmp; asm volatile("" : "+v"(nm_)); f32x4 S[16]; const f32x4 sinit = (f32x4){nm_, nm_, nm_, nm_}; float ls = 0.f;
#pragma unroll
        for (int kt = 0; kt < 16; ++kt) {
            if (kt <= ktmax) {
                const bf16x8 k0 = *(const LAS bf16x8*)(Kc + (16 * kt + l15) * KROW + quad * 16), k1 = *(const LAS bf16x8*)(Kc + (16 * kt + l15) * KROW + 64 + quad * 16);
                S[kt] = MFMA16(k0, Q[0], sinit); S[kt] = MFMA16(k1, Q[1], S[kt]);
#pragma unroll
                for (int j = 0; j < 4; ++j) { const int c = 16 * kt + 4 * quad + j; const float p = (16 * c + 31 <= t) ? fexp2(S[kt][j]) : 0.f; S[kt][j] = p; ls += p; }
            } else S[kt] = (f32x4){0.f, 0.f, 0.f, 0.f};
        }
        ls += __shfl_xor(ls, 16); ls += __shfl_xor(ls, 32);
        const float inv = ls > 0.f ? 1.f / ls : 0.f;
#pragma unroll
        for (int kt = 0; kt < 16; ++kt) S[kt] = S[kt] * inv;
#pragma unroll
        for (int kt = 0; kt < 16; ++kt) {
            const float send = (quad == 3) ? (kt > 0 ? S[kt > 0 ? kt - 1 : 0][3] : 0.f) : S[kt][3];
            const float prev = __shfl(send, (lane + 48) & 63);
            float v = ((quad == 0 && kt == 0) ? 0.f : prev) + 2.f * (S[kt][0] + S[kt][1] + S[kt][2]) + S[kt][3];
            v = group_sum<4>(v);
            if (head == 0) imps[(8 * w + 4 * q + (l15 >> 2)) * 64 + 4 * kt + quad] = v;
        }
#pragma unroll
        for (int d = 0; d < 4; ++d) Oc[q][d] = (f32x4){0.f, 0.f, 0.f, 0.f};
#pragma unroll
        for (int ks = 0; ks < 8; ++ks) {
            if (2 * ks <= ktmax) {
                VFrag vf; vt_issue(vf, vaddr0 + ks * 32 * KROW); const bf16x8 pf = pack8(S[2 * ks], S[2 * ks + 1]); vt_wait(vf);
#pragma unroll
                for (int d = 0; d < 4; ++d) Oc[q][d] = MFMA16(vt_get(vf, d), pf, Oc[q][d]);
            }
        }
    }
    {
        float* OCm = WSP(float, R_OCMP);
#pragma unroll
        for (int q = 0; q < 2; ++q) { float* o = OCm + (tb + t0 + 8 * w + 4 * q + (l15 >> 2)) * 256 + head * 64 + 4 * quad;
#pragma unroll
            for (int d = 0; d < 4; ++d) *(f32x4*)(o + 16 * d) = Oc[q][d]; }
    }
    __syncthreads();
    if (tid < 64) {
        const int cur = tbk; unsigned long long mask;
        if (cur <= 15) mask = (2ull << cur) - 1ull;
        else {
            mask = 1ull | (1ull << cur) | (1ull << (cur - 1));
            float v[64];
#pragma unroll
            for (int i = 0; i < 16; ++i) { const f32x4 a = *(const LAS f32x4*)(imps + tid * 64 + 4 * i);
#pragma unroll
                for (int j = 0; j < 4; ++j) { const int jb = 4 * i + j; v[jb] = (jb >= 1 && jb <= cur - 2) ? a[j] : -1.f; } }
#pragma unroll 1
            for (int r = 0; r < 13; ++r) {
                float bv = -0.5f; int bi = 0;
#pragma unroll
                for (int jb = 0; jb < 64; ++jb) if (v[jb] > bv) { bv = v[jb]; bi = jb; }
                mask |= 1ull << bi;
#pragma unroll
                for (int jb = 0; jb < 64; ++jb) v[jb] = (jb == bi) ? -1.f : v[jb];
            }
        }
        unsigned lo = (unsigned)mask, hi = (unsigned)(mask >> 32);
        selm[2 * tid] = lo; selm[2 * tid + 1] = hi;
#pragma unroll
        for (int o = 1; o < 64; o <<= 1) { lo |= __shfl_xor(lo, o); hi |= __shfl_xor(hi, o); }
        if (tid == 0) { uw[0] = lo; uw[1] = hi; }
    }
    __syncthreads();
    unsigned long long U = ((unsigned long long)uw[1] << 32) | uw[0];
    bf16x8 Q[2][2]; SlcMask mk; FA<2> st; fa_init(st); st.negM = -bnd_slc; unsigned long long msk[2];
#pragma unroll
    for (int q = 0; q < 2; ++q) { const int tl = 8 * w + 4 * q + (l15 >> 2); mk.t[q] = t0 + tl; msk[q] = ((unsigned long long)selm[2 * tl + 1] << 32) | selm[2 * tl]; q_load(Q[q], QR + (tb + mk.t[q]) * 256 + head * 64, quad); }
    unsigned long long QM[2];
#pragma unroll
    for (int q = 0; q < 2; ++q) { unsigned lo = (unsigned)msk[q], hi = (unsigned)(msk[q] >> 32);
#pragma unroll
        for (int o = 1; o < 64; o <<= 1) { lo |= __shfl_xor(lo, o); hi |= __shfl_xor(hi, o); }
        QM[q] = ((unsigned long long)hi << 32) | lo; }
#ifndef PROBE_SLC2
#define PROBE_SLC2 0
#endif
#ifndef PROBE_SWA2
#define PROBE_SWA2 0
#endif
    u32x4 kr, vr; const unsigned long long U0 = U;
    for (int prep_ = 0; prep_ <= PROBE_SLC2; ++prep_) { U = U0; if (prep_ < PROBE_SLC2) { fa_init(st); }
#define SLC_LOAD(j) do { const size_t rowk = tb + 64 * (j) + (tid >> 3); kr = *(const u32x4*)(KSb + rowk * 64 + (tid & 7) * 8); vr = *(const u32x4*)(PROJ + rowk * NPJ + 3008 + (tid & 7) * 8); } while (0)
    {
        int j = __builtin_ctzll(U); U &= U - 1ull;
        int jn = U ? __builtin_ctzll(U) : -1; U &= U - 1ull;
        SLC_LOAD(j); __syncthreads(); kv_store(Ks, Vs, tid, kr, vr); if (jn >= 0) SLC_LOAD(jn);
        for (int it = 0;; ++it) {
            __syncthreads();
            const int jnn = U ? __builtin_ctzll(U) : -1; U &= U - 1ull;
            if (jn >= 0) kv_store(Ks + ((it + 1) & 1) * 2 * KT_BYTES, Vs + ((it + 1) & 1) * 2 * KT_BYTES, tid, kr, vr);
            if (jnn >= 0) SLC_LOAD(jnn);
            const bool act[2] = {(bool)((QM[0] >> j) & 1ull), (bool)((QM[1] >> j) & 1ull)};
            if (act[0] || act[1]) { mk.k0 = 64 * j; mk.sel[0] = (msk[0] >> j) & 1ull; mk.sel[1] = (msk[1] >> j) & 1ull; fa_tile<2, true>(st, Q, Ks + (it & 1) * 2 * KT_BYTES, Vs + (it & 1) * 2 * KT_BYTES, lane, mk, act); }
            if (jn < 0) break; j = jn; jn = jnn;
        }
    }
#undef SLC_LOAD
    }
    float lse2[2]; fa_finish<2>(st, lse2);
    {   float* OSl = WSP(float, R_OSLC);
#pragma unroll
        for (int q = 0; q < 2; ++q) { float* o = OSl + (tb + mk.t[q]) * 256 + head * 64 + 4 * quad;
#pragma unroll
            for (int d = 0; d < 4; ++d) *(f32x4*)(o + 16 * d) = st.O[q][d]; }
    }
    FA<2> sw; fa_init(sw); sw.negM = -bnd_swa; SwaMask mw; mw.t[0] = mk.t[0]; mw.t[1] = mk.t[1];
    for (int prep_ = 0; prep_ <= PROBE_SWA2; ++prep_) { if (prep_ < PROBE_SWA2) fa_init(sw);
    {
        const int j0 = tbk >= 8 ? tbk - 8 : 0; const bool act[2] = {true, true};
#define SWA_LOAD(j) do { const size_t rowk = tb + 64 * (j) + (tid >> 3); kr = *(const u32x4*)(KWb + rowk * 64 + (tid & 7) * 8); vr = *(const u32x4*)(PROJ + rowk * NPJ + 3136 + (tid & 7) * 8); } while (0)
        SWA_LOAD(j0); __syncthreads(); kv_store(Ks, Vs, tid, kr, vr); if (j0 + 1 <= tbk) SWA_LOAD(j0 + 1);
        for (int j = j0; j <= tbk; ++j) {
            const int pb_ = (j - j0) & 1;
            __syncthreads();
            if (j + 1 <= tbk) kv_store(Ks + (pb_ ^ 1) * 2 * KT_BYTES, Vs + (pb_ ^ 1) * 2 * KT_BYTES, tid, kr, vr);
            if (j + 2 <= tbk) SWA_LOAD(j + 2);
            mw.k0 = 64 * j;
            if (j == tbk || j == tbk - 8) fa_tile<2, true>(sw, Q, Ks + pb_ * 2 * KT_BYTES, Vs + pb_ * 2 * KT_BYTES, lane, mw, act);
            else fa_tile<2, false>(sw, Q, Ks + pb_ * 2 * KT_BYTES, Vs + pb_ * 2 * KT_BYTES, lane, NoMask(), act);
        }
#undef SWA_LOAD
    }
    }
    fa_finish<2>(sw, lse2);
#pragma unroll
    for (int q = 0; q < 2; ++q) {
        const size_t row = tb + mk.t[q]; const float* gp = GATE + row * 12 + head * 3; const float g0 = gp[0], g1 = gp[1], g2 = gp[2];
        f32x4 o[4]; float ss = 0.f; const float* pc = WSP(float, R_OCMP) + row * 256 + head * 64 + 4 * quad; const float* ps = WSP(float, R_OSLC) + row * 256 + head * 64 + 4 * quad;
#pragma unroll
        for (int d = 0; d < 4; ++d) { o[d] = *(const f32x4*)(pc + 16 * d) * g0 + *(const f32x4*)(ps + 16 * d) * g1 + sw.O[q][d] * g2; ss += (o[d][0] * o[d][0] + o[d][1] * o[d][1]) + (o[d][2] * o[d][2] + o[d][3] * o[d][3]); }
        ss += __shfl_xor(ss, 16); ss += __shfl_xor(ss, 32);
        const float rstd = rsqrtf(ss * (1.f / 64.f) + 1e-6f); const float* og = C.onorm_g + (size_t)l * 768 + 512 + head * 64 + 4 * quad;
        bf16* yo = YCAT + row * DM + 768 + head * 64 + 4 * quad;
#pragma unroll
        for (int d = 0; d < 4; ++d) { const f32x4 g4 = *(const f32x4*)(og + 16 * d); u32x2 wv; wv.x = pk2(o[d][0] * rstd * g4[0], o[d][1] * rstd * g4[1]); wv.y = pk2(o[d][2] * rstd * g4[2], o[d][3] * rstd * g4[3]); *(u32x2*)(yo + 16 * d) = wv; }
    }
}

DI void fin_phase(const Ctx& C, int l) {
    const bf16* SCH = WSP(bf16, R_SCH); const float* YA = WSP(float, R_YA); const bf16* Gb = WSP(bf16, R_G); const float* OC = WSP(float, R_OC); const float* LSE = WSP(float, R_LSE);
    const float* UB = WSP(float, R_SCANU); const float* SMT = WSP(float, R_SCANS); bf16* YCAT = WSP(bf16, R_YCAT);
    const int lane = C.lane, ch = 4 * lane, hh = lane >> 4;
    LAS float* sm = (LAS float*)C.lds;
    LAS float* us = sm + 4 * 4096 + C.wave * 512;
    const f32x4 rk = *(const f32x4*)(C.rk + (size_t)l * 256 + ch), gw4 = *(const f32x4*)(C.gn_w + (size_t)l * 256 + ch), gb4 = *(const f32x4*)(C.gn_b + (size_t)l * 256 + ch);
    const f32x4 og = *(const f32x4*)(C.onorm_g + (size_t)l * 768 + 256 + ch);
    int bl = -1;
    for (int it = C.bid; it < NT / 128; it += C.G) {
        const int b = it >> 5, kk = it & 31;
        if (b != bl) { __syncthreads(); for (int i = C.tid; i < 4096; i += NTHR) *(LAS f32x4*)(sm + 4 * i) = *(const f32x4*)(SMT + (size_t)b * 4 * 4096 + 4 * i); bl = b; __syncthreads(); }
#pragma unroll 4
        for (int r = 0; r < 16; ++r) {
            const int row = b * NS + (r >> 3) * (NS / 2) + 64 * kk + C.wave * 8 + (r & 7); const size_t o = (size_t)row * 256 + ch;
            const float l0 = LSE[(size_t)row * 4 + hh], l1 = LSE[((size_t)NT + row) * 4 + hh], l2 = LSE[((size_t)2 * NT + row) * 4 + hh];
            const bf16* ocb = (const bf16*)OC; const u32x2 a_ = *(const u32x2*)(ocb + o), b_ = *(const u32x2*)(ocb + (size_t)NT * 256 + o), c_ = *(const u32x2*)(ocb + (size_t)2 * NT * 256 + o);
            const f32x4 a = (f32x4){bflo(a_.x), bfhi(a_.x), bflo(a_.y), bfhi(a_.y)}, bq = (f32x4){bflo(b_.x), bfhi(b_.x), bflo(b_.y), bfhi(b_.y)}, c = (f32x4){bflo(c_.x), bfhi(c_.x), bflo(c_.y), bfhi(c_.y)};
            const float mx = fmaxf(l0, fmaxf(l1, l2)); float w0 = fexp2(l0 - mx), w1 = fexp2(l1 - mx), w2 = fexp2(l2 - mx); const float inv = __builtin_amdgcn_rcpf(w0 + w1 + w2); w0 *= inv; w1 *= inv; w2 *= inv;
            const f32x4 y = a * w0 + bq * w1 + c * w2;
            const float ss = group_sum<16>((y[0] * y[0] + y[1] * y[1]) + (y[2] * y[2] + y[3] * y[3])); const float rstd = rsqrtf(ss * (1.f / 64.f) + 1e-6f);
            u32x2 w; w.x = pk2(y[0] * rstd * og[0], y[1] * rstd * og[1]); w.y = pk2(y[2] * rstd * og[2], y[3] * rstd * og[3]); *(u32x2*)(YCAT + (size_t)row * DM + 512 + ch) = w;
        }
#pragma unroll 1
        for (int hf = 0; hf < 2; ++hf) {
#pragma unroll 2
            for (int r = 0; r < 8; ++r) {
                const int row = b * NS + hf * (NS / 2) + 64 * kk + C.wave * 8 + r, s = row % NS; const size_t o = (size_t)row * 256 + ch;
                f32x4 y = *(const f32x4*)(YA + o); const u32x2 rr_ = *(const u32x2*)(SCH + (size_t)3 * NT * 256 + o), k_ = *(const u32x2*)(SCH + o), v_ = *(const u32x2*)(SCH + (size_t)4 * NT * 256 + o), g_ = *(const u32x2*)(Gb + o);
                const f32x4 rr = (f32x4){bflo(rr_.x), bfhi(rr_.x), bflo(rr_.y), bfhi(rr_.y)}, k = (f32x4){bflo(k_.x), bfhi(k_.x), bflo(k_.y), bfhi(k_.y)}, v = (f32x4){bflo(v_.x), bfhi(v_.x), bflo(v_.y), bfhi(v_.y)}, g = (f32x4){bflo(g_.x), bfhi(g_.x), bflo(g_.y), bfhi(g_.y)};
                if (hf == 1) {
                    LAS float* ub = us + (r & 1) * 256;
                    *(LAS f32x4*)(ub + ch) = *(const f32x4*)(UB + ((size_t)b * (NS / 2) + (s - NS / 2)) * 256 + ch);
                    asm volatile("s_waitcnt lgkmcnt(0)" ::: "memory");
                    const LAS float* sp = sm + hh * 4096 + 4 * (lane & 15); const LAS float* up = ub + hh * 64;
#pragma unroll 8
                    for (int j4 = 0; j4 < 16; ++j4) { const f32x4 u4 = *(const LAS f32x4*)(up + 4 * j4);
#pragma unroll
                        for (int jj = 0; jj < 4; ++jj) y += *(const LAS f32x4*)(sp + (4 * j4 + jj) * 64) * u4[jj]; }
                }
                const float mu = group_sum<16>((y[0] + y[1]) + (y[2] + y[3])) * (1.f / 64.f);
                const f32x4 dy = y - mu; const float var = group_sum<16>((dy[0] * dy[0] + dy[1] * dy[1]) + (dy[2] * dy[2] + dy[3] * dy[3])) * (1.f / 64.f);
                const float rstd = rsqrtf(var + 64e-5f);
                const float dot = group_sum<16>((rr[0] * k[0] * rk[0] + rr[1] * k[1] * rk[1]) + (rr[2] * k[2] * rk[2] + rr[3] * k[3] * rk[3]));
                float out[4];
#pragma unroll
                for (int i = 0; i < 4; ++i) out[i] = ((dy[i] * rstd * gw4[i] + gb4[i]) + dot * v[i]) * g[i];
                u32x2 w; w.x = pk2(out[0], out[1]); w.y = pk2(out[2], out[3]); *(u32x2*)(YCAT + (size_t)row * DM + ch) = w;
            }
        }
    }
    __syncthreads();
}

constexpr int CW_Q = 40000;
DI int q_next(const Ctx& C, unsigned* ctr, LAS int* slot) {
    __syncthreads();
    if (C.tid == 0) *slot = (int)__hip_atomic_fetch_add(ctr, 1u, __ATOMIC_RELAXED, __HIP_MEMORY_SCOPE_AGENT);
    __syncthreads();
    return *slot;
}
DI void conv_ticket(const Ctx& C, int l, int tk);
constexpr int CW_CD = 41000;
DI void cmp_mlp_unit(const Ctx& C, int l, int cb) {
    const int kv = cb >> 3;
    { pg8::Gemm g{kv ? WSP(bf16, R_VCR) : WSP(bf16, R_KCR), WSP(bf16, WS_WK1) + (size_t)(l * 2 + kv) * 256 * 2048, 1024, 2048}; pg8::StaticOrder S; S.init(8, 1, 8, cb & 7);
      EpiC1 E{WSP(bf16, R_CH1) + (size_t)kv * 2048 * 256, (WSP(float, WS_SMALL) + NLAYER * 8 * 6144 + l * 512 + kv * 256)}; pg8::gemm_phase(C.lds, C.tid, g, S, E); }
    asm volatile("s_waitcnt vmcnt(0)" ::: "memory"); __syncthreads();
    { pg8::Gemm g{WSP(bf16, R_CH1) + (size_t)kv * 2048 * 256, WSP(bf16, WS_WK2) + (size_t)(l * 2 + kv) * 256 * 256, 256, 256}; pg8::StaticOrder S; S.init(8, 1, 8, cb & 7);
      EpiC2 E{WSP(float, R_CMP) + (size_t)kv * 2048 * 64}; pg8::gemm_phase(C.lds, C.tid, g, S, E); }
    asm volatile("s_waitcnt vmcnt(0)" ::: "memory"); __syncthreads();
    if (C.tid == 0) { __builtin_amdgcn_fence(__ATOMIC_RELEASE, "agent"); asm volatile("s_waitcnt vmcnt(0)" ::: "memory");
        __hip_atomic_fetch_add(WSP(unsigned, WS_CTL) + CW_CD + 64 * l, 1u, __ATOMIC_RELAXED, __HIP_MEMORY_SCOPE_AGENT); }
}
DI void cmp_mlp_wait(const Ctx& C, int l) {
    if (C.tid == 0) { unsigned* c = WSP(unsigned, WS_CTL) + CW_CD + 64 * l; unsigned sp = 0u;
        while (__hip_atomic_load(c, __ATOMIC_RELAXED, __HIP_MEMORY_SCOPE_AGENT) < 16u) { __builtin_amdgcn_s_sleep(8); if (++sp > (1u << 21)) break; }
        __builtin_amdgcn_fence(__ATOMIC_ACQUIRE, "agent"); asm volatile("s_waitcnt vmcnt(0)" ::: "memory"); }
    __syncthreads();
}
DI void mix_phase(const Ctx& C, int l, int rep) {
    unsigned* ctl = WSP(unsigned, WS_CTL) + CW_Q + 64 * 3 * (l + 2 * rep); LAS int* slot = (LAS int*)(C.lds + MISC_OFF + 1024);
#ifndef PROBE_SPLIT
#define PROBE_SPLIT 0
#endif
    if (C.bid < 96) { scan_unit8(C, C.bid); if (PROBE_SCAN2) scan_unit8(C, C.bid); }
    else if (C.bid < 112) cmp_mlp_unit(C, l, C.bid - 96);
    bool cmp_ready = false;
    if (PROBE_SPLIT) { asm volatile("s_waitcnt vmcnt(0)" ::: "memory"); __syncthreads(); { XcdBarrier bar2; bar2.bar = WSP(unsigned, WS_CTL) + CW_BAR; bar2.x = xb_xcc_id(); bar2.st = (volatile LAS unsigned*)(C.lds + MISC_OFF); xcd_barrier(bar2); } }
    int bl = -1;
    const float bnd_cmp = score_bound(C.nsa_q_g + (size_t)l * 64, C.nsa_kc_g + (size_t)l * 64, C.lane), bnd_slc = score_bound(C.nsa_q_g + (size_t)l * 64, C.nsa_ks_g + (size_t)l * 64, C.lane),
                bnd_swa = score_bound(C.nsa_q_g + (size_t)l * 64, C.nsa_kw_g + (size_t)l * 64, C.lane), bnd_dil = score_bound(C.dil_q_g + (size_t)l * 64, C.dil_k_g + (size_t)l * 64, C.lane);
    bool conv_left = true;
#define CONV_ONE() do { if (conv_left) { const int t_ = q_next(C, ctl + 128, slot); if (t_ >= 768 * (1 + PROBE_CONV2)) conv_left = false; else { conv_ticket(C, l, t_ % 768); bl = -1; } } } while (0)
    for (;;) { const int u = q_next(C, ctl, slot); if (u >= 512 * (1 + PROBE_ATT2)) break; nsa_unit(C, l, u & 7, 63 - ((u & 511) >> 3), bl, cmp_ready, bnd_cmp, bnd_slc, bnd_swa); CONV_ONE(); }
    for (int n = 0;; ++n) { const int u = q_next(C, ctl + 64, slot); if (u >= 1536 * (1 + PROBE_ATT2)) break; dil_unit(C, u % 1536, C.lds, C.lds + KT_BYTES, bnd_dil); if ((n & 3) == 3) CONV_ONE(); }
    while (conv_left) CONV_ONE();
#undef CONV_ONE if (C.bid >= 96)
    __syncthreads();
}
#define MFMA_F32(a, b, c) __builtin_amdgcn_mfma_f32_16x16x4f32((a), (b), (c), 0, 0, 0)
DI void router_phase(const Ctx& C, int l) {
    const float* X = C.out; const float* MOD = WSP(float, WS_SMALL) + (size_t)l * 8 * 6144; unsigned char* H8 = WSP(unsigned char, R_XS);
    int* TOPE = WSP(int, WS_ROUTE); float* TOPG = (float*)(TOPE + NT * 4); unsigned* CNTB = WSP(unsigned, WS_CTL) + CW_CNT + l * 8192;
    LAS float* wl = (LAS float*)C.lds;
    LAS float* lg = (LAS float*)(C.lds + MISC_OFF + 8192) + C.wave * 512;
    LAS unsigned* hist = (LAS unsigned*)(C.lds + MISC_OFF + 6144);
    LAS float* rs = (LAS float*)(C.lds + MISC_OFF + 6400) + C.wave * 16;
    const int lane = C.lane, l15 = lane & 15, quad = lane >> 4, gw = C.bid * NWAVE + C.wave, NGW = C.G * NWAVE;
    const float* wr = C.w_router + (size_t)l * 1024 * 32; const float* g2 = C.norm2_g + (size_t)l * DM;
    __syncthreads();
    if (C.tid < 32) hist[C.tid] = 0u;
    for (int i = C.tid; i < 8192; i += NTHR) { const int k = i >> 3, e4 = (i & 7) * 4; const f32x4 v = *(const f32x4*)(wr + (size_t)k * 32 + e4); LAS float* d = wl + ((k >> 2) * 32 + e4) * 4 + (k & 3);
        d[0] = v[0]; d[4] = v[1]; d[8] = v[2]; d[12] = v[3]; }
    __syncthreads();
    for (int task = gw; task < NT / 16; task += NGW) {
        const int row0 = 16 * task, b = row0 / NS;
        const float* shb = MOD + (size_t)b * 6144 + 3072; const float* scb = shb + 1024;
        {
            f32x4 gg[4], sa[4], sb[4];
#pragma unroll
            for (int j = 0; j < 4; ++j) { const int k = 4 * lane + 256 * j; const f32x4 g = *(const f32x4*)(g2 + k), a = *(const f32x4*)(scb + k); gg[j] = g * (a + 1.f); sb[j] = *(const f32x4*)(shb + k); }
#pragma unroll 4
            for (int r = 0; r < 16; ++r) {
                const float* xr = X + (size_t)(row0 + r) * DM + 4 * lane; f32x4 v[4]; float ss = 0.f;
#pragma unroll
                for (int j = 0; j < 4; ++j) { v[j] = *(const f32x4*)(xr + 256 * j); ss += (v[j][0] * v[j][0] + v[j][1] * v[j][1]) + (v[j][2] * v[j][2] + v[j][3] * v[j][3]); }
                ss = group_sum<64>(ss); const float rstd = rsqrtf(ss * (1.f / DM) + 1e-6f);
                if (lane == 0) rs[r] = rstd;
                unsigned char* hp = H8 + (size_t)(row0 + r) * DM + 4 * lane;
#pragma unroll
                for (int j = 0; j < 4; ++j) { const f32x4 h = v[j] * rstd * gg[j] + sb[j]; *(unsigned*)(hp + 256 * j) = pk4_fp8(h[0], h[1], h[2], h[3]); }
            }
        }
        const float* xr = X + (size_t)(row0 + l15) * DM + 4 * quad; const float* sh = shb + 4 * quad; const float* sc = scb + 4 * quad;
        asm volatile("s_waitcnt lgkmcnt(0)" ::: "memory");
        const float rstd = rs[l15];
        f32x4 acc0 = (f32x4){0.f, 0.f, 0.f, 0.f}, acc1 = acc0;
#pragma unroll 2
        for (int i = 0; i < 64; ++i) {
            const f32x4 a = *(const f32x4*)(xr + 16 * i), g = *(const f32x4*)(g2 + 16 * i + 4 * quad), s1 = *(const f32x4*)(sc + 16 * i), s0 = *(const f32x4*)(sh + 16 * i);
            f32x4 h;
#pragma unroll
            for (int j = 0; j < 4; ++j) h[j] = a[j] * rstd * g[j] * (1.f + s1[j]) + s0[j];
            const LAS float* wp = wl + ((4 * i + quad) * 32 + l15) * 4; const f32x4 w0 = *(const LAS f32x4*)wp, w1 = *(const LAS f32x4*)(wp + 64);
#pragma unroll
            for (int j = 0; j < 4; ++j) { acc0 = MFMA_F32(h[j], w0[j], acc0); acc1 = MFMA_F32(h[j], w1[j], acc1); }
        }
        const float b0 = C.b_router[l * 32 + l15], b1 = C.b_router[l * 32 + 16 + l15];
#pragma unroll
        for (int j = 0; j < 4; ++j) { lg[(4 * quad + j) * 32 + l15] = acc0[j] + b0; lg[(4 * quad + j) * 32 + 16 + l15] = acc1[j] + b1; }
        asm volatile("s_waitcnt lgkmcnt(0)" ::: "memory");
        if (lane < 16) {
            float v[32];
#pragma unroll
            for (int i = 0; i < 8; ++i) { const f32x4 a = *(const LAS f32x4*)(lg + lane * 32 + 4 * i); v[4 * i] = a[0]; v[4 * i + 1] = a[1]; v[4 * i + 2] = a[2]; v[4 * i + 3] = a[3]; }
            float tv[4]; int ti[4];
#pragma unroll
            for (int r = 0; r < 4; ++r) { float bv = -3.0e38f; int bi = 0;
#pragma unroll
                for (int e = 0; e < 32; ++e) if (v[e] > bv) { bv = v[e]; bi = e; }
                tv[r] = bv; ti[r] = bi;
#pragma unroll
                for (int e = 0; e < 32; ++e) v[e] = (e == bi) ? -3.0e38f : v[e]; }
            const float e1 = __expf(tv[1] - tv[0]), e2 = __expf(tv[2] - tv[0]), e3 = __expf(tv[3] - tv[0]), inv = 1.f / (1.f + e1 + e2 + e3);
            const int row = row0 + lane;
            *(int4*)(TOPE + (size_t)row * 4) = make_int4(ti[0], ti[1], ti[2], ti[3]);
            *(f32x4*)(TOPG + (size_t)row * 4) = (f32x4){inv, e1 * inv, e2 * inv, e3 * inv};
#pragma unroll
            for (int r = 0; r < 4; ++r) __hip_atomic_fetch_add(&hist[ti[r]], 1u, __ATOMIC_RELAXED, __HIP_MEMORY_SCOPE_WORKGROUP);
        }
        asm volatile("s_waitcnt lgkmcnt(0)" ::: "memory");
    }
    __syncthreads();
    if (C.tid < 32) CNTB[C.bid * 32 + C.tid] = hist[C.tid];
}

DI void moe_tables(const Ctx& C, int l, LAS int* tab) {
    const unsigned* CNTB = WSP(unsigned, WS_CTL) + CW_CNT + l * 8192;
    LAS unsigned* part = (LAS unsigned*)(tab + 192);
    __syncthreads();
    { const int e = C.tid & 31, pt = C.tid >> 5; unsigned tot = 0u, mine = 0u;
        const int g0 = pt * ((C.G + 15) >> 4), g1 = min(C.G, g0 + ((C.G + 15) >> 4));
#pragma unroll 16
        for (int g = g0; g < g1; ++g) { const unsigned c = CNTB[g * 32 + e]; tot += c; mine += (g < C.bid) ? c : 0u; }
        part[(pt * 2) * 32 + e] = tot; part[(pt * 2 + 1) * 32 + e] = mine; }
    __syncthreads();
    if (C.tid < 32) { unsigned tot = 0u, mine = 0u;
#pragma unroll
        for (int pt = 0; pt < 16; ++pt) { tot += part[(pt * 2) * 32 + C.tid]; mine += part[(pt * 2 + 1) * 32 + C.tid]; }
        tab[128 + C.tid] = (int)((tot + 255u) >> 8); tab[64 + C.tid] = (int)mine; }
    __syncthreads();
    if (C.tid == 0) { int s = 0; for (int e = 0; e < 32; ++e) { tab[e] = s; s += tab[128 + e]; } tab[32] = s; }
    __syncthreads();
}
DI void scatter_phase(const Ctx& C, int l) {
    const int* TOPE = WSP(int, WS_ROUTE); int* POS = (int*)(TOPE + NT * 8); int* ROWMAP = (int*)(TOPE + NT * 12);
    LAS int* tab = (LAS int*)(C.lds + MISC_OFF + 64); LAS unsigned* cur = (LAS unsigned*)(C.lds + 16384);
    moe_tables(C, l, tab);
    if (C.tid < 32) cur[C.tid] = (unsigned)(tab[C.tid] * 256 + tab[64 + C.tid]);
    __syncthreads();
    const int lane = C.lane, gw = C.bid * NWAVE + C.wave, NGW = C.G * NWAVE;
    for (int task = gw; task < NT / 16; task += NGW) {
        const int row0 = 16 * task, tok = row0 + (lane >> 2);
        const int e = TOPE[(size_t)tok * 4 + (lane & 3)];
        const int slot = (int)__hip_atomic_fetch_add(&cur[e], 1u, __ATOMIC_RELAXED, __HIP_MEMORY_SCOPE_WORKGROUP);
        POS[(size_t)tok * 4 + (lane & 3)] = slot; ROWMAP[slot] = tok;
    }
}
DI void combine_phase(const Ctx& C, int l, float* dst) {
    const bf16* YB = WSP(bf16, R_YB); const int* TOPE = WSP(int, WS_ROUTE); const float* TOPG = (const float*)(TOPE + NT * 4); const int* POS = (const int*)(TOPE + NT * 8);
    const float* MOD = WSP(float, WS_SMALL) + (size_t)l * 8 * 6144; bf16* H = WSP(bf16, WS_H);
    const int lane = C.lane, gw = C.bid * NWAVE + C.wave, NGW = C.G * NWAVE;
    for (int task = gw; task < NT / 16; task += NGW) {
        const int row0 = 16 * task, b = row0 / NS; const float* gt = MOD + (size_t)b * 6144 + 5120 + 8 * lane;
        f32x4 g4[4], gg[4], sb[4];
#pragma unroll
        for (int j = 0; j < 2; ++j) { g4[2 * j] = *(const f32x4*)(gt + 512 * j); g4[2 * j + 1] = *(const f32x4*)(gt + 512 * j + 4); }
        if (l + 1 < NLAYER) { const float* M2 = MOD + 8 * 6144 + (size_t)b * 6144 + 8 * lane; const float* g = C.norm1_g + (size_t)(l + 1) * DM + 8 * lane;
#pragma unroll
            for (int j = 0; j < 2; ++j)
#pragma unroll
                for (int hlf = 0; hlf < 2; ++hlf) { const int o = 512 * j + 4 * hlf; gg[2 * j + hlf] = *(const f32x4*)(g + o) * (*(const f32x4*)(M2 + 1024 + o) + 1.f); sb[2 * j + hlf] = *(const f32x4*)(M2 + o); } }
#pragma unroll 2
        for (int r = 0; r < 16; ++r) {
            const int row = row0 + r; const int4 ps = *(const int4*)(POS + (size_t)row * 4); const f32x4 gk = *(const f32x4*)(TOPG + (size_t)row * 4);
            const int pp[4] = {ps.x, ps.y, ps.z, ps.w};
            const float* orow = C.out + (size_t)row * DM + 8 * lane; float* drow = dst + (size_t)row * DM + 8 * lane;
            u32x4 y[4][2]; f32x4 x[4];
#pragma unroll
            for (int q = 0; q < 4; ++q)
#pragma unroll
                for (int j = 0; j < 2; ++j) { if (YB_FP8) { const u32x2 t_ = *(const u32x2*)((const unsigned char*)YB + (size_t)pp[q] * DM + 8 * lane + 512 * j); y[q][j] = (u32x4){t_.x, t_.y, 0u, 0u}; } else y[q][j] = *(const u32x4*)(YB + (size_t)pp[q] * DM + 8 * lane + 512 * j); }
#pragma unroll
            for (int j = 0; j < 2; ++j) { x[2 * j] = *(const f32x4*)(orow + 512 * j); x[2 * j + 1] = *(const f32x4*)(orow + 512 * j + 4); }
            f32x4 v[4]; float s = 0.f;
#pragma unroll
            for (int j = 0; j < 2; ++j) { f32x4 a0 = (f32x4){0.f, 0.f, 0.f, 0.f}, a1 = a0;
#pragma unroll
                for (int q = 0; q < 4; ++q) { const u32x4 w = y[q][j];
                    if (YB_FP8) { const f32x2 p0 = __builtin_amdgcn_cvt_pk_f32_fp8(w.x, false), p1 = __builtin_amdgcn_cvt_pk_f32_fp8(w.x, true), p2 = __builtin_amdgcn_cvt_pk_f32_fp8(w.y, false), p3 = __builtin_amdgcn_cvt_pk_f32_fp8(w.y, true);
                        a0 += (f32x4){p0[0], p0[1], p1[0], p1[1]} * gk[q]; a1 += (f32x4){p2[0], p2[1], p3[0], p3[1]} * gk[q]; }
                    else { a0 += (f32x4){bflo(w.x), bfhi(w.x), bflo(w.y), bfhi(w.y)} * gk[q]; a1 += (f32x4){bflo(w.z), bfhi(w.z), bflo(w.w), bfhi(w.w)} * gk[q]; } }
                v[2 * j] = x[2 * j] + g4[2 * j] * a0; v[2 * j + 1] = x[2 * j + 1] + g4[2 * j + 1] * a1;
                *(f32x4*)(drow + 512 * j) = v[2 * j]; *(f32x4*)(drow + 512 * j + 4) = v[2 * j + 1]; }
#pragma unroll
            for (int i = 0; i < 4; ++i) s += (v[i][0] * v[i][0] + v[i][1] * v[i][1]) + (v[i][2] * v[i][2] + v[i][3] * v[i][3]);
            if (l + 1 < NLAYER) {
                s = group_sum<64>(s); const float rstd = rsqrtf(s * (1.f / DM) + 1e-6f); bf16* hrow = H + (size_t)row * DM + 8 * lane;
#pragma unroll
                for (int j = 0; j < 2; ++j) { const f32x4 h0 = v[2 * j] * rstd * gg[2 * j] + sb[2 * j], h1 = v[2 * j + 1] * rstd * gg[2 * j + 1] + sb[2 * j + 1]; u32x4 o;
                    if (INPROJ_FP8) { u32x2 o8; o8.x = pk4_fp8(h0[0], h0[1], h0[2], h0[3]); o8.y = pk4_fp8(h1[0], h1[1], h1[2], h1[3]); *(u32x2*)((unsigned char*)H + (size_t)row * DM + 8 * lane + 512 * j) = o8; }
                    else { o.x = pk2(h0[0], h0[1]); o.y = pk2(h0[2], h0[3]); o.z = pk2(h1[0], h1[1]); o.w = pk2(h1[2], h1[3]); *(u32x4*)(hrow + 512 * j) = o; } }
            }
        }
    }
}
constexpr int PH_PER_LAYER = 11, PH_BASE = 2, N_PHASES = PH_BASE + NLAYER * PH_PER_LAYER;
#ifndef MK_ONE_LAUNCH
#define MK_ONE_LAUNCH 1
#endif
__global__ void __launch_bounds__(NTHR, 2) mk_fwd(Args args) {
    extern __shared__ __attribute__((aligned(16))) unsigned char lds_raw[];
    Ctx C;
    C.lds = (LAS unsigned char*)lds_raw; C.tid = threadIdx.x; C.lane = C.tid & 63; C.wave = __builtin_amdgcn_readfirstlane(C.tid >> 6); C.G = gridDim.x; C.bid = blockIdx.x;
    C.x = (const float*)args.in[0]; C.c = (const float*)args.in[1]; C.pos = (const int*)args.in[2]; C.w_ada = (const float*)args.in[3]; C.b_ada = (const float*)args.in[4];
    C.norm1_g = (const float*)args.in[5]; C.norm2_g = (const float*)args.in[6]; C.w_in = (const float*)args.in[7]; C.w_out = (const float*)args.in[8]; C.mu = (const float*)args.in[9];
    C.w0 = (const float*)args.in[10]; C.w2 = (const float*)args.in[11]; C.a0 = (const float*)args.in[12]; C.a2 = (const float*)args.in[13]; C.g2 = (const float*)args.in[14];
    C.kkw = (const float*)args.in[15]; C.ka = (const float*)args.in[16]; C.rk = (const float*)args.in[17]; C.gn_w = (const float*)args.in[18]; C.gn_b = (const float*)args.in[19];
    C.conv_w = (const float*)args.in[20]; C.dil_q_g = (const float*)args.in[21]; C.dil_k_g = (const float*)args.in[22]; C.nsa_q_g = (const float*)args.in[23]; C.nsa_kc_g = (const float*)args.in[24];
    C.nsa_ks_g = (const float*)args.in[25]; C.nsa_kw_g = (const float*)args.in[26]; C.pe_k = (const float*)args.in[27]; C.pe_v = (const float*)args.in[28]; C.wk1 = (const float*)args.in[29];
    C.wk2 = (const float*)args.in[30]; C.wv1 = (const float*)args.in[31]; C.wv2 = (const float*)args.in[32]; C.onorm_g = (const float*)args.in[33]; C.w_router = (const float*)args.in[34];
    C.b_router = (const float*)args.in[35]; C.w_gu = (const float*)args.in[36]; C.b_gu = (const float*)args.in[37]; C.w_down = (const float*)args.in[38]; C.b_down = (const float*)args.in[39];
    C.out = args.out; C.ws = args.ws;
    const int lo = args.ph_lo, hi = args.ph_hi;
    for (int u = C.tid; u < (LDS_BYTES - MISC_OFF) / 4; u += NTHR) ((LAS unsigned*)(C.lds + MISC_OFF))[u] = 0u;
    __syncthreads();
    XcdBarrier bar; bar.bar = WSP(unsigned, WS_CTL) + CW_BAR; bar.x = 0; bar.st = nullptr;
    if (hi - lo > 1) bar = xcd_barrier_post(WSP(unsigned, WS_CTL) + CW_BAR, (volatile LAS unsigned*)(C.lds + MISC_OFF));
#ifndef PHMASK
#define PHMASK 0xFFFFFFFFu
#endif
#define PHON(n) (((PHMASK) >> (n)) & 1u)
#ifndef PHREP
#define PHREP 0u
#endif
#define NREP(n) (1 + (int)(((PHREP) >> (n)) & 1u))
#define WSPP(T, off) ((T*)(P.ws + (off)))
#define IN(k) (lo <= (k) && (k) < hi)
#define SEAM(k) do { if (IN(k) && IN((k) + 1)) xcd_barrier(bar); } while (0)
#define PCTX Ctx P = C; asm volatile("" : "+v"(P.tid), "+v"(P.lane)); asm volatile("" : "+s"(P.ws), "+s"(P.out), "+s"(P.wave), "+s"(P.bid))
    if (PHON(17) && IN(0)) for (int rep = 0; rep < NREP(17); ++rep) { PCTX; p0_prologue(P); __syncthreads(); }
    SEAM(0);
#ifndef PROBE_BARS
#define PROBE_BARS 0
#endif
    if (hi - lo > 1) for (int i = 0; i < PROBE_BARS; ++i) xcd_barrier(bar);
    if (PHON(18) && IN(1)) { PCTX; norm1_phase(P, 0, P.x); }
    SEAM(1);
    for (int l = 0; l < NLAYER; ++l) {
        const int pb = PH_BASE + PH_PER_LAYER * l;
        if (PHON(0) && IN(pb + 0)) for (int rep = 0; rep < NREP(0); ++rep) { PCTX;
            pg8::StaticOrder S; S.init(NT / 256, NPJ / 256, P.G, P.bid);
            if (INPROJ_FP8) { pg8::Gemm g{WSPP(bf16, WS_H), WSPP(bf16, WS_WIN) + (size_t)l * NPJ * 512, 512, 512, WSPP(int, WS_ROUTE) + NT * 12 + NR, 0x3FFFF}; EpiProj E{WSPP(bf16, R_PROJ), W8_INV}; pg8::gemm_phase<EpiProj, pg8::StaticOrder, true, true>(P.lds, P.tid, g, S, E); }
            else { pg8::Gemm g{WSPP(bf16, WS_H), WSPP(bf16, WS_WIN) + (size_t)l * NPJ * 1024, 1024, 1024}; EpiProj E{WSPP(bf16, R_PROJ), 1.f}; pg8::gemm_phase(P.lds, P.tid, g, S, E); }
        }
        SEAM(pb + 0);
        if (PHON(1) && IN(pb + 1)) for (int rep = 0; rep < NREP(1); ++rep) { PCTX; prep_phase(P, l); __syncthreads(); }
        SEAM(pb + 1);
        if (PHON(2) && IN(pb + 2)) for (int rep = 0; rep < NREP(2); ++rep) { PCTX;
            { pg8::Gemm g{WSPP(bf16, R_LIN), WSPP(bf16, WS_LORA) + (size_t)l * 768 * 256, 256, 256}; pg8::StaticOrder S; S.init(NT / 256, 3, P.G, P.bid);
              EpiLora E{WSPP(float, R_SC), WSPP(bf16, R_SCH), WSPP(bf16, R_G), P.w0 + l * 256, P.a0 + l * 256, P.ka + l * 256, (rep + 1 < NREP(2)) ? WSPP(bf16, WS_END) : WSPP(bf16, R_SCH), (rep + 1 < NREP(2)) ? WSPP(float, WS_END) + 64 * MiB : WSPP(float, R_SC)}; pg8::gemm_phase(P.lds, P.tid, g, S, E); }
        }
        SEAM(pb + 2);
        if (PHON(3) && IN(pb + 3)) for (int rep = 0; rep < NREP(3); ++rep) { PCTX; mix_phase(P, l, rep); }
        SEAM(pb + 3);
        if (PHON(4) && IN(pb + 4)) for (int rep = 0; rep < NREP(4); ++rep) { PCTX; fin_phase(P, l); __syncthreads(); }
        SEAM(pb + 4);
        if (PHON(5) && IN(pb + 5)) for (int rep = 0; rep < NREP(5); ++rep) { PCTX;
            pg8::Gemm g{WSPP(bf16, R_YCAT), WSPP(bf16, WS_WOUT) + (size_t)l * 1024 * 1024, 1024, 1024}; pg8::StaticOrder S; S.init(NT / 256, 4, P.G, P.bid);
            EpiOut E{(rep + 1 < NREP(5)) ? WSPP(float, WS_END) : P.out, l == 0 ? P.x : (const float*)P.out, WSPP(float, WS_SMALL) + (size_t)l * 8 * 6144 + 2048}; pg8::gemm_phase(P.lds, P.tid, g, S, E);
        }
        SEAM(pb + 5);
        if (PHON(6) && IN(pb + 6)) for (int rep = 0; rep < NREP(6); ++rep) { PCTX; router_phase(P, l); __syncthreads(); }
        SEAM(pb + 6);
        if (PHON(7) && IN(pb + 7)) for (int rep = 0; rep < NREP(7); ++rep) { PCTX; scatter_phase(P, l); __syncthreads(); }
        SEAM(pb + 7);
        if (PHON(8) && IN(pb + 8)) for (int rep = 0; rep < NREP(8); ++rep) { PCTX;
            LAS int* tab = (LAS int*)(P.lds + MISC_OFF + 64); moe_tables(P, l, tab);
            pg8::Gemm g{WSPP(bf16, R_XS), WSPP(bf16, WS_WGU) + (size_t)l * 32 * 2048 * 512, 512, 512, WSPP(int, WS_ROUTE) + NT * 12, 32767};
            pg8::GroupedOrder S; S.init(tab[32], 8, P.G, P.bid); S.tstart = tab; S.nrow_e = 2048;
            EpiGU8 E{WSPP(unsigned char, R_ACT), P.b_gu + (size_t)l * 32 * 2048}; pg8::gemm_phase<EpiGU8, pg8::GroupedOrder, true, true>(P.lds, P.tid, g, S, E);
        }
        SEAM(pb + 8);
        if (PHON(9) && IN(pb + 9)) for (int rep = 0; rep < NREP(9); ++rep) { PCTX;
            LAS int* tab = (LAS int*)(P.lds + MISC_OFF + 64); moe_tables(P, l, tab);
            pg8::Gemm g{WSPP(bf16, R_ACT), WSPP(bf16, WS_WDN) + (size_t)l * 32 * 1024 * 512, 512, 512, WSPP(int, WS_ROUTE) + NT * 12 + NR, 0x3FFFF}; pg8::GroupedOrder S; S.init(tab[32], 4, P.G, P.bid); S.tstart = tab; S.nrow_e = 1024;
            EpiDN8 E{WSPP(bf16, R_YB), P.b_down + (size_t)l * 32 * 1024}; pg8::gemm_phase<EpiDN8, pg8::GroupedOrder, true, true>(P.lds, P.tid, g, S, E);
        }
        SEAM(pb + 9);
        if (PHON(10) && IN(pb + 10)) for (int rep = 0; rep < NREP(10); ++rep) { PCTX; combine_phase(P, l, (rep + 1 < NREP(10)) ? WSPP(float, WS_END) : P.out); __syncthreads(); }
        SEAM(pb + 10);
    }
#undef IN
#undef SEAM
}

extern "C" void kernel_launch(void* const* d_in, const int* in_sizes, int n_in, void* d_out, int out_size, void* d_ws, size_t ws_size, hipStream_t stream) {
    static int grid = 0;
    if (grid == 0) {
        if (n_in != 40 || out_size != NT * DM || ws_size < WS_END + 256 * MiB) { fprintf(stderr, "kernel_launch: unexpected problem (n_in %d, out %d, ws %zu < %zu)\n", n_in, out_size, ws_size, (size_t)WS_END); grid = -1; return; }
        int dev = 0, cus = 0, per_cu = 0;
        if (hipGetDevice(&dev) != hipSuccess || hipDeviceGetAttribute(&cus, hipDeviceAttributeMultiprocessorCount, dev) != hipSuccess) { grid = -1; return; }
        if (hipFuncSetAttribute((const void*)mk_fwd, hipFuncAttributeMaxDynamicSharedMemorySize, LDS_BYTES) != hipSuccess) { fprintf(stderr, "kernel_launch: hipFuncSetAttribute failed\n"); grid = -1; return; }
        if (hipOccupancyMaxActiveBlocksPerMultiprocessor(&per_cu, (const void*)mk_fwd, NTHR, LDS_BYTES) != hipSuccess || per_cu < 1) fprintf(stderr, "kernel_launch: occupancy query says %d blocks per CU\n", per_cu);
        (void)hipGetLastError();
        grid = cus > 256 ? 256 : cus;
    }
    if (grid < 0) return;
    (void)hipMemsetAsync((char*)d_ws, 0, ZERO_BYTES, stream);
    Args a{};
    for (int i = 0; i < 40; ++i) a.in[i] = d_in[i];
    a.out = (float*)d_out; a.ws = (unsigned char*)d_ws;
#if MK_ONE_LAUNCH
    a.ph_lo = 0; a.ph_hi = N_PHASES;
    hipLaunchKernelGGL(mk_fwd, dim3(grid), dim3(NTHR), LDS_BYTES, stream, a);
#else
    for (int p = 0; p < N_PHASES; ++p) { a.ph_lo = p; a.ph_hi = p + 1; hipLaunchKernelGGL(mk_fwd, dim3(grid), dim3(NTHR), LDS_BYTES, stream, a); }
#endif
    const hipError_t le = hipPeekAtLastError();
    if (le != hipSuccess) fprintf(stderr, "kernel_launch: launch failed: %s\n", hipGetErrorName(le));
}
```

```cpp
#include <hip/hip_runtime.h>
#include <cstdio>
#include <cstdint>

#define DI __device__ __forceinline__
#define LAS __attribute__((address_space(3)))
#define GAS __attribute__((address_space(1)))
typedef unsigned short bf16;
typedef short bf16x8 __attribute__((ext_vector_type(8)));
typedef float f32x4 __attribute__((ext_vector_type(4)));
typedef float f32x2 __attribute__((ext_vector_type(2)));
typedef unsigned u32x4 __attribute__((ext_vector_type(4)));
typedef unsigned u32x2 __attribute__((ext_vector_type(2)));
typedef unsigned char uchar;

#ifndef PROBE_SCAN2
#define PROBE_SCAN2 0
#endif
#ifndef PROBE_ATT2
#define PROBE_ATT2 0
#endif
#ifndef PROBE_CONV2
#define PROBE_CONV2 0
#endif
#ifndef INPROJ_FP8
#define INPROJ_FP8 0
#endif
constexpr int NB = 8, NS = 4096, NT = NB * NS, DM = 1024, NPJ = 3328, NE = 32, FF = 1024, NLAYER = 2;
constexpr int PJ_A = 0, PJ_B = 1024, PJ_C = 1792, PJ_D = 2560;
constexpr int NR = NT * 4 + NE * 256;
constexpr int NTHR = 512, NWAVE = 8;

DI float bf2f(unsigned v) { return __builtin_bit_cast(float, v << 16); }
DI unsigned f2bf(float f) { unsigned u = __builtin_bit_cast(unsigned, f); return (u + 0x7fffu + ((u >> 16) & 1u)) >> 16; }
DI unsigned pk2(float lo, float hi) { return f2bf(lo) | (f2bf(hi) << 16); }
DI float bflo(unsigned w) { return __builtin_bit_cast(float, w << 16); }
DI float bfhi(unsigned w) { return __builtin_bit_cast(float, w & 0xffff0000u); }
DI float fexp2(float x) { return __builtin_amdgcn_exp2f(x); }
DI float fsigmoid(float x) { return __builtin_amdgcn_rcpf(1.f + __builtin_amdgcn_exp2f(-1.44269504089f * x)); }
DI float wsum_xor(float v, int o) { return v + __shfl_xor(v, o); }
template <int CTRL> DI float dppmov(float x) { return __builtin_bit_cast(float, __builtin_amdgcn_update_dpp(0, __builtin_bit_cast(int, x), CTRL, 0xF, 0xF, true)); }
template <int W> DI float group_sum(float v) {
    if (W >= 2) v += dppmov<0xB1>(v);
    if (W >= 4) v += dppmov<0x4E>(v);
    if (W >= 8) v += dppmov<0x141>(v);
    if (W >= 16) v += dppmov<0x140>(v);
    if (W >= 32) v += __shfl_xor(v, 16);
    if (W >= 64) v += __shfl_xor(v, 32);
    return v;
}
DI float sum8(float x) { x += dppmov<0xB1>(x); x += dppmov<0x4E>(x); x += dppmov<0x141>(x); return x; }

#define XB_TMO      128
#define XB_XCNT(j)  (256  + 64 * (j))
#define XB_XSUB(j)  (1280 + 64 * (j))
#define XB_XGEN(j)  (2304 + 64 * (j))
#define XB_TOP      3328
#define XB_TOPGEN   3392
#define XCD_BAR_WORDS 3456
#define XB_SPIN_CAP (1u << 18)
DI unsigned xb_ld(unsigned* p)              { return __hip_atomic_load(p, __ATOMIC_RELAXED, __HIP_MEMORY_SCOPE_AGENT); }
DI unsigned xb_add(unsigned* p, unsigned v) { return __hip_atomic_fetch_add(p, v, __ATOMIC_RELAXED, __HIP_MEMORY_SCOPE_AGENT); }
DI unsigned xb_xcc_id() { return (unsigned)__builtin_amdgcn_s_getreg((3 << 11) | 20) & 0xFu; }
#define XB_SPIN(cond, bar) do { unsigned _sp = 0; while (cond) { __builtin_amdgcn_s_sleep(1); \
    if ((++_sp & 255u) == 0u) { if (xb_ld(&(bar)[XB_TMO])) break; if (_sp > XB_SPIN_CAP) { atomicAdd(&(bar)[XB_TMO], 1u); break; } } } } while (0)
struct XcdBarrier { unsigned* bar; unsigned x; volatile LAS unsigned* st; };
DI XcdBarrier xcd_barrier_post(unsigned* bar, volatile LAS unsigned* st) {
    XcdBarrier b; b.bar = bar; b.x = xb_xcc_id(); b.st = st;
    if (threadIdx.x == 0) (void)xb_add(&bar[XB_XCNT(b.x)], 1u);
    return b;
}
DI void xcd_barrier_complete(unsigned* bar, unsigned x, unsigned& nloc, unsigned& nx) {
    const unsigned G = gridDim.x * gridDim.y * gridDim.z;
    unsigned sum, cnt, mine, sp = 0u;
    for (;;) {
        sum = 0u; cnt = 0u; mine = 0u;
#pragma unroll
        for (unsigned j = 0; j < 16; ++j) { const unsigned c = xb_ld(&bar[XB_XCNT(j)]); sum += c; cnt += (c > 0u) ? 1u : 0u; mine = (j == x) ? c : mine; }
        if (sum == G) break;
        __builtin_amdgcn_s_sleep(1);
        if ((++sp & 255u) == 0u) { if (xb_ld(&bar[XB_TMO])) break; if (sp > XB_SPIN_CAP) { atomicAdd(&bar[XB_TMO], 1u); break; } }
    }
    nloc = mine > 0u ? mine : 1u; nx = cnt > 0u ? cnt : 1u;
}
DI void xcd_barrier(const XcdBarrier& b) {
    asm volatile("s_waitcnt vmcnt(0)" ::: "memory");
    __syncthreads();
    if (threadIdx.x == 0) {
        unsigned* bar = b.bar;
        __builtin_amdgcn_s_waitcnt(0);
        unsigned nloc = b.st[0], nx = b.st[1];
        if (nloc == 0u) { xcd_barrier_complete(bar, b.x, nloc, nx); b.st[0] = nloc; b.st[1] = nx; }
        const unsigned old = xb_add(&bar[XB_XSUB(b.x)], 1u);
        const unsigned gen = old / nloc;
        if (old + 1u == (gen + 1u) * nloc) {
            __builtin_amdgcn_fence(__ATOMIC_RELEASE, "agent");
            asm volatile("s_waitcnt vmcnt(0)" ::: "memory");
            const unsigned og = xb_add(&bar[XB_TOP], 1u);
            const unsigned tg = og / nx;
            if (og + 1u == (tg + 1u) * nx) xb_add(&bar[XB_TOPGEN], 1u);
            else XB_SPIN(xb_ld(&bar[XB_TOPGEN]) == tg, bar);
            __builtin_amdgcn_fence(__ATOMIC_ACQUIRE, "agent");
            xb_add(&bar[XB_XGEN(b.x)], 1u);
            asm volatile("s_waitcnt vmcnt(0)" ::: "memory");
        } else {
            XB_SPIN(xb_ld(&bar[XB_XGEN(b.x)]) == gen, bar);
            __builtin_amdgcn_fence(__ATOMIC_ACQUIRE, "agent");
            asm volatile("s_waitcnt vmcnt(0)" ::: "memory");
        }
    }
    __syncthreads();
}
namespace pg8 {
constexpr int BM = 256, BK = 64, HALF = 128, HTB = HALF * BK * 2, STAGE_BYTES = 8 * HTB, NXCD = 8, WGM = 8;
__host__ __device__ __forceinline__ int lds_byte(int r, int c) { const int st = (r >> 4) * 2 + (c >> 5), rr = r & 15, cc = c & 31, ob = rr * 64 + cc * 2; return st * 1024 + (ob ^ (((ob >> 9) & 1) << 5)); }
__host__ __device__ __forceinline__ void stage_rc(int b, int& R, int& C) { const int st = b / 1024, sb = b % 1024, swz = sb ^ (((sb >> 9) & 1) << 5); R = (st >> 1) * 16 + swz / 64; C = (st & 1) * 32 + (swz % 64) / 2; }
__host__ __device__ __forceinline__ int perm32(int rho) { const int n = rho >> 4, i = rho & 15; return 8 * (i >> 2) + 4 * n + (i & 3); }

struct Unit { int pm, pn, brow, e; };
struct Gemm { const bf16* A; const bf16* Bt; int lda, K; const int* rowmap; int rowmask; };

struct StaticOrder {
    int nM, nN, nwg, G, c;
    __device__ void init(int nM_, int nN_, int G_, int c_) { nM = nM_; nN = nN_; nwg = nM * nN; G = G_; c = c_; }
    __device__ bool tile(int i, int& pm, int& pn) const {
        const long L = (long)i * G + c; if (L >= nwg) return false;
        int wgid = (int)L; { const int q = nwg / NXCD, r = nwg % NXCD, xcd = wgid % NXCD, off = wgid / NXCD; wgid = (xcd < r ? xcd * (q + 1) : r * (q + 1) + (xcd - r) * q) + off; }
        const int nig = WGM * nN, gid = wgid / nig, fm = gid * WGM, gsz = (nM - fm) < WGM ? (nM - fm) : WGM;
        pm = fm + ((wgid % nig) % gsz); pn = (wgid % nig) / gsz; return true;
    }
    __device__ bool next(int i, Unit& u) const { if (!tile(i, u.pm, u.pn)) return false; u.brow = u.pn * BM; u.e = 0; return true; }
};
struct GroupedOrder : StaticOrder {
    const LAS int* tstart; int nrow_e;
    __device__ bool next(int i, Unit& u) const {
        if (!tile(i, u.pm, u.pn)) return false;
        int e = 0;
#pragma unroll 1
        for (int j = 16; j > 0; j >>= 1) if (tstart[e + j] <= u.pm) e += j;
        u.e = e; u.brow = e * nrow_e + u.pn * BM; return true;
    }
};
DI unsigned cvt_pk_bf16(float lo, float hi) { unsigned r; asm volatile("v_cvt_pk_bf16_f32 %0, %1, %2" : "=v"(r) : "v"(lo), "v"(hi)); return r; }

template <class Epi, class Sched, bool GATHER = false, bool FP8 = false>
DI void gemm_phase(LAS unsigned char* lds, const int tid, const Gemm g, const Sched& S, const Epi& E) {
    const int wid = __builtin_amdgcn_readfirstlane(tid >> 6), lane = tid & 63, wr = wid >> 2, wc = wid & 3, fr = lane & 15, fq = lane >> 4;
    int K = g.K, lda = g.lda; asm volatile("" : "+s"(K), "+s"(lda));
    const int nt = K / BK;
    unsigned voffA[2], voffB[2]; int Ra[2], Ca[2];
#pragma unroll
    for (int i = 0; i < 2; ++i) { int R, C; stage_rc(tid * 16 + i * 8192, R, C); const int Rb = Epi::PERM ? ((R & ~31) + perm32(R & 31)) : R; Ra[i] = R; Ca[i] = C;
        voffA[i] = (unsigned)(R * lda + C) * 2u; voffB[i] = (unsigned)(Rb * K + C) * 2u; }
    unsigned vgc[2][2]; int rawn[2][2];
#define PG8_GLOAD(dst, pm_) do { _Pragma("unroll") for (int _h = 0; _h < 2; ++_h) _Pragma("unroll") for (int _i = 0; _i < 2; ++_i) { const int* _p = g.rowmap + (size_t)(pm_) * BM + _h * HALF + Ra[_i]; \
        asm volatile("global_load_dword %0, %1, off" : "=v"(dst[_h][_i]) : "v"(_p) : "memory"); } } while (0)
#define PG8_GCONV(vg, raw) do { _Pragma("unroll") for (int _h = 0; _h < 2; ++_h) _Pragma("unroll") for (int _i = 0; _i < 2; ++_i) { int _r = raw[_h][_i]; asm volatile("" : "+v"(_r)); \
        vg[_h][_i] = (unsigned)((_r & g.rowmask) * lda + Ca[_i]) * 2u; } } while (0)
#define PG8_STAGE_A(bufoff, kptr, h, vg) do { if (GATHER) PG8_STAGE(bufoff, kptr, vg[h]); else PG8_STAGE(bufoff, (kptr) + (h) * hstepA, voffA); } while (0)
    const size_t kstep = (size_t)(BK * 2);
    const size_t hstepA = (size_t)HALF * lda * 2, hstepB = (size_t)HALF * K * 2;
    const size_t tstepA = 2 * hstepA;
    const unsigned ldsw = (unsigned)wid * 1024u;
    const int aoff = lds_byte(wr * 64 + fr, fq * 8), boff = lds_byte(wc * 32 + fr, fq * 8);
#define PG8_SA(b, h) (((b) * 2 + (h)) * HTB)
#define PG8_SB(b, h) ((4 + (b) * 2 + (h)) * HTB)
#define PG8_STAGE(bufoff, gbase, voff) do { _Pragma("unroll") for (int _i = 0; _i < 2; ++_i) \
        __builtin_amdgcn_global_load_lds((const unsigned*)((const char*)(gbase) + (voff)[_i]), (LAS unsigned*)(lds + (bufoff) + ldsw + _i * 8192), 16, 0, 0); } while (0)
#define PG8_LDA(dst, b, h) do { _Pragma("unroll") for (int m = 0; m < 4; ++m) { const v4i_ lo_ = *(const LAS v4i_*)(lds + PG8_SA(b, h) + aoff + m * 2048), hi_ = *(const LAS v4i_*)(lds + PG8_SA(b, h) + aoff + m * 2048 + 1024); \
        dst[m] = __builtin_shufflevector(lo_, hi_, 0, 1, 2, 3, 4, 5, 6, 7); } } while (0)
#define PG8_LDB(dst, b, h) do { _Pragma("unroll") for (int n = 0; n < 2; ++n) { const v4i_ lo_ = *(const LAS v4i_*)(lds + PG8_SB(b, h) + boff + n * 2048), hi_ = *(const LAS v4i_*)(lds + PG8_SB(b, h) + boff + n * 2048 + 1024); \
        dst[n] = __builtin_shufflevector(lo_, hi_, 0, 1, 2, 3, 4, 5, 6, 7); } } while (0)
#define PG8_MMA(ai, bj, At, Bt) do { __builtin_amdgcn_s_setprio(1); _Pragma("unroll") for (int m = 0; m < 4; ++m) _Pragma("unroll") for (int n = 0; n < 2; ++n) { \
        if (FP8) acc[ai][bj][m][n] = __builtin_amdgcn_mfma_scale_f32_16x16x128_f8f6f4(Bt[n], At[m], acc[ai][bj][m][n], 0, 0, 0, 0x7F7F7F7F, 0, 0x7F7F7F7F); \
        else { const v8i_ b_ = Bt[n], a_ = At[m]; \
            acc[ai][bj][m][n] = __builtin_amdgcn_mfma_f32_16x16x32_bf16(__builtin_bit_cast(bf16x8, __builtin_shufflevector(b_, b_, 0, 1, 2, 3)), __builtin_bit_cast(bf16x8, __builtin_shufflevector(a_, a_, 0, 1, 2, 3)), acc[ai][bj][m][n], 0, 0, 0); \
            acc[ai][bj][m][n] = __builtin_amdgcn_mfma_f32_16x16x32_bf16(__builtin_bit_cast(bf16x8, __builtin_shufflevector(b_, b_, 4, 5, 6, 7)), __builtin_bit_cast(bf16x8, __builtin_shufflevector(a_, a_, 4, 5, 6, 7)), acc[ai][bj][m][n], 0, 0, 0); } } \
        __builtin_amdgcn_s_setprio(0); } while (0)
#define PG8_WAIT_V(n) asm volatile("s_waitcnt vmcnt(" #n ")" ::: "memory")
#define PG8_WAIT_L(n) asm volatile("s_waitcnt lgkmcnt(" #n ")" ::: "memory")
#define PG8_BAR __builtin_amdgcn_s_barrier()
#define PG8_SCHED __builtin_amdgcn_sched_barrier(0)
    Unit cur, nxt; int ui = 0;
    if (!S.next(0, cur)) return;
    f32x4 acc[2][2][4][2];
#pragma unroll
    for (int a = 0; a < 2; ++a)
#pragma unroll
        for (int b = 0; b < 2; ++b)
#pragma unroll
            for (int m = 0; m < 4; ++m)
#pragma unroll
                for (int n = 0; n < 2; ++n) acc[a][b][m][n] = (f32x4){0.f, 0.f, 0.f, 0.f};
    typedef int v8i_ __attribute__((ext_vector_type(8))); typedef int v4i_ __attribute__((ext_vector_type(4)));
    v8i_ At[4], B0[2], B1[2];
    const char* cA = (const char*)g.A + (GATHER ? (size_t)0 : (size_t)cur.pm * tstepA); const char* cB = (const char*)g.Bt + (size_t)cur.brow * K * 2;
    if (GATHER) { PG8_GLOAD(rawn, cur.pm); asm volatile("s_waitcnt vmcnt(0)" : "+v"(rawn[0][0]), "+v"(rawn[0][1]), "+v"(rawn[1][0]), "+v"(rawn[1][1]) :: "memory"); PG8_GCONV(vgc, rawn); }
    PG8_STAGE(PG8_SB(0, 0), cB, voffB); PG8_STAGE(PG8_SB(0, 1), cB + hstepB, voffB); PG8_STAGE_A(PG8_SA(0, 0), cA, 0, vgc); PG8_STAGE_A(PG8_SA(0, 1), cA, 1, vgc);
    if (wr == 1) PG8_BAR;
    PG8_WAIT_V(2); PG8_BAR;
    PG8_STAGE(PG8_SB(1, 0), cB + kstep, voffB); PG8_STAGE_A(PG8_SA(1, 0), cA + kstep, 0, vgc); PG8_STAGE(PG8_SB(1, 1), cB + hstepB + kstep, voffB);
    PG8_WAIT_V(6); PG8_BAR;
    for (;;) {
        const bool has_next = S.next(ui + 1, nxt);
        const char* nA = (has_next && !GATHER) ? (const char*)g.A + (size_t)nxt.pm * tstepA : cA;
        if (GATHER && has_next) PG8_GLOAD(rawn, nxt.pm); const char* nB = has_next ? (const char*)g.Bt + (size_t)nxt.brow * K * 2 : cB;
#pragma unroll 1
        for (int t = 0; t < nt; t += 2) {
            const bool last = (t == nt - 2);
            const char* a1 = cA + (size_t)(t + 1) * kstep;
            const char* a2 = last ? nA : cA + (size_t)(t + 2) * kstep; const char* b2 = last ? nB : cB + (size_t)(t + 2) * kstep;
            const char* a3 = a2 + kstep; const char* b3 = b2 + kstep;
            PG8_LDB(B0, 0, 0); PG8_LDB(B1, 0, 1); PG8_SCHED; PG8_LDA(At, 0, 0); PG8_STAGE_A(PG8_SA(1, 1), a1, 1, vgc);
            if (GATHER) { if (last && has_next) PG8_GCONV(vgc, rawn); }
            PG8_WAIT_V(8); PG8_WAIT_L(0); PG8_BAR; PG8_MMA(0, 0, At, B0); PG8_MMA(0, 1, At, B1); PG8_BAR; PG8_SCHED;
            PG8_LDA(At, 0, 1); PG8_STAGE(PG8_SB(0, 0), b2, voffB); PG8_STAGE(PG8_SB(0, 1), b2 + hstepB, voffB); PG8_STAGE_A(PG8_SA(0, 0), a2, 0, vgc);
            PG8_WAIT_V(8); PG8_WAIT_L(0); PG8_BAR; PG8_MMA(1, 0, At, B0); PG8_MMA(1, 1, At, B1); PG8_BAR; PG8_SCHED;
            PG8_LDB(B0, 1, 0); PG8_LDB(B1, 1, 1); PG8_SCHED; PG8_LDA(At, 1, 0); PG8_STAGE_A(PG8_SA(0, 1), a2, 1, vgc);
            PG8_WAIT_V(8); PG8_WAIT_L(0); PG8_BAR; PG8_MMA(0, 0, At, B0); PG8_MMA(0, 1, At, B1); PG8_BAR; PG8_SCHED;
            PG8_LDA(At, 1, 1); PG8_STAGE(PG8_SB(1, 0), b3, voffB); PG8_STAGE(PG8_SB(1, 1), b3 + hstepB, voffB); PG8_STAGE_A(PG8_SA(1, 0), a3, 0, vgc);
            PG8_WAIT_V(8); PG8_WAIT_L(0); PG8_BAR; PG8_MMA(1, 0, At, B0); PG8_MMA(1, 1, At, B1); PG8_BAR; PG8_SCHED;
        }
        if (wr == 0) PG8_BAR;
        { int fr2 = fr, fq2 = fq; asm volatile("" : "+v"(fr2), "+v"(fq2)); E(acc, cur, wr, wc, fr2, fq2); }
        if (!has_next) break;
#pragma unroll
        for (int a = 0; a < 2; ++a)
#pragma unroll
            for (int b = 0; b < 2; ++b)
#pragma unroll
                for (int m = 0; m < 4; ++m)
#pragma unroll
                    for (int n = 0; n < 2; ++n) acc[a][b][m][n] = (f32x4){0.f, 0.f, 0.f, 0.f};
        cur = nxt; cA = nA; cB = nB; ++ui;
        if (wr == 1) PG8_BAR;
    }
    PG8_WAIT_V(0);
    PG8_BAR;
#undef PG8_SA
#undef PG8_SB
#undef PG8_STAGE
#undef PG8_STAGE_A
#undef PG8_GLOAD
#undef PG8_GCONV
#undef PG8_LDA
#undef PG8_LDB
#undef PG8_MMA
#undef PG8_WAIT_V
#undef PG8_WAIT_L
#undef PG8_BAR
#undef PG8_SCHED
}
}
constexpr size_t MiB = 1u << 20;
constexpr size_t WS_CTL = 0;
constexpr size_t WS_LORA = 1 * MiB;
constexpr size_t WS_WK2 = 2 * MiB;
constexpr size_t ZERO_BYTES = 3 * MiB;
constexpr size_t WS_WIN = 3 * MiB;
constexpr size_t WS_WOUT = 17 * MiB;
constexpr size_t WS_WK1 = 21 * MiB;
constexpr size_t WS_SMALL = 25 * MiB;
constexpr size_t WS_ROUTE = 27 * MiB;
constexpr size_t WS_WGU = 32 * MiB;
constexpr size_t WS_WDN = 288 * MiB;
constexpr size_t WS_H = 416 * MiB;
constexpr size_t WS_R = 480 * MiB;
constexpr size_t R_PROJ = WS_R;
constexpr size_t R_SC = R_PROJ + 208 * MiB;
constexpr size_t R_SCH = R_SC + 32 * MiB;
constexpr size_t R_LIN = R_SC + 192 * MiB;
constexpr size_t R_G = R_LIN + 16 * MiB;
constexpr size_t R_YA = R_G + 32 * MiB;
constexpr size_t R_YCAT = R_YA + 32 * MiB;
constexpr size_t R_QC = R_YCAT + 64 * MiB;
constexpr size_t R_KC = R_QC + 16 * MiB;
constexpr size_t R_OC = R_KC + 16 * MiB;
constexpr size_t R_LSE = R_OC + 96 * MiB;
constexpr size_t R_QN = R_LSE + 2 * MiB;
constexpr size_t R_QR = R_QN + 16 * MiB;
constexpr size_t R_KCR = R_QR + 16 * MiB;
constexpr size_t R_VCR = R_KCR + 5 * MiB;
constexpr size_t R_KS = R_VCR + 5 * MiB;
constexpr size_t R_KW = R_KS + 4 * MiB;
constexpr size_t R_GATE = R_KW + 4 * MiB;
constexpr size_t R_CH1 = R_GATE + 2 * MiB;
constexpr size_t R_CMP = R_CH1 + 2 * MiB;
constexpr size_t R_OCMP = R_CMP + 1 * MiB;
constexpr size_t R_OSLC = R_OCMP + 32 * MiB;
constexpr size_t R_OSWA = R_OSLC + 32 * MiB;
constexpr size_t R_SCANU = R_OSWA;
constexpr size_t R_SCANS = R_OSWA + 16 * MiB;
constexpr size_t R_IMP = R_OSWA + 32 * MiB;
constexpr size_t R_SELM = R_IMP + 8 * MiB;
constexpr size_t R_MIX_END = R_SELM + 1 * MiB;
constexpr size_t R_XS = WS_R;
constexpr size_t R_ACT = R_XS + 272 * MiB;
constexpr size_t R_YB = R_ACT + 272 * MiB;
constexpr size_t R_MOE_END = R_YB + 272 * MiB;
constexpr size_t WS_END = (R_MIX_END > R_MOE_END ? R_MIX_END : R_MOE_END);
static_assert((size_t)NR * 1024 * 2 <= 272 * MiB, "sorted buffers");
constexpr int CW_BAR = 4096;
constexpr int CW_CNT = 16384;
constexpr int CW_CUR = 16384 + 64;

constexpr int RING_BYTES = 131072;
constexpr int MISC_OFF = RING_BYTES;
constexpr int LDS_BYTES = 155648;

struct Args { const void* in[40]; float* out; unsigned char* ws; int ph_lo, ph_hi; };

struct Ctx {
    LAS unsigned char* lds; int tid, lane, wave, G, bid;
    const float *x, *c, *w_ada, *b_ada, *norm1_g, *norm2_g, *w_in, *w_out, *mu, *w0, *w2, *a0, *a2, *g2, *kkw, *ka, *rk, *gn_w, *gn_b, *conv_w, *dil_q_g, *dil_k_g,
        *nsa_q_g, *nsa_kc_g, *nsa_ks_g, *nsa_kw_g, *pe_k, *pe_v, *wk1, *wk2, *wv1, *wv2, *onorm_g, *w_router, *b_router, *w_gu, *b_gu, *w_down, *b_down;
    const int* pos;
    float* out; unsigned char* ws;
};
#define WSP(T, off) ((T*)(C.ws + (off)))

typedef f32x4 Acc[2][2][4][2];
struct EpiProj {
    static constexpr bool PERM = true; bf16* O; float scale;
    DI void operator()(const Acc& acc, const pg8::Unit& u, int wr, int wc, int fr, int fq) const {
        const int row0 = u.pm * 256 + wr * 64 + fr, col0 = u.pn * 256 + wc * 32 + 8 * fq;
#pragma unroll
        for (int ai = 0; ai < 2; ++ai)
#pragma unroll
            for (int m = 0; m < 4; ++m) { bf16* rowp = O + (size_t)(row0 + ai * 128 + m * 16) * NPJ + col0;
#pragma unroll
                for (int bj = 0; bj < 2; ++bj) { const f32x4 v0 = acc[ai][bj][m][0] * scale, v1 = acc[ai][bj][m][1] * scale; u32x4 w;
                    w.x = pg8::cvt_pk_bf16(v0[0], v0[1]); w.y = pg8::cvt_pk_bf16(v0[2], v0[3]); w.z = pg8::cvt_pk_bf16(v1[0], v1[1]); w.w = pg8::cvt_pk_bf16(v1[2], v1[3]);
                    *(u32x4*)(rowp + bj * 128) = w; } }
    }
};
struct EpiLora {
    static constexpr bool PERM = false; float* Wp; bf16* SCH; bf16* Gb; const float *w0, *a0, *ka; bf16* SCo; float* Wo;
    DI void operator()(const Acc& acc, const pg8::Unit& u, int wr, int wc, int fr, int fq) const {
        const int row0 = u.pm * 256 + wr * 64 + fr, col0 = wc * 32 + 4 * fq;
        if (u.pn == 0) {
#pragma unroll
            for (int bj = 0; bj < 2; ++bj)
#pragma unroll
                for (int n = 0; n < 2; ++n) { const int ch = col0 + bj * 128 + n * 16; const f32x4 b = *(const f32x4*)(w0 + ch);
#pragma unroll
                    for (int ai = 0; ai < 2; ++ai)
#pragma unroll
                        for (int m = 0; m < 4; ++m) { const size_t o = (size_t)(row0 + ai * 128 + m * 16) * 256 + ch; const f32x4 v = acc[ai][bj][m][n] + b; f32x4 r;
#pragma unroll
                            for (int j = 0; j < 4; ++j) r[j] = fexp2(-0.875040829f * fsigmoid(v[j]));
                            *(f32x4*)(Wo + o) = r; } }
        } else if (u.pn == 1) {
#pragma unroll
            for (int bj = 0; bj < 2; ++bj)
#pragma unroll
                for (int n = 0; n < 2; ++n) { const int ch = col0 + bj * 128 + n * 16; const f32x4 b = *(const f32x4*)(a0 + ch), kav = *(const f32x4*)(ka + ch);
#pragma unroll
                    for (int ai = 0; ai < 2; ++ai)
#pragma unroll
                        for (int m = 0; m < 4; ++m) { __builtin_amdgcn_sched_barrier(0); const size_t o = (size_t)(row0 + ai * 128 + m * 16) * 256 + ch; const f32x4 v = acc[ai][bj][m][n] + b;
                            const u32x2 kr = *(const u32x2*)(SCH + o), kn = *(const u32x2*)(SCH + (size_t)NT * 256 + o);
                            const float krf[4] = {bflo(kr.x), bfhi(kr.x), bflo(kr.y), bfhi(kr.y)}, knf[4] = {bflo(kn.x), bfhi(kn.x), bflo(kn.y), bfhi(kn.y)}; float k2[4], bb[4];
#pragma unroll
                            for (int j = 0; j < 4; ++j) { const float a = fsigmoid(v[j]); k2[j] = krf[j] * (1.f + (a - 1.f) * kav[j]); bb[j] = knf[j] * a; }
                            u32x2 o1, o2; o1.x = pk2(k2[0], k2[1]); o1.y = pk2(k2[2], k2[3]); o2.x = pk2(bb[0], bb[1]); o2.y = pk2(bb[2], bb[3]);
                            *(u32x2*)(SCo + o) = o1; *(u32x2*)(SCo + (size_t)2 * NT * 256 + o) = o2; } }
        } else {
#pragma unroll
            for (int bj = 0; bj < 2; ++bj)
#pragma unroll
                for (int n = 0; n < 2; ++n) { const int ch = col0 + bj * 128 + n * 16;
#pragma unroll
                    for (int ai = 0; ai < 2; ++ai)
#pragma unroll
                        for (int m = 0; m < 4; ++m) { const size_t o = (size_t)(row0 + ai * 128 + m * 16) * 256 + ch; const f32x4 v = acc[ai][bj][m][n]; u32x2 w; w.x = pk2(v[0], v[1]); w.y = pk2(v[2], v[3]); *(u32x2*)(Gb + o) = w; } }
        }
    }
};
DI float gelu_tanh(float x) { const float t = 0.7978845608f * (x + 0.044715f * x * x * x); return x * fsigmoid(2.f * t); }
struct EpiC1 {
    static constexpr bool PERM = true; bf16* O; const float* peb;
    DI void operator()(const Acc& acc, const pg8::Unit& u, int wr, int wc, int fr, int fq) const {
        const int row0 = u.pm * 256 + wr * 64 + fr, col0 = wc * 32 + 8 * fq;
#pragma unroll
        for (int bj = 0; bj < 2; ++bj) { const f32x4 b0 = *(const f32x4*)(peb + col0 + bj * 128), b1 = *(const f32x4*)(peb + col0 + bj * 128 + 4);
#pragma unroll
            for (int ai = 0; ai < 2; ++ai)
#pragma unroll
                for (int m = 0; m < 4; ++m) { bf16* p = O + (size_t)(row0 + ai * 128 + m * 16) * 256 + col0 + bj * 128; const f32x4 v0 = acc[ai][bj][m][0] + b0, v1 = acc[ai][bj][m][1] + b1; u32x4 w;
                    w.x = pk2(gelu_tanh(v0[0]), gelu_tanh(v0[1])); w.y = pk2(gelu_tanh(v0[2]), gelu_tanh(v0[3])); w.z = pk2(gelu_tanh(v1[0]), gelu_tanh(v1[1])); w.w = pk2(gelu_tanh(v1[2]), gelu_tanh(v1[3]));
                    *(u32x4*)p = w; } }
    }
};
struct EpiC2 {
    static constexpr bool PERM = false; float* O;
    DI void operator()(const Acc& acc, const pg8::Unit& u, int wr, int wc, int fr, int fq) const {
        if (wc >= 2) return;
        const int row0 = u.pm * 256 + wr * 64 + fr, col0 = wc * 32 + 4 * fq;
#pragma unroll
        for (int ai = 0; ai < 2; ++ai)
#pragma unroll
            for (int m = 0; m < 4; ++m)
#pragma unroll
                for (int n = 0; n < 2; ++n) *(f32x4*)(O + (size_t)(row0 + ai * 128 + m * 16) * 64 + col0 + n * 16) = acc[ai][0][m][n];
    }
};
struct EpiOut {
    static constexpr bool PERM = false; float* O; const float* xin; const float* gt;
    DI void operator()(const Acc& acc, const pg8::Unit& u, int wr, int wc, int fr, int fq) const {
        const int row0 = u.pm * 256 + wr * 64 + fr, col0 = u.pn * 256 + wc * 32 + 4 * fq; const int b = (u.pm * 256) / NS;
#pragma unroll
        for (int bj = 0; bj < 2; ++bj)
#pragma unroll
            for (int n = 0; n < 2; ++n) { const int col = col0 + bj * 128 + n * 16; const f32x4 g = *(const f32x4*)(gt + (size_t)b * 6144 + col);
#pragma unroll
                for (int ai = 0; ai < 2; ++ai)
#pragma unroll
                    for (int m = 0; m < 4; ++m) { const size_t o = (size_t)(row0 + ai * 128 + m * 16) * DM + col; *(f32x4*)(O + o) = *(const f32x4*)(xin + o) + g * acc[ai][bj][m][n]; } }
    }
};
struct EpiGU {
    static constexpr bool PERM = true; bf16* O; const float* bgu;
    DI void operator()(const Acc& acc, const pg8::Unit& u, int wr, int wc, int fr, int fq) const {
        const int row0 = u.pm * 256 + wr * 64 + fr, cc = u.pn * 128 + wc * 32 + 8 * fq; const float* bp = bgu + (size_t)u.e * 2048 + cc;
        const f32x4 g0 = *(const f32x4*)bp, g1 = *(const f32x4*)(bp + 4), u0 = *(const f32x4*)(bp + 1024), u1 = *(const f32x4*)(bp + 1028);
#pragma unroll
        for (int ai = 0; ai < 2; ++ai)
#pragma unroll
            for (int m = 0; m < 4; ++m) { bf16* p = O + (size_t)(row0 + ai * 128 + m * 16) * FF + cc; float r[8];
#pragma unroll
                for (int n = 0; n < 2; ++n) { const f32x4 gv = acc[ai][0][m][n] + (n ? g1 : g0), uv = acc[ai][1][m][n] + (n ? u1 : u0);
#pragma unroll
                    for (int j = 0; j < 4; ++j) { const float ga = fminf(gv[j], 7.f), up = fminf(fmaxf(uv[j], -7.f), 7.f); r[4 * n + j] = ga * fsigmoid(1.702f * ga) * (up + 1.f); } }
                u32x4 w; w.x = pk2(r[0], r[1]); w.y = pk2(r[2], r[3]); w.z = pk2(r[4], r[5]); w.w = pk2(r[6], r[7]); *(u32x4*)p = w; }
    }
};
struct EpiDN {
    static constexpr bool PERM = true; bf16* O; const float* bd;
    DI void operator()(const Acc& acc, const pg8::Unit& u, int wr, int wc, int fr, int fq) const {
        const int row0 = u.pm * 256 + wr * 64 + fr, col0 = u.pn * 256 + wc * 32 + 8 * fq; const float* bp = bd + (size_t)u.e * 1024 + col0;
#pragma unroll
        for (int bj = 0; bj < 2; ++bj) { const f32x4 b0 = *(const f32x4*)(bp + bj * 128), b1 = *(const f32x4*)(bp + bj * 128 + 4);
#pragma unroll
            for (int ai = 0; ai < 2; ++ai)
#pragma unroll
                for (int m = 0; m < 4; ++m) { bf16* p = O + (size_t)(row0 + ai * 128 + m * 16) * DM + col0 + bj * 128; const f32x4 v0 = acc[ai][bj][m][0] + b0, v1 = acc[ai][bj][m][1] + b1; u32x4 w;
                    w.x = pk2(v0[0], v0[1]); w.y = pk2(v0[2], v0[3]); w.z = pk2(v1[0], v1[1]); w.w = pk2(v1[2], v1[3]); *(u32x4*)p = w; } }
    }
};
DI float clamp8(float x) { return fminf(fmaxf(x, -448.f), 448.f); }
DI unsigned pk4_fp8_nc(float a, float b, float c, float d) { unsigned w = 0u; w = __builtin_amdgcn_cvt_pk_fp8_f32(a, b, w, false); w = __builtin_amdgcn_cvt_pk_fp8_f32(c, d, w, true); return w; }
DI unsigned pk4_fp8(float a, float b, float c, float d) { unsigned w = 0u; w = __builtin_amdgcn_cvt_pk_fp8_f32(clamp8(a), clamp8(b), w, false); w = __builtin_amdgcn_cvt_pk_fp8_f32(clamp8(c), clamp8(d), w, true); return w; }
constexpr float W8_SCALE = 32.f, W8_INV = 1.f / 32.f;
struct EpiGU8 {
    static constexpr bool PERM = true; unsigned char* O; const float* bgu;
    DI void operator()(const Acc& acc, const pg8::Unit& u, int wr, int wc, int fr, int fq) const {
        const int row0 = u.pm * 256 + wr * 64 + fr, cc = u.pn * 128 + wc * 32 + 8 * fq; const float* bp = bgu + (size_t)u.e * 2048 + cc;
        const f32x4 g0 = *(const f32x4*)bp, g1 = *(const f32x4*)(bp + 4), u0 = *(const f32x4*)(bp + 1024), u1 = *(const f32x4*)(bp + 1028);
        const f32x2 bg[4] = {(f32x2){g0[0], g0[1]}, (f32x2){g0[2], g0[3]}, (f32x2){g1[0], g1[1]}, (f32x2){g1[2], g1[3]}};
        const f32x2 bu[4] = {(f32x2){u0[0] + 1.f, u0[1] + 1.f}, (f32x2){u0[2] + 1.f, u0[3] + 1.f}, (f32x2){u1[0] + 1.f, u1[1] + 1.f}, (f32x2){u1[2] + 1.f, u1[3] + 1.f}};
#pragma unroll
        for (int ai = 0; ai < 2; ++ai)
#pragma unroll
            for (int m = 0; m < 4; ++m) { unsigned char* p = O + (size_t)(row0 + ai * 128 + m * 16) * FF + cc; f32x2 r[4];
#pragma unroll
                for (int h2 = 0; h2 < 4; ++h2) { const int n = h2 >> 1, j = (h2 & 1) * 2;
                    f32x2 gv = (f32x2){acc[ai][0][m][n][j], acc[ai][0][m][n][j + 1]} * W8_INV + bg[h2];
                    f32x2 uv = (f32x2){acc[ai][1][m][n][j], acc[ai][1][m][n][j + 1]} * W8_INV + bu[h2];
                    gv[0] = fminf(gv[0], 7.f); gv[1] = fminf(gv[1], 7.f); uv[0] = __builtin_amdgcn_fmed3f(uv[0], -6.f, 8.f); uv[1] = __builtin_amdgcn_fmed3f(uv[1], -6.f, 8.f);
                    const f32x2 t = gv * -2.45546695959f; f32x2 e; e[0] = __builtin_amdgcn_exp2f(t[0]); e[1] = __builtin_amdgcn_exp2f(t[1]);
                    e = e + 1.f; f32x2 sg; sg[0] = __builtin_amdgcn_rcpf(e[0]); sg[1] = __builtin_amdgcn_rcpf(e[1]);
                    r[h2] = (gv * sg) * uv; }
                u32x2 w; w.x = pk4_fp8_nc(r[0][0], r[0][1], r[1][0], r[1][1]); w.y = pk4_fp8_nc(r[2][0], r[2][1], r[3][0], r[3][1]); *(u32x2*)p = w; }
    }
};
#ifndef YB_FP8
#define YB_FP8 1
#endif
struct EpiDN8 {
    static constexpr bool PERM = true; bf16* O; const float* bd;
    DI void operator()(const Acc& acc, const pg8::Unit& u, int wr, int wc, int fr, int fq) const {
        const int row0 = u.pm * 256 + wr * 64 + fr, col0 = u.pn * 256 + wc * 32 + 8 * fq; const float* bp = bd + (size_t)u.e * 1024 + col0;
#pragma unroll
        for (int bj = 0; bj < 2; ++bj) { const f32x4 b0 = *(const f32x4*)(bp + bj * 128), b1 = *(const f32x4*)(bp + bj * 128 + 4);
#pragma unroll
            for (int ai = 0; ai < 2; ++ai)
#pragma unroll
                for (int m = 0; m < 4; ++m) { const size_t oo = (size_t)(row0 + ai * 128 + m * 16) * DM + col0 + bj * 128; const f32x4 v0 = acc[ai][bj][m][0] * W8_INV + b0, v1 = acc[ai][bj][m][1] * W8_INV + b1;
                    if (YB_FP8) { u32x2 w; w.x = pk4_fp8(v0[0], v0[1], v0[2], v0[3]); w.y = pk4_fp8(v1[0], v1[1], v1[2], v1[3]); *(u32x2*)((unsigned char*)O + oo) = w; }
                    else { u32x4 w; w.x = pk2(v0[0], v0[1]); w.y = pk2(v0[2], v0[3]); w.z = pk2(v1[0], v1[1]); w.w = pk2(v1[2], v1[3]); *(u32x4*)(O + oo) = w; } } }
    }
};
DI void tr_item(const float* src, int ld_src, int scol0, int nvalid, int k0, bf16* dst, int ld_dst, int drow0, int dk0, LAS float* scr, int lane) {
    const int n4 = (lane & 7) * 4, kr = lane >> 3; f32x4 v[8];
#pragma unroll
    for (int i = 0; i < 8; ++i) v[i] = (n4 < nvalid) ? *(const f32x4*)(src + (size_t)(k0 + kr + 8 * i) * ld_src + scol0 + n4) : (f32x4){0.f, 0.f, 0.f, 0.f};
#pragma unroll
    for (int i = 0; i < 8; ++i) { LAS float* s = scr + (kr + 8 * i) * 33 + n4; s[0] = v[i][0]; s[1] = v[i][1]; s[2] = v[i][2]; s[3] = v[i][3]; }
    asm volatile("s_waitcnt lgkmcnt(0)" ::: "memory");
    const int c = lane & 7;
#pragma unroll
    for (int jq = 0; jq < 4; ++jq) { const int n = (lane >> 3) + 8 * jq; const LAS float* s = scr + (8 * c) * 33 + n;
        u32x4 o; o.x = pk2(s[0 * 33], s[1 * 33]); o.y = pk2(s[2 * 33], s[3 * 33]); o.z = pk2(s[4 * 33], s[5 * 33]); o.w = pk2(s[6 * 33], s[7 * 33]);
        *(u32x4*)(dst + (size_t)(drow0 + n) * ld_dst + dk0 + k0 + 8 * c) = o; }
    asm volatile("s_waitcnt lgkmcnt(0)" ::: "memory");
}
DI void tr_item8(const float* src, int ld_src, int scol0, int k0, unsigned char* dst, int ld_dst, int drow0, LAS float* scr, int lane, int nvalid = 32) {
    const int n4 = (lane & 7) * 4, kr = lane >> 3; f32x4 v[8];
#pragma unroll
    for (int i = 0; i < 8; ++i) v[i] = (n4 < nvalid) ? *(const f32x4*)(src + (size_t)(k0 + kr + 8 * i) * ld_src + scol0 + n4) : (f32x4){0.f, 0.f, 0.f, 0.f};
#pragma unroll
    for (int i = 0; i < 8; ++i) { LAS float* s = scr + (kr + 8 * i) * 33 + n4; s[0] = v[i][0]; s[1] = v[i][1]; s[2] = v[i][2]; s[3] = v[i][3]; }
    asm volatile("s_waitcnt lgkmcnt(0)" ::: "memory");
    const int c = lane & 7;
#pragma unroll
    for (int jq = 0; jq < 4; ++jq) { const int n = (lane >> 3) + 8 * jq; const LAS float* s = scr + (8 * c) * 33 + n;
        u32x2 o; o.x = pk4_fp8(s[0 * 33] * W8_SCALE, s[1 * 33] * W8_SCALE, s[2 * 33] * W8_SCALE, s[3 * 33] * W8_SCALE); o.y = pk4_fp8(s[4 * 33] * W8_SCALE, s[5 * 33] * W8_SCALE, s[6 * 33] * W8_SCALE, s[7 * 33] * W8_SCALE);
        *(u32x2*)(dst + (size_t)(drow0 + n) * ld_dst + k0 + 8 * c) = o; }
    asm volatile("s_waitcnt lgkmcnt(0)" ::: "memory");
}
DI void conv_item(const Ctx& C, int l, int r, LAS float* scr) {
    constexpr int I_GU = 32 * 16 * 64;
    if (r < I_GU) { const int e = r / 1024, r2 = r % 1024, kb = r2 / 64, nb = r2 % 64, n0 = 32 * nb, j = n0 / 256, i = n0 % 256;
        const int scol0 = (i < 128) ? 128 * j + i : 1024 + 128 * j + (i - 128);
        tr_item8(C.w_gu + (size_t)(l * 32 + e) * 1024 * 2048, 2048, scol0, 64 * kb, WSP(unsigned char, WS_WGU) + (size_t)(l * 32 + e) * 2048 * 1024, 1024, n0, scr, C.lane); }
    else { r -= I_GU; const int e = r / 512, r2 = r % 512, kb = r2 / 32, nb = r2 % 32;
        tr_item8(C.w_down + (size_t)(l * 32 + e) * 1024 * 1024, 1024, 32 * nb, 64 * kb, WSP(unsigned char, WS_WDN) + (size_t)(l * 32 + e) * 1024 * 1024, 1024, 32 * nb, scr, C.lane); }
}
DI void conv_ticket(const Ctx& C0, int l, int tk) {
    Ctx C = C0; asm volatile("" : "+v"(C.lane), "+v"(C.tid));
    LAS float* scr = (LAS float*)(C.lds + C.wave * 16384);
    __syncthreads();
#pragma unroll 1
    for (int i = 0; i < 8; ++i) conv_item(C, l, tk * 64 + C.wave * 8 + i, scr);
}
DI void p0_prologue(const Ctx& C) {
    LAS float* scr = (LAS float*)(C.lds + C.wave * 16384);
    const int gw = C.bid * NWAVE + C.wave, NGW = C.G * NWAVE;
    constexpr int I_IN = 16 * 104, I_OUT = 16 * 32, I_LW = 8, I_LA = 8, I_LG = 16, I_K1 = 256, I_K2 = 8;
    constexpr int I_LAYER = I_IN + I_OUT + I_LW + I_LA + I_LG + 2 * I_K1 + 2 * I_K2;
    for (int it = gw; it < NLAYER * I_LAYER; it += NGW) {
        const int l = it / I_LAYER; int r = it % I_LAYER;
        if (r < I_IN) { const int kb = r / 104, nb = r % 104, n0 = 32 * nb; int nv = 3212 - n0; nv = nv < 0 ? 0 : (nv > 32 ? 32 : nv);
            if (INPROJ_FP8) tr_item8(C.w_in + (size_t)l * 1024 * 3212, 3212, n0, 64 * kb, WSP(unsigned char, WS_WIN) + (size_t)l * NPJ * 1024, 1024, n0, scr, C.lane, nv);
            else tr_item(C.w_in + (size_t)l * 1024 * 3212, 3212, n0, nv, 64 * kb, WSP(bf16, WS_WIN) + (size_t)l * NPJ * 1024, 1024, n0, 0, scr, C.lane); continue; } r -= I_IN;
        if (r < I_OUT) { const int kb = r / 32, nb = r % 32;
            tr_item(C.w_out + (size_t)l * 1024 * 1024, 1024, 32 * nb, 32, 64 * kb, WSP(bf16, WS_WOUT) + (size_t)l * 1024 * 1024, 1024, 32 * nb, 0, scr, C.lane); continue; } r -= I_OUT;
        bf16* lora = WSP(bf16, WS_LORA) + (size_t)l * 768 * 256;
        if (r < I_LW) { tr_item(C.w2 + (size_t)l * 64 * 256, 256, 32 * r, 32, 0, lora, 256, 32 * r, 0, scr, C.lane); continue; } r -= I_LW;
        if (r < I_LA) { tr_item(C.a2 + (size_t)l * 64 * 256, 256, 32 * r, 32, 0, lora, 256, 256 + 32 * r, 64, scr, C.lane); continue; } r -= I_LA;
        if (r < I_LG) { const int kb = r / 8, nb = r % 8; tr_item(C.g2 + (size_t)l * 128 * 256, 256, 32 * nb, 32, 64 * kb, lora, 256, 512 + 32 * nb, 128, scr, C.lane); continue; } r -= I_LG;
        if (r < 2 * I_K1) { const int kv = r / I_K1, r2 = r % I_K1, kb = r2 / 8, nb = r2 % 8;
            tr_item((kv ? C.wv1 : C.wk1) + (size_t)l * 2048 * 256, 256, 32 * nb, 32, 64 * kb, WSP(bf16, WS_WK1) + (size_t)(l * 2 + kv) * 256 * 2048, 2048, 32 * nb, 0, scr, C.lane); continue; } r -= 2 * I_K1;
        { const int kv = r / I_K2, r2 = r % I_K2, kb = r2 / 2, nb = r2 % 2;
            tr_item((kv ? C.wv2 : C.wk2) + (size_t)l * 256 * 64, 64, 32 * nb, 32, 64 * kb, WSP(bf16, WS_WK2) + (size_t)(l * 2 + kv) * 256 * 256, 256, 32 * nb, 0, scr, C.lane); }
    }
    { int* idm = WSP(int, WS_ROUTE) + NT * 12 + NR; for (int i = C.bid * NTHR + C.tid; i < NR; i += C.G * NTHR) idm[i] = i; }
    __syncthreads();
    float* MOD = WSP(float, WS_SMALL); float* PEB = MOD + NLAYER * 8 * 6144;
    LAS float* sc = (LAS float*)C.lds;
    LAS float* red = sc + 8192;
    for (int it = C.bid; it < 192 + 32; it += C.G) {
        if (it < 192) {
            const int l = it / 96, n0 = (it % 96) * 64;
            for (int i = C.tid; i < 8192; i += NTHR) { const float v = C.c[i]; sc[i] = v * fsigmoid(v); }
            __syncthreads();
            const int kq = C.tid >> 6, col = C.tid & 63; float a[8];
#pragma unroll
            for (int b = 0; b < 8; ++b) a[b] = 0.f;
            const float* wp = C.w_ada + (size_t)l * 1024 * 6144 + n0 + col;
#pragma unroll 32
            for (int k = kq * 128; k < kq * 128 + 128; ++k) { const float w = wp[(size_t)k * 6144];
#pragma unroll
                for (int b = 0; b < 8; ++b) a[b] += sc[b * 1024 + k] * w; }
#pragma unroll
            for (int b = 0; b < 8; ++b) red[(kq * 8 + b) * 64 + col] = a[b];
            __syncthreads();
            { const int b = C.tid >> 6; float s = C.b_ada[(size_t)l * 6144 + n0 + col];
#pragma unroll
              for (int q = 0; q < 8; ++q) s += red[(q * 8 + b) * 64 + col];
              MOD[((size_t)l * 8 + b) * 6144 + n0 + col] = s; }
            __syncthreads();
        } else {
            const int r = it - 192, l = r >> 4, kv = (r >> 3) & 1, c0 = (r & 7) * 32; const float* pe = (kv ? C.pe_v : C.pe_k) + (size_t)l * 2048; const float* w1 = (kv ? C.wv1 : C.wk1) + (size_t)l * 2048 * 256;
            const int kq = C.tid >> 5, col = C.tid & 31; float a = 0.f;
#pragma unroll 16
            for (int k = kq * 128; k < kq * 128 + 128; ++k) a += pe[k] * w1[(size_t)k * 256 + c0 + col];
            red[kq * 32 + col] = a; __syncthreads();
            if (C.tid < 32) { float s = 0.f;
#pragma unroll
                for (int q = 0; q < 16; ++q) s += red[q * 32 + C.tid];
                PEB[(l * 2 + kv) * 256 + c0 + C.tid] = s; }
            __syncthreads();
        }
    }
}

DI void norm_row(const Ctx& C, const float* xrow, const float* g, const float* sh, const float* sc, bf16* orow) {
    f32x4 v[4]; float s = 0.f;
#pragma unroll
    for (int j = 0; j < 4; ++j) { v[j] = *(const f32x4*)(xrow + 4 * C.lane + 256 * j); s += (v[j][0] * v[j][0] + v[j][1] * v[j][1]) + (v[j][2] * v[j][2] + v[j][3] * v[j][3]); }
    s = group_sum<64>(s); const float rstd = rsqrtf(s * (1.f / DM) + 1e-6f);
#pragma unroll
    for (int j = 0; j < 4; ++j) { const int k = 4 * C.lane + 256 * j; const f32x4 gg = *(const f32x4*)(g + k), a = *(const f32x4*)(sc + k), b = *(const f32x4*)(sh + k); f32x4 h;
#pragma unroll
        for (int i = 0; i < 4; ++i) h[i] = v[j][i] * rstd * gg[i] * (1.f + a[i]) + b[i];
        if (INPROJ_FP8) *(unsigned*)((unsigned char*)orow + k) = pk4_fp8(h[0], h[1], h[2], h[3]);
        else { u32x2 o; o.x = pk2(h[0], h[1]); o.y = pk2(h[2], h[3]); *(u32x2*)(orow + k) = o; } }
}
DI void norm1_phase(const Ctx& C, int l, const float* xin) {
    const float* MOD = WSP(float, WS_SMALL) + (size_t)l * 8 * 6144; bf16* H = WSP(bf16, WS_H);
    const int gw = C.bid * NWAVE + C.wave, NGW = C.G * NWAVE;
    for (int m = gw; m < NT; m += NGW) { const int b = m / NS; norm_row(C, xin + (size_t)m * DM, C.norm1_g + l * DM, MOD + b * 6144, MOD + b * 6144 + 1024, INPROJ_FP8 ? (bf16*)((unsigned char*)H + (size_t)m * DM) : H + (size_t)m * DM); }
}

constexpr float QSCALE = 0.125f * 1.44269504089f;
DI void prep_phase(const Ctx& C, int l) {
    const bf16* PROJ = WSP(bf16, R_PROJ); bf16* SCH = WSP(bf16, R_SCH); bf16* LIN = WSP(bf16, R_LIN); bf16* YCAT = WSP(bf16, R_YCAT);
    bf16 *QC = WSP(bf16, R_QC), *KC = WSP(bf16, R_KC), *QN = WSP(bf16, R_QN), *QR = WSP(bf16, R_QR), *KCR = WSP(bf16, R_KCR), *VCR = WSP(bf16, R_VCR), *KS = WSP(bf16, R_KS), *KW = WSP(bf16, R_KW);
    float* GATE = WSP(float, R_GATE);
    const int lane = C.lane, gw = C.bid * NWAVE + C.wave, NGW = C.G * NWAVE;
    const int hh = lane >> 4, jj = lane & 15;
    const float inv0 = exp2f(-(float)(2 * jj) * (13.287712379549449f / 32.f)) * 0.15915494309189535f, inv1 = exp2f(-(float)(2 * jj + 1) * (13.287712379549449f / 32.f)) * 0.15915494309189535f;
    for (int task = gw; task < NT / 16; task += NGW) {
        const int row0 = 16 * task, s0 = row0 % NS;
        {
            const int c0 = 16 * lane, cc = (c0 - 256) & 255; float mu16[16], kw16[16];
#pragma unroll
            for (int q = 0; q < 4; ++q) { const f32x4 m4 = *(const f32x4*)(C.mu + (size_t)l * 1024 + c0 + 4 * q), k4 = *(const f32x4*)(C.kkw + (size_t)l * 256 + cc + 4 * q);
#pragma unroll
                for (int i = 0; i < 4; ++i) { mu16[4 * q + i] = m4[i]; kw16[4 * q + i] = k4[i]; } }
#pragma unroll 2
            for (int r = 0; r < 16; ++r) {
                const int row = row0 + r; const bf16* pr = PROJ + (size_t)row * NPJ; float z[16];
                const u32x4 c0v = *(const u32x4*)(pr + c0), c1v = *(const u32x4*)(pr + c0 + 8);
                u32x4 p0v = (u32x4){0u, 0u, 0u, 0u}, p1v = p0v;
                if (s0 + r > 0) { p0v = *(const u32x4*)(pr - NPJ + c0); p1v = *(const u32x4*)(pr - NPJ + c0 + 8); }
                const unsigned cw[8] = {c0v.x, c0v.y, c0v.z, c0v.w, c1v.x, c1v.y, c1v.z, c1v.w}, pw[8] = {p0v.x, p0v.y, p0v.z, p0v.w, p1v.x, p1v.y, p1v.z, p1v.w};
#pragma unroll
                for (int e = 0; e < 16; ++e) { const float cu = (e & 1) ? bfhi(cw[e >> 1]) : bflo(cw[e >> 1]), pv = (e & 1) ? bfhi(pw[e >> 1]) : bflo(pw[e >> 1]); z[e] = cu + (pv - cu) * mu16[e]; }
                float kk[16]; float ss = 0.f;
#pragma unroll
                for (int e = 0; e < 16; ++e) { kk[e] = z[e] * kw16[e]; ss += kk[e] * kk[e]; }
                ss = group_sum<4>(ss); const float kinv = rsqrtf(ss + 1e-12f);
                if (lane < 48) {
                    const int pl = lane < 16 ? 3 : (lane < 32 ? 0 : 4); bf16* dst = SCH + ((size_t)pl * NT + row) * 256 + (c0 & 255);
                    u32x4 o0, o1; o0.x = pk2(z[0], z[1]); o0.y = pk2(z[2], z[3]); o0.z = pk2(z[4], z[5]); o0.w = pk2(z[6], z[7]); o1.x = pk2(z[8], z[9]); o1.y = pk2(z[10], z[11]); o1.z = pk2(z[12], z[13]); o1.w = pk2(z[14], z[15]);
                    *(u32x4*)dst = o0; *(u32x4*)(dst + 8) = o1;
                    if (lane >= 16 && lane < 32) { bf16* d2 = SCH + ((size_t)1 * NT + row) * 256 + cc;
                        u32x4 q0, q1; q0.x = pk2(kk[0] * kinv, kk[1] * kinv); q0.y = pk2(kk[2] * kinv, kk[3] * kinv); q0.z = pk2(kk[4] * kinv, kk[5] * kinv); q0.w = pk2(kk[6] * kinv, kk[7] * kinv);
                        q1.x = pk2(kk[8] * kinv, kk[9] * kinv); q1.y = pk2(kk[10] * kinv, kk[11] * kinv); q1.z = pk2(kk[12] * kinv, kk[13] * kinv); q1.w = pk2(kk[14] * kinv, kk[15] * kinv);
                        *(u32x4*)d2 = q0; *(u32x4*)(d2 + 8) = q1; }
                } else {
                    float t[16];
#pragma unroll
                    for (int i = 0; i < 16; ++i) { const float sg = fsigmoid(lane < 52 ? 2.f * z[i] : z[i]); t[i] = lane < 52 ? 2.f * sg - 1.f : (lane < 56 ? z[i] : sg); }
                    bf16* dst = LIN + (size_t)row * 256 + (c0 - 768);
                    u32x4 o0, o1; o0.x = pk2(t[0], t[1]); o0.y = pk2(t[2], t[3]); o0.z = pk2(t[4], t[5]); o0.w = pk2(t[6], t[7]); o1.x = pk2(t[8], t[9]); o1.y = pk2(t[10], t[11]); o1.z = pk2(t[12], t[13]); o1.w = pk2(t[14], t[15]);
                    *(u32x4*)dst = o0; *(u32x4*)(dst + 8) = o1;
                }
            }
        }
        {
            const int ch = 4 * lane; const float* cw = C.conv_w + (size_t)l * 3 * 256 + ch; const f32x4 w0 = *(const f32x4*)cw, w1 = *(const f32x4*)(cw + 256), w2 = *(const f32x4*)(cw + 512);
            const f32x4 og = *(const f32x4*)(C.onorm_g + (size_t)l * 768 + ch);
#pragma unroll 2
            for (int r = 0; r < 16; ++r) {
                const int row = row0 + r, s = s0 + r; const bf16* pr = PROJ + (size_t)row * NPJ; float u[3][4];
#pragma unroll
                for (int d = 0; d < 3; ++d) {
                    u32x2 cg = (u32x2){0u, 0u}, xi = cg;
                    if (s >= d) { cg = *(const u32x2*)(pr - (size_t)d * NPJ + PJ_B + 256 + ch); xi = *(const u32x2*)(pr - (size_t)d * NPJ + PJ_B + 512 + ch); }
                    u[d][0] = bflo(cg.x) * bflo(xi.x); u[d][1] = bfhi(cg.x) * bfhi(xi.x); u[d][2] = bflo(cg.y) * bflo(xi.y); u[d][3] = bfhi(cg.y) * bfhi(xi.y);
                }
                const u32x2 bgv = *(const u32x2*)(pr + PJ_B + ch); const float bg[4] = {bflo(bgv.x), bfhi(bgv.x), bflo(bgv.y), bfhi(bgv.y)};
                float y[4]; float ss = 0.f;
#pragma unroll
                for (int i = 0; i < 4; ++i) { y[i] = bg[i] * (w0[i] * u[2][i] + w1[i] * u[1][i] + w2[i] * u[0][i]); ss += y[i] * y[i]; }
                ss = group_sum<16>(ss); const float rstd = rsqrtf(ss * (1.f / 64.f) + 1e-6f);
                u32x2 o; o.x = pk2(y[0] * rstd * og[0], y[1] * rstd * og[1]); o.y = pk2(y[2] * rstd * og[2], y[3] * rstd * og[3]);
                *(u32x2*)(YCAT + (size_t)row * DM + 256 + ch) = o;
            }
        }
        {
            const float* gq = C.dil_q_g + (size_t)l * 64; const float* gk = C.dil_k_g + (size_t)l * 64; const float* gn = C.nsa_q_g + (size_t)l * 64; const float* gv = (hh == 0 ? C.nsa_ks_g : C.nsa_kw_g) + (size_t)l * 64;
            float Gq[4], Gk[4], Gn[4], Gv[4];
#pragma unroll
            for (int i = 0; i < 4; ++i) { const int d = (i >> 1) * 32 + 2 * jj + (i & 1); Gq[i] = gq[d] * QSCALE; Gk[i] = gk[d]; Gn[i] = gn[d] * QSCALE; Gv[i] = gv[d]; }
            const int vcol = hh == 0 ? 2944 : (hh == 1 ? 3072 : (hh == 2 ? 2816 : 2880));
            bf16* vdst = (hh == 0 ? KS : (hh == 1 ? KW : (hh == 2 ? KCR : VCR)));
#pragma unroll 2
            for (int r = 0; r < 16; ++r) {
                const int row = row0 + r; const bf16* pr = PROJ + (size_t)row * NPJ;
                const float posf = (float)C.pos[row];
                const float x0 = __builtin_amdgcn_fractf(posf * inv0), x1 = __builtin_amdgcn_fractf(posf * inv1);
                const float sn0 = __builtin_amdgcn_sinf(x0), cs0 = __builtin_amdgcn_cosf(x0), sn1 = __builtin_amdgcn_sinf(x1), cs1 = __builtin_amdgcn_cosf(x1);
                const unsigned qa = *(const unsigned*)(pr + PJ_C + hh * 64 + 2 * jj), qb = *(const unsigned*)(pr + PJ_C + hh * 64 + 32 + 2 * jj);
                const unsigned ka = *(const unsigned*)(pr + PJ_C + 256 + hh * 64 + 2 * jj), kb = *(const unsigned*)(pr + PJ_C + 256 + hh * 64 + 32 + 2 * jj);
                const unsigned na = *(const unsigned*)(pr + PJ_D + hh * 64 + 2 * jj), nb = *(const unsigned*)(pr + PJ_D + hh * 64 + 32 + 2 * jj);
                const unsigned va = *(const unsigned*)(pr + vcol + 2 * jj), vb = *(const unsigned*)(pr + vcol + 32 + 2 * jj);
                float gate_in = 0.f; if (lane < 12) gate_in = bf2f(pr[3200 + lane]);
#define ROPE_NORM(a, b, G, o1, o2, n1a, n1b, n2a, n2b) \
                float n1a = bflo(a), n1b = bfhi(a), n2a = bflo(b), n2b = bfhi(b); { const float ss_ = group_sum<16>(n1a * n1a + n1b * n1b + n2a * n2a + n2b * n2b); const float rs_ = rsqrtf(ss_ * (1.f / 64.f) + 1e-6f); \
                    n1a *= rs_ * G[0]; n1b *= rs_ * G[1]; n2a *= rs_ * G[2]; n2b *= rs_ * G[3]; } \
                const unsigned o1 = pk2(n1a * cs0 - n2a * sn0, n1b * cs1 - n2b * sn1), o2 = pk2(n2a * cs0 + n1a * sn0, n2b * cs1 + n1b * sn1);
                ROPE_NORM(qa, qb, Gq, q1, q2, q1a, q1b, q2a, q2b)
                ROPE_NORM(ka, kb, Gk, k1, k2, k1a, k1b, k2a, k2b)
                ROPE_NORM(na, nb, Gn, r1, r2, r1a, r1b, r2a, r2b)
                ROPE_NORM(va, vb, Gv, v1, v2, v1a, v1b, v2a, v2b)
#undef ROPE_NORM
                bf16* o = QC + (size_t)row * 256 + hh * 64 + 2 * jj; *(unsigned*)o = q1; *(unsigned*)(o + 32) = q2;
                o = KC + (size_t)row * 256 + hh * 64 + 2 * jj; *(unsigned*)o = k1; *(unsigned*)(o + 32) = k2;
                o = QN + (size_t)row * 256 + hh * 64 + 2 * jj; *(unsigned*)o = pk2(r1a, r1b); *(unsigned*)(o + 32) = pk2(r2a, r2b);
                o = QR + (size_t)row * 256 + hh * 64 + 2 * jj; *(unsigned*)o = r1; *(unsigned*)(o + 32) = r2;
                o = vdst + (size_t)row * 64 + 2 * jj; *(unsigned*)o = (hh >= 2) ? va : v1; *(unsigned*)(o + 32) = (hh >= 2) ? vb : v2;
                if (lane < 12) GATE[(size_t)row * 12 + lane] = fsigmoid(gate_in);
            }
        }
    }
}
constexpr int SCAN_TC = 16;
DI void scan_unit8(const Ctx& C, int u) {
    const float* Wp = WSP(float, R_SC); const bf16* SCH = WSP(bf16, R_SCH); float* YA = WSP(float, R_YA); float* UB = WSP(float, R_SCANU); float* SMT = WSP(float, R_SCANS);
    const int pair = u / 3, kind = u % 3, b = pair >> 2, h = pair & 3, tid = C.tid;
    LAS float* buf = (LAS float*)C.lds;
    LAS float* ybuf = buf + 2 * 6144;
    const int row = tid >> 3, cg = tid & 7, tbase = kind == 0 ? 0 : NS / 2;
    const float vm = kind == 2 ? 0.f : 1.f;
    u32x4 ldA[2], ldB[2];
#define SCAN_LOAD(ld, chunk) do { _Pragma("unroll") for (int i = 0; i < 2; ++i) { const int p_ = tid + 512 * i; if (p_ < 896) { const int step = p_ / 56, r_ = p_ % 56; const size_t row_ = (size_t)b * NS + tbase + (chunk) * SCAN_TC + step; \
        if (r_ < 16) ld[i] = *(const u32x4*)(Wp + row_ * 256 + h * 64 + r_ * 4); else { const int v5 = (r_ - 16) >> 3, c_ = (r_ - 16) & 7; ld[i] = *(const u32x4*)(SCH + ((size_t)v5 * NT + row_) * 256 + h * 64 + c_ * 8); } } } } while (0)
#define SCAN_STORE(ld, slot) do { _Pragma("unroll") for (int i = 0; i < 2; ++i) { const int p_ = tid + 512 * i; if (p_ < 896) { const int step = p_ / 56, r_ = p_ % 56; LAS float* d_ = buf + (slot) * 6144 + step * 384; \
        if (r_ < 16) *(LAS u32x4*)(d_ + r_ * 4) = ld[i]; else { const int v5 = (r_ - 16) >> 3, c_ = (r_ - 16) & 7; LAS float* e_ = d_ + (1 + v5) * 64 + c_ * 8; const u32x4 x_ = ld[i]; \
            *(LAS f32x4*)e_ = (f32x4){bflo(x_.x), bfhi(x_.x), bflo(x_.y), bfhi(x_.y)}; *(LAS f32x4*)(e_ + 4) = (f32x4){bflo(x_.z), bfhi(x_.z), bflo(x_.w), bfhi(x_.w)}; } } } } while (0)
#define SCAN_FLUSH(chunk) do { _Pragma("unroll") for (int i = 0; i < 2; ++i) { const int i2 = tid + 512 * i, step = i2 >> 6, rr = i2 & 63; const LAS float* pp_ = ybuf + ((chunk) & 1) * 8192 + step * 512 + rr * 8; \
        const f32x4 pa_ = *(const LAS f32x4*)pp_, pb_ = *(const LAS f32x4*)(pp_ + 4); const float yv = ((pa_[0] + pa_[1]) + (pa_[2] + pa_[3])) + ((pb_[0] + pb_[1]) + (pb_[2] + pb_[3])); \
        if (kind == 2) UB[((size_t)b * (NS / 2) + (chunk) * SCAN_TC + step) * 256 + h * 64 + rr] = yv; else YA[((size_t)b * NS + tbase + (chunk) * SCAN_TC + step) * 256 + h * 64 + rr] = yv; } } while (0)
    __syncthreads();
    SCAN_LOAD(ldA, 0); SCAN_STORE(ldA, 0); SCAN_LOAD(ldB, 1); SCAN_LOAD(ldA, 2);
    f32x2 S[4];
#pragma unroll
    for (int c = 0; c < 4; ++c) { S[c][0] = (kind == 2 && row == 8 * cg + 2 * c) ? 1.f : 0.f; S[c][1] = (kind == 2 && row == 8 * cg + 2 * c + 1) ? 1.f : 0.f; }
    constexpr int NCH = (NS / 2) / SCAN_TC;
#pragma unroll 2
    for (int ck = 0; ck < NCH; ++ck) {
        __syncthreads();
        if (ck & 1) { if (ck + 1 < NCH) SCAN_STORE(ldA, (ck + 1) & 1); if (ck + 3 < NCH) SCAN_LOAD(ldA, ck + 3); }
        else        { if (ck + 1 < NCH) SCAN_STORE(ldB, (ck + 1) & 1); if (ck + 3 < NCH) SCAN_LOAD(ldB, ck + 3); }
        {
            const LAS float* bp = buf + (ck & 1) * 6144; LAS float* yb = ybuf + (ck & 1) * 8192 + tid;
#define SCAN_LDS(X, step) do { const LAS float* sp = bp + (step) * 384 + 8 * cg; X.w0 = *(const LAS f32x4*)(sp); X.w1 = *(const LAS f32x4*)(sp + 4); X.k0 = *(const LAS f32x4*)(sp + 64); X.k1 = *(const LAS f32x4*)(sp + 68); \
                X.q0 = *(const LAS f32x4*)(sp + 128); X.q1 = *(const LAS f32x4*)(sp + 132); X.b0 = *(const LAS f32x4*)(sp + 192); X.b1 = *(const LAS f32x4*)(sp + 196); \
                X.r0 = *(const LAS f32x4*)(sp + 256); X.r1 = *(const LAS f32x4*)(sp + 260); X.v = bp[(step) * 384 + 320 + row] * vm; } while (0)
#define SCAN_STEP(X, step) do { \
                f32x2 d2 = S[0] * (f32x2){X.q0[0], X.q0[1]}; d2 = S[1] * (f32x2){X.q0[2], X.q0[3]} + d2; d2 = S[2] * (f32x2){X.q1[0], X.q1[1]} + d2; d2 = S[3] * (f32x2){X.q1[2], X.q1[3]} + d2; \
                const float sa = -sum8(d2[0] + d2[1]); const f32x2 sa2 = (f32x2){sa, sa}, v2 = (f32x2){X.v, X.v}; \
                S[0] = S[0] * (f32x2){X.w0[0], X.w0[1]} + (sa2 * (f32x2){X.b0[0], X.b0[1]} + v2 * (f32x2){X.k0[0], X.k0[1]}); \
                S[1] = S[1] * (f32x2){X.w0[2], X.w0[3]} + (sa2 * (f32x2){X.b0[2], X.b0[3]} + v2 * (f32x2){X.k0[2], X.k0[3]}); \
                S[2] = S[2] * (f32x2){X.w1[0], X.w1[1]} + (sa2 * (f32x2){X.b1[0], X.b1[1]} + v2 * (f32x2){X.k1[0], X.k1[1]}); \
                S[3] = S[3] * (f32x2){X.w1[2], X.w1[3]} + (sa2 * (f32x2){X.b1[2], X.b1[3]} + v2 * (f32x2){X.k1[2], X.k1[3]}); \
                f32x2 y2 = S[0] * (f32x2){X.r0[0], X.r0[1]}; y2 = S[1] * (f32x2){X.r0[2], X.r0[3]} + y2; y2 = S[2] * (f32x2){X.r1[0], X.r1[1]} + y2; y2 = S[3] * (f32x2){X.r1[2], X.r1[3]} + y2; \
                yb[(step) * 512] = y2[0] + y2[1]; } while (0)
            struct StepIn { f32x4 w0, w1, k0, k1, q0, q1, b0, b1, r0, r1; float v; } A, B;
            SCAN_LDS(A, 0);
#pragma unroll 2
            for (int step = 0; step < SCAN_TC; step += 2) {
                SCAN_LDS(B, step + 1);
                __builtin_amdgcn_sched_barrier(0);
                SCAN_STEP(A, step);
                __builtin_amdgcn_sched_barrier(0);
                if (step + 2 < SCAN_TC) SCAN_LDS(A, step + 2);
                __builtin_amdgcn_sched_barrier(0);
                SCAN_STEP(B, step + 1);
                __builtin_amdgcn_sched_barrier(0);
            }
#undef SCAN_LDS
#undef SCAN_STEP
        }
        if (ck > 0) SCAN_FLUSH(ck - 1);
    }
    __syncthreads();
    SCAN_FLUSH(NCH - 1);
    if (kind == 0) {
        float* o = SMT + (size_t)pair * 4096 + row;
#pragma unroll
        for (int c = 0; c < 4; ++c) { o[(8 * cg + 2 * c) * 64] = S[c][0]; o[(8 * cg + 2 * c + 1) * 64] = S[c][1]; }
    }
#undef SCAN_LOAD
#undef SCAN_STORE
#undef SCAN_FLUSH
    __syncthreads();
}

constexpr int KROW = 144, KT_BYTES = 64 * KROW;
#define MFMA16(a, b, c) __builtin_amdgcn_mfma_f32_16x16x32_bf16((a), (b), (c), 0, 0, 0)
template <int NQT> struct FA { f32x4 O[NQT][4]; float l[NQT]; float negM; };
template <int NQT> DI void fa_init(FA<NQT>& st) {
#pragma unroll
    for (int q = 0; q < NQT; ++q) { st.l[q] = 0.f;
#pragma unroll
        for (int d = 0; d < 4; ++d) st.O[q][d] = (f32x4){0.f, 0.f, 0.f, 0.f}; }
}
DI bf16x8 pack8(const f32x4& a, const f32x4& b) { u32x4 w; w.x = pk2(a[0], a[1]); w.y = pk2(a[2], a[3]); w.z = pk2(b[0], b[1]); w.w = pk2(b[2], b[3]); return __builtin_bit_cast(bf16x8, w); }
struct VFrag { u32x2 a[4], b[4]; };
DI void vt_issue(VFrag& f, unsigned vaddr) {
    asm volatile("ds_read_b64_tr_b16 %0, %8\n\tds_read_b64_tr_b16 %1, %8 offset:2304\n\tds_read_b64_tr_b16 %2, %8 offset:32\n\tds_read_b64_tr_b16 %3, %8 offset:2336\n\t"
                 "ds_read_b64_tr_b16 %4, %8 offset:64\n\tds_read_b64_tr_b16 %5, %8 offset:2368\n\tds_read_b64_tr_b16 %6, %8 offset:96\n\tds_read_b64_tr_b16 %7, %8 offset:2400"
                 : "=&v"(f.a[0]), "=&v"(f.b[0]), "=&v"(f.a[1]), "=&v"(f.b[1]), "=&v"(f.a[2]), "=&v"(f.b[2]), "=&v"(f.a[3]), "=&v"(f.b[3]) : "v"(vaddr) : "memory");
}
DI void vt_wait(VFrag& f) { asm volatile("s_waitcnt lgkmcnt(0)" : "+v"(f.a[0]), "+v"(f.b[0]), "+v"(f.a[1]), "+v"(f.b[1]), "+v"(f.a[2]), "+v"(f.b[2]), "+v"(f.a[3]), "+v"(f.b[3]) :: "memory"); }
DI bf16x8 vt_get(const VFrag& f, int d) { return __builtin_bit_cast(bf16x8, ((u32x4){f.a[d].x, f.a[d].y, f.b[d].x, f.b[d].y})); }
template <int NQT, bool MASKED, class MaskF>
DI void fa_tile(FA<NQT>& st, const bf16x8 (&Q)[NQT][2], const LAS uchar* Ks, const LAS uchar* Vs, int lane, const MaskF& allowed, const bool (&act)[NQT]) {
    const int l15 = lane & 15, quad = lane >> 4;
    float nm_ = st.negM; asm volatile("" : "+v"(nm_));
    f32x4 S[NQT][4]; const f32x4 sinit = (f32x4){nm_, nm_, nm_, nm_};
#pragma unroll
    for (int kt = 0; kt < 4; ++kt) {
        const bf16x8 k0 = *(const LAS bf16x8*)(Ks + (16 * kt + l15) * KROW + quad * 16), k1 = *(const LAS bf16x8*)(Ks + (16 * kt + l15) * KROW + 64 + quad * 16);
#pragma unroll
        for (int q = 0; q < NQT; ++q) if (act[q]) { S[q][kt] = MFMA16(k0, Q[q][0], sinit); S[q][kt] = MFMA16(k1, Q[q][1], S[q][kt]); }
    }
    const unsigned vaddr = (unsigned)(size_t)(Vs + (4 * quad + (l15 >> 2)) * KROW + 8 * (l15 & 3));
    VFrag v0, v1; vt_issue(v0, vaddr);
#pragma unroll
    for (int q = 0; q < NQT; ++q) if (act[q]) {
        float rs = 0.f;
#pragma unroll
        for (int kt = 0; kt < 4; ++kt)
#pragma unroll
            for (int j = 0; j < 4; ++j) { float p = fexp2(S[q][kt][j]); if (MASKED) p = allowed(q, 16 * kt + 4 * quad + j) ? p : 0.f; S[q][kt][j] = p; rs += p; }
        st.l[q] += rs;
    }
    vt_wait(v0); vt_issue(v1, vaddr + 32 * KROW);
#pragma unroll
    for (int q = 0; q < NQT; ++q) if (act[q]) {
        const bf16x8 p0 = pack8(S[q][0], S[q][1]);
#pragma unroll
        for (int d = 0; d < 4; ++d) st.O[q][d] = MFMA16(vt_get(v0, d), p0, st.O[q][d]);
    }
    vt_wait(v1);
#pragma unroll
    for (int q = 0; q < NQT; ++q) if (act[q]) {
        const bf16x8 p1 = pack8(S[q][2], S[q][3]);
#pragma unroll
        for (int d = 0; d < 4; ++d) st.O[q][d] = MFMA16(vt_get(v1, d), p1, st.O[q][d]);
    }
}
template <int NQT> DI void fa_finish(FA<NQT>& st, float (&lse2)[NQT]) {
#pragma unroll
    for (int q = 0; q < NQT; ++q) { float l = st.l[q]; l += __shfl_xor(l, 16); l += __shfl_xor(l, 32); const float inv = l > 0.f ? 1.f / l : 0.f; lse2[q] = __log2f(fmaxf(l, 1e-37f));
#pragma unroll
        for (int d = 0; d < 4; ++d) st.O[q][d] = st.O[q][d] * inv; }
}
DI float score_bound(const float* gq, const float* gk, int lane) {
    float a = fabsf(gq[lane & 63]), b = fabsf(gk[lane & 63]);
#pragma unroll
    for (int o = 1; o < 64; o <<= 1) { a = fmaxf(a, __shfl_xor(a, o)); b = fmaxf(b, __shfl_xor(b, o)); }
    return __builtin_bit_cast(float, __builtin_amdgcn_readfirstlane(__builtin_bit_cast(int, 64.f * a * b * QSCALE * 1.02f + 0.5f)));
}
DI void kv_store(LAS uchar* Ks, LAS uchar* Vs, int tid, const u32x4& kr, const u32x4& vr) {
    const int o = (tid >> 3) * KROW + (tid & 7) * 16; *(LAS u32x4*)(Ks + o) = kr; *(LAS u32x4*)(Vs + o) = vr;
}
DI void q_load(bf16x8 (&Q)[2], const bf16* qrow, int quad) { Q[0] = *(const bf16x8*)(qrow + 8 * quad); Q[1] = *(const bf16x8*)(qrow + 32 + 8 * quad); }

struct DilMask { int qi[2]; int k0; DI bool operator()(int q, int key) const { const int ki = k0 + key, d = qi[q] - ki; return ki >= 0 && (unsigned)d <= 128u; } };
DI void dil_unit(const Ctx& C, int unit, LAS uchar* lds0, LAS uchar*  , float negM_bound) {
    const bf16 *QC = WSP(bf16, R_QC), *KC = WSP(bf16, R_KC), *PROJ = WSP(bf16, R_PROJ); float* OC = WSP(float, R_OC); float* LSE = WSP(float, R_LSE);
    int tid = C.tid, lane = C.lane; asm volatile("" : "+v"(tid), "+v"(lane));
    const int w = C.wave, l15 = lane & 15, quad = lane >> 4, wq = w & 3;
    const int cfg = unit / 512, r = unit % 512, dsh = 2 * cfg, d = 1 << dsh;
    const int b = r >> 6, hp = (r >> 5) & 1, r2 = r & 31;
    const int nblk = 32 >> dsh, res = r2 / nblk, blk = r2 % nblk, i0 = blk * 128, h = 2 * hp + (w >> 2);
    const size_t tb = (size_t)b * NS;
    bf16x8 Q[2][2]; DilMask mk; FA<2> st; fa_init(st); st.negM = -negM_bound;
#pragma unroll
    for (int q = 0; q < 2; ++q) { mk.qi[q] = i0 + 32 * wq + 16 * q + l15; q_load(Q[q], QC + (tb + res + (size_t)d * mk.qi[q]) * 256 + h * 64, quad); }
    const int jlo = wq >> 1, jhi = (wq >> 1) + 2;
    const bool act[2] = {true, true};
    u32x4 kr0, vr0, kr1, vr1;
#define DIL_LOAD(j) do { const int ki = i0 - 128 + 64 * (j) + (tid >> 3); kr0 = (u32x4){0u, 0u, 0u, 0u}; vr0 = kr0; kr1 = kr0; vr1 = kr0; \
    if (ki >= 0) { const size_t rowk = tb + res + (size_t)d * ki; const bf16* kp = KC + rowk * 256 + 128 * hp + (tid & 7) * 8; const bf16* vp = PROJ + rowk * NPJ + PJ_C + 512 + 128 * hp + (tid & 7) * 8; \
        kr0 = *(const u32x4*)kp; kr1 = *(const u32x4*)(kp + 64); vr0 = *(const u32x4*)vp; vr1 = *(const u32x4*)(vp + 64); } } while (0)
#define DIL_STORE(p) do { LAS uchar* b_ = lds0 + (p) * 4 * KT_BYTES; kv_store(b_, b_ + KT_BYTES, tid, kr0, vr0); kv_store(b_ + 2 * KT_BYTES, b_ + 3 * KT_BYTES, tid, kr1, vr1); } while (0)
    DIL_LOAD(0); __syncthreads(); DIL_STORE(0); DIL_LOAD(1);
    for (int j = 0; j < 4; ++j) {
        __syncthreads();
        if (j + 1 < 4) DIL_STORE((j + 1) & 1);
        if (j + 2 < 4) DIL_LOAD(j + 2);
        if (j >= jlo && j <= jhi) { mk.k0 = i0 - 128 + 64 * j; const LAS uchar* kb = lds0 + (j & 1) * 4 * KT_BYTES + (w >> 2) * 2 * KT_BYTES; fa_tile<2, true>(st, Q, kb, kb + KT_BYTES, lane, mk, act); }
    }
#undef DIL_LOAD
#undef DIL_STORE
    float lse2[2]; fa_finish<2>(st, lse2);
#pragma unroll
    for (int q = 0; q < 2; ++q) { const size_t rowq = tb + res + (size_t)d * mk.qi[q]; bf16* o = (bf16*)OC + ((size_t)cfg * NT + rowq) * 256 + h * 64 + 4 * quad;
#pragma unroll
        for (int dt = 0; dt < 4; ++dt) { u32x2 w_; w_.x = pk2(st.O[q][dt][0], st.O[q][dt][1]); w_.y = pk2(st.O[q][dt][2], st.O[q][dt][3]); *(u32x2*)(o + 16 * dt) = w_; }
        if (quad == 0) LSE[((size_t)cfg * NT + rowq) * 4 + h] = lse2[q]; }
}
constexpr int NSA_KC = 0, NSA_VC = 256 * KROW, NSA_KT = 2 * 256 * KROW, NSA_VT = NSA_KT + KT_BYTES, NSA_IMP = NSA_KT + 4 * KT_BYTES,
    NSA_SELM = NSA_IMP + 64 * 64 * 4, NSA_UW = NSA_SELM + 512;
static_assert(NSA_UW + 16 <= RING_BYTES, "NSA LDS map");
DI void cmp_mlp_wait(const Ctx& C, int l);
struct SwaMask { int t[2]; int k0; DI bool operator()(int q, int key) const { const int d = t[q] - (k0 + key); return (unsigned)d <= 511u; } };
struct SlcMask { int t[2]; int k0; bool sel[2]; DI bool operator()(int q, int key) const { return sel[q] && (k0 + key <= t[q]); } };
struct NoMask { DI bool operator()(int, int) const { return true; } };
DI void nsa_unit(const Ctx& C, int l, int b, int tbk, int& bl, bool& cmp_ready, float bnd_cmp, float bnd_slc, float bnd_swa) {
    const bf16 *QN = WSP(bf16, R_QN), *QR = WSP(bf16, R_QR), *KSb = WSP(bf16, R_KS), *KWb = WSP(bf16, R_KW), *PROJ = WSP(bf16, R_PROJ); const float* CMP = WSP(float, R_CMP); const float* GATE = WSP(float, R_GATE);
    bf16* YCAT = WSP(bf16, R_YCAT);
    LAS uchar* Kc = C.lds + NSA_KC; LAS uchar* Vc = C.lds + NSA_VC; LAS uchar* Ks = C.lds + NSA_KT; LAS uchar* Vs = C.lds + NSA_VT;
    LAS float* imps = (LAS float*)(C.lds + NSA_IMP); LAS unsigned* selm = (LAS unsigned*)(C.lds + NSA_SELM); LAS unsigned* uw = (LAS unsigned*)(C.lds + NSA_UW);
    int tid = C.tid, lane = C.lane; asm volatile("" : "+v"(tid), "+v"(lane));
    const int w = C.wave, l15 = lane & 15, quad = lane >> 4, head = l15 & 3, t0 = 64 * tbk; const size_t tb = (size_t)b * NS;
    __syncthreads();
    if (b != bl) {
        if (!cmp_ready) { cmp_mlp_wait(C, l); cmp_ready = true; }
        const int key = tid >> 1, hf = tid & 1; const float* kp = CMP + ((size_t)b * 256 + key) * 64 + 32 * hf; const float* vp = CMP + ((size_t)2048 + (size_t)b * 256 + key) * 64 + 32 * hf;
        float kv[32], vv[32]; float ss = 0.f;
#pragma unroll
        for (int i = 0; i < 8; ++i) { const f32x4 a = *(const f32x4*)(kp + 4 * i), c = *(const f32x4*)(vp + 4 * i);
#pragma unroll
            for (int j = 0; j < 4; ++j) { kv[4 * i + j] = a[j]; vv[4 * i + j] = c[j]; ss += a[j] * a[j]; } }
        ss += __shfl_xor(ss, 1); const float rstd = rsqrtf(ss * (1.f / 64.f) + 1e-6f); const float* g = C.nsa_kc_g + (size_t)l * 64 + 32 * hf; const bool dead = (key == 255);
#pragma unroll
        for (int i = 0; i < 4; ++i) { u32x4 o, p;
            o.x = pk2(kv[8 * i] * rstd * g[8 * i], kv[8 * i + 1] * rstd * g[8 * i + 1]); o.y = pk2(kv[8 * i + 2] * rstd * g[8 * i + 2], kv[8 * i + 3] * rstd * g[8 * i + 3]);
            o.z = pk2(kv[8 * i + 4] * rstd * g[8 * i + 4], kv[8 * i + 5] * rstd * g[8 * i + 5]); o.w = pk2(kv[8 * i + 6] * rstd * g[8 * i + 6], kv[8 * i + 7] * rstd * g[8 * i + 7]);
            p.x = pk2(vv[8 * i], vv[8 * i + 1]); p.y = pk2(vv[8 * i + 2], vv[8 * i + 3]); p.z = pk2(vv[8 * i + 4], vv[8 * i + 5]); p.w = pk2(vv[8 * i + 6], vv[8 * i + 7]);
            if (dead) { o = (u32x4){0u, 0u, 0u, 0u}; p = o; }
            *(LAS u32x4*)(Kc + key * KROW + hf * 64 + i * 16) = o; *(LAS u32x4*)(Vc + key * KROW + hf * 64 + i * 16) = p; }
        bl = b;
        __syncthreads();
    }
    f32x4 Oc[2][4];
    const int cmaxu = (t0 + 32) >> 4, ktmax = cmaxu >> 4;
    const unsigned vaddr0 = (unsigned)(size_t)(Vc + (4 * quad + (l15 >> 2)) * KROW + 8 * (l15 & 3));
#pragma unroll
    for (int q = 0; q < 2; ++q) {
        const int t = t0 + 8 * w + 4 * q + (l15 >> 2);
        bf16x8 Q[2]; q_load(Q, QN + (tb + t) * 256 + head * 64, quad);
        float nm_ = -bnd_cmp; asm volatile("" : "+v"(nm_)); f32x4 S[16]; const f32x4 sinit = (f32x4){nm_, nm_, nm_, nm_}; float ls = 0.f;
#pragma unroll
        for (int kt = 0; kt < 16; ++kt) {
            if (kt <= ktmax) {
                const bf16x8 k0 = *(const LAS bf16x8*)(Kc + (16 * kt + l15) * KROW + quad * 16), k1 = *(const LAS bf16x8*)(Kc + (16 * kt + l15) * KROW + 64 + quad * 16);
                S[kt] = MFMA16(k0, Q[0], sinit); S[kt] = MFMA16(k1, Q[1], S[kt]);
#pragma unroll
                for (int j = 0; j < 4; ++j) { const int c = 16 * kt + 4 * quad + j; const float p = (16 * c + 31 <= t) ? fexp2(S[kt][j]) : 0.f; S[kt][j] = p; ls += p; }
            } else S[kt] = (f32x4){0.f, 0.f, 0.f, 0.f};
        }
        ls += __shfl_xor(ls, 16); ls += __shfl_xor(ls, 32);
        const float inv = ls > 0.f ? 1.f / ls : 0.f;
#pragma unroll
        for (int kt = 0; kt < 16; ++kt) S[kt] = S[kt] * inv;
#pragma unroll
        for (int kt = 0; kt < 16; ++kt) {
            const float send = (quad == 3) ? (kt > 0 ? S[kt > 0 ? kt - 1 : 0][3] : 0.f) : S[kt][3];
            const float prev = __shfl(send, (lane + 48) & 63);
            float v = ((quad == 0 && kt == 0) ? 0.f : prev) + 2.f * (S[kt][0] + S[kt][1] + S[kt][2]) + S[kt][3];
            v = group_sum<4>(v);
            if (head == 0) imps[(8 * w + 4 * q + (l15 >> 2)) * 64 + 4 * kt + quad] = v;
        }
#pragma unroll
        for (int d = 0; d < 4; ++d) Oc[q][d] = (f32x4){0.f, 0.f, 0.f, 0.f};
#pragma unroll
        for (int ks = 0; ks < 8; ++ks) {
            if (2 * ks <= ktmax) {
                VFrag vf; vt_issue(vf, vaddr0 + ks * 32 * KROW); const bf16x8 pf = pack8(S[2 * ks], S[2 * ks + 1]); vt_wait(vf);
#pragma unroll
                for (int d = 0; d < 4; ++d) Oc[q][d] = MFMA16(vt_get(vf, d), pf, Oc[q][d]);
            }
        }
    }
    {
        bf16* OCm = WSP(bf16, R_OCMP);
#pragma unroll
        for (int q = 0; q < 2; ++q) { bf16* o = OCm + (tb + t0 + 8 * w + 4 * q + (l15 >> 2)) * 256 + head * 64 + 4 * quad;
#pragma unroll
            for (int d = 0; d < 4; ++d) { u32x2 w_; w_.x = pk2(Oc[q][d][0], Oc[q][d][1]); w_.y = pk2(Oc[q][d][2], Oc[q][d][3]); *(u32x2*)(o + 16 * d) = w_; } }
    }
    __syncthreads();
    if (tid < 64) {
        const int cur = tbk; unsigned long long mask;
        if (cur <= 15) mask = (2ull << cur) - 1ull;
        else {
            mask = 1ull | (1ull << cur) | (1ull << (cur - 1));
            float v[64];
#pragma unroll
            for (int i = 0; i < 16; ++i) { const f32x4 a = *(const LAS f32x4*)(imps + tid * 64 + 4 * i);
#pragma unroll
                for (int j = 0; j < 4; ++j) { const int jb = 4 * i + j; v[jb] = (jb >= 1 && jb <= cur - 2) ? a[j] : -1.f; } }
#pragma unroll 1
            for (int r = 0; r < 13; ++r) {
                float bv = -0.5f; int bi = 0;
#pragma unroll
                for (int jb = 0; jb < 64; ++jb) if (v[jb] > bv) { bv = v[jb]; bi = jb; }
                mask |= 1ull << bi;
#pragma unroll
                for (int jb = 0; jb < 64; ++jb) v[jb] = (jb == bi) ? -1.f : v[jb];
            }
        }
        unsigned lo = (unsigned)mask, hi = (unsigned)(mask >> 32);
        selm[2 * tid] = lo; selm[2 * tid + 1] = hi;
#pragma unroll
        for (int o = 1; o < 64; o <<= 1) { lo |= __shfl_xor(lo, o); hi |= __shfl_xor(hi, o); }
        if (tid == 0) { uw[0] = lo; uw[1] = hi; }
    }
    __syncthreads();
    unsigned long long U = ((unsigned long long)uw[1] << 32) | uw[0];
    bf16x8 Q[2][2]; SlcMask mk; FA<2> st; fa_init(st); st.negM = -bnd_slc; unsigned long long msk[2];
#pragma unroll
    for (int q = 0; q < 2; ++q) { const int tl = 8 * w + 4 * q + (l15 >> 2); mk.t[q] = t0 + tl; msk[q] = ((unsigned long long)selm[2 * tl + 1] << 32) | selm[2 * tl]; q_load(Q[q], QR + (tb + mk.t[q]) * 256 + head * 64, quad); }
    unsigned long long QM[2];
#pragma unroll
    for (int q = 0; q < 2; ++q) { unsigned lo = (unsigned)msk[q], hi = (unsigned)(msk[q] >> 32);
#pragma unroll
        for (int o = 1; o < 64; o <<= 1) { lo |= __shfl_xor(lo, o); hi |= __shfl_xor(hi, o); }
        QM[q] = ((unsigned long long)hi << 32) | lo; }
#ifndef PROBE_SLC2
#define PROBE_SLC2 0
#endif
#ifndef PROBE_SWA2
#define PROBE_SWA2 0
#endif
    u32x4 kr, vr; const unsigned long long U0 = U;
    for (int prep_ = 0; prep_ <= PROBE_SLC2; ++prep_) { U = U0; if (prep_ < PROBE_SLC2) { fa_init(st); }
#define SLC_LOAD(j) do { const size_t rowk = tb + 64 * (j) + (tid >> 3); kr = *(const u32x4*)(KSb + rowk * 64 + (tid & 7) * 8); vr = *(const u32x4*)(PROJ + rowk * NPJ + 3008 + (tid & 7) * 8); } while (0)
    {
        int j = __builtin_ctzll(U); U &= U - 1ull;
        int jn = U ? __builtin_ctzll(U) : -1; U &= U - 1ull;
        SLC_LOAD(j); __syncthreads(); kv_store(Ks, Vs, tid, kr, vr); if (jn >= 0) SLC_LOAD(jn);
        for (int it = 0;; ++it) {
            __syncthreads();
            const int jnn = U ? __builtin_ctzll(U) : -1; U &= U - 1ull;
            if (jn >= 0) kv_store(Ks + ((it + 1) & 1) * 2 * KT_BYTES, Vs + ((it + 1) & 1) * 2 * KT_BYTES, tid, kr, vr);
            if (jnn >= 0) SLC_LOAD(jnn);
            const bool act[2] = {(bool)((QM[0] >> j) & 1ull), (bool)((QM[1] >> j) & 1ull)};
            if (act[0] || act[1]) { mk.k0 = 64 * j; mk.sel[0] = (msk[0] >> j) & 1ull; mk.sel[1] = (msk[1] >> j) & 1ull; fa_tile<2, true>(st, Q, Ks + (it & 1) * 2 * KT_BYTES, Vs + (it & 1) * 2 * KT_BYTES, lane, mk, act); }
            if (jn < 0) break; j = jn; jn = jnn;
        }
    }
#undef SLC_LOAD
    }
    float lse2[2]; fa_finish<2>(st, lse2);
    {   bf16* OSl = WSP(bf16, R_OSLC);
#pragma unroll
        for (int q = 0; q < 2; ++q) { bf16* o = OSl + (tb + mk.t[q]) * 256 + head * 64 + 4 * quad;
#pragma unroll
            for (int d = 0; d < 4; ++d) { u32x2 w_; w_.x = pk2(st.O[q][d][0], st.O[q][d][1]); w_.y = pk2(st.O[q][d][2], st.O[q][d][3]); *(u32x2*)(o + 16 * d) = w_; } }
    }
    FA<2> sw; fa_init(sw); sw.negM = -bnd_swa; SwaMask mw; mw.t[0] = mk.t[0]; mw.t[1] = mk.t[1];
    for (int prep_ = 0; prep_ <= PROBE_SWA2; ++prep_) { if (prep_ < PROBE_SWA2) fa_init(sw);
    {
        const int j0 = tbk >= 8 ? tbk - 8 : 0; const bool act[2] = {true, true};
#define SWA_LOAD(j) do { const size_t rowk = tb + 64 * (j) + (tid >> 3); kr = *(const u32x4*)(KWb + rowk * 64 + (tid & 7) * 8); vr = *(const u32x4*)(PROJ + rowk * NPJ + 3136 + (tid & 7) * 8); } while (0)
        SWA_LOAD(j0); __syncthreads(); kv_store(Ks, Vs, tid, kr, vr); if (j0 + 1 <= tbk) SWA_LOAD(j0 + 1);
        for (int j = j0; j <= tbk; ++j) {
            const int pb_ = (j - j0) & 1;
            __syncthreads();
            if (j + 1 <= tbk) kv_store(Ks + (pb_ ^ 1) * 2 * KT_BYTES, Vs + (pb_ ^ 1) * 2 * KT_BYTES, tid, kr, vr);
            if (j + 2 <= tbk) SWA_LOAD(j + 2);
            mw.k0 = 64 * j;
            if (j == tbk || j == tbk - 8) fa_tile<2, true>(sw, Q, Ks + pb_ * 2 * KT_BYTES, Vs + pb_ * 2 * KT_BYTES, lane, mw, act);
            else fa_tile<2, false>(sw, Q, Ks + pb_ * 2 * KT_BYTES, Vs + pb_ * 2 * KT_BYTES, lane, NoMask(), act);
        }
#undef SWA_LOAD
    }
    }
    fa_finish<2>(sw, lse2);
#pragma unroll
    for (int q = 0; q < 2; ++q) {
        const size_t row = tb + mk.t[q]; const float* gp = GATE + row * 12 + head * 3; const float g0 = gp[0], g1 = gp[1], g2 = gp[2];
        f32x4 o[4]; float ss = 0.f; const bf16* pc = WSP(bf16, R_OCMP) + row * 256 + head * 64 + 4 * quad; const bf16* ps = WSP(bf16, R_OSLC) + row * 256 + head * 64 + 4 * quad;
#pragma unroll
        for (int d = 0; d < 4; ++d) { const u32x2 c_ = *(const u32x2*)(pc + 16 * d), s_ = *(const u32x2*)(ps + 16 * d);
            o[d] = (f32x4){bflo(c_.x), bfhi(c_.x), bflo(c_.y), bfhi(c_.y)} * g0 + (f32x4){bflo(s_.x), bfhi(s_.x), bflo(s_.y), bfhi(s_.y)} * g1 + sw.O[q][d] * g2; ss += (o[d][0] * o[d][0] + o[d][1] * o[d][1]) + (o[d][2] * o[d][2] + o[d][3] * o[d][3]); }
        ss += __shfl_xor(ss, 16); ss += __shfl_xor(ss, 32);
        const float rstd = rsqrtf(ss * (1.f / 64.f) + 1e-6f); const float* og = C.onorm_g + (size_t)l * 768 + 512 + head * 64 + 4 * quad;
        bf16* yo = YCAT + row * DM + 768 + head * 64 + 4 * quad;
#pragma unroll
        for (int d = 0; d < 4; ++d) { const f32x4 g4 = *(const f32x4*)(og + 16 * d); u32x2 wv; wv.x = pk2(o[d][0] * rstd * g4[0], o[d][1] * rstd * g4[1]); wv.y = pk2(o[d][2] * rstd * g4[2], o[d][3] * rstd * g4[3]); *(u32x2*)(yo + 16 * d) = wv; }
    }
}

DI void fin_phase(const Ctx& C, int l) {
    const bf16* SCH = WSP(bf16, R_SCH); const float* YA = WSP(float, R_YA); const bf16* Gb = WSP(bf16, R_G); const float* OC = WSP(float, R_OC); const float* LSE = WSP(float, R_LSE);
    const float* UB = WSP(float, R_SCANU); const float* SMT = WSP(float, R_SCANS); bf16* YCAT = WSP(bf16, R_YCAT);
    const int lane = C.lane, ch = 4 * lane, hh = lane >> 4;
    LAS float* sm = (LAS float*)C.lds;
    LAS float* us = sm + 4 * 4096 + C.wave * 512;
    const f32x4 rk = *(const f32x4*)(C.rk + (size_t)l * 256 + ch), gw4 = *(const f32x4*)(C.gn_w + (size_t)l * 256 + ch), gb4 = *(const f32x4*)(C.gn_b + (size_t)l * 256 + ch);
    const f32x4 og = *(const f32x4*)(C.onorm_g + (size_t)l * 768 + 256 + ch);
    int bl = -1;
    for (int it = C.bid; it < NT / 128; it += C.G) {
        const int b = it >> 5, kk = it & 31;
        if (b != bl) { __syncthreads(); for (int i = C.tid; i < 4096; i += NTHR) *(LAS f32x4*)(sm + 4 * i) = *(const f32x4*)(SMT + (size_t)b * 4 * 4096 + 4 * i); bl = b; __syncthreads(); }
#pragma unroll 4
        for (int r = 0; r < 16; ++r) {
            const int row = b * NS + (r >> 3) * (NS / 2) + 64 * kk + C.wave * 8 + (r & 7); const size_t o = (size_t)row * 256 + ch;
            const float l0 = LSE[(size_t)row * 4 + hh], l1 = LSE[((size_t)NT + row) * 4 + hh], l2 = LSE[((size_t)2 * NT + row) * 4 + hh];
            const bf16* ocb = (const bf16*)OC; const u32x2 a_ = *(const u32x2*)(ocb + o), b_ = *(const u32x2*)(ocb + (size_t)NT * 256 + o), c_ = *(const u32x2*)(ocb + (size_t)2 * NT * 256 + o);
            const f32x4 a = (f32x4){bflo(a_.x), bfhi(a_.x), bflo(a_.y), bfhi(a_.y)}, bq = (f32x4){bflo(b_.x), bfhi(b_.x), bflo(b_.y), bfhi(b_.y)}, c = (f32x4){bflo(c_.x), bfhi(c_.x), bflo(c_.y), bfhi(c_.y)};
            const float mx = fmaxf(l0, fmaxf(l1, l2)); float w0 = fexp2(l0 - mx), w1 = fexp2(l1 - mx), w2 = fexp2(l2 - mx); const float inv = __builtin_amdgcn_rcpf(w0 + w1 + w2); w0 *= inv; w1 *= inv; w2 *= inv;
            const f32x4 y = a * w0 + bq * w1 + c * w2;
            const float ss = group_sum<16>((y[0] * y[0] + y[1] * y[1]) + (y[2] * y[2] + y[3] * y[3])); const float rstd = rsqrtf(ss * (1.f / 64.f) + 1e-6f);
            u32x2 w; w.x = pk2(y[0] * rstd * og[0], y[1] * rstd * og[1]); w.y = pk2(y[2] * rstd * og[2], y[3] * rstd * og[3]); *(u32x2*)(YCAT + (size_t)row * DM + 512 + ch) = w;
        }
#pragma unroll 1
        for (int hf = 0; hf < 2; ++hf) {
#pragma unroll 2
            for (int r = 0; r < 8; ++r) {
                const int row = b * NS + hf * (NS / 2) + 64 * kk + C.wave * 8 + r, s = row % NS; const size_t o = (size_t)row * 256 + ch;
                f32x4 y = *(const f32x4*)(YA + o); const u32x2 rr_ = *(const u32x2*)(SCH + (size_t)3 * NT * 256 + o), k_ = *(const u32x2*)(SCH + o), v_ = *(const u32x2*)(SCH + (size_t)4 * NT * 256 + o), g_ = *(const u32x2*)(Gb + o);
                const f32x4 rr = (f32x4){bflo(rr_.x), bfhi(rr_.x), bflo(rr_.y), bfhi(rr_.y)}, k = (f32x4){bflo(k_.x), bfhi(k_.x), bflo(k_.y), bfhi(k_.y)}, v = (f32x4){bflo(v_.x), bfhi(v_.x), bflo(v_.y), bfhi(v_.y)}, g = (f32x4){bflo(g_.x), bfhi(g_.x), bflo(g_.y), bfhi(g_.y)};
                if (hf == 1) {
                    LAS float* ub = us + (r & 1) * 256;
                    *(LAS f32x4*)(ub + ch) = *(const f32x4*)(UB + ((size_t)b * (NS / 2) + (s - NS / 2)) * 256 + ch);
                    asm volatile("s_waitcnt lgkmcnt(0)" ::: "memory");
                    const LAS float* sp = sm + hh * 4096 + 4 * (lane & 15); const LAS float* up = ub + hh * 64;
#pragma unroll 8
                    for (int j4 = 0; j4 < 16; ++j4) { const f32x4 u4 = *(const LAS f32x4*)(up + 4 * j4);
#pragma unroll
                        for (int jj = 0; jj < 4; ++jj) y += *(const LAS f32x4*)(sp + (4 * j4 + jj) * 64) * u4[jj]; }
                }
                const float mu = group_sum<16>((y[0] + y[1]) + (y[2] + y[3])) * (1.f / 64.f);
                const f32x4 dy = y - mu; const float var = group_sum<16>((dy[0] * dy[0] + dy[1] * dy[1]) + (dy[2] * dy[2] + dy[3] * dy[3])) * (1.f / 64.f);
                const float rstd = rsqrtf(var + 64e-5f);
                const float dot = group_sum<16>((rr[0] * k[0] * rk[0] + rr[1] * k[1] * rk[1]) + (rr[2] * k[2] * rk[2] + rr[3] * k[3] * rk[3]));
                float out[4];
#pragma unroll
                for (int i = 0; i < 4; ++i) out[i] = ((dy[i] * rstd * gw4[i] + gb4[i]) + dot * v[i]) * g[i];
                u32x2 w; w.x = pk2(out[0], out[1]); w.y = pk2(out[2], out[3]); *(u32x2*)(YCAT + (size_t)row * DM + ch) = w;
            }
        }
    }
    __syncthreads();
}

constexpr int CW_Q = 40000;
DI int q_next(const Ctx& C, unsigned* ctr, LAS int* slot) {
    __syncthreads();
    if (C.tid == 0) *slot = (int)__hip_atomic_fetch_add(ctr, 1u, __ATOMIC_RELAXED, __HIP_MEMORY_SCOPE_AGENT);
    __syncthreads();
    return *slot;
}
DI void conv_ticket(const Ctx& C, int l, int tk);
constexpr int CW_CD = 41000;
DI void cmp_mlp_unit(const Ctx& C, int l, int cb) {
    const int kv = cb >> 3;
    { pg8::Gemm g{kv ? WSP(bf16, R_VCR) : WSP(bf16, R_KCR), WSP(bf16, WS_WK1) + (size_t)(l * 2 + kv) * 256 * 2048, 1024, 2048}; pg8::StaticOrder S; S.init(8, 1, 8, cb & 7);
      EpiC1 E{WSP(bf16, R_CH1) + (size_t)kv * 2048 * 256, (WSP(float, WS_SMALL) + NLAYER * 8 * 6144 + l * 512 + kv * 256)}; pg8::gemm_phase(C.lds, C.tid, g, S, E); }
    asm volatile("s_waitcnt vmcnt(0)" ::: "memory"); __syncthreads();
    { pg8::Gemm g{WSP(bf16, R_CH1) + (size_t)kv * 2048 * 256, WSP(bf16, WS_WK2) + (size_t)(l * 2 + kv) * 256 * 256, 256, 256}; pg8::StaticOrder S; S.init(8, 1, 8, cb & 7);
      EpiC2 E{WSP(float, R_CMP) + (size_t)kv * 2048 * 64}; pg8::gemm_phase(C.lds, C.tid, g, S, E); }
    asm volatile("s_waitcnt vmcnt(0)" ::: "memory"); __syncthreads();
    if (C.tid == 0) { __builtin_amdgcn_fence(__ATOMIC_RELEASE, "agent"); asm volatile("s_waitcnt vmcnt(0)" ::: "memory");
        __hip_atomic_fetch_add(WSP(unsigned, WS_CTL) + CW_CD + 64 * l, 1u, __ATOMIC_RELAXED, __HIP_MEMORY_SCOPE_AGENT); }
}
DI void cmp_mlp_wait(const Ctx& C, int l) {
    if (C.tid == 0) { unsigned* c = WSP(unsigned, WS_CTL) + CW_CD + 64 * l; unsigned sp = 0u;
        while (__hip_atomic_load(c, __ATOMIC_RELAXED, __HIP_MEMORY_SCOPE_AGENT) < 16u) { __builtin_amdgcn_s_sleep(8); if (++sp > (1u << 21)) break; }
        __builtin_amdgcn_fence(__ATOMIC_ACQUIRE, "agent"); asm volatile("s_waitcnt vmcnt(0)" ::: "memory"); }
    __syncthreads();
}
DI void mix_phase(const Ctx& C, int l, int rep) {
    unsigned* ctl = WSP(unsigned, WS_CTL) + CW_Q + 64 * 3 * (l + 2 * rep); LAS int* slot = (LAS int*)(C.lds + MISC_OFF + 1024);
#ifndef PROBE_SPLIT
#define PROBE_SPLIT 0
#endif
    if (C.bid < 96) { scan_unit8(C, C.bid); if (PROBE_SCAN2) scan_unit8(C, C.bid); }
    else if (C.bid < 112) cmp_mlp_unit(C, l, C.bid - 96);
    bool cmp_ready = false;
    if (PROBE_SPLIT) { asm volatile("s_waitcnt vmcnt(0)" ::: "memory"); __syncthreads(); { XcdBarrier bar2; bar2.bar = WSP(unsigned, WS_CTL) + CW_BAR; bar2.x = xb_xcc_id(); bar2.st = (volatile LAS unsigned*)(C.lds + MISC_OFF); xcd_barrier(bar2); } }
    int bl = -1;
    const float bnd_cmp = score_bound(C.nsa_q_g + (size_t)l * 64, C.nsa_kc_g + (size_t)l * 64, C.lane), bnd_slc = score_bound(C.nsa_q_g + (size_t)l * 64, C.nsa_ks_g + (size_t)l * 64, C.lane),
                bnd_swa = score_bound(C.nsa_q_g + (size_t)l * 64, C.nsa_kw_g + (size_t)l * 64, C.lane), bnd_dil = score_bound(C.dil_q_g + (size_t)l * 64, C.dil_k_g + (size_t)l * 64, C.lane);
    bool conv_left = true;
#define CONV_ONE() do { if (conv_left) { const int t_ = q_next(C, ctl + 128, slot); if (t_ >= 768 * (1 + PROBE_CONV2)) conv_left = false; else { conv_ticket(C, l, t_ % 768); bl = -1; } } } while (0)
    for (;;) { const int u = q_next(C, ctl, slot); if (u >= 512 * (1 + PROBE_ATT2)) break; nsa_unit(C, l, u & 7, 63 - ((u & 511) >> 3), bl, cmp_ready, bnd_cmp, bnd_slc, bnd_swa); CONV_ONE(); }
    for (int n = 0;; ++n) { const int u = q_next(C, ctl + 64, slot); if (u >= 1536 * (1 + PROBE_ATT2)) break; dil_unit(C, u % 1536, C.lds, C.lds + KT_BYTES, bnd_dil); if ((n & 3) == 3) CONV_ONE(); }
    while (conv_left) CONV_ONE();
#undef CONV_ONE if (C.bid >= 96)
    __syncthreads();
}
#define MFMA_F32(a, b, c) __builtin_amdgcn_mfma_f32_16x16x4f32((a), (b), (c), 0, 0, 0)
DI void router_phase(const Ctx& C, int l) {
    const float* X = C.out; const float* MOD = WSP(float, WS_SMALL) + (size_t)l * 8 * 6144; unsigned char* H8 = WSP(unsigned char, R_XS);
    int* TOPE = WSP(int, WS_ROUTE); float* TOPG = (float*)(TOPE + NT * 4); unsigned* CNTB = WSP(unsigned, WS_CTL) + CW_CNT + l * 8192;
    LAS float* wl = (LAS float*)C.lds;
    LAS float* lg = (LAS float*)(C.lds + MISC_OFF + 8192) + C.wave * 512;
    LAS unsigned* hist = (LAS unsigned*)(C.lds + MISC_OFF + 6144);
    LAS float* rs = (LAS float*)(C.lds + MISC_OFF + 6400) + C.wave * 16;
    const int lane = C.lane, l15 = lane & 15, quad = lane >> 4, gw = C.bid * NWAVE + C.wave, NGW = C.G * NWAVE;
    const float* wr = C.w_router + (size_t)l * 1024 * 32; const float* g2 = C.norm2_g + (size_t)l * DM;
    __syncthreads();
    if (C.tid < 32) hist[C.tid] = 0u;
    for (int i = C.tid; i < 8192; i += NTHR) { const int k = i >> 3, e4 = (i & 7) * 4; const f32x4 v = *(const f32x4*)(wr + (size_t)k * 32 + e4); LAS float* d = wl + ((k >> 2) * 32 + e4) * 4 + (k & 3);
        d[0] = v[0]; d[4] = v[1]; d[8] = v[2]; d[12] = v[3]; }
    __syncthreads();
    for (int task = gw; task < NT / 16; task += NGW) {
        const int row0 = 16 * task, b = row0 / NS;
        const float* shb = MOD + (size_t)b * 6144 + 3072; const float* scb = shb + 1024;
        {
            f32x4 gg[4], sa[4], sb[4];
#pragma unroll
            for (int j = 0; j < 4; ++j) { const int k = 4 * lane + 256 * j; const f32x4 g = *(const f32x4*)(g2 + k), a = *(const f32x4*)(scb + k); gg[j] = g * (a + 1.f); sb[j] = *(const f32x4*)(shb + k); }
#pragma unroll 4
            for (int r = 0; r < 16; ++r) {
                const float* xr = X + (size_t)(row0 + r) * DM + 4 * lane; f32x4 v[4]; float ss = 0.f;
#pragma unroll
                for (int j = 0; j < 4; ++j) { v[j] = *(const f32x4*)(xr + 256 * j); ss += (v[j][0] * v[j][0] + v[j][1] * v[j][1]) + (v[j][2] * v[j][2] + v[j][3] * v[j][3]); }
                ss = group_sum<64>(ss); const float rstd = rsqrtf(ss * (1.f / DM) + 1e-6f);
                if (lane == 0) rs[r] = rstd;
                unsigned char* hp = H8 + (size_t)(row0 + r) * DM + 4 * lane;
#pragma unroll
                for (int j = 0; j < 4; ++j) { const f32x4 h = v[j] * rstd * gg[j] + sb[j]; *(unsigned*)(hp + 256 * j) = pk4_fp8(h[0], h[1], h[2], h[3]); }
            }
        }
        const float* xr = X + (size_t)(row0 + l15) * DM + 4 * quad; const float* sh = shb + 4 * quad; const float* sc = scb + 4 * quad;
        asm volatile("s_waitcnt lgkmcnt(0)" ::: "memory");
        const float rstd = rs[l15];
        f32x4 acc0 = (f32x4){0.f, 0.f, 0.f, 0.f}, acc1 = acc0;
#pragma unroll 2
        for (int i = 0; i < 64; ++i) {
            const f32x4 a = *(const f32x4*)(xr + 16 * i), g = *(const f32x4*)(g2 + 16 * i + 4 * quad), s1 = *(const f32x4*)(sc + 16 * i), s0 = *(const f32x4*)(sh + 16 * i);
            f32x4 h;
#pragma unroll
            for (int j = 0; j < 4; ++j) h[j] = a[j] * rstd * g[j] * (1.f + s1[j]) + s0[j];
            const LAS float* wp = wl + ((4 * i + quad) * 32 + l15) * 4; const f32x4 w0 = *(const LAS f32x4*)wp, w1 = *(const LAS f32x4*)(wp + 64);
#pragma unroll
            for (int j = 0; j < 4; ++j) { acc0 = MFMA_F32(h[j], w0[j], acc0); acc1 = MFMA_F32(h[j], w1[j], acc1); }
        }
        const float b0 = C.b_router[l * 32 + l15], b1 = C.b_router[l * 32 + 16 + l15];
#pragma unroll
        for (int j = 0; j < 4; ++j) { lg[(4 * quad + j) * 32 + l15] = acc0[j] + b0; lg[(4 * quad + j) * 32 + 16 + l15] = acc1[j] + b1; }
        asm volatile("s_waitcnt lgkmcnt(0)" ::: "memory");
        if (lane < 16) {
            float v[32];
#pragma unroll
            for (int i = 0; i < 8; ++i) { const f32x4 a = *(const LAS f32x4*)(lg + lane * 32 + 4 * i); v[4 * i] = a[0]; v[4 * i + 1] = a[1]; v[4 * i + 2] = a[2]; v[4 * i + 3] = a[3]; }
            float tv[4]; int ti[4];
#pragma unroll
            for (int r = 0; r < 4; ++r) { float bv = -3.0e38f; int bi = 0;
#pragma unroll
                for (int e = 0; e < 32; ++e) if (v[e] > bv) { bv = v[e]; bi = e; }
                tv[r] = bv; ti[r] = bi;
#pragma unroll
                for (int e = 0; e < 32; ++e) v[e] = (e == bi) ? -3.0e38f : v[e]; }
            const float e1 = __expf(tv[1] - tv[0]), e2 = __expf(tv[2] - tv[0]), e3 = __expf(tv[3] - tv[0]), inv = 1.f / (1.f + e1 + e2 + e3);
            const int row = row0 + lane;
            *(int4*)(TOPE + (size_t)row * 4) = make_int4(ti[0], ti[1], ti[2], ti[3]);
            *(f32x4*)(TOPG + (size_t)row * 4) = (f32x4){inv, e1 * inv, e2 * inv, e3 * inv};
#pragma unroll
            for (int r = 0; r < 4; ++r) __hip_atomic_fetch_add(&hist[ti[r]], 1u, __ATOMIC_RELAXED, __HIP_MEMORY_SCOPE_WORKGROUP);
        }
        asm volatile("s_waitcnt lgkmcnt(0)" ::: "memory");
    }
    __syncthreads();
    if (C.tid < 32) CNTB[C.bid * 32 + C.tid] = hist[C.tid];
}

DI void moe_tables(const Ctx& C, int l, LAS int* tab) {
    const unsigned* CNTB = WSP(unsigned, WS_CTL) + CW_CNT + l * 8192;
    LAS unsigned* part = (LAS unsigned*)(tab + 192);
    __syncthreads();
    { const int e = C.tid & 31, pt = C.tid >> 5; unsigned tot = 0u, mine = 0u;
        const int g0 = pt * ((C.G + 15) >> 4), g1 = min(C.G, g0 + ((C.G + 15) >> 4));
#pragma unroll 16
        for (int g = g0; g < g1; ++g) { const unsigned c = CNTB[g * 32 + e]; tot += c; mine += (g < C.bid) ? c : 0u; }
        part[(pt * 2) * 32 + e] = tot; part[(pt * 2 + 1) * 32 + e] = mine; }
    __syncthreads();
    if (C.tid < 32) { unsigned tot = 0u, mine = 0u;
#pragma unroll
        for (int pt = 0; pt < 16; ++pt) { tot += part[(pt * 2) * 32 + C.tid]; mine += part[(pt * 2 + 1) * 32 + C.tid]; }
        tab[128 + C.tid] = (int)((tot + 255u) >> 8); tab[64 + C.tid] = (int)mine; }
    __syncthreads();
    if (C.tid == 0) { int s = 0; for (int e = 0; e < 32; ++e) { tab[e] = s; s += tab[128 + e]; } tab[32] = s; }
    __syncthreads();
}
DI void scatter_phase(const Ctx& C, int l) {
    const int* TOPE = WSP(int, WS_ROUTE); int* POS = (int*)(TOPE + NT * 8); int* ROWMAP = (int*)(TOPE + NT * 12);
    LAS int* tab = (LAS int*)(C.lds + MISC_OFF + 64); LAS unsigned* cur = (LAS unsigned*)(C.lds + 16384);
    moe_tables(C, l, tab);
    if (C.tid < 32) cur[C.tid] = (unsigned)(tab[C.tid] * 256 + tab[64 + C.tid]);
    __syncthreads();
    const int lane = C.lane, gw = C.bid * NWAVE + C.wave, NGW = C.G * NWAVE;
    for (int task = gw; task < NT / 16; task += NGW) {
        const int row0 = 16 * task, tok = row0 + (lane >> 2);
        const int e = TOPE[(size_t)tok * 4 + (lane & 3)];
        const int slot = (int)__hip_atomic_fetch_add(&cur[e], 1u, __ATOMIC_RELAXED, __HIP_MEMORY_SCOPE_WORKGROUP);
        POS[(size_t)tok * 4 + (lane & 3)] = slot; ROWMAP[slot] = tok;
    }
}
DI void combine_phase(const Ctx& C, int l, float* dst) {
    const bf16* YB = WSP(bf16, R_YB); const int* TOPE = WSP(int, WS_ROUTE); const float* TOPG = (const float*)(TOPE + NT * 4); const int* POS = (const int*)(TOPE + NT * 8);
    const float* MOD = WSP(float, WS_SMALL) + (size_t)l * 8 * 6144; bf16* H = WSP(bf16, WS_H);
    const int lane = C.lane, gw = C.bid * NWAVE + C.wave, NGW = C.G * NWAVE;
    for (int task = gw; task < NT / 16; task += NGW) {
        const int row0 = 16 * task, b = row0 / NS; const float* gt = MOD + (size_t)b * 6144 + 5120 + 8 * lane;
        f32x4 g4[4], gg[4], sb[4];
#pragma unroll
        for (int j = 0; j < 2; ++j) { g4[2 * j] = *(const f32x4*)(gt + 512 * j); g4[2 * j + 1] = *(const f32x4*)(gt + 512 * j + 4); }
        if (l + 1 < NLAYER) { const float* M2 = MOD + 8 * 6144 + (size_t)b * 6144 + 8 * lane; const float* g = C.norm1_g + (size_t)(l + 1) * DM + 8 * lane;
#pragma unroll
            for (int j = 0; j < 2; ++j)
#pragma unroll
                for (int hlf = 0; hlf < 2; ++hlf) { const int o = 512 * j + 4 * hlf; gg[2 * j + hlf] = *(const f32x4*)(g + o) * (*(const f32x4*)(M2 + 1024 + o) + 1.f); sb[2 * j + hlf] = *(const f32x4*)(M2 + o); } }
#pragma unroll 2
        for (int r = 0; r < 16; ++r) {
            const int row = row0 + r; const int4 ps = *(const int4*)(POS + (size_t)row * 4); const f32x4 gk = *(const f32x4*)(TOPG + (size_t)row * 4);
            const int pp[4] = {ps.x, ps.y, ps.z, ps.w};
            const float* orow = C.out + (size_t)row * DM + 8 * lane; float* drow = dst + (size_t)row * DM + 8 * lane;
            u32x4 y[4][2]; f32x4 x[4];
#pragma unroll
            for (int q = 0; q < 4; ++q)
#pragma unroll
                for (int j = 0; j < 2; ++j) { if (YB_FP8) { const u32x2 t_ = *(const u32x2*)((const unsigned char*)YB + (size_t)pp[q] * DM + 8 * lane + 512 * j); y[q][j] = (u32x4){t_.x, t_.y, 0u, 0u}; } else y[q][j] = *(const u32x4*)(YB + (size_t)pp[q] * DM + 8 * lane + 512 * j); }
#pragma unroll
            for (int j = 0; j < 2; ++j) { x[2 * j] = *(const f32x4*)(orow + 512 * j); x[2 * j + 1] = *(const f32x4*)(orow + 512 * j + 4); }
            f32x4 v[4]; float s = 0.f;
#pragma unroll
            for (int j = 0; j < 2; ++j) { f32x4 a0 = (f32x4){0.f, 0.f, 0.f, 0.f}, a1 = a0;
#pragma unroll
                for (int q = 0; q < 4; ++q) { const u32x4 w = y[q][j];
                    if (YB_FP8) { const f32x2 p0 = __builtin_amdgcn_cvt_pk_f32_fp8(w.x, false), p1 = __builtin_amdgcn_cvt_pk_f32_fp8(w.x, true), p2 = __builtin_amdgcn_cvt_pk_f32_fp8(w.y, false), p3 = __builtin_amdgcn_cvt_pk_f32_fp8(w.y, true);
                        a0 += (f32x4){p0[0], p0[1], p1[0], p1[1]} * gk[q]; a1 += (f32x4){p2[0], p2[1], p3[0], p3[1]} * gk[q]; }
                    else { a0 += (f32x4){bflo(w.x), bfhi(w.x), bflo(w.y), bfhi(w.y)} * gk[q]; a1 += (f32x4){bflo(w.z), bfhi(w.z), bflo(w.w), bfhi(w.w)} * gk[q]; } }
                v[2 * j] = x[2 * j] + g4[2 * j] * a0; v[2 * j + 1] = x[2 * j + 1] + g4[2 * j + 1] * a1;
                *(f32x4*)(drow + 512 * j) = v[2 * j]; *(f32x4*)(drow + 512 * j + 4) = v[2 * j + 1]; }
#pragma unroll
            for (int i = 0; i < 4; ++i) s += (v[i][0] * v[i][0] + v[i][1] * v[i][1]) + (v[i][2] * v[i][2] + v[i][3] * v[i][3]);
            if (l + 1 < NLAYER) {
                s = group_sum<64>(s); const float rstd = rsqrtf(s * (1.f / DM) + 1e-6f); bf16* hrow = H + (size_t)row * DM + 8 * lane;
#pragma unroll
                for (int j = 0; j < 2; ++j) { const f32x4 h0 = v[2 * j] * rstd * gg[2 * j] + sb[2 * j], h1 = v[2 * j + 1] * rstd * gg[2 * j + 1] + sb[2 * j + 1]; u32x4 o;
                    if (INPROJ_FP8) { u32x2 o8; o8.x = pk4_fp8(h0[0], h0[1], h0[2], h0[3]); o8.y = pk4_fp8(h1[0], h1[1], h1[2], h1[3]); *(u32x2*)((unsigned char*)H + (size_t)row * DM + 8 * lane + 512 * j) = o8; }
                    else { o.x = pk2(h0[0], h0[1]); o.y = pk2(h0[2], h0[3]); o.z = pk2(h1[0], h1[1]); o.w = pk2(h1[2], h1[3]); *(u32x4*)(hrow + 512 * j) = o; } }
            }
        }
    }
}
constexpr int PH_PER_LAYER = 11, PH_BASE = 2, N_PHASES = PH_BASE + NLAYER * PH_PER_LAYER;
#ifndef MK_ONE_LAUNCH
#define MK_ONE_LAUNCH 1
#endif
__global__ void __launch_bounds__(NTHR, 2) mk_fwd(Args args) {
    extern __shared__ __attribute__((aligned(16))) unsigned char lds_raw[];
    Ctx C;
    C.lds = (LAS unsigned char*)lds_raw; C.tid = threadIdx.x; C.lane = C.tid & 63; C.wave = __builtin_amdgcn_readfirstlane(C.tid >> 6); C.G = gridDim.x; C.bid = blockIdx.x;
    C.x = (const float*)args.in[0]; C.c = (const float*)args.in[1]; C.pos = (const int*)args.in[2]; C.w_ada = (const float*)args.in[3]; C.b_ada = (const float*)args.in[4];
    C.norm1_g = (const float*)args.in[5]; C.norm2_g = (const float*)args.in[6]; C.w_in = (const float*)args.in[7]; C.w_out = (const float*)args.in[8]; C.mu = (const float*)args.in[9];
    C.w0 = (const float*)args.in[10]; C.w2 = (const float*)args.in[11]; C.a0 = (const float*)args.in[12]; C.a2 = (const float*)args.in[13]; C.g2 = (const float*)args.in[14];
    C.kkw = (const float*)args.in[15]; C.ka = (const float*)args.in[16]; C.rk = (const float*)args.in[17]; C.gn_w = (const float*)args.in[18]; C.gn_b = (const float*)args.in[19];
    C.conv_w = (const float*)args.in[20]; C.dil_q_g = (const float*)args.in[21]; C.dil_k_g = (const float*)args.in[22]; C.nsa_q_g = (const float*)args.in[23]; C.nsa_kc_g = (const float*)args.in[24];
    C.nsa_ks_g = (const float*)args.in[25]; C.nsa_kw_g = (const float*)args.in[26]; C.pe_k = (const float*)args.in[27]; C.pe_v = (const float*)args.in[28]; C.wk1 = (const float*)args.in[29];
    C.wk2 = (const float*)args.in[30]; C.wv1 = (const float*)args.in[31]; C.wv2 = (const float*)args.in[32]; C.onorm_g = (const float*)args.in[33]; C.w_router = (const float*)args.in[34];
    C.b_router = (const float*)args.in[35]; C.w_gu = (const float*)args.in[36]; C.b_gu = (const float*)args.in[37]; C.w_down = (const float*)args.in[38]; C.b_down = (const float*)args.in[39];
    C.out = args.out; C.ws = args.ws;
    const int lo = args.ph_lo, hi = args.ph_hi;
    for (int u = C.tid; u < (LDS_BYTES - MISC_OFF) / 4; u += NTHR) ((LAS unsigned*)(C.lds + MISC_OFF))[u] = 0u;
    __syncthreads();
    XcdBarrier bar; bar.bar = WSP(unsigned, WS_CTL) + CW_BAR; bar.x = 0; bar.st = nullptr;
    if (hi - lo > 1) bar = xcd_barrier_post(WSP(unsigned, WS_CTL) + CW_BAR, (volatile LAS unsigned*)(C.lds + MISC_OFF));
#ifndef PHMASK
#define PHMASK 0xFFFFFFFFu
#endif
#define PHON(n) (((PHMASK) >> (n)) & 1u)
#ifndef PHREP
#define PHREP 0u
#endif
#define NREP(n) (1 + (int)(((PHREP) >> (n)) & 1u))
#define WSPP(T, off) ((T*)(P.ws + (off)))
#define IN(k) (lo <= (k) && (k) < hi)
#define SEAM(k) do { if (IN(k) && IN((k) + 1)) xcd_barrier(bar); } while (0)
#define PCTX Ctx P = C; asm volatile("" : "+v"(P.tid), "+v"(P.lane)); asm volatile("" : "+s"(P.ws), "+s"(P.out), "+s"(P.wave), "+s"(P.bid))
    if (PHON(17) && IN(0)) for (int rep = 0; rep < NREP(17); ++rep) { PCTX; p0_prologue(P); __syncthreads(); }
    SEAM(0);
#ifndef PROBE_BARS
#define PROBE_BARS 0
#endif
    if (hi - lo > 1) for (int i = 0; i < PROBE_BARS; ++i) xcd_barrier(bar);
    if (PHON(18) && IN(1)) { PCTX; norm1_phase(P, 0, P.x); }
    SEAM(1);
    for (int l = 0; l < NLAYER; ++l) {
        const int pb = PH_BASE + PH_PER_LAYER * l;
        if (PHON(0) && IN(pb + 0)) for (int rep = 0; rep < NREP(0); ++rep) { PCTX;
            pg8::StaticOrder S; S.init(NT / 256, NPJ / 256, P.G, P.bid);
            if (INPROJ_FP8) { pg8::Gemm g{WSPP(bf16, WS_H), WSPP(bf16, WS_WIN) + (size_t)l * NPJ * 512, 512, 512, WSPP(int, WS_ROUTE) + NT * 12 + NR, 0x3FFFF}; EpiProj E{WSPP(bf16, R_PROJ), W8_INV}; pg8::gemm_phase<EpiProj, pg8::StaticOrder, true, true>(P.lds, P.tid, g, S, E); }
            else { pg8::Gemm g{WSPP(bf16, WS_H), WSPP(bf16, WS_WIN) + (size_t)l * NPJ * 1024, 1024, 1024}; EpiProj E{WSPP(bf16, R_PROJ), 1.f}; pg8::gemm_phase(P.lds, P.tid, g, S, E); }
        }
        SEAM(pb + 0);
        if (PHON(1) && IN(pb + 1)) for (int rep = 0; rep < NREP(1); ++rep) { PCTX; prep_phase(P, l); __syncthreads(); }
        SEAM(pb + 1);
        if (PHON(2) && IN(pb + 2)) for (int rep = 0; rep < NREP(2); ++rep) { PCTX;
            { pg8::Gemm g{WSPP(bf16, R_LIN), WSPP(bf16, WS_LORA) + (size_t)l * 768 * 256, 256, 256}; pg8::StaticOrder S; S.init(NT / 256, 3, P.G, P.bid);
              EpiLora E{WSPP(float, R_SC), WSPP(bf16, R_SCH), WSPP(bf16, R_G), P.w0 + l * 256, P.a0 + l * 256, P.ka + l * 256, (rep + 1 < NREP(2)) ? WSPP(bf16, WS_END) : WSPP(bf16, R_SCH), (rep + 1 < NREP(2)) ? WSPP(float, WS_END) + 64 * MiB : WSPP(float, R_SC)}; pg8::gemm_phase(P.lds, P.tid, g, S, E); }
        }
        SEAM(pb + 2);
        if (PHON(3) && IN(pb + 3)) for (int rep = 0; rep < NREP(3); ++rep) { PCTX; mix_phase(P, l, rep); }
        SEAM(pb + 3);
        if (PHON(4) && IN(pb + 4)) for (int rep = 0; rep < NREP(4); ++rep) { PCTX; fin_phase(P, l); __syncthreads(); }
        SEAM(pb + 4);
        if (PHON(5) && IN(pb + 5)) for (int rep = 0; rep < NREP(5); ++rep) { PCTX;
            pg8::Gemm g{WSPP(bf16, R_YCAT), WSPP(bf16, WS_WOUT) + (size_t)l * 1024 * 1024, 1024, 1024}; pg8::StaticOrder S; S.init(NT / 256, 4, P.G, P.bid);
            EpiOut E{(rep + 1 < NREP(5)) ? WSPP(float, WS_END) : P.out, l == 0 ? P.x : (const float*)P.out, WSPP(float, WS_SMALL) + (size_t)l * 8 * 6144 + 2048}; pg8::gemm_phase(P.lds, P.tid, g, S, E);
        }
        SEAM(pb + 5);
        if (PHON(6) && IN(pb + 6)) for (int rep = 0; rep < NREP(6); ++rep) { PCTX; router_phase(P, l); __syncthreads(); }
        SEAM(pb + 6);
        if (PHON(7) && IN(pb + 7)) for (int rep = 0; rep < NREP(7); ++rep) { PCTX; scatter_phase(P, l); __syncthreads(); }
        SEAM(pb + 7);
        if (PHON(8) && IN(pb + 8)) for (int rep = 0; rep < NREP(8); ++rep) { PCTX;
            LAS int* tab = (LAS int*)(P.lds + MISC_OFF + 64); moe_tables(P, l, tab);
            pg8::Gemm g{WSPP(bf16, R_XS), WSPP(bf16, WS_WGU) + (size_t)l * 32 * 2048 * 512, 512, 512, WSPP(int, WS_ROUTE) + NT * 12, 32767};
            pg8::GroupedOrder S; S.init(tab[32], 8, P.G, P.bid); S.tstart = tab; S.nrow_e = 2048;
            EpiGU8 E{WSPP(unsigned char, R_ACT), P.b_gu + (size_t)l * 32 * 2048}; pg8::gemm_phase<EpiGU8, pg8::GroupedOrder, true, true>(P.lds, P.tid, g, S, E);
        }
        SEAM(pb + 8);
        if (PHON(9) && IN(pb + 9)) for (int rep = 0; rep < NREP(9); ++rep) { PCTX;
            LAS int* tab = (LAS int*)(P.lds + MISC_OFF + 64); moe_tables(P, l, tab);
            pg8::Gemm g{WSPP(bf16, R_ACT), WSPP(bf16, WS_WDN) + (size_t)l * 32 * 1024 * 512, 512, 512, WSPP(int, WS_ROUTE) + NT * 12 + NR, 0x3FFFF}; pg8::GroupedOrder S; S.init(tab[32], 4, P.G, P.bid); S.tstart = tab; S.nrow_e = 1024;
            EpiDN8 E{WSPP(bf16, R_YB), P.b_down + (size_t)l * 32 * 1024}; pg8::gemm_phase<EpiDN8, pg8::GroupedOrder, true, true>(P.lds, P.tid, g, S, E);
        }
        SEAM(pb + 9);
        if (PHON(10) && IN(pb + 10)) for (int rep = 0; rep < NREP(10); ++rep) { PCTX; combine_phase(P, l, (rep + 1 < NREP(10)) ? WSPP(float, WS_END) : P.out); __syncthreads(); }
        SEAM(pb + 10);
    }
#undef IN
#undef SEAM
}

extern "C" void kernel_launch(void* const* d_in, const int* in_sizes, int n_in, void* d_out, int out_size, void* d_ws, size_t ws_size, hipStream_t stream) {
    static int grid = 0;
    if (grid == 0) {
        if (n_in != 40 || out_size != NT * DM || ws_size < WS_END + 256 * MiB) { fprintf(stderr, "kernel_launch: unexpected problem (n_in %d, out %d, ws %zu < %zu)\n", n_in, out_size, ws_size, (size_t)WS_END); grid = -1; return; }
        int dev = 0, cus = 0, per_cu = 0;
        if (hipGetDevice(&dev) != hipSuccess || hipDeviceGetAttribute(&cus, hipDeviceAttributeMultiprocessorCount, dev) != hipSuccess) { grid = -1; return; }
        if (hipFuncSetAttribute((const void*)mk_fwd, hipFuncAttributeMaxDynamicSharedMemorySize, LDS_BYTES) != hipSuccess) { fprintf(stderr, "kernel_launch: hipFuncSetAttribute failed\n"); grid = -1; return; }
        if (hipOccupancyMaxActiveBlocksPerMultiprocessor(&per_cu, (const void*)mk_fwd, NTHR, LDS_BYTES) != hipSuccess || per_cu < 1) fprintf(stderr, "kernel_launch: occupancy query says %d blocks per CU\n", per_cu);
        (void)hipGetLastError();
        grid = cus > 256 ? 256 : cus;
    }
    if (grid < 0) return;
    (void)hipMemsetAsync((char*)d_ws, 0, ZERO_BYTES, stream);
    Args a{};
    for (int i = 0; i < 40; ++i) a.in[i] = d_in[i];
    a.out = (float*)d_out; a.ws = (unsigned char*)d_ws;
#if MK_ONE_LAUNCH
    a.ph_lo = 0; a.ph_hi = N_PHASES;
    hipLaunchKernelGGL(mk_fwd, dim3(grid), dim3(NTHR), LDS_BYTES, stream, a);
#else
    for (int p = 0; p < N_PHASES; ++p) { a.ph_lo = p; a.ph_hi = p + 1; hipLaunchKernelGGL(mk_fwd, dim3(grid), dim3(NTHR), LDS_BYTES, stream, a); }
#endif
    const hipError_t le = hipPeekAtLastError();
    if (le != hipSuccess) fprintf(stderr, "kernel_launch: launch failed: %s\n", hipGetErrorName(le));
}
```

```cpp
#include <hip/hip_runtime.h>
#include <cstdio>
#include <cstdint>

#define DI __device__ __forceinline__
#define LAS __attribute__((address_space(3)))
#define GAS __attribute__((address_space(1)))
typedef unsigned short bf16;
typedef short bf16x8 __attribute__((ext_vector_type(8)));
typedef float f32x4 __attribute__((ext_vector_type(4)));
typedef float f32x2 __attribute__((ext_vector_type(2)));
typedef unsigned u32x4 __attribute__((ext_vector_type(4)));
typedef unsigned u32x2 __attribute__((ext_vector_type(2)));
typedef unsigned char uchar;

#ifndef PROBE_SCAN2
#define PROBE_SCAN2 0
#endif
#ifndef PROBE_ATT2
#define PROBE_ATT2 0
#endif
#ifndef PROBE_CONV2
#define PROBE_CONV2 0
#endif
#ifndef INPROJ_FP8
#define INPROJ_FP8 0
#endif
constexpr int NB = 8, NS = 4096, NT = NB * NS, DM = 1024, NPJ = 3328, NE = 32, FF = 1024, NLAYER = 2;
constexpr int PJ_A = 0, PJ_B = 1024, PJ_C = 1792, PJ_D = 2560;
constexpr int NR = NT * 4 + NE * 256;
constexpr int NTHR = 512, NWAVE = 8;

DI float bf2f(unsigned v) { return __builtin_bit_cast(float, v << 16); }
DI unsigned f2bf(float f) { unsigned u = __builtin_bit_cast(unsigned, f); return (u + 0x7fffu + ((u >> 16) & 1u)) >> 16; }
DI unsigned pk2(float lo, float hi) { return f2bf(lo) | (f2bf(hi) << 16); }
DI float bflo(unsigned w) { return __builtin_bit_cast(float, w << 16); }
DI float bfhi(unsigned w) { return __builtin_bit_cast(float, w & 0xffff0000u); }
DI float fexp2(float x) { return __builtin_amdgcn_exp2f(x); }
DI float fsigmoid(float x) { return __builtin_amdgcn_rcpf(1.f + __builtin_amdgcn_exp2f(-1.44269504089f * x)); }
DI float wsum_xor(float v, int o) { return v + __shfl_xor(v, o); }
template <int CTRL> DI float dppmov(float x) { return __builtin_bit_cast(float, __builtin_amdgcn_update_dpp(0, __builtin_bit_cast(int, x), CTRL, 0xF, 0xF, true)); }
template <int W> DI float group_sum(float v) {
    if (W >= 2) v += dppmov<0xB1>(v);
    if (W >= 4) v += dppmov<0x4E>(v);
    if (W >= 8) v += dppmov<0x141>(v);
    if (W >= 16) v += dppmov<0x140>(v);
    if (W >= 32) v += __shfl_xor(v, 16);
    if (W >= 64) v += __shfl_xor(v, 32);
    return v;
}
DI float sum8(float x) { x += dppmov<0xB1>(x); x += dppmov<0x4E>(x); x += dppmov<0x141>(x); return x; }

#define XB_TMO      128
#define XB_XCNT(j)  (256  + 64 * (j))
#define XB_XSUB(j)  (1280 + 64 * (j))
#define XB_XGEN(j)  (2304 + 64 * (j))
#define XB_TOP      3328
#define XB_TOPGEN   3392
#define XCD_BAR_WORDS 3456
#define XB_SPIN_CAP (1u << 18)
DI unsigned xb_ld(unsigned* p)              { return __hip_atomic_load(p, __ATOMIC_RELAXED, __HIP_MEMORY_SCOPE_AGENT); }
DI unsigned xb_add(unsigned* p, unsigned v) { return __hip_atomic_fetch_add(p, v, __ATOMIC_RELAXED, __HIP_MEMORY_SCOPE_AGENT); }
DI unsigned xb_xcc_id() { return (unsigned)__builtin_amdgcn_s_getreg((3 << 11) | 20) & 0xFu; }
#define XB_SPIN(cond, bar) do { unsigned _sp = 0; while (cond) { __builtin_amdgcn_s_sleep(1); \
    if ((++_sp & 255u) == 0u) { if (xb_ld(&(bar)[XB_TMO])) break; if (_sp > XB_SPIN_CAP) { atomicAdd(&(bar)[XB_TMO], 1u); break; } } } } while (0)
struct XcdBarrier { unsigned* bar; unsigned x; volatile LAS unsigned* st; };
DI XcdBarrier xcd_barrier_post(unsigned* bar, volatile LAS unsigned* st) {
    XcdBarrier b; b.bar = bar; b.x = xb_xcc_id(); b.st = st;
    if (threadIdx.x == 0) (void)xb_add(&bar[XB_XCNT(b.x)], 1u);
    return b;
}
DI void xcd_barrier_complete(unsigned* bar, unsigned x, unsigned& nloc, unsigned& nx) {
    const unsigned G = gridDim.x * gridDim.y * gridDim.z;
    unsigned sum, cnt, mine, sp = 0u;
    for (;;) {
        sum = 0u; cnt = 0u; mine = 0u;
#pragma unroll
        for (unsigned j = 0; j < 16; ++j) { const unsigned c = xb_ld(&bar[XB_XCNT(j)]); sum += c; cnt += (c > 0u) ? 1u : 0u; mine = (j == x) ? c : mine; }
        if (sum == G) break;
        __builtin_amdgcn_s_sleep(1);
        if ((++sp & 255u) == 0u) { if (xb_ld(&bar[XB_TMO])) break; if (sp > XB_SPIN_CAP) { atomicAdd(&bar[XB_TMO], 1u); break; } }
    }
    nloc = mine > 0u ? mine : 1u; nx = cnt > 0u ? cnt : 1u;
}
DI void xcd_barrier(const XcdBarrier& b) {
    asm volatile("s_waitcnt vmcnt(0)" ::: "memory");
    __syncthreads();
    if (threadIdx.x == 0) {
        unsigned* bar = b.bar;
        __builtin_amdgcn_s_waitcnt(0);
        unsigned nloc = b.st[0], nx = b.st[1];
        if (nloc == 0u) { xcd_barrier_complete(bar, b.x, nloc, nx); b.st[0] = nloc; b.st[1] = nx; }
        const unsigned old = xb_add(&bar[XB_XSUB(b.x)], 1u);
        const unsigned gen = old / nloc;
        if (old + 1u == (gen + 1u) * nloc) {
            __builtin_amdgcn_fence(__ATOMIC_RELEASE, "agent");
            asm volatile("s_waitcnt vmcnt(0)" ::: "memory");
            const unsigned og = xb_add(&bar[XB_TOP], 1u);
            const unsigned tg = og / nx;
            if (og + 1u == (tg + 1u) * nx) xb_add(&bar[XB_TOPGEN], 1u);
            else XB_SPIN(xb_ld(&bar[XB_TOPGEN]) == tg, bar);
            __builtin_amdgcn_fence(__ATOMIC_ACQUIRE, "agent");
            xb_add(&bar[XB_XGEN(b.x)], 1u);
            asm volatile("s_waitcnt vmcnt(0)" ::: "memory");
        } else {
            XB_SPIN(xb_ld(&bar[XB_XGEN(b.x)]) == gen, bar);
            __builtin_amdgcn_fence(__ATOMIC_ACQUIRE, "agent");
            asm volatile("s_waitcnt vmcnt(0)" ::: "memory");
        }
    }
    __syncthreads();
}
namespace pg8 {
constexpr int BM = 256, BK = 64, HALF = 128, HTB = HALF * BK * 2, STAGE_BYTES = 8 * HTB, NXCD = 8, WGM = 4;
__host__ __device__ __forceinline__ int lds_byte(int r, int c) { const int st = (r >> 4) * 2 + (c >> 5), rr = r & 15, cc = c & 31, ob = rr * 64 + cc * 2; return st * 1024 + (ob ^ (((ob >> 9) & 1) << 5)); }
__host__ __device__ __forceinline__ void stage_rc(int b, int& R, int& C) { const int st = b / 1024, sb = b % 1024, swz = sb ^ (((sb >> 9) & 1) << 5); R = (st >> 1) * 16 + swz / 64; C = (st & 1) * 32 + (swz % 64) / 2; }
__host__ __device__ __forceinline__ int perm32(int rho) { const int n = rho >> 4, i = rho & 15; return 8 * (i >> 2) + 4 * n + (i & 3); }

struct Unit { int pm, pn, brow, e; };
struct Gemm { const bf16* A; const bf16* Bt; int lda, K; const int* rowmap; int rowmask; };

struct StaticOrder {
    int nM, nN, nwg, G, c;
    __device__ void init(int nM_, int nN_, int G_, int c_) { nM = nM_; nN = nN_; nwg = nM * nN; G = G_; c = c_; }
    __device__ bool tile(int i, int& pm, int& pn) const {
        const long L = (long)i * G + c; if (L >= nwg) return false;
        int wgid = (int)L; { const int q = nwg / NXCD, r = nwg % NXCD, xcd = wgid % NXCD, off = wgid / NXCD; wgid = (xcd < r ? xcd * (q + 1) : r * (q + 1) + (xcd - r) * q) + off; }
        const int nig = WGM * nN, gid = wgid / nig, fm = gid * WGM, gsz = (nM - fm) < WGM ? (nM - fm) : WGM;
        pm = fm + ((wgid % nig) % gsz); pn = (wgid % nig) / gsz; return true;
    }
    __device__ bool next(int i, Unit& u) const { if (!tile(i, u.pm, u.pn)) return false; u.brow = u.pn * BM; u.e = 0; return true; }
};
struct GroupedOrder : StaticOrder {
    const LAS int* tstart; int nrow_e;
    __device__ bool next(int i, Unit& u) const {
        if (!tile(i, u.pm, u.pn)) return false;
        int e = 0;
#pragma unroll 1
        for (int j = 16; j > 0; j >>= 1) if (tstart[e + j] <= u.pm) e += j;
        u.e = e; u.brow = e * nrow_e + u.pn * BM; return true;
    }
};
DI unsigned cvt_pk_bf16(float lo, float hi) { unsigned r; asm volatile("v_cvt_pk_bf16_f32 %0, %1, %2" : "=v"(r) : "v"(lo), "v"(hi)); return r; }

template <class Epi, class Sched, bool GATHER = false, bool FP8 = false>
DI void gemm_phase(LAS unsigned char* lds, const int tid, const Gemm g, const Sched& S, const Epi& E) {
    const int wid = __builtin_amdgcn_readfirstlane(tid >> 6), lane = tid & 63, wr = wid >> 2, wc = wid & 3, fr = lane & 15, fq = lane >> 4;
    int K = g.K, lda = g.lda; asm volatile("" : "+s"(K), "+s"(lda));
    const int nt = K / BK;
    unsigned voffA[2], voffB[2]; int Ra[2], Ca[2];
#pragma unroll
    for (int i = 0; i < 2; ++i) { int R, C; stage_rc(tid * 16 + i * 8192, R, C); const int Rb = Epi::PERM ? ((R & ~31) + perm32(R & 31)) : R; Ra[i] = R; Ca[i] = C;
        voffA[i] = (unsigned)(R * lda + C) * 2u; voffB[i] = (unsigned)(Rb * K + C) * 2u; }
    unsigned vgc[2][2]; int rawn[2][2];
#define PG8_GLOAD(dst, pm_) do { _Pragma("unroll") for (int _h = 0; _h < 2; ++_h) _Pragma("unroll") for (int _i = 0; _i < 2; ++_i) { const int* _p = g.rowmap + (size_t)(pm_) * BM + _h * HALF + Ra[_i]; \
        asm volatile("global_load_dword %0, %1, off" : "=v"(dst[_h][_i]) : "v"(_p) : "memory"); } } while (0)
#define PG8_GCONV(vg, raw) do { _Pragma("unroll") for (int _h = 0; _h < 2; ++_h) _Pragma("unroll") for (int _i = 0; _i < 2; ++_i) { int _r = raw[_h][_i]; asm volatile("" : "+v"(_r)); \
        vg[_h][_i] = (unsigned)((_r & g.rowmask) * lda + Ca[_i]) * 2u; } } while (0)
#define PG8_STAGE_A(bufoff, kptr, h, vg) do { if (GATHER) PG8_STAGE(bufoff, kptr, vg[h]); else PG8_STAGE(bufoff, (kptr) + (h) * hstepA, voffA); } while (0)
    const size_t kstep = (size_t)(BK * 2);
    const size_t hstepA = (size_t)HALF * lda * 2, hstepB = (size_t)HALF * K * 2;
    const size_t tstepA = 2 * hstepA;
    const unsigned ldsw = (unsigned)wid * 1024u;
    const int aoff = lds_byte(wr * 64 + fr, fq * 8), boff = lds_byte(wc * 32 + fr, fq * 8);
#define PG8_SA(b, h) (((b) * 2 + (h)) * HTB)
#define PG8_SB(b, h) ((4 + (b) * 2 + (h)) * HTB)
#define PG8_STAGE(bufoff, gbase, voff) do { _Pragma("unroll") for (int _i = 0; _i < 2; ++_i) \
        __builtin_amdgcn_global_load_lds((const unsigned*)((const char*)(gbase) + (voff)[_i]), (LAS unsigned*)(lds + (bufoff) + ldsw + _i * 8192), 16, 0, 0); } while (0)
#define PG8_LDA(dst, b, h) do { _Pragma("unroll") for (int m = 0; m < 4; ++m) { const v4i_ lo_ = *(const LAS v4i_*)(lds + PG8_SA(b, h) + aoff + m * 2048), hi_ = *(const LAS v4i_*)(lds + PG8_SA(b, h) + aoff + m * 2048 + 1024); \
        dst[m] = __builtin_shufflevector(lo_, hi_, 0, 1, 2, 3, 4, 5, 6, 7); } } while (0)
#define PG8_LDB(dst, b, h) do { _Pragma("unroll") for (int n = 0; n < 2; ++n) { const v4i_ lo_ = *(const LAS v4i_*)(lds + PG8_SB(b, h) + boff + n * 2048), hi_ = *(const LAS v4i_*)(lds + PG8_SB(b, h) + boff + n * 2048 + 1024); \
        dst[n] = __builtin_shufflevector(lo_, hi_, 0, 1, 2, 3, 4, 5, 6, 7); } } while (0)
#define PG8_MMA(ai, bj, At, Bt) do { __builtin_amdgcn_s_setprio(1); _Pragma("unroll") for (int m = 0; m < 4; ++m) _Pragma("unroll") for (int n = 0; n < 2; ++n) { \
        if (FP8) acc[ai][bj][m][n] = __builtin_amdgcn_mfma_scale_f32_16x16x128_f8f6f4(Bt[n], At[m], acc[ai][bj][m][n], 0, 0, 0, 0x7F7F7F7F, 0, 0x7F7F7F7F); \
        else { const v8i_ b_ = Bt[n], a_ = At[m]; \
            acc[ai][bj][m][n] = __builtin_amdgcn_mfma_f32_16x16x32_bf16(__builtin_bit_cast(bf16x8, __builtin_shufflevector(b_, b_, 0, 1, 2, 3)), __builtin_bit_cast(bf16x8, __builtin_shufflevector(a_, a_, 0, 1, 2, 3)), acc[ai][bj][m][n], 0, 0, 0); \
            acc[ai][bj][m][n] = __builtin_amdgcn_mfma_f32_16x16x32_bf16(__builtin_bit_cast(bf16x8, __builtin_shufflevector(b_, b_, 4, 5, 6, 7)), __builtin_bit_cast(bf16x8, __builtin_shufflevector(a_, a_, 4, 5, 6, 7)), acc[ai][bj][m][n], 0, 0, 0); } } \
        __builtin_amdgcn_s_setprio(0); } while (0)
#define PG8_WAIT_V(n) asm volatile("s_waitcnt vmcnt(" #n ")" ::: "memory")
#define PG8_WAIT_L(n) asm volatile("s_waitcnt lgkmcnt(" #n ")" ::: "memory")
#define PG8_BAR __builtin_amdgcn_s_barrier()
#define PG8_SCHED __builtin_amdgcn_sched_barrier(0)
    Unit cur, nxt; int ui = 0;
    if (!S.next(0, cur)) return;
    f32x4 acc[2][2][4][2];
#pragma unroll
    for (int a = 0; a < 2; ++a)
#pragma unroll
        for (int b = 0; b < 2; ++b)
#pragma unroll
            for (int m = 0; m < 4; ++m)
#pragma unroll
                for (int n = 0; n < 2; ++n) acc[a][b][m][n] = (f32x4){0.f, 0.f, 0.f, 0.f};
    typedef int v8i_ __attribute__((ext_vector_type(8))); typedef int v4i_ __attribute__((ext_vector_type(4)));
    v8i_ At[4], B0[2], B1[2];
    const char* cA = (const char*)g.A + (GATHER ? (size_t)0 : (size_t)cur.pm * tstepA); const char* cB = (const char*)g.Bt + (size_t)cur.brow * K * 2;
    if (GATHER) { PG8_GLOAD(rawn, cur.pm); asm volatile("s_waitcnt vmcnt(0)" : "+v"(rawn[0][0]), "+v"(rawn[0][1]), "+v"(rawn[1][0]), "+v"(rawn[1][1]) :: "memory"); PG8_GCONV(vgc, rawn); }
    PG8_STAGE(PG8_SB(0, 0), cB, voffB); PG8_STAGE(PG8_SB(0, 1), cB + hstepB, voffB); PG8_STAGE_A(PG8_SA(0, 0), cA, 0, vgc); PG8_STAGE_A(PG8_SA(0, 1), cA, 1, vgc);
    if (wr == 1) PG8_BAR;
    PG8_WAIT_V(2); PG8_BAR;
    PG8_STAGE(PG8_SB(1, 0), cB + kstep, voffB); PG8_STAGE_A(PG8_SA(1, 0), cA + kstep, 0, vgc); PG8_STAGE(PG8_SB(1, 1), cB + hstepB + kstep, voffB);
    PG8_WAIT_V(6); PG8_BAR;
    for (;;) {
        const bool has_next = S.next(ui + 1, nxt);
        const char* nA = (has_next && !GATHER) ? (const char*)g.A + (size_t)nxt.pm * tstepA : cA;
        if (GATHER && has_next) PG8_GLOAD(rawn, nxt.pm); const char* nB = has_next ? (const char*)g.Bt + (size_t)nxt.brow * K * 2 : cB;
#pragma unroll 1
        for (int t = 0; t < nt; t += 2) {
            const bool last = (t == nt - 2);
            const char* a1 = cA + (size_t)(t + 1) * kstep;
            const char* a2 = last ? nA : cA + (size_t)(t + 2) * kstep; const char* b2 = last ? nB : cB + (size_t)(t + 2) * kstep;
            const char* a3 = a2 + kstep; const char* b3 = b2 + kstep;
            PG8_LDB(B0, 0, 0); PG8_LDB(B1, 0, 1); PG8_SCHED; PG8_LDA(At, 0, 0); PG8_STAGE_A(PG8_SA(1, 1), a1, 1, vgc);
            if (GATHER) { if (last && has_next) PG8_GCONV(vgc, rawn); }
            PG8_WAIT_V(8); PG8_WAIT_L(0); PG8_BAR; PG8_MMA(0, 0, At, B0); PG8_MMA(0, 1, At, B1); PG8_BAR; PG8_SCHED;
            PG8_LDA(At, 0, 1); PG8_STAGE(PG8_SB(0, 0), b2, voffB); PG8_STAGE(PG8_SB(0, 1), b2 + hstepB, voffB); PG8_STAGE_A(PG8_SA(0, 0), a2, 0, vgc);
            PG8_WAIT_V(8); PG8_WAIT_L(0); PG8_BAR; PG8_MMA(1, 0, At, B0); PG8_MMA(1, 1, At, B1); PG8_BAR; PG8_SCHED;
            PG8_LDB(B0, 1, 0); PG8_LDB(B1, 1, 1); PG8_SCHED; PG8_LDA(At, 1, 0); PG8_STAGE_A(PG8_SA(0, 1), a2, 1, vgc);
            PG8_WAIT_V(8); PG8_WAIT_L(0); PG8_BAR; PG8_MMA(0, 0, At, B0); PG8_MMA(0, 1, At, B1); PG8_BAR; PG8_SCHED;
            PG8_LDA(At, 1, 1); PG8_STAGE(PG8_SB(1, 0), b3, voffB); PG8_STAGE(PG8_SB(1, 1), b3 + hstepB, voffB); PG8_STAGE_A(PG8_SA(1, 0), a3, 0, vgc);
            PG8_WAIT_V(8); PG8_WAIT_L(0); PG8_BAR; PG8_MMA(1, 0, At, B0); PG8_MMA(1, 1, At, B1); PG8_BAR; PG8_SCHED;
        }
        if (wr == 0) PG8_BAR;
        { int fr2 = fr, fq2 = fq; asm volatile("" : "+v"(fr2), "+v"(fq2)); E(acc, cur, wr, wc, fr2, fq2); }
        if (!has_next) break;
#pragma unroll
        for (int a = 0; a < 2; ++a)
#pragma unroll
            for (int b = 0; b < 2; ++b)
#pragma unroll
                for (int m = 0; m < 4; ++m)
#pragma unroll
                    for (int n = 0; n < 2; ++n) acc[a][b][m][n] = (f32x4){0.f, 0.f, 0.f, 0.f};
        cur = nxt; cA = nA; cB = nB; ++ui;
        if (wr == 1) PG8_BAR;
    }
    PG8_WAIT_V(0);
    PG8_BAR;
#undef PG8_SA
#undef PG8_SB
#undef PG8_STAGE
#undef PG8_STAGE_A
#undef PG8_GLOAD
#undef PG8_GCONV
#undef PG8_LDA
#undef PG8_LDB
#undef PG8_MMA
#undef PG8_WAIT_V
#undef PG8_WAIT_L
#undef PG8_BAR
#undef PG8_SCHED
}
}
constexpr size_t MiB = 1u << 20;
constexpr size_t WS_CTL = 0;
constexpr size_t WS_LORA = 1 * MiB;
constexpr size_t WS_WK2 = 2 * MiB;
constexpr size_t ZERO_BYTES = 3 * MiB;
constexpr size_t WS_WIN = 3 * MiB;
constexpr size_t WS_WOUT = 17 * MiB;
constexpr size_t WS_WK1 = 21 * MiB;
constexpr size_t WS_SMALL = 25 * MiB;
constexpr size_t WS_ROUTE = 27 * MiB;
constexpr size_t WS_WGU = 32 * MiB;
constexpr size_t WS_WDN = 288 * MiB;
constexpr size_t WS_H = 416 * MiB;
constexpr size_t WS_R = 480 * MiB;
constexpr size_t R_PROJ = WS_R;
constexpr size_t R_SC = R_PROJ + 208 * MiB;
constexpr size_t R_SCH = R_SC + 32 * MiB;
constexpr size_t R_LIN = R_SC + 192 * MiB;
constexpr size_t R_G = R_LIN + 16 * MiB;
constexpr size_t R_YA = R_G + 32 * MiB;
constexpr size_t R_YCAT = R_YA + 32 * MiB;
constexpr size_t R_QC = R_YCAT + 64 * MiB;
constexpr size_t R_KC = R_QC + 16 * MiB;
constexpr size_t R_OC = R_KC + 16 * MiB;
constexpr size_t R_LSE = R_OC + 96 * MiB;
constexpr size_t R_QN = R_LSE + 2 * MiB;
constexpr size_t R_QR = R_QN + 16 * MiB;
constexpr size_t R_KCR = R_QR + 16 * MiB;
constexpr size_t R_VCR = R_KCR + 5 * MiB;
constexpr size_t R_KS = R_VCR + 5 * MiB;
constexpr size_t R_KW = R_KS + 4 * MiB;
constexpr size_t R_GATE = R_KW + 4 * MiB;
constexpr size_t R_CH1 = R_GATE + 2 * MiB;
constexpr size_t R_CMP = R_CH1 + 2 * MiB;
constexpr size_t R_OCMP = R_CMP + 1 * MiB;
constexpr size_t R_OSLC = R_OCMP + 32 * MiB;
constexpr size_t R_OSWA = R_OSLC + 32 * MiB;
constexpr size_t R_SCANU = R_OSWA;
constexpr size_t R_SCANS = R_OSWA + 16 * MiB;
constexpr size_t R_IMP = R_OSWA + 32 * MiB;
constexpr size_t R_SELM = R_IMP + 8 * MiB;
constexpr size_t R_MIX_END = R_SELM + 1 * MiB;
constexpr size_t R_XS = WS_R;
constexpr size_t R_ACT = R_XS + 272 * MiB;
constexpr size_t R_YB = R_ACT + 272 * MiB;
constexpr size_t R_MOE_END = R_YB + 272 * MiB;
constexpr size_t WS_END = (R_MIX_END > R_MOE_END ? R_MIX_END : R_MOE_END);
constexpr size_t WS_XB = WS_END;
constexpr size_t WS_PROBE = WS_XB + 64 * MiB;
static_assert((size_t)NR * 1024 * 2 <= 272 * MiB, "sorted buffers");
constexpr int CW_BAR = 4096;
constexpr int CW_CNT = 16384;
constexpr int CW_CUR = 16384 + 64;

constexpr int RING_BYTES = 131072;
constexpr int MISC_OFF = RING_BYTES;
constexpr int LDS_BYTES = 155648;

struct Args { const void* in[40]; float* out; unsigned char* ws; int ph_lo, ph_hi; };

struct Ctx {
    LAS unsigned char* lds; int tid, lane, wave, G, bid;
    const float *x, *c, *w_ada, *b_ada, *norm1_g, *norm2_g, *w_in, *w_out, *mu, *w0, *w2, *a0, *a2, *g2, *kkw, *ka, *rk, *gn_w, *gn_b, *conv_w, *dil_q_g, *dil_k_g,
        *nsa_q_g, *nsa_kc_g, *nsa_ks_g, *nsa_kw_g, *pe_k, *pe_v, *wk1, *wk2, *wv1, *wv2, *onorm_g, *w_router, *b_router, *w_gu, *b_gu, *w_down, *b_down;
    const int* pos;
    float* out; unsigned char* ws;
};
#define WSP(T, off) ((T*)(C.ws + (off)))

typedef f32x4 Acc[2][2][4][2];
struct EpiProj {
    static constexpr bool PERM = true; bf16* O; float scale;
    DI void operator()(const Acc& acc, const pg8::Unit& u, int wr, int wc, int fr, int fq) const {
        const int row0 = u.pm * 256 + wr * 64 + fr, col0 = u.pn * 256 + wc * 32 + 8 * fq;
#pragma unroll
        for (int ai = 0; ai < 2; ++ai)
#pragma unroll
            for (int m = 0; m < 4; ++m) { bf16* rowp = O + (size_t)(row0 + ai * 128 + m * 16) * NPJ + col0;
#pragma unroll
                for (int bj = 0; bj < 2; ++bj) { const f32x4 v0 = acc[ai][bj][m][0] * scale, v1 = acc[ai][bj][m][1] * scale; u32x4 w;
                    w.x = pg8::cvt_pk_bf16(v0[0], v0[1]); w.y = pg8::cvt_pk_bf16(v0[2], v0[3]); w.z = pg8::cvt_pk_bf16(v1[0], v1[1]); w.w = pg8::cvt_pk_bf16(v1[2], v1[3]);
                    *(u32x4*)(rowp + bj * 128) = w; } }
    }
};
struct EpiLora {
    static constexpr bool PERM = false; float* Wp; bf16* SCH; bf16* Gb; const float *w0, *a0, *ka; bf16* SCo; float* Wo;
    DI void operator()(const Acc& acc, const pg8::Unit& u, int wr, int wc, int fr, int fq) const {
        const int row0 = u.pm * 256 + wr * 64 + fr, col0 = wc * 32 + 4 * fq;
        if (u.pn == 0) {
#pragma unroll
            for (int bj = 0; bj < 2; ++bj)
#pragma unroll
                for (int n = 0; n < 2; ++n) { const int ch = col0 + bj * 128 + n * 16; const f32x4 b = *(const f32x4*)(w0 + ch);
#pragma unroll
                    for (int ai = 0; ai < 2; ++ai)
#pragma unroll
                        for (int m = 0; m < 4; ++m) { const size_t o = (size_t)(row0 + ai * 128 + m * 16) * 256 + ch; const f32x4 v = acc[ai][bj][m][n] + b; f32x4 r;
#pragma unroll
                            for (int j = 0; j < 4; ++j) r[j] = fexp2(-0.875040829f * fsigmoid(v[j]));
                            *(f32x4*)(Wo + o) = r; } }
        } else if (u.pn == 1) {
#pragma unroll
            for (int bj = 0; bj < 2; ++bj)
#pragma unroll
                for (int n = 0; n < 2; ++n) { const int ch = col0 + bj * 128 + n * 16; const f32x4 b = *(const f32x4*)(a0 + ch), kav = *(const f32x4*)(ka + ch);
#pragma unroll
                    for (int ai = 0; ai < 2; ++ai)
#pragma unroll
                        for (int m = 0; m < 4; ++m) { __builtin_amdgcn_sched_barrier(0); const size_t o = (size_t)(row0 + ai * 128 + m * 16) * 256 + ch; const f32x4 v = acc[ai][bj][m][n] + b;
                            const u32x2 kr = *(const u32x2*)(SCH + o), kn = *(const u32x2*)(SCH + (size_t)NT * 256 + o);
                            const float krf[4] = {bflo(kr.x), bfhi(kr.x), bflo(kr.y), bfhi(kr.y)}, knf[4] = {bflo(kn.x), bfhi(kn.x), bflo(kn.y), bfhi(kn.y)}; float k2[4], bb[4];
#pragma unroll
                            for (int j = 0; j < 4; ++j) { const float a = fsigmoid(v[j]); k2[j] = krf[j] * (1.f + (a - 1.f) * kav[j]); bb[j] = knf[j] * a; }
                            u32x2 o1, o2; o1.x = pk2(k2[0], k2[1]); o1.y = pk2(k2[2], k2[3]); o2.x = pk2(bb[0], bb[1]); o2.y = pk2(bb[2], bb[3]);
                            *(u32x2*)(SCo + o) = o1; *(u32x2*)(SCo + (size_t)2 * NT * 256 + o) = o2; } }
        } else {
#pragma unroll
            for (int bj = 0; bj < 2; ++bj)
#pragma unroll
                for (int n = 0; n < 2; ++n) { const int ch = col0 + bj * 128 + n * 16;
#pragma unroll
                    for (int ai = 0; ai < 2; ++ai)
#pragma unroll
                        for (int m = 0; m < 4; ++m) { const size_t o = (size_t)(row0 + ai * 128 + m * 16) * 256 + ch; const f32x4 v = acc[ai][bj][m][n]; u32x2 w; w.x = pk2(v[0], v[1]); w.y = pk2(v[2], v[3]); *(u32x2*)(Gb + o) = w; } }
        }
    }
};
DI float gelu_tanh(float x) { const float t = 0.7978845608f * (x + 0.044715f * x * x * x); return x * fsigmoid(2.f * t); }
struct EpiC1 {
    static constexpr bool PERM = true; bf16* O; const float* peb;
    DI void operator()(const Acc& acc, const pg8::Unit& u, int wr, int wc, int fr, int fq) const {
        const int row0 = u.pm * 256 + wr * 64 + fr, col0 = wc * 32 + 8 * fq;
#pragma unroll
        for (int bj = 0; bj < 2; ++bj) { const f32x4 b0 = *(const f32x4*)(peb + col0 + bj * 128), b1 = *(const f32x4*)(peb + col0 + bj * 128 + 4);
#pragma unroll
            for (int ai = 0; ai < 2; ++ai)
#pragma unroll
                for (int m = 0; m < 4; ++m) { bf16* p = O + (size_t)(row0 + ai * 128 + m * 16) * 256 + col0 + bj * 128; const f32x4 v0 = acc[ai][bj][m][0] + b0, v1 = acc[ai][bj][m][1] + b1; u32x4 w;
                    w.x = pk2(gelu_tanh(v0[0]), gelu_tanh(v0[1])); w.y = pk2(gelu_tanh(v0[2]), gelu_tanh(v0[3])); w.z = pk2(gelu_tanh(v1[0]), gelu_tanh(v1[1])); w.w = pk2(gelu_tanh(v1[2]), gelu_tanh(v1[3]));
                    *(u32x4*)p = w; } }
    }
};
struct EpiC2 {
    static constexpr bool PERM = false; float* O;
    DI void operator()(const Acc& acc, const pg8::Unit& u, int wr, int wc, int fr, int fq) const {
        if (wc >= 2) return;
        const int row0 = u.pm * 256 + wr * 64 + fr, col0 = wc * 32 + 4 * fq;
#pragma unroll
        for (int ai = 0; ai < 2; ++ai)
#pragma unroll
            for (int m = 0; m < 4; ++m)
#pragma unroll
                for (int n = 0; n < 2; ++n) *(f32x4*)(O + (size_t)(row0 + ai * 128 + m * 16) * 64 + col0 + n * 16) = acc[ai][0][m][n];
    }
};
struct EpiOut {
    static constexpr bool PERM = true; bf16* O; const float* xin; const bf16* xb; const float* gt;
    DI void operator()(const Acc& acc, const pg8::Unit& u, int wr, int wc, int fr, int fq) const {
        const int row0 = u.pm * 256 + wr * 64 + fr, col0 = u.pn * 256 + wc * 32 + 8 * fq; const int b = (u.pm * 256) / NS;
#pragma unroll
        for (int bj = 0; bj < 2; ++bj) { const float* gp = gt + (size_t)b * 6144 + col0 + bj * 128; const f32x4 g0 = *(const f32x4*)gp, g1 = *(const f32x4*)(gp + 4);
#pragma unroll
            for (int ai = 0; ai < 2; ++ai)
#pragma unroll
                for (int m = 0; m < 4; ++m) { const size_t o = (size_t)(row0 + ai * 128 + m * 16) * DM + col0 + bj * 128; f32x4 x0, x1;
                    if (xin) { x0 = *(const f32x4*)(xin + o); x1 = *(const f32x4*)(xin + o + 4); }
                    else { const u32x4 t = *(const u32x4*)(xb + o); x0 = (f32x4){bflo(t.x), bfhi(t.x), bflo(t.y), bfhi(t.y)}; x1 = (f32x4){bflo(t.z), bfhi(t.z), bflo(t.w), bfhi(t.w)}; }
                    const f32x4 v0 = x0 + g0 * acc[ai][bj][m][0], v1 = x1 + g1 * acc[ai][bj][m][1]; u32x4 w;
                    w.x = pk2(v0[0], v0[1]); w.y = pk2(v0[2], v0[3]); w.z = pk2(v1[0], v1[1]); w.w = pk2(v1[2], v1[3]); *(u32x4*)(O + o) = w; } }
    }
};
struct EpiGU {
    static constexpr bool PERM = true; bf16* O; const float* bgu;
    DI void operator()(const Acc& acc, const pg8::Unit& u, int wr, int wc, int fr, int fq) const {
        const int row0 = u.pm * 256 + wr * 64 + fr, cc = u.pn * 128 + wc * 32 + 8 * fq; const float* bp = bgu + (size_t)u.e * 2048 + cc;
        const f32x4 g0 = *(const f32x4*)bp, g1 = *(const f32x4*)(bp + 4), u0 = *(const f32x4*)(bp + 1024), u1 = *(const f32x4*)(bp + 1028);
#pragma unroll
        for (int ai = 0; ai < 2; ++ai)
#pragma unroll
            for (int m = 0; m < 4; ++m) { bf16* p = O + (size_t)(row0 + ai * 128 + m * 16) * FF + cc; float r[8];
#pragma unroll
                for (int n = 0; n < 2; ++n) { const f32x4 gv = acc[ai][0][m][n] + (n ? g1 : g0), uv = acc[ai][1][m][n] + (n ? u1 : u0);
#pragma unroll
                    for (int j = 0; j < 4; ++j) { const float ga = fminf(gv[j], 7.f), up = fminf(fmaxf(uv[j], -7.f), 7.f); r[4 * n + j] = ga * fsigmoid(1.702f * ga) * (up + 1.f); } }
                u32x4 w; w.x = pk2(r[0], r[1]); w.y = pk2(r[2], r[3]); w.z = pk2(r[4], r[5]); w.w = pk2(r[6], r[7]); *(u32x4*)p = w; }
    }
};
struct EpiDN {
    static constexpr bool PERM = true; bf16* O; const float* bd;
    DI void operator()(const Acc& acc, const pg8::Unit& u, int wr, int wc, int fr, int fq) const {
        const int row0 = u.pm * 256 + wr * 64 + fr, col0 = u.pn * 256 + wc * 32 + 8 * fq; const float* bp = bd + (size_t)u.e * 1024 + col0;
#pragma unroll
        for (int bj = 0; bj < 2; ++bj) { const f32x4 b0 = *(const f32x4*)(bp + bj * 128), b1 = *(const f32x4*)(bp + bj * 128 + 4);
#pragma unroll
            for (int ai = 0; ai < 2; ++ai)
#pragma unroll
                for (int m = 0; m < 4; ++m) { bf16* p = O + (size_t)(row0 + ai * 128 + m * 16) * DM + col0 + bj * 128; const f32x4 v0 = acc[ai][bj][m][0] + b0, v1 = acc[ai][bj][m][1] + b1; u32x4 w;
                    w.x = pk2(v0[0], v0[1]); w.y = pk2(v0[2], v0[3]); w.z = pk2(v1[0], v1[1]); w.w = pk2(v1[2], v1[3]); *(u32x4*)p = w; } }
    }
};
DI float clamp8(float x) { return fminf(fmaxf(x, -448.f), 448.f); }
DI unsigned pk4_fp8_nc(float a, float b, float c, float d) { unsigned w = 0u; w = __builtin_amdgcn_cvt_pk_fp8_f32(a, b, w, false); w = __builtin_amdgcn_cvt_pk_fp8_f32(c, d, w, true); return w; }
DI unsigned pk4_fp8(float a, float b, float c, float d) { unsigned w = 0u; w = __builtin_amdgcn_cvt_pk_fp8_f32(clamp8(a), clamp8(b), w, false); w = __builtin_amdgcn_cvt_pk_fp8_f32(clamp8(c), clamp8(d), w, true); return w; }
constexpr float W8_SCALE = 32.f, W8_INV = 1.f / 32.f;
struct EpiGU8 {
    static constexpr bool PERM = true; unsigned char* O; const float* bgu;
    DI void operator()(const Acc& acc, const pg8::Unit& u, int wr, int wc, int fr, int fq) const {
        const int row0 = u.pm * 256 + wr * 64 + fr, cc = u.pn * 128 + wc * 32 + 8 * fq; const float* bp = bgu + (size_t)u.e * 2048 + cc;
        const f32x4 g0 = *(const f32x4*)bp, g1 = *(const f32x4*)(bp + 4), u0 = *(const f32x4*)(bp + 1024), u1 = *(const f32x4*)(bp + 1028);
        const f32x2 bg[4] = {(f32x2){g0[0], g0[1]}, (f32x2){g0[2], g0[3]}, (f32x2){g1[0], g1[1]}, (f32x2){g1[2], g1[3]}};
        const f32x2 bu[4] = {(f32x2){u0[0] + 1.f, u0[1] + 1.f}, (f32x2){u0[2] + 1.f, u0[3] + 1.f}, (f32x2){u1[0] + 1.f, u1[1] + 1.f}, (f32x2){u1[2] + 1.f, u1[3] + 1.f}};
#pragma unroll
        for (int ai = 0; ai < 2; ++ai)
#pragma unroll
            for (int m = 0; m < 4; ++m) { unsigned char* p = O + (size_t)(row0 + ai * 128 + m * 16) * FF + cc; f32x2 r[4];
#pragma unroll
                for (int h2 = 0; h2 < 4; ++h2) { const int n = h2 >> 1, j = (h2 & 1) * 2;
                    f32x2 gv = (f32x2){acc[ai][0][m][n][j], acc[ai][0][m][n][j + 1]} * W8_INV + bg[h2];
                    f32x2 uv = (f32x2){acc[ai][1][m][n][j], acc[ai][1][m][n][j + 1]} * W8_INV + bu[h2];
                    gv[0] = fminf(gv[0], 7.f); gv[1] = fminf(gv[1], 7.f); uv[0] = __builtin_amdgcn_fmed3f(uv[0], -6.f, 8.f); uv[1] = __builtin_amdgcn_fmed3f(uv[1], -6.f, 8.f);
                    const f32x2 t = gv * -2.45546695959f; f32x2 e; e[0] = __builtin_amdgcn_exp2f(t[0]); e[1] = __builtin_amdgcn_exp2f(t[1]);
                    e = e + 1.f; f32x2 sg; sg[0] = __builtin_amdgcn_rcpf(e[0]); sg[1] = __builtin_amdgcn_rcpf(e[1]);
                    r[h2] = (gv * sg) * uv; }
                u32x2 w; w.x = pk4_fp8_nc(r[0][0], r[0][1], r[1][0], r[1][1]); w.y = pk4_fp8_nc(r[2][0], r[2][1], r[3][0], r[3][1]); *(u32x2*)p = w; }
    }
};
#ifndef YB_FP8
#define YB_FP8 1
#endif
struct EpiDN8 {
    static constexpr bool PERM = true; bf16* O; const float* bd;
    DI void operator()(const Acc& acc, const pg8::Unit& u, int wr, int wc, int fr, int fq) const {
        const int row0 = u.pm * 256 + wr * 64 + fr, col0 = u.pn * 256 + wc * 32 + 8 * fq; const float* bp = bd + (size_t)u.e * 1024 + col0;
#pragma unroll
        for (int bj = 0; bj < 2; ++bj) { const f32x4 b0 = *(const f32x4*)(bp + bj * 128), b1 = *(const f32x4*)(bp + bj * 128 + 4);
#pragma unroll
            for (int ai = 0; ai < 2; ++ai)
#pragma unroll
                for (int m = 0; m < 4; ++m) { const size_t oo = (size_t)(row0 + ai * 128 + m * 16) * DM + col0 + bj * 128; const f32x4 v0 = acc[ai][bj][m][0] * W8_INV + b0, v1 = acc[ai][bj][m][1] * W8_INV + b1;
                    if (YB_FP8) { u32x2 w; w.x = pk4_fp8(v0[0], v0[1], v0[2], v0[3]); w.y = pk4_fp8(v1[0], v1[1], v1[2], v1[3]); *(u32x2*)((unsigned char*)O + oo) = w; }
                    else { u32x4 w; w.x = pk2(v0[0], v0[1]); w.y = pk2(v0[2], v0[3]); w.z = pk2(v1[0], v1[1]); w.w = pk2(v1[2], v1[3]); *(u32x4*)(O + oo) = w; } } }
    }
};
DI void tr_item(const float* src, int ld_src, int scol0, int nvalid, int k0, bf16* dst, int ld_dst, int drow0, int dk0, LAS float* scr, int lane) {
    const int n4 = (lane & 7) * 4, kr = lane >> 3; f32x4 v[8];
#pragma unroll
    for (int i = 0; i < 8; ++i) v[i] = (n4 < nvalid) ? *(const f32x4*)(src + (size_t)(k0 + kr + 8 * i) * ld_src + scol0 + n4) : (f32x4){0.f, 0.f, 0.f, 0.f};
#pragma unroll
    for (int i = 0; i < 8; ++i) { LAS float* s = scr + (kr + 8 * i) * 33 + n4; s[0] = v[i][0]; s[1] = v[i][1]; s[2] = v[i][2]; s[3] = v[i][3]; }
    asm volatile("s_waitcnt lgkmcnt(0)" ::: "memory");
    const int c = lane & 7;
#pragma unroll
    for (int jq = 0; jq < 4; ++jq) { const int n = (lane >> 3) + 8 * jq; const LAS float* s = scr + (8 * c) * 33 + n;
        u32x4 o; o.x = pk2(s[0 * 33], s[1 * 33]); o.y = pk2(s[2 * 33], s[3 * 33]); o.z = pk2(s[4 * 33], s[5 * 33]); o.w = pk2(s[6 * 33], s[7 * 33]);
        *(u32x4*)(dst + (size_t)(drow0 + n) * ld_dst + dk0 + k0 + 8 * c) = o; }
    asm volatile("s_waitcnt lgkmcnt(0)" ::: "memory");
}
DI void tr_item8(const float* src, int ld_src, int scol0, int k0, unsigned char* dst, int ld_dst, int drow0, LAS float* scr, int lane, int nvalid = 32) {
    const int n4 = (lane & 7) * 4, kr = lane >> 3; f32x4 v[8];
#pragma unroll
    for (int i = 0; i < 8; ++i) v[i] = (n4 < nvalid) ? *(const f32x4*)(src + (size_t)(k0 + kr + 8 * i) * ld_src + scol0 + n4) : (f32x4){0.f, 0.f, 0.f, 0.f};
#pragma unroll
    for (int i = 0; i < 8; ++i) { LAS float* s = scr + (kr + 8 * i) * 33 + n4; s[0] = v[i][0]; s[1] = v[i][1]; s[2] = v[i][2]; s[3] = v[i][3]; }
    asm volatile("s_waitcnt lgkmcnt(0)" ::: "memory");
    const int c = lane & 7;
#pragma unroll
    for (int jq = 0; jq < 4; ++jq) { const int n = (lane >> 3) + 8 * jq; const LAS float* s = scr + (8 * c) * 33 + n;
        u32x2 o; o.x = pk4_fp8(s[0 * 33] * W8_SCALE, s[1 * 33] * W8_SCALE, s[2 * 33] * W8_SCALE, s[3 * 33] * W8_SCALE); o.y = pk4_fp8(s[4 * 33] * W8_SCALE, s[5 * 33] * W8_SCALE, s[6 * 33] * W8_SCALE, s[7 * 33] * W8_SCALE);
        *(u32x2*)(dst + (size_t)(drow0 + n) * ld_dst + k0 + 8 * c) = o; }
    asm volatile("s_waitcnt lgkmcnt(0)" ::: "memory");
}
DI void conv_item(const Ctx& C, int l, int r, LAS float* scr) {
    constexpr int I_GU = 32 * 16 * 64;
    if (r < I_GU) { const int e = r / 1024, r2 = r % 1024, kb = r2 / 64, nb = r2 % 64, n0 = 32 * nb, j = n0 / 256, i = n0 % 256;
        const int scol0 = (i < 128) ? 128 * j + i : 1024 + 128 * j + (i - 128);
        tr_item8(C.w_gu + (size_t)(l * 32 + e) * 1024 * 2048, 2048, scol0, 64 * kb, WSP(unsigned char, WS_WGU) + (size_t)(l * 32 + e) * 2048 * 1024, 1024, n0, scr, C.lane); }
    else { r -= I_GU; const int e = r / 512, r2 = r % 512, kb = r2 / 32, nb = r2 % 32;
        tr_item8(C.w_down + (size_t)(l * 32 + e) * 1024 * 1024, 1024, 32 * nb, 64 * kb, WSP(unsigned char, WS_WDN) + (size_t)(l * 32 + e) * 1024 * 1024, 1024, 32 * nb, scr, C.lane); }
}
DI void conv_ticket(const Ctx& C0, int l, int tk) {
    Ctx C = C0; asm volatile("" : "+v"(C.lane), "+v"(C.tid));
    LAS float* scr = (LAS float*)(C.lds + C.wave * 16384);
    __syncthreads();
#pragma unroll 1
    for (int i = 0; i < 8; ++i) conv_item(C, l, tk * 64 + C.wave * 8 + i, scr);
}
DI void p0_prologue(const Ctx& C) {
    LAS float* scr = (LAS float*)(C.lds + C.wave * 16384);
    const int gw = C.bid * NWAVE + C.wave, NGW = C.G * NWAVE;
    constexpr int I_IN = 16 * 104, I_OUT = 16 * 32, I_LW = 8, I_LA = 8, I_LG = 16, I_K1 = 256, I_K2 = 8;
    constexpr int I_LAYER = I_IN + I_OUT + I_LW + I_LA + I_LG + 2 * I_K1 + 2 * I_K2;
    for (int it = gw; it < NLAYER * I_LAYER; it += NGW) {
        const int l = it / I_LAYER; int r = it % I_LAYER;
        if (r < I_IN) { const int kb = r / 104, nb = r % 104, n0 = 32 * nb; int nv = 3212 - n0; nv = nv < 0 ? 0 : (nv > 32 ? 32 : nv);
            if (INPROJ_FP8) tr_item8(C.w_in + (size_t)l * 1024 * 3212, 3212, n0, 64 * kb, WSP(unsigned char, WS_WIN) + (size_t)l * NPJ * 1024, 1024, n0, scr, C.lane, nv);
            else tr_item(C.w_in + (size_t)l * 1024 * 3212, 3212, n0, nv, 64 * kb, WSP(bf16, WS_WIN) + (size_t)l * NPJ * 1024, 1024, n0, 0, scr, C.lane); continue; } r -= I_IN;
        if (r < I_OUT) { const int kb = r / 32, nb = r % 32;
            tr_item(C.w_out + (size_t)l * 1024 * 1024, 1024, 32 * nb, 32, 64 * kb, WSP(bf16, WS_WOUT) + (size_t)l * 1024 * 1024, 1024, 32 * nb, 0, scr, C.lane); continue; } r -= I_OUT;
        bf16* lora = WSP(bf16, WS_LORA) + (size_t)l * 768 * 256;
        if (r < I_LW) { tr_item(C.w2 + (size_t)l * 64 * 256, 256, 32 * r, 32, 0, lora, 256, 32 * r, 0, scr, C.lane); continue; } r -= I_LW;
        if (r < I_LA) { tr_item(C.a2 + (size_t)l * 64 * 256, 256, 32 * r, 32, 0, lora, 256, 256 + 32 * r, 64, scr, C.lane); continue; } r -= I_LA;
        if (r < I_LG) { const int kb = r / 8, nb = r % 8; tr_item(C.g2 + (size_t)l * 128 * 256, 256, 32 * nb, 32, 64 * kb, lora, 256, 512 + 32 * nb, 128, scr, C.lane); continue; } r -= I_LG;
        if (r < 2 * I_K1) { const int kv = r / I_K1, r2 = r % I_K1, kb = r2 / 8, nb = r2 % 8;
            tr_item((kv ? C.wv1 : C.wk1) + (size_t)l * 2048 * 256, 256, 32 * nb, 32, 64 * kb, WSP(bf16, WS_WK1) + (size_t)(l * 2 + kv) * 256 * 2048, 2048, 32 * nb, 0, scr, C.lane); continue; } r -= 2 * I_K1;
        { const int kv = r / I_K2, r2 = r % I_K2, kb = r2 / 2, nb = r2 % 2;
            tr_item((kv ? C.wv2 : C.wk2) + (size_t)l * 256 * 64, 64, 32 * nb, 32, 64 * kb, WSP(bf16, WS_WK2) + (size_t)(l * 2 + kv) * 256 * 256, 256, 32 * nb, 0, scr, C.lane); }
    }
    { int* idm = WSP(int, WS_ROUTE) + NT * 12 + NR; for (int i = C.bid * NTHR + C.tid; i < NR; i += C.G * NTHR) idm[i] = i; }
    __syncthreads();
    float* MOD = WSP(float, WS_SMALL); float* PEB = MOD + NLAYER * 8 * 6144;
    LAS float* sc = (LAS float*)C.lds;
    LAS float* red = sc + 8192;
    for (int it = C.bid; it < 192 + 32; it += C.G) {
        if (it < 192) {
            const int l = it / 96, n0 = (it % 96) * 64;
            for (int i = C.tid; i < 8192; i += NTHR) { const float v = C.c[i]; sc[i] = v * fsigmoid(v); }
            __syncthreads();
            const int kq = C.tid >> 6, col = C.tid & 63; float a[8];
#pragma unroll
            for (int b = 0; b < 8; ++b) a[b] = 0.f;
            const float* wp = C.w_ada + (size_t)l * 1024 * 6144 + n0 + col;
#pragma unroll 32
            for (int k = kq * 128; k < kq * 128 + 128; ++k) { const float w = wp[(size_t)k * 6144];
#pragma unroll
                for (int b = 0; b < 8; ++b) a[b] += sc[b * 1024 + k] * w; }
#pragma unroll
            for (int b = 0; b < 8; ++b) red[(kq * 8 + b) * 64 + col] = a[b];
            __syncthreads();
            { const int b = C.tid >> 6; float s = C.b_ada[(size_t)l * 6144 + n0 + col];
#pragma unroll
              for (int q = 0; q < 8; ++q) s += red[(q * 8 + b) * 64 + col];
              MOD[((size_t)l * 8 + b) * 6144 + n0 + col] = s; }
            __syncthreads();
        } else {
            const int r = it - 192, l = r >> 4, kv = (r >> 3) & 1, c0 = (r & 7) * 32; const float* pe = (kv ? C.pe_v : C.pe_k) + (size_t)l * 2048; const float* w1 = (kv ? C.wv1 : C.wk1) + (size_t)l * 2048 * 256;
            const int kq = C.tid >> 5, col = C.tid & 31; float a = 0.f;
#pragma unroll 16
            for (int k = kq * 128; k < kq * 128 + 128; ++k) a += pe[k] * w1[(size_t)k * 256 + c0 + col];
            red[kq * 32 + col] = a; __syncthreads();
            if (C.tid < 32) { float s = 0.f;
#pragma unroll
                for (int q = 0; q < 16; ++q) s += red[q * 32 + C.tid];
                PEB[(l * 2 + kv) * 256 + c0 + C.tid] = s; }
            __syncthreads();
        }
    }
}

DI void norm_row(const Ctx& C, const float* xrow, const float* g, const float* sh, const float* sc, bf16* orow) {
    f32x4 v[4]; float s = 0.f;
#pragma unroll
    for (int j = 0; j < 4; ++j) { v[j] = *(const f32x4*)(xrow + 4 * C.lane + 256 * j); s += (v[j][0] * v[j][0] + v[j][1] * v[j][1]) + (v[j][2] * v[j][2] + v[j][3] * v[j][3]); }
    s = group_sum<64>(s); const float rstd = rsqrtf(s * (1.f / DM) + 1e-6f);
#pragma unroll
    for (int j = 0; j < 4; ++j) { const int k = 4 * C.lane + 256 * j; const f32x4 gg = *(const f32x4*)(g + k), a = *(const f32x4*)(sc + k), b = *(const f32x4*)(sh + k); f32x4 h;
#pragma unroll
        for (int i = 0; i < 4; ++i) h[i] = v[j][i] * rstd * gg[i] * (1.f + a[i]) + b[i];
        if (INPROJ_FP8) *(unsigned*)((unsigned char*)orow + k) = pk4_fp8(h[0], h[1], h[2], h[3]);
        else { u32x2 o; o.x = pk2(h[0], h[1]); o.y = pk2(h[2], h[3]); *(u32x2*)(orow + k) = o; } }
}
DI void norm1_phase(const Ctx& C, int l, const float* xin) {
    const float* MOD = WSP(float, WS_SMALL) + (size_t)l * 8 * 6144; bf16* H = WSP(bf16, WS_H);
    const int gw = C.bid * NWAVE + C.wave, NGW = C.G * NWAVE;
    for (int m = gw; m < NT; m += NGW) { const int b = m / NS; norm_row(C, xin + (size_t)m * DM, C.norm1_g + l * DM, MOD + b * 6144, MOD + b * 6144 + 1024, INPROJ_FP8 ? (bf16*)((unsigned char*)H + (size_t)m * DM) : H + (size_t)m * DM); }
}

constexpr float QSCALE = 0.125f * 1.44269504089f;
DI void prep_phase(const Ctx& C, int l) {
    const bf16* PROJ = WSP(bf16, R_PROJ); bf16* SCH = WSP(bf16, R_SCH); bf16* LIN = WSP(bf16, R_LIN); bf16* YCAT = WSP(bf16, R_YCAT);
    bf16 *QC = WSP(bf16, R_QC), *KC = WSP(bf16, R_KC), *QN = WSP(bf16, R_QN), *QR = WSP(bf16, R_QR), *KCR = WSP(bf16, R_KCR), *VCR = WSP(bf16, R_VCR), *KS = WSP(bf16, R_KS), *KW = WSP(bf16, R_KW);
    float* GATE = WSP(float, R_GATE);
    const int lane = C.lane, gw = C.bid * NWAVE + C.wave, NGW = C.G * NWAVE;
    const int hh = lane >> 4, jj = lane & 15;
    const float inv0 = exp2f(-(float)(2 * jj) * (13.287712379549449f / 32.f)) * 0.15915494309189535f, inv1 = exp2f(-(float)(2 * jj + 1) * (13.287712379549449f / 32.f)) * 0.15915494309189535f;
    for (int task = gw; task < NT / 16; task += NGW) {
        const int row0 = 16 * task, s0 = row0 % NS;
        {
            const int c0 = 16 * lane, cc = (c0 - 256) & 255; float mu16[16], kw16[16];
#pragma unroll
            for (int q = 0; q < 4; ++q) { const f32x4 m4 = *(const f32x4*)(C.mu + (size_t)l * 1024 + c0 + 4 * q), k4 = *(const f32x4*)(C.kkw + (size_t)l * 256 + cc + 4 * q);
#pragma unroll
                for (int i = 0; i < 4; ++i) { mu16[4 * q + i] = m4[i]; kw16[4 * q + i] = k4[i]; } }
#pragma unroll 2
            for (int r = 0; r < 16; ++r) {
                const int row = row0 + r; const bf16* pr = PROJ + (size_t)row * NPJ; float z[16];
                const u32x4 c0v = *(const u32x4*)(pr + c0), c1v = *(const u32x4*)(pr + c0 + 8);
                u32x4 p0v = (u32x4){0u, 0u, 0u, 0u}, p1v = p0v;
                if (s0 + r > 0) { p0v = *(const u32x4*)(pr - NPJ + c0); p1v = *(const u32x4*)(pr - NPJ + c0 + 8); }
                const unsigned cw[8] = {c0v.x, c0v.y, c0v.z, c0v.w, c1v.x, c1v.y, c1v.z, c1v.w}, pw[8] = {p0v.x, p0v.y, p0v.z, p0v.w, p1v.x, p1v.y, p1v.z, p1v.w};
#pragma unroll
                for (int e = 0; e < 16; ++e) { const float cu = (e & 1) ? bfhi(cw[e >> 1]) : bflo(cw[e >> 1]), pv = (e & 1) ? bfhi(pw[e >> 1]) : bflo(pw[e >> 1]); z[e] = cu + (pv - cu) * mu16[e]; }
                float kk[16]; float ss = 0.f;
#pragma unroll
                for (int e = 0; e < 16; ++e) { kk[e] = z[e] * kw16[e]; ss += kk[e] * kk[e]; }
                ss = group_sum<4>(ss); const float kinv = rsqrtf(ss + 1e-12f);
                if (lane < 48) {
                    const int pl = lane < 16 ? 3 : (lane < 32 ? 0 : 4); bf16* dst = SCH + ((size_t)pl * NT + row) * 256 + (c0 & 255);
                    u32x4 o0, o1; o0.x = pk2(z[0], z[1]); o0.y = pk2(z[2], z[3]); o0.z = pk2(z[4], z[5]); o0.w = pk2(z[6], z[7]); o1.x = pk2(z[8], z[9]); o1.y = pk2(z[10], z[11]); o1.z = pk2(z[12], z[13]); o1.w = pk2(z[14], z[15]);
                    *(u32x4*)dst = o0; *(u32x4*)(dst + 8) = o1;
                    if (lane >= 16 && lane < 32) { bf16* d2 = SCH + ((size_t)1 * NT + row) * 256 + cc;
                        u32x4 q0, q1; q0.x = pk2(kk[0] * kinv, kk[1] * kinv); q0.y = pk2(kk[2] * kinv, kk[3] * kinv); q0.z = pk2(kk[4] * kinv, kk[5] * kinv); q0.w = pk2(kk[6] * kinv, kk[7] * kinv);
                        q1.x = pk2(kk[8] * kinv, kk[9] * kinv); q1.y = pk2(kk[10] * kinv, kk[11] * kinv); q1.z = pk2(kk[12] * kinv, kk[13] * kinv); q1.w = pk2(kk[14] * kinv, kk[15] * kinv);
                        *(u32x4*)d2 = q0; *(u32x4*)(d2 + 8) = q1; }
                } else {
                    float t[16];
#pragma unroll
                    for (int i = 0; i < 16; ++i) { const float sg = fsigmoid(lane < 52 ? 2.f * z[i] : z[i]); t[i] = lane < 52 ? 2.f * sg - 1.f : (lane < 56 ? z[i] : sg); }
                    bf16* dst = LIN + (size_t)row * 256 + (c0 - 768);
                    u32x4 o0, o1; o0.x = pk2(t[0], t[1]); o0.y = pk2(t[2], t[3]); o0.z = pk2(t[4], t[5]); o0.w = pk2(t[6], t[7]); o1.x = pk2(t[8], t[9]); o1.y = pk2(t[10], t[11]); o1.z = pk2(t[12], t[13]); o1.w = pk2(t[14], t[15]);
                    *(u32x4*)dst = o0; *(u32x4*)(dst + 8) = o1;
                }
            }
        }
        {
            const int ch = 4 * lane; const float* cw = C.conv_w + (size_t)l * 3 * 256 + ch; const f32x4 w0 = *(const f32x4*)cw, w1 = *(const f32x4*)(cw + 256), w2 = *(const f32x4*)(cw + 512);
            const f32x4 og = *(const f32x4*)(C.onorm_g + (size_t)l * 768 + ch);
#pragma unroll 2
            for (int r = 0; r < 16; ++r) {
                const int row = row0 + r, s = s0 + r; const bf16* pr = PROJ + (size_t)row * NPJ; float u[3][4];
#pragma unroll
                for (int d = 0; d < 3; ++d) {
                    u32x2 cg = (u32x2){0u, 0u}, xi = cg;
                    if (s >= d) { cg = *(const u32x2*)(pr - (size_t)d * NPJ + PJ_B + 256 + ch); xi = *(const u32x2*)(pr - (size_t)d * NPJ + PJ_B + 512 + ch); }
                    u[d][0] = bflo(cg.x) * bflo(xi.x); u[d][1] = bfhi(cg.x) * bfhi(xi.x); u[d][2] = bflo(cg.y) * bflo(xi.y); u[d][3] = bfhi(cg.y) * bfhi(xi.y);
                }
                const u32x2 bgv = *(const u32x2*)(pr + PJ_B + ch); const float bg[4] = {bflo(bgv.x), bfhi(bgv.x), bflo(bgv.y), bfhi(bgv.y)};
                float y[4]; float ss = 0.f;
#pragma unroll
                for (int i = 0; i < 4; ++i) { y[i] = bg[i] * (w0[i] * u[2][i] + w1[i] * u[1][i] + w2[i] * u[0][i]); ss += y[i] * y[i]; }
                ss = group_sum<16>(ss); const float rstd = rsqrtf(ss * (1.f / 64.f) + 1e-6f);
                u32x2 o; o.x = pk2(y[0] * rstd * og[0], y[1] * rstd * og[1]); o.y = pk2(y[2] * rstd * og[2], y[3] * rstd * og[3]);
                *(u32x2*)(YCAT + (size_t)row * DM + 256 + ch) = o;
            }
        }
        {
            const float* gq = C.dil_q_g + (size_t)l * 64; const float* gk = C.dil_k_g + (size_t)l * 64; const float* gn = C.nsa_q_g + (size_t)l * 64; const float* gv = (hh == 0 ? C.nsa_ks_g : C.nsa_kw_g) + (size_t)l * 64;
            float Gq[4], Gk[4], Gn[4], Gv[4];
#pragma unroll
            for (int i = 0; i < 4; ++i) { const int d = (i >> 1) * 32 + 2 * jj + (i & 1); Gq[i] = gq[d] * QSCALE; Gk[i] = gk[d]; Gn[i] = gn[d] * QSCALE; Gv[i] = gv[d]; }
            const int vcol = hh == 0 ? 2944 : (hh == 1 ? 3072 : (hh == 2 ? 2816 : 2880));
            bf16* vdst = (hh == 0 ? KS : (hh == 1 ? KW : (hh == 2 ? KCR : VCR)));
#pragma unroll 2
            for (int r = 0; r < 16; ++r) {
                const int row = row0 + r; const bf16* pr = PROJ + (size_t)row * NPJ;
                const float posf = (float)C.pos[row];
                const float x0 = __builtin_amdgcn_fractf(posf * inv0), x1 = __builtin_amdgcn_fractf(posf * inv1);
                const float sn0 = __builtin_amdgcn_sinf(x0), cs0 = __builtin_amdgcn_cosf(x0), sn1 = __builtin_amdgcn_sinf(x1), cs1 = __builtin_amdgcn_cosf(x1);
                const unsigned qa = *(const unsigned*)(pr + PJ_C + hh * 64 + 2 * jj), qb = *(const unsigned*)(pr + PJ_C + hh * 64 + 32 + 2 * jj);
                const unsigned ka = *(const unsigned*)(pr + PJ_C + 256 + hh * 64 + 2 * jj), kb = *(const unsigned*)(pr + PJ_C + 256 + hh * 64 + 32 + 2 * jj);
                const unsigned na = *(const unsigned*)(pr + PJ_D + hh * 64 + 2 * jj), nb = *(const unsigned*)(pr + PJ_D + hh * 64 + 32 + 2 * jj);
                const unsigned va = *(const unsigned*)(pr + vcol + 2 * jj), vb = *(const unsigned*)(pr + vcol + 32 + 2 * jj);
                float gate_in = 0.f; if (lane < 12) gate_in = bf2f(pr[3200 + lane]);
#define ROPE_NORM(a, b, G, o1, o2, n1a, n1b, n2a, n2b) \
                float n1a = bflo(a), n1b = bfhi(a), n2a = bflo(b), n2b = bfhi(b); { const float ss_ = group_sum<16>(n1a * n1a + n1b * n1b + n2a * n2a + n2b * n2b); const float rs_ = rsqrtf(ss_ * (1.f / 64.f) + 1e-6f); \
                    n1a *= rs_ * G[0]; n1b *= rs_ * G[1]; n2a *= rs_ * G[2]; n2b *= rs_ * G[3]; } \
                const unsigned o1 = pk2(n1a * cs0 - n2a * sn0, n1b * cs1 - n2b * sn1), o2 = pk2(n2a * cs0 + n1a * sn0, n2b * cs1 + n1b * sn1);
                ROPE_NORM(qa, qb, Gq, q1, q2, q1a, q1b, q2a, q2b)
                ROPE_NORM(ka, kb, Gk, k1, k2, k1a, k1b, k2a, k2b)
                ROPE_NORM(na, nb, Gn, r1, r2, r1a, r1b, r2a, r2b)
                ROPE_NORM(va, vb, Gv, v1, v2, v1a, v1b, v2a, v2b)
#undef ROPE_NORM
                bf16* o = QC + (size_t)row * 256 + hh * 64 + 2 * jj; *(unsigned*)o = q1; *(unsigned*)(o + 32) = q2;
                o = KC + (size_t)row * 256 + hh * 64 + 2 * jj; *(unsigned*)o = k1; *(unsigned*)(o + 32) = k2;
                o = QN + (size_t)row * 256 + hh * 64 + 2 * jj; *(unsigned*)o = pk2(r1a, r1b); *(unsigned*)(o + 32) = pk2(r2a, r2b);
                o = QR + (size_t)row * 256 + hh * 64 + 2 * jj; *(unsigned*)o = r1; *(unsigned*)(o + 32) = r2;
                o = vdst + (size_t)row * 64 + 2 * jj; *(unsigned*)o = (hh >= 2) ? va : v1; *(unsigned*)(o + 32) = (hh >= 2) ? vb : v2;
                if (lane < 12) GATE[(size_t)row * 12 + lane] = fsigmoid(gate_in);
            }
        }
    }
}
constexpr int SCAN_TC = 16;
DI void scan_unit8(const Ctx& C, int u) {
    const float* Wp = WSP(float, R_SC); const bf16* SCH = WSP(bf16, R_SCH); float* YA = WSP(float, R_YA); float* UB = WSP(float, R_SCANU); float* SMT = WSP(float, R_SCANS);
    const int pair = u / 3, kind = u % 3, b = pair >> 2, h = pair & 3, tid = C.tid;
    LAS float* buf = (LAS float*)C.lds;
    LAS float* ybuf = buf + 2 * 6144;
    const int row = tid >> 3, cg = tid & 7, tbase = kind == 0 ? 0 : NS / 2;
    const float vm = kind == 2 ? 0.f : 1.f;
    u32x4 ldA[2], ldB[2];
#define SCAN_LOAD(ld, chunk) do { _Pragma("unroll") for (int i = 0; i < 2; ++i) { const int p_ = tid + 512 * i; if (p_ < 896) { const int step = p_ / 56, r_ = p_ % 56; const size_t row_ = (size_t)b * NS + tbase + (chunk) * SCAN_TC + step; \
        if (r_ < 16) ld[i] = *(const u32x4*)(Wp + row_ * 256 + h * 64 + r_ * 4); else { const int v5 = (r_ - 16) >> 3, c_ = (r_ - 16) & 7; ld[i] = *(const u32x4*)(SCH + ((size_t)v5 * NT + row_) * 256 + h * 64 + c_ * 8); } } } } while (0)
#define SCAN_STORE(ld, slot) do { _Pragma("unroll") for (int i = 0; i < 2; ++i) { const int p_ = tid + 512 * i; if (p_ < 896) { const int step = p_ / 56, r_ = p_ % 56; LAS float* d_ = buf + (slot) * 6144 + step * 384; \
        if (r_ < 16) *(LAS u32x4*)(d_ + r_ * 4) = ld[i]; else { const int v5 = (r_ - 16) >> 3, c_ = (r_ - 16) & 7; LAS float* e_ = d_ + (1 + v5) * 64 + c_ * 8; const u32x4 x_ = ld[i]; \
            *(LAS f32x4*)e_ = (f32x4){bflo(x_.x), bfhi(x_.x), bflo(x_.y), bfhi(x_.y)}; *(LAS f32x4*)(e_ + 4) = (f32x4){bflo(x_.z), bfhi(x_.z), bflo(x_.w), bfhi(x_.w)}; } } } } while (0)
#define SCAN_FLUSH(chunk) do { _Pragma("unroll") for (int i = 0; i < 2; ++i) { const int i2 = tid + 512 * i, step = i2 >> 6, rr = i2 & 63; const LAS float* pp_ = ybuf + ((chunk) & 1) * 8192 + step * 512 + rr * 8; \
        const f32x4 pa_ = *(const LAS f32x4*)pp_, pb_ = *(const LAS f32x4*)(pp_ + 4); const float yv = ((pa_[0] + pa_[1]) + (pa_[2] + pa_[3])) + ((pb_[0] + pb_[1]) + (pb_[2] + pb_[3])); \
        if (kind == 2) UB[((size_t)b * (NS / 2) + (chunk) * SCAN_TC + step) * 256 + h * 64 + rr] = yv; else YA[((size_t)b * NS + tbase + (chunk) * SCAN_TC + step) * 256 + h * 64 + rr] = yv; } } while (0)
    __syncthreads();
    SCAN_LOAD(ldA, 0); SCAN_STORE(ldA, 0); SCAN_LOAD(ldB, 1); SCAN_LOAD(ldA, 2);
    f32x2 S[4];
#pragma unroll
    for (int c = 0; c < 4; ++c) { S[c][0] = (kind == 2 && row == 8 * cg + 2 * c) ? 1.f : 0.f; S[c][1] = (kind == 2 && row == 8 * cg + 2 * c + 1) ? 1.f : 0.f; }
    constexpr int NCH = (NS / 2) / SCAN_TC;
#pragma unroll 2
    for (int ck = 0; ck < NCH; ++ck) {
        __syncthreads();
        if (ck & 1) { if (ck + 1 < NCH) SCAN_STORE(ldA, (ck + 1) & 1); if (ck + 3 < NCH) SCAN_LOAD(ldA, ck + 3); }
        else        { if (ck + 1 < NCH) SCAN_STORE(ldB, (ck + 1) & 1); if (ck + 3 < NCH) SCAN_LOAD(ldB, ck + 3); }
        {
            const LAS float* bp = buf + (ck & 1) * 6144; LAS float* yb = ybuf + (ck & 1) * 8192 + tid;
#define SCAN_LDS(X, step) do { const LAS float* sp = bp + (step) * 384 + 8 * cg; X.w0 = *(const LAS f32x4*)(sp); X.w1 = *(const LAS f32x4*)(sp + 4); X.k0 = *(const LAS f32x4*)(sp + 64); X.k1 = *(const LAS f32x4*)(sp + 68); \
                X.q0 = *(const LAS f32x4*)(sp + 128); X.q1 = *(const LAS f32x4*)(sp + 132); X.b0 = *(const LAS f32x4*)(sp + 192); X.b1 = *(const LAS f32x4*)(sp + 196); \
                X.r0 = *(const LAS f32x4*)(sp + 256); X.r1 = *(const LAS f32x4*)(sp + 260); X.v = bp[(step) * 384 + 320 + row] * vm; } while (0)
#define SCAN_STEP(X, step) do { \
                f32x2 d2 = S[0] * (f32x2){X.q0[0], X.q0[1]}; d2 = S[1] * (f32x2){X.q0[2], X.q0[3]} + d2; d2 = S[2] * (f32x2){X.q1[0], X.q1[1]} + d2; d2 = S[3] * (f32x2){X.q1[2], X.q1[3]} + d2; \
                const float sa = -sum8(d2[0] + d2[1]); const f32x2 sa2 = (f32x2){sa, sa}, v2 = (f32x2){X.v, X.v}; \
                S[0] = S[0] * (f32x2){X.w0[0], X.w0[1]} + (sa2 * (f32x2){X.b0[0], X.b0[1]} + v2 * (f32x2){X.k0[0], X.k0[1]}); \
                S[1] = S[1] * (f32x2){X.w0[2], X.w0[3]} + (sa2 * (f32x2){X.b0[2], X.b0[3]} + v2 * (f32x2){X.k0[2], X.k0[3]}); \
                S[2] = S[2] * (f32x2){X.w1[0], X.w1[1]} + (sa2 * (f32x2){X.b1[0], X.b1[1]} + v2 * (f32x2){X.k1[0], X.k1[1]}); \
                S[3] = S[3] * (f32x2){X.w1[2], X.w1[3]} + (sa2 * (f32x2){X.b1[2], X.b1[3]} + v2 * (f32x2){X.k1[2], X.k1[3]}); \
                f32x2 y2 = S[0] * (f32x2){X.r0[0], X.r0[1]}; y2 = S[1] * (f32x2){X.r0[2], X.r0[3]} + y2; y2 = S[2] * (f32x2){X.r1[0], X.r1[1]} + y2; y2 = S[3] * (f32x2){X.r1[2], X.r1[3]} + y2; \
                yb[(step) * 512] = y2[0] + y2[1]; } while (0)
            struct StepIn { f32x4 w0, w1, k0, k1, q0, q1, b0, b1, r0, r1; float v; } A, B;
            SCAN_LDS(A, 0);
#pragma unroll 2
            for (int step = 0; step < SCAN_TC; step += 2) {
                SCAN_LDS(B, step + 1);
                __builtin_amdgcn_sched_barrier(0);
                SCAN_STEP(A, step);
                __builtin_amdgcn_sched_barrier(0);
                if (step + 2 < SCAN_TC) SCAN_LDS(A, step + 2);
                __builtin_amdgcn_sched_barrier(0);
                SCAN_STEP(B, step + 1);
                __builtin_amdgcn_sched_barrier(0);
            }
#undef SCAN_LDS
#undef SCAN_STEP
        }
        if (ck > 0) SCAN_FLUSH(ck - 1);
    }
    __syncthreads();
    SCAN_FLUSH(NCH - 1);
    if (kind == 0) {
        float* o = SMT + (size_t)pair * 4096 + row;
#pragma unroll
        for (int c = 0; c < 4; ++c) { o[(8 * cg + 2 * c) * 64] = S[c][0]; o[(8 * cg + 2 * c + 1) * 64] = S[c][1]; }
    }
#undef SCAN_LOAD
#undef SCAN_STORE
#undef SCAN_FLUSH
    __syncthreads();
}

constexpr int KROW = 144, KT_BYTES = 64 * KROW;
#define MFMA16(a, b, c) __builtin_amdgcn_mfma_f32_16x16x32_bf16((a), (b), (c), 0, 0, 0)
template <int NQT> struct FA { f32x4 O[NQT][4]; float l[NQT]; float negM; };
template <int NQT> DI void fa_init(FA<NQT>& st) {
#pragma unroll
    for (int q = 0; q < NQT; ++q) { st.l[q] = 0.f;
#pragma unroll
        for (int d = 0; d < 4; ++d) st.O[q][d] = (f32x4){0.f, 0.f, 0.f, 0.f}; }
}
DI bf16x8 pack8(const f32x4& a, const f32x4& b) { u32x4 w; w.x = pk2(a[0], a[1]); w.y = pk2(a[2], a[3]); w.z = pk2(b[0], b[1]); w.w = pk2(b[2], b[3]); return __builtin_bit_cast(bf16x8, w); }
struct VFrag { u32x2 a[4], b[4]; };
DI void vt_issue(VFrag& f, unsigned vaddr) {
    asm volatile("ds_read_b64_tr_b16 %0, %8\n\tds_read_b64_tr_b16 %1, %8 offset:2304\n\tds_read_b64_tr_b16 %2, %8 offset:32\n\tds_read_b64_tr_b16 %3, %8 offset:2336\n\t"
                 "ds_read_b64_tr_b16 %4, %8 offset:64\n\tds_read_b64_tr_b16 %5, %8 offset:2368\n\tds_read_b64_tr_b16 %6, %8 offset:96\n\tds_read_b64_tr_b16 %7, %8 offset:2400"
                 : "=&v"(f.a[0]), "=&v"(f.b[0]), "=&v"(f.a[1]), "=&v"(f.b[1]), "=&v"(f.a[2]), "=&v"(f.b[2]), "=&v"(f.a[3]), "=&v"(f.b[3]) : "v"(vaddr) : "memory");
}
DI void vt_wait(VFrag& f) { asm volatile("s_waitcnt lgkmcnt(0)" : "+v"(f.a[0]), "+v"(f.b[0]), "+v"(f.a[1]), "+v"(f.b[1]), "+v"(f.a[2]), "+v"(f.b[2]), "+v"(f.a[3]), "+v"(f.b[3]) :: "memory"); }
DI bf16x8 vt_get(const VFrag& f, int d) { return __builtin_bit_cast(bf16x8, ((u32x4){f.a[d].x, f.a[d].y, f.b[d].x, f.b[d].y})); }
template <int NQT, bool MASKED, class MaskF>
DI void fa_tile(FA<NQT>& st, const bf16x8 (&Q)[NQT][2], const LAS uchar* Ks, const LAS uchar* Vs, int lane, const MaskF& allowed, const bool (&act)[NQT]) {
    const int l15 = lane & 15, quad = lane >> 4;
    float nm_ = st.negM; asm volatile("" : "+v"(nm_));
    f32x4 S[NQT][4]; const f32x4 sinit = (f32x4){nm_, nm_, nm_, nm_};
#pragma unroll
    for (int kt = 0; kt < 4; ++kt) {
        const bf16x8 k0 = *(const LAS bf16x8*)(Ks + (16 * kt + l15) * KROW + quad * 16), k1 = *(const LAS bf16x8*)(Ks + (16 * kt + l15) * KROW + 64 + quad * 16);
#pragma unroll
        for (int q = 0; q < NQT; ++q) if (act[q]) { S[q][kt] = MFMA16(k0, Q[q][0], sinit); S[q][kt] = MFMA16(k1, Q[q][1], S[q][kt]); }
    }
    const unsigned vaddr = (unsigned)(size_t)(Vs + (4 * quad + (l15 >> 2)) * KROW + 8 * (l15 & 3));
    VFrag v0, v1; vt_issue(v0, vaddr);
#pragma unroll
    for (int q = 0; q < NQT; ++q) if (act[q]) {
        float rs = 0.f;
#pragma unroll
        for (int kt = 0; kt < 4; ++kt)
#pragma unroll
            for (int j = 0; j < 4; ++j) { float p = fexp2(S[q][kt][j]); if (MASKED) p = allowed(q, 16 * kt + 4 * quad + j) ? p : 0.f; S[q][kt][j] = p; rs += p; }
        st.l[q] += rs;
    }
    vt_wait(v0); vt_issue(v1, vaddr + 32 * KROW);
#pragma unroll
    for (int q = 0; q < NQT; ++q) if (act[q]) {
        const bf16x8 p0 = pack8(S[q][0], S[q][1]);
#pragma unroll
        for (int d = 0; d < 4; ++d) st.O[q][d] = MFMA16(vt_get(v0, d), p0, st.O[q][d]);
    }
    vt_wait(v1);
#pragma unroll
    for (int q = 0; q < NQT; ++q) if (act[q]) {
        const bf16x8 p1 = pack8(S[q][2], S[q][3]);
#pragma unroll
        for (int d = 0; d < 4; ++d) st.O[q][d] = MFMA16(vt_get(v1, d), p1, st.O[q][d]);
    }
}
template <int NQT> DI void fa_finish(FA<NQT>& st, float (&lse2)[NQT]) {
#pragma unroll
    for (int q = 0; q < NQT; ++q) { float l = st.l[q]; l += __shfl_xor(l, 16); l += __shfl_xor(l, 32); const float inv = l > 0.f ? 1.f / l : 0.f; lse2[q] = __log2f(fmaxf(l, 1e-37f));
#pragma unroll
        for (int d = 0; d < 4; ++d) st.O[q][d] = st.O[q][d] * inv; }
}
DI float score_bound(const float* gq, const float* gk, int lane) {
    float a = fabsf(gq[lane & 63]), b = fabsf(gk[lane & 63]);
#pragma unroll
    for (int o = 1; o < 64; o <<= 1) { a = fmaxf(a, __shfl_xor(a, o)); b = fmaxf(b, __shfl_xor(b, o)); }
    return __builtin_bit_cast(float, __builtin_amdgcn_readfirstlane(__builtin_bit_cast(int, 64.f * a * b * QSCALE * 1.02f + 0.5f)));
}
DI void kv_store(LAS uchar* Ks, LAS uchar* Vs, int tid, const u32x4& kr, const u32x4& vr) {
    const int o = (tid >> 3) * KROW + (tid & 7) * 16; *(LAS u32x4*)(Ks + o) = kr; *(LAS u32x4*)(Vs + o) = vr;
}
DI void q_load(bf16x8 (&Q)[2], const bf16* qrow, int quad) { Q[0] = *(const bf16x8*)(qrow + 8 * quad); Q[1] = *(const bf16x8*)(qrow + 32 + 8 * quad); }

struct DilMask { int qi[2]; int k0; DI bool operator()(int q, int key) const { const int ki = k0 + key, d = qi[q] - ki; return ki >= 0 && (unsigned)d <= 128u; } };
DI void dil_unit(const Ctx& C, int unit, LAS uchar* lds0, LAS uchar*  , float negM_bound) {
    const bf16 *QC = WSP(bf16, R_QC), *KC = WSP(bf16, R_KC), *PROJ = WSP(bf16, R_PROJ); float* OC = WSP(float, R_OC); float* LSE = WSP(float, R_LSE);
    int tid = C.tid, lane = C.lane; asm volatile("" : "+v"(tid), "+v"(lane));
    const int w = C.wave, l15 = lane & 15, quad = lane >> 4, wq = w & 3;
    const int cfg = unit / 512, r = unit % 512, dsh = 2 * cfg, d = 1 << dsh;
    const int b = r >> 6, hp = (r >> 5) & 1, r2 = r & 31;
    const int nblk = 32 >> dsh, res = r2 / nblk, blk = r2 % nblk, i0 = blk * 128, h = 2 * hp + (w >> 2);
    const size_t tb = (size_t)b * NS;
    bf16x8 Q[2][2]; DilMask mk; FA<2> st; fa_init(st); st.negM = -negM_bound;
#pragma unroll
    for (int q = 0; q < 2; ++q) { mk.qi[q] = i0 + 32 * wq + 16 * q + l15; q_load(Q[q], QC + (tb + res + (size_t)d * mk.qi[q]) * 256 + h * 64, quad); }
    const int jlo = wq >> 1, jhi = (wq >> 1) + 2;
    const bool act[2] = {true, true};
    u32x4 kr0, vr0, kr1, vr1;
#define DIL_LOAD(j) do { const int ki = i0 - 128 + 64 * (j) + (tid >> 3); kr0 = (u32x4){0u, 0u, 0u, 0u}; vr0 = kr0; kr1 = kr0; vr1 = kr0; \
    if (ki >= 0) { const size_t rowk = tb + res + (size_t)d * ki; const bf16* kp = KC + rowk * 256 + 128 * hp + (tid & 7) * 8; const bf16* vp = PROJ + rowk * NPJ + PJ_C + 512 + 128 * hp + (tid & 7) * 8; \
        kr0 = *(const u32x4*)kp; kr1 = *(const u32x4*)(kp + 64); vr0 = *(const u32x4*)vp; vr1 = *(const u32x4*)(vp + 64); } } while (0)
#define DIL_STORE(p) do { LAS uchar* b_ = lds0 + (p) * 4 * KT_BYTES; kv_store(b_, b_ + KT_BYTES, tid, kr0, vr0); kv_store(b_ + 2 * KT_BYTES, b_ + 3 * KT_BYTES, tid, kr1, vr1); } while (0)
    DIL_LOAD(0); __syncthreads(); DIL_STORE(0); DIL_LOAD(1);
    for (int j = 0; j < 4; ++j) {
        __syncthreads();
        if (j + 1 < 4) DIL_STORE((j + 1) & 1);
        if (j + 2 < 4) DIL_LOAD(j + 2);
        if (j >= jlo && j <= jhi) { mk.k0 = i0 - 128 + 64 * j; const LAS uchar* kb = lds0 + (j & 1) * 4 * KT_BYTES + (w >> 2) * 2 * KT_BYTES; fa_tile<2, true>(st, Q, kb, kb + KT_BYTES, lane, mk, act); }
    }
#undef DIL_LOAD
#undef DIL_STORE
    float lse2[2]; fa_finish<2>(st, lse2);
#pragma unroll
    for (int q = 0; q < 2; ++q) { const size_t rowq = tb + res + (size_t)d * mk.qi[q]; bf16* o = (bf16*)OC + ((size_t)cfg * NT + rowq) * 256 + h * 64 + 4 * quad;
#pragma unroll
        for (int dt = 0; dt < 4; ++dt) { u32x2 w_; w_.x = pk2(st.O[q][dt][0], st.O[q][dt][1]); w_.y = pk2(st.O[q][dt][2], st.O[q][dt][3]); *(u32x2*)(o + 16 * dt) = w_; }
        if (quad == 0) LSE[((size_t)cfg * NT + rowq) * 4 + h] = lse2[q]; }
}
constexpr int NSA_KC = 0, NSA_VC = 256 * KROW, NSA_KT = 2 * 256 * KROW, NSA_VT = NSA_KT + KT_BYTES, NSA_IMP = NSA_KT + 4 * KT_BYTES,
    NSA_SELM = NSA_IMP + 64 * 64 * 4, NSA_UW = NSA_SELM + 512;
static_assert(NSA_UW + 16 <= RING_BYTES, "NSA LDS map");
DI void cmp_mlp_wait(const Ctx& C, int l);
struct SwaMask { int t[2]; int k0; DI bool operator()(int q, int key) const { const int d = t[q] - (k0 + key); return (unsigned)d <= 511u; } };
struct SlcMask { int t[2]; int k0; bool sel[2]; DI bool operator()(int q, int key) const { return sel[q] && (k0 + key <= t[q]); } };
struct NoMask { DI bool operator()(int, int) const { return true; } };
DI void nsa_unit(const Ctx& C, int l, int b, int tbk, int& bl, bool& cmp_ready, float bnd_cmp, float bnd_slc, float bnd_swa) {
    const bf16 *QN = WSP(bf16, R_QN), *QR = WSP(bf16, R_QR), *KSb = WSP(bf16, R_KS), *KWb = WSP(bf16, R_KW), *PROJ = WSP(bf16, R_PROJ); const float* CMP = WSP(float, R_CMP); const float* GATE = WSP(float, R_GATE);
    bf16* YCAT = WSP(bf16, R_YCAT);
    LAS uchar* Kc = C.lds + NSA_KC; LAS uchar* Vc = C.lds + NSA_VC; LAS uchar* Ks = C.lds + NSA_KT; LAS uchar* Vs = C.lds + NSA_VT;
    LAS float* imps = (LAS float*)(C.lds + NSA_IMP); LAS unsigned* selm = (LAS unsigned*)(C.lds + NSA_SELM); LAS unsigned* uw = (LAS unsigned*)(C.lds + NSA_UW);
    int tid = C.tid, lane = C.lane; asm volatile("" : "+v"(tid), "+v"(lane));
    const int w = C.wave, l15 = lane & 15, quad = lane >> 4, head = l15 & 3, t0 = 64 * tbk; const size_t tb = (size_t)b * NS;
    __syncthreads();
    if (b != bl) {
        if (!cmp_ready) { cmp_mlp_wait(C, l); cmp_ready = true; }
        const int key = tid >> 1, hf = tid & 1; const float* kp = CMP + ((size_t)b * 256 + key) * 64 + 32 * hf; const float* vp = CMP + ((size_t)2048 + (size_t)b * 256 + key) * 64 + 32 * hf;
        float kv[32], vv[32]; float ss = 0.f;
#pragma unroll
        for (int i = 0; i < 8; ++i) { const f32x4 a = *(const f32x4*)(kp + 4 * i), c = *(const f32x4*)(vp + 4 * i);
#pragma unroll
            for (int j = 0; j < 4; ++j) { kv[4 * i + j] = a[j]; vv[4 * i + j] = c[j]; ss += a[j] * a[j]; } }
        ss += __shfl_xor(ss, 1); const float rstd = rsqrtf(ss * (1.f / 64.f) + 1e-6f); const float* g = C.nsa_kc_g + (size_t)l * 64 + 32 * hf; const bool dead = (key == 255);
#pragma unroll
        for (int i = 0; i < 4; ++i) { u32x4 o, p;
            o.x = pk2(kv[8 * i] * rstd * g[8 * i], kv[8 * i + 1] * rstd * g[8 * i + 1]); o.y = pk2(kv[8 * i + 2] * rstd * g[8 * i + 2], kv[8 * i + 3] * rstd * g[8 * i + 3]);
            o.z = pk2(kv[8 * i + 4] * rstd * g[8 * i + 4], kv[8 * i + 5] * rstd * g[8 * i + 5]); o.w = pk2(kv[8 * i + 6] * rstd * g[8 * i + 6], kv[8 * i + 7] * rstd * g[8 * i + 7]);
            p.x = pk2(vv[8 * i], vv[8 * i + 1]); p.y = pk2(vv[8 * i + 2], vv[8 * i + 3]); p.z = pk2(vv[8 * i + 4], vv[8 * i + 5]); p.w = pk2(vv[8 * i + 6], vv[8 * i + 7]);
            if (dead) { o = (u32x4){0u, 0u, 0u, 0u}; p = o; }
            *(LAS u32x4*)(Kc + key * KROW + hf * 64 + i * 16) = o; *(LAS u32x4*)(Vc + key * KROW + hf * 64 + i * 16) = p; }
        bl = b;
        __syncthreads();
    }
    f32x4 Oc[2][4];
    const int cmaxu = (t0 + 32) >> 4, ktmax = cmaxu >> 4;
    const unsigned vaddr0 = (unsigned)(size_t)(Vc + (4 * quad + (l15 >> 2)) * KROW + 8 * (l15 & 3));
#pragma unroll
    for (int q = 0; q < 2; ++q) {
        const int t = t0 + 8 * w + 4 * q + (l15 >> 2);
        bf16x8 Q[2]; q_load(Q, QN + (tb + t) * 256 + head * 64, quad);
        float nm_ = -bnd_cmp; asm volatile("" : "+v"(nm_)); f32x4 S[16]; const f32x4 sinit = (f32x4){nm_, nm_, nm_, nm_}; float ls = 0.f;
#pragma unroll
        for (int kt = 0; kt < 16; ++kt) {
            if (kt <= ktmax) {
                const bf16x8 k0 = *(const LAS bf16x8*)(Kc + (16 * kt + l15) * KROW + quad * 16), k1 = *(const LAS bf16x8*)(Kc + (16 * kt + l15) * KROW + 64 + quad * 16);
                S[kt] = MFMA16(k0, Q[0], sinit); S[kt] = MFMA16(k1, Q[1], S[kt]);
#pragma unroll
                for (int j = 0; j < 4; ++j) { const int c = 16 * kt + 4 * quad + j; const float p = (16 * c + 31 <= t) ? fexp2(S[kt][j]) : 0.f; S[kt][j] = p; ls += p; }
            } else S[kt] = (f32x4){0.f, 0.f, 0.f, 0.f};
        }
        ls += __shfl_xor(ls, 16); ls += __shfl_xor(ls, 32);
        const float inv = ls > 0.f ? 1.f / ls : 0.f;
#pragma unroll
        for (int kt = 0; kt < 16; ++kt) S[kt] = S[kt] * inv;
#pragma unroll
        for (int kt = 0; kt < 16; ++kt) {
            const float send = (quad == 3) ? (kt > 0 ? S[kt > 0 ? kt - 1 : 0][3] : 0.f) : S[kt][3];
            const float prev = __shfl(send, (lane + 48) & 63);
            float v = ((quad == 0 && kt == 0) ? 0.f : prev) + 2.f * (S[kt][0] + S[kt][1] + S[kt][2]) + S[kt][3];
            v = group_sum<4>(v);
            if (head == 0) imps[(8 * w + 4 * q + (l15 >> 2)) * 64 + 4 * kt + quad] = v;
        }
#pragma unroll
        for (int d = 0; d < 4; ++d) Oc[q][d] = (f32x4){0.f, 0.f, 0.f, 0.f};
#pragma unroll
        for (int ks = 0; ks < 8; ++ks) {
            if (2 * ks <= ktmax) {
                VFrag vf; vt_issue(vf, vaddr0 + ks * 32 * KROW); const bf16x8 pf = pack8(S[2 * ks], S[2 * ks + 1]); vt_wait(vf);
#pragma unroll
                for (int d = 0; d < 4; ++d) Oc[q][d] = MFMA16(vt_get(vf, d), pf, Oc[q][d]);
            }
        }
    }
    {
        bf16* OCm = WSP(bf16, R_OCMP);
#pragma unroll
        for (int q = 0; q < 2; ++q) { bf16* o = OCm + (tb + t0 + 8 * w + 4 * q + (l15 >> 2)) * 256 + head * 64 + 4 * quad;
#pragma unroll
            for (int d = 0; d < 4; ++d) { u32x2 w_; w_.x = pk2(Oc[q][d][0], Oc[q][d][1]); w_.y = pk2(Oc[q][d][2], Oc[q][d][3]); *(u32x2*)(o + 16 * d) = w_; } }
    }
    __syncthreads();
    if (tid < 64) {
        const int cur = tbk; unsigned long long mask;
        if (cur <= 15) mask = (2ull << cur) - 1ull;
        else {
            mask = 1ull | (1ull << cur) | (1ull << (cur - 1));
            float v[64];
#pragma unroll
            for (int i = 0; i < 16; ++i) { const f32x4 a = *(const LAS f32x4*)(imps + tid * 64 + 4 * i);
#pragma unroll
                for (int j = 0; j < 4; ++j) { const int jb = 4 * i + j; v[jb] = (jb >= 1 && jb <= cur - 2) ? a[j] : -1.f; } }
#pragma unroll 1
            for (int r = 0; r < 13; ++r) {
                float bv = -0.5f; int bi = 0;
#pragma unroll
                for (int jb = 0; jb < 64; ++jb) if (v[jb] > bv) { bv = v[jb]; bi = jb; }
                mask |= 1ull << bi;
#pragma unroll
                for (int jb = 0; jb < 64; ++jb) v[jb] = (jb == bi) ? -1.f : v[jb];
            }
        }
        unsigned lo = (unsigned)mask, hi = (unsigned)(mask >> 32);
        selm[2 * tid] = lo; selm[2 * tid + 1] = hi;
#pragma unroll
        for (int o = 1; o < 64; o <<= 1) { lo |= __shfl_xor(lo, o); hi |= __shfl_xor(hi, o); }
        if (tid == 0) { uw[0] = lo; uw[1] = hi; }
    }
    __syncthreads();
    unsigned long long U = ((unsigned long long)uw[1] << 32) | uw[0];
    bf16x8 Q[2][2]; SlcMask mk; FA<2> st; fa_init(st); st.negM = -bnd_slc; unsigned long long msk[2];
#pragma unroll
    for (int q = 0; q < 2; ++q) { const int tl = 8 * w + 4 * q + (l15 >> 2); mk.t[q] = t0 + tl; msk[q] = ((unsigned long long)selm[2 * tl + 1] << 32) | selm[2 * tl]; q_load(Q[q], QR + (tb + mk.t[q]) * 256 + head * 64, quad); }
    unsigned long long QM[2];
#pragma unroll
    for (int q = 0; q < 2; ++q) { unsigned lo = (unsigned)msk[q], hi = (unsigned)(msk[q] >> 32);
#pragma unroll
        for (int o = 1; o < 64; o <<= 1) { lo |= __shfl_xor(lo, o); hi |= __shfl_xor(hi, o); }
        QM[q] = ((unsigned long long)hi << 32) | lo; }
#ifndef PROBE_SLC2
#define PROBE_SLC2 0
#endif
#ifndef PROBE_SWA2
#define PROBE_SWA2 0
#endif
    u32x4 kr, vr; const unsigned long long U0 = U;
    for (int prep_ = 0; prep_ <= PROBE_SLC2; ++prep_) { U = U0; if (prep_ < PROBE_SLC2) { fa_init(st); }
#define SLC_LOAD(j) do { const size_t rowk = tb + 64 * (j) + (tid >> 3); kr = *(const u32x4*)(KSb + rowk * 64 + (tid & 7) * 8); vr = *(const u32x4*)(PROJ + rowk * NPJ + 3008 + (tid & 7) * 8); } while (0)
    {
        int j = __builtin_ctzll(U); U &= U - 1ull;
        int jn = U ? __builtin_ctzll(U) : -1; U &= U - 1ull;
        SLC_LOAD(j); __syncthreads(); kv_store(Ks, Vs, tid, kr, vr); if (jn >= 0) SLC_LOAD(jn);
        for (int it = 0;; ++it) {
            __syncthreads();
            const int jnn = U ? __builtin_ctzll(U) : -1; U &= U - 1ull;
            if (jn >= 0) kv_store(Ks + ((it + 1) & 1) * 2 * KT_BYTES, Vs + ((it + 1) & 1) * 2 * KT_BYTES, tid, kr, vr);
            if (jnn >= 0) SLC_LOAD(jnn);
            const bool act[2] = {(bool)((QM[0] >> j) & 1ull), (bool)((QM[1] >> j) & 1ull)};
            if (act[0] || act[1]) { mk.k0 = 64 * j; mk.sel[0] = (msk[0] >> j) & 1ull; mk.sel[1] = (msk[1] >> j) & 1ull; fa_tile<2, true>(st, Q, Ks + (it & 1) * 2 * KT_BYTES, Vs + (it & 1) * 2 * KT_BYTES, lane, mk, act); }
            if (jn < 0) break; j = jn; jn = jnn;
        }
    }
#undef SLC_LOAD
    }
    float lse2[2]; fa_finish<2>(st, lse2);
    {   bf16* OSl = WSP(bf16, R_OSLC);
#pragma unroll
        for (int q = 0; q < 2; ++q) { bf16* o = OSl + (tb + mk.t[q]) * 256 + head * 64 + 4 * quad;
#pragma unroll
            for (int d = 0; d < 4; ++d) { u32x2 w_; w_.x = pk2(st.O[q][d][0], st.O[q][d][1]); w_.y = pk2(st.O[q][d][2], st.O[q][d][3]); *(u32x2*)(o + 16 * d) = w_; } }
    }
    FA<2> sw; fa_init(sw); sw.negM = -bnd_swa; SwaMask mw; mw.t[0] = mk.t[0]; mw.t[1] = mk.t[1];
    for (int prep_ = 0; prep_ <= PROBE_SWA2; ++prep_) { if (prep_ < PROBE_SWA2) fa_init(sw);
    {
        const int j0 = tbk >= 8 ? tbk - 8 : 0; const bool act[2] = {true, true};
#define SWA_LOAD(j) do { const size_t rowk = tb + 64 * (j) + (tid >> 3); kr = *(const u32x4*)(KWb + rowk * 64 + (tid & 7) * 8); vr = *(const u32x4*)(PROJ + rowk * NPJ + 3136 + (tid & 7) * 8); } while (0)
        SWA_LOAD(j0); __syncthreads(); kv_store(Ks, Vs, tid, kr, vr); if (j0 + 1 <= tbk) SWA_LOAD(j0 + 1);
        for (int j = j0; j <= tbk; ++j) {
            const int pb_ = (j - j0) & 1;
            __syncthreads();
            if (j + 1 <= tbk) kv_store(Ks + (pb_ ^ 1) * 2 * KT_BYTES, Vs + (pb_ ^ 1) * 2 * KT_BYTES, tid, kr, vr);
            if (j + 2 <= tbk) SWA_LOAD(j + 2);
            mw.k0 = 64 * j;
            if (j == tbk || j == tbk - 8) fa_tile<2, true>(sw, Q, Ks + pb_ * 2 * KT_BYTES, Vs + pb_ * 2 * KT_BYTES, lane, mw, act);
            else fa_tile<2, false>(sw, Q, Ks + pb_ * 2 * KT_BYTES, Vs + pb_ * 2 * KT_BYTES, lane, NoMask(), act);
        }
#undef SWA_LOAD
    }
    }
    fa_finish<2>(sw, lse2);
#pragma unroll
    for (int q = 0; q < 2; ++q) {
        const size_t row = tb + mk.t[q]; const float* gp = GATE + row * 12 + head * 3; const float g0 = gp[0], g1 = gp[1], g2 = gp[2];
        f32x4 o[4]; float ss = 0.f; const bf16* pc = WSP(bf16, R_OCMP) + row * 256 + head * 64 + 4 * quad; const bf16* ps = WSP(bf16, R_OSLC) + row * 256 + head * 64 + 4 * quad;
#pragma unroll
        for (int d = 0; d < 4; ++d) { const u32x2 c_ = *(const u32x2*)(pc + 16 * d), s_ = *(const u32x2*)(ps + 16 * d);
            o[d] = (f32x4){bflo(c_.x), bfhi(c_.x), bflo(c_.y), bfhi(c_.y)} * g0 + (f32x4){bflo(s_.x), bfhi(s_.x), bflo(s_.y), bfhi(s_.y)} * g1 + sw.O[q][d] * g2; ss += (o[d][0] * o[d][0] + o[d][1] * o[d][1]) + (o[d][2] * o[d][2] + o[d][3] * o[d][3]); }
        ss += __shfl_xor(ss, 16); ss += __shfl_xor(ss, 32);
        const float rstd = rsqrtf(ss * (1.f / 64.f) + 1e-6f); const float* og = C.onorm_g + (size_t)l * 768 + 512 + head * 64 + 4 * quad;
        bf16* yo = YCAT + row * DM + 768 + head * 64 + 4 * quad;
#pragma unroll
        for (int d = 0; d < 4; ++d) { const f32x4 g4 = *(const f32x4*)(og + 16 * d); u32x2 wv; wv.x = pk2(o[d][0] * rstd * g4[0], o[d][1] * rstd * g4[1]); wv.y = pk2(o[d][2] * rstd * g4[2], o[d][3] * rstd * g4[3]); *(u32x2*)(yo + 16 * d) = wv; }
    }
}

DI void fin_phase(const Ctx& C, int l) {
    const bf16* SCH = WSP(bf16, R_SCH); const float* YA = WSP(float, R_YA); const bf16* Gb = WSP(bf16, R_G); const float* OC = WSP(float, R_OC); const float* LSE = WSP(float, R_LSE);
    const float* UB = WSP(float, R_SCANU); const float* SMT = WSP(float, R_SCANS); bf16* YCAT = WSP(bf16, R_YCAT);
    const int lane = C.lane, ch = 4 * lane, hh = lane >> 4;
    LAS float* sm = (LAS float*)C.lds;
    LAS float* us = sm + 4 * 4096 + C.wave * 512;
    const f32x4 rk = *(const f32x4*)(C.rk + (size_t)l * 256 + ch), gw4 = *(const f32x4*)(C.gn_w + (size_t)l * 256 + ch), gb4 = *(const f32x4*)(C.gn_b + (size_t)l * 256 + ch);
    const f32x4 og = *(const f32x4*)(C.onorm_g + (size_t)l * 768 + 256 + ch);
    int bl = -1;
    for (int it = C.bid; it < NT / 128; it += C.G) {
        const int b = it >> 5, kk = it & 31;
        if (b != bl) { __syncthreads(); for (int i = C.tid; i < 4096; i += NTHR) *(LAS f32x4*)(sm + 4 * i) = *(const f32x4*)(SMT + (size_t)b * 4 * 4096 + 4 * i); bl = b; __syncthreads(); }
#pragma unroll 4
        for (int r = 0; r < 16; ++r) {
            const int row = b * NS + (r >> 3) * (NS / 2) + 64 * kk + C.wave * 8 + (r & 7); const size_t o = (size_t)row * 256 + ch;
            const float l0 = LSE[(size_t)row * 4 + hh], l1 = LSE[((size_t)NT + row) * 4 + hh], l2 = LSE[((size_t)2 * NT + row) * 4 + hh];
            const bf16* ocb = (const bf16*)OC; const u32x2 a_ = *(const u32x2*)(ocb + o), b_ = *(const u32x2*)(ocb + (size_t)NT * 256 + o), c_ = *(const u32x2*)(ocb + (size_t)2 * NT * 256 + o);
            const f32x4 a = (f32x4){bflo(a_.x), bfhi(a_.x), bflo(a_.y), bfhi(a_.y)}, bq = (f32x4){bflo(b_.x), bfhi(b_.x), bflo(b_.y), bfhi(b_.y)}, c = (f32x4){bflo(c_.x), bfhi(c_.x), bflo(c_.y), bfhi(c_.y)};
            const float mx = fmaxf(l0, fmaxf(l1, l2)); float w0 = fexp2(l0 - mx), w1 = fexp2(l1 - mx), w2 = fexp2(l2 - mx); const float inv = __builtin_amdgcn_rcpf(w0 + w1 + w2); w0 *= inv; w1 *= inv; w2 *= inv;
            const f32x4 y = a * w0 + bq * w1 + c * w2;
            const float ss = group_sum<16>((y[0] * y[0] + y[1] * y[1]) + (y[2] * y[2] + y[3] * y[3])); const float rstd = rsqrtf(ss * (1.f / 64.f) + 1e-6f);
            u32x2 w; w.x = pk2(y[0] * rstd * og[0], y[1] * rstd * og[1]); w.y = pk2(y[2] * rstd * og[2], y[3] * rstd * og[3]); *(u32x2*)(YCAT + (size_t)row * DM + 512 + ch) = w;
        }
#pragma unroll 1
        for (int hf = 0; hf < 2; ++hf) {
#pragma unroll 2
            for (int r = 0; r < 8; ++r) {
                const int row = b * NS + hf * (NS / 2) + 64 * kk + C.wave * 8 + r, s = row % NS; const size_t o = (size_t)row * 256 + ch;
                f32x4 y = *(const f32x4*)(YA + o); const u32x2 rr_ = *(const u32x2*)(SCH + (size_t)3 * NT * 256 + o), k_ = *(const u32x2*)(SCH + o), v_ = *(const u32x2*)(SCH + (size_t)4 * NT * 256 + o), g_ = *(const u32x2*)(Gb + o);
                const f32x4 rr = (f32x4){bflo(rr_.x), bfhi(rr_.x), bflo(rr_.y), bfhi(rr_.y)}, k = (f32x4){bflo(k_.x), bfhi(k_.x), bflo(k_.y), bfhi(k_.y)}, v = (f32x4){bflo(v_.x), bfhi(v_.x), bflo(v_.y), bfhi(v_.y)}, g = (f32x4){bflo(g_.x), bfhi(g_.x), bflo(g_.y), bfhi(g_.y)};
                if (hf == 1) {
                    LAS float* ub = us + (r & 1) * 256;
                    *(LAS f32x4*)(ub + ch) = *(const f32x4*)(UB + ((size_t)b * (NS / 2) + (s - NS / 2)) * 256 + ch);
                    asm volatile("s_waitcnt lgkmcnt(0)" ::: "memory");
                    const LAS float* sp = sm + hh * 4096 + 4 * (lane & 15); const LAS float* up = ub + hh * 64;
#pragma unroll 8
                    for (int j4 = 0; j4 < 16; ++j4) { const f32x4 u4 = *(const LAS f32x4*)(up + 4 * j4);
#pragma unroll
                        for (int jj = 0; jj < 4; ++jj) y += *(const LAS f32x4*)(sp + (4 * j4 + jj) * 64) * u4[jj]; }
                }
                const float mu = group_sum<16>((y[0] + y[1]) + (y[2] + y[3])) * (1.f / 64.f);
                const f32x4 dy = y - mu; const float var = group_sum<16>((dy[0] * dy[0] + dy[1] * dy[1]) + (dy[2] * dy[2] + dy[3] * dy[3])) * (1.f / 64.f);
                const float rstd = rsqrtf(var + 64e-5f);
                const float dot = group_sum<16>((rr[0] * k[0] * rk[0] + rr[1] * k[1] * rk[1]) + (rr[2] * k[2] * rk[2] + rr[3] * k[3] * rk[3]));
                float out[4];
#pragma unroll
                for (int i = 0; i < 4; ++i) out[i] = ((dy[i] * rstd * gw4[i] + gb4[i]) + dot * v[i]) * g[i];
                u32x2 w; w.x = pk2(out[0], out[1]); w.y = pk2(out[2], out[3]); *(u32x2*)(YCAT + (size_t)row * DM + ch) = w;
            }
        }
    }
    __syncthreads();
}

constexpr int CW_Q = 40000;
DI int q_next(const Ctx& C, unsigned* ctr, LAS int* slot) {
    __syncthreads();
    if (C.tid == 0) *slot = (int)__hip_atomic_fetch_add(ctr, 1u, __ATOMIC_RELAXED, __HIP_MEMORY_SCOPE_AGENT);
    __syncthreads();
    return *slot;
}
DI void conv_ticket(const Ctx& C, int l, int tk);
constexpr int CW_CD = 41000;
DI void cmp_mlp_unit(const Ctx& C, int l, int cb) {
    const int kv = cb >> 3;
    { pg8::Gemm g{kv ? WSP(bf16, R_VCR) : WSP(bf16, R_KCR), WSP(bf16, WS_WK1) + (size_t)(l * 2 + kv) * 256 * 2048, 1024, 2048}; pg8::StaticOrder S; S.init(8, 1, 8, cb & 7);
      EpiC1 E{WSP(bf16, R_CH1) + (size_t)kv * 2048 * 256, (WSP(float, WS_SMALL) + NLAYER * 8 * 6144 + l * 512 + kv * 256)}; pg8::gemm_phase(C.lds, C.tid, g, S, E); }
    asm volatile("s_waitcnt vmcnt(0)" ::: "memory"); __syncthreads();
    { pg8::Gemm g{WSP(bf16, R_CH1) + (size_t)kv * 2048 * 256, WSP(bf16, WS_WK2) + (size_t)(l * 2 + kv) * 256 * 256, 256, 256}; pg8::StaticOrder S; S.init(8, 1, 8, cb & 7);
      EpiC2 E{WSP(float, R_CMP) + (size_t)kv * 2048 * 64}; pg8::gemm_phase(C.lds, C.tid, g, S, E); }
    asm volatile("s_waitcnt vmcnt(0)" ::: "memory"); __syncthreads();
    if (C.tid == 0) { __builtin_amdgcn_fence(__ATOMIC_RELEASE, "agent"); asm volatile("s_waitcnt vmcnt(0)" ::: "memory");
        __hip_atomic_fetch_add(WSP(unsigned, WS_CTL) + CW_CD + 64 * l, 1u, __ATOMIC_RELAXED, __HIP_MEMORY_SCOPE_AGENT); }
}
DI void cmp_mlp_wait(const Ctx& C, int l) {
    if (C.tid == 0) { unsigned* c = WSP(unsigned, WS_CTL) + CW_CD + 64 * l; unsigned sp = 0u;
        while (__hip_atomic_load(c, __ATOMIC_RELAXED, __HIP_MEMORY_SCOPE_AGENT) < 16u) { __builtin_amdgcn_s_sleep(8); if (++sp > (1u << 21)) break; }
        __builtin_amdgcn_fence(__ATOMIC_ACQUIRE, "agent"); asm volatile("s_waitcnt vmcnt(0)" ::: "memory"); }
    __syncthreads();
}
DI void mix_phase(const Ctx& C, int l, int rep) {
    unsigned* ctl = WSP(unsigned, WS_CTL) + CW_Q + 64 * 3 * (l + 2 * rep); LAS int* slot = (LAS int*)(C.lds + MISC_OFF + 1024);
#ifndef PROBE_SPLIT
#define PROBE_SPLIT 0
#endif
    if (C.bid < 96) { scan_unit8(C, C.bid); if (PROBE_SCAN2) scan_unit8(C, C.bid); }
    else if (C.bid < 112) cmp_mlp_unit(C, l, C.bid - 96);
    bool cmp_ready = false;
    if (PROBE_SPLIT) { asm volatile("s_waitcnt vmcnt(0)" ::: "memory"); __syncthreads(); { XcdBarrier bar2; bar2.bar = WSP(unsigned, WS_CTL) + CW_BAR; bar2.x = xb_xcc_id(); bar2.st = (volatile LAS unsigned*)(C.lds + MISC_OFF); xcd_barrier(bar2); } }
    int bl = -1;
    const float bnd_cmp = score_bound(C.nsa_q_g + (size_t)l * 64, C.nsa_kc_g + (size_t)l * 64, C.lane), bnd_slc = score_bound(C.nsa_q_g + (size_t)l * 64, C.nsa_ks_g + (size_t)l * 64, C.lane),
                bnd_swa = score_bound(C.nsa_q_g + (size_t)l * 64, C.nsa_kw_g + (size_t)l * 64, C.lane), bnd_dil = score_bound(C.dil_q_g + (size_t)l * 64, C.dil_k_g + (size_t)l * 64, C.lane);
    bool conv_left = true;
#define CONV_ONE() do { if (conv_left) { const int t_ = q_next(C, ctl + 128, slot); if (t_ >= 768 * (1 + PROBE_CONV2)) conv_left = false; else { conv_ticket(C, l, t_ % 768); bl = -1; } } } while (0)
    for (;;) { const int u = q_next(C, ctl, slot); if (u >= 512 * (1 + PROBE_ATT2)) break; nsa_unit(C, l, u & 7, 63 - ((u & 511) >> 3), bl, cmp_ready, bnd_cmp, bnd_slc, bnd_swa); CONV_ONE(); }
    for (int n = 0;; ++n) { const int u = q_next(C, ctl + 64, slot); if (u >= 1536 * (1 + PROBE_ATT2)) break; dil_unit(C, u % 1536, C.lds, C.lds + KT_BYTES, bnd_dil); if ((n & 3) == 3) CONV_ONE(); }
    while (conv_left) CONV_ONE();
#undef CONV_ONE if (C.bid >= 96)
    __syncthreads();
}
#define MFMA_F32(a, b, c) __builtin_amdgcn_mfma_f32_16x16x4f32((a), (b), (c), 0, 0, 0)
DI void router_phase(const Ctx& C, int l) {
    const bf16* X = WSP(bf16, WS_XB); const float* MOD = WSP(float, WS_SMALL) + (size_t)l * 8 * 6144; unsigned char* H8 = WSP(unsigned char, R_XS);
    int* TOPE = WSP(int, WS_ROUTE); float* TOPG = (float*)(TOPE + NT * 4); unsigned* CNTB = WSP(unsigned, WS_CTL) + CW_CNT + l * 8192;
    LAS float* wl = (LAS float*)C.lds;
    LAS float* lg = (LAS float*)(C.lds + MISC_OFF + 8192) + C.wave * 512;
    LAS unsigned* hist = (LAS unsigned*)(C.lds + MISC_OFF + 6144);
    LAS float* rs = (LAS float*)(C.lds + MISC_OFF + 6400) + C.wave * 16;
    const int lane = C.lane, l15 = lane & 15, quad = lane >> 4, gw = C.bid * NWAVE + C.wave, NGW = C.G * NWAVE;
    const float* wr = C.w_router + (size_t)l * 1024 * 32; const float* g2 = C.norm2_g + (size_t)l * DM;
    __syncthreads();
    if (C.tid < 32) hist[C.tid] = 0u;
    for (int i = C.tid; i < 8192; i += NTHR) { const int k = i >> 3, e4 = (i & 7) * 4; const f32x4 v = *(const f32x4*)(wr + (size_t)k * 32 + e4); LAS float* d = wl + ((k >> 2) * 32 + e4) * 4 + (k & 3);
        d[0] = v[0]; d[4] = v[1]; d[8] = v[2]; d[12] = v[3]; }
    __syncthreads();
    for (int task = gw; task < NT / 16; task += NGW) {
        const int row0 = 16 * task, b = row0 / NS;
        const float* shb = MOD + (size_t)b * 6144 + 3072; const float* scb = shb + 1024;
        {
            f32x4 gg[4], sb[4];
#pragma unroll
            for (int j = 0; j < 2; ++j)
#pragma unroll
                for (int hlf = 0; hlf < 2; ++hlf) { const int k = 8 * lane + 512 * j + 4 * hlf; gg[2 * j + hlf] = *(const f32x4*)(g2 + k) * (*(const f32x4*)(scb + k) + 1.f); sb[2 * j + hlf] = *(const f32x4*)(shb + k); }
#pragma unroll 4
            for (int r = 0; r < 16; ++r) {
                const bf16* xr = X + (size_t)(row0 + r) * DM + 8 * lane; f32x4 v[4]; float ss = 0.f;
#pragma unroll
                for (int j = 0; j < 2; ++j) { const u32x4 t = *(const u32x4*)(xr + 512 * j); v[2 * j] = (f32x4){bflo(t.x), bfhi(t.x), bflo(t.y), bfhi(t.y)}; v[2 * j + 1] = (f32x4){bflo(t.z), bfhi(t.z), bflo(t.w), bfhi(t.w)}; }
#pragma unroll
                for (int j = 0; j < 4; ++j) ss += (v[j][0] * v[j][0] + v[j][1] * v[j][1]) + (v[j][2] * v[j][2] + v[j][3] * v[j][3]);
                ss = group_sum<64>(ss); const float rstd = rsqrtf(ss * (1.f / DM) + 1e-6f);
                if (lane == 0) rs[r] = rstd;
                unsigned char* hp = H8 + (size_t)(row0 + r) * DM + 8 * lane;
#pragma unroll
                for (int j = 0; j < 2; ++j) { const f32x4 h0 = v[2 * j] * rstd * gg[2 * j] + sb[2 * j], h1 = v[2 * j + 1] * rstd * gg[2 * j + 1] + sb[2 * j + 1]; u32x2 o8; o8.x = pk4_fp8(h0[0], h0[1], h0[2], h0[3]); o8.y = pk4_fp8(h1[0], h1[1], h1[2], h1[3]); *(u32x2*)(hp + 512 * j) = o8; }
            }
        }
        const bf16* xr = X + (size_t)(row0 + l15) * DM + 4 * quad; const float* sh = shb + 4 * quad; const float* sc = scb + 4 * quad;
        asm volatile("s_waitcnt lgkmcnt(0)" ::: "memory");
        const float rstd = rs[l15];
        f32x4 acc0 = (f32x4){0.f, 0.f, 0.f, 0.f}, acc1 = acc0;
#pragma unroll 2
        for (int i = 0; i < 64; ++i) {
            const u32x2 ab = *(const u32x2*)(xr + 16 * i); const f32x4 a = (f32x4){bflo(ab.x), bfhi(ab.x), bflo(ab.y), bfhi(ab.y)}, g = *(const f32x4*)(g2 + 16 * i + 4 * quad), s1 = *(const f32x4*)(sc + 16 * i), s0 = *(const f32x4*)(sh + 16 * i);
            f32x4 h;
#pragma unroll
            for (int j = 0; j < 4; ++j) h[j] = a[j] * rstd * g[j] * (1.f + s1[j]) + s0[j];
            const LAS float* wp = wl + ((4 * i + quad) * 32 + l15) * 4; const f32x4 w0 = *(const LAS f32x4*)wp, w1 = *(const LAS f32x4*)(wp + 64);
#pragma unroll
            for (int j = 0; j < 4; ++j) { acc0 = MFMA_F32(h[j], w0[j], acc0); acc1 = MFMA_F32(h[j], w1[j], acc1); }
        }
        const float b0 = C.b_router[l * 32 + l15], b1 = C.b_router[l * 32 + 16 + l15];
#pragma unroll
        for (int j = 0; j < 4; ++j) { lg[(4 * quad + j) * 32 + l15] = acc0[j] + b0; lg[(4 * quad + j) * 32 + 16 + l15] = acc1[j] + b1; }
        asm volatile("s_waitcnt lgkmcnt(0)" ::: "memory");
        if (lane < 16) {
            float v[32];
#pragma unroll
            for (int i = 0; i < 8; ++i) { const f32x4 a = *(const LAS f32x4*)(lg + lane * 32 + 4 * i); v[4 * i] = a[0]; v[4 * i + 1] = a[1]; v[4 * i + 2] = a[2]; v[4 * i + 3] = a[3]; }
            float tv[4]; int ti[4];
#pragma unroll
            for (int r = 0; r < 4; ++r) { float bv = -3.0e38f; int bi = 0;
#pragma unroll
                for (int e = 0; e < 32; ++e) if (v[e] > bv) { bv = v[e]; bi = e; }
                tv[r] = bv; ti[r] = bi;
#pragma unroll
                for (int e = 0; e < 32; ++e) v[e] = (e == bi) ? -3.0e38f : v[e]; }
            const float e1 = __expf(tv[1] - tv[0]), e2 = __expf(tv[2] - tv[0]), e3 = __expf(tv[3] - tv[0]), inv = 1.f / (1.f + e1 + e2 + e3);
            const int row = row0 + lane;
            *(int4*)(TOPE + (size_t)row * 4) = make_int4(ti[0], ti[1], ti[2], ti[3]);
            *(f32x4*)(TOPG + (size_t)row * 4) = (f32x4){inv, e1 * inv, e2 * inv, e3 * inv};
#pragma unroll
            for (int r = 0; r < 4; ++r) __hip_atomic_fetch_add(&hist[ti[r]], 1u, __ATOMIC_RELAXED, __HIP_MEMORY_SCOPE_WORKGROUP);
        }
        asm volatile("s_waitcnt lgkmcnt(0)" ::: "memory");
    }
    __syncthreads();
    if (C.tid < 32) CNTB[C.bid * 32 + C.tid] = hist[C.tid];
}

DI void moe_tables(const Ctx& C, int l, LAS int* tab) {
    const unsigned* CNTB = WSP(unsigned, WS_CTL) + CW_CNT + l * 8192;
    LAS unsigned* part = (LAS unsigned*)(tab + 192);
    __syncthreads();
    { const int e = C.tid & 31, pt = C.tid >> 5; unsigned tot = 0u, mine = 0u;
        const int g0 = pt * ((C.G + 15) >> 4), g1 = min(C.G, g0 + ((C.G + 15) >> 4));
#pragma unroll 16
        for (int g = g0; g < g1; ++g) { const unsigned c = CNTB[g * 32 + e]; tot += c; mine += (g < C.bid) ? c : 0u; }
        part[(pt * 2) * 32 + e] = tot; part[(pt * 2 + 1) * 32 + e] = mine; }
    __syncthreads();
    if (C.tid < 32) { unsigned tot = 0u, mine = 0u;
#pragma unroll
        for (int pt = 0; pt < 16; ++pt) { tot += part[(pt * 2) * 32 + C.tid]; mine += part[(pt * 2 + 1) * 32 + C.tid]; }
        tab[128 + C.tid] = (int)((tot + 255u) >> 8); tab[64 + C.tid] = (int)mine; }
    __syncthreads();
    if (C.tid == 0) { int s = 0; for (int e = 0; e < 32; ++e) { tab[e] = s; s += tab[128 + e]; } tab[32] = s; }
    __syncthreads();
}
DI void scatter_phase(const Ctx& C, int l) {
    const int* TOPE = WSP(int, WS_ROUTE); int* POS = (int*)(TOPE + NT * 8); int* ROWMAP = (int*)(TOPE + NT * 12);
    LAS int* tab = (LAS int*)(C.lds + MISC_OFF + 64); LAS unsigned* cur = (LAS unsigned*)(C.lds + 16384);
    moe_tables(C, l, tab);
    if (C.tid < 32) cur[C.tid] = (unsigned)(tab[C.tid] * 256 + tab[64 + C.tid]);
    __syncthreads();
    const int lane = C.lane, gw = C.bid * NWAVE + C.wave, NGW = C.G * NWAVE;
    for (int task = gw; task < NT / 16; task += NGW) {
        const int row0 = 16 * task, tok = row0 + (lane >> 2);
        const int e = TOPE[(size_t)tok * 4 + (lane & 3)];
        const int slot = (int)__hip_atomic_fetch_add(&cur[e], 1u, __ATOMIC_RELAXED, __HIP_MEMORY_SCOPE_WORKGROUP);
        POS[(size_t)tok * 4 + (lane & 3)] = slot; ROWMAP[slot] = tok;
    }
}
DI void combine_phase(const Ctx& C, int l, float* dst, bf16* dstb) {
    const bf16* YB = WSP(bf16, R_YB); const int* TOPE = WSP(int, WS_ROUTE); const float* TOPG = (const float*)(TOPE + NT * 4); const int* POS = (const int*)(TOPE + NT * 8);
    const float* MOD = WSP(float, WS_SMALL) + (size_t)l * 8 * 6144; bf16* H = WSP(bf16, WS_H); const bf16* XB = WSP(bf16, WS_XB);
    const int lane = C.lane, gw = C.bid * NWAVE + C.wave, NGW = C.G * NWAVE;
    for (int task = gw; task < NT / 16; task += NGW) {
        const int row0 = 16 * task, b = row0 / NS; const float* gt = MOD + (size_t)b * 6144 + 5120 + 8 * lane;
        f32x4 g4[4], gg[4], sb[4];
#pragma unroll
        for (int j = 0; j < 2; ++j) { g4[2 * j] = *(const f32x4*)(gt + 512 * j); g4[2 * j + 1] = *(const f32x4*)(gt + 512 * j + 4); }
        if (l + 1 < NLAYER) { const float* M2 = MOD + 8 * 6144 + (size_t)b * 6144 + 8 * lane; const float* g = C.norm1_g + (size_t)(l + 1) * DM + 8 * lane;
#pragma unroll
            for (int j = 0; j < 2; ++j)
#pragma unroll
                for (int hlf = 0; hlf < 2; ++hlf) { const int o = 512 * j + 4 * hlf; gg[2 * j + hlf] = *(const f32x4*)(g + o) * (*(const f32x4*)(M2 + 1024 + o) + 1.f); sb[2 * j + hlf] = *(const f32x4*)(M2 + o); } }
#pragma unroll 2
        for (int r = 0; r < 16; ++r) {
            const int row = row0 + r; const int4 ps = *(const int4*)(POS + (size_t)row * 4); const f32x4 gk = *(const f32x4*)(TOPG + (size_t)row * 4);
            const int pp[4] = {ps.x, ps.y, ps.z, ps.w};
            const bf16* orow = XB + (size_t)row * DM + 8 * lane; float* drow = dst + (size_t)row * DM + 8 * lane; bf16* drowb = dstb + (size_t)row * DM + 8 * lane;
            u32x4 y[4][2]; f32x4 x[4];
#pragma unroll
            for (int q = 0; q < 4; ++q)
#pragma unroll
                for (int j = 0; j < 2; ++j) { if (YB_FP8) { const u32x2 t_ = *(const u32x2*)((const unsigned char*)YB + (size_t)pp[q] * DM + 8 * lane + 512 * j); y[q][j] = (u32x4){t_.x, t_.y, 0u, 0u}; } else y[q][j] = *(const u32x4*)(YB + (size_t)pp[q] * DM + 8 * lane + 512 * j); }
#pragma unroll
            for (int j = 0; j < 2; ++j) { const u32x4 t = *(const u32x4*)(orow + 512 * j); x[2 * j] = (f32x4){bflo(t.x), bfhi(t.x), bflo(t.y), bfhi(t.y)}; x[2 * j + 1] = (f32x4){bflo(t.z), bfhi(t.z), bflo(t.w), bfhi(t.w)}; }
            f32x4 v[4]; float s = 0.f;
#pragma unroll
            for (int j = 0; j < 2; ++j) { f32x4 a0 = (f32x4){0.f, 0.f, 0.f, 0.f}, a1 = a0;
#pragma unroll
                for (int q = 0; q < 4; ++q) { const u32x4 w = y[q][j];
                    if (YB_FP8) { const f32x2 p0 = __builtin_amdgcn_cvt_pk_f32_fp8(w.x, false), p1 = __builtin_amdgcn_cvt_pk_f32_fp8(w.x, true), p2 = __builtin_amdgcn_cvt_pk_f32_fp8(w.y, false), p3 = __builtin_amdgcn_cvt_pk_f32_fp8(w.y, true);
                        a0 += (f32x4){p0[0], p0[1], p1[0], p1[1]} * gk[q]; a1 += (f32x4){p2[0], p2[1], p3[0], p3[1]} * gk[q]; }
                    else { a0 += (f32x4){bflo(w.x), bfhi(w.x), bflo(w.y), bfhi(w.y)} * gk[q]; a1 += (f32x4){bflo(w.z), bfhi(w.z), bflo(w.w), bfhi(w.w)} * gk[q]; } }
                v[2 * j] = x[2 * j] + g4[2 * j] * a0; v[2 * j + 1] = x[2 * j + 1] + g4[2 * j + 1] * a1;
                if (l + 1 < NLAYER) { u32x4 o; o.x = pk2(v[2 * j][0], v[2 * j][1]); o.y = pk2(v[2 * j][2], v[2 * j][3]); o.z = pk2(v[2 * j + 1][0], v[2 * j + 1][1]); o.w = pk2(v[2 * j + 1][2], v[2 * j + 1][3]); *(u32x4*)(drowb + 512 * j) = o; }
                else { *(f32x4*)(drow + 512 * j) = v[2 * j]; *(f32x4*)(drow + 512 * j + 4) = v[2 * j + 1]; } }
#pragma unroll
            for (int i = 0; i < 4; ++i) s += (v[i][0] * v[i][0] + v[i][1] * v[i][1]) + (v[i][2] * v[i][2] + v[i][3] * v[i][3]);
            if (l + 1 < NLAYER) {
                s = group_sum<64>(s); const float rstd = rsqrtf(s * (1.f / DM) + 1e-6f); bf16* hrow = H + (size_t)row * DM + 8 * lane;
#pragma unroll
                for (int j = 0; j < 2; ++j) { const f32x4 h0 = v[2 * j] * rstd * gg[2 * j] + sb[2 * j], h1 = v[2 * j + 1] * rstd * gg[2 * j + 1] + sb[2 * j + 1]; u32x4 o;
                    if (INPROJ_FP8) { u32x2 o8; o8.x = pk4_fp8(h0[0], h0[1], h0[2], h0[3]); o8.y = pk4_fp8(h1[0], h1[1], h1[2], h1[3]); *(u32x2*)((unsigned char*)H + (size_t)row * DM + 8 * lane + 512 * j) = o8; }
                    else { o.x = pk2(h0[0], h0[1]); o.y = pk2(h0[2], h0[3]); o.z = pk2(h1[0], h1[1]); o.w = pk2(h1[2], h1[3]); *(u32x4*)(hrow + 512 * j) = o; } }
            }
        }
    }
}
constexpr int PH_PER_LAYER = 11, PH_BASE = 2, N_PHASES = PH_BASE + NLAYER * PH_PER_LAYER;
#ifndef MK_ONE_LAUNCH
#define MK_ONE_LAUNCH 1
#endif
__global__ void __launch_bounds__(NTHR, 2) mk_fwd(Args args) {
    extern __shared__ __attribute__((aligned(16))) unsigned char lds_raw[];
    Ctx C;
    C.lds = (LAS unsigned char*)lds_raw; C.tid = threadIdx.x; C.lane = C.tid & 63; C.wave = __builtin_amdgcn_readfirstlane(C.tid >> 6); C.G = gridDim.x; C.bid = blockIdx.x;
    C.x = (const float*)args.in[0]; C.c = (const float*)args.in[1]; C.pos = (const int*)args.in[2]; C.w_ada = (const float*)args.in[3]; C.b_ada = (const float*)args.in[4];
    C.norm1_g = (const float*)args.in[5]; C.norm2_g = (const float*)args.in[6]; C.w_in = (const float*)args.in[7]; C.w_out = (const float*)args.in[8]; C.mu = (const float*)args.in[9];
    C.w0 = (const float*)args.in[10]; C.w2 = (const float*)args.in[11]; C.a0 = (const float*)args.in[12]; C.a2 = (const float*)args.in[13]; C.g2 = (const float*)args.in[14];
    C.kkw = (const float*)args.in[15]; C.ka = (const float*)args.in[16]; C.rk = (const float*)args.in[17]; C.gn_w = (const float*)args.in[18]; C.gn_b = (const float*)args.in[19];
    C.conv_w = (const float*)args.in[20]; C.dil_q_g = (const float*)args.in[21]; C.dil_k_g = (const float*)args.in[22]; C.nsa_q_g = (const float*)args.in[23]; C.nsa_kc_g = (const float*)args.in[24];
    C.nsa_ks_g = (const float*)args.in[25]; C.nsa_kw_g = (const float*)args.in[26]; C.pe_k = (const float*)args.in[27]; C.pe_v = (const float*)args.in[28]; C.wk1 = (const float*)args.in[29];
    C.wk2 = (const float*)args.in[30]; C.wv1 = (const float*)args.in[31]; C.wv2 = (const float*)args.in[32]; C.onorm_g = (const float*)args.in[33]; C.w_router = (const float*)args.in[34];
    C.b_router = (const float*)args.in[35]; C.w_gu = (const float*)args.in[36]; C.b_gu = (const float*)args.in[37]; C.w_down = (const float*)args.in[38]; C.b_down = (const float*)args.in[39];
    C.out = args.out; C.ws = args.ws;
    const int lo = args.ph_lo, hi = args.ph_hi;
    for (int u = C.tid; u < (LDS_BYTES - MISC_OFF) / 4; u += NTHR) ((LAS unsigned*)(C.lds + MISC_OFF))[u] = 0u;
    __syncthreads();
    XcdBarrier bar; bar.bar = WSP(unsigned, WS_CTL) + CW_BAR; bar.x = 0; bar.st = nullptr;
    if (hi - lo > 1) bar = xcd_barrier_post(WSP(unsigned, WS_CTL) + CW_BAR, (volatile LAS unsigned*)(C.lds + MISC_OFF));
#ifndef PHMASK
#define PHMASK 0xFFFFFFFFu
#endif
#define PHON(n) (((PHMASK) >> (n)) & 1u)
#ifndef PHREP
#define PHREP 0u
#endif
#define NREP(n) (1 + (int)(((PHREP) >> (n)) & 1u))
#define WSPP(T, off) ((T*)(P.ws + (off)))
#define IN(k) (lo <= (k) && (k) < hi)
#define SEAM(k) do { if (IN(k) && IN((k) + 1)) xcd_barrier(bar); } while (0)
#define PCTX Ctx P = C; asm volatile("" : "+v"(P.tid), "+v"(P.lane)); asm volatile("" : "+s"(P.ws), "+s"(P.out), "+s"(P.wave), "+s"(P.bid))
    if (PHON(17) && IN(0)) for (int rep = 0; rep < NREP(17); ++rep) { PCTX; p0_prologue(P); __syncthreads(); }
    SEAM(0);
#ifndef PROBE_BARS
#define PROBE_BARS 0
#endif
    if (hi - lo > 1) for (int i = 0; i < PROBE_BARS; ++i) xcd_barrier(bar);
    if (PHON(18) && IN(1)) { PCTX; norm1_phase(P, 0, P.x); }
    SEAM(1);
    for (int l = 0; l < NLAYER; ++l) {
        const int pb = PH_BASE + PH_PER_LAYER * l;
        if (PHON(0) && IN(pb + 0)) for (int rep = 0; rep < NREP(0); ++rep) { PCTX;
            pg8::StaticOrder S; S.init(NT / 256, NPJ / 256, P.G, P.bid);
            if (INPROJ_FP8) { pg8::Gemm g{WSPP(bf16, WS_H), WSPP(bf16, WS_WIN) + (size_t)l * NPJ * 512, 512, 512, WSPP(int, WS_ROUTE) + NT * 12 + NR, 0x3FFFF}; EpiProj E{WSPP(bf16, R_PROJ), W8_INV}; pg8::gemm_phase<EpiProj, pg8::StaticOrder, true, true>(P.lds, P.tid, g, S, E); }
            else { pg8::Gemm g{WSPP(bf16, WS_H), WSPP(bf16, WS_WIN) + (size_t)l * NPJ * 1024, 1024, 1024}; EpiProj E{WSPP(bf16, R_PROJ), 1.f}; pg8::gemm_phase(P.lds, P.tid, g, S, E); }
        }
        SEAM(pb + 0);
        if (PHON(1) && IN(pb + 1)) for (int rep = 0; rep < NREP(1); ++rep) { PCTX; prep_phase(P, l); __syncthreads(); }
        SEAM(pb + 1);
        if (PHON(2) && IN(pb + 2)) for (int rep = 0; rep < NREP(2); ++rep) { PCTX;
            { pg8::Gemm g{WSPP(bf16, R_LIN), WSPP(bf16, WS_LORA) + (size_t)l * 768 * 256, 256, 256}; pg8::StaticOrder S; S.init(NT / 256, 3, P.G, P.bid);
              EpiLora E{WSPP(float, R_SC), WSPP(bf16, R_SCH), WSPP(bf16, R_G), P.w0 + l * 256, P.a0 + l * 256, P.ka + l * 256, (rep + 1 < NREP(2)) ? WSPP(bf16, WS_PROBE) : WSPP(bf16, R_SCH), (rep + 1 < NREP(2)) ? WSPP(float, WS_PROBE) + 64 * MiB : WSPP(float, R_SC)}; pg8::gemm_phase(P.lds, P.tid, g, S, E); }
        }
        SEAM(pb + 2);
        if (PHON(3) && IN(pb + 3)) for (int rep = 0; rep < NREP(3); ++rep) { PCTX; mix_phase(P, l, rep); }
        SEAM(pb + 3);
        if (PHON(4) && IN(pb + 4)) for (int rep = 0; rep < NREP(4); ++rep) { PCTX; fin_phase(P, l); __syncthreads(); }
        SEAM(pb + 4);
        if (PHON(5) && IN(pb + 5)) for (int rep = 0; rep < NREP(5); ++rep) { PCTX;
            pg8::Gemm g{WSPP(bf16, R_YCAT), WSPP(bf16, WS_WOUT) + (size_t)l * 1024 * 1024, 1024, 1024}; pg8::StaticOrder S; S.init(NT / 256, 4, P.G, P.bid);
            EpiOut E{(rep + 1 < NREP(5)) ? WSPP(bf16, WS_PROBE) : WSPP(bf16, WS_XB), l == 0 ? P.x : (const float*)nullptr, WSPP(bf16, WS_XB), WSPP(float, WS_SMALL) + (size_t)l * 8 * 6144 + 2048}; pg8::gemm_phase(P.lds, P.tid, g, S, E);
        }
        SEAM(pb + 5);
        if (PHON(6) && IN(pb + 6)) for (int rep = 0; rep < NREP(6); ++rep) { PCTX; router_phase(P, l); __syncthreads(); }
        SEAM(pb + 6);
        if (PHON(7) && IN(pb + 7)) for (int rep = 0; rep < NREP(7); ++rep) { PCTX; scatter_phase(P, l); __syncthreads(); }
        SEAM(pb + 7);
        if (PHON(8) && IN(pb + 8)) for (int rep = 0; rep < NREP(8); ++rep) { PCTX;
            LAS int* tab = (LAS int*)(P.lds + MISC_OFF + 64); moe_tables(P, l, tab);
            pg8::Gemm g{WSPP(bf16, R_XS), WSPP(bf16, WS_WGU) + (size_t)l * 32 * 2048 * 512, 512, 512, WSPP(int, WS_ROUTE) + NT * 12, 32767};
            pg8::GroupedOrder S; S.init(tab[32], 8, P.G, P.bid); S.tstart = tab; S.nrow_e = 2048;
            EpiGU8 E{WSPP(unsigned char, R_ACT), P.b_gu + (size_t)l * 32 * 2048}; pg8::gemm_phase<EpiGU8, pg8::GroupedOrder, true, true>(P.lds, P.tid, g, S, E);
        }
        SEAM(pb + 8);
        if (PHON(9) && IN(pb + 9)) for (int rep = 0; rep < NREP(9); ++rep) { PCTX;
            LAS int* tab = (LAS int*)(P.lds + MISC_OFF + 64); moe_tables(P, l, tab);
            pg8::Gemm g{WSPP(bf16, R_ACT), WSPP(bf16, WS_WDN) + (size_t)l * 32 * 1024 * 512, 512, 512, WSPP(int, WS_ROUTE) + NT * 12 + NR, 0x3FFFF}; pg8::GroupedOrder S; S.init(tab[32], 4, P.G, P.bid); S.tstart = tab; S.nrow_e = 1024;
            EpiDN8 E{WSPP(bf16, R_YB), P.b_down + (size_t)l * 32 * 1024}; pg8::gemm_phase<EpiDN8, pg8::GroupedOrder, true, true>(P.lds, P.tid, g, S, E);
        }
        SEAM(pb + 9);
        if (PHON(10) && IN(pb + 10)) for (int rep = 0; rep < NREP(10); ++rep) { PCTX; combine_phase(P, l, (rep + 1 < NREP(10)) ? WSPP(float, WS_PROBE) : P.out, (rep + 1 < NREP(10)) ? WSPP(bf16, WS_PROBE) : WSPP(bf16, WS_XB)); __syncthreads(); }
        SEAM(pb + 10);
    }
#undef IN
#undef SEAM
}

extern "C" void kernel_launch(void* const* d_in, const int* in_sizes, int n_in, void* d_out, int out_size, void* d_ws, size_t ws_size, hipStream_t stream) {
    static int grid = 0;
    if (grid == 0) {
        if (n_in != 40 || out_size != NT * DM || ws_size < WS_PROBE + 256 * MiB) { fprintf(stderr, "kernel_launch: unexpected problem (n_in %d, out %d, ws %zu < %zu)\n", n_in, out_size, ws_size, (size_t)WS_END); grid = -1; return; }
        int dev = 0, cus = 0, per_cu = 0;
        if (hipGetDevice(&dev) != hipSuccess || hipDeviceGetAttribute(&cus, hipDeviceAttributeMultiprocessorCount, dev) != hipSuccess) { grid = -1; return; }
        if (hipFuncSetAttribute((const void*)mk_fwd, hipFuncAttributeMaxDynamicSharedMemorySize, LDS_BYTES) != hipSuccess) { fprintf(stderr, "kernel_launch: hipFuncSetAttribute failed\n"); grid = -1; return; }
        if (hipOccupancyMaxActiveBlocksPerMultiprocessor(&per_cu, (const void*)mk_fwd, NTHR, LDS_BYTES) != hipSuccess || per_cu < 1) fprintf(stderr, "kernel_launch: occupancy query says %d blocks per CU\n", per_cu);
        (void)hipGetLastError();
        grid = cus > 256 ? 256 : cus;
    }
    if (grid < 0) return;
    (void)hipMemsetAsync((char*)d_ws, 0, ZERO_BYTES, stream);
    Args a{};
    for (int i = 0; i < 40; ++i) a.in[i] = d_in[i];
    a.out = (float*)d_out; a.ws = (unsigned char*)d_ws;
#if MK_ONE_LAUNCH
    a.ph_lo = 0; a.ph_hi = N_PHASES;
    hipLaunchKernelGGL(mk_fwd, dim3(grid), dim3(NTHR), LDS_BYTES, stream, a);
#else
    for (int p = 0; p < N_PHASES; ++p) { a.ph_lo = p; a.ph_hi = p + 1; hipLaunchKernelGGL(mk_fwd, dim3(grid), dim3(NTHR), LDS_BYTES, stream, a); }
#endif
    const hipError_t le = hipPeekAtLastError();
    if (le != hipSuccess) fprintf(stderr, "kernel_launch: launch failed: %s\n", hipGetErrorName(le));
}
```

```cpp
#include <hip/hip_runtime.h>
#include <cstdio>
#include <cstdint>

#define DI __device__ __forceinline__
#define LAS __attribute__((address_space(3)))
#define GAS __attribute__((address_space(1)))
typedef unsigned short bf16;
typedef short bf16x8 __attribute__((ext_vector_type(8)));
typedef float f32x4 __attribute__((ext_vector_type(4)));
typedef float f32x2 __attribute__((ext_vector_type(2)));
typedef unsigned u32x4 __attribute__((ext_vector_type(4)));
typedef unsigned u32x2 __attribute__((ext_vector_type(2)));
typedef unsigned char uchar;

#ifndef PROBE_SCAN2
#define PROBE_SCAN2 0
#endif
#ifndef PROBE_ATT2
#define PROBE_ATT2 0
#endif
#ifndef PROBE_NSA2
#define PROBE_NSA2 PROBE_ATT2
#endif
#ifndef PROBE_DIL2
#define PROBE_DIL2 PROBE_ATT2
#endif
#ifndef PROBE_CONV2
#define PROBE_CONV2 0
#endif
#ifndef INPROJ_FP8
#define INPROJ_FP8 0
#endif
constexpr int NB = 8, NS = 4096, NT = NB * NS, DM = 1024, NPJ = 3328, NE = 32, FF = 1024, NLAYER = 2;
constexpr int PJ_A = 0, PJ_B = 1024, PJ_C = 1792, PJ_D = 2560;
constexpr int NR = NT * 4 + NE * 256;
constexpr int NTHR = 512, NWAVE = 8;

DI float bf2f(unsigned v) { return __builtin_bit_cast(float, v << 16); }
DI unsigned f2bf(float f) { unsigned u = __builtin_bit_cast(unsigned, f); return (u + 0x7fffu + ((u >> 16) & 1u)) >> 16; }
DI unsigned pk2(float lo, float hi) { return f2bf(lo) | (f2bf(hi) << 16); }
DI float bflo(unsigned w) { return __builtin_bit_cast(float, w << 16); }
DI float bfhi(unsigned w) { return __builtin_bit_cast(float, w & 0xffff0000u); }
DI float fexp2(float x) { return __builtin_amdgcn_exp2f(x); }
DI float fsigmoid(float x) { return __builtin_amdgcn_rcpf(1.f + __builtin_amdgcn_exp2f(-1.44269504089f * x)); }
DI float wsum_xor(float v, int o) { return v + __shfl_xor(v, o); }
template <int CTRL> DI float dppmov(float x) { return __builtin_bit_cast(float, __builtin_amdgcn_update_dpp(0, __builtin_bit_cast(int, x), CTRL, 0xF, 0xF, true)); }
template <int W> DI float group_sum(float v) {
    if (W >= 2) v += dppmov<0xB1>(v);
    if (W >= 4) v += dppmov<0x4E>(v);
    if (W >= 8) v += dppmov<0x141>(v);
    if (W >= 16) v += dppmov<0x140>(v);
    if (W >= 32) v += __shfl_xor(v, 16);
    if (W >= 64) v += __shfl_xor(v, 32);
    return v;
}
DI float sum8(float x) { x += dppmov<0xB1>(x); x += dppmov<0x4E>(x); x += dppmov<0x141>(x); return x; }

#define XB_TMO      128
#define XB_XCNT(j)  (256  + 64 * (j))
#define XB_XSUB(j)  (1280 + 64 * (j))
#define XB_XGEN(j)  (2304 + 64 * (j))
#define XB_TOP      3328
#define XB_TOPGEN   3392
#define XCD_BAR_WORDS 3456
#define XB_SPIN_CAP (1u << 18)
DI unsigned xb_ld(unsigned* p)              { return __hip_atomic_load(p, __ATOMIC_RELAXED, __HIP_MEMORY_SCOPE_AGENT); }
DI unsigned xb_add(unsigned* p, unsigned v) { return __hip_atomic_fetch_add(p, v, __ATOMIC_RELAXED, __HIP_MEMORY_SCOPE_AGENT); }
DI unsigned xb_xcc_id() { return (unsigned)__builtin_amdgcn_s_getreg((3 << 11) | 20) & 0xFu; }
#define XB_SPIN(cond, bar) do { unsigned _sp = 0; while (cond) { __builtin_amdgcn_s_sleep(1); \
    if ((++_sp & 255u) == 0u) { if (xb_ld(&(bar)[XB_TMO])) break; if (_sp > XB_SPIN_CAP) { atomicAdd(&(bar)[XB_TMO], 1u); break; } } } } while (0)
struct XcdBarrier { unsigned* bar; unsigned x; volatile LAS unsigned* st; };
DI XcdBarrier xcd_barrier_post(unsigned* bar, volatile LAS unsigned* st) {
    XcdBarrier b; b.bar = bar; b.x = xb_xcc_id(); b.st = st;
    if (threadIdx.x == 0) (void)xb_add(&bar[XB_XCNT(b.x)], 1u);
    return b;
}
DI void xcd_barrier_complete(unsigned* bar, unsigned x, unsigned& nloc, unsigned& nx) {
    const unsigned G = gridDim.x * gridDim.y * gridDim.z;
    unsigned sum, cnt, mine, sp = 0u;
    for (;;) {
        sum = 0u; cnt = 0u; mine = 0u;
#pragma unroll
        for (unsigned j = 0; j < 16; ++j) { const unsigned c = xb_ld(&bar[XB_XCNT(j)]); sum += c; cnt += (c > 0u) ? 1u : 0u; mine = (j == x) ? c : mine; }
        if (sum == G) break;
        __builtin_amdgcn_s_sleep(1);
        if ((++sp & 255u) == 0u) { if (xb_ld(&bar[XB_TMO])) break; if (sp > XB_SPIN_CAP) { atomicAdd(&bar[XB_TMO], 1u); break; } }
    }
    nloc = mine > 0u ? mine : 1u; nx = cnt > 0u ? cnt : 1u;
}
DI void xcd_barrier(const XcdBarrier& b) {
    asm volatile("s_waitcnt vmcnt(0)" ::: "memory");
    __syncthreads();
    if (threadIdx.x == 0) {
        unsigned* bar = b.bar;
        __builtin_amdgcn_s_waitcnt(0);
        unsigned nloc = b.st[0], nx = b.st[1];
        if (nloc == 0u) { xcd_barrier_complete(bar, b.x, nloc, nx); b.st[0] = nloc; b.st[1] = nx; }
        const unsigned old = xb_add(&bar[XB_XSUB(b.x)], 1u);
        const unsigned gen = old / nloc;
        if (old + 1u == (gen + 1u) * nloc) {
            __builtin_amdgcn_fence(__ATOMIC_RELEASE, "agent");
            asm volatile("s_waitcnt vmcnt(0)" ::: "memory");
            const unsigned og = xb_add(&bar[XB_TOP], 1u);
            const unsigned tg = og / nx;
            if (og + 1u == (tg + 1u) * nx) xb_add(&bar[XB_TOPGEN], 1u);
            else XB_SPIN(xb_ld(&bar[XB_TOPGEN]) == tg, bar);
            __builtin_amdgcn_fence(__ATOMIC_ACQUIRE, "agent");
            xb_add(&bar[XB_XGEN(b.x)], 1u);
            asm volatile("s_waitcnt vmcnt(0)" ::: "memory");
        } else {
            XB_SPIN(xb_ld(&bar[XB_XGEN(b.x)]) == gen, bar);
            __builtin_amdgcn_fence(__ATOMIC_ACQUIRE, "agent");
            asm volatile("s_waitcnt vmcnt(0)" ::: "memory");
        }
    }
    __syncthreads();
}
namespace pg8 {
constexpr int BM = 256, BK = 64, HALF = 128, HTB = HALF * BK * 2, STAGE_BYTES = 8 * HTB, NXCD = 8, WGM = 4;
__host__ __device__ __forceinline__ int lds_byte(int r, int c) { const int st = (r >> 4) * 2 + (c >> 5), rr = r & 15, cc = c & 31, ob = rr * 64 + cc * 2; return st * 1024 + (ob ^ (((ob >> 9) & 1) << 5)); }
__host__ __device__ __forceinline__ void stage_rc(int b, int& R, int& C) { const int st = b / 1024, sb = b % 1024, swz = sb ^ (((sb >> 9) & 1) << 5); R = (st >> 1) * 16 + swz / 64; C = (st & 1) * 32 + (swz % 64) / 2; }
__host__ __device__ __forceinline__ int perm32(int rho) { const int n = rho >> 4, i = rho & 15; return 8 * (i >> 2) + 4 * n + (i & 3); }

struct Unit { int pm, pn, brow, e; };
struct Gemm { const bf16* A; const bf16* Bt; int lda, K; const int* rowmap; int rowmask; };

struct StaticOrder {
    int nM, nN, nwg, G, c;
    __device__ void init(int nM_, int nN_, int G_, int c_) { nM = nM_; nN = nN_; nwg = nM * nN; G = G_; c = c_; }
    __device__ bool tile(int i, int& pm, int& pn) const {
        const long L = (long)i * G + c; if (L >= nwg) return false;
        int wgid = (int)L; { const int q = nwg / NXCD, r = nwg % NXCD, xcd = wgid % NXCD, off = wgid / NXCD; wgid = (xcd < r ? xcd * (q + 1) : r * (q + 1) + (xcd - r) * q) + off; }
        const int nig = WGM * nN, gid = wgid / nig, fm = gid * WGM, gsz = (nM - fm) < WGM ? (nM - fm) : WGM;
        pm = fm + ((wgid % nig) % gsz); pn = (wgid % nig) / gsz; return true;
    }
    __device__ bool next(int i, Unit& u) const { if (!tile(i, u.pm, u.pn)) return false; u.brow = u.pn * BM; u.e = 0; return true; }
};
struct GroupedOrder : StaticOrder {
    const LAS int* tstart; int nrow_e;
    __device__ bool next(int i, Unit& u) const {
        if (!tile(i, u.pm, u.pn)) return false;
        int e = 0;
#pragma unroll 1
        for (int j = 16; j > 0; j >>= 1) if (tstart[e + j] <= u.pm) e += j;
        u.e = e; u.brow = e * nrow_e + u.pn * BM; return true;
    }
};
DI unsigned cvt_pk_bf16(float lo, float hi) { unsigned r; asm volatile("v_cvt_pk_bf16_f32 %0, %1, %2" : "=v"(r) : "v"(lo), "v"(hi)); return r; }

template <class Epi, class Sched, bool GATHER = false, bool FP8 = false>
DI void gemm_phase(LAS unsigned char* lds, const int tid, const Gemm g, const Sched& S, const Epi& E) {
    const int wid = __builtin_amdgcn_readfirstlane(tid >> 6), lane = tid & 63, wr = wid >> 2, wc = wid & 3, fr = lane & 15, fq = lane >> 4;
    int K = g.K, lda = g.lda; asm volatile("" : "+s"(K), "+s"(lda));
    const int nt = K / BK;
    unsigned voffA[2], voffB[2]; int Ra[2], Ca[2];
#pragma unroll
    for (int i = 0; i < 2; ++i) { int R, C; stage_rc(tid * 16 + i * 8192, R, C); const int Rb = Epi::PERM ? ((R & ~31) + perm32(R & 31)) : R; Ra[i] = R; Ca[i] = C;
        voffA[i] = (unsigned)(R * lda + C) * 2u; voffB[i] = (unsigned)(Rb * K + C) * 2u; }
    unsigned vgc[2][2]; int rawn[2][2];
#define PG8_GLOAD(dst, pm_) do { _Pragma("unroll") for (int _h = 0; _h < 2; ++_h) _Pragma("unroll") for (int _i = 0; _i < 2; ++_i) { const int* _p = g.rowmap + (size_t)(pm_) * BM + _h * HALF + Ra[_i]; \
        asm volatile("global_load_dword %0, %1, off" : "=v"(dst[_h][_i]) : "v"(_p) : "memory"); } } while (0)
#define PG8_GCONV(vg, raw) do { _Pragma("unroll") for (int _h = 0; _h < 2; ++_h) _Pragma("unroll") for (int _i = 0; _i < 2; ++_i) { int _r = raw[_h][_i]; asm volatile("" : "+v"(_r)); \
        vg[_h][_i] = (unsigned)((_r & g.rowmask) * lda + Ca[_i]) * 2u; } } while (0)
#define PG8_STAGE_A(bufoff, kptr, h, vg) do { if (GATHER) PG8_STAGE(bufoff, kptr, vg[h]); else PG8_STAGE(bufoff, (kptr) + (h) * hstepA, voffA); } while (0)
    const size_t kstep = (size_t)(BK * 2);
    const size_t hstepA = (size_t)HALF * lda * 2, hstepB = (size_t)HALF * K * 2;
    const size_t tstepA = 2 * hstepA;
    const unsigned ldsw = (unsigned)wid * 1024u;
    const int aoff = lds_byte(wr * 64 + fr, fq * 8), boff = lds_byte(wc * 32 + fr, fq * 8);
#define PG8_SA(b, h) (((b) * 2 + (h)) * HTB)
#define PG8_SB(b, h) ((4 + (b) * 2 + (h)) * HTB)
#define PG8_STAGE(bufoff, gbase, voff) do { _Pragma("unroll") for (int _i = 0; _i < 2; ++_i) \
        __builtin_amdgcn_global_load_lds((const unsigned*)((const char*)(gbase) + (voff)[_i]), (LAS unsigned*)(lds + (bufoff) + ldsw + _i * 8192), 16, 0, 0); } while (0)
#define PG8_LDA(dst, b, h) do { _Pragma("unroll") for (int m = 0; m < 4; ++m) { const v4i_ lo_ = *(const LAS v4i_*)(lds + PG8_SA(b, h) + aoff + m * 2048), hi_ = *(const LAS v4i_*)(lds + PG8_SA(b, h) + aoff + m * 2048 + 1024); \
        dst[m] = __builtin_shufflevector(lo_, hi_, 0, 1, 2, 3, 4, 5, 6, 7); } } while (0)
#define PG8_LDB(dst, b, h) do { _Pragma("unroll") for (int n = 0; n < 2; ++n) { const v4i_ lo_ = *(const LAS v4i_*)(lds + PG8_SB(b, h) + boff + n * 2048), hi_ = *(const LAS v4i_*)(lds + PG8_SB(b, h) + boff + n * 2048 + 1024); \
        dst[n] = __builtin_shufflevector(lo_, hi_, 0, 1, 2, 3, 4, 5, 6, 7); } } while (0)
#define PG8_MMA(ai, bj, At, Bt) do { __builtin_amdgcn_s_setprio(1); _Pragma("unroll") for (int m = 0; m < 4; ++m) _Pragma("unroll") for (int n = 0; n < 2; ++n) { \
        if (FP8) acc[ai][bj][m][n] = __builtin_amdgcn_mfma_scale_f32_16x16x128_f8f6f4(Bt[n], At[m], acc[ai][bj][m][n], 0, 0, 0, 0x7F7F7F7F, 0, 0x7F7F7F7F); \
        else { const v8i_ b_ = Bt[n], a_ = At[m]; \
            acc[ai][bj][m][n] = __builtin_amdgcn_mfma_f32_16x16x32_bf16(__builtin_bit_cast(bf16x8, __builtin_shufflevector(b_, b_, 0, 1, 2, 3)), __builtin_bit_cast(bf16x8, __builtin_shufflevector(a_, a_, 0, 1, 2, 3)), acc[ai][bj][m][n], 0, 0, 0); \
            acc[ai][bj][m][n] = __builtin_amdgcn_mfma_f32_16x16x32_bf16(__builtin_bit_cast(bf16x8, __builtin_shufflevector(b_, b_, 4, 5, 6, 7)), __builtin_bit_cast(bf16x8, __builtin_shufflevector(a_, a_, 4, 5, 6, 7)), acc[ai][bj][m][n], 0, 0, 0); } } \
        __builtin_amdgcn_s_setprio(0); } while (0)
#define PG8_WAIT_V(n) asm volatile("s_waitcnt vmcnt(" #n ")" ::: "memory")
#define PG8_WAIT_L(n) asm volatile("s_waitcnt lgkmcnt(" #n ")" ::: "memory")
#define PG8_BAR __builtin_amdgcn_s_barrier()
#define PG8_SCHED __builtin_amdgcn_sched_barrier(0)
    Unit cur, nxt; int ui = 0;
    if (!S.next(0, cur)) return;
    f32x4 acc[2][2][4][2];
#pragma unroll
    for (int a = 0; a < 2; ++a)
#pragma unroll
        for (int b = 0; b < 2; ++b)
#pragma unroll
            for (int m = 0; m < 4; ++m)
#pragma unroll
                for (int n = 0; n < 2; ++n) acc[a][b][m][n] = (f32x4){0.f, 0.f, 0.f, 0.f};
    typedef int v8i_ __attribute__((ext_vector_type(8))); typedef int v4i_ __attribute__((ext_vector_type(4)));
    v8i_ At[4], B0[2], B1[2];
    const char* cA = (const char*)g.A + (GATHER ? (size_t)0 : (size_t)cur.pm * tstepA); const char* cB = (const char*)g.Bt + (size_t)cur.brow * K * 2;
    if (GATHER) { PG8_GLOAD(rawn, cur.pm); asm volatile("s_waitcnt vmcnt(0)" : "+v"(rawn[0][0]), "+v"(rawn[0][1]), "+v"(rawn[1][0]), "+v"(rawn[1][1]) :: "memory"); PG8_GCONV(vgc, rawn); }
    PG8_STAGE(PG8_SB(0, 0), cB, voffB); PG8_STAGE(PG8_SB(0, 1), cB + hstepB, voffB); PG8_STAGE_A(PG8_SA(0, 0), cA, 0, vgc); PG8_STAGE_A(PG8_SA(0, 1), cA, 1, vgc);
    if (wr == 1) PG8_BAR;
    PG8_WAIT_V(2); PG8_BAR;
    PG8_STAGE(PG8_SB(1, 0), cB + kstep, voffB); PG8_STAGE_A(PG8_SA(1, 0), cA + kstep, 0, vgc); PG8_STAGE(PG8_SB(1, 1), cB + hstepB + kstep, voffB);
    PG8_WAIT_V(6); PG8_BAR;
    for (;;) {
        const bool has_next = S.next(ui + 1, nxt);
        const char* nA = (has_next && !GATHER) ? (const char*)g.A + (size_t)nxt.pm * tstepA : cA;
        if (GATHER && has_next) PG8_GLOAD(rawn, nxt.pm); const char* nB = has_next ? (const char*)g.Bt + (size_t)nxt.brow * K * 2 : cB;
#pragma unroll 1
        for (int t = 0; t < nt; t += 2) {
            const bool last = (t == nt - 2);
            const char* a1 = cA + (size_t)(t + 1) * kstep;
            const char* a2 = last ? nA : cA + (size_t)(t + 2) * kstep; const char* b2 = last ? nB : cB + (size_t)(t + 2) * kstep;
            const char* a3 = a2 + kstep; const char* b3 = b2 + kstep;
            PG8_LDB(B0, 0, 0); PG8_LDB(B1, 0, 1); PG8_SCHED; PG8_LDA(At, 0, 0); PG8_STAGE_A(PG8_SA(1, 1), a1, 1, vgc);
            if (GATHER) { if (last && has_next) PG8_GCONV(vgc, rawn); }
            PG8_WAIT_V(8); PG8_WAIT_L(0); PG8_BAR; PG8_MMA(0, 0, At, B0); PG8_MMA(0, 1, At, B1); PG8_BAR; PG8_SCHED;
            PG8_LDA(At, 0, 1); PG8_STAGE(PG8_SB(0, 0), b2, voffB); PG8_STAGE(PG8_SB(0, 1), b2 + hstepB, voffB); PG8_STAGE_A(PG8_SA(0, 0), a2, 0, vgc);
            PG8_WAIT_V(8); PG8_WAIT_L(0); PG8_BAR; PG8_MMA(1, 0, At, B0); PG8_MMA(1, 1, At, B1); PG8_BAR; PG8_SCHED;
            PG8_LDB(B0, 1, 0); PG8_LDB(B1, 1, 1); PG8_SCHED; PG8_LDA(At, 1, 0); PG8_STAGE_A(PG8_SA(0, 1), a2, 1, vgc);
            PG8_WAIT_V(8); PG8_WAIT_L(0); PG8_BAR; PG8_MMA(0, 0, At, B0); PG8_MMA(0, 1, At, B1); PG8_BAR; PG8_SCHED;
            PG8_LDA(At, 1, 1); PG8_STAGE(PG8_SB(1, 0), b3, voffB); PG8_STAGE(PG8_SB(1, 1), b3 + hstepB, voffB); PG8_STAGE_A(PG8_SA(1, 0), a3, 0, vgc);
            PG8_WAIT_V(8); PG8_WAIT_L(0); PG8_BAR; PG8_MMA(1, 0, At, B0); PG8_MMA(1, 1, At, B1); PG8_BAR; PG8_SCHED;
        }
        if (wr == 0) PG8_BAR;
        { int fr2 = fr, fq2 = fq; asm volatile("" : "+v"(fr2), "+v"(fq2)); E(acc, cur, wr, wc, fr2, fq2); }
        if (!has_next) break;
#pragma unroll
        for (int a = 0; a < 2; ++a)
#pragma unroll
            for (int b = 0; b < 2; ++b)
#pragma unroll
                for (int m = 0; m < 4; ++m)
#pragma unroll
                    for (int n = 0; n < 2; ++n) acc[a][b][m][n] = (f32x4){0.f, 0.f, 0.f, 0.f};
        cur = nxt; cA = nA; cB = nB; ++ui;
        if (wr == 1) PG8_BAR;
    }
    PG8_WAIT_V(0);
    PG8_BAR;
#undef PG8_SA
#undef PG8_SB
#undef PG8_STAGE
#undef PG8_STAGE_A
#undef PG8_GLOAD
#undef PG8_GCONV
#undef PG8_LDA
#undef PG8_LDB
#undef PG8_MMA
#undef PG8_WAIT_V
#undef PG8_WAIT_L
#undef PG8_BAR
#undef PG8_SCHED
}
}
constexpr size_t MiB = 1u << 20;
constexpr size_t WS_CTL = 0;
constexpr size_t WS_LORA = 1 * MiB;
constexpr size_t WS_WK2 = 2 * MiB;
constexpr size_t ZERO_BYTES = 3 * MiB;
constexpr size_t WS_WIN = 3 * MiB;
constexpr size_t WS_WOUT = 17 * MiB;
constexpr size_t WS_WK1 = 21 * MiB;
constexpr size_t WS_SMALL = 25 * MiB;
constexpr size_t WS_ROUTE = 27 * MiB;
constexpr size_t WS_WGU = 32 * MiB;
constexpr size_t WS_WDN = 288 * MiB;
constexpr size_t WS_H = 416 * MiB;
constexpr size_t WS_R = 480 * MiB;
constexpr size_t R_PROJ = WS_R;
constexpr size_t R_SC = R_PROJ + 208 * MiB;
constexpr size_t R_SCH = R_SC + 32 * MiB;
constexpr size_t R_LIN = R_SC + 192 * MiB;
constexpr size_t R_G = R_LIN + 16 * MiB;
constexpr size_t R_YA = R_G + 32 * MiB;
constexpr size_t R_YCAT = R_YA + 32 * MiB;
constexpr size_t R_QC = R_YCAT + 64 * MiB;
constexpr size_t R_KC = R_QC + 16 * MiB;
constexpr size_t R_OC = R_KC + 16 * MiB;
constexpr size_t R_LSE = R_OC + 96 * MiB;
constexpr size_t R_QN = R_LSE + 2 * MiB;
constexpr size_t R_QR = R_QN + 16 * MiB;
constexpr size_t R_KCR = R_QR + 16 * MiB;
constexpr size_t R_VCR = R_KCR + 5 * MiB;
constexpr size_t R_KS = R_VCR + 5 * MiB;
constexpr size_t R_KW = R_KS + 4 * MiB;
constexpr size_t R_GATE = R_KW + 4 * MiB;
constexpr size_t R_CH1 = R_GATE + 2 * MiB;
constexpr size_t R_CMP = R_CH1 + 2 * MiB;
constexpr size_t R_OCMP = R_CMP + 1 * MiB;
constexpr size_t R_OSLC = R_OCMP + 32 * MiB;
constexpr size_t R_OSWA = R_OSLC + 32 * MiB;
constexpr size_t R_SCANU = R_OSWA;
constexpr size_t R_SCANS = R_OSWA + 16 * MiB;
constexpr size_t R_IMP = R_OSWA + 32 * MiB;
constexpr size_t R_SELM = R_IMP + 8 * MiB;
constexpr size_t R_MIX_END = R_SELM + 1 * MiB;
constexpr size_t R_XS = WS_R;
constexpr size_t R_ACT = R_XS + 272 * MiB;
constexpr size_t R_YB = R_ACT + 272 * MiB;
constexpr size_t R_MOE_END = R_YB + 272 * MiB;
constexpr size_t WS_END = (R_MIX_END > R_MOE_END ? R_MIX_END : R_MOE_END);
constexpr size_t WS_XB = WS_END;
constexpr size_t WS_PROBE = WS_XB + 64 * MiB;
static_assert((size_t)NR * 1024 * 2 <= 272 * MiB, "sorted buffers");
constexpr int CW_BAR = 4096;
constexpr int CW_CNT = 16384;
constexpr int CW_CUR = 16384 + 64;

constexpr int RING_BYTES = 131072;
constexpr int MISC_OFF = RING_BYTES;
constexpr int LDS_BYTES = 155648;

struct Args { const void* in[40]; float* out; unsigned char* ws; int ph_lo, ph_hi; };

struct Ctx {
    LAS unsigned char* lds; int tid, lane, wave, G, bid;
    const float *x, *c, *w_ada, *b_ada, *norm1_g, *norm2_g, *w_in, *w_out, *mu, *w0, *w2, *a0, *a2, *g2, *kkw, *ka, *rk, *gn_w, *gn_b, *conv_w, *dil_q_g, *dil_k_g,
        *nsa_q_g, *nsa_kc_g, *nsa_ks_g, *nsa_kw_g, *pe_k, *pe_v, *wk1, *wk2, *wv1, *wv2, *onorm_g, *w_router, *b_router, *w_gu, *b_gu, *w_down, *b_down;
    const int* pos;
    float* out; unsigned char* ws;
};
#define WSP(T, off) ((T*)(C.ws + (off)))

typedef f32x4 Acc[2][2][4][2];
struct EpiProj {
    static constexpr bool PERM = true; bf16* O; float scale;
    DI void operator()(const Acc& acc, const pg8::Unit& u, int wr, int wc, int fr, int fq) const {
        const int row0 = u.pm * 256 + wr * 64 + fr, col0 = u.pn * 256 + wc * 32 + 8 * fq;
#pragma unroll
        for (int ai = 0; ai < 2; ++ai)
#pragma unroll
            for (int m = 0; m < 4; ++m) { bf16* rowp = O + (size_t)(row0 + ai * 128 + m * 16) * NPJ + col0;
#pragma unroll
                for (int bj = 0; bj < 2; ++bj) { const f32x4 v0 = acc[ai][bj][m][0] * scale, v1 = acc[ai][bj][m][1] * scale; u32x4 w;
                    w.x = pg8::cvt_pk_bf16(v0[0], v0[1]); w.y = pg8::cvt_pk_bf16(v0[2], v0[3]); w.z = pg8::cvt_pk_bf16(v1[0], v1[1]); w.w = pg8::cvt_pk_bf16(v1[2], v1[3]);
                    *(u32x4*)(rowp + bj * 128) = w; } }
    }
};
struct EpiLora {
    static constexpr bool PERM = false; float* Wp; bf16* SCH; bf16* Gb; const float *w0, *a0, *ka; bf16* SCo; float* Wo;
    DI void operator()(const Acc& acc, const pg8::Unit& u, int wr, int wc, int fr, int fq) const {
        const int row0 = u.pm * 256 + wr * 64 + fr, col0 = wc * 32 + 4 * fq;
        if (u.pn == 0) {
#pragma unroll
            for (int bj = 0; bj < 2; ++bj)
#pragma unroll
                for (int n = 0; n < 2; ++n) { const int ch = col0 + bj * 128 + n * 16; const f32x4 b = *(const f32x4*)(w0 + ch);
#pragma unroll
                    for (int ai = 0; ai < 2; ++ai)
#pragma unroll
                        for (int m = 0; m < 4; ++m) { const size_t o = (size_t)(row0 + ai * 128 + m * 16) * 256 + ch; const f32x4 v = acc[ai][bj][m][n] + b; f32x4 r;
#pragma unroll
                            for (int j = 0; j < 4; ++j) r[j] = fexp2(-0.875040829f * fsigmoid(v[j]));
                            *(f32x4*)(Wo + o) = r; } }
        } else if (u.pn == 1) {
#pragma unroll
            for (int bj = 0; bj < 2; ++bj)
#pragma unroll
                for (int n = 0; n < 2; ++n) { const int ch = col0 + bj * 128 + n * 16; const f32x4 b = *(const f32x4*)(a0 + ch), kav = *(const f32x4*)(ka + ch);
#pragma unroll
                    for (int ai = 0; ai < 2; ++ai)
#pragma unroll
                        for (int m = 0; m < 4; ++m) { __builtin_amdgcn_sched_barrier(0); const size_t o = (size_t)(row0 + ai * 128 + m * 16) * 256 + ch; const f32x4 v = acc[ai][bj][m][n] + b;
                            const u32x2 kr = *(const u32x2*)(SCH + o), kn = *(const u32x2*)(SCH + (size_t)NT * 256 + o);
                            const float krf[4] = {bflo(kr.x), bfhi(kr.x), bflo(kr.y), bfhi(kr.y)}, knf[4] = {bflo(kn.x), bfhi(kn.x), bflo(kn.y), bfhi(kn.y)}; float k2[4], bb[4];
#pragma unroll
                            for (int j = 0; j < 4; ++j) { const float a = fsigmoid(v[j]); k2[j] = krf[j] * (1.f + (a - 1.f) * kav[j]); bb[j] = knf[j] * a; }
                            u32x2 o1, o2; o1.x = pk2(k2[0], k2[1]); o1.y = pk2(k2[2], k2[3]); o2.x = pk2(bb[0], bb[1]); o2.y = pk2(bb[2], bb[3]);
                            *(u32x2*)(SCo + o) = o1; *(u32x2*)(SCo + (size_t)2 * NT * 256 + o) = o2; } }
        } else {
#pragma unroll
            for (int bj = 0; bj < 2; ++bj)
#pragma unroll
                for (int n = 0; n < 2; ++n) { const int ch = col0 + bj * 128 + n * 16;
#pragma unroll
                    for (int ai = 0; ai < 2; ++ai)
#pragma unroll
                        for (int m = 0; m < 4; ++m) { const size_t o = (size_t)(row0 + ai * 128 + m * 16) * 256 + ch; const f32x4 v = acc[ai][bj][m][n]; u32x2 w; w.x = pk2(v[0], v[1]); w.y = pk2(v[2], v[3]); *(u32x2*)(Gb + o) = w; } }
        }
    }
};
DI float gelu_tanh(float x) { const float t = 0.7978845608f * (x + 0.044715f * x * x * x); return x * fsigmoid(2.f * t); }
struct EpiC1 {
    static constexpr bool PERM = true; bf16* O; const float* peb;
    DI void operator()(const Acc& acc, const pg8::Unit& u, int wr, int wc, int fr, int fq) const {
        const int row0 = u.pm * 256 + wr * 64 + fr, col0 = wc * 32 + 8 * fq;
#pragma unroll
        for (int bj = 0; bj < 2; ++bj) { const f32x4 b0 = *(const f32x4*)(peb + col0 + bj * 128), b1 = *(const f32x4*)(peb + col0 + bj * 128 + 4);
#pragma unroll
            for (int ai = 0; ai < 2; ++ai)
#pragma unroll
                for (int m = 0; m < 4; ++m) { bf16* p = O + (size_t)(row0 + ai * 128 + m * 16) * 256 + col0 + bj * 128; const f32x4 v0 = acc[ai][bj][m][0] + b0, v1 = acc[ai][bj][m][1] + b1; u32x4 w;
                    w.x = pk2(gelu_tanh(v0[0]), gelu_tanh(v0[1])); w.y = pk2(gelu_tanh(v0[2]), gelu_tanh(v0[3])); w.z = pk2(gelu_tanh(v1[0]), gelu_tanh(v1[1])); w.w = pk2(gelu_tanh(v1[2]), gelu_tanh(v1[3]));
                    *(u32x4*)p = w; } }
    }
};
struct EpiC2 {
    static constexpr bool PERM = false; float* O;
    DI void operator()(const Acc& acc, const pg8::Unit& u, int wr, int wc, int fr, int fq) const {
        if (wc >= 2) return;
        const int row0 = u.pm * 256 + wr * 64 + fr, col0 = wc * 32 + 4 * fq;
#pragma unroll
        for (int ai = 0; ai < 2; ++ai)
#pragma unroll
            for (int m = 0; m < 4; ++m)
#pragma unroll
                for (int n = 0; n < 2; ++n) *(f32x4*)(O + (size_t)(row0 + ai * 128 + m * 16) * 64 + col0 + n * 16) = acc[ai][0][m][n];
    }
};
struct EpiOut {
    static constexpr bool PERM = true; bf16* O; const float* xin; const bf16* xb; const float* gt;
    DI void operator()(const Acc& acc, const pg8::Unit& u, int wr, int wc, int fr, int fq) const {
        const int row0 = u.pm * 256 + wr * 64 + fr, col0 = u.pn * 256 + wc * 32 + 8 * fq; const int b = (u.pm * 256) / NS;
#pragma unroll
        for (int bj = 0; bj < 2; ++bj) { const float* gp = gt + (size_t)b * 6144 + col0 + bj * 128; const f32x4 g0 = *(const f32x4*)gp, g1 = *(const f32x4*)(gp + 4);
#pragma unroll
            for (int ai = 0; ai < 2; ++ai)
#pragma unroll
                for (int m = 0; m < 4; ++m) { const size_t o = (size_t)(row0 + ai * 128 + m * 16) * DM + col0 + bj * 128; f32x4 x0, x1;
                    if (xin) { x0 = *(const f32x4*)(xin + o); x1 = *(const f32x4*)(xin + o + 4); }
                    else { const u32x4 t = *(const u32x4*)(xb + o); x0 = (f32x4){bflo(t.x), bfhi(t.x), bflo(t.y), bfhi(t.y)}; x1 = (f32x4){bflo(t.z), bfhi(t.z), bflo(t.w), bfhi(t.w)}; }
                    const f32x4 v0 = x0 + g0 * acc[ai][bj][m][0], v1 = x1 + g1 * acc[ai][bj][m][1]; u32x4 w;
                    w.x = pk2(v0[0], v0[1]); w.y = pk2(v0[2], v0[3]); w.z = pk2(v1[0], v1[1]); w.w = pk2(v1[2], v1[3]); *(u32x4*)(O + o) = w; } }
    }
};
struct EpiGU {
    static constexpr bool PERM = true; bf16* O; const float* bgu;
    DI void operator()(const Acc& acc, const pg8::Unit& u, int wr, int wc, int fr, int fq) const {
        const int row0 = u.pm * 256 + wr * 64 + fr, cc = u.pn * 128 + wc * 32 + 8 * fq; const float* bp = bgu + (size_t)u.e * 2048 + cc;
        const f32x4 g0 = *(const f32x4*)bp, g1 = *(const f32x4*)(bp + 4), u0 = *(const f32x4*)(bp + 1024), u1 = *(const f32x4*)(bp + 1028);
#pragma unroll
        for (int ai = 0; ai < 2; ++ai)
#pragma unroll
            for (int m = 0; m < 4; ++m) { bf16* p = O + (size_t)(row0 + ai * 128 + m * 16) * FF + cc; float r[8];
#pragma unroll
                for (int n = 0; n < 2; ++n) { const f32x4 gv = acc[ai][0][m][n] + (n ? g1 : g0), uv = acc[ai][1][m][n] + (n ? u1 : u0);
#pragma unroll
                    for (int j = 0; j < 4; ++j) { const float ga = fminf(gv[j], 7.f), up = fminf(fmaxf(uv[j], -7.f), 7.f); r[4 * n + j] = ga * fsigmoid(1.702f * ga) * (up + 1.f); } }
                u32x4 w; w.x = pk2(r[0], r[1]); w.y = pk2(r[2], r[3]); w.z = pk2(r[4], r[5]); w.w = pk2(r[6], r[7]); *(u32x4*)p = w; }
    }
};
struct EpiDN {
    static constexpr bool PERM = true; bf16* O; const float* bd;
    DI void operator()(const Acc& acc, const pg8::Unit& u, int wr, int wc, int fr, int fq) const {
        const int row0 = u.pm * 256 + wr * 64 + fr, col0 = u.pn * 256 + wc * 32 + 8 * fq; const float* bp = bd + (size_t)u.e * 1024 + col0;
#pragma unroll
        for (int bj = 0; bj < 2; ++bj) { const f32x4 b0 = *(const f32x4*)(bp + bj * 128), b1 = *(const f32x4*)(bp + bj * 128 + 4);
#pragma unroll
            for (int ai = 0; ai < 2; ++ai)
#pragma unroll
                for (int m = 0; m < 4; ++m) { bf16* p = O + (size_t)(row0 + ai * 128 + m * 16) * DM + col0 + bj * 128; const f32x4 v0 = acc[ai][bj][m][0] + b0, v1 = acc[ai][bj][m][1] + b1; u32x4 w;
                    w.x = pk2(v0[0], v0[1]); w.y = pk2(v0[2], v0[3]); w.z = pk2(v1[0], v1[1]); w.w = pk2(v1[2], v1[3]); *(u32x4*)p = w; } }
    }
};
DI float clamp8(float x) { return fminf(fmaxf(x, -448.f), 448.f); }
DI unsigned pk4_fp8_nc(float a, float b, float c, float d) { unsigned w = 0u; w = __builtin_amdgcn_cvt_pk_fp8_f32(a, b, w, false); w = __builtin_amdgcn_cvt_pk_fp8_f32(c, d, w, true); return w; }
DI unsigned pk4_fp8(float a, float b, float c, float d) { unsigned w = 0u; w = __builtin_amdgcn_cvt_pk_fp8_f32(clamp8(a), clamp8(b), w, false); w = __builtin_amdgcn_cvt_pk_fp8_f32(clamp8(c), clamp8(d), w, true); return w; }
constexpr float W8_SCALE = 32.f, W8_INV = 1.f / 32.f;
struct EpiGU8 {
    static constexpr bool PERM = true; unsigned char* O; const float* bgu;
    DI void operator()(const Acc& acc, const pg8::Unit& u, int wr, int wc, int fr, int fq) const {
        const int row0 = u.pm * 256 + wr * 64 + fr, cc = u.pn * 128 + wc * 32 + 8 * fq; const float* bp = bgu + (size_t)u.e * 2048 + cc;
        const f32x4 g0 = *(const f32x4*)bp, g1 = *(const f32x4*)(bp + 4), u0 = *(const f32x4*)(bp + 1024), u1 = *(const f32x4*)(bp + 1028);
        const f32x2 bg[4] = {(f32x2){g0[0], g0[1]}, (f32x2){g0[2], g0[3]}, (f32x2){g1[0], g1[1]}, (f32x2){g1[2], g1[3]}};
        const f32x2 bu[4] = {(f32x2){u0[0] + 1.f, u0[1] + 1.f}, (f32x2){u0[2] + 1.f, u0[3] + 1.f}, (f32x2){u1[0] + 1.f, u1[1] + 1.f}, (f32x2){u1[2] + 1.f, u1[3] + 1.f}};
#pragma unroll
        for (int ai = 0; ai < 2; ++ai)
#pragma unroll
            for (int m = 0; m < 4; ++m) { unsigned char* p = O + (size_t)(row0 + ai * 128 + m * 16) * FF + cc; f32x2 r[4];
#pragma unroll
                for (int h2 = 0; h2 < 4; ++h2) { const int n = h2 >> 1, j = (h2 & 1) * 2;
                    f32x2 gv = (f32x2){acc[ai][0][m][n][j], acc[ai][0][m][n][j + 1]} * W8_INV + bg[h2];
                    f32x2 uv = (f32x2){acc[ai][1][m][n][j], acc[ai][1][m][n][j + 1]} * W8_INV + bu[h2];
                    gv[0] = fminf(gv[0], 7.f); gv[1] = fminf(gv[1], 7.f); uv[0] = __builtin_amdgcn_fmed3f(uv[0], -6.f, 8.f); uv[1] = __builtin_amdgcn_fmed3f(uv[1], -6.f, 8.f);
                    const f32x2 t = gv * -2.45546695959f; f32x2 e; e[0] = __builtin_amdgcn_exp2f(t[0]); e[1] = __builtin_amdgcn_exp2f(t[1]);
                    e = e + 1.f; f32x2 sg; sg[0] = __builtin_amdgcn_rcpf(e[0]); sg[1] = __builtin_amdgcn_rcpf(e[1]);
                    r[h2] = (gv * sg) * uv; }
                u32x2 w; w.x = pk4_fp8_nc(r[0][0], r[0][1], r[1][0], r[1][1]); w.y = pk4_fp8_nc(r[2][0], r[2][1], r[3][0], r[3][1]); *(u32x2*)p = w; }
    }
};
#ifndef YB_FP8
#define YB_FP8 1
#endif
struct EpiDN8 {
    static constexpr bool PERM = true; bf16* O; const float* bd;
    DI void operator()(const Acc& acc, const pg8::Unit& u, int wr, int wc, int fr, int fq) const {
        const int row0 = u.pm * 256 + wr * 64 + fr, col0 = u.pn * 256 + wc * 32 + 8 * fq; const float* bp = bd + (size_t)u.e * 1024 + col0;
#pragma unroll
        for (int bj = 0; bj < 2; ++bj) { const f32x4 b0 = *(const f32x4*)(bp + bj * 128), b1 = *(const f32x4*)(bp + bj * 128 + 4);
#pragma unroll
            for (int ai = 0; ai < 2; ++ai)
#pragma unroll
                for (int m = 0; m < 4; ++m) { const size_t oo = (size_t)(row0 + ai * 128 + m * 16) * DM + col0 + bj * 128; const f32x4 v0 = acc[ai][bj][m][0] * W8_INV + b0, v1 = acc[ai][bj][m][1] * W8_INV + b1;
                    if (YB_FP8) { u32x2 w; w.x = pk4_fp8(v0[0], v0[1], v0[2], v0[3]); w.y = pk4_fp8(v1[0], v1[1], v1[2], v1[3]); *(u32x2*)((unsigned char*)O + oo) = w; }
                    else { u32x4 w; w.x = pk2(v0[0], v0[1]); w.y = pk2(v0[2], v0[3]); w.z = pk2(v1[0], v1[1]); w.w = pk2(v1[2], v1[3]); *(u32x4*)(O + oo) = w; } } }
    }
};
DI void tr_item(const float* src, int ld_src, int scol0, int nvalid, int k0, bf16* dst, int ld_dst, int drow0, int dk0, LAS float* scr, int lane) {
    const int n4 = (lane & 7) * 4, kr = lane >> 3; f32x4 v[8];
#pragma unroll
    for (int i = 0; i < 8; ++i) v[i] = (n4 < nvalid) ? *(const f32x4*)(src + (size_t)(k0 + kr + 8 * i) * ld_src + scol0 + n4) : (f32x4){0.f, 0.f, 0.f, 0.f};
#pragma unroll
    for (int i = 0; i < 8; ++i) { LAS float* s = scr + (kr + 8 * i) * 33 + n4; s[0] = v[i][0]; s[1] = v[i][1]; s[2] = v[i][2]; s[3] = v[i][3]; }
    asm volatile("s_waitcnt lgkmcnt(0)" ::: "memory");
    const int c = lane & 7;
#pragma unroll
    for (int jq = 0; jq < 4; ++jq) { const int n = (lane >> 3) + 8 * jq; const LAS float* s = scr + (8 * c) * 33 + n;
        u32x4 o; o.x = pk2(s[0 * 33], s[1 * 33]); o.y = pk2(s[2 * 33], s[3 * 33]); o.z = pk2(s[4 * 33], s[5 * 33]); o.w = pk2(s[6 * 33], s[7 * 33]);
        *(u32x4*)(dst + (size_t)(drow0 + n) * ld_dst + dk0 + k0 + 8 * c) = o; }
    asm volatile("s_waitcnt lgkmcnt(0)" ::: "memory");
}
DI void tr_item8(const float* src, int ld_src, int scol0, int k0, unsigned char* dst, int ld_dst, int drow0, LAS float* scr, int lane, int nvalid = 32) {
    const int n4 = (lane & 7) * 4, kr = lane >> 3; f32x4 v[8];
#pragma unroll
    for (int i = 0; i < 8; ++i) v[i] = (n4 < nvalid) ? *(const f32x4*)(src + (size_t)(k0 + kr + 8 * i) * ld_src + scol0 + n4) : (f32x4){0.f, 0.f, 0.f, 0.f};
#pragma unroll
    for (int i = 0; i < 8; ++i) { LAS float* s = scr + (kr + 8 * i) * 33 + n4; s[0] = v[i][0]; s[1] = v[i][1]; s[2] = v[i][2]; s[3] = v[i][3]; }
    asm volatile("s_waitcnt lgkmcnt(0)" ::: "memory");
    const int c = lane & 7;
#pragma unroll
    for (int jq = 0; jq < 4; ++jq) { const int n = (lane >> 3) + 8 * jq; const LAS float* s = scr + (8 * c) * 33 + n;
        u32x2 o; o.x = pk4_fp8(s[0 * 33] * W8_SCALE, s[1 * 33] * W8_SCALE, s[2 * 33] * W8_SCALE, s[3 * 33] * W8_SCALE); o.y = pk4_fp8(s[4 * 33] * W8_SCALE, s[5 * 33] * W8_SCALE, s[6 * 33] * W8_SCALE, s[7 * 33] * W8_SCALE);
        *(u32x2*)(dst + (size_t)(drow0 + n) * ld_dst + k0 + 8 * c) = o; }
    asm volatile("s_waitcnt lgkmcnt(0)" ::: "memory");
}
DI void conv_item(const Ctx& C, int l, int r, LAS float* scr) {
    constexpr int I_GU = 32 * 16 * 64;
    if (r < I_GU) { const int e = r / 1024, r2 = r % 1024, kb = r2 / 64, nb = r2 % 64, n0 = 32 * nb, j = n0 / 256, i = n0 % 256;
        const int scol0 = (i < 128) ? 128 * j + i : 1024 + 128 * j + (i - 128);
        tr_item8(C.w_gu + (size_t)(l * 32 + e) * 1024 * 2048, 2048, scol0, 64 * kb, WSP(unsigned char, WS_WGU) + (size_t)(l * 32 + e) * 2048 * 1024, 1024, n0, scr, C.lane); }
    else { r -= I_GU; const int e = r / 512, r2 = r % 512, kb = r2 / 32, nb = r2 % 32;
        tr_item8(C.w_down + (size_t)(l * 32 + e) * 1024 * 1024, 1024, 32 * nb, 64 * kb, WSP(unsigned char, WS_WDN) + (size_t)(l * 32 + e) * 1024 * 1024, 1024, 32 * nb, scr, C.lane); }
}
DI void conv_ticket(const Ctx& C0, int l, int tk) {
    Ctx C = C0; asm volatile("" : "+v"(C.lane), "+v"(C.tid));
    LAS float* scr = (LAS float*)(C.lds + C.wave * 16384);
    __syncthreads();
#pragma unroll 1
    for (int i = 0; i < 8; ++i) conv_item(C, l, tk * 64 + C.wave * 8 + i, scr);
}
DI void p0_prologue(const Ctx& C) {
    LAS float* scr = (LAS float*)(C.lds + C.wave * 16384);
    const int gw = C.bid * NWAVE + C.wave, NGW = C.G * NWAVE;
    constexpr int I_IN = 16 * 104, I_OUT = 16 * 32, I_LW = 8, I_LA = 8, I_LG = 16, I_K1 = 256, I_K2 = 8;
    constexpr int I_LAYER = I_IN + I_OUT + I_LW + I_LA + I_LG + 2 * I_K1 + 2 * I_K2;
    for (int it = gw; it < NLAYER * I_LAYER; it += NGW) {
        const int l = it / I_LAYER; int r = it % I_LAYER;
        if (r < I_IN) { const int kb = r / 104, nb = r % 104, n0 = 32 * nb; int nv = 3212 - n0; nv = nv < 0 ? 0 : (nv > 32 ? 32 : nv);
            if (INPROJ_FP8) tr_item8(C.w_in + (size_t)l * 1024 * 3212, 3212, n0, 64 * kb, WSP(unsigned char, WS_WIN) + (size_t)l * NPJ * 1024, 1024, n0, scr, C.lane, nv);
            else tr_item(C.w_in + (size_t)l * 1024 * 3212, 3212, n0, nv, 64 * kb, WSP(bf16, WS_WIN) + (size_t)l * NPJ * 1024, 1024, n0, 0, scr, C.lane); continue; } r -= I_IN;
        if (r < I_OUT) { const int kb = r / 32, nb = r % 32;
            tr_item(C.w_out + (size_t)l * 1024 * 1024, 1024, 32 * nb, 32, 64 * kb, WSP(bf16, WS_WOUT) + (size_t)l * 1024 * 1024, 1024, 32 * nb, 0, scr, C.lane); continue; } r -= I_OUT;
        bf16* lora = WSP(bf16, WS_LORA) + (size_t)l * 768 * 256;
        if (r < I_LW) { tr_item(C.w2 + (size_t)l * 64 * 256, 256, 32 * r, 32, 0, lora, 256, 32 * r, 0, scr, C.lane); continue; } r -= I_LW;
        if (r < I_LA) { tr_item(C.a2 + (size_t)l * 64 * 256, 256, 32 * r, 32, 0, lora, 256, 256 + 32 * r, 64, scr, C.lane); continue; } r -= I_LA;
        if (r < I_LG) { const int kb = r / 8, nb = r % 8; tr_item(C.g2 + (size_t)l * 128 * 256, 256, 32 * nb, 32, 64 * kb, lora, 256, 512 + 32 * nb, 128, scr, C.lane); continue; } r -= I_LG;
        if (r < 2 * I_K1) { const int kv = r / I_K1, r2 = r % I_K1, kb = r2 / 8, nb = r2 % 8;
            tr_item((kv ? C.wv1 : C.wk1) + (size_t)l * 2048 * 256, 256, 32 * nb, 32, 64 * kb, WSP(bf16, WS_WK1) + (size_t)(l * 2 + kv) * 256 * 2048, 2048, 32 * nb, 0, scr, C.lane); continue; } r -= 2 * I_K1;
        { const int kv = r / I_K2, r2 = r % I_K2, kb = r2 / 2, nb = r2 % 2;
            tr_item((kv ? C.wv2 : C.wk2) + (size_t)l * 256 * 64, 64, 32 * nb, 32, 64 * kb, WSP(bf16, WS_WK2) + (size_t)(l * 2 + kv) * 256 * 256, 256, 32 * nb, 0, scr, C.lane); }
    }
    { int* idm = WSP(int, WS_ROUTE) + NT * 12 + NR; for (int i = C.bid * NTHR + C.tid; i < NR; i += C.G * NTHR) idm[i] = i; }
    __syncthreads();
    float* MOD = WSP(float, WS_SMALL); float* PEB = MOD + NLAYER * 8 * 6144;
    LAS float* sc = (LAS float*)C.lds;
    LAS float* red = sc + 8192;
    for (int it = C.bid; it < 192 + 32; it += C.G) {
        if (it < 192) {
            const int l = it / 96, n0 = (it % 96) * 64;
            for (int i = C.tid; i < 8192; i += NTHR) { const float v = C.c[i]; sc[i] = v * fsigmoid(v); }
            __syncthreads();
            const int kq = C.tid >> 6, col = C.tid & 63; float a[8];
#pragma unroll
            for (int b = 0; b < 8; ++b) a[b] = 0.f;
            const float* wp = C.w_ada + (size_t)l * 1024 * 6144 + n0 + col;
#pragma unroll 32
            for (int k = kq * 128; k < kq * 128 + 128; ++k) { const float w = wp[(size_t)k * 6144];
#pragma unroll
                for (int b = 0; b < 8; ++b) a[b] += sc[b * 1024 + k] * w; }
#pragma unroll
            for (int b = 0; b < 8; ++b) red[(kq * 8 + b) * 64 + col] = a[b];
            __syncthreads();
            { const int b = C.tid >> 6; float s = C.b_ada[(size_t)l * 6144 + n0 + col];
#pragma unroll
              for (int q = 0; q < 8; ++q) s += red[(q * 8 + b) * 64 + col];
              MOD[((size_t)l * 8 + b) * 6144 + n0 + col] = s; }
            __syncthreads();
        } else {
            const int r = it - 192, l = r >> 4, kv = (r >> 3) & 1, c0 = (r & 7) * 32; const float* pe = (kv ? C.pe_v : C.pe_k) + (size_t)l * 2048; const float* w1 = (kv ? C.wv1 : C.wk1) + (size_t)l * 2048 * 256;
            const int kq = C.tid >> 5, col = C.tid & 31; float a = 0.f;
#pragma unroll 16
            for (int k = kq * 128; k < kq * 128 + 128; ++k) a += pe[k] * w1[(size_t)k * 256 + c0 + col];
            red[kq * 32 + col] = a; __syncthreads();
            if (C.tid < 32) { float s = 0.f;
#pragma unroll
                for (int q = 0; q < 16; ++q) s += red[q * 32 + C.tid];
                PEB[(l * 2 + kv) * 256 + c0 + C.tid] = s; }
            __syncthreads();
        }
    }
}

DI void norm_row(const Ctx& C, const float* __restrict__ xrow, const float* __restrict__ g, const float* __restrict__ sh, const float* __restrict__ sc, bf16* __restrict__ orow) {
    f32x4 v[4]; float s = 0.f;
#pragma unroll
    for (int j = 0; j < 4; ++j) { v[j] = *(const f32x4*)(xrow + 4 * C.lane + 256 * j); s += (v[j][0] * v[j][0] + v[j][1] * v[j][1]) + (v[j][2] * v[j][2] + v[j][3] * v[j][3]); }
    s = group_sum<64>(s); const float rstd = rsqrtf(s * (1.f / DM) + 1e-6f);
#pragma unroll
    for (int j = 0; j < 4; ++j) { const int k = 4 * C.lane + 256 * j; const f32x4 gg = *(const f32x4*)(g + k), a = *(const f32x4*)(sc + k), b = *(const f32x4*)(sh + k); f32x4 h;
#pragma unroll
        for (int i = 0; i < 4; ++i) h[i] = v[j][i] * rstd * gg[i] * (1.f + a[i]) + b[i];
        if (INPROJ_FP8) *(unsigned*)((unsigned char*)orow + k) = pk4_fp8(h[0], h[1], h[2], h[3]);
        else { u32x2 o; o.x = pk2(h[0], h[1]); o.y = pk2(h[2], h[3]); *(u32x2*)(orow + k) = o; } }
}
DI void norm1_phase(const Ctx& C, int l, const float* xin) {
    const float* MOD = WSP(float, WS_SMALL) + (size_t)l * 8 * 6144; bf16* H = WSP(bf16, WS_H);
    const int gw = C.bid * NWAVE + C.wave, NGW = C.G * NWAVE;
    for (int m = gw; m < NT; m += NGW) { const int b = m / NS; norm_row(C, xin + (size_t)m * DM, C.norm1_g + l * DM, MOD + b * 6144, MOD + b * 6144 + 1024, INPROJ_FP8 ? (bf16*)((unsigned char*)H + (size_t)m * DM) : H + (size_t)m * DM); }
}

constexpr float QSCALE = 0.125f * 1.44269504089f;
DI void prep_body(const Ctx& C, int l, const bf16* __restrict__ PROJ, bf16* __restrict__ SCH, bf16* __restrict__ LIN, bf16* __restrict__ YCAT, bf16* __restrict__ QC, bf16* __restrict__ KC, bf16* __restrict__ QN, bf16* __restrict__ QR,
                  bf16* __restrict__ KCR, bf16* __restrict__ VCR, bf16* __restrict__ KS, bf16* __restrict__ KW, float* __restrict__ GATE) {
    const int lane = C.lane, gw = C.bid * NWAVE + C.wave, NGW = C.G * NWAVE;
    const int hh = lane >> 4, jj = lane & 15;
    const float inv0 = exp2f(-(float)(2 * jj) * (13.287712379549449f / 32.f)) * 0.15915494309189535f, inv1 = exp2f(-(float)(2 * jj + 1) * (13.287712379549449f / 32.f)) * 0.15915494309189535f;
    for (int task = gw; task < NT / 16; task += NGW) {
        const int row0 = 16 * task, s0 = row0 % NS;
        {
            const int c0 = 16 * lane, cc = (c0 - 256) & 255; float mu16[16], kw16[16];
#pragma unroll
            for (int q = 0; q < 4; ++q) { const f32x4 m4 = *(const f32x4*)(C.mu + (size_t)l * 1024 + c0 + 4 * q), k4 = *(const f32x4*)(C.kkw + (size_t)l * 256 + cc + 4 * q);
#pragma unroll
                for (int i = 0; i < 4; ++i) { mu16[4 * q + i] = m4[i]; kw16[4 * q + i] = k4[i]; } }
#pragma unroll 2
            for (int r = 0; r < 16; ++r) {
                const int row = row0 + r; const bf16* pr = PROJ + (size_t)row * NPJ; float z[16];
                const u32x4 c0v = *(const u32x4*)(pr + c0), c1v = *(const u32x4*)(pr + c0 + 8);
                u32x4 p0v = (u32x4){0u, 0u, 0u, 0u}, p1v = p0v;
                if (s0 + r > 0) { p0v = *(const u32x4*)(pr - NPJ + c0); p1v = *(const u32x4*)(pr - NPJ + c0 + 8); }
                const unsigned cw[8] = {c0v.x, c0v.y, c0v.z, c0v.w, c1v.x, c1v.y, c1v.z, c1v.w}, pw[8] = {p0v.x, p0v.y, p0v.z, p0v.w, p1v.x, p1v.y, p1v.z, p1v.w};
#pragma unroll
                for (int e = 0; e < 16; ++e) { const float cu = (e & 1) ? bfhi(cw[e >> 1]) : bflo(cw[e >> 1]), pv = (e & 1) ? bfhi(pw[e >> 1]) : bflo(pw[e >> 1]); z[e] = cu + (pv - cu) * mu16[e]; }
                float kk[16]; float ss = 0.f;
#pragma unroll
                for (int e = 0; e < 16; ++e) { kk[e] = z[e] * kw16[e]; ss += kk[e] * kk[e]; }
                ss = group_sum<4>(ss); const float kinv = rsqrtf(ss + 1e-12f);
                if (lane < 48) {
                    const int pl = lane < 16 ? 3 : (lane < 32 ? 0 : 4); bf16* dst = SCH + ((size_t)pl * NT + row) * 256 + (c0 & 255);
                    u32x4 o0, o1; o0.x = pk2(z[0], z[1]); o0.y = pk2(z[2], z[3]); o0.z = pk2(z[4], z[5]); o0.w = pk2(z[6], z[7]); o1.x = pk2(z[8], z[9]); o1.y = pk2(z[10], z[11]); o1.z = pk2(z[12], z[13]); o1.w = pk2(z[14], z[15]);
                    *(u32x4*)dst = o0; *(u32x4*)(dst + 8) = o1;
                    if (lane >= 16 && lane < 32) { bf16* d2 = SCH + ((size_t)1 * NT + row) * 256 + cc;
                        u32x4 q0, q1; q0.x = pk2(kk[0] * kinv, kk[1] * kinv); q0.y = pk2(kk[2] * kinv, kk[3] * kinv); q0.z = pk2(kk[4] * kinv, kk[5] * kinv); q0.w = pk2(kk[6] * kinv, kk[7] * kinv);
                        q1.x = pk2(kk[8] * kinv, kk[9] * kinv); q1.y = pk2(kk[10] * kinv, kk[11] * kinv); q1.z = pk2(kk[12] * kinv, kk[13] * kinv); q1.w = pk2(kk[14] * kinv, kk[15] * kinv);
                        *(u32x4*)d2 = q0; *(u32x4*)(d2 + 8) = q1; }
                } else {
                    float t[16];
#pragma unroll
                    for (int i = 0; i < 16; ++i) { const float sg = fsigmoid(lane < 52 ? 2.f * z[i] : z[i]); t[i] = lane < 52 ? 2.f * sg - 1.f : (lane < 56 ? z[i] : sg); }
                    bf16* dst = LIN + (size_t)row * 256 + (c0 - 768);
                    u32x4 o0, o1; o0.x = pk2(t[0], t[1]); o0.y = pk2(t[2], t[3]); o0.z = pk2(t[4], t[5]); o0.w = pk2(t[6], t[7]); o1.x = pk2(t[8], t[9]); o1.y = pk2(t[10], t[11]); o1.z = pk2(t[12], t[13]); o1.w = pk2(t[14], t[15]);
                    *(u32x4*)dst = o0; *(u32x4*)(dst + 8) = o1;
                }
            }
        }
        {
            const int ch = 4 * lane; const float* cw = C.conv_w + (size_t)l * 3 * 256 + ch; const f32x4 w0 = *(const f32x4*)cw, w1 = *(const f32x4*)(cw + 256), w2 = *(const f32x4*)(cw + 512);
            const f32x4 og = *(const f32x4*)(C.onorm_g + (size_t)l * 768 + ch);
#pragma unroll 2
            for (int r = 0; r < 16; ++r) {
                const int row = row0 + r, s = s0 + r; const bf16* pr = PROJ + (size_t)row * NPJ; float u[3][4];
#pragma unroll
                for (int d = 0; d < 3; ++d) {
                    u32x2 cg = (u32x2){0u, 0u}, xi = cg;
                    if (s >= d) { cg = *(const u32x2*)(pr - (size_t)d * NPJ + PJ_B + 256 + ch); xi = *(const u32x2*)(pr - (size_t)d * NPJ + PJ_B + 512 + ch); }
                    u[d][0] = bflo(cg.x) * bflo(xi.x); u[d][1] = bfhi(cg.x) * bfhi(xi.x); u[d][2] = bflo(cg.y) * bflo(xi.y); u[d][3] = bfhi(cg.y) * bfhi(xi.y);
                }
                const u32x2 bgv = *(const u32x2*)(pr + PJ_B + ch); const float bg[4] = {bflo(bgv.x), bfhi(bgv.x), bflo(bgv.y), bfhi(bgv.y)};
                float y[4]; float ss = 0.f;
#pragma unroll
                for (int i = 0; i < 4; ++i) { y[i] = bg[i] * (w0[i] * u[2][i] + w1[i] * u[1][i] + w2[i] * u[0][i]); ss += y[i] * y[i]; }
                ss = group_sum<16>(ss); const float rstd = rsqrtf(ss * (1.f / 64.f) + 1e-6f);
                u32x2 o; o.x = pk2(y[0] * rstd * og[0], y[1] * rstd * og[1]); o.y = pk2(y[2] * rstd * og[2], y[3] * rstd * og[3]);
                *(u32x2*)(YCAT + (size_t)row * DM + 256 + ch) = o;
            }
        }
        {
            const float* gq = C.dil_q_g + (size_t)l * 64; const float* gk = C.dil_k_g + (size_t)l * 64; const float* gn = C.nsa_q_g + (size_t)l * 64; const float* gv = (hh == 0 ? C.nsa_ks_g : C.nsa_kw_g) + (size_t)l * 64;
            float Gq[4], Gk[4], Gn[4], Gv[4];
#pragma unroll
            for (int i = 0; i < 4; ++i) { const int d = (i >> 1) * 32 + 2 * jj + (i & 1); Gq[i] = gq[d] * QSCALE; Gk[i] = gk[d]; Gn[i] = gn[d] * QSCALE; Gv[i] = gv[d]; }
            const int vcol = hh == 0 ? 2944 : (hh == 1 ? 3072 : (hh == 2 ? 2816 : 2880));
            bf16* vdst = (hh == 0 ? KS : (hh == 1 ? KW : (hh == 2 ? KCR : VCR)));
#pragma unroll 2
            for (int r = 0; r < 16; ++r) {
                const int row = row0 + r; const bf16* pr = PROJ + (size_t)row * NPJ;
                const float posf = (float)C.pos[row];
                const float x0 = __builtin_amdgcn_fractf(posf * inv0), x1 = __builtin_amdgcn_fractf(posf * inv1);
                const float sn0 = __builtin_amdgcn_sinf(x0), cs0 = __builtin_amdgcn_cosf(x0), sn1 = __builtin_amdgcn_sinf(x1), cs1 = __builtin_amdgcn_cosf(x1);
                const unsigned qa = *(const unsigned*)(pr + PJ_C + hh * 64 + 2 * jj), qb = *(const unsigned*)(pr + PJ_C + hh * 64 + 32 + 2 * jj);
                const unsigned ka = *(const unsigned*)(pr + PJ_C + 256 + hh * 64 + 2 * jj), kb = *(const unsigned*)(pr + PJ_C + 256 + hh * 64 + 32 + 2 * jj);
                const unsigned na = *(const unsigned*)(pr + PJ_D + hh * 64 + 2 * jj), nb = *(const unsigned*)(pr + PJ_D + hh * 64 + 32 + 2 * jj);
                const unsigned va = *(const unsigned*)(pr + vcol + 2 * jj), vb = *(const unsigned*)(pr + vcol + 32 + 2 * jj);
                float gate_in = 0.f; if (lane < 12) gate_in = bf2f(pr[3200 + lane]);
#define ROPE_NORM(a, b, G, o1, o2, n1a, n1b, n2a, n2b) \
                float n1a = bflo(a), n1b = bfhi(a), n2a = bflo(b), n2b = bfhi(b); { const float ss_ = group_sum<16>(n1a * n1a + n1b * n1b + n2a * n2a + n2b * n2b); const float rs_ = rsqrtf(ss_ * (1.f / 64.f) + 1e-6f); \
                    n1a *= rs_ * G[0]; n1b *= rs_ * G[1]; n2a *= rs_ * G[2]; n2b *= rs_ * G[3]; } \
                const unsigned o1 = pk2(n1a * cs0 - n2a * sn0, n1b * cs1 - n2b * sn1), o2 = pk2(n2a * cs0 + n1a * sn0, n2b * cs1 + n1b * sn1);
                ROPE_NORM(qa, qb, Gq, q1, q2, q1a, q1b, q2a, q2b)
                ROPE_NORM(ka, kb, Gk, k1, k2, k1a, k1b, k2a, k2b)
                ROPE_NORM(na, nb, Gn, r1, r2, r1a, r1b, r2a, r2b)
                ROPE_NORM(va, vb, Gv, v1, v2, v1a, v1b, v2a, v2b)
#undef ROPE_NORM
                bf16* o = QC + (size_t)row * 256 + hh * 64 + 2 * jj; *(unsigned*)o = q1; *(unsigned*)(o + 32) = q2;
                o = KC + (size_t)row * 256 + hh * 64 + 2 * jj; *(unsigned*)o = k1; *(unsigned*)(o + 32) = k2;
                o = QN + (size_t)row * 256 + hh * 64 + 2 * jj; *(unsigned*)o = pk2(r1a, r1b); *(unsigned*)(o + 32) = pk2(r2a, r2b);
                o = QR + (size_t)row * 256 + hh * 64 + 2 * jj; *(unsigned*)o = r1; *(unsigned*)(o + 32) = r2;
                o = vdst + (size_t)row * 64 + 2 * jj; *(unsigned*)o = (hh >= 2) ? va : v1; *(unsigned*)(o + 32) = (hh >= 2) ? vb : v2;
                if (lane < 12) GATE[(size_t)row * 12 + lane] = fsigmoid(gate_in);
            }
        }
    }
}
DI void prep_phase(const Ctx& C, int l) {
    prep_body(C, l, WSP(bf16, R_PROJ), WSP(bf16, R_SCH), WSP(bf16, R_LIN), WSP(bf16, R_YCAT), WSP(bf16, R_QC), WSP(bf16, R_KC), WSP(bf16, R_QN), WSP(bf16, R_QR), WSP(bf16, R_KCR), WSP(bf16, R_VCR), WSP(bf16, R_KS), WSP(bf16, R_KW), WSP(float, R_GATE));
}
constexpr int SCAN_TC = 16;
DI void scan_unit8(const Ctx& C, int u) {
    const float* Wp = WSP(float, R_SC); const bf16* SCH = WSP(bf16, R_SCH); float* YA = WSP(float, R_YA); float* UB = WSP(float, R_SCANU); float* SMT = WSP(float, R_SCANS);
    const int pair = u / 3, kind = u % 3, b = pair >> 2, h = pair & 3, tid = C.tid;
    LAS float* buf = (LAS float*)C.lds;
    LAS float* ybuf = buf + 2 * 6144;
    const int row = tid >> 3, cg = tid & 7, tbase = kind == 0 ? 0 : NS / 2;
    const float vm = kind == 2 ? 0.f : 1.f;
    u32x4 ldA[2], ldB[2];
#define SCAN_LOAD(ld, chunk) do { _Pragma("unroll") for (int i = 0; i < 2; ++i) { const int p_ = tid + 512 * i; if (p_ < 896) { const int step = p_ / 56, r_ = p_ % 56; const size_t row_ = (size_t)b * NS + tbase + (chunk) * SCAN_TC + step; \
        if (r_ < 16) ld[i] = *(const u32x4*)(Wp + row_ * 256 + h * 64 + r_ * 4); else { const int v5 = (r_ - 16) >> 3, c_ = (r_ - 16) & 7; ld[i] = *(const u32x4*)(SCH + ((size_t)v5 * NT + row_) * 256 + h * 64 + c_ * 8); } } } } while (0)
#define SCAN_STORE(ld, slot) do { _Pragma("unroll") for (int i = 0; i < 2; ++i) { const int p_ = tid + 512 * i; if (p_ < 896) { const int step = p_ / 56, r_ = p_ % 56; LAS float* d_ = buf + (slot) * 6144 + step * 384; \
        if (r_ < 16) *(LAS u32x4*)(d_ + r_ * 4) = ld[i]; else { const int v5 = (r_ - 16) >> 3, c_ = (r_ - 16) & 7; LAS float* e_ = d_ + (1 + v5) * 64 + c_ * 8; const u32x4 x_ = ld[i]; \
            *(LAS f32x4*)e_ = (f32x4){bflo(x_.x), bfhi(x_.x), bflo(x_.y), bfhi(x_.y)}; *(LAS f32x4*)(e_ + 4) = (f32x4){bflo(x_.z), bfhi(x_.z), bflo(x_.w), bfhi(x_.w)}; } } } } while (0)
#define SCAN_FLUSH(chunk) do { _Pragma("unroll") for (int i = 0; i < 2; ++i) { const int i2 = tid + 512 * i, step = i2 >> 6, rr = i2 & 63; const LAS float* pp_ = ybuf + ((chunk) & 1) * 8192 + step * 512 + rr * 8; \
        const f32x4 pa_ = *(const LAS f32x4*)pp_, pb_ = *(const LAS f32x4*)(pp_ + 4); const float yv = ((pa_[0] + pa_[1]) + (pa_[2] + pa_[3])) + ((pb_[0] + pb_[1]) + (pb_[2] + pb_[3])); \
        if (kind == 2) UB[((size_t)b * (NS / 2) + (chunk) * SCAN_TC + step) * 256 + h * 64 + rr] = yv; else YA[((size_t)b * NS + tbase + (chunk) * SCAN_TC + step) * 256 + h * 64 + rr] = yv; } } while (0)
    __syncthreads();
    SCAN_LOAD(ldA, 0); SCAN_STORE(ldA, 0); SCAN_LOAD(ldB, 1); SCAN_LOAD(ldA, 2);
    f32x2 S[4];
#pragma unroll
    for (int c = 0; c < 4; ++c) { S[c][0] = (kind == 2 && row == 8 * cg + 2 * c) ? 1.f : 0.f; S[c][1] = (kind == 2 && row == 8 * cg + 2 * c + 1) ? 1.f : 0.f; }
    constexpr int NCH = (NS / 2) / SCAN_TC;
#pragma unroll 2
    for (int ck = 0; ck < NCH; ++ck) {
        __syncthreads();
        if (ck & 1) { if (ck + 1 < NCH) SCAN_STORE(ldA, (ck + 1) & 1); if (ck + 3 < NCH) SCAN_LOAD(ldA, ck + 3); }
        else        { if (ck + 1 < NCH) SCAN_STORE(ldB, (ck + 1) & 1); if (ck + 3 < NCH) SCAN_LOAD(ldB, ck + 3); }
        {
            const LAS float* bp = buf + (ck & 1) * 6144; LAS float* yb = ybuf + (ck & 1) * 8192 + tid;
#define SCAN_LDS(X, step) do { const LAS float* sp = bp + (step) * 384 + 8 * cg; X.w0 = *(const LAS f32x4*)(sp); X.w1 = *(const LAS f32x4*)(sp + 4); X.k0 = *(const LAS f32x4*)(sp + 64); X.k1 = *(const LAS f32x4*)(sp + 68); \
                X.q0 = *(const LAS f32x4*)(sp + 128); X.q1 = *(const LAS f32x4*)(sp + 132); X.b0 = *(const LAS f32x4*)(sp + 192); X.b1 = *(const LAS f32x4*)(sp + 196); \
                X.r0 = *(const LAS f32x4*)(sp + 256); X.r1 = *(const LAS f32x4*)(sp + 260); X.v = bp[(step) * 384 + 320 + row] * vm; } while (0)
#define SCAN_STEP(X, step) do { \
                f32x2 d2 = S[0] * (f32x2){X.q0[0], X.q0[1]}; d2 = S[1] * (f32x2){X.q0[2], X.q0[3]} + d2; d2 = S[2] * (f32x2){X.q1[0], X.q1[1]} + d2; d2 = S[3] * (f32x2){X.q1[2], X.q1[3]} + d2; \
                const float sa = -sum8(d2[0] + d2[1]); const f32x2 sa2 = (f32x2){sa, sa}, v2 = (f32x2){X.v, X.v}; \
                S[0] = S[0] * (f32x2){X.w0[0], X.w0[1]} + (sa2 * (f32x2){X.b0[0], X.b0[1]} + v2 * (f32x2){X.k0[0], X.k0[1]}); \
                S[1] = S[1] * (f32x2){X.w0[2], X.w0[3]} + (sa2 * (f32x2){X.b0[2], X.b0[3]} + v2 * (f32x2){X.k0[2], X.k0[3]}); \
                S[2] = S[2] * (f32x2){X.w1[0], X.w1[1]} + (sa2 * (f32x2){X.b1[0], X.b1[1]} + v2 * (f32x2){X.k1[0], X.k1[1]}); \
                S[3] = S[3] * (f32x2){X.w1[2], X.w1[3]} + (sa2 * (f32x2){X.b1[2], X.b1[3]} + v2 * (f32x2){X.k1[2], X.k1[3]}); \
                f32x2 y2 = S[0] * (f32x2){X.r0[0], X.r0[1]}; y2 = S[1] * (f32x2){X.r0[2], X.r0[3]} + y2; y2 = S[2] * (f32x2){X.r1[0], X.r1[1]} + y2; y2 = S[3] * (f32x2){X.r1[2], X.r1[3]} + y2; \
                yb[(step) * 512] = y2[0] + y2[1]; } while (0)
            struct StepIn { f32x4 w0, w1, k0, k1, q0, q1, b0, b1, r0, r1; float v; } A, B;
            SCAN_LDS(A, 0);
#pragma unroll 2
            for (int step = 0; step < SCAN_TC; step += 2) {
                SCAN_LDS(B, step + 1);
                __builtin_amdgcn_sched_barrier(0);
                SCAN_STEP(A, step);
                __builtin_amdgcn_sched_barrier(0);
                if (step + 2 < SCAN_TC) SCAN_LDS(A, step + 2);
                __builtin_amdgcn_sched_barrier(0);
                SCAN_STEP(B, step + 1);
                __builtin_amdgcn_sched_barrier(0);
            }
#undef SCAN_LDS
#undef SCAN_STEP
        }
        if (ck > 0) SCAN_FLUSH(ck - 1);
    }
    __syncthreads();
    SCAN_FLUSH(NCH - 1);
    if (kind == 0) {
        float* o = SMT + (size_t)pair * 4096 + row;
#pragma unroll
        for (int c = 0; c < 4; ++c) { o[(8 * cg + 2 * c) * 64] = S[c][0]; o[(8 * cg + 2 * c + 1) * 64] = S[c][1]; }
    }
#undef SCAN_LOAD
#undef SCAN_STORE
#undef SCAN_FLUSH
    __syncthreads();
}

constexpr int KROW = 144, KT_BYTES = 64 * KROW;
#define MFMA16(a, b, c) __builtin_amdgcn_mfma_f32_16x16x32_bf16((a), (b), (c), 0, 0, 0)
template <int NQT> struct FA { f32x4 O[NQT][4]; float l[NQT]; float negM; };
template <int NQT> DI void fa_init(FA<NQT>& st) {
#pragma unroll
    for (int q = 0; q < NQT; ++q) { st.l[q] = 0.f;
#pragma unroll
        for (int d = 0; d < 4; ++d) st.O[q][d] = (f32x4){0.f, 0.f, 0.f, 0.f}; }
}
DI bf16x8 pack8(const f32x4& a, const f32x4& b) { u32x4 w; w.x = pk2(a[0], a[1]); w.y = pk2(a[2], a[3]); w.z = pk2(b[0], b[1]); w.w = pk2(b[2], b[3]); return __builtin_bit_cast(bf16x8, w); }
struct VFrag { u32x2 a[4], b[4]; };
DI void vt_issue(VFrag& f, unsigned vaddr) {
    asm volatile("ds_read_b64_tr_b16 %0, %8\n\tds_read_b64_tr_b16 %1, %8 offset:2304\n\tds_read_b64_tr_b16 %2, %8 offset:32\n\tds_read_b64_tr_b16 %3, %8 offset:2336\n\t"
                 "ds_read_b64_tr_b16 %4, %8 offset:64\n\tds_read_b64_tr_b16 %5, %8 offset:2368\n\tds_read_b64_tr_b16 %6, %8 offset:96\n\tds_read_b64_tr_b16 %7, %8 offset:2400"
                 : "=&v"(f.a[0]), "=&v"(f.b[0]), "=&v"(f.a[1]), "=&v"(f.b[1]), "=&v"(f.a[2]), "=&v"(f.b[2]), "=&v"(f.a[3]), "=&v"(f.b[3]) : "v"(vaddr) : "memory");
}
DI void vt_wait(VFrag& f) { asm volatile("s_waitcnt lgkmcnt(0)" : "+v"(f.a[0]), "+v"(f.b[0]), "+v"(f.a[1]), "+v"(f.b[1]), "+v"(f.a[2]), "+v"(f.b[2]), "+v"(f.a[3]), "+v"(f.b[3]) :: "memory"); }
DI bf16x8 vt_get(const VFrag& f, int d) { return __builtin_bit_cast(bf16x8, ((u32x4){f.a[d].x, f.a[d].y, f.b[d].x, f.b[d].y})); }
template <int NQT, bool MASKED, class MaskF>
DI void fa_tile(FA<NQT>& st, const bf16x8 (&Q)[NQT][2], const LAS uchar* Ks, const LAS uchar* Vs, int lane, const MaskF& allowed, const bool (&act)[NQT]) {
    const int l15 = lane & 15, quad = lane >> 4;
    float nm_ = st.negM; asm volatile("" : "+v"(nm_));
    f32x4 S[NQT][4]; const f32x4 sinit = (f32x4){nm_, nm_, nm_, nm_};
#pragma unroll
    for (int kt = 0; kt < 4; ++kt) {
        const bf16x8 k0 = *(const LAS bf16x8*)(Ks + (16 * kt + l15) * KROW + quad * 16), k1 = *(const LAS bf16x8*)(Ks + (16 * kt + l15) * KROW + 64 + quad * 16);
#pragma unroll
        for (int q = 0; q < NQT; ++q) if (act[q]) { S[q][kt] = MFMA16(k0, Q[q][0], sinit); S[q][kt] = MFMA16(k1, Q[q][1], S[q][kt]); }
    }
    const unsigned vaddr = (unsigned)(size_t)(Vs + (4 * quad + (l15 >> 2)) * KROW + 8 * (l15 & 3));
    VFrag v0, v1; vt_issue(v0, vaddr);
#pragma unroll
    for (int q = 0; q < NQT; ++q) if (act[q]) {
        float rs = 0.f;
#pragma unroll
        for (int kt = 0; kt < 4; ++kt)
#pragma unroll
            for (int j = 0; j < 4; ++j) { float p = fexp2(S[q][kt][j]); if (MASKED) p = allowed(q, 16 * kt + 4 * quad + j) ? p : 0.f; S[q][kt][j] = p; rs += p; }
        st.l[q] += rs;
    }
    vt_wait(v0); vt_issue(v1, vaddr + 32 * KROW);
#pragma unroll
    for (int q = 0; q < NQT; ++q) if (act[q]) {
        const bf16x8 p0 = pack8(S[q][0], S[q][1]);
#pragma unroll
        for (int d = 0; d < 4; ++d) st.O[q][d] = MFMA16(vt_get(v0, d), p0, st.O[q][d]);
    }
    vt_wait(v1);
#pragma unroll
    for (int q = 0; q < NQT; ++q) if (act[q]) {
        const bf16x8 p1 = pack8(S[q][2], S[q][3]);
#pragma unroll
        for (int d = 0; d < 4; ++d) st.O[q][d] = MFMA16(vt_get(v1, d), p1, st.O[q][d]);
    }
}
template <int NQT> DI void fa_finish(FA<NQT>& st, float (&lse2)[NQT]) {
#pragma unroll
    for (int q = 0; q < NQT; ++q) { float l = st.l[q]; l += __shfl_xor(l, 16); l += __shfl_xor(l, 32); const float inv = l > 0.f ? 1.f / l : 0.f; lse2[q] = __log2f(fmaxf(l, 1e-37f));
#pragma unroll
        for (int d = 0; d < 4; ++d) st.O[q][d] = st.O[q][d] * inv; }
}
DI float score_bound(const float* gq, const float* gk, int lane) {
    float a = fabsf(gq[lane & 63]), b = fabsf(gk[lane & 63]);
#pragma unroll
    for (int o = 1; o < 64; o <<= 1) { a = fmaxf(a, __shfl_xor(a, o)); b = fmaxf(b, __shfl_xor(b, o)); }
    return __builtin_bit_cast(float, __builtin_amdgcn_readfirstlane(__builtin_bit_cast(int, 64.f * a * b * QSCALE * 1.02f + 0.5f)));
}
DI void kv_store(LAS uchar* Ks, LAS uchar* Vs, int tid, const u32x4& kr, const u32x4& vr) {
    const int o = (tid >> 3) * KROW + (tid & 7) * 16; *(LAS u32x4*)(Ks + o) = kr; *(LAS u32x4*)(Vs + o) = vr;
}
DI void q_load(bf16x8 (&Q)[2], const bf16* qrow, int quad) { Q[0] = *(const bf16x8*)(qrow + 8 * quad); Q[1] = *(const bf16x8*)(qrow + 32 + 8 * quad); }

struct DilMask { int qi[2]; int k0; DI bool operator()(int q, int key) const { const int ki = k0 + key, d = qi[q] - ki; return ki >= 0 && (unsigned)d <= 128u; } };
DI void dil_unit(const Ctx& C, int unit, LAS uchar* lds0, LAS uchar*  , float negM_bound) {
    const bf16 *QC = WSP(bf16, R_QC), *KC = WSP(bf16, R_KC), *PROJ = WSP(bf16, R_PROJ); float* OC = WSP(float, R_OC); float* LSE = WSP(float, R_LSE);
    int tid = C.tid, lane = C.lane; asm volatile("" : "+v"(tid), "+v"(lane));
    const int w = C.wave, l15 = lane & 15, quad = lane >> 4, wq = w & 3;
    const int cfg = unit / 512, r = unit % 512, dsh = 2 * cfg, d = 1 << dsh;
    const int b = r >> 6, hp = (r >> 5) & 1, r2 = r & 31;
    const int nblk = 32 >> dsh, res = r2 / nblk, blk = r2 % nblk, i0 = blk * 128, h = 2 * hp + (w >> 2);
    const size_t tb = (size_t)b * NS;
    bf16x8 Q[2][2]; DilMask mk; FA<2> st; fa_init(st); st.negM = -negM_bound;
#pragma unroll
    for (int q = 0; q < 2; ++q) { mk.qi[q] = i0 + 32 * wq + 16 * q + l15; q_load(Q[q], QC + (tb + res + (size_t)d * mk.qi[q]) * 256 + h * 64, quad); }
    const int jlo = wq >> 1, jhi = (wq >> 1) + 2;
    const bool act[2] = {true, true};
    u32x4 kr0, vr0, kr1, vr1;
#define DIL_LOAD(j) do { const int ki = i0 - 128 + 64 * (j) + (tid >> 3); kr0 = (u32x4){0u, 0u, 0u, 0u}; vr0 = kr0; kr1 = kr0; vr1 = kr0; \
    if (ki >= 0) { const size_t rowk = tb + res + (size_t)d * ki; const bf16* kp = KC + rowk * 256 + 128 * hp + (tid & 7) * 8; const bf16* vp = PROJ + rowk * NPJ + PJ_C + 512 + 128 * hp + (tid & 7) * 8; \
        kr0 = *(const u32x4*)kp; kr1 = *(const u32x4*)(kp + 64); vr0 = *(const u32x4*)vp; vr1 = *(const u32x4*)(vp + 64); } } while (0)
#define DIL_STORE(p) do { LAS uchar* b_ = lds0 + (p) * 4 * KT_BYTES; kv_store(b_, b_ + KT_BYTES, tid, kr0, vr0); kv_store(b_ + 2 * KT_BYTES, b_ + 3 * KT_BYTES, tid, kr1, vr1); } while (0)
    DIL_LOAD(0); __syncthreads(); DIL_STORE(0); DIL_LOAD(1);
    for (int j = 0; j < 4; ++j) {
        __syncthreads();
        if (j + 1 < 4) DIL_STORE((j + 1) & 1);
        if (j + 2 < 4) DIL_LOAD(j + 2);
        if (j >= jlo && j <= jhi) { mk.k0 = i0 - 128 + 64 * j; const LAS uchar* kb = lds0 + (j & 1) * 4 * KT_BYTES + (w >> 2) * 2 * KT_BYTES; fa_tile<2, true>(st, Q, kb, kb + KT_BYTES, lane, mk, act); }
    }
#undef DIL_LOAD
#undef DIL_STORE
    float lse2[2]; fa_finish<2>(st, lse2);
#pragma unroll
    for (int q = 0; q < 2; ++q) { const size_t rowq = tb + res + (size_t)d * mk.qi[q]; bf16* o = (bf16*)OC + ((size_t)cfg * NT + rowq) * 256 + h * 64 + 4 * quad;
#pragma unroll
        for (int dt = 0; dt < 4; ++dt) { u32x2 w_; w_.x = pk2(st.O[q][dt][0], st.O[q][dt][1]); w_.y = pk2(st.O[q][dt][2], st.O[q][dt][3]); *(u32x2*)(o + 16 * dt) = w_; }
        if (quad == 0) LSE[((size_t)cfg * NT + rowq) * 4 + h] = lse2[q]; }
}
constexpr int NSA_KC = 0, NSA_VC = 256 * KROW, NSA_KT = 2 * 256 * KROW, NSA_VT = NSA_KT + KT_BYTES, NSA_IMP = NSA_KT + 4 * KT_BYTES,
    NSA_SELM = NSA_IMP + 64 * 64 * 4, NSA_UW = NSA_SELM + 512;
static_assert(NSA_UW + 16 <= RING_BYTES, "NSA LDS map");
DI void cmp_mlp_wait(const Ctx& C, int l);
struct SwaMask { int t[2]; int k0; DI bool operator()(int q, int key) const { const int d = t[q] - (k0 + key); return (unsigned)d <= 511u; } };
struct SlcMask { int t[2]; int k0; bool sel[2]; DI bool operator()(int q, int key) const { return sel[q] && (k0 + key <= t[q]); } };
struct NoMask { DI bool operator()(int, int) const { return true; } };
DI void nsa_unit(const Ctx& C, int l, int b, int tbk, int& bl, bool& cmp_ready, float bnd_cmp, float bnd_slc, float bnd_swa) {
    const bf16 *QN = WSP(bf16, R_QN), *QR = WSP(bf16, R_QR), *KSb = WSP(bf16, R_KS), *KWb = WSP(bf16, R_KW), *PROJ = WSP(bf16, R_PROJ); const float* CMP = WSP(float, R_CMP); const float* GATE = WSP(float, R_GATE);
    bf16* YCAT = WSP(bf16, R_YCAT);
    LAS uchar* Kc = C.lds + NSA_KC; LAS uchar* Vc = C.lds + NSA_VC; LAS uchar* Ks = C.lds + NSA_KT; LAS uchar* Vs = C.lds + NSA_VT;
    LAS float* imps = (LAS float*)(C.lds + NSA_IMP); LAS unsigned* selm = (LAS unsigned*)(C.lds + NSA_SELM); LAS unsigned* uw = (LAS unsigned*)(C.lds + NSA_UW);
    int tid = C.tid, lane = C.lane; asm volatile("" : "+v"(tid), "+v"(lane));
    const int w = C.wave, l15 = lane & 15, quad = lane >> 4, head = l15 & 3, t0 = 64 * tbk; const size_t tb = (size_t)b * NS;
    __syncthreads();
    if (b != bl) {
        if (!cmp_ready) { cmp_mlp_wait(C, l); cmp_ready = true; }
        const int key = tid >> 1, hf = tid & 1; const float* kp = CMP + ((size_t)b * 256 + key) * 64 + 32 * hf; const float* vp = CMP + ((size_t)2048 + (size_t)b * 256 + key) * 64 + 32 * hf;
        float kv[32], vv[32]; float ss = 0.f;
#pragma unroll
        for (int i = 0; i < 8; ++i) { const f32x4 a = *(const f32x4*)(kp + 4 * i), c = *(const f32x4*)(vp + 4 * i);
#pragma unroll
            for (int j = 0; j < 4; ++j) { kv[4 * i + j] = a[j]; vv[4 * i + j] = c[j]; ss += a[j] * a[j]; } }
        ss += __shfl_xor(ss, 1); const float rstd = rsqrtf(ss * (1.f / 64.f) + 1e-6f); const float* g = C.nsa_kc_g + (size_t)l * 64 + 32 * hf; const bool dead = (key == 255);
#pragma unroll
        for (int i = 0; i < 4; ++i) { u32x4 o, p;
            o.x = pk2(kv[8 * i] * rstd * g[8 * i], kv[8 * i + 1] * rstd * g[8 * i + 1]); o.y = pk2(kv[8 * i + 2] * rstd * g[8 * i + 2], kv[8 * i + 3] * rstd * g[8 * i + 3]);
            o.z = pk2(kv[8 * i + 4] * rstd * g[8 * i + 4], kv[8 * i + 5] * rstd * g[8 * i + 5]); o.w = pk2(kv[8 * i + 6] * rstd * g[8 * i + 6], kv[8 * i + 7] * rstd * g[8 * i + 7]);
            p.x = pk2(vv[8 * i], vv[8 * i + 1]); p.y = pk2(vv[8 * i + 2], vv[8 * i + 3]); p.z = pk2(vv[8 * i + 4], vv[8 * i + 5]); p.w = pk2(vv[8 * i + 6], vv[8 * i + 7]);
            if (dead) { o = (u32x4){0u, 0u, 0u, 0u}; p = o; }
            *(LAS u32x4*)(Kc + key * KROW + hf * 64 + i * 16) = o; *(LAS u32x4*)(Vc + key * KROW + hf * 64 + i * 16) = p; }
        bl = b;
        __syncthreads();
    }
    f32x4 Oc[2][4];
    const int cmaxu = (t0 + 32) >> 4, ktmax = cmaxu >> 4;
    const unsigned vaddr0 = (unsigned)(size_t)(Vc + (4 * quad + (l15 >> 2)) * KROW + 8 * (l15 & 3));
#pragma unroll
    for (int q = 0; q < 2; ++q) {
        const int t = t0 + 8 * w + 4 * q + (l15 >> 2);
        bf16x8 Q[2]; q_load(Q, QN + (tb + t) * 256 + head * 64, quad);
        float nm_ = -bnd_cmp; asm volatile("" : "+v"(nm_)); f32x4 S[16]; const f32x4 sinit = (f32x4){nm_, nm_, nm_, nm_}; float ls = 0.f;
#pragma unroll
        for (int kt = 0; kt < 16; ++kt) {
            if (kt <= ktmax) {
                const bf16x8 k0 = *(const LAS bf16x8*)(Kc + (16 * kt + l15) * KROW + quad * 16), k1 = *(const LAS bf16x8*)(Kc + (16 * kt + l15) * KROW + 64 + quad * 16);
                S[kt] = MFMA16(k0, Q[0], sinit); S[kt] = MFMA16(k1, Q[1], S[kt]);
#pragma unroll
                for (int j = 0; j < 4; ++j) { const int c = 16 * kt + 4 * quad + j; const float p = (16 * c + 31 <= t) ? fexp2(S[kt][j]) : 0.f; S[kt][j] = p; ls += p; }
            } else S[kt] = (f32x4){0.f, 0.f, 0.f, 0.f};
        }
        ls += __shfl_xor(ls, 16); ls += __shfl_xor(ls, 32);
        const float inv = ls > 0.f ? 1.f / ls : 0.f;
#pragma unroll
        for (int kt = 0; kt < 16; ++kt) S[kt] = S[kt] * inv;
#pragma unroll
        for (int kt = 0; kt < 16; ++kt) {
            const float send = (quad == 3) ? (kt > 0 ? S[kt > 0 ? kt - 1 : 0][3] : 0.f) : S[kt][3];
            const float prev = __shfl(send, (lane + 48) & 63);
            float v = ((quad == 0 && kt == 0) ? 0.f : prev) + 2.f * (S[kt][0] + S[kt][1] + S[kt][2]) + S[kt][3];
            v = group_sum<4>(v);
            if (head == 0) imps[(8 * w + 4 * q + (l15 >> 2)) * 64 + 4 * kt + quad] = v;
        }
#pragma unroll
        for (int d = 0; d < 4; ++d) Oc[q][d] = (f32x4){0.f, 0.f, 0.f, 0.f};
#pragma unroll
        for (int ks = 0; ks < 8; ++ks) {
            if (2 * ks <= ktmax) {
                VFrag vf; vt_issue(vf, vaddr0 + ks * 32 * KROW); const bf16x8 pf = pack8(S[2 * ks], S[2 * ks + 1]); vt_wait(vf);
#pragma unroll
                for (int d = 0; d < 4; ++d) Oc[q][d] = MFMA16(vt_get(vf, d), pf, Oc[q][d]);
            }
        }
    }
    {
        bf16* OCm = WSP(bf16, R_OCMP);
#pragma unroll
        for (int q = 0; q < 2; ++q) { bf16* o = OCm + (tb + t0 + 8 * w + 4 * q + (l15 >> 2)) * 256 + head * 64 + 4 * quad;
#pragma unroll
            for (int d = 0; d < 4; ++d) { u32x2 w_; w_.x = pk2(Oc[q][d][0], Oc[q][d][1]); w_.y = pk2(Oc[q][d][2], Oc[q][d][3]); *(u32x2*)(o + 16 * d) = w_; } }
    }
    __syncthreads();
    if (tid < 64) {
        const int cur = tbk; unsigned long long mask;
        if (cur <= 15) mask = (2ull << cur) - 1ull;
        else {
            mask = 1ull | (1ull << cur) | (1ull << (cur - 1));
            float v[64];
#pragma unroll
            for (int i = 0; i < 16; ++i) { const f32x4 a = *(const LAS f32x4*)(imps + tid * 64 + 4 * i);
#pragma unroll
                for (int j = 0; j < 4; ++j) { const int jb = 4 * i + j; v[jb] = (jb >= 1 && jb <= cur - 2) ? a[j] : -1.f; } }
#pragma unroll 1
            for (int r = 0; r < 13; ++r) {
                float bv = -0.5f; int bi = 0;
#pragma unroll
                for (int jb = 0; jb < 64; ++jb) if (v[jb] > bv) { bv = v[jb]; bi = jb; }
                mask |= 1ull << bi;
#pragma unroll
                for (int jb = 0; jb < 64; ++jb) v[jb] = (jb == bi) ? -1.f : v[jb];
            }
        }
        unsigned lo = (unsigned)mask, hi = (unsigned)(mask >> 32);
        selm[2 * tid] = lo; selm[2 * tid + 1] = hi;
#pragma unroll
        for (int o = 1; o < 64; o <<= 1) { lo |= __shfl_xor(lo, o); hi |= __shfl_xor(hi, o); }
        if (tid == 0) { uw[0] = lo; uw[1] = hi; }
    }
    __syncthreads();
    unsigned long long U = ((unsigned long long)uw[1] << 32) | uw[0];
    bf16x8 Q[2][2]; SlcMask mk; FA<2> st; fa_init(st); st.negM = -bnd_slc; unsigned long long msk[2];
#pragma unroll
    for (int q = 0; q < 2; ++q) { const int tl = 8 * w + 4 * q + (l15 >> 2); mk.t[q] = t0 + tl; msk[q] = ((unsigned long long)selm[2 * tl + 1] << 32) | selm[2 * tl]; q_load(Q[q], QR + (tb + mk.t[q]) * 256 + head * 64, quad); }
    unsigned long long QM[2];
#pragma unroll
    for (int q = 0; q < 2; ++q) { unsigned lo = (unsigned)msk[q], hi = (unsigned)(msk[q] >> 32);
#pragma unroll
        for (int o = 1; o < 64; o <<= 1) { lo |= __shfl_xor(lo, o); hi |= __shfl_xor(hi, o); }
        QM[q] = ((unsigned long long)hi << 32) | lo; }
#ifndef PROBE_SLC2
#define PROBE_SLC2 0
#endif
#ifndef PROBE_SWA2
#define PROBE_SWA2 0
#endif
    u32x4 kr, vr; const unsigned long long U0 = U;
    for (int prep_ = 0; prep_ <= PROBE_SLC2; ++prep_) { U = U0; if (prep_ < PROBE_SLC2) { fa_init(st); }
#define SLC_LOAD(j) do { const size_t rowk = tb + 64 * (j) + (tid >> 3); kr = *(const u32x4*)(KSb + rowk * 64 + (tid & 7) * 8); vr = *(const u32x4*)(PROJ + rowk * NPJ + 3008 + (tid & 7) * 8); } while (0)
    {
        int j = __builtin_ctzll(U); U &= U - 1ull;
        int jn = U ? __builtin_ctzll(U) : -1; U &= U - 1ull;
        SLC_LOAD(j); __syncthreads(); kv_store(Ks, Vs, tid, kr, vr); if (jn >= 0) SLC_LOAD(jn);
        for (int it = 0;; ++it) {
            __syncthreads();
            const int jnn = U ? __builtin_ctzll(U) : -1; U &= U - 1ull;
            if (jn >= 0) kv_store(Ks + ((it + 1) & 1) * 2 * KT_BYTES, Vs + ((it + 1) & 1) * 2 * KT_BYTES, tid, kr, vr);
            if (jnn >= 0) SLC_LOAD(jnn);
            const bool act[2] = {(bool)((QM[0] >> j) & 1ull), (bool)((QM[1] >> j) & 1ull)};
            if (act[0] || act[1]) { mk.k0 = 64 * j; mk.sel[0] = (msk[0] >> j) & 1ull; mk.sel[1] = (msk[1] >> j) & 1ull; fa_tile<2, true>(st, Q, Ks + (it & 1) * 2 * KT_BYTES, Vs + (it & 1) * 2 * KT_BYTES, lane, mk, act); }
            if (jn < 0) break; j = jn; jn = jnn;
        }
    }
#undef SLC_LOAD
    }
    float lse2[2]; fa_finish<2>(st, lse2);
    {   bf16* OSl = WSP(bf16, R_OSLC);
#pragma unroll
        for (int q = 0; q < 2; ++q) { bf16* o = OSl + (tb + mk.t[q]) * 256 + head * 64 + 4 * quad;
#pragma unroll
            for (int d = 0; d < 4; ++d) { u32x2 w_; w_.x = pk2(st.O[q][d][0], st.O[q][d][1]); w_.y = pk2(st.O[q][d][2], st.O[q][d][3]); *(u32x2*)(o + 16 * d) = w_; } }
    }
    FA<2> sw; fa_init(sw); sw.negM = -bnd_swa; SwaMask mw; mw.t[0] = mk.t[0]; mw.t[1] = mk.t[1];
    for (int prep_ = 0; prep_ <= PROBE_SWA2; ++prep_) { if (prep_ < PROBE_SWA2) fa_init(sw);
    {
        const int j0 = tbk >= 8 ? tbk - 8 : 0; const bool act[2] = {true, true};
#define SWA_LOAD(j) do { const size_t rowk = tb + 64 * (j) + (tid >> 3); kr = *(const u32x4*)(KWb + rowk * 64 + (tid & 7) * 8); vr = *(const u32x4*)(PROJ + rowk * NPJ + 3136 + (tid & 7) * 8); } while (0)
        SWA_LOAD(j0); __syncthreads(); kv_store(Ks, Vs, tid, kr, vr); if (j0 + 1 <= tbk) SWA_LOAD(j0 + 1);
        for (int j = j0; j <= tbk; ++j) {
            const int pb_ = (j - j0) & 1;
            __syncthreads();
            if (j + 1 <= tbk) kv_store(Ks + (pb_ ^ 1) * 2 * KT_BYTES, Vs + (pb_ ^ 1) * 2 * KT_BYTES, tid, kr, vr);
            if (j + 2 <= tbk) SWA_LOAD(j + 2);
            mw.k0 = 64 * j;
            if (j == tbk || j == tbk - 8) fa_tile<2, true>(sw, Q, Ks + pb_ * 2 * KT_BYTES, Vs + pb_ * 2 * KT_BYTES, lane, mw, act);
            else fa_tile<2, false>(sw, Q, Ks + pb_ * 2 * KT_BYTES, Vs + pb_ * 2 * KT_BYTES, lane, NoMask(), act);
        }
#undef SWA_LOAD
    }
    }
    fa_finish<2>(sw, lse2);
#pragma unroll
    for (int q = 0; q < 2; ++q) {
        const size_t row = tb + mk.t[q]; const float* gp = GATE + row * 12 + head * 3; const float g0 = gp[0], g1 = gp[1], g2 = gp[2];
        f32x4 o[4]; float ss = 0.f; const bf16* pc = WSP(bf16, R_OCMP) + row * 256 + head * 64 + 4 * quad; const bf16* ps = WSP(bf16, R_OSLC) + row * 256 + head * 64 + 4 * quad;
#pragma unroll
        for (int d = 0; d < 4; ++d) { const u32x2 c_ = *(const u32x2*)(pc + 16 * d), s_ = *(const u32x2*)(ps + 16 * d);
            o[d] = (f32x4){bflo(c_.x), bfhi(c_.x), bflo(c_.y), bfhi(c_.y)} * g0 + (f32x4){bflo(s_.x), bfhi(s_.x), bflo(s_.y), bfhi(s_.y)} * g1 + sw.O[q][d] * g2; ss += (o[d][0] * o[d][0] + o[d][1] * o[d][1]) + (o[d][2] * o[d][2] + o[d][3] * o[d][3]); }
        ss += __shfl_xor(ss, 16); ss += __shfl_xor(ss, 32);
        const float rstd = rsqrtf(ss * (1.f / 64.f) + 1e-6f); const float* og = C.onorm_g + (size_t)l * 768 + 512 + head * 64 + 4 * quad;
        bf16* yo = YCAT + row * DM + 768 + head * 64 + 4 * quad;
#pragma unroll
        for (int d = 0; d < 4; ++d) { const f32x4 g4 = *(const f32x4*)(og + 16 * d); u32x2 wv; wv.x = pk2(o[d][0] * rstd * g4[0], o[d][1] * rstd * g4[1]); wv.y = pk2(o[d][2] * rstd * g4[2], o[d][3] * rstd * g4[3]); *(u32x2*)(yo + 16 * d) = wv; }
    }
}

DI void fin_phase(const Ctx& C, int l) {
    const bf16* SCH = WSP(bf16, R_SCH); const float* YA = WSP(float, R_YA); const bf16* Gb = WSP(bf16, R_G); const float* OC = WSP(float, R_OC); const float* LSE = WSP(float, R_LSE);
    const float* UB = WSP(float, R_SCANU); const float* SMT = WSP(float, R_SCANS); bf16* YCAT = WSP(bf16, R_YCAT);
    const int lane = C.lane, ch = 4 * lane, hh = lane >> 4;
    LAS float* sm = (LAS float*)C.lds;
    LAS float* us = sm + 4 * 4096 + C.wave * 512;
    const f32x4 rk = *(const f32x4*)(C.rk + (size_t)l * 256 + ch), gw4 = *(const f32x4*)(C.gn_w + (size_t)l * 256 + ch), gb4 = *(const f32x4*)(C.gn_b + (size_t)l * 256 + ch);
    const f32x4 og = *(const f32x4*)(C.onorm_g + (size_t)l * 768 + 256 + ch);
    int bl = -1;
    for (int it = C.bid; it < NT / 128; it += C.G) {
        const int b = it >> 5, kk = it & 31;
        if (b != bl) { __syncthreads(); for (int i = C.tid; i < 4096; i += NTHR) *(LAS f32x4*)(sm + 4 * i) = *(const f32x4*)(SMT + (size_t)b * 4 * 4096 + 4 * i); bl = b; __syncthreads(); }
#pragma unroll 4
        for (int r = 0; r < 16; ++r) {
            const int row = b * NS + (r >> 3) * (NS / 2) + 64 * kk + C.wave * 8 + (r & 7); const size_t o = (size_t)row * 256 + ch;
            const float l0 = LSE[(size_t)row * 4 + hh], l1 = LSE[((size_t)NT + row) * 4 + hh], l2 = LSE[((size_t)2 * NT + row) * 4 + hh];
            const bf16* ocb = (const bf16*)OC; const u32x2 a_ = *(const u32x2*)(ocb + o), b_ = *(const u32x2*)(ocb + (size_t)NT * 256 + o), c_ = *(const u32x2*)(ocb + (size_t)2 * NT * 256 + o);
            const f32x4 a = (f32x4){bflo(a_.x), bfhi(a_.x), bflo(a_.y), bfhi(a_.y)}, bq = (f32x4){bflo(b_.x), bfhi(b_.x), bflo(b_.y), bfhi(b_.y)}, c = (f32x4){bflo(c_.x), bfhi(c_.x), bflo(c_.y), bfhi(c_.y)};
            const float mx = fmaxf(l0, fmaxf(l1, l2)); float w0 = fexp2(l0 - mx), w1 = fexp2(l1 - mx), w2 = fexp2(l2 - mx); const float inv = __builtin_amdgcn_rcpf(w0 + w1 + w2); w0 *= inv; w1 *= inv; w2 *= inv;
            const f32x4 y = a * w0 + bq * w1 + c * w2;
            const float ss = group_sum<16>((y[0] * y[0] + y[1] * y[1]) + (y[2] * y[2] + y[3] * y[3])); const float rstd = rsqrtf(ss * (1.f / 64.f) + 1e-6f);
            u32x2 w; w.x = pk2(y[0] * rstd * og[0], y[1] * rstd * og[1]); w.y = pk2(y[2] * rstd * og[2], y[3] * rstd * og[3]); *(u32x2*)(YCAT + (size_t)row * DM + 512 + ch) = w;
        }
#pragma unroll 1
        for (int hf = 0; hf < 2; ++hf) {
#pragma unroll 2
            for (int r = 0; r < 8; ++r) {
                const int row = b * NS + hf * (NS / 2) + 64 * kk + C.wave * 8 + r, s = row % NS; const size_t o = (size_t)row * 256 + ch;
                f32x4 y = *(const f32x4*)(YA + o); const u32x2 rr_ = *(const u32x2*)(SCH + (size_t)3 * NT * 256 + o), k_ = *(const u32x2*)(SCH + o), v_ = *(const u32x2*)(SCH + (size_t)4 * NT * 256 + o), g_ = *(const u32x2*)(Gb + o);
                const f32x4 rr = (f32x4){bflo(rr_.x), bfhi(rr_.x), bflo(rr_.y), bfhi(rr_.y)}, k = (f32x4){bflo(k_.x), bfhi(k_.x), bflo(k_.y), bfhi(k_.y)}, v = (f32x4){bflo(v_.x), bfhi(v_.x), bflo(v_.y), bfhi(v_.y)}, g = (f32x4){bflo(g_.x), bfhi(g_.x), bflo(g_.y), bfhi(g_.y)};
                if (hf == 1) {
                    LAS float* ub = us + (r & 1) * 256;
                    *(LAS f32x4*)(ub + ch) = *(const f32x4*)(UB + ((size_t)b * (NS / 2) + (s - NS / 2)) * 256 + ch);
                    asm volatile("s_waitcnt lgkmcnt(0)" ::: "memory");
                    const LAS float* sp = sm + hh * 4096 + 4 * (lane & 15); const LAS float* up = ub + hh * 64;
#pragma unroll 8
                    for (int j4 = 0; j4 < 16; ++j4) { const f32x4 u4 = *(const LAS f32x4*)(up + 4 * j4);
#pragma unroll
                        for (int jj = 0; jj < 4; ++jj) y += *(const LAS f32x4*)(sp + (4 * j4 + jj) * 64) * u4[jj]; }
                }
                const float mu = group_sum<16>((y[0] + y[1]) + (y[2] + y[3])) * (1.f / 64.f);
                const f32x4 dy = y - mu; const float var = group_sum<16>((dy[0] * dy[0] + dy[1] * dy[1]) + (dy[2] * dy[2] + dy[3] * dy[3])) * (1.f / 64.f);
                const float rstd = rsqrtf(var + 64e-5f);
                const float dot = group_sum<16>((rr[0] * k[0] * rk[0] + rr[1] * k[1] * rk[1]) + (rr[2] * k[2] * rk[2] + rr[3] * k[3] * rk[3]));
                float out[4];
#pragma unroll
                for (int i = 0; i < 4; ++i) out[i] = ((dy[i] * rstd * gw4[i] + gb4[i]) + dot * v[i]) * g[i];
                u32x2 w; w.x = pk2(out[0], out[1]); w.y = pk2(out[2], out[3]); *(u32x2*)(YCAT + (size_t)row * DM + ch) = w;
            }
        }
    }
    __syncthreads();
}

constexpr int CW_Q = 40000;
DI int q_next(const Ctx& C, unsigned* ctr, LAS int* slot) {
    __syncthreads();
    if (C.tid == 0) *slot = (int)__hip_atomic_fetch_add(ctr, 1u, __ATOMIC_RELAXED, __HIP_MEMORY_SCOPE_AGENT);
    __syncthreads();
    return *slot;
}
DI void conv_ticket(const Ctx& C, int l, int tk);
constexpr int CW_CD = 41000;
DI void cmp_mlp_unit(const Ctx& C, int l, int cb) {
    const int kv = cb >> 3;
    { pg8::Gemm g{kv ? WSP(bf16, R_VCR) : WSP(bf16, R_KCR), WSP(bf16, WS_WK1) + (size_t)(l * 2 + kv) * 256 * 2048, 1024, 2048}; pg8::StaticOrder S; S.init(8, 1, 8, cb & 7);
      EpiC1 E{WSP(bf16, R_CH1) + (size_t)kv * 2048 * 256, (WSP(float, WS_SMALL) + NLAYER * 8 * 6144 + l * 512 + kv * 256)}; pg8::gemm_phase(C.lds, C.tid, g, S, E); }
    asm volatile("s_waitcnt vmcnt(0)" ::: "memory"); __syncthreads();
    { pg8::Gemm g{WSP(bf16, R_CH1) + (size_t)kv * 2048 * 256, WSP(bf16, WS_WK2) + (size_t)(l * 2 + kv) * 256 * 256, 256, 256}; pg8::StaticOrder S; S.init(8, 1, 8, cb & 7);
      EpiC2 E{WSP(float, R_CMP) + (size_t)kv * 2048 * 64}; pg8::gemm_phase(C.lds, C.tid, g, S, E); }
    asm volatile("s_waitcnt vmcnt(0)" ::: "memory"); __syncthreads();
    if (C.tid == 0) { __builtin_amdgcn_fence(__ATOMIC_RELEASE, "agent"); asm volatile("s_waitcnt vmcnt(0)" ::: "memory");
        __hip_atomic_fetch_add(WSP(unsigned, WS_CTL) + CW_CD + 64 * l, 1u, __ATOMIC_RELAXED, __HIP_MEMORY_SCOPE_AGENT); }
}
DI void cmp_mlp_wait(const Ctx& C, int l) {
    if (C.tid == 0) { unsigned* c = WSP(unsigned, WS_CTL) + CW_CD + 64 * l; unsigned sp = 0u;
        while (__hip_atomic_load(c, __ATOMIC_RELAXED, __HIP_MEMORY_SCOPE_AGENT) < 16u) { __builtin_amdgcn_s_sleep(8); if (++sp > (1u << 21)) break; }
        __builtin_amdgcn_fence(__ATOMIC_ACQUIRE, "agent"); asm volatile("s_waitcnt vmcnt(0)" ::: "memory"); }
    __syncthreads();
}
DI void mix_phase(const Ctx& C, int l, int rep) {
    unsigned* ctl = WSP(unsigned, WS_CTL) + CW_Q + 64 * 3 * (l + 2 * rep); LAS int* slot = (LAS int*)(C.lds + MISC_OFF + 1024);
#ifndef PROBE_SPLIT
#define PROBE_SPLIT 0
#endif
    if (C.bid < 96) { scan_unit8(C, C.bid); if (PROBE_SCAN2) scan_unit8(C, C.bid); }
    else if (C.bid < 112) cmp_mlp_unit(C, l, C.bid - 96);
    bool cmp_ready = false;
    if (PROBE_SPLIT) { asm volatile("s_waitcnt vmcnt(0)" ::: "memory"); __syncthreads(); { XcdBarrier bar2; bar2.bar = WSP(unsigned, WS_CTL) + CW_BAR; bar2.x = xb_xcc_id(); bar2.st = (volatile LAS unsigned*)(C.lds + MISC_OFF); xcd_barrier(bar2); } }
    int bl = -1;
    const float bnd_cmp = score_bound(C.nsa_q_g + (size_t)l * 64, C.nsa_kc_g + (size_t)l * 64, C.lane), bnd_slc = score_bound(C.nsa_q_g + (size_t)l * 64, C.nsa_ks_g + (size_t)l * 64, C.lane),
                bnd_swa = score_bound(C.nsa_q_g + (size_t)l * 64, C.nsa_kw_g + (size_t)l * 64, C.lane), bnd_dil = score_bound(C.dil_q_g + (size_t)l * 64, C.dil_k_g + (size_t)l * 64, C.lane);
    bool conv_left = true;
#define CONV_ONE() do { if (conv_left) { const int t_ = q_next(C, ctl + 128, slot); if (t_ >= 768 * (1 + PROBE_CONV2)) conv_left = false; else { conv_ticket(C, l, t_ % 768); bl = -1; } } } while (0)
    for (;;) { const int u = q_next(C, ctl, slot); if (u >= 512 * (1 + PROBE_NSA2)) break; nsa_unit(C, l, u & 7, 63 - ((u & 511) >> 3), bl, cmp_ready, bnd_cmp, bnd_slc, bnd_swa); CONV_ONE(); }
    for (int n = 0;; ++n) { const int u = q_next(C, ctl + 64, slot); if (u >= 1536 * (1 + PROBE_DIL2)) break; dil_unit(C, u % 1536, C.lds, C.lds + KT_BYTES, bnd_dil); if ((n & 3) == 3) CONV_ONE(); }
    while (conv_left) CONV_ONE();
#undef CONV_ONE if (C.bid >= 96)
    __syncthreads();
}
#define MFMA_F32(a, b, c) __builtin_amdgcn_mfma_f32_16x16x4f32((a), (b), (c), 0, 0, 0)
DI void router_body(const Ctx& C, int l, const bf16* __restrict__ X, unsigned char* __restrict__ H8, int* __restrict__ TOPE, float* __restrict__ TOPG) {
    const float* MOD = WSP(float, WS_SMALL) + (size_t)l * 8 * 6144; unsigned* CNTB = WSP(unsigned, WS_CTL) + CW_CNT + l * 8192;
    LAS float* wl = (LAS float*)C.lds;
    LAS float* lg = (LAS float*)(C.lds + MISC_OFF + 8192) + C.wave * 512;
    LAS unsigned* hist = (LAS unsigned*)(C.lds + MISC_OFF + 6144);
    LAS float* rs = (LAS float*)(C.lds + MISC_OFF + 6400) + C.wave * 16;
    const int lane = C.lane, l15 = lane & 15, quad = lane >> 4, gw = C.bid * NWAVE + C.wave, NGW = C.G * NWAVE;
    const float* wr = C.w_router + (size_t)l * 1024 * 32; const float* g2 = C.norm2_g + (size_t)l * DM;
    __syncthreads();
    if (C.tid < 32) hist[C.tid] = 0u;
    for (int i = C.tid; i < 8192; i += NTHR) { const int k = i >> 3, e4 = (i & 7) * 4; const f32x4 v = *(const f32x4*)(wr + (size_t)k * 32 + e4); LAS float* d = wl + ((k >> 2) * 32 + e4) * 4 + (k & 3);
        d[0] = v[0]; d[4] = v[1]; d[8] = v[2]; d[12] = v[3]; }
    __syncthreads();
    for (int task = gw; task < NT / 16; task += NGW) {
        const int row0 = 16 * task, b = row0 / NS;
        const float* shb = MOD + (size_t)b * 6144 + 3072; const float* scb = shb + 1024;
        {
            f32x4 gg[4], sb[4];
#pragma unroll
            for (int j = 0; j < 2; ++j)
#pragma unroll
                for (int hlf = 0; hlf < 2; ++hlf) { const int k = 8 * lane + 512 * j + 4 * hlf; gg[2 * j + hlf] = *(const f32x4*)(g2 + k) * (*(const f32x4*)(scb + k) + 1.f); sb[2 * j + hlf] = *(const f32x4*)(shb + k); }
#pragma unroll 4
            for (int r = 0; r < 16; ++r) {
                const bf16* xr = X + (size_t)(row0 + r) * DM + 8 * lane; f32x4 v[4]; float ss = 0.f;
#pragma unroll
                for (int j = 0; j < 2; ++j) { const u32x4 t = *(const u32x4*)(xr + 512 * j); v[2 * j] = (f32x4){bflo(t.x), bfhi(t.x), bflo(t.y), bfhi(t.y)}; v[2 * j + 1] = (f32x4){bflo(t.z), bfhi(t.z), bflo(t.w), bfhi(t.w)}; }
#pragma unroll
                for (int j = 0; j < 4; ++j) ss += (v[j][0] * v[j][0] + v[j][1] * v[j][1]) + (v[j][2] * v[j][2] + v[j][3] * v[j][3]);
                ss = group_sum<64>(ss); const float rstd = rsqrtf(ss * (1.f / DM) + 1e-6f);
                if (lane == 0) rs[r] = rstd;
                unsigned char* hp = H8 + (size_t)(row0 + r) * DM + 8 * lane;
#pragma unroll
                for (int j = 0; j < 2; ++j) { const f32x4 h0 = v[2 * j] * rstd * gg[2 * j] + sb[2 * j], h1 = v[2 * j + 1] * rstd * gg[2 * j + 1] + sb[2 * j + 1]; u32x2 o8; o8.x = pk4_fp8(h0[0], h0[1], h0[2], h0[3]); o8.y = pk4_fp8(h1[0], h1[1], h1[2], h1[3]); *(u32x2*)(hp + 512 * j) = o8; }
            }
        }
        const bf16* xr = X + (size_t)(row0 + l15) * DM + 4 * quad; const float* sh = shb + 4 * quad; const float* sc = scb + 4 * quad;
        asm volatile("s_waitcnt lgkmcnt(0)" ::: "memory");
        const float rstd = rs[l15];
        f32x4 acc0 = (f32x4){0.f, 0.f, 0.f, 0.f}, acc1 = acc0;
#pragma unroll 2
        for (int i = 0; i < 64; ++i) {
            const u32x2 ab = *(const u32x2*)(xr + 16 * i); const f32x4 a = (f32x4){bflo(ab.x), bfhi(ab.x), bflo(ab.y), bfhi(ab.y)}, g = *(const f32x4*)(g2 + 16 * i + 4 * quad), s1 = *(const f32x4*)(sc + 16 * i), s0 = *(const f32x4*)(sh + 16 * i);
            f32x4 h;
#pragma unroll
            for (int j = 0; j < 4; ++j) h[j] = a[j] * rstd * g[j] * (1.f + s1[j]) + s0[j];
            const LAS float* wp = wl + ((4 * i + quad) * 32 + l15) * 4; const f32x4 w0 = *(const LAS f32x4*)wp, w1 = *(const LAS f32x4*)(wp + 64);
#pragma unroll
            for (int j = 0; j < 4; ++j) { acc0 = MFMA_F32(h[j], w0[j], acc0); acc1 = MFMA_F32(h[j], w1[j], acc1); }
        }
        const float b0 = C.b_router[l * 32 + l15], b1 = C.b_router[l * 32 + 16 + l15];
#pragma unroll
        for (int j = 0; j < 4; ++j) { lg[(4 * quad + j) * 32 + l15] = acc0[j] + b0; lg[(4 * quad + j) * 32 + 16 + l15] = acc1[j] + b1; }
        asm volatile("s_waitcnt lgkmcnt(0)" ::: "memory");
        if (lane < 16) {
            float v[32];
#pragma unroll
            for (int i = 0; i < 8; ++i) { const f32x4 a = *(const LAS f32x4*)(lg + lane * 32 + 4 * i); v[4 * i] = a[0]; v[4 * i + 1] = a[1]; v[4 * i + 2] = a[2]; v[4 * i + 3] = a[3]; }
            float tv[4]; int ti[4];
#pragma unroll
            for (int r = 0; r < 4; ++r) { float bv = -3.0e38f; int bi = 0;
#pragma unroll
                for (int e = 0; e < 32; ++e) if (v[e] > bv) { bv = v[e]; bi = e; }
                tv[r] = bv; ti[r] = bi;
#pragma unroll
                for (int e = 0; e < 32; ++e) v[e] = (e == bi) ? -3.0e38f : v[e]; }
            const float e1 = __expf(tv[1] - tv[0]), e2 = __expf(tv[2] - tv[0]), e3 = __expf(tv[3] - tv[0]), inv = 1.f / (1.f + e1 + e2 + e3);
            const int row = row0 + lane;
            *(int4*)(TOPE + (size_t)row * 4) = make_int4(ti[0], ti[1], ti[2], ti[3]);
            *(f32x4*)(TOPG + (size_t)row * 4) = (f32x4){inv, e1 * inv, e2 * inv, e3 * inv};
#pragma unroll
            for (int r = 0; r < 4; ++r) __hip_atomic_fetch_add(&hist[ti[r]], 1u, __ATOMIC_RELAXED, __HIP_MEMORY_SCOPE_WORKGROUP);
        }
        asm volatile("s_waitcnt lgkmcnt(0)" ::: "memory");
    }
    __syncthreads();
    if (C.tid < 32) CNTB[C.bid * 32 + C.tid] = hist[C.tid];
}

DI void router_phase(const Ctx& C, int l) { int* TOPE = WSP(int, WS_ROUTE); router_body(C, l, WSP(bf16, WS_XB), WSP(unsigned char, R_XS), TOPE, (float*)(TOPE + NT * 4)); }

DI void moe_tables(const Ctx& C, int l, LAS int* tab) {
    const unsigned* CNTB = WSP(unsigned, WS_CTL) + CW_CNT + l * 8192;
    LAS unsigned* part = (LAS unsigned*)(tab + 192);
    __syncthreads();
    { const int e = C.tid & 31, pt = C.tid >> 5; unsigned tot = 0u, mine = 0u;
        const int g0 = pt * ((C.G + 15) >> 4), g1 = min(C.G, g0 + ((C.G + 15) >> 4));
#pragma unroll 16
        for (int g = g0; g < g1; ++g) { const unsigned c = CNTB[g * 32 + e]; tot += c; mine += (g < C.bid) ? c : 0u; }
        part[(pt * 2) * 32 + e] = tot; part[(pt * 2 + 1) * 32 + e] = mine; }
    __syncthreads();
    if (C.tid < 32) { unsigned tot = 0u, mine = 0u;
#pragma unroll
        for (int pt = 0; pt < 16; ++pt) { tot += part[(pt * 2) * 32 + C.tid]; mine += part[(pt * 2 + 1) * 32 + C.tid]; }
        tab[128 + C.tid] = (int)((tot + 255u) >> 8); tab[64 + C.tid] = (int)mine; }
    __syncthreads();
    if (C.tid == 0) { int s = 0; for (int e = 0; e < 32; ++e) { tab[e] = s; s += tab[128 + e]; } tab[32] = s; }
    __syncthreads();
}
DI void scatter_phase(const Ctx& C, int l) {
    const int* TOPE = WSP(int, WS_ROUTE); int* POS = (int*)(TOPE + NT * 8); int* ROWMAP = (int*)(TOPE + NT * 12);
    LAS int* tab = (LAS int*)(C.lds + MISC_OFF + 64); LAS unsigned* cur = (LAS unsigned*)(C.lds + 16384);
    moe_tables(C, l, tab);
    if (C.tid < 32) cur[C.tid] = (unsigned)(tab[C.tid] * 256 + tab[64 + C.tid]);
    __syncthreads();
    const int lane = C.lane, gw = C.bid * NWAVE + C.wave, NGW = C.G * NWAVE;
    for (int task = gw; task < NT / 16; task += NGW) {
        const int row0 = 16 * task, tok = row0 + (lane >> 2);
        const int e = TOPE[(size_t)tok * 4 + (lane & 3)];
        const int slot = (int)__hip_atomic_fetch_add(&cur[e], 1u, __ATOMIC_RELAXED, __HIP_MEMORY_SCOPE_WORKGROUP);
        POS[(size_t)tok * 4 + (lane & 3)] = slot; ROWMAP[slot] = tok;
    }
}
DI void combine_body(const Ctx& C, int l, float* __restrict__ dst, bf16* __restrict__ dstb, const bf16* __restrict__ YB, const bf16* __restrict__ XB, bf16* __restrict__ H, const int* __restrict__ POS, const float* __restrict__ TOPG) {
    const float* MOD = WSP(float, WS_SMALL) + (size_t)l * 8 * 6144;
    const int lane = C.lane, gw = C.bid * NWAVE + C.wave, NGW = C.G * NWAVE;
    for (int task = gw; task < NT / 16; task += NGW) {
        const int row0 = 16 * task, b = row0 / NS; const float* gt = MOD + (size_t)b * 6144 + 5120 + 8 * lane;
        f32x4 g4[4], gg[4], sb[4];
#pragma unroll
        for (int j = 0; j < 2; ++j) { g4[2 * j] = *(const f32x4*)(gt + 512 * j); g4[2 * j + 1] = *(const f32x4*)(gt + 512 * j + 4); }
        if (l + 1 < NLAYER) { const float* M2 = MOD + 8 * 6144 + (size_t)b * 6144 + 8 * lane; const float* g = C.norm1_g + (size_t)(l + 1) * DM + 8 * lane;
#pragma unroll
            for (int j = 0; j < 2; ++j)
#pragma unroll
                for (int hlf = 0; hlf < 2; ++hlf) { const int o = 512 * j + 4 * hlf; gg[2 * j + hlf] = *(const f32x4*)(g + o) * (*(const f32x4*)(M2 + 1024 + o) + 1.f); sb[2 * j + hlf] = *(const f32x4*)(M2 + o); } }
#pragma unroll 2
        for (int r = 0; r < 16; ++r) {
            const int row = row0 + r; const int4 ps = *(const int4*)(POS + (size_t)row * 4); const f32x4 gk = *(const f32x4*)(TOPG + (size_t)row * 4);
            const int pp[4] = {ps.x, ps.y, ps.z, ps.w};
            const bf16* orow = XB + (size_t)row * DM + 8 * lane; float* drow = dst + (size_t)row * DM + 8 * lane; bf16* drowb = dstb + (size_t)row * DM + 8 * lane;
            u32x4 y[4][2]; f32x4 x[4];
#pragma unroll
            for (int q = 0; q < 4; ++q)
#pragma unroll
                for (int j = 0; j < 2; ++j) { if (YB_FP8) { const u32x2 t_ = *(const u32x2*)((const unsigned char*)YB + (size_t)pp[q] * DM + 8 * lane + 512 * j); y[q][j] = (u32x4){t_.x, t_.y, 0u, 0u}; } else y[q][j] = *(const u32x4*)(YB + (size_t)pp[q] * DM + 8 * lane + 512 * j); }
#pragma unroll
            for (int j = 0; j < 2; ++j) { const u32x4 t = *(const u32x4*)(orow + 512 * j); x[2 * j] = (f32x4){bflo(t.x), bfhi(t.x), bflo(t.y), bfhi(t.y)}; x[2 * j + 1] = (f32x4){bflo(t.z), bfhi(t.z), bflo(t.w), bfhi(t.w)}; }
            f32x4 v[4]; float s = 0.f;
#pragma unroll
            for (int j = 0; j < 2; ++j) { f32x4 a0 = (f32x4){0.f, 0.f, 0.f, 0.f}, a1 = a0;
#pragma unroll
                for (int q = 0; q < 4; ++q) { const u32x4 w = y[q][j];
                    if (YB_FP8) { const f32x2 p0 = __builtin_amdgcn_cvt_pk_f32_fp8(w.x, false), p1 = __builtin_amdgcn_cvt_pk_f32_fp8(w.x, true), p2 = __builtin_amdgcn_cvt_pk_f32_fp8(w.y, false), p3 = __builtin_amdgcn_cvt_pk_f32_fp8(w.y, true);
                        a0 += (f32x4){p0[0], p0[1], p1[0], p1[1]} * gk[q]; a1 += (f32x4){p2[0], p2[1], p3[0], p3[1]} * gk[q]; }
                    else { a0 += (f32x4){bflo(w.x), bfhi(w.x), bflo(w.y), bfhi(w.y)} * gk[q]; a1 += (f32x4){bflo(w.z), bfhi(w.z), bflo(w.w), bfhi(w.w)} * gk[q]; } }
                v[2 * j] = x[2 * j] + g4[2 * j] * a0; v[2 * j + 1] = x[2 * j + 1] + g4[2 * j + 1] * a1;
                if (l + 1 < NLAYER) { u32x4 o; o.x = pk2(v[2 * j][0], v[2 * j][1]); o.y = pk2(v[2 * j][2], v[2 * j][3]); o.z = pk2(v[2 * j + 1][0], v[2 * j + 1][1]); o.w = pk2(v[2 * j + 1][2], v[2 * j + 1][3]); *(u32x4*)(drowb + 512 * j) = o; }
                else { *(f32x4*)(drow + 512 * j) = v[2 * j]; *(f32x4*)(drow + 512 * j + 4) = v[2 * j + 1]; } }
#pragma unroll
            for (int i = 0; i < 4; ++i) s += (v[i][0] * v[i][0] + v[i][1] * v[i][1]) + (v[i][2] * v[i][2] + v[i][3] * v[i][3]);
            if (l + 1 < NLAYER) {
                s = group_sum<64>(s); const float rstd = rsqrtf(s * (1.f / DM) + 1e-6f); bf16* hrow = H + (size_t)row * DM + 8 * lane;
#pragma unroll
                for (int j = 0; j < 2; ++j) { const f32x4 h0 = v[2 * j] * rstd * gg[2 * j] + sb[2 * j], h1 = v[2 * j + 1] * rstd * gg[2 * j + 1] + sb[2 * j + 1]; u32x4 o;
                    if (INPROJ_FP8) { u32x2 o8; o8.x = pk4_fp8(h0[0], h0[1], h0[2], h0[3]); o8.y = pk4_fp8(h1[0], h1[1], h1[2], h1[3]); *(u32x2*)((unsigned char*)H + (size_t)row * DM + 8 * lane + 512 * j) = o8; }
                    else { o.x = pk2(h0[0], h0[1]); o.y = pk2(h0[2], h0[3]); o.z = pk2(h1[0], h1[1]); o.w = pk2(h1[2], h1[3]); *(u32x4*)(hrow + 512 * j) = o; } }
            }
        }
    }
}
DI void combine_phase(const Ctx& C, int l, float* dst, bf16* dstb) {
    const int* TOPE = WSP(int, WS_ROUTE); combine_body(C, l, dst, dstb, WSP(bf16, R_YB), WSP(bf16, WS_XB), WSP(bf16, WS_H), (const int*)(TOPE + NT * 8), (const float*)(TOPE + NT * 4));
}
constexpr int PH_PER_LAYER = 11, PH_BASE = 2, N_PHASES = PH_BASE + NLAYER * PH_PER_LAYER;
#ifndef MK_ONE_LAUNCH
#define MK_ONE_LAUNCH 1
#endif
__global__ void __launch_bounds__(NTHR, 2) mk_fwd(Args args) {
    extern __shared__ __attribute__((aligned(16))) unsigned char lds_raw[];
    Ctx C;
    C.lds = (LAS unsigned char*)lds_raw; C.tid = threadIdx.x; C.lane = C.tid & 63; C.wave = __builtin_amdgcn_readfirstlane(C.tid >> 6); C.G = gridDim.x; C.bid = blockIdx.x;
    C.x = (const float*)args.in[0]; C.c = (const float*)args.in[1]; C.pos = (const int*)args.in[2]; C.w_ada = (const float*)args.in[3]; C.b_ada = (const float*)args.in[4];
    C.norm1_g = (const float*)args.in[5]; C.norm2_g = (const float*)args.in[6]; C.w_in = (const float*)args.in[7]; C.w_out = (const float*)args.in[8]; C.mu = (const float*)args.in[9];
    C.w0 = (const float*)args.in[10]; C.w2 = (const float*)args.in[11]; C.a0 = (const float*)args.in[12]; C.a2 = (const float*)args.in[13]; C.g2 = (const float*)args.in[14];
    C.kkw = (const float*)args.in[15]; C.ka = (const float*)args.in[16]; C.rk = (const float*)args.in[17]; C.gn_w = (const float*)args.in[18]; C.gn_b = (const float*)args.in[19];
    C.conv_w = (const float*)args.in[20]; C.dil_q_g = (const float*)args.in[21]; C.dil_k_g = (const float*)args.in[22]; C.nsa_q_g = (const float*)args.in[23]; C.nsa_kc_g = (const float*)args.in[24];
    C.nsa_ks_g = (const float*)args.in[25]; C.nsa_kw_g = (const float*)args.in[26]; C.pe_k = (const float*)args.in[27]; C.pe_v = (const float*)args.in[28]; C.wk1 = (const float*)args.in[29];
    C.wk2 = (const float*)args.in[30]; C.wv1 = (const float*)args.in[31]; C.wv2 = (const float*)args.in[32]; C.onorm_g = (const float*)args.in[33]; C.w_router = (const float*)args.in[34];
    C.b_router = (const float*)args.in[35]; C.w_gu = (const float*)args.in[36]; C.b_gu = (const float*)args.in[37]; C.w_down = (const float*)args.in[38]; C.b_down = (const float*)args.in[39];
    C.out = args.out; C.ws = args.ws;
    const int lo = args.ph_lo, hi = args.ph_hi;
    for (int u = C.tid; u < (LDS_BYTES - MISC_OFF) / 4; u += NTHR) ((LAS unsigned*)(C.lds + MISC_OFF))[u] = 0u;
    __syncthreads();
    XcdBarrier bar; bar.bar = WSP(unsigned, WS_CTL) + CW_BAR; bar.x = 0; bar.st = nullptr;
    if (hi - lo > 1) bar = xcd_barrier_post(WSP(unsigned, WS_CTL) + CW_BAR, (volatile LAS unsigned*)(C.lds + MISC_OFF));
#ifndef PHMASK
#define PHMASK 0xFFFFFFFFu
#endif
#define PHON(n) (((PHMASK) >> (n)) & 1u)
#ifndef PHREP
#define PHREP 0u
#endif
#define NREP(n) (1 + (int)(((PHREP) >> (n)) & 1u))
#define WSPP(T, off) ((T*)(P.ws + (off)))
#define IN(k) (lo <= (k) && (k) < hi)
#define SEAM(k) do { if (IN(k) && IN((k) + 1)) xcd_barrier(bar); } while (0)
#define PCTX Ctx P = C; asm volatile("" : "+v"(P.tid), "+v"(P.lane)); asm volatile("" : "+s"(P.ws), "+s"(P.out), "+s"(P.wave), "+s"(P.bid))
    if (PHON(17) && IN(0)) for (int rep = 0; rep < NREP(17); ++rep) { PCTX; p0_prologue(P); __syncthreads(); }
    SEAM(0);
#ifndef PROBE_BARS
#define PROBE_BARS 0
#endif
    if (hi - lo > 1) for (int i = 0; i < PROBE_BARS; ++i) xcd_barrier(bar);
    if (PHON(18) && IN(1)) { PCTX; norm1_phase(P, 0, P.x); }
    SEAM(1);
    for (int l = 0; l < NLAYER; ++l) {
        const int pb = PH_BASE + PH_PER_LAYER * l;
        if (PHON(0) && IN(pb + 0)) for (int rep = 0; rep < NREP(0); ++rep) { PCTX;
            pg8::StaticOrder S; S.init(NT / 256, NPJ / 256, P.G, P.bid);
            if (INPROJ_FP8) { pg8::Gemm g{WSPP(bf16, WS_H), WSPP(bf16, WS_WIN) + (size_t)l * NPJ * 512, 512, 512, WSPP(int, WS_ROUTE) + NT * 12 + NR, 0x3FFFF}; EpiProj E{WSPP(bf16, R_PROJ), W8_INV}; pg8::gemm_phase<EpiProj, pg8::StaticOrder, true, true>(P.lds, P.tid, g, S, E); }
            else { pg8::Gemm g{WSPP(bf16, WS_H), WSPP(bf16, WS_WIN) + (size_t)l * NPJ * 1024, 1024, 1024}; EpiProj E{WSPP(bf16, R_PROJ), 1.f}; pg8::gemm_phase(P.lds, P.tid, g, S, E); }
        }
        SEAM(pb + 0);
        if (PHON(1) && IN(pb + 1)) for (int rep = 0; rep < NREP(1); ++rep) { PCTX; prep_phase(P, l); __syncthreads(); }
        SEAM(pb + 1);
        if (PHON(2) && IN(pb + 2)) for (int rep = 0; rep < NREP(2); ++rep) { PCTX;
            { pg8::Gemm g{WSPP(bf16, R_LIN), WSPP(bf16, WS_LORA) + (size_t)l * 768 * 256, 256, 256}; pg8::StaticOrder S; S.init(NT / 256, 3, P.G, P.bid);
              EpiLora E{WSPP(float, R_SC), WSPP(bf16, R_SCH), WSPP(bf16, R_G), P.w0 + l * 256, P.a0 + l * 256, P.ka + l * 256, (rep + 1 < NREP(2)) ? WSPP(bf16, WS_PROBE) : WSPP(bf16, R_SCH), (rep + 1 < NREP(2)) ? WSPP(float, WS_PROBE) + 64 * MiB : WSPP(float, R_SC)}; pg8::gemm_phase(P.lds, P.tid, g, S, E); }
        }
        SEAM(pb + 2);
        if (PHON(3) && IN(pb + 3)) for (int rep = 0; rep < NREP(3); ++rep) { PCTX; mix_phase(P, l, rep); }
        SEAM(pb + 3);
        if (PHON(4) && IN(pb + 4)) for (int rep = 0; rep < NREP(4); ++rep) { PCTX; fin_phase(P, l); __syncthreads(); }
        SEAM(pb + 4);
        if (PHON(5) && IN(pb + 5)) for (int rep = 0; rep < NREP(5); ++rep) { PCTX;
            pg8::Gemm g{WSPP(bf16, R_YCAT), WSPP(bf16, WS_WOUT) + (size_t)l * 1024 * 1024, 1024, 1024}; pg8::StaticOrder S; S.init(NT / 256, 4, P.G, P.bid);
            EpiOut E{(rep + 1 < NREP(5)) ? WSPP(bf16, WS_PROBE) : WSPP(bf16, WS_XB), l == 0 ? P.x : (const float*)nullptr, WSPP(bf16, WS_XB), WSPP(float, WS_SMALL) + (size_t)l * 8 * 6144 + 2048}; pg8::gemm_phase(P.lds, P.tid, g, S, E);
        }
        SEAM(pb + 5);
        if (PHON(6) && IN(pb + 6)) for (int rep = 0; rep < NREP(6); ++rep) { PCTX; router_phase(P, l); __syncthreads(); }
        SEAM(pb + 6);
        if (PHON(7) && IN(pb + 7)) for (int rep = 0; rep < NREP(7); ++rep) { PCTX; scatter_phase(P, l); __syncthreads(); }
        SEAM(pb + 7);
        if (PHON(8) && IN(pb + 8)) for (int rep = 0; rep < NREP(8); ++rep) { PCTX;
            LAS int* tab = (LAS int*)(P.lds + MISC_OFF + 64); moe_tables(P, l, tab);
            pg8::Gemm g{WSPP(bf16, R_XS), WSPP(bf16, WS_WGU) + (size_t)l * 32 * 2048 * 512, 512, 512, WSPP(int, WS_ROUTE) + NT * 12, 32767};
            pg8::GroupedOrder S; S.init(tab[32], 8, P.G, P.bid); S.tstart = tab; S.nrow_e = 2048;
            EpiGU8 E{WSPP(unsigned char, R_ACT), P.b_gu + (size_t)l * 32 * 2048}; pg8::gemm_phase<EpiGU8, pg8::GroupedOrder, true, true>(P.lds, P.tid, g, S, E);
        }
        SEAM(pb + 8);
        if (PHON(9) && IN(pb + 9)) for (int rep = 0; rep < NREP(9); ++rep) { PCTX;
            LAS int* tab = (LAS int*)(P.lds + MISC_OFF + 64); moe_tables(P, l, tab);
            pg8::Gemm g{WSPP(bf16, R_ACT), WSPP(bf16, WS_WDN) + (size_t)l * 32 * 1024 * 512, 512, 512, WSPP(int, WS_ROUTE) + NT * 12 + NR, 0x3FFFF}; pg8::GroupedOrder S; S.init(tab[32], 4, P.G, P.bid); S.tstart = tab; S.nrow_e = 1024;
            EpiDN8 E{WSPP(bf16, R_YB), P.b_down + (size_t)l * 32 * 1024}; pg8::gemm_phase<EpiDN8, pg8::GroupedOrder, true, true>(P.lds, P.tid, g, S, E);
        }
        SEAM(pb + 9);
        if (PHON(10) && IN(pb + 10)) for (int rep = 0; rep < NREP(10); ++rep) { PCTX; combine_phase(P, l, (rep + 1 < NREP(10)) ? WSPP(float, WS_PROBE) : P.out, (rep + 1 < NREP(10)) ? WSPP(bf16, WS_PROBE) : WSPP(bf16, WS_XB)); __syncthreads(); }
        SEAM(pb + 10);
    }
#undef IN
#undef SEAM
}

extern "C" void kernel_launch(void* const* d_in, const int* in_sizes, int n_in, void* d_out, int out_size, void* d_ws, size_t ws_size, hipStream_t stream) {
    static int grid = 0;
    if (grid == 0) {
        if (n_in != 40 || out_size != NT * DM || ws_size < WS_PROBE + 256 * MiB) { fprintf(stderr, "kernel_launch: unexpected problem (n_in %d, out %d, ws %zu < %zu)\n", n_in, out_size, ws_size, (size_t)WS_END); grid = -1; return; }
        int dev = 0, cus = 0, per_cu = 0;
        if (hipGetDevice(&dev) != hipSuccess || hipDeviceGetAttribute(&cus, hipDeviceAttributeMultiprocessorCount, dev) != hipSuccess) { grid = -1; return; }
        if (hipFuncSetAttribute((const void*)mk_fwd, hipFuncAttributeMaxDynamicSharedMemorySize, LDS_BYTES) != hipSuccess) { fprintf(stderr, "kernel_launch: hipFuncSetAttribute failed\n"); grid = -1; return; }
        if (hipOccupancyMaxActiveBlocksPerMultiprocessor(&per_cu, (const void*)mk_fwd, NTHR, LDS_BYTES) != hipSuccess || per_cu < 1) fprintf(stderr, "kernel_launch: occupancy query says %d blocks per CU\n", per_cu);
        (void)hipGetLastError();
        grid = cus > 256 ? 256 : cus;
    }
    if (grid < 0) return;
    (void)hipMemsetAsync((char*)d_ws, 0, ZERO_BYTES, stream);
    Args a{};
    for (int i = 0; i < 40; ++i) a.in[i] = d_in[i];
    a.out = (float*)d_out; a.ws = (unsigned char*)d_ws;
#if MK_ONE_LAUNCH
    a.ph_lo = 0; a.ph_hi = N_PHASES;
    hipLaunchKernelGGL(mk_fwd, dim3(grid), dim3(NTHR), LDS_BYTES, stream, a);
#else
    for (int p = 0; p < N_PHASES; ++p) { a.ph_lo = p; a.ph_hi = p + 1; hipLaunchKernelGGL(mk_fwd, dim3(grid), dim3(NTHR), LDS_BYTES, stream, a); }
#endif
    const hipError_t le = hipPeekAtLastError();
    if (le != hipSuccess) fprintf(stderr, "kernel_launch: launch failed: %s\n", hipGetErrorName(le));
}
```

```cpp
#include <hip/hip_runtime.h>
#include <cstdio>
#include <cstdint>

#define DI __device__ __forceinline__
#define LAS __attribute__((address_space(3)))
#define GAS __attribute__((address_space(1)))
typedef unsigned short bf16;
typedef short bf16x8 __attribute__((ext_vector_type(8)));
typedef float f32x4 __attribute__((ext_vector_type(4)));
typedef float f32x2 __attribute__((ext_vector_type(2)));
typedef unsigned u32x4 __attribute__((ext_vector_type(4)));
typedef unsigned u32x2 __attribute__((ext_vector_type(2)));
typedef unsigned char uchar;

#ifndef PROBE_EPI_PROJ
#define PROBE_EPI_PROJ 0
#endif
#ifndef PROBE_EPI_GU
#define PROBE_EPI_GU 0
#endif
#ifndef PROBE_EPI_DN
#define PROBE_EPI_DN 0
#endif
#ifndef PROBE_SCAN2
#define PROBE_SCAN2 0
#endif
#ifndef PROBE_ATT2
#define PROBE_ATT2 0
#endif
#ifndef PROBE_NSA2
#define PROBE_NSA2 PROBE_ATT2
#endif
#ifndef PROBE_DIL2
#define PROBE_DIL2 PROBE_ATT2
#endif
#ifndef PROBE_CONV2
#define PROBE_CONV2 0
#endif
#ifndef INPROJ_FP8
#define INPROJ_FP8 0
#endif
constexpr int NB = 8, NS = 4096, NT = NB * NS, DM = 1024, NPJ = 3328, NE = 32, FF = 1024, NLAYER = 2;
constexpr int PJ_A = 0, PJ_B = 1024, PJ_C = 1792, PJ_D = 2560;
constexpr int NR = NT * 4 + NE * 256;
constexpr int NTHR = 512, NWAVE = 8;

DI float bf2f(unsigned v) { return __builtin_bit_cast(float, v << 16); }
DI unsigned f2bf(float f) { unsigned u = __builtin_bit_cast(unsigned, f); return (u + 0x7fffu + ((u >> 16) & 1u)) >> 16; }
typedef __bf16 hwbf2 __attribute__((ext_vector_type(2)));
DI unsigned pk2(float lo, float hi) { const f32x2 v = {lo, hi}; return __builtin_bit_cast(unsigned, __builtin_convertvector(v, hwbf2)); }
DI float bflo(unsigned w) { return __builtin_bit_cast(float, w << 16); }
DI float bfhi(unsigned w) { return __builtin_bit_cast(float, w & 0xffff0000u); }
DI float fexp2(float x) { return __builtin_amdgcn_exp2f(x); }
DI float fsigmoid(float x) { return __builtin_amdgcn_rcpf(1.f + __builtin_amdgcn_exp2f(-1.44269504089f * x)); }
DI float wsum_xor(float v, int o) { return v + __shfl_xor(v, o); }
template <int CTRL> DI float dppmov(float x) { return __builtin_bit_cast(float, __builtin_amdgcn_update_dpp(0, __builtin_bit_cast(int, x), CTRL, 0xF, 0xF, true)); }
template <int W> DI float group_sum(float v) {
    if (W >= 2) v += dppmov<0xB1>(v);
    if (W >= 4) v += dppmov<0x4E>(v);
    if (W >= 8) v += dppmov<0x141>(v);
    if (W >= 16) v += dppmov<0x140>(v);
    if (W >= 32) v += __shfl_xor(v, 16);
    if (W >= 64) v += __shfl_xor(v, 32);
    return v;
}
DI float sum8(float x) { x += dppmov<0xB1>(x); x += dppmov<0x4E>(x); x += dppmov<0x141>(x); return x; }

#define XB_TMO      128
#define XB_XCNT(j)  (256  + 64 * (j))
#define XB_XSUB(j)  (1280 + 64 * (j))
#define XB_XGEN(j)  (2304 + 64 * (j))
#define XB_TOP      3328
#define XB_TOPGEN   3392
#define XCD_BAR_WORDS 3456
#define XB_SPIN_CAP (1u << 18)
DI unsigned xb_ld(unsigned* p)              { return __hip_atomic_load(p, __ATOMIC_RELAXED, __HIP_MEMORY_SCOPE_AGENT); }
DI unsigned xb_add(unsigned* p, unsigned v) { return __hip_atomic_fetch_add(p, v, __ATOMIC_RELAXED, __HIP_MEMORY_SCOPE_AGENT); }
DI unsigned xb_xcc_id() { return (unsigned)__builtin_amdgcn_s_getreg((3 << 11) | 20) & 0xFu; }
#define XB_SPIN(cond, bar) do { unsigned _sp = 0; while (cond) { __builtin_amdgcn_s_sleep(1); \
    if ((++_sp & 255u) == 0u) { if (xb_ld(&(bar)[XB_TMO])) break; if (_sp > XB_SPIN_CAP) { atomicAdd(&(bar)[XB_TMO], 1u); break; } } } } while (0)
struct XcdBarrier { unsigned* bar; unsigned x; volatile LAS unsigned* st; };
DI XcdBarrier xcd_barrier_post(unsigned* bar, volatile LAS unsigned* st) {
    XcdBarrier b; b.bar = bar; b.x = xb_xcc_id(); b.st = st;
    if (threadIdx.x == 0) (void)xb_add(&bar[XB_XCNT(b.x)], 1u);
    return b;
}
DI void xcd_barrier_complete(unsigned* bar, unsigned x, unsigned& nloc, unsigned& nx) {
    const unsigned G = gridDim.x * gridDim.y * gridDim.z;
    unsigned sum, cnt, mine, sp = 0u;
    for (;;) {
        sum = 0u; cnt = 0u; mine = 0u;
#pragma unroll
        for (unsigned j = 0; j < 16; ++j) { const unsigned c = xb_ld(&bar[XB_XCNT(j)]); sum += c; cnt += (c > 0u) ? 1u : 0u; mine = (j == x) ? c : mine; }
        if (sum == G) break;
        __builtin_amdgcn_s_sleep(1);
        if ((++sp & 255u) == 0u) { if (xb_ld(&bar[XB_TMO])) break; if (sp > XB_SPIN_CAP) { atomicAdd(&bar[XB_TMO], 1u); break; } }
    }
    nloc = mine > 0u ? mine : 1u; nx = cnt > 0u ? cnt : 1u;
}
DI void xcd_barrier(const XcdBarrier& b) {
    asm volatile("s_waitcnt vmcnt(0)" ::: "memory");
    __syncthreads();
    if (threadIdx.x == 0) {
        unsigned* bar = b.bar;
        __builtin_amdgcn_s_waitcnt(0);
        unsigned nloc = b.st[0], nx = b.st[1];
        if (nloc == 0u) { xcd_barrier_complete(bar, b.x, nloc, nx); b.st[0] = nloc; b.st[1] = nx; }
        const unsigned old = xb_add(&bar[XB_XSUB(b.x)], 1u);
        const unsigned gen = old / nloc;
        if (old + 1u == (gen + 1u) * nloc) {
            __builtin_amdgcn_fence(__ATOMIC_RELEASE, "agent");
            asm volatile("s_waitcnt vmcnt(0)" ::: "memory");
            const unsigned og = xb_add(&bar[XB_TOP], 1u);
            const unsigned tg = og / nx;
            if (og + 1u == (tg + 1u) * nx) xb_add(&bar[XB_TOPGEN], 1u);
            else XB_SPIN(xb_ld(&bar[XB_TOPGEN]) == tg, bar);
            __builtin_amdgcn_fence(__ATOMIC_ACQUIRE, "agent");
            xb_add(&bar[XB_XGEN(b.x)], 1u);
            asm volatile("s_waitcnt vmcnt(0)" ::: "memory");
        } else {
            XB_SPIN(xb_ld(&bar[XB_XGEN(b.x)]) == gen, bar);
            __builtin_amdgcn_fence(__ATOMIC_ACQUIRE, "agent");
            asm volatile("s_waitcnt vmcnt(0)" ::: "memory");
        }
    }
    __syncthreads();
}
namespace pg8 {
constexpr int BM = 256, BK = 64, HALF = 128, HTB = HALF * BK * 2, STAGE_BYTES = 8 * HTB, NXCD = 8, WGM = 4;
__host__ __device__ __forceinline__ int lds_byte(int r, int c) { const int st = (r >> 4) * 2 + (c >> 5), rr = r & 15, cc = c & 31, ob = rr * 64 + cc * 2; return st * 1024 + (ob ^ (((ob >> 9) & 1) << 5)); }
__host__ __device__ __forceinline__ void stage_rc(int b, int& R, int& C) { const int st = b / 1024, sb = b % 1024, swz = sb ^ (((sb >> 9) & 1) << 5); R = (st >> 1) * 16 + swz / 64; C = (st & 1) * 32 + (swz % 64) / 2; }
__host__ __device__ __forceinline__ int perm32(int rho) { const int n = rho >> 4, i = rho & 15; return 8 * (i >> 2) + 4 * n + (i & 3); }

struct Unit { int pm, pn, brow, e; };
struct Gemm { const bf16* A; const bf16* Bt; int lda, K; const int* rowmap; int rowmask; };

struct StaticOrder {
    int nM, nN, nwg, G, c;
    __device__ void init(int nM_, int nN_, int G_, int c_) { nM = nM_; nN = nN_; nwg = nM * nN; G = G_; c = c_; }
    __device__ bool tile(int i, int& pm, int& pn) const {
        const long L = (long)i * G + c; if (L >= nwg) return false;
        int wgid = (int)L; { const int q = nwg / NXCD, r = nwg % NXCD, xcd = wgid % NXCD, off = wgid / NXCD; wgid = (xcd < r ? xcd * (q + 1) : r * (q + 1) + (xcd - r) * q) + off; }
        const int nig = WGM * nN, gid = wgid / nig, fm = gid * WGM, gsz = (nM - fm) < WGM ? (nM - fm) : WGM;
        pm = fm + ((wgid % nig) % gsz); pn = (wgid % nig) / gsz; return true;
    }
    __device__ bool next(int i, Unit& u) const { if (!tile(i, u.pm, u.pn)) return false; u.brow = u.pn * BM; u.e = 0; return true; }
};
struct LoraOrder : StaticOrder {
    __device__ bool next(int i, Unit& u) const {
        if (G != 256 || nM != 128 || nN != 3) return StaticOrder::next(i, u);
        if (c < 128) { if (i > 0) return false; u.pm = c; u.pn = 1; }
        else { if (i > 1) return false; u.pm = c - 128; u.pn = i == 0 ? 0 : 2; }
        u.brow = u.pn * BM; u.e = 0; return true;
    }
};
struct GroupedOrder : StaticOrder {
    const LAS int* tstart; int nrow_e;
    __device__ bool next(int i, Unit& u) const {
        if (!tile(i, u.pm, u.pn)) return false;
        int e = 0;
#pragma unroll 1
        for (int j = 16; j > 0; j >>= 1) if (tstart[e + j] <= u.pm) e += j;
        u.e = e; u.brow = e * nrow_e + u.pn * BM; return true;
    }
};
DI unsigned cvt_pk_bf16(float lo, float hi) { unsigned r; asm volatile("v_cvt_pk_bf16_f32 %0, %1, %2" : "=v"(r) : "v"(lo), "v"(hi)); return r; }

template <class Epi, class Sched, bool GATHER = false, bool FP8 = false>
DI void gemm_phase(LAS unsigned char* lds, const int tid, const Gemm g, const Sched& S, const Epi& E) {
    const int wid = __builtin_amdgcn_readfirstlane(tid >> 6), lane = tid & 63, wr = wid >> 2, wc = wid & 3, fr = lane & 15, fq = lane >> 4;
    int K = g.K, lda = g.lda; asm volatile("" : "+s"(K), "+s"(lda));
    const int nt = K / BK;
    unsigned voffA[2], voffB[2]; int Ra[2], Ca[2];
#pragma unroll
    for (int i = 0; i < 2; ++i) { int R, C; stage_rc(tid * 16 + i * 8192, R, C); const int Rb = Epi::PERM ? ((R & ~31) + perm32(R & 31)) : R; Ra[i] = R; Ca[i] = C;
        voffA[i] = (unsigned)(R * lda + C) * 2u; voffB[i] = (unsigned)(Rb * K + C) * 2u; }
    unsigned vgc[2][2]; int rawn[2][2];
#define PG8_GLOAD(dst, pm_) do { _Pragma("unroll") for (int _h = 0; _h < 2; ++_h) _Pragma("unroll") for (int _i = 0; _i < 2; ++_i) { const int* _p = g.rowmap + (size_t)(pm_) * BM + _h * HALF + Ra[_i]; \
        asm volatile("global_load_dword %0, %1, off" : "=v"(dst[_h][_i]) : "v"(_p) : "memory"); } } while (0)
#define PG8_GCONV(vg, raw) do { _Pragma("unroll") for (int _h = 0; _h < 2; ++_h) _Pragma("unroll") for (int _i = 0; _i < 2; ++_i) { int _r = raw[_h][_i]; asm volatile("" : "+v"(_r)); \
        vg[_h][_i] = (unsigned)((_r & g.rowmask) * lda + Ca[_i]) * 2u; } } while (0)
#define PG8_STAGE_A(bufoff, kptr, h, vg) do { if (GATHER) PG8_STAGE(bufoff, kptr, vg[h]); else PG8_STAGE(bufoff, (kptr) + (h) * hstepA, voffA); } while (0)
    const size_t kstep = (size_t)(BK * 2);
    const size_t hstepA = (size_t)HALF * lda * 2, hstepB = (size_t)HALF * K * 2;
    const size_t tstepA = 2 * hstepA;
    const unsigned ldsw = (unsigned)wid * 1024u;
    const int aoff = lds_byte(wr * 64 + fr, fq * 8), boff = lds_byte(wc * 32 + fr, fq * 8);
#define PG8_SA(b, h) (((b) * 2 + (h)) * HTB)
#define PG8_SB(b, h) ((4 + (b) * 2 + (h)) * HTB)
#define PG8_STAGE(bufoff, gbase, voff) do { _Pragma("unroll") for (int _i = 0; _i < 2; ++_i) \
        __builtin_amdgcn_global_load_lds((const unsigned*)((const char*)(gbase) + (voff)[_i]), (LAS unsigned*)(lds + (bufoff) + ldsw + _i * 8192), 16, 0, 0); } while (0)
#define PG8_LDA(dst, b, h) do { _Pragma("unroll") for (int m = 0; m < 4; ++m) { const v4i_ lo_ = *(const LAS v4i_*)(lds + PG8_SA(b, h) + aoff + m * 2048), hi_ = *(const LAS v4i_*)(lds + PG8_SA(b, h) + aoff + m * 2048 + 1024); \
        dst[m] = __builtin_shufflevector(lo_, hi_, 0, 1, 2, 3, 4, 5, 6, 7); } } while (0)
#define PG8_LDB(dst, b, h) do { _Pragma("unroll") for (int n = 0; n < 2; ++n) { const v4i_ lo_ = *(const LAS v4i_*)(lds + PG8_SB(b, h) + boff + n * 2048), hi_ = *(const LAS v4i_*)(lds + PG8_SB(b, h) + boff + n * 2048 + 1024); \
        dst[n] = __builtin_shufflevector(lo_, hi_, 0, 1, 2, 3, 4, 5, 6, 7); } } while (0)
#define PG8_MMA(ai, bj, At, Bt) do { __builtin_amdgcn_s_setprio(1); _Pragma("unroll") for (int m = 0; m < 4; ++m) _Pragma("unroll") for (int n = 0; n < 2; ++n) { \
        if (FP8) acc[ai][bj][m][n] = __builtin_amdgcn_mfma_scale_f32_16x16x128_f8f6f4(Bt[n], At[m], acc[ai][bj][m][n], 0, 0, 0, 0x7F7F7F7F, 0, 0x7F7F7F7F); \
        else { const v8i_ b_ = Bt[n], a_ = At[m]; \
            acc[ai][bj][m][n] = __builtin_amdgcn_mfma_f32_16x16x32_bf16(__builtin_bit_cast(bf16x8, __builtin_shufflevector(b_, b_, 0, 1, 2, 3)), __builtin_bit_cast(bf16x8, __builtin_shufflevector(a_, a_, 0, 1, 2, 3)), acc[ai][bj][m][n], 0, 0, 0); \
            acc[ai][bj][m][n] = __builtin_amdgcn_mfma_f32_16x16x32_bf16(__builtin_bit_cast(bf16x8, __builtin_shufflevector(b_, b_, 4, 5, 6, 7)), __builtin_bit_cast(bf16x8, __builtin_shufflevector(a_, a_, 4, 5, 6, 7)), acc[ai][bj][m][n], 0, 0, 0); } } \
        __builtin_amdgcn_s_setprio(0); } while (0)
#define PG8_WAIT_V(n) asm volatile("s_waitcnt vmcnt(" #n ")" ::: "memory")
#define PG8_WAIT_L(n) asm volatile("s_waitcnt lgkmcnt(" #n ")" ::: "memory")
#define PG8_BAR __builtin_amdgcn_s_barrier()
#define PG8_SCHED __builtin_amdgcn_sched_barrier(0)
    Unit cur, nxt; int ui = 0;
    if (!S.next(0, cur)) return;
    f32x4 acc[2][2][4][2];
#pragma unroll
    for (int a = 0; a < 2; ++a)
#pragma unroll
        for (int b = 0; b < 2; ++b)
#pragma unroll
            for (int m = 0; m < 4; ++m)
#pragma unroll
                for (int n = 0; n < 2; ++n) acc[a][b][m][n] = (f32x4){0.f, 0.f, 0.f, 0.f};
    typedef int v8i_ __attribute__((ext_vector_type(8))); typedef int v4i_ __attribute__((ext_vector_type(4)));
    v8i_ At[4], B0[2], B1[2];
    const char* cA = (const char*)g.A + (GATHER ? (size_t)0 : (size_t)cur.pm * tstepA); const char* cB = (const char*)g.Bt + (size_t)cur.brow * K * 2;
    if (GATHER) { PG8_GLOAD(rawn, cur.pm); asm volatile("s_waitcnt vmcnt(0)" : "+v"(rawn[0][0]), "+v"(rawn[0][1]), "+v"(rawn[1][0]), "+v"(rawn[1][1]) :: "memory"); PG8_GCONV(vgc, rawn); }
    PG8_STAGE(PG8_SB(0, 0), cB, voffB); PG8_STAGE(PG8_SB(0, 1), cB + hstepB, voffB); PG8_STAGE_A(PG8_SA(0, 0), cA, 0, vgc); PG8_STAGE_A(PG8_SA(0, 1), cA, 1, vgc);
    if (wr == 1) PG8_BAR;
    PG8_WAIT_V(2); PG8_BAR;
    PG8_STAGE(PG8_SB(1, 0), cB + kstep, voffB); PG8_STAGE_A(PG8_SA(1, 0), cA + kstep, 0, vgc); PG8_STAGE(PG8_SB(1, 1), cB + hstepB + kstep, voffB);
    PG8_WAIT_V(6); PG8_BAR;
    for (;;) {
        const bool has_next = S.next(ui + 1, nxt);
        const char* nA = (has_next && !GATHER) ? (const char*)g.A + (size_t)nxt.pm * tstepA : cA;
        if (GATHER && has_next) PG8_GLOAD(rawn, nxt.pm); const char* nB = has_next ? (const char*)g.Bt + (size_t)nxt.brow * K * 2 : cB;
#pragma unroll 1
        for (int t = 0; t < nt; t += 2) {
            const bool last = (t == nt - 2);
            const char* a1 = cA + (size_t)(t + 1) * kstep;
            const char* a2 = last ? nA : cA + (size_t)(t + 2) * kstep; const char* b2 = last ? nB : cB + (size_t)(t + 2) * kstep;
            const char* a3 = a2 + kstep; const char* b3 = b2 + kstep;
            PG8_LDB(B0, 0, 0); PG8_LDB(B1, 0, 1); PG8_SCHED; PG8_LDA(At, 0, 0); PG8_STAGE_A(PG8_SA(1, 1), a1, 1, vgc);
            if (GATHER) { if (last && has_next) PG8_GCONV(vgc, rawn); }
            PG8_WAIT_V(8); PG8_WAIT_L(0); PG8_BAR; PG8_MMA(0, 0, At, B0); PG8_MMA(0, 1, At, B1); PG8_BAR; PG8_SCHED;
            PG8_LDA(At, 0, 1); PG8_STAGE(PG8_SB(0, 0), b2, voffB); PG8_STAGE(PG8_SB(0, 1), b2 + hstepB, voffB); PG8_STAGE_A(PG8_SA(0, 0), a2, 0, vgc);
            PG8_WAIT_V(8); PG8_WAIT_L(0); PG8_BAR; PG8_MMA(1, 0, At, B0); PG8_MMA(1, 1, At, B1); PG8_BAR; PG8_SCHED;
            PG8_LDB(B0, 1, 0); PG8_LDB(B1, 1, 1); PG8_SCHED; PG8_LDA(At, 1, 0); PG8_STAGE_A(PG8_SA(0, 1), a2, 1, vgc);
            PG8_WAIT_V(8); PG8_WAIT_L(0); PG8_BAR; PG8_MMA(0, 0, At, B0); PG8_MMA(0, 1, At, B1); PG8_BAR; PG8_SCHED;
            PG8_LDA(At, 1, 1); PG8_STAGE(PG8_SB(1, 0), b3, voffB); PG8_STAGE(PG8_SB(1, 1), b3 + hstepB, voffB); PG8_STAGE_A(PG8_SA(1, 0), a3, 0, vgc);
            PG8_WAIT_V(8); PG8_WAIT_L(0); PG8_BAR; PG8_MMA(1, 0, At, B0); PG8_MMA(1, 1, At, B1); PG8_BAR; PG8_SCHED;
        }
        if (wr == 0) PG8_BAR;
        for (int r_ = 0; r_ < Epi::REP; ++r_) { int fr2 = fr, fq2 = fq; asm volatile("" : "+v"(fr2), "+v"(fq2)); E(acc, cur, wr, wc, fr2, fq2); }
        if (!has_next) break;
#pragma unroll
        for (int a = 0; a < 2; ++a)
#pragma unroll
            for (int b = 0; b < 2; ++b)
#pragma unroll
                for (int m = 0; m < 4; ++m)
#pragma unroll
                    for (int n = 0; n < 2; ++n) acc[a][b][m][n] = (f32x4){0.f, 0.f, 0.f, 0.f};
        cur = nxt; cA = nA; cB = nB; ++ui;
        if (wr == 1) PG8_BAR;
    }
    PG8_WAIT_V(0);
    PG8_BAR;
#undef PG8_SA
#undef PG8_SB
#undef PG8_STAGE
#undef PG8_STAGE_A
#undef PG8_GLOAD
#undef PG8_GCONV
#undef PG8_LDA
#undef PG8_LDB
#undef PG8_MMA
#undef PG8_WAIT_V
#undef PG8_WAIT_L
#undef PG8_BAR
#undef PG8_SCHED
}
}
constexpr size_t MiB = 1u << 20;
constexpr size_t WS_CTL = 0;
constexpr size_t WS_LORA = 1 * MiB;
constexpr size_t WS_WK2 = 2 * MiB;
constexpr size_t ZERO_BYTES = 3 * MiB;
constexpr size_t WS_WIN = 3 * MiB;
constexpr size_t WS_WOUT = 17 * MiB;
constexpr size_t WS_WK1 = 21 * MiB;
constexpr size_t WS_SMALL = 25 * MiB;
constexpr size_t WS_ROUTE = 27 * MiB;
constexpr size_t WS_WGU = 32 * MiB;
constexpr size_t WS_WDN = 288 * MiB;
constexpr size_t WS_H = 416 * MiB;
constexpr size_t WS_R = 480 * MiB;
constexpr size_t R_PROJ = WS_R;
constexpr size_t R_SC = R_PROJ + 208 * MiB;
constexpr size_t R_SCH = R_SC + 32 * MiB;
constexpr size_t R_LIN = R_SC + 192 * MiB;
constexpr size_t R_G = R_LIN + 16 * MiB;
constexpr size_t R_YA = R_G + 32 * MiB;
constexpr size_t R_YCAT = R_YA + 32 * MiB;
constexpr size_t R_QC = R_YCAT + 64 * MiB;
constexpr size_t R_KC = R_QC + 16 * MiB;
constexpr size_t R_OC = R_KC + 16 * MiB;
constexpr size_t R_LSE = R_OC + 96 * MiB;
constexpr size_t R_QN = R_LSE + 2 * MiB;
constexpr size_t R_QR = R_QN + 16 * MiB;
constexpr size_t R_KCR = R_QR + 16 * MiB;
constexpr size_t R_VCR = R_KCR + 5 * MiB;
constexpr size_t R_KS = R_VCR + 5 * MiB;
constexpr size_t R_KW = R_KS + 4 * MiB;
constexpr size_t R_GATE = R_KW + 4 * MiB;
constexpr size_t R_CH1 = R_GATE + 2 * MiB;
constexpr size_t R_CMP = R_CH1 + 2 * MiB;
constexpr size_t R_OCMP = R_CMP + 1 * MiB;
constexpr size_t R_OSLC = R_OCMP + 32 * MiB;
constexpr size_t R_OSWA = R_OSLC + 32 * MiB;
constexpr size_t R_SCANU = R_OSWA;
constexpr size_t R_SCANS = R_OSWA + 16 * MiB;
constexpr size_t R_IMP = R_OSWA + 32 * MiB;
constexpr size_t R_SELM = R_IMP + 8 * MiB;
constexpr size_t R_MIX_END = R_SELM + 1 * MiB;
constexpr size_t R_XS = WS_R;
constexpr size_t R_ACT = R_XS + 272 * MiB;
constexpr size_t R_YB = R_ACT + 272 * MiB;
constexpr size_t R_MOE_END = R_YB + 272 * MiB;
constexpr size_t WS_END = (R_MIX_END > R_MOE_END ? R_MIX_END : R_MOE_END);
constexpr size_t WS_XB = WS_END;
constexpr size_t WS_PROBE = WS_XB + 64 * MiB;
static_assert((size_t)NR * 1024 * 2 <= 272 * MiB, "sorted buffers");
constexpr int CW_BAR = 4096;
constexpr int CW_CNT = 16384;
constexpr int CW_CUR = 16384 + 64;

constexpr int RING_BYTES = 131072;
constexpr int MISC_OFF = RING_BYTES;
constexpr int LDS_BYTES = 155648;

struct Args { const void* in[40]; float* out; unsigned char* ws; int ph_lo, ph_hi; };

struct Ctx {
    LAS unsigned char* lds; int tid, lane, wave, G, bid;
    const float *x, *c, *w_ada, *b_ada, *norm1_g, *norm2_g, *w_in, *w_out, *mu, *w0, *w2, *a0, *a2, *g2, *kkw, *ka, *rk, *gn_w, *gn_b, *conv_w, *dil_q_g, *dil_k_g,
        *nsa_q_g, *nsa_kc_g, *nsa_ks_g, *nsa_kw_g, *pe_k, *pe_v, *wk1, *wk2, *wv1, *wv2, *onorm_g, *w_router, *b_router, *w_gu, *b_gu, *w_down, *b_down;
    const int* pos;
    float* out; unsigned char* ws;
};
#define WSP(T, off) ((T*)(C.ws + (off)))

typedef f32x4 Acc[2][2][4][2];
struct EpiProj {
    static constexpr int REP = 1 + PROBE_EPI_PROJ; static constexpr bool PERM = true; bf16* O; float scale;
    DI void operator()(const Acc& acc, const pg8::Unit& u, int wr, int wc, int fr, int fq) const {
        const int row0 = u.pm * 256 + wr * 64 + fr, col0 = u.pn * 256 + wc * 32 + 8 * fq;
#pragma unroll
        for (int ai = 0; ai < 2; ++ai)
#pragma unroll
            for (int m = 0; m < 4; ++m) { bf16* rowp = O + (size_t)(row0 + ai * 128 + m * 16) * NPJ + col0;
#pragma unroll
                for (int bj = 0; bj < 2; ++bj) { const f32x4 v0 = acc[ai][bj][m][0] * scale, v1 = acc[ai][bj][m][1] * scale; u32x4 w;
                    w.x = pg8::cvt_pk_bf16(v0[0], v0[1]); w.y = pg8::cvt_pk_bf16(v0[2], v0[3]); w.z = pg8::cvt_pk_bf16(v1[0], v1[1]); w.w = pg8::cvt_pk_bf16(v1[2], v1[3]);
                    *(u32x4*)(rowp + bj * 128) = w; } }
    }
};
struct EpiLora {
    static constexpr int REP = 1; static constexpr bool PERM = false; float* Wp; bf16* SCH; bf16* Gb; const float *w0, *a0, *ka; bf16* SCo; float* Wo;
    DI void operator()(const Acc& acc, const pg8::Unit& u, int wr, int wc, int fr, int fq) const {
        const int row0 = u.pm * 256 + wr * 64 + fr, col0 = wc * 32 + 4 * fq;
        if (u.pn == 0) {
#pragma unroll
            for (int bj = 0; bj < 2; ++bj)
#pragma unroll
                for (int n = 0; n < 2; ++n) { const int ch = col0 + bj * 128 + n * 16; const f32x4 b = *(const f32x4*)(w0 + ch);
#pragma unroll
                    for (int ai = 0; ai < 2; ++ai)
#pragma unroll
                        for (int m = 0; m < 4; ++m) { const size_t o = (size_t)(row0 + ai * 128 + m * 16) * 256 + ch; const f32x4 v = acc[ai][bj][m][n] + b; f32x4 r;
#pragma unroll
                            for (int j = 0; j < 4; ++j) r[j] = fexp2(-0.875040829f * fsigmoid(v[j]));
                            *(f32x4*)(Wo + o) = r; } }
        } else if (u.pn == 1) {
#pragma unroll
            for (int bj = 0; bj < 2; ++bj)
#pragma unroll
                for (int n = 0; n < 2; ++n) { const int ch = col0 + bj * 128 + n * 16; const f32x4 b = *(const f32x4*)(a0 + ch), kav = *(const f32x4*)(ka + ch);
#pragma unroll
                    for (int ai = 0; ai < 2; ++ai) {
                        __builtin_amdgcn_sched_barrier(0);
                        u32x2 krv[4], knv[4];
#pragma unroll
                        for (int m = 0; m < 4; ++m) { const size_t o = (size_t)(row0 + ai * 128 + m * 16) * 256 + ch; krv[m] = *(const u32x2*)(SCH + o); knv[m] = *(const u32x2*)(SCH + (size_t)NT * 256 + o); }
                        __builtin_amdgcn_sched_barrier(0);
#pragma unroll
                        for (int m = 0; m < 4; ++m) { const size_t o = (size_t)(row0 + ai * 128 + m * 16) * 256 + ch; const f32x4 v = acc[ai][bj][m][n] + b;
                            const u32x2 kr = krv[m], kn = knv[m];
                            const float krf[4] = {bflo(kr.x), bfhi(kr.x), bflo(kr.y), bfhi(kr.y)}, knf[4] = {bflo(kn.x), bfhi(kn.x), bflo(kn.y), bfhi(kn.y)}; float k2[4], bb[4];
#pragma unroll
                            for (int j = 0; j < 4; ++j) { const float a = fsigmoid(v[j]); k2[j] = krf[j] * (1.f + (a - 1.f) * kav[j]); bb[j] = knf[j] * a; }
                            u32x2 o1, o2; o1.x = pk2(k2[0], k2[1]); o1.y = pk2(k2[2], k2[3]); o2.x = pk2(bb[0], bb[1]); o2.y = pk2(bb[2], bb[3]);
                            *(u32x2*)(SCo + o) = o1; *(u32x2*)(SCo + (size_t)2 * NT * 256 + o) = o2; } } }
        } else {
#pragma unroll
            for (int bj = 0; bj < 2; ++bj)
#pragma unroll
                for (int n = 0; n < 2; ++n) { const int ch = col0 + bj * 128 + n * 16;
#pragma unroll
                    for (int ai = 0; ai < 2; ++ai)
#pragma unroll
                        for (int m = 0; m < 4; ++m) { const size_t o = (size_t)(row0 + ai * 128 + m * 16) * 256 + ch; const f32x4 v = acc[ai][bj][m][n]; u32x2 w; w.x = pk2(v[0], v[1]); w.y = pk2(v[2], v[3]); *(u32x2*)(Gb + o) = w; } }
        }
    }
};
DI float gelu_tanh(float x) { const float t = 0.7978845608f * (x + 0.044715f * x * x * x); return x * fsigmoid(2.f * t); }
struct EpiC1 {
    static constexpr int REP = 1; static constexpr bool PERM = true; bf16* O; const float* peb;
    DI void operator()(const Acc& acc, const pg8::Unit& u, int wr, int wc, int fr, int fq) const {
        const int row0 = u.pm * 256 + wr * 64 + fr, col0 = wc * 32 + 8 * fq;
#pragma unroll
        for (int bj = 0; bj < 2; ++bj) { const f32x4 b0 = *(const f32x4*)(peb + col0 + bj * 128), b1 = *(const f32x4*)(peb + col0 + bj * 128 + 4);
#pragma unroll
            for (int ai = 0; ai < 2; ++ai)
#pragma unroll
                for (int m = 0; m < 4; ++m) { bf16* p = O + (size_t)(row0 + ai * 128 + m * 16) * 256 + col0 + bj * 128; const f32x4 v0 = acc[ai][bj][m][0] + b0, v1 = acc[ai][bj][m][1] + b1; u32x4 w;
                    w.x = pk2(gelu_tanh(v0[0]), gelu_tanh(v0[1])); w.y = pk2(gelu_tanh(v0[2]), gelu_tanh(v0[3])); w.z = pk2(gelu_tanh(v1[0]), gelu_tanh(v1[1])); w.w = pk2(gelu_tanh(v1[2]), gelu_tanh(v1[3]));
                    *(u32x4*)p = w; } }
    }
};
struct EpiC2 {
    static constexpr int REP = 1; static constexpr bool PERM = false; float* O;
    DI void operator()(const Acc& acc, const pg8::Unit& u, int wr, int wc, int fr, int fq) const {
        if (wc >= 2) return;
        const int row0 = u.pm * 256 + wr * 64 + fr, col0 = wc * 32 + 4 * fq;
#pragma unroll
        for (int ai = 0; ai < 2; ++ai)
#pragma unroll
            for (int m = 0; m < 4; ++m)
#pragma unroll
                for (int n = 0; n < 2; ++n) *(f32x4*)(O + (size_t)(row0 + ai * 128 + m * 16) * 64 + col0 + n * 16) = acc[ai][0][m][n];
    }
};
struct EpiOut {
    static constexpr int REP = 1; static constexpr bool PERM = true; bf16* O; const float* xin; const bf16* xb; const float* gt;
    DI void operator()(const Acc& acc, const pg8::Unit& u, int wr, int wc, int fr, int fq) const {
        const int row0 = u.pm * 256 + wr * 64 + fr, col0 = u.pn * 256 + wc * 32 + 8 * fq; const int b = (u.pm * 256) / NS;
#pragma unroll
        for (int bj = 0; bj < 2; ++bj) { const float* gp = gt + (size_t)b * 6144 + col0 + bj * 128; const f32x4 g0 = *(const f32x4*)gp, g1 = *(const f32x4*)(gp + 4);
#pragma unroll
            for (int ai = 0; ai < 2; ++ai) {
            __builtin_amdgcn_sched_barrier(0);
            f32x4 xa[4], xc[4];
#pragma unroll
                for (int m = 0; m < 4; ++m) { const size_t o = (size_t)(row0 + ai * 128 + m * 16) * DM + col0 + bj * 128;
                    if (xin) { xa[m] = *(const f32x4*)(xin + o); xc[m] = *(const f32x4*)(xin + o + 4); }
                    else { const u32x4 t = *(const u32x4*)(xb + o); xa[m] = __builtin_bit_cast(f32x4, t); } }
            __builtin_amdgcn_sched_barrier(0);
#pragma unroll
                for (int m = 0; m < 4; ++m) { const size_t o = (size_t)(row0 + ai * 128 + m * 16) * DM + col0 + bj * 128; f32x4 x0, x1;
                    if (xin) { x0 = xa[m]; x1 = xc[m]; }
                    else { const u32x4 t = __builtin_bit_cast(u32x4, xa[m]); x0 = (f32x4){bflo(t.x), bfhi(t.x), bflo(t.y), bfhi(t.y)}; x1 = (f32x4){bflo(t.z), bfhi(t.z), bflo(t.w), bfhi(t.w)}; }
                    const f32x4 v0 = x0 + g0 * acc[ai][bj][m][0], v1 = x1 + g1 * acc[ai][bj][m][1]; u32x4 w;
                    w.x = pk2(v0[0], v0[1]); w.y = pk2(v0[2], v0[3]); w.z = pk2(v1[0], v1[1]); w.w = pk2(v1[2], v1[3]); *(u32x4*)(O + o) = w; } } }
    }
};
struct EpiGU {
    static constexpr int REP = 1; static constexpr bool PERM = true; bf16* O; const float* bgu;
    DI void operator()(const Acc& acc, const pg8::Unit& u, int wr, int wc, int fr, int fq) const {
        const int row0 = u.pm * 256 + wr * 64 + fr, cc = u.pn * 128 + wc * 32 + 8 * fq; const float* bp = bgu + (size_t)u.e * 2048 + cc;
        const f32x4 g0 = *(const f32x4*)bp, g1 = *(const f32x4*)(bp + 4), u0 = *(const f32x4*)(bp + 1024), u1 = *(const f32x4*)(bp + 1028);
#pragma unroll
        for (int ai = 0; ai < 2; ++ai)
#pragma unroll
            for (int m = 0; m < 4; ++m) { bf16* p = O + (size_t)(row0 + ai * 128 + m * 16) * FF + cc; float r[8];
#pragma unroll
                for (int n = 0; n < 2; ++n) { const f32x4 gv = acc[ai][0][m][n] + (n ? g1 : g0), uv = acc[ai][1][m][n] + (n ? u1 : u0);
#pragma unroll
                    for (int j = 0; j < 4; ++j) { const float ga = fminf(gv[j], 7.f), up = fminf(fmaxf(uv[j], -7.f), 7.f); r[4 * n + j] = ga * fsigmoid(1.702f * ga) * (up + 1.f); } }
                u32x4 w; w.x = pk2(r[0], r[1]); w.y = pk2(r[2], r[3]); w.z = pk2(r[4], r[5]); w.w = pk2(r[6], r[7]); *(u32x4*)p = w; }
    }
};
struct EpiDN {
    static constexpr int REP = 1; static constexpr bool PERM = true; bf16* O; const float* bd;
    DI void operator()(const Acc& acc, const pg8::Unit& u, int wr, int wc, int fr, int fq) const {
        const int row0 = u.pm * 256 + wr * 64 + fr, col0 = u.pn * 256 + wc * 32 + 8 * fq; const float* bp = bd + (size_t)u.e * 1024 + col0;
#pragma unroll
        for (int bj = 0; bj < 2; ++bj) { const f32x4 b0 = *(const f32x4*)(bp + bj * 128), b1 = *(const f32x4*)(bp + bj * 128 + 4);
#pragma unroll
            for (int ai = 0; ai < 2; ++ai)
#pragma unroll
                for (int m = 0; m < 4; ++m) { bf16* p = O + (size_t)(row0 + ai * 128 + m * 16) * DM + col0 + bj * 128; const f32x4 v0 = acc[ai][bj][m][0] + b0, v1 = acc[ai][bj][m][1] + b1; u32x4 w;
                    w.x = pk2(v0[0], v0[1]); w.y = pk2(v0[2], v0[3]); w.z = pk2(v1[0], v1[1]); w.w = pk2(v1[2], v1[3]); *(u32x4*)p = w; } }
    }
};
DI float clamp8(float x) { return fminf(fmaxf(x, -448.f), 448.f); }
DI unsigned pk4_fp8_nc(float a, float b, float c, float d) { unsigned w = 0u; w = __builtin_amdgcn_cvt_pk_fp8_f32(a, b, w, false); w = __builtin_amdgcn_cvt_pk_fp8_f32(c, d, w, true); return w; }
DI unsigned pk4_fp8(float a, float b, float c, float d) { unsigned w = 0u; w = __builtin_amdgcn_cvt_pk_fp8_f32(clamp8(a), clamp8(b), w, false); w = __builtin_amdgcn_cvt_pk_fp8_f32(clamp8(c), clamp8(d), w, true); return w; }
constexpr float W8_SCALE = 32.f, W8_INV = 1.f / 32.f;
struct EpiGU8 {
    static constexpr int REP = 1 + PROBE_EPI_GU; static constexpr bool PERM = true; unsigned char* O; const float* bgu;
    DI void operator()(const Acc& acc, const pg8::Unit& u, int wr, int wc, int fr, int fq) const {
        const int row0 = u.pm * 256 + wr * 64 + fr, cc = u.pn * 128 + wc * 32 + 8 * fq; const float* bp = bgu + (size_t)u.e * 2048 + cc;
        const f32x4 g0 = *(const f32x4*)bp, g1 = *(const f32x4*)(bp + 4), u0 = *(const f32x4*)(bp + 1024), u1 = *(const f32x4*)(bp + 1028);
        const f32x2 bg[4] = {(f32x2){g0[0], g0[1]}, (f32x2){g0[2], g0[3]}, (f32x2){g1[0], g1[1]}, (f32x2){g1[2], g1[3]}};
        const f32x2 bu[4] = {(f32x2){u0[0] + 1.f, u0[1] + 1.f}, (f32x2){u0[2] + 1.f, u0[3] + 1.f}, (f32x2){u1[0] + 1.f, u1[1] + 1.f}, (f32x2){u1[2] + 1.f, u1[3] + 1.f}};
#pragma unroll
        for (int ai = 0; ai < 2; ++ai)
#pragma unroll
            for (int m = 0; m < 4; ++m) { unsigned char* p = O + (size_t)(row0 + ai * 128 + m * 16) * FF + cc; f32x2 r[4];
#pragma unroll
                for (int h2 = 0; h2 < 4; ++h2) { const int n = h2 >> 1, j = (h2 & 1) * 2;
                    f32x2 gv = (f32x2){acc[ai][0][m][n][j], acc[ai][0][m][n][j + 1]} * W8_INV + bg[h2];
                    f32x2 uv = (f32x2){acc[ai][1][m][n][j], acc[ai][1][m][n][j + 1]} * W8_INV + bu[h2];
                    gv[0] = fminf(gv[0], 7.f); gv[1] = fminf(gv[1], 7.f); uv[0] = __builtin_amdgcn_fmed3f(uv[0], -6.f, 8.f); uv[1] = __builtin_amdgcn_fmed3f(uv[1], -6.f, 8.f);
                    const f32x2 t = gv * -2.45546695959f; f32x2 e; e[0] = __builtin_amdgcn_exp2f(t[0]); e[1] = __builtin_amdgcn_exp2f(t[1]);
                    e = e + 1.f; f32x2 sg; sg[0] = __builtin_amdgcn_rcpf(e[0]); sg[1] = __builtin_amdgcn_rcpf(e[1]);
                    r[h2] = (gv * sg) * uv; }
                u32x2 w; w.x = pk4_fp8_nc(r[0][0], r[0][1], r[1][0], r[1][1]); w.y = pk4_fp8_nc(r[2][0], r[2][1], r[3][0], r[3][1]); *(u32x2*)p = w; }
    }
};
#ifndef YB_FP8
#define YB_FP8 1
#endif
struct EpiDN8 {
    static constexpr int REP = 1 + PROBE_EPI_DN; static constexpr bool PERM = true; bf16* O; const float* bd;
    DI void operator()(const Acc& acc, const pg8::Unit& u, int wr, int wc, int fr, int fq) const {
        const int row0 = u.pm * 256 + wr * 64 + fr, col0 = u.pn * 256 + wc * 32 + 8 * fq; const float* bp = bd + (size_t)u.e * 1024 + col0;
#pragma unroll
        for (int bj = 0; bj < 2; ++bj) { const f32x4 b0 = *(const f32x4*)(bp + bj * 128), b1 = *(const f32x4*)(bp + bj * 128 + 4);
#pragma unroll
            for (int ai = 0; ai < 2; ++ai)
#pragma unroll
                for (int m = 0; m < 4; ++m) { const size_t oo = (size_t)(row0 + ai * 128 + m * 16) * DM + col0 + bj * 128; const f32x4 v0 = acc[ai][bj][m][0] * W8_INV + b0, v1 = acc[ai][bj][m][1] * W8_INV + b1;
                    if (YB_FP8) { u32x2 w; w.x = pk4_fp8(v0[0], v0[1], v0[2], v0[3]); w.y = pk4_fp8(v1[0], v1[1], v1[2], v1[3]); *(u32x2*)((unsigned char*)O + oo) = w; }
                    else { u32x4 w; w.x = pk2(v0[0], v0[1]); w.y = pk2(v0[2], v0[3]); w.z = pk2(v1[0], v1[1]); w.w = pk2(v1[2], v1[3]); *(u32x4*)(O + oo) = w; } } }
    }
};
DI void tr_item(const float* src, int ld_src, int scol0, int nvalid, int k0, bf16* dst, int ld_dst, int drow0, int dk0, LAS float* scr, int lane) {
    const int n4 = (lane & 7) * 4, kr = lane >> 3; f32x4 v[8];
#pragma unroll
    for (int i = 0; i < 8; ++i) v[i] = (n4 < nvalid) ? *(const f32x4*)(src + (size_t)(k0 + kr + 8 * i) * ld_src + scol0 + n4) : (f32x4){0.f, 0.f, 0.f, 0.f};
#pragma unroll
    for (int i = 0; i < 8; ++i) { LAS float* s = scr + (kr + 8 * i) * 33 + n4; s[0] = v[i][0]; s[1] = v[i][1]; s[2] = v[i][2]; s[3] = v[i][3]; }
    asm volatile("s_waitcnt lgkmcnt(0)" ::: "memory");
    const int c = lane & 7;
#pragma unroll
    for (int jq = 0; jq < 4; ++jq) { const int n = (lane >> 3) + 8 * jq; const LAS float* s = scr + (8 * c) * 33 + n;
        u32x4 o; o.x = pk2(s[0 * 33], s[1 * 33]); o.y = pk2(s[2 * 33], s[3 * 33]); o.z = pk2(s[4 * 33], s[5 * 33]); o.w = pk2(s[6 * 33], s[7 * 33]);
        *(u32x4*)(dst + (size_t)(drow0 + n) * ld_dst + dk0 + k0 + 8 * c) = o; }
    asm volatile("s_waitcnt lgkmcnt(0)" ::: "memory");
}
DI void tr_item8(const float* src, int ld_src, int scol0, int k0, unsigned char* dst, int ld_dst, int drow0, LAS float* scr, int lane, int nvalid = 32) {
    const int n4 = (lane & 7) * 4, kr = lane >> 3; f32x4 v[8];
#pragma unroll
    for (int i = 0; i < 8; ++i) v[i] = (n4 < nvalid) ? *(const f32x4*)(src + (size_t)(k0 + kr + 8 * i) * ld_src + scol0 + n4) : (f32x4){0.f, 0.f, 0.f, 0.f};
#pragma unroll
    for (int i = 0; i < 8; ++i) { LAS float* s = scr + (kr + 8 * i) * 33 + n4; s[0] = v[i][0]; s[1] = v[i][1]; s[2] = v[i][2]; s[3] = v[i][3]; }
    asm volatile("s_waitcnt lgkmcnt(0)" ::: "memory");
    const int c = lane & 7;
#pragma unroll
    for (int jq = 0; jq < 4; ++jq) { const int n = (lane >> 3) + 8 * jq; const LAS float* s = scr + (8 * c) * 33 + n;
        u32x2 o; o.x = pk4_fp8(s[0 * 33] * W8_SCALE, s[1 * 33] * W8_SCALE, s[2 * 33] * W8_SCALE, s[3 * 33] * W8_SCALE); o.y = pk4_fp8(s[4 * 33] * W8_SCALE, s[5 * 33] * W8_SCALE, s[6 * 33] * W8_SCALE, s[7 * 33] * W8_SCALE);
        *(u32x2*)(dst + (size_t)(drow0 + n) * ld_dst + k0 + 8 * c) = o; }
    asm volatile("s_waitcnt lgkmcnt(0)" ::: "memory");
}
struct ConvItem { const float* src; unsigned char* dst; int ld_src; };
DI ConvItem conv_addr(const Ctx& C, int l, int r) {
    constexpr int I_GU = 32 * 16 * 64; ConvItem it;
    if (r < I_GU) { const int e = r / 1024, r2 = r % 1024, kb = r2 / 64, nb = r2 % 64, n0 = 32 * nb, j = n0 / 256, i = n0 % 256;
        const int scol0 = (i < 128) ? 128 * j + i : 1024 + 128 * j + (i - 128);
        it.src = C.w_gu + (size_t)(l * 32 + e) * 1024 * 2048 + (size_t)(64 * kb) * 2048 + scol0; it.ld_src = 2048;
        it.dst = WSP(unsigned char, WS_WGU) + (size_t)(l * 32 + e) * 2048 * 1024 + (size_t)n0 * 1024 + 64 * kb; }
    else { r -= I_GU; const int e = r / 512, r2 = r % 512, kb = r2 / 32, nb = r2 % 32;
        it.src = C.w_down + (size_t)(l * 32 + e) * 1024 * 1024 + (size_t)(64 * kb) * 1024 + 32 * nb; it.ld_src = 1024;
        it.dst = WSP(unsigned char, WS_WDN) + (size_t)(l * 32 + e) * 1024 * 1024 + (size_t)(32 * nb) * 1024 + 64 * kb; }
    return it;
}
DI void conv_load(const ConvItem& it, int lane, f32x4 (&v)[8]) {
    const int n4 = (lane & 7) * 4, kr = lane >> 3;
#pragma unroll
    for (int i = 0; i < 8; ++i) v[i] = *(const f32x4*)(it.src + (size_t)(kr + 8 * i) * it.ld_src + n4);
}
DI void conv_emit(const ConvItem& it, int lane, const f32x4 (&v)[8], LAS float* scr) {
    const int n4 = (lane & 7) * 4, kr = lane >> 3;
#pragma unroll
    for (int i = 0; i < 8; ++i) { LAS float* s = scr + (kr + 8 * i) * 33 + n4; s[0] = v[i][0]; s[1] = v[i][1]; s[2] = v[i][2]; s[3] = v[i][3]; }
    asm volatile("s_waitcnt lgkmcnt(0)" ::: "memory");
    const int c = lane & 7;
#pragma unroll
    for (int jq = 0; jq < 4; ++jq) { const int n = (lane >> 3) + 8 * jq; const LAS float* s = scr + (8 * c) * 33 + n;
        u32x2 o; o.x = pk4_fp8(s[0 * 33] * W8_SCALE, s[1 * 33] * W8_SCALE, s[2 * 33] * W8_SCALE, s[3 * 33] * W8_SCALE); o.y = pk4_fp8(s[4 * 33] * W8_SCALE, s[5 * 33] * W8_SCALE, s[6 * 33] * W8_SCALE, s[7 * 33] * W8_SCALE);
        *(u32x2*)(it.dst + (size_t)n * 1024 + 8 * c) = o; }
    asm volatile("s_waitcnt lgkmcnt(0)" ::: "memory");
}
DI void conv_ticket(const Ctx& C0, int l, int tk) {
    Ctx C = C0; asm volatile("" : "+v"(C.lane), "+v"(C.tid));
    LAS float* scr = (LAS float*)(C.lds + C.wave * 16384);
    __syncthreads();
    const int r0 = tk * 64 + C.wave * 8;
    f32x4 va[8], vb[8], vc[8];
    conv_load(conv_addr(C, l, r0), C.lane, va); conv_load(conv_addr(C, l, r0 + 1), C.lane, vb); conv_load(conv_addr(C, l, r0 + 2), C.lane, vc);
    conv_emit(conv_addr(C, l, r0), C.lane, va, scr);     conv_load(conv_addr(C, l, r0 + 3), C.lane, va);
    conv_emit(conv_addr(C, l, r0 + 1), C.lane, vb, scr); conv_load(conv_addr(C, l, r0 + 4), C.lane, vb);
    conv_emit(conv_addr(C, l, r0 + 2), C.lane, vc, scr); conv_load(conv_addr(C, l, r0 + 5), C.lane, vc);
    conv_emit(conv_addr(C, l, r0 + 3), C.lane, va, scr); conv_load(conv_addr(C, l, r0 + 6), C.lane, va);
    conv_emit(conv_addr(C, l, r0 + 4), C.lane, vb, scr); conv_load(conv_addr(C, l, r0 + 7), C.lane, vb);
    conv_emit(conv_addr(C, l, r0 + 5), C.lane, vc, scr);
    conv_emit(conv_addr(C, l, r0 + 6), C.lane, va, scr);
    conv_emit(conv_addr(C, l, r0 + 7), C.lane, vb, scr);
}
DI void p0_prologue(const Ctx& C) {
    LAS float* scr = (LAS float*)(C.lds + C.wave * 16384);
    const int gw = C.bid * NWAVE + C.wave, NGW = C.G * NWAVE;
    constexpr int I_IN = 16 * 104, I_OUT = 16 * 32, I_LW = 8, I_LA = 8, I_LG = 16, I_K1 = 256, I_K2 = 8;
    constexpr int I_LAYER = I_IN + I_OUT + I_LW + I_LA + I_LG + 2 * I_K1 + 2 * I_K2;
    for (int it = gw; it < NLAYER * I_LAYER; it += NGW) {
        const int l = it / I_LAYER; int r = it % I_LAYER;
        if (r < I_IN) { const int kb = r / 104, nb = r % 104, n0 = 32 * nb; int nv = 3212 - n0; nv = nv < 0 ? 0 : (nv > 32 ? 32 : nv);
            if (INPROJ_FP8) tr_item8(C.w_in + (size_t)l * 1024 * 3212, 3212, n0, 64 * kb, WSP(unsigned char, WS_WIN) + (size_t)l * NPJ * 1024, 1024, n0, scr, C.lane, nv);
            else tr_item(C.w_in + (size_t)l * 1024 * 3212, 3212, n0, nv, 64 * kb, WSP(bf16, WS_WIN) + (size_t)l * NPJ * 1024, 1024, n0, 0, scr, C.lane); continue; } r -= I_IN;
        if (r < I_OUT) { const int kb = r / 32, nb = r % 32;
            tr_item(C.w_out + (size_t)l * 1024 * 1024, 1024, 32 * nb, 32, 64 * kb, WSP(bf16, WS_WOUT) + (size_t)l * 1024 * 1024, 1024, 32 * nb, 0, scr, C.lane); continue; } r -= I_OUT;
        bf16* lora = WSP(bf16, WS_LORA) + (size_t)l * 768 * 256;
        if (r < I_LW) { tr_item(C.w2 + (size_t)l * 64 * 256, 256, 32 * r, 32, 0, lora, 256, 32 * r, 0, scr, C.lane); continue; } r -= I_LW;
        if (r < I_LA) { tr_item(C.a2 + (size_t)l * 64 * 256, 256, 32 * r, 32, 0, lora, 256, 256 + 32 * r, 64, scr, C.lane); continue; } r -= I_LA;
        if (r < I_LG) { const int kb = r / 8, nb = r % 8; tr_item(C.g2 + (size_t)l * 128 * 256, 256, 32 * nb, 32, 64 * kb, lora, 256, 512 + 32 * nb, 128, scr, C.lane); continue; } r -= I_LG;
        if (r < 2 * I_K1) { const int kv = r / I_K1, r2 = r % I_K1, kb = r2 / 8, nb = r2 % 8;
            tr_item((kv ? C.wv1 : C.wk1) + (size_t)l * 2048 * 256, 256, 32 * nb, 32, 64 * kb, WSP(bf16, WS_WK1) + (size_t)(l * 2 + kv) * 256 * 2048, 2048, 32 * nb, 0, scr, C.lane); continue; } r -= 2 * I_K1;
        { const int kv = r / I_K2, r2 = r % I_K2, kb = r2 / 2, nb = r2 % 2;
            tr_item((kv ? C.wv2 : C.wk2) + (size_t)l * 256 * 64, 64, 32 * nb, 32, 64 * kb, WSP(bf16, WS_WK2) + (size_t)(l * 2 + kv) * 256 * 256, 256, 32 * nb, 0, scr, C.lane); }
    }
    { int* idm = WSP(int, WS_ROUTE) + NT * 12 + NR; for (int i = C.bid * NTHR + C.tid; i < NR; i += C.G * NTHR) idm[i] = i; }
    __syncthreads();
    float* MOD = WSP(float, WS_SMALL); float* PEB = MOD + NLAYER * 8 * 6144;
    LAS float* sc = (LAS float*)C.lds;
    LAS float* red = sc + 8192;
    for (int it = C.bid; it < 192 + 32; it += C.G) {
        if (it < 192) {
            const int l = it / 96, n0 = (it % 96) * 64;
            for (int i = C.tid; i < 8192; i += NTHR) { const float v = C.c[i]; sc[i] = v * fsigmoid(v); }
            __syncthreads();
            const int kq = C.tid >> 6, col = C.tid & 63; float a[8];
#pragma unroll
            for (int b = 0; b < 8; ++b) a[b] = 0.f;
            const float* wp = C.w_ada + (size_t)l * 1024 * 6144 + n0 + col;
#pragma unroll 32
            for (int k = kq * 128; k < kq * 128 + 128; ++k) { const float w = wp[(size_t)k * 6144];
#pragma unroll
                for (int b = 0; b < 8; ++b) a[b] += sc[b * 1024 + k] * w; }
#pragma unroll
            for (int b = 0; b < 8; ++b) red[(kq * 8 + b) * 64 + col] = a[b];
            __syncthreads();
            { const int b = C.tid >> 6; float s = C.b_ada[(size_t)l * 6144 + n0 + col];
#pragma unroll
              for (int q = 0; q < 8; ++q) s += red[(q * 8 + b) * 64 + col];
              MOD[((size_t)l * 8 + b) * 6144 + n0 + col] = s; }
            __syncthreads();
        } else {
            const int r = it - 192, l = r >> 4, kv = (r >> 3) & 1, c0 = (r & 7) * 32; const float* pe = (kv ? C.pe_v : C.pe_k) + (size_t)l * 2048; const float* w1 = (kv ? C.wv1 : C.wk1) + (size_t)l * 2048 * 256;
            const int kq = C.tid >> 5, col = C.tid & 31; float a = 0.f;
#pragma unroll 16
            for (int k = kq * 128; k < kq * 128 + 128; ++k) a += pe[k] * w1[(size_t)k * 256 + c0 + col];
            red[kq * 32 + col] = a; __syncthreads();
            if (C.tid < 32) { float s = 0.f;
#pragma unroll
                for (int q = 0; q < 16; ++q) s += red[q * 32 + C.tid];
                PEB[(l * 2 + kv) * 256 + c0 + C.tid] = s; }
            __syncthreads();
        }
    }
}

DI void norm_row(const Ctx& C, const float* __restrict__ xrow, const float* __restrict__ g, const float* __restrict__ sh, const float* __restrict__ sc, bf16* __restrict__ orow) {
    f32x4 v[4]; float s = 0.f;
#pragma unroll
    for (int j = 0; j < 4; ++j) { v[j] = *(const f32x4*)(xrow + 4 * C.lane + 256 * j); s += (v[j][0] * v[j][0] + v[j][1] * v[j][1]) + (v[j][2] * v[j][2] + v[j][3] * v[j][3]); }
    s = group_sum<64>(s); const float rstd = rsqrtf(s * (1.f / DM) + 1e-6f);
#pragma unroll
    for (int j = 0; j < 4; ++j) { const int k = 4 * C.lane + 256 * j; const f32x4 gg = *(const f32x4*)(g + k), a = *(const f32x4*)(sc + k), b = *(const f32x4*)(sh + k); f32x4 h;
#pragma unroll
        for (int i = 0; i < 4; ++i) h[i] = v[j][i] * rstd * gg[i] * (1.f + a[i]) + b[i];
        if (INPROJ_FP8) *(unsigned*)((unsigned char*)orow + k) = pk4_fp8(h[0], h[1], h[2], h[3]);
        else { u32x2 o; o.x = pk2(h[0], h[1]); o.y = pk2(h[2], h[3]); *(u32x2*)(orow + k) = o; } }
}
DI void norm1_phase(const Ctx& C, int l, const float* xin) {
    const float* MOD = WSP(float, WS_SMALL) + (size_t)l * 8 * 6144; bf16* H = WSP(bf16, WS_H);
    const int gw = C.bid * NWAVE + C.wave, NGW = C.G * NWAVE;
    for (int m = gw; m < NT; m += NGW) { const int b = m / NS; norm_row(C, xin + (size_t)m * DM, C.norm1_g + l * DM, MOD + b * 6144, MOD + b * 6144 + 1024, INPROJ_FP8 ? (bf16*)((unsigned char*)H + (size_t)m * DM) : H + (size_t)m * DM); }
}

constexpr float QSCALE = 0.125f * 1.44269504089f;
DI void prep_body(const Ctx& C, int l, const bf16* __restrict__ PROJ, bf16* __restrict__ SCH, bf16* __restrict__ LIN, bf16* __restrict__ YCAT, bf16* __restrict__ QC, bf16* __restrict__ KC, bf16* __restrict__ QN, bf16* __restrict__ QR,
                  bf16* __restrict__ KCR, bf16* __restrict__ VCR, bf16* __restrict__ KS, bf16* __restrict__ KW, float* __restrict__ GATE) {
    const int lane = C.lane, gw = C.bid * NWAVE + C.wave, NGW = C.G * NWAVE;
    const int hh = lane >> 4, jj = lane & 15;
    const float inv0 = exp2f(-(float)(2 * jj) * (13.287712379549449f / 32.f)) * 0.15915494309189535f, inv1 = exp2f(-(float)(2 * jj + 1) * (13.287712379549449f / 32.f)) * 0.15915494309189535f;
    for (int task = gw; task < NT / 16; task += NGW) {
        const int row0 = 16 * task, s0 = row0 % NS;
        {
            const int c0 = 16 * lane, cc = (c0 - 256) & 255; float mu16[16], kw16[16];
#pragma unroll
            for (int q = 0; q < 4; ++q) { const f32x4 m4 = *(const f32x4*)(C.mu + (size_t)l * 1024 + c0 + 4 * q), k4 = *(const f32x4*)(C.kkw + (size_t)l * 256 + cc + 4 * q);
#pragma unroll
                for (int i = 0; i < 4; ++i) { mu16[4 * q + i] = m4[i]; kw16[4 * q + i] = k4[i]; } }
#pragma unroll 2
            for (int r = 0; r < 16; ++r) {
                const int row = row0 + r; const bf16* pr = PROJ + (size_t)row * NPJ; float z[16];
                const u32x4 c0v = *(const u32x4*)(pr + c0), c1v = *(const u32x4*)(pr + c0 + 8);
                u32x4 p0v = (u32x4){0u, 0u, 0u, 0u}, p1v = p0v;
                if (s0 + r > 0) { p0v = *(const u32x4*)(pr - NPJ + c0); p1v = *(const u32x4*)(pr - NPJ + c0 + 8); }
                const unsigned cw[8] = {c0v.x, c0v.y, c0v.z, c0v.w, c1v.x, c1v.y, c1v.z, c1v.w}, pw[8] = {p0v.x, p0v.y, p0v.z, p0v.w, p1v.x, p1v.y, p1v.z, p1v.w};
#pragma unroll
                for (int e = 0; e < 16; ++e) { const float cu = (e & 1) ? bfhi(cw[e >> 1]) : bflo(cw[e >> 1]), pv = (e & 1) ? bfhi(pw[e >> 1]) : bflo(pw[e >> 1]); z[e] = cu + (pv - cu) * mu16[e]; }
                float kk[16]; float ss = 0.f;
#pragma unroll
                for (int e = 0; e < 16; ++e) { kk[e] = z[e] * kw16[e]; ss += kk[e] * kk[e]; }
                ss = group_sum<4>(ss); const float kinv = rsqrtf(ss + 1e-12f);
                if (lane < 48) {
                    const int pl = lane < 16 ? 3 : (lane < 32 ? 0 : 4); bf16* dst = SCH + ((size_t)pl * NT + row) * 256 + (c0 & 255);
                    u32x4 o0, o1; o0.x = pk2(z[0], z[1]); o0.y = pk2(z[2], z[3]); o0.z = pk2(z[4], z[5]); o0.w = pk2(z[6], z[7]); o1.x = pk2(z[8], z[9]); o1.y = pk2(z[10], z[11]); o1.z = pk2(z[12], z[13]); o1.w = pk2(z[14], z[15]);
                    *(u32x4*)dst = o0; *(u32x4*)(dst + 8) = o1;
                    if (lane >= 16 && lane < 32) { bf16* d2 = SCH + ((size_t)1 * NT + row) * 256 + cc;
                        u32x4 q0, q1; q0.x = pk2(kk[0] * kinv, kk[1] * kinv); q0.y = pk2(kk[2] * kinv, kk[3] * kinv); q0.z = pk2(kk[4] * kinv, kk[5] * kinv); q0.w = pk2(kk[6] * kinv, kk[7] * kinv);
                        q1.x = pk2(kk[8] * kinv, kk[9] * kinv); q1.y = pk2(kk[10] * kinv, kk[11] * kinv); q1.z = pk2(kk[12] * kinv, kk[13] * kinv); q1.w = pk2(kk[14] * kinv, kk[15] * kinv);
                        *(u32x4*)d2 = q0; *(u32x4*)(d2 + 8) = q1; }
                } else {
                    float t[16];
#pragma unroll
                    for (int i = 0; i < 16; ++i) { const float sg = fsigmoid(lane < 52 ? 2.f * z[i] : z[i]); t[i] = lane < 52 ? 2.f * sg - 1.f : (lane < 56 ? z[i] : sg); }
                    bf16* dst = LIN + (size_t)row * 256 + (c0 - 768);
                    u32x4 o0, o1; o0.x = pk2(t[0], t[1]); o0.y = pk2(t[2], t[3]); o0.z = pk2(t[4], t[5]); o0.w = pk2(t[6], t[7]); o1.x = pk2(t[8], t[9]); o1.y = pk2(t[10], t[11]); o1.z = pk2(t[12], t[13]); o1.w = pk2(t[14], t[15]);
                    *(u32x4*)dst = o0; *(u32x4*)(dst + 8) = o1;
                }
            }
        }
        {
            const int ch = 4 * lane; const float* cw = C.conv_w + (size_t)l * 3 * 256 + ch; const f32x4 w0 = *(const f32x4*)cw, w1 = *(const f32x4*)(cw + 256), w2 = *(const f32x4*)(cw + 512);
            const f32x4 og = *(const f32x4*)(C.onorm_g + (size_t)l * 768 + ch);
#pragma unroll 2
            for (int r = 0; r < 16; ++r) {
                const int row = row0 + r, s = s0 + r; const bf16* pr = PROJ + (size_t)row * NPJ; float u[3][4];
#pragma unroll
                for (int d = 0; d < 3; ++d) {
                    u32x2 cg = (u32x2){0u, 0u}, xi = cg;
                    if (s >= d) { cg = *(const u32x2*)(pr - (size_t)d * NPJ + PJ_B + 256 + ch); xi = *(const u32x2*)(pr - (size_t)d * NPJ + PJ_B + 512 + ch); }
                    u[d][0] = bflo(cg.x) * bflo(xi.x); u[d][1] = bfhi(cg.x) * bfhi(xi.x); u[d][2] = bflo(cg.y) * bflo(xi.y); u[d][3] = bfhi(cg.y) * bfhi(xi.y);
                }
                const u32x2 bgv = *(const u32x2*)(pr + PJ_B + ch); const float bg[4] = {bflo(bgv.x), bfhi(bgv.x), bflo(bgv.y), bfhi(bgv.y)};
                float y[4]; float ss = 0.f;
#pragma unroll
                for (int i = 0; i < 4; ++i) { y[i] = bg[i] * (w0[i] * u[2][i] + w1[i] * u[1][i] + w2[i] * u[0][i]); ss += y[i] * y[i]; }
                ss = group_sum<16>(ss); const float rstd = rsqrtf(ss * (1.f / 64.f) + 1e-6f);
                u32x2 o; o.x = pk2(y[0] * rstd * og[0], y[1] * rstd * og[1]); o.y = pk2(y[2] * rstd * og[2], y[3] * rstd * og[3]);
                *(u32x2*)(YCAT + (size_t)row * DM + 256 + ch) = o;
            }
        }
        {
            const float* gq = C.dil_q_g + (size_t)l * 64; const float* gk = C.dil_k_g + (size_t)l * 64; const float* gn = C.nsa_q_g + (size_t)l * 64; const float* gv = (hh == 0 ? C.nsa_ks_g : C.nsa_kw_g) + (size_t)l * 64;
            float Gq[4], Gk[4], Gn[4], Gv[4];
#pragma unroll
            for (int i = 0; i < 4; ++i) { const int d = (i >> 1) * 32 + 2 * jj + (i & 1); Gq[i] = gq[d] * QSCALE; Gk[i] = gk[d]; Gn[i] = gn[d] * QSCALE; Gv[i] = gv[d]; }
            const int vcol = hh == 0 ? 2944 : (hh == 1 ? 3072 : (hh == 2 ? 2816 : 2880));
            bf16* vdst = (hh == 0 ? KS : (hh == 1 ? KW : (hh == 2 ? KCR : VCR)));
#pragma unroll 2
            for (int r = 0; r < 16; ++r) {
                const int row = row0 + r; const bf16* pr = PROJ + (size_t)row * NPJ;
                const float posf = (float)C.pos[row];
                const float x0 = __builtin_amdgcn_fractf(posf * inv0), x1 = __builtin_amdgcn_fractf(posf * inv1);
                const float sn0 = __builtin_amdgcn_sinf(x0), cs0 = __builtin_amdgcn_cosf(x0), sn1 = __builtin_amdgcn_sinf(x1), cs1 = __builtin_amdgcn_cosf(x1);
                const unsigned qa = *(const unsigned*)(pr + PJ_C + hh * 64 + 2 * jj), qb = *(const unsigned*)(pr + PJ_C + hh * 64 + 32 + 2 * jj);
                const unsigned ka = *(const unsigned*)(pr + PJ_C + 256 + hh * 64 + 2 * jj), kb = *(const unsigned*)(pr + PJ_C + 256 + hh * 64 + 32 + 2 * jj);
                const unsigned na = *(const unsigned*)(pr + PJ_D + hh * 64 + 2 * jj), nb = *(const unsigned*)(pr + PJ_D + hh * 64 + 32 + 2 * jj);
                const unsigned va = *(const unsigned*)(pr + vcol + 2 * jj), vb = *(const unsigned*)(pr + vcol + 32 + 2 * jj);
                float gate_in = 0.f; if (lane < 12) gate_in = bf2f(pr[3200 + lane]);
#define ROPE_NORM(a, b, G, o1, o2, n1a, n1b, n2a, n2b) \
                float n1a = bflo(a), n1b = bfhi(a), n2a = bflo(b), n2b = bfhi(b); { const float ss_ = group_sum<16>(n1a * n1a + n1b * n1b + n2a * n2a + n2b * n2b); const float rs_ = rsqrtf(ss_ * (1.f / 64.f) + 1e-6f); \
                    n1a *= rs_ * G[0]; n1b *= rs_ * G[1]; n2a *= rs_ * G[2]; n2b *= rs_ * G[3]; } \
                const unsigned o1 = pk2(n1a * cs0 - n2a * sn0, n1b * cs1 - n2b * sn1), o2 = pk2(n2a * cs0 + n1a * sn0, n2b * cs1 + n1b * sn1);
                ROPE_NORM(qa, qb, Gq, q1, q2, q1a, q1b, q2a, q2b)
                ROPE_NORM(ka, kb, Gk, k1, k2, k1a, k1b, k2a, k2b)
                ROPE_NORM(na, nb, Gn, r1, r2, r1a, r1b, r2a, r2b)
                ROPE_NORM(va, vb, Gv, v1, v2, v1a, v1b, v2a, v2b)
#undef ROPE_NORM
                bf16* o = QC + (size_t)row * 256 + hh * 64 + 2 * jj; *(unsigned*)o = q1; *(unsigned*)(o + 32) = q2;
                o = KC + (size_t)row * 256 + hh * 64 + 2 * jj; *(unsigned*)o = k1; *(unsigned*)(o + 32) = k2;
                o = QN + (size_t)row * 256 + hh * 64 + 2 * jj; *(unsigned*)o = pk2(r1a, r1b); *(unsigned*)(o + 32) = pk2(r2a, r2b);
                o = QR + (size_t)row * 256 + hh * 64 + 2 * jj; *(unsigned*)o = r1; *(unsigned*)(o + 32) = r2;
                o = vdst + (size_t)row * 64 + 2 * jj; *(unsigned*)o = (hh >= 2) ? va : v1; *(unsigned*)(o + 32) = (hh >= 2) ? vb : v2;
                if (lane < 12) GATE[(size_t)row * 12 + lane] = fsigmoid(gate_in);
            }
        }
    }
}
DI void prep_phase(const Ctx& C, int l) {
    prep_body(C, l, WSP(bf16, R_PROJ), WSP(bf16, R_SCH), WSP(bf16, R_LIN), WSP(bf16, R_YCAT), WSP(bf16, R_QC), WSP(bf16, R_KC), WSP(bf16, R_QN), WSP(bf16, R_QR), WSP(bf16, R_KCR), WSP(bf16, R_VCR), WSP(bf16, R_KS), WSP(bf16, R_KW), WSP(float, R_GATE));
}
constexpr int SCAN_TC = 16;
DI void scan_unit8(const Ctx& C, int u) {
    const float* Wp = WSP(float, R_SC); const bf16* SCH = WSP(bf16, R_SCH); float* YA = WSP(float, R_YA); float* UB = WSP(float, R_SCANU); float* SMT = WSP(float, R_SCANS);
    const int pair = u / 3, kind = u % 3, b = pair >> 2, h = pair & 3, tid = C.tid;
    LAS float* buf = (LAS float*)C.lds;
    LAS float* ybuf = buf + 2 * 6144;
    const int row = tid >> 3, cg = tid & 7, tbase = kind == 0 ? 0 : NS / 2;
    const float vm = kind == 2 ? 0.f : 1.f;
    u32x4 ldA[2], ldB[2];
#define SCAN_LOAD(ld, chunk) do { _Pragma("unroll") for (int i = 0; i < 2; ++i) { const int p_ = tid + 512 * i; if (p_ < 896) { const int step = p_ / 56, r_ = p_ % 56; const size_t row_ = (size_t)b * NS + tbase + (chunk) * SCAN_TC + step; \
        if (r_ < 16) ld[i] = *(const u32x4*)(Wp + row_ * 256 + h * 64 + r_ * 4); else { const int v5 = (r_ - 16) >> 3, c_ = (r_ - 16) & 7; ld[i] = *(const u32x4*)(SCH + ((size_t)v5 * NT + row_) * 256 + h * 64 + c_ * 8); } } } } while (0)
#define SCAN_STORE(ld, slot) do { asm volatile("" :: "v"(ld[0]), "v"(ld[1]));     \
        _Pragma("unroll") for (int i = 0; i < 2; ++i) { const int p_ = tid + 512 * i; if (p_ < 896) { const int step = p_ / 56, r_ = p_ % 56; LAS float* d_ = buf + (slot) * 6144 + step * 384; \
        if (r_ < 16) *(LAS u32x4*)(d_ + r_ * 4) = ld[i]; else { const int v5 = (r_ - 16) >> 3, c_ = (r_ - 16) & 7; LAS float* e_ = d_ + (1 + v5) * 64 + c_ * 8; const u32x4 x_ = ld[i]; \
            *(LAS f32x4*)e_ = (f32x4){bflo(x_.x), bfhi(x_.x), bflo(x_.y), bfhi(x_.y)}; *(LAS f32x4*)(e_ + 4) = (f32x4){bflo(x_.z), bfhi(x_.z), bflo(x_.w), bfhi(x_.w)}; } } } } while (0)
#define SCAN_FLUSH(chunk) do { _Pragma("unroll") for (int i = 0; i < 2; ++i) { const int i2 = tid + 512 * i, step = i2 >> 6, rr = i2 & 63; const LAS float* pp_ = ybuf + ((chunk) & 1) * 8192 + step * 512 + rr * 8; \
        const f32x4 pa_ = *(const LAS f32x4*)pp_, pb_ = *(const LAS f32x4*)(pp_ + 4); const float yv = ((pa_[0] + pa_[1]) + (pa_[2] + pa_[3])) + ((pb_[0] + pb_[1]) + (pb_[2] + pb_[3])); \
        if (kind == 2) UB[((size_t)b * (NS / 2) + (chunk) * SCAN_TC + step) * 256 + h * 64 + rr] = yv; else YA[((size_t)b * NS + tbase + (chunk) * SCAN_TC + step) * 256 + h * 64 + rr] = yv; } } while (0)
    __syncthreads();
    SCAN_LOAD(ldA, 0); SCAN_STORE(ldA, 0); SCAN_LOAD(ldB, 1); SCAN_LOAD(ldA, 2);
    f32x2 S[4];
#pragma unroll
    for (int c = 0; c < 4; ++c) { S[c][0] = (kind == 2 && row == 8 * cg + 2 * c) ? 1.f : 0.f; S[c][1] = (kind == 2 && row == 8 * cg + 2 * c + 1) ? 1.f : 0.f; }
    constexpr int NCH = (NS / 2) / SCAN_TC;
#pragma unroll 2
    for (int ck = 0; ck < NCH; ++ck) {
        __syncthreads();
        if (ck & 1) { if (ck + 1 < NCH) SCAN_STORE(ldA, (ck + 1) & 1); if (ck + 3 < NCH) SCAN_LOAD(ldA, ck + 3); }
        else        { if (ck + 1 < NCH) SCAN_STORE(ldB, (ck + 1) & 1); if (ck + 3 < NCH) SCAN_LOAD(ldB, ck + 3); }
        if (ck > 0) SCAN_FLUSH(ck - 1);
        {
            const LAS float* bp = buf + (ck & 1) * 6144; LAS float* yb = ybuf + (ck & 1) * 8192 + tid;
#define SCAN_LDS(X, step) do { const LAS float* sp = bp + (step) * 384 + 8 * cg; X.w0 = *(const LAS f32x4*)(sp); X.w1 = *(const LAS f32x4*)(sp + 4); X.k0 = *(const LAS f32x4*)(sp + 64); X.k1 = *(const LAS f32x4*)(sp + 68); \
                X.q0 = *(const LAS f32x4*)(sp + 128); X.q1 = *(const LAS f32x4*)(sp + 132); X.b0 = *(const LAS f32x4*)(sp + 192); X.b1 = *(const LAS f32x4*)(sp + 196); \
                X.r0 = *(const LAS f32x4*)(sp + 256); X.r1 = *(const LAS f32x4*)(sp + 260); X.v = bp[(step) * 384 + 320 + row] * vm; } while (0)
#define SCAN_STEP(X, step) do { \
                f32x2 d2 = S[0] * (f32x2){X.q0[0], X.q0[1]}; d2 = S[1] * (f32x2){X.q0[2], X.q0[3]} + d2; d2 = S[2] * (f32x2){X.q1[0], X.q1[1]} + d2; d2 = S[3] * (f32x2){X.q1[2], X.q1[3]} + d2; \
                const float sa = -sum8(d2[0] + d2[1]); const f32x2 sa2 = (f32x2){sa, sa}, v2 = (f32x2){X.v, X.v}; \
                S[0] = S[0] * (f32x2){X.w0[0], X.w0[1]} + (sa2 * (f32x2){X.b0[0], X.b0[1]} + v2 * (f32x2){X.k0[0], X.k0[1]}); \
                S[1] = S[1] * (f32x2){X.w0[2], X.w0[3]} + (sa2 * (f32x2){X.b0[2], X.b0[3]} + v2 * (f32x2){X.k0[2], X.k0[3]}); \
                S[2] = S[2] * (f32x2){X.w1[0], X.w1[1]} + (sa2 * (f32x2){X.b1[0], X.b1[1]} + v2 * (f32x2){X.k1[0], X.k1[1]}); \
                S[3] = S[3] * (f32x2){X.w1[2], X.w1[3]} + (sa2 * (f32x2){X.b1[2], X.b1[3]} + v2 * (f32x2){X.k1[2], X.k1[3]}); \
                f32x2 y2 = S[0] * (f32x2){X.r0[0], X.r0[1]}; y2 = S[1] * (f32x2){X.r0[2], X.r0[3]} + y2; y2 = S[2] * (f32x2){X.r1[0], X.r1[1]} + y2; y2 = S[3] * (f32x2){X.r1[2], X.r1[3]} + y2; \
                yb[(step) * 512] = y2[0] + y2[1]; } while (0)
            struct StepIn { f32x4 w0, w1, k0, k1, q0, q1, b0, b1, r0, r1; float v; } A, B;
            SCAN_LDS(A, 0);
#pragma unroll 2
            for (int step = 0; step < SCAN_TC; step += 2) {
                SCAN_LDS(B, step + 1);
                SCAN_STEP(A, step);
                if (step + 2 < SCAN_TC) SCAN_LDS(A, step + 2);
                SCAN_STEP(B, step + 1);
            }
#undef SCAN_LDS
#undef SCAN_STEP
        }
    }
    __syncthreads();
    SCAN_FLUSH(NCH - 1);
    if (kind == 0) {
        float* o = SMT + (size_t)pair * 4096 + row;
#pragma unroll
        for (int c = 0; c < 4; ++c) { o[(8 * cg + 2 * c) * 64] = S[c][0]; o[(8 * cg + 2 * c + 1) * 64] = S[c][1]; }
    }
#undef SCAN_LOAD
#undef SCAN_STORE
#undef SCAN_FLUSH
    __syncthreads();
}

constexpr int KROW = 144, KT_BYTES = 64 * KROW;
#define MFMA16(a, b, c) __builtin_amdgcn_mfma_f32_16x16x32_bf16((a), (b), (c), 0, 0, 0)
template <int NQT> struct FA { f32x4 O[NQT][4]; f32x4 L[NQT]; float negM; };
template <int NQT> DI void fa_init(FA<NQT>& st) {
#pragma unroll
    for (int q = 0; q < NQT; ++q) { st.L[q] = (f32x4){0.f, 0.f, 0.f, 0.f};
#pragma unroll
        for (int d = 0; d < 4; ++d) st.O[q][d] = (f32x4){0.f, 0.f, 0.f, 0.f}; }
}
DI bf16x8 pack8(const f32x4& a, const f32x4& b) { u32x4 w; w.x = pk2(a[0], a[1]); w.y = pk2(a[2], a[3]); w.z = pk2(b[0], b[1]); w.w = pk2(b[2], b[3]); return __builtin_bit_cast(bf16x8, w); }
struct VFrag { u32x2 a[4], b[4]; };
DI void vt_issue(VFrag& f, unsigned vaddr) {
    asm volatile("ds_read_b64_tr_b16 %0, %8\n\tds_read_b64_tr_b16 %1, %8 offset:2304\n\tds_read_b64_tr_b16 %2, %8 offset:32\n\tds_read_b64_tr_b16 %3, %8 offset:2336\n\t"
                 "ds_read_b64_tr_b16 %4, %8 offset:64\n\tds_read_b64_tr_b16 %5, %8 offset:2368\n\tds_read_b64_tr_b16 %6, %8 offset:96\n\tds_read_b64_tr_b16 %7, %8 offset:2400"
                 : "=&v"(f.a[0]), "=&v"(f.b[0]), "=&v"(f.a[1]), "=&v"(f.b[1]), "=&v"(f.a[2]), "=&v"(f.b[2]), "=&v"(f.a[3]), "=&v"(f.b[3]) : "v"(vaddr) : "memory");
}
DI void vt_wait(VFrag& f) { asm volatile("s_waitcnt lgkmcnt(0)" : "+v"(f.a[0]), "+v"(f.b[0]), "+v"(f.a[1]), "+v"(f.b[1]), "+v"(f.a[2]), "+v"(f.b[2]), "+v"(f.a[3]), "+v"(f.b[3]) :: "memory"); }
DI bf16x8 vt_get(const VFrag& f, int d) { return __builtin_bit_cast(bf16x8, ((u32x4){f.a[d].x, f.a[d].y, f.b[d].x, f.b[d].y})); }
template <int NQT, bool MASKED, class MaskF>
DI void fa_tile(FA<NQT>& st, const bf16x8 (&Q)[NQT][2], const LAS uchar* Ks, const LAS uchar* Vs, int lane, const MaskF& allowed, const bool (&act)[NQT], const float (&init)[NQT]) {
    const int l15 = lane & 15, quad = lane >> 4;
    f32x4 S[NQT][4]; f32x4 sinit[NQT];
#pragma unroll
    for (int q = 0; q < NQT; ++q) { float nm_ = init[q]; asm volatile("" : "+v"(nm_)); sinit[q] = (f32x4){nm_, nm_, nm_, nm_}; }
#pragma unroll
    for (int kt = 0; kt < 4; ++kt) {
        const bf16x8 k0 = *(const LAS bf16x8*)(Ks + (16 * kt + l15) * KROW + quad * 16), k1 = *(const LAS bf16x8*)(Ks + (16 * kt + l15) * KROW + 64 + quad * 16);
#pragma unroll
        for (int q = 0; q < NQT; ++q) if (act[q]) { S[q][kt] = MFMA16(k0, Q[q][0], sinit[q]); S[q][kt] = MFMA16(k1, Q[q][1], S[q][kt]); }
    }
    const unsigned vaddr = (unsigned)(size_t)(Vs + (4 * quad + (l15 >> 2)) * KROW + 8 * (l15 & 3));
    VFrag v0, v1; vt_issue(v0, vaddr);
#pragma unroll
    for (int q = 0; q < NQT; ++q) if (act[q]) {
#pragma unroll
        for (int kt = 0; kt < 4; ++kt)
#pragma unroll
            for (int j = 0; j < 4; ++j) { float p = fexp2(S[q][kt][j]); if (MASKED) p = allowed(q, 16 * kt + 4 * quad + j) ? p : 0.f; S[q][kt][j] = p; }
    }
    const bf16x8 ones = __builtin_bit_cast(bf16x8, ((u32x4){0x3F803F80u, 0x3F803F80u, 0x3F803F80u, 0x3F803F80u}));
    vt_wait(v0); vt_issue(v1, vaddr + 32 * KROW);
#pragma unroll
    for (int q = 0; q < NQT; ++q) if (act[q]) {
        const bf16x8 p0 = pack8(S[q][0], S[q][1]);
#pragma unroll
        for (int d = 0; d < 4; ++d) st.O[q][d] = MFMA16(vt_get(v0, d), p0, st.O[q][d]);
        st.L[q] = MFMA16(ones, p0, st.L[q]);
    }
    vt_wait(v1);
#pragma unroll
    for (int q = 0; q < NQT; ++q) if (act[q]) {
        const bf16x8 p1 = pack8(S[q][2], S[q][3]);
#pragma unroll
        for (int d = 0; d < 4; ++d) st.O[q][d] = MFMA16(vt_get(v1, d), p1, st.O[q][d]);
        st.L[q] = MFMA16(ones, p1, st.L[q]);
    }
}
template <int NQT> DI void fa_finish(FA<NQT>& st, float (&lse2)[NQT]) {
#pragma unroll
    for (int q = 0; q < NQT; ++q) { const float l = st.L[q][0]; const float inv = l > 0.f ? 1.f / l : 0.f; lse2[q] = __log2f(fmaxf(l, 1e-37f));
#pragma unroll
        for (int d = 0; d < 4; ++d) st.O[q][d] = st.O[q][d] * inv; }
}
DI float score_bound(const float* gq, const float* gk, int lane) {
    float a = fabsf(gq[lane & 63]), b = fabsf(gk[lane & 63]);
#pragma unroll
    for (int o = 1; o < 64; o <<= 1) { a = fmaxf(a, __shfl_xor(a, o)); b = fmaxf(b, __shfl_xor(b, o)); }
    return __builtin_bit_cast(float, __builtin_amdgcn_readfirstlane(__builtin_bit_cast(int, 64.f * a * b * QSCALE * 1.02f + 0.5f)));
}
DI void kv_store(LAS uchar* Ks, LAS uchar* Vs, int tid, const u32x4& kr, const u32x4& vr) {
    const int o = (tid >> 3) * KROW + (tid & 7) * 16; *(LAS u32x4*)(Ks + o) = kr; *(LAS u32x4*)(Vs + o) = vr;
}
DI void q_ready(const bf16x8 (&Q)[2][2]) { asm volatile("" :: "v"(Q[0][0]), "v"(Q[0][1]), "v"(Q[1][0]), "v"(Q[1][1])); }
DI void q_load(bf16x8 (&Q)[2], const bf16* qrow, int quad) { Q[0] = *(const bf16x8*)(qrow + 8 * quad); Q[1] = *(const bf16x8*)(qrow + 32 + 8 * quad); }

struct NoMask { DI bool operator()(int, int) const { return true; } };
struct DilMask { int qi[2]; int k0; DI bool operator()(int q, int key) const { const int ki = k0 + key, d = qi[q] - ki; return ki >= 0 && (unsigned)d <= 128u; } };
DI void dil_unit(const Ctx& C, int unit, LAS uchar* lds0, LAS uchar*  , float negM_bound) {
    const bf16 *QC = WSP(bf16, R_QC), *KC = WSP(bf16, R_KC), *PROJ = WSP(bf16, R_PROJ); float* OC = WSP(float, R_OC); float* LSE = WSP(float, R_LSE);
    int tid = C.tid, lane = C.lane; asm volatile("" : "+v"(tid), "+v"(lane));
    const int w = C.wave, l15 = lane & 15, quad = lane >> 4, wq = w & 3;
    const int cfg = unit / 512, r = unit % 512, dsh = 2 * cfg, d = 1 << dsh;
    const int b = r >> 6, hp = (r >> 5) & 1, r2 = r & 31;
    const int nblk = 32 >> dsh, res = r2 / nblk, blk = r2 % nblk, i0 = blk * 128, h = 2 * hp + (w >> 2);
    const size_t tb = (size_t)b * NS;
    bf16x8 Q[2][2]; DilMask mk; FA<2> st; fa_init(st); st.negM = -negM_bound;
#pragma unroll
    for (int q = 0; q < 2; ++q) { mk.qi[q] = i0 + 32 * wq + 16 * q + l15; q_load(Q[q], QC + (tb + res + (size_t)d * mk.qi[q]) * 256 + h * 64, quad); }
    const int jlo = wq >> 1, jhi = (wq >> 1) + 2;
    const bool act[2] = {true, true};
    u32x4 kr0, vr0, kr1, vr1;
#define DIL_LOAD(j) do { const int ki = i0 - 128 + 64 * (j) + (tid >> 3); kr0 = (u32x4){0u, 0u, 0u, 0u}; vr0 = kr0; kr1 = kr0; vr1 = kr0; \
    if (ki >= 0) { const size_t rowk = tb + res + (size_t)d * ki; const bf16* kp = KC + rowk * 256 + 128 * hp + (tid & 7) * 8; const bf16* vp = PROJ + rowk * NPJ + PJ_C + 512 + 128 * hp + (tid & 7) * 8; \
        kr0 = *(const u32x4*)kp; kr1 = *(const u32x4*)(kp + 64); vr0 = *(const u32x4*)vp; vr1 = *(const u32x4*)(vp + 64); } } while (0)
#define DIL_STORE(p) do { LAS uchar* b_ = lds0 + (p) * 4 * KT_BYTES; kv_store(b_, b_ + KT_BYTES, tid, kr0, vr0); kv_store(b_ + 2 * KT_BYTES, b_ + 3 * KT_BYTES, tid, kr1, vr1); } while (0)
    DIL_LOAD(0); q_ready(Q); __syncthreads(); DIL_STORE(0); DIL_LOAD(1);
    for (int j = 0; j < 4; ++j) {
        __syncthreads();
        if (j + 1 < 4) DIL_STORE((j + 1) & 1);
        if (j + 2 < 4) DIL_LOAD(j + 2);
        if (j >= jlo && j <= jhi) { mk.k0 = i0 - 128 + 64 * j; const LAS uchar* kb = lds0 + (j & 1) * 4 * KT_BYTES + (w >> 2) * 2 * KT_BYTES; const float ini[2] = {-negM_bound, -negM_bound};
            if (j == jlo + 1 && i0 > 0) fa_tile<2, false>(st, Q, kb, kb + KT_BYTES, lane, NoMask(), act, ini);
            else fa_tile<2, true>(st, Q, kb, kb + KT_BYTES, lane, mk, act, ini); }
    }
#undef DIL_LOAD
#undef DIL_STORE
    float lse2[2]; fa_finish<2>(st, lse2);
#pragma unroll
    for (int q = 0; q < 2; ++q) { const size_t rowq = tb + res + (size_t)d * mk.qi[q]; bf16* o = (bf16*)OC + ((size_t)cfg * NT + rowq) * 256 + h * 64 + 4 * quad;
#pragma unroll
        for (int dt = 0; dt < 4; ++dt) { u32x2 w_; w_.x = pk2(st.O[q][dt][0], st.O[q][dt][1]); w_.y = pk2(st.O[q][dt][2], st.O[q][dt][3]); *(u32x2*)(o + 16 * dt) = w_; }
        if (quad == 0) LSE[((size_t)cfg * NT + rowq) * 4 + h] = lse2[q]; }
}
constexpr int NSA_KC = 0, NSA_VC = 256 * KROW, NSA_KT = 2 * 256 * KROW, NSA_VT = NSA_KT + KT_BYTES, NSA_IMP = NSA_KT + 4 * KT_BYTES,
    NSA_SELM = NSA_IMP + 64 * 64 * 4, NSA_UW = NSA_SELM + 512;
static_assert(NSA_UW + 16 <= RING_BYTES, "NSA LDS map");
DI void cmp_mlp_wait(const Ctx& C, int l);
struct SwaMask { int t[2]; int k0; DI bool operator()(int q, int key) const { const int d = t[q] - (k0 + key); return (unsigned)d <= 511u; } };
struct SlcMask { int t[2]; int k0; DI bool operator()(int q, int key) const { return k0 + key <= t[q]; } };
DI void nsa_unit(const Ctx& C, int l, int b, int tbk, int& bl, bool& cmp_ready, float bnd_cmp, float bnd_slc, float bnd_swa) {
    const bf16 *QN = WSP(bf16, R_QN), *QR = WSP(bf16, R_QR), *KSb = WSP(bf16, R_KS), *KWb = WSP(bf16, R_KW), *PROJ = WSP(bf16, R_PROJ); const float* CMP = WSP(float, R_CMP); const float* GATE = WSP(float, R_GATE);
    bf16* YCAT = WSP(bf16, R_YCAT);
    LAS uchar* Kc = C.lds + NSA_KC; LAS uchar* Vc = C.lds + NSA_VC; LAS uchar* Ks = C.lds + NSA_KT; LAS uchar* Vs = C.lds + NSA_VT;
    LAS float* imps = (LAS float*)(C.lds + NSA_IMP); LAS unsigned* selm = (LAS unsigned*)(C.lds + NSA_SELM); LAS unsigned* uw = (LAS unsigned*)(C.lds + NSA_UW);
    int tid = C.tid, lane = C.lane; asm volatile("" : "+v"(tid), "+v"(lane));
    const int w = C.wave, l15 = lane & 15, quad = lane >> 4, head = l15 & 3, t0 = 64 * tbk; const size_t tb = (size_t)b * NS;
    __syncthreads();
    if (b != bl) {
        if (!cmp_ready) { cmp_mlp_wait(C, l); cmp_ready = true; }
        const int key = tid >> 1, hf = tid & 1; const float* kp = CMP + ((size_t)b * 256 + key) * 64 + 32 * hf; const float* vp = CMP + ((size_t)2048 + (size_t)b * 256 + key) * 64 + 32 * hf;
        float kv[32], vv[32]; float ss = 0.f;
#pragma unroll
        for (int i = 0; i < 8; ++i) { const f32x4 a = *(const f32x4*)(kp + 4 * i), c = *(const f32x4*)(vp + 4 * i);
#pragma unroll
            for (int j = 0; j < 4; ++j) { kv[4 * i + j] = a[j]; vv[4 * i + j] = c[j]; ss += a[j] * a[j]; } }
        ss += __shfl_xor(ss, 1); const float rstd = rsqrtf(ss * (1.f / 64.f) + 1e-6f); const float* g = C.nsa_kc_g + (size_t)l * 64 + 32 * hf; const bool dead = (key == 255);
#pragma unroll
        for (int i = 0; i < 4; ++i) { u32x4 o, p;
            o.x = pk2(kv[8 * i] * rstd * g[8 * i], kv[8 * i + 1] * rstd * g[8 * i + 1]); o.y = pk2(kv[8 * i + 2] * rstd * g[8 * i + 2], kv[8 * i + 3] * rstd * g[8 * i + 3]);
            o.z = pk2(kv[8 * i + 4] * rstd * g[8 * i + 4], kv[8 * i + 5] * rstd * g[8 * i + 5]); o.w = pk2(kv[8 * i + 6] * rstd * g[8 * i + 6], kv[8 * i + 7] * rstd * g[8 * i + 7]);
            p.x = pk2(vv[8 * i], vv[8 * i + 1]); p.y = pk2(vv[8 * i + 2], vv[8 * i + 3]); p.z = pk2(vv[8 * i + 4], vv[8 * i + 5]); p.w = pk2(vv[8 * i + 6], vv[8 * i + 7]);
            if (dead) { o = (u32x4){0u, 0u, 0u, 0u}; p = o; }
            *(LAS u32x4*)(Kc + key * KROW + hf * 64 + i * 16) = o; *(LAS u32x4*)(Vc + key * KROW + hf * 64 + i * 16) = p; }
        bl = b;
        __syncthreads();
    }
    f32x4 Oc[2][4];
    const int cmaxu = (t0 + 32) >> 4, ktmax = cmaxu >> 4;
    const unsigned vaddr0 = (unsigned)(size_t)(Vc + (4 * quad + (l15 >> 2)) * KROW + 8 * (l15 & 3));
#pragma unroll
    for (int q = 0; q < 2; ++q) {
        const int t = t0 + 8 * w + 4 * q + (l15 >> 2);
        bf16x8 Q[2]; q_load(Q, QN + (tb + t) * 256 + head * 64, quad);
        float nm_ = -bnd_cmp; asm volatile("" : "+v"(nm_)); f32x4 S[16]; const f32x4 sinit = (f32x4){nm_, nm_, nm_, nm_}; float ls = 0.f;
#pragma unroll
        for (int kt = 0; kt < 16; ++kt) {
            if (kt <= ktmax) {
                const bf16x8 k0 = *(const LAS bf16x8*)(Kc + (16 * kt + l15) * KROW + quad * 16), k1 = *(const LAS bf16x8*)(Kc + (16 * kt + l15) * KROW + 64 + quad * 16);
                S[kt] = MFMA16(k0, Q[0], sinit); S[kt] = MFMA16(k1, Q[1], S[kt]);
#pragma unroll
                for (int j = 0; j < 4; ++j) { const int c = 16 * kt + 4 * quad + j; const float p = (16 * c + 31 <= t) ? fexp2(S[kt][j]) : 0.f; S[kt][j] = p; ls += p; }
            } else S[kt] = (f32x4){0.f, 0.f, 0.f, 0.f};
        }
        ls += __shfl_xor(ls, 16); ls += __shfl_xor(ls, 32);
        const float inv = ls > 0.f ? 1.f / ls : 0.f;
#pragma unroll
        for (int kt = 0; kt < 16; ++kt) S[kt] = S[kt] * inv;
#pragma unroll
        for (int kt = 0; kt < 16; ++kt) {
            const float send = (quad == 3) ? (kt > 0 ? S[kt > 0 ? kt - 1 : 0][3] : 0.f) : S[kt][3];
            const float prev = __shfl(send, (lane + 48) & 63);
            float v = ((quad == 0 && kt == 0) ? 0.f : prev) + 2.f * (S[kt][0] + S[kt][1] + S[kt][2]) + S[kt][3];
            v = group_sum<4>(v);
            if (head == 0) imps[(8 * w + 4 * q + (l15 >> 2)) * 64 + 4 * kt + quad] = v;
        }
#pragma unroll
        for (int d = 0; d < 4; ++d) Oc[q][d] = (f32x4){0.f, 0.f, 0.f, 0.f};
#pragma unroll
        for (int ks = 0; ks < 8; ++ks) {
            if (2 * ks <= ktmax) {
                VFrag vf; vt_issue(vf, vaddr0 + ks * 32 * KROW); const bf16x8 pf = pack8(S[2 * ks], S[2 * ks + 1]); vt_wait(vf);
#pragma unroll
                for (int d = 0; d < 4; ++d) Oc[q][d] = MFMA16(vt_get(vf, d), pf, Oc[q][d]);
            }
        }
    }
    {
        bf16* OCm = WSP(bf16, R_OCMP);
#pragma unroll
        for (int q = 0; q < 2; ++q) { bf16* o = OCm + (tb + t0 + 8 * w + 4 * q + (l15 >> 2)) * 256 + head * 64 + 4 * quad;
#pragma unroll
            for (int d = 0; d < 4; ++d) { u32x2 w_; w_.x = pk2(Oc[q][d][0], Oc[q][d][1]); w_.y = pk2(Oc[q][d][2], Oc[q][d][3]); *(u32x2*)(o + 16 * d) = w_; } }
    }
    __syncthreads();
    if (tid < 64) {
        const int cur = tbk; unsigned long long mask;
        if (cur <= 15) mask = (2ull << cur) - 1ull;
        else {
            mask = 1ull | (1ull << cur) | (1ull << (cur - 1));
            float v[64];
#pragma unroll
            for (int i = 0; i < 16; ++i) { const f32x4 a = *(const LAS f32x4*)(imps + tid * 64 + 4 * i);
#pragma unroll
                for (int j = 0; j < 4; ++j) { const int jb = 4 * i + j; v[jb] = (jb >= 1 && jb <= cur - 2) ? a[j] : -1.f; } }
#pragma unroll 1
            for (int r = 0; r < 13; ++r) {
                float bv = -0.5f; int bi = 0;
#pragma unroll
                for (int jb = 0; jb < 64; ++jb) if (v[jb] > bv) { bv = v[jb]; bi = jb; }
                mask |= 1ull << bi;
#pragma unroll
                for (int jb = 0; jb < 64; ++jb) v[jb] = (jb == bi) ? -1.f : v[jb];
            }
        }
        unsigned lo = (unsigned)mask, hi = (unsigned)(mask >> 32);
        selm[2 * tid] = lo; selm[2 * tid + 1] = hi;
#pragma unroll
        for (int o = 1; o < 64; o <<= 1) { lo |= __shfl_xor(lo, o); hi |= __shfl_xor(hi, o); }
        if (tid == 0) { uw[0] = lo; uw[1] = hi; }
    }
    __syncthreads();
    unsigned long long U = ((unsigned long long)uw[1] << 32) | uw[0];
    bf16x8 Q[2][2]; SlcMask mk; FA<2> st; fa_init(st); st.negM = -bnd_slc; unsigned long long msk[2];
#pragma unroll
    for (int q = 0; q < 2; ++q) { const int tl = 8 * w + 4 * q + (l15 >> 2); mk.t[q] = t0 + tl; msk[q] = ((unsigned long long)selm[2 * tl + 1] << 32) | selm[2 * tl]; q_load(Q[q], QR + (tb + mk.t[q]) * 256 + head * 64, quad); }
    unsigned long long QM[2];
#pragma unroll
    for (int q = 0; q < 2; ++q) { unsigned lo = (unsigned)msk[q], hi = (unsigned)(msk[q] >> 32);
#pragma unroll
        for (int o = 1; o < 64; o <<= 1) { lo |= __shfl_xor(lo, o); hi |= __shfl_xor(hi, o); }
        QM[q] = ((unsigned long long)hi << 32) | lo; }
#ifndef PROBE_SLC2
#define PROBE_SLC2 0
#endif
#ifndef PROBE_SWA2
#define PROBE_SWA2 0
#endif
    u32x4 kr, vr; const unsigned long long U0 = U;
    for (int prep_ = 0; prep_ <= PROBE_SLC2; ++prep_) { U = U0; if (prep_ < PROBE_SLC2) { fa_init(st); }
#define SLC_LOAD(j) do { const size_t rowk = tb + 64 * (j) + (tid >> 3); kr = *(const u32x4*)(KSb + rowk * 64 + (tid & 7) * 8); vr = *(const u32x4*)(PROJ + rowk * NPJ + 3008 + (tid & 7) * 8); } while (0)
    {
        int j = __builtin_ctzll(U); U &= U - 1ull;
        int jn = U ? __builtin_ctzll(U) : -1; U &= U - 1ull;
        SLC_LOAD(j); q_ready(Q); __syncthreads(); kv_store(Ks, Vs, tid, kr, vr); if (jn >= 0) SLC_LOAD(jn);
        for (int it = 0;; ++it) {
            __syncthreads();
            const int jnn = U ? __builtin_ctzll(U) : -1; U &= U - 1ull;
            if (jn >= 0) kv_store(Ks + ((it + 1) & 1) * 2 * KT_BYTES, Vs + ((it + 1) & 1) * 2 * KT_BYTES, tid, kr, vr);
            if (jnn >= 0) SLC_LOAD(jnn);
            const bool act[2] = {(bool)((QM[0] >> j) & 1ull), (bool)((QM[1] >> j) & 1ull)};
            if (act[0] || act[1]) { mk.k0 = 64 * j; const float ini[2] = {((msk[0] >> j) & 1ull) ? -bnd_slc : -1.0e30f, ((msk[1] >> j) & 1ull) ? -bnd_slc : -1.0e30f};
                if (j == tbk) fa_tile<2, true>(st, Q, Ks + (it & 1) * 2 * KT_BYTES, Vs + (it & 1) * 2 * KT_BYTES, lane, mk, act, ini);
                else fa_tile<2, false>(st, Q, Ks + (it & 1) * 2 * KT_BYTES, Vs + (it & 1) * 2 * KT_BYTES, lane, NoMask(), act, ini); }
            if (jn < 0) break; j = jn; jn = jnn;
        }
    }
#undef SLC_LOAD
    }
    float lse2[2]; fa_finish<2>(st, lse2);
    {   bf16* OSl = WSP(bf16, R_OSLC);
#pragma unroll
        for (int q = 0; q < 2; ++q) { bf16* o = OSl + (tb + mk.t[q]) * 256 + head * 64 + 4 * quad;
#pragma unroll
            for (int d = 0; d < 4; ++d) { u32x2 w_; w_.x = pk2(st.O[q][d][0], st.O[q][d][1]); w_.y = pk2(st.O[q][d][2], st.O[q][d][3]); *(u32x2*)(o + 16 * d) = w_; } }
    }
    FA<2> sw; fa_init(sw); sw.negM = -bnd_swa; SwaMask mw; mw.t[0] = mk.t[0]; mw.t[1] = mk.t[1];
    for (int prep_ = 0; prep_ <= PROBE_SWA2; ++prep_) { if (prep_ < PROBE_SWA2) fa_init(sw);
    {
        const int j0 = tbk >= 8 ? tbk - 8 : 0; const bool act[2] = {true, true}; const float ini[2] = {-bnd_swa, -bnd_swa};
#define SWA_LOAD(j) do { const size_t rowk = tb + 64 * (j) + (tid >> 3); kr = *(const u32x4*)(KWb + rowk * 64 + (tid & 7) * 8); vr = *(const u32x4*)(PROJ + rowk * NPJ + 3136 + (tid & 7) * 8); } while (0)
        SWA_LOAD(j0); q_ready(Q); __syncthreads(); kv_store(Ks, Vs, tid, kr, vr); if (j0 + 1 <= tbk) SWA_LOAD(j0 + 1);
        for (int j = j0; j <= tbk; ++j) {
            const int pb_ = (j - j0) & 1;
            __syncthreads();
            if (j + 1 <= tbk) kv_store(Ks + (pb_ ^ 1) * 2 * KT_BYTES, Vs + (pb_ ^ 1) * 2 * KT_BYTES, tid, kr, vr);
            if (j + 2 <= tbk) SWA_LOAD(j + 2);
            mw.k0 = 64 * j;
            if (j == tbk || j == tbk - 8) fa_tile<2, true>(sw, Q, Ks + pb_ * 2 * KT_BYTES, Vs + pb_ * 2 * KT_BYTES, lane, mw, act, ini);
            else fa_tile<2, false>(sw, Q, Ks + pb_ * 2 * KT_BYTES, Vs + pb_ * 2 * KT_BYTES, lane, NoMask(), act, ini);
        }
#undef SWA_LOAD
    }
    }
    fa_finish<2>(sw, lse2);
#pragma unroll
    for (int q = 0; q < 2; ++q) {
        const size_t row = tb + mk.t[q]; const float* gp = GATE + row * 12 + head * 3; const float g0 = gp[0], g1 = gp[1], g2 = gp[2];
        f32x4 o[4]; float ss = 0.f; const bf16* pc = WSP(bf16, R_OCMP) + row * 256 + head * 64 + 4 * quad; const bf16* ps = WSP(bf16, R_OSLC) + row * 256 + head * 64 + 4 * quad;
#pragma unroll
        for (int d = 0; d < 4; ++d) { const u32x2 c_ = *(const u32x2*)(pc + 16 * d), s_ = *(const u32x2*)(ps + 16 * d);
            o[d] = (f32x4){bflo(c_.x), bfhi(c_.x), bflo(c_.y), bfhi(c_.y)} * g0 + (f32x4){bflo(s_.x), bfhi(s_.x), bflo(s_.y), bfhi(s_.y)} * g1 + sw.O[q][d] * g2; ss += (o[d][0] * o[d][0] + o[d][1] * o[d][1]) + (o[d][2] * o[d][2] + o[d][3] * o[d][3]); }
        ss += __shfl_xor(ss, 16); ss += __shfl_xor(ss, 32);
        const float rstd = rsqrtf(ss * (1.f / 64.f) + 1e-6f); const float* og = C.onorm_g + (size_t)l * 768 + 512 + head * 64 + 4 * quad;
        bf16* yo = YCAT + row * DM + 768 + head * 64 + 4 * quad;
#pragma unroll
        for (int d = 0; d < 4; ++d) { const f32x4 g4 = *(const f32x4*)(og + 16 * d); u32x2 wv; wv.x = pk2(o[d][0] * rstd * g4[0], o[d][1] * rstd * g4[1]); wv.y = pk2(o[d][2] * rstd * g4[2], o[d][3] * rstd * g4[3]); *(u32x2*)(yo + 16 * d) = wv; }
    }
}

DI void fin_phase(const Ctx& C, int l) {
    const bf16* SCH = WSP(bf16, R_SCH); const float* YA = WSP(float, R_YA); const bf16* Gb = WSP(bf16, R_G); const float* OC = WSP(float, R_OC); const float* LSE = WSP(float, R_LSE);
    const float* UB = WSP(float, R_SCANU); const float* SMT = WSP(float, R_SCANS); bf16* YCAT = WSP(bf16, R_YCAT);
    const int lane = C.lane, ch = 4 * lane, hh = lane >> 4;
    LAS float* sm = (LAS float*)C.lds;
    LAS float* us = sm + 4 * 4096 + C.wave * 512;
    const f32x4 rk = *(const f32x4*)(C.rk + (size_t)l * 256 + ch), gw4 = *(const f32x4*)(C.gn_w + (size_t)l * 256 + ch), gb4 = *(const f32x4*)(C.gn_b + (size_t)l * 256 + ch);
    const f32x4 og = *(const f32x4*)(C.onorm_g + (size_t)l * 768 + 256 + ch);
    int bl = -1;
    for (int it = C.bid; it < NT / 128; it += C.G) {
        const int b = it >> 5, kk = it & 31;
        if (b != bl) { __syncthreads(); for (int i = C.tid; i < 4096; i += NTHR) *(LAS f32x4*)(sm + 4 * i) = *(const f32x4*)(SMT + (size_t)b * 4 * 4096 + 4 * i); bl = b; __syncthreads(); }
#pragma unroll 4
        for (int r = 0; r < 16; ++r) {
            const int row = b * NS + (r >> 3) * (NS / 2) + 64 * kk + C.wave * 8 + (r & 7); const size_t o = (size_t)row * 256 + ch;
            const float l0 = LSE[(size_t)row * 4 + hh], l1 = LSE[((size_t)NT + row) * 4 + hh], l2 = LSE[((size_t)2 * NT + row) * 4 + hh];
            const bf16* ocb = (const bf16*)OC; const u32x2 a_ = *(const u32x2*)(ocb + o), b_ = *(const u32x2*)(ocb + (size_t)NT * 256 + o), c_ = *(const u32x2*)(ocb + (size_t)2 * NT * 256 + o);
            const f32x4 a = (f32x4){bflo(a_.x), bfhi(a_.x), bflo(a_.y), bfhi(a_.y)}, bq = (f32x4){bflo(b_.x), bfhi(b_.x), bflo(b_.y), bfhi(b_.y)}, c = (f32x4){bflo(c_.x), bfhi(c_.x), bflo(c_.y), bfhi(c_.y)};
            const float mx = fmaxf(l0, fmaxf(l1, l2)); float w0 = fexp2(l0 - mx), w1 = fexp2(l1 - mx), w2 = fexp2(l2 - mx); const float inv = __builtin_amdgcn_rcpf(w0 + w1 + w2); w0 *= inv; w1 *= inv; w2 *= inv;
            const f32x4 y = a * w0 + bq * w1 + c * w2;
            const float ss = group_sum<16>((y[0] * y[0] + y[1] * y[1]) + (y[2] * y[2] + y[3] * y[3])); const float rstd = rsqrtf(ss * (1.f / 64.f) + 1e-6f);
            u32x2 w; w.x = pk2(y[0] * rstd * og[0], y[1] * rstd * og[1]); w.y = pk2(y[2] * rstd * og[2], y[3] * rstd * og[3]); *(u32x2*)(YCAT + (size_t)row * DM + 512 + ch) = w;
        }
#pragma unroll 1
        for (int hf = 0; hf < 2; ++hf) {
#pragma unroll 2
            for (int r = 0; r < 8; ++r) {
                const int row = b * NS + hf * (NS / 2) + 64 * kk + C.wave * 8 + r, s = row % NS; const size_t o = (size_t)row * 256 + ch;
                f32x4 y = *(const f32x4*)(YA + o); const u32x2 rr_ = *(const u32x2*)(SCH + (size_t)3 * NT * 256 + o), k_ = *(const u32x2*)(SCH + o), v_ = *(const u32x2*)(SCH + (size_t)4 * NT * 256 + o), g_ = *(const u32x2*)(Gb + o);
                const f32x4 rr = (f32x4){bflo(rr_.x), bfhi(rr_.x), bflo(rr_.y), bfhi(rr_.y)}, k = (f32x4){bflo(k_.x), bfhi(k_.x), bflo(k_.y), bfhi(k_.y)}, v = (f32x4){bflo(v_.x), bfhi(v_.x), bflo(v_.y), bfhi(v_.y)}, g = (f32x4){bflo(g_.x), bfhi(g_.x), bflo(g_.y), bfhi(g_.y)};
                if (hf == 1) {
                    LAS float* ub = us + (r & 1) * 256;
                    *(LAS f32x4*)(ub + ch) = *(const f32x4*)(UB + ((size_t)b * (NS / 2) + (s - NS / 2)) * 256 + ch);
                    asm volatile("s_waitcnt lgkmcnt(0)" ::: "memory");
                    const LAS float* sp = sm + hh * 4096 + 4 * (lane & 15); const LAS float* up = ub + hh * 64;
#pragma unroll 8
                    for (int j4 = 0; j4 < 16; ++j4) { const f32x4 u4 = *(const LAS f32x4*)(up + 4 * j4);
#pragma unroll
                        for (int jj = 0; jj < 4; ++jj) y += *(const LAS f32x4*)(sp + (4 * j4 + jj) * 64) * u4[jj]; }
                }
                const float mu = group_sum<16>((y[0] + y[1]) + (y[2] + y[3])) * (1.f / 64.f);
                const f32x4 dy = y - mu; const float var = group_sum<16>((dy[0] * dy[0] + dy[1] * dy[1]) + (dy[2] * dy[2] + dy[3] * dy[3])) * (1.f / 64.f);
                const float rstd = rsqrtf(var + 64e-5f);
                const float dot = group_sum<16>((rr[0] * k[0] * rk[0] + rr[1] * k[1] * rk[1]) + (rr[2] * k[2] * rk[2] + rr[3] * k[3] * rk[3]));
                float out[4];
#pragma unroll
                for (int i = 0; i < 4; ++i) out[i] = ((dy[i] * rstd * gw4[i] + gb4[i]) + dot * v[i]) * g[i];
                u32x2 w; w.x = pk2(out[0], out[1]); w.y = pk2(out[2], out[3]); *(u32x2*)(YCAT + (size_t)row * DM + ch) = w;
            }
        }
    }
    __syncthreads();
}

constexpr int CW_Q = 40000;
DI int q_next(const Ctx& C, unsigned* ctr, LAS int* slot) {
    __syncthreads();
    if (C.tid == 0) *slot = (int)__hip_atomic_fetch_add(ctr, 1u, __ATOMIC_RELAXED, __HIP_MEMORY_SCOPE_AGENT);
    __syncthreads();
    return *slot;
}
DI void conv_ticket(const Ctx& C, int l, int tk);
constexpr int CW_CD = 41000;
DI void cmp_mlp_unit(const Ctx& C, int l, int cb) {
    const int kv = cb >> 3;
    { pg8::Gemm g{kv ? WSP(bf16, R_VCR) : WSP(bf16, R_KCR), WSP(bf16, WS_WK1) + (size_t)(l * 2 + kv) * 256 * 2048, 1024, 2048}; pg8::StaticOrder S; S.init(8, 1, 8, cb & 7);
      EpiC1 E{WSP(bf16, R_CH1) + (size_t)kv * 2048 * 256, (WSP(float, WS_SMALL) + NLAYER * 8 * 6144 + l * 512 + kv * 256)}; pg8::gemm_phase(C.lds, C.tid, g, S, E); }
    asm volatile("s_waitcnt vmcnt(0)" ::: "memory"); __syncthreads();
    { pg8::Gemm g{WSP(bf16, R_CH1) + (size_t)kv * 2048 * 256, WSP(bf16, WS_WK2) + (size_t)(l * 2 + kv) * 256 * 256, 256, 256}; pg8::StaticOrder S; S.init(8, 1, 8, cb & 7);
      EpiC2 E{WSP(float, R_CMP) + (size_t)kv * 2048 * 64}; pg8::gemm_phase(C.lds, C.tid, g, S, E); }
    asm volatile("s_waitcnt vmcnt(0)" ::: "memory"); __syncthreads();
    if (C.tid == 0) { __builtin_amdgcn_fence(__ATOMIC_RELEASE, "agent"); asm volatile("s_waitcnt vmcnt(0)" ::: "memory");
        __hip_atomic_fetch_add(WSP(unsigned, WS_CTL) + CW_CD + 64 * l, 1u, __ATOMIC_RELAXED, __HIP_MEMORY_SCOPE_AGENT); }
}
DI void cmp_mlp_wait(const Ctx& C, int l) {
    if (C.tid == 0) { unsigned* c = WSP(unsigned, WS_CTL) + CW_CD + 64 * l; unsigned sp = 0u;
        while (__hip_atomic_load(c, __ATOMIC_RELAXED, __HIP_MEMORY_SCOPE_AGENT) < 16u) { __builtin_amdgcn_s_sleep(8); if (++sp > (1u << 21)) break; }
        __builtin_amdgcn_fence(__ATOMIC_ACQUIRE, "agent"); asm volatile("s_waitcnt vmcnt(0)" ::: "memory"); }
    __syncthreads();
}
DI void mix_phase(const Ctx& C, int l, int rep) {
    unsigned* ctl = WSP(unsigned, WS_CTL) + CW_Q + 64 * 3 * (l + 2 * rep); LAS int* slot = (LAS int*)(C.lds + MISC_OFF + 1024);
#ifndef PROBE_SPLIT
#define PROBE_SPLIT 0
#endif
    if (C.bid < 96) { scan_unit8(C, C.bid); if (PROBE_SCAN2) scan_unit8(C, C.bid); }
    else if (C.bid < 112) cmp_mlp_unit(C, l, C.bid - 96);
    bool cmp_ready = false;
    if (PROBE_SPLIT) { asm volatile("s_waitcnt vmcnt(0)" ::: "memory"); __syncthreads(); { XcdBarrier bar2; bar2.bar = WSP(unsigned, WS_CTL) + CW_BAR; bar2.x = xb_xcc_id(); bar2.st = (volatile LAS unsigned*)(C.lds + MISC_OFF); xcd_barrier(bar2); } }
    int bl = -1;
    const float bnd_cmp = score_bound(C.nsa_q_g + (size_t)l * 64, C.nsa_kc_g + (size_t)l * 64, C.lane), bnd_slc = score_bound(C.nsa_q_g + (size_t)l * 64, C.nsa_ks_g + (size_t)l * 64, C.lane),
                bnd_swa = score_bound(C.nsa_q_g + (size_t)l * 64, C.nsa_kw_g + (size_t)l * 64, C.lane), bnd_dil = score_bound(C.dil_q_g + (size_t)l * 64, C.dil_k_g + (size_t)l * 64, C.lane);
    bool conv_left = true;
#define CONV_ONE() do { if (conv_left) { const int t_ = q_next(C, ctl + 128, slot); if (t_ >= 768 * (1 + PROBE_CONV2)) conv_left = false; else { conv_ticket(C, l, t_ % 768); bl = -1; } } } while (0)
    bool dil_left = true;
#ifndef CONV_FIRST
#define CONV_FIRST 1
#endif
    if (CONV_FIRST && C.bid >= 112) while (conv_left) CONV_ONE();
    if (C.bid >= 112) for (;;) {
        __syncthreads();
        if (C.tid == 0) { const int r_ = __hip_atomic_load(WSP(unsigned, WS_CTL) + CW_CD + 64 * l, __ATOMIC_RELAXED, __HIP_MEMORY_SCOPE_AGENT) >= 16u;
            if (r_) { __builtin_amdgcn_fence(__ATOMIC_ACQUIRE, "agent"); asm volatile("s_waitcnt vmcnt(0)" ::: "memory"); } slot[1] = r_; }
        __syncthreads();
        if (slot[1]) { cmp_ready = true; break; }
        if (dil_left) { const int u = q_next(C, ctl + 64, slot); if (u >= 1536 * (1 + PROBE_DIL2)) dil_left = false; else { dil_unit(C, u % 1536, C.lds, C.lds + KT_BYTES, bnd_dil); continue; } }
        if (conv_left) { CONV_ONE(); continue; }
        break;
    }
    for (;;) { const int u = q_next(C, ctl, slot); if (u >= 512 * (1 + PROBE_NSA2)) break; nsa_unit(C, l, u & 7, 63 - ((u & 511) >> 3), bl, cmp_ready, bnd_cmp, bnd_slc, bnd_swa); if (!CONV_FIRST) CONV_ONE(); }
    if (dil_left) for (int n = 0;; ++n) { const int u = q_next(C, ctl + 64, slot); if (u >= 1536 * (1 + PROBE_DIL2)) break; dil_unit(C, u % 1536, C.lds, C.lds + KT_BYTES, bnd_dil); if (!CONV_FIRST && (n & 3) == 3) CONV_ONE(); }
    while (conv_left) CONV_ONE();
#undef CONV_ONE if (C.bid >= 96)
    __syncthreads();
}
#define MFMA_F32(a, b, c) __builtin_amdgcn_mfma_f32_16x16x4f32((a), (b), (c), 0, 0, 0)
DI void router_body(const Ctx& C, int l, const bf16* __restrict__ X, unsigned char* __restrict__ H8, int* __restrict__ TOPE, float* __restrict__ TOPG) {
    const float* MOD = WSP(float, WS_SMALL) + (size_t)l * 8 * 6144; unsigned* CNTB = WSP(unsigned, WS_CTL) + CW_CNT + l * 8192;
    LAS float* wl = (LAS float*)C.lds;
    LAS float* lg = (LAS float*)(C.lds + MISC_OFF + 8192) + C.wave * 512;
    LAS unsigned* hist = (LAS unsigned*)(C.lds + MISC_OFF + 6144);
    LAS float* rs = (LAS float*)(C.lds + MISC_OFF + 6400) + C.wave * 16;
    const int lane = C.lane, l15 = lane & 15, quad = lane >> 4, gw = C.bid * NWAVE + C.wave, NGW = C.G * NWAVE;
    const float* wr = C.w_router + (size_t)l * 1024 * 32; const float* g2 = C.norm2_g + (size_t)l * DM;
    __syncthreads();
    if (C.tid < 32) hist[C.tid] = 0u;
    for (int i = C.tid; i < 8192; i += NTHR) { const int k = i >> 3, e4 = (i & 7) * 4; const f32x4 v = *(const f32x4*)(wr + (size_t)k * 32 + e4); LAS float* d = wl + ((k >> 2) * 32 + e4) * 4 + (k & 3);
        d[0] = v[0]; d[4] = v[1]; d[8] = v[2]; d[12] = v[3]; }
    __syncthreads();
    for (int task = gw; task < NT / 16; task += NGW) {
        const int row0 = 16 * task, b = row0 / NS;
        const float* shb = MOD + (size_t)b * 6144 + 3072; const float* scb = shb + 1024;
        {
            f32x4 gg[4], sb[4];
#pragma unroll
            for (int j = 0; j < 2; ++j)
#pragma unroll
                for (int hlf = 0; hlf < 2; ++hlf) { const int k = 8 * lane + 512 * j + 4 * hlf; gg[2 * j + hlf] = *(const f32x4*)(g2 + k) * (*(const f32x4*)(scb + k) + 1.f); sb[2 * j + hlf] = *(const f32x4*)(shb + k); }
#pragma unroll 4
            for (int r = 0; r < 16; ++r) {
                const bf16* xr = X + (size_t)(row0 + r) * DM + 8 * lane; f32x4 v[4]; float ss = 0.f;
#pragma unroll
                for (int j = 0; j < 2; ++j) { const u32x4 t = *(const u32x4*)(xr + 512 * j); v[2 * j] = (f32x4){bflo(t.x), bfhi(t.x), bflo(t.y), bfhi(t.y)}; v[2 * j + 1] = (f32x4){bflo(t.z), bfhi(t.z), bflo(t.w), bfhi(t.w)}; }
#pragma unroll
                for (int j = 0; j < 4; ++j) ss += (v[j][0] * v[j][0] + v[j][1] * v[j][1]) + (v[j][2] * v[j][2] + v[j][3] * v[j][3]);
                ss = group_sum<64>(ss); const float rstd = rsqrtf(ss * (1.f / DM) + 1e-6f);
                if (lane == 0) rs[r] = rstd;
                unsigned char* hp = H8 + (size_t)(row0 + r) * DM + 8 * lane;
#pragma unroll
                for (int j = 0; j < 2; ++j) { const f32x4 h0 = v[2 * j] * rstd * gg[2 * j] + sb[2 * j], h1 = v[2 * j + 1] * rstd * gg[2 * j + 1] + sb[2 * j + 1]; u32x2 o8; o8.x = pk4_fp8(h0[0], h0[1], h0[2], h0[3]); o8.y = pk4_fp8(h1[0], h1[1], h1[2], h1[3]); *(u32x2*)(hp + 512 * j) = o8; }
            }
        }
        const bf16* xr = X + (size_t)(row0 + l15) * DM + 4 * quad; const float* sh = shb + 4 * quad; const float* sc = scb + 4 * quad;
        asm volatile("s_waitcnt lgkmcnt(0)" ::: "memory");
        const float rstd = rs[l15];
        f32x4 acc0 = (f32x4){0.f, 0.f, 0.f, 0.f}, acc1 = acc0;
#pragma unroll 8
        for (int i = 0; i < 64; ++i) {
            const u32x2 ab = *(const u32x2*)(xr + 16 * i); const f32x4 a = (f32x4){bflo(ab.x), bfhi(ab.x), bflo(ab.y), bfhi(ab.y)}, g = *(const f32x4*)(g2 + 16 * i + 4 * quad), s1 = *(const f32x4*)(sc + 16 * i), s0 = *(const f32x4*)(sh + 16 * i);
            f32x4 h;
#pragma unroll
            for (int j = 0; j < 4; ++j) h[j] = a[j] * rstd * g[j] * (1.f + s1[j]) + s0[j];
            const LAS float* wp = wl + ((4 * i + quad) * 32 + l15) * 4; const f32x4 w0 = *(const LAS f32x4*)wp, w1 = *(const LAS f32x4*)(wp + 64);
#pragma unroll
            for (int j = 0; j < 4; ++j) { acc0 = MFMA_F32(h[j], w0[j], acc0); acc1 = MFMA_F32(h[j], w1[j], acc1); }
        }
        const float b0 = C.b_router[l * 32 + l15], b1 = C.b_router[l * 32 + 16 + l15];
#pragma unroll
        for (int j = 0; j < 4; ++j) { lg[(4 * quad + j) * 32 + l15] = acc0[j] + b0; lg[(4 * quad + j) * 32 + 16 + l15] = acc1[j] + b1; }
        asm volatile("s_waitcnt lgkmcnt(0)" ::: "memory");
        if (lane < 16) {
            float v[32];
#pragma unroll
            for (int i = 0; i < 8; ++i) { const f32x4 a = *(const LAS f32x4*)(lg + lane * 32 + 4 * i); v[4 * i] = a[0]; v[4 * i + 1] = a[1]; v[4 * i + 2] = a[2]; v[4 * i + 3] = a[3]; }
            float tv[4]; int ti[4];
#pragma unroll
            for (int r = 0; r < 4; ++r) { float bv = -3.0e38f; int bi = 0;
#pragma unroll
                for (int e = 0; e < 32; ++e) if (v[e] > bv) { bv = v[e]; bi = e; }
                tv[r] = bv; ti[r] = bi;
#pragma unroll
                for (int e = 0; e < 32; ++e) v[e] = (e == bi) ? -3.0e38f : v[e]; }
            const float e1 = __expf(tv[1] - tv[0]), e2 = __expf(tv[2] - tv[0]), e3 = __expf(tv[3] - tv[0]), inv = 1.f / (1.f + e1 + e2 + e3);
            const int row = row0 + lane;
            *(int4*)(TOPE + (size_t)row * 4) = make_int4(ti[0], ti[1], ti[2], ti[3]);
            *(f32x4*)(TOPG + (size_t)row * 4) = (f32x4){inv, e1 * inv, e2 * inv, e3 * inv};
#pragma unroll
            for (int r = 0; r < 4; ++r) __hip_atomic_fetch_add(&hist[ti[r]], 1u, __ATOMIC_RELAXED, __HIP_MEMORY_SCOPE_WORKGROUP);
        }
        asm volatile("s_waitcnt lgkmcnt(0)" ::: "memory");
    }
    __syncthreads();
    if (C.tid < 32) CNTB[C.bid * 32 + C.tid] = hist[C.tid];
}

DI void router_body_fold(const Ctx& C, int l, const bf16* __restrict__ X, unsigned char* __restrict__ H8, int* __restrict__ TOPE, float* __restrict__ TOPG) {
    const float* MOD = WSP(float, WS_SMALL) + (size_t)l * 8 * 6144; unsigned* CNTB = WSP(unsigned, WS_CTL) + CW_CNT + l * 8192;
    LAS float* wl = (LAS float*)C.lds;
    LAS float* lg = (LAS float*)(C.lds + MISC_OFF + 8192) + C.wave * 512;
    LAS unsigned* hist = (LAS unsigned*)(C.lds + MISC_OFF + 6144);
    LAS float* rs = (LAS float*)(C.lds + MISC_OFF + 6400) + C.wave * 16;
    const int lane = C.lane, l15 = lane & 15, quad = lane >> 4, gw = C.bid * NWAVE + C.wave, NGW = C.G * NWAVE;
    const float* wr = C.w_router + (size_t)l * 1024 * 32; const float* g2 = C.norm2_g + (size_t)l * DM;
    __syncthreads();
    if (C.tid < 32) hist[C.tid] = 0u;
    LAS float* cvec = (LAS float*)(C.lds + MISC_OFF + 6912);
    const int b0 = (16 * (C.bid * NWAVE)) / NS; const float* shb0 = MOD + (size_t)b0 * 6144 + 3072; const float* scb0 = shb0 + 1024;
    for (int i = C.tid; i < 4096; i += NTHR) { const int kg = i >> 5, e = i & 31; f32x4 v0, v1;
#pragma unroll
        for (int j = 0; j < 4; ++j) { const int k = 8 * kg + j; v0[j] = wr[(size_t)k * 32 + e] * (g2[k] * (1.f + scb0[k])); v1[j] = wr[(size_t)(k + 4) * 32 + e] * (g2[k + 4] * (1.f + scb0[k + 4])); }
        *(LAS f32x4*)(wl + (kg * 32 + e) * 8) = v0; *(LAS f32x4*)(wl + (kg * 32 + e) * 8 + 4) = v1; }
    {   LAS float* cp = (LAS float*)(C.lds + MISC_OFF + 8192); const int e = C.tid & 31, pt = C.tid >> 5; float a_ = 0.f;
#pragma unroll 8
        for (int k = 64 * pt; k < 64 * pt + 64; ++k) a_ += shb0[k] * wr[(size_t)k * 32 + e];
        cp[pt * 32 + e] = a_;
        __syncthreads();
        if (C.tid < 32) { float s_ = C.b_router[l * 32 + C.tid];
#pragma unroll
            for (int q = 0; q < 16; ++q) s_ += cp[q * 32 + C.tid];
            cvec[C.tid] = s_; }
    }
    __syncthreads();
    for (int task = gw; task < NT / 16; task += NGW) {
        const int row0 = 16 * task, b = row0 / NS;
        const float* shb = MOD + (size_t)b * 6144 + 3072; const float* scb = shb + 1024;
        const bf16* xr = X + (size_t)(row0 + l15) * DM + 8 * quad;
        f32x4 acc0 = (f32x4){0.f, 0.f, 0.f, 0.f}, acc1 = acc0;
#pragma unroll 4
        for (int i = 0; i < 32; ++i) {
            const u32x4 ab = *(const u32x4*)(xr + 32 * i); const float a[8] = {bflo(ab.x), bfhi(ab.x), bflo(ab.y), bfhi(ab.y), bflo(ab.z), bfhi(ab.z), bflo(ab.w), bfhi(ab.w)};
            const LAS float* wp = wl + ((4 * i + quad) * 32 + l15) * 8; const f32x4 w0a = *(const LAS f32x4*)wp, w0b = *(const LAS f32x4*)(wp + 4), w1a = *(const LAS f32x4*)(wp + 128), w1b = *(const LAS f32x4*)(wp + 132);
#pragma unroll
            for (int j = 0; j < 4; ++j) { acc0 = MFMA_F32(a[j], w0a[j], acc0); acc1 = MFMA_F32(a[j], w1a[j], acc1); }
#pragma unroll
            for (int j = 0; j < 4; ++j) { acc0 = MFMA_F32(a[4 + j], w0b[j], acc0); acc1 = MFMA_F32(a[4 + j], w1b[j], acc1); }
        }
        {
            f32x4 gg[4], sb[4];
#pragma unroll
            for (int j = 0; j < 2; ++j)
#pragma unroll
                for (int hlf = 0; hlf < 2; ++hlf) { const int k = 8 * lane + 512 * j + 4 * hlf; gg[2 * j + hlf] = *(const f32x4*)(g2 + k) * (*(const f32x4*)(scb + k) + 1.f); sb[2 * j + hlf] = *(const f32x4*)(shb + k); }
#pragma unroll 8
            for (int r = 0; r < 16; ++r) {
                const bf16* xr = X + (size_t)(row0 + r) * DM + 8 * lane; f32x4 v[4]; float ss = 0.f;
#pragma unroll
                for (int j = 0; j < 2; ++j) { const u32x4 t = *(const u32x4*)(xr + 512 * j); v[2 * j] = (f32x4){bflo(t.x), bfhi(t.x), bflo(t.y), bfhi(t.y)}; v[2 * j + 1] = (f32x4){bflo(t.z), bfhi(t.z), bflo(t.w), bfhi(t.w)}; }
#pragma unroll
                for (int j = 0; j < 4; ++j) ss += (v[j][0] * v[j][0] + v[j][1] * v[j][1]) + (v[j][2] * v[j][2] + v[j][3] * v[j][3]);
                ss = group_sum<64>(ss); const float rstd = rsqrtf(ss * (1.f / DM) + 1e-6f);
                if (lane == 0) rs[r] = rstd;
                unsigned char* hp = H8 + (size_t)(row0 + r) * DM + 8 * lane;
#pragma unroll
                for (int j = 0; j < 2; ++j) { const f32x4 h0 = v[2 * j] * rstd * gg[2 * j] + sb[2 * j], h1 = v[2 * j + 1] * rstd * gg[2 * j + 1] + sb[2 * j + 1]; u32x2 o8; o8.x = pk4_fp8(h0[0], h0[1], h0[2], h0[3]); o8.y = pk4_fp8(h1[0], h1[1], h1[2], h1[3]); *(u32x2*)(hp + 512 * j) = o8; }
            }
        }
        asm volatile("s_waitcnt lgkmcnt(0)" ::: "memory");
        { const float c0 = cvec[l15], c1 = cvec[16 + l15];
#pragma unroll
          for (int j = 0; j < 4; ++j) { const float r_ = rs[4 * quad + j]; lg[(4 * quad + j) * 32 + l15] = r_ * acc0[j] + c0; lg[(4 * quad + j) * 32 + 16 + l15] = r_ * acc1[j] + c1; } }
        asm volatile("s_waitcnt lgkmcnt(0)" ::: "memory");
        if (lane < 16) {
            float v[32];
#pragma unroll
            for (int i = 0; i < 8; ++i) { const f32x4 a = *(const LAS f32x4*)(lg + lane * 32 + 4 * i); v[4 * i] = a[0]; v[4 * i + 1] = a[1]; v[4 * i + 2] = a[2]; v[4 * i + 3] = a[3]; }
            float tv[4]; int ti[4];
#pragma unroll
            for (int r = 0; r < 4; ++r) { float bv = -3.0e38f; int bi = 0;
#pragma unroll
                for (int e = 0; e < 32; ++e) if (v[e] > bv) { bv = v[e]; bi = e; }
                tv[r] = bv; ti[r] = bi;
#pragma unroll
                for (int e = 0; e < 32; ++e) v[e] = (e == bi) ? -3.0e38f : v[e]; }
            const float e1 = __expf(tv[1] - tv[0]), e2 = __expf(tv[2] - tv[0]), e3 = __expf(tv[3] - tv[0]), inv = 1.f / (1.f + e1 + e2 + e3);
            const int row = row0 + lane;
            *(int4*)(TOPE + (size_t)row * 4) = make_int4(ti[0], ti[1], ti[2], ti[3]);
            *(f32x4*)(TOPG + (size_t)row * 4) = (f32x4){inv, e1 * inv, e2 * inv, e3 * inv};
#pragma unroll
            for (int r = 0; r < 4; ++r) __hip_atomic_fetch_add(&hist[ti[r]], 1u, __ATOMIC_RELAXED, __HIP_MEMORY_SCOPE_WORKGROUP);
        }
        asm volatile("s_waitcnt lgkmcnt(0)" ::: "memory");
    }
    __syncthreads();
    if (C.tid < 32) CNTB[C.bid * 32 + C.tid] = hist[C.tid];
}

DI void router_phase(const Ctx& C, int l) { int* TOPE = WSP(int, WS_ROUTE);
    if ((long)C.G * NWAVE * 16 >= NT) router_body_fold(C, l, WSP(bf16, WS_XB), WSP(unsigned char, R_XS), TOPE, (float*)(TOPE + NT * 4));
    else router_body(C, l, WSP(bf16, WS_XB), WSP(unsigned char, R_XS), TOPE, (float*)(TOPE + NT * 4)); }

DI void moe_tables(const Ctx& C, int l, LAS int* tab) {
    const unsigned* CNTB = WSP(unsigned, WS_CTL) + CW_CNT + l * 8192;
    LAS unsigned* part = (LAS unsigned*)(tab + 192);
    __syncthreads();
    { const int e = C.tid & 31, pt = C.tid >> 5; unsigned tot = 0u, mine = 0u;
        const int g0 = pt * ((C.G + 15) >> 4), g1 = min(C.G, g0 + ((C.G + 15) >> 4));
#pragma unroll 16
        for (int g = g0; g < g1; ++g) { const unsigned c = CNTB[g * 32 + e]; tot += c; mine += (g < C.bid) ? c : 0u; }
        part[(pt * 2) * 32 + e] = tot; part[(pt * 2 + 1) * 32 + e] = mine; }
    __syncthreads();
    if (C.tid < 32) { unsigned tot = 0u, mine = 0u;
#pragma unroll
        for (int pt = 0; pt < 16; ++pt) { tot += part[(pt * 2) * 32 + C.tid]; mine += part[(pt * 2 + 1) * 32 + C.tid]; }
        tab[128 + C.tid] = (int)((tot + 255u) >> 8); tab[64 + C.tid] = (int)mine; }
    __syncthreads();
    if (C.tid == 0) { int s = 0; for (int e = 0; e < 32; ++e) { tab[e] = s; s += tab[128 + e]; } tab[32] = s; }
    __syncthreads();
}
DI void scatter_phase(const Ctx& C, int l) {
    const int* TOPE = WSP(int, WS_ROUTE); int* POS = (int*)(TOPE + NT * 8); int* ROWMAP = (int*)(TOPE + NT * 12);
    LAS int* tab = (LAS int*)(C.lds + MISC_OFF + 64); LAS unsigned* cur = (LAS unsigned*)(C.lds + 16384);
    moe_tables(C, l, tab);
    if (C.tid < 32) cur[C.tid] = (unsigned)(tab[C.tid] * 256 + tab[64 + C.tid]);
    __syncthreads();
    const int lane = C.lane, gw = C.bid * NWAVE + C.wave, NGW = C.G * NWAVE;
    for (int task = gw; task < NT / 16; task += NGW) {
        const int row0 = 16 * task, tok = row0 + (lane >> 2);
        const int e = TOPE[(size_t)tok * 4 + (lane & 3)];
        const int slot = (int)__hip_atomic_fetch_add(&cur[e], 1u, __ATOMIC_RELAXED, __HIP_MEMORY_SCOPE_WORKGROUP);
        POS[(size_t)tok * 4 + (lane & 3)] = slot; ROWMAP[slot] = tok;
    }
}
DI void combine_body(const Ctx& C, int l, float* __restrict__ dst, bf16* __restrict__ dstb, const bf16* __restrict__ YB, const bf16* __restrict__ XB, bf16* __restrict__ H, const int* __restrict__ POS, const float* __restrict__ TOPG) {
    const float* MOD = WSP(float, WS_SMALL) + (size_t)l * 8 * 6144;
    const int lane = C.lane, gw = C.bid * NWAVE + C.wave, NGW = C.G * NWAVE;
    for (int task = gw; task < NT / 16; task += NGW) {
        const int row0 = 16 * task, b = row0 / NS; const float* gt = MOD + (size_t)b * 6144 + 5120 + 8 * lane;
        f32x4 g4[4], gg[4], sb[4];
#pragma unroll
        for (int j = 0; j < 2; ++j) { g4[2 * j] = *(const f32x4*)(gt + 512 * j); g4[2 * j + 1] = *(const f32x4*)(gt + 512 * j + 4); }
        if (l + 1 < NLAYER) { const float* M2 = MOD + 8 * 6144 + (size_t)b * 6144 + 8 * lane; const float* g = C.norm1_g + (size_t)(l + 1) * DM + 8 * lane;
#pragma unroll
            for (int j = 0; j < 2; ++j)
#pragma unroll
                for (int hlf = 0; hlf < 2; ++hlf) { const int o = 512 * j + 4 * hlf; gg[2 * j + hlf] = *(const f32x4*)(g + o) * (*(const f32x4*)(M2 + 1024 + o) + 1.f); sb[2 * j + hlf] = *(const f32x4*)(M2 + o); } }
#pragma unroll 4
        for (int r = 0; r < 16; ++r) {
            const int row = row0 + r; const int4 ps = *(const int4*)(POS + (size_t)row * 4); const f32x4 gk = *(const f32x4*)(TOPG + (size_t)row * 4);
            const int pp[4] = {ps.x, ps.y, ps.z, ps.w};
            const bf16* orow = XB + (size_t)row * DM + 8 * lane; float* drow = dst + (size_t)row * DM + 8 * lane; bf16* drowb = dstb + (size_t)row * DM + 8 * lane;
            u32x4 y[4][2]; f32x4 x[4];
#pragma unroll
            for (int q = 0; q < 4; ++q)
#pragma unroll
                for (int j = 0; j < 2; ++j) { if (YB_FP8) { const u32x2 t_ = *(const u32x2*)((const unsigned char*)YB + (size_t)pp[q] * DM + 8 * lane + 512 * j); y[q][j] = (u32x4){t_.x, t_.y, 0u, 0u}; } else y[q][j] = *(const u32x4*)(YB + (size_t)pp[q] * DM + 8 * lane + 512 * j); }
#pragma unroll
            for (int j = 0; j < 2; ++j) { const u32x4 t = *(const u32x4*)(orow + 512 * j); x[2 * j] = (f32x4){bflo(t.x), bfhi(t.x), bflo(t.y), bfhi(t.y)}; x[2 * j + 1] = (f32x4){bflo(t.z), bfhi(t.z), bflo(t.w), bfhi(t.w)}; }
            f32x4 v[4]; float s = 0.f;
#pragma unroll
            for (int j = 0; j < 2; ++j) { f32x4 a0 = (f32x4){0.f, 0.f, 0.f, 0.f}, a1 = a0;
#pragma unroll
                for (int q = 0; q < 4; ++q) { const u32x4 w = y[q][j];
                    if (YB_FP8) { const f32x2 p0 = __builtin_amdgcn_cvt_pk_f32_fp8(w.x, false), p1 = __builtin_amdgcn_cvt_pk_f32_fp8(w.x, true), p2 = __builtin_amdgcn_cvt_pk_f32_fp8(w.y, false), p3 = __builtin_amdgcn_cvt_pk_f32_fp8(w.y, true);
                        a0 += (f32x4){p0[0], p0[1], p1[0], p1[1]} * gk[q]; a1 += (f32x4){p2[0], p2[1], p3[0], p3[1]} * gk[q]; }
                    else { a0 += (f32x4){bflo(w.x), bfhi(w.x), bflo(w.y), bfhi(w.y)} * gk[q]; a1 += (f32x4){bflo(w.z), bfhi(w.z), bflo(w.w), bfhi(w.w)} * gk[q]; } }
                v[2 * j] = x[2 * j] + g4[2 * j] * a0; v[2 * j + 1] = x[2 * j + 1] + g4[2 * j + 1] * a1;
                if (l + 1 < NLAYER) { u32x4 o; o.x = pk2(v[2 * j][0], v[2 * j][1]); o.y = pk2(v[2 * j][2], v[2 * j][3]); o.z = pk2(v[2 * j + 1][0], v[2 * j + 1][1]); o.w = pk2(v[2 * j + 1][2], v[2 * j + 1][3]); *(u32x4*)(drowb + 512 * j) = o; }
                else { *(f32x4*)(drow + 512 * j) = v[2 * j]; *(f32x4*)(drow + 512 * j + 4) = v[2 * j + 1]; } }
#pragma unroll
            for (int i = 0; i < 4; ++i) s += (v[i][0] * v[i][0] + v[i][1] * v[i][1]) + (v[i][2] * v[i][2] + v[i][3] * v[i][3]);
            if (l + 1 < NLAYER) {
                s = group_sum<64>(s); const float rstd = rsqrtf(s * (1.f / DM) + 1e-6f); bf16* hrow = H + (size_t)row * DM + 8 * lane;
#pragma unroll
                for (int j = 0; j < 2; ++j) { const f32x4 h0 = v[2 * j] * rstd * gg[2 * j] + sb[2 * j], h1 = v[2 * j + 1] * rstd * gg[2 * j + 1] + sb[2 * j + 1]; u32x4 o;
                    if (INPROJ_FP8) { u32x2 o8; o8.x = pk4_fp8(h0[0], h0[1], h0[2], h0[3]); o8.y = pk4_fp8(h1[0], h1[1], h1[2], h1[3]); *(u32x2*)((unsigned char*)H + (size_t)row * DM + 8 * lane + 512 * j) = o8; }
                    else { o.x = pk2(h0[0], h0[1]); o.y = pk2(h0[2], h0[3]); o.z = pk2(h1[0], h1[1]); o.w = pk2(h1[2], h1[3]); *(u32x4*)(hrow + 512 * j) = o; } }
            }
        }
    }
}
DI void combine_phase(const Ctx& C, int l, float* dst, bf16* dstb) {
    const int* TOPE = WSP(int, WS_ROUTE); combine_body(C, l, dst, dstb, WSP(bf16, R_YB), WSP(bf16, WS_XB), WSP(bf16, WS_H), (const int*)(TOPE + NT * 8), (const float*)(TOPE + NT * 4));
}
constexpr int PH_PER_LAYER = 11, PH_BASE = 2, N_PHASES = PH_BASE + NLAYER * PH_PER_LAYER;
#ifndef MK_ONE_LAUNCH
#define MK_ONE_LAUNCH 1
#endif
__global__ void __launch_bounds__(NTHR, 2) mk_fwd(Args args) {
    extern __shared__ __attribute__((aligned(16))) unsigned char lds_raw[];
    Ctx C;
    C.lds = (LAS unsigned char*)lds_raw; C.tid = threadIdx.x; C.lane = C.tid & 63; C.wave = __builtin_amdgcn_readfirstlane(C.tid >> 6); C.G = gridDim.x; C.bid = blockIdx.x;
    C.x = (const float*)args.in[0]; C.c = (const float*)args.in[1]; C.pos = (const int*)args.in[2]; C.w_ada = (const float*)args.in[3]; C.b_ada = (const float*)args.in[4];
    C.norm1_g = (const float*)args.in[5]; C.norm2_g = (const float*)args.in[6]; C.w_in = (const float*)args.in[7]; C.w_out = (const float*)args.in[8]; C.mu = (const float*)args.in[9];
    C.w0 = (const float*)args.in[10]; C.w2 = (const float*)args.in[11]; C.a0 = (const float*)args.in[12]; C.a2 = (const float*)args.in[13]; C.g2 = (const float*)args.in[14];
    C.kkw = (const float*)args.in[15]; C.ka = (const float*)args.in[16]; C.rk = (const float*)args.in[17]; C.gn_w = (const float*)args.in[18]; C.gn_b = (const float*)args.in[19];
    C.conv_w = (const float*)args.in[20]; C.dil_q_g = (const float*)args.in[21]; C.dil_k_g = (const float*)args.in[22]; C.nsa_q_g = (const float*)args.in[23]; C.nsa_kc_g = (const float*)args.in[24];
    C.nsa_ks_g = (const float*)args.in[25]; C.nsa_kw_g = (const float*)args.in[26]; C.pe_k = (const float*)args.in[27]; C.pe_v = (const float*)args.in[28]; C.wk1 = (const float*)args.in[29];
    C.wk2 = (const float*)args.in[30]; C.wv1 = (const float*)args.in[31]; C.wv2 = (const float*)args.in[32]; C.onorm_g = (const float*)args.in[33]; C.w_router = (const float*)args.in[34];
    C.b_router = (const float*)args.in[35]; C.w_gu = (const float*)args.in[36]; C.b_gu = (const float*)args.in[37]; C.w_down = (const float*)args.in[38]; C.b_down = (const float*)args.in[39];
    C.out = args.out; C.ws = args.ws;
    const int lo = args.ph_lo, hi = args.ph_hi;
    for (int u = C.tid; u < (LDS_BYTES - MISC_OFF) / 4; u += NTHR) ((LAS unsigned*)(C.lds + MISC_OFF))[u] = 0u;
    __syncthreads();
    XcdBarrier bar; bar.bar = WSP(unsigned, WS_CTL) + CW_BAR; bar.x = 0; bar.st = nullptr;
    if (hi - lo > 1) bar = xcd_barrier_post(WSP(unsigned, WS_CTL) + CW_BAR, (volatile LAS unsigned*)(C.lds + MISC_OFF));
#ifndef PHMASK
#define PHMASK 0xFFFFFFFFu
#endif
#define PHON(n) (((PHMASK) >> (n)) & 1u)
#ifndef PHREP
#define PHREP 0u
#endif
#define NREP(n) (1 + (int)(((PHREP) >> (n)) & 1u))
#define WSPP(T, off) ((T*)(P.ws + (off)))
#define IN(k) (lo <= (k) && (k) < hi)
#define SEAM(k) do { if (IN(k) && IN((k) + 1)) xcd_barrier(bar); } while (0)
#define PCTX Ctx P = C; asm volatile("" : "+v"(P.tid), "+v"(P.lane)); asm volatile("" : "+s"(P.wave), "+s"(P.bid)); \
    { GAS unsigned char* w_ = (GAS unsigned char*)P.ws; GAS float* o_ = (GAS float*)P.out; asm volatile("" : "+s"(w_), "+s"(o_)); P.ws = (unsigned char*)w_; P.out = (float*)o_; }
    if (PHON(17) && IN(0)) for (int rep = 0; rep < NREP(17); ++rep) { PCTX; p0_prologue(P); __syncthreads(); }
    SEAM(0);
#ifndef PROBE_BARS
#define PROBE_BARS 0
#endif
    if (hi - lo > 1) for (int i = 0; i < PROBE_BARS; ++i) xcd_barrier(bar);
    if (PHON(18) && IN(1)) { PCTX; norm1_phase(P, 0, P.x); }
    SEAM(1);
    for (int l = 0; l < NLAYER; ++l) {
        const int pb = PH_BASE + PH_PER_LAYER * l;
        if (PHON(0) && IN(pb + 0)) for (int rep = 0; rep < NREP(0); ++rep) { PCTX;
            pg8::StaticOrder S; S.init(NT / 256, NPJ / 256, P.G, P.bid);
            if (INPROJ_FP8) { pg8::Gemm g{WSPP(bf16, WS_H), WSPP(bf16, WS_WIN) + (size_t)l * NPJ * 512, 512, 512, WSPP(int, WS_ROUTE) + NT * 12 + NR, 0x3FFFF}; EpiProj E{WSPP(bf16, R_PROJ), W8_INV}; pg8::gemm_phase<EpiProj, pg8::StaticOrder, true, true>(P.lds, P.tid, g, S, E); }
            else { pg8::Gemm g{WSPP(bf16, WS_H), WSPP(bf16, WS_WIN) + (size_t)l * NPJ * 1024, 1024, 1024}; EpiProj E{WSPP(bf16, R_PROJ), 1.f}; pg8::gemm_phase(P.lds, P.tid, g, S, E); }
        }
        SEAM(pb + 0);
        if (PHON(1) && IN(pb + 1)) for (int rep = 0; rep < NREP(1); ++rep) { PCTX; prep_phase(P, l); __syncthreads(); }
        SEAM(pb + 1);
        if (PHON(2) && IN(pb + 2)) for (int rep = 0; rep < NREP(2); ++rep) { PCTX;
            { pg8::Gemm g{WSPP(bf16, R_LIN), WSPP(bf16, WS_LORA) + (size_t)l * 768 * 256, 256, 256}; pg8::LoraOrder S; S.init(NT / 256, 3, P.G, P.bid);
              EpiLora E{WSPP(float, R_SC), WSPP(bf16, R_SCH), WSPP(bf16, R_G), P.w0 + l * 256, P.a0 + l * 256, P.ka + l * 256, (rep + 1 < NREP(2)) ? WSPP(bf16, WS_PROBE) : WSPP(bf16, R_SCH), (rep + 1 < NREP(2)) ? WSPP(float, WS_PROBE) + 64 * MiB : WSPP(float, R_SC)}; pg8::gemm_phase(P.lds, P.tid, g, S, E); }
        }
        SEAM(pb + 2);
        if (PHON(3) && IN(pb + 3)) for (int rep = 0; rep < NREP(3); ++rep) { PCTX; mix_phase(P, l, rep); }
        SEAM(pb + 3);
        if (PHON(4) && IN(pb + 4)) for (int rep = 0; rep < NREP(4); ++rep) { PCTX; fin_phase(P, l); __syncthreads(); }
        SEAM(pb + 4);
        if (PHON(5) && IN(pb + 5)) for (int rep = 0; rep < NREP(5); ++rep) { PCTX;
            pg8::Gemm g{WSPP(bf16, R_YCAT), WSPP(bf16, WS_WOUT) + (size_t)l * 1024 * 1024, 1024, 1024}; pg8::StaticOrder S; S.init(NT / 256, 4, P.G, P.bid);
            EpiOut E{(rep + 1 < NREP(5)) ? WSPP(bf16, WS_PROBE) : WSPP(bf16, WS_XB), l == 0 ? P.x : (const float*)nullptr, WSPP(bf16, WS_XB), WSPP(float, WS_SMALL) + (size_t)l * 8 * 6144 + 2048}; pg8::gemm_phase(P.lds, P.tid, g, S, E);
        }
        SEAM(pb + 5);
        if (PHON(6) && IN(pb + 6)) for (int rep = 0; rep < NREP(6); ++rep) { PCTX; router_phase(P, l); __syncthreads(); }
        SEAM(pb + 6);
        if (PHON(7) && IN(pb + 7)) for (int rep = 0; rep < NREP(7); ++rep) { PCTX; scatter_phase(P, l); __syncthreads(); }
        SEAM(pb + 7);
        if (PHON(8) && IN(pb + 8)) for (int rep = 0; rep < NREP(8); ++rep) { PCTX;
            LAS int* tab = (LAS int*)(P.lds + MISC_OFF + 64); moe_tables(P, l, tab);
            pg8::Gemm g{WSPP(bf16, R_XS), WSPP(bf16, WS_WGU) + (size_t)l * 32 * 2048 * 512, 512, 512, WSPP(int, WS_ROUTE) + NT * 12, 32767};
            pg8::GroupedOrder S; S.init(tab[32], 8, P.G, P.bid); S.tstart = tab; S.nrow_e = 2048;
            EpiGU8 E{WSPP(unsigned char, R_ACT), P.b_gu + (size_t)l * 32 * 2048}; pg8::gemm_phase<EpiGU8, pg8::GroupedOrder, true, true>(P.lds, P.tid, g, S, E);
        }
        SEAM(pb + 8);
        if (PHON(9) && IN(pb + 9)) for (int rep = 0; rep < NREP(9); ++rep) { PCTX;
            LAS int* tab = (LAS int*)(P.lds + MISC_OFF + 64); moe_tables(P, l, tab);
            pg8::Gemm g{WSPP(bf16, R_ACT), WSPP(bf16, WS_WDN) + (size_t)l * 32 * 1024 * 512, 512, 512, WSPP(int, WS_ROUTE) + NT * 12 + NR, 0x3FFFF}; pg8::GroupedOrder S; S.init(tab[32], 4, P.G, P.bid); S.tstart = tab; S.nrow_e = 1024;
            EpiDN8 E{WSPP(bf16, R_YB), P.b_down + (size_t)l * 32 * 1024}; pg8::gemm_phase<EpiDN8, pg8::GroupedOrder, true, true>(P.lds, P.tid, g, S, E);
        }
        SEAM(pb + 9);
        if (PHON(10) && IN(pb + 10)) for (int rep = 0; rep < NREP(10); ++rep) { PCTX; combine_phase(P, l, (rep + 1 < NREP(10)) ? WSPP(float, WS_PROBE) : P.out, (rep + 1 < NREP(10)) ? WSPP(bf16, WS_PROBE) : WSPP(bf16, WS_XB)); __syncthreads(); }
        SEAM(pb + 10);
    }
#undef IN
#undef SEAM
}

extern "C" void kernel_launch(void* const* d_in, const int* in_sizes, int n_in, void* d_out, int out_size, void* d_ws, size_t ws_size, hipStream_t stream) {
    static int grid = 0;
    if (grid == 0) {
        if (n_in != 40 || out_size != NT * DM || ws_size < WS_PROBE + 256 * MiB) { fprintf(stderr, "kernel_launch: unexpected problem (n_in %d, out %d, ws %zu < %zu)\n", n_in, out_size, ws_size, (size_t)WS_END); grid = -1; return; }
        int dev = 0, cus = 0, per_cu = 0;
        if (hipGetDevice(&dev) != hipSuccess || hipDeviceGetAttribute(&cus, hipDeviceAttributeMultiprocessorCount, dev) != hipSuccess) { grid = -1; return; }
        if (hipFuncSetAttribute((const void*)mk_fwd, hipFuncAttributeMaxDynamicSharedMemorySize, LDS_BYTES) != hipSuccess) { fprintf(stderr, "kernel_launch: hipFuncSetAttribute failed\n"); grid = -1; return; }
        if (hipOccupancyMaxActiveBlocksPerMultiprocessor(&per_cu, (const void*)mk_fwd, NTHR, LDS_BYTES) != hipSuccess || per_cu < 1) fprintf(stderr, "kernel_launch: occupancy query says %d blocks per CU\n", per_cu);
        (void)hipGetLastError();
        grid = cus > 256 ? 256 : cus;
    }
    if (grid < 0) return;
    (void)hipMemsetAsync((char*)d_ws, 0, ZERO_BYTES, stream);
    Args a{};
    for (int i = 0; i < 40; ++i) a.in[i] = d_in[i];
    a.out = (float*)d_out; a.ws = (unsigned char*)d_ws;
#if MK_ONE_LAUNCH
    a.ph_lo = 0; a.ph_hi = N_PHASES;
    hipLaunchKernelGGL(mk_fwd, dim3(grid), dim3(NTHR), LDS_BYTES, stream, a);
#else
    for (int p = 0; p < N_PHASES; ++p) { a.ph_lo = p; a.ph_hi = p + 1; hipLaunchKernelGGL(mk_fwd, dim3(grid), dim3(NTHR), LDS_BYTES, stream, a); }
#endif
    const hipError_t le = hipPeekAtLastError();
    if (le != hipSuccess) fprintf(stderr, "kernel_launch: launch failed: %s\n", hipGetErrorName(le));
}
```
